# Optimizing an MI355X kernel written in HIP

```python
import jax, jax.numpy as jnp
from jax import lax
import numpy as np

D_MODEL = 2048
BATCH = 1
SEQ = 8192
DEPTH = 1

CHUNK = 64
D_MIX = D_MODEL
GMLP_HEADS = 8
GMLP_HEAD_DIM = 128
GMLP_WIDTH = GMLP_HEADS * GMLP_HEAD_DIM
GMLP_BLOCK = 128
MLA_HEADS = 8
MLA_NOPE = 128
MLA_ROPE = 64
MLA_QK = MLA_NOPE + MLA_ROPE
MLA_V = 128
MLA_WIDTH = MLA_HEADS * MLA_V
MLA_Q_RANK = 512
MLA_KV_RANK = 256
ROPE_THETA = 10000.0
Q_BLOCK = 128
PEER_HEADS = 8
PEER_N_KEYS = 128
PEER_N_EXPERTS = PEER_N_KEYS * PEER_N_KEYS
PEER_D_KEY = 256
PEER_D_HALF = PEER_D_KEY // 2
PEER_TOPK = 16
PEER_TOKEN_BLOCK = 128
RMS_EPS = 1e-6
IN_COLS = 2 * GMLP_WIDTH + MLA_Q_RANK + MLA_KV_RANK + MLA_ROPE
SPLIT_POINTS = (2 * GMLP_WIDTH, 2 * GMLP_WIDTH + MLA_Q_RANK, 2 * GMLP_WIDTH + MLA_Q_RANK + MLA_KV_RANK)

kernel_name = "hybrid_gmlp_mla_peer_block"


def rmsnorm(x, g):
    xf = x.astype(jnp.float32)
    xf = xf * lax.rsqrt(jnp.mean(xf * xf, axis=-1, keepdims=True) + RMS_EPS)
    return xf.astype(x.dtype) * g


def rope_tables(seq_len, dtype):
    pos = jnp.arange(seq_len, dtype=jnp.float32)
    inv_freq = ROPE_THETA ** (-jnp.arange(0, MLA_ROPE, 2, dtype=jnp.float32) / MLA_ROPE)
    ang = pos[:, None] * inv_freq[None, :]
    return jnp.cos(ang).astype(dtype), jnp.sin(ang).astype(dtype)


def apply_rope(x, cos, sin):
    c = cos[None, :, None, :]
    s = sin[None, :, None, :]
    x1, x2 = jnp.split(x, 2, axis=-1)
    return jnp.concatenate([x1 * c - x2 * s, x1 * s + x2 * c], axis=-1)


def gmlp_mixer(z, vnorm_g, ws, bs):
    bsz, seq, _ = z.shape
    z = jax.nn.gelu(z)
    u, v = jnp.split(z, 2, axis=-1)
    v = rmsnorm(v, vnorm_g)
    nblk = seq // GMLP_BLOCK
    v = v.reshape(bsz, nblk, GMLP_BLOCK, GMLP_HEADS, GMLP_HEAD_DIM)
    mask = jnp.tril(jnp.ones((GMLP_BLOCK, GMLP_BLOCK), dtype=bool))
    w = jnp.where(mask[None], ws, jnp.zeros_like(ws))
    sv = jnp.einsum('hij,bnjhc->bnihc', w, v) + bs.T[None, None, :, :, None]
    return u * sv.reshape(bsz, seq, GMLP_WIDTH)


def mla_mixer(c_q, c_kv, k_rope, qnorm_g, w_uq, kvnorm_g, w_ukv, qk_q_g, qk_k_g, cos, sin):
    bsz, seq, _ = c_q.shape
    q = (rmsnorm(c_q, qnorm_g) @ w_uq).reshape(bsz, seq, MLA_HEADS, MLA_QK)
    kv = (rmsnorm(c_kv, kvnorm_g) @ w_ukv).reshape(bsz, seq, MLA_HEADS, MLA_NOPE + MLA_V)
    k_nope, v = kv[..., :MLA_NOPE], kv[..., MLA_NOPE:]
    k_r = jnp.broadcast_to(k_rope[:, :, None, :], (bsz, seq, MLA_HEADS, MLA_ROPE))
    k = jnp.concatenate([k_nope, k_r], axis=-1)
    q = rmsnorm(q, qk_q_g)
    k = rmsnorm(k, qk_k_g)
    q = jnp.concatenate([q[..., :MLA_NOPE], apply_rope(q[..., MLA_NOPE:], cos, sin)], axis=-1)
    k = jnp.concatenate([k[..., :MLA_NOPE], apply_rope(k[..., MLA_NOPE:], cos, sin)], axis=-1)
    q = q * (MLA_QK ** -0.5)
    key_chunk = jnp.arange(seq) // CHUNK

    def attend_block(i):
        start = i * Q_BLOCK
        qb = lax.dynamic_slice_in_dim(q, start, Q_BLOCK, axis=1)
        s = jnp.einsum('bqhd,bkhd->bhqk', qb, k).astype(jnp.float32)
        q_chunk = (start + jnp.arange(Q_BLOCK)) // CHUNK
        allowed = key_chunk[None, :] <= q_chunk[:, None]
        s = jnp.where(allowed[None, None], s, -jnp.inf)
        p = jax.nn.softmax(s, axis=-1).astype(v.dtype)
        return jnp.einsum('bhqk,bkhd->bqhd', p, v)

    out = lax.map(attend_block, jnp.arange(seq // Q_BLOCK))
    return out.transpose(1, 0, 2, 3, 4).reshape(bsz, seq, MLA_WIDTH)


def peer_ffn(x, w_q, subkeys, u_tab, v_tab):
    bsz, seq, d = x.shape
    xb = x.reshape(bsz * seq // PEER_TOKEN_BLOCK, PEER_TOKEN_BLOCK, d)

    def retrieve(xblk):
        t = xblk.shape[0]
        q = (xblk @ w_q).reshape(t, PEER_HEADS, 2, PEER_D_HALF)
        s = jnp.einsum('thpd,hpnd->thpn', q, subkeys).astype(jnp.float32)
        sv, si = lax.top_k(s, PEER_TOPK)
        cand = (sv[:, :, 0, :, None] + sv[:, :, 1, None, :]).reshape(t, PEER_HEADS, PEER_TOPK * PEER_TOPK)
        cand_id = (si[:, :, 0, :, None] * PEER_N_KEYS + si[:, :, 1, None, :]).reshape(t, PEER_HEADS, PEER_TOPK * PEER_TOPK)
        top_s, top_pos = lax.top_k(cand, PEER_TOPK)
        experts = jnp.take_along_axis(cand_id, top_pos, axis=-1)
        g = jax.nn.softmax(top_s, axis=-1).astype(xblk.dtype)
        u = u_tab[experts]
        a = jax.nn.gelu(jnp.einsum('thkd,td->thk', u, xblk))
        vv = v_tab[experts]
        return jnp.einsum('thk,thkd->td', g * a, vv)

    return lax.map(retrieve, xb).reshape(bsz, seq, d)


def setup_inputs(seed: int = 0) -> dict:
    key = jax.random.key(seed)
    ks = jax.random.split(key, 18)
    f32 = jnp.float32
    nrm = lambda k, shape, scale: jax.random.normal(k, shape, f32) * scale
    gain = lambda k, n: 1.0 + 0.05 * jax.random.normal(k, (DEPTH, n), f32)
    return {
        "x": nrm(ks[0], (BATCH, SEQ, D_MODEL), 1.0),
        "norm_mix_g": gain(ks[1], D_MODEL),
        "w_in": nrm(ks[2], (DEPTH, D_MODEL, IN_COLS), D_MODEL ** -0.5),
        "gmlp_vnorm_g": gain(ks[3], GMLP_WIDTH),
        "gmlp_ws": nrm(ks[4], (DEPTH, GMLP_HEADS, GMLP_BLOCK, GMLP_BLOCK), GMLP_BLOCK ** -0.5),
        "gmlp_bs": 1.0 + nrm(ks[5], (DEPTH, GMLP_HEADS, GMLP_BLOCK), 0.1),
        "mla_qnorm_g": gain(ks[6], MLA_Q_RANK),
        "mla_w_uq": nrm(ks[7], (DEPTH, MLA_Q_RANK, MLA_HEADS * MLA_QK), MLA_Q_RANK ** -0.5),
        "mla_kvnorm_g": gain(ks[8], MLA_KV_RANK),
        "mla_w_ukv": nrm(ks[9], (DEPTH, MLA_KV_RANK, MLA_HEADS * (MLA_NOPE + MLA_V)), MLA_KV_RANK ** -0.5),
        "mla_qk_q_g": gain(ks[10], MLA_QK),
        "mla_qk_k_g": gain(ks[11], MLA_QK),
        "w_out": nrm(ks[12], (DEPTH, D_MIX, D_MODEL), D_MIX ** -0.5),
        "norm_ffn_g": gain(ks[13], D_MODEL),
        "peer_w_q": nrm(ks[14], (DEPTH, D_MODEL, PEER_HEADS * PEER_D_KEY), D_MODEL ** -0.5),
        "peer_subkeys": nrm(ks[15], (DEPTH, PEER_HEADS, 2, PEER_N_KEYS, PEER_D_HALF), PEER_D_HALF ** -0.5),
        "peer_u": nrm(ks[16], (DEPTH, PEER_N_EXPERTS, D_MODEL), D_MODEL ** -0.5),
        "peer_v": nrm(ks[17], (DEPTH, PEER_N_EXPERTS, D_MODEL), PEER_HEADS ** -0.5),
    }


def reference(x, norm_mix_g, w_in, gmlp_vnorm_g, gmlp_ws, gmlp_bs, mla_qnorm_g, mla_w_uq,
              mla_kvnorm_g, mla_w_ukv, mla_qk_q_g, mla_qk_k_g, w_out, norm_ffn_g,
              peer_w_q, peer_subkeys, peer_u, peer_v):
    cos, sin = rope_tables(x.shape[1], x.dtype)
    for l in range(DEPTH):
        h = rmsnorm(x, norm_mix_g[l])
        proj = h @ w_in[l]
        z_a, c_q, c_kv, k_rope = jnp.split(proj, SPLIT_POINTS, axis=-1)
        out_a = gmlp_mixer(z_a, gmlp_vnorm_g[l], gmlp_ws[l], gmlp_bs[l])
        out_b = mla_mixer(c_q, c_kv, k_rope, mla_qnorm_g[l], mla_w_uq[l], mla_kvnorm_g[l],
                          mla_w_ukv[l], mla_qk_q_g[l], mla_qk_k_g[l], cos, sin)
        x = x + jnp.concatenate([out_a, out_b], axis=-1) @ w_out[l]
        x = x + peer_ffn(rmsnorm(x, norm_ffn_g[l]), peer_w_q[l], peer_subkeys[l], peer_u[l], peer_v[l])
    return x
```

```cpp
#include <hip/hip_runtime.h>
#include <hip/hip_cooperative_groups.h>
#include <cstdio>
#include <cstdint>
namespace cg = cooperative_groups;

#define LAS __attribute__((address_space(3)))
typedef unsigned short bf16_t;
typedef short bf16x8 __attribute__((ext_vector_type(8)));
typedef short s16x4 __attribute__((ext_vector_type(4)));
typedef float f32x4 __attribute__((ext_vector_type(4)));
typedef float f32x16 __attribute__((ext_vector_type(16)));
typedef unsigned u32x4 __attribute__((ext_vector_type(4)));
typedef unsigned u32x2 __attribute__((ext_vector_type(2)));

#ifndef MK_ONE_LAUNCH
#define MK_ONE_LAUNCH 1
#endif

constexpr int S = 8192, DM = 2048, NIN = 2880, NINP = 3072;
constexpr int NPH = 9;
constexpr float EPS = 1e-6f;
constexpr int LDS_BYTES = 147456;
constexpr int NTHREADS = 512;

constexpr size_t MiB = 1u << 20;
constexpr size_t WS_CTL = 0;
constexpr size_t WS_ROWSS = 128 * 1024;
constexpr size_t WS_COS = 1 * MiB, WS_SIN = 2 * MiB;
constexpr size_t WS_RSTD1 = 3 * MiB;
constexpr size_t WS_EXP = 4 * MiB;
constexpr size_t WS_GATE = 8 * MiB;
constexpr size_t WS_WIN = 12 * MiB;
constexpr size_t WS_WUQ = 24 * MiB;
constexpr size_t WS_WUKV = 26 * MiB;
constexpr size_t WS_WOUT = 28 * MiB;
constexpr size_t WS_WS = 36 * MiB;
constexpr size_t WS_XB = 44 * MiB;
constexpr size_t WS_PROJ = 76 * MiB;
constexpr size_t WS_QRAW = 124 * MiB;
constexpr size_t WS_KVRAW = 148 * MiB;
constexpr size_t WS_QH = 180 * MiB;
constexpr size_t WS_KH = 204 * MiB;
constexpr size_t WS_VH = 228 * MiB;
constexpr size_t WS_MIX = 244 * MiB;
constexpr size_t WS_X1B = 276 * MiB;
constexpr size_t WS_SC = 308 * MiB;
constexpr size_t WS_UT = 372 * MiB;
constexpr size_t WS_VT = 436 * MiB;
constexpr size_t WS_END = 500 * MiB;

__device__ __forceinline__ unsigned f2bf(float f) { unsigned u = __builtin_bit_cast(unsigned, f); return (u + 0x7fffu + ((u >> 16) & 1u)) >> 16; }
__device__ __forceinline__ unsigned pk2(float lo, float hi) { return f2bf(lo) | (f2bf(hi) << 16); }
__device__ __forceinline__ float bf2f(unsigned short b) { return __builtin_bit_cast(float, (unsigned)b << 16); }
__device__ __forceinline__ float bflo(unsigned w) { return __builtin_bit_cast(float, w << 16); }
__device__ __forceinline__ float bfhi(unsigned w) { return __builtin_bit_cast(float, w & 0xffff0000u); }
__device__ __forceinline__ float wave_sum(float v) {
#pragma unroll
    for (int o = 32; o > 0; o >>= 1) v += __shfl_xor(v, o);
    return v;
}
__device__ __forceinline__ float wave_max(float v) {
#pragma unroll
    for (int o = 32; o > 0; o >>= 1) v = fmaxf(v, __shfl_xor(v, o));
    return v;
}
__device__ __forceinline__ float gelu_tanh(float x) {
    const float y = 0.7978845608028654f * (x + 0.044715f * x * x * x);
    return x / (1.0f + __expf(-2.0f * y));
}
__device__ __forceinline__ int crow(int r, int hi) { return (r & 3) + 8 * (r >> 2) + 4 * hi; }
#define LDS_WAIT() asm volatile("s_waitcnt lgkmcnt(0)" ::: "memory")
#define SBAR() __builtin_amdgcn_sched_barrier(0)

namespace pg8 {
#define PG8_LAS __attribute__((address_space(3)))
constexpr int BM = 256, BK = 64, HALF = 128, HTB = HALF * BK * 2  , STAGE_BYTES = 8 * HTB, NXCD = 8, WGM = 8;

__host__ __device__ __forceinline__ int lds_byte(int r, int c) { const int st = (r >> 4) * 2 + (c >> 5), rr = r & 15, cc = c & 31, ob = rr * 64 + cc * 2; return st * 1024 + (ob ^ (((ob >> 9) & 1) << 5)); }
__host__ __device__ __forceinline__ void stage_rc(int b, int& R, int& C) { const int st = b / 1024, sb = b % 1024, swz = sb ^ (((sb >> 9) & 1) << 5); R = (st >> 1) * 16 + swz / 64; C = (st & 1) * 32 + (swz % 64) / 2; }
__host__ __device__ __forceinline__ int perm32(int rho) { const int n = rho >> 4, i = rho & 15; return 8 * (i >> 2) + 4 * n + (i & 3); }

struct Unit { int pm, pn; };
struct Gemm { const bf16_t* A; const bf16_t* Bt; int M, N, K, lda, ldb; };

struct StaticOrder {
    int nM, nN, nwg, G, c;
    __host__ __device__ void init(int M, int N, int G_, int c_) { nM = M / BM; nN = N / BM; nwg = nM * nN; G = G_; c = c_; }
    __host__ __device__ bool next(int i, Unit& u) const {
        const long L = (long)i * G + c; if (L >= nwg) return false;
        int wgid = (int)L; { const int q = nwg / NXCD, r = nwg % NXCD, xcd = wgid % NXCD, off = wgid / NXCD; wgid = (xcd < r ? xcd * (q + 1) : r * (q + 1) + (xcd - r) * q) + off; }
        const int nig = WGM * nN, gid = wgid / nig, fm = gid * WGM, gsz = (nM - fm) < WGM ? (nM - fm) : WGM;
        u.pm = fm + ((wgid % nig) % gsz); u.pn = (wgid % nig) / gsz; return true;
    }
    __device__ __forceinline__ void a_ready(const Unit&) const {}
    __device__ __forceinline__ void done(const Unit&) const {}
};

template <class Epi, class Sched, bool ALIGN_EPI = false, bool SP2 = false>
__device__ __forceinline__ void gemm_phase(PG8_LAS unsigned char* lds, const Gemm g, const Sched& S, const Epi& E) {
    const int tid = threadIdx.x, wid = __builtin_amdgcn_readfirstlane(tid >> 6), lane = tid & 63, wr = wid >> 2, wc = wid & 3, fr = lane & 15, fq = lane >> 4;
    const int K = g.K, nt = K / BK;
    unsigned voffA[2], voffB[2];
#pragma unroll
    for (int i = 0; i < 2; ++i) { int R, C; stage_rc(tid * 16 + i * 8192, R, C); const int Rb = Epi::PERM ? ((R & ~31) + perm32(R & 31)) : R;
        voffA[i] = (unsigned)(R * g.lda + C) * 2u; voffB[i] = (unsigned)(Rb * g.ldb + C) * 2u; }
    const size_t kstep = (size_t)(BK * 2);
    const size_t hstepA = (size_t)HALF * g.lda * 2, hstepB = (size_t)HALF * g.ldb * 2;
    const size_t tstepA = 2 * hstepA, tstepB = 2 * hstepB;
    const unsigned ldsw = (unsigned)wid * 1024u;
    const int aoff = lds_byte(wr * 64 + fr, fq * 8), boff = lds_byte(wc * 32 + fr, fq * 8);
#define PG8_SA(b, h) (((b) * 2 + (h)) * HTB)
#define PG8_SB(b, h) ((4 + (b) * 2 + (h)) * HTB)
#define PG8_STAGE(bufoff, gbase, voff) do { _Pragma("unroll") for (int _i = 0; _i < 2; ++_i) \
        __builtin_amdgcn_global_load_lds((const unsigned*)((const char*)(gbase) + (voff)[_i]), (PG8_LAS unsigned*)(lds + (bufoff) + ldsw + _i * 8192), 16, 0, 0); } while (0)
#define PG8_LDA(dst, b, h) do { _Pragma("unroll") for (int m = 0; m < 4; ++m) _Pragma("unroll") for (int k = 0; k < 2; ++k) dst[m][k] = *(const PG8_LAS bf16x8*)(lds + PG8_SA(b, h) + aoff + m * 2048 + k * 1024); } while (0)
#define PG8_LDB(dst, b, h) do { _Pragma("unroll") for (int n = 0; n < 2; ++n) _Pragma("unroll") for (int k = 0; k < 2; ++k) dst[n][k] = *(const PG8_LAS bf16x8*)(lds + PG8_SB(b, h) + boff + n * 2048 + k * 1024); } while (0)
#define PG8_MMA(ai, bj, At, Bt) do { __builtin_amdgcn_s_setprio(1); _Pragma("unroll") for (int m = 0; m < 4; ++m) _Pragma("unroll") for (int n = 0; n < 2; ++n) _Pragma("unroll") for (int k = 0; k < 2; ++k) \
        acc[ai][bj][m][n] = __builtin_amdgcn_mfma_f32_16x16x32_bf16(Bt[n][k], At[m][k], acc[ai][bj][m][n], 0, 0, 0); __builtin_amdgcn_s_setprio(0); } while (0)
#define PG8_WAIT_V(n) asm volatile("s_waitcnt vmcnt(" #n ")" ::: "memory")
#define PG8_WAIT_L(n) asm volatile("s_waitcnt lgkmcnt(" #n ")" ::: "memory")
#define PG8_BAR __builtin_amdgcn_s_barrier()
#define PG8_SCHED __builtin_amdgcn_sched_barrier(0)
    Unit cur, nxt; int ui = 0;
    if (!S.next(0, cur)) return;
    f32x4 acc[2][2][4][2];
#pragma unroll
    for (int a = 0; a < 2; ++a)
#pragma unroll
        for (int b = 0; b < 2; ++b)
#pragma unroll
            for (int m = 0; m < 4; ++m)
#pragma unroll
                for (int n = 0; n < 2; ++n) acc[a][b][m][n] = (f32x4){0.f, 0.f, 0.f, 0.f};
    bf16x8 At[4][2], B0[2][2], B1[2][2];
    const char* cA = (const char*)g.A + (size_t)cur.pm * tstepA; const char* cB = (const char*)g.Bt + (size_t)cur.pn * tstepB;
    S.a_ready(cur);
    if constexpr (SP2) {
        PG8_STAGE(PG8_SB(0, 0), cB, voffB); PG8_STAGE(PG8_SB(0, 1), cB + hstepB, voffB); PG8_STAGE(PG8_SA(0, 0), cA, voffA); PG8_STAGE(PG8_SA(0, 1), cA + hstepA, voffA);
        if (wr == 1) PG8_BAR;
        PG8_WAIT_V(2); PG8_BAR;
        PG8_STAGE(PG8_SB(1, 0), cB + kstep, voffB); PG8_STAGE(PG8_SA(1, 0), cA + kstep, voffA); PG8_STAGE(PG8_SB(1, 1), cB + hstepB + kstep, voffB);
        PG8_WAIT_V(6); PG8_BAR;
    } else {
        PG8_STAGE(PG8_SB(0, 0), cB, voffB); PG8_STAGE(PG8_SA(0, 0), cA, voffA); PG8_STAGE(PG8_SB(0, 1), cB + hstepB, voffB); PG8_STAGE(PG8_SA(0, 1), cA + hstepA, voffA);
        if (wr == 1) PG8_BAR;
        PG8_WAIT_V(4); PG8_BAR;
        PG8_STAGE(PG8_SB(1, 0), cB + kstep, voffB); PG8_STAGE(PG8_SA(1, 0), cA + kstep, voffA); PG8_STAGE(PG8_SB(1, 1), cB + hstepB + kstep, voffB);
        PG8_WAIT_V(6); PG8_BAR;
    }
    for (;;) {
        const bool has_next = S.next(ui + 1, nxt);
        const char* nA = has_next ? (const char*)g.A + (size_t)nxt.pm * tstepA : cA; const char* nB = has_next ? (const char*)g.Bt + (size_t)nxt.pn * tstepB : cB;
        for (int t = 0; t < nt; t += 2) {
            const bool last = (t == nt - 2);
            const char* a1 = cA + (size_t)(t + 1) * kstep;
            const char* a2 = last ? nA : cA + (size_t)(t + 2) * kstep; const char* b2 = last ? nB : cB + (size_t)(t + 2) * kstep;
            const char* a3 = a2 + kstep; const char* b3 = b2 + kstep;
            if (last && has_next) S.a_ready(nxt);
            if constexpr (SP2) {
            PG8_LDB(B0, 0, 0); PG8_LDB(B1, 0, 1); PG8_SCHED; PG8_LDA(At, 0, 0); PG8_STAGE(PG8_SA(1, 1), a1 + hstepA, voffA);
            PG8_WAIT_V(8); PG8_WAIT_L(0); PG8_BAR; PG8_MMA(0, 0, At, B0); PG8_MMA(0, 1, At, B1); PG8_BAR; PG8_SCHED;
            PG8_LDA(At, 0, 1); PG8_STAGE(PG8_SB(0, 0), b2, voffB); PG8_STAGE(PG8_SB(0, 1), b2 + hstepB, voffB); PG8_STAGE(PG8_SA(0, 0), a2, voffA);
            PG8_WAIT_V(8); PG8_WAIT_L(0); PG8_BAR; PG8_MMA(1, 0, At, B0); PG8_MMA(1, 1, At, B1); PG8_BAR; PG8_SCHED;
            PG8_LDB(B0, 1, 0); PG8_LDB(B1, 1, 1); PG8_SCHED; PG8_LDA(At, 1, 0); PG8_STAGE(PG8_SA(0, 1), a2 + hstepA, voffA);
            PG8_WAIT_V(8); PG8_WAIT_L(0); PG8_BAR; PG8_MMA(0, 0, At, B0); PG8_MMA(0, 1, At, B1); PG8_BAR; PG8_SCHED;
            PG8_LDA(At, 1, 1); PG8_STAGE(PG8_SB(1, 0), b3, voffB); PG8_STAGE(PG8_SB(1, 1), b3 + hstepB, voffB); PG8_STAGE(PG8_SA(1, 0), a3, voffA);
            PG8_WAIT_V(8); PG8_WAIT_L(0); PG8_BAR; PG8_MMA(1, 0, At, B0); PG8_MMA(1, 1, At, B1); PG8_BAR; PG8_SCHED;
            } else {
            PG8_LDB(B0, 0, 0); PG8_SCHED; PG8_LDA(At, 0, 0); PG8_STAGE(PG8_SA(1, 1), a1 + hstepA, voffA);
            PG8_WAIT_L(8); PG8_BAR; PG8_WAIT_L(0); PG8_MMA(0, 0, At, B0); PG8_BAR; PG8_SCHED;
            PG8_LDB(B1, 0, 1); PG8_STAGE(PG8_SB(0, 0), b2, voffB);
            PG8_BAR; PG8_WAIT_L(0); PG8_MMA(0, 1, At, B1); PG8_BAR;
            PG8_LDA(At, 0, 1); PG8_STAGE(PG8_SA(0, 0), a2, voffA);
            PG8_BAR; PG8_WAIT_L(0); PG8_MMA(1, 0, At, B0); PG8_BAR; PG8_SCHED;
            PG8_STAGE(PG8_SB(0, 1), b2 + hstepB, voffB);
            PG8_WAIT_V(6); PG8_BAR; PG8_MMA(1, 1, At, B1); PG8_BAR;
            PG8_LDB(B0, 1, 0); PG8_SCHED; PG8_LDA(At, 1, 0); PG8_STAGE(PG8_SA(0, 1), a2 + hstepA, voffA);
            PG8_WAIT_L(8); PG8_BAR; PG8_WAIT_L(0); PG8_MMA(0, 0, At, B0); PG8_BAR; PG8_SCHED;
            PG8_LDB(B1, 1, 1); PG8_STAGE(PG8_SB(1, 0), b3, voffB);
            PG8_BAR; PG8_WAIT_L(0); PG8_MMA(0, 1, At, B1); PG8_BAR;
            PG8_LDA(At, 1, 1); PG8_STAGE(PG8_SA(1, 0), a3, voffA);
            PG8_BAR; PG8_WAIT_L(0); PG8_MMA(1, 0, At, B0); PG8_BAR; PG8_SCHED;
            PG8_STAGE(PG8_SB(1, 1), b3 + hstepB, voffB);
            PG8_WAIT_V(6); PG8_BAR; PG8_MMA(1, 1, At, B1); PG8_BAR;
            }
        }
        if constexpr (ALIGN_EPI) { if (wr == 0) PG8_BAR; }
        if constexpr (!Epi::AFTER_DRAIN) { E(acc, cur, wr, wc, fr, fq); S.done(cur); }
        if (!has_next) break;
#pragma unroll
        for (int a = 0; a < 2; ++a)
#pragma unroll
            for (int b = 0; b < 2; ++b)
#pragma unroll
                for (int m = 0; m < 4; ++m)
#pragma unroll
                    for (int n = 0; n < 2; ++n) acc[a][b][m][n] = (f32x4){0.f, 0.f, 0.f, 0.f};
        cur = nxt; cA = nA; cB = nB; ++ui;
        if constexpr (ALIGN_EPI) { if (wr == 1) PG8_BAR; }
    }
    PG8_WAIT_V(0);
    if constexpr (!ALIGN_EPI) { if (wr == 0) PG8_BAR; }
    PG8_BAR;
#undef PG8_SA
#undef PG8_SB
#undef PG8_STAGE
#undef PG8_LDA
#undef PG8_LDB
#undef PG8_MMA
#undef PG8_WAIT_V
#undef PG8_WAIT_L
#undef PG8_BAR
#undef PG8_SCHED
}

template <int MODE> struct Epi {
    static constexpr bool PERM = false, AFTER_DRAIN = false;
    const float* rowsrc; float inv_n; float* ss; bf16_t* ob; int ldc; float* of; const float* xin;
    __device__ __forceinline__ void operator()(const f32x4 (&acc)[2][2][4][2], const Unit& u, int wr, int wc, int fr, int fq) const {
#pragma unroll
        for (int ai = 0; ai < 2; ++ai)
#pragma unroll
            for (int m = 0; m < 4; ++m) {
                const int row = u.pm * BM + ai * HALF + wr * 64 + m * 16 + fr;
                float rs = 1.f;
                if (MODE == 1) rs = rowsrc[row];
                if (MODE == 2 || MODE == 5) rs = rsqrtf(rowsrc[row] * inv_n + EPS);
                float ssq = 0.f;
#pragma unroll
                for (int bj = 0; bj < 2; ++bj)
#pragma unroll
                    for (int n = 0; n < 2; ++n) {
                        const int col = u.pn * BM + bj * HALF + wc * 32 + n * 16 + fq * 4;
                        f32x4 v = acc[ai][bj][m][n] * rs;
                        if (MODE == 1) { if (u.pn < 8) { v[0] = gelu_tanh(v[0]); v[1] = gelu_tanh(v[1]); v[2] = gelu_tanh(v[2]); v[3] = gelu_tanh(v[3]); } }
                        if (MODE == 4) { const f32x4 xr = *(const f32x4*)(xin + (size_t)row * DM + col); v = v + xr; }
                        if (MODE == 1 || MODE == 4) ssq += (v[0] * v[0] + v[1] * v[1]) + (v[2] * v[2] + v[3] * v[3]);
                        if (MODE == 1 || MODE == 2 || MODE == 4) { u32x2 w; w.x = pk2(v[0], v[1]); w.y = pk2(v[2], v[3]); *(u32x2*)(ob + (size_t)row * ldc + col) = w; }
                        if (MODE == 4 || MODE == 5) *(f32x4*)(of + (size_t)row * DM + col) = v;
                    }
                if (MODE == 1) {
                    const int seg = (u.pn >= 4 && u.pn < 8) ? 0 : ((u.pn == 8 || u.pn == 9) ? 1 : (u.pn == 10 ? 2 : -1));
                    if (seg >= 0) { ssq += __shfl_xor(ssq, 16); ssq += __shfl_xor(ssq, 32); if (fq == 0) atomicAdd(ss + seg * S + row, ssq); }
                }
                if (MODE == 4) { ssq += __shfl_xor(ssq, 16); ssq += __shfl_xor(ssq, 32); if (fq == 0) atomicAdd(ss + row, ssq); }
            }
    }
};
}

struct Params {
    const float* in[18];
    float* out;
    unsigned char* ws;
    int ph_lo, ph_hi;
};

__device__ __forceinline__ void p0_transpose_item(const float* W, const float* g, int K, int N, bf16_t* WT, LAS float* scr, int item, int lane) {
    const int nblk = N / 32, kb = item / nblk, nb = item % nblk, k0 = 64 * kb, n0 = 32 * nb;
#pragma unroll 8
    for (int i = 0; i < 32; ++i) { const int kk = 2 * i + (lane >> 5); const float gv = g ? g[k0 + kk] : 1.f;
        scr[kk * 33 + (lane & 31)] = W[(size_t)(k0 + kk) * N + n0 + (lane & 31)] * gv; }
    LDS_WAIT(); asm volatile("" ::: "memory");
    const int c = lane & 7;
#pragma unroll
    for (int j = 0; j < 4; ++j) { const int n = (lane >> 3) + 8 * j; const LAS float* s = scr + (8 * c) * 33 + n;
        u32x4 o; o.x = pk2(s[0 * 33], s[1 * 33]); o.y = pk2(s[2 * 33], s[3 * 33]); o.z = pk2(s[4 * 33], s[5 * 33]); o.w = pk2(s[6 * 33], s[7 * 33]);
        *(u32x4*)(WT + (size_t)(n0 + n) * K + k0 + 8 * c) = o; }
    LDS_WAIT(); asm volatile("" ::: "memory");
}
__device__ __forceinline__ float row_to_bf16(const float* src, const float* g, bf16_t* dst, int lane) {
    float ss = 0.f;
#pragma unroll
    for (int i = 0; i < 8; ++i) {
        const int c = (i * 64 + lane) * 4;
        f32x4 v = *(const f32x4*)(src + c);
        ss += (v[0] * v[0] + v[1] * v[1]) + (v[2] * v[2] + v[3] * v[3]);
        if (g) { const f32x4 gv = *(const f32x4*)(g + c); v = v * gv; }
        u32x2 w; w.x = pk2(v[0], v[1]); w.y = pk2(v[2], v[3]);
        *(u32x2*)(dst + c) = w;
    }
    return ss;
}
__device__ __forceinline__ bf16x8 cvt8(const float* p) {
    const f32x4 a = *(const f32x4*)p, b = *(const f32x4*)(p + 4);
    u32x4 w; w.x = pk2(a[0], a[1]); w.y = pk2(a[2], a[3]); w.z = pk2(b[0], b[1]); w.w = pk2(b[2], b[3]);
    return __builtin_bit_cast(bf16x8, w);
}

__device__ __forceinline__ void phase0(const Params& p, LAS unsigned char* lds, int gw, int NGW, int wave, int lane) {
    unsigned char* ws = p.ws;
    LAS float* scr = (LAS float*)(lds + wave * 16384);
    const float* x = p.in[0];
    {
        constexpr int I_IN = (DM / 64) * (NIN / 32), I_UQ = (512 / 64) * (1536 / 32), I_UKV = (256 / 64) * (2048 / 32), I_OUT = (DM / 64) * (DM / 32);
        constexpr int NIT = I_IN + I_UQ + I_UKV + I_OUT;
        for (int it = gw; it < NIT; it += NGW) {
            int r = it;
            if (r < I_IN) { p0_transpose_item(p.in[2], p.in[1], DM, NIN, (bf16_t*)(ws + WS_WIN), scr, r, lane); continue; } r -= I_IN;
            if (r < I_UQ) { p0_transpose_item(p.in[7], p.in[6], 512, 1536, (bf16_t*)(ws + WS_WUQ), scr, r, lane); continue; } r -= I_UQ;
            if (r < I_UKV) { p0_transpose_item(p.in[9], p.in[8], 256, 2048, (bf16_t*)(ws + WS_WUKV), scr, r, lane); continue; } r -= I_UKV;
            p0_transpose_item(p.in[12], nullptr, DM, DM, (bf16_t*)(ws + WS_WOUT), scr, r, lane);
        }
    }
    for (int r = gw; r < NINP - NIN; r += NGW) {
        bf16_t* d = (bf16_t*)(ws + WS_WIN) + (size_t)(NIN + r) * DM;
#pragma unroll
        for (int i = 0; i < 4; ++i) *(u32x4*)(d + (i * 64 + lane) * 8) = (u32x4){0u, 0u, 0u, 0u};
    }
    {
        const float* wq = p.in[14]; const float* sk = p.in[15]; const float* g2 = p.in[13];
        bf16_t* WsT = (bf16_t*)(ws + WS_WS);
        const int r32 = lane & 31, hh = lane >> 5;
        for (int it = gw; it < 16 * 4 * 64; it += NGW) {
            const int hp = it >> 8, kb = (it >> 6) & 3, nb = it & 63;
            f32x16 acc = {};
            const float* ap = sk + ((size_t)(hp * 128 + kb * 32 + r32)) * 128 + hh * 8;
            const float* bp = wq + ((size_t)(nb * 32 + r32)) * DM + hp * 128 + hh * 8;
#pragma unroll
            for (int s = 0; s < 8; ++s) {
                const bf16x8 a = cvt8(ap + s * 16), b = cvt8(bp + s * 16);
                acc = __builtin_amdgcn_mfma_f32_32x32x16_bf16(a, b, acc, 0, 0, 0);
            }
            const int kcol = nb * 32 + r32; const float gk = g2[kcol];
#pragma unroll
            for (int r = 0; r < 16; ++r) WsT[(size_t)(hp * 128 + kb * 32 + crow(r, hh)) * DM + kcol] = (bf16_t)f2bf(acc[r] * gk);
        }
    }
    {
        bf16_t* xb = (bf16_t*)(ws + WS_XB); float* rstd1 = (float*)(ws + WS_RSTD1);
        for (int t = gw; t < S; t += NGW) {
            float ss = row_to_bf16(x + (size_t)t * DM, nullptr, xb + (size_t)t * DM, lane);
            ss = wave_sum(ss);
            if (lane == 0) rstd1[t] = rsqrtf(ss * (1.0f / DM) + EPS);
        }
    }
    {
        bf16_t* UT = (bf16_t*)(ws + WS_UT); bf16_t* VT = (bf16_t*)(ws + WS_VT);
        for (int e = gw; e < 2 * 16384; e += NGW) {
            if (e < 16384) (void)row_to_bf16(p.in[16] + (size_t)e * DM, p.in[13], UT + (size_t)e * DM, lane);
            else (void)row_to_bf16(p.in[17] + (size_t)(e - 16384) * DM, nullptr, VT + (size_t)(e - 16384) * DM, lane);
        }
    }
    {
        float* ct = (float*)(ws + WS_COS); float* st = (float*)(ws + WS_SIN);
        for (int it = gw; it < S * 32 / 64; it += NGW) {
            const int idx = it * 64 + lane, t = idx >> 5, j = idx & 31;
            const float inv_freq = powf(10000.0f, -(float)j / 32.0f);
            const float ang = (float)t * inv_freq;
            ct[idx] = cosf(ang); st[idx] = sinf(ang);
        }
    }
}

__device__ __forceinline__ void phase3(const Params& p, int gw, int NGW, int lane) {
    unsigned char* ws = p.ws;
    const bf16_t* qraw = (const bf16_t*)(ws + WS_QRAW); const bf16_t* kvraw = (const bf16_t*)(ws + WS_KVRAW); const bf16_t* proj = (const bf16_t*)(ws + WS_PROJ);
    bf16_t* Qh = (bf16_t*)(ws + WS_QH); bf16_t* Kh = (bf16_t*)(ws + WS_KH); bf16_t* Vh = (bf16_t*)(ws + WS_VH);
    const float* ct = (const float*)(ws + WS_COS); const float* st = (const float*)(ws + WS_SIN);
    const float* gq = p.in[10]; const float* gk = p.in[11];
    const float gq0 = gq[lane], gq1 = gq[64 + lane], gq2 = gq[128 + lane], gk0 = gk[lane], gk1 = gk[64 + lane], gk2 = gk[128 + lane];
    constexpr float QS = 0.07216878364870322f * 1.4426950408889634f;
    for (int t = gw; t < S; t += NGW) {
        const float cs = ct[t * 32 + (lane & 31)], sn = st[t * 32 + (lane & 31)];
        const float kr = bf2f(proj[(size_t)t * NINP + 2816 + lane]);
#pragma unroll
        for (int h = 0; h < 8; ++h) {
            const bf16_t* qp = qraw + (size_t)t * 1536 + h * 192;
            float q0 = bf2f(qp[lane]), q1 = bf2f(qp[64 + lane]), q2 = bf2f(qp[128 + lane]);
            float ss = wave_sum(q0 * q0 + q1 * q1 + q2 * q2);
            float rs = rsqrtf(ss * (1.0f / 192.0f) + EPS);
            q0 *= rs * gq0; q1 *= rs * gq1; q2 *= rs * gq2;
            float pr = __shfl_xor(q2, 32);
            q2 = (lane < 32) ? (q2 * cs - pr * sn) : (pr * sn + q2 * cs);
            bf16_t* qo = Qh + ((size_t)h * S + t) * 192;
            qo[lane] = (bf16_t)f2bf(q0 * QS); qo[64 + lane] = (bf16_t)f2bf(q1 * QS); qo[128 + lane] = (bf16_t)f2bf(q2 * QS);
            const bf16_t* kp = kvraw + (size_t)t * 2048 + h * 256;
            float k0 = bf2f(kp[lane]), k1 = bf2f(kp[64 + lane]), k2 = kr;
            ss = wave_sum(k0 * k0 + k1 * k1 + k2 * k2);
            rs = rsqrtf(ss * (1.0f / 192.0f) + EPS);
            k0 *= rs * gk0; k1 *= rs * gk1; k2 *= rs * gk2;
            pr = __shfl_xor(k2, 32);
            k2 = (lane < 32) ? (k2 * cs - pr * sn) : (pr * sn + k2 * cs);
            bf16_t* ko = Kh + ((size_t)h * S + t) * 192;
            ko[lane] = (bf16_t)f2bf(k0); ko[64 + lane] = (bf16_t)f2bf(k1); ko[128 + lane] = (bf16_t)f2bf(k2);
            bf16_t* vo = Vh + ((size_t)h * S + t) * 128;
            vo[lane] = kp[128 + lane]; vo[64 + lane] = kp[192 + lane];
        }
    }
}

constexpr int KP = 400, VP = 320;
constexpr int ATT_BUF = 64 * KP + 64 * VP;
template <int OFF> __device__ __forceinline__ s16x4 tr_read(unsigned addr) {
    s16x4 r; asm volatile("ds_read_b64_tr_b16 %0, %1 offset:%2" : "=&v"(r) : "v"(addr), "i"(OFF) : "memory"); return r;
}
__device__ __forceinline__ unsigned cvtpk(float lo, float hi) { unsigned r; asm volatile("v_cvt_pk_bf16_f32 %0, %1, %2" : "=v"(r) : "v"(lo), "v"(hi)); return r; }
#define PK8(L, H) ((bf16x8){L[0], L[1], L[2], L[3], H[0], H[1], H[2], H[3]})
constexpr float ATT_THR = 8.0f;

__device__ __forceinline__ void attn_tile(const LAS unsigned char* kbuf, unsigned vaddr, const bf16x8 (&qr)[12], f32x16 (&o)[4], float& m, float& lsum, int lane) {
    f32x16 pacc = {};
    const LAS unsigned char* kp = kbuf + (lane & 31) * KP + (lane >> 5) * 16;
#pragma unroll
    for (int ks = 0; ks < 12; ++ks) { const bf16x8 a = *(const LAS bf16x8*)(kp + ks * 32); pacc = __builtin_amdgcn_mfma_f32_32x32x16_bf16(a, qr[ks], pacc, 0, 0, 0); }
    float pmax = pacc[0];
#pragma unroll
    for (int r = 1; r < 16; ++r) pmax = fmaxf(pmax, pacc[r]);
    pmax = fmaxf(pmax, __shfl_xor(pmax, 32));
    if (!__all(pmax - m <= ATT_THR)) {
        const float mn = fmaxf(m, pmax); const float alpha = __builtin_amdgcn_exp2f(m - mn); m = mn; lsum *= alpha;
#pragma unroll
        for (int d = 0; d < 4; ++d)
#pragma unroll
            for (int r = 0; r < 16; ++r) o[d][r] *= alpha;
    }
    float ps = 0.f;
#pragma unroll
    for (int r = 0; r < 16; ++r) { pacc[r] = __builtin_amdgcn_exp2f(pacc[r] - m); ps += pacc[r]; }
    ps += __shfl_xor(ps, 32);
    lsum += ps;
    u32x4 w0 = {cvtpk(pacc[0], pacc[1]), cvtpk(pacc[2], pacc[3]), cvtpk(pacc[4], pacc[5]), cvtpk(pacc[6], pacc[7])};
    u32x4 w1 = {cvtpk(pacc[8], pacc[9]), cvtpk(pacc[10], pacc[11]), cvtpk(pacc[12], pacc[13]), cvtpk(pacc[14], pacc[15])};
    const bf16x8 pb0 = __builtin_bit_cast(bf16x8, w0), pb1 = __builtin_bit_cast(bf16x8, w1);
#define VOFF(d0, s, hi) (((16 * (s) + 8 * (hi)) * VP) + 64 * (d0))
    const s16x4 a00l = tr_read<VOFF(0, 0, 0)>(vaddr), a00h = tr_read<VOFF(0, 0, 1)>(vaddr), a01l = tr_read<VOFF(0, 1, 0)>(vaddr), a01h = tr_read<VOFF(0, 1, 1)>(vaddr);
    const s16x4 a10l = tr_read<VOFF(1, 0, 0)>(vaddr), a10h = tr_read<VOFF(1, 0, 1)>(vaddr), a11l = tr_read<VOFF(1, 1, 0)>(vaddr), a11h = tr_read<VOFF(1, 1, 1)>(vaddr);
    const s16x4 a20l = tr_read<VOFF(2, 0, 0)>(vaddr), a20h = tr_read<VOFF(2, 0, 1)>(vaddr), a21l = tr_read<VOFF(2, 1, 0)>(vaddr), a21h = tr_read<VOFF(2, 1, 1)>(vaddr);
    const s16x4 a30l = tr_read<VOFF(3, 0, 0)>(vaddr), a30h = tr_read<VOFF(3, 0, 1)>(vaddr), a31l = tr_read<VOFF(3, 1, 0)>(vaddr), a31h = tr_read<VOFF(3, 1, 1)>(vaddr);
#undef VOFF
    LDS_WAIT(); SBAR();
    o[0] = __builtin_amdgcn_mfma_f32_32x32x16_bf16(PK8(a00l, a00h), pb0, o[0], 0, 0, 0); o[0] = __builtin_amdgcn_mfma_f32_32x32x16_bf16(PK8(a01l, a01h), pb1, o[0], 0, 0, 0);
    o[1] = __builtin_amdgcn_mfma_f32_32x32x16_bf16(PK8(a10l, a10h), pb0, o[1], 0, 0, 0); o[1] = __builtin_amdgcn_mfma_f32_32x32x16_bf16(PK8(a11l, a11h), pb1, o[1], 0, 0, 0);
    o[2] = __builtin_amdgcn_mfma_f32_32x32x16_bf16(PK8(a20l, a20h), pb0, o[2], 0, 0, 0); o[2] = __builtin_amdgcn_mfma_f32_32x32x16_bf16(PK8(a21l, a21h), pb1, o[2], 0, 0, 0);
    o[3] = __builtin_amdgcn_mfma_f32_32x32x16_bf16(PK8(a30l, a30h), pb0, o[3], 0, 0, 0); o[3] = __builtin_amdgcn_mfma_f32_32x32x16_bf16(PK8(a31l, a31h), pb1, o[3], 0, 0, 0);
}

__device__ __forceinline__ void attn_unit(const Params& p, LAS unsigned char* lds, int head, int qb, int tid, int wave, int lane) {
    unsigned char* ws = p.ws;
    const bf16_t* Qh = (const bf16_t*)(ws + WS_QH); const bf16_t* Kh = (const bf16_t*)(ws + WS_KH); const bf16_t* Vh = (const bf16_t*)(ws + WS_VH);
    bf16_t* mix = (bf16_t*)(ws + WS_MIX);
    const int rg = wave & 3, kh = wave >> 2, r32 = lane & 31, hh = lane >> 5;
    const int q0row = qb * 128 + rg * 32;
    bf16x8 qr[12];
    {
        const bf16_t* qp = Qh + ((size_t)head * S + q0row + r32) * 192 + hh * 8;
#pragma unroll
        for (int ks = 0; ks < 12; ++ks) qr[ks] = *(const bf16x8*)(qp + ks * 16);
    }
    const int ntiles = 2 * qb + 2, mylast = 2 * qb + (rg >> 1);
    float m = -1e30f, lsum = 0.f; f32x16 o[4] = {};
    int kgo[3], klo[3], vgo[2], vlo[2];
#pragma unroll
    for (int i = 0; i < 3; ++i) { const int pc = tid + 512 * i, r = pc / 24, c = pc % 24; kgo[i] = r * 192 + c * 8; klo[i] = r * KP + c * 16; }
#pragma unroll
    for (int i = 0; i < 2; ++i) { const int pc = tid + 512 * i, r = pc >> 4, c = pc & 15; vgo[i] = r * 128 + c * 8; vlo[i] = 64 * KP + r * VP + c * 16; }
    const bf16_t* kbase = Kh + (size_t)head * S * 192; const bf16_t* vbase = Vh + (size_t)head * S * 128;
    u32x4 sk0, sk1, sk2, sv0, sv1;
#define ATT_LOAD(t) do { const bf16_t* kt = kbase + (size_t)(t) * 64 * 192; const bf16_t* vt = vbase + (size_t)(t) * 64 * 128; \
        sk0 = *(const u32x4*)(kt + kgo[0]); sk1 = *(const u32x4*)(kt + kgo[1]); sk2 = *(const u32x4*)(kt + kgo[2]); sv0 = *(const u32x4*)(vt + vgo[0]); sv1 = *(const u32x4*)(vt + vgo[1]); } while (0)
#define ATT_WRITE(b) do { LAS unsigned char* bb = lds + (b) * ATT_BUF; *(LAS u32x4*)(bb + klo[0]) = sk0; *(LAS u32x4*)(bb + klo[1]) = sk1; *(LAS u32x4*)(bb + klo[2]) = sk2; \
        *(LAS u32x4*)(bb + vlo[0]) = sv0; *(LAS u32x4*)(bb + vlo[1]) = sv1; } while (0)
    const unsigned ldsbase = (unsigned)(size_t)lds;
    const unsigned vrel = (unsigned)(64 * KP + (32 * kh + 4 * hh + ((lane & 15) >> 2)) * VP + (16 * ((lane >> 4) & 1) + 4 * (lane & 3)) * 2);
    ATT_LOAD(0); ATT_WRITE(0); __syncthreads();
    for (int t = 0; t < ntiles; ++t) {
        const bool more = (t + 1 < ntiles);
        if (more) ATT_LOAD(t + 1);
        if (t <= mylast) {
            const int b = t & 1;
            attn_tile(lds + b * ATT_BUF + (32 * kh) * KP, ldsbase + b * ATT_BUF + vrel, qr, o, m, lsum, lane);
        }
        if (more) ATT_WRITE((t + 1) & 1);
        __syncthreads();
    }
#undef ATT_LOAD
#undef ATT_WRITE
    LAS float* scr = (LAS float*)lds + (size_t)rg * 66 * 64 + lane;
    if (kh == 1) {
        scr[0] = m; scr[64] = lsum;
#pragma unroll
        for (int d = 0; d < 4; ++d)
#pragma unroll
            for (int r = 0; r < 16; ++r) scr[(2 + d * 16 + r) * 64] = o[d][r];
    }
    __syncthreads();
    if (kh == 0) {
        const float m2 = scr[0], l2 = scr[64];
        const float mn = fmaxf(m, m2), a1 = __builtin_amdgcn_exp2f(m - mn), a2 = __builtin_amdgcn_exp2f(m2 - mn);
        const float inv = 1.0f / (lsum * a1 + l2 * a2);
        bf16_t* op = mix + (size_t)(q0row + r32) * DM + 1024 + head * 128 + 4 * hh;
#pragma unroll
        for (int d = 0; d < 4; ++d)
#pragma unroll
            for (int g4 = 0; g4 < 4; ++g4) {
                float v[4];
#pragma unroll
                for (int i = 0; i < 4; ++i) { const int r = 4 * g4 + i; v[i] = (o[d][r] * a1 + scr[(2 + d * 16 + r) * 64] * a2) * inv; }
                u32x2 w; w.x = pk2(v[0], v[1]); w.y = pk2(v[2], v[3]);
                *(u32x2*)(op + 32 * d + 8 * g4) = w;
            }
    }
    __syncthreads();
}

__device__ __forceinline__ void gmlp_unit(const Params& p, LAS unsigned char* lds, int nb, int h, int tid, int wave, int lane) {
    unsigned char* ws = p.ws;
    const bf16_t* proj = (const bf16_t*)(ws + WS_PROJ); bf16_t* mix = (bf16_t*)(ws + WS_MIX);
    const float* ssv = (const float*)(ws + WS_ROWSS);
    const float* vg = p.in[3]; const float* wsp = p.in[4]; const float* bs = p.in[5];
#pragma unroll
    for (int i = 0; i < 4; ++i) {
        const int pc = tid + 512 * i, r = pc >> 4, c = pc & 15, t = nb * 128 + r;
        const u32x4 w = *(const u32x4*)(proj + (size_t)t * NINP + 1024 + h * 128 + c * 8);
        const float rs = rsqrtf(ssv[t] * (1.0f / 1024.0f) + EPS);
        const f32x4 g0 = *(const f32x4*)(vg + h * 128 + c * 8), g1 = *(const f32x4*)(vg + h * 128 + c * 8 + 4);
        u32x4 ov;
        ov.x = pk2(bflo(w.x) * rs * g0[0], bfhi(w.x) * rs * g0[1]); ov.y = pk2(bflo(w.y) * rs * g0[2], bfhi(w.y) * rs * g0[3]);
        ov.z = pk2(bflo(w.z) * rs * g1[0], bfhi(w.z) * rs * g1[1]); ov.w = pk2(bflo(w.w) * rs * g1[2], bfhi(w.w) * rs * g1[3]);
        *(LAS u32x4*)(lds + r * VP + c * 16) = ov;
    }
    __syncthreads();
    const int ib = wave & 3, ch = wave >> 2, r32 = lane & 31, hh = lane >> 5;
    const int irow = 32 * ib + r32;
    f32x16 acc0 = {}, acc1 = {};
    const unsigned vaddr = (unsigned)(size_t)lds + (unsigned)((8 * hh + ((lane & 15) >> 2)) * VP + (64 * ch + 16 * ((lane >> 4) & 1) + 4 * (lane & 3)) * 2);
    const float* wrow = wsp + ((size_t)h * 128 + irow) * 128 + hh * 8;
#define GSTEP(s) do { if ((s) < 2 * (ib + 1)) { \
        const f32x4 wa = *(const f32x4*)(wrow + (s) * 16), wb = *(const f32x4*)(wrow + (s) * 16 + 4); const int j0 = (s) * 16 + hh * 8; \
        u32x4 aw; aw.x = pk2(j0 + 0 <= irow ? wa[0] : 0.f, j0 + 1 <= irow ? wa[1] : 0.f); aw.y = pk2(j0 + 2 <= irow ? wa[2] : 0.f, j0 + 3 <= irow ? wa[3] : 0.f); \
        aw.z = pk2(j0 + 4 <= irow ? wb[0] : 0.f, j0 + 5 <= irow ? wb[1] : 0.f); aw.w = pk2(j0 + 6 <= irow ? wb[2] : 0.f, j0 + 7 <= irow ? wb[3] : 0.f); \
        const bf16x8 af = __builtin_bit_cast(bf16x8, aw); \
        const s16x4 b0l = tr_read<(16 * (s)) * VP>(vaddr), b0h = tr_read<(16 * (s) + 4) * VP>(vaddr), b1l = tr_read<(16 * (s)) * VP + 64>(vaddr), b1h = tr_read<(16 * (s) + 4) * VP + 64>(vaddr); \
        LDS_WAIT(); SBAR(); \
        acc0 = __builtin_amdgcn_mfma_f32_32x32x16_bf16(af, PK8(b0l, b0h), acc0, 0, 0, 0); acc1 = __builtin_amdgcn_mfma_f32_32x32x16_bf16(af, PK8(b1l, b1h), acc1, 0, 0, 0); } } while (0)
    GSTEP(0); GSTEP(1); GSTEP(2); GSTEP(3); GSTEP(4); GSTEP(5); GSTEP(6); GSTEP(7);
#undef GSTEP
#pragma unroll
    for (int r = 0; r < 16; ++r) {
        const int i = 32 * ib + crow(r, hh), t = nb * 128 + i; const float b = bs[h * 128 + i];
        const int c0 = h * 128 + 64 * ch + r32;
        const float u0 = bf2f(proj[(size_t)t * NINP + c0]), u1 = bf2f(proj[(size_t)t * NINP + c0 + 32]);
        mix[(size_t)t * DM + c0] = (bf16_t)f2bf(u0 * (acc0[r] + b)); mix[(size_t)t * DM + c0 + 32] = (bf16_t)f2bf(u1 * (acc1[r] + b));
    }
    __syncthreads();
}

__device__ __forceinline__ void select16(float& a0, float& a1, float& sv, int& si, int lane) {
    const float NEG = -3.0e38f;
    float x0 = a0, x1 = a1, rv = 0.f; int ri = 0;
#pragma unroll 1
    for (int k = 0; k < 16; ++k) {
        const float M = wave_max(fmaxf(x0, x1));
        const unsigned long long b0 = __ballot(x0 == M), b1 = __ballot(x1 == M);
        const bool use0 = (b0 != 0ull);
        const unsigned long long bb = use0 ? b0 : b1;
        const int ln = __ffsll((long long)bb) - 1;
        const int idx = use0 ? ln : 64 + ln;
        const bool own = (lane == ln);
        x0 = (own && use0) ? NEG : x0;
        x1 = (own && !use0) ? NEG : x1;
        rv = (lane == k) ? M : rv; ri = (lane == k) ? idx : ri;
    }
    a0 = x0; a1 = x1; sv = rv; si = ri;
}
__device__ __forceinline__ void phase7(const Params& p, int gw, int NGW, int lane) {
    unsigned char* ws = p.ws;
    const float* sc = (const float*)(ws + WS_SC); int* ex = (int*)(ws + WS_EXP); float* gt = (float*)(ws + WS_GATE);
    const float NEG = -3.0e38f;
    for (int it = gw; it < S * 8; it += NGW) {
        const int t = it >> 3, h = it & 7;
        const float* b = sc + (size_t)t * DM + h * 256;
        float a0 = b[lane], a1 = b[64 + lane], c0 = b[128 + lane], c1 = b[192 + lane];
        float sv1 = 0.f, sv2 = 0.f; int si1 = 0, si2 = 0;
        select16(a0, a1, sv1, si1, lane);
        select16(c0, c1, sv2, si2, lane);
        const int i = lane >> 2, jb = (lane & 3) * 4;
        const float s1 = __shfl(sv1, i); const int id1 = __shfl(si1, i) * 128;
        float d0 = s1 + __shfl(sv2, jb + 0), d1 = s1 + __shfl(sv2, jb + 1), d2 = s1 + __shfl(sv2, jb + 2), d3 = s1 + __shfl(sv2, jb + 3);
        const int e0 = id1 + __shfl(si2, jb + 0), e1 = id1 + __shfl(si2, jb + 1), e2 = id1 + __shfl(si2, jb + 2), e3 = id1 + __shfl(si2, jb + 3);
        float ts = 0.f; int te = 0;
#pragma unroll 1
        for (int k = 0; k < 16; ++k) {
            const float M = wave_max(fmaxf(fmaxf(d0, d1), fmaxf(d2, d3)));
            const bool has = (d0 == M) || (d1 == M) || (d2 == M) || (d3 == M);
            const unsigned long long bl = __ballot(has);
            const int ln = __ffsll((long long)bl) - 1;
            const bool own = (lane == ln);
            const bool m0 = (d0 == M), m1 = !m0 && (d1 == M), m2 = !m0 && !m1 && (d2 == M), m3 = !m0 && !m1 && !m2;
            int sel = m0 ? e0 : (m1 ? e1 : (m2 ? e2 : e3));
            d0 = (own && m0) ? NEG : d0; d1 = (own && m1) ? NEG : d1; d2 = (own && m2) ? NEG : d2; d3 = (own && m3) ? NEG : d3;
            sel = __shfl(sel, ln);
            ts = (lane == k) ? M : ts; te = (lane == k) ? sel : te;
        }
        const float mx = __shfl(ts, 0);
        const float e = (lane < 16) ? __expf(ts - mx) : 0.f;
        const float sum = wave_sum(e);
        if (lane < 16) { ex[(size_t)t * 128 + h * 16 + lane] = te; gt[(size_t)t * 128 + h * 16 + lane] = e / sum; }
    }
}

__device__ __forceinline__ float dot8(u32x4 w, const float (&x)[32], int base) {
    return (bflo(w.x) * x[base + 0] + bfhi(w.x) * x[base + 1]) + (bflo(w.y) * x[base + 2] + bfhi(w.y) * x[base + 3]) +
           (bflo(w.z) * x[base + 4] + bfhi(w.z) * x[base + 5]) + (bflo(w.w) * x[base + 6] + bfhi(w.w) * x[base + 7]);
}
__device__ __forceinline__ void phase8(const Params& p, int gw, int NGW, int lane) {
    unsigned char* ws = p.ws;
    const bf16_t* x1b = (const bf16_t*)(ws + WS_X1B); const bf16_t* UT = (const bf16_t*)(ws + WS_UT); const bf16_t* VT = (const bf16_t*)(ws + WS_VT);
    const int* ex = (const int*)(ws + WS_EXP); const float* gt = (const float*)(ws + WS_GATE); const float* ss2 = (const float*)(ws + WS_ROWSS) + 3 * S;
    float* out = p.out;
    for (int t = gw; t < S; t += NGW) {
        const float rstd2 = rsqrtf(ss2[t] * (1.0f / DM) + EPS);
        float xf[32];
#pragma unroll
        for (int i = 0; i < 4; ++i) {
            const u32x4 w = *(const u32x4*)(x1b + (size_t)t * DM + (i * 64 + lane) * 8);
            xf[8 * i + 0] = bflo(w.x); xf[8 * i + 1] = bfhi(w.x); xf[8 * i + 2] = bflo(w.y); xf[8 * i + 3] = bfhi(w.y);
            xf[8 * i + 4] = bflo(w.z); xf[8 * i + 5] = bfhi(w.z); xf[8 * i + 6] = bflo(w.w); xf[8 * i + 7] = bfhi(w.w);
        }
        float acc[32];
#pragma unroll
        for (int i = 0; i < 32; ++i) acc[i] = 0.f;
#pragma unroll 1
        for (int gi = 0; gi < 32; ++gi) {
            const int* ep = ex + (size_t)t * 128 + gi * 4; const float* gp = gt + (size_t)t * 128 + gi * 4;
            const int e0 = ep[0], e1 = ep[1], e2 = ep[2], e3 = ep[3];
            float p0 = 0.f, p1 = 0.f, p2 = 0.f, p3 = 0.f;
            {
                const bf16_t* u0 = UT + (size_t)e0 * DM + lane * 8; const bf16_t* u1 = UT + (size_t)e1 * DM + lane * 8;
                const bf16_t* u2 = UT + (size_t)e2 * DM + lane * 8; const bf16_t* u3 = UT + (size_t)e3 * DM + lane * 8;
#pragma unroll
                for (int i = 0; i < 4; ++i) {
                    const u32x4 w0 = *(const u32x4*)(u0 + i * 512), w1 = *(const u32x4*)(u1 + i * 512), w2 = *(const u32x4*)(u2 + i * 512), w3 = *(const u32x4*)(u3 + i * 512);
                    p0 += dot8(w0, xf, 8 * i); p1 += dot8(w1, xf, 8 * i); p2 += dot8(w2, xf, 8 * i); p3 += dot8(w3, xf, 8 * i);
                }
            }
            p0 = wave_sum(p0); p1 = wave_sum(p1); p2 = wave_sum(p2); p3 = wave_sum(p3);
            const float c0 = gp[0] * gelu_tanh(rstd2 * p0), c1 = gp[1] * gelu_tanh(rstd2 * p1), c2 = gp[2] * gelu_tanh(rstd2 * p2), c3 = gp[3] * gelu_tanh(rstd2 * p3);
            {
                const bf16_t* v0 = VT + (size_t)e0 * DM + lane * 8; const bf16_t* v1 = VT + (size_t)e1 * DM + lane * 8;
                const bf16_t* v2 = VT + (size_t)e2 * DM + lane * 8; const bf16_t* v3 = VT + (size_t)e3 * DM + lane * 8;
#pragma unroll
                for (int i = 0; i < 4; ++i) {
                    const u32x4 w0 = *(const u32x4*)(v0 + i * 512), w1 = *(const u32x4*)(v1 + i * 512), w2 = *(const u32x4*)(v2 + i * 512), w3 = *(const u32x4*)(v3 + i * 512);
#define ACC8(W_, c) do { acc[8 * i + 0] += (c) * bflo((W_).x); acc[8 * i + 1] += (c) * bfhi((W_).x); acc[8 * i + 2] += (c) * bflo((W_).y); acc[8 * i + 3] += (c) * bfhi((W_).y); \
                        acc[8 * i + 4] += (c) * bflo((W_).z); acc[8 * i + 5] += (c) * bfhi((W_).z); acc[8 * i + 6] += (c) * bflo((W_).w); acc[8 * i + 7] += (c) * bfhi((W_).w); } while (0)
                    ACC8(w0, c0); ACC8(w1, c1); ACC8(w2, c2); ACC8(w3, c3);
#undef ACC8
                }
            }
        }
#pragma unroll
        for (int i = 0; i < 4; ++i) {
            float* op = out + (size_t)t * DM + (i * 64 + lane) * 8;
            f32x4 a = *(const f32x4*)op, b = *(const f32x4*)(op + 4);
            a[0] += acc[8 * i + 0]; a[1] += acc[8 * i + 1]; a[2] += acc[8 * i + 2]; a[3] += acc[8 * i + 3];
            b[0] += acc[8 * i + 4]; b[1] += acc[8 * i + 5]; b[2] += acc[8 * i + 6]; b[3] += acc[8 * i + 7];
            *(f32x4*)op = a; *(f32x4*)(op + 4) = b;
        }
    }
}

__global__ void __launch_bounds__(NTHREADS, 2) mega(Params p) {
    extern __shared__ __attribute__((aligned(16))) unsigned char lds_raw[];
    LAS unsigned char* lds = (LAS unsigned char*)lds_raw;
    cg::grid_group grid = cg::this_grid();
    const int tid = threadIdx.x, lane = tid & 63, wave = __builtin_amdgcn_readfirstlane(tid >> 6);
    const int G = gridDim.x, bx = blockIdx.x;
    const int gw = bx * 8 + wave, NGW = G * 8;
    unsigned char* ws = p.ws;
    const int lo = p.ph_lo, hi = p.ph_hi;
#ifndef PH_MASK
#define PH_MASK 0x1ff
#endif
#define IN(k) (((PH_MASK >> (k)) & 1) && lo <= (k) && (k) < hi)
#define SEAM(k) do { if (IN(k) && IN((k) + 1)) grid.sync(); } while (0)

    if (IN(0)) phase0(p, lds, gw, NGW, wave, lane);
    SEAM(0);
    if (IN(1)) {
        pg8::Gemm g{(const bf16_t*)(ws + WS_XB), (const bf16_t*)(ws + WS_WIN), S, NINP, DM, DM, DM};
        pg8::StaticOrder So; So.init(S, NINP, G, bx);
        pg8::Epi<1> E{(const float*)(ws + WS_RSTD1), 0.f, (float*)(ws + WS_ROWSS), (bf16_t*)(ws + WS_PROJ), NINP, nullptr, nullptr};
        pg8::gemm_phase<pg8::Epi<1>, pg8::StaticOrder, true, true>(lds, g, So, E);
    }
    SEAM(1);
    if (IN(2)) {
        {
            pg8::Gemm g{(const bf16_t*)(ws + WS_PROJ) + 2048, (const bf16_t*)(ws + WS_WUQ), S, 1536, 512, NINP, 512};
            pg8::StaticOrder So; So.init(S, 1536, G, bx);
            pg8::Epi<2> E{(const float*)(ws + WS_ROWSS) + 1 * S, 1.0f / 512.0f, nullptr, (bf16_t*)(ws + WS_QRAW), 1536, nullptr, nullptr};
            pg8::gemm_phase<pg8::Epi<2>, pg8::StaticOrder, true, true>(lds, g, So, E);
        }
        __syncthreads();
        {
            pg8::Gemm g{(const bf16_t*)(ws + WS_PROJ) + 2560, (const bf16_t*)(ws + WS_WUKV), S, 2048, 256, NINP, 256};
            pg8::StaticOrder So; So.init(S, 2048, G, bx);
            pg8::Epi<2> E{(const float*)(ws + WS_ROWSS) + 2 * S, 1.0f / 256.0f, nullptr, (bf16_t*)(ws + WS_KVRAW), 2048, nullptr, nullptr};
            pg8::gemm_phase<pg8::Epi<2>, pg8::StaticOrder, true, true>(lds, g, So, E);
        }
    }
    SEAM(2);
    if (IN(3)) phase3(p, gw, NGW, lane);
    SEAM(3);
    if (IN(4)) {
        for (int pr = bx; pr < 256; pr += G) {
            const int head = pr & 7, x = pr >> 3;
            attn_unit(p, lds, head, 63 - x, tid, wave, lane);
            attn_unit(p, lds, head, x, tid, wave, lane);
        }
        for (int u = bx; u < 512; u += G) gmlp_unit(p, lds, u >> 3, u & 7, tid, wave, lane);
    }
    SEAM(4);
    if (IN(5)) {
        pg8::Gemm g{(const bf16_t*)(ws + WS_MIX), (const bf16_t*)(ws + WS_WOUT), S, DM, DM, DM, DM};
        pg8::StaticOrder So; So.init(S, DM, G, bx);
        pg8::Epi<4> E{nullptr, 0.f, (float*)(ws + WS_ROWSS) + 3 * S, (bf16_t*)(ws + WS_X1B), DM, p.out, p.in[0]};
        pg8::gemm_phase<pg8::Epi<4>, pg8::StaticOrder, true, true>(lds, g, So, E);
    }
    SEAM(5);
    if (IN(6)) {
        pg8::Gemm g{(const bf16_t*)(ws + WS_X1B), (const bf16_t*)(ws + WS_WS), S, DM, DM, DM, DM};
        pg8::StaticOrder So; So.init(S, DM, G, bx);
        pg8::Epi<5> E{(const float*)(ws + WS_ROWSS) + 3 * S, 1.0f / DM, nullptr, nullptr, DM, (float*)(ws + WS_SC), nullptr};
        pg8::gemm_phase<pg8::Epi<5>, pg8::StaticOrder, true, true>(lds, g, So, E);
    }
    SEAM(6);
    if (IN(7)) phase7(p, gw, NGW, lane);
    SEAM(7);
    if (IN(8)) phase8(p, gw, NGW, lane);
#undef IN
#undef SEAM
}

extern "C" void kernel_launch(void* const* d_in, const int* in_sizes, int n_in, void* d_out, int out_size, void* d_ws, size_t ws_size, hipStream_t stream) {
    static int grid = 0;
    if (grid == 0) {
        if (n_in != 18 || out_size != S * DM || ws_size < WS_END) { fprintf(stderr, "kernel_launch: unexpected shapes (n_in %d out %d ws %zu)\n", n_in, out_size, ws_size); grid = -1; return; }
        int dev = 0, cus = 0, per_cu = 0;
        hipGetDevice(&dev);
        hipDeviceGetAttribute(&cus, hipDeviceAttributeMultiprocessorCount, dev);
        if (hipFuncSetAttribute((const void*)mega, hipFuncAttributeMaxDynamicSharedMemorySize, LDS_BYTES) != hipSuccess) { fprintf(stderr, "kernel_launch: hipFuncSetAttribute failed\n"); grid = -1; return; }
        if (hipOccupancyMaxActiveBlocksPerMultiprocessor(&per_cu, (const void*)mega, NTHREADS, LDS_BYTES) != hipSuccess || per_cu < 1) { fprintf(stderr, "kernel_launch: occupancy query failed (%d)\n", per_cu); grid = -1; return; }
        grid = cus;
        fprintf(stderr, "kernel_launch: cus %d per_cu %d grid %d\n", cus, per_cu, grid);
    }
    if (grid < 0) return;
    hipMemsetAsync((char*)d_ws + WS_CTL, 0, 1 * MiB, stream);
    Params prm{};
    for (int i = 0; i < 18; ++i) prm.in[i] = (const float*)d_in[i];
    prm.out = (float*)d_out; prm.ws = (unsigned char*)d_ws;
#if MK_ONE_LAUNCH
    prm.ph_lo = 0; prm.ph_hi = NPH;
    { void* args[] = {&prm}; hipError_t e = hipLaunchCooperativeKernel((const void*)mega, dim3(grid), dim3(NTHREADS), args, LDS_BYTES, stream);
      if (e != hipSuccess) fprintf(stderr, "cooperative launch failed: %s\n", hipGetErrorString(e)); }
#else
    for (int ph = 0; ph < NPH; ++ph) {
        prm.ph_lo = ph; prm.ph_hi = ph + 1;
        void* args[] = {&prm};
        hipError_t e = hipLaunchCooperativeKernel((const void*)mega, dim3(grid), dim3(NTHREADS), args, LDS_BYTES, stream);
        if (e != hipSuccess) { fprintf(stderr, "cooperative launch %d failed: %s\n", ph, hipGetErrorString(e)); break; }
    }
#endif
}
```

```cpp
#include <hip/hip_runtime.h>
#include <cstdio>
#include <cstdint>

#define LAS __attribute__((address_space(3)))
typedef unsigned short bf16_t;
typedef short bf16x8 __attribute__((ext_vector_type(8)));
typedef short s16x4 __attribute__((ext_vector_type(4)));
typedef float f32x4 __attribute__((ext_vector_type(4)));
typedef float f32x16 __attribute__((ext_vector_type(16)));
typedef unsigned u32x4 __attribute__((ext_vector_type(4)));
typedef unsigned u32x2 __attribute__((ext_vector_type(2)));

#ifndef PROBE_DUP
#define PROBE_DUP 0
#endif
#ifndef MK_ONE_LAUNCH
#define MK_ONE_LAUNCH 1
#endif

constexpr int S = 8192, DM = 2048, NIN = 2880, NINP = 3072;
constexpr int NPH = 9;
constexpr float EPS = 1e-6f;
constexpr int LDS_BYTES = 147456;
constexpr int NTHREADS = 512;
constexpr int LDS_MISC = 131072 + 1024;

constexpr size_t MiB = 1u << 20;
constexpr size_t WS_CTL = 0;
constexpr size_t WS_ROWSS = 128 * 1024;
constexpr size_t WS_COS = 1 * MiB, WS_SIN = 2 * MiB;
constexpr size_t WS_RSTD1 = 3 * MiB;
constexpr size_t WS_EXP = 4 * MiB;
constexpr size_t WS_GATE = 8 * MiB;
constexpr size_t WS_WIN = 12 * MiB;
constexpr size_t WS_WUQ = 24 * MiB;
constexpr size_t WS_WUKV = 26 * MiB;
constexpr size_t WS_WOUT = 28 * MiB;
constexpr size_t WS_WS = 36 * MiB;
constexpr size_t WS_XB = 44 * MiB;
constexpr size_t WS_PROJ = 76 * MiB;
constexpr size_t WS_QRAW = 124 * MiB;
constexpr size_t WS_KVRAW = 148 * MiB;
constexpr size_t WS_QH = 180 * MiB;
constexpr size_t WS_KH = 204 * MiB;
constexpr size_t WS_VH = 228 * MiB;
constexpr size_t WS_MIX = 244 * MiB;
constexpr size_t WS_X1B = 276 * MiB;
constexpr size_t WS_SC = 308 * MiB;
constexpr size_t WS_UT = 372 * MiB;
constexpr size_t WS_VT = 436 * MiB;
constexpr size_t WS_END = 500 * MiB;

__device__ __forceinline__ unsigned f2bf(float f) { unsigned u = __builtin_bit_cast(unsigned, f); return (u + 0x7fffu + ((u >> 16) & 1u)) >> 16; }
__device__ __forceinline__ unsigned pk2(float lo, float hi) { return f2bf(lo) | (f2bf(hi) << 16); }
__device__ __forceinline__ float bf2f(unsigned short b) { return __builtin_bit_cast(float, (unsigned)b << 16); }
__device__ __forceinline__ float bflo(unsigned w) { return __builtin_bit_cast(float, w << 16); }
__device__ __forceinline__ float bfhi(unsigned w) { return __builtin_bit_cast(float, w & 0xffff0000u); }
__device__ __forceinline__ float wave_sum(float v) {
#pragma unroll
    for (int o = 32; o > 0; o >>= 1) v += __shfl_xor(v, o);
    return v;
}
__device__ __forceinline__ float wave_max(float v) {
#pragma unroll
    for (int o = 32; o > 0; o >>= 1) v = fmaxf(v, __shfl_xor(v, o));
    return v;
}
__device__ __forceinline__ float gelu_tanh(float x) {
    const float y = 0.7978845608028654f * (x + 0.044715f * x * x * x);
    return x / (1.0f + __expf(-2.0f * y));
}
__device__ __forceinline__ int crow(int r, int hi) { return (r & 3) + 8 * (r >> 2) + 4 * hi; }
#define LDS_WAIT() asm volatile("s_waitcnt lgkmcnt(0)" ::: "memory")
#define SBAR() __builtin_amdgcn_sched_barrier(0)

namespace pg8 {
#define PG8_LAS __attribute__((address_space(3)))
constexpr int BM = 256, BK = 64, HALF = 128, HTB = HALF * BK * 2  , STAGE_BYTES = 8 * HTB, NXCD = 8, WGM = 8;

__host__ __device__ __forceinline__ int lds_byte(int r, int c) { const int st = (r >> 4) * 2 + (c >> 5), rr = r & 15, cc = c & 31, ob = rr * 64 + cc * 2; return st * 1024 + (ob ^ (((ob >> 9) & 1) << 5)); }
__host__ __device__ __forceinline__ void stage_rc(int b, int& R, int& C) { const int st = b / 1024, sb = b % 1024, swz = sb ^ (((sb >> 9) & 1) << 5); R = (st >> 1) * 16 + swz / 64; C = (st & 1) * 32 + (swz % 64) / 2; }
__host__ __device__ __forceinline__ int perm32(int rho) { const int n = rho >> 4, i = rho & 15; return 8 * (i >> 2) + 4 * n + (i & 3); }

struct Unit { int pm, pn; };
struct Gemm { const bf16_t* A; const bf16_t* Bt; int M, N, K, lda, ldb; };

struct StaticOrder {
    int nM, nN, nwg, G, c;
    __host__ __device__ void init(int M, int N, int G_, int c_) { nM = M / BM; nN = N / BM; nwg = nM * nN; G = G_; c = c_; }
    __host__ __device__ bool next(int i, Unit& u) const {
        const long L = (long)i * G + c; if (L >= nwg) return false;
        int wgid = (int)L; { const int q = nwg / NXCD, r = nwg % NXCD, xcd = wgid % NXCD, off = wgid / NXCD; wgid = (xcd < r ? xcd * (q + 1) : r * (q + 1) + (xcd - r) * q) + off; }
        const int nig = WGM * nN, gid = wgid / nig, fm = gid * WGM, gsz = (nM - fm) < WGM ? (nM - fm) : WGM;
        u.pm = fm + ((wgid % nig) % gsz); u.pn = (wgid % nig) / gsz; return true;
    }
    __device__ __forceinline__ void a_ready(const Unit&) const {}
    __device__ __forceinline__ void done(const Unit&) const {}
};

template <class Epi, class Sched, bool ALIGN_EPI = false, bool SP2 = false>
__device__ __forceinline__ void gemm_phase(PG8_LAS unsigned char* lds, const Gemm g, const Sched& S, const Epi& E) {
    const int tid = threadIdx.x, wid = __builtin_amdgcn_readfirstlane(tid >> 6), lane = tid & 63, wr = wid >> 2, wc = wid & 3, fr = lane & 15, fq = lane >> 4;
    const int K = g.K, nt = K / BK;
    unsigned voffA[2], voffB[2];
#pragma unroll
    for (int i = 0; i < 2; ++i) { int R, C; stage_rc(tid * 16 + i * 8192, R, C); const int Rb = Epi::PERM ? ((R & ~31) + perm32(R & 31)) : R;
        voffA[i] = (unsigned)(R * g.lda + C) * 2u; voffB[i] = (unsigned)(Rb * g.ldb + C) * 2u; }
    const size_t kstep = (size_t)(BK * 2);
    const size_t hstepA = (size_t)HALF * g.lda * 2, hstepB = (size_t)HALF * g.ldb * 2;
    const size_t tstepA = 2 * hstepA, tstepB = 2 * hstepB;
    const unsigned ldsw = (unsigned)wid * 1024u;
    const int aoff = lds_byte(wr * 64 + fr, fq * 8), boff = lds_byte(wc * 32 + fr, fq * 8);
#define PG8_SA(b, h) (((b) * 2 + (h)) * HTB)
#define PG8_SB(b, h) ((4 + (b) * 2 + (h)) * HTB)
#define PG8_STAGE(bufoff, gbase, voff) do { _Pragma("unroll") for (int _i = 0; _i < 2; ++_i) \
        __builtin_amdgcn_global_load_lds((const unsigned*)((const char*)(gbase) + (voff)[_i]), (PG8_LAS unsigned*)(lds + (bufoff) + ldsw + _i * 8192), 16, 0, 0); } while (0)
#define PG8_LDA(dst, b, h) do { _Pragma("unroll") for (int m = 0; m < 4; ++m) _Pragma("unroll") for (int k = 0; k < 2; ++k) dst[m][k] = *(const PG8_LAS bf16x8*)(lds + PG8_SA(b, h) + aoff + m * 2048 + k * 1024); } while (0)
#define PG8_LDB(dst, b, h) do { _Pragma("unroll") for (int n = 0; n < 2; ++n) _Pragma("unroll") for (int k = 0; k < 2; ++k) dst[n][k] = *(const PG8_LAS bf16x8*)(lds + PG8_SB(b, h) + boff + n * 2048 + k * 1024); } while (0)
#define PG8_MMA(ai, bj, At, Bt) do { __builtin_amdgcn_s_setprio(1); _Pragma("unroll") for (int m = 0; m < 4; ++m) _Pragma("unroll") for (int n = 0; n < 2; ++n) _Pragma("unroll") for (int k = 0; k < 2; ++k) \
        acc[ai][bj][m][n] = __builtin_amdgcn_mfma_f32_16x16x32_bf16(Bt[n][k], At[m][k], acc[ai][bj][m][n], 0, 0, 0); __builtin_amdgcn_s_setprio(0); } while (0)
#define PG8_WAIT_V(n) asm volatile("s_waitcnt vmcnt(" #n ")" ::: "memory")
#define PG8_WAIT_L(n) asm volatile("s_waitcnt lgkmcnt(" #n ")" ::: "memory")
#define PG8_BAR __builtin_amdgcn_s_barrier()
#define PG8_SCHED __builtin_amdgcn_sched_barrier(0)
    Unit cur, nxt; int ui = 0;
    if (!S.next(0, cur)) return;
    f32x4 acc[2][2][4][2];
#pragma unroll
    for (int a = 0; a < 2; ++a)
#pragma unroll
        for (int b = 0; b < 2; ++b)
#pragma unroll
            for (int m = 0; m < 4; ++m)
#pragma unroll
                for (int n = 0; n < 2; ++n) acc[a][b][m][n] = (f32x4){0.f, 0.f, 0.f, 0.f};
    bf16x8 At[4][2], B0[2][2], B1[2][2];
    const char* cA = (const char*)g.A + (size_t)cur.pm * tstepA; const char* cB = (const char*)g.Bt + (size_t)cur.pn * tstepB;
    S.a_ready(cur);
    if constexpr (SP2) {
        PG8_STAGE(PG8_SB(0, 0), cB, voffB); PG8_STAGE(PG8_SB(0, 1), cB + hstepB, voffB); PG8_STAGE(PG8_SA(0, 0), cA, voffA); PG8_STAGE(PG8_SA(0, 1), cA + hstepA, voffA);
        if (wr == 1) PG8_BAR;
        PG8_WAIT_V(2); PG8_BAR;
        PG8_STAGE(PG8_SB(1, 0), cB + kstep, voffB); PG8_STAGE(PG8_SA(1, 0), cA + kstep, voffA); PG8_STAGE(PG8_SB(1, 1), cB + hstepB + kstep, voffB);
        PG8_WAIT_V(6); PG8_BAR;
    } else {
        PG8_STAGE(PG8_SB(0, 0), cB, voffB); PG8_STAGE(PG8_SA(0, 0), cA, voffA); PG8_STAGE(PG8_SB(0, 1), cB + hstepB, voffB); PG8_STAGE(PG8_SA(0, 1), cA + hstepA, voffA);
        if (wr == 1) PG8_BAR;
        PG8_WAIT_V(4); PG8_BAR;
        PG8_STAGE(PG8_SB(1, 0), cB + kstep, voffB); PG8_STAGE(PG8_SA(1, 0), cA + kstep, voffA); PG8_STAGE(PG8_SB(1, 1), cB + hstepB + kstep, voffB);
        PG8_WAIT_V(6); PG8_BAR;
    }
    for (;;) {
        const bool has_next = S.next(ui + 1, nxt);
        const char* nA = has_next ? (const char*)g.A + (size_t)nxt.pm * tstepA : cA; const char* nB = has_next ? (const char*)g.Bt + (size_t)nxt.pn * tstepB : cB;
        for (int t = 0; t < nt; t += 2) {
            const bool last = (t == nt - 2);
            const char* a1 = cA + (size_t)(t + 1) * kstep;
            const char* a2 = last ? nA : cA + (size_t)(t + 2) * kstep; const char* b2 = last ? nB : cB + (size_t)(t + 2) * kstep;
            const char* a3 = a2 + kstep; const char* b3 = b2 + kstep;
            if (last && has_next) S.a_ready(nxt);
            if constexpr (SP2) {
            PG8_LDB(B0, 0, 0); PG8_LDB(B1, 0, 1); PG8_SCHED; PG8_LDA(At, 0, 0); PG8_STAGE(PG8_SA(1, 1), a1 + hstepA, voffA);
            PG8_WAIT_V(8); PG8_WAIT_L(0); PG8_BAR; PG8_MMA(0, 0, At, B0); PG8_MMA(0, 1, At, B1); PG8_BAR; PG8_SCHED;
            PG8_LDA(At, 0, 1); PG8_STAGE(PG8_SB(0, 0), b2, voffB); PG8_STAGE(PG8_SB(0, 1), b2 + hstepB, voffB); PG8_STAGE(PG8_SA(0, 0), a2, voffA);
            PG8_WAIT_V(8); PG8_WAIT_L(0); PG8_BAR; PG8_MMA(1, 0, At, B0); PG8_MMA(1, 1, At, B1); PG8_BAR; PG8_SCHED;
            PG8_LDB(B0, 1, 0); PG8_LDB(B1, 1, 1); PG8_SCHED; PG8_LDA(At, 1, 0); PG8_STAGE(PG8_SA(0, 1), a2 + hstepA, voffA);
            PG8_WAIT_V(8); PG8_WAIT_L(0); PG8_BAR; PG8_MMA(0, 0, At, B0); PG8_MMA(0, 1, At, B1); PG8_BAR; PG8_SCHED;
            PG8_LDA(At, 1, 1); PG8_STAGE(PG8_SB(1, 0), b3, voffB); PG8_STAGE(PG8_SB(1, 1), b3 + hstepB, voffB); PG8_STAGE(PG8_SA(1, 0), a3, voffA);
            PG8_WAIT_V(8); PG8_WAIT_L(0); PG8_BAR; PG8_MMA(1, 0, At, B0); PG8_MMA(1, 1, At, B1); PG8_BAR; PG8_SCHED;
            } else {
            PG8_LDB(B0, 0, 0); PG8_SCHED; PG8_LDA(At, 0, 0); PG8_STAGE(PG8_SA(1, 1), a1 + hstepA, voffA);
            PG8_WAIT_L(8); PG8_BAR; PG8_WAIT_L(0); PG8_MMA(0, 0, At, B0); PG8_BAR; PG8_SCHED;
            PG8_LDB(B1, 0, 1); PG8_STAGE(PG8_SB(0, 0), b2, voffB);
            PG8_BAR; PG8_WAIT_L(0); PG8_MMA(0, 1, At, B1); PG8_BAR;
            PG8_LDA(At, 0, 1); PG8_STAGE(PG8_SA(0, 0), a2, voffA);
            PG8_BAR; PG8_WAIT_L(0); PG8_MMA(1, 0, At, B0); PG8_BAR; PG8_SCHED;
            PG8_STAGE(PG8_SB(0, 1), b2 + hstepB, voffB);
            PG8_WAIT_V(6); PG8_BAR; PG8_MMA(1, 1, At, B1); PG8_BAR;
            PG8_LDB(B0, 1, 0); PG8_SCHED; PG8_LDA(At, 1, 0); PG8_STAGE(PG8_SA(0, 1), a2 + hstepA, voffA);
            PG8_WAIT_L(8); PG8_BAR; PG8_WAIT_L(0); PG8_MMA(0, 0, At, B0); PG8_BAR; PG8_SCHED;
            PG8_LDB(B1, 1, 1); PG8_STAGE(PG8_SB(1, 0), b3, voffB);
            PG8_BAR; PG8_WAIT_L(0); PG8_MMA(0, 1, At, B1); PG8_BAR;
            PG8_LDA(At, 1, 1); PG8_STAGE(PG8_SA(1, 0), a3, voffA);
            PG8_BAR; PG8_WAIT_L(0); PG8_MMA(1, 0, At, B0); PG8_BAR; PG8_SCHED;
            PG8_STAGE(PG8_SB(1, 1), b3 + hstepB, voffB);
            PG8_WAIT_V(6); PG8_BAR; PG8_MMA(1, 1, At, B1); PG8_BAR;
            }
        }
        if constexpr (ALIGN_EPI) { if (wr == 0) PG8_BAR; }
        if constexpr (!Epi::AFTER_DRAIN) { E(acc, cur, wr, wc, fr, fq); S.done(cur); }
        if (!has_next) break;
#pragma unroll
        for (int a = 0; a < 2; ++a)
#pragma unroll
            for (int b = 0; b < 2; ++b)
#pragma unroll
                for (int m = 0; m < 4; ++m)
#pragma unroll
                    for (int n = 0; n < 2; ++n) acc[a][b][m][n] = (f32x4){0.f, 0.f, 0.f, 0.f};
        cur = nxt; cA = nA; cB = nB; ++ui;
        if constexpr (ALIGN_EPI) { if (wr == 1) PG8_BAR; }
    }
    PG8_WAIT_V(0);
    if constexpr (!ALIGN_EPI) { if (wr == 0) PG8_BAR; }
    PG8_BAR;
#undef PG8_SA
#undef PG8_SB
#undef PG8_STAGE
#undef PG8_LDA
#undef PG8_LDB
#undef PG8_MMA
#undef PG8_WAIT_V
#undef PG8_WAIT_L
#undef PG8_BAR
#undef PG8_SCHED
}

template <int MODE> struct Epi {
    static constexpr bool PERM = false, AFTER_DRAIN = false;
    const float* rowsrc; float inv_n; float* ss; bf16_t* ob; int ldc; float* of; const float* xin;
    __device__ __forceinline__ void operator()(const f32x4 (&acc)[2][2][4][2], const Unit& u, int wr, int wc, int fr, int fq) const {
#pragma unroll
        for (int ai = 0; ai < 2; ++ai)
#pragma unroll
            for (int m = 0; m < 4; ++m) {
                const int row = u.pm * BM + ai * HALF + wr * 64 + m * 16 + fr;
                float rs = 1.f;
                if (MODE == 1) rs = rowsrc[row];
                if (MODE == 2 || MODE == 5) rs = rsqrtf(rowsrc[row] * inv_n + EPS);
                float ssq = 0.f;
#pragma unroll
                for (int bj = 0; bj < 2; ++bj)
#pragma unroll
                    for (int n = 0; n < 2; ++n) {
                        const int col = u.pn * BM + bj * HALF + wc * 32 + n * 16 + fq * 4;
                        f32x4 v = acc[ai][bj][m][n] * rs;
                        if (MODE == 1) { if (u.pn < 8) { v[0] = gelu_tanh(v[0]); v[1] = gelu_tanh(v[1]); v[2] = gelu_tanh(v[2]); v[3] = gelu_tanh(v[3]); } }
                        if (MODE == 4) { const f32x4 xr = *(const f32x4*)(xin + (size_t)row * DM + col); v = v + xr; }
                        if (MODE == 1 || MODE == 4) ssq += (v[0] * v[0] + v[1] * v[1]) + (v[2] * v[2] + v[3] * v[3]);
                        if (MODE == 1 || MODE == 2 || MODE == 4) { u32x2 w; w.x = pk2(v[0], v[1]); w.y = pk2(v[2], v[3]); *(u32x2*)(ob + (size_t)row * ldc + col) = w; }
                        if (MODE == 4 || MODE == 5) *(f32x4*)(of + (size_t)row * DM + col) = v;
                    }
                if (MODE == 1) {
                    const int seg = (u.pn >= 4 && u.pn < 8) ? 0 : ((u.pn == 8 || u.pn == 9) ? 1 : (u.pn == 10 ? 2 : -1));
                    if (seg >= 0) { ssq += __shfl_xor(ssq, 16); ssq += __shfl_xor(ssq, 32); if (fq == 0) atomicAdd(ss + seg * S + row, ssq); }
                }
                if (MODE == 4) { ssq += __shfl_xor(ssq, 16); ssq += __shfl_xor(ssq, 32); if (fq == 0) atomicAdd(ss + row, ssq); }
            }
    }
};
}

#define XB_TMO      128
#define XB_XCNT(j)  (256  + 64 * (j))
#define XB_XSUB(j)  (1280 + 64 * (j))
#define XB_XGEN(j)  (2304 + 64 * (j))
#define XB_TOP      3328
#define XB_TOPGEN   3392
#define XCD_BAR_WORDS 3456
#define XB_SPIN_CAP (1u << 18)
__device__ __forceinline__ unsigned xb_ld(unsigned* p)              { return __hip_atomic_load(p, __ATOMIC_RELAXED, __HIP_MEMORY_SCOPE_AGENT); }
__device__ __forceinline__ unsigned xb_add(unsigned* p, unsigned v) { return __hip_atomic_fetch_add(p, v, __ATOMIC_RELAXED, __HIP_MEMORY_SCOPE_AGENT); }
__device__ __forceinline__ unsigned xb_xcc_id() { return (unsigned)__builtin_amdgcn_s_getreg((3 << 11) | 20) & 0xFu; }
#define XB_SPIN(cond, bar) do { unsigned _sp = 0; while (cond) { __builtin_amdgcn_s_sleep(1); \
    if ((++_sp & 255u) == 0u) { if (xb_ld(&(bar)[XB_TMO])) break; if (_sp > XB_SPIN_CAP) { atomicAdd(&(bar)[XB_TMO], 1u); break; } } } } while (0)
struct XcdBarrier { unsigned* bar; unsigned x; volatile LAS unsigned* st; };
__device__ __forceinline__ XcdBarrier xcd_barrier_post(unsigned* bar, volatile LAS unsigned* st) {
    XcdBarrier b; b.bar = bar; b.x = xb_xcc_id(); b.st = st;
    if (threadIdx.x == 0) (void)xb_add(&bar[XB_XCNT(b.x)], 1u);
    return b;
}
__device__ __forceinline__ void xcd_barrier_complete(unsigned* bar, unsigned x, unsigned& nloc, unsigned& nx) {
    const unsigned G = gridDim.x * gridDim.y * gridDim.z;
    unsigned sum, cnt, mine, sp = 0u;
    for (;;) {
        sum = 0u; cnt = 0u; mine = 0u;
#pragma unroll
        for (unsigned j = 0; j < 16; ++j) { const unsigned c = xb_ld(&bar[XB_XCNT(j)]); sum += c; cnt += (c > 0u) ? 1u : 0u; mine = (j == x) ? c : mine; }
        if (sum == G) break;
        __builtin_amdgcn_s_sleep(1);
        if ((++sp & 255u) == 0u) { if (xb_ld(&bar[XB_TMO])) break; if (sp > XB_SPIN_CAP) { atomicAdd(&bar[XB_TMO], 1u); break; } }
    }
    nloc = mine > 0u ? mine : 1u; nx = cnt > 0u ? cnt : 1u;
}
__device__ __forceinline__ void xcd_barrier(const XcdBarrier& b) {
    asm volatile("s_waitcnt vmcnt(0)" ::: "memory");
    __syncthreads();
    if (threadIdx.x == 0) {
        unsigned* bar = b.bar;
        __builtin_amdgcn_s_waitcnt(0);
        unsigned nloc = b.st[0], nx = b.st[1];
        if (nloc == 0u) { xcd_barrier_complete(bar, b.x, nloc, nx); b.st[0] = nloc; b.st[1] = nx; }
        const unsigned old = xb_add(&bar[XB_XSUB(b.x)], 1u);
        const unsigned gen = old / nloc;
        if (old + 1u == (gen + 1u) * nloc) {
            __builtin_amdgcn_fence(__ATOMIC_RELEASE, "agent");
            asm volatile("s_waitcnt vmcnt(0)" ::: "memory");
            const unsigned og = xb_add(&bar[XB_TOP], 1u);
            const unsigned tg = og / nx;
            if (og + 1u == (tg + 1u) * nx) xb_add(&bar[XB_TOPGEN], 1u);
            else XB_SPIN(xb_ld(&bar[XB_TOPGEN]) == tg, bar);
            __builtin_amdgcn_fence(__ATOMIC_ACQUIRE, "agent");
            xb_add(&bar[XB_XGEN(b.x)], 1u);
            asm volatile("s_waitcnt vmcnt(0)" ::: "memory");
        } else {
            XB_SPIN(xb_ld(&bar[XB_XGEN(b.x)]) == gen, bar);
            __builtin_amdgcn_fence(__ATOMIC_ACQUIRE, "agent");
            asm volatile("s_waitcnt vmcnt(0)" ::: "memory");
        }
    }
    __syncthreads();
}

struct Params {
    const float* in[18];
    float* out;
    unsigned char* ws;
    int ph_lo, ph_hi;
};

__device__ __forceinline__ void p0_transpose_item(const float* W, const float* g, int K, int N, bf16_t* WT, LAS float* scr, int item, int lane) {
    const int nblk = N / 32, kb = item / nblk, nb = item % nblk, k0 = 64 * kb, n0 = 32 * nb;
#pragma unroll 8
    for (int i = 0; i < 32; ++i) { const int kk = 2 * i + (lane >> 5); const float gv = g ? g[k0 + kk] : 1.f;
        scr[kk * 33 + (lane & 31)] = W[(size_t)(k0 + kk) * N + n0 + (lane & 31)] * gv; }
    LDS_WAIT(); asm volatile("" ::: "memory");
    const int c = lane & 7;
#pragma unroll
    for (int j = 0; j < 4; ++j) { const int n = (lane >> 3) + 8 * j; const LAS float* s = scr + (8 * c) * 33 + n;
        u32x4 o; o.x = pk2(s[0 * 33], s[1 * 33]); o.y = pk2(s[2 * 33], s[3 * 33]); o.z = pk2(s[4 * 33], s[5 * 33]); o.w = pk2(s[6 * 33], s[7 * 33]);
        *(u32x4*)(WT + (size_t)(n0 + n) * K + k0 + 8 * c) = o; }
    LDS_WAIT(); asm volatile("" ::: "memory");
}
__device__ __forceinline__ float row_to_bf16(const float* src, const float* g, bf16_t* dst, int lane) {
    float ss = 0.f;
#pragma unroll
    for (int i = 0; i < 8; ++i) {
        const int c = (i * 64 + lane) * 4;
        f32x4 v = *(const f32x4*)(src + c);
        ss += (v[0] * v[0] + v[1] * v[1]) + (v[2] * v[2] + v[3] * v[3]);
        if (g) { const f32x4 gv = *(const f32x4*)(g + c); v = v * gv; }
        u32x2 w; w.x = pk2(v[0], v[1]); w.y = pk2(v[2], v[3]);
        *(u32x2*)(dst + c) = w;
    }
    return ss;
}
__device__ __forceinline__ bf16x8 cvt8(const float* p) {
    const f32x4 a = *(const f32x4*)p, b = *(const f32x4*)(p + 4);
    u32x4 w; w.x = pk2(a[0], a[1]); w.y = pk2(a[2], a[3]); w.z = pk2(b[0], b[1]); w.w = pk2(b[2], b[3]);
    return __builtin_bit_cast(bf16x8, w);
}

__device__ __forceinline__ void phase0(const Params& p, LAS unsigned char* lds, int gw, int NGW, int wave, int lane) {
    unsigned char* ws = p.ws;
    LAS float* scr = (LAS float*)(lds + wave * 16384);
    const float* x = p.in[0];
    {
        constexpr int I_IN = (DM / 64) * (NIN / 32), I_UQ = (512 / 64) * (1536 / 32), I_UKV = (256 / 64) * (2048 / 32), I_OUT = (DM / 64) * (DM / 32);
        constexpr int NIT = I_IN + I_UQ + I_UKV + I_OUT;
        for (int it = gw; it < NIT; it += NGW) {
            int r = it;
            if (r < I_IN) { p0_transpose_item(p.in[2], p.in[1], DM, NIN, (bf16_t*)(ws + WS_WIN), scr, r, lane); continue; } r -= I_IN;
            if (r < I_UQ) { p0_transpose_item(p.in[7], p.in[6], 512, 1536, (bf16_t*)(ws + WS_WUQ), scr, r, lane); continue; } r -= I_UQ;
            if (r < I_UKV) { p0_transpose_item(p.in[9], p.in[8], 256, 2048, (bf16_t*)(ws + WS_WUKV), scr, r, lane); continue; } r -= I_UKV;
            p0_transpose_item(p.in[12], nullptr, DM, DM, (bf16_t*)(ws + WS_WOUT), scr, r, lane);
        }
    }
    for (int r = gw; r < NINP - NIN; r += NGW) {
        bf16_t* d = (bf16_t*)(ws + WS_WIN) + (size_t)(NIN + r) * DM;
#pragma unroll
        for (int i = 0; i < 4; ++i) *(u32x4*)(d + (i * 64 + lane) * 8) = (u32x4){0u, 0u, 0u, 0u};
    }
    {
        const float* wq = p.in[14]; const float* sk = p.in[15]; const float* g2 = p.in[13];
        bf16_t* WsT = (bf16_t*)(ws + WS_WS);
        const int r32 = lane & 31, hh = lane >> 5;
        for (int it = gw; it < 16 * 4 * 64; it += NGW) {
            const int hp = it >> 8, kb = (it >> 6) & 3, nb = it & 63;
            f32x16 acc = {};
            const float* ap = sk + ((size_t)(hp * 128 + kb * 32 + r32)) * 128 + hh * 8;
            const float* bp = wq + ((size_t)(nb * 32 + r32)) * DM + hp * 128 + hh * 8;
#pragma unroll
            for (int s = 0; s < 8; ++s) {
                const bf16x8 a = cvt8(ap + s * 16), b = cvt8(bp + s * 16);
                acc = __builtin_amdgcn_mfma_f32_32x32x16_bf16(a, b, acc, 0, 0, 0);
            }
            const int kcol = nb * 32 + r32; const float gk = g2[kcol];
#pragma unroll
            for (int r = 0; r < 16; ++r) WsT[(size_t)(hp * 128 + kb * 32 + crow(r, hh)) * DM + kcol] = (bf16_t)f2bf(acc[r] * gk);
        }
    }
    {
        bf16_t* xb = (bf16_t*)(ws + WS_XB); float* rstd1 = (float*)(ws + WS_RSTD1);
        for (int t = gw; t < S; t += NGW) {
            float ss = row_to_bf16(x + (size_t)t * DM, nullptr, xb + (size_t)t * DM, lane);
            ss = wave_sum(ss);
            if (lane == 0) rstd1[t] = rsqrtf(ss * (1.0f / DM) + EPS);
        }
    }
    {
        bf16_t* UT = (bf16_t*)(ws + WS_UT); bf16_t* VT = (bf16_t*)(ws + WS_VT);
        for (int e = gw; e < 2 * 16384; e += NGW) {
            if (e < 16384) (void)row_to_bf16(p.in[16] + (size_t)e * DM, p.in[13], UT + (size_t)e * DM, lane);
            else (void)row_to_bf16(p.in[17] + (size_t)(e - 16384) * DM, nullptr, VT + (size_t)(e - 16384) * DM, lane);
        }
    }
    {
        float* ct = (float*)(ws + WS_COS); float* st = (float*)(ws + WS_SIN);
        for (int it = gw; it < S * 32 / 64; it += NGW) {
            const int idx = it * 64 + lane, t = idx >> 5, j = idx & 31;
            const float inv_freq = powf(10000.0f, -(float)j / 32.0f);
            const float ang = (float)t * inv_freq;
            ct[idx] = cosf(ang); st[idx] = sinf(ang);
        }
    }
}

__device__ __forceinline__ void phase3(const Params& p, int gw, int NGW, int lane) {
    unsigned char* ws = p.ws;
    const bf16_t* qraw = (const bf16_t*)(ws + WS_QRAW); const bf16_t* kvraw = (const bf16_t*)(ws + WS_KVRAW); const bf16_t* proj = (const bf16_t*)(ws + WS_PROJ);
    bf16_t* Qh = (bf16_t*)(ws + WS_QH); bf16_t* Kh = (bf16_t*)(ws + WS_KH); bf16_t* Vh = (bf16_t*)(ws + WS_VH);
    const float* ct = (const float*)(ws + WS_COS); const float* st = (const float*)(ws + WS_SIN);
    const float* gq = p.in[10]; const float* gk = p.in[11];
    const float gq0 = gq[lane], gq1 = gq[64 + lane], gq2 = gq[128 + lane], gk0 = gk[lane], gk1 = gk[64 + lane], gk2 = gk[128 + lane];
    constexpr float QS = 0.07216878364870322f * 1.4426950408889634f;
    for (int t = gw; t < S; t += NGW) {
        const float cs = ct[t * 32 + (lane & 31)], sn = st[t * 32 + (lane & 31)];
        const float kr = bf2f(proj[(size_t)t * NINP + 2816 + lane]);
#pragma unroll
        for (int h = 0; h < 8; ++h) {
            const bf16_t* qp = qraw + (size_t)t * 1536 + h * 192;
            float q0 = bf2f(qp[lane]), q1 = bf2f(qp[64 + lane]), q2 = bf2f(qp[128 + lane]);
            float ss = wave_sum(q0 * q0 + q1 * q1 + q2 * q2);
            float rs = rsqrtf(ss * (1.0f / 192.0f) + EPS);
            q0 *= rs * gq0; q1 *= rs * gq1; q2 *= rs * gq2;
            float pr = __shfl_xor(q2, 32);
            q2 = (lane < 32) ? (q2 * cs - pr * sn) : (pr * sn + q2 * cs);
            bf16_t* qo = Qh + ((size_t)h * S + t) * 192;
            qo[lane] = (bf16_t)f2bf(q0 * QS); qo[64 + lane] = (bf16_t)f2bf(q1 * QS); qo[128 + lane] = (bf16_t)f2bf(q2 * QS);
            const bf16_t* kp = kvraw + (size_t)t * 2048 + h * 256;
            float k0 = bf2f(kp[lane]), k1 = bf2f(kp[64 + lane]), k2 = kr;
            ss = wave_sum(k0 * k0 + k1 * k1 + k2 * k2);
            rs = rsqrtf(ss * (1.0f / 192.0f) + EPS);
            k0 *= rs * gk0; k1 *= rs * gk1; k2 *= rs * gk2;
            pr = __shfl_xor(k2, 32);
            k2 = (lane < 32) ? (k2 * cs - pr * sn) : (pr * sn + k2 * cs);
            bf16_t* ko = Kh + ((size_t)h * S + t) * 192;
            ko[lane] = (bf16_t)f2bf(k0); ko[64 + lane] = (bf16_t)f2bf(k1); ko[128 + lane] = (bf16_t)f2bf(k2);
            bf16_t* vo = Vh + ((size_t)h * S + t) * 128;
            vo[lane] = kp[128 + lane]; vo[64 + lane] = kp[192 + lane];
        }
    }
}

constexpr int KP = 400, VP = 320;
constexpr int ATT_BUF = 64 * KP + 64 * VP;
template <int OFF> __device__ __forceinline__ s16x4 tr_read(unsigned addr) {
    s16x4 r; asm volatile("ds_read_b64_tr_b16 %0, %1 offset:%2" : "=&v"(r) : "v"(addr), "i"(OFF) : "memory"); return r;
}
__device__ __forceinline__ unsigned cvtpk(float lo, float hi) { unsigned r; asm volatile("v_cvt_pk_bf16_f32 %0, %1, %2" : "=v"(r) : "v"(lo), "v"(hi)); return r; }
#define PK8(L, H) ((bf16x8){L[0], L[1], L[2], L[3], H[0], H[1], H[2], H[3]})
constexpr float ATT_THR = 8.0f;

__device__ __forceinline__ void attn_tile(const LAS unsigned char* kbuf, unsigned vaddr, const bf16x8 (&qr)[12], f32x16 (&o)[4], float& m, float& lsum, int lane) {
    f32x16 pacc = {};
    const LAS unsigned char* kp = kbuf + (lane & 31) * KP + (lane >> 5) * 16;
#pragma unroll
    for (int ks = 0; ks < 12; ++ks) { const bf16x8 a = *(const LAS bf16x8*)(kp + ks * 32); pacc = __builtin_amdgcn_mfma_f32_32x32x16_bf16(a, qr[ks], pacc, 0, 0, 0); }
    float pmax = pacc[0];
#pragma unroll
    for (int r = 1; r < 16; ++r) pmax = fmaxf(pmax, pacc[r]);
    pmax = fmaxf(pmax, __shfl_xor(pmax, 32));
    if (!__all(pmax - m <= ATT_THR)) {
        const float mn = fmaxf(m, pmax); const float alpha = __builtin_amdgcn_exp2f(m - mn); m = mn; lsum *= alpha;
#pragma unroll
        for (int d = 0; d < 4; ++d)
#pragma unroll
            for (int r = 0; r < 16; ++r) o[d][r] *= alpha;
    }
    float ps = 0.f;
#pragma unroll
    for (int r = 0; r < 16; ++r) { pacc[r] = __builtin_amdgcn_exp2f(pacc[r] - m); ps += pacc[r]; }
    ps += __shfl_xor(ps, 32);
    lsum += ps;
    u32x4 w0 = {cvtpk(pacc[0], pacc[1]), cvtpk(pacc[2], pacc[3]), cvtpk(pacc[4], pacc[5]), cvtpk(pacc[6], pacc[7])};
    u32x4 w1 = {cvtpk(pacc[8], pacc[9]), cvtpk(pacc[10], pacc[11]), cvtpk(pacc[12], pacc[13]), cvtpk(pacc[14], pacc[15])};
    const bf16x8 pb0 = __builtin_bit_cast(bf16x8, w0), pb1 = __builtin_bit_cast(bf16x8, w1);
#define VOFF(d0, s, hi) (((16 * (s) + 8 * (hi)) * VP) + 64 * (d0))
    const s16x4 a00l = tr_read<VOFF(0, 0, 0)>(vaddr), a00h = tr_read<VOFF(0, 0, 1)>(vaddr), a01l = tr_read<VOFF(0, 1, 0)>(vaddr), a01h = tr_read<VOFF(0, 1, 1)>(vaddr);
    const s16x4 a10l = tr_read<VOFF(1, 0, 0)>(vaddr), a10h = tr_read<VOFF(1, 0, 1)>(vaddr), a11l = tr_read<VOFF(1, 1, 0)>(vaddr), a11h = tr_read<VOFF(1, 1, 1)>(vaddr);
    const s16x4 a20l = tr_read<VOFF(2, 0, 0)>(vaddr), a20h = tr_read<VOFF(2, 0, 1)>(vaddr), a21l = tr_read<VOFF(2, 1, 0)>(vaddr), a21h = tr_read<VOFF(2, 1, 1)>(vaddr);
    const s16x4 a30l = tr_read<VOFF(3, 0, 0)>(vaddr), a30h = tr_read<VOFF(3, 0, 1)>(vaddr), a31l = tr_read<VOFF(3, 1, 0)>(vaddr), a31h = tr_read<VOFF(3, 1, 1)>(vaddr);
#undef VOFF
    LDS_WAIT(); SBAR();
    o[0] = __builtin_amdgcn_mfma_f32_32x32x16_bf16(PK8(a00l, a00h), pb0, o[0], 0, 0, 0); o[0] = __builtin_amdgcn_mfma_f32_32x32x16_bf16(PK8(a01l, a01h), pb1, o[0], 0, 0, 0);
    o[1] = __builtin_amdgcn_mfma_f32_32x32x16_bf16(PK8(a10l, a10h), pb0, o[1], 0, 0, 0); o[1] = __builtin_amdgcn_mfma_f32_32x32x16_bf16(PK8(a11l, a11h), pb1, o[1], 0, 0, 0);
    o[2] = __builtin_amdgcn_mfma_f32_32x32x16_bf16(PK8(a20l, a20h), pb0, o[2], 0, 0, 0); o[2] = __builtin_amdgcn_mfma_f32_32x32x16_bf16(PK8(a21l, a21h), pb1, o[2], 0, 0, 0);
    o[3] = __builtin_amdgcn_mfma_f32_32x32x16_bf16(PK8(a30l, a30h), pb0, o[3], 0, 0, 0); o[3] = __builtin_amdgcn_mfma_f32_32x32x16_bf16(PK8(a31l, a31h), pb1, o[3], 0, 0, 0);
}

__device__ __forceinline__ void attn_unit(const Params& p, LAS unsigned char* lds, int head, int qb, int tid, int wave, int lane) {
    unsigned char* ws = p.ws;
    const bf16_t* Qh = (const bf16_t*)(ws + WS_QH); const bf16_t* Kh = (const bf16_t*)(ws + WS_KH); const bf16_t* Vh = (const bf16_t*)(ws + WS_VH);
    bf16_t* mix = (bf16_t*)(ws + WS_MIX);
    const int rg = wave & 3, kh = wave >> 2, r32 = lane & 31, hh = lane >> 5;
    const int q0row = qb * 128 + rg * 32;
    bf16x8 qr[12];
    {
        const bf16_t* qp = Qh + ((size_t)head * S + q0row + r32) * 192 + hh * 8;
#pragma unroll
        for (int ks = 0; ks < 12; ++ks) qr[ks] = *(const bf16x8*)(qp + ks * 16);
    }
    const int ntiles = 2 * qb + 2, mylast = 2 * qb + (rg >> 1);
    float m = -1e30f, lsum = 0.f; f32x16 o[4] = {};
    int kgo[3], klo[3], vgo[2], vlo[2];
#pragma unroll
    for (int i = 0; i < 3; ++i) { const int pc = tid + 512 * i, r = pc / 24, c = pc % 24; kgo[i] = r * 192 + c * 8; klo[i] = r * KP + c * 16; }
#pragma unroll
    for (int i = 0; i < 2; ++i) { const int pc = tid + 512 * i, r = pc >> 4, c = pc & 15; vgo[i] = r * 128 + c * 8; vlo[i] = 64 * KP + r * VP + c * 16; }
    const bf16_t* kbase = Kh + (size_t)head * S * 192; const bf16_t* vbase = Vh + (size_t)head * S * 128;
    u32x4 sk0, sk1, sk2, sv0, sv1;
#define ATT_LOAD(t) do { const bf16_t* kt = kbase + (size_t)(t) * 64 * 192; const bf16_t* vt = vbase + (size_t)(t) * 64 * 128; \
        sk0 = *(const u32x4*)(kt + kgo[0]); sk1 = *(const u32x4*)(kt + kgo[1]); sk2 = *(const u32x4*)(kt + kgo[2]); sv0 = *(const u32x4*)(vt + vgo[0]); sv1 = *(const u32x4*)(vt + vgo[1]); } while (0)
#define ATT_WRITE(b) do { LAS unsigned char* bb = lds + (b) * ATT_BUF; *(LAS u32x4*)(bb + klo[0]) = sk0; *(LAS u32x4*)(bb + klo[1]) = sk1; *(LAS u32x4*)(bb + klo[2]) = sk2; \
        *(LAS u32x4*)(bb + vlo[0]) = sv0; *(LAS u32x4*)(bb + vlo[1]) = sv1; } while (0)
    const unsigned ldsbase = (unsigned)(size_t)lds;
    const unsigned vrel = (unsigned)(64 * KP + (32 * kh + 4 * hh + ((lane & 15) >> 2)) * VP + (16 * ((lane >> 4) & 1) + 4 * (lane & 3)) * 2);
    ATT_LOAD(0); ATT_WRITE(0); __syncthreads();
    for (int t = 0; t < ntiles; ++t) {
        const bool more = (t + 1 < ntiles);
        if (more) ATT_LOAD(t + 1);
        if (t <= mylast) {
            const int b = t & 1;
            attn_tile(lds + b * ATT_BUF + (32 * kh) * KP, ldsbase + b * ATT_BUF + vrel, qr, o, m, lsum, lane);
        }
        if (more) ATT_WRITE((t + 1) & 1);
        __syncthreads();
    }
#undef ATT_LOAD
#undef ATT_WRITE
    LAS float* scr = (LAS float*)lds + (size_t)rg * 66 * 64 + lane;
    if (kh == 1) {
        scr[0] = m; scr[64] = lsum;
#pragma unroll
        for (int d = 0; d < 4; ++d)
#pragma unroll
            for (int r = 0; r < 16; ++r) scr[(2 + d * 16 + r) * 64] = o[d][r];
    }
    __syncthreads();
    if (kh == 0) {
        const float m2 = scr[0], l2 = scr[64];
        const float mn = fmaxf(m, m2), a1 = __builtin_amdgcn_exp2f(m - mn), a2 = __builtin_amdgcn_exp2f(m2 - mn);
        const float inv = 1.0f / (lsum * a1 + l2 * a2);
        bf16_t* op = mix + (size_t)(q0row + r32) * DM + 1024 + head * 128 + 4 * hh;
#pragma unroll
        for (int d = 0; d < 4; ++d)
#pragma unroll
            for (int g4 = 0; g4 < 4; ++g4) {
                float v[4];
#pragma unroll
                for (int i = 0; i < 4; ++i) { const int r = 4 * g4 + i; v[i] = (o[d][r] * a1 + scr[(2 + d * 16 + r) * 64] * a2) * inv; }
                u32x2 w; w.x = pk2(v[0], v[1]); w.y = pk2(v[2], v[3]);
                *(u32x2*)(op + 32 * d + 8 * g4) = w;
            }
    }
    __syncthreads();
}

__device__ __forceinline__ void gmlp_unit(const Params& p, LAS unsigned char* lds, int nb, int h, int tid, int wave, int lane) {
    unsigned char* ws = p.ws;
    const bf16_t* proj = (const bf16_t*)(ws + WS_PROJ); bf16_t* mix = (bf16_t*)(ws + WS_MIX);
    const float* ssv = (const float*)(ws + WS_ROWSS);
    const float* vg = p.in[3]; const float* wsp = p.in[4]; const float* bs = p.in[5];
#pragma unroll
    for (int i = 0; i < 4; ++i) {
        const int pc = tid + 512 * i, r = pc >> 4, c = pc & 15, t = nb * 128 + r;
        const u32x4 w = *(const u32x4*)(proj + (size_t)t * NINP + 1024 + h * 128 + c * 8);
        const float rs = rsqrtf(ssv[t] * (1.0f / 1024.0f) + EPS);
        const f32x4 g0 = *(const f32x4*)(vg + h * 128 + c * 8), g1 = *(const f32x4*)(vg + h * 128 + c * 8 + 4);
        u32x4 ov;
        ov.x = pk2(bflo(w.x) * rs * g0[0], bfhi(w.x) * rs * g0[1]); ov.y = pk2(bflo(w.y) * rs * g0[2], bfhi(w.y) * rs * g0[3]);
        ov.z = pk2(bflo(w.z) * rs * g1[0], bfhi(w.z) * rs * g1[1]); ov.w = pk2(bflo(w.w) * rs * g1[2], bfhi(w.w) * rs * g1[3]);
        *(LAS u32x4*)(lds + r * VP + c * 16) = ov;
    }
    __syncthreads();
    const int ib = wave & 3, ch = wave >> 2, r32 = lane & 31, hh = lane >> 5;
    const int irow = 32 * ib + r32;
    f32x16 acc0 = {}, acc1 = {};
    const unsigned vaddr = (unsigned)(size_t)lds + (unsigned)((8 * hh + ((lane & 15) >> 2)) * VP + (64 * ch + 16 * ((lane >> 4) & 1) + 4 * (lane & 3)) * 2);
    const float* wrow = wsp + ((size_t)h * 128 + irow) * 128 + hh * 8;
#define GSTEP(s) do { if ((s) < 2 * (ib + 1)) { \
        const f32x4 wa = *(const f32x4*)(wrow + (s) * 16), wb = *(const f32x4*)(wrow + (s) * 16 + 4); const int j0 = (s) * 16 + hh * 8; \
        u32x4 aw; aw.x = pk2(j0 + 0 <= irow ? wa[0] : 0.f, j0 + 1 <= irow ? wa[1] : 0.f); aw.y = pk2(j0 + 2 <= irow ? wa[2] : 0.f, j0 + 3 <= irow ? wa[3] : 0.f); \
        aw.z = pk2(j0 + 4 <= irow ? wb[0] : 0.f, j0 + 5 <= irow ? wb[1] : 0.f); aw.w = pk2(j0 + 6 <= irow ? wb[2] : 0.f, j0 + 7 <= irow ? wb[3] : 0.f); \
        const bf16x8 af = __builtin_bit_cast(bf16x8, aw); \
        const s16x4 b0l = tr_read<(16 * (s)) * VP>(vaddr), b0h = tr_read<(16 * (s) + 4) * VP>(vaddr), b1l = tr_read<(16 * (s)) * VP + 64>(vaddr), b1h = tr_read<(16 * (s) + 4) * VP + 64>(vaddr); \
        LDS_WAIT(); SBAR(); \
        acc0 = __builtin_amdgcn_mfma_f32_32x32x16_bf16(af, PK8(b0l, b0h), acc0, 0, 0, 0); acc1 = __builtin_amdgcn_mfma_f32_32x32x16_bf16(af, PK8(b1l, b1h), acc1, 0, 0, 0); } } while (0)
    GSTEP(0); GSTEP(1); GSTEP(2); GSTEP(3); GSTEP(4); GSTEP(5); GSTEP(6); GSTEP(7);
#undef GSTEP
#pragma unroll
    for (int r = 0; r < 16; ++r) {
        const int i = 32 * ib + crow(r, hh), t = nb * 128 + i; const float b = bs[h * 128 + i];
        const int c0 = h * 128 + 64 * ch + r32;
        const float u0 = bf2f(proj[(size_t)t * NINP + c0]), u1 = bf2f(proj[(size_t)t * NINP + c0 + 32]);
        mix[(size_t)t * DM + c0] = (bf16_t)f2bf(u0 * (acc0[r] + b)); mix[(size_t)t * DM + c0 + 32] = (bf16_t)f2bf(u1 * (acc1[r] + b));
    }
    __syncthreads();
}

__device__ __forceinline__ void select16(float& a0, float& a1, float& sv, int& si, int lane) {
    const float NEG = -3.0e38f;
    float x0 = a0, x1 = a1, rv = 0.f; int ri = 0;
#pragma unroll 1
    for (int k = 0; k < 16; ++k) {
        const float M = wave_max(fmaxf(x0, x1));
        const unsigned long long b0 = __ballot(x0 == M), b1 = __ballot(x1 == M);
        const bool use0 = (b0 != 0ull);
        const unsigned long long bb = use0 ? b0 : b1;
        const int ln = __ffsll((long long)bb) - 1;
        const int idx = use0 ? ln : 64 + ln;
        const bool own = (lane == ln);
        x0 = (own && use0) ? NEG : x0;
        x1 = (own && !use0) ? NEG : x1;
        rv = (lane == k) ? M : rv; ri = (lane == k) ? idx : ri;
    }
    a0 = x0; a1 = x1; sv = rv; si = ri;
}
__device__ __forceinline__ void phase7(const Params& p, int gw, int NGW, int lane) {
    unsigned char* ws = p.ws;
    const float* sc = (const float*)(ws + WS_SC); int* ex = (int*)(ws + WS_EXP); float* gt = (float*)(ws + WS_GATE);
    const float NEG = -3.0e38f;
    for (int it = gw; it < S * 8; it += NGW) {
        const int t = it >> 3, h = it & 7;
        const float* b = sc + (size_t)t * DM + h * 256;
        float a0 = b[lane], a1 = b[64 + lane], c0 = b[128 + lane], c1 = b[192 + lane];
        float sv1 = 0.f, sv2 = 0.f; int si1 = 0, si2 = 0;
        select16(a0, a1, sv1, si1, lane);
        select16(c0, c1, sv2, si2, lane);
        const int i = lane >> 2, jb = (lane & 3) * 4;
        const float s1 = __shfl(sv1, i); const int id1 = __shfl(si1, i) * 128;
        float d0 = s1 + __shfl(sv2, jb + 0), d1 = s1 + __shfl(sv2, jb + 1), d2 = s1 + __shfl(sv2, jb + 2), d3 = s1 + __shfl(sv2, jb + 3);
        const int e0 = id1 + __shfl(si2, jb + 0), e1 = id1 + __shfl(si2, jb + 1), e2 = id1 + __shfl(si2, jb + 2), e3 = id1 + __shfl(si2, jb + 3);
        float ts = 0.f; int te = 0;
#pragma unroll 1
        for (int k = 0; k < 16; ++k) {
            const float M = wave_max(fmaxf(fmaxf(d0, d1), fmaxf(d2, d3)));
            const bool has = (d0 == M) || (d1 == M) || (d2 == M) || (d3 == M);
            const unsigned long long bl = __ballot(has);
            const int ln = __ffsll((long long)bl) - 1;
            const bool own = (lane == ln);
            const bool m0 = (d0 == M), m1 = !m0 && (d1 == M), m2 = !m0 && !m1 && (d2 == M), m3 = !m0 && !m1 && !m2;
            int sel = m0 ? e0 : (m1 ? e1 : (m2 ? e2 : e3));
            d0 = (own && m0) ? NEG : d0; d1 = (own && m1) ? NEG : d1; d2 = (own && m2) ? NEG : d2; d3 = (own && m3) ? NEG : d3;
            sel = __shfl(sel, ln);
            ts = (lane == k) ? M : ts; te = (lane == k) ? sel : te;
        }
        const float mx = __shfl(ts, 0);
        const float e = (lane < 16) ? __expf(ts - mx) : 0.f;
        const float sum = wave_sum(e);
        if (lane < 16) { ex[(size_t)t * 128 + h * 16 + lane] = te; gt[(size_t)t * 128 + h * 16 + lane] = e / sum; }
    }
}

__device__ __forceinline__ float dot8(u32x4 w, const float (&x)[32], int base) {
    return (bflo(w.x) * x[base + 0] + bfhi(w.x) * x[base + 1]) + (bflo(w.y) * x[base + 2] + bfhi(w.y) * x[base + 3]) +
           (bflo(w.z) * x[base + 4] + bfhi(w.z) * x[base + 5]) + (bflo(w.w) * x[base + 6] + bfhi(w.w) * x[base + 7]);
}
__device__ __forceinline__ void phase8(const Params& p, float* dst, int gw, int NGW, int lane) {
    unsigned char* ws = p.ws;
    const bf16_t* x1b = (const bf16_t*)(ws + WS_X1B); const bf16_t* UT = (const bf16_t*)(ws + WS_UT); const bf16_t* VT = (const bf16_t*)(ws + WS_VT);
    const int* ex = (const int*)(ws + WS_EXP); const float* gt = (const float*)(ws + WS_GATE); const float* ss2 = (const float*)(ws + WS_ROWSS) + 3 * S;
    const float* out = p.out;
    for (int t = gw; t < S; t += NGW) {
        const float rstd2 = rsqrtf(ss2[t] * (1.0f / DM) + EPS);
        float xf[32];
#pragma unroll
        for (int i = 0; i < 4; ++i) {
            const u32x4 w = *(const u32x4*)(x1b + (size_t)t * DM + (i * 64 + lane) * 8);
            xf[8 * i + 0] = bflo(w.x); xf[8 * i + 1] = bfhi(w.x); xf[8 * i + 2] = bflo(w.y); xf[8 * i + 3] = bfhi(w.y);
            xf[8 * i + 4] = bflo(w.z); xf[8 * i + 5] = bfhi(w.z); xf[8 * i + 6] = bflo(w.w); xf[8 * i + 7] = bfhi(w.w);
        }
        float acc[32];
#pragma unroll
        for (int i = 0; i < 32; ++i) acc[i] = 0.f;
#pragma unroll 1
        for (int gi = 0; gi < 32; ++gi) {
            const int* ep = ex + (size_t)t * 128 + gi * 4; const float* gp = gt + (size_t)t * 128 + gi * 4;
            const int e0 = ep[0], e1 = ep[1], e2 = ep[2], e3 = ep[3];
            float p0 = 0.f, p1 = 0.f, p2 = 0.f, p3 = 0.f;
            {
                const bf16_t* u0 = UT + (size_t)e0 * DM + lane * 8; const bf16_t* u1 = UT + (size_t)e1 * DM + lane * 8;
                const bf16_t* u2 = UT + (size_t)e2 * DM + lane * 8; const bf16_t* u3 = UT + (size_t)e3 * DM + lane * 8;
#pragma unroll
                for (int i = 0; i < 4; ++i) {
                    const u32x4 w0 = *(const u32x4*)(u0 + i * 512), w1 = *(const u32x4*)(u1 + i * 512), w2 = *(const u32x4*)(u2 + i * 512), w3 = *(const u32x4*)(u3 + i * 512);
                    p0 += dot8(w0, xf, 8 * i); p1 += dot8(w1, xf, 8 * i); p2 += dot8(w2, xf, 8 * i); p3 += dot8(w3, xf, 8 * i);
                }
            }
            p0 = wave_sum(p0); p1 = wave_sum(p1); p2 = wave_sum(p2); p3 = wave_sum(p3);
            const float c0 = gp[0] * gelu_tanh(rstd2 * p0), c1 = gp[1] * gelu_tanh(rstd2 * p1), c2 = gp[2] * gelu_tanh(rstd2 * p2), c3 = gp[3] * gelu_tanh(rstd2 * p3);
            {
                const bf16_t* v0 = VT + (size_t)e0 * DM + lane * 8; const bf16_t* v1 = VT + (size_t)e1 * DM + lane * 8;
                const bf16_t* v2 = VT + (size_t)e2 * DM + lane * 8; const bf16_t* v3 = VT + (size_t)e3 * DM + lane * 8;
#pragma unroll
                for (int i = 0; i < 4; ++i) {
                    const u32x4 w0 = *(const u32x4*)(v0 + i * 512), w1 = *(const u32x4*)(v1 + i * 512), w2 = *(const u32x4*)(v2 + i * 512), w3 = *(const u32x4*)(v3 + i * 512);
#define ACC8(W_, c) do { acc[8 * i + 0] += (c) * bflo((W_).x); acc[8 * i + 1] += (c) * bfhi((W_).x); acc[8 * i + 2] += (c) * bflo((W_).y); acc[8 * i + 3] += (c) * bfhi((W_).y); \
                        acc[8 * i + 4] += (c) * bflo((W_).z); acc[8 * i + 5] += (c) * bfhi((W_).z); acc[8 * i + 6] += (c) * bflo((W_).w); acc[8 * i + 7] += (c) * bfhi((W_).w); } while (0)
                    ACC8(w0, c0); ACC8(w1, c1); ACC8(w2, c2); ACC8(w3, c3);
#undef ACC8
                }
            }
        }
#pragma unroll
        for (int i = 0; i < 4; ++i) {
            const float* op = out + (size_t)t * DM + (i * 64 + lane) * 8; float* dp = dst + (size_t)t * DM + (i * 64 + lane) * 8;
            f32x4 a = *(const f32x4*)op, b = *(const f32x4*)(op + 4);
            a[0] += acc[8 * i + 0]; a[1] += acc[8 * i + 1]; a[2] += acc[8 * i + 2]; a[3] += acc[8 * i + 3];
            b[0] += acc[8 * i + 4]; b[1] += acc[8 * i + 5]; b[2] += acc[8 * i + 6]; b[3] += acc[8 * i + 7];
            *(f32x4*)dp = a; *(f32x4*)(dp + 4) = b;
        }
    }
}

__global__ void __launch_bounds__(NTHREADS, 2) mega(Params p) {
    extern __shared__ __attribute__((aligned(16))) unsigned char lds_raw[];
    LAS unsigned char* lds = (LAS unsigned char*)lds_raw;
    const int tid = threadIdx.x, lane = tid & 63, wave = __builtin_amdgcn_readfirstlane(tid >> 6);
    const int G = gridDim.x, bx = blockIdx.x;
    const int gw = bx * 8 + wave, NGW = G * 8;
    unsigned char* ws = p.ws;
    const int lo = p.ph_lo, hi = p.ph_hi;
    volatile LAS unsigned* misc = (volatile LAS unsigned*)(lds + LDS_MISC);
    if (tid < 4) misc[tid] = 0u;
    __syncthreads();
    const XcdBarrier xbar = xcd_barrier_post((unsigned*)(ws + WS_CTL), misc);
#ifndef PH_MASK
#define PH_MASK 0x1ff
#endif
#define IN(k) (((PH_MASK >> (k)) & 1) && lo <= (k) && (k) < hi)
#define SEAM(k) do { if (IN(k) && IN((k) + 1)) xcd_barrier(xbar); } while (0)

#if (PROBE_DUP >> 0) & 1
    if (IN(0)) { phase0(p, lds, gw, NGW, wave, lane); xcd_barrier(xbar); }
#endif
    if (IN(0)) phase0(p, lds, gw, NGW, wave, lane);
    SEAM(0);
    if (IN(1)) {
        pg8::Gemm g{(const bf16_t*)(ws + WS_XB), (const bf16_t*)(ws + WS_WIN), S, NINP, DM, DM, DM};
        pg8::StaticOrder So; So.init(S, NINP, G, bx);
        pg8::Epi<1> E{(const float*)(ws + WS_RSTD1), 0.f, (float*)(ws + WS_ROWSS), (bf16_t*)(ws + WS_PROJ), NINP, nullptr, nullptr};
        pg8::gemm_phase<pg8::Epi<1>, pg8::StaticOrder, true, true>(lds, g, So, E);
    }
    SEAM(1);
    if (IN(2)) {
        {
            pg8::Gemm g{(const bf16_t*)(ws + WS_PROJ) + 2048, (const bf16_t*)(ws + WS_WUQ), S, 1536, 512, NINP, 512};
            pg8::StaticOrder So; So.init(S, 1536, G, bx);
            pg8::Epi<2> E{(const float*)(ws + WS_ROWSS) + 1 * S, 1.0f / 512.0f, nullptr, (bf16_t*)(ws + WS_QRAW), 1536, nullptr, nullptr};
            pg8::gemm_phase<pg8::Epi<2>, pg8::StaticOrder, true, true>(lds, g, So, E);
        }
        __syncthreads();
        {
            pg8::Gemm g{(const bf16_t*)(ws + WS_PROJ) + 2560, (const bf16_t*)(ws + WS_WUKV), S, 2048, 256, NINP, 256};
            pg8::StaticOrder So; So.init(S, 2048, G, bx);
            pg8::Epi<2> E{(const float*)(ws + WS_ROWSS) + 2 * S, 1.0f / 256.0f, nullptr, (bf16_t*)(ws + WS_KVRAW), 2048, nullptr, nullptr};
            pg8::gemm_phase<pg8::Epi<2>, pg8::StaticOrder, true, true>(lds, g, So, E);
        }
    }
    SEAM(2);
#if (PROBE_DUP >> 3) & 1
    if (IN(3)) { phase3(p, gw, NGW, lane); xcd_barrier(xbar); }
#endif
    if (IN(3)) phase3(p, gw, NGW, lane);
    SEAM(3);
#if (PROBE_DUP >> 4) & 1
#define P4_REPS 2
#else
#define P4_REPS 1
#endif
    if (IN(4)) {
        for (int rep = 0; rep < P4_REPS; ++rep) {
#if (PROBE_DUP >> 9) & 1
        if (rep == 0)
#endif
        for (int pr = bx; pr < 256; pr += G) {
            const int head = pr & 7, x = pr >> 3;
            attn_unit(p, lds, head, 63 - x, tid, wave, lane);
            attn_unit(p, lds, head, x, tid, wave, lane);
        }
        for (int u = bx; u < 512; u += G) gmlp_unit(p, lds, u >> 3, u & 7, tid, wave, lane);
        if (rep + 1 < P4_REPS) xcd_barrier(xbar);
        }
    }
    SEAM(4);
    if (IN(5)) {
        pg8::Gemm g{(const bf16_t*)(ws + WS_MIX), (const bf16_t*)(ws + WS_WOUT), S, DM, DM, DM, DM};
        pg8::StaticOrder So; So.init(S, DM, G, bx);
        pg8::Epi<4> E{nullptr, 0.f, (float*)(ws + WS_ROWSS) + 3 * S, (bf16_t*)(ws + WS_X1B), DM, p.out, p.in[0]};
        pg8::gemm_phase<pg8::Epi<4>, pg8::StaticOrder, true, true>(lds, g, So, E);
    }
    SEAM(5);
    if (IN(6)) {
        pg8::Gemm g{(const bf16_t*)(ws + WS_X1B), (const bf16_t*)(ws + WS_WS), S, DM, DM, DM, DM};
        pg8::StaticOrder So; So.init(S, DM, G, bx);
        pg8::Epi<5> E{(const float*)(ws + WS_ROWSS) + 3 * S, 1.0f / DM, nullptr, nullptr, DM, (float*)(ws + WS_SC), nullptr};
        pg8::gemm_phase<pg8::Epi<5>, pg8::StaticOrder, true, true>(lds, g, So, E);
    }
    SEAM(6);
#if (PROBE_DUP >> 7) & 1
    if (IN(7)) { phase7(p, gw, NGW, lane); xcd_barrier(xbar); }
#endif
    if (IN(7)) phase7(p, gw, NGW, lane);
    SEAM(7);
#if (PROBE_DUP >> 8) & 1
    if (IN(8)) { phase8(p, (float*)(ws + WS_SC), gw, NGW, lane); xcd_barrier(xbar); }
#endif
    if (IN(8)) phase8(p, p.out, gw, NGW, lane);
#undef IN
#undef SEAM
}

extern "C" void kernel_launch(void* const* d_in, const int* in_sizes, int n_in, void* d_out, int out_size, void* d_ws, size_t ws_size, hipStream_t stream) {
    static int grid = 0;
    if (grid == 0) {
        if (n_in != 18 || out_size != S * DM || ws_size < WS_END) { fprintf(stderr, "kernel_launch: unexpected shapes (n_in %d out %d ws %zu)\n", n_in, out_size, ws_size); grid = -1; return; }
        int dev = 0, cus = 0, per_cu = 0;
        hipGetDevice(&dev);
        hipDeviceGetAttribute(&cus, hipDeviceAttributeMultiprocessorCount, dev);
        if (hipFuncSetAttribute((const void*)mega, hipFuncAttributeMaxDynamicSharedMemorySize, LDS_BYTES) != hipSuccess) { fprintf(stderr, "kernel_launch: hipFuncSetAttribute failed\n"); grid = -1; return; }
        if (hipOccupancyMaxActiveBlocksPerMultiprocessor(&per_cu, (const void*)mega, NTHREADS, LDS_BYTES) != hipSuccess || per_cu < 1) { fprintf(stderr, "kernel_launch: occupancy query failed (%d)\n", per_cu); grid = -1; return; }
        grid = cus;
        fprintf(stderr, "kernel_launch: cus %d per_cu %d grid %d\n", cus, per_cu, grid);
    }
    if (grid < 0) return;
    hipMemsetAsync((char*)d_ws + WS_CTL, 0, 1 * MiB, stream);
    Params prm{};
    for (int i = 0; i < 18; ++i) prm.in[i] = (const float*)d_in[i];
    prm.out = (float*)d_out; prm.ws = (unsigned char*)d_ws;
#if MK_ONE_LAUNCH
    prm.ph_lo = 0; prm.ph_hi = NPH;
    { void* args[] = {&prm}; hipError_t e = hipLaunchCooperativeKernel((const void*)mega, dim3(grid), dim3(NTHREADS), args, LDS_BYTES, stream);
      if (e != hipSuccess) fprintf(stderr, "cooperative launch failed: %s\n", hipGetErrorString(e)); }
#else
    for (int ph = 0; ph < NPH; ++ph) {
        prm.ph_lo = ph; prm.ph_hi = ph + 1;
        void* args[] = {&prm};
        hipError_t e = hipLaunchCooperativeKernel((const void*)mega, dim3(grid), dim3(NTHREADS), args, LDS_BYTES, stream);
        if (e != hipSuccess) { fprintf(stderr, "cooperative launch %d failed: %s\n", ph, hipGetErrorString(e)); break; }
    }
#endif
}
```

```cpp
#include <hip/hip_runtime.h>
#include <cstdio>
#include <cstdint>

#define LAS __attribute__((address_space(3)))
typedef unsigned short bf16_t;
typedef short bf16x8 __attribute__((ext_vector_type(8)));
typedef short s16x4 __attribute__((ext_vector_type(4)));
typedef float f32x4 __attribute__((ext_vector_type(4)));
typedef float f32x16 __attribute__((ext_vector_type(16)));
typedef unsigned u32x4 __attribute__((ext_vector_type(4)));
typedef unsigned u32x2 __attribute__((ext_vector_type(2)));

#ifndef PROBE_DUP
#define PROBE_DUP 0
#endif
#ifndef MK_ONE_LAUNCH
#define MK_ONE_LAUNCH 1
#endif

constexpr int S = 8192, DM = 2048, NIN = 2880, NINP = 3072;
constexpr int NPH = 9;
constexpr float EPS = 1e-6f;
constexpr int LDS_BYTES = 147456;
constexpr int NTHREADS = 512;
constexpr int LDS_MISC = 131072 + 1024;

constexpr size_t MiB = 1u << 20;
constexpr size_t WS_CTL = 0;
constexpr size_t WS_ROWSS = 128 * 1024;
constexpr size_t WS_COS = 1 * MiB, WS_SIN = 2 * MiB;
constexpr size_t WS_RSTD1 = 3 * MiB;
constexpr size_t WS_EXP = 4 * MiB;
constexpr size_t WS_GATE = 8 * MiB;
constexpr size_t WS_WIN = 12 * MiB;
constexpr size_t WS_WUQ = 24 * MiB;
constexpr size_t WS_WUKV = 26 * MiB;
constexpr size_t WS_WOUT = 28 * MiB;
constexpr size_t WS_WS = 36 * MiB;
constexpr size_t WS_XB = 44 * MiB;
constexpr size_t WS_PROJ = 76 * MiB;
constexpr size_t WS_QRAW = 124 * MiB;
constexpr size_t WS_KVRAW = 148 * MiB;
constexpr size_t WS_QH = 180 * MiB;
constexpr size_t WS_KH = 204 * MiB;
constexpr size_t WS_VH = 228 * MiB;
constexpr size_t WS_MIX = 244 * MiB;
constexpr size_t WS_X1B = 276 * MiB;
constexpr size_t WS_SC = 308 * MiB;
constexpr size_t WS_UT = 372 * MiB;
constexpr size_t WS_VT = 436 * MiB;
constexpr size_t WS_END = 500 * MiB;

__device__ __forceinline__ unsigned f2bf(float f) { unsigned u = __builtin_bit_cast(unsigned, f); return (u + 0x7fffu + ((u >> 16) & 1u)) >> 16; }
__device__ __forceinline__ unsigned pk2(float lo, float hi) { return f2bf(lo) | (f2bf(hi) << 16); }
__device__ __forceinline__ float bf2f(unsigned short b) { return __builtin_bit_cast(float, (unsigned)b << 16); }
__device__ __forceinline__ float bflo(unsigned w) { return __builtin_bit_cast(float, w << 16); }
__device__ __forceinline__ float bfhi(unsigned w) { return __builtin_bit_cast(float, w & 0xffff0000u); }
__device__ __forceinline__ float wave_sum(float v) {
#pragma unroll
    for (int o = 32; o > 0; o >>= 1) v += __shfl_xor(v, o);
    return v;
}
__device__ __forceinline__ float wave_max(float v) {
#pragma unroll
    for (int o = 32; o > 0; o >>= 1) v = fmaxf(v, __shfl_xor(v, o));
    return v;
}
__device__ __forceinline__ float gelu_tanh(float x) {
    const float y = 0.7978845608028654f * (x + 0.044715f * x * x * x);
    return x / (1.0f + __expf(-2.0f * y));
}
__device__ __forceinline__ int crow(int r, int hi) { return (r & 3) + 8 * (r >> 2) + 4 * hi; }
#define LDS_WAIT() asm volatile("s_waitcnt lgkmcnt(0)" ::: "memory")
#define SBAR() __builtin_amdgcn_sched_barrier(0)

namespace pg8 {
#define PG8_LAS __attribute__((address_space(3)))
constexpr int BM = 256, BK = 64, HALF = 128, HTB = HALF * BK * 2  , STAGE_BYTES = 8 * HTB, NXCD = 8, WGM = 8;

__host__ __device__ __forceinline__ int lds_byte(int r, int c) { const int st = (r >> 4) * 2 + (c >> 5), rr = r & 15, cc = c & 31, ob = rr * 64 + cc * 2; return st * 1024 + (ob ^ (((ob >> 9) & 1) << 5)); }
__host__ __device__ __forceinline__ void stage_rc(int b, int& R, int& C) { const int st = b / 1024, sb = b % 1024, swz = sb ^ (((sb >> 9) & 1) << 5); R = (st >> 1) * 16 + swz / 64; C = (st & 1) * 32 + (swz % 64) / 2; }
__host__ __device__ __forceinline__ int perm32(int rho) { const int n = rho >> 4, i = rho & 15; return 8 * (i >> 2) + 4 * n + (i & 3); }

struct Unit { int pm, pn; };
struct Gemm { const bf16_t* A; const bf16_t* Bt; int M, N, K, lda, ldb; };

struct StaticOrder {
    int nM, nN, nwg, G, c;
    __host__ __device__ void init(int M, int N, int G_, int c_) { nM = M / BM; nN = N / BM; nwg = nM * nN; G = G_; c = c_; }
    __host__ __device__ bool next(int i, Unit& u) const {
        const long L = (long)i * G + c; if (L >= nwg) return false;
        int wgid = (int)L; { const int q = nwg / NXCD, r = nwg % NXCD, xcd = wgid % NXCD, off = wgid / NXCD; wgid = (xcd < r ? xcd * (q + 1) : r * (q + 1) + (xcd - r) * q) + off; }
        const int nig = WGM * nN, gid = wgid / nig, fm = gid * WGM, gsz = (nM - fm) < WGM ? (nM - fm) : WGM;
        u.pm = fm + ((wgid % nig) % gsz); u.pn = (wgid % nig) / gsz; return true;
    }
    __device__ __forceinline__ void a_ready(const Unit&) const {}
    __device__ __forceinline__ void done(const Unit&) const {}
};

template <class Epi, class Sched, bool ALIGN_EPI = false, bool SP2 = false>
__device__ __forceinline__ void gemm_phase(PG8_LAS unsigned char* lds, const Gemm g, const Sched& S, const Epi& E) {
    const int tid = threadIdx.x, wid = __builtin_amdgcn_readfirstlane(tid >> 6), lane = tid & 63, wr = wid >> 2, wc = wid & 3, fr = lane & 15, fq = lane >> 4;
    const int K = g.K, nt = K / BK;
    unsigned voffA[2], voffB[2];
#pragma unroll
    for (int i = 0; i < 2; ++i) { int R, C; stage_rc(tid * 16 + i * 8192, R, C); const int Rb = Epi::PERM ? ((R & ~31) + perm32(R & 31)) : R;
        voffA[i] = (unsigned)(R * g.lda + C) * 2u; voffB[i] = (unsigned)(Rb * g.ldb + C) * 2u; }
    const size_t kstep = (size_t)(BK * 2);
    const size_t hstepA = (size_t)HALF * g.lda * 2, hstepB = (size_t)HALF * g.ldb * 2;
    const size_t tstepA = 2 * hstepA, tstepB = 2 * hstepB;
    const unsigned ldsw = (unsigned)wid * 1024u;
    const int aoff = lds_byte(wr * 64 + fr, fq * 8), boff = lds_byte(wc * 32 + fr, fq * 8);
#define PG8_SA(b, h) (((b) * 2 + (h)) * HTB)
#define PG8_SB(b, h) ((4 + (b) * 2 + (h)) * HTB)
#define PG8_STAGE(bufoff, gbase, voff) do { _Pragma("unroll") for (int _i = 0; _i < 2; ++_i) \
        __builtin_amdgcn_global_load_lds((const unsigned*)((const char*)(gbase) + (voff)[_i]), (PG8_LAS unsigned*)(lds + (bufoff) + ldsw + _i * 8192), 16, 0, 0); } while (0)
#define PG8_LDA(dst, b, h) do { _Pragma("unroll") for (int m = 0; m < 4; ++m) _Pragma("unroll") for (int k = 0; k < 2; ++k) dst[m][k] = *(const PG8_LAS bf16x8*)(lds + PG8_SA(b, h) + aoff + m * 2048 + k * 1024); } while (0)
#define PG8_LDB(dst, b, h) do { _Pragma("unroll") for (int n = 0; n < 2; ++n) _Pragma("unroll") for (int k = 0; k < 2; ++k) dst[n][k] = *(const PG8_LAS bf16x8*)(lds + PG8_SB(b, h) + boff + n * 2048 + k * 1024); } while (0)
#define PG8_MMA(ai, bj, At, Bt) do { __builtin_amdgcn_s_setprio(1); _Pragma("unroll") for (int m = 0; m < 4; ++m) _Pragma("unroll") for (int n = 0; n < 2; ++n) _Pragma("unroll") for (int k = 0; k < 2; ++k) \
        acc[ai][bj][m][n] = __builtin_amdgcn_mfma_f32_16x16x32_bf16(Bt[n][k], At[m][k], acc[ai][bj][m][n], 0, 0, 0); __builtin_amdgcn_s_setprio(0); } while (0)
#define PG8_WAIT_V(n) asm volatile("s_waitcnt vmcnt(" #n ")" ::: "memory")
#define PG8_WAIT_L(n) asm volatile("s_waitcnt lgkmcnt(" #n ")" ::: "memory")
#define PG8_BAR __builtin_amdgcn_s_barrier()
#define PG8_SCHED __builtin_amdgcn_sched_barrier(0)
    Unit cur, nxt; int ui = 0;
    if (!S.next(0, cur)) return;
    f32x4 acc[2][2][4][2];
#pragma unroll
    for (int a = 0; a < 2; ++a)
#pragma unroll
        for (int b = 0; b < 2; ++b)
#pragma unroll
            for (int m = 0; m < 4; ++m)
#pragma unroll
                for (int n = 0; n < 2; ++n) acc[a][b][m][n] = (f32x4){0.f, 0.f, 0.f, 0.f};
    bf16x8 At[4][2], B0[2][2], B1[2][2];
    const char* cA = (const char*)g.A + (size_t)cur.pm * tstepA; const char* cB = (const char*)g.Bt + (size_t)cur.pn * tstepB;
    S.a_ready(cur);
    if constexpr (SP2) {
        PG8_STAGE(PG8_SB(0, 0), cB, voffB); PG8_STAGE(PG8_SB(0, 1), cB + hstepB, voffB); PG8_STAGE(PG8_SA(0, 0), cA, voffA); PG8_STAGE(PG8_SA(0, 1), cA + hstepA, voffA);
        if (wr == 1) PG8_BAR;
        PG8_WAIT_V(2); PG8_BAR;
        PG8_STAGE(PG8_SB(1, 0), cB + kstep, voffB); PG8_STAGE(PG8_SA(1, 0), cA + kstep, voffA); PG8_STAGE(PG8_SB(1, 1), cB + hstepB + kstep, voffB);
        PG8_WAIT_V(6); PG8_BAR;
    } else {
        PG8_STAGE(PG8_SB(0, 0), cB, voffB); PG8_STAGE(PG8_SA(0, 0), cA, voffA); PG8_STAGE(PG8_SB(0, 1), cB + hstepB, voffB); PG8_STAGE(PG8_SA(0, 1), cA + hstepA, voffA);
        if (wr == 1) PG8_BAR;
        PG8_WAIT_V(4); PG8_BAR;
        PG8_STAGE(PG8_SB(1, 0), cB + kstep, voffB); PG8_STAGE(PG8_SA(1, 0), cA + kstep, voffA); PG8_STAGE(PG8_SB(1, 1), cB + hstepB + kstep, voffB);
        PG8_WAIT_V(6); PG8_BAR;
    }
    for (;;) {
        const bool has_next = S.next(ui + 1, nxt);
        const char* nA = has_next ? (const char*)g.A + (size_t)nxt.pm * tstepA : cA; const char* nB = has_next ? (const char*)g.Bt + (size_t)nxt.pn * tstepB : cB;
        for (int t = 0; t < nt; t += 2) {
            const bool last = (t == nt - 2);
            const char* a1 = cA + (size_t)(t + 1) * kstep;
            const char* a2 = last ? nA : cA + (size_t)(t + 2) * kstep; const char* b2 = last ? nB : cB + (size_t)(t + 2) * kstep;
            const char* a3 = a2 + kstep; const char* b3 = b2 + kstep;
            if (last && has_next) S.a_ready(nxt);
            if constexpr (SP2) {
            PG8_LDB(B0, 0, 0); PG8_LDB(B1, 0, 1); PG8_SCHED; PG8_LDA(At, 0, 0); PG8_STAGE(PG8_SA(1, 1), a1 + hstepA, voffA);
            PG8_WAIT_V(8); PG8_WAIT_L(0); PG8_BAR; PG8_MMA(0, 0, At, B0); PG8_MMA(0, 1, At, B1); PG8_BAR; PG8_SCHED;
            PG8_LDA(At, 0, 1); PG8_STAGE(PG8_SB(0, 0), b2, voffB); PG8_STAGE(PG8_SB(0, 1), b2 + hstepB, voffB); PG8_STAGE(PG8_SA(0, 0), a2, voffA);
            PG8_WAIT_V(8); PG8_WAIT_L(0); PG8_BAR; PG8_MMA(1, 0, At, B0); PG8_MMA(1, 1, At, B1); PG8_BAR; PG8_SCHED;
            PG8_LDB(B0, 1, 0); PG8_LDB(B1, 1, 1); PG8_SCHED; PG8_LDA(At, 1, 0); PG8_STAGE(PG8_SA(0, 1), a2 + hstepA, voffA);
            PG8_WAIT_V(8); PG8_WAIT_L(0); PG8_BAR; PG8_MMA(0, 0, At, B0); PG8_MMA(0, 1, At, B1); PG8_BAR; PG8_SCHED;
            PG8_LDA(At, 1, 1); PG8_STAGE(PG8_SB(1, 0), b3, voffB); PG8_STAGE(PG8_SB(1, 1), b3 + hstepB, voffB); PG8_STAGE(PG8_SA(1, 0), a3, voffA);
            PG8_WAIT_V(8); PG8_WAIT_L(0); PG8_BAR; PG8_MMA(1, 0, At, B0); PG8_MMA(1, 1, At, B1); PG8_BAR; PG8_SCHED;
            } else {
            PG8_LDB(B0, 0, 0); PG8_SCHED; PG8_LDA(At, 0, 0); PG8_STAGE(PG8_SA(1, 1), a1 + hstepA, voffA);
            PG8_WAIT_L(8); PG8_BAR; PG8_WAIT_L(0); PG8_MMA(0, 0, At, B0); PG8_BAR; PG8_SCHED;
            PG8_LDB(B1, 0, 1); PG8_STAGE(PG8_SB(0, 0), b2, voffB);
            PG8_BAR; PG8_WAIT_L(0); PG8_MMA(0, 1, At, B1); PG8_BAR;
            PG8_LDA(At, 0, 1); PG8_STAGE(PG8_SA(0, 0), a2, voffA);
            PG8_BAR; PG8_WAIT_L(0); PG8_MMA(1, 0, At, B0); PG8_BAR; PG8_SCHED;
            PG8_STAGE(PG8_SB(0, 1), b2 + hstepB, voffB);
            PG8_WAIT_V(6); PG8_BAR; PG8_MMA(1, 1, At, B1); PG8_BAR;
            PG8_LDB(B0, 1, 0); PG8_SCHED; PG8_LDA(At, 1, 0); PG8_STAGE(PG8_SA(0, 1), a2 + hstepA, voffA);
            PG8_WAIT_L(8); PG8_BAR; PG8_WAIT_L(0); PG8_MMA(0, 0, At, B0); PG8_BAR; PG8_SCHED;
            PG8_LDB(B1, 1, 1); PG8_STAGE(PG8_SB(1, 0), b3, voffB);
            PG8_BAR; PG8_WAIT_L(0); PG8_MMA(0, 1, At, B1); PG8_BAR;
            PG8_LDA(At, 1, 1); PG8_STAGE(PG8_SA(1, 0), a3, voffA);
            PG8_BAR; PG8_WAIT_L(0); PG8_MMA(1, 0, At, B0); PG8_BAR; PG8_SCHED;
            PG8_STAGE(PG8_SB(1, 1), b3 + hstepB, voffB);
            PG8_WAIT_V(6); PG8_BAR; PG8_MMA(1, 1, At, B1); PG8_BAR;
            }
        }
        if constexpr (ALIGN_EPI) { if (wr == 0) PG8_BAR; }
        if constexpr (!Epi::AFTER_DRAIN) { E(acc, cur, wr, wc, fr, fq); S.done(cur); }
        if (!has_next) break;
#pragma unroll
        for (int a = 0; a < 2; ++a)
#pragma unroll
            for (int b = 0; b < 2; ++b)
#pragma unroll
                for (int m = 0; m < 4; ++m)
#pragma unroll
                    for (int n = 0; n < 2; ++n) acc[a][b][m][n] = (f32x4){0.f, 0.f, 0.f, 0.f};
        cur = nxt; cA = nA; cB = nB; ++ui;
        if constexpr (ALIGN_EPI) { if (wr == 1) PG8_BAR; }
    }
    PG8_WAIT_V(0);
    if constexpr (!ALIGN_EPI) { if (wr == 0) PG8_BAR; }
    PG8_BAR;
#undef PG8_SA
#undef PG8_SB
#undef PG8_STAGE
#undef PG8_LDA
#undef PG8_LDB
#undef PG8_MMA
#undef PG8_WAIT_V
#undef PG8_WAIT_L
#undef PG8_BAR
#undef PG8_SCHED
}

template <int MODE> struct Epi {
    static constexpr bool PERM = false, AFTER_DRAIN = false;
    const float* rowsrc; float inv_n; float* ss; bf16_t* ob; int ldc; float* of; const float* xin;
    __device__ __forceinline__ void operator()(const f32x4 (&acc)[2][2][4][2], const Unit& u, int wr, int wc, int fr, int fq) const {
#pragma unroll
        for (int ai = 0; ai < 2; ++ai)
#pragma unroll
            for (int m = 0; m < 4; ++m) {
                const int row = u.pm * BM + ai * HALF + wr * 64 + m * 16 + fr;
                float rs = 1.f;
                if (MODE == 1) rs = rowsrc[row];
                if (MODE == 2 || MODE == 5) rs = rsqrtf(rowsrc[row] * inv_n + EPS);
                float ssq = 0.f;
#pragma unroll
                for (int bj = 0; bj < 2; ++bj)
#pragma unroll
                    for (int n = 0; n < 2; ++n) {
                        const int col = u.pn * BM + bj * HALF + wc * 32 + n * 16 + fq * 4;
                        f32x4 v = acc[ai][bj][m][n] * rs;
                        if (MODE == 1) { if (u.pn < 8) { v[0] = gelu_tanh(v[0]); v[1] = gelu_tanh(v[1]); v[2] = gelu_tanh(v[2]); v[3] = gelu_tanh(v[3]); } }
                        if (MODE == 4) { const f32x4 xr = *(const f32x4*)(xin + (size_t)row * DM + col); v = v + xr; }
                        if (MODE == 1 || MODE == 4) ssq += (v[0] * v[0] + v[1] * v[1]) + (v[2] * v[2] + v[3] * v[3]);
                        if (MODE == 1 || MODE == 2 || MODE == 4) { u32x2 w; w.x = pk2(v[0], v[1]); w.y = pk2(v[2], v[3]); *(u32x2*)(ob + (size_t)row * ldc + col) = w; }
                        if (MODE == 4 || MODE == 5) *(f32x4*)(of + (size_t)row * DM + col) = v;
                    }
                if (MODE == 1) {
                    const int seg = (u.pn >= 4 && u.pn < 8) ? 0 : ((u.pn == 8 || u.pn == 9) ? 1 : (u.pn == 10 ? 2 : -1));
                    if (seg >= 0) { ssq += __shfl_xor(ssq, 16); ssq += __shfl_xor(ssq, 32); if (fq == 0) atomicAdd(ss + seg * S + row, ssq); }
                }
                if (MODE == 4) { ssq += __shfl_xor(ssq, 16); ssq += __shfl_xor(ssq, 32); if (fq == 0) atomicAdd(ss + row, ssq); }
            }
    }
};
}

#define XB_TMO      128
#define XB_XCNT(j)  (256  + 64 * (j))
#define XB_XSUB(j)  (1280 + 64 * (j))
#define XB_XGEN(j)  (2304 + 64 * (j))
#define XB_TOP      3328
#define XB_TOPGEN   3392
#define XCD_BAR_WORDS 3456
#define XB_SPIN_CAP (1u << 18)
__device__ __forceinline__ unsigned xb_ld(unsigned* p)              { return __hip_atomic_load(p, __ATOMIC_RELAXED, __HIP_MEMORY_SCOPE_AGENT); }
__device__ __forceinline__ unsigned xb_add(unsigned* p, unsigned v) { return __hip_atomic_fetch_add(p, v, __ATOMIC_RELAXED, __HIP_MEMORY_SCOPE_AGENT); }
__device__ __forceinline__ unsigned xb_xcc_id() { return (unsigned)__builtin_amdgcn_s_getreg((3 << 11) | 20) & 0xFu; }
#define XB_SPIN(cond, bar) do { unsigned _sp = 0; while (cond) { __builtin_amdgcn_s_sleep(1); \
    if ((++_sp & 255u) == 0u) { if (xb_ld(&(bar)[XB_TMO])) break; if (_sp > XB_SPIN_CAP) { atomicAdd(&(bar)[XB_TMO], 1u); break; } } } } while (0)
struct XcdBarrier { unsigned* bar; unsigned x; volatile LAS unsigned* st; };
__device__ __forceinline__ XcdBarrier xcd_barrier_post(unsigned* bar, volatile LAS unsigned* st) {
    XcdBarrier b; b.bar = bar; b.x = xb_xcc_id(); b.st = st;
    if (threadIdx.x == 0) (void)xb_add(&bar[XB_XCNT(b.x)], 1u);
    return b;
}
__device__ __forceinline__ void xcd_barrier_complete(unsigned* bar, unsigned x, unsigned& nloc, unsigned& nx) {
    const unsigned G = gridDim.x * gridDim.y * gridDim.z;
    unsigned sum, cnt, mine, sp = 0u;
    for (;;) {
        sum = 0u; cnt = 0u; mine = 0u;
#pragma unroll
        for (unsigned j = 0; j < 16; ++j) { const unsigned c = xb_ld(&bar[XB_XCNT(j)]); sum += c; cnt += (c > 0u) ? 1u : 0u; mine = (j == x) ? c : mine; }
        if (sum == G) break;
        __builtin_amdgcn_s_sleep(1);
        if ((++sp & 255u) == 0u) { if (xb_ld(&bar[XB_TMO])) break; if (sp > XB_SPIN_CAP) { atomicAdd(&bar[XB_TMO], 1u); break; } }
    }
    nloc = mine > 0u ? mine : 1u; nx = cnt > 0u ? cnt : 1u;
}
__device__ __forceinline__ void xcd_barrier(const XcdBarrier& b) {
    asm volatile("s_waitcnt vmcnt(0)" ::: "memory");
    __syncthreads();
    if (threadIdx.x == 0) {
        unsigned* bar = b.bar;
        __builtin_amdgcn_s_waitcnt(0);
        unsigned nloc = b.st[0], nx = b.st[1];
        if (nloc == 0u) { xcd_barrier_complete(bar, b.x, nloc, nx); b.st[0] = nloc; b.st[1] = nx; }
        const unsigned old = xb_add(&bar[XB_XSUB(b.x)], 1u);
        const unsigned gen = old / nloc;
        if (old + 1u == (gen + 1u) * nloc) {
            __builtin_amdgcn_fence(__ATOMIC_RELEASE, "agent");
            asm volatile("s_waitcnt vmcnt(0)" ::: "memory");
            const unsigned og = xb_add(&bar[XB_TOP], 1u);
            const unsigned tg = og / nx;
            if (og + 1u == (tg + 1u) * nx) xb_add(&bar[XB_TOPGEN], 1u);
            else XB_SPIN(xb_ld(&bar[XB_TOPGEN]) == tg, bar);
            __builtin_amdgcn_fence(__ATOMIC_ACQUIRE, "agent");
            xb_add(&bar[XB_XGEN(b.x)], 1u);
            asm volatile("s_waitcnt vmcnt(0)" ::: "memory");
        } else {
            XB_SPIN(xb_ld(&bar[XB_XGEN(b.x)]) == gen, bar);
            __builtin_amdgcn_fence(__ATOMIC_ACQUIRE, "agent");
            asm volatile("s_waitcnt vmcnt(0)" ::: "memory");
        }
    }
    __syncthreads();
}

struct Params {
    const float* in[18];
    float* out;
    unsigned char* ws;
    int ph_lo, ph_hi;
};

__device__ __forceinline__ void p0_transpose_item(const float* W, const float* g, int K, int N, bf16_t* WT, LAS float* scr, int item, int lane) {
    const int nblk = N / 32, kb = item / nblk, nb = item % nblk, k0 = 64 * kb, n0 = 32 * nb;
#pragma unroll 8
    for (int i = 0; i < 32; ++i) { const int kk = 2 * i + (lane >> 5); const float gv = g ? g[k0 + kk] : 1.f;
        scr[kk * 33 + (lane & 31)] = W[(size_t)(k0 + kk) * N + n0 + (lane & 31)] * gv; }
    LDS_WAIT(); asm volatile("" ::: "memory");
    const int c = lane & 7;
#pragma unroll
    for (int j = 0; j < 4; ++j) { const int n = (lane >> 3) + 8 * j; const LAS float* s = scr + (8 * c) * 33 + n;
        u32x4 o; o.x = pk2(s[0 * 33], s[1 * 33]); o.y = pk2(s[2 * 33], s[3 * 33]); o.z = pk2(s[4 * 33], s[5 * 33]); o.w = pk2(s[6 * 33], s[7 * 33]);
        *(u32x4*)(WT + (size_t)(n0 + n) * K + k0 + 8 * c) = o; }
    LDS_WAIT(); asm volatile("" ::: "memory");
}
__device__ __forceinline__ float row_to_bf16(const float* src, const float* g, bf16_t* dst, int lane) {
    float ss = 0.f;
#pragma unroll
    for (int i = 0; i < 8; ++i) {
        const int c = (i * 64 + lane) * 4;
        f32x4 v = *(const f32x4*)(src + c);
        ss += (v[0] * v[0] + v[1] * v[1]) + (v[2] * v[2] + v[3] * v[3]);
        if (g) { const f32x4 gv = *(const f32x4*)(g + c); v = v * gv; }
        u32x2 w; w.x = pk2(v[0], v[1]); w.y = pk2(v[2], v[3]);
        *(u32x2*)(dst + c) = w;
    }
    return ss;
}
constexpr float PEER_USC = 1024.0f, PEER_VSC = 64.0f;
__device__ __forceinline__ unsigned pk4_fp8(f32x4 v) {
    v[0] = fminf(fmaxf(v[0], -448.f), 448.f); v[1] = fminf(fmaxf(v[1], -448.f), 448.f); v[2] = fminf(fmaxf(v[2], -448.f), 448.f); v[3] = fminf(fmaxf(v[3], -448.f), 448.f);
    int w = __builtin_amdgcn_cvt_pk_fp8_f32(v[0], v[1], 0, false);
    w = __builtin_amdgcn_cvt_pk_fp8_f32(v[2], v[3], w, true);
    return (unsigned)w;
}
__device__ __forceinline__ void row2_to_fp8(const float* src, const float* g, float scale, unsigned char* dst, int lane) {
    f32x4 v[16];
#pragma unroll
    for (int i = 0; i < 16; ++i) v[i] = *(const f32x4*)(src + (i * 64 + lane) * 4);
#pragma unroll
    for (int i = 0; i < 16; ++i) {
        f32x4 x = v[i] * scale;
        if (g) { const f32x4 gv = *(const f32x4*)(g + ((i & 7) * 64 + lane) * 4); x = x * gv; }
        *(unsigned*)(dst + (i * 64 + lane) * 4) = pk4_fp8(x);
    }
}
__device__ __forceinline__ bf16x8 cvt8(const float* p) {
    const f32x4 a = *(const f32x4*)p, b = *(const f32x4*)(p + 4);
    u32x4 w; w.x = pk2(a[0], a[1]); w.y = pk2(a[2], a[3]); w.z = pk2(b[0], b[1]); w.w = pk2(b[2], b[3]);
    return __builtin_bit_cast(bf16x8, w);
}

__device__ __forceinline__ void phase0(const Params& p, LAS unsigned char* lds, int gw, int NGW, int wave, int lane) {
    unsigned char* ws = p.ws;
    LAS float* scr = (LAS float*)(lds + wave * 16384);
    const float* x = p.in[0];
    {
        constexpr int I_IN = (DM / 64) * (NIN / 32), I_UQ = (512 / 64) * (1536 / 32), I_UKV = (256 / 64) * (2048 / 32), I_OUT = (DM / 64) * (DM / 32);
        constexpr int NIT = I_IN + I_UQ + I_UKV + I_OUT;
        for (int it = gw; it < NIT; it += NGW) {
            int r = it;
            if (r < I_IN) { p0_transpose_item(p.in[2], p.in[1], DM, NIN, (bf16_t*)(ws + WS_WIN), scr, r, lane); continue; } r -= I_IN;
            if (r < I_UQ) { p0_transpose_item(p.in[7], p.in[6], 512, 1536, (bf16_t*)(ws + WS_WUQ), scr, r, lane); continue; } r -= I_UQ;
            if (r < I_UKV) { p0_transpose_item(p.in[9], p.in[8], 256, 2048, (bf16_t*)(ws + WS_WUKV), scr, r, lane); continue; } r -= I_UKV;
            p0_transpose_item(p.in[12], nullptr, DM, DM, (bf16_t*)(ws + WS_WOUT), scr, r, lane);
        }
    }
    for (int r = gw; r < NINP - NIN; r += NGW) {
        bf16_t* d = (bf16_t*)(ws + WS_WIN) + (size_t)(NIN + r) * DM;
#pragma unroll
        for (int i = 0; i < 4; ++i) *(u32x4*)(d + (i * 64 + lane) * 8) = (u32x4){0u, 0u, 0u, 0u};
    }
    {
        const float* wq = p.in[14]; const float* sk = p.in[15]; const float* g2 = p.in[13];
        bf16_t* WsT = (bf16_t*)(ws + WS_WS);
        const int r32 = lane & 31, hh = lane >> 5;
        for (int it = gw; it < 16 * 4 * 64; it += NGW) {
            const int hp = it >> 8, kb = (it >> 6) & 3, nb = it & 63;
            f32x16 acc = {};
            const float* ap = sk + ((size_t)(hp * 128 + kb * 32 + r32)) * 128 + hh * 8;
            const float* bp = wq + ((size_t)(nb * 32 + r32)) * DM + hp * 128 + hh * 8;
#pragma unroll
            for (int s = 0; s < 8; ++s) {
                const bf16x8 a = cvt8(ap + s * 16), b = cvt8(bp + s * 16);
                acc = __builtin_amdgcn_mfma_f32_32x32x16_bf16(a, b, acc, 0, 0, 0);
            }
            const int kcol = nb * 32 + r32; const float gk = g2[kcol];
#pragma unroll
            for (int r = 0; r < 16; ++r) WsT[(size_t)(hp * 128 + kb * 32 + crow(r, hh)) * DM + kcol] = (bf16_t)f2bf(acc[r] * gk);
        }
    }
    {
        bf16_t* xb = (bf16_t*)(ws + WS_XB); float* rstd1 = (float*)(ws + WS_RSTD1);
        for (int t = gw; t < S; t += NGW) {
            float ss = row_to_bf16(x + (size_t)t * DM, nullptr, xb + (size_t)t * DM, lane);
            ss = wave_sum(ss);
            if (lane == 0) rstd1[t] = rsqrtf(ss * (1.0f / DM) + EPS);
        }
    }
    {
        unsigned char* UT = ws + WS_UT; unsigned char* VT = ws + WS_VT;
        for (int e = gw * 2; e < 2 * 16384; e += NGW * 2) {
            if (e < 16384) row2_to_fp8(p.in[16] + (size_t)e * DM, p.in[13], PEER_USC, UT + (size_t)e * DM, lane);
            else row2_to_fp8(p.in[17] + (size_t)(e - 16384) * DM, nullptr, PEER_VSC, VT + (size_t)(e - 16384) * DM, lane);
        }
    }
    {
        float* ct = (float*)(ws + WS_COS); float* st = (float*)(ws + WS_SIN);
        for (int it = gw; it < S * 32 / 64; it += NGW) {
            const int idx = it * 64 + lane, t = idx >> 5, j = idx & 31;
            const float inv_freq = powf(10000.0f, -(float)j / 32.0f);
            const float ang = (float)t * inv_freq;
            ct[idx] = cosf(ang); st[idx] = sinf(ang);
        }
    }
}

__device__ __forceinline__ void phase3(const Params& p, int gw, int NGW, int lane) {
    unsigned char* ws = p.ws;
    const bf16_t* qraw = (const bf16_t*)(ws + WS_QRAW); const bf16_t* kvraw = (const bf16_t*)(ws + WS_KVRAW); const bf16_t* proj = (const bf16_t*)(ws + WS_PROJ);
    bf16_t* Qh = (bf16_t*)(ws + WS_QH); bf16_t* Kh = (bf16_t*)(ws + WS_KH); bf16_t* Vh = (bf16_t*)(ws + WS_VH);
    const float* ct = (const float*)(ws + WS_COS); const float* st = (const float*)(ws + WS_SIN);
    const float* gq = p.in[10]; const float* gk = p.in[11];
    const float gq0 = gq[lane], gq1 = gq[64 + lane], gq2 = gq[128 + lane], gk0 = gk[lane], gk1 = gk[64 + lane], gk2 = gk[128 + lane];
    constexpr float QS = 0.07216878364870322f * 1.4426950408889634f;
    for (int t = gw; t < S; t += NGW) {
        const float cs = ct[t * 32 + (lane & 31)], sn = st[t * 32 + (lane & 31)];
        const float kr = bf2f(proj[(size_t)t * NINP + 2816 + lane]);
#pragma unroll
        for (int h = 0; h < 8; ++h) {
            const bf16_t* qp = qraw + (size_t)t * 1536 + h * 192;
            float q0 = bf2f(qp[lane]), q1 = bf2f(qp[64 + lane]), q2 = bf2f(qp[128 + lane]);
            float ss = wave_sum(q0 * q0 + q1 * q1 + q2 * q2);
            float rs = rsqrtf(ss * (1.0f / 192.0f) + EPS);
            q0 *= rs * gq0; q1 *= rs * gq1; q2 *= rs * gq2;
            float pr = __shfl_xor(q2, 32);
            q2 = (lane < 32) ? (q2 * cs - pr * sn) : (pr * sn + q2 * cs);
            bf16_t* qo = Qh + ((size_t)h * S + t) * 192;
            qo[lane] = (bf16_t)f2bf(q0 * QS); qo[64 + lane] = (bf16_t)f2bf(q1 * QS); qo[128 + lane] = (bf16_t)f2bf(q2 * QS);
            const bf16_t* kp = kvraw + (size_t)t * 2048 + h * 256;
            float k0 = bf2f(kp[lane]), k1 = bf2f(kp[64 + lane]), k2 = kr;
            ss = wave_sum(k0 * k0 + k1 * k1 + k2 * k2);
            rs = rsqrtf(ss * (1.0f / 192.0f) + EPS);
            k0 *= rs * gk0; k1 *= rs * gk1; k2 *= rs * gk2;
            pr = __shfl_xor(k2, 32);
            k2 = (lane < 32) ? (k2 * cs - pr * sn) : (pr * sn + k2 * cs);
            bf16_t* ko = Kh + ((size_t)h * S + t) * 192;
            ko[lane] = (bf16_t)f2bf(k0); ko[64 + lane] = (bf16_t)f2bf(k1); ko[128 + lane] = (bf16_t)f2bf(k2);
            bf16_t* vo = Vh + ((size_t)h * S + t) * 128;
            vo[lane] = kp[128 + lane]; vo[64 + lane] = kp[192 + lane];
        }
    }
}

constexpr int KP = 400, VP = 320;
constexpr int ATT_BUF = 64 * KP + 64 * VP;
template <int OFF> __device__ __forceinline__ s16x4 tr_read(unsigned addr) {
    s16x4 r; asm volatile("ds_read_b64_tr_b16 %0, %1 offset:%2" : "=&v"(r) : "v"(addr), "i"(OFF) : "memory"); return r;
}
__device__ __forceinline__ unsigned cvtpk(float lo, float hi) { unsigned r; asm volatile("v_cvt_pk_bf16_f32 %0, %1, %2" : "=v"(r) : "v"(lo), "v"(hi)); return r; }
#define PK8(L, H) ((bf16x8){L[0], L[1], L[2], L[3], H[0], H[1], H[2], H[3]})
constexpr float ATT_THR = 8.0f;

__device__ __forceinline__ void attn_tile(const LAS unsigned char* kbuf, unsigned vaddr, const bf16x8 (&qr)[12], f32x16 (&o)[4], float& m, float& lsum, int lane) {
    f32x16 pacc = {};
    const LAS unsigned char* kp = kbuf + (lane & 31) * KP + (lane >> 5) * 16;
#pragma unroll
    for (int ks = 0; ks < 12; ++ks) { const bf16x8 a = *(const LAS bf16x8*)(kp + ks * 32); pacc = __builtin_amdgcn_mfma_f32_32x32x16_bf16(a, qr[ks], pacc, 0, 0, 0); }
    float pmax = pacc[0];
#pragma unroll
    for (int r = 1; r < 16; ++r) pmax = fmaxf(pmax, pacc[r]);
    pmax = fmaxf(pmax, __shfl_xor(pmax, 32));
    if (!__all(pmax - m <= ATT_THR)) {
        const float mn = fmaxf(m, pmax); const float alpha = __builtin_amdgcn_exp2f(m - mn); m = mn; lsum *= alpha;
#pragma unroll
        for (int d = 0; d < 4; ++d)
#pragma unroll
            for (int r = 0; r < 16; ++r) o[d][r] *= alpha;
    }
    float ps = 0.f;
#pragma unroll
    for (int r = 0; r < 16; ++r) { pacc[r] = __builtin_amdgcn_exp2f(pacc[r] - m); ps += pacc[r]; }
    ps += __shfl_xor(ps, 32);
    lsum += ps;
    u32x4 w0 = {cvtpk(pacc[0], pacc[1]), cvtpk(pacc[2], pacc[3]), cvtpk(pacc[4], pacc[5]), cvtpk(pacc[6], pacc[7])};
    u32x4 w1 = {cvtpk(pacc[8], pacc[9]), cvtpk(pacc[10], pacc[11]), cvtpk(pacc[12], pacc[13]), cvtpk(pacc[14], pacc[15])};
    const bf16x8 pb0 = __builtin_bit_cast(bf16x8, w0), pb1 = __builtin_bit_cast(bf16x8, w1);
#define VOFF(d0, s, hi) (((16 * (s) + 8 * (hi)) * VP) + 64 * (d0))
    const s16x4 a00l = tr_read<VOFF(0, 0, 0)>(vaddr), a00h = tr_read<VOFF(0, 0, 1)>(vaddr), a01l = tr_read<VOFF(0, 1, 0)>(vaddr), a01h = tr_read<VOFF(0, 1, 1)>(vaddr);
    const s16x4 a10l = tr_read<VOFF(1, 0, 0)>(vaddr), a10h = tr_read<VOFF(1, 0, 1)>(vaddr), a11l = tr_read<VOFF(1, 1, 0)>(vaddr), a11h = tr_read<VOFF(1, 1, 1)>(vaddr);
    const s16x4 a20l = tr_read<VOFF(2, 0, 0)>(vaddr), a20h = tr_read<VOFF(2, 0, 1)>(vaddr), a21l = tr_read<VOFF(2, 1, 0)>(vaddr), a21h = tr_read<VOFF(2, 1, 1)>(vaddr);
    const s16x4 a30l = tr_read<VOFF(3, 0, 0)>(vaddr), a30h = tr_read<VOFF(3, 0, 1)>(vaddr), a31l = tr_read<VOFF(3, 1, 0)>(vaddr), a31h = tr_read<VOFF(3, 1, 1)>(vaddr);
#undef VOFF
    LDS_WAIT(); SBAR();
    o[0] = __builtin_amdgcn_mfma_f32_32x32x16_bf16(PK8(a00l, a00h), pb0, o[0], 0, 0, 0); o[0] = __builtin_amdgcn_mfma_f32_32x32x16_bf16(PK8(a01l, a01h), pb1, o[0], 0, 0, 0);
    o[1] = __builtin_amdgcn_mfma_f32_32x32x16_bf16(PK8(a10l, a10h), pb0, o[1], 0, 0, 0); o[1] = __builtin_amdgcn_mfma_f32_32x32x16_bf16(PK8(a11l, a11h), pb1, o[1], 0, 0, 0);
    o[2] = __builtin_amdgcn_mfma_f32_32x32x16_bf16(PK8(a20l, a20h), pb0, o[2], 0, 0, 0); o[2] = __builtin_amdgcn_mfma_f32_32x32x16_bf16(PK8(a21l, a21h), pb1, o[2], 0, 0, 0);
    o[3] = __builtin_amdgcn_mfma_f32_32x32x16_bf16(PK8(a30l, a30h), pb0, o[3], 0, 0, 0); o[3] = __builtin_amdgcn_mfma_f32_32x32x16_bf16(PK8(a31l, a31h), pb1, o[3], 0, 0, 0);
}

__device__ __forceinline__ void attn_unit(const Params& p, LAS unsigned char* lds, int head, int qb, int tid, int wave, int lane) {
    unsigned char* ws = p.ws;
    const bf16_t* Qh = (const bf16_t*)(ws + WS_QH); const bf16_t* Kh = (const bf16_t*)(ws + WS_KH); const bf16_t* Vh = (const bf16_t*)(ws + WS_VH);
    bf16_t* mix = (bf16_t*)(ws + WS_MIX);
    const int rg = wave & 3, kh = wave >> 2, r32 = lane & 31, hh = lane >> 5;
    const int q0row = qb * 128 + rg * 32;
    bf16x8 qr[12];
    {
        const bf16_t* qp = Qh + ((size_t)head * S + q0row + r32) * 192 + hh * 8;
#pragma unroll
        for (int ks = 0; ks < 12; ++ks) qr[ks] = *(const bf16x8*)(qp + ks * 16);
    }
    const int ntiles = 2 * qb + 2, mylast = 2 * qb + (rg >> 1);
    float m = -1e30f, lsum = 0.f; f32x16 o[4] = {};
    int kgo[3], klo[3], vgo[2], vlo[2];
#pragma unroll
    for (int i = 0; i < 3; ++i) { const int pc = tid + 512 * i, r = pc / 24, c = pc % 24; kgo[i] = r * 192 + c * 8; klo[i] = r * KP + c * 16; }
#pragma unroll
    for (int i = 0; i < 2; ++i) { const int pc = tid + 512 * i, r = pc >> 4, c = pc & 15; vgo[i] = r * 128 + c * 8; vlo[i] = 64 * KP + r * VP + c * 16; }
    const bf16_t* kbase = Kh + (size_t)head * S * 192; const bf16_t* vbase = Vh + (size_t)head * S * 128;
    u32x4 sk0, sk1, sk2, sv0, sv1;
#define ATT_LOAD(t) do { const bf16_t* kt = kbase + (size_t)(t) * 64 * 192; const bf16_t* vt = vbase + (size_t)(t) * 64 * 128; \
        sk0 = *(const u32x4*)(kt + kgo[0]); sk1 = *(const u32x4*)(kt + kgo[1]); sk2 = *(const u32x4*)(kt + kgo[2]); sv0 = *(const u32x4*)(vt + vgo[0]); sv1 = *(const u32x4*)(vt + vgo[1]); } while (0)
#define ATT_WRITE(b) do { LAS unsigned char* bb = lds + (b) * ATT_BUF; *(LAS u32x4*)(bb + klo[0]) = sk0; *(LAS u32x4*)(bb + klo[1]) = sk1; *(LAS u32x4*)(bb + klo[2]) = sk2; \
        *(LAS u32x4*)(bb + vlo[0]) = sv0; *(LAS u32x4*)(bb + vlo[1]) = sv1; } while (0)
    const unsigned ldsbase = (unsigned)(size_t)lds;
    const unsigned vrel = (unsigned)(64 * KP + (32 * kh + 4 * hh + ((lane & 15) >> 2)) * VP + (16 * ((lane >> 4) & 1) + 4 * (lane & 3)) * 2);
    ATT_LOAD(0); ATT_WRITE(0); __syncthreads();
    for (int t = 0; t < ntiles; ++t) {
        const bool more = (t + 1 < ntiles);
        if (more) ATT_LOAD(t + 1);
        if (t <= mylast) {
            const int b = t & 1;
            attn_tile(lds + b * ATT_BUF + (32 * kh) * KP, ldsbase + b * ATT_BUF + vrel, qr, o, m, lsum, lane);
        }
        if (more) ATT_WRITE((t + 1) & 1);
        __syncthreads();
    }
#undef ATT_LOAD
#undef ATT_WRITE
    LAS float* scr = (LAS float*)lds + (size_t)rg * 66 * 64 + lane;
    if (kh == 1) {
        scr[0] = m; scr[64] = lsum;
#pragma unroll
        for (int d = 0; d < 4; ++d)
#pragma unroll
            for (int r = 0; r < 16; ++r) scr[(2 + d * 16 + r) * 64] = o[d][r];
    }
    __syncthreads();
    if (kh == 0) {
        const float m2 = scr[0], l2 = scr[64];
        const float mn = fmaxf(m, m2), a1 = __builtin_amdgcn_exp2f(m - mn), a2 = __builtin_amdgcn_exp2f(m2 - mn);
        const float inv = 1.0f / (lsum * a1 + l2 * a2);
        bf16_t* op = mix + (size_t)(q0row + r32) * DM + 1024 + head * 128 + 4 * hh;
#pragma unroll
        for (int d = 0; d < 4; ++d)
#pragma unroll
            for (int g4 = 0; g4 < 4; ++g4) {
                float v[4];
#pragma unroll
                for (int i = 0; i < 4; ++i) { const int r = 4 * g4 + i; v[i] = (o[d][r] * a1 + scr[(2 + d * 16 + r) * 64] * a2) * inv; }
                u32x2 w; w.x = pk2(v[0], v[1]); w.y = pk2(v[2], v[3]);
                *(u32x2*)(op + 32 * d + 8 * g4) = w;
            }
    }
    __syncthreads();
}

__device__ __forceinline__ void gmlp_unit(const Params& p, LAS unsigned char* lds, int nb, int h, int tid, int wave, int lane) {
    unsigned char* ws = p.ws;
    const bf16_t* proj = (const bf16_t*)(ws + WS_PROJ); bf16_t* mix = (bf16_t*)(ws + WS_MIX);
    const float* ssv = (const float*)(ws + WS_ROWSS);
    const float* vg = p.in[3]; const float* wsp = p.in[4]; const float* bs = p.in[5];
#pragma unroll
    for (int i = 0; i < 4; ++i) {
        const int pc = tid + 512 * i, r = pc >> 4, c = pc & 15, t = nb * 128 + r;
        const u32x4 w = *(const u32x4*)(proj + (size_t)t * NINP + 1024 + h * 128 + c * 8);
        const float rs = rsqrtf(ssv[t] * (1.0f / 1024.0f) + EPS);
        const f32x4 g0 = *(const f32x4*)(vg + h * 128 + c * 8), g1 = *(const f32x4*)(vg + h * 128 + c * 8 + 4);
        u32x4 ov;
        ov.x = pk2(bflo(w.x) * rs * g0[0], bfhi(w.x) * rs * g0[1]); ov.y = pk2(bflo(w.y) * rs * g0[2], bfhi(w.y) * rs * g0[3]);
        ov.z = pk2(bflo(w.z) * rs * g1[0], bfhi(w.z) * rs * g1[1]); ov.w = pk2(bflo(w.w) * rs * g1[2], bfhi(w.w) * rs * g1[3]);
        *(LAS u32x4*)(lds + r * VP + c * 16) = ov;
    }
    __syncthreads();
    const int ib = wave & 3, ch = wave >> 2, r32 = lane & 31, hh = lane >> 5;
    const int irow = 32 * ib + r32;
    f32x16 acc0 = {}, acc1 = {};
    const unsigned vaddr = (unsigned)(size_t)lds + (unsigned)((8 * hh + ((lane & 15) >> 2)) * VP + (64 * ch + 16 * ((lane >> 4) & 1) + 4 * (lane & 3)) * 2);
    const float* wrow = wsp + ((size_t)h * 128 + irow) * 128 + hh * 8;
#define GSTEP(s) do { if ((s) < 2 * (ib + 1)) { \
        const f32x4 wa = *(const f32x4*)(wrow + (s) * 16), wb = *(const f32x4*)(wrow + (s) * 16 + 4); const int j0 = (s) * 16 + hh * 8; \
        u32x4 aw; aw.x = pk2(j0 + 0 <= irow ? wa[0] : 0.f, j0 + 1 <= irow ? wa[1] : 0.f); aw.y = pk2(j0 + 2 <= irow ? wa[2] : 0.f, j0 + 3 <= irow ? wa[3] : 0.f); \
        aw.z = pk2(j0 + 4 <= irow ? wb[0] : 0.f, j0 + 5 <= irow ? wb[1] : 0.f); aw.w = pk2(j0 + 6 <= irow ? wb[2] : 0.f, j0 + 7 <= irow ? wb[3] : 0.f); \
        const bf16x8 af = __builtin_bit_cast(bf16x8, aw); \
        const s16x4 b0l = tr_read<(16 * (s)) * VP>(vaddr), b0h = tr_read<(16 * (s) + 4) * VP>(vaddr), b1l = tr_read<(16 * (s)) * VP + 64>(vaddr), b1h = tr_read<(16 * (s) + 4) * VP + 64>(vaddr); \
        LDS_WAIT(); SBAR(); \
        acc0 = __builtin_amdgcn_mfma_f32_32x32x16_bf16(af, PK8(b0l, b0h), acc0, 0, 0, 0); acc1 = __builtin_amdgcn_mfma_f32_32x32x16_bf16(af, PK8(b1l, b1h), acc1, 0, 0, 0); } } while (0)
    GSTEP(0); GSTEP(1); GSTEP(2); GSTEP(3); GSTEP(4); GSTEP(5); GSTEP(6); GSTEP(7);
#undef GSTEP
#pragma unroll
    for (int r = 0; r < 16; ++r) {
        const int i = 32 * ib + crow(r, hh), t = nb * 128 + i; const float b = bs[h * 128 + i];
        const int c0 = h * 128 + 64 * ch + r32;
        const float u0 = bf2f(proj[(size_t)t * NINP + c0]), u1 = bf2f(proj[(size_t)t * NINP + c0 + 32]);
        mix[(size_t)t * DM + c0] = (bf16_t)f2bf(u0 * (acc0[r] + b)); mix[(size_t)t * DM + c0 + 32] = (bf16_t)f2bf(u1 * (acc1[r] + b));
    }
    __syncthreads();
}

template <int CTRL, int ROW_MASK> __device__ __forceinline__ float dpp_f(float old, float v) {
    return __builtin_bit_cast(float, __builtin_amdgcn_update_dpp(__builtin_bit_cast(int, old), __builtin_bit_cast(int, v), CTRL, ROW_MASK, 0xf, false));
}
__device__ __forceinline__ float wave_max_u(float v) {
    v = fmaxf(v, dpp_f<0xB1, 0xf>(v, v));
    v = fmaxf(v, dpp_f<0x4E, 0xf>(v, v));
    v = fmaxf(v, dpp_f<0x141, 0xf>(v, v));
    v = fmaxf(v, dpp_f<0x140, 0xf>(v, v));
    v = fmaxf(v, dpp_f<0x142, 0xa>(v, v));
    v = fmaxf(v, dpp_f<0x143, 0xc>(v, v));
    return __builtin_bit_cast(float, __builtin_amdgcn_readlane(__builtin_bit_cast(int, v), 63));
}
__device__ __forceinline__ float wave_sum_u(float v) {
    v += dpp_f<0xB1, 0xf>(0.f, v);
    v += dpp_f<0x4E, 0xf>(0.f, v);
    v += dpp_f<0x141, 0xf>(0.f, v);
    v += dpp_f<0x140, 0xf>(0.f, v);
    v += dpp_f<0x142, 0xa>(0.f, v);
    v += dpp_f<0x143, 0xc>(0.f, v);
    return __builtin_bit_cast(float, __builtin_amdgcn_readlane(__builtin_bit_cast(int, v), 63));
}
__device__ __forceinline__ void phase7(const Params& p, int gw, int NGW, int lane) {
    unsigned char* ws = p.ws;
    const float* sc = (const float*)(ws + WS_SC); int* ex = (int*)(ws + WS_EXP); float* gt = (float*)(ws + WS_GATE);
    const float NEG = -3.0e38f;
    int ci = 0, cstart = 0;
    {
        constexpr int starts[16] = {0, 16, 24, 29, 33, 36, 38, 40, 42, 43, 44, 45, 46, 47, 48, 49};
#pragma unroll
        for (int i = 1; i < 16; ++i) if (lane >= starts[i]) { ci = i; cstart = starts[i]; }
    }
    const int cj = lane - cstart; const bool cvalid = lane < 50;
    for (int it = gw; it < S * 8; it += NGW) {
        const int t = it >> 3, h = it & 7;
        const float* b = sc + (size_t)t * DM + h * 256;
        float a0 = b[lane], a1 = b[64 + lane], c0 = b[128 + lane], c1 = b[192 + lane];
        float rv1 = 0.f, rv2 = 0.f; int ri1 = 0, ri2 = 0;
#pragma unroll 2
        for (int k = 0; k < 16; ++k) {
            const float M1 = wave_max_u(fmaxf(a0, a1)), M2 = wave_max_u(fmaxf(c0, c1));
            const unsigned long long b10 = __ballot(a0 == M1), b11 = __ballot(a1 == M1), b20 = __ballot(c0 == M2), b21 = __ballot(c1 == M2);
            const bool u1 = (b10 != 0ull), u2 = (b20 != 0ull);
            const int l1 = __ffsll((long long)(u1 ? b10 : b11)) - 1, l2 = __ffsll((long long)(u2 ? b20 : b21)) - 1;
            const bool o1 = (lane == l1), o2 = (lane == l2);
            a0 = (o1 && u1) ? NEG : a0; a1 = (o1 && !u1) ? NEG : a1;
            c0 = (o2 && u2) ? NEG : c0; c1 = (o2 && !u2) ? NEG : c1;
            const bool rk = (lane == k);
            rv1 = rk ? M1 : rv1; ri1 = rk ? (u1 ? l1 : 64 + l1) : ri1;
            rv2 = rk ? M2 : rv2; ri2 = rk ? (u2 ? l2 : 64 + l2) : ri2;
        }
        const float s1 = __shfl(rv1, ci), s2 = __shfl(rv2, cj);
        const int id = __shfl(ri1, ci) * 128 + __shfl(ri2, cj);
        const float orig = cvalid ? (s1 + s2) : NEG;
        float cv = orig; bool sel = false; float M0 = 0.f;
#pragma unroll 2
        for (int k = 0; k < 16; ++k) {
            const float M = wave_max_u(cv);
            if (k == 0) M0 = M;
            const unsigned long long bl = __ballot(cv == M);
            const int ln = __ffsll((long long)bl) - 1;
            const bool own = (lane == ln);
            sel = sel || own; cv = own ? NEG : cv;
        }
        const float e = sel ? __expf(orig - M0) : 0.f;
        const float sum = wave_sum_u(e);
        const unsigned long long sm = __ballot(sel);
        const int pos = __builtin_amdgcn_mbcnt_hi((unsigned)(sm >> 32), __builtin_amdgcn_mbcnt_lo((unsigned)sm, 0u));
        if (sel) { ex[(size_t)t * 128 + h * 16 + pos] = id; gt[(size_t)t * 128 + h * 16 + pos] = e / sum; }
    }
}

typedef float f32x2 __attribute__((ext_vector_type(2)));
__device__ __forceinline__ float dot16_fp8(u32x4 w, const float (&x)[32], int base) {
    float d = 0.f;
#pragma unroll
    for (int q = 0; q < 4; ++q) {
        const f32x2 lo = __builtin_amdgcn_cvt_pk_f32_fp8((int)w[q], false), hi = __builtin_amdgcn_cvt_pk_f32_fp8((int)w[q], true);
        d += (lo[0] * x[base + 4 * q + 0] + lo[1] * x[base + 4 * q + 1]) + (hi[0] * x[base + 4 * q + 2] + hi[1] * x[base + 4 * q + 3]);
    }
    return d;
}
__device__ __forceinline__ void axpy16_fp8(u32x4 w, float c, float (&acc)[32], int base) {
#pragma unroll
    for (int q = 0; q < 4; ++q) {
        const f32x2 lo = __builtin_amdgcn_cvt_pk_f32_fp8((int)w[q], false), hi = __builtin_amdgcn_cvt_pk_f32_fp8((int)w[q], true);
        acc[base + 4 * q + 0] += c * lo[0]; acc[base + 4 * q + 1] += c * lo[1]; acc[base + 4 * q + 2] += c * hi[0]; acc[base + 4 * q + 3] += c * hi[1];
    }
}
__device__ __forceinline__ void phase8(const Params& p, float* dst, int gw, int NGW, int lane) {
    unsigned char* ws = p.ws;
    const bf16_t* x1b = (const bf16_t*)(ws + WS_X1B); const unsigned char* UT = ws + WS_UT; const unsigned char* VT = ws + WS_VT;
    const int* ex = (const int*)(ws + WS_EXP); const float* gt = (const float*)(ws + WS_GATE); const float* ss2 = (const float*)(ws + WS_ROWSS) + 3 * S;
    const float* out = p.out;
    for (int t = gw; t < S; t += NGW) {
        const float rstd2 = rsqrtf(ss2[t] * (1.0f / DM) + EPS) * (1.0f / PEER_USC);
        float xf[32];
#pragma unroll
        for (int i = 0; i < 2; ++i)
#pragma unroll
            for (int hq = 0; hq < 2; ++hq) {
                const u32x4 w = *(const u32x4*)(x1b + (size_t)t * DM + (i * 64 + lane) * 16 + hq * 8);
                const int b = 16 * i + 8 * hq;
                xf[b + 0] = bflo(w.x); xf[b + 1] = bfhi(w.x); xf[b + 2] = bflo(w.y); xf[b + 3] = bfhi(w.y);
                xf[b + 4] = bflo(w.z); xf[b + 5] = bfhi(w.z); xf[b + 6] = bflo(w.w); xf[b + 7] = bfhi(w.w);
            }
        float acc[32];
#pragma unroll
        for (int i = 0; i < 32; ++i) acc[i] = 0.f;
        const int* ep = ex + (size_t)t * 128; const float* gp = gt + (size_t)t * 128;
        u32x4 ua[2][2], va[2][2], ub[2][2], vb[2][2];
#define P8_LOAD(U_, V_, g) do { _Pragma("unroll") for (int e = 0; e < 2; ++e) { const size_t ro = (size_t)ep[(g) * 2 + e] * DM + lane * 16; \
            U_[e][0] = *(const u32x4*)(UT + ro); U_[e][1] = *(const u32x4*)(UT + ro + 1024); V_[e][0] = *(const u32x4*)(VT + ro); V_[e][1] = *(const u32x4*)(VT + ro + 1024); } } while (0)
#define P8_PROC(U_, V_, g) do { float d_[2]; \
            _Pragma("unroll") for (int e = 0; e < 2; ++e) d_[e] = dot16_fp8(U_[e][0], xf, 0) + dot16_fp8(U_[e][1], xf, 16); \
            _Pragma("unroll") for (int e = 0; e < 2; ++e) d_[e] = wave_sum_u(d_[e]); \
            _Pragma("unroll") for (int e = 0; e < 2; ++e) { const float c_ = gp[(g) * 2 + e] * gelu_tanh(rstd2 * d_[e]) * (1.0f / PEER_VSC); \
                axpy16_fp8(V_[e][0], c_, acc, 0); axpy16_fp8(V_[e][1], c_, acc, 16); } } while (0)
        P8_LOAD(ua, va, 0);
#pragma unroll 1
        for (int g = 0; g < 64; g += 2) {
            P8_LOAD(ub, vb, g + 1);
            P8_PROC(ua, va, g);
            if (g + 2 < 64) P8_LOAD(ua, va, g + 2);
            P8_PROC(ub, vb, g + 1);
        }
#undef P8_LOAD
#undef P8_PROC
#pragma unroll
        for (int i = 0; i < 2; ++i) {
            const float* op = out + (size_t)t * DM + (i * 64 + lane) * 16; float* dp = dst + (size_t)t * DM + (i * 64 + lane) * 16;
#pragma unroll
            for (int q = 0; q < 4; ++q) {
                f32x4 a = *(const f32x4*)(op + 4 * q);
                a[0] += acc[16 * i + 4 * q + 0]; a[1] += acc[16 * i + 4 * q + 1]; a[2] += acc[16 * i + 4 * q + 2]; a[3] += acc[16 * i + 4 * q + 3];
                *(f32x4*)(dp + 4 * q) = a;
            }
        }
    }
}

__global__ void __launch_bounds__(NTHREADS, 2) mega(Params p) {
    extern __shared__ __attribute__((aligned(16))) unsigned char lds_raw[];
    LAS unsigned char* lds = (LAS unsigned char*)lds_raw;
    const int tid = threadIdx.x, lane = tid & 63, wave = __builtin_amdgcn_readfirstlane(tid >> 6);
    const int G = gridDim.x, bx = blockIdx.x;
    const int gw = bx * 8 + wave, NGW = G * 8;
    unsigned char* ws = p.ws;
    const int lo = p.ph_lo, hi = p.ph_hi;
    volatile LAS unsigned* misc = (volatile LAS unsigned*)(lds + LDS_MISC);
    if (tid < 4) misc[tid] = 0u;
    __syncthreads();
    const XcdBarrier xbar = xcd_barrier_post((unsigned*)(ws + WS_CTL), misc);
#ifndef PH_MASK
#define PH_MASK 0x1ff
#endif
#define IN(k) (((PH_MASK >> (k)) & 1) && lo <= (k) && (k) < hi)
#define SEAM(k) do { if (IN(k) && IN((k) + 1)) xcd_barrier(xbar); } while (0)

#if (PROBE_DUP >> 0) & 1
    if (IN(0)) { phase0(p, lds, gw, NGW, wave, lane); xcd_barrier(xbar); }
#endif
    if (IN(0)) phase0(p, lds, gw, NGW, wave, lane);
    SEAM(0);
    if (IN(1)) {
        pg8::Gemm g{(const bf16_t*)(ws + WS_XB), (const bf16_t*)(ws + WS_WIN), S, NINP, DM, DM, DM};
        pg8::StaticOrder So; So.init(S, NINP, G, bx);
        pg8::Epi<1> E{(const float*)(ws + WS_RSTD1), 0.f, (float*)(ws + WS_ROWSS), (bf16_t*)(ws + WS_PROJ), NINP, nullptr, nullptr};
        pg8::gemm_phase<pg8::Epi<1>, pg8::StaticOrder, true, true>(lds, g, So, E);
    }
    SEAM(1);
    if (IN(2)) {
        {
            pg8::Gemm g{(const bf16_t*)(ws + WS_PROJ) + 2048, (const bf16_t*)(ws + WS_WUQ), S, 1536, 512, NINP, 512};
            pg8::StaticOrder So; So.init(S, 1536, G, bx);
            pg8::Epi<2> E{(const float*)(ws + WS_ROWSS) + 1 * S, 1.0f / 512.0f, nullptr, (bf16_t*)(ws + WS_QRAW), 1536, nullptr, nullptr};
            pg8::gemm_phase<pg8::Epi<2>, pg8::StaticOrder, true, true>(lds, g, So, E);
        }
        __syncthreads();
        {
            pg8::Gemm g{(const bf16_t*)(ws + WS_PROJ) + 2560, (const bf16_t*)(ws + WS_WUKV), S, 2048, 256, NINP, 256};
            pg8::StaticOrder So; So.init(S, 2048, G, bx);
            pg8::Epi<2> E{(const float*)(ws + WS_ROWSS) + 2 * S, 1.0f / 256.0f, nullptr, (bf16_t*)(ws + WS_KVRAW), 2048, nullptr, nullptr};
            pg8::gemm_phase<pg8::Epi<2>, pg8::StaticOrder, true, true>(lds, g, So, E);
        }
    }
    SEAM(2);
#if (PROBE_DUP >> 3) & 1
    if (IN(3)) { phase3(p, gw, NGW, lane); xcd_barrier(xbar); }
#endif
    if (IN(3)) phase3(p, gw, NGW, lane);
    SEAM(3);
#if (PROBE_DUP >> 4) & 1
#define P4_REPS 2
#else
#define P4_REPS 1
#endif
    if (IN(4)) {
        for (int rep = 0; rep < P4_REPS; ++rep) {
#if (PROBE_DUP >> 9) & 1
        if (rep == 0)
#endif
        for (int pr = bx; pr < 256; pr += G) {
            const int head = pr & 7, x = pr >> 3;
            attn_unit(p, lds, head, 63 - x, tid, wave, lane);
            attn_unit(p, lds, head, x, tid, wave, lane);
        }
        for (int u = bx; u < 512; u += G) gmlp_unit(p, lds, u >> 3, u & 7, tid, wave, lane);
        if (rep + 1 < P4_REPS) xcd_barrier(xbar);
        }
    }
    SEAM(4);
    if (IN(5)) {
        pg8::Gemm g{(const bf16_t*)(ws + WS_MIX), (const bf16_t*)(ws + WS_WOUT), S, DM, DM, DM, DM};
        pg8::StaticOrder So; So.init(S, DM, G, bx);
        pg8::Epi<4> E{nullptr, 0.f, (float*)(ws + WS_ROWSS) + 3 * S, (bf16_t*)(ws + WS_X1B), DM, p.out, p.in[0]};
        pg8::gemm_phase<pg8::Epi<4>, pg8::StaticOrder, true, true>(lds, g, So, E);
    }
    SEAM(5);
    if (IN(6)) {
        pg8::Gemm g{(const bf16_t*)(ws + WS_X1B), (const bf16_t*)(ws + WS_WS), S, DM, DM, DM, DM};
        pg8::StaticOrder So; So.init(S, DM, G, bx);
        pg8::Epi<5> E{(const float*)(ws + WS_ROWSS) + 3 * S, 1.0f / DM, nullptr, nullptr, DM, (float*)(ws + WS_SC), nullptr};
        pg8::gemm_phase<pg8::Epi<5>, pg8::StaticOrder, true, true>(lds, g, So, E);
    }
    SEAM(6);
#if (PROBE_DUP >> 7) & 1
    if (IN(7)) { phase7(p, gw, NGW, lane); xcd_barrier(xbar); }
#endif
    if (IN(7)) phase7(p, gw, NGW, lane);
    SEAM(7);
#if (PROBE_DUP >> 8) & 1
    if (IN(8)) { phase8(p, (float*)(ws + WS_SC), gw, NGW, lane); xcd_barrier(xbar); }
#endif
    if (IN(8)) phase8(p, p.out, gw, NGW, lane);
#undef IN
#undef SEAM
}

extern "C" void kernel_launch(void* const* d_in, const int* in_sizes, int n_in, void* d_out, int out_size, void* d_ws, size_t ws_size, hipStream_t stream) {
    static int grid = 0;
    if (grid == 0) {
        if (n_in != 18 || out_size != S * DM || ws_size < WS_END) { fprintf(stderr, "kernel_launch: unexpected shapes (n_in %d out %d ws %zu)\n", n_in, out_size, ws_size); grid = -1; return; }
        int dev = 0, cus = 0, per_cu = 0;
        hipGetDevice(&dev);
        hipDeviceGetAttribute(&cus, hipDeviceAttributeMultiprocessorCount, dev);
        if (hipFuncSetAttribute((const void*)mega, hipFuncAttributeMaxDynamicSharedMemorySize, LDS_BYTES) != hipSuccess) { fprintf(stderr, "kernel_launch: hipFuncSetAttribute failed\n"); grid = -1; return; }
        if (hipOccupancyMaxActiveBlocksPerMultiprocessor(&per_cu, (const void*)mega, NTHREADS, LDS_BYTES) != hipSuccess || per_cu < 1) { fprintf(stderr, "kernel_launch: occupancy query failed (%d)\n", per_cu); grid = -1; return; }
        grid = cus;
        fprintf(stderr, "kernel_launch: cus %d per_cu %d grid %d\n", cus, per_cu, grid);
    }
    if (grid < 0) return;
    hipMemsetAsync((char*)d_ws + WS_CTL, 0, 1 * MiB, stream);
    Params prm{};
    for (int i = 0; i < 18; ++i) prm.in[i] = (const float*)d_in[i];
    prm.out = (float*)d_out; prm.ws = (unsigned char*)d_ws;
#if MK_ONE_LAUNCH
    prm.ph_lo = 0; prm.ph_hi = NPH;
    { void* args[] = {&prm}; hipError_t e = hipLaunchCooperativeKernel((const void*)mega, dim3(grid), dim3(NTHREADS), args, LDS_BYTES, stream);
      if (e != hipSuccess) fprintf(stderr, "cooperative launch failed: %s\n", hipGetErrorString(e)); }
#else
    for (int ph = 0; ph < NPH; ++ph) {
        prm.ph_lo = ph; prm.ph_hi = ph + 1;
        void* args[] = {&prm};
        hipError_t e = hipLaunchCooperativeKernel((const void*)mega, dim3(grid), dim3(NTHREADS), args, LDS_BYTES, stream);
        if (e != hipSuccess) { fprintf(stderr, "cooperative launch %d failed: %s\n", ph, hipGetErrorString(e)); break; }
    }
#endif
}
```

```cpp
#include <hip/hip_runtime.h>
#include <cstdio>
#include <cstdint>

#define LAS __attribute__((address_space(3)))
typedef unsigned short bf16_t;
typedef short bf16x8 __attribute__((ext_vector_type(8)));
typedef short s16x4 __attribute__((ext_vector_type(4)));
typedef float f32x4 __attribute__((ext_vector_type(4)));
typedef float f32x16 __attribute__((ext_vector_type(16)));
typedef unsigned u32x4 __attribute__((ext_vector_type(4)));
typedef unsigned u32x2 __attribute__((ext_vector_type(2)));

#ifndef PROBE_DUP
#define PROBE_DUP 0
#endif
#ifndef MK_ONE_LAUNCH
#define MK_ONE_LAUNCH 1
#endif

constexpr int S = 8192, DM = 2048, NIN = 2880, NINP = 3072;
constexpr int NPH = 9;
constexpr float EPS = 1e-6f;
constexpr int LDS_BYTES = 147456;
constexpr int NTHREADS = 512;
constexpr int LDS_MISC = 131072 + 1024;

constexpr size_t MiB = 1u << 20;
constexpr size_t WS_CTL = 0;
constexpr size_t WS_ROWSS = 128 * 1024;
constexpr size_t WS_COS = 1 * MiB, WS_SIN = 2 * MiB;
constexpr size_t WS_RSTD1 = 3 * MiB;
constexpr size_t WS_EXP = 4 * MiB;
constexpr size_t WS_GATE = 8 * MiB;
constexpr size_t WS_WIN = 12 * MiB;
constexpr size_t WS_WUQ = 24 * MiB;
constexpr size_t WS_WUKV = 26 * MiB;
constexpr size_t WS_WOUT = 28 * MiB;
constexpr size_t WS_WS = 36 * MiB;
constexpr size_t WS_XB = 44 * MiB;
constexpr size_t WS_PROJ = 76 * MiB;
constexpr size_t WS_QRAW = 124 * MiB;
constexpr size_t WS_KVRAW = 148 * MiB;
constexpr size_t WS_QH = 180 * MiB;
constexpr size_t WS_KH = 204 * MiB;
constexpr size_t WS_VH = 228 * MiB;
constexpr size_t WS_MIX = 244 * MiB;
constexpr size_t WS_X1B = 276 * MiB;
constexpr size_t WS_SC = 308 * MiB;
constexpr size_t WS_UT = 372 * MiB;
constexpr size_t WS_VT = 436 * MiB;
constexpr size_t WS_END = 500 * MiB;

__device__ __forceinline__ unsigned f2bf(float f) { unsigned u = __builtin_bit_cast(unsigned, f); return (u + 0x7fffu + ((u >> 16) & 1u)) >> 16; }
__device__ __forceinline__ unsigned pk2(float lo, float hi) { return f2bf(lo) | (f2bf(hi) << 16); }
__device__ __forceinline__ float bf2f(unsigned short b) { return __builtin_bit_cast(float, (unsigned)b << 16); }
__device__ __forceinline__ float bflo(unsigned w) { return __builtin_bit_cast(float, w << 16); }
__device__ __forceinline__ float bfhi(unsigned w) { return __builtin_bit_cast(float, w & 0xffff0000u); }
__device__ __forceinline__ float wave_sum(float v) {
#pragma unroll
    for (int o = 32; o > 0; o >>= 1) v += __shfl_xor(v, o);
    return v;
}
__device__ __forceinline__ float wave_max(float v) {
#pragma unroll
    for (int o = 32; o > 0; o >>= 1) v = fmaxf(v, __shfl_xor(v, o));
    return v;
}
__device__ __forceinline__ float gelu_tanh(float x) {
    const float y = 0.7978845608028654f * (x + 0.044715f * x * x * x);
    return x / (1.0f + __expf(-2.0f * y));
}
__device__ __forceinline__ int crow(int r, int hi) { return (r & 3) + 8 * (r >> 2) + 4 * hi; }
#define LDS_WAIT() asm volatile("s_waitcnt lgkmcnt(0)" ::: "memory")
#define SBAR() __builtin_amdgcn_sched_barrier(0)

namespace pg8 {
#define PG8_LAS __attribute__((address_space(3)))
constexpr int BM = 256, BK = 64, HALF = 128, HTB = HALF * BK * 2  , STAGE_BYTES = 8 * HTB, NXCD = 8, WGM = 8;

__host__ __device__ __forceinline__ int lds_byte(int r, int c) { const int st = (r >> 4) * 2 + (c >> 5), rr = r & 15, cc = c & 31, ob = rr * 64 + cc * 2; return st * 1024 + (ob ^ (((ob >> 9) & 1) << 5)); }
__host__ __device__ __forceinline__ void stage_rc(int b, int& R, int& C) { const int st = b / 1024, sb = b % 1024, swz = sb ^ (((sb >> 9) & 1) << 5); R = (st >> 1) * 16 + swz / 64; C = (st & 1) * 32 + (swz % 64) / 2; }
__host__ __device__ __forceinline__ int perm32(int rho) { const int n = rho >> 4, i = rho & 15; return 8 * (i >> 2) + 4 * n + (i & 3); }

struct Unit { int pm, pn; };
struct Gemm { const bf16_t* A; const bf16_t* Bt; int M, N, K, lda, ldb; };

struct StaticOrder {
    int nM, nN, nwg, G, c;
    __host__ __device__ void init(int M, int N, int G_, int c_) { nM = M / BM; nN = N / BM; nwg = nM * nN; G = G_; c = c_; }
    __host__ __device__ bool next(int i, Unit& u) const {
        const long L = (long)i * G + c; if (L >= nwg) return false;
        int wgid = (int)L; { const int q = nwg / NXCD, r = nwg % NXCD, xcd = wgid % NXCD, off = wgid / NXCD; wgid = (xcd < r ? xcd * (q + 1) : r * (q + 1) + (xcd - r) * q) + off; }
        const int nig = WGM * nN, gid = wgid / nig, fm = gid * WGM, gsz = (nM - fm) < WGM ? (nM - fm) : WGM;
        u.pm = fm + ((wgid % nig) % gsz); u.pn = (wgid % nig) / gsz; return true;
    }
    __device__ __forceinline__ void a_ready(const Unit&) const {}
    __device__ __forceinline__ void done(const Unit&) const {}
};

template <class Epi, class Sched, bool ALIGN_EPI = false, bool SP2 = false>
__device__ __forceinline__ void gemm_phase(PG8_LAS unsigned char* lds, const Gemm g, const Sched& S, const Epi& E) {
    const int tid = threadIdx.x, wid = __builtin_amdgcn_readfirstlane(tid >> 6), lane = tid & 63, wr = wid >> 2, wc = wid & 3, fr = lane & 15, fq = lane >> 4;
    const int K = g.K, nt = K / BK;
    unsigned voffA[2], voffB[2];
#pragma unroll
    for (int i = 0; i < 2; ++i) { int R, C; stage_rc(tid * 16 + i * 8192, R, C); const int Rb = Epi::PERM ? ((R & ~31) + perm32(R & 31)) : R;
        voffA[i] = (unsigned)(R * g.lda + C) * 2u; voffB[i] = (unsigned)(Rb * g.ldb + C) * 2u; }
    const size_t kstep = (size_t)(BK * 2);
    const size_t hstepA = (size_t)HALF * g.lda * 2, hstepB = (size_t)HALF * g.ldb * 2;
    const size_t tstepA = 2 * hstepA, tstepB = 2 * hstepB;
    const unsigned ldsw = (unsigned)wid * 1024u;
    const int aoff = lds_byte(wr * 64 + fr, fq * 8), boff = lds_byte(wc * 32 + fr, fq * 8);
#define PG8_SA(b, h) (((b) * 2 + (h)) * HTB)
#define PG8_SB(b, h) ((4 + (b) * 2 + (h)) * HTB)
#define PG8_STAGE(bufoff, gbase, voff) do { _Pragma("unroll") for (int _i = 0; _i < 2; ++_i) \
        __builtin_amdgcn_global_load_lds((const unsigned*)((const char*)(gbase) + (voff)[_i]), (PG8_LAS unsigned*)(lds + (bufoff) + ldsw + _i * 8192), 16, 0, 0); } while (0)
#define PG8_LDA(dst, b, h) do { _Pragma("unroll") for (int m = 0; m < 4; ++m) _Pragma("unroll") for (int k = 0; k < 2; ++k) dst[m][k] = *(const PG8_LAS bf16x8*)(lds + PG8_SA(b, h) + aoff + m * 2048 + k * 1024); } while (0)
#define PG8_LDB(dst, b, h) do { _Pragma("unroll") for (int n = 0; n < 2; ++n) _Pragma("unroll") for (int k = 0; k < 2; ++k) dst[n][k] = *(const PG8_LAS bf16x8*)(lds + PG8_SB(b, h) + boff + n * 2048 + k * 1024); } while (0)
#define PG8_MMA(ai, bj, At, Bt) do { __builtin_amdgcn_s_setprio(1); _Pragma("unroll") for (int m = 0; m < 4; ++m) _Pragma("unroll") for (int n = 0; n < 2; ++n) _Pragma("unroll") for (int k = 0; k < 2; ++k) \
        acc[ai][bj][m][n] = __builtin_amdgcn_mfma_f32_16x16x32_bf16(Bt[n][k], At[m][k], acc[ai][bj][m][n], 0, 0, 0); __builtin_amdgcn_s_setprio(0); } while (0)
#define PG8_WAIT_V(n) asm volatile("s_waitcnt vmcnt(" #n ")" ::: "memory")
#define PG8_WAIT_L(n) asm volatile("s_waitcnt lgkmcnt(" #n ")" ::: "memory")
#define PG8_BAR __builtin_amdgcn_s_barrier()
#define PG8_SCHED __builtin_amdgcn_sched_barrier(0)
    Unit cur, nxt; int ui = 0;
    if (!S.next(0, cur)) return;
    f32x4 acc[2][2][4][2];
#pragma unroll
    for (int a = 0; a < 2; ++a)
#pragma unroll
        for (int b = 0; b < 2; ++b)
#pragma unroll
            for (int m = 0; m < 4; ++m)
#pragma unroll
                for (int n = 0; n < 2; ++n) acc[a][b][m][n] = (f32x4){0.f, 0.f, 0.f, 0.f};
    bf16x8 At[4][2], B0[2][2], B1[2][2];
    const char* cA = (const char*)g.A + (size_t)cur.pm * tstepA; const char* cB = (const char*)g.Bt + (size_t)cur.pn * tstepB;
    S.a_ready(cur);
    if constexpr (SP2) {
        PG8_STAGE(PG8_SB(0, 0), cB, voffB); PG8_STAGE(PG8_SB(0, 1), cB + hstepB, voffB); PG8_STAGE(PG8_SA(0, 0), cA, voffA); PG8_STAGE(PG8_SA(0, 1), cA + hstepA, voffA);
        if (wr == 1) PG8_BAR;
        PG8_WAIT_V(2); PG8_BAR;
        PG8_STAGE(PG8_SB(1, 0), cB + kstep, voffB); PG8_STAGE(PG8_SA(1, 0), cA + kstep, voffA); PG8_STAGE(PG8_SB(1, 1), cB + hstepB + kstep, voffB);
        PG8_WAIT_V(6); PG8_BAR;
    } else {
        PG8_STAGE(PG8_SB(0, 0), cB, voffB); PG8_STAGE(PG8_SA(0, 0), cA, voffA); PG8_STAGE(PG8_SB(0, 1), cB + hstepB, voffB); PG8_STAGE(PG8_SA(0, 1), cA + hstepA, voffA);
        if (wr == 1) PG8_BAR;
        PG8_WAIT_V(4); PG8_BAR;
        PG8_STAGE(PG8_SB(1, 0), cB + kstep, voffB); PG8_STAGE(PG8_SA(1, 0), cA + kstep, voffA); PG8_STAGE(PG8_SB(1, 1), cB + hstepB + kstep, voffB);
        PG8_WAIT_V(6); PG8_BAR;
    }
    for (;;) {
        const bool has_next = S.next(ui + 1, nxt);
        const char* nA = has_next ? (const char*)g.A + (size_t)nxt.pm * tstepA : cA; const char* nB = has_next ? (const char*)g.Bt + (size_t)nxt.pn * tstepB : cB;
        for (int t = 0; t < nt; t += 2) {
            const bool last = (t == nt - 2);
            const char* a1 = cA + (size_t)(t + 1) * kstep;
            const char* a2 = last ? nA : cA + (size_t)(t + 2) * kstep; const char* b2 = last ? nB : cB + (size_t)(t + 2) * kstep;
            const char* a3 = a2 + kstep; const char* b3 = b2 + kstep;
            if (last && has_next) S.a_ready(nxt);
            if constexpr (SP2) {
            PG8_LDB(B0, 0, 0); PG8_LDB(B1, 0, 1); PG8_SCHED; PG8_LDA(At, 0, 0); PG8_STAGE(PG8_SA(1, 1), a1 + hstepA, voffA);
            PG8_WAIT_V(8); PG8_WAIT_L(0); PG8_BAR; PG8_MMA(0, 0, At, B0); PG8_MMA(0, 1, At, B1); PG8_BAR; PG8_SCHED;
            PG8_LDA(At, 0, 1); PG8_STAGE(PG8_SB(0, 0), b2, voffB); PG8_STAGE(PG8_SB(0, 1), b2 + hstepB, voffB); PG8_STAGE(PG8_SA(0, 0), a2, voffA);
            PG8_WAIT_V(8); PG8_WAIT_L(0); PG8_BAR; PG8_MMA(1, 0, At, B0); PG8_MMA(1, 1, At, B1); PG8_BAR; PG8_SCHED;
            PG8_LDB(B0, 1, 0); PG8_LDB(B1, 1, 1); PG8_SCHED; PG8_LDA(At, 1, 0); PG8_STAGE(PG8_SA(0, 1), a2 + hstepA, voffA);
            PG8_WAIT_V(8); PG8_WAIT_L(0); PG8_BAR; PG8_MMA(0, 0, At, B0); PG8_MMA(0, 1, At, B1); PG8_BAR; PG8_SCHED;
            PG8_LDA(At, 1, 1); PG8_STAGE(PG8_SB(1, 0), b3, voffB); PG8_STAGE(PG8_SB(1, 1), b3 + hstepB, voffB); PG8_STAGE(PG8_SA(1, 0), a3, voffA);
            PG8_WAIT_V(8); PG8_WAIT_L(0); PG8_BAR; PG8_MMA(1, 0, At, B0); PG8_MMA(1, 1, At, B1); PG8_BAR; PG8_SCHED;
            } else {
            PG8_LDB(B0, 0, 0); PG8_SCHED; PG8_LDA(At, 0, 0); PG8_STAGE(PG8_SA(1, 1), a1 + hstepA, voffA);
            PG8_WAIT_L(8); PG8_BAR; PG8_WAIT_L(0); PG8_MMA(0, 0, At, B0); PG8_BAR; PG8_SCHED;
            PG8_LDB(B1, 0, 1); PG8_STAGE(PG8_SB(0, 0), b2, voffB);
            PG8_BAR; PG8_WAIT_L(0); PG8_MMA(0, 1, At, B1); PG8_BAR;
            PG8_LDA(At, 0, 1); PG8_STAGE(PG8_SA(0, 0), a2, voffA);
            PG8_BAR; PG8_WAIT_L(0); PG8_MMA(1, 0, At, B0); PG8_BAR; PG8_SCHED;
            PG8_STAGE(PG8_SB(0, 1), b2 + hstepB, voffB);
            PG8_WAIT_V(6); PG8_BAR; PG8_MMA(1, 1, At, B1); PG8_BAR;
            PG8_LDB(B0, 1, 0); PG8_SCHED; PG8_LDA(At, 1, 0); PG8_STAGE(PG8_SA(0, 1), a2 + hstepA, voffA);
            PG8_WAIT_L(8); PG8_BAR; PG8_WAIT_L(0); PG8_MMA(0, 0, At, B0); PG8_BAR; PG8_SCHED;
            PG8_LDB(B1, 1, 1); PG8_STAGE(PG8_SB(1, 0), b3, voffB);
            PG8_BAR; PG8_WAIT_L(0); PG8_MMA(0, 1, At, B1); PG8_BAR;
            PG8_LDA(At, 1, 1); PG8_STAGE(PG8_SA(1, 0), a3, voffA);
            PG8_BAR; PG8_WAIT_L(0); PG8_MMA(1, 0, At, B0); PG8_BAR; PG8_SCHED;
            PG8_STAGE(PG8_SB(1, 1), b3 + hstepB, voffB);
            PG8_WAIT_V(6); PG8_BAR; PG8_MMA(1, 1, At, B1); PG8_BAR;
            }
        }
        if constexpr (ALIGN_EPI) { if (wr == 0) PG8_BAR; }
        if constexpr (!Epi::AFTER_DRAIN) { E(acc, cur, wr, wc, fr, fq); S.done(cur); }
        if (!has_next) break;
#pragma unroll
        for (int a = 0; a < 2; ++a)
#pragma unroll
            for (int b = 0; b < 2; ++b)
#pragma unroll
                for (int m = 0; m < 4; ++m)
#pragma unroll
                    for (int n = 0; n < 2; ++n) acc[a][b][m][n] = (f32x4){0.f, 0.f, 0.f, 0.f};
        cur = nxt; cA = nA; cB = nB; ++ui;
        if constexpr (ALIGN_EPI) { if (wr == 1) PG8_BAR; }
    }
    PG8_WAIT_V(0);
    if constexpr (!ALIGN_EPI) { if (wr == 0) PG8_BAR; }
    PG8_BAR;
#undef PG8_SA
#undef PG8_SB
#undef PG8_STAGE
#undef PG8_LDA
#undef PG8_LDB
#undef PG8_MMA
#undef PG8_WAIT_V
#undef PG8_WAIT_L
#undef PG8_BAR
#undef PG8_SCHED
}

template <int MODE> struct Epi {
    static constexpr bool PERM = false, AFTER_DRAIN = false;
    const float* rowsrc; float inv_n; float* ss; bf16_t* ob; int ldc; float* of; const float* xin;
    __device__ __forceinline__ void operator()(const f32x4 (&acc)[2][2][4][2], const Unit& u, int wr, int wc, int fr, int fq) const {
#pragma unroll
        for (int ai = 0; ai < 2; ++ai)
#pragma unroll
            for (int m = 0; m < 4; ++m) {
                const int row = u.pm * BM + ai * HALF + wr * 64 + m * 16 + fr;
                float rs = 1.f;
                if (MODE == 1) rs = rowsrc[row];
                if (MODE == 2 || MODE == 5) rs = rsqrtf(rowsrc[row] * inv_n + EPS);
                float ssq = 0.f;
#pragma unroll
                for (int bj = 0; bj < 2; ++bj)
#pragma unroll
                    for (int n = 0; n < 2; ++n) {
                        const int col = u.pn * BM + bj * HALF + wc * 32 + n * 16 + fq * 4;
                        f32x4 v = acc[ai][bj][m][n] * rs;
                        if (MODE == 1) { if (u.pn < 8) { v[0] = gelu_tanh(v[0]); v[1] = gelu_tanh(v[1]); v[2] = gelu_tanh(v[2]); v[3] = gelu_tanh(v[3]); } }
                        if (MODE == 4) { const f32x4 xr = *(const f32x4*)(xin + (size_t)row * DM + col); v = v + xr; }
                        if (MODE == 1 || MODE == 4) ssq += (v[0] * v[0] + v[1] * v[1]) + (v[2] * v[2] + v[3] * v[3]);
                        if (MODE == 1 || MODE == 2 || MODE == 4) { u32x2 w; w.x = pk2(v[0], v[1]); w.y = pk2(v[2], v[3]); *(u32x2*)(ob + (size_t)row * ldc + col) = w; }
                        if (MODE == 4 || MODE == 5) *(f32x4*)(of + (size_t)row * DM + col) = v;
                    }
                if (MODE == 1) {
                    const int seg = (u.pn >= 4 && u.pn < 8) ? 0 : ((u.pn == 8 || u.pn == 9) ? 1 : (u.pn == 10 ? 2 : -1));
                    if (seg >= 0) { ssq += __shfl_xor(ssq, 16); ssq += __shfl_xor(ssq, 32); if (fq == 0) atomicAdd(ss + seg * S + row, ssq); }
                }
                if (MODE == 4) { ssq += __shfl_xor(ssq, 16); ssq += __shfl_xor(ssq, 32); if (fq == 0) atomicAdd(ss + row, ssq); }
            }
    }
};
}

#define XB_TMO      128
#define XB_XCNT(j)  (256  + 64 * (j))
#define XB_XSUB(j)  (1280 + 64 * (j))
#define XB_XGEN(j)  (2304 + 64 * (j))
#define XB_TOP      3328
#define XB_TOPGEN   3392
#define XCD_BAR_WORDS 3456
#define XB_SPIN_CAP (1u << 18)
__device__ __forceinline__ unsigned xb_ld(unsigned* p)              { return __hip_atomic_load(p, __ATOMIC_RELAXED, __HIP_MEMORY_SCOPE_AGENT); }
__device__ __forceinline__ unsigned xb_add(unsigned* p, unsigned v) { return __hip_atomic_fetch_add(p, v, __ATOMIC_RELAXED, __HIP_MEMORY_SCOPE_AGENT); }
__device__ __forceinline__ unsigned xb_xcc_id() { return (unsigned)__builtin_amdgcn_s_getreg((3 << 11) | 20) & 0xFu; }
#define XB_SPIN(cond, bar) do { unsigned _sp = 0; while (cond) { __builtin_amdgcn_s_sleep(1); \
    if ((++_sp & 255u) == 0u) { if (xb_ld(&(bar)[XB_TMO])) break; if (_sp > XB_SPIN_CAP) { atomicAdd(&(bar)[XB_TMO], 1u); break; } } } } while (0)
struct XcdBarrier { unsigned* bar; unsigned x; volatile LAS unsigned* st; };
__device__ __forceinline__ XcdBarrier xcd_barrier_post(unsigned* bar, volatile LAS unsigned* st) {
    XcdBarrier b; b.bar = bar; b.x = xb_xcc_id(); b.st = st;
    if (threadIdx.x == 0) (void)xb_add(&bar[XB_XCNT(b.x)], 1u);
    return b;
}
__device__ __forceinline__ void xcd_barrier_complete(unsigned* bar, unsigned x, unsigned& nloc, unsigned& nx) {
    const unsigned G = gridDim.x * gridDim.y * gridDim.z;
    unsigned sum, cnt, mine, sp = 0u;
    for (;;) {
        sum = 0u; cnt = 0u; mine = 0u;
#pragma unroll
        for (unsigned j = 0; j < 16; ++j) { const unsigned c = xb_ld(&bar[XB_XCNT(j)]); sum += c; cnt += (c > 0u) ? 1u : 0u; mine = (j == x) ? c : mine; }
        if (sum == G) break;
        __builtin_amdgcn_s_sleep(1);
        if ((++sp & 255u) == 0u) { if (xb_ld(&bar[XB_TMO])) break; if (sp > XB_SPIN_CAP) { atomicAdd(&bar[XB_TMO], 1u); break; } }
    }
    nloc = mine > 0u ? mine : 1u; nx = cnt > 0u ? cnt : 1u;
}
__device__ __forceinline__ void xcd_barrier(const XcdBarrier& b) {
    asm volatile("s_waitcnt vmcnt(0)" ::: "memory");
    __syncthreads();
    if (threadIdx.x == 0) {
        unsigned* bar = b.bar;
        __builtin_amdgcn_s_waitcnt(0);
        unsigned nloc = b.st[0], nx = b.st[1];
        if (nloc == 0u) { xcd_barrier_complete(bar, b.x, nloc, nx); b.st[0] = nloc; b.st[1] = nx; }
        const unsigned old = xb_add(&bar[XB_XSUB(b.x)], 1u);
        const unsigned gen = old / nloc;
        if (old + 1u == (gen + 1u) * nloc) {
            __builtin_amdgcn_fence(__ATOMIC_RELEASE, "agent");
            asm volatile("s_waitcnt vmcnt(0)" ::: "memory");
            const unsigned og = xb_add(&bar[XB_TOP], 1u);
            const unsigned tg = og / nx;
            if (og + 1u == (tg + 1u) * nx) xb_add(&bar[XB_TOPGEN], 1u);
            else XB_SPIN(xb_ld(&bar[XB_TOPGEN]) == tg, bar);
            __builtin_amdgcn_fence(__ATOMIC_ACQUIRE, "agent");
            xb_add(&bar[XB_XGEN(b.x)], 1u);
            asm volatile("s_waitcnt vmcnt(0)" ::: "memory");
        } else {
            XB_SPIN(xb_ld(&bar[XB_XGEN(b.x)]) == gen, bar);
            __builtin_amdgcn_fence(__ATOMIC_ACQUIRE, "agent");
            asm volatile("s_waitcnt vmcnt(0)" ::: "memory");
        }
    }
    __syncthreads();
}

struct Params {
    const float* in[18];
    float* out;
    unsigned char* ws;
    int ph_lo, ph_hi;
};

__device__ __forceinline__ void p0_transpose_item(const float* W, const float* g, int K, int N, bf16_t* WT, LAS float* scr, int item, int lane) {
    const int nblk = N / 32, kb = item / nblk, nb = item % nblk, k0 = 64 * kb, n0 = 32 * nb;
#pragma unroll 8
    for (int i = 0; i < 32; ++i) { const int kk = 2 * i + (lane >> 5); const float gv = g ? g[k0 + kk] : 1.f;
        scr[kk * 33 + (lane & 31)] = W[(size_t)(k0 + kk) * N + n0 + (lane & 31)] * gv; }
    LDS_WAIT(); asm volatile("" ::: "memory");
    const int c = lane & 7;
#pragma unroll
    for (int j = 0; j < 4; ++j) { const int n = (lane >> 3) + 8 * j; const LAS float* s = scr + (8 * c) * 33 + n;
        u32x4 o; o.x = pk2(s[0 * 33], s[1 * 33]); o.y = pk2(s[2 * 33], s[3 * 33]); o.z = pk2(s[4 * 33], s[5 * 33]); o.w = pk2(s[6 * 33], s[7 * 33]);
        *(u32x4*)(WT + (size_t)(n0 + n) * K + k0 + 8 * c) = o; }
    LDS_WAIT(); asm volatile("" ::: "memory");
}
__device__ __forceinline__ float row_to_bf16(const float* src, const float* g, bf16_t* dst, int lane) {
    float ss = 0.f;
#pragma unroll
    for (int i = 0; i < 8; ++i) {
        const int c = (i * 64 + lane) * 4;
        f32x4 v = *(const f32x4*)(src + c);
        ss += (v[0] * v[0] + v[1] * v[1]) + (v[2] * v[2] + v[3] * v[3]);
        if (g) { const f32x4 gv = *(const f32x4*)(g + c); v = v * gv; }
        u32x2 w; w.x = pk2(v[0], v[1]); w.y = pk2(v[2], v[3]);
        *(u32x2*)(dst + c) = w;
    }
    return ss;
}
constexpr float PEER_USC = 1024.0f, PEER_VSC = 64.0f;
__device__ __forceinline__ unsigned pk4_fp8(f32x4 v) {
    v[0] = fminf(fmaxf(v[0], -448.f), 448.f); v[1] = fminf(fmaxf(v[1], -448.f), 448.f); v[2] = fminf(fmaxf(v[2], -448.f), 448.f); v[3] = fminf(fmaxf(v[3], -448.f), 448.f);
    int w = __builtin_amdgcn_cvt_pk_fp8_f32(v[0], v[1], 0, false);
    w = __builtin_amdgcn_cvt_pk_fp8_f32(v[2], v[3], w, true);
    return (unsigned)w;
}
__device__ __forceinline__ void row2_to_fp8(const float* src, const float* g, float scale, unsigned char* dst, int lane) {
    f32x4 v[16];
#pragma unroll
    for (int i = 0; i < 16; ++i) v[i] = *(const f32x4*)(src + (i * 64 + lane) * 4);
#pragma unroll
    for (int i = 0; i < 16; ++i) {
        f32x4 x = v[i] * scale;
        if (g) { const f32x4 gv = *(const f32x4*)(g + ((i & 7) * 64 + lane) * 4); x = x * gv; }
        *(unsigned*)(dst + (i * 64 + lane) * 4) = pk4_fp8(x);
    }
}
__device__ __forceinline__ bf16x8 cvt8(const float* p) {
    const f32x4 a = *(const f32x4*)p, b = *(const f32x4*)(p + 4);
    u32x4 w; w.x = pk2(a[0], a[1]); w.y = pk2(a[2], a[3]); w.z = pk2(b[0], b[1]); w.w = pk2(b[2], b[3]);
    return __builtin_bit_cast(bf16x8, w);
}

__device__ __forceinline__ void phase0(const Params& p, LAS unsigned char* lds, int gw, int NGW, int wave, int lane) {
    unsigned char* ws = p.ws;
    LAS float* scr = (LAS float*)(lds + wave * 16384);
    const float* x = p.in[0];
    {
        constexpr int I_IN = (DM / 64) * (NIN / 32), I_UQ = (512 / 64) * (1536 / 32), I_UKV = (256 / 64) * (2048 / 32), I_OUT = (DM / 64) * (DM / 32);
        constexpr int NIT = I_IN + I_UQ + I_UKV + I_OUT;
        for (int it = gw; it < NIT; it += NGW) {
            int r = it;
            if (r < I_IN) { p0_transpose_item(p.in[2], p.in[1], DM, NIN, (bf16_t*)(ws + WS_WIN), scr, r, lane); continue; } r -= I_IN;
            if (r < I_UQ) { p0_transpose_item(p.in[7], p.in[6], 512, 1536, (bf16_t*)(ws + WS_WUQ), scr, r, lane); continue; } r -= I_UQ;
            if (r < I_UKV) { p0_transpose_item(p.in[9], p.in[8], 256, 2048, (bf16_t*)(ws + WS_WUKV), scr, r, lane); continue; } r -= I_UKV;
            p0_transpose_item(p.in[12], nullptr, DM, DM, (bf16_t*)(ws + WS_WOUT), scr, r, lane);
        }
    }
    for (int r = gw; r < NINP - NIN; r += NGW) {
        bf16_t* d = (bf16_t*)(ws + WS_WIN) + (size_t)(NIN + r) * DM;
#pragma unroll
        for (int i = 0; i < 4; ++i) *(u32x4*)(d + (i * 64 + lane) * 8) = (u32x4){0u, 0u, 0u, 0u};
    }
    {
        const float* wq = p.in[14]; const float* sk = p.in[15]; const float* g2 = p.in[13];
        bf16_t* WsT = (bf16_t*)(ws + WS_WS);
        const int r32 = lane & 31, hh = lane >> 5;
        for (int it = gw; it < 16 * 4 * 64; it += NGW) {
            const int hp = it >> 8, kb = (it >> 6) & 3, nb = it & 63;
            f32x16 acc = {};
            const float* ap = sk + ((size_t)(hp * 128 + kb * 32 + r32)) * 128 + hh * 8;
            const float* bp = wq + ((size_t)(nb * 32 + r32)) * DM + hp * 128 + hh * 8;
#pragma unroll
            for (int s = 0; s < 8; ++s) {
                const bf16x8 a = cvt8(ap + s * 16), b = cvt8(bp + s * 16);
                acc = __builtin_amdgcn_mfma_f32_32x32x16_bf16(a, b, acc, 0, 0, 0);
            }
            const int kcol = nb * 32 + r32; const float gk = g2[kcol];
#pragma unroll
            for (int r = 0; r < 16; ++r) WsT[(size_t)(hp * 128 + kb * 32 + crow(r, hh)) * DM + kcol] = (bf16_t)f2bf(acc[r] * gk);
        }
    }
    {
        bf16_t* xb = (bf16_t*)(ws + WS_XB); float* rstd1 = (float*)(ws + WS_RSTD1);
        for (int t = gw; t < S; t += NGW) {
            float ss = row_to_bf16(x + (size_t)t * DM, nullptr, xb + (size_t)t * DM, lane);
            ss = wave_sum(ss);
            if (lane == 0) rstd1[t] = rsqrtf(ss * (1.0f / DM) + EPS);
        }
    }
    {
        unsigned char* UT = ws + WS_UT; unsigned char* VT = ws + WS_VT;
        for (int e = gw * 2; e < 2 * 16384; e += NGW * 2) {
            if (e < 16384) row2_to_fp8(p.in[16] + (size_t)e * DM, p.in[13], PEER_USC, UT + (size_t)e * DM, lane);
            else row2_to_fp8(p.in[17] + (size_t)(e - 16384) * DM, nullptr, PEER_VSC, VT + (size_t)(e - 16384) * DM, lane);
        }
    }
    {
        float* ct = (float*)(ws + WS_COS); float* st = (float*)(ws + WS_SIN);
        for (int it = gw; it < S * 32 / 64; it += NGW) {
            const int idx = it * 64 + lane, t = idx >> 5, j = idx & 31;
            const float inv_freq = powf(10000.0f, -(float)j / 32.0f);
            const float ang = (float)t * inv_freq;
            ct[idx] = cosf(ang); st[idx] = sinf(ang);
        }
    }
}

__device__ __forceinline__ void phase3(const Params& p, int gw, int NGW, int lane) {
    unsigned char* ws = p.ws;
    const bf16_t* qraw = (const bf16_t*)(ws + WS_QRAW); const bf16_t* kvraw = (const bf16_t*)(ws + WS_KVRAW); const bf16_t* proj = (const bf16_t*)(ws + WS_PROJ);
    bf16_t* Qh = (bf16_t*)(ws + WS_QH); bf16_t* Kh = (bf16_t*)(ws + WS_KH); bf16_t* Vh = (bf16_t*)(ws + WS_VH);
    const float* ct = (const float*)(ws + WS_COS); const float* st = (const float*)(ws + WS_SIN);
    const float* gq = p.in[10]; const float* gk = p.in[11];
    const float gq0 = gq[lane], gq1 = gq[64 + lane], gq2 = gq[128 + lane], gk0 = gk[lane], gk1 = gk[64 + lane], gk2 = gk[128 + lane];
    constexpr float QS = 0.07216878364870322f * 1.4426950408889634f;
    for (int t = gw; t < S; t += NGW) {
        const float cs = ct[t * 32 + (lane & 31)], sn = st[t * 32 + (lane & 31)];
        const float kr = bf2f(proj[(size_t)t * NINP + 2816 + lane]);
#pragma unroll
        for (int h = 0; h < 8; ++h) {
            const bf16_t* qp = qraw + (size_t)t * 1536 + h * 192;
            float q0 = bf2f(qp[lane]), q1 = bf2f(qp[64 + lane]), q2 = bf2f(qp[128 + lane]);
            float ss = wave_sum(q0 * q0 + q1 * q1 + q2 * q2);
            float rs = rsqrtf(ss * (1.0f / 192.0f) + EPS);
            q0 *= rs * gq0; q1 *= rs * gq1; q2 *= rs * gq2;
            float pr = __shfl_xor(q2, 32);
            q2 = (lane < 32) ? (q2 * cs - pr * sn) : (pr * sn + q2 * cs);
            bf16_t* qo = Qh + ((size_t)h * S + t) * 192;
            qo[lane] = (bf16_t)f2bf(q0 * QS); qo[64 + lane] = (bf16_t)f2bf(q1 * QS); qo[128 + lane] = (bf16_t)f2bf(q2 * QS);
            const bf16_t* kp = kvraw + (size_t)t * 2048 + h * 256;
            float k0 = bf2f(kp[lane]), k1 = bf2f(kp[64 + lane]), k2 = kr;
            ss = wave_sum(k0 * k0 + k1 * k1 + k2 * k2);
            rs = rsqrtf(ss * (1.0f / 192.0f) + EPS);
            k0 *= rs * gk0; k1 *= rs * gk1; k2 *= rs * gk2;
            pr = __shfl_xor(k2, 32);
            k2 = (lane < 32) ? (k2 * cs - pr * sn) : (pr * sn + k2 * cs);
            bf16_t* ko = Kh + ((size_t)h * S + t) * 192;
            ko[lane] = (bf16_t)f2bf(k0); ko[64 + lane] = (bf16_t)f2bf(k1); ko[128 + lane] = (bf16_t)f2bf(k2);
            bf16_t* vo = Vh + ((size_t)h * S + t) * 128;
            vo[lane] = kp[128 + lane]; vo[64 + lane] = kp[192 + lane];
        }
    }
}

constexpr int KP = 400, VP = 320;
constexpr int ATT_BUF = 64 * KP + 64 * VP;
template <int OFF> __device__ __forceinline__ s16x4 tr_read(unsigned addr) {
    s16x4 r; asm volatile("ds_read_b64_tr_b16 %0, %1 offset:%2" : "=&v"(r) : "v"(addr), "i"(OFF) : "memory"); return r;
}
__device__ __forceinline__ unsigned cvtpk(float lo, float hi) { unsigned r; asm volatile("v_cvt_pk_bf16_f32 %0, %1, %2" : "=v"(r) : "v"(lo), "v"(hi)); return r; }
#define PK8(L, H) ((bf16x8){L[0], L[1], L[2], L[3], H[0], H[1], H[2], H[3]})
constexpr float ATT_THR = 8.0f;

__device__ __forceinline__ void attn_tile(const LAS unsigned char* kbuf, unsigned vaddr, const bf16x8 (&qr)[12], f32x16 (&o)[4], float& m, float& lsum, int lane) {
    f32x16 pacc = {};
    const LAS unsigned char* kp = kbuf + (lane & 31) * KP + (lane >> 5) * 16;
#pragma unroll
    for (int ks = 0; ks < 12; ++ks) { const bf16x8 a = *(const LAS bf16x8*)(kp + ks * 32); pacc = __builtin_amdgcn_mfma_f32_32x32x16_bf16(a, qr[ks], pacc, 0, 0, 0); }
    float pmax = pacc[0];
#pragma unroll
    for (int r = 1; r < 16; ++r) pmax = fmaxf(pmax, pacc[r]);
    pmax = fmaxf(pmax, __shfl_xor(pmax, 32));
    if (!__all(pmax - m <= ATT_THR)) {
        const float mn = fmaxf(m, pmax); const float alpha = __builtin_amdgcn_exp2f(m - mn); m = mn; lsum *= alpha;
#pragma unroll
        for (int d = 0; d < 4; ++d)
#pragma unroll
            for (int r = 0; r < 16; ++r) o[d][r] *= alpha;
    }
    float ps = 0.f;
#pragma unroll
    for (int r = 0; r < 16; ++r) { pacc[r] = __builtin_amdgcn_exp2f(pacc[r] - m); ps += pacc[r]; }
    ps += __shfl_xor(ps, 32);
    lsum += ps;
    u32x4 w0 = {cvtpk(pacc[0], pacc[1]), cvtpk(pacc[2], pacc[3]), cvtpk(pacc[4], pacc[5]), cvtpk(pacc[6], pacc[7])};
    u32x4 w1 = {cvtpk(pacc[8], pacc[9]), cvtpk(pacc[10], pacc[11]), cvtpk(pacc[12], pacc[13]), cvtpk(pacc[14], pacc[15])};
    const bf16x8 pb0 = __builtin_bit_cast(bf16x8, w0), pb1 = __builtin_bit_cast(bf16x8, w1);
#define VOFF(d0, s, hi) (((16 * (s) + 8 * (hi)) * VP) + 64 * (d0))
    const s16x4 a00l = tr_read<VOFF(0, 0, 0)>(vaddr), a00h = tr_read<VOFF(0, 0, 1)>(vaddr), a01l = tr_read<VOFF(0, 1, 0)>(vaddr), a01h = tr_read<VOFF(0, 1, 1)>(vaddr);
    const s16x4 a10l = tr_read<VOFF(1, 0, 0)>(vaddr), a10h = tr_read<VOFF(1, 0, 1)>(vaddr), a11l = tr_read<VOFF(1, 1, 0)>(vaddr), a11h = tr_read<VOFF(1, 1, 1)>(vaddr);
    const s16x4 a20l = tr_read<VOFF(2, 0, 0)>(vaddr), a20h = tr_read<VOFF(2, 0, 1)>(vaddr), a21l = tr_read<VOFF(2, 1, 0)>(vaddr), a21h = tr_read<VOFF(2, 1, 1)>(vaddr);
    const s16x4 a30l = tr_read<VOFF(3, 0, 0)>(vaddr), a30h = tr_read<VOFF(3, 0, 1)>(vaddr), a31l = tr_read<VOFF(3, 1, 0)>(vaddr), a31h = tr_read<VOFF(3, 1, 1)>(vaddr);
#undef VOFF
    LDS_WAIT(); SBAR();
    o[0] = __builtin_amdgcn_mfma_f32_32x32x16_bf16(PK8(a00l, a00h), pb0, o[0], 0, 0, 0); o[0] = __builtin_amdgcn_mfma_f32_32x32x16_bf16(PK8(a01l, a01h), pb1, o[0], 0, 0, 0);
    o[1] = __builtin_amdgcn_mfma_f32_32x32x16_bf16(PK8(a10l, a10h), pb0, o[1], 0, 0, 0); o[1] = __builtin_amdgcn_mfma_f32_32x32x16_bf16(PK8(a11l, a11h), pb1, o[1], 0, 0, 0);
    o[2] = __builtin_amdgcn_mfma_f32_32x32x16_bf16(PK8(a20l, a20h), pb0, o[2], 0, 0, 0); o[2] = __builtin_amdgcn_mfma_f32_32x32x16_bf16(PK8(a21l, a21h), pb1, o[2], 0, 0, 0);
    o[3] = __builtin_amdgcn_mfma_f32_32x32x16_bf16(PK8(a30l, a30h), pb0, o[3], 0, 0, 0); o[3] = __builtin_amdgcn_mfma_f32_32x32x16_bf16(PK8(a31l, a31h), pb1, o[3], 0, 0, 0);
}

__device__ __forceinline__ void attn_unit(const Params& p, LAS unsigned char* lds, int head, int qb, int tid, int wave, int lane) {
    unsigned char* ws = p.ws;
    const bf16_t* Qh = (const bf16_t*)(ws + WS_QH); const bf16_t* Kh = (const bf16_t*)(ws + WS_KH); const bf16_t* Vh = (const bf16_t*)(ws + WS_VH);
    bf16_t* mix = (bf16_t*)(ws + WS_MIX);
    const int rg = wave & 3, kh = wave >> 2, r32 = lane & 31, hh = lane >> 5;
    const int q0row = qb * 128 + rg * 32;
    bf16x8 qr[12];
    {
        const bf16_t* qp = Qh + ((size_t)head * S + q0row + r32) * 192 + hh * 8;
#pragma unroll
        for (int ks = 0; ks < 12; ++ks) qr[ks] = *(const bf16x8*)(qp + ks * 16);
    }
    const int ntiles = 2 * qb + 2, mylast = 2 * qb + (rg >> 1);
    float m = -1e30f, lsum = 0.f; f32x16 o[4] = {};
    int kgo[3], klo[3], vgo[2], vlo[2];
#pragma unroll
    for (int i = 0; i < 3; ++i) { const int pc = tid + 512 * i, r = pc / 24, c = pc % 24; kgo[i] = r * 192 + c * 8; klo[i] = r * KP + c * 16; }
#pragma unroll
    for (int i = 0; i < 2; ++i) { const int pc = tid + 512 * i, r = pc >> 4, c = pc & 15; vgo[i] = r * 128 + c * 8; vlo[i] = 64 * KP + r * VP + c * 16; }
    const bf16_t* kbase = Kh + (size_t)head * S * 192; const bf16_t* vbase = Vh + (size_t)head * S * 128;
    u32x4 sk0, sk1, sk2, sv0, sv1;
#define ATT_LOAD(t) do { const bf16_t* kt = kbase + (size_t)(t) * 64 * 192; const bf16_t* vt = vbase + (size_t)(t) * 64 * 128; \
        sk0 = *(const u32x4*)(kt + kgo[0]); sk1 = *(const u32x4*)(kt + kgo[1]); sk2 = *(const u32x4*)(kt + kgo[2]); sv0 = *(const u32x4*)(vt + vgo[0]); sv1 = *(const u32x4*)(vt + vgo[1]); } while (0)
#define ATT_WRITE(b) do { LAS unsigned char* bb = lds + (b) * ATT_BUF; *(LAS u32x4*)(bb + klo[0]) = sk0; *(LAS u32x4*)(bb + klo[1]) = sk1; *(LAS u32x4*)(bb + klo[2]) = sk2; \
        *(LAS u32x4*)(bb + vlo[0]) = sv0; *(LAS u32x4*)(bb + vlo[1]) = sv1; } while (0)
    const unsigned ldsbase = (unsigned)(size_t)lds;
    const unsigned vrel = (unsigned)(64 * KP + (32 * kh + 4 * hh + ((lane & 15) >> 2)) * VP + (16 * ((lane >> 4) & 1) + 4 * (lane & 3)) * 2);
    ATT_LOAD(0); ATT_WRITE(0); __syncthreads();
    for (int t = 0; t < ntiles; ++t) {
        const bool more = (t + 1 < ntiles);
        if (more) ATT_LOAD(t + 1);
        if (t <= mylast) {
            const int b = t & 1;
            attn_tile(lds + b * ATT_BUF + (32 * kh) * KP, ldsbase + b * ATT_BUF + vrel, qr, o, m, lsum, lane);
        }
        if (more) ATT_WRITE((t + 1) & 1);
        __syncthreads();
    }
#undef ATT_LOAD
#undef ATT_WRITE
    LAS float* scr = (LAS float*)lds + (size_t)rg * 66 * 64 + lane;
    if (kh == 1) {
        scr[0] = m; scr[64] = lsum;
#pragma unroll
        for (int d = 0; d < 4; ++d)
#pragma unroll
            for (int r = 0; r < 16; ++r) scr[(2 + d * 16 + r) * 64] = o[d][r];
    }
    __syncthreads();
    if (kh == 0) {
        const float m2 = scr[0], l2 = scr[64];
        const float mn = fmaxf(m, m2), a1 = __builtin_amdgcn_exp2f(m - mn), a2 = __builtin_amdgcn_exp2f(m2 - mn);
        const float inv = 1.0f / (lsum * a1 + l2 * a2);
        bf16_t* op = mix + (size_t)(q0row + r32) * DM + 1024 + head * 128 + 4 * hh;
#pragma unroll
        for (int d = 0; d < 4; ++d)
#pragma unroll
            for (int g4 = 0; g4 < 4; ++g4) {
                float v[4];
#pragma unroll
                for (int i = 0; i < 4; ++i) { const int r = 4 * g4 + i; v[i] = (o[d][r] * a1 + scr[(2 + d * 16 + r) * 64] * a2) * inv; }
                u32x2 w; w.x = pk2(v[0], v[1]); w.y = pk2(v[2], v[3]);
                *(u32x2*)(op + 32 * d + 8 * g4) = w;
            }
    }
    __syncthreads();
}

__device__ __forceinline__ void gmlp_unit(const Params& p, LAS unsigned char* lds, int nb, int h, int tid, int wave, int lane) {
    unsigned char* ws = p.ws;
    const bf16_t* proj = (const bf16_t*)(ws + WS_PROJ); bf16_t* mix = (bf16_t*)(ws + WS_MIX);
    const float* ssv = (const float*)(ws + WS_ROWSS);
    const float* vg = p.in[3]; const float* wsp = p.in[4]; const float* bs = p.in[5];
#pragma unroll
    for (int i = 0; i < 4; ++i) {
        const int pc = tid + 512 * i, r = pc >> 4, c = pc & 15, t = nb * 128 + r;
        const u32x4 w = *(const u32x4*)(proj + (size_t)t * NINP + 1024 + h * 128 + c * 8);
        const float rs = rsqrtf(ssv[t] * (1.0f / 1024.0f) + EPS);
        const f32x4 g0 = *(const f32x4*)(vg + h * 128 + c * 8), g1 = *(const f32x4*)(vg + h * 128 + c * 8 + 4);
        u32x4 ov;
        ov.x = pk2(bflo(w.x) * rs * g0[0], bfhi(w.x) * rs * g0[1]); ov.y = pk2(bflo(w.y) * rs * g0[2], bfhi(w.y) * rs * g0[3]);
        ov.z = pk2(bflo(w.z) * rs * g1[0], bfhi(w.z) * rs * g1[1]); ov.w = pk2(bflo(w.w) * rs * g1[2], bfhi(w.w) * rs * g1[3]);
        *(LAS u32x4*)(lds + r * VP + c * 16) = ov;
    }
    __syncthreads();
    const int ib = wave & 3, ch = wave >> 2, r32 = lane & 31, hh = lane >> 5;
    const int irow = 32 * ib + r32;
    f32x16 acc0 = {}, acc1 = {};
    const unsigned vaddr = (unsigned)(size_t)lds + (unsigned)((8 * hh + ((lane & 15) >> 2)) * VP + (64 * ch + 16 * ((lane >> 4) & 1) + 4 * (lane & 3)) * 2);
    const float* wrow = wsp + ((size_t)h * 128 + irow) * 128 + hh * 8;
#define GSTEP(s) do { if ((s) < 2 * (ib + 1)) { \
        const f32x4 wa = *(const f32x4*)(wrow + (s) * 16), wb = *(const f32x4*)(wrow + (s) * 16 + 4); const int j0 = (s) * 16 + hh * 8; \
        u32x4 aw; aw.x = pk2(j0 + 0 <= irow ? wa[0] : 0.f, j0 + 1 <= irow ? wa[1] : 0.f); aw.y = pk2(j0 + 2 <= irow ? wa[2] : 0.f, j0 + 3 <= irow ? wa[3] : 0.f); \
        aw.z = pk2(j0 + 4 <= irow ? wb[0] : 0.f, j0 + 5 <= irow ? wb[1] : 0.f); aw.w = pk2(j0 + 6 <= irow ? wb[2] : 0.f, j0 + 7 <= irow ? wb[3] : 0.f); \
        const bf16x8 af = __builtin_bit_cast(bf16x8, aw); \
        const s16x4 b0l = tr_read<(16 * (s)) * VP>(vaddr), b0h = tr_read<(16 * (s) + 4) * VP>(vaddr), b1l = tr_read<(16 * (s)) * VP + 64>(vaddr), b1h = tr_read<(16 * (s) + 4) * VP + 64>(vaddr); \
        LDS_WAIT(); SBAR(); \
        acc0 = __builtin_amdgcn_mfma_f32_32x32x16_bf16(af, PK8(b0l, b0h), acc0, 0, 0, 0); acc1 = __builtin_amdgcn_mfma_f32_32x32x16_bf16(af, PK8(b1l, b1h), acc1, 0, 0, 0); } } while (0)
    GSTEP(0); GSTEP(1); GSTEP(2); GSTEP(3); GSTEP(4); GSTEP(5); GSTEP(6); GSTEP(7);
#undef GSTEP
#pragma unroll
    for (int r = 0; r < 16; ++r) {
        const int i = 32 * ib + crow(r, hh), t = nb * 128 + i; const float b = bs[h * 128 + i];
        const int c0 = h * 128 + 64 * ch + r32;
        const float u0 = bf2f(proj[(size_t)t * NINP + c0]), u1 = bf2f(proj[(size_t)t * NINP + c0 + 32]);
        mix[(size_t)t * DM + c0] = (bf16_t)f2bf(u0 * (acc0[r] + b)); mix[(size_t)t * DM + c0 + 32] = (bf16_t)f2bf(u1 * (acc1[r] + b));
    }
    __syncthreads();
}

template <int CTRL, int ROW_MASK> __device__ __forceinline__ float dpp_f(float old, float v) {
    return __builtin_bit_cast(float, __builtin_amdgcn_update_dpp(__builtin_bit_cast(int, old), __builtin_bit_cast(int, v), CTRL, ROW_MASK, 0xf, false));
}
__device__ __forceinline__ float wave_max_u(float v) {
    v = fmaxf(v, dpp_f<0xB1, 0xf>(v, v));
    v = fmaxf(v, dpp_f<0x4E, 0xf>(v, v));
    v = fmaxf(v, dpp_f<0x141, 0xf>(v, v));
    v = fmaxf(v, dpp_f<0x140, 0xf>(v, v));
    v = fmaxf(v, dpp_f<0x142, 0xa>(v, v));
    v = fmaxf(v, dpp_f<0x143, 0xc>(v, v));
    return __builtin_bit_cast(float, __builtin_amdgcn_readlane(__builtin_bit_cast(int, v), 63));
}
__device__ __forceinline__ float wave_sum_u(float v) {
    v += dpp_f<0xB1, 0xf>(0.f, v);
    v += dpp_f<0x4E, 0xf>(0.f, v);
    v += dpp_f<0x141, 0xf>(0.f, v);
    v += dpp_f<0x140, 0xf>(0.f, v);
    v += dpp_f<0x142, 0xa>(0.f, v);
    v += dpp_f<0x143, 0xc>(0.f, v);
    return __builtin_bit_cast(float, __builtin_amdgcn_readlane(__builtin_bit_cast(int, v), 63));
}
__device__ __forceinline__ void phase7(const Params& p, LAS unsigned char* lds, int gw, int NGW, int wave, int lane) {
    unsigned char* ws = p.ws;
    const float* sc = (const float*)(ws + WS_SC); int* ex = (int*)(ws + WS_EXP); float* gt = (float*)(ws + WS_GATE);
    const float NEG = -3.0e38f;
    LAS float* sl = (LAS float*)(lds + wave * 1024);
    const int j8 = lane & 7, g8 = lane >> 3, row = lane >> 4, i16 = lane & 15;
    int ci[4], cj[4]; bool cval[4];
    {
        constexpr int starts[16] = {0, 16, 24, 29, 33, 36, 38, 40, 42, 43, 44, 45, 46, 47, 48, 49};
#pragma unroll
        for (int m = 0; m < 4; ++m) {
            const int c = i16 + 16 * m; int a = 0, st = 0;
#pragma unroll
            for (int i = 1; i < 16; ++i) if (c >= starts[i]) { a = i; st = starts[i]; }
            cval[m] = c < 50; ci[m] = cval[m] ? a : 0; cj[m] = cval[m] ? (c - st) : 0;
        }
    }
    constexpr int NT = S * 2;
    f32x4 nx0, nx1, nx2, nx3;
    if (gw < NT) { const float* b = sc + (size_t)(gw >> 1) * DM + (gw & 1) * 1024 + lane * 16; nx0 = *(const f32x4*)b; nx1 = *(const f32x4*)(b + 4); nx2 = *(const f32x4*)(b + 8); nx3 = *(const f32x4*)(b + 12); }
    for (int it = gw; it < NT; it += NGW) {
        const int t = it >> 1, hh = it & 1;
        float v[16];
#pragma unroll
        for (int q = 0; q < 4; ++q) { v[q] = nx0[q]; v[4 + q] = nx1[q]; v[8 + q] = nx2[q]; v[12 + q] = nx3[q]; }
        if (it + NGW < NT) { const int it2 = it + NGW; const float* b = sc + (size_t)(it2 >> 1) * DM + (it2 & 1) * 1024 + lane * 16;
            nx0 = *(const f32x4*)b; nx1 = *(const f32x4*)(b + 4); nx2 = *(const f32x4*)(b + 8); nx3 = *(const f32x4*)(b + 12); }
#pragma unroll
        for (int m = 0; m < 16; ++m) v[m] = __builtin_bit_cast(float, (__builtin_bit_cast(unsigned, v[m]) & ~127u) | (unsigned)(16 * j8 + m));
        float ra = 0.f, rb = 0.f;
#pragma unroll
        for (int k = 0; k < 16; ++k) {
            float mx = fmaxf(fmaxf(fmaxf(v[0], v[1]), fmaxf(v[2], v[3])), fmaxf(fmaxf(v[4], v[5]), fmaxf(v[6], v[7])));
            mx = fmaxf(mx, fmaxf(fmaxf(fmaxf(v[8], v[9]), fmaxf(v[10], v[11])), fmaxf(fmaxf(v[12], v[13]), fmaxf(v[14], v[15]))));
            mx = fmaxf(mx, dpp_f<0xB1, 0xf>(mx, mx));
            mx = fmaxf(mx, dpp_f<0x4E, 0xf>(mx, mx));
            mx = fmaxf(mx, dpp_f<0x141, 0xf>(mx, mx));
#pragma unroll
            for (int m = 0; m < 16; ++m) v[m] = (v[m] == mx) ? NEG : v[m];
            if (k < 8) ra = (j8 == k) ? mx : ra; else rb = (j8 == k - 8) ? mx : rb;
        }
        sl[g8 * 16 + j8] = ra; sl[g8 * 16 + 8 + j8] = rb;
        LDS_WAIT(); asm volatile("" ::: "memory");
        float cv[4], og[4]; int id[4];
#pragma unroll
        for (int m = 0; m < 4; ++m) {
            const float s1 = sl[(2 * row) * 16 + ci[m]], s2 = sl[(2 * row + 1) * 16 + cj[m]];
            og[m] = cval[m] ? (s1 + s2) : NEG; cv[m] = og[m];
            id[m] = (int)((__builtin_bit_cast(unsigned, s1) & 127u) * 128u + (__builtin_bit_cast(unsigned, s2) & 127u));
        }
        LDS_WAIT(); asm volatile("" ::: "memory");
        float M0 = 0.f;
#pragma unroll
        for (int k = 0; k < 16; ++k) {
            float mx = fmaxf(fmaxf(cv[0], cv[1]), fmaxf(cv[2], cv[3]));
            mx = fmaxf(mx, dpp_f<0xB1, 0xf>(mx, mx));
            mx = fmaxf(mx, dpp_f<0x4E, 0xf>(mx, mx));
            mx = fmaxf(mx, dpp_f<0x141, 0xf>(mx, mx));
            mx = fmaxf(mx, dpp_f<0x140, 0xf>(mx, mx));
            if (k == 0) M0 = mx;
#pragma unroll
            for (int m = 0; m < 4; ++m) cv[m] = (cv[m] == mx) ? NEG : cv[m];
        }
        bool sel[4]; float e[4]; float es = 0.f;
#pragma unroll
        for (int m = 0; m < 4; ++m) { sel[m] = (cv[m] != og[m]); e[m] = sel[m] ? __expf(og[m] - M0) : 0.f; es += e[m]; }
        es += dpp_f<0xB1, 0xf>(0.f, es); es += dpp_f<0x4E, 0xf>(0.f, es); es += dpp_f<0x141, 0xf>(0.f, es); es += dpp_f<0x140, 0xf>(0.f, es);
        const float inv = 1.0f / es;
        int basepos = 0;
        const int head = 4 * hh + row;
#pragma unroll
        for (int m = 0; m < 4; ++m) {
            const unsigned long long bl = __ballot(sel[m]);
            const unsigned rbits = (unsigned)(bl >> (16 * row)) & 0xffffu;
            const int pos = basepos + __popc(rbits & ((1u << i16) - 1u));
            if (sel[m] && pos < 16) { ex[(size_t)t * 128 + head * 16 + pos] = id[m]; gt[(size_t)t * 128 + head * 16 + pos] = e[m] * inv; }
            basepos += __popc(rbits);
        }
    }
}

typedef float f32x2 __attribute__((ext_vector_type(2)));
__device__ __forceinline__ float dot16_fp8(u32x4 w, const float (&x)[32], int base) {
    float d = 0.f;
#pragma unroll
    for (int q = 0; q < 4; ++q) {
        const f32x2 lo = __builtin_amdgcn_cvt_pk_f32_fp8((int)w[q], false), hi = __builtin_amdgcn_cvt_pk_f32_fp8((int)w[q], true);
        d += (lo[0] * x[base + 4 * q + 0] + lo[1] * x[base + 4 * q + 1]) + (hi[0] * x[base + 4 * q + 2] + hi[1] * x[base + 4 * q + 3]);
    }
    return d;
}
__device__ __forceinline__ void axpy16_fp8(u32x4 w, float c, float (&acc)[32], int base) {
#pragma unroll
    for (int q = 0; q < 4; ++q) {
        const f32x2 lo = __builtin_amdgcn_cvt_pk_f32_fp8((int)w[q], false), hi = __builtin_amdgcn_cvt_pk_f32_fp8((int)w[q], true);
        acc[base + 4 * q + 0] += c * lo[0]; acc[base + 4 * q + 1] += c * lo[1]; acc[base + 4 * q + 2] += c * hi[0]; acc[base + 4 * q + 3] += c * hi[1];
    }
}
__device__ __forceinline__ void phase8(const Params& p, float* dst, int gw, int NGW, int lane) {
    unsigned char* ws = p.ws;
    const bf16_t* x1b = (const bf16_t*)(ws + WS_X1B); const unsigned char* UT = ws + WS_UT; const unsigned char* VT = ws + WS_VT;
    const int* ex = (const int*)(ws + WS_EXP); const float* gt = (const float*)(ws + WS_GATE); const float* ss2 = (const float*)(ws + WS_ROWSS) + 3 * S;
    const float* out = p.out;
    for (int t = gw; t < S; t += NGW) {
        const float rstd2 = rsqrtf(ss2[t] * (1.0f / DM) + EPS) * (1.0f / PEER_USC);
        float xf[32];
#pragma unroll
        for (int i = 0; i < 2; ++i)
#pragma unroll
            for (int hq = 0; hq < 2; ++hq) {
                const u32x4 w = *(const u32x4*)(x1b + (size_t)t * DM + (i * 64 + lane) * 16 + hq * 8);
                const int b = 16 * i + 8 * hq;
                xf[b + 0] = bflo(w.x); xf[b + 1] = bfhi(w.x); xf[b + 2] = bflo(w.y); xf[b + 3] = bfhi(w.y);
                xf[b + 4] = bflo(w.z); xf[b + 5] = bfhi(w.z); xf[b + 6] = bflo(w.w); xf[b + 7] = bfhi(w.w);
            }
        float acc[32];
#pragma unroll
        for (int i = 0; i < 32; ++i) acc[i] = 0.f;
        const int* ep = ex + (size_t)t * 128; const float* gp = gt + (size_t)t * 128;
        u32x4 ua[2][2], va[2][2], ub[2][2], vb[2][2];
#define P8_LOAD(U_, V_, g) do { _Pragma("unroll") for (int e = 0; e < 2; ++e) { const size_t ro = (size_t)ep[(g) * 2 + e] * DM + lane * 16; \
            U_[e][0] = *(const u32x4*)(UT + ro); U_[e][1] = *(const u32x4*)(UT + ro + 1024); V_[e][0] = *(const u32x4*)(VT + ro); V_[e][1] = *(const u32x4*)(VT + ro + 1024); } } while (0)
#define P8_PROC(U_, V_, g) do { float d_[2]; \
            _Pragma("unroll") for (int e = 0; e < 2; ++e) d_[e] = dot16_fp8(U_[e][0], xf, 0) + dot16_fp8(U_[e][1], xf, 16); \
            _Pragma("unroll") for (int e = 0; e < 2; ++e) d_[e] = wave_sum_u(d_[e]); \
            _Pragma("unroll") for (int e = 0; e < 2; ++e) { const float c_ = gp[(g) * 2 + e] * gelu_tanh(rstd2 * d_[e]) * (1.0f / PEER_VSC); \
                axpy16_fp8(V_[e][0], c_, acc, 0); axpy16_fp8(V_[e][1], c_, acc, 16); } } while (0)
        P8_LOAD(ua, va, 0);
#pragma unroll 1
        for (int g = 0; g < 64; g += 2) {
            P8_LOAD(ub, vb, g + 1);
            P8_PROC(ua, va, g);
            if (g + 2 < 64) P8_LOAD(ua, va, g + 2);
            P8_PROC(ub, vb, g + 1);
        }
#undef P8_LOAD
#undef P8_PROC
#pragma unroll
        for (int i = 0; i < 2; ++i) {
            const float* op = out + (size_t)t * DM + (i * 64 + lane) * 16; float* dp = dst + (size_t)t * DM + (i * 64 + lane) * 16;
#pragma unroll
            for (int q = 0; q < 4; ++q) {
                f32x4 a = *(const f32x4*)(op + 4 * q);
                a[0] += acc[16 * i + 4 * q + 0]; a[1] += acc[16 * i + 4 * q + 1]; a[2] += acc[16 * i + 4 * q + 2]; a[3] += acc[16 * i + 4 * q + 3];
                *(f32x4*)(dp + 4 * q) = a;
            }
        }
    }
}

__global__ void __launch_bounds__(NTHREADS, 2) mega(Params p) {
    extern __shared__ __attribute__((aligned(16))) unsigned char lds_raw[];
    LAS unsigned char* lds = (LAS unsigned char*)lds_raw;
    const int tid = threadIdx.x, lane = tid & 63, wave = __builtin_amdgcn_readfirstlane(tid >> 6);
    const int G = gridDim.x, bx = blockIdx.x;
    const int gw = bx * 8 + wave, NGW = G * 8;
    unsigned char* ws = p.ws;
    const int lo = p.ph_lo, hi = p.ph_hi;
    volatile LAS unsigned* misc = (volatile LAS unsigned*)(lds + LDS_MISC);
    if (tid < 4) misc[tid] = 0u;
    __syncthreads();
    const XcdBarrier xbar = xcd_barrier_post((unsigned*)(ws + WS_CTL), misc);
#ifndef PH_MASK
#define PH_MASK 0x1ff
#endif
#define IN(k) (((PH_MASK >> (k)) & 1) && lo <= (k) && (k) < hi)
#define SEAM(k) do { if (IN(k) && IN((k) + 1)) xcd_barrier(xbar); } while (0)

#if (PROBE_DUP >> 0) & 1
    if (IN(0)) { phase0(p, lds, gw, NGW, wave, lane); xcd_barrier(xbar); }
#endif
    if (IN(0)) phase0(p, lds, gw, NGW, wave, lane);
    SEAM(0);
    if (IN(1)) {
        pg8::Gemm g{(const bf16_t*)(ws + WS_XB), (const bf16_t*)(ws + WS_WIN), S, NINP, DM, DM, DM};
        pg8::StaticOrder So; So.init(S, NINP, G, bx);
        pg8::Epi<1> E{(const float*)(ws + WS_RSTD1), 0.f, (float*)(ws + WS_ROWSS), (bf16_t*)(ws + WS_PROJ), NINP, nullptr, nullptr};
#if (PROBE_DUP >> 1) & 1
        { pg8::Epi<1> E2 = E; E2.ss = (float*)(ws + 512 * 1024); pg8::gemm_phase<pg8::Epi<1>, pg8::StaticOrder, true, true>(lds, g, So, E2); xcd_barrier(xbar); }
#endif
        pg8::gemm_phase<pg8::Epi<1>, pg8::StaticOrder, true, true>(lds, g, So, E);
    }
    SEAM(1);
    if (IN(2)) {
        {
            pg8::Gemm g{(const bf16_t*)(ws + WS_PROJ) + 2048, (const bf16_t*)(ws + WS_WUQ), S, 1536, 512, NINP, 512};
            pg8::StaticOrder So; So.init(S, 1536, G, bx);
            pg8::Epi<2> E{(const float*)(ws + WS_ROWSS) + 1 * S, 1.0f / 512.0f, nullptr, (bf16_t*)(ws + WS_QRAW), 1536, nullptr, nullptr};
            pg8::gemm_phase<pg8::Epi<2>, pg8::StaticOrder, true, true>(lds, g, So, E);
        }
        __syncthreads();
        {
            pg8::Gemm g{(const bf16_t*)(ws + WS_PROJ) + 2560, (const bf16_t*)(ws + WS_WUKV), S, 2048, 256, NINP, 256};
            pg8::StaticOrder So; So.init(S, 2048, G, bx);
            pg8::Epi<2> E{(const float*)(ws + WS_ROWSS) + 2 * S, 1.0f / 256.0f, nullptr, (bf16_t*)(ws + WS_KVRAW), 2048, nullptr, nullptr};
            pg8::gemm_phase<pg8::Epi<2>, pg8::StaticOrder, true, true>(lds, g, So, E);
        }
    }
    SEAM(2);
#if (PROBE_DUP >> 3) & 1
    if (IN(3)) { phase3(p, gw, NGW, lane); xcd_barrier(xbar); }
#endif
    if (IN(3)) phase3(p, gw, NGW, lane);
    SEAM(3);
#define P4_BODY_ATT for (int pr = bx; pr < 256; pr += G) { const int head = pr & 7, x = pr >> 3; attn_unit(p, lds, head, 63 - x, tid, wave, lane); attn_unit(p, lds, head, x, tid, wave, lane); }
#define P4_BODY_GMLP for (int u = bx; u < 512; u += G) gmlp_unit(p, lds, u >> 3, u & 7, tid, wave, lane);
#if (PROBE_DUP >> 4) & 1
    if (IN(4)) { P4_BODY_ATT; xcd_barrier(xbar); }
#endif
#if (PROBE_DUP >> 9) & 1
    if (IN(4)) { P4_BODY_GMLP; xcd_barrier(xbar); }
#endif
    if (IN(4)) { P4_BODY_ATT; P4_BODY_GMLP; }
    SEAM(4);
    if (IN(5)) {
        pg8::Gemm g{(const bf16_t*)(ws + WS_MIX), (const bf16_t*)(ws + WS_WOUT), S, DM, DM, DM, DM};
        pg8::StaticOrder So; So.init(S, DM, G, bx);
        pg8::Epi<4> E{nullptr, 0.f, (float*)(ws + WS_ROWSS) + 3 * S, (bf16_t*)(ws + WS_X1B), DM, p.out, p.in[0]};
#if (PROBE_DUP >> 5) & 1
        { pg8::Epi<4> E2 = E; E2.ss = (float*)(ws + 512 * 1024); pg8::gemm_phase<pg8::Epi<4>, pg8::StaticOrder, true, true>(lds, g, So, E2); xcd_barrier(xbar); }
#endif
        pg8::gemm_phase<pg8::Epi<4>, pg8::StaticOrder, true, true>(lds, g, So, E);
    }
    SEAM(5);
    if (IN(6)) {
        pg8::Gemm g{(const bf16_t*)(ws + WS_X1B), (const bf16_t*)(ws + WS_WS), S, DM, DM, DM, DM};
        pg8::StaticOrder So; So.init(S, DM, G, bx);
        pg8::Epi<5> E{(const float*)(ws + WS_ROWSS) + 3 * S, 1.0f / DM, nullptr, nullptr, DM, (float*)(ws + WS_SC), nullptr};
#if (PROBE_DUP >> 6) & 1
        { pg8::gemm_phase<pg8::Epi<5>, pg8::StaticOrder, true, true>(lds, g, So, E); xcd_barrier(xbar); }
#endif
        pg8::gemm_phase<pg8::Epi<5>, pg8::StaticOrder, true, true>(lds, g, So, E);
    }
    SEAM(6);
#if (PROBE_DUP >> 7) & 1
    if (IN(7)) { phase7(p, lds, gw, NGW, wave, lane); xcd_barrier(xbar); }
#endif
    if (IN(7)) phase7(p, lds, gw, NGW, wave, lane);
    SEAM(7);
#if (PROBE_DUP >> 8) & 1
    if (IN(8)) { phase8(p, (float*)(ws + WS_SC), gw, NGW, lane); xcd_barrier(xbar); }
#endif
    if (IN(8)) phase8(p, p.out, gw, NGW, lane);
#undef IN
#undef SEAM
}

extern "C" void kernel_launch(void* const* d_in, const int* in_sizes, int n_in, void* d_out, int out_size, void* d_ws, size_t ws_size, hipStream_t stream) {
    static int grid = 0;
    if (grid == 0) {
        if (n_in != 18 || out_size != S * DM || ws_size < WS_END) { fprintf(stderr, "kernel_launch: unexpected shapes (n_in %d out %d ws %zu)\n", n_in, out_size, ws_size); grid = -1; return; }
        int dev = 0, cus = 0, per_cu = 0;
        hipGetDevice(&dev);
        hipDeviceGetAttribute(&cus, hipDeviceAttributeMultiprocessorCount, dev);
        if (hipFuncSetAttribute((const void*)mega, hipFuncAttributeMaxDynamicSharedMemorySize, LDS_BYTES) != hipSuccess) { fprintf(stderr, "kernel_launch: hipFuncSetAttribute failed\n"); grid = -1; return; }
        if (hipOccupancyMaxActiveBlocksPerMultiprocessor(&per_cu, (const void*)mega, NTHREADS, LDS_BYTES) != hipSuccess || per_cu < 1) { fprintf(stderr, "kernel_launch: occupancy query failed (%d)\n", per_cu); grid = -1; return; }
        grid = cus;
        fprintf(stderr, "kernel_launch: cus %d per_cu %d grid %d\n", cus, per_cu, grid);
    }
    if (grid < 0) return;
    hipMemsetAsync((char*)d_ws + WS_CTL, 0, 1 * MiB, stream);
    Params prm{};
    for (int i = 0; i < 18; ++i) prm.in[i] = (const float*)d_in[i];
    prm.out = (float*)d_out; prm.ws = (unsigned char*)d_ws;
#if MK_ONE_LAUNCH
    prm.ph_lo = 0; prm.ph_hi = NPH;
    { void* args[] = {&prm}; hipError_t e = hipLaunchCooperativeKernel((const void*)mega, dim3(grid), dim3(NTHREADS), args, LDS_BYTES, stream);
      if (e != hipSuccess) fprintf(stderr, "cooperative launch failed: %s\n", hipGetErrorString(e)); }
#else
    for (int ph = 0; ph < NPH; ++ph) {
        prm.ph_lo = ph; prm.ph_hi = ph + 1;
        void* args[] = {&prm};
        hipError_t e = hipLaunchCooperativeKernel((const void*)mega, dim3(grid), dim3(NTHREADS), args, LDS_BYTES, stream);
        if (e != hipSuccess) { fprintf(stderr, "cooperative launch %d failed: %s\n", ph, hipGetErrorString(e)); break; }
    }
#endif
}
```

```cpp
#include <hip/hip_runtime.h>
#include <cstdio>
#include <cstdint>

#define LAS __attribute__((address_space(3)))
typedef unsigned short bf16_t;
typedef short bf16x8 __attribute__((ext_vector_type(8)));
typedef short s16x4 __attribute__((ext_vector_type(4)));
typedef float f32x4 __attribute__((ext_vector_type(4)));
typedef float f32x16 __attribute__((ext_vector_type(16)));
typedef unsigned u32x4 __attribute__((ext_vector_type(4)));
typedef unsigned u32x2 __attribute__((ext_vector_type(2)));

#ifndef PROBE_DUP
#define PROBE_DUP 0
#endif
#ifndef MK_ONE_LAUNCH
#define MK_ONE_LAUNCH 1
#endif

constexpr int S = 8192, DM = 2048, NIN = 2880, NINP = 3072;
constexpr int NPH = 9;
constexpr float EPS = 1e-6f;
constexpr int LDS_BYTES = 147456;
constexpr int NTHREADS = 512;
constexpr int LDS_MISC = 131072 + 1024;

constexpr size_t MiB = 1u << 20;
constexpr size_t WS_CTL = 0;
constexpr size_t WS_ROWSS = 128 * 1024;
constexpr size_t WS_COS = 1 * MiB, WS_SIN = 2 * MiB;
constexpr size_t WS_RSTD1 = 3 * MiB;
constexpr size_t WS_EXP = 4 * MiB;
constexpr size_t WS_GATE = 8 * MiB;
constexpr size_t WS_WIN = 12 * MiB;
constexpr size_t WS_WUQ = 24 * MiB;
constexpr size_t WS_WUKV = 26 * MiB;
constexpr size_t WS_WOUT = 28 * MiB;
constexpr size_t WS_WS = 36 * MiB;
constexpr size_t WS_XB = 44 * MiB;
constexpr size_t WS_PROJ = 76 * MiB;
constexpr size_t WS_QRAW = 124 * MiB;
constexpr size_t WS_KVRAW = 148 * MiB;
constexpr size_t WS_QH = 180 * MiB;
constexpr size_t WS_KH = 204 * MiB;
constexpr size_t WS_VH = 228 * MiB;
constexpr size_t WS_MIX = 244 * MiB;
constexpr size_t WS_X1B = 276 * MiB;
constexpr size_t WS_SC = 308 * MiB;
constexpr size_t WS_UT = 372 * MiB;
constexpr size_t WS_VT = 436 * MiB;
constexpr size_t WS_END = 500 * MiB;

__device__ __forceinline__ unsigned f2bf(float f) { unsigned u = __builtin_bit_cast(unsigned, f); return (u + 0x7fffu + ((u >> 16) & 1u)) >> 16; }
__device__ __forceinline__ unsigned pk2(float lo, float hi) { return f2bf(lo) | (f2bf(hi) << 16); }
__device__ __forceinline__ float bf2f(unsigned short b) { return __builtin_bit_cast(float, (unsigned)b << 16); }
__device__ __forceinline__ float bflo(unsigned w) { return __builtin_bit_cast(float, w << 16); }
__device__ __forceinline__ float bfhi(unsigned w) { return __builtin_bit_cast(float, w & 0xffff0000u); }
__device__ __forceinline__ float wave_sum(float v) {
#pragma unroll
    for (int o = 32; o > 0; o >>= 1) v += __shfl_xor(v, o);
    return v;
}
__device__ __forceinline__ float wave_max(float v) {
#pragma unroll
    for (int o = 32; o > 0; o >>= 1) v = fmaxf(v, __shfl_xor(v, o));
    return v;
}
__device__ __forceinline__ float gelu_tanh(float x) {
    const float y = 0.7978845608028654f * (x + 0.044715f * x * x * x);
    return x / (1.0f + __expf(-2.0f * y));
}
__device__ __forceinline__ int crow(int r, int hi) { return (r & 3) + 8 * (r >> 2) + 4 * hi; }
#define LDS_WAIT() asm volatile("s_waitcnt lgkmcnt(0)" ::: "memory")
#define SBAR() __builtin_amdgcn_sched_barrier(0)

namespace pg8 {
#define PG8_LAS __attribute__((address_space(3)))
constexpr int BM = 256, BK = 64, HALF = 128, HTB = HALF * BK * 2  , STAGE_BYTES = 8 * HTB, NXCD = 8, WGM = 8;

__host__ __device__ __forceinline__ int lds_byte(int r, int c) { const int st = (r >> 4) * 2 + (c >> 5), rr = r & 15, cc = c & 31, ob = rr * 64 + cc * 2; return st * 1024 + (ob ^ (((ob >> 9) & 1) << 5)); }
__host__ __device__ __forceinline__ void stage_rc(int b, int& R, int& C) { const int st = b / 1024, sb = b % 1024, swz = sb ^ (((sb >> 9) & 1) << 5); R = (st >> 1) * 16 + swz / 64; C = (st & 1) * 32 + (swz % 64) / 2; }
__host__ __device__ __forceinline__ int perm32(int rho) { const int n = rho >> 4, i = rho & 15; return 8 * (i >> 2) + 4 * n + (i & 3); }

struct Unit { int pm, pn; };
struct Gemm { const bf16_t* A; const bf16_t* Bt; int M, N, K, lda, ldb; };

struct StaticOrder {
    int nM, nN, nwg, G, c;
    __host__ __device__ void init(int M, int N, int G_, int c_) { nM = M / BM; nN = N / BM; nwg = nM * nN; G = G_; c = c_; }
    __host__ __device__ bool next(int i, Unit& u) const {
        const long L = (long)i * G + c; if (L >= nwg) return false;
        int wgid = (int)L; { const int q = nwg / NXCD, r = nwg % NXCD, xcd = wgid % NXCD, off = wgid / NXCD; wgid = (xcd < r ? xcd * (q + 1) : r * (q + 1) + (xcd - r) * q) + off; }
        const int nig = WGM * nN, gid = wgid / nig, fm = gid * WGM, gsz = (nM - fm) < WGM ? (nM - fm) : WGM;
        u.pm = fm + ((wgid % nig) % gsz); u.pn = (wgid % nig) / gsz; return true;
    }
    __device__ __forceinline__ void a_ready(const Unit&) const {}
    __device__ __forceinline__ void done(const Unit&) const {}
};

template <class Epi, class Sched, bool ALIGN_EPI = false, bool SP2 = false>
__device__ __forceinline__ void gemm_phase(PG8_LAS unsigned char* lds, const Gemm g, const Sched& S, const Epi& E) {
    const int tid = threadIdx.x, wid = __builtin_amdgcn_readfirstlane(tid >> 6), lane = tid & 63, wr = wid >> 2, wc = wid & 3, fr = lane & 15, fq = lane >> 4;
    const int K = g.K, nt = K / BK;
    unsigned voffA[2], voffB[2];
#pragma unroll
    for (int i = 0; i < 2; ++i) { int R, C; stage_rc(tid * 16 + i * 8192, R, C); const int Rb = Epi::PERM ? ((R & ~31) + perm32(R & 31)) : R;
        voffA[i] = (unsigned)(R * g.lda + C) * 2u; voffB[i] = (unsigned)(Rb * g.ldb + C) * 2u; }
    const size_t kstep = (size_t)(BK * 2);
    const size_t hstepA = (size_t)HALF * g.lda * 2, hstepB = (size_t)HALF * g.ldb * 2;
    const size_t tstepA = 2 * hstepA, tstepB = 2 * hstepB;
    const unsigned ldsw = (unsigned)wid * 1024u;
    const int aoff = lds_byte(wr * 64 + fr, fq * 8), boff = lds_byte(wc * 32 + fr, fq * 8);
#define PG8_SA(b, h) (((b) * 2 + (h)) * HTB)
#define PG8_SB(b, h) ((4 + (b) * 2 + (h)) * HTB)
#define PG8_STAGE(bufoff, gbase, voff) do { _Pragma("unroll") for (int _i = 0; _i < 2; ++_i) \
        __builtin_amdgcn_global_load_lds((const unsigned*)((const char*)(gbase) + (voff)[_i]), (PG8_LAS unsigned*)(lds + (bufoff) + ldsw + _i * 8192), 16, 0, 0); } while (0)
#define PG8_LDA(dst, b, h) do { _Pragma("unroll") for (int m = 0; m < 4; ++m) _Pragma("unroll") for (int k = 0; k < 2; ++k) dst[m][k] = *(const PG8_LAS bf16x8*)(lds + PG8_SA(b, h) + aoff + m * 2048 + k * 1024); } while (0)
#define PG8_LDB(dst, b, h) do { _Pragma("unroll") for (int n = 0; n < 2; ++n) _Pragma("unroll") for (int k = 0; k < 2; ++k) dst[n][k] = *(const PG8_LAS bf16x8*)(lds + PG8_SB(b, h) + boff + n * 2048 + k * 1024); } while (0)
#define PG8_MMA(ai, bj, At, Bt) do { __builtin_amdgcn_s_setprio(1); _Pragma("unroll") for (int m = 0; m < 4; ++m) _Pragma("unroll") for (int n = 0; n < 2; ++n) _Pragma("unroll") for (int k = 0; k < 2; ++k) \
        acc[ai][bj][m][n] = __builtin_amdgcn_mfma_f32_16x16x32_bf16(Bt[n][k], At[m][k], acc[ai][bj][m][n], 0, 0, 0); __builtin_amdgcn_s_setprio(0); } while (0)
#define PG8_WAIT_V(n) asm volatile("s_waitcnt vmcnt(" #n ")" ::: "memory")
#define PG8_WAIT_L(n) asm volatile("s_waitcnt lgkmcnt(" #n ")" ::: "memory")
#define PG8_BAR __builtin_amdgcn_s_barrier()
#define PG8_SCHED __builtin_amdgcn_sched_barrier(0)
    Unit cur, nxt; int ui = 0;
    if (!S.next(0, cur)) return;
    f32x4 acc[2][2][4][2];
#pragma unroll
    for (int a = 0; a < 2; ++a)
#pragma unroll
        for (int b = 0; b < 2; ++b)
#pragma unroll
            for (int m = 0; m < 4; ++m)
#pragma unroll
                for (int n = 0; n < 2; ++n) acc[a][b][m][n] = (f32x4){0.f, 0.f, 0.f, 0.f};
    bf16x8 At[4][2], B0[2][2], B1[2][2];
    const char* cA = (const char*)g.A + (size_t)cur.pm * tstepA; const char* cB = (const char*)g.Bt + (size_t)cur.pn * tstepB;
    S.a_ready(cur);
    if constexpr (SP2) {
        PG8_STAGE(PG8_SB(0, 0), cB, voffB); PG8_STAGE(PG8_SB(0, 1), cB + hstepB, voffB); PG8_STAGE(PG8_SA(0, 0), cA, voffA); PG8_STAGE(PG8_SA(0, 1), cA + hstepA, voffA);
        if (wr == 1) PG8_BAR;
        PG8_WAIT_V(2); PG8_BAR;
        PG8_STAGE(PG8_SB(1, 0), cB + kstep, voffB); PG8_STAGE(PG8_SA(1, 0), cA + kstep, voffA); PG8_STAGE(PG8_SB(1, 1), cB + hstepB + kstep, voffB);
        PG8_WAIT_V(6); PG8_BAR;
    } else {
        PG8_STAGE(PG8_SB(0, 0), cB, voffB); PG8_STAGE(PG8_SA(0, 0), cA, voffA); PG8_STAGE(PG8_SB(0, 1), cB + hstepB, voffB); PG8_STAGE(PG8_SA(0, 1), cA + hstepA, voffA);
        if (wr == 1) PG8_BAR;
        PG8_WAIT_V(4); PG8_BAR;
        PG8_STAGE(PG8_SB(1, 0), cB + kstep, voffB); PG8_STAGE(PG8_SA(1, 0), cA + kstep, voffA); PG8_STAGE(PG8_SB(1, 1), cB + hstepB + kstep, voffB);
        PG8_WAIT_V(6); PG8_BAR;
    }
    for (;;) {
        const bool has_next = S.next(ui + 1, nxt);
        const char* nA = has_next ? (const char*)g.A + (size_t)nxt.pm * tstepA : cA; const char* nB = has_next ? (const char*)g.Bt + (size_t)nxt.pn * tstepB : cB;
        for (int t = 0; t < nt; t += 2) {
            const bool last = (t == nt - 2);
            const char* a1 = cA + (size_t)(t + 1) * kstep;
            const char* a2 = last ? nA : cA + (size_t)(t + 2) * kstep; const char* b2 = last ? nB : cB + (size_t)(t + 2) * kstep;
            const char* a3 = a2 + kstep; const char* b3 = b2 + kstep;
            if (last && has_next) S.a_ready(nxt);
            if constexpr (SP2) {
            PG8_LDB(B0, 0, 0); PG8_LDB(B1, 0, 1); PG8_SCHED; PG8_LDA(At, 0, 0); PG8_STAGE(PG8_SA(1, 1), a1 + hstepA, voffA);
            PG8_WAIT_V(8); PG8_WAIT_L(0); PG8_BAR; PG8_MMA(0, 0, At, B0); PG8_MMA(0, 1, At, B1); PG8_BAR; PG8_SCHED;
            PG8_LDA(At, 0, 1); PG8_STAGE(PG8_SB(0, 0), b2, voffB); PG8_STAGE(PG8_SB(0, 1), b2 + hstepB, voffB); PG8_STAGE(PG8_SA(0, 0), a2, voffA);
            PG8_WAIT_V(8); PG8_WAIT_L(0); PG8_BAR; PG8_MMA(1, 0, At, B0); PG8_MMA(1, 1, At, B1); PG8_BAR; PG8_SCHED;
            PG8_LDB(B0, 1, 0); PG8_LDB(B1, 1, 1); PG8_SCHED; PG8_LDA(At, 1, 0); PG8_STAGE(PG8_SA(0, 1), a2 + hstepA, voffA);
            PG8_WAIT_V(8); PG8_WAIT_L(0); PG8_BAR; PG8_MMA(0, 0, At, B0); PG8_MMA(0, 1, At, B1); PG8_BAR; PG8_SCHED;
            PG8_LDA(At, 1, 1); PG8_STAGE(PG8_SB(1, 0), b3, voffB); PG8_STAGE(PG8_SB(1, 1), b3 + hstepB, voffB); PG8_STAGE(PG8_SA(1, 0), a3, voffA);
            PG8_WAIT_V(8); PG8_WAIT_L(0); PG8_BAR; PG8_MMA(1, 0, At, B0); PG8_MMA(1, 1, At, B1); PG8_BAR; PG8_SCHED;
            } else {
            PG8_LDB(B0, 0, 0); PG8_SCHED; PG8_LDA(At, 0, 0); PG8_STAGE(PG8_SA(1, 1), a1 + hstepA, voffA);
            PG8_WAIT_L(8); PG8_BAR; PG8_WAIT_L(0); PG8_MMA(0, 0, At, B0); PG8_BAR; PG8_SCHED;
            PG8_LDB(B1, 0, 1); PG8_STAGE(PG8_SB(0, 0), b2, voffB);
            PG8_BAR; PG8_WAIT_L(0); PG8_MMA(0, 1, At, B1); PG8_BAR;
            PG8_LDA(At, 0, 1); PG8_STAGE(PG8_SA(0, 0), a2, voffA);
            PG8_BAR; PG8_WAIT_L(0); PG8_MMA(1, 0, At, B0); PG8_BAR; PG8_SCHED;
            PG8_STAGE(PG8_SB(0, 1), b2 + hstepB, voffB);
            PG8_WAIT_V(6); PG8_BAR; PG8_MMA(1, 1, At, B1); PG8_BAR;
            PG8_LDB(B0, 1, 0); PG8_SCHED; PG8_LDA(At, 1, 0); PG8_STAGE(PG8_SA(0, 1), a2 + hstepA, voffA);
            PG8_WAIT_L(8); PG8_BAR; PG8_WAIT_L(0); PG8_MMA(0, 0, At, B0); PG8_BAR; PG8_SCHED;
            PG8_LDB(B1, 1, 1); PG8_STAGE(PG8_SB(1, 0), b3, voffB);
            PG8_BAR; PG8_WAIT_L(0); PG8_MMA(0, 1, At, B1); PG8_BAR;
            PG8_LDA(At, 1, 1); PG8_STAGE(PG8_SA(1, 0), a3, voffA);
            PG8_BAR; PG8_WAIT_L(0); PG8_MMA(1, 0, At, B0); PG8_BAR; PG8_SCHED;
            PG8_STAGE(PG8_SB(1, 1), b3 + hstepB, voffB);
            PG8_WAIT_V(6); PG8_BAR; PG8_MMA(1, 1, At, B1); PG8_BAR;
            }
        }
        if constexpr (ALIGN_EPI) { if (wr == 0) PG8_BAR; }
        if constexpr (!Epi::AFTER_DRAIN) { E(acc, cur, wr, wc, fr, fq); S.done(cur); }
        if (!has_next) break;
#pragma unroll
        for (int a = 0; a < 2; ++a)
#pragma unroll
            for (int b = 0; b < 2; ++b)
#pragma unroll
                for (int m = 0; m < 4; ++m)
#pragma unroll
                    for (int n = 0; n < 2; ++n) acc[a][b][m][n] = (f32x4){0.f, 0.f, 0.f, 0.f};
        cur = nxt; cA = nA; cB = nB; ++ui;
        if constexpr (ALIGN_EPI) { if (wr == 1) PG8_BAR; }
    }
    PG8_WAIT_V(0);
    if constexpr (!ALIGN_EPI) { if (wr == 0) PG8_BAR; }
    PG8_BAR;
#undef PG8_SA
#undef PG8_SB
#undef PG8_STAGE
#undef PG8_LDA
#undef PG8_LDB
#undef PG8_MMA
#undef PG8_WAIT_V
#undef PG8_WAIT_L
#undef PG8_BAR
#undef PG8_SCHED
}

template <int MODE> struct Epi {
    static constexpr bool PERM = false, AFTER_DRAIN = false;
    const float* rowsrc; float inv_n; float* ss; bf16_t* ob; int ldc; float* of; const float* xin;
    __device__ __forceinline__ void operator()(const f32x4 (&acc)[2][2][4][2], const Unit& u, int wr, int wc, int fr, int fq) const {
#pragma unroll
        for (int ai = 0; ai < 2; ++ai)
#pragma unroll
            for (int m = 0; m < 4; ++m) {
                const int row = u.pm * BM + ai * HALF + wr * 64 + m * 16 + fr;
                float rs = 1.f;
                if (MODE == 1) rs = rowsrc[row];
                if (MODE == 2 || MODE == 5) rs = rsqrtf(rowsrc[row] * inv_n + EPS);
                float ssq = 0.f;
#pragma unroll
                for (int bj = 0; bj < 2; ++bj)
#pragma unroll
                    for (int n = 0; n < 2; ++n) {
                        const int col = u.pn * BM + bj * HALF + wc * 32 + n * 16 + fq * 4;
                        f32x4 v = acc[ai][bj][m][n] * rs;
                        if (MODE == 1) { if (u.pn < 8) { v[0] = gelu_tanh(v[0]); v[1] = gelu_tanh(v[1]); v[2] = gelu_tanh(v[2]); v[3] = gelu_tanh(v[3]); } }
                        if (MODE == 4) { const f32x4 xr = *(const f32x4*)(xin + (size_t)row * DM + col); v = v + xr; }
                        if (MODE == 1 || MODE == 4) ssq += (v[0] * v[0] + v[1] * v[1]) + (v[2] * v[2] + v[3] * v[3]);
                        if (MODE == 1 || MODE == 2 || MODE == 4) { u32x2 w; w.x = pk2(v[0], v[1]); w.y = pk2(v[2], v[3]); *(u32x2*)(ob + (size_t)row * ldc + col) = w; }
                        if (MODE == 4 || MODE == 5) *(f32x4*)(of + (size_t)row * DM + col) = v;
                    }
                if (MODE == 1) {
                    const int seg = (u.pn >= 4 && u.pn < 8) ? 0 : ((u.pn == 8 || u.pn == 9) ? 1 : (u.pn == 10 ? 2 : -1));
                    if (seg >= 0) { ssq += __shfl_xor(ssq, 16); ssq += __shfl_xor(ssq, 32); if (fq == 0) atomicAdd(ss + seg * S + row, ssq); }
                }
                if (MODE == 4) { ssq += __shfl_xor(ssq, 16); ssq += __shfl_xor(ssq, 32); if (fq == 0) atomicAdd(ss + row, ssq); }
            }
    }
};
}

#define XB_TMO      128
#define XB_XCNT(j)  (256  + 64 * (j))
#define XB_XSUB(j)  (1280 + 64 * (j))
#define XB_XGEN(j)  (2304 + 64 * (j))
#define XB_TOP      3328
#define XB_TOPGEN   3392
#define XCD_BAR_WORDS 3456
#define XB_SPIN_CAP (1u << 18)
__device__ __forceinline__ unsigned xb_ld(unsigned* p)              { return __hip_atomic_load(p, __ATOMIC_RELAXED, __HIP_MEMORY_SCOPE_AGENT); }
__device__ __forceinline__ unsigned xb_add(unsigned* p, unsigned v) { return __hip_atomic_fetch_add(p, v, __ATOMIC_RELAXED, __HIP_MEMORY_SCOPE_AGENT); }
__device__ __forceinline__ unsigned xb_xcc_id() { return (unsigned)__builtin_amdgcn_s_getreg((3 << 11) | 20) & 0xFu; }
#define XB_SPIN(cond, bar) do { unsigned _sp = 0; while (cond) { __builtin_amdgcn_s_sleep(1); \
    if ((++_sp & 255u) == 0u) { if (xb_ld(&(bar)[XB_TMO])) break; if (_sp > XB_SPIN_CAP) { atomicAdd(&(bar)[XB_TMO], 1u); break; } } } } while (0)
struct XcdBarrier { unsigned* bar; unsigned x; volatile LAS unsigned* st; };
__device__ __forceinline__ XcdBarrier xcd_barrier_post(unsigned* bar, volatile LAS unsigned* st) {
    XcdBarrier b; b.bar = bar; b.x = xb_xcc_id(); b.st = st;
    if (threadIdx.x == 0) (void)xb_add(&bar[XB_XCNT(b.x)], 1u);
    return b;
}
__device__ __forceinline__ void xcd_barrier_complete(unsigned* bar, unsigned x, unsigned& nloc, unsigned& nx) {
    const unsigned G = gridDim.x * gridDim.y * gridDim.z;
    unsigned sum, cnt, mine, sp = 0u;
    for (;;) {
        sum = 0u; cnt = 0u; mine = 0u;
#pragma unroll
        for (unsigned j = 0; j < 16; ++j) { const unsigned c = xb_ld(&bar[XB_XCNT(j)]); sum += c; cnt += (c > 0u) ? 1u : 0u; mine = (j == x) ? c : mine; }
        if (sum == G) break;
        __builtin_amdgcn_s_sleep(1);
        if ((++sp & 255u) == 0u) { if (xb_ld(&bar[XB_TMO])) break; if (sp > XB_SPIN_CAP) { atomicAdd(&bar[XB_TMO], 1u); break; } }
    }
    nloc = mine > 0u ? mine : 1u; nx = cnt > 0u ? cnt : 1u;
}
__device__ __forceinline__ void xcd_barrier(const XcdBarrier& b) {
    asm volatile("s_waitcnt vmcnt(0)" ::: "memory");
    __syncthreads();
    if (threadIdx.x == 0) {
        unsigned* bar = b.bar;
        __builtin_amdgcn_s_waitcnt(0);
        unsigned nloc = b.st[0], nx = b.st[1];
        if (nloc == 0u) { xcd_barrier_complete(bar, b.x, nloc, nx); b.st[0] = nloc; b.st[1] = nx; }
        const unsigned old = xb_add(&bar[XB_XSUB(b.x)], 1u);
        const unsigned gen = old / nloc;
        if (old + 1u == (gen + 1u) * nloc) {
            __builtin_amdgcn_fence(__ATOMIC_RELEASE, "agent");
            asm volatile("s_waitcnt vmcnt(0)" ::: "memory");
            const unsigned og = xb_add(&bar[XB_TOP], 1u);
            const unsigned tg = og / nx;
            if (og + 1u == (tg + 1u) * nx) xb_add(&bar[XB_TOPGEN], 1u);
            else XB_SPIN(xb_ld(&bar[XB_TOPGEN]) == tg, bar);
            __builtin_amdgcn_fence(__ATOMIC_ACQUIRE, "agent");
            xb_add(&bar[XB_XGEN(b.x)], 1u);
            asm volatile("s_waitcnt vmcnt(0)" ::: "memory");
        } else {
            XB_SPIN(xb_ld(&bar[XB_XGEN(b.x)]) == gen, bar);
            __builtin_amdgcn_fence(__ATOMIC_ACQUIRE, "agent");
            asm volatile("s_waitcnt vmcnt(0)" ::: "memory");
        }
    }
    __syncthreads();
}

struct Params {
    const float* in[18];
    float* out;
    unsigned char* ws;
    int ph_lo, ph_hi;
};

__device__ __forceinline__ void p0_transpose_item(const float* W, const float* g, int K, int N, bf16_t* WT, LAS float* scr, int item, int lane) {
    const int nblk = N / 32, kb = item / nblk, nb = item % nblk, k0 = 64 * kb, n0 = 32 * nb;
#pragma unroll 8
    for (int i = 0; i < 32; ++i) { const int kk = 2 * i + (lane >> 5); const float gv = g ? g[k0 + kk] : 1.f;
        scr[kk * 33 + (lane & 31)] = W[(size_t)(k0 + kk) * N + n0 + (lane & 31)] * gv; }
    LDS_WAIT(); asm volatile("" ::: "memory");
    const int c = lane & 7;
#pragma unroll
    for (int j = 0; j < 4; ++j) { const int n = (lane >> 3) + 8 * j; const LAS float* s = scr + (8 * c) * 33 + n;
        u32x4 o; o.x = pk2(s[0 * 33], s[1 * 33]); o.y = pk2(s[2 * 33], s[3 * 33]); o.z = pk2(s[4 * 33], s[5 * 33]); o.w = pk2(s[6 * 33], s[7 * 33]);
        *(u32x4*)(WT + (size_t)(n0 + n) * K + k0 + 8 * c) = o; }
    LDS_WAIT(); asm volatile("" ::: "memory");
}
__device__ __forceinline__ float row_to_bf16(const float* src, const float* g, bf16_t* dst, int lane) {
    float ss = 0.f;
#pragma unroll
    for (int i = 0; i < 8; ++i) {
        const int c = (i * 64 + lane) * 4;
        f32x4 v = *(const f32x4*)(src + c);
        ss += (v[0] * v[0] + v[1] * v[1]) + (v[2] * v[2] + v[3] * v[3]);
        if (g) { const f32x4 gv = *(const f32x4*)(g + c); v = v * gv; }
        u32x2 w; w.x = pk2(v[0], v[1]); w.y = pk2(v[2], v[3]);
        *(u32x2*)(dst + c) = w;
    }
    return ss;
}
constexpr float PEER_USC = 80.0f, PEER_VSC = 5.0f;
constexpr int PEER_ROWB = 1536;
typedef float f32x16v __attribute__((ext_vector_type(16)));
typedef float f32x32v __attribute__((ext_vector_type(32)));
typedef unsigned u32x6 __attribute__((ext_vector_type(6)));
__device__ __forceinline__ void row_to_fp6(const float* src, const float* g, float scale, unsigned char* dst, int lane) {
    f32x16v a, b;
#pragma unroll
    for (int i = 0; i < 8; ++i) {
        f32x4 x = *(const f32x4*)(src + (i * 64 + lane) * 4) * scale;
        if (g) { const f32x4 gv = *(const f32x4*)(g + (i * 64 + lane) * 4); x = x * gv; }
#pragma unroll
        for (int q = 0; q < 4; ++q) { const float c = fminf(fmaxf(x[q], -7.5f), 7.5f); const int sl = 4 * i + q; if ((sl & 1) == 0) a[sl >> 1] = c; else b[sl >> 1] = c; }
    }
    const u32x6 pk = __builtin_amdgcn_cvt_scalef32_2xpk16_fp6_f32(a, b, 1.0f);
    *(u32x4*)(dst + lane * 16) = (u32x4){pk[0], pk[1], pk[2], pk[3]};
    *(u32x2*)(dst + 1024 + lane * 8) = (u32x2){pk[4], pk[5]};
}
__device__ __forceinline__ bf16x8 cvt8(const float* p) {
    const f32x4 a = *(const f32x4*)p, b = *(const f32x4*)(p + 4);
    u32x4 w; w.x = pk2(a[0], a[1]); w.y = pk2(a[2], a[3]); w.z = pk2(b[0], b[1]); w.w = pk2(b[2], b[3]);
    return __builtin_bit_cast(bf16x8, w);
}

__device__ __forceinline__ void phase0(const Params& p, LAS unsigned char* lds, int gw, int NGW, int wave, int lane) {
    unsigned char* ws = p.ws;
    LAS float* scr = (LAS float*)(lds + wave * 16384);
    const float* x = p.in[0];
    {
        constexpr int I_IN = (DM / 64) * (NIN / 32), I_UQ = (512 / 64) * (1536 / 32), I_UKV = (256 / 64) * (2048 / 32), I_OUT = (DM / 64) * (DM / 32);
        constexpr int NIT = I_IN + I_UQ + I_UKV + I_OUT;
        for (int it = gw; it < NIT; it += NGW) {
            int r = it;
            if (r < I_IN) { p0_transpose_item(p.in[2], p.in[1], DM, NIN, (bf16_t*)(ws + WS_WIN), scr, r, lane); continue; } r -= I_IN;
            if (r < I_UQ) { p0_transpose_item(p.in[7], p.in[6], 512, 1536, (bf16_t*)(ws + WS_WUQ), scr, r, lane); continue; } r -= I_UQ;
            if (r < I_UKV) { p0_transpose_item(p.in[9], p.in[8], 256, 2048, (bf16_t*)(ws + WS_WUKV), scr, r, lane); continue; } r -= I_UKV;
            p0_transpose_item(p.in[12], nullptr, DM, DM, (bf16_t*)(ws + WS_WOUT), scr, r, lane);
        }
    }
    for (int r = gw; r < NINP - NIN; r += NGW) {
        bf16_t* d = (bf16_t*)(ws + WS_WIN) + (size_t)(NIN + r) * DM;
#pragma unroll
        for (int i = 0; i < 4; ++i) *(u32x4*)(d + (i * 64 + lane) * 8) = (u32x4){0u, 0u, 0u, 0u};
    }
    {
        const float* wq = p.in[14]; const float* sk = p.in[15]; const float* g2 = p.in[13];
        bf16_t* WsT = (bf16_t*)(ws + WS_WS);
        const int r32 = lane & 31, hh = lane >> 5;
        for (int it = gw; it < 16 * 4 * 64; it += NGW) {
            const int hp = it >> 8, kb = (it >> 6) & 3, nb = it & 63;
            f32x16 acc = {};
            const float* ap = sk + ((size_t)(hp * 128 + kb * 32 + r32)) * 128 + hh * 8;
            const float* bp = wq + ((size_t)(nb * 32 + r32)) * DM + hp * 128 + hh * 8;
#pragma unroll
            for (int s = 0; s < 8; ++s) {
                const bf16x8 a = cvt8(ap + s * 16), b = cvt8(bp + s * 16);
                acc = __builtin_amdgcn_mfma_f32_32x32x16_bf16(a, b, acc, 0, 0, 0);
            }
            const int kcol = nb * 32 + r32; const float gk = g2[kcol];
#pragma unroll
            for (int r = 0; r < 16; ++r) WsT[(size_t)(hp * 128 + kb * 32 + crow(r, hh)) * DM + kcol] = (bf16_t)f2bf(acc[r] * gk);
        }
    }
    {
        bf16_t* xb = (bf16_t*)(ws + WS_XB); float* rstd1 = (float*)(ws + WS_RSTD1);
        for (int t = gw; t < S; t += NGW) {
            float ss = row_to_bf16(x + (size_t)t * DM, nullptr, xb + (size_t)t * DM, lane);
            ss = wave_sum(ss);
            if (lane == 0) rstd1[t] = rsqrtf(ss * (1.0f / DM) + EPS);
        }
    }
    {
        unsigned char* UT = ws + WS_UT; unsigned char* VT = ws + WS_VT;
        for (int e = gw; e < 2 * 16384; e += NGW) {
            if (e < 16384) row_to_fp6(p.in[16] + (size_t)e * DM, p.in[13], PEER_USC, UT + (size_t)e * PEER_ROWB, lane);
            else row_to_fp6(p.in[17] + (size_t)(e - 16384) * DM, nullptr, PEER_VSC, VT + (size_t)(e - 16384) * PEER_ROWB, lane);
        }
    }
    {
        float* ct = (float*)(ws + WS_COS); float* st = (float*)(ws + WS_SIN);
        for (int it = gw; it < S * 32 / 64; it += NGW) {
            const int idx = it * 64 + lane, t = idx >> 5, j = idx & 31;
            const float inv_freq = powf(10000.0f, -(float)j / 32.0f);
            const float ang = (float)t * inv_freq;
            ct[idx] = cosf(ang); st[idx] = sinf(ang);
        }
    }
}

__device__ __forceinline__ void phase3(const Params& p, int gw, int NGW, int lane) {
    unsigned char* ws = p.ws;
    const bf16_t* qraw = (const bf16_t*)(ws + WS_QRAW); const bf16_t* kvraw = (const bf16_t*)(ws + WS_KVRAW); const bf16_t* proj = (const bf16_t*)(ws + WS_PROJ);
    bf16_t* Qh = (bf16_t*)(ws + WS_QH); bf16_t* Kh = (bf16_t*)(ws + WS_KH); bf16_t* Vh = (bf16_t*)(ws + WS_VH);
    const float* ct = (const float*)(ws + WS_COS); const float* st = (const float*)(ws + WS_SIN);
    const float* gq = p.in[10]; const float* gk = p.in[11];
    const float gq0 = gq[lane], gq1 = gq[64 + lane], gq2 = gq[128 + lane], gk0 = gk[lane], gk1 = gk[64 + lane], gk2 = gk[128 + lane];
    constexpr float QS = 0.07216878364870322f * 1.4426950408889634f;
    for (int t = gw; t < S; t += NGW) {
        const float cs = ct[t * 32 + (lane & 31)], sn = st[t * 32 + (lane & 31)];
        const float kr = bf2f(proj[(size_t)t * NINP + 2816 + lane]);
#pragma unroll
        for (int h = 0; h < 8; ++h) {
            const bf16_t* qp = qraw + (size_t)t * 1536 + h * 192;
            float q0 = bf2f(qp[lane]), q1 = bf2f(qp[64 + lane]), q2 = bf2f(qp[128 + lane]);
            float ss = wave_sum(q0 * q0 + q1 * q1 + q2 * q2);
            float rs = rsqrtf(ss * (1.0f / 192.0f) + EPS);
            q0 *= rs * gq0; q1 *= rs * gq1; q2 *= rs * gq2;
            float pr = __shfl_xor(q2, 32);
            q2 = (lane < 32) ? (q2 * cs - pr * sn) : (pr * sn + q2 * cs);
            bf16_t* qo = Qh + ((size_t)h * S + t) * 192;
            qo[lane] = (bf16_t)f2bf(q0 * QS); qo[64 + lane] = (bf16_t)f2bf(q1 * QS); qo[128 + lane] = (bf16_t)f2bf(q2 * QS);
            const bf16_t* kp = kvraw + (size_t)t * 2048 + h * 256;
            float k0 = bf2f(kp[lane]), k1 = bf2f(kp[64 + lane]), k2 = kr;
            ss = wave_sum(k0 * k0 + k1 * k1 + k2 * k2);
            rs = rsqrtf(ss * (1.0f / 192.0f) + EPS);
            k0 *= rs * gk0; k1 *= rs * gk1; k2 *= rs * gk2;
            pr = __shfl_xor(k2, 32);
            k2 = (lane < 32) ? (k2 * cs - pr * sn) : (pr * sn + k2 * cs);
            bf16_t* ko = Kh + ((size_t)h * S + t) * 192;
            ko[lane] = (bf16_t)f2bf(k0); ko[64 + lane] = (bf16_t)f2bf(k1); ko[128 + lane] = (bf16_t)f2bf(k2);
            bf16_t* vo = Vh + ((size_t)h * S + t) * 128;
            vo[lane] = kp[128 + lane]; vo[64 + lane] = kp[192 + lane];
        }
    }
}

constexpr int KP = 400, VP = 320;
constexpr int ATT_BUF = 64 * KP + 64 * VP;
template <int OFF> __device__ __forceinline__ s16x4 tr_read(unsigned addr) {
    s16x4 r; asm volatile("ds_read_b64_tr_b16 %0, %1 offset:%2" : "=&v"(r) : "v"(addr), "i"(OFF) : "memory"); return r;
}
__device__ __forceinline__ unsigned cvtpk(float lo, float hi) { unsigned r; asm volatile("v_cvt_pk_bf16_f32 %0, %1, %2" : "=v"(r) : "v"(lo), "v"(hi)); return r; }
#define PK8(L, H) ((bf16x8){L[0], L[1], L[2], L[3], H[0], H[1], H[2], H[3]})
constexpr float ATT_THR = 8.0f;

__device__ __forceinline__ void attn_tile(const LAS unsigned char* kbuf, unsigned vaddr, const bf16x8 (&qr)[12], f32x16 (&o)[4], float& m, float& lsum, int lane) {
    f32x16 pacc = {};
    const LAS unsigned char* kp = kbuf + (lane & 31) * KP + (lane >> 5) * 16;
#pragma unroll
    for (int ks = 0; ks < 12; ++ks) { const bf16x8 a = *(const LAS bf16x8*)(kp + ks * 32); pacc = __builtin_amdgcn_mfma_f32_32x32x16_bf16(a, qr[ks], pacc, 0, 0, 0); }
    float pmax = pacc[0];
#pragma unroll
    for (int r = 1; r < 16; ++r) pmax = fmaxf(pmax, pacc[r]);
    pmax = fmaxf(pmax, __shfl_xor(pmax, 32));
    if (!__all(pmax - m <= ATT_THR)) {
        const float mn = fmaxf(m, pmax); const float alpha = __builtin_amdgcn_exp2f(m - mn); m = mn; lsum *= alpha;
#pragma unroll
        for (int d = 0; d < 4; ++d)
#pragma unroll
            for (int r = 0; r < 16; ++r) o[d][r] *= alpha;
    }
    float ps = 0.f;
#pragma unroll
    for (int r = 0; r < 16; ++r) { pacc[r] = __builtin_amdgcn_exp2f(pacc[r] - m); ps += pacc[r]; }
    ps += __shfl_xor(ps, 32);
    lsum += ps;
    u32x4 w0 = {cvtpk(pacc[0], pacc[1]), cvtpk(pacc[2], pacc[3]), cvtpk(pacc[4], pacc[5]), cvtpk(pacc[6], pacc[7])};
    u32x4 w1 = {cvtpk(pacc[8], pacc[9]), cvtpk(pacc[10], pacc[11]), cvtpk(pacc[12], pacc[13]), cvtpk(pacc[14], pacc[15])};
    const bf16x8 pb0 = __builtin_bit_cast(bf16x8, w0), pb1 = __builtin_bit_cast(bf16x8, w1);
#define VOFF(d0, s, hi) (((16 * (s) + 8 * (hi)) * VP) + 64 * (d0))
    const s16x4 a00l = tr_read<VOFF(0, 0, 0)>(vaddr), a00h = tr_read<VOFF(0, 0, 1)>(vaddr), a01l = tr_read<VOFF(0, 1, 0)>(vaddr), a01h = tr_read<VOFF(0, 1, 1)>(vaddr);
    const s16x4 a10l = tr_read<VOFF(1, 0, 0)>(vaddr), a10h = tr_read<VOFF(1, 0, 1)>(vaddr), a11l = tr_read<VOFF(1, 1, 0)>(vaddr), a11h = tr_read<VOFF(1, 1, 1)>(vaddr);
    const s16x4 a20l = tr_read<VOFF(2, 0, 0)>(vaddr), a20h = tr_read<VOFF(2, 0, 1)>(vaddr), a21l = tr_read<VOFF(2, 1, 0)>(vaddr), a21h = tr_read<VOFF(2, 1, 1)>(vaddr);
    const s16x4 a30l = tr_read<VOFF(3, 0, 0)>(vaddr), a30h = tr_read<VOFF(3, 0, 1)>(vaddr), a31l = tr_read<VOFF(3, 1, 0)>(vaddr), a31h = tr_read<VOFF(3, 1, 1)>(vaddr);
#undef VOFF
    LDS_WAIT(); SBAR();
    o[0] = __builtin_amdgcn_mfma_f32_32x32x16_bf16(PK8(a00l, a00h), pb0, o[0], 0, 0, 0); o[0] = __builtin_amdgcn_mfma_f32_32x32x16_bf16(PK8(a01l, a01h), pb1, o[0], 0, 0, 0);
    o[1] = __builtin_amdgcn_mfma_f32_32x32x16_bf16(PK8(a10l, a10h), pb0, o[1], 0, 0, 0); o[1] = __builtin_amdgcn_mfma_f32_32x32x16_bf16(PK8(a11l, a11h), pb1, o[1], 0, 0, 0);
    o[2] = __builtin_amdgcn_mfma_f32_32x32x16_bf16(PK8(a20l, a20h), pb0, o[2], 0, 0, 0); o[2] = __builtin_amdgcn_mfma_f32_32x32x16_bf16(PK8(a21l, a21h), pb1, o[2], 0, 0, 0);
    o[3] = __builtin_amdgcn_mfma_f32_32x32x16_bf16(PK8(a30l, a30h), pb0, o[3], 0, 0, 0); o[3] = __builtin_amdgcn_mfma_f32_32x32x16_bf16(PK8(a31l, a31h), pb1, o[3], 0, 0, 0);
}

__device__ __forceinline__ void attn_unit(const Params& p, LAS unsigned char* lds, int head, int qb, int tid, int wave, int lane) {
    unsigned char* ws = p.ws;
    const bf16_t* Qh = (const bf16_t*)(ws + WS_QH); const bf16_t* Kh = (const bf16_t*)(ws + WS_KH); const bf16_t* Vh = (const bf16_t*)(ws + WS_VH);
    bf16_t* mix = (bf16_t*)(ws + WS_MIX);
    const int rg = wave & 3, kh = wave >> 2, r32 = lane & 31, hh = lane >> 5;
    const int q0row = qb * 128 + rg * 32;
    bf16x8 qr[12];
    {
        const bf16_t* qp = Qh + ((size_t)head * S + q0row + r32) * 192 + hh * 8;
#pragma unroll
        for (int ks = 0; ks < 12; ++ks) qr[ks] = *(const bf16x8*)(qp + ks * 16);
    }
    const int ntiles = 2 * qb + 2, mylast = 2 * qb + (rg >> 1);
    float m = -1e30f, lsum = 0.f; f32x16 o[4] = {};
    int kgo[3], klo[3], vgo[2], vlo[2];
#pragma unroll
    for (int i = 0; i < 3; ++i) { const int pc = tid + 512 * i, r = pc / 24, c = pc % 24; kgo[i] = r * 192 + c * 8; klo[i] = r * KP + c * 16; }
#pragma unroll
    for (int i = 0; i < 2; ++i) { const int pc = tid + 512 * i, r = pc >> 4, c = pc & 15; vgo[i] = r * 128 + c * 8; vlo[i] = 64 * KP + r * VP + c * 16; }
    const bf16_t* kbase = Kh + (size_t)head * S * 192; const bf16_t* vbase = Vh + (size_t)head * S * 128;
    u32x4 sk0, sk1, sk2, sv0, sv1;
#define ATT_LOAD(t) do { const bf16_t* kt = kbase + (size_t)(t) * 64 * 192; const bf16_t* vt = vbase + (size_t)(t) * 64 * 128; \
        sk0 = *(const u32x4*)(kt + kgo[0]); sk1 = *(const u32x4*)(kt + kgo[1]); sk2 = *(const u32x4*)(kt + kgo[2]); sv0 = *(const u32x4*)(vt + vgo[0]); sv1 = *(const u32x4*)(vt + vgo[1]); } while (0)
#define ATT_WRITE(b) do { LAS unsigned char* bb = lds + (b) * ATT_BUF; *(LAS u32x4*)(bb + klo[0]) = sk0; *(LAS u32x4*)(bb + klo[1]) = sk1; *(LAS u32x4*)(bb + klo[2]) = sk2; \
        *(LAS u32x4*)(bb + vlo[0]) = sv0; *(LAS u32x4*)(bb + vlo[1]) = sv1; } while (0)
    const unsigned ldsbase = (unsigned)(size_t)lds;
    const unsigned vrel = (unsigned)(64 * KP + (32 * kh + 4 * hh + ((lane & 15) >> 2)) * VP + (16 * ((lane >> 4) & 1) + 4 * (lane & 3)) * 2);
    ATT_LOAD(0); ATT_WRITE(0); __syncthreads();
    for (int t = 0; t < ntiles; ++t) {
        const bool more = (t + 1 < ntiles);
        if (more) ATT_LOAD(t + 1);
        if (t <= mylast) {
            const int b = t & 1;
            attn_tile(lds + b * ATT_BUF + (32 * kh) * KP, ldsbase + b * ATT_BUF + vrel, qr, o, m, lsum, lane);
        }
        if (more) ATT_WRITE((t + 1) & 1);
        __syncthreads();
    }
#undef ATT_LOAD
#undef ATT_WRITE
    LAS float* scr = (LAS float*)lds + (size_t)rg * 66 * 64 + lane;
    if (kh == 1) {
        scr[0] = m; scr[64] = lsum;
#pragma unroll
        for (int d = 0; d < 4; ++d)
#pragma unroll
            for (int r = 0; r < 16; ++r) scr[(2 + d * 16 + r) * 64] = o[d][r];
    }
    __syncthreads();
    if (kh == 0) {
        const float m2 = scr[0], l2 = scr[64];
        const float mn = fmaxf(m, m2), a1 = __builtin_amdgcn_exp2f(m - mn), a2 = __builtin_amdgcn_exp2f(m2 - mn);
        const float inv = 1.0f / (lsum * a1 + l2 * a2);
        bf16_t* op = mix + (size_t)(q0row + r32) * DM + 1024 + head * 128 + 4 * hh;
#pragma unroll
        for (int d = 0; d < 4; ++d)
#pragma unroll
            for (int g4 = 0; g4 < 4; ++g4) {
                float v[4];
#pragma unroll
                for (int i = 0; i < 4; ++i) { const int r = 4 * g4 + i; v[i] = (o[d][r] * a1 + scr[(2 + d * 16 + r) * 64] * a2) * inv; }
                u32x2 w; w.x = pk2(v[0], v[1]); w.y = pk2(v[2], v[3]);
                *(u32x2*)(op + 32 * d + 8 * g4) = w;
            }
    }
    __syncthreads();
}

__device__ __forceinline__ void gmlp_unit(const Params& p, LAS unsigned char* lds, int nb, int h, int tid, int wave, int lane) {
    unsigned char* ws = p.ws;
    const bf16_t* proj = (const bf16_t*)(ws + WS_PROJ); bf16_t* mix = (bf16_t*)(ws + WS_MIX);
    const float* ssv = (const float*)(ws + WS_ROWSS);
    const float* vg = p.in[3]; const float* wsp = p.in[4]; const float* bs = p.in[5];
#pragma unroll
    for (int i = 0; i < 4; ++i) {
        const int pc = tid + 512 * i, r = pc >> 4, c = pc & 15, t = nb * 128 + r;
        const u32x4 w = *(const u32x4*)(proj + (size_t)t * NINP + 1024 + h * 128 + c * 8);
        const float rs = rsqrtf(ssv[t] * (1.0f / 1024.0f) + EPS);
        const f32x4 g0 = *(const f32x4*)(vg + h * 128 + c * 8), g1 = *(const f32x4*)(vg + h * 128 + c * 8 + 4);
        u32x4 ov;
        ov.x = pk2(bflo(w.x) * rs * g0[0], bfhi(w.x) * rs * g0[1]); ov.y = pk2(bflo(w.y) * rs * g0[2], bfhi(w.y) * rs * g0[3]);
        ov.z = pk2(bflo(w.z) * rs * g1[0], bfhi(w.z) * rs * g1[1]); ov.w = pk2(bflo(w.w) * rs * g1[2], bfhi(w.w) * rs * g1[3]);
        *(LAS u32x4*)(lds + r * VP + c * 16) = ov;
    }
    __syncthreads();
    const int ib = wave & 3, ch = wave >> 2, r32 = lane & 31, hh = lane >> 5;
    const int irow = 32 * ib + r32;
    f32x16 acc0 = {}, acc1 = {};
    const unsigned vaddr = (unsigned)(size_t)lds + (unsigned)((8 * hh + ((lane & 15) >> 2)) * VP + (64 * ch + 16 * ((lane >> 4) & 1) + 4 * (lane & 3)) * 2);
    const float* wrow = wsp + ((size_t)h * 128 + irow) * 128 + hh * 8;
#define GSTEP(s) do { if ((s) < 2 * (ib + 1)) { \
        const f32x4 wa = *(const f32x4*)(wrow + (s) * 16), wb = *(const f32x4*)(wrow + (s) * 16 + 4); const int j0 = (s) * 16 + hh * 8; \
        u32x4 aw; aw.x = pk2(j0 + 0 <= irow ? wa[0] : 0.f, j0 + 1 <= irow ? wa[1] : 0.f); aw.y = pk2(j0 + 2 <= irow ? wa[2] : 0.f, j0 + 3 <= irow ? wa[3] : 0.f); \
        aw.z = pk2(j0 + 4 <= irow ? wb[0] : 0.f, j0 + 5 <= irow ? wb[1] : 0.f); aw.w = pk2(j0 + 6 <= irow ? wb[2] : 0.f, j0 + 7 <= irow ? wb[3] : 0.f); \
        const bf16x8 af = __builtin_bit_cast(bf16x8, aw); \
        const s16x4 b0l = tr_read<(16 * (s)) * VP>(vaddr), b0h = tr_read<(16 * (s) + 4) * VP>(vaddr), b1l = tr_read<(16 * (s)) * VP + 64>(vaddr), b1h = tr_read<(16 * (s) + 4) * VP + 64>(vaddr); \
        LDS_WAIT(); SBAR(); \
        acc0 = __builtin_amdgcn_mfma_f32_32x32x16_bf16(af, PK8(b0l, b0h), acc0, 0, 0, 0); acc1 = __builtin_amdgcn_mfma_f32_32x32x16_bf16(af, PK8(b1l, b1h), acc1, 0, 0, 0); } } while (0)
    GSTEP(0); GSTEP(1); GSTEP(2); GSTEP(3); GSTEP(4); GSTEP(5); GSTEP(6); GSTEP(7);
#undef GSTEP
#pragma unroll
    for (int r = 0; r < 16; ++r) {
        const int i = 32 * ib + crow(r, hh), t = nb * 128 + i; const float b = bs[h * 128 + i];
        const int c0 = h * 128 + 64 * ch + r32;
        const float u0 = bf2f(proj[(size_t)t * NINP + c0]), u1 = bf2f(proj[(size_t)t * NINP + c0 + 32]);
        mix[(size_t)t * DM + c0] = (bf16_t)f2bf(u0 * (acc0[r] + b)); mix[(size_t)t * DM + c0 + 32] = (bf16_t)f2bf(u1 * (acc1[r] + b));
    }
    __syncthreads();
}

template <int CTRL, int ROW_MASK> __device__ __forceinline__ float dpp_f(float old, float v) {
    return __builtin_bit_cast(float, __builtin_amdgcn_update_dpp(__builtin_bit_cast(int, old), __builtin_bit_cast(int, v), CTRL, ROW_MASK, 0xf, false));
}
__device__ __forceinline__ float wave_max_u(float v) {
    v = fmaxf(v, dpp_f<0xB1, 0xf>(v, v));
    v = fmaxf(v, dpp_f<0x4E, 0xf>(v, v));
    v = fmaxf(v, dpp_f<0x141, 0xf>(v, v));
    v = fmaxf(v, dpp_f<0x140, 0xf>(v, v));
    v = fmaxf(v, dpp_f<0x142, 0xa>(v, v));
    v = fmaxf(v, dpp_f<0x143, 0xc>(v, v));
    return __builtin_bit_cast(float, __builtin_amdgcn_readlane(__builtin_bit_cast(int, v), 63));
}
__device__ __forceinline__ float wave_sum_u(float v) {
    v += dpp_f<0xB1, 0xf>(0.f, v);
    v += dpp_f<0x4E, 0xf>(0.f, v);
    v += dpp_f<0x141, 0xf>(0.f, v);
    v += dpp_f<0x140, 0xf>(0.f, v);
    v += dpp_f<0x142, 0xa>(0.f, v);
    v += dpp_f<0x143, 0xc>(0.f, v);
    return __builtin_bit_cast(float, __builtin_amdgcn_readlane(__builtin_bit_cast(int, v), 63));
}
__device__ __forceinline__ void phase7(const Params& p, LAS unsigned char* lds, int gw, int NGW, int wave, int lane) {
    unsigned char* ws = p.ws;
    const float* sc = (const float*)(ws + WS_SC); int* ex = (int*)(ws + WS_EXP); float* gt = (float*)(ws + WS_GATE);
    const float NEG = -3.0e38f;
    LAS float* sl = (LAS float*)(lds + wave * 1024);
    const int j8 = lane & 7, g8 = lane >> 3, row = lane >> 4, i16 = lane & 15;
    int ci[4], cj[4]; bool cval[4];
    {
        constexpr int starts[16] = {0, 16, 24, 29, 33, 36, 38, 40, 42, 43, 44, 45, 46, 47, 48, 49};
#pragma unroll
        for (int m = 0; m < 4; ++m) {
            const int c = i16 + 16 * m; int a = 0, st = 0;
#pragma unroll
            for (int i = 1; i < 16; ++i) if (c >= starts[i]) { a = i; st = starts[i]; }
            cval[m] = c < 50; ci[m] = cval[m] ? a : 0; cj[m] = cval[m] ? (c - st) : 0;
        }
    }
    constexpr int NT = S * 2;
    f32x4 nx0, nx1, nx2, nx3;
    if (gw < NT) { const float* b = sc + (size_t)(gw >> 1) * DM + (gw & 1) * 1024 + lane * 16; nx0 = *(const f32x4*)b; nx1 = *(const f32x4*)(b + 4); nx2 = *(const f32x4*)(b + 8); nx3 = *(const f32x4*)(b + 12); }
    for (int it = gw; it < NT; it += NGW) {
        const int t = it >> 1, hh = it & 1;
        float v[16];
#pragma unroll
        for (int q = 0; q < 4; ++q) { v[q] = nx0[q]; v[4 + q] = nx1[q]; v[8 + q] = nx2[q]; v[12 + q] = nx3[q]; }
        if (it + NGW < NT) { const int it2 = it + NGW; const float* b = sc + (size_t)(it2 >> 1) * DM + (it2 & 1) * 1024 + lane * 16;
            nx0 = *(const f32x4*)b; nx1 = *(const f32x4*)(b + 4); nx2 = *(const f32x4*)(b + 8); nx3 = *(const f32x4*)(b + 12); }
#pragma unroll
        for (int m = 0; m < 16; ++m) v[m] = __builtin_bit_cast(float, (__builtin_bit_cast(unsigned, v[m]) & ~127u) | (unsigned)(16 * j8 + m));
        float ra = 0.f, rb = 0.f;
#pragma unroll
        for (int k = 0; k < 16; ++k) {
            float mx = fmaxf(fmaxf(fmaxf(v[0], v[1]), fmaxf(v[2], v[3])), fmaxf(fmaxf(v[4], v[5]), fmaxf(v[6], v[7])));
            mx = fmaxf(mx, fmaxf(fmaxf(fmaxf(v[8], v[9]), fmaxf(v[10], v[11])), fmaxf(fmaxf(v[12], v[13]), fmaxf(v[14], v[15]))));
            mx = fmaxf(mx, dpp_f<0xB1, 0xf>(mx, mx));
            mx = fmaxf(mx, dpp_f<0x4E, 0xf>(mx, mx));
            mx = fmaxf(mx, dpp_f<0x141, 0xf>(mx, mx));
#pragma unroll
            for (int m = 0; m < 16; ++m) v[m] = (v[m] == mx) ? NEG : v[m];
            if (k < 8) ra = (j8 == k) ? mx : ra; else rb = (j8 == k - 8) ? mx : rb;
        }
        sl[g8 * 16 + j8] = ra; sl[g8 * 16 + 8 + j8] = rb;
        LDS_WAIT(); asm volatile("" ::: "memory");
        float cv[4], og[4]; int id[4];
#pragma unroll
        for (int m = 0; m < 4; ++m) {
            const float s1 = sl[(2 * row) * 16 + ci[m]], s2 = sl[(2 * row + 1) * 16 + cj[m]];
            og[m] = cval[m] ? (s1 + s2) : NEG; cv[m] = og[m];
            id[m] = (int)((__builtin_bit_cast(unsigned, s1) & 127u) * 128u + (__builtin_bit_cast(unsigned, s2) & 127u));
        }
        LDS_WAIT(); asm volatile("" ::: "memory");
        float M0 = 0.f;
#pragma unroll
        for (int k = 0; k < 16; ++k) {
            float mx = fmaxf(fmaxf(cv[0], cv[1]), fmaxf(cv[2], cv[3]));
            mx = fmaxf(mx, dpp_f<0xB1, 0xf>(mx, mx));
            mx = fmaxf(mx, dpp_f<0x4E, 0xf>(mx, mx));
            mx = fmaxf(mx, dpp_f<0x141, 0xf>(mx, mx));
            mx = fmaxf(mx, dpp_f<0x140, 0xf>(mx, mx));
            if (k == 0) M0 = mx;
#pragma unroll
            for (int m = 0; m < 4; ++m) cv[m] = (cv[m] == mx) ? NEG : cv[m];
        }
        bool sel[4]; float e[4]; float es = 0.f;
#pragma unroll
        for (int m = 0; m < 4; ++m) { sel[m] = (cv[m] != og[m]); e[m] = sel[m] ? __expf(og[m] - M0) : 0.f; es += e[m]; }
        es += dpp_f<0xB1, 0xf>(0.f, es); es += dpp_f<0x4E, 0xf>(0.f, es); es += dpp_f<0x141, 0xf>(0.f, es); es += dpp_f<0x140, 0xf>(0.f, es);
        const float inv = 1.0f / es;
        int basepos = 0;
        const int head = 4 * hh + row;
#pragma unroll
        for (int m = 0; m < 4; ++m) {
            const unsigned long long bl = __ballot(sel[m]);
            const unsigned rbits = (unsigned)(bl >> (16 * row)) & 0xffffu;
            const int pos = basepos + __popc(rbits & ((1u << i16) - 1u));
            if (sel[m] && pos < 16) { ex[(size_t)t * 128 + head * 16 + pos] = id[m]; gt[(size_t)t * 128 + head * 16 + pos] = e[m] * inv; }
            basepos += __popc(rbits);
        }
    }
}

constexpr int P8G = 2;
__device__ __forceinline__ void phase8(const Params& p, float* dst, int gw, int NGW, int lane) {
    unsigned char* ws = p.ws;
    const bf16_t* x1b = (const bf16_t*)(ws + WS_X1B); const unsigned char* UT = ws + WS_UT; const unsigned char* VT = ws + WS_VT;
    const int* ex = (const int*)(ws + WS_EXP); const float* gt = (const float*)(ws + WS_GATE); const float* ss2 = (const float*)(ws + WS_ROWSS) + 3 * S;
    const float* out = p.out;
    for (int t = gw; t < S; t += NGW) {
        const float rstd2 = rsqrtf(ss2[t] * (1.0f / DM) + EPS) * (1.0f / PEER_USC);
        float xf[32];
#pragma unroll
        for (int i = 0; i < 8; ++i) {
            const u32x2 w = *(const u32x2*)(x1b + (size_t)t * DM + (i * 64 + lane) * 4);
            xf[4 * i + 0] = bflo(w.x); xf[4 * i + 1] = bfhi(w.x); xf[4 * i + 2] = bflo(w.y); xf[4 * i + 3] = bfhi(w.y);
        }
        float acc[32];
#pragma unroll
        for (int i = 0; i < 32; ++i) acc[i] = 0.f;
        const int* ep = ex + (size_t)t * 128; const float* gp = gt + (size_t)t * 128;
        u32x4 ua4[P8G], va4[P8G], ub4[P8G], vb4[P8G]; u32x2 ua2[P8G], va2[P8G], ub2[P8G], vb2[P8G];
#define P8_LOAD(U4, U2, V4, V2, g) do { _Pragma("unroll") for (int e = 0; e < P8G; ++e) { const size_t ro = (size_t)ep[(g) * P8G + e] * PEER_ROWB; \
            U4[e] = *(const u32x4*)(UT + ro + lane * 16); U2[e] = *(const u32x2*)(UT + ro + 1024 + lane * 8); \
            V4[e] = *(const u32x4*)(VT + ro + lane * 16); V2[e] = *(const u32x2*)(VT + ro + 1024 + lane * 8); } } while (0)
#define P8_PROC(U4, U2, V4, V2, g) do { float d_[P8G]; \
            _Pragma("unroll") for (int e = 0; e < P8G; ++e) { const u32x6 pk = {U4[e][0], U4[e][1], U4[e][2], U4[e][3], U2[e][0], U2[e][1]}; \
                const f32x32v r = __builtin_amdgcn_cvt_scalef32_pk32_f32_fp6(pk, 1.0f); float d = 0.f; \
                _Pragma("unroll") for (int s_ = 0; s_ < 32; ++s_) d += r[s_] * xf[s_]; d_[e] = d; } \
            _Pragma("unroll") for (int e = 0; e < P8G; ++e) d_[e] = wave_sum_u(d_[e]); \
            _Pragma("unroll") for (int e = 0; e < P8G; ++e) { const float c_ = gp[(g) * P8G + e] * gelu_tanh(rstd2 * d_[e]) * (1.0f / PEER_VSC); \
                const u32x6 pk = {V4[e][0], V4[e][1], V4[e][2], V4[e][3], V2[e][0], V2[e][1]}; \
                const f32x32v r = __builtin_amdgcn_cvt_scalef32_pk32_f32_fp6(pk, 1.0f); \
                _Pragma("unroll") for (int s_ = 0; s_ < 32; ++s_) acc[s_] += c_ * r[s_]; } } while (0)
        constexpr int NG = 128 / P8G;
        P8_LOAD(ua4, ua2, va4, va2, 0);
#pragma unroll 1
        for (int g = 0; g < NG; g += 2) {
            P8_LOAD(ub4, ub2, vb4, vb2, g + 1);
            P8_PROC(ua4, ua2, va4, va2, g);
            if (g + 2 < NG) P8_LOAD(ua4, ua2, va4, va2, g + 2);
            P8_PROC(ub4, ub2, vb4, vb2, g + 1);
        }
#undef P8_LOAD
#undef P8_PROC
#pragma unroll
        for (int i = 0; i < 8; ++i) {
            const float* op = out + (size_t)t * DM + (i * 64 + lane) * 4; float* dp = dst + (size_t)t * DM + (i * 64 + lane) * 4;
            f32x4 a = *(const f32x4*)op;
            a[0] += acc[4 * i + 0]; a[1] += acc[4 * i + 1]; a[2] += acc[4 * i + 2]; a[3] += acc[4 * i + 3];
            *(f32x4*)dp = a;
        }
    }
}

__global__ void __launch_bounds__(NTHREADS, 2) mega(Params p) {
    extern __shared__ __attribute__((aligned(16))) unsigned char lds_raw[];
    LAS unsigned char* lds = (LAS unsigned char*)lds_raw;
    const int tid = threadIdx.x, lane = tid & 63, wave = __builtin_amdgcn_readfirstlane(tid >> 6);
    const int G = gridDim.x, bx = blockIdx.x;
    const int gw = bx * 8 + wave, NGW = G * 8;
    unsigned char* ws = p.ws;
    const int lo = p.ph_lo, hi = p.ph_hi;
    volatile LAS unsigned* misc = (volatile LAS unsigned*)(lds + LDS_MISC);
    if (tid < 4) misc[tid] = 0u;
    __syncthreads();
    const XcdBarrier xbar = xcd_barrier_post((unsigned*)(ws + WS_CTL), misc);
#ifndef PH_MASK
#define PH_MASK 0x1ff
#endif
#define IN(k) (((PH_MASK >> (k)) & 1) && lo <= (k) && (k) < hi)
#define SEAM(k) do { if (IN(k) && IN((k) + 1)) xcd_barrier(xbar); } while (0)

#if (PROBE_DUP >> 0) & 1
    if (IN(0)) { phase0(p, lds, gw, NGW, wave, lane); xcd_barrier(xbar); }
#endif
    if (IN(0)) phase0(p, lds, gw, NGW, wave, lane);
    SEAM(0);
    if (IN(1)) {
        pg8::Gemm g{(const bf16_t*)(ws + WS_XB), (const bf16_t*)(ws + WS_WIN), S, NINP, DM, DM, DM};
        pg8::StaticOrder So; So.init(S, NINP, G, bx);
        pg8::Epi<1> E{(const float*)(ws + WS_RSTD1), 0.f, (float*)(ws + WS_ROWSS), (bf16_t*)(ws + WS_PROJ), NINP, nullptr, nullptr};
#if (PROBE_DUP >> 1) & 1
        { pg8::Epi<1> E2 = E; E2.ss = (float*)(ws + 512 * 1024); pg8::gemm_phase<pg8::Epi<1>, pg8::StaticOrder, true, true>(lds, g, So, E2); xcd_barrier(xbar); }
#endif
        pg8::gemm_phase<pg8::Epi<1>, pg8::StaticOrder, true, true>(lds, g, So, E);
    }
    SEAM(1);
    if (IN(2)) {
        {
            pg8::Gemm g{(const bf16_t*)(ws + WS_PROJ) + 2048, (const bf16_t*)(ws + WS_WUQ), S, 1536, 512, NINP, 512};
            pg8::StaticOrder So; So.init(S, 1536, G, bx);
            pg8::Epi<2> E{(const float*)(ws + WS_ROWSS) + 1 * S, 1.0f / 512.0f, nullptr, (bf16_t*)(ws + WS_QRAW), 1536, nullptr, nullptr};
            pg8::gemm_phase<pg8::Epi<2>, pg8::StaticOrder, true, true>(lds, g, So, E);
        }
        __syncthreads();
        {
            pg8::Gemm g{(const bf16_t*)(ws + WS_PROJ) + 2560, (const bf16_t*)(ws + WS_WUKV), S, 2048, 256, NINP, 256};
            pg8::StaticOrder So; So.init(S, 2048, G, bx);
            pg8::Epi<2> E{(const float*)(ws + WS_ROWSS) + 2 * S, 1.0f / 256.0f, nullptr, (bf16_t*)(ws + WS_KVRAW), 2048, nullptr, nullptr};
            pg8::gemm_phase<pg8::Epi<2>, pg8::StaticOrder, true, true>(lds, g, So, E);
        }
    }
    SEAM(2);
#if (PROBE_DUP >> 3) & 1
    if (IN(3)) { phase3(p, gw, NGW, lane); xcd_barrier(xbar); }
#endif
    if (IN(3)) phase3(p, gw, NGW, lane);
    SEAM(3);
#define P4_BODY_ATT for (int pr = bx; pr < 256; pr += G) { const int head = pr & 7, x = pr >> 3; attn_unit(p, lds, head, 63 - x, tid, wave, lane); attn_unit(p, lds, head, x, tid, wave, lane); }
#define P4_BODY_GMLP for (int u = bx; u < 512; u += G) gmlp_unit(p, lds, u >> 3, u & 7, tid, wave, lane);
#if (PROBE_DUP >> 4) & 1
    if (IN(4)) { P4_BODY_ATT; xcd_barrier(xbar); }
#endif
#if (PROBE_DUP >> 9) & 1
    if (IN(4)) { P4_BODY_GMLP; xcd_barrier(xbar); }
#endif
    if (IN(4)) { P4_BODY_ATT; P4_BODY_GMLP; }
    SEAM(4);
    if (IN(5)) {
        pg8::Gemm g{(const bf16_t*)(ws + WS_MIX), (const bf16_t*)(ws + WS_WOUT), S, DM, DM, DM, DM};
        pg8::StaticOrder So; So.init(S, DM, G, bx);
        pg8::Epi<4> E{nullptr, 0.f, (float*)(ws + WS_ROWSS) + 3 * S, (bf16_t*)(ws + WS_X1B), DM, p.out, p.in[0]};
#if (PROBE_DUP >> 5) & 1
        { pg8::Epi<4> E2 = E; E2.ss = (float*)(ws + 512 * 1024); pg8::gemm_phase<pg8::Epi<4>, pg8::StaticOrder, true, true>(lds, g, So, E2); xcd_barrier(xbar); }
#endif
        pg8::gemm_phase<pg8::Epi<4>, pg8::StaticOrder, true, true>(lds, g, So, E);
    }
    SEAM(5);
    if (IN(6)) {
        pg8::Gemm g{(const bf16_t*)(ws + WS_X1B), (const bf16_t*)(ws + WS_WS), S, DM, DM, DM, DM};
        pg8::StaticOrder So; So.init(S, DM, G, bx);
        pg8::Epi<5> E{(const float*)(ws + WS_ROWSS) + 3 * S, 1.0f / DM, nullptr, nullptr, DM, (float*)(ws + WS_SC), nullptr};
#if (PROBE_DUP >> 6) & 1
        { pg8::gemm_phase<pg8::Epi<5>, pg8::StaticOrder, true, true>(lds, g, So, E); xcd_barrier(xbar); }
#endif
        pg8::gemm_phase<pg8::Epi<5>, pg8::StaticOrder, true, true>(lds, g, So, E);
    }
    SEAM(6);
#if (PROBE_DUP >> 7) & 1
    if (IN(7)) { phase7(p, lds, gw, NGW, wave, lane); xcd_barrier(xbar); }
#endif
    if (IN(7)) phase7(p, lds, gw, NGW, wave, lane);
    SEAM(7);
#if (PROBE_DUP >> 8) & 1
    if (IN(8)) { phase8(p, (float*)(ws + WS_SC), gw, NGW, lane); xcd_barrier(xbar); }
#endif
    if (IN(8)) phase8(p, p.out, gw, NGW, lane);
#undef IN
#undef SEAM
}

extern "C" void kernel_launch(void* const* d_in, const int* in_sizes, int n_in, void* d_out, int out_size, void* d_ws, size_t ws_size, hipStream_t stream) {
    static int grid = 0;
    if (grid == 0) {
        if (n_in != 18 || out_size != S * DM || ws_size < WS_END) { fprintf(stderr, "kernel_launch: unexpected shapes (n_in %d out %d ws %zu)\n", n_in, out_size, ws_size); grid = -1; return; }
        int dev = 0, cus = 0, per_cu = 0;
        hipGetDevice(&dev);
        hipDeviceGetAttribute(&cus, hipDeviceAttributeMultiprocessorCount, dev);
        if (hipFuncSetAttribute((const void*)mega, hipFuncAttributeMaxDynamicSharedMemorySize, LDS_BYTES) != hipSuccess) { fprintf(stderr, "kernel_launch: hipFuncSetAttribute failed\n"); grid = -1; return; }
        if (hipOccupancyMaxActiveBlocksPerMultiprocessor(&per_cu, (const void*)mega, NTHREADS, LDS_BYTES) != hipSuccess || per_cu < 1) { fprintf(stderr, "kernel_launch: occupancy query failed (%d)\n", per_cu); grid = -1; return; }
        grid = cus;
        fprintf(stderr, "kernel_launch: cus %d per_cu %d grid %d\n", cus, per_cu, grid);
    }
    if (grid < 0) return;
    hipMemsetAsync((char*)d_ws + WS_CTL, 0, 1 * MiB, stream);
    Params prm{};
    for (int i = 0; i < 18; ++i) prm.in[i] = (const float*)d_in[i];
    prm.out = (float*)d_out; prm.ws = (unsigned char*)d_ws;
#if MK_ONE_LAUNCH
    prm.ph_lo = 0; prm.ph_hi = NPH;
    { void* args[] = {&prm}; hipError_t e = hipLaunchCooperativeKernel((const void*)mega, dim3(grid), dim3(NTHREADS), args, LDS_BYTES, stream);
      if (e != hipSuccess) fprintf(stderr, "cooperative launch failed: %s\n", hipGetErrorString(e)); }
#else
    for (int ph = 0; ph < NPH; ++ph) {
        prm.ph_lo = ph; prm.ph_hi = ph + 1;
        void* args[] = {&prm};
        hipError_t e = hipLaunchCooperativeKernel((const void*)mega, dim3(grid), dim3(NTHREADS), args, LDS_BYTES, stream);
        if (e != hipSuccess) { fprintf(stderr, "cooperative launch %d failed: %s\n", ph, hipGetErrorString(e)); break; }
    }
#endif
}
```

```cpp
#include <hip/hip_runtime.h>
#include <cstdio>
#include <cstdint>

#define LAS __attribute__((address_space(3)))
typedef unsigned short bf16_t;
typedef short bf16x8 __attribute__((ext_vector_type(8)));
typedef short s16x4 __attribute__((ext_vector_type(4)));
typedef float f32x4 __attribute__((ext_vector_type(4)));
typedef float f32x16 __attribute__((ext_vector_type(16)));
typedef unsigned u32x4 __attribute__((ext_vector_type(4)));
typedef unsigned u32x2 __attribute__((ext_vector_type(2)));

#ifndef PROBE_DUP
#define PROBE_DUP 0
#endif
#ifndef MK_ONE_LAUNCH
#define MK_ONE_LAUNCH 1
#endif

constexpr int S = 8192, DM = 2048, NIN = 2880, NINP = 3072;
constexpr int NPH = 9;
constexpr float EPS = 1e-6f;
constexpr int LDS_BYTES = 147456;
constexpr int NTHREADS = 512;
constexpr int LDS_MISC = 131072 + 1024;

constexpr size_t MiB = 1u << 20;
constexpr size_t WS_CTL = 0;
constexpr size_t WS_ROWSS = 128 * 1024;
constexpr size_t WS_COS = 1 * MiB, WS_SIN = 2 * MiB;
constexpr size_t WS_RSTD1 = 3 * MiB;
constexpr size_t WS_EXP = 4 * MiB;
constexpr size_t WS_GATE = 8 * MiB;
constexpr size_t WS_WIN = 12 * MiB;
constexpr size_t WS_WUQ = 24 * MiB;
constexpr size_t WS_WUKV = 26 * MiB;
constexpr size_t WS_WOUT = 28 * MiB;
constexpr size_t WS_WS = 36 * MiB;
constexpr size_t WS_XB = 44 * MiB;
constexpr size_t WS_PROJ = 76 * MiB;
constexpr size_t WS_QRAW = 124 * MiB;
constexpr size_t WS_KVRAW = 148 * MiB;
constexpr size_t WS_QH = 180 * MiB;
constexpr size_t WS_KH = 204 * MiB;
constexpr size_t WS_VH = 228 * MiB;
constexpr size_t WS_MIX = 244 * MiB;
constexpr size_t WS_X1B = 276 * MiB;
constexpr size_t WS_SC = 308 * MiB;
constexpr size_t WS_UT = 372 * MiB;
constexpr size_t WS_VT = 436 * MiB;
constexpr size_t WS_END = 500 * MiB;

__device__ __forceinline__ unsigned f2bf(float f) { unsigned u = __builtin_bit_cast(unsigned, f); return (u + 0x7fffu + ((u >> 16) & 1u)) >> 16; }
__device__ __forceinline__ unsigned pk2(float lo, float hi) { return f2bf(lo) | (f2bf(hi) << 16); }
__device__ __forceinline__ float bf2f(unsigned short b) { return __builtin_bit_cast(float, (unsigned)b << 16); }
__device__ __forceinline__ float bflo(unsigned w) { return __builtin_bit_cast(float, w << 16); }
__device__ __forceinline__ float bfhi(unsigned w) { return __builtin_bit_cast(float, w & 0xffff0000u); }
__device__ __forceinline__ float wave_sum(float v) {
#pragma unroll
    for (int o = 32; o > 0; o >>= 1) v += __shfl_xor(v, o);
    return v;
}
__device__ __forceinline__ float wave_max(float v) {
#pragma unroll
    for (int o = 32; o > 0; o >>= 1) v = fmaxf(v, __shfl_xor(v, o));
    return v;
}
__device__ __forceinline__ float gelu_tanh(float x) {
    const float y = 0.7978845608028654f * (x + 0.044715f * x * x * x);
    return x / (1.0f + __expf(-2.0f * y));
}
__device__ __forceinline__ int crow(int r, int hi) { return (r & 3) + 8 * (r >> 2) + 4 * hi; }
#define LDS_WAIT() asm volatile("s_waitcnt lgkmcnt(0)" ::: "memory")
#define SBAR() __builtin_amdgcn_sched_barrier(0)

namespace pg8 {
#define PG8_LAS __attribute__((address_space(3)))
constexpr int BM = 256, BK = 64, HALF = 128, HTB = HALF * BK * 2  , STAGE_BYTES = 8 * HTB, NXCD = 8, WGM = 8;

__host__ __device__ __forceinline__ int lds_byte(int r, int c) { const int st = (r >> 4) * 2 + (c >> 5), rr = r & 15, cc = c & 31, ob = rr * 64 + cc * 2; return st * 1024 + (ob ^ (((ob >> 9) & 1) << 5)); }
__host__ __device__ __forceinline__ void stage_rc(int b, int& R, int& C) { const int st = b / 1024, sb = b % 1024, swz = sb ^ (((sb >> 9) & 1) << 5); R = (st >> 1) * 16 + swz / 64; C = (st & 1) * 32 + (swz % 64) / 2; }
__host__ __device__ __forceinline__ int perm32(int rho) { const int n = rho >> 4, i = rho & 15; return 8 * (i >> 2) + 4 * n + (i & 3); }

struct Unit { int pm, pn; };
struct Gemm { const bf16_t* A; const bf16_t* Bt; int M, N, K, lda, ldb; };

struct StaticOrder {
    int nM, nN, nwg, G, c;
    __host__ __device__ void init(int M, int N, int G_, int c_) { nM = M / BM; nN = N / BM; nwg = nM * nN; G = G_; c = c_; }
    __host__ __device__ bool next(int i, Unit& u) const {
        const long L = (long)i * G + c; if (L >= nwg) return false;
        int wgid = (int)L; { const int q = nwg / NXCD, r = nwg % NXCD, xcd = wgid % NXCD, off = wgid / NXCD; wgid = (xcd < r ? xcd * (q + 1) : r * (q + 1) + (xcd - r) * q) + off; }
        const int nig = WGM * nN, gid = wgid / nig, fm = gid * WGM, gsz = (nM - fm) < WGM ? (nM - fm) : WGM;
        u.pm = fm + ((wgid % nig) % gsz); u.pn = (wgid % nig) / gsz; return true;
    }
    __device__ __forceinline__ void a_ready(const Unit&) const {}
    __device__ __forceinline__ void done(const Unit&) const {}
};

template <class Epi, class Sched, bool ALIGN_EPI = false, bool SP2 = false>
__device__ __forceinline__ void gemm_phase(PG8_LAS unsigned char* lds, const Gemm g, const Sched& S, const Epi& E) {
    const int tid = threadIdx.x, wid = __builtin_amdgcn_readfirstlane(tid >> 6), lane = tid & 63, wr = wid >> 2, wc = wid & 3, fr = lane & 15, fq = lane >> 4;
    const int K = g.K, nt = K / BK;
    unsigned voffA[2], voffB[2];
#pragma unroll
    for (int i = 0; i < 2; ++i) { int R, C; stage_rc(tid * 16 + i * 8192, R, C); const int Rb = Epi::PERM ? ((R & ~31) + perm32(R & 31)) : R;
        voffA[i] = (unsigned)(R * g.lda + C) * 2u; voffB[i] = (unsigned)(Rb * g.ldb + C) * 2u; }
    const size_t kstep = (size_t)(BK * 2);
    const size_t hstepA = (size_t)HALF * g.lda * 2, hstepB = (size_t)HALF * g.ldb * 2;
    const size_t tstepA = 2 * hstepA, tstepB = 2 * hstepB;
    const unsigned ldsw = (unsigned)wid * 1024u;
    const int aoff = lds_byte(wr * 64 + fr, fq * 8), boff = lds_byte(wc * 32 + fr, fq * 8);
#define PG8_SA(b, h) (((b) * 2 + (h)) * HTB)
#define PG8_SB(b, h) ((4 + (b) * 2 + (h)) * HTB)
#define PG8_STAGE(bufoff, gbase, voff) do { _Pragma("unroll") for (int _i = 0; _i < 2; ++_i) \
        __builtin_amdgcn_global_load_lds((const unsigned*)((const char*)(gbase) + (voff)[_i]), (PG8_LAS unsigned*)(lds + (bufoff) + ldsw + _i * 8192), 16, 0, 0); } while (0)
#define PG8_LDA(dst, b, h) do { _Pragma("unroll") for (int m = 0; m < 4; ++m) _Pragma("unroll") for (int k = 0; k < 2; ++k) dst[m][k] = *(const PG8_LAS bf16x8*)(lds + PG8_SA(b, h) + aoff + m * 2048 + k * 1024); } while (0)
#define PG8_LDB(dst, b, h) do { _Pragma("unroll") for (int n = 0; n < 2; ++n) _Pragma("unroll") for (int k = 0; k < 2; ++k) dst[n][k] = *(const PG8_LAS bf16x8*)(lds + PG8_SB(b, h) + boff + n * 2048 + k * 1024); } while (0)
#define PG8_MMA(ai, bj, At, Bt) do { __builtin_amdgcn_s_setprio(1); _Pragma("unroll") for (int m = 0; m < 4; ++m) _Pragma("unroll") for (int n = 0; n < 2; ++n) _Pragma("unroll") for (int k = 0; k < 2; ++k) \
        acc[ai][bj][m][n] = __builtin_amdgcn_mfma_f32_16x16x32_bf16(Bt[n][k], At[m][k], acc[ai][bj][m][n], 0, 0, 0); __builtin_amdgcn_s_setprio(0); } while (0)
#define PG8_WAIT_V(n) asm volatile("s_waitcnt vmcnt(" #n ")" ::: "memory")
#define PG8_WAIT_L(n) asm volatile("s_waitcnt lgkmcnt(" #n ")" ::: "memory")
#define PG8_BAR __builtin_amdgcn_s_barrier()
#define PG8_SCHED __builtin_amdgcn_sched_barrier(0)
    Unit cur, nxt; int ui = 0;
    if (!S.next(0, cur)) return;
    f32x4 acc[2][2][4][2];
#pragma unroll
    for (int a = 0; a < 2; ++a)
#pragma unroll
        for (int b = 0; b < 2; ++b)
#pragma unroll
            for (int m = 0; m < 4; ++m)
#pragma unroll
                for (int n = 0; n < 2; ++n) acc[a][b][m][n] = (f32x4){0.f, 0.f, 0.f, 0.f};
    bf16x8 At[4][2], B0[2][2], B1[2][2];
    const char* cA = (const char*)g.A + (size_t)cur.pm * tstepA; const char* cB = (const char*)g.Bt + (size_t)cur.pn * tstepB;
    S.a_ready(cur);
    if constexpr (SP2) {
        PG8_STAGE(PG8_SB(0, 0), cB, voffB); PG8_STAGE(PG8_SB(0, 1), cB + hstepB, voffB); PG8_STAGE(PG8_SA(0, 0), cA, voffA); PG8_STAGE(PG8_SA(0, 1), cA + hstepA, voffA);
        if (wr == 1) PG8_BAR;
        PG8_WAIT_V(2); PG8_BAR;
        PG8_STAGE(PG8_SB(1, 0), cB + kstep, voffB); PG8_STAGE(PG8_SA(1, 0), cA + kstep, voffA); PG8_STAGE(PG8_SB(1, 1), cB + hstepB + kstep, voffB);
        PG8_WAIT_V(6); PG8_BAR;
    } else {
        PG8_STAGE(PG8_SB(0, 0), cB, voffB); PG8_STAGE(PG8_SA(0, 0), cA, voffA); PG8_STAGE(PG8_SB(0, 1), cB + hstepB, voffB); PG8_STAGE(PG8_SA(0, 1), cA + hstepA, voffA);
        if (wr == 1) PG8_BAR;
        PG8_WAIT_V(4); PG8_BAR;
        PG8_STAGE(PG8_SB(1, 0), cB + kstep, voffB); PG8_STAGE(PG8_SA(1, 0), cA + kstep, voffA); PG8_STAGE(PG8_SB(1, 1), cB + hstepB + kstep, voffB);
        PG8_WAIT_V(6); PG8_BAR;
    }
    for (;;) {
        const bool has_next = S.next(ui + 1, nxt);
        const char* nA = has_next ? (const char*)g.A + (size_t)nxt.pm * tstepA : cA; const char* nB = has_next ? (const char*)g.Bt + (size_t)nxt.pn * tstepB : cB;
        for (int t = 0; t < nt; t += 2) {
            const bool last = (t == nt - 2);
            const char* a1 = cA + (size_t)(t + 1) * kstep;
            const char* a2 = last ? nA : cA + (size_t)(t + 2) * kstep; const char* b2 = last ? nB : cB + (size_t)(t + 2) * kstep;
            const char* a3 = a2 + kstep; const char* b3 = b2 + kstep;
            if (last && has_next) S.a_ready(nxt);
            if constexpr (SP2) {
            PG8_LDB(B0, 0, 0); PG8_LDB(B1, 0, 1); PG8_SCHED; PG8_LDA(At, 0, 0); PG8_STAGE(PG8_SA(1, 1), a1 + hstepA, voffA);
            PG8_WAIT_V(8); PG8_WAIT_L(0); PG8_BAR; PG8_MMA(0, 0, At, B0); PG8_MMA(0, 1, At, B1); PG8_BAR; PG8_SCHED;
            PG8_LDA(At, 0, 1); PG8_STAGE(PG8_SB(0, 0), b2, voffB); PG8_STAGE(PG8_SB(0, 1), b2 + hstepB, voffB); PG8_STAGE(PG8_SA(0, 0), a2, voffA);
            PG8_WAIT_V(8); PG8_WAIT_L(0); PG8_BAR; PG8_MMA(1, 0, At, B0); PG8_MMA(1, 1, At, B1); PG8_BAR; PG8_SCHED;
            PG8_LDB(B0, 1, 0); PG8_LDB(B1, 1, 1); PG8_SCHED; PG8_LDA(At, 1, 0); PG8_STAGE(PG8_SA(0, 1), a2 + hstepA, voffA);
            PG8_WAIT_V(8); PG8_WAIT_L(0); PG8_BAR; PG8_MMA(0, 0, At, B0); PG8_MMA(0, 1, At, B1); PG8_BAR; PG8_SCHED;
            PG8_LDA(At, 1, 1); PG8_STAGE(PG8_SB(1, 0), b3, voffB); PG8_STAGE(PG8_SB(1, 1), b3 + hstepB, voffB); PG8_STAGE(PG8_SA(1, 0), a3, voffA);
            PG8_WAIT_V(8); PG8_WAIT_L(0); PG8_BAR; PG8_MMA(1, 0, At, B0); PG8_MMA(1, 1, At, B1); PG8_BAR; PG8_SCHED;
            } else {
            PG8_LDB(B0, 0, 0); PG8_SCHED; PG8_LDA(At, 0, 0); PG8_STAGE(PG8_SA(1, 1), a1 + hstepA, voffA);
            PG8_WAIT_L(8); PG8_BAR; PG8_WAIT_L(0); PG8_MMA(0, 0, At, B0); PG8_BAR; PG8_SCHED;
            PG8_LDB(B1, 0, 1); PG8_STAGE(PG8_SB(0, 0), b2, voffB);
            PG8_BAR; PG8_WAIT_L(0); PG8_MMA(0, 1, At, B1); PG8_BAR;
            PG8_LDA(At, 0, 1); PG8_STAGE(PG8_SA(0, 0), a2, voffA);
            PG8_BAR; PG8_WAIT_L(0); PG8_MMA(1, 0, At, B0); PG8_BAR; PG8_SCHED;
            PG8_STAGE(PG8_SB(0, 1), b2 + hstepB, voffB);
            PG8_WAIT_V(6); PG8_BAR; PG8_MMA(1, 1, At, B1); PG8_BAR;
            PG8_LDB(B0, 1, 0); PG8_SCHED; PG8_LDA(At, 1, 0); PG8_STAGE(PG8_SA(0, 1), a2 + hstepA, voffA);
            PG8_WAIT_L(8); PG8_BAR; PG8_WAIT_L(0); PG8_MMA(0, 0, At, B0); PG8_BAR; PG8_SCHED;
            PG8_LDB(B1, 1, 1); PG8_STAGE(PG8_SB(1, 0), b3, voffB);
            PG8_BAR; PG8_WAIT_L(0); PG8_MMA(0, 1, At, B1); PG8_BAR;
            PG8_LDA(At, 1, 1); PG8_STAGE(PG8_SA(1, 0), a3, voffA);
            PG8_BAR; PG8_WAIT_L(0); PG8_MMA(1, 0, At, B0); PG8_BAR; PG8_SCHED;
            PG8_STAGE(PG8_SB(1, 1), b3 + hstepB, voffB);
            PG8_WAIT_V(6); PG8_BAR; PG8_MMA(1, 1, At, B1); PG8_BAR;
            }
        }
        if constexpr (ALIGN_EPI) { if (wr == 0) PG8_BAR; }
        if constexpr (!Epi::AFTER_DRAIN) { E(acc, cur, wr, wc, fr, fq); S.done(cur); }
        if (!has_next) break;
#pragma unroll
        for (int a = 0; a < 2; ++a)
#pragma unroll
            for (int b = 0; b < 2; ++b)
#pragma unroll
                for (int m = 0; m < 4; ++m)
#pragma unroll
                    for (int n = 0; n < 2; ++n) acc[a][b][m][n] = (f32x4){0.f, 0.f, 0.f, 0.f};
        cur = nxt; cA = nA; cB = nB; ++ui;
        if constexpr (ALIGN_EPI) { if (wr == 1) PG8_BAR; }
    }
    PG8_WAIT_V(0);
    if constexpr (!ALIGN_EPI) { if (wr == 0) PG8_BAR; }
    PG8_BAR;
#undef PG8_SA
#undef PG8_SB
#undef PG8_STAGE
#undef PG8_LDA
#undef PG8_LDB
#undef PG8_MMA
#undef PG8_WAIT_V
#undef PG8_WAIT_L
#undef PG8_BAR
#undef PG8_SCHED
}

template <int MODE> struct Epi {
    static constexpr bool PERM = false, AFTER_DRAIN = false;
    const float* rowsrc; float inv_n; float* ss; bf16_t* ob; int ldc; float* of; const float* xin;
    __device__ __forceinline__ void operator()(const f32x4 (&acc)[2][2][4][2], const Unit& u, int wr, int wc, int fr, int fq) const {
#pragma unroll
        for (int ai = 0; ai < 2; ++ai)
#pragma unroll
            for (int m = 0; m < 4; ++m) {
                const int row = u.pm * BM + ai * HALF + wr * 64 + m * 16 + fr;
                float rs = 1.f;
                if (MODE == 1) rs = rowsrc[row];
                if (MODE == 2 || MODE == 5) rs = rsqrtf(rowsrc[row] * inv_n + EPS);
                float ssq = 0.f;
#pragma unroll
                for (int bj = 0; bj < 2; ++bj)
#pragma unroll
                    for (int n = 0; n < 2; ++n) {
                        const int col = u.pn * BM + bj * HALF + wc * 32 + n * 16 + fq * 4;
                        f32x4 v = acc[ai][bj][m][n] * rs;
                        if (MODE == 1) { if (u.pn < 8) { v[0] = gelu_tanh(v[0]); v[1] = gelu_tanh(v[1]); v[2] = gelu_tanh(v[2]); v[3] = gelu_tanh(v[3]); } }
                        if (MODE == 4) { const f32x4 xr = *(const f32x4*)(xin + (size_t)row * DM + col); v = v + xr; }
                        if (MODE == 1 || MODE == 4) ssq += (v[0] * v[0] + v[1] * v[1]) + (v[2] * v[2] + v[3] * v[3]);
                        if (MODE == 1 || MODE == 2 || MODE == 4) { u32x2 w; w.x = pk2(v[0], v[1]); w.y = pk2(v[2], v[3]); *(u32x2*)(ob + (size_t)row * ldc + col) = w; }
                        if (MODE == 4 || MODE == 5) *(f32x4*)(of + (size_t)row * DM + col) = v;
                    }
                if (MODE == 1) {
                    const int seg = (u.pn >= 4 && u.pn < 8) ? 0 : ((u.pn == 8 || u.pn == 9) ? 1 : (u.pn == 10 ? 2 : -1));
                    if (seg >= 0) { ssq += __shfl_xor(ssq, 16); ssq += __shfl_xor(ssq, 32); if (fq == 0) atomicAdd(ss + seg * S + row, ssq); }
                }
                if (MODE == 4) { ssq += __shfl_xor(ssq, 16); ssq += __shfl_xor(ssq, 32); if (fq == 0) atomicAdd(ss + row, ssq); }
            }
    }
};
}

#define XB_TMO      128
#define XB_XCNT(j)  (256  + 64 * (j))
#define XB_XSUB(j)  (1280 + 64 * (j))
#define XB_XGEN(j)  (2304 + 64 * (j))
#define XB_TOP      3328
#define XB_TOPGEN   3392
#define XCD_BAR_WORDS 3456
#define XB_SPIN_CAP (1u << 18)
__device__ __forceinline__ unsigned xb_ld(unsigned* p)              { return __hip_atomic_load(p, __ATOMIC_RELAXED, __HIP_MEMORY_SCOPE_AGENT); }
__device__ __forceinline__ unsigned xb_add(unsigned* p, unsigned v) { return __hip_atomic_fetch_add(p, v, __ATOMIC_RELAXED, __HIP_MEMORY_SCOPE_AGENT); }
__device__ __forceinline__ unsigned xb_xcc_id() { return (unsigned)__builtin_amdgcn_s_getreg((3 << 11) | 20) & 0xFu; }
#define XB_SPIN(cond, bar) do { unsigned _sp = 0; while (cond) { __builtin_amdgcn_s_sleep(1); \
    if ((++_sp & 255u) == 0u) { if (xb_ld(&(bar)[XB_TMO])) break; if (_sp > XB_SPIN_CAP) { atomicAdd(&(bar)[XB_TMO], 1u); break; } } } } while (0)
struct XcdBarrier { unsigned* bar; unsigned x; volatile LAS unsigned* st; };
__device__ __forceinline__ XcdBarrier xcd_barrier_post(unsigned* bar, volatile LAS unsigned* st) {
    XcdBarrier b; b.bar = bar; b.x = xb_xcc_id(); b.st = st;
    if (threadIdx.x == 0) (void)xb_add(&bar[XB_XCNT(b.x)], 1u);
    return b;
}
__device__ __forceinline__ void xcd_barrier_complete(unsigned* bar, unsigned x, unsigned& nloc, unsigned& nx) {
    const unsigned G = gridDim.x * gridDim.y * gridDim.z;
    unsigned sum, cnt, mine, sp = 0u;
    for (;;) {
        sum = 0u; cnt = 0u; mine = 0u;
#pragma unroll
        for (unsigned j = 0; j < 16; ++j) { const unsigned c = xb_ld(&bar[XB_XCNT(j)]); sum += c; cnt += (c > 0u) ? 1u : 0u; mine = (j == x) ? c : mine; }
        if (sum == G) break;
        __builtin_amdgcn_s_sleep(1);
        if ((++sp & 255u) == 0u) { if (xb_ld(&bar[XB_TMO])) break; if (sp > XB_SPIN_CAP) { atomicAdd(&bar[XB_TMO], 1u); break; } }
    }
    nloc = mine > 0u ? mine : 1u; nx = cnt > 0u ? cnt : 1u;
}
__device__ __forceinline__ void xcd_barrier(const XcdBarrier& b) {
    asm volatile("s_waitcnt vmcnt(0)" ::: "memory");
    __syncthreads();
    if (threadIdx.x == 0) {
        unsigned* bar = b.bar;
        __builtin_amdgcn_s_waitcnt(0);
        unsigned nloc = b.st[0], nx = b.st[1];
        if (nloc == 0u) { xcd_barrier_complete(bar, b.x, nloc, nx); b.st[0] = nloc; b.st[1] = nx; }
        const unsigned old = xb_add(&bar[XB_XSUB(b.x)], 1u);
        const unsigned gen = old / nloc;
        if (old + 1u == (gen + 1u) * nloc) {
            __builtin_amdgcn_fence(__ATOMIC_RELEASE, "agent");
            asm volatile("s_waitcnt vmcnt(0)" ::: "memory");
            const unsigned og = xb_add(&bar[XB_TOP], 1u);
            const unsigned tg = og / nx;
            if (og + 1u == (tg + 1u) * nx) xb_add(&bar[XB_TOPGEN], 1u);
            else XB_SPIN(xb_ld(&bar[XB_TOPGEN]) == tg, bar);
            __builtin_amdgcn_fence(__ATOMIC_ACQUIRE, "agent");
            xb_add(&bar[XB_XGEN(b.x)], 1u);
            asm volatile("s_waitcnt vmcnt(0)" ::: "memory");
        } else {
            XB_SPIN(xb_ld(&bar[XB_XGEN(b.x)]) == gen, bar);
            __builtin_amdgcn_fence(__ATOMIC_ACQUIRE, "agent");
            asm volatile("s_waitcnt vmcnt(0)" ::: "memory");
        }
    }
    __syncthreads();
}

struct Params {
    const float* in[18];
    float* out;
    unsigned char* ws;
    int ph_lo, ph_hi;
};

__device__ __forceinline__ void p0_transpose_item(const float* W, const float* g, int K, int N, bf16_t* WT, LAS float* scr, int item, int lane) {
    const int nblk = N / 32, kb = item / nblk, nb = item % nblk, k0 = 64 * kb, n0 = 32 * nb;
#pragma unroll 8
    for (int i = 0; i < 32; ++i) { const int kk = 2 * i + (lane >> 5); const float gv = g ? g[k0 + kk] : 1.f;
        scr[kk * 33 + (lane & 31)] = W[(size_t)(k0 + kk) * N + n0 + (lane & 31)] * gv; }
    LDS_WAIT(); asm volatile("" ::: "memory");
    const int c = lane & 7;
#pragma unroll
    for (int j = 0; j < 4; ++j) { const int n = (lane >> 3) + 8 * j; const LAS float* s = scr + (8 * c) * 33 + n;
        u32x4 o; o.x = pk2(s[0 * 33], s[1 * 33]); o.y = pk2(s[2 * 33], s[3 * 33]); o.z = pk2(s[4 * 33], s[5 * 33]); o.w = pk2(s[6 * 33], s[7 * 33]);
        *(u32x4*)(WT + (size_t)(n0 + n) * K + k0 + 8 * c) = o; }
    LDS_WAIT(); asm volatile("" ::: "memory");
}
__device__ __forceinline__ float row_to_bf16(const float* src, const float* g, bf16_t* dst, int lane) {
    float ss = 0.f;
#pragma unroll
    for (int i = 0; i < 8; ++i) {
        const int c = (i * 64 + lane) * 4;
        f32x4 v = *(const f32x4*)(src + c);
        ss += (v[0] * v[0] + v[1] * v[1]) + (v[2] * v[2] + v[3] * v[3]);
        if (g) { const f32x4 gv = *(const f32x4*)(g + c); v = v * gv; }
        u32x2 w; w.x = pk2(v[0], v[1]); w.y = pk2(v[2], v[3]);
        *(u32x2*)(dst + c) = w;
    }
    return ss;
}
constexpr float PEER_USC = 80.0f, PEER_VSC = 5.0f;
constexpr int PEER_ROWB = 1536;
typedef float f32x16v __attribute__((ext_vector_type(16)));
typedef float f32x32v __attribute__((ext_vector_type(32)));
typedef unsigned u32x6 __attribute__((ext_vector_type(6)));
__device__ __forceinline__ void row_to_fp6(const float* src, const float* g, float scale, unsigned char* dst, int lane) {
    f32x16v a, b;
#pragma unroll
    for (int i = 0; i < 8; ++i) {
        f32x4 x = *(const f32x4*)(src + (i * 64 + lane) * 4) * scale;
        if (g) { const f32x4 gv = *(const f32x4*)(g + (i * 64 + lane) * 4); x = x * gv; }
#pragma unroll
        for (int q = 0; q < 4; ++q) { const float c = fminf(fmaxf(x[q], -7.5f), 7.5f); const int sl = 4 * i + q; if ((sl & 1) == 0) a[sl >> 1] = c; else b[sl >> 1] = c; }
    }
    const u32x6 pk = __builtin_amdgcn_cvt_scalef32_2xpk16_fp6_f32(a, b, 1.0f);
    *(u32x4*)(dst + lane * 16) = (u32x4){pk[0], pk[1], pk[2], pk[3]};
    *(u32x2*)(dst + 1024 + lane * 8) = (u32x2){pk[4], pk[5]};
}
__device__ __forceinline__ bf16x8 cvt8(const float* p) {
    const f32x4 a = *(const f32x4*)p, b = *(const f32x4*)(p + 4);
    u32x4 w; w.x = pk2(a[0], a[1]); w.y = pk2(a[2], a[3]); w.z = pk2(b[0], b[1]); w.w = pk2(b[2], b[3]);
    return __builtin_bit_cast(bf16x8, w);
}

__device__ __forceinline__ void phase0(const Params& p, LAS unsigned char* lds, int gw, int NGW, int wave, int lane) {
    unsigned char* ws = p.ws;
    LAS float* scr = (LAS float*)(lds + wave * 16384);
    const float* x = p.in[0];
    {
        constexpr int I_IN = (DM / 64) * (NIN / 32), I_UQ = (512 / 64) * (1536 / 32), I_UKV = (256 / 64) * (2048 / 32), I_OUT = (DM / 64) * (DM / 32);
        constexpr int NIT = I_IN + I_UQ + I_UKV + I_OUT;
        for (int it = gw; it < NIT; it += NGW) {
            int r = it;
            if (r < I_IN) { p0_transpose_item(p.in[2], p.in[1], DM, NIN, (bf16_t*)(ws + WS_WIN), scr, r, lane); continue; } r -= I_IN;
            if (r < I_UQ) { p0_transpose_item(p.in[7], p.in[6], 512, 1536, (bf16_t*)(ws + WS_WUQ), scr, r, lane); continue; } r -= I_UQ;
            if (r < I_UKV) { p0_transpose_item(p.in[9], p.in[8], 256, 2048, (bf16_t*)(ws + WS_WUKV), scr, r, lane); continue; } r -= I_UKV;
            p0_transpose_item(p.in[12], nullptr, DM, DM, (bf16_t*)(ws + WS_WOUT), scr, r, lane);
        }
    }
    for (int r = gw; r < NINP - NIN; r += NGW) {
        bf16_t* d = (bf16_t*)(ws + WS_WIN) + (size_t)(NIN + r) * DM;
#pragma unroll
        for (int i = 0; i < 4; ++i) *(u32x4*)(d + (i * 64 + lane) * 8) = (u32x4){0u, 0u, 0u, 0u};
    }
    {
        const float* wq = p.in[14]; const float* sk = p.in[15]; const float* g2 = p.in[13];
        bf16_t* WsT = (bf16_t*)(ws + WS_WS);
        const int r32 = lane & 31, hh = lane >> 5;
        for (int it = gw; it < 16 * 4 * 64; it += NGW) {
            const int hp = it >> 8, kb = (it >> 6) & 3, nb = it & 63;
            f32x16 acc = {};
            const float* ap = sk + ((size_t)(hp * 128 + kb * 32 + r32)) * 128 + hh * 8;
            const float* bp = wq + ((size_t)(nb * 32 + r32)) * DM + hp * 128 + hh * 8;
#pragma unroll
            for (int s = 0; s < 8; ++s) {
                const bf16x8 a = cvt8(ap + s * 16), b = cvt8(bp + s * 16);
                acc = __builtin_amdgcn_mfma_f32_32x32x16_bf16(a, b, acc, 0, 0, 0);
            }
            const int kcol = nb * 32 + r32; const float gk = g2[kcol];
#pragma unroll
            for (int r = 0; r < 16; ++r) WsT[(size_t)(hp * 128 + kb * 32 + crow(r, hh)) * DM + kcol] = (bf16_t)f2bf(acc[r] * gk);
        }
    }
    {
        bf16_t* xb = (bf16_t*)(ws + WS_XB); float* rstd1 = (float*)(ws + WS_RSTD1);
        for (int t = gw; t < S; t += NGW) {
            float ss = row_to_bf16(x + (size_t)t * DM, nullptr, xb + (size_t)t * DM, lane);
            ss = wave_sum(ss);
            if (lane == 0) rstd1[t] = rsqrtf(ss * (1.0f / DM) + EPS);
        }
    }
    {
        unsigned char* UT = ws + WS_UT; unsigned char* VT = ws + WS_VT;
        for (int e = gw; e < 2 * 16384; e += NGW) {
            if (e < 16384) row_to_fp6(p.in[16] + (size_t)e * DM, p.in[13], PEER_USC, UT + (size_t)e * PEER_ROWB, lane);
            else row_to_fp6(p.in[17] + (size_t)(e - 16384) * DM, nullptr, PEER_VSC, VT + (size_t)(e - 16384) * PEER_ROWB, lane);
        }
    }
    {
        float* ct = (float*)(ws + WS_COS); float* st = (float*)(ws + WS_SIN);
        for (int it = gw; it < S * 32 / 64; it += NGW) {
            const int idx = it * 64 + lane, t = idx >> 5, j = idx & 31;
            const float inv_freq = powf(10000.0f, -(float)j / 32.0f);
            const float ang = (float)t * inv_freq;
            ct[idx] = cosf(ang); st[idx] = sinf(ang);
        }
    }
}

__device__ __forceinline__ void phase3(const Params& p, int gw, int NGW, int lane) {
    unsigned char* ws = p.ws;
    const bf16_t* qraw = (const bf16_t*)(ws + WS_QRAW); const bf16_t* kvraw = (const bf16_t*)(ws + WS_KVRAW); const bf16_t* proj = (const bf16_t*)(ws + WS_PROJ);
    bf16_t* Qh = (bf16_t*)(ws + WS_QH); bf16_t* Kh = (bf16_t*)(ws + WS_KH); bf16_t* Vh = (bf16_t*)(ws + WS_VH);
    const float* ct = (const float*)(ws + WS_COS); const float* st = (const float*)(ws + WS_SIN);
    const float* gq = p.in[10]; const float* gk = p.in[11];
    const float gq0 = gq[lane], gq1 = gq[64 + lane], gq2 = gq[128 + lane], gk0 = gk[lane], gk1 = gk[64 + lane], gk2 = gk[128 + lane];
    constexpr float QS = 0.07216878364870322f * 1.4426950408889634f;
    for (int t = gw; t < S; t += NGW) {
        const float cs = ct[t * 32 + (lane & 31)], sn = st[t * 32 + (lane & 31)];
        const float kr = bf2f(proj[(size_t)t * NINP + 2816 + lane]);
#pragma unroll
        for (int h = 0; h < 8; ++h) {
            const bf16_t* qp = qraw + (size_t)t * 1536 + h * 192;
            float q0 = bf2f(qp[lane]), q1 = bf2f(qp[64 + lane]), q2 = bf2f(qp[128 + lane]);
            float ss = wave_sum(q0 * q0 + q1 * q1 + q2 * q2);
            float rs = rsqrtf(ss * (1.0f / 192.0f) + EPS);
            q0 *= rs * gq0; q1 *= rs * gq1; q2 *= rs * gq2;
            float pr = __shfl_xor(q2, 32);
            q2 = (lane < 32) ? (q2 * cs - pr * sn) : (pr * sn + q2 * cs);
            bf16_t* qo = Qh + ((size_t)h * S + t) * 192;
            qo[lane] = (bf16_t)f2bf(q0 * QS); qo[64 + lane] = (bf16_t)f2bf(q1 * QS); qo[128 + lane] = (bf16_t)f2bf(q2 * QS);
            const bf16_t* kp = kvraw + (size_t)t * 2048 + h * 256;
            float k0 = bf2f(kp[lane]), k1 = bf2f(kp[64 + lane]), k2 = kr;
            ss = wave_sum(k0 * k0 + k1 * k1 + k2 * k2);
            rs = rsqrtf(ss * (1.0f / 192.0f) + EPS);
            k0 *= rs * gk0; k1 *= rs * gk1; k2 *= rs * gk2;
            pr = __shfl_xor(k2, 32);
            k2 = (lane < 32) ? (k2 * cs - pr * sn) : (pr * sn + k2 * cs);
            bf16_t* ko = Kh + ((size_t)h * S + t) * 192;
            ko[lane] = (bf16_t)f2bf(k0); ko[64 + lane] = (bf16_t)f2bf(k1); ko[128 + lane] = (bf16_t)f2bf(k2);
            bf16_t* vo = Vh + ((size_t)h * S + t) * 128;
            vo[lane] = kp[128 + lane]; vo[64 + lane] = kp[192 + lane];
        }
    }
}

constexpr int KP = 400, VP = 320;
constexpr int ATT_BUF = 64 * KP + 64 * VP;
template <int OFF> __device__ __forceinline__ s16x4 tr_read(unsigned addr) {
    s16x4 r; asm volatile("ds_read_b64_tr_b16 %0, %1 offset:%2" : "=&v"(r) : "v"(addr), "i"(OFF) : "memory"); return r;
}
__device__ __forceinline__ unsigned cvtpk(float lo, float hi) { unsigned r; asm volatile("v_cvt_pk_bf16_f32 %0, %1, %2" : "=v"(r) : "v"(lo), "v"(hi)); return r; }
#define PK8(L, H) ((bf16x8){L[0], L[1], L[2], L[3], H[0], H[1], H[2], H[3]})
constexpr float ATT_THR = 8.0f;

__device__ __forceinline__ void attn_tile(const LAS unsigned char* kbuf, unsigned vaddr, const bf16x8 (&qr)[12], f32x16 (&o)[4], float& m, float& lsum, int lane) {
    f32x16 pacc = {};
    const LAS unsigned char* kp = kbuf + (lane & 31) * KP + (lane >> 5) * 16;
#pragma unroll
    for (int ks = 0; ks < 12; ++ks) { const bf16x8 a = *(const LAS bf16x8*)(kp + ks * 32); pacc = __builtin_amdgcn_mfma_f32_32x32x16_bf16(a, qr[ks], pacc, 0, 0, 0); }
    float pmax = pacc[0];
#pragma unroll
    for (int r = 1; r < 16; ++r) pmax = fmaxf(pmax, pacc[r]);
    pmax = fmaxf(pmax, __shfl_xor(pmax, 32));
    if (!__all(pmax - m <= ATT_THR)) {
        const float mn = fmaxf(m, pmax); const float alpha = __builtin_amdgcn_exp2f(m - mn); m = mn; lsum *= alpha;
#pragma unroll
        for (int d = 0; d < 4; ++d)
#pragma unroll
            for (int r = 0; r < 16; ++r) o[d][r] *= alpha;
    }
    float ps = 0.f;
#pragma unroll
    for (int r = 0; r < 16; ++r) { pacc[r] = __builtin_amdgcn_exp2f(pacc[r] - m); ps += pacc[r]; }
    ps += __shfl_xor(ps, 32);
    lsum += ps;
    u32x4 w0 = {cvtpk(pacc[0], pacc[1]), cvtpk(pacc[2], pacc[3]), cvtpk(pacc[4], pacc[5]), cvtpk(pacc[6], pacc[7])};
    u32x4 w1 = {cvtpk(pacc[8], pacc[9]), cvtpk(pacc[10], pacc[11]), cvtpk(pacc[12], pacc[13]), cvtpk(pacc[14], pacc[15])};
    const bf16x8 pb0 = __builtin_bit_cast(bf16x8, w0), pb1 = __builtin_bit_cast(bf16x8, w1);
#define VOFF(d0, s, hi) (((16 * (s) + 8 * (hi)) * VP) + 64 * (d0))
    const s16x4 a00l = tr_read<VOFF(0, 0, 0)>(vaddr), a00h = tr_read<VOFF(0, 0, 1)>(vaddr), a01l = tr_read<VOFF(0, 1, 0)>(vaddr), a01h = tr_read<VOFF(0, 1, 1)>(vaddr);
    const s16x4 a10l = tr_read<VOFF(1, 0, 0)>(vaddr), a10h = tr_read<VOFF(1, 0, 1)>(vaddr), a11l = tr_read<VOFF(1, 1, 0)>(vaddr), a11h = tr_read<VOFF(1, 1, 1)>(vaddr);
    const s16x4 a20l = tr_read<VOFF(2, 0, 0)>(vaddr), a20h = tr_read<VOFF(2, 0, 1)>(vaddr), a21l = tr_read<VOFF(2, 1, 0)>(vaddr), a21h = tr_read<VOFF(2, 1, 1)>(vaddr);
    const s16x4 a30l = tr_read<VOFF(3, 0, 0)>(vaddr), a30h = tr_read<VOFF(3, 0, 1)>(vaddr), a31l = tr_read<VOFF(3, 1, 0)>(vaddr), a31h = tr_read<VOFF(3, 1, 1)>(vaddr);
#undef VOFF
    LDS_WAIT(); SBAR();
    o[0] = __builtin_amdgcn_mfma_f32_32x32x16_bf16(PK8(a00l, a00h), pb0, o[0], 0, 0, 0); o[0] = __builtin_amdgcn_mfma_f32_32x32x16_bf16(PK8(a01l, a01h), pb1, o[0], 0, 0, 0);
    o[1] = __builtin_amdgcn_mfma_f32_32x32x16_bf16(PK8(a10l, a10h), pb0, o[1], 0, 0, 0); o[1] = __builtin_amdgcn_mfma_f32_32x32x16_bf16(PK8(a11l, a11h), pb1, o[1], 0, 0, 0);
    o[2] = __builtin_amdgcn_mfma_f32_32x32x16_bf16(PK8(a20l, a20h), pb0, o[2], 0, 0, 0); o[2] = __builtin_amdgcn_mfma_f32_32x32x16_bf16(PK8(a21l, a21h), pb1, o[2], 0, 0, 0);
    o[3] = __builtin_amdgcn_mfma_f32_32x32x16_bf16(PK8(a30l, a30h), pb0, o[3], 0, 0, 0); o[3] = __builtin_amdgcn_mfma_f32_32x32x16_bf16(PK8(a31l, a31h), pb1, o[3], 0, 0, 0);
}

__device__ __forceinline__ void attn_unit(const Params& p, LAS unsigned char* lds, int head, int qb, int tid, int wave, int lane) {
    unsigned char* ws = p.ws;
    const bf16_t* Qh = (const bf16_t*)(ws + WS_QH); const bf16_t* Kh = (const bf16_t*)(ws + WS_KH); const bf16_t* Vh = (const bf16_t*)(ws + WS_VH);
    bf16_t* mix = (bf16_t*)(ws + WS_MIX);
    const int rg = wave & 3, kh = wave >> 2, r32 = lane & 31, hh = lane >> 5;
    const int q0row = qb * 128 + rg * 32;
    bf16x8 qr[12];
    {
        const bf16_t* qp = Qh + ((size_t)head * S + q0row + r32) * 192 + hh * 8;
#pragma unroll
        for (int ks = 0; ks < 12; ++ks) qr[ks] = *(const bf16x8*)(qp + ks * 16);
    }
    const int ntiles = 2 * qb + 2, mylast = 2 * qb + (rg >> 1);
    float m = -1e30f, lsum = 0.f; f32x16 o[4] = {};
    int kgo[3], klo[3], vgo[2], vlo[2];
#pragma unroll
    for (int i = 0; i < 3; ++i) { const int pc = tid + 512 * i, r = pc / 24, c = pc % 24; kgo[i] = r * 192 + c * 8; klo[i] = r * KP + c * 16; }
#pragma unroll
    for (int i = 0; i < 2; ++i) { const int pc = tid + 512 * i, r = pc >> 4, c = pc & 15; vgo[i] = r * 128 + c * 8; vlo[i] = 64 * KP + r * VP + c * 16; }
    const bf16_t* kbase = Kh + (size_t)head * S * 192; const bf16_t* vbase = Vh + (size_t)head * S * 128;
    u32x4 sk0, sk1, sk2, sv0, sv1;
#define ATT_LOAD(t) do { const bf16_t* kt = kbase + (size_t)(t) * 64 * 192; const bf16_t* vt = vbase + (size_t)(t) * 64 * 128; \
        sk0 = *(const u32x4*)(kt + kgo[0]); sk1 = *(const u32x4*)(kt + kgo[1]); sk2 = *(const u32x4*)(kt + kgo[2]); sv0 = *(const u32x4*)(vt + vgo[0]); sv1 = *(const u32x4*)(vt + vgo[1]); } while (0)
#define ATT_WRITE(b) do { LAS unsigned char* bb = lds + (b) * ATT_BUF; *(LAS u32x4*)(bb + klo[0]) = sk0; *(LAS u32x4*)(bb + klo[1]) = sk1; *(LAS u32x4*)(bb + klo[2]) = sk2; \
        *(LAS u32x4*)(bb + vlo[0]) = sv0; *(LAS u32x4*)(bb + vlo[1]) = sv1; } while (0)
    const unsigned ldsbase = (unsigned)(size_t)lds;
    const unsigned vrel = (unsigned)(64 * KP + (32 * kh + 4 * hh + ((lane & 15) >> 2)) * VP + (16 * ((lane >> 4) & 1) + 4 * (lane & 3)) * 2);
    ATT_LOAD(0); ATT_WRITE(0); __syncthreads();
    for (int t = 0; t < ntiles; ++t) {
        const bool more = (t + 1 < ntiles);
        if (more) ATT_LOAD(t + 1);
        if (t <= mylast) {
            const int b = t & 1;
            attn_tile(lds + b * ATT_BUF + (32 * kh) * KP, ldsbase + b * ATT_BUF + vrel, qr, o, m, lsum, lane);
        }
        if (more) ATT_WRITE((t + 1) & 1);
        __syncthreads();
    }
#undef ATT_LOAD
#undef ATT_WRITE
    LAS float* scr = (LAS float*)lds + (size_t)rg * 66 * 64 + lane;
    if (kh == 1) {
        scr[0] = m; scr[64] = lsum;
#pragma unroll
        for (int d = 0; d < 4; ++d)
#pragma unroll
            for (int r = 0; r < 16; ++r) scr[(2 + d * 16 + r) * 64] = o[d][r];
    }
    __syncthreads();
    if (kh == 0) {
        const float m2 = scr[0], l2 = scr[64];
        const float mn = fmaxf(m, m2), a1 = __builtin_amdgcn_exp2f(m - mn), a2 = __builtin_amdgcn_exp2f(m2 - mn);
        const float inv = 1.0f / (lsum * a1 + l2 * a2);
        bf16_t* op = mix + (size_t)(q0row + r32) * DM + 1024 + head * 128 + 4 * hh;
#pragma unroll
        for (int d = 0; d < 4; ++d)
#pragma unroll
            for (int g4 = 0; g4 < 4; ++g4) {
                float v[4];
#pragma unroll
                for (int i = 0; i < 4; ++i) { const int r = 4 * g4 + i; v[i] = (o[d][r] * a1 + scr[(2 + d * 16 + r) * 64] * a2) * inv; }
                u32x2 w; w.x = pk2(v[0], v[1]); w.y = pk2(v[2], v[3]);
                *(u32x2*)(op + 32 * d + 8 * g4) = w;
            }
    }
    __syncthreads();
}

__device__ __forceinline__ void gmlp_unit(const Params& p, LAS unsigned char* lds, int nb, int h, int tid, int wave, int lane) {
    unsigned char* ws = p.ws;
    const bf16_t* proj = (const bf16_t*)(ws + WS_PROJ); bf16_t* mix = (bf16_t*)(ws + WS_MIX);
    const float* ssv = (const float*)(ws + WS_ROWSS);
    const float* vg = p.in[3]; const float* wsp = p.in[4]; const float* bs = p.in[5];
#pragma unroll
    for (int i = 0; i < 4; ++i) {
        const int pc = tid + 512 * i, r = pc >> 4, c = pc & 15, t = nb * 128 + r;
        const u32x4 w = *(const u32x4*)(proj + (size_t)t * NINP + 1024 + h * 128 + c * 8);
        const float rs = rsqrtf(ssv[t] * (1.0f / 1024.0f) + EPS);
        const f32x4 g0 = *(const f32x4*)(vg + h * 128 + c * 8), g1 = *(const f32x4*)(vg + h * 128 + c * 8 + 4);
        u32x4 ov;
        ov.x = pk2(bflo(w.x) * rs * g0[0], bfhi(w.x) * rs * g0[1]); ov.y = pk2(bflo(w.y) * rs * g0[2], bfhi(w.y) * rs * g0[3]);
        ov.z = pk2(bflo(w.z) * rs * g1[0], bfhi(w.z) * rs * g1[1]); ov.w = pk2(bflo(w.w) * rs * g1[2], bfhi(w.w) * rs * g1[3]);
        *(LAS u32x4*)(lds + r * VP + c * 16) = ov;
    }
    __syncthreads();
    const int ib = wave & 3, ch = wave >> 2, r32 = lane & 31, hh = lane >> 5;
    const int irow = 32 * ib + r32;
    f32x16 acc0 = {}, acc1 = {};
    const unsigned vaddr = (unsigned)(size_t)lds + (unsigned)((8 * hh + ((lane & 15) >> 2)) * VP + (64 * ch + 16 * ((lane >> 4) & 1) + 4 * (lane & 3)) * 2);
    const float* wrow = wsp + ((size_t)h * 128 + irow) * 128 + hh * 8;
#define GSTEP(s) do { if ((s) < 2 * (ib + 1)) { \
        const f32x4 wa = *(const f32x4*)(wrow + (s) * 16), wb = *(const f32x4*)(wrow + (s) * 16 + 4); const int j0 = (s) * 16 + hh * 8; \
        u32x4 aw; aw.x = pk2(j0 + 0 <= irow ? wa[0] : 0.f, j0 + 1 <= irow ? wa[1] : 0.f); aw.y = pk2(j0 + 2 <= irow ? wa[2] : 0.f, j0 + 3 <= irow ? wa[3] : 0.f); \
        aw.z = pk2(j0 + 4 <= irow ? wb[0] : 0.f, j0 + 5 <= irow ? wb[1] : 0.f); aw.w = pk2(j0 + 6 <= irow ? wb[2] : 0.f, j0 + 7 <= irow ? wb[3] : 0.f); \
        const bf16x8 af = __builtin_bit_cast(bf16x8, aw); \
        const s16x4 b0l = tr_read<(16 * (s)) * VP>(vaddr), b0h = tr_read<(16 * (s) + 4) * VP>(vaddr), b1l = tr_read<(16 * (s)) * VP + 64>(vaddr), b1h = tr_read<(16 * (s) + 4) * VP + 64>(vaddr); \
        LDS_WAIT(); SBAR(); \
        acc0 = __builtin_amdgcn_mfma_f32_32x32x16_bf16(af, PK8(b0l, b0h), acc0, 0, 0, 0); acc1 = __builtin_amdgcn_mfma_f32_32x32x16_bf16(af, PK8(b1l, b1h), acc1, 0, 0, 0); } } while (0)
    GSTEP(0); GSTEP(1); GSTEP(2); GSTEP(3); GSTEP(4); GSTEP(5); GSTEP(6); GSTEP(7);
#undef GSTEP
#pragma unroll
    for (int r = 0; r < 16; ++r) {
        const int i = 32 * ib + crow(r, hh), t = nb * 128 + i; const float b = bs[h * 128 + i];
        const int c0 = h * 128 + 64 * ch + r32;
        const float u0 = bf2f(proj[(size_t)t * NINP + c0]), u1 = bf2f(proj[(size_t)t * NINP + c0 + 32]);
        mix[(size_t)t * DM + c0] = (bf16_t)f2bf(u0 * (acc0[r] + b)); mix[(size_t)t * DM + c0 + 32] = (bf16_t)f2bf(u1 * (acc1[r] + b));
    }
    __syncthreads();
}

template <int CTRL, int ROW_MASK> __device__ __forceinline__ float dpp_f(float old, float v) {
    return __builtin_bit_cast(float, __builtin_amdgcn_update_dpp(__builtin_bit_cast(int, old), __builtin_bit_cast(int, v), CTRL, ROW_MASK, 0xf, false));
}
__device__ __forceinline__ float wave_max_u(float v) {
    v = fmaxf(v, dpp_f<0xB1, 0xf>(v, v));
    v = fmaxf(v, dpp_f<0x4E, 0xf>(v, v));
    v = fmaxf(v, dpp_f<0x141, 0xf>(v, v));
    v = fmaxf(v, dpp_f<0x140, 0xf>(v, v));
    v = fmaxf(v, dpp_f<0x142, 0xa>(v, v));
    v = fmaxf(v, dpp_f<0x143, 0xc>(v, v));
    return __builtin_bit_cast(float, __builtin_amdgcn_readlane(__builtin_bit_cast(int, v), 63));
}
__device__ __forceinline__ float wave_sum_u(float v) {
    v += dpp_f<0xB1, 0xf>(0.f, v);
    v += dpp_f<0x4E, 0xf>(0.f, v);
    v += dpp_f<0x141, 0xf>(0.f, v);
    v += dpp_f<0x140, 0xf>(0.f, v);
    v += dpp_f<0x142, 0xa>(0.f, v);
    v += dpp_f<0x143, 0xc>(0.f, v);
    return __builtin_bit_cast(float, __builtin_amdgcn_readlane(__builtin_bit_cast(int, v), 63));
}
__device__ __forceinline__ void phase7(const Params& p, LAS unsigned char* lds, int gw, int NGW, int wave, int lane) {
    unsigned char* ws = p.ws;
    const float* sc = (const float*)(ws + WS_SC); int* ex = (int*)(ws + WS_EXP); float* gt = (float*)(ws + WS_GATE);
    const float NEG = -3.0e38f;
    LAS float* sl = (LAS float*)(lds + wave * 1024);
    const int j8 = lane & 7, g8 = lane >> 3, row = lane >> 4, i16 = lane & 15;
    int ci[4], cj[4]; bool cval[4];
    {
        constexpr int starts[16] = {0, 16, 24, 29, 33, 36, 38, 40, 42, 43, 44, 45, 46, 47, 48, 49};
#pragma unroll
        for (int m = 0; m < 4; ++m) {
            const int c = i16 + 16 * m; int a = 0, st = 0;
#pragma unroll
            for (int i = 1; i < 16; ++i) if (c >= starts[i]) { a = i; st = starts[i]; }
            cval[m] = c < 50; ci[m] = cval[m] ? a : 0; cj[m] = cval[m] ? (c - st) : 0;
        }
    }
    constexpr int NT = S * 2;
    f32x4 nx0, nx1, nx2, nx3;
    if (gw < NT) { const float* b = sc + (size_t)(gw >> 1) * DM + (gw & 1) * 1024 + lane * 16; nx0 = *(const f32x4*)b; nx1 = *(const f32x4*)(b + 4); nx2 = *(const f32x4*)(b + 8); nx3 = *(const f32x4*)(b + 12); }
    for (int it = gw; it < NT; it += NGW) {
        const int t = it >> 1, hh = it & 1;
        float v[16];
#pragma unroll
        for (int q = 0; q < 4; ++q) { v[q] = nx0[q]; v[4 + q] = nx1[q]; v[8 + q] = nx2[q]; v[12 + q] = nx3[q]; }
        if (it + NGW < NT) { const int it2 = it + NGW; const float* b = sc + (size_t)(it2 >> 1) * DM + (it2 & 1) * 1024 + lane * 16;
            nx0 = *(const f32x4*)b; nx1 = *(const f32x4*)(b + 4); nx2 = *(const f32x4*)(b + 8); nx3 = *(const f32x4*)(b + 12); }
#pragma unroll
        for (int m = 0; m < 16; ++m) v[m] = __builtin_bit_cast(float, (__builtin_bit_cast(unsigned, v[m]) & ~127u) | (unsigned)(16 * j8 + m));
        float ra = 0.f, rb = 0.f;
#pragma unroll
        for (int k = 0; k < 16; ++k) {
            float mx = fmaxf(fmaxf(fmaxf(v[0], v[1]), fmaxf(v[2], v[3])), fmaxf(fmaxf(v[4], v[5]), fmaxf(v[6], v[7])));
            mx = fmaxf(mx, fmaxf(fmaxf(fmaxf(v[8], v[9]), fmaxf(v[10], v[11])), fmaxf(fmaxf(v[12], v[13]), fmaxf(v[14], v[15]))));
            mx = fmaxf(mx, dpp_f<0xB1, 0xf>(mx, mx));
            mx = fmaxf(mx, dpp_f<0x4E, 0xf>(mx, mx));
            mx = fmaxf(mx, dpp_f<0x141, 0xf>(mx, mx));
#pragma unroll
            for (int m = 0; m < 16; ++m) v[m] = (v[m] == mx) ? NEG : v[m];
            if (k < 8) ra = (j8 == k) ? mx : ra; else rb = (j8 == k - 8) ? mx : rb;
        }
        sl[g8 * 16 + j8] = ra; sl[g8 * 16 + 8 + j8] = rb;
        LDS_WAIT(); asm volatile("" ::: "memory");
        float cv[4], og[4]; int id[4];
#pragma unroll
        for (int m = 0; m < 4; ++m) {
            const float s1 = sl[(2 * row) * 16 + ci[m]], s2 = sl[(2 * row + 1) * 16 + cj[m]];
            og[m] = cval[m] ? (s1 + s2) : NEG; cv[m] = og[m];
            id[m] = (int)((__builtin_bit_cast(unsigned, s1) & 127u) * 128u + (__builtin_bit_cast(unsigned, s2) & 127u));
        }
        LDS_WAIT(); asm volatile("" ::: "memory");
        float M0 = 0.f;
#pragma unroll
        for (int k = 0; k < 16; ++k) {
            float mx = fmaxf(fmaxf(cv[0], cv[1]), fmaxf(cv[2], cv[3]));
            mx = fmaxf(mx, dpp_f<0xB1, 0xf>(mx, mx));
            mx = fmaxf(mx, dpp_f<0x4E, 0xf>(mx, mx));
            mx = fmaxf(mx, dpp_f<0x141, 0xf>(mx, mx));
            mx = fmaxf(mx, dpp_f<0x140, 0xf>(mx, mx));
            if (k == 0) M0 = mx;
#pragma unroll
            for (int m = 0; m < 4; ++m) cv[m] = (cv[m] == mx) ? NEG : cv[m];
        }
        bool sel[4]; float e[4]; float es = 0.f;
#pragma unroll
        for (int m = 0; m < 4; ++m) { sel[m] = (cv[m] != og[m]); e[m] = sel[m] ? __expf(og[m] - M0) : 0.f; es += e[m]; }
        es += dpp_f<0xB1, 0xf>(0.f, es); es += dpp_f<0x4E, 0xf>(0.f, es); es += dpp_f<0x141, 0xf>(0.f, es); es += dpp_f<0x140, 0xf>(0.f, es);
        const float inv = 1.0f / es;
        int basepos = 0;
        const int head = 4 * hh + row;
#pragma unroll
        for (int m = 0; m < 4; ++m) {
            const unsigned long long bl = __ballot(sel[m]);
            const unsigned rbits = (unsigned)(bl >> (16 * row)) & 0xffffu;
            const int pos = basepos + __popc(rbits & ((1u << i16) - 1u));
            if (sel[m] && pos < 16) { ex[(size_t)t * 128 + head * 16 + pos] = id[m]; gt[(size_t)t * 128 + head * 16 + pos] = e[m] * inv; }
            basepos += __popc(rbits);
        }
    }
}

typedef __bf16 bf16x32v __attribute__((ext_vector_type(32)));
typedef __bf16 bf16x2v __attribute__((ext_vector_type(2)));
typedef float f32x2 __attribute__((ext_vector_type(2)));
constexpr int P8_LDSW = 9216;
__device__ __forceinline__ void phase8(const Params& p, LAS unsigned char* lds, float* dst, int gw, int NGW, int wave, int lane) {
    unsigned char* ws = p.ws;
    const bf16_t* x1b = (const bf16_t*)(ws + WS_X1B); const unsigned char* UT = ws + WS_UT; const unsigned char* VT = ws + WS_VT;
    const int* ex = (const int*)(ws + WS_EXP); const float* gt = (const float*)(ws + WS_GATE); const float* ss2 = (const float*)(ws + WS_ROWSS) + 3 * S;
    const float* out = p.out;
    LAS unsigned* hist = (LAS unsigned*)(lds + wave * P8_LDSW);
    LAS unsigned* list = hist + 64; LAS float* gsort = (LAS float*)(list + 512); LAS float* coef = gsort + 512; LAS float* rsort = coef + 512;
    for (int tb = gw; tb < S / 4; tb += NGW) {
        const int t0 = tb * 4;
        int id[8]; float gv[8];
#pragma unroll
        for (int r = 0; r < 8; ++r) { const size_t o = (size_t)(t0 + (r >> 1)) * 128 + (r & 1) * 64 + lane; id[r] = ex[o]; gv[r] = gt[o]; }
        const float rs0 = rsqrtf(ss2[t0 + 0] * (1.0f / DM) + EPS) * (1.0f / PEER_USC), rs1 = rsqrtf(ss2[t0 + 1] * (1.0f / DM) + EPS) * (1.0f / PEER_USC);
        const float rs2 = rsqrtf(ss2[t0 + 2] * (1.0f / DM) + EPS) * (1.0f / PEER_USC), rs3 = rsqrtf(ss2[t0 + 3] * (1.0f / DM) + EPS) * (1.0f / PEER_USC);
        hist[lane] = 0u;
        LDS_WAIT(); asm volatile("" ::: "memory");
        unsigned pos[8];
#pragma unroll
        for (int r = 0; r < 8; ++r) pos[r] = __hip_atomic_fetch_add(hist + (id[r] >> 8), 1u, __ATOMIC_RELAXED, __HIP_MEMORY_SCOPE_WORKGROUP);
        LDS_WAIT(); asm volatile("" ::: "memory");
        const unsigned cnt = hist[lane];
        unsigned inc = cnt;
#pragma unroll
        for (int o = 1; o < 64; o <<= 1) { const unsigned n = __shfl_up(inc, o); if (lane >= o) inc += n; }
        LDS_WAIT(); asm volatile("" ::: "memory");
        hist[lane] = inc - cnt;
        LDS_WAIT(); asm volatile("" ::: "memory");
#pragma unroll
        for (int r = 0; r < 8; ++r) { const unsigned d = hist[id[r] >> 8] + pos[r]; list[d] = (unsigned)id[r] | ((unsigned)(r >> 1) << 14); gsort[d] = gv[r]; rsort[d] = (r >> 1) == 0 ? rs0 : ((r >> 1) == 1 ? rs1 : ((r >> 1) == 2 ? rs2 : rs3)); }
        LDS_WAIT(); asm volatile("" ::: "memory");
        unsigned xq[4][16];
#pragma unroll
        for (int j = 0; j < 4; ++j) {
#pragma unroll
            for (int i = 0; i < 8; ++i) { const u32x2 w = *(const u32x2*)(x1b + (size_t)(t0 + j) * DM + (i * 64 + lane) * 4); xq[j][2 * i] = w.x; xq[j][2 * i + 1] = w.y; }
        }
#define P8_DOT(J) do { _Pragma("unroll") for (int m = 0; m < 16; ++m) { const bf16x2v uu = {r_[2 * m], r_[2 * m + 1]}; d = __builtin_amdgcn_fdot2_f32_bf16(uu, __builtin_bit_cast(bf16x2v, xq[J][m]), d, false); } } while (0)
#define P8_ULOAD(k, i) do { const unsigned en = (unsigned)__builtin_amdgcn_readfirstlane((int)list[(i)]); uen[k] = en; \
            const size_t ro = (size_t)(en & 0x3fffu) * PEER_ROWB; u4[k] = *(const u32x4*)(UT + ro + lane * 16); u2[k] = *(const u32x2*)(UT + ro + 1024 + lane * 8); } while (0)
#define P8_UPROC(k, i) do { const u32x6 pk = {u4[k][0], u4[k][1], u4[k][2], u4[k][3], u2[k][0], u2[k][1]}; \
            const bf16x32v r_ = __builtin_amdgcn_cvt_scalef32_pk32_bf16_fp6(pk, 1.0f); const unsigned j = uen[k] >> 14; float d = 0.f; \
            if (j == 0u) { P8_DOT(0); } else if (j == 1u) { P8_DOT(1); } else if (j == 2u) { P8_DOT(2); } else { P8_DOT(3); } \
            d = wave_sum_u(d); const float c_ = gsort[(i)] * gelu_tanh(rsort[(i)] * d) * (1.0f / PEER_VSC); if (lane == 0) coef[(i)] = c_; } while (0)
#if (PROBE_DUP >> 10) & 1
#define P8_UREPS 2
#else
#define P8_UREPS 1
#endif
#pragma unroll 1
        for (int urep = 0; urep < P8_UREPS; ++urep) {
            u32x4 u4[8]; u32x2 u2[8]; unsigned uen[8];
#pragma unroll
            for (int k = 0; k < 8; ++k) P8_ULOAD(k, k);
#pragma unroll 1
            for (int i = 0; i < 512; i += 8) {
#pragma unroll
                for (int k = 0; k < 8; ++k) { P8_UPROC(k, i + k); if (i + 8 < 512) P8_ULOAD(k, i + 8 + k); }
            }
        }
#undef P8_ULOAD
        LDS_WAIT(); asm volatile("" ::: "memory");
        f32x2 acc[4][16];
#pragma unroll
        for (int j = 0; j < 4; ++j)
#pragma unroll
            for (int i = 0; i < 16; ++i) acc[j][i] = (f32x2){0.f, 0.f};
#define P8_VLOAD(X4, X2, EN, i) do { const unsigned en = (unsigned)__builtin_amdgcn_readfirstlane((int)list[(i)]); EN = en; \
            const size_t ro = (size_t)(en & 0x3fffu) * PEER_ROWB; X4 = *(const u32x4*)(VT + ro + lane * 16); X2 = *(const u32x2*)(VT + ro + 1024 + lane * 8); } while (0)
#define P8_VPROC(X4, X2, EN, i) do { const u32x6 pk = {X4[0], X4[1], X4[2], X4[3], X2[0], X2[1]}; \
            const f32x32v r_ = __builtin_amdgcn_cvt_scalef32_pk32_f32_fp6(pk, 1.0f); const unsigned j = EN >> 14; const float c_ = coef[(i)]; \
            const float c0_ = j == 0u ? c_ : 0.f, c1_ = j == 1u ? c_ : 0.f, c2_ = j == 2u ? c_ : 0.f, c3_ = j == 3u ? c_ : 0.f; \
            _Pragma("unroll") for (int m_ = 0; m_ < 16; ++m_) { const f32x2 rr = {r_[2 * m_], r_[2 * m_ + 1]}; \
                acc[0][m_] = __builtin_elementwise_fma((f32x2){c0_, c0_}, rr, acc[0][m_]); acc[1][m_] = __builtin_elementwise_fma((f32x2){c1_, c1_}, rr, acc[1][m_]); \
                acc[2][m_] = __builtin_elementwise_fma((f32x2){c2_, c2_}, rr, acc[2][m_]); acc[3][m_] = __builtin_elementwise_fma((f32x2){c3_, c3_}, rr, acc[3][m_]); } } while (0)
        {
            u32x4 c4, d4, e4; u32x2 c2, d2, e2; unsigned cen, den, een;
            P8_VLOAD(c4, c2, cen, 0); P8_VLOAD(d4, d2, den, 1);
#pragma unroll 1
            for (int i = 0; i < 510; i += 3) {
                P8_VLOAD(e4, e2, een, i + 2);
                P8_VPROC(c4, c2, cen, i);
                P8_VLOAD(c4, c2, cen, i + 3);
                P8_VPROC(d4, d2, den, i + 1);
                P8_VLOAD(d4, d2, den, i + 4);
                P8_VPROC(e4, e2, een, i + 2);
            }
            P8_VPROC(c4, c2, cen, 510); P8_VPROC(d4, d2, den, 511);
        }
#undef P8_VLOAD
#undef P8_DOT
#undef P8_UPROC
#undef P8_VPROC
        int tq = t0, lq = lane; asm volatile("" : "+s"(tq)); asm volatile("" : "+v"(lq));
#pragma unroll
        for (int j = 0; j < 4; ++j)
#pragma unroll
            for (int i = 0; i < 8; ++i) {
                const size_t o = (size_t)(tq + j) * DM + (i * 64 + lq) * 4;
                f32x4 a = *(const f32x4*)(out + o);
#pragma unroll
                for (int q = 0; q < 4; ++q) a[q] += acc[j][2 * i + (q >> 1)][q & 1];
                *(f32x4*)(dst + o) = a;
                if (i & 1) asm volatile("" ::: "memory");
            }
        LDS_WAIT(); asm volatile("" ::: "memory");
    }
}

__global__ void __launch_bounds__(NTHREADS, 2) mega(Params p) {
    extern __shared__ __attribute__((aligned(16))) unsigned char lds_raw[];
    LAS unsigned char* lds = (LAS unsigned char*)lds_raw;
    const int tid = threadIdx.x, lane = tid & 63, wave = __builtin_amdgcn_readfirstlane(tid >> 6);
    const int G = gridDim.x, bx = blockIdx.x;
    const int gw = bx * 8 + wave, NGW = G * 8;
    unsigned char* ws = p.ws;
    const int lo = p.ph_lo, hi = p.ph_hi;
    volatile LAS unsigned* misc = (volatile LAS unsigned*)(lds + LDS_MISC);
    if (tid < 4) misc[tid] = 0u;
    __syncthreads();
    const XcdBarrier xbar = xcd_barrier_post((unsigned*)(ws + WS_CTL), misc);
#ifndef PH_MASK
#define PH_MASK 0x1ff
#endif
#define IN(k) (((PH_MASK >> (k)) & 1) && lo <= (k) && (k) < hi)
#define SEAM(k) do { if (IN(k) && IN((k) + 1)) xcd_barrier(xbar); } while (0)

#if (PROBE_DUP >> 0) & 1
    if (IN(0)) { phase0(p, lds, gw, NGW, wave, lane); xcd_barrier(xbar); }
#endif
    if (IN(0)) phase0(p, lds, gw, NGW, wave, lane);
    SEAM(0);
    if (IN(1)) {
        pg8::Gemm g{(const bf16_t*)(ws + WS_XB), (const bf16_t*)(ws + WS_WIN), S, NINP, DM, DM, DM};
        pg8::StaticOrder So; So.init(S, NINP, G, bx);
        pg8::Epi<1> E{(const float*)(ws + WS_RSTD1), 0.f, (float*)(ws + WS_ROWSS), (bf16_t*)(ws + WS_PROJ), NINP, nullptr, nullptr};
#if (PROBE_DUP >> 1) & 1
        { pg8::Epi<1> E2 = E; E2.ss = (float*)(ws + 512 * 1024); pg8::gemm_phase<pg8::Epi<1>, pg8::StaticOrder, true, true>(lds, g, So, E2); xcd_barrier(xbar); }
#endif
        pg8::gemm_phase<pg8::Epi<1>, pg8::StaticOrder, true, true>(lds, g, So, E);
    }
    SEAM(1);
    if (IN(2)) {
        {
            pg8::Gemm g{(const bf16_t*)(ws + WS_PROJ) + 2048, (const bf16_t*)(ws + WS_WUQ), S, 1536, 512, NINP, 512};
            pg8::StaticOrder So; So.init(S, 1536, G, bx);
            pg8::Epi<2> E{(const float*)(ws + WS_ROWSS) + 1 * S, 1.0f / 512.0f, nullptr, (bf16_t*)(ws + WS_QRAW), 1536, nullptr, nullptr};
            pg8::gemm_phase<pg8::Epi<2>, pg8::StaticOrder, true, true>(lds, g, So, E);
        }
        __syncthreads();
        {
            pg8::Gemm g{(const bf16_t*)(ws + WS_PROJ) + 2560, (const bf16_t*)(ws + WS_WUKV), S, 2048, 256, NINP, 256};
            pg8::StaticOrder So; So.init(S, 2048, G, bx);
            pg8::Epi<2> E{(const float*)(ws + WS_ROWSS) + 2 * S, 1.0f / 256.0f, nullptr, (bf16_t*)(ws + WS_KVRAW), 2048, nullptr, nullptr};
            pg8::gemm_phase<pg8::Epi<2>, pg8::StaticOrder, true, true>(lds, g, So, E);
        }
    }
    SEAM(2);
#if (PROBE_DUP >> 3) & 1
    if (IN(3)) { phase3(p, gw, NGW, lane); xcd_barrier(xbar); }
#endif
    if (IN(3)) phase3(p, gw, NGW, lane);
    SEAM(3);
#define P4_BODY_ATT for (int pr = bx; pr < 256; pr += G) { const int head = pr & 7, x = pr >> 3; attn_unit(p, lds, head, 63 - x, tid, wave, lane); attn_unit(p, lds, head, x, tid, wave, lane); }
#define P4_BODY_GMLP for (int u = bx; u < 512; u += G) gmlp_unit(p, lds, u >> 3, u & 7, tid, wave, lane);
#if (PROBE_DUP >> 4) & 1
    if (IN(4)) { P4_BODY_ATT; xcd_barrier(xbar); }
#endif
#if (PROBE_DUP >> 9) & 1
    if (IN(4)) { P4_BODY_GMLP; xcd_barrier(xbar); }
#endif
    if (IN(4)) { P4_BODY_ATT; P4_BODY_GMLP; }
    SEAM(4);
    if (IN(5)) {
        pg8::Gemm g{(const bf16_t*)(ws + WS_MIX), (const bf16_t*)(ws + WS_WOUT), S, DM, DM, DM, DM};
        pg8::StaticOrder So; So.init(S, DM, G, bx);
        pg8::Epi<4> E{nullptr, 0.f, (float*)(ws + WS_ROWSS) + 3 * S, (bf16_t*)(ws + WS_X1B), DM, p.out, p.in[0]};
#if (PROBE_DUP >> 5) & 1
        { pg8::Epi<4> E2 = E; E2.ss = (float*)(ws + 512 * 1024); pg8::gemm_phase<pg8::Epi<4>, pg8::StaticOrder, true, true>(lds, g, So, E2); xcd_barrier(xbar); }
#endif
        pg8::gemm_phase<pg8::Epi<4>, pg8::StaticOrder, true, true>(lds, g, So, E);
    }
    SEAM(5);
    if (IN(6)) {
        pg8::Gemm g{(const bf16_t*)(ws + WS_X1B), (const bf16_t*)(ws + WS_WS), S, DM, DM, DM, DM};
        pg8::StaticOrder So; So.init(S, DM, G, bx);
        pg8::Epi<5> E{(const float*)(ws + WS_ROWSS) + 3 * S, 1.0f / DM, nullptr, nullptr, DM, (float*)(ws + WS_SC), nullptr};
#if (PROBE_DUP >> 6) & 1
        { pg8::gemm_phase<pg8::Epi<5>, pg8::StaticOrder, true, true>(lds, g, So, E); xcd_barrier(xbar); }
#endif
        pg8::gemm_phase<pg8::Epi<5>, pg8::StaticOrder, true, true>(lds, g, So, E);
    }
    SEAM(6);
#if (PROBE_DUP >> 7) & 1
    if (IN(7)) { phase7(p, lds, gw, NGW, wave, lane); xcd_barrier(xbar); }
#endif
    if (IN(7)) phase7(p, lds, gw, NGW, wave, lane);
    SEAM(7);
#if (PROBE_DUP >> 8) & 1
    if (IN(8)) { phase8(p, lds, (float*)(ws + WS_SC), gw, NGW, wave, lane); xcd_barrier(xbar); }
#endif
    if (IN(8)) phase8(p, lds, p.out, gw, NGW, wave, lane);
#undef IN
#undef SEAM
}

extern "C" void kernel_launch(void* const* d_in, const int* in_sizes, int n_in, void* d_out, int out_size, void* d_ws, size_t ws_size, hipStream_t stream) {
    static int grid = 0;
    if (grid == 0) {
        if (n_in != 18 || out_size != S * DM || ws_size < WS_END) { fprintf(stderr, "kernel_launch: unexpected shapes (n_in %d out %d ws %zu)\n", n_in, out_size, ws_size); grid = -1; return; }
        int dev = 0, cus = 0, per_cu = 0;
        hipGetDevice(&dev);
        hipDeviceGetAttribute(&cus, hipDeviceAttributeMultiprocessorCount, dev);
        if (hipFuncSetAttribute((const void*)mega, hipFuncAttributeMaxDynamicSharedMemorySize, LDS_BYTES) != hipSuccess) { fprintf(stderr, "kernel_launch: hipFuncSetAttribute failed\n"); grid = -1; return; }
        if (hipOccupancyMaxActiveBlocksPerMultiprocessor(&per_cu, (const void*)mega, NTHREADS, LDS_BYTES) != hipSuccess || per_cu < 1) { fprintf(stderr, "kernel_launch: occupancy query failed (%d)\n", per_cu); grid = -1; return; }
        grid = cus;
        fprintf(stderr, "kernel_launch: cus %d per_cu %d grid %d\n", cus, per_cu, grid);
    }
    if (grid < 0) return;
    hipMemsetAsync((char*)d_ws + WS_CTL, 0, 1 * MiB, stream);
    Params prm{};
    for (int i = 0; i < 18; ++i) prm.in[i] = (const float*)d_in[i];
    prm.out = (float*)d_out; prm.ws = (unsigned char*)d_ws;
#if MK_ONE_LAUNCH
    prm.ph_lo = 0; prm.ph_hi = NPH;
    { void* args[] = {&prm}; hipError_t e = hipLaunchCooperativeKernel((const void*)mega, dim3(grid), dim3(NTHREADS), args, LDS_BYTES, stream);
      if (e != hipSuccess) fprintf(stderr, "cooperative launch failed: %s\n", hipGetErrorString(e)); }
#else
    for (int ph = 0; ph < NPH; ++ph) {
        prm.ph_lo = ph; prm.ph_hi = ph + 1;
        void* args[] = {&prm};
        hipError_t e = hipLaunchCooperativeKernel((const void*)mega, dim3(grid), dim3(NTHREADS), args, LDS_BYTES, stream);
        if (e != hipSuccess) { fprintf(stderr, "cooperative launch %d failed: %s\n", ph, hipGetErrorString(e)); break; }
    }
#endif
}
```

```cpp
#include <hip/hip_runtime.h>
#include <cstdio>
#include <cstdint>

#define LAS __attribute__((address_space(3)))
typedef unsigned short bf16_t;
typedef short bf16x8 __attribute__((ext_vector_type(8)));
typedef short s16x4 __attribute__((ext_vector_type(4)));
typedef float f32x4 __attribute__((ext_vector_type(4)));
typedef float f32x16 __attribute__((ext_vector_type(16)));
typedef unsigned u32x4 __attribute__((ext_vector_type(4)));
typedef unsigned u32x2 __attribute__((ext_vector_type(2)));

#ifndef PROBE_DUP
#define PROBE_DUP 0
#endif
#ifndef MK_ONE_LAUNCH
#define MK_ONE_LAUNCH 1
#endif

constexpr int S = 8192, DM = 2048, NIN = 2880, NINP = 3072;
constexpr int NPH = 9;
constexpr float EPS = 1e-6f;
constexpr int LDS_BYTES = 163840;
constexpr int NTHREADS = 512;
constexpr int LDS_MISC = 161792;

constexpr size_t MiB = 1u << 20;
constexpr size_t WS_CTL = 0;
constexpr size_t WS_ROWSS = 128 * 1024;
constexpr size_t WS_COS = 1 * MiB, WS_SIN = 2 * MiB;
constexpr size_t WS_RSTD1 = 3 * MiB;
constexpr size_t WS_EXP = 4 * MiB;
constexpr size_t WS_GATE = 8 * MiB;
constexpr size_t WS_WIN = 12 * MiB;
constexpr size_t WS_WUQ = 24 * MiB;
constexpr size_t WS_WUKV = 26 * MiB;
constexpr size_t WS_WOUT = 28 * MiB;
constexpr size_t WS_WS = 36 * MiB;
constexpr size_t WS_XB = 44 * MiB;
constexpr size_t WS_PROJ = 76 * MiB;
constexpr size_t WS_QRAW = 124 * MiB;
constexpr size_t WS_KVRAW = 148 * MiB;
constexpr size_t WS_QH = 180 * MiB;
constexpr size_t WS_KH = 204 * MiB;
constexpr size_t WS_VH = 228 * MiB;
constexpr size_t WS_MIX = 244 * MiB;
constexpr size_t WS_X1B = 276 * MiB;
constexpr size_t WS_SC = 308 * MiB;
constexpr size_t WS_UT = 372 * MiB;
constexpr size_t WS_VT = 436 * MiB;
constexpr size_t WS_END = 500 * MiB;

__device__ __forceinline__ unsigned f2bf(float f) { unsigned u = __builtin_bit_cast(unsigned, f); return (u + 0x7fffu + ((u >> 16) & 1u)) >> 16; }
__device__ __forceinline__ unsigned pk2(float lo, float hi) { return f2bf(lo) | (f2bf(hi) << 16); }
__device__ __forceinline__ float bf2f(unsigned short b) { return __builtin_bit_cast(float, (unsigned)b << 16); }
__device__ __forceinline__ float bflo(unsigned w) { return __builtin_bit_cast(float, w << 16); }
__device__ __forceinline__ float bfhi(unsigned w) { return __builtin_bit_cast(float, w & 0xffff0000u); }
__device__ __forceinline__ float wave_sum(float v) {
#pragma unroll
    for (int o = 32; o > 0; o >>= 1) v += __shfl_xor(v, o);
    return v;
}
__device__ __forceinline__ float wave_max(float v) {
#pragma unroll
    for (int o = 32; o > 0; o >>= 1) v = fmaxf(v, __shfl_xor(v, o));
    return v;
}
__device__ __forceinline__ float gelu_tanh(float x) {
    const float y = 0.7978845608028654f * (x + 0.044715f * x * x * x);
    return x / (1.0f + __expf(-2.0f * y));
}
__device__ __forceinline__ int crow(int r, int hi) { return (r & 3) + 8 * (r >> 2) + 4 * hi; }
#define LDS_WAIT() asm volatile("s_waitcnt lgkmcnt(0)" ::: "memory")
#define SBAR() __builtin_amdgcn_sched_barrier(0)

namespace pg8 {
#define PG8_LAS __attribute__((address_space(3)))
constexpr int BM = 256, BK = 64, HALF = 128, HTB = HALF * BK * 2  , STAGE_BYTES = 8 * HTB, NXCD = 8, WGM = 8;

__host__ __device__ __forceinline__ int lds_byte(int r, int c) { const int st = (r >> 4) * 2 + (c >> 5), rr = r & 15, cc = c & 31, ob = rr * 64 + cc * 2; return st * 1024 + (ob ^ (((ob >> 9) & 1) << 5)); }
__host__ __device__ __forceinline__ void stage_rc(int b, int& R, int& C) { const int st = b / 1024, sb = b % 1024, swz = sb ^ (((sb >> 9) & 1) << 5); R = (st >> 1) * 16 + swz / 64; C = (st & 1) * 32 + (swz % 64) / 2; }
__host__ __device__ __forceinline__ int perm32(int rho) { const int n = rho >> 4, i = rho & 15; return 8 * (i >> 2) + 4 * n + (i & 3); }

struct Unit { int pm, pn; };
struct Gemm { const bf16_t* A; const bf16_t* Bt; int M, N, K, lda, ldb; };

struct StaticOrder {
    int nM, nN, nwg, G, c;
    __host__ __device__ void init(int M, int N, int G_, int c_) { nM = M / BM; nN = N / BM; nwg = nM * nN; G = G_; c = c_; }
    __host__ __device__ bool next(int i, Unit& u) const {
        const long L = (long)i * G + c; if (L >= nwg) return false;
        int wgid = (int)L; { const int q = nwg / NXCD, r = nwg % NXCD, xcd = wgid % NXCD, off = wgid / NXCD; wgid = (xcd < r ? xcd * (q + 1) : r * (q + 1) + (xcd - r) * q) + off; }
        const int nig = WGM * nN, gid = wgid / nig, fm = gid * WGM, gsz = (nM - fm) < WGM ? (nM - fm) : WGM;
        u.pm = fm + ((wgid % nig) % gsz); u.pn = (wgid % nig) / gsz; return true;
    }
    __device__ __forceinline__ void a_ready(const Unit&) const {}
    __device__ __forceinline__ void done(const Unit&) const {}
};

template <class Epi, class Sched, bool ALIGN_EPI = false, bool SP2 = false>
__device__ __forceinline__ void gemm_phase(PG8_LAS unsigned char* lds, const Gemm g, const Sched& S, const Epi& E) {
    const int tid = threadIdx.x, wid = __builtin_amdgcn_readfirstlane(tid >> 6), lane = tid & 63, wr = wid >> 2, wc = wid & 3, fr = lane & 15, fq = lane >> 4;
    const int K = g.K, nt = K / BK;
    unsigned voffA[2], voffB[2];
#pragma unroll
    for (int i = 0; i < 2; ++i) { int R, C; stage_rc(tid * 16 + i * 8192, R, C); const int Rb = Epi::PERM ? ((R & ~31) + perm32(R & 31)) : R;
        voffA[i] = (unsigned)(R * g.lda + C) * 2u; voffB[i] = (unsigned)(Rb * g.ldb + C) * 2u; }
    const size_t kstep = (size_t)(BK * 2);
    const size_t hstepA = (size_t)HALF * g.lda * 2, hstepB = (size_t)HALF * g.ldb * 2;
    const size_t tstepA = 2 * hstepA, tstepB = 2 * hstepB;
    const unsigned ldsw = (unsigned)wid * 1024u;
    const int aoff = lds_byte(wr * 64 + fr, fq * 8), boff = lds_byte(wc * 32 + fr, fq * 8);
#define PG8_SA(b, h) (((b) * 2 + (h)) * HTB)
#define PG8_SB(b, h) ((4 + (b) * 2 + (h)) * HTB)
#define PG8_STAGE(bufoff, gbase, voff) do { _Pragma("unroll") for (int _i = 0; _i < 2; ++_i) \
        __builtin_amdgcn_global_load_lds((const unsigned*)((const char*)(gbase) + (voff)[_i]), (PG8_LAS unsigned*)(lds + (bufoff) + ldsw + _i * 8192), 16, 0, 0); } while (0)
#define PG8_LDA(dst, b, h) do { _Pragma("unroll") for (int m = 0; m < 4; ++m) _Pragma("unroll") for (int k = 0; k < 2; ++k) dst[m][k] = *(const PG8_LAS bf16x8*)(lds + PG8_SA(b, h) + aoff + m * 2048 + k * 1024); } while (0)
#define PG8_LDB(dst, b, h) do { _Pragma("unroll") for (int n = 0; n < 2; ++n) _Pragma("unroll") for (int k = 0; k < 2; ++k) dst[n][k] = *(const PG8_LAS bf16x8*)(lds + PG8_SB(b, h) + boff + n * 2048 + k * 1024); } while (0)
#define PG8_MMA(ai, bj, At, Bt) do { __builtin_amdgcn_s_setprio(1); _Pragma("unroll") for (int m = 0; m < 4; ++m) _Pragma("unroll") for (int n = 0; n < 2; ++n) _Pragma("unroll") for (int k = 0; k < 2; ++k) \
        acc[ai][bj][m][n] = __builtin_amdgcn_mfma_f32_16x16x32_bf16(Bt[n][k], At[m][k], acc[ai][bj][m][n], 0, 0, 0); __builtin_amdgcn_s_setprio(0); } while (0)
#define PG8_WAIT_V(n) asm volatile("s_waitcnt vmcnt(" #n ")" ::: "memory")
#define PG8_WAIT_L(n) asm volatile("s_waitcnt lgkmcnt(" #n ")" ::: "memory")
#define PG8_BAR __builtin_amdgcn_s_barrier()
#define PG8_SCHED __builtin_amdgcn_sched_barrier(0)
    Unit cur, nxt; int ui = 0;
    if (!S.next(0, cur)) return;
    f32x4 acc[2][2][4][2];
#pragma unroll
    for (int a = 0; a < 2; ++a)
#pragma unroll
        for (int b = 0; b < 2; ++b)
#pragma unroll
            for (int m = 0; m < 4; ++m)
#pragma unroll
                for (int n = 0; n < 2; ++n) acc[a][b][m][n] = (f32x4){0.f, 0.f, 0.f, 0.f};
    bf16x8 At[4][2], B0[2][2], B1[2][2];
    const char* cA = (const char*)g.A + (size_t)cur.pm * tstepA; const char* cB = (const char*)g.Bt + (size_t)cur.pn * tstepB;
    S.a_ready(cur);
    if constexpr (SP2) {
        PG8_STAGE(PG8_SB(0, 0), cB, voffB); PG8_STAGE(PG8_SB(0, 1), cB + hstepB, voffB); PG8_STAGE(PG8_SA(0, 0), cA, voffA); PG8_STAGE(PG8_SA(0, 1), cA + hstepA, voffA);
        if (wr == 1) PG8_BAR;
        PG8_WAIT_V(2); PG8_BAR;
        PG8_STAGE(PG8_SB(1, 0), cB + kstep, voffB); PG8_STAGE(PG8_SA(1, 0), cA + kstep, voffA); PG8_STAGE(PG8_SB(1, 1), cB + hstepB + kstep, voffB);
        PG8_WAIT_V(6); PG8_BAR;
    } else {
        PG8_STAGE(PG8_SB(0, 0), cB, voffB); PG8_STAGE(PG8_SA(0, 0), cA, voffA); PG8_STAGE(PG8_SB(0, 1), cB + hstepB, voffB); PG8_STAGE(PG8_SA(0, 1), cA + hstepA, voffA);
        if (wr == 1) PG8_BAR;
        PG8_WAIT_V(4); PG8_BAR;
        PG8_STAGE(PG8_SB(1, 0), cB + kstep, voffB); PG8_STAGE(PG8_SA(1, 0), cA + kstep, voffA); PG8_STAGE(PG8_SB(1, 1), cB + hstepB + kstep, voffB);
        PG8_WAIT_V(6); PG8_BAR;
    }
    for (;;) {
        const bool has_next = S.next(ui + 1, nxt);
        const char* nA = has_next ? (const char*)g.A + (size_t)nxt.pm * tstepA : cA; const char* nB = has_next ? (const char*)g.Bt + (size_t)nxt.pn * tstepB : cB;
        for (int t = 0; t < nt; t += 2) {
            const bool last = (t == nt - 2);
            const char* a1 = cA + (size_t)(t + 1) * kstep;
            const char* a2 = last ? nA : cA + (size_t)(t + 2) * kstep; const char* b2 = last ? nB : cB + (size_t)(t + 2) * kstep;
            const char* a3 = a2 + kstep; const char* b3 = b2 + kstep;
            if (last && has_next) S.a_ready(nxt);
            if constexpr (SP2) {
            PG8_LDB(B0, 0, 0); PG8_LDB(B1, 0, 1); PG8_SCHED; PG8_LDA(At, 0, 0); PG8_STAGE(PG8_SA(1, 1), a1 + hstepA, voffA);
            PG8_WAIT_V(8); PG8_WAIT_L(0); PG8_BAR; PG8_MMA(0, 0, At, B0); PG8_MMA(0, 1, At, B1); PG8_BAR; PG8_SCHED;
            PG8_LDA(At, 0, 1); PG8_STAGE(PG8_SB(0, 0), b2, voffB); PG8_STAGE(PG8_SB(0, 1), b2 + hstepB, voffB); PG8_STAGE(PG8_SA(0, 0), a2, voffA);
            PG8_WAIT_V(8); PG8_WAIT_L(0); PG8_BAR; PG8_MMA(1, 0, At, B0); PG8_MMA(1, 1, At, B1); PG8_BAR; PG8_SCHED;
            PG8_LDB(B0, 1, 0); PG8_LDB(B1, 1, 1); PG8_SCHED; PG8_LDA(At, 1, 0); PG8_STAGE(PG8_SA(0, 1), a2 + hstepA, voffA);
            PG8_WAIT_V(8); PG8_WAIT_L(0); PG8_BAR; PG8_MMA(0, 0, At, B0); PG8_MMA(0, 1, At, B1); PG8_BAR; PG8_SCHED;
            PG8_LDA(At, 1, 1); PG8_STAGE(PG8_SB(1, 0), b3, voffB); PG8_STAGE(PG8_SB(1, 1), b3 + hstepB, voffB); PG8_STAGE(PG8_SA(1, 0), a3, voffA);
            PG8_WAIT_V(8); PG8_WAIT_L(0); PG8_BAR; PG8_MMA(1, 0, At, B0); PG8_MMA(1, 1, At, B1); PG8_BAR; PG8_SCHED;
            } else {
            PG8_LDB(B0, 0, 0); PG8_SCHED; PG8_LDA(At, 0, 0); PG8_STAGE(PG8_SA(1, 1), a1 + hstepA, voffA);
            PG8_WAIT_L(8); PG8_BAR; PG8_WAIT_L(0); PG8_MMA(0, 0, At, B0); PG8_BAR; PG8_SCHED;
            PG8_LDB(B1, 0, 1); PG8_STAGE(PG8_SB(0, 0), b2, voffB);
            PG8_BAR; PG8_WAIT_L(0); PG8_MMA(0, 1, At, B1); PG8_BAR;
            PG8_LDA(At, 0, 1); PG8_STAGE(PG8_SA(0, 0), a2, voffA);
            PG8_BAR; PG8_WAIT_L(0); PG8_MMA(1, 0, At, B0); PG8_BAR; PG8_SCHED;
            PG8_STAGE(PG8_SB(0, 1), b2 + hstepB, voffB);
            PG8_WAIT_V(6); PG8_BAR; PG8_MMA(1, 1, At, B1); PG8_BAR;
            PG8_LDB(B0, 1, 0); PG8_SCHED; PG8_LDA(At, 1, 0); PG8_STAGE(PG8_SA(0, 1), a2 + hstepA, voffA);
            PG8_WAIT_L(8); PG8_BAR; PG8_WAIT_L(0); PG8_MMA(0, 0, At, B0); PG8_BAR; PG8_SCHED;
            PG8_LDB(B1, 1, 1); PG8_STAGE(PG8_SB(1, 0), b3, voffB);
            PG8_BAR; PG8_WAIT_L(0); PG8_MMA(0, 1, At, B1); PG8_BAR;
            PG8_LDA(At, 1, 1); PG8_STAGE(PG8_SA(1, 0), a3, voffA);
            PG8_BAR; PG8_WAIT_L(0); PG8_MMA(1, 0, At, B0); PG8_BAR; PG8_SCHED;
            PG8_STAGE(PG8_SB(1, 1), b3 + hstepB, voffB);
            PG8_WAIT_V(6); PG8_BAR; PG8_MMA(1, 1, At, B1); PG8_BAR;
            }
        }
        if constexpr (ALIGN_EPI) { if (wr == 0) PG8_BAR; }
        if constexpr (!Epi::AFTER_DRAIN) { E(acc, cur, wr, wc, fr, fq); S.done(cur); }
        if (!has_next) break;
#pragma unroll
        for (int a = 0; a < 2; ++a)
#pragma unroll
            for (int b = 0; b < 2; ++b)
#pragma unroll
                for (int m = 0; m < 4; ++m)
#pragma unroll
                    for (int n = 0; n < 2; ++n) acc[a][b][m][n] = (f32x4){0.f, 0.f, 0.f, 0.f};
        cur = nxt; cA = nA; cB = nB; ++ui;
        if constexpr (ALIGN_EPI) { if (wr == 1) PG8_BAR; }
    }
    PG8_WAIT_V(0);
    if constexpr (!ALIGN_EPI) { if (wr == 0) PG8_BAR; }
    PG8_BAR;
#undef PG8_SA
#undef PG8_SB
#undef PG8_STAGE
#undef PG8_LDA
#undef PG8_LDB
#undef PG8_MMA
#undef PG8_WAIT_V
#undef PG8_WAIT_L
#undef PG8_BAR
#undef PG8_SCHED
}

template <int MODE> struct Epi {
    static constexpr bool PERM = false, AFTER_DRAIN = false;
    const float* rowsrc; float inv_n; float* ss; bf16_t* ob; int ldc; float* of; const float* xin;
    __device__ __forceinline__ void operator()(const f32x4 (&acc)[2][2][4][2], const Unit& u, int wr, int wc, int fr, int fq) const {
#pragma unroll
        for (int ai = 0; ai < 2; ++ai)
#pragma unroll
            for (int m = 0; m < 4; ++m) {
                const int row = u.pm * BM + ai * HALF + wr * 64 + m * 16 + fr;
                float rs = 1.f;
                if (MODE == 1) rs = rowsrc[row];
                if (MODE == 2 || MODE == 5) rs = rsqrtf(rowsrc[row] * inv_n + EPS);
                float ssq = 0.f;
#pragma unroll
                for (int bj = 0; bj < 2; ++bj)
#pragma unroll
                    for (int n = 0; n < 2; ++n) {
                        const int col = u.pn * BM + bj * HALF + wc * 32 + n * 16 + fq * 4;
                        f32x4 v = acc[ai][bj][m][n] * rs;
                        if (MODE == 1) { if (u.pn < 8) { v[0] = gelu_tanh(v[0]); v[1] = gelu_tanh(v[1]); v[2] = gelu_tanh(v[2]); v[3] = gelu_tanh(v[3]); } }
                        if (MODE == 4) { const f32x4 xr = *(const f32x4*)(xin + (size_t)row * DM + col); v = v + xr; }
                        if (MODE == 1 || MODE == 4) ssq += (v[0] * v[0] + v[1] * v[1]) + (v[2] * v[2] + v[3] * v[3]);
                        if (MODE == 1 || MODE == 2 || MODE == 4) { u32x2 w; w.x = pk2(v[0], v[1]); w.y = pk2(v[2], v[3]); *(u32x2*)(ob + (size_t)row * ldc + col) = w; }
                        if (MODE == 4 || MODE == 5) *(f32x4*)(of + (size_t)row * DM + col) = v;
                    }
                if (MODE == 1) {
                    const int seg = (u.pn >= 4 && u.pn < 8) ? 0 : ((u.pn == 8 || u.pn == 9) ? 1 : (u.pn == 10 ? 2 : -1));
                    if (seg >= 0) { ssq += __shfl_xor(ssq, 16); ssq += __shfl_xor(ssq, 32); if (fq == 0) atomicAdd(ss + seg * S + row, ssq); }
                }
                if (MODE == 4) { ssq += __shfl_xor(ssq, 16); ssq += __shfl_xor(ssq, 32); if (fq == 0) atomicAdd(ss + row, ssq); }
            }
    }
};
}

#define XB_TMO      128
#define XB_XCNT(j)  (256  + 64 * (j))
#define XB_XSUB(j)  (1280 + 64 * (j))
#define XB_XGEN(j)  (2304 + 64 * (j))
#define XB_TOP      3328
#define XB_TOPGEN   3392
#define XCD_BAR_WORDS 3456
#define XB_SPIN_CAP (1u << 18)
__device__ __forceinline__ unsigned xb_ld(unsigned* p)              { return __hip_atomic_load(p, __ATOMIC_RELAXED, __HIP_MEMORY_SCOPE_AGENT); }
__device__ __forceinline__ unsigned xb_add(unsigned* p, unsigned v) { return __hip_atomic_fetch_add(p, v, __ATOMIC_RELAXED, __HIP_MEMORY_SCOPE_AGENT); }
__device__ __forceinline__ unsigned xb_xcc_id() { return (unsigned)__builtin_amdgcn_s_getreg((3 << 11) | 20) & 0xFu; }
#define XB_SPIN(cond, bar) do { unsigned _sp = 0; while (cond) { __builtin_amdgcn_s_sleep(1); \
    if ((++_sp & 255u) == 0u) { if (xb_ld(&(bar)[XB_TMO])) break; if (_sp > XB_SPIN_CAP) { atomicAdd(&(bar)[XB_TMO], 1u); break; } } } } while (0)
struct XcdBarrier { unsigned* bar; unsigned x; volatile LAS unsigned* st; };
__device__ __forceinline__ XcdBarrier xcd_barrier_post(unsigned* bar, volatile LAS unsigned* st) {
    XcdBarrier b; b.bar = bar; b.x = xb_xcc_id(); b.st = st;
    if (threadIdx.x == 0) (void)xb_add(&bar[XB_XCNT(b.x)], 1u);
    return b;
}
__device__ __forceinline__ void xcd_barrier_complete(unsigned* bar, unsigned x, unsigned& nloc, unsigned& nx) {
    const unsigned G = gridDim.x * gridDim.y * gridDim.z;
    unsigned sum, cnt, mine, sp = 0u;
    for (;;) {
        sum = 0u; cnt = 0u; mine = 0u;
#pragma unroll
        for (unsigned j = 0; j < 16; ++j) { const unsigned c = xb_ld(&bar[XB_XCNT(j)]); sum += c; cnt += (c > 0u) ? 1u : 0u; mine = (j == x) ? c : mine; }
        if (sum == G) break;
        __builtin_amdgcn_s_sleep(1);
        if ((++sp & 255u) == 0u) { if (xb_ld(&bar[XB_TMO])) break; if (sp > XB_SPIN_CAP) { atomicAdd(&bar[XB_TMO], 1u); break; } }
    }
    nloc = mine > 0u ? mine : 1u; nx = cnt > 0u ? cnt : 1u;
}
__device__ __forceinline__ void xcd_barrier(const XcdBarrier& b) {
    asm volatile("s_waitcnt vmcnt(0)" ::: "memory");
    __syncthreads();
    if (threadIdx.x == 0) {
        unsigned* bar = b.bar;
        __builtin_amdgcn_s_waitcnt(0);
        unsigned nloc = b.st[0], nx = b.st[1];
        if (nloc == 0u) { xcd_barrier_complete(bar, b.x, nloc, nx); b.st[0] = nloc; b.st[1] = nx; }
        const unsigned old = xb_add(&bar[XB_XSUB(b.x)], 1u);
        const unsigned gen = old / nloc;
        if (old + 1u == (gen + 1u) * nloc) {
            __builtin_amdgcn_fence(__ATOMIC_RELEASE, "agent");
            asm volatile("s_waitcnt vmcnt(0)" ::: "memory");
            const unsigned og = xb_add(&bar[XB_TOP], 1u);
            const unsigned tg = og / nx;
            if (og + 1u == (tg + 1u) * nx) xb_add(&bar[XB_TOPGEN], 1u);
            else XB_SPIN(xb_ld(&bar[XB_TOPGEN]) == tg, bar);
            __builtin_amdgcn_fence(__ATOMIC_ACQUIRE, "agent");
            xb_add(&bar[XB_XGEN(b.x)], 1u);
            asm volatile("s_waitcnt vmcnt(0)" ::: "memory");
        } else {
            XB_SPIN(xb_ld(&bar[XB_XGEN(b.x)]) == gen, bar);
            __builtin_amdgcn_fence(__ATOMIC_ACQUIRE, "agent");
            asm volatile("s_waitcnt vmcnt(0)" ::: "memory");
        }
    }
    __syncthreads();
}

struct Params {
    const float* in[18];
    float* out;
    unsigned char* ws;
    int ph_lo, ph_hi;
};

__device__ __forceinline__ void p0_transpose_item(const float* W, const float* g, int K, int N, bf16_t* WT, LAS float* scr, int item, int lane) {
    const int nblk = N / 32, kb = item / nblk, nb = item % nblk, k0 = 64 * kb, n0 = 32 * nb;
#pragma unroll 8
    for (int i = 0; i < 32; ++i) { const int kk = 2 * i + (lane >> 5); const float gv = g ? g[k0 + kk] : 1.f;
        scr[kk * 33 + (lane & 31)] = W[(size_t)(k0 + kk) * N + n0 + (lane & 31)] * gv; }
    LDS_WAIT(); asm volatile("" ::: "memory");
    const int c = lane & 7;
#pragma unroll
    for (int j = 0; j < 4; ++j) { const int n = (lane >> 3) + 8 * j; const LAS float* s = scr + (8 * c) * 33 + n;
        u32x4 o; o.x = pk2(s[0 * 33], s[1 * 33]); o.y = pk2(s[2 * 33], s[3 * 33]); o.z = pk2(s[4 * 33], s[5 * 33]); o.w = pk2(s[6 * 33], s[7 * 33]);
        *(u32x4*)(WT + (size_t)(n0 + n) * K + k0 + 8 * c) = o; }
    LDS_WAIT(); asm volatile("" ::: "memory");
}
__device__ __forceinline__ float row_to_bf16(const float* src, const float* g, bf16_t* dst, int lane) {
    float ss = 0.f;
#pragma unroll
    for (int i = 0; i < 8; ++i) {
        const int c = (i * 64 + lane) * 4;
        f32x4 v = *(const f32x4*)(src + c);
        ss += (v[0] * v[0] + v[1] * v[1]) + (v[2] * v[2] + v[3] * v[3]);
        if (g) { const f32x4 gv = *(const f32x4*)(g + c); v = v * gv; }
        u32x2 w; w.x = pk2(v[0], v[1]); w.y = pk2(v[2], v[3]);
        *(u32x2*)(dst + c) = w;
    }
    return ss;
}
constexpr float PEER_USC = 80.0f, PEER_VSC = 5.0f;
constexpr int PEER_ROWB = 1536;
typedef float f32x16v __attribute__((ext_vector_type(16)));
typedef float f32x32v __attribute__((ext_vector_type(32)));
typedef unsigned u32x6 __attribute__((ext_vector_type(6)));
__device__ __forceinline__ void row_to_fp6(const float* src, const float* g, float scale, unsigned char* dst, int lane) {
    f32x16v a, b;
#pragma unroll
    for (int i = 0; i < 8; ++i) {
        f32x4 x = *(const f32x4*)(src + (i * 64 + lane) * 4) * scale;
        if (g) { const f32x4 gv = *(const f32x4*)(g + (i * 64 + lane) * 4); x = x * gv; }
#pragma unroll
        for (int q = 0; q < 4; ++q) { const float c = fminf(fmaxf(x[q], -7.5f), 7.5f); const int sl = 4 * i + q; if ((sl & 1) == 0) a[sl >> 1] = c; else b[sl >> 1] = c; }
    }
    const u32x6 pk = __builtin_amdgcn_cvt_scalef32_2xpk16_fp6_f32(a, b, 1.0f);
    *(u32x4*)(dst + lane * 16) = (u32x4){pk[0], pk[1], pk[2], pk[3]};
    *(u32x2*)(dst + 1024 + lane * 8) = (u32x2){pk[4], pk[5]};
}
__device__ __forceinline__ bf16x8 cvt8(const float* p) {
    const f32x4 a = *(const f32x4*)p, b = *(const f32x4*)(p + 4);
    u32x4 w; w.x = pk2(a[0], a[1]); w.y = pk2(a[2], a[3]); w.z = pk2(b[0], b[1]); w.w = pk2(b[2], b[3]);
    return __builtin_bit_cast(bf16x8, w);
}

__device__ __forceinline__ void phase0(const Params& p, LAS unsigned char* lds, int gw, int NGW, int wave, int lane) {
    unsigned char* ws = p.ws;
    LAS float* scr = (LAS float*)(lds + wave * 16384);
    const float* x = p.in[0];
    {
        constexpr int I_IN = (DM / 64) * (NIN / 32), I_UQ = (512 / 64) * (1536 / 32), I_UKV = (256 / 64) * (2048 / 32), I_OUT = (DM / 64) * (DM / 32);
        constexpr int NIT = I_IN + I_UQ + I_UKV + I_OUT;
        for (int it = gw; it < NIT; it += NGW) {
            int r = it;
            if (r < I_IN) { p0_transpose_item(p.in[2], p.in[1], DM, NIN, (bf16_t*)(ws + WS_WIN), scr, r, lane); continue; } r -= I_IN;
            if (r < I_UQ) { p0_transpose_item(p.in[7], p.in[6], 512, 1536, (bf16_t*)(ws + WS_WUQ), scr, r, lane); continue; } r -= I_UQ;
            if (r < I_UKV) { p0_transpose_item(p.in[9], p.in[8], 256, 2048, (bf16_t*)(ws + WS_WUKV), scr, r, lane); continue; } r -= I_UKV;
            p0_transpose_item(p.in[12], nullptr, DM, DM, (bf16_t*)(ws + WS_WOUT), scr, r, lane);
        }
    }
    for (int r = gw; r < NINP - NIN; r += NGW) {
        bf16_t* d = (bf16_t*)(ws + WS_WIN) + (size_t)(NIN + r) * DM;
#pragma unroll
        for (int i = 0; i < 4; ++i) *(u32x4*)(d + (i * 64 + lane) * 8) = (u32x4){0u, 0u, 0u, 0u};
    }
    {
        const float* wq = p.in[14]; const float* sk = p.in[15]; const float* g2 = p.in[13];
        bf16_t* WsT = (bf16_t*)(ws + WS_WS);
        const int r32 = lane & 31, hh = lane >> 5;
        for (int it = gw; it < 16 * 4 * 64; it += NGW) {
            const int hp = it >> 8, kb = (it >> 6) & 3, nb = it & 63;
            f32x16 acc = {};
            const float* ap = sk + ((size_t)(hp * 128 + kb * 32 + r32)) * 128 + hh * 8;
            const float* bp = wq + ((size_t)(nb * 32 + r32)) * DM + hp * 128 + hh * 8;
#pragma unroll
            for (int s = 0; s < 8; ++s) {
                const bf16x8 a = cvt8(ap + s * 16), b = cvt8(bp + s * 16);
                acc = __builtin_amdgcn_mfma_f32_32x32x16_bf16(a, b, acc, 0, 0, 0);
            }
            const int kcol = nb * 32 + r32; const float gk = g2[kcol];
#pragma unroll
            for (int r = 0; r < 16; ++r) WsT[(size_t)(hp * 128 + kb * 32 + crow(r, hh)) * DM + kcol] = (bf16_t)f2bf(acc[r] * gk);
        }
    }
    {
        bf16_t* xb = (bf16_t*)(ws + WS_XB); float* rstd1 = (float*)(ws + WS_RSTD1);
        for (int t = gw; t < S; t += NGW) {
            float ss = row_to_bf16(x + (size_t)t * DM, nullptr, xb + (size_t)t * DM, lane);
            ss = wave_sum(ss);
            if (lane == 0) rstd1[t] = rsqrtf(ss * (1.0f / DM) + EPS);
        }
    }
    {
        unsigned char* UT = ws + WS_UT; unsigned char* VT = ws + WS_VT;
        for (int e = gw; e < 2 * 16384; e += NGW) {
            if (e < 16384) row_to_fp6(p.in[16] + (size_t)e * DM, p.in[13], PEER_USC, UT + (size_t)e * PEER_ROWB, lane);
            else row_to_fp6(p.in[17] + (size_t)(e - 16384) * DM, nullptr, PEER_VSC, VT + (size_t)(e - 16384) * PEER_ROWB, lane);
        }
    }
    {
        float* ct = (float*)(ws + WS_COS); float* st = (float*)(ws + WS_SIN);
        for (int it = gw; it < S * 32 / 64; it += NGW) {
            const int idx = it * 64 + lane, t = idx >> 5, j = idx & 31;
            const float inv_freq = powf(10000.0f, -(float)j / 32.0f);
            const float ang = (float)t * inv_freq;
            ct[idx] = cosf(ang); st[idx] = sinf(ang);
        }
    }
}

__device__ __forceinline__ void phase3(const Params& p, int gw, int NGW, int lane) {
    unsigned char* ws = p.ws;
    const bf16_t* qraw = (const bf16_t*)(ws + WS_QRAW); const bf16_t* kvraw = (const bf16_t*)(ws + WS_KVRAW); const bf16_t* proj = (const bf16_t*)(ws + WS_PROJ);
    bf16_t* Qh = (bf16_t*)(ws + WS_QH); bf16_t* Kh = (bf16_t*)(ws + WS_KH); bf16_t* Vh = (bf16_t*)(ws + WS_VH);
    const float* ct = (const float*)(ws + WS_COS); const float* st = (const float*)(ws + WS_SIN);
    const float* gq = p.in[10]; const float* gk = p.in[11];
    const float gq0 = gq[lane], gq1 = gq[64 + lane], gq2 = gq[128 + lane], gk0 = gk[lane], gk1 = gk[64 + lane], gk2 = gk[128 + lane];
    constexpr float QS = 0.07216878364870322f * 1.4426950408889634f;
    for (int t = gw; t < S; t += NGW) {
        const float cs = ct[t * 32 + (lane & 31)], sn = st[t * 32 + (lane & 31)];
        const float kr = bf2f(proj[(size_t)t * NINP + 2816 + lane]);
#pragma unroll
        for (int h = 0; h < 8; ++h) {
            const bf16_t* qp = qraw + (size_t)t * 1536 + h * 192;
            float q0 = bf2f(qp[lane]), q1 = bf2f(qp[64 + lane]), q2 = bf2f(qp[128 + lane]);
            float ss = wave_sum(q0 * q0 + q1 * q1 + q2 * q2);
            float rs = rsqrtf(ss * (1.0f / 192.0f) + EPS);
            q0 *= rs * gq0; q1 *= rs * gq1; q2 *= rs * gq2;
            float pr = __shfl_xor(q2, 32);
            q2 = (lane < 32) ? (q2 * cs - pr * sn) : (pr * sn + q2 * cs);
            bf16_t* qo = Qh + ((size_t)h * S + t) * 192;
            qo[lane] = (bf16_t)f2bf(q0 * QS); qo[64 + lane] = (bf16_t)f2bf(q1 * QS); qo[128 + lane] = (bf16_t)f2bf(q2 * QS);
            const bf16_t* kp = kvraw + (size_t)t * 2048 + h * 256;
            float k0 = bf2f(kp[lane]), k1 = bf2f(kp[64 + lane]), k2 = kr;
            ss = wave_sum(k0 * k0 + k1 * k1 + k2 * k2);
            rs = rsqrtf(ss * (1.0f / 192.0f) + EPS);
            k0 *= rs * gk0; k1 *= rs * gk1; k2 *= rs * gk2;
            pr = __shfl_xor(k2, 32);
            k2 = (lane < 32) ? (k2 * cs - pr * sn) : (pr * sn + k2 * cs);
            bf16_t* ko = Kh + ((size_t)h * S + t) * 192;
            ko[lane] = (bf16_t)f2bf(k0); ko[64 + lane] = (bf16_t)f2bf(k1); ko[128 + lane] = (bf16_t)f2bf(k2);
            bf16_t* vo = Vh + ((size_t)h * S + t) * 128;
            vo[lane] = kp[128 + lane]; vo[64 + lane] = kp[192 + lane];
        }
    }
}

constexpr int KP = 400, VP = 320;
constexpr int ATT_BUF = 64 * KP + 64 * VP;
template <int OFF> __device__ __forceinline__ s16x4 tr_read(unsigned addr) {
    s16x4 r; asm volatile("ds_read_b64_tr_b16 %0, %1 offset:%2" : "=&v"(r) : "v"(addr), "i"(OFF) : "memory"); return r;
}
__device__ __forceinline__ unsigned cvtpk(float lo, float hi) { unsigned r; asm volatile("v_cvt_pk_bf16_f32 %0, %1, %2" : "=v"(r) : "v"(lo), "v"(hi)); return r; }
#define PK8(L, H) ((bf16x8){L[0], L[1], L[2], L[3], H[0], H[1], H[2], H[3]})
constexpr float ATT_THR = 8.0f;

__device__ __forceinline__ void attn_tile(const LAS unsigned char* kbuf, unsigned vaddr, const bf16x8 (&qr)[12], f32x16 (&o)[4], float& m, float& lsum, int lane) {
    f32x16 pacc = {};
    const LAS unsigned char* kp = kbuf + (lane & 31) * KP + (lane >> 5) * 16;
#pragma unroll
    for (int ks = 0; ks < 12; ++ks) { const bf16x8 a = *(const LAS bf16x8*)(kp + ks * 32); pacc = __builtin_amdgcn_mfma_f32_32x32x16_bf16(a, qr[ks], pacc, 0, 0, 0); }
    float pmax = pacc[0];
#pragma unroll
    for (int r = 1; r < 16; ++r) pmax = fmaxf(pmax, pacc[r]);
    pmax = fmaxf(pmax, __shfl_xor(pmax, 32));
    if (!__all(pmax - m <= ATT_THR)) {
        const float mn = fmaxf(m, pmax); const float alpha = __builtin_amdgcn_exp2f(m - mn); m = mn; lsum *= alpha;
#pragma unroll
        for (int d = 0; d < 4; ++d)
#pragma unroll
            for (int r = 0; r < 16; ++r) o[d][r] *= alpha;
    }
    float ps = 0.f;
#pragma unroll
    for (int r = 0; r < 16; ++r) { pacc[r] = __builtin_amdgcn_exp2f(pacc[r] - m); ps += pacc[r]; }
    ps += __shfl_xor(ps, 32);
    lsum += ps;
    u32x4 w0 = {cvtpk(pacc[0], pacc[1]), cvtpk(pacc[2], pacc[3]), cvtpk(pacc[4], pacc[5]), cvtpk(pacc[6], pacc[7])};
    u32x4 w1 = {cvtpk(pacc[8], pacc[9]), cvtpk(pacc[10], pacc[11]), cvtpk(pacc[12], pacc[13]), cvtpk(pacc[14], pacc[15])};
    const bf16x8 pb0 = __builtin_bit_cast(bf16x8, w0), pb1 = __builtin_bit_cast(bf16x8, w1);
#define VOFF(d0, s, hi) (((16 * (s) + 8 * (hi)) * VP) + 64 * (d0))
    const s16x4 a00l = tr_read<VOFF(0, 0, 0)>(vaddr), a00h = tr_read<VOFF(0, 0, 1)>(vaddr), a01l = tr_read<VOFF(0, 1, 0)>(vaddr), a01h = tr_read<VOFF(0, 1, 1)>(vaddr);
    const s16x4 a10l = tr_read<VOFF(1, 0, 0)>(vaddr), a10h = tr_read<VOFF(1, 0, 1)>(vaddr), a11l = tr_read<VOFF(1, 1, 0)>(vaddr), a11h = tr_read<VOFF(1, 1, 1)>(vaddr);
    const s16x4 a20l = tr_read<VOFF(2, 0, 0)>(vaddr), a20h = tr_read<VOFF(2, 0, 1)>(vaddr), a21l = tr_read<VOFF(2, 1, 0)>(vaddr), a21h = tr_read<VOFF(2, 1, 1)>(vaddr);
    const s16x4 a30l = tr_read<VOFF(3, 0, 0)>(vaddr), a30h = tr_read<VOFF(3, 0, 1)>(vaddr), a31l = tr_read<VOFF(3, 1, 0)>(vaddr), a31h = tr_read<VOFF(3, 1, 1)>(vaddr);
#undef VOFF
    LDS_WAIT(); SBAR();
    o[0] = __builtin_amdgcn_mfma_f32_32x32x16_bf16(PK8(a00l, a00h), pb0, o[0], 0, 0, 0); o[0] = __builtin_amdgcn_mfma_f32_32x32x16_bf16(PK8(a01l, a01h), pb1, o[0], 0, 0, 0);
    o[1] = __builtin_amdgcn_mfma_f32_32x32x16_bf16(PK8(a10l, a10h), pb0, o[1], 0, 0, 0); o[1] = __builtin_amdgcn_mfma_f32_32x32x16_bf16(PK8(a11l, a11h), pb1, o[1], 0, 0, 0);
    o[2] = __builtin_amdgcn_mfma_f32_32x32x16_bf16(PK8(a20l, a20h), pb0, o[2], 0, 0, 0); o[2] = __builtin_amdgcn_mfma_f32_32x32x16_bf16(PK8(a21l, a21h), pb1, o[2], 0, 0, 0);
    o[3] = __builtin_amdgcn_mfma_f32_32x32x16_bf16(PK8(a30l, a30h), pb0, o[3], 0, 0, 0); o[3] = __builtin_amdgcn_mfma_f32_32x32x16_bf16(PK8(a31l, a31h), pb1, o[3], 0, 0, 0);
}

__device__ __forceinline__ void attn_unit(const Params& p, LAS unsigned char* lds, int head, int qb, int tid, int wave, int lane) {
    unsigned char* ws = p.ws;
    const bf16_t* Qh = (const bf16_t*)(ws + WS_QH); const bf16_t* Kh = (const bf16_t*)(ws + WS_KH); const bf16_t* Vh = (const bf16_t*)(ws + WS_VH);
    bf16_t* mix = (bf16_t*)(ws + WS_MIX);
    const int rg = wave & 3, kh = wave >> 2, r32 = lane & 31, hh = lane >> 5;
    const int q0row = qb * 128 + rg * 32;
    bf16x8 qr[12];
    {
        const bf16_t* qp = Qh + ((size_t)head * S + q0row + r32) * 192 + hh * 8;
#pragma unroll
        for (int ks = 0; ks < 12; ++ks) qr[ks] = *(const bf16x8*)(qp + ks * 16);
    }
    const int ntiles = 2 * qb + 2, mylast = 2 * qb + (rg >> 1);
    float m = -1e30f, lsum = 0.f; f32x16 o[4] = {};
    int kgo[3], klo[3], vgo[2], vlo[2];
#pragma unroll
    for (int i = 0; i < 3; ++i) { const int pc = tid + 512 * i, r = pc / 24, c = pc % 24; kgo[i] = r * 192 + c * 8; klo[i] = r * KP + c * 16; }
#pragma unroll
    for (int i = 0; i < 2; ++i) { const int pc = tid + 512 * i, r = pc >> 4, c = pc & 15; vgo[i] = r * 128 + c * 8; vlo[i] = 64 * KP + r * VP + c * 16; }
    const bf16_t* kbase = Kh + (size_t)head * S * 192; const bf16_t* vbase = Vh + (size_t)head * S * 128;
    u32x4 sk0, sk1, sk2, sv0, sv1;
#define ATT_LOAD(t) do { const bf16_t* kt = kbase + (size_t)(t) * 64 * 192; const bf16_t* vt = vbase + (size_t)(t) * 64 * 128; \
        sk0 = *(const u32x4*)(kt + kgo[0]); sk1 = *(const u32x4*)(kt + kgo[1]); sk2 = *(const u32x4*)(kt + kgo[2]); sv0 = *(const u32x4*)(vt + vgo[0]); sv1 = *(const u32x4*)(vt + vgo[1]); } while (0)
#define ATT_WRITE(b) do { LAS unsigned char* bb = lds + (b) * ATT_BUF; *(LAS u32x4*)(bb + klo[0]) = sk0; *(LAS u32x4*)(bb + klo[1]) = sk1; *(LAS u32x4*)(bb + klo[2]) = sk2; \
        *(LAS u32x4*)(bb + vlo[0]) = sv0; *(LAS u32x4*)(bb + vlo[1]) = sv1; } while (0)
    const unsigned ldsbase = (unsigned)(size_t)lds;
    const unsigned vrel = (unsigned)(64 * KP + (32 * kh + 4 * hh + ((lane & 15) >> 2)) * VP + (16 * ((lane >> 4) & 1) + 4 * (lane & 3)) * 2);
    ATT_LOAD(0); ATT_WRITE(0); __syncthreads();
    for (int t = 0; t < ntiles; ++t) {
        const bool more = (t + 1 < ntiles);
        if (more) ATT_LOAD(t + 1);
        if (t <= mylast) {
            const int b = t & 1;
            attn_tile(lds + b * ATT_BUF + (32 * kh) * KP, ldsbase + b * ATT_BUF + vrel, qr, o, m, lsum, lane);
        }
        if (more) ATT_WRITE((t + 1) & 1);
        __syncthreads();
    }
#undef ATT_LOAD
#undef ATT_WRITE
    LAS float* scr = (LAS float*)lds + (size_t)rg * 66 * 64 + lane;
    if (kh == 1) {
        scr[0] = m; scr[64] = lsum;
#pragma unroll
        for (int d = 0; d < 4; ++d)
#pragma unroll
            for (int r = 0; r < 16; ++r) scr[(2 + d * 16 + r) * 64] = o[d][r];
    }
    __syncthreads();
    if (kh == 0) {
        const float m2 = scr[0], l2 = scr[64];
        const float mn = fmaxf(m, m2), a1 = __builtin_amdgcn_exp2f(m - mn), a2 = __builtin_amdgcn_exp2f(m2 - mn);
        const float inv = 1.0f / (lsum * a1 + l2 * a2);
        bf16_t* op = mix + (size_t)(q0row + r32) * DM + 1024 + head * 128 + 4 * hh;
#pragma unroll
        for (int d = 0; d < 4; ++d)
#pragma unroll
            for (int g4 = 0; g4 < 4; ++g4) {
                float v[4];
#pragma unroll
                for (int i = 0; i < 4; ++i) { const int r = 4 * g4 + i; v[i] = (o[d][r] * a1 + scr[(2 + d * 16 + r) * 64] * a2) * inv; }
                u32x2 w; w.x = pk2(v[0], v[1]); w.y = pk2(v[2], v[3]);
                *(u32x2*)(op + 32 * d + 8 * g4) = w;
            }
    }
    __syncthreads();
}

__device__ __forceinline__ void gmlp_unit(const Params& p, LAS unsigned char* lds, int nb, int h, int tid, int wave, int lane) {
    unsigned char* ws = p.ws;
    const bf16_t* proj = (const bf16_t*)(ws + WS_PROJ); bf16_t* mix = (bf16_t*)(ws + WS_MIX);
    const float* ssv = (const float*)(ws + WS_ROWSS);
    const float* vg = p.in[3]; const float* wsp = p.in[4]; const float* bs = p.in[5];
#pragma unroll
    for (int i = 0; i < 4; ++i) {
        const int pc = tid + 512 * i, r = pc >> 4, c = pc & 15, t = nb * 128 + r;
        const u32x4 w = *(const u32x4*)(proj + (size_t)t * NINP + 1024 + h * 128 + c * 8);
        const float rs = rsqrtf(ssv[t] * (1.0f / 1024.0f) + EPS);
        const f32x4 g0 = *(const f32x4*)(vg + h * 128 + c * 8), g1 = *(const f32x4*)(vg + h * 128 + c * 8 + 4);
        u32x4 ov;
        ov.x = pk2(bflo(w.x) * rs * g0[0], bfhi(w.x) * rs * g0[1]); ov.y = pk2(bflo(w.y) * rs * g0[2], bfhi(w.y) * rs * g0[3]);
        ov.z = pk2(bflo(w.z) * rs * g1[0], bfhi(w.z) * rs * g1[1]); ov.w = pk2(bflo(w.w) * rs * g1[2], bfhi(w.w) * rs * g1[3]);
        *(LAS u32x4*)(lds + r * VP + c * 16) = ov;
    }
    __syncthreads();
    const int ib = wave & 3, ch = wave >> 2, r32 = lane & 31, hh = lane >> 5;
    const int irow = 32 * ib + r32;
    f32x16 acc0 = {}, acc1 = {};
    const unsigned vaddr = (unsigned)(size_t)lds + (unsigned)((8 * hh + ((lane & 15) >> 2)) * VP + (64 * ch + 16 * ((lane >> 4) & 1) + 4 * (lane & 3)) * 2);
    const float* wrow = wsp + ((size_t)h * 128 + irow) * 128 + hh * 8;
#define GSTEP(s) do { if ((s) < 2 * (ib + 1)) { \
        const f32x4 wa = *(const f32x4*)(wrow + (s) * 16), wb = *(const f32x4*)(wrow + (s) * 16 + 4); const int j0 = (s) * 16 + hh * 8; \
        u32x4 aw; aw.x = pk2(j0 + 0 <= irow ? wa[0] : 0.f, j0 + 1 <= irow ? wa[1] : 0.f); aw.y = pk2(j0 + 2 <= irow ? wa[2] : 0.f, j0 + 3 <= irow ? wa[3] : 0.f); \
        aw.z = pk2(j0 + 4 <= irow ? wb[0] : 0.f, j0 + 5 <= irow ? wb[1] : 0.f); aw.w = pk2(j0 + 6 <= irow ? wb[2] : 0.f, j0 + 7 <= irow ? wb[3] : 0.f); \
        const bf16x8 af = __builtin_bit_cast(bf16x8, aw); \
        const s16x4 b0l = tr_read<(16 * (s)) * VP>(vaddr), b0h = tr_read<(16 * (s) + 4) * VP>(vaddr), b1l = tr_read<(16 * (s)) * VP + 64>(vaddr), b1h = tr_read<(16 * (s) + 4) * VP + 64>(vaddr); \
        LDS_WAIT(); SBAR(); \
        acc0 = __builtin_amdgcn_mfma_f32_32x32x16_bf16(af, PK8(b0l, b0h), acc0, 0, 0, 0); acc1 = __builtin_amdgcn_mfma_f32_32x32x16_bf16(af, PK8(b1l, b1h), acc1, 0, 0, 0); } } while (0)
    GSTEP(0); GSTEP(1); GSTEP(2); GSTEP(3); GSTEP(4); GSTEP(5); GSTEP(6); GSTEP(7);
#undef GSTEP
#pragma unroll
    for (int r = 0; r < 16; ++r) {
        const int i = 32 * ib + crow(r, hh), t = nb * 128 + i; const float b = bs[h * 128 + i];
        const int c0 = h * 128 + 64 * ch + r32;
        const float u0 = bf2f(proj[(size_t)t * NINP + c0]), u1 = bf2f(proj[(size_t)t * NINP + c0 + 32]);
        mix[(size_t)t * DM + c0] = (bf16_t)f2bf(u0 * (acc0[r] + b)); mix[(size_t)t * DM + c0 + 32] = (bf16_t)f2bf(u1 * (acc1[r] + b));
    }
    __syncthreads();
}

template <int CTRL, int ROW_MASK> __device__ __forceinline__ float dpp_f(float old, float v) {
    return __builtin_bit_cast(float, __builtin_amdgcn_update_dpp(__builtin_bit_cast(int, old), __builtin_bit_cast(int, v), CTRL, ROW_MASK, 0xf, false));
}
__device__ __forceinline__ float wave_max_u(float v) {
    v = fmaxf(v, dpp_f<0xB1, 0xf>(v, v));
    v = fmaxf(v, dpp_f<0x4E, 0xf>(v, v));
    v = fmaxf(v, dpp_f<0x141, 0xf>(v, v));
    v = fmaxf(v, dpp_f<0x140, 0xf>(v, v));
    v = fmaxf(v, dpp_f<0x142, 0xa>(v, v));
    v = fmaxf(v, dpp_f<0x143, 0xc>(v, v));
    return __builtin_bit_cast(float, __builtin_amdgcn_readlane(__builtin_bit_cast(int, v), 63));
}
__device__ __forceinline__ float wave_sum_u(float v) {
    v += dpp_f<0xB1, 0xf>(0.f, v);
    v += dpp_f<0x4E, 0xf>(0.f, v);
    v += dpp_f<0x141, 0xf>(0.f, v);
    v += dpp_f<0x140, 0xf>(0.f, v);
    v += dpp_f<0x142, 0xa>(0.f, v);
    v += dpp_f<0x143, 0xc>(0.f, v);
    return __builtin_bit_cast(float, __builtin_amdgcn_readlane(__builtin_bit_cast(int, v), 63));
}
__device__ __forceinline__ void phase7(const Params& p, LAS unsigned char* lds, int gw, int NGW, int wave, int lane) {
    unsigned char* ws = p.ws;
    const float* sc = (const float*)(ws + WS_SC); int* ex = (int*)(ws + WS_EXP); float* gt = (float*)(ws + WS_GATE);
    const float NEG = -3.0e38f;
    LAS float* sl = (LAS float*)(lds + wave * 1024);
    const int j8 = lane & 7, g8 = lane >> 3, row = lane >> 4, i16 = lane & 15;
    int ci[4], cj[4]; bool cval[4];
    {
        constexpr int starts[16] = {0, 16, 24, 29, 33, 36, 38, 40, 42, 43, 44, 45, 46, 47, 48, 49};
#pragma unroll
        for (int m = 0; m < 4; ++m) {
            const int c = i16 + 16 * m; int a = 0, st = 0;
#pragma unroll
            for (int i = 1; i < 16; ++i) if (c >= starts[i]) { a = i; st = starts[i]; }
            cval[m] = c < 50; ci[m] = cval[m] ? a : 0; cj[m] = cval[m] ? (c - st) : 0;
        }
    }
    constexpr int NT = S * 2;
    f32x4 nx0, nx1, nx2, nx3;
    if (gw < NT) { const float* b = sc + (size_t)(gw >> 1) * DM + (gw & 1) * 1024 + lane * 16; nx0 = *(const f32x4*)b; nx1 = *(const f32x4*)(b + 4); nx2 = *(const f32x4*)(b + 8); nx3 = *(const f32x4*)(b + 12); }
    for (int it = gw; it < NT; it += NGW) {
        const int t = it >> 1, hh = it & 1;
        float v[16];
#pragma unroll
        for (int q = 0; q < 4; ++q) { v[q] = nx0[q]; v[4 + q] = nx1[q]; v[8 + q] = nx2[q]; v[12 + q] = nx3[q]; }
        if (it + NGW < NT) { const int it2 = it + NGW; const float* b = sc + (size_t)(it2 >> 1) * DM + (it2 & 1) * 1024 + lane * 16;
            nx0 = *(const f32x4*)b; nx1 = *(const f32x4*)(b + 4); nx2 = *(const f32x4*)(b + 8); nx3 = *(const f32x4*)(b + 12); }
#pragma unroll
        for (int m = 0; m < 16; ++m) v[m] = __builtin_bit_cast(float, (__builtin_bit_cast(unsigned, v[m]) & ~127u) | (unsigned)(16 * j8 + m));
        float ra = 0.f, rb = 0.f;
#pragma unroll
        for (int k = 0; k < 16; ++k) {
            float mx = fmaxf(fmaxf(fmaxf(v[0], v[1]), fmaxf(v[2], v[3])), fmaxf(fmaxf(v[4], v[5]), fmaxf(v[6], v[7])));
            mx = fmaxf(mx, fmaxf(fmaxf(fmaxf(v[8], v[9]), fmaxf(v[10], v[11])), fmaxf(fmaxf(v[12], v[13]), fmaxf(v[14], v[15]))));
            mx = fmaxf(mx, dpp_f<0xB1, 0xf>(mx, mx));
            mx = fmaxf(mx, dpp_f<0x4E, 0xf>(mx, mx));
            mx = fmaxf(mx, dpp_f<0x141, 0xf>(mx, mx));
#pragma unroll
            for (int m = 0; m < 16; ++m) v[m] = (v[m] == mx) ? NEG : v[m];
            if (k < 8) ra = (j8 == k) ? mx : ra; else rb = (j8 == k - 8) ? mx : rb;
        }
        sl[g8 * 16 + j8] = ra; sl[g8 * 16 + 8 + j8] = rb;
        LDS_WAIT(); asm volatile("" ::: "memory");
        float cv[4], og[4]; int id[4];
#pragma unroll
        for (int m = 0; m < 4; ++m) {
            const float s1 = sl[(2 * row) * 16 + ci[m]], s2 = sl[(2 * row + 1) * 16 + cj[m]];
            og[m] = cval[m] ? (s1 + s2) : NEG; cv[m] = og[m];
            id[m] = (int)((__builtin_bit_cast(unsigned, s1) & 127u) * 128u + (__builtin_bit_cast(unsigned, s2) & 127u));
        }
        LDS_WAIT(); asm volatile("" ::: "memory");
        float M0 = 0.f;
#pragma unroll
        for (int k = 0; k < 16; ++k) {
            float mx = fmaxf(fmaxf(cv[0], cv[1]), fmaxf(cv[2], cv[3]));
            mx = fmaxf(mx, dpp_f<0xB1, 0xf>(mx, mx));
            mx = fmaxf(mx, dpp_f<0x4E, 0xf>(mx, mx));
            mx = fmaxf(mx, dpp_f<0x141, 0xf>(mx, mx));
            mx = fmaxf(mx, dpp_f<0x140, 0xf>(mx, mx));
            if (k == 0) M0 = mx;
#pragma unroll
            for (int m = 0; m < 4; ++m) cv[m] = (cv[m] == mx) ? NEG : cv[m];
        }
        bool sel[4]; float e[4]; float es = 0.f;
#pragma unroll
        for (int m = 0; m < 4; ++m) { sel[m] = (cv[m] != og[m]); e[m] = sel[m] ? __expf(og[m] - M0) : 0.f; es += e[m]; }
        es += dpp_f<0xB1, 0xf>(0.f, es); es += dpp_f<0x4E, 0xf>(0.f, es); es += dpp_f<0x141, 0xf>(0.f, es); es += dpp_f<0x140, 0xf>(0.f, es);
        const float inv = 1.0f / es;
        int basepos = 0;
        const int head = 4 * hh + row;
#pragma unroll
        for (int m = 0; m < 4; ++m) {
            const unsigned long long bl = __ballot(sel[m]);
            const unsigned rbits = (unsigned)(bl >> (16 * row)) & 0xffffu;
            const int pos = basepos + __popc(rbits & ((1u << i16) - 1u));
            if (sel[m] && pos < 16) { ex[(size_t)t * 128 + head * 16 + pos] = id[m]; gt[(size_t)t * 128 + head * 16 + pos] = e[m] * inv; }
            basepos += __popc(rbits);
        }
    }
}

typedef __bf16 bf16x32v __attribute__((ext_vector_type(32)));
typedef __bf16 bf16x2v __attribute__((ext_vector_type(2)));
typedef float f32x2 __attribute__((ext_vector_type(2)));
#ifndef P8_THROTTLE
#define P8_THROTTLE 0
#endif
constexpr unsigned P8_SLACK = 12;
__device__ __forceinline__ void phase8(const Params& p, LAS unsigned char* lds, float* dst, unsigned xcc, unsigned nwx, int gw, int NGW, int wave, int lane) {
    unsigned char* ws = p.ws;
    const bf16_t* x1b = (const bf16_t*)(ws + WS_X1B); const unsigned char* UT = ws + WS_UT; const unsigned char* VT = ws + WS_VT;
    const int* ex = (const int*)(ws + WS_EXP); const float* gt = (const float*)(ws + WS_GATE); const float* ss2 = (const float*)(ws + WS_ROWSS) + 3 * S;
    const float* out = p.out;
    LAS unsigned char* xl = lds + wave * 16384;
    LAS unsigned* list = (LAS unsigned*)(lds + 131072 + wave * 2048);
    LAS unsigned* hist = (LAS unsigned*)(lds + 147456 + wave * 256);
    for (int tb = gw; tb < S / 4; tb += NGW) {
        const int t0 = tb * 4;
        int id[8]; float gv[8];
#pragma unroll
        for (int r = 0; r < 8; ++r) { const size_t o = (size_t)(t0 + (r >> 1)) * 128 + (r & 1) * 64 + lane; id[r] = ex[o]; gv[r] = gt[o]; }
        const float rs0 = rsqrtf(ss2[t0 + 0] * (1.0f / DM) + EPS) * (1.0f / PEER_USC), rs1 = rsqrtf(ss2[t0 + 1] * (1.0f / DM) + EPS) * (1.0f / PEER_USC);
        const float rs2 = rsqrtf(ss2[t0 + 2] * (1.0f / DM) + EPS) * (1.0f / PEER_USC), rs3 = rsqrtf(ss2[t0 + 3] * (1.0f / DM) + EPS) * (1.0f / PEER_USC);
        hist[lane] = 0u;
        LDS_WAIT(); asm volatile("" ::: "memory");
        unsigned pos[8];
#pragma unroll
        for (int r = 0; r < 8; ++r) pos[r] = __hip_atomic_fetch_add(hist + (id[r] >> 8), 1u, __ATOMIC_RELAXED, __HIP_MEMORY_SCOPE_WORKGROUP);
        LDS_WAIT(); asm volatile("" ::: "memory");
        const unsigned cnt = hist[lane];
        unsigned inc = cnt;
#pragma unroll
        for (int o = 1; o < 64; o <<= 1) { const unsigned n = __shfl_up(inc, o); if (lane >= o) inc += n; }
        LDS_WAIT(); asm volatile("" ::: "memory");
        hist[lane] = inc - cnt;
        LDS_WAIT(); asm volatile("" ::: "memory");
#pragma unroll
        for (int r = 0; r < 8; ++r) { const unsigned d = hist[id[r] >> 8] + pos[r]; list[d] = (unsigned)id[r] | ((unsigned)(r >> 1) << 14) | (f2bf(gv[r]) << 16); }
#pragma unroll
        for (int j = 0; j < 4; ++j)
#pragma unroll
            for (int g = 0; g < 4; ++g) {
                const u32x2 w0 = *(const u32x2*)(x1b + (size_t)(t0 + j) * DM + ((2 * g) * 64 + lane) * 4), w1 = *(const u32x2*)(x1b + (size_t)(t0 + j) * DM + ((2 * g + 1) * 64 + lane) * 4);
                *(LAS u32x4*)(xl + j * 4096 + g * 1024 + lane * 16) = (u32x4){w0.x, w0.y, w1.x, w1.y};
            }
        asm volatile("s_waitcnt vmcnt(0) lgkmcnt(0)" ::: "memory");
#define P8_ULOAD(k, i) do { const unsigned en = (unsigned)__builtin_amdgcn_readfirstlane((int)list[(i)]); uen[k] = en; \
            const size_t ro = (size_t)(en & (((PROBE_DUP >> 11) & 1) && urep == 0 ? 0x3ffu : 0x3fffu)) * PEER_ROWB; u4[k] = *(const u32x4*)(UT + ro + lane * 16); u2[k] = *(const u32x2*)(UT + ro + 1024 + lane * 8); } while (0)
#define P8_UPROC(k) do { const u32x6 pk = {u4[k][0], u4[k][1], u4[k][2], u4[k][3], u2[k][0], u2[k][1]}; \
            const bf16x32v r_ = __builtin_amdgcn_cvt_scalef32_pk32_bf16_fp6(pk, 1.0f); const LAS unsigned char* xp = xl + ((uen[k] >> 14) & 3u) * 4096 + lane * 16; \
            float d0 = 0.f, d1 = 0.f, d2 = 0.f, d3 = 0.f; \
            _Pragma("unroll") for (int g = 0; g < 4; ++g) { const LAS unsigned* xw = (const LAS unsigned*)(xp + g * 1024); const unsigned x0 = xw[0], x1 = xw[1], x2 = xw[2], x3 = xw[3]; \
                { const bf16x2v uu = {r_[8 * g + 0], r_[8 * g + 1]}; d0 = __builtin_amdgcn_fdot2_f32_bf16(uu, __builtin_bit_cast(bf16x2v, x0), d0, false); } \
                { const bf16x2v uu = {r_[8 * g + 2], r_[8 * g + 3]}; d1 = __builtin_amdgcn_fdot2_f32_bf16(uu, __builtin_bit_cast(bf16x2v, x1), d1, false); } \
                { const bf16x2v uu = {r_[8 * g + 4], r_[8 * g + 5]}; d2 = __builtin_amdgcn_fdot2_f32_bf16(uu, __builtin_bit_cast(bf16x2v, x2), d2, false); } \
                { const bf16x2v uu = {r_[8 * g + 6], r_[8 * g + 7]}; d3 = __builtin_amdgcn_fdot2_f32_bf16(uu, __builtin_bit_cast(bf16x2v, x3), d3, false); } } \
            const float dsum = wave_sum_u((d0 + d1) + (d2 + d3)); \
            dres = (lane == k) ? dsum : dres; } while (0)
#if (PROBE_DUP >> 10) & 1
#define P8_UREPS 2
#else
#define P8_UREPS 1
#endif
#pragma unroll 1
        for (int urep = 0; urep < P8_UREPS; ++urep) {
            u32x4 u4[8]; u32x2 u2[8]; unsigned uen[8];
#pragma unroll
            for (int k = 0; k < 8; ++k) P8_ULOAD(k, k);
#pragma unroll 1
            for (int i = 0; i < 512; i += 8) {
                const unsigned ev = list[i + (lane & 7)]; const unsigned jl = (ev >> 14) & 3u;
                const float gl = __builtin_bit_cast(float, ev & 0xffff0000u), rl = jl == 0u ? rs0 : (jl == 1u ? rs1 : (jl == 2u ? rs2 : rs3));
                float dres = 0.f;
#pragma unroll
                for (int k = 0; k < 8; ++k) { P8_UPROC(k); if (i + 8 < 512) P8_ULOAD(k, i + 8 + k); }
                const float c_ = gl * gelu_tanh(rl * dres) * (1.0f / PEER_VSC);
                if (lane < 8 && urep == P8_UREPS - 1) list[i + lane] = (ev & 0xffffu) | (f2bf(c_) << 16);
            }
        }
#undef P8_ULOAD
#undef P8_UPROC
        asm volatile("s_waitcnt vmcnt(0)" ::: "memory");
        LDS_WAIT(); asm volatile("" ::: "memory");
        f32x4 acc[32];
#pragma unroll
        for (int i = 0; i < 32; ++i) acc[i] = (f32x4){0.f, 0.f, 0.f, 0.f};
        {
            typedef unsigned u32x16 __attribute__((ext_vector_type(16)));
            u32x4 v4[4]; u32x2 v2[4]; unsigned ven[4];
            const unsigned tok = (unsigned)lane & 3u;
#define P8_VLOAD(k, i) do { const unsigned en = (unsigned)__builtin_amdgcn_readfirstlane((int)list[(i)]); ven[k] = en; \
            const size_t ro = (size_t)(en & 0x3fffu) * PEER_ROWB; v4[k] = *(const u32x4*)(VT + ro + lane * 16); v2[k] = *(const u32x2*)(VT + ro + 1024 + lane * 8); } while (0)
#define P8_VPROC2(ka, kb) do { const u32x6 pka = {v4[ka][0], v4[ka][1], v4[ka][2], v4[ka][3], v2[ka][0], v2[ka][1]}, pkb = {v4[kb][0], v4[kb][1], v4[kb][2], v4[kb][3], v2[kb][0], v2[kb][1]}; \
            const u32x16 da = __builtin_bit_cast(u32x16, __builtin_amdgcn_cvt_scalef32_pk32_bf16_fp6(pka, 1.0f)), db = __builtin_bit_cast(u32x16, __builtin_amdgcn_cvt_scalef32_pk32_bf16_fp6(pkb, 1.0f)); \
            const unsigned ea = ven[ka], eb = ven[kb]; \
            const unsigned alo = ((((ea >> 14) & 3u) == tok) ? (ea >> 16) : 0u) | ((((eb >> 14) & 3u) == tok) ? (eb & 0xffff0000u) : 0u); \
            const s16x4 av = __builtin_bit_cast(s16x4, (unsigned long long)alo); \
            _Pragma("unroll") for (int m = 0; m < 16; ++m) { \
                const unsigned be = __builtin_amdgcn_perm(db[m], da[m], 0x05040100u), bo = __builtin_amdgcn_perm(db[m], da[m], 0x07060302u); \
                acc[2 * m] = __builtin_amdgcn_mfma_f32_4x4x4bf16_1k(av, __builtin_bit_cast(s16x4, (unsigned long long)be), acc[2 * m], 0, 0, 0); \
                acc[2 * m + 1] = __builtin_amdgcn_mfma_f32_4x4x4bf16_1k(av, __builtin_bit_cast(s16x4, (unsigned long long)bo), acc[2 * m + 1], 0, 0, 0); } } while (0)
#pragma unroll
            for (int k = 0; k < 4; ++k) P8_VLOAD(k, k);
#pragma unroll 1
            for (int i = 0; i < 512; i += 4) {
#pragma unroll
                for (int k = 0; k < 4; k += 2) { P8_VPROC2(k, k + 1); if (i + 4 < 512) { P8_VLOAD(k, i + 4 + k); P8_VLOAD(k + 1, i + 5 + k); } }
            }
#undef P8_VLOAD
#undef P8_VPROC2
        }
        int tq = t0, lq = lane; asm volatile("" : "+s"(tq)); asm volatile("" : "+v"(lq));
#pragma unroll
        for (int j = 0; j < 4; ++j)
#pragma unroll
            for (int i = 0; i < 8; ++i) {
                const size_t o = (size_t)(tq + j) * DM + (i * 64 + lq) * 4;
                f32x4 a = *(const f32x4*)(out + o);
#pragma unroll
                for (int q = 0; q < 4; ++q) a[q] += acc[4 * i + q][j];
                *(f32x4*)(dst + o) = a;
                if (i & 1) asm volatile("" ::: "memory");
            }
        LDS_WAIT(); asm volatile("" ::: "memory");
    }
}

__global__ void __launch_bounds__(NTHREADS, 2) mega(Params p) {
    extern __shared__ __attribute__((aligned(16))) unsigned char lds_raw[];
    LAS unsigned char* lds = (LAS unsigned char*)lds_raw;
    const int tid = threadIdx.x, lane = tid & 63, wave = __builtin_amdgcn_readfirstlane(tid >> 6);
    const int G = gridDim.x, bx = blockIdx.x;
    const int gw = bx * 8 + wave, NGW = G * 8;
    unsigned char* ws = p.ws;
    const int lo = p.ph_lo, hi = p.ph_hi;
    volatile LAS unsigned* misc = (volatile LAS unsigned*)(lds + LDS_MISC);
    if (tid < 4) misc[tid] = 0u;
    __syncthreads();
    const XcdBarrier xbar = xcd_barrier_post((unsigned*)(ws + WS_CTL), misc);
#ifndef PH_MASK
#define PH_MASK 0x1ff
#endif
#define IN(k) (((PH_MASK >> (k)) & 1) && lo <= (k) && (k) < hi)
#define SEAM(k) do { if (IN(k) && IN((k) + 1)) xcd_barrier(xbar); } while (0)

#if (PROBE_DUP >> 0) & 1
    if (IN(0)) { phase0(p, lds, gw, NGW, wave, lane); xcd_barrier(xbar); }
#endif
    if (IN(0)) phase0(p, lds, gw, NGW, wave, lane);
    SEAM(0);
    if (IN(1)) {
        pg8::Gemm g{(const bf16_t*)(ws + WS_XB), (const bf16_t*)(ws + WS_WIN), S, NINP, DM, DM, DM};
        pg8::StaticOrder So; So.init(S, NINP, G, bx);
        pg8::Epi<1> E{(const float*)(ws + WS_RSTD1), 0.f, (float*)(ws + WS_ROWSS), (bf16_t*)(ws + WS_PROJ), NINP, nullptr, nullptr};
#if (PROBE_DUP >> 1) & 1
        { pg8::Epi<1> E2 = E; E2.ss = (float*)(ws + 512 * 1024); pg8::gemm_phase<pg8::Epi<1>, pg8::StaticOrder, true, true>(lds, g, So, E2); xcd_barrier(xbar); }
#endif
        pg8::gemm_phase<pg8::Epi<1>, pg8::StaticOrder, true, true>(lds, g, So, E);
    }
    SEAM(1);
    if (IN(2)) {
        {
            pg8::Gemm g{(const bf16_t*)(ws + WS_PROJ) + 2048, (const bf16_t*)(ws + WS_WUQ), S, 1536, 512, NINP, 512};
            pg8::StaticOrder So; So.init(S, 1536, G, bx);
            pg8::Epi<2> E{(const float*)(ws + WS_ROWSS) + 1 * S, 1.0f / 512.0f, nullptr, (bf16_t*)(ws + WS_QRAW), 1536, nullptr, nullptr};
            pg8::gemm_phase<pg8::Epi<2>, pg8::StaticOrder, true, true>(lds, g, So, E);
        }
        __syncthreads();
        {
            pg8::Gemm g{(const bf16_t*)(ws + WS_PROJ) + 2560, (const bf16_t*)(ws + WS_WUKV), S, 2048, 256, NINP, 256};
            pg8::StaticOrder So; So.init(S, 2048, G, bx);
            pg8::Epi<2> E{(const float*)(ws + WS_ROWSS) + 2 * S, 1.0f / 256.0f, nullptr, (bf16_t*)(ws + WS_KVRAW), 2048, nullptr, nullptr};
            pg8::gemm_phase<pg8::Epi<2>, pg8::StaticOrder, true, true>(lds, g, So, E);
        }
    }
    SEAM(2);
#if (PROBE_DUP >> 3) & 1
    if (IN(3)) { phase3(p, gw, NGW, lane); xcd_barrier(xbar); }
#endif
    if (IN(3)) phase3(p, gw, NGW, lane);
    SEAM(3);
#define P4_BODY_ATT for (int pr = bx; pr < 256; pr += G) { const int head = pr & 7, x = pr >> 3; attn_unit(p, lds, head, 63 - x, tid, wave, lane); attn_unit(p, lds, head, x, tid, wave, lane); }
#define P4_BODY_GMLP for (int u = bx; u < 512; u += G) gmlp_unit(p, lds, u >> 3, u & 7, tid, wave, lane);
#if (PROBE_DUP >> 4) & 1
    if (IN(4)) { P4_BODY_ATT; xcd_barrier(xbar); }
#endif
#if (PROBE_DUP >> 9) & 1
    if (IN(4)) { P4_BODY_GMLP; xcd_barrier(xbar); }
#endif
    if (IN(4)) { P4_BODY_ATT; P4_BODY_GMLP; }
    SEAM(4);
    if (IN(5)) {
        pg8::Gemm g{(const bf16_t*)(ws + WS_MIX), (const bf16_t*)(ws + WS_WOUT), S, DM, DM, DM, DM};
        pg8::StaticOrder So; So.init(S, DM, G, bx);
        pg8::Epi<4> E{nullptr, 0.f, (float*)(ws + WS_ROWSS) + 3 * S, (bf16_t*)(ws + WS_X1B), DM, p.out, p.in[0]};
#if (PROBE_DUP >> 5) & 1
        { pg8::Epi<4> E2 = E; E2.ss = (float*)(ws + 512 * 1024); pg8::gemm_phase<pg8::Epi<4>, pg8::StaticOrder, true, true>(lds, g, So, E2); xcd_barrier(xbar); }
#endif
        pg8::gemm_phase<pg8::Epi<4>, pg8::StaticOrder, true, true>(lds, g, So, E);
    }
    SEAM(5);
    if (IN(6)) {
        pg8::Gemm g{(const bf16_t*)(ws + WS_X1B), (const bf16_t*)(ws + WS_WS), S, DM, DM, DM, DM};
        pg8::StaticOrder So; So.init(S, DM, G, bx);
        pg8::Epi<5> E{(const float*)(ws + WS_ROWSS) + 3 * S, 1.0f / DM, nullptr, nullptr, DM, (float*)(ws + WS_SC), nullptr};
#if (PROBE_DUP >> 6) & 1
        { pg8::gemm_phase<pg8::Epi<5>, pg8::StaticOrder, true, true>(lds, g, So, E); xcd_barrier(xbar); }
#endif
        pg8::gemm_phase<pg8::Epi<5>, pg8::StaticOrder, true, true>(lds, g, So, E);
    }
    SEAM(6);
#if (PROBE_DUP >> 7) & 1
    if (IN(7)) { phase7(p, lds, gw, NGW, wave, lane); xcd_barrier(xbar); }
#endif
    if (IN(7)) phase7(p, lds, gw, NGW, wave, lane);
    SEAM(7);
#if (PROBE_DUP >> 8) & 1
    if (IN(8)) { phase8(p, lds, (float*)(ws + WS_SC), xbar.x, 8u * misc[0], gw, NGW, wave, lane); xcd_barrier(xbar); }
#endif
    if (IN(8)) phase8(p, lds, p.out, xbar.x, 8u * misc[0], gw, NGW, wave, lane);
#undef IN
#undef SEAM
}

extern "C" void kernel_launch(void* const* d_in, const int* in_sizes, int n_in, void* d_out, int out_size, void* d_ws, size_t ws_size, hipStream_t stream) {
    static int grid = 0;
    if (grid == 0) {
        if (n_in != 18 || out_size != S * DM || ws_size < WS_END) { fprintf(stderr, "kernel_launch: unexpected shapes (n_in %d out %d ws %zu)\n", n_in, out_size, ws_size); grid = -1; return; }
        int dev = 0, cus = 0, per_cu = 0;
        hipGetDevice(&dev);
        hipDeviceGetAttribute(&cus, hipDeviceAttributeMultiprocessorCount, dev);
        if (hipFuncSetAttribute((const void*)mega, hipFuncAttributeMaxDynamicSharedMemorySize, LDS_BYTES) != hipSuccess) { fprintf(stderr, "kernel_launch: hipFuncSetAttribute failed\n"); grid = -1; return; }
        if (hipOccupancyMaxActiveBlocksPerMultiprocessor(&per_cu, (const void*)mega, NTHREADS, LDS_BYTES) != hipSuccess || per_cu < 1) { fprintf(stderr, "kernel_launch: occupancy query failed (%d)\n", per_cu); grid = -1; return; }
        grid = cus;
        fprintf(stderr, "kernel_launch: cus %d per_cu %d grid %d\n", cus, per_cu, grid);
    }
    if (grid < 0) return;
    hipMemsetAsync((char*)d_ws + WS_CTL, 0, 1 * MiB, stream);
    Params prm{};
    for (int i = 0; i < 18; ++i) prm.in[i] = (const float*)d_in[i];
    prm.out = (float*)d_out; prm.ws = (unsigned char*)d_ws;
#if MK_ONE_LAUNCH
    prm.ph_lo = 0; prm.ph_hi = NPH;
    { void* args[] = {&prm}; hipError_t e = hipLaunchCooperativeKernel((const void*)mega, dim3(grid), dim3(NTHREADS), args, LDS_BYTES, stream);
      if (e != hipSuccess) fprintf(stderr, "cooperative launch failed: %s\n", hipGetErrorString(e)); }
#else
    for (int ph = 0; ph < NPH; ++ph) {
        prm.ph_lo = ph; prm.ph_hi = ph + 1;
        void* args[] = {&prm};
        hipError_t e = hipLaunchCooperativeKernel((const void*)mega, dim3(grid), dim3(NTHREADS), args, LDS_BYTES, stream);
        if (e != hipSuccess) { fprintf(stderr, "cooperative launch %d failed: %s\n", ph, hipGetErrorString(e)); break; }
    }
#endif
}
```

```cpp
#include <hip/hip_runtime.h>
#include <cstdio>
#include <cstdint>

#define LAS __attribute__((address_space(3)))
typedef unsigned short bf16_t;
typedef short bf16x8 __attribute__((ext_vector_type(8)));
typedef short s16x4 __attribute__((ext_vector_type(4)));
typedef float f32x4 __attribute__((ext_vector_type(4)));
typedef float f32x16 __attribute__((ext_vector_type(16)));
typedef unsigned u32x4 __attribute__((ext_vector_type(4)));
typedef unsigned u32x2 __attribute__((ext_vector_type(2)));

#ifndef PROBE_DUP
#define PROBE_DUP 0
#endif
#ifndef MK_ONE_LAUNCH
#define MK_ONE_LAUNCH 1
#endif

constexpr int S = 8192, DM = 2048, NIN = 2880, NINP = 3072;
constexpr int NPH = 9;
constexpr float EPS = 1e-6f;
constexpr int LDS_BYTES = 163840;
constexpr int NTHREADS = 512;
constexpr int LDS_MISC = 161792;

constexpr size_t MiB = 1u << 20;
constexpr size_t WS_CTL = 0;
constexpr size_t WS_ROWSS = 128 * 1024;
constexpr size_t WS_COS = 1 * MiB, WS_SIN = 2 * MiB;
constexpr size_t WS_RSTD1 = 3 * MiB;
constexpr size_t WS_EXP = 4 * MiB;
constexpr size_t WS_GATE = 8 * MiB;
constexpr size_t WS_WIN = 12 * MiB;
constexpr size_t WS_WUQ = 24 * MiB;
constexpr size_t WS_WUKV = 26 * MiB;
constexpr size_t WS_WOUT = 28 * MiB;
constexpr size_t WS_WS = 36 * MiB;
constexpr size_t WS_XB = 44 * MiB;
constexpr size_t WS_PROJ = 76 * MiB;
constexpr size_t WS_QRAW = 124 * MiB;
constexpr size_t WS_KVRAW = 148 * MiB;
constexpr size_t WS_QH = 180 * MiB;
constexpr size_t WS_KH = 204 * MiB;
constexpr size_t WS_VH = 228 * MiB;
constexpr size_t WS_MIX = 244 * MiB;
constexpr size_t WS_X1B = 276 * MiB;
constexpr size_t WS_SC = 308 * MiB;
constexpr size_t WS_UT = 372 * MiB;
constexpr size_t WS_VT = 436 * MiB;
constexpr size_t WS_END = 500 * MiB;

__device__ __forceinline__ unsigned f2bf(float f) { unsigned u = __builtin_bit_cast(unsigned, f); return (u + 0x7fffu + ((u >> 16) & 1u)) >> 16; }
__device__ __forceinline__ unsigned pk2(float lo, float hi) { return f2bf(lo) | (f2bf(hi) << 16); }
__device__ __forceinline__ float bf2f(unsigned short b) { return __builtin_bit_cast(float, (unsigned)b << 16); }
__device__ __forceinline__ float bflo(unsigned w) { return __builtin_bit_cast(float, w << 16); }
__device__ __forceinline__ float bfhi(unsigned w) { return __builtin_bit_cast(float, w & 0xffff0000u); }
__device__ __forceinline__ float wave_sum(float v) {
#pragma unroll
    for (int o = 32; o > 0; o >>= 1) v += __shfl_xor(v, o);
    return v;
}
__device__ __forceinline__ float wave_max(float v) {
#pragma unroll
    for (int o = 32; o > 0; o >>= 1) v = fmaxf(v, __shfl_xor(v, o));
    return v;
}
__device__ __forceinline__ float gelu_tanh(float x) {
    const float y = 0.7978845608028654f * (x + 0.044715f * x * x * x);
    return x / (1.0f + __expf(-2.0f * y));
}
__device__ __forceinline__ int crow(int r, int hi) { return (r & 3) + 8 * (r >> 2) + 4 * hi; }
#define LDS_WAIT() asm volatile("s_waitcnt lgkmcnt(0)" ::: "memory")
#define SBAR() __builtin_amdgcn_sched_barrier(0)

namespace pg8 {
#define PG8_LAS __attribute__((address_space(3)))
constexpr int BM = 256, BK = 64, HALF = 128, HTB = HALF * BK * 2  , STAGE_BYTES = 8 * HTB, NXCD = 8, WGM = 8;

__host__ __device__ __forceinline__ int lds_byte(int r, int c) { const int st = (r >> 4) * 2 + (c >> 5), rr = r & 15, cc = c & 31, ob = rr * 64 + cc * 2; return st * 1024 + (ob ^ (((ob >> 9) & 1) << 5)); }
__host__ __device__ __forceinline__ void stage_rc(int b, int& R, int& C) { const int st = b / 1024, sb = b % 1024, swz = sb ^ (((sb >> 9) & 1) << 5); R = (st >> 1) * 16 + swz / 64; C = (st & 1) * 32 + (swz % 64) / 2; }
__host__ __device__ __forceinline__ int perm32(int rho) { const int n = rho >> 4, i = rho & 15; return 8 * (i >> 2) + 4 * n + (i & 3); }

struct Unit { int pm, pn; };
struct Gemm { const bf16_t* A; const bf16_t* Bt; int M, N, K, lda, ldb; };

struct StaticOrder {
    int nM, nN, nwg, G, c;
    __host__ __device__ void init(int M, int N, int G_, int c_) { nM = M / BM; nN = N / BM; nwg = nM * nN; G = G_; c = c_; }
    __host__ __device__ bool next(int i, Unit& u) const {
        const long L = (long)i * G + c; if (L >= nwg) return false;
        int wgid = (int)L; { const int q = nwg / NXCD, r = nwg % NXCD, xcd = wgid % NXCD, off = wgid / NXCD; wgid = (xcd < r ? xcd * (q + 1) : r * (q + 1) + (xcd - r) * q) + off; }
        const int nig = WGM * nN, gid = wgid / nig, fm = gid * WGM, gsz = (nM - fm) < WGM ? (nM - fm) : WGM;
        u.pm = fm + ((wgid % nig) % gsz); u.pn = (wgid % nig) / gsz; return true;
    }
    __device__ __forceinline__ void a_ready(const Unit&) const {}
    __device__ __forceinline__ void done(const Unit&) const {}
};

template <class Epi, class Sched, bool ALIGN_EPI = false, bool SP2 = false>
__device__ __forceinline__ void gemm_phase(PG8_LAS unsigned char* lds, const Gemm g, const Sched& S, const Epi& E) {
    const int tid = threadIdx.x, wid = __builtin_amdgcn_readfirstlane(tid >> 6), lane = tid & 63, wr = wid >> 2, wc = wid & 3, fr = lane & 15, fq = lane >> 4;
    const int K = g.K, nt = K / BK;
    unsigned voffA[2], voffB[2];
#pragma unroll
    for (int i = 0; i < 2; ++i) { int R, C; stage_rc(tid * 16 + i * 8192, R, C); const int Rb = Epi::PERM ? ((R & ~31) + perm32(R & 31)) : R;
        voffA[i] = (unsigned)(R * g.lda + C) * 2u; voffB[i] = (unsigned)(Rb * g.ldb + C) * 2u; }
    const size_t kstep = (size_t)(BK * 2);
    const size_t hstepA = (size_t)HALF * g.lda * 2, hstepB = (size_t)HALF * g.ldb * 2;
    const size_t tstepA = 2 * hstepA, tstepB = 2 * hstepB;
    const unsigned ldsw = (unsigned)wid * 1024u;
    const int aoff = lds_byte(wr * 64 + fr, fq * 8), boff = lds_byte(wc * 32 + fr, fq * 8);
#define PG8_SA(b, h) (((b) * 2 + (h)) * HTB)
#define PG8_SB(b, h) ((4 + (b) * 2 + (h)) * HTB)
#define PG8_STAGE(bufoff, gbase, voff) do { _Pragma("unroll") for (int _i = 0; _i < 2; ++_i) \
        __builtin_amdgcn_global_load_lds((const unsigned*)((const char*)(gbase) + (voff)[_i]), (PG8_LAS unsigned*)(lds + (bufoff) + ldsw + _i * 8192), 16, 0, 0); } while (0)
#define PG8_LDA(dst, b, h) do { _Pragma("unroll") for (int m = 0; m < 4; ++m) _Pragma("unroll") for (int k = 0; k < 2; ++k) dst[m][k] = *(const PG8_LAS bf16x8*)(lds + PG8_SA(b, h) + aoff + m * 2048 + k * 1024); } while (0)
#define PG8_LDB(dst, b, h) do { _Pragma("unroll") for (int n = 0; n < 2; ++n) _Pragma("unroll") for (int k = 0; k < 2; ++k) dst[n][k] = *(const PG8_LAS bf16x8*)(lds + PG8_SB(b, h) + boff + n * 2048 + k * 1024); } while (0)
#define PG8_MMA(ai, bj, At, Bt) do { __builtin_amdgcn_s_setprio(1); _Pragma("unroll") for (int m = 0; m < 4; ++m) _Pragma("unroll") for (int n = 0; n < 2; ++n) _Pragma("unroll") for (int k = 0; k < 2; ++k) \
        acc[ai][bj][m][n] = __builtin_amdgcn_mfma_f32_16x16x32_bf16(Bt[n][k], At[m][k], acc[ai][bj][m][n], 0, 0, 0); __builtin_amdgcn_s_setprio(0); } while (0)
#define PG8_WAIT_V(n) asm volatile("s_waitcnt vmcnt(" #n ")" ::: "memory")
#define PG8_WAIT_L(n) asm volatile("s_waitcnt lgkmcnt(" #n ")" ::: "memory")
#define PG8_BAR __builtin_amdgcn_s_barrier()
#define PG8_SCHED __builtin_amdgcn_sched_barrier(0)
    Unit cur, nxt; int ui = 0;
    if (!S.next(0, cur)) return;
    f32x4 acc[2][2][4][2];
#pragma unroll
    for (int a = 0; a < 2; ++a)
#pragma unroll
        for (int b = 0; b < 2; ++b)
#pragma unroll
            for (int m = 0; m < 4; ++m)
#pragma unroll
                for (int n = 0; n < 2; ++n) acc[a][b][m][n] = (f32x4){0.f, 0.f, 0.f, 0.f};
    bf16x8 At[4][2], B0[2][2], B1[2][2];
    const char* cA = (const char*)g.A + (size_t)cur.pm * tstepA; const char* cB = (const char*)g.Bt + (size_t)cur.pn * tstepB;
    S.a_ready(cur);
    if constexpr (SP2) {
        PG8_STAGE(PG8_SB(0, 0), cB, voffB); PG8_STAGE(PG8_SB(0, 1), cB + hstepB, voffB); PG8_STAGE(PG8_SA(0, 0), cA, voffA); PG8_STAGE(PG8_SA(0, 1), cA + hstepA, voffA);
        if (wr == 1) PG8_BAR;
        PG8_WAIT_V(2); PG8_BAR;
        PG8_STAGE(PG8_SB(1, 0), cB + kstep, voffB); PG8_STAGE(PG8_SA(1, 0), cA + kstep, voffA); PG8_STAGE(PG8_SB(1, 1), cB + hstepB + kstep, voffB);
        PG8_WAIT_V(6); PG8_BAR;
    } else {
        PG8_STAGE(PG8_SB(0, 0), cB, voffB); PG8_STAGE(PG8_SA(0, 0), cA, voffA); PG8_STAGE(PG8_SB(0, 1), cB + hstepB, voffB); PG8_STAGE(PG8_SA(0, 1), cA + hstepA, voffA);
        if (wr == 1) PG8_BAR;
        PG8_WAIT_V(4); PG8_BAR;
        PG8_STAGE(PG8_SB(1, 0), cB + kstep, voffB); PG8_STAGE(PG8_SA(1, 0), cA + kstep, voffA); PG8_STAGE(PG8_SB(1, 1), cB + hstepB + kstep, voffB);
        PG8_WAIT_V(6); PG8_BAR;
    }
    for (;;) {
        const bool has_next = S.next(ui + 1, nxt);
        const char* nA = has_next ? (const char*)g.A + (size_t)nxt.pm * tstepA : cA; const char* nB = has_next ? (const char*)g.Bt + (size_t)nxt.pn * tstepB : cB;
        for (int t = 0; t < nt; t += 2) {
            const bool last = (t == nt - 2);
            const char* a1 = cA + (size_t)(t + 1) * kstep;
            const char* a2 = last ? nA : cA + (size_t)(t + 2) * kstep; const char* b2 = last ? nB : cB + (size_t)(t + 2) * kstep;
            const char* a3 = a2 + kstep; const char* b3 = b2 + kstep;
            if (last && has_next) S.a_ready(nxt);
            if constexpr (SP2) {
            PG8_LDB(B0, 0, 0); PG8_LDB(B1, 0, 1); PG8_SCHED; PG8_LDA(At, 0, 0); PG8_STAGE(PG8_SA(1, 1), a1 + hstepA, voffA);
            PG8_WAIT_V(8); PG8_WAIT_L(0); PG8_BAR; PG8_MMA(0, 0, At, B0); PG8_MMA(0, 1, At, B1); PG8_BAR; PG8_SCHED;
            PG8_LDA(At, 0, 1); PG8_STAGE(PG8_SB(0, 0), b2, voffB); PG8_STAGE(PG8_SB(0, 1), b2 + hstepB, voffB); PG8_STAGE(PG8_SA(0, 0), a2, voffA);
            PG8_WAIT_V(8); PG8_WAIT_L(0); PG8_BAR; PG8_MMA(1, 0, At, B0); PG8_MMA(1, 1, At, B1); PG8_BAR; PG8_SCHED;
            PG8_LDB(B0, 1, 0); PG8_LDB(B1, 1, 1); PG8_SCHED; PG8_LDA(At, 1, 0); PG8_STAGE(PG8_SA(0, 1), a2 + hstepA, voffA);
            PG8_WAIT_V(8); PG8_WAIT_L(0); PG8_BAR; PG8_MMA(0, 0, At, B0); PG8_MMA(0, 1, At, B1); PG8_BAR; PG8_SCHED;
            PG8_LDA(At, 1, 1); PG8_STAGE(PG8_SB(1, 0), b3, voffB); PG8_STAGE(PG8_SB(1, 1), b3 + hstepB, voffB); PG8_STAGE(PG8_SA(1, 0), a3, voffA);
            PG8_WAIT_V(8); PG8_WAIT_L(0); PG8_BAR; PG8_MMA(1, 0, At, B0); PG8_MMA(1, 1, At, B1); PG8_BAR; PG8_SCHED;
            } else {
            PG8_LDB(B0, 0, 0); PG8_SCHED; PG8_LDA(At, 0, 0); PG8_STAGE(PG8_SA(1, 1), a1 + hstepA, voffA);
            PG8_WAIT_L(8); PG8_BAR; PG8_WAIT_L(0); PG8_MMA(0, 0, At, B0); PG8_BAR; PG8_SCHED;
            PG8_LDB(B1, 0, 1); PG8_STAGE(PG8_SB(0, 0), b2, voffB);
            PG8_BAR; PG8_WAIT_L(0); PG8_MMA(0, 1, At, B1); PG8_BAR;
            PG8_LDA(At, 0, 1); PG8_STAGE(PG8_SA(0, 0), a2, voffA);
            PG8_BAR; PG8_WAIT_L(0); PG8_MMA(1, 0, At, B0); PG8_BAR; PG8_SCHED;
            PG8_STAGE(PG8_SB(0, 1), b2 + hstepB, voffB);
            PG8_WAIT_V(6); PG8_BAR; PG8_MMA(1, 1, At, B1); PG8_BAR;
            PG8_LDB(B0, 1, 0); PG8_SCHED; PG8_LDA(At, 1, 0); PG8_STAGE(PG8_SA(0, 1), a2 + hstepA, voffA);
            PG8_WAIT_L(8); PG8_BAR; PG8_WAIT_L(0); PG8_MMA(0, 0, At, B0); PG8_BAR; PG8_SCHED;
            PG8_LDB(B1, 1, 1); PG8_STAGE(PG8_SB(1, 0), b3, voffB);
            PG8_BAR; PG8_WAIT_L(0); PG8_MMA(0, 1, At, B1); PG8_BAR;
            PG8_LDA(At, 1, 1); PG8_STAGE(PG8_SA(1, 0), a3, voffA);
            PG8_BAR; PG8_WAIT_L(0); PG8_MMA(1, 0, At, B0); PG8_BAR; PG8_SCHED;
            PG8_STAGE(PG8_SB(1, 1), b3 + hstepB, voffB);
            PG8_WAIT_V(6); PG8_BAR; PG8_MMA(1, 1, At, B1); PG8_BAR;
            }
        }
        if constexpr (ALIGN_EPI) { if (wr == 0) PG8_BAR; }
        if constexpr (!Epi::AFTER_DRAIN) { E(acc, cur, wr, wc, fr, fq); S.done(cur); }
        if (!has_next) break;
#pragma unroll
        for (int a = 0; a < 2; ++a)
#pragma unroll
            for (int b = 0; b < 2; ++b)
#pragma unroll
                for (int m = 0; m < 4; ++m)
#pragma unroll
                    for (int n = 0; n < 2; ++n) acc[a][b][m][n] = (f32x4){0.f, 0.f, 0.f, 0.f};
        cur = nxt; cA = nA; cB = nB; ++ui;
        if constexpr (ALIGN_EPI) { if (wr == 1) PG8_BAR; }
    }
    PG8_WAIT_V(0);
    if constexpr (!ALIGN_EPI) { if (wr == 0) PG8_BAR; }
    PG8_BAR;
#undef PG8_SA
#undef PG8_SB
#undef PG8_STAGE
#undef PG8_LDA
#undef PG8_LDB
#undef PG8_MMA
#undef PG8_WAIT_V
#undef PG8_WAIT_L
#undef PG8_BAR
#undef PG8_SCHED
}

template <int MODE> struct Epi {
    static constexpr bool PERM = false, AFTER_DRAIN = false;
    const float* rowsrc; float inv_n; float* ss; bf16_t* ob; int ldc; float* of; const float* xin;
    __device__ __forceinline__ void operator()(const f32x4 (&acc)[2][2][4][2], const Unit& u, int wr, int wc, int fr, int fq) const {
#pragma unroll
        for (int ai = 0; ai < 2; ++ai)
#pragma unroll
            for (int m = 0; m < 4; ++m) {
                const int row = u.pm * BM + ai * HALF + wr * 64 + m * 16 + fr;
                float rs = 1.f;
                if (MODE == 1) rs = rowsrc[row];
                if (MODE == 2 || MODE == 5) rs = rsqrtf(rowsrc[row] * inv_n + EPS);
                float ssq = 0.f;
#pragma unroll
                for (int bj = 0; bj < 2; ++bj)
#pragma unroll
                    for (int n = 0; n < 2; ++n) {
                        const int col = u.pn * BM + bj * HALF + wc * 32 + n * 16 + fq * 4;
                        f32x4 v = acc[ai][bj][m][n] * rs;
                        if (MODE == 1) { if (u.pn < 8) { v[0] = gelu_tanh(v[0]); v[1] = gelu_tanh(v[1]); v[2] = gelu_tanh(v[2]); v[3] = gelu_tanh(v[3]); } }
                        if (MODE == 4) { const f32x4 xr = *(const f32x4*)(xin + (size_t)row * DM + col); v = v + xr; }
                        if (MODE == 1 || MODE == 4) ssq += (v[0] * v[0] + v[1] * v[1]) + (v[2] * v[2] + v[3] * v[3]);
                        if (MODE == 1 || MODE == 2 || MODE == 4) { u32x2 w; w.x = pk2(v[0], v[1]); w.y = pk2(v[2], v[3]); *(u32x2*)(ob + (size_t)row * ldc + col) = w; }
                        if (MODE == 4 || MODE == 5) *(f32x4*)(of + (size_t)row * DM + col) = v;
                    }
                if (MODE == 1) {
                    const int seg = (u.pn >= 4 && u.pn < 8) ? 0 : ((u.pn == 8 || u.pn == 9) ? 1 : (u.pn == 10 ? 2 : -1));
                    if (seg >= 0) { ssq += __shfl_xor(ssq, 16); ssq += __shfl_xor(ssq, 32); if (fq == 0) atomicAdd(ss + seg * S + row, ssq); }
                }
                if (MODE == 4) { ssq += __shfl_xor(ssq, 16); ssq += __shfl_xor(ssq, 32); if (fq == 0) atomicAdd(ss + row, ssq); }
            }
    }
};
}

#define XB_TMO      128
#define XB_XCNT(j)  (256  + 64 * (j))
#define XB_XSUB(j)  (1280 + 64 * (j))
#define XB_XGEN(j)  (2304 + 64 * (j))
#define XB_TOP      3328
#define XB_TOPGEN   3392
#define XCD_BAR_WORDS 3456
#define XB_SPIN_CAP (1u << 18)
__device__ __forceinline__ unsigned xb_ld(unsigned* p)              { return __hip_atomic_load(p, __ATOMIC_RELAXED, __HIP_MEMORY_SCOPE_AGENT); }
__device__ __forceinline__ unsigned xb_add(unsigned* p, unsigned v) { return __hip_atomic_fetch_add(p, v, __ATOMIC_RELAXED, __HIP_MEMORY_SCOPE_AGENT); }
__device__ __forceinline__ unsigned xb_xcc_id() { return (unsigned)__builtin_amdgcn_s_getreg((3 << 11) | 20) & 0xFu; }
#define XB_SPIN(cond, bar) do { unsigned _sp = 0; while (cond) { __builtin_amdgcn_s_sleep(1); \
    if ((++_sp & 255u) == 0u) { if (xb_ld(&(bar)[XB_TMO])) break; if (_sp > XB_SPIN_CAP) { atomicAdd(&(bar)[XB_TMO], 1u); break; } } } } while (0)
struct XcdBarrier { unsigned* bar; unsigned x; volatile LAS unsigned* st; };
__device__ __forceinline__ XcdBarrier xcd_barrier_post(unsigned* bar, volatile LAS unsigned* st) {
    XcdBarrier b; b.bar = bar; b.x = xb_xcc_id(); b.st = st;
    if (threadIdx.x == 0) (void)xb_add(&bar[XB_XCNT(b.x)], 1u);
    return b;
}
__device__ __forceinline__ void xcd_barrier_complete(unsigned* bar, unsigned x, unsigned& nloc, unsigned& nx) {
    const unsigned G = gridDim.x * gridDim.y * gridDim.z;
    unsigned sum, cnt, mine, sp = 0u;
    for (;;) {
        sum = 0u; cnt = 0u; mine = 0u;
#pragma unroll
        for (unsigned j = 0; j < 16; ++j) { const unsigned c = xb_ld(&bar[XB_XCNT(j)]); sum += c; cnt += (c > 0u) ? 1u : 0u; mine = (j == x) ? c : mine; }
        if (sum == G) break;
        __builtin_amdgcn_s_sleep(1);
        if ((++sp & 255u) == 0u) { if (xb_ld(&bar[XB_TMO])) break; if (sp > XB_SPIN_CAP) { atomicAdd(&bar[XB_TMO], 1u); break; } }
    }
    nloc = mine > 0u ? mine : 1u; nx = cnt > 0u ? cnt : 1u;
}
__device__ __forceinline__ void xcd_barrier(const XcdBarrier& b) {
    asm volatile("s_waitcnt vmcnt(0)" ::: "memory");
    __syncthreads();
    if (threadIdx.x == 0) {
        unsigned* bar = b.bar;
        __builtin_amdgcn_s_waitcnt(0);
        unsigned nloc = b.st[0], nx = b.st[1];
        if (nloc == 0u) { xcd_barrier_complete(bar, b.x, nloc, nx); b.st[0] = nloc; b.st[1] = nx; }
        const unsigned old = xb_add(&bar[XB_XSUB(b.x)], 1u);
        const unsigned gen = old / nloc;
        if (old + 1u == (gen + 1u) * nloc) {
            __builtin_amdgcn_fence(__ATOMIC_RELEASE, "agent");
            asm volatile("s_waitcnt vmcnt(0)" ::: "memory");
            const unsigned og = xb_add(&bar[XB_TOP], 1u);
            const unsigned tg = og / nx;
            if (og + 1u == (tg + 1u) * nx) xb_add(&bar[XB_TOPGEN], 1u);
            else XB_SPIN(xb_ld(&bar[XB_TOPGEN]) == tg, bar);
            __builtin_amdgcn_fence(__ATOMIC_ACQUIRE, "agent");
            xb_add(&bar[XB_XGEN(b.x)], 1u);
            asm volatile("s_waitcnt vmcnt(0)" ::: "memory");
        } else {
            XB_SPIN(xb_ld(&bar[XB_XGEN(b.x)]) == gen, bar);
            __builtin_amdgcn_fence(__ATOMIC_ACQUIRE, "agent");
            asm volatile("s_waitcnt vmcnt(0)" ::: "memory");
        }
    }
    __syncthreads();
}

struct Params {
    const float* in[18];
    float* out;
    unsigned char* ws;
    int ph_lo, ph_hi;
};

__device__ __forceinline__ void p0_transpose_item(const float* W, const float* g, int K, int N, bf16_t* WT, LAS float* scr, int item, int lane) {
    const int nblk = N / 32, kb = item / nblk, nb = item % nblk, k0 = 64 * kb, n0 = 32 * nb;
#pragma unroll 8
    for (int i = 0; i < 32; ++i) { const int kk = 2 * i + (lane >> 5); const float gv = g ? g[k0 + kk] : 1.f;
        scr[kk * 33 + (lane & 31)] = W[(size_t)(k0 + kk) * N + n0 + (lane & 31)] * gv; }
    LDS_WAIT(); asm volatile("" ::: "memory");
    const int c = lane & 7;
#pragma unroll
    for (int j = 0; j < 4; ++j) { const int n = (lane >> 3) + 8 * j; const LAS float* s = scr + (8 * c) * 33 + n;
        u32x4 o; o.x = pk2(s[0 * 33], s[1 * 33]); o.y = pk2(s[2 * 33], s[3 * 33]); o.z = pk2(s[4 * 33], s[5 * 33]); o.w = pk2(s[6 * 33], s[7 * 33]);
        *(u32x4*)(WT + (size_t)(n0 + n) * K + k0 + 8 * c) = o; }
    LDS_WAIT(); asm volatile("" ::: "memory");
}
__device__ __forceinline__ float row_to_bf16(const float* src, const float* g, bf16_t* dst, int lane) {
    float ss = 0.f;
#pragma unroll
    for (int i = 0; i < 8; ++i) {
        const int c = (i * 64 + lane) * 4;
        f32x4 v = *(const f32x4*)(src + c);
        ss += (v[0] * v[0] + v[1] * v[1]) + (v[2] * v[2] + v[3] * v[3]);
        if (g) { const f32x4 gv = *(const f32x4*)(g + c); v = v * gv; }
        u32x2 w; w.x = pk2(v[0], v[1]); w.y = pk2(v[2], v[3]);
        *(u32x2*)(dst + c) = w;
    }
    return ss;
}
constexpr float PEER_USC = 80.0f, PEER_VSC = 5.0f;
constexpr int PEER_ROWB = 1536;
typedef float f32x16v __attribute__((ext_vector_type(16)));
typedef float f32x32v __attribute__((ext_vector_type(32)));
typedef unsigned u32x6 __attribute__((ext_vector_type(6)));
__device__ __forceinline__ void fp6_pack_store(const f32x4 (&x)[8], const f32x4 (&sc)[8], unsigned char* dst, int lane) {
    f32x16v a, b;
#pragma unroll
    for (int i = 0; i < 8; ++i) {
        const f32x4 y = x[i] * sc[i];
#pragma unroll
        for (int q = 0; q < 4; ++q) { const float c = fminf(fmaxf(y[q], -7.5f), 7.5f); const int sl = 4 * i + q; if ((sl & 1) == 0) a[sl >> 1] = c; else b[sl >> 1] = c; }
    }
    const u32x6 pk = __builtin_amdgcn_cvt_scalef32_2xpk16_fp6_f32(a, b, 1.0f);
    *(u32x4*)(dst + lane * 16) = (u32x4){pk[0], pk[1], pk[2], pk[3]};
    *(u32x2*)(dst + 1024 + lane * 8) = (u32x2){pk[4], pk[5]};
}
__device__ __forceinline__ void rows2_to_fp6(const float* s0, const float* s1, const f32x4 (&sc)[8], unsigned char* d0, unsigned char* d1, int lane) {
    f32x4 x0[8], x1[8];
#pragma unroll
    for (int i = 0; i < 8; ++i) { x0[i] = *(const f32x4*)(s0 + (i * 64 + lane) * 4); x1[i] = *(const f32x4*)(s1 + (i * 64 + lane) * 4); }
    fp6_pack_store(x0, sc, d0, lane); fp6_pack_store(x1, sc, d1, lane);
}
__device__ __forceinline__ bf16x8 cvt8(const float* p) {
    const f32x4 a = *(const f32x4*)p, b = *(const f32x4*)(p + 4);
    u32x4 w; w.x = pk2(a[0], a[1]); w.y = pk2(a[2], a[3]); w.z = pk2(b[0], b[1]); w.w = pk2(b[2], b[3]);
    return __builtin_bit_cast(bf16x8, w);
}

__device__ __forceinline__ void phase0(const Params& p, LAS unsigned char* lds, int gw, int NGW, int wave, int lane) {
    unsigned char* ws = p.ws;
    LAS float* scr = (LAS float*)(lds + wave * 16384);
    const float* x = p.in[0];
    {
        constexpr int I_IN = (DM / 64) * (NIN / 32), I_UQ = (512 / 64) * (1536 / 32), I_UKV = (256 / 64) * (2048 / 32), I_OUT = (DM / 64) * (DM / 32);
        constexpr int NIT = I_IN + I_UQ + I_UKV + I_OUT;
        for (int it = gw; it < NIT; it += NGW) {
            int r = it;
            if (r < I_IN) { p0_transpose_item(p.in[2], p.in[1], DM, NIN, (bf16_t*)(ws + WS_WIN), scr, r, lane); continue; } r -= I_IN;
            if (r < I_UQ) { p0_transpose_item(p.in[7], p.in[6], 512, 1536, (bf16_t*)(ws + WS_WUQ), scr, r, lane); continue; } r -= I_UQ;
            if (r < I_UKV) { p0_transpose_item(p.in[9], p.in[8], 256, 2048, (bf16_t*)(ws + WS_WUKV), scr, r, lane); continue; } r -= I_UKV;
            p0_transpose_item(p.in[12], nullptr, DM, DM, (bf16_t*)(ws + WS_WOUT), scr, r, lane);
        }
    }
    for (int r = gw; r < NINP - NIN; r += NGW) {
        bf16_t* d = (bf16_t*)(ws + WS_WIN) + (size_t)(NIN + r) * DM;
#pragma unroll
        for (int i = 0; i < 4; ++i) *(u32x4*)(d + (i * 64 + lane) * 8) = (u32x4){0u, 0u, 0u, 0u};
    }
    {
        const float* wq = p.in[14]; const float* sk = p.in[15]; const float* g2 = p.in[13];
        bf16_t* WsT = (bf16_t*)(ws + WS_WS);
        const int r32 = lane & 31, hh = lane >> 5;
        for (int it = gw; it < 16 * 4 * 64; it += NGW) {
            const int hp = it >> 8, kb = (it >> 6) & 3, nb = it & 63;
            f32x16 acc = {};
            const float* ap = sk + ((size_t)(hp * 128 + kb * 32 + r32)) * 128 + hh * 8;
            const float* bp = wq + ((size_t)(nb * 32 + r32)) * DM + hp * 128 + hh * 8;
#pragma unroll
            for (int s = 0; s < 8; ++s) {
                const bf16x8 a = cvt8(ap + s * 16), b = cvt8(bp + s * 16);
                acc = __builtin_amdgcn_mfma_f32_32x32x16_bf16(a, b, acc, 0, 0, 0);
            }
            const int kcol = nb * 32 + r32; const float gk = g2[kcol];
#pragma unroll
            for (int r = 0; r < 16; ++r) WsT[(size_t)(hp * 128 + kb * 32 + crow(r, hh)) * DM + kcol] = (bf16_t)f2bf(acc[r] * gk);
        }
    }
    {
        bf16_t* xb = (bf16_t*)(ws + WS_XB); float* rstd1 = (float*)(ws + WS_RSTD1);
        for (int t = gw; t + NGW < S; t += 2 * NGW) {
            const int t1 = t + NGW;
            f32x4 a[8], b[8];
#pragma unroll
            for (int i = 0; i < 8; ++i) { a[i] = *(const f32x4*)(x + (size_t)t * DM + (i * 64 + lane) * 4); b[i] = *(const f32x4*)(x + (size_t)t1 * DM + (i * 64 + lane) * 4); }
            float sa = 0.f, sb = 0.f;
#pragma unroll
            for (int i = 0; i < 8; ++i) {
                sa += (a[i][0] * a[i][0] + a[i][1] * a[i][1]) + (a[i][2] * a[i][2] + a[i][3] * a[i][3]);
                sb += (b[i][0] * b[i][0] + b[i][1] * b[i][1]) + (b[i][2] * b[i][2] + b[i][3] * b[i][3]);
                u32x2 wa, wb; wa.x = pk2(a[i][0], a[i][1]); wa.y = pk2(a[i][2], a[i][3]); wb.x = pk2(b[i][0], b[i][1]); wb.y = pk2(b[i][2], b[i][3]);
                *(u32x2*)(xb + (size_t)t * DM + (i * 64 + lane) * 4) = wa; *(u32x2*)(xb + (size_t)t1 * DM + (i * 64 + lane) * 4) = wb;
            }
            sa = wave_sum(sa); sb = wave_sum(sb);
            if (lane == 0) { rstd1[t] = rsqrtf(sa * (1.0f / DM) + EPS); rstd1[t1] = rsqrtf(sb * (1.0f / DM) + EPS); }
        }
    }
    {
        unsigned char* UT = ws + WS_UT; unsigned char* VT = ws + WS_VT;
        f32x4 sc[8];
#pragma unroll
        for (int i = 0; i < 8; ++i) sc[i] = *(const f32x4*)(p.in[13] + (i * 64 + lane) * 4) * PEER_USC;
        for (int e = gw; e + NGW < 16384; e += 2 * NGW)
            rows2_to_fp6(p.in[16] + (size_t)e * DM, p.in[16] + (size_t)(e + NGW) * DM, sc, UT + (size_t)e * PEER_ROWB, UT + (size_t)(e + NGW) * PEER_ROWB, lane);
#pragma unroll
        for (int i = 0; i < 8; ++i) sc[i] = (f32x4){PEER_VSC, PEER_VSC, PEER_VSC, PEER_VSC};
        for (int e = gw; e + NGW < 16384; e += 2 * NGW)
            rows2_to_fp6(p.in[17] + (size_t)e * DM, p.in[17] + (size_t)(e + NGW) * DM, sc, VT + (size_t)e * PEER_ROWB, VT + (size_t)(e + NGW) * PEER_ROWB, lane);
    }
    {
        float* ct = (float*)(ws + WS_COS); float* st = (float*)(ws + WS_SIN);
        for (int it = gw; it < S * 32 / 64; it += NGW) {
            const int idx = it * 64 + lane, t = idx >> 5, j = idx & 31;
            const float inv_freq = powf(10000.0f, -(float)j / 32.0f);
            const float ang = (float)t * inv_freq;
            ct[idx] = cosf(ang); st[idx] = sinf(ang);
        }
    }
}

__device__ __forceinline__ void phase3(const Params& p, int gw, int NGW, int lane) {
    unsigned char* ws = p.ws;
    const bf16_t* qraw = (const bf16_t*)(ws + WS_QRAW); const bf16_t* kvraw = (const bf16_t*)(ws + WS_KVRAW); const bf16_t* proj = (const bf16_t*)(ws + WS_PROJ);
    bf16_t* Qh = (bf16_t*)(ws + WS_QH); bf16_t* Kh = (bf16_t*)(ws + WS_KH); bf16_t* Vh = (bf16_t*)(ws + WS_VH);
    const float* ct = (const float*)(ws + WS_COS); const float* st = (const float*)(ws + WS_SIN);
    const float* gq = p.in[10]; const float* gk = p.in[11];
    const float gq0 = gq[lane], gq1 = gq[64 + lane], gq2 = gq[128 + lane], gk0 = gk[lane], gk1 = gk[64 + lane], gk2 = gk[128 + lane];
    constexpr float QS = 0.07216878364870322f * 1.4426950408889634f;
    for (int t = gw; t < S; t += NGW) {
        const float cs = ct[t * 32 + (lane & 31)], sn = st[t * 32 + (lane & 31)];
        const float kr = bf2f(proj[(size_t)t * NINP + 2816 + lane]);
#pragma unroll
        for (int h = 0; h < 8; ++h) {
            const bf16_t* qp = qraw + (size_t)t * 1536 + h * 192;
            float q0 = bf2f(qp[lane]), q1 = bf2f(qp[64 + lane]), q2 = bf2f(qp[128 + lane]);
            float ss = wave_sum(q0 * q0 + q1 * q1 + q2 * q2);
            float rs = rsqrtf(ss * (1.0f / 192.0f) + EPS);
            q0 *= rs * gq0; q1 *= rs * gq1; q2 *= rs * gq2;
            float pr = __shfl_xor(q2, 32);
            q2 = (lane < 32) ? (q2 * cs - pr * sn) : (pr * sn + q2 * cs);
            bf16_t* qo = Qh + ((size_t)h * S + t) * 192;
            qo[lane] = (bf16_t)f2bf(q0 * QS); qo[64 + lane] = (bf16_t)f2bf(q1 * QS); qo[128 + lane] = (bf16_t)f2bf(q2 * QS);
            const bf16_t* kp = kvraw + (size_t)t * 2048 + h * 256;
            float k0 = bf2f(kp[lane]), k1 = bf2f(kp[64 + lane]), k2 = kr;
            ss = wave_sum(k0 * k0 + k1 * k1 + k2 * k2);
            rs = rsqrtf(ss * (1.0f / 192.0f) + EPS);
            k0 *= rs * gk0; k1 *= rs * gk1; k2 *= rs * gk2;
            pr = __shfl_xor(k2, 32);
            k2 = (lane < 32) ? (k2 * cs - pr * sn) : (pr * sn + k2 * cs);
            bf16_t* ko = Kh + ((size_t)h * S + t) * 192;
            ko[lane] = (bf16_t)f2bf(k0); ko[64 + lane] = (bf16_t)f2bf(k1); ko[128 + lane] = (bf16_t)f2bf(k2);
            bf16_t* vo = Vh + ((size_t)h * S + t) * 128;
            vo[lane] = kp[128 + lane]; vo[64 + lane] = kp[192 + lane];
        }
    }
}

constexpr int KP = 400, VP = 320;
template <int OFF> __device__ __forceinline__ s16x4 tr_read(unsigned addr) {
    s16x4 r; asm volatile("ds_read_b64_tr_b16 %0, %1 offset:%2" : "=&v"(r) : "v"(addr), "i"(OFF) : "memory"); return r;
}
__device__ __forceinline__ unsigned cvtpk(float lo, float hi) { unsigned r; asm volatile("v_cvt_pk_bf16_f32 %0, %1, %2" : "=v"(r) : "v"(lo), "v"(hi)); return r; }
#define PK8(L, H) ((bf16x8){L[0], L[1], L[2], L[3], H[0], H[1], H[2], H[3]})
constexpr float ATT_THR = 8.0f;

constexpr int ATT_KB = 64 * KP, ATT_VB = 64 * VP;
constexpr int ATT_VOFF = 2 * ATT_KB;
__device__ __forceinline__ float xhalf_max(float v) {
    auto rr = __builtin_amdgcn_permlane32_swap(__builtin_bit_cast(unsigned, v), __builtin_bit_cast(unsigned, v), false, false);
    return fmaxf(__builtin_bit_cast(float, rr[0]), __builtin_bit_cast(float, rr[1]));
}
__device__ __forceinline__ float xhalf_sum(float v) {
    auto rr = __builtin_amdgcn_permlane32_swap(__builtin_bit_cast(unsigned, v), __builtin_bit_cast(unsigned, v), false, false);
    return __builtin_bit_cast(float, rr[0]) + __builtin_bit_cast(float, rr[1]);
}
template <int OFF> __device__ __forceinline__ bf16x8 lds_read128(unsigned addr) {
    bf16x8 r; asm volatile("ds_read_b128 %0, %1 offset:%2" : "=&v"(r) : "v"(addr), "i"(OFF) : "memory"); return r;
}
#define LGKM_WAIT(n) do { asm volatile("s_waitcnt lgkmcnt(" #n ")" ::: "memory"); SBAR(); } while (0)
__device__ __forceinline__ f32x16 att_qk(unsigned kaddr, const bf16x8 (&qr)[12]) {
    f32x16 p = {};
    bf16x8 a0 = lds_read128<0>(kaddr), a1 = lds_read128<32>(kaddr), a2 = lds_read128<64>(kaddr), a3 = lds_read128<96>(kaddr);
    LGKM_WAIT(3); p = __builtin_amdgcn_mfma_f32_32x32x16_bf16(a0, qr[0], p, 0, 0, 0); a0 = lds_read128<128>(kaddr);
    LGKM_WAIT(3); p = __builtin_amdgcn_mfma_f32_32x32x16_bf16(a1, qr[1], p, 0, 0, 0); a1 = lds_read128<160>(kaddr);
    LGKM_WAIT(3); p = __builtin_amdgcn_mfma_f32_32x32x16_bf16(a2, qr[2], p, 0, 0, 0); a2 = lds_read128<192>(kaddr);
    LGKM_WAIT(3); p = __builtin_amdgcn_mfma_f32_32x32x16_bf16(a3, qr[3], p, 0, 0, 0); a3 = lds_read128<224>(kaddr);
    LGKM_WAIT(3); p = __builtin_amdgcn_mfma_f32_32x32x16_bf16(a0, qr[4], p, 0, 0, 0); a0 = lds_read128<256>(kaddr);
    LGKM_WAIT(3); p = __builtin_amdgcn_mfma_f32_32x32x16_bf16(a1, qr[5], p, 0, 0, 0); a1 = lds_read128<288>(kaddr);
    LGKM_WAIT(3); p = __builtin_amdgcn_mfma_f32_32x32x16_bf16(a2, qr[6], p, 0, 0, 0); a2 = lds_read128<320>(kaddr);
    LGKM_WAIT(3); p = __builtin_amdgcn_mfma_f32_32x32x16_bf16(a3, qr[7], p, 0, 0, 0); a3 = lds_read128<352>(kaddr);
    LGKM_WAIT(3); p = __builtin_amdgcn_mfma_f32_32x32x16_bf16(a0, qr[8], p, 0, 0, 0);
    LGKM_WAIT(2); p = __builtin_amdgcn_mfma_f32_32x32x16_bf16(a1, qr[9], p, 0, 0, 0);
    LGKM_WAIT(1); p = __builtin_amdgcn_mfma_f32_32x32x16_bf16(a2, qr[10], p, 0, 0, 0);
    LGKM_WAIT(0); p = __builtin_amdgcn_mfma_f32_32x32x16_bf16(a3, qr[11], p, 0, 0, 0);
    return p;
}
__device__ __forceinline__ void att_finish(f32x16& s, float m, float& lsum, bf16x8& pb0, bf16x8& pb1) {
    float ps = 0.f;
#pragma unroll
    for (int r = 0; r < 16; ++r) { s[r] = __builtin_amdgcn_exp2f(s[r] - m); ps += s[r]; }
    lsum += xhalf_sum(ps);
    u32x4 w0 = {cvtpk(s[0], s[1]), cvtpk(s[2], s[3]), cvtpk(s[4], s[5]), cvtpk(s[6], s[7])};
    u32x4 w1 = {cvtpk(s[8], s[9]), cvtpk(s[10], s[11]), cvtpk(s[12], s[13]), cvtpk(s[14], s[15])};
    pb0 = __builtin_bit_cast(bf16x8, w0); pb1 = __builtin_bit_cast(bf16x8, w1);
}
__device__ __forceinline__ void att_pv(unsigned vaddr, bf16x8 pb0, bf16x8 pb1, f32x16 (&o)[4]) {
#define VOFF(d0, s, hi) (((16 * (s) + 8 * (hi)) * VP) + 64 * (d0))
    const s16x4 a00l = tr_read<VOFF(0, 0, 0)>(vaddr), a00h = tr_read<VOFF(0, 0, 1)>(vaddr), a01l = tr_read<VOFF(0, 1, 0)>(vaddr), a01h = tr_read<VOFF(0, 1, 1)>(vaddr);
    const s16x4 a10l = tr_read<VOFF(1, 0, 0)>(vaddr), a10h = tr_read<VOFF(1, 0, 1)>(vaddr), a11l = tr_read<VOFF(1, 1, 0)>(vaddr), a11h = tr_read<VOFF(1, 1, 1)>(vaddr);
    LGKM_WAIT(4);
    o[0] = __builtin_amdgcn_mfma_f32_32x32x16_bf16(PK8(a00l, a00h), pb0, o[0], 0, 0, 0); o[0] = __builtin_amdgcn_mfma_f32_32x32x16_bf16(PK8(a01l, a01h), pb1, o[0], 0, 0, 0);
    const s16x4 a20l = tr_read<VOFF(2, 0, 0)>(vaddr), a20h = tr_read<VOFF(2, 0, 1)>(vaddr), a21l = tr_read<VOFF(2, 1, 0)>(vaddr), a21h = tr_read<VOFF(2, 1, 1)>(vaddr);
    LGKM_WAIT(4);
    o[1] = __builtin_amdgcn_mfma_f32_32x32x16_bf16(PK8(a10l, a10h), pb0, o[1], 0, 0, 0); o[1] = __builtin_amdgcn_mfma_f32_32x32x16_bf16(PK8(a11l, a11h), pb1, o[1], 0, 0, 0);
    const s16x4 a30l = tr_read<VOFF(3, 0, 0)>(vaddr), a30h = tr_read<VOFF(3, 0, 1)>(vaddr), a31l = tr_read<VOFF(3, 1, 0)>(vaddr), a31h = tr_read<VOFF(3, 1, 1)>(vaddr);
    LGKM_WAIT(4);
    o[2] = __builtin_amdgcn_mfma_f32_32x32x16_bf16(PK8(a20l, a20h), pb0, o[2], 0, 0, 0); o[2] = __builtin_amdgcn_mfma_f32_32x32x16_bf16(PK8(a21l, a21h), pb1, o[2], 0, 0, 0);
    LGKM_WAIT(0);
    o[3] = __builtin_amdgcn_mfma_f32_32x32x16_bf16(PK8(a30l, a30h), pb0, o[3], 0, 0, 0); o[3] = __builtin_amdgcn_mfma_f32_32x32x16_bf16(PK8(a31l, a31h), pb1, o[3], 0, 0, 0);
#undef VOFF
}
__device__ __forceinline__ void att_partial(const f32x16& s, float& m, float& lsum, f32x16 (&o)[4]) {
    float pmax = s[0];
#pragma unroll
    for (int r = 1; r < 16; ++r) pmax = fmaxf(pmax, s[r]);
    pmax = xhalf_max(pmax);
    if (!__all(pmax - m <= ATT_THR)) {
        const float mn = fmaxf(m, pmax); const float alpha = __builtin_amdgcn_exp2f(m - mn); m = mn; lsum *= alpha;
#pragma unroll
        for (int d = 0; d < 4; ++d)
#pragma unroll
            for (int r = 0; r < 16; ++r) o[d][r] *= alpha;
    }
}

__device__ __forceinline__ void attn_unit(const Params& p, LAS unsigned char* lds, int head, int qb, int tid, int wave, int lane) {
    unsigned char* ws = p.ws;
    const bf16_t* Qh = (const bf16_t*)(ws + WS_QH); const bf16_t* Kh = (const bf16_t*)(ws + WS_KH); const bf16_t* Vh = (const bf16_t*)(ws + WS_VH);
    bf16_t* mix = (bf16_t*)(ws + WS_MIX);
    const int rg = wave & 3, kh = wave >> 2, r32 = lane & 31, hh = lane >> 5;
    const int q0row = qb * 128 + rg * 32;
    bf16x8 qr[12];
    {
        const bf16_t* qp = Qh + ((size_t)head * S + q0row + r32) * 192 + hh * 8;
#pragma unroll
        for (int ks = 0; ks < 12; ++ks) qr[ks] = *(const bf16x8*)(qp + ks * 16);
    }
    const int ntiles = 2 * qb + 2, mylast = 2 * qb + (rg >> 1);
    float m = -1e30f, lsum = 0.f; f32x16 o[4] = {};
    const int srow = tid >> 3, sch = tid & 7;
    const int kg0 = srow * 192 + sch * 8, kl0 = srow * KP + sch * 16, vg0 = srow * 128 + sch * 8, vl0 = ATT_VOFF + srow * VP + sch * 16;
    const bf16_t* kbase = Kh + (size_t)head * S * 192; const bf16_t* vbase = Vh + (size_t)head * S * 128;
    u32x4 sk0, sk1, sk2, sv0, sv1;
#define ATT_LOAD(t) do { const bf16_t* kt = kbase + (size_t)(t) * 64 * 192 + kg0; const bf16_t* vt = vbase + (size_t)(t) * 64 * 128 + vg0; \
        sk0 = *(const u32x4*)(kt); sk1 = *(const u32x4*)(kt + 64); sk2 = *(const u32x4*)(kt + 128); sv0 = *(const u32x4*)(vt); sv1 = *(const u32x4*)(vt + 64); } while (0)
#define ATT_WRITE(kb_, vb_) do { LAS unsigned char* bk = lds + (kb_) * ATT_KB + kl0; LAS unsigned char* bv = lds + (vb_) * ATT_VB + vl0; *(LAS u32x4*)(bk) = sk0; *(LAS u32x4*)(bk + 128) = sk1; *(LAS u32x4*)(bk + 256) = sk2; \
        *(LAS u32x4*)(bv) = sv0; *(LAS u32x4*)(bv + 128) = sv1; } while (0)
    const unsigned ldsbase = (unsigned)(size_t)lds;
    const unsigned kaddr0 = ldsbase + (unsigned)((32 * kh + r32) * KP + hh * 16);
    const unsigned vrel = (unsigned)(ATT_VOFF + (32 * kh + 4 * hh + ((lane & 15) >> 2)) * VP + (16 * ((lane >> 4) & 1) + 4 * (lane & 3)) * 2);
    ATT_LOAD(0); ATT_WRITE(0, 0); __syncthreads();
    bf16x8 pb0, pb1;
    const bool more0 = (1 < ntiles);
    if (more0) ATT_LOAD(1);
    f32x16 sprev = att_qk(kaddr0, qr);
    att_partial(sprev, m, lsum, o);
    if (more0) ATT_WRITE(1, 1);
    __syncthreads();
    int vprev = 0, vcur = 1;
#pragma unroll 1
    for (int t = 1; t <= ntiles; ++t) {
        const bool more = (t + 1 < ntiles);
        if (more) ATT_LOAD(t + 1);
        f32x16 sc;
        if (t <= mylast) sc = att_qk(kaddr0 + (t & 1) * ATT_KB, qr);
        else {
#pragma unroll
            for (int r = 0; r < 16; ++r) sc[r] = -1e30f;
        }
        att_finish(sprev, m, lsum, pb0, pb1);
        att_pv(ldsbase + vprev * ATT_VB + vrel, pb0, pb1, o);
        att_partial(sc, m, lsum, o);
        sprev = sc;
        const int vnext = (vcur == 2) ? 0 : vcur + 1;
        if (more) ATT_WRITE((t + 1) & 1, vnext);
        vprev = vcur; vcur = vnext;
        __syncthreads();
    }
#undef ATT_LOAD
#undef ATT_WRITE
    LAS float* scr = (LAS float*)lds + (size_t)rg * 66 * 64 + lane;
    if (kh == 1) {
        scr[0] = m; scr[64] = lsum;
#pragma unroll
        for (int d = 0; d < 4; ++d)
#pragma unroll
            for (int r = 0; r < 16; ++r) scr[(2 + d * 16 + r) * 64] = o[d][r];
    }
    __syncthreads();
    if (kh == 0) {
        const float m2 = scr[0], l2 = scr[64];
        const float mn = fmaxf(m, m2), a1 = __builtin_amdgcn_exp2f(m - mn), a2 = __builtin_amdgcn_exp2f(m2 - mn);
        const float inv = 1.0f / (lsum * a1 + l2 * a2);
        bf16_t* op = mix + (size_t)(q0row + r32) * DM + 1024 + head * 128 + 4 * hh;
#pragma unroll
        for (int d = 0; d < 4; ++d)
#pragma unroll
            for (int g4 = 0; g4 < 4; ++g4) {
                float v[4];
#pragma unroll
                for (int i = 0; i < 4; ++i) { const int r = 4 * g4 + i; v[i] = (o[d][r] * a1 + scr[(2 + d * 16 + r) * 64] * a2) * inv; }
                u32x2 w; w.x = pk2(v[0], v[1]); w.y = pk2(v[2], v[3]);
                *(u32x2*)(op + 32 * d + 8 * g4) = w;
            }
    }
    __syncthreads();
}

__device__ __forceinline__ void gmlp_unit(const Params& p, LAS unsigned char* lds, int nb, int h, int tid, int wave, int lane) {
    unsigned char* ws = p.ws;
    const bf16_t* proj = (const bf16_t*)(ws + WS_PROJ); bf16_t* mix = (bf16_t*)(ws + WS_MIX);
    const float* ssv = (const float*)(ws + WS_ROWSS);
    const float* vg = p.in[3]; const float* wsp = p.in[4]; const float* bs = p.in[5];
#pragma unroll
    for (int i = 0; i < 4; ++i) {
        const int pc = tid + 512 * i, r = pc >> 4, c = pc & 15, t = nb * 128 + r;
        const u32x4 w = *(const u32x4*)(proj + (size_t)t * NINP + 1024 + h * 128 + c * 8);
        const float rs = rsqrtf(ssv[t] * (1.0f / 1024.0f) + EPS);
        const f32x4 g0 = *(const f32x4*)(vg + h * 128 + c * 8), g1 = *(const f32x4*)(vg + h * 128 + c * 8 + 4);
        u32x4 ov;
        ov.x = pk2(bflo(w.x) * rs * g0[0], bfhi(w.x) * rs * g0[1]); ov.y = pk2(bflo(w.y) * rs * g0[2], bfhi(w.y) * rs * g0[3]);
        ov.z = pk2(bflo(w.z) * rs * g1[0], bfhi(w.z) * rs * g1[1]); ov.w = pk2(bflo(w.w) * rs * g1[2], bfhi(w.w) * rs * g1[3]);
        *(LAS u32x4*)(lds + r * VP + c * 16) = ov;
    }
    __syncthreads();
    const int ib = wave & 3, ch = wave >> 2, r32 = lane & 31, hh = lane >> 5;
    const int irow = 32 * ib + r32;
    f32x16 acc0 = {}, acc1 = {};
    const unsigned vaddr = (unsigned)(size_t)lds + (unsigned)((8 * hh + ((lane & 15) >> 2)) * VP + (64 * ch + 16 * ((lane >> 4) & 1) + 4 * (lane & 3)) * 2);
    const float* wrow = wsp + ((size_t)h * 128 + irow) * 128 + hh * 8;
#define GSTEP(s) do { if ((s) < 2 * (ib + 1)) { \
        const f32x4 wa = *(const f32x4*)(wrow + (s) * 16), wb = *(const f32x4*)(wrow + (s) * 16 + 4); const int j0 = (s) * 16 + hh * 8; \
        u32x4 aw; aw.x = pk2(j0 + 0 <= irow ? wa[0] : 0.f, j0 + 1 <= irow ? wa[1] : 0.f); aw.y = pk2(j0 + 2 <= irow ? wa[2] : 0.f, j0 + 3 <= irow ? wa[3] : 0.f); \
        aw.z = pk2(j0 + 4 <= irow ? wb[0] : 0.f, j0 + 5 <= irow ? wb[1] : 0.f); aw.w = pk2(j0 + 6 <= irow ? wb[2] : 0.f, j0 + 7 <= irow ? wb[3] : 0.f); \
        const bf16x8 af = __builtin_bit_cast(bf16x8, aw); \
        const s16x4 b0l = tr_read<(16 * (s)) * VP>(vaddr), b0h = tr_read<(16 * (s) + 4) * VP>(vaddr), b1l = tr_read<(16 * (s)) * VP + 64>(vaddr), b1h = tr_read<(16 * (s) + 4) * VP + 64>(vaddr); \
        LDS_WAIT(); SBAR(); \
        acc0 = __builtin_amdgcn_mfma_f32_32x32x16_bf16(af, PK8(b0l, b0h), acc0, 0, 0, 0); acc1 = __builtin_amdgcn_mfma_f32_32x32x16_bf16(af, PK8(b1l, b1h), acc1, 0, 0, 0); } } while (0)
    GSTEP(0); GSTEP(1); GSTEP(2); GSTEP(3); GSTEP(4); GSTEP(5); GSTEP(6); GSTEP(7);
#undef GSTEP
#pragma unroll
    for (int r = 0; r < 16; ++r) {
        const int i = 32 * ib + crow(r, hh), t = nb * 128 + i; const float b = bs[h * 128 + i];
        const int c0 = h * 128 + 64 * ch + r32;
        const float u0 = bf2f(proj[(size_t)t * NINP + c0]), u1 = bf2f(proj[(size_t)t * NINP + c0 + 32]);
        mix[(size_t)t * DM + c0] = (bf16_t)f2bf(u0 * (acc0[r] + b)); mix[(size_t)t * DM + c0 + 32] = (bf16_t)f2bf(u1 * (acc1[r] + b));
    }
    __syncthreads();
}

template <int CTRL, int ROW_MASK> __device__ __forceinline__ float dpp_f(float old, float v) {
    return __builtin_bit_cast(float, __builtin_amdgcn_update_dpp(__builtin_bit_cast(int, old), __builtin_bit_cast(int, v), CTRL, ROW_MASK, 0xf, false));
}
__device__ __forceinline__ float wave_max_u(float v) {
    v = fmaxf(v, dpp_f<0xB1, 0xf>(v, v));
    v = fmaxf(v, dpp_f<0x4E, 0xf>(v, v));
    v = fmaxf(v, dpp_f<0x141, 0xf>(v, v));
    v = fmaxf(v, dpp_f<0x140, 0xf>(v, v));
    v = fmaxf(v, dpp_f<0x142, 0xa>(v, v));
    v = fmaxf(v, dpp_f<0x143, 0xc>(v, v));
    return __builtin_bit_cast(float, __builtin_amdgcn_readlane(__builtin_bit_cast(int, v), 63));
}
__device__ __forceinline__ float wave_sum_u(float v) {
    v += dpp_f<0xB1, 0xf>(0.f, v);
    v += dpp_f<0x4E, 0xf>(0.f, v);
    v += dpp_f<0x141, 0xf>(0.f, v);
    v += dpp_f<0x140, 0xf>(0.f, v);
    v += dpp_f<0x142, 0xa>(0.f, v);
    v += dpp_f<0x143, 0xc>(0.f, v);
    return __builtin_bit_cast(float, __builtin_amdgcn_readlane(__builtin_bit_cast(int, v), 63));
}
__device__ __forceinline__ void phase7(const Params& p, LAS unsigned char* lds, int gw, int NGW, int wave, int lane) {
    unsigned char* ws = p.ws;
    const float* sc = (const float*)(ws + WS_SC); int* ex = (int*)(ws + WS_EXP); float* gt = (float*)(ws + WS_GATE);
    const float NEG = -3.0e38f;
    LAS float* sl = (LAS float*)(lds + wave * 1024);
    const int j8 = lane & 7, g8 = lane >> 3, row = lane >> 4, i16 = lane & 15;
    int ci[4], cj[4]; bool cval[4];
    {
        constexpr int starts[16] = {0, 16, 24, 29, 33, 36, 38, 40, 42, 43, 44, 45, 46, 47, 48, 49};
#pragma unroll
        for (int m = 0; m < 4; ++m) {
            const int c = i16 + 16 * m; int a = 0, st = 0;
#pragma unroll
            for (int i = 1; i < 16; ++i) if (c >= starts[i]) { a = i; st = starts[i]; }
            cval[m] = c < 50; ci[m] = cval[m] ? a : 0; cj[m] = cval[m] ? (c - st) : 0;
        }
    }
    constexpr int NT = S * 2;
    f32x4 nx0, nx1, nx2, nx3;
    if (gw < NT) { const float* b = sc + (size_t)(gw >> 1) * DM + (gw & 1) * 1024 + lane * 16; nx0 = *(const f32x4*)b; nx1 = *(const f32x4*)(b + 4); nx2 = *(const f32x4*)(b + 8); nx3 = *(const f32x4*)(b + 12); }
    for (int it = gw; it < NT; it += NGW) {
        const int t = it >> 1, hh = it & 1;
        float v[16];
#pragma unroll
        for (int q = 0; q < 4; ++q) { v[q] = nx0[q]; v[4 + q] = nx1[q]; v[8 + q] = nx2[q]; v[12 + q] = nx3[q]; }
        if (it + NGW < NT) { const int it2 = it + NGW; const float* b = sc + (size_t)(it2 >> 1) * DM + (it2 & 1) * 1024 + lane * 16;
            nx0 = *(const f32x4*)b; nx1 = *(const f32x4*)(b + 4); nx2 = *(const f32x4*)(b + 8); nx3 = *(const f32x4*)(b + 12); }
#pragma unroll
        for (int m = 0; m < 16; ++m) v[m] = __builtin_bit_cast(float, (__builtin_bit_cast(unsigned, v[m]) & ~127u) | (unsigned)(16 * j8 + m));
        float ra = 0.f, rb = 0.f;
#pragma unroll
        for (int k = 0; k < 16; ++k) {
            float mx = fmaxf(fmaxf(fmaxf(v[0], v[1]), fmaxf(v[2], v[3])), fmaxf(fmaxf(v[4], v[5]), fmaxf(v[6], v[7])));
            mx = fmaxf(mx, fmaxf(fmaxf(fmaxf(v[8], v[9]), fmaxf(v[10], v[11])), fmaxf(fmaxf(v[12], v[13]), fmaxf(v[14], v[15]))));
            mx = fmaxf(mx, dpp_f<0xB1, 0xf>(mx, mx));
            mx = fmaxf(mx, dpp_f<0x4E, 0xf>(mx, mx));
            mx = fmaxf(mx, dpp_f<0x141, 0xf>(mx, mx));
#pragma unroll
            for (int m = 0; m < 16; ++m) v[m] = (v[m] == mx) ? NEG : v[m];
            if (k < 8) ra = (j8 == k) ? mx : ra; else rb = (j8 == k - 8) ? mx : rb;
        }
        sl[g8 * 16 + j8] = ra; sl[g8 * 16 + 8 + j8] = rb;
        LDS_WAIT(); asm volatile("" ::: "memory");
        float cv[4], og[4]; int id[4];
#pragma unroll
        for (int m = 0; m < 4; ++m) {
            const float s1 = sl[(2 * row) * 16 + ci[m]], s2 = sl[(2 * row + 1) * 16 + cj[m]];
            og[m] = cval[m] ? (s1 + s2) : NEG; cv[m] = og[m];
            id[m] = (int)((__builtin_bit_cast(unsigned, s1) & 127u) * 128u + (__builtin_bit_cast(unsigned, s2) & 127u));
        }
        LDS_WAIT(); asm volatile("" ::: "memory");
        float M0 = 0.f;
#pragma unroll
        for (int k = 0; k < 16; ++k) {
            float mx = fmaxf(fmaxf(cv[0], cv[1]), fmaxf(cv[2], cv[3]));
            mx = fmaxf(mx, dpp_f<0xB1, 0xf>(mx, mx));
            mx = fmaxf(mx, dpp_f<0x4E, 0xf>(mx, mx));
            mx = fmaxf(mx, dpp_f<0x141, 0xf>(mx, mx));
            mx = fmaxf(mx, dpp_f<0x140, 0xf>(mx, mx));
            if (k == 0) M0 = mx;
#pragma unroll
            for (int m = 0; m < 4; ++m) cv[m] = (cv[m] == mx) ? NEG : cv[m];
        }
        bool sel[4]; float e[4]; float es = 0.f;
#pragma unroll
        for (int m = 0; m < 4; ++m) { sel[m] = (cv[m] != og[m]); e[m] = sel[m] ? __expf(og[m] - M0) : 0.f; es += e[m]; }
        es += dpp_f<0xB1, 0xf>(0.f, es); es += dpp_f<0x4E, 0xf>(0.f, es); es += dpp_f<0x141, 0xf>(0.f, es); es += dpp_f<0x140, 0xf>(0.f, es);
        const float inv = 1.0f / es;
        int basepos = 0;
        const int head = 4 * hh + row;
#pragma unroll
        for (int m = 0; m < 4; ++m) {
            const unsigned long long bl = __ballot(sel[m]);
            const unsigned rbits = (unsigned)(bl >> (16 * row)) & 0xffffu;
            const int pos = basepos + __popc(rbits & ((1u << i16) - 1u));
            if (sel[m] && pos < 16) { ex[(size_t)t * 128 + head * 16 + pos] = id[m]; gt[(size_t)t * 128 + head * 16 + pos] = e[m] * inv; }
            basepos += __popc(rbits);
        }
    }
}

typedef __bf16 bf16x32v __attribute__((ext_vector_type(32)));
typedef __bf16 bf16x2v __attribute__((ext_vector_type(2)));
typedef float f32x2 __attribute__((ext_vector_type(2)));
#ifndef P8_THROTTLE
#define P8_THROTTLE 0
#endif
constexpr unsigned P8_SLACK = 12;
__device__ __forceinline__ void phase8(const Params& p, LAS unsigned char* lds, float* dst, unsigned xcc, unsigned nwx, int gw, int NGW, int wave, int lane) {
    unsigned char* ws = p.ws;
    const bf16_t* x1b = (const bf16_t*)(ws + WS_X1B); const unsigned char* UT = ws + WS_UT; const unsigned char* VT = ws + WS_VT;
    const int* ex = (const int*)(ws + WS_EXP); const float* gt = (const float*)(ws + WS_GATE); const float* ss2 = (const float*)(ws + WS_ROWSS) + 3 * S;
    const float* out = p.out;
    LAS unsigned char* xl = lds + wave * 16384;
    LAS unsigned* list = (LAS unsigned*)(lds + 131072 + wave * 2048);
    LAS unsigned* hist = (LAS unsigned*)(lds + 147456 + wave * 256);
    for (int tb = gw; tb < S / 4; tb += NGW) {
        const int t0 = tb * 4;
        int id[8]; float gv[8];
#pragma unroll
        for (int r = 0; r < 8; ++r) { const size_t o = (size_t)(t0 + (r >> 1)) * 128 + (r & 1) * 64 + lane; id[r] = ex[o]; gv[r] = gt[o]; }
        const float rs0 = rsqrtf(ss2[t0 + 0] * (1.0f / DM) + EPS) * (1.0f / PEER_USC), rs1 = rsqrtf(ss2[t0 + 1] * (1.0f / DM) + EPS) * (1.0f / PEER_USC);
        const float rs2 = rsqrtf(ss2[t0 + 2] * (1.0f / DM) + EPS) * (1.0f / PEER_USC), rs3 = rsqrtf(ss2[t0 + 3] * (1.0f / DM) + EPS) * (1.0f / PEER_USC);
        hist[lane] = 0u;
        LDS_WAIT(); asm volatile("" ::: "memory");
        unsigned pos[8];
#pragma unroll
        for (int r = 0; r < 8; ++r) pos[r] = __hip_atomic_fetch_add(hist + (id[r] >> 8), 1u, __ATOMIC_RELAXED, __HIP_MEMORY_SCOPE_WORKGROUP);
        LDS_WAIT(); asm volatile("" ::: "memory");
        const unsigned cnt = hist[lane];
        unsigned inc = cnt;
#pragma unroll
        for (int o = 1; o < 64; o <<= 1) { const unsigned n = __shfl_up(inc, o); if (lane >= o) inc += n; }
        LDS_WAIT(); asm volatile("" ::: "memory");
        hist[lane] = inc - cnt;
        LDS_WAIT(); asm volatile("" ::: "memory");
#pragma unroll
        for (int r = 0; r < 8; ++r) { const unsigned d = hist[id[r] >> 8] + pos[r]; list[d] = (unsigned)id[r] | ((unsigned)(r >> 1) << 14) | (f2bf(gv[r]) << 16); }
#pragma unroll
        for (int j = 0; j < 4; ++j)
#pragma unroll
            for (int g = 0; g < 4; ++g) {
                const u32x2 w0 = *(const u32x2*)(x1b + (size_t)(t0 + j) * DM + ((2 * g) * 64 + lane) * 4), w1 = *(const u32x2*)(x1b + (size_t)(t0 + j) * DM + ((2 * g + 1) * 64 + lane) * 4);
                *(LAS u32x4*)(xl + j * 4096 + g * 1024 + lane * 16) = (u32x4){w0.x, w0.y, w1.x, w1.y};
            }
        asm volatile("s_waitcnt vmcnt(0) lgkmcnt(0)" ::: "memory");
        {
            const __amdgpu_buffer_rsrc_t urs = __builtin_amdgcn_make_buffer_rsrc((void*)UT, 0, 16384 * PEER_ROWB, 0x00020000);
            const int vo4 = lane * 16, vo2 = lane * 8 + 1024;
            const bool lb0 = (lane & 1) != 0, lb1 = (lane & 2) != 0, lb2 = (lane & 4) != 0;
#define P8_ULOAD(k, i) do { const unsigned en = (unsigned)__builtin_amdgcn_readfirstlane((int)list[(i)]); uen[k] = en; const int ro = (int)((en & 0x3fffu) * (unsigned)PEER_ROWB); \
            u4[k] = __builtin_amdgcn_raw_buffer_load_b128(urs, vo4, ro, 0); u2[k] = __builtin_amdgcn_raw_buffer_load_b64(urs, vo2, ro, 0); } while (0)
#define P8_UPROC(k) do { const u32x6 pk = {u4[k][0], u4[k][1], u4[k][2], u4[k][3], u2[k][0], u2[k][1]}; \
            const bf16x32v r_ = __builtin_amdgcn_cvt_scalef32_pk32_bf16_fp6(pk, 1.0f); const LAS unsigned char* xp = xl + ((uen[k] >> 14) & 3u) * 4096 + lane * 16; \
            float d0 = 0.f, d1 = 0.f, d2 = 0.f, d3 = 0.f; \
            _Pragma("unroll") for (int g = 0; g < 4; ++g) { const LAS unsigned* xw = (const LAS unsigned*)(xp + g * 1024); const unsigned x0 = xw[0], x1 = xw[1], x2 = xw[2], x3 = xw[3]; \
                { const bf16x2v uu = {r_[8 * g + 0], r_[8 * g + 1]}; d0 = __builtin_amdgcn_fdot2_f32_bf16(uu, __builtin_bit_cast(bf16x2v, x0), d0, false); } \
                { const bf16x2v uu = {r_[8 * g + 2], r_[8 * g + 3]}; d1 = __builtin_amdgcn_fdot2_f32_bf16(uu, __builtin_bit_cast(bf16x2v, x1), d1, false); } \
                { const bf16x2v uu = {r_[8 * g + 4], r_[8 * g + 5]}; d2 = __builtin_amdgcn_fdot2_f32_bf16(uu, __builtin_bit_cast(bf16x2v, x2), d2, false); } \
                { const bf16x2v uu = {r_[8 * g + 6], r_[8 * g + 7]}; d3 = __builtin_amdgcn_fdot2_f32_bf16(uu, __builtin_bit_cast(bf16x2v, x3), d3, false); } } \
            dd[k] = (d0 + d1) + (d2 + d3); } while (0)
#if (PROBE_DUP >> 10) & 1
#define P8_UREPS 2
#else
#define P8_UREPS 1
#endif
#pragma unroll 1
            for (int urep = 0; urep < P8_UREPS; ++urep) {
                u32x4 u4[8]; u32x2 u2[8]; unsigned uen[8];
#pragma unroll
                for (int k = 0; k < 8; ++k) P8_ULOAD(k, k);
#pragma unroll 1
                for (int i = 0; i < 512; i += 8) {
                    const unsigned ev = list[i + (lane & 7)]; const unsigned jl = (ev >> 14) & 3u;
                    const float gl = __builtin_bit_cast(float, ev & 0xffff0000u), rl = jl == 0u ? rs0 : (jl == 1u ? rs1 : (jl == 2u ? rs2 : rs3));
                    float dd[8];
#pragma unroll
                    for (int k = 0; k < 8; ++k) { P8_UPROC(k); const int nx = i + 8 + k; P8_ULOAD(k, nx < 512 ? nx : 511); }
                    float w4[4], w2[2];
#pragma unroll
                    for (int q = 0; q < 4; ++q) { const float kp = lb2 ? dd[q + 4] : dd[q], sd = lb2 ? dd[q] : dd[q + 4]; w4[q] = kp + __shfl_xor(sd, 4); }
#pragma unroll
                    for (int q = 0; q < 2; ++q) { const float kp = lb1 ? w4[q + 2] : w4[q], sd = lb1 ? w4[q] : w4[q + 2]; w2[q] = kp + __shfl_xor(sd, 2); }
                    float dres; { const float kp = lb0 ? w2[1] : w2[0], sd = lb0 ? w2[0] : w2[1]; dres = kp + __shfl_xor(sd, 1); }
                    dres += __shfl_xor(dres, 8); dres += __shfl_xor(dres, 16); dres += __shfl_xor(dres, 32);
                    const float c_ = gl * gelu_tanh(rl * dres) * (1.0f / PEER_VSC);
                    if (lane < 8 && urep == P8_UREPS - 1) list[i + lane] = (ev & 0xffffu) | (f2bf(c_) << 16);
                }
            }
#undef P8_ULOAD
#undef P8_UPROC
        }
        asm volatile("s_waitcnt vmcnt(0)" ::: "memory");
        LDS_WAIT(); asm volatile("" ::: "memory");
        f32x4 acc[32];
#if (PROBE_DUP >> 12) & 1
#define P8_VREPS 2
#else
#define P8_VREPS 1
#endif
#pragma unroll 1
        for (int vrep = 0; vrep < P8_VREPS; ++vrep) {
#pragma unroll
        for (int i = 0; i < 32; ++i) acc[i] = (f32x4){0.f, 0.f, 0.f, 0.f};
        {
            typedef unsigned u32x16 __attribute__((ext_vector_type(16)));
            u32x4 v4[4]; u32x2 v2[4]; unsigned ven[4];
            const unsigned tok = (unsigned)lane & 3u;
            const __amdgpu_buffer_rsrc_t vrs = __builtin_amdgcn_make_buffer_rsrc((void*)VT, 0, 16384 * PEER_ROWB, 0x00020000);
            const int vo4 = lane * 16, vo2 = lane * 8 + 1024;
#define P8_VLOAD(k, i) do { const unsigned en = (unsigned)__builtin_amdgcn_readfirstlane((int)list[(i)]); ven[k] = en; const int ro = (int)((en & 0x3fffu) * (unsigned)PEER_ROWB); \
            v4[k] = __builtin_amdgcn_raw_buffer_load_b128(vrs, vo4, ro, 0); v2[k] = __builtin_amdgcn_raw_buffer_load_b64(vrs, vo2, ro, 0); } while (0)
#define P8_VPROC2(ka, kb) do { const u32x6 pka = {v4[ka][0], v4[ka][1], v4[ka][2], v4[ka][3], v2[ka][0], v2[ka][1]}, pkb = {v4[kb][0], v4[kb][1], v4[kb][2], v4[kb][3], v2[kb][0], v2[kb][1]}; \
            const u32x16 da = __builtin_bit_cast(u32x16, __builtin_amdgcn_cvt_scalef32_pk32_bf16_fp6(pka, 1.0f)), db = __builtin_bit_cast(u32x16, __builtin_amdgcn_cvt_scalef32_pk32_bf16_fp6(pkb, 1.0f)); \
            const unsigned ea = ven[ka], eb = ven[kb]; \
            const unsigned alo = ((((ea >> 14) & 3u) == tok) ? (ea >> 16) : 0u) | ((((eb >> 14) & 3u) == tok) ? (eb & 0xffff0000u) : 0u); \
            const s16x4 av = __builtin_bit_cast(s16x4, (unsigned long long)alo); \
            _Pragma("unroll") for (int m = 0; m < 16; ++m) { \
                const unsigned be = __builtin_amdgcn_perm(db[m], da[m], 0x05040100u), bo = __builtin_amdgcn_perm(db[m], da[m], 0x07060302u); \
                acc[2 * m] = __builtin_amdgcn_mfma_f32_4x4x4bf16_1k(av, __builtin_bit_cast(s16x4, (unsigned long long)be), acc[2 * m], 0, 0, 0); \
                acc[2 * m + 1] = __builtin_amdgcn_mfma_f32_4x4x4bf16_1k(av, __builtin_bit_cast(s16x4, (unsigned long long)bo), acc[2 * m + 1], 0, 0, 0); } } while (0)
#pragma unroll
            for (int k = 0; k < 4; ++k) P8_VLOAD(k, k);
#pragma unroll 1
            for (int i = 0; i < 512; i += 4) {
#pragma unroll
                for (int k = 0; k < 4; k += 2) { P8_VPROC2(k, k + 1); const int nx = i + 4 + k < 512 ? i + 4 + k : 510; P8_VLOAD(k, nx); P8_VLOAD(k + 1, nx + 1); }
            }
#undef P8_VLOAD
#undef P8_VPROC2
        }
        }
        int tq = t0, lq = lane; asm volatile("" : "+s"(tq)); asm volatile("" : "+v"(lq));
#pragma unroll
        for (int j = 0; j < 4; ++j)
#pragma unroll
            for (int i = 0; i < 8; ++i) {
                const size_t o = (size_t)(tq + j) * DM + (i * 64 + lq) * 4;
                f32x4 a = *(const f32x4*)(out + o);
#pragma unroll
                for (int q = 0; q < 4; ++q) a[q] += acc[4 * i + q][j];
                *(f32x4*)(dst + o) = a;
                if (i & 1) asm volatile("" ::: "memory");
            }
        LDS_WAIT(); asm volatile("" ::: "memory");
    }
}

__global__ void __launch_bounds__(NTHREADS, 2) mega(Params p) {
    extern __shared__ __attribute__((aligned(16))) unsigned char lds_raw[];
    LAS unsigned char* lds = (LAS unsigned char*)lds_raw;
    const int tid = threadIdx.x, lane = tid & 63, wave = __builtin_amdgcn_readfirstlane(tid >> 6);
    const int G = gridDim.x, bx = blockIdx.x;
    const int gw = bx * 8 + wave, NGW = G * 8;
    unsigned char* ws = p.ws;
    const int lo = p.ph_lo, hi = p.ph_hi;
    volatile LAS unsigned* misc = (volatile LAS unsigned*)(lds + LDS_MISC);
    if (tid < 4) misc[tid] = 0u;
    __syncthreads();
    const XcdBarrier xbar = xcd_barrier_post((unsigned*)(ws + WS_CTL), misc);
#ifndef PH_MASK
#define PH_MASK 0x1ff
#endif
#define IN(k) (((PH_MASK >> (k)) & 1) && lo <= (k) && (k) < hi)
#define SEAM(k) do { if (IN(k) && IN((k) + 1)) xcd_barrier(xbar); } while (0)

#if (PROBE_DUP >> 0) & 1
    if (IN(0)) { phase0(p, lds, gw, NGW, wave, lane); xcd_barrier(xbar); }
#endif
    if (IN(0)) phase0(p, lds, gw, NGW, wave, lane);
    SEAM(0);
    if (IN(1)) {
        pg8::Gemm g{(const bf16_t*)(ws + WS_XB), (const bf16_t*)(ws + WS_WIN), S, NINP, DM, DM, DM};
        pg8::StaticOrder So; So.init(S, NINP, G, bx);
        pg8::Epi<1> E{(const float*)(ws + WS_RSTD1), 0.f, (float*)(ws + WS_ROWSS), (bf16_t*)(ws + WS_PROJ), NINP, nullptr, nullptr};
#if (PROBE_DUP >> 1) & 1
        { pg8::Epi<1> E2 = E; E2.ss = (float*)(ws + 512 * 1024); pg8::gemm_phase<pg8::Epi<1>, pg8::StaticOrder, true, true>(lds, g, So, E2); xcd_barrier(xbar); }
#endif
        pg8::gemm_phase<pg8::Epi<1>, pg8::StaticOrder, true, true>(lds, g, So, E);
    }
    SEAM(1);
    if (IN(2)) {
        {
            pg8::Gemm g{(const bf16_t*)(ws + WS_PROJ) + 2048, (const bf16_t*)(ws + WS_WUQ), S, 1536, 512, NINP, 512};
            pg8::StaticOrder So; So.init(S, 1536, G, bx);
            pg8::Epi<2> E{(const float*)(ws + WS_ROWSS) + 1 * S, 1.0f / 512.0f, nullptr, (bf16_t*)(ws + WS_QRAW), 1536, nullptr, nullptr};
            pg8::gemm_phase<pg8::Epi<2>, pg8::StaticOrder, true, true>(lds, g, So, E);
        }
        __syncthreads();
        {
            pg8::Gemm g{(const bf16_t*)(ws + WS_PROJ) + 2560, (const bf16_t*)(ws + WS_WUKV), S, 2048, 256, NINP, 256};
            pg8::StaticOrder So; So.init(S, 2048, G, bx);
            pg8::Epi<2> E{(const float*)(ws + WS_ROWSS) + 2 * S, 1.0f / 256.0f, nullptr, (bf16_t*)(ws + WS_KVRAW), 2048, nullptr, nullptr};
            pg8::gemm_phase<pg8::Epi<2>, pg8::StaticOrder, true, true>(lds, g, So, E);
        }
    }
    SEAM(2);
#if (PROBE_DUP >> 3) & 1
    if (IN(3)) { phase3(p, gw, NGW, lane); xcd_barrier(xbar); }
#endif
    if (IN(3)) phase3(p, gw, NGW, lane);
    SEAM(3);
#define P4_BODY_ATT for (int pr = bx; pr < 256; pr += G) { const int head = pr & 7, x = pr >> 3; attn_unit(p, lds, head, 63 - x, tid, wave, lane); attn_unit(p, lds, head, x, tid, wave, lane); }
#define P4_BODY_GMLP for (int u = bx; u < 512; u += G) gmlp_unit(p, lds, u >> 3, u & 7, tid, wave, lane);
#if (PROBE_DUP >> 4) & 1
    if (IN(4)) { P4_BODY_ATT; xcd_barrier(xbar); }
#endif
#if (PROBE_DUP >> 9) & 1
    if (IN(4)) { P4_BODY_GMLP; xcd_barrier(xbar); }
#endif
    if (IN(4)) { P4_BODY_ATT; P4_BODY_GMLP; }
    SEAM(4);
    if (IN(5)) {
        pg8::Gemm g{(const bf16_t*)(ws + WS_MIX), (const bf16_t*)(ws + WS_WOUT), S, DM, DM, DM, DM};
        pg8::StaticOrder So; So.init(S, DM, G, bx);
        pg8::Epi<4> E{nullptr, 0.f, (float*)(ws + WS_ROWSS) + 3 * S, (bf16_t*)(ws + WS_X1B), DM, p.out, p.in[0]};
#if (PROBE_DUP >> 5) & 1
        { pg8::Epi<4> E2 = E; E2.ss = (float*)(ws + 512 * 1024); pg8::gemm_phase<pg8::Epi<4>, pg8::StaticOrder, true, true>(lds, g, So, E2); xcd_barrier(xbar); }
#endif
        pg8::gemm_phase<pg8::Epi<4>, pg8::StaticOrder, true, true>(lds, g, So, E);
    }
    SEAM(5);
    if (IN(6)) {
        pg8::Gemm g{(const bf16_t*)(ws + WS_X1B), (const bf16_t*)(ws + WS_WS), S, DM, DM, DM, DM};
        pg8::StaticOrder So; So.init(S, DM, G, bx);
        pg8::Epi<5> E{(const float*)(ws + WS_ROWSS) + 3 * S, 1.0f / DM, nullptr, nullptr, DM, (float*)(ws + WS_SC), nullptr};
#if (PROBE_DUP >> 6) & 1
        { pg8::gemm_phase<pg8::Epi<5>, pg8::StaticOrder, true, true>(lds, g, So, E); xcd_barrier(xbar); }
#endif
        pg8::gemm_phase<pg8::Epi<5>, pg8::StaticOrder, true, true>(lds, g, So, E);
    }
    SEAM(6);
#if (PROBE_DUP >> 7) & 1
    if (IN(7)) { phase7(p, lds, gw, NGW, wave, lane); xcd_barrier(xbar); }
#endif
    if (IN(7)) phase7(p, lds, gw, NGW, wave, lane);
    SEAM(7);
#if (PROBE_DUP >> 8) & 1
    if (IN(8)) { phase8(p, lds, (float*)(ws + WS_SC), xbar.x, 8u * misc[0], gw, NGW, wave, lane); xcd_barrier(xbar); }
#endif
    if (IN(8)) phase8(p, lds, p.out, xbar.x, 8u * misc[0], gw, NGW, wave, lane);
#undef IN
#undef SEAM
}

extern "C" void kernel_launch(void* const* d_in, const int* in_sizes, int n_in, void* d_out, int out_size, void* d_ws, size_t ws_size, hipStream_t stream) {
    static int grid = 0;
    if (grid == 0) {
        if (n_in != 18 || out_size != S * DM || ws_size < WS_END) { fprintf(stderr, "kernel_launch: unexpected shapes (n_in %d out %d ws %zu)\n", n_in, out_size, ws_size); grid = -1; return; }
        int dev = 0, cus = 0, per_cu = 0;
        hipGetDevice(&dev);
        hipDeviceGetAttribute(&cus, hipDeviceAttributeMultiprocessorCount, dev);
        if (hipFuncSetAttribute((const void*)mega, hipFuncAttributeMaxDynamicSharedMemorySize, LDS_BYTES) != hipSuccess) { fprintf(stderr, "kernel_launch: hipFuncSetAttribute failed\n"); grid = -1; return; }
        if (hipOccupancyMaxActiveBlocksPerMultiprocessor(&per_cu, (const void*)mega, NTHREADS, LDS_BYTES) != hipSuccess || per_cu < 1) { fprintf(stderr, "kernel_launch: occupancy query failed (%d)\n", per_cu); grid = -1; return; }
        grid = cus;
        fprintf(stderr, "kernel_launch: cus %d per_cu %d grid %d\n", cus, per_cu, grid);
    }
    if (grid < 0) return;
    hipMemsetAsync((char*)d_ws + WS_CTL, 0, 1 * MiB, stream);
    Params prm{};
    for (int i = 0; i < 18; ++i) prm.in[i] = (const float*)d_in[i];
    prm.out = (float*)d_out; prm.ws = (unsigned char*)d_ws;
#if MK_ONE_LAUNCH
    prm.ph_lo = 0; prm.ph_hi = NPH;
    { void* args[] = {&prm}; hipError_t e = hipLaunchCooperativeKernel((const void*)mega, dim3(grid), dim3(NTHREADS), args, LDS_BYTES, stream);
      if (e != hipSuccess) fprintf(stderr, "cooperative launch failed: %s\n", hipGetErrorString(e)); }
#else
    for (int ph = 0; ph < NPH; ++ph) {
        prm.ph_lo = ph; prm.ph_hi = ph + 1;
        void* args[] = {&prm};
        hipError_t e = hipLaunchCooperativeKernel((const void*)mega, dim3(grid), dim3(NTHREADS), args, LDS_BYTES, stream);
        if (e != hipSuccess) { fprintf(stderr, "cooperative launch %d failed: %s\n", ph, hipGetErrorString(e)); break; }
    }
#endif
}
```

```cpp
#include <hip/hip_runtime.h>
#include <cstdio>
#include <cstdint>

#define LAS __attribute__((address_space(3)))
typedef unsigned short bf16_t;
typedef short bf16x8 __attribute__((ext_vector_type(8)));
typedef short s16x4 __attribute__((ext_vector_type(4)));
typedef float f32x4 __attribute__((ext_vector_type(4)));
typedef float f32x16 __attribute__((ext_vector_type(16)));
typedef unsigned u32x4 __attribute__((ext_vector_type(4)));
typedef unsigned u32x2 __attribute__((ext_vector_type(2)));

#ifndef PROBE_DUP
#define PROBE_DUP 0
#endif
#ifndef MK_ONE_LAUNCH
#define MK_ONE_LAUNCH 1
#endif

constexpr int S = 8192, DM = 2048, NIN = 2880, NINP = 3072;
constexpr int NPH = 9;
constexpr float EPS = 1e-6f;
constexpr int LDS_BYTES = 163840;
constexpr int NTHREADS = 512;
constexpr int LDS_MISC = 161792;

constexpr size_t MiB = 1u << 20;
constexpr size_t WS_CTL = 0;
constexpr size_t WS_ROWSS = 128 * 1024;
constexpr size_t WS_COS = 1 * MiB, WS_SIN = 2 * MiB;
constexpr size_t WS_RSTD1 = 3 * MiB;
constexpr size_t WS_EXP = 4 * MiB;
constexpr size_t WS_GATE = 8 * MiB;
constexpr size_t WS_WIN = 12 * MiB;
constexpr size_t WS_WUQ = 24 * MiB;
constexpr size_t WS_WUKV = 26 * MiB;
constexpr size_t WS_WOUT = 28 * MiB;
constexpr size_t WS_WS = 36 * MiB;
constexpr size_t WS_XB = 44 * MiB;
constexpr size_t WS_PROJ = 76 * MiB;
constexpr size_t WS_QRAW = 124 * MiB;
constexpr size_t WS_KVRAW = 148 * MiB;
constexpr size_t WS_QH = 180 * MiB;
constexpr size_t WS_KH = 204 * MiB;
constexpr size_t WS_VH = 228 * MiB;
constexpr size_t WS_MIX = 244 * MiB;
constexpr size_t WS_X1B = 276 * MiB;
constexpr size_t WS_SC = 308 * MiB;
constexpr size_t WS_UT = 372 * MiB;
constexpr size_t WS_VT = 436 * MiB;
constexpr size_t WS_END = 500 * MiB;

__device__ __forceinline__ unsigned f2bf(float f) { unsigned u = __builtin_bit_cast(unsigned, f); return (u + 0x7fffu + ((u >> 16) & 1u)) >> 16; }
__device__ __forceinline__ unsigned pk2(float lo, float hi) { return f2bf(lo) | (f2bf(hi) << 16); }
__device__ __forceinline__ float bf2f(unsigned short b) { return __builtin_bit_cast(float, (unsigned)b << 16); }
__device__ __forceinline__ float bflo(unsigned w) { return __builtin_bit_cast(float, w << 16); }
__device__ __forceinline__ float bfhi(unsigned w) { return __builtin_bit_cast(float, w & 0xffff0000u); }
__device__ __forceinline__ float wave_sum(float v) {
#pragma unroll
    for (int o = 32; o > 0; o >>= 1) v += __shfl_xor(v, o);
    return v;
}
__device__ __forceinline__ float wave_max(float v) {
#pragma unroll
    for (int o = 32; o > 0; o >>= 1) v = fmaxf(v, __shfl_xor(v, o));
    return v;
}
template <int CTRL, int ROW_MASK> __device__ __forceinline__ float dpp_f(float old, float v) {
    return __builtin_bit_cast(float, __builtin_amdgcn_update_dpp(__builtin_bit_cast(int, old), __builtin_bit_cast(int, v), CTRL, ROW_MASK, 0xf, false));
}
__device__ __forceinline__ float wave_max_u(float v) {
    v = fmaxf(v, dpp_f<0xB1, 0xf>(v, v));
    v = fmaxf(v, dpp_f<0x4E, 0xf>(v, v));
    v = fmaxf(v, dpp_f<0x141, 0xf>(v, v));
    v = fmaxf(v, dpp_f<0x140, 0xf>(v, v));
    v = fmaxf(v, dpp_f<0x142, 0xa>(v, v));
    v = fmaxf(v, dpp_f<0x143, 0xc>(v, v));
    return __builtin_bit_cast(float, __builtin_amdgcn_readlane(__builtin_bit_cast(int, v), 63));
}
__device__ __forceinline__ float wave_sum_u(float v) {
    v += dpp_f<0xB1, 0xf>(0.f, v);
    v += dpp_f<0x4E, 0xf>(0.f, v);
    v += dpp_f<0x141, 0xf>(0.f, v);
    v += dpp_f<0x140, 0xf>(0.f, v);
    v += dpp_f<0x142, 0xa>(0.f, v);
    v += dpp_f<0x143, 0xc>(0.f, v);
    return __builtin_bit_cast(float, __builtin_amdgcn_readlane(__builtin_bit_cast(int, v), 63));
}
__device__ __forceinline__ float gelu_tanh(float x) {
    const float y = 0.7978845608028654f * (x + 0.044715f * x * x * x);
    return x / (1.0f + __expf(-2.0f * y));
}
__device__ __forceinline__ int crow(int r, int hi) { return (r & 3) + 8 * (r >> 2) + 4 * hi; }
#define LDS_WAIT() asm volatile("s_waitcnt lgkmcnt(0)" ::: "memory")
#define SBAR() __builtin_amdgcn_sched_barrier(0)

namespace pg8 {
#define PG8_LAS __attribute__((address_space(3)))
constexpr int BM = 256, BK = 64, HALF = 128, HTB = HALF * BK * 2  , STAGE_BYTES = 8 * HTB, NXCD = 8, WGM = 8;

__host__ __device__ __forceinline__ int lds_byte(int r, int c) { const int st = (r >> 4) * 2 + (c >> 5), rr = r & 15, cc = c & 31, ob = rr * 64 + cc * 2; return st * 1024 + (ob ^ (((ob >> 9) & 1) << 5)); }
__host__ __device__ __forceinline__ void stage_rc(int b, int& R, int& C) { const int st = b / 1024, sb = b % 1024, swz = sb ^ (((sb >> 9) & 1) << 5); R = (st >> 1) * 16 + swz / 64; C = (st & 1) * 32 + (swz % 64) / 2; }
__host__ __device__ __forceinline__ int perm32(int rho) { const int n = rho >> 4, i = rho & 15; return 8 * (i >> 2) + 4 * n + (i & 3); }

struct Unit { int pm, pn; };
struct Gemm { const bf16_t* A; const bf16_t* Bt; int M, N, K, lda, ldb; };

struct StaticOrder {
    int nM, nN, nwg, G, c;
    __host__ __device__ void init(int M, int N, int G_, int c_) { nM = M / BM; nN = N / BM; nwg = nM * nN; G = G_; c = c_; }
    __host__ __device__ bool next(int i, Unit& u) const {
        const long L = (long)i * G + c; if (L >= nwg) return false;
        int wgid = (int)L; { const int q = nwg / NXCD, r = nwg % NXCD, xcd = wgid % NXCD, off = wgid / NXCD; wgid = (xcd < r ? xcd * (q + 1) : r * (q + 1) + (xcd - r) * q) + off; }
        const int nig = WGM * nN, gid = wgid / nig, fm = gid * WGM, gsz = (nM - fm) < WGM ? (nM - fm) : WGM;
        u.pm = fm + ((wgid % nig) % gsz); u.pn = (wgid % nig) / gsz; return true;
    }
    __device__ __forceinline__ void a_ready(const Unit&) const {}
    __device__ __forceinline__ void done(const Unit&) const {}
};

template <class Epi, class Sched, bool ALIGN_EPI = false, bool SP2 = false>
__device__ __forceinline__ void gemm_phase(PG8_LAS unsigned char* lds, const Gemm g, const Sched& S, const Epi& E) {
    const int tid = threadIdx.x, wid = __builtin_amdgcn_readfirstlane(tid >> 6), lane = tid & 63, wr = wid >> 2, wc = wid & 3, fr = lane & 15, fq = lane >> 4;
    const int K = g.K, nt = K / BK;
    unsigned voffA[2], voffB[2];
#pragma unroll
    for (int i = 0; i < 2; ++i) { int R, C; stage_rc(tid * 16 + i * 8192, R, C); const int Rb = Epi::PERM ? ((R & ~31) + perm32(R & 31)) : R;
        voffA[i] = (unsigned)(R * g.lda + C) * 2u; voffB[i] = (unsigned)(Rb * g.ldb + C) * 2u; }
    const size_t kstep = (size_t)(BK * 2);
    const size_t hstepA = (size_t)HALF * g.lda * 2, hstepB = (size_t)HALF * g.ldb * 2;
    const size_t tstepA = 2 * hstepA, tstepB = 2 * hstepB;
    const unsigned ldsw = (unsigned)wid * 1024u;
    const int aoff = lds_byte(wr * 64 + fr, fq * 8), boff = lds_byte(wc * 32 + fr, fq * 8);
#define PG8_SA(b, h) (((b) * 2 + (h)) * HTB)
#define PG8_SB(b, h) ((4 + (b) * 2 + (h)) * HTB)
#define PG8_STAGE(bufoff, gbase, voff) do { _Pragma("unroll") for (int _i = 0; _i < 2; ++_i) \
        __builtin_amdgcn_global_load_lds((const unsigned*)((const char*)(gbase) + (voff)[_i]), (PG8_LAS unsigned*)(lds + (bufoff) + ldsw + _i * 8192), 16, 0, 0); } while (0)
#define PG8_LDA(dst, b, h) do { _Pragma("unroll") for (int m = 0; m < 4; ++m) _Pragma("unroll") for (int k = 0; k < 2; ++k) dst[m][k] = *(const PG8_LAS bf16x8*)(lds + PG8_SA(b, h) + aoff + m * 2048 + k * 1024); } while (0)
#define PG8_LDB(dst, b, h) do { _Pragma("unroll") for (int n = 0; n < 2; ++n) _Pragma("unroll") for (int k = 0; k < 2; ++k) dst[n][k] = *(const PG8_LAS bf16x8*)(lds + PG8_SB(b, h) + boff + n * 2048 + k * 1024); } while (0)
#define PG8_MMA(ai, bj, At, Bt) do { __builtin_amdgcn_s_setprio(1); _Pragma("unroll") for (int m = 0; m < 4; ++m) _Pragma("unroll") for (int n = 0; n < 2; ++n) _Pragma("unroll") for (int k = 0; k < 2; ++k) \
        acc[ai][bj][m][n] = __builtin_amdgcn_mfma_f32_16x16x32_bf16(Bt[n][k], At[m][k], acc[ai][bj][m][n], 0, 0, 0); __builtin_amdgcn_s_setprio(0); } while (0)
#define PG8_WAIT_V(n) asm volatile("s_waitcnt vmcnt(" #n ")" ::: "memory")
#define PG8_WAIT_L(n) asm volatile("s_waitcnt lgkmcnt(" #n ")" ::: "memory")
#define PG8_BAR __builtin_amdgcn_s_barrier()
#define PG8_SCHED __builtin_amdgcn_sched_barrier(0)
    Unit cur, nxt; int ui = 0;
    if (!S.next(0, cur)) return;
    f32x4 acc[2][2][4][2];
#pragma unroll
    for (int a = 0; a < 2; ++a)
#pragma unroll
        for (int b = 0; b < 2; ++b)
#pragma unroll
            for (int m = 0; m < 4; ++m)
#pragma unroll
                for (int n = 0; n < 2; ++n) acc[a][b][m][n] = (f32x4){0.f, 0.f, 0.f, 0.f};
    bf16x8 At[4][2], B0[2][2], B1[2][2];
    const char* cA = (const char*)g.A + (size_t)cur.pm * tstepA; const char* cB = (const char*)g.Bt + (size_t)cur.pn * tstepB;
    S.a_ready(cur);
    if constexpr (SP2) {
        PG8_STAGE(PG8_SB(0, 0), cB, voffB); PG8_STAGE(PG8_SB(0, 1), cB + hstepB, voffB); PG8_STAGE(PG8_SA(0, 0), cA, voffA); PG8_STAGE(PG8_SA(0, 1), cA + hstepA, voffA);
        if (wr == 1) PG8_BAR;
        PG8_WAIT_V(2); PG8_BAR;
        PG8_STAGE(PG8_SB(1, 0), cB + kstep, voffB); PG8_STAGE(PG8_SA(1, 0), cA + kstep, voffA); PG8_STAGE(PG8_SB(1, 1), cB + hstepB + kstep, voffB);
        PG8_WAIT_V(6); PG8_BAR;
    } else {
        PG8_STAGE(PG8_SB(0, 0), cB, voffB); PG8_STAGE(PG8_SA(0, 0), cA, voffA); PG8_STAGE(PG8_SB(0, 1), cB + hstepB, voffB); PG8_STAGE(PG8_SA(0, 1), cA + hstepA, voffA);
        if (wr == 1) PG8_BAR;
        PG8_WAIT_V(4); PG8_BAR;
        PG8_STAGE(PG8_SB(1, 0), cB + kstep, voffB); PG8_STAGE(PG8_SA(1, 0), cA + kstep, voffA); PG8_STAGE(PG8_SB(1, 1), cB + hstepB + kstep, voffB);
        PG8_WAIT_V(6); PG8_BAR;
    }
    for (;;) {
        const bool has_next = S.next(ui + 1, nxt);
        const char* nA = has_next ? (const char*)g.A + (size_t)nxt.pm * tstepA : cA; const char* nB = has_next ? (const char*)g.Bt + (size_t)nxt.pn * tstepB : cB;
        for (int t = 0; t < nt; t += 2) {
            const bool last = (t == nt - 2);
            const char* a1 = cA + (size_t)(t + 1) * kstep;
            const char* a2 = last ? nA : cA + (size_t)(t + 2) * kstep; const char* b2 = last ? nB : cB + (size_t)(t + 2) * kstep;
            const char* a3 = a2 + kstep; const char* b3 = b2 + kstep;
            if (last && has_next) S.a_ready(nxt);
            if constexpr (SP2) {
            PG8_LDB(B0, 0, 0); PG8_LDB(B1, 0, 1); PG8_SCHED; PG8_LDA(At, 0, 0); PG8_STAGE(PG8_SA(1, 1), a1 + hstepA, voffA);
            PG8_WAIT_V(8); PG8_WAIT_L(0); PG8_BAR; PG8_MMA(0, 0, At, B0); PG8_MMA(0, 1, At, B1); PG8_BAR; PG8_SCHED;
            PG8_LDA(At, 0, 1); PG8_STAGE(PG8_SB(0, 0), b2, voffB); PG8_STAGE(PG8_SB(0, 1), b2 + hstepB, voffB); PG8_STAGE(PG8_SA(0, 0), a2, voffA);
            PG8_WAIT_V(8); PG8_WAIT_L(0); PG8_BAR; PG8_MMA(1, 0, At, B0); PG8_MMA(1, 1, At, B1); PG8_BAR; PG8_SCHED;
            PG8_LDB(B0, 1, 0); PG8_LDB(B1, 1, 1); PG8_SCHED; PG8_LDA(At, 1, 0); PG8_STAGE(PG8_SA(0, 1), a2 + hstepA, voffA);
            PG8_WAIT_V(8); PG8_WAIT_L(0); PG8_BAR; PG8_MMA(0, 0, At, B0); PG8_MMA(0, 1, At, B1); PG8_BAR; PG8_SCHED;
            PG8_LDA(At, 1, 1); PG8_STAGE(PG8_SB(1, 0), b3, voffB); PG8_STAGE(PG8_SB(1, 1), b3 + hstepB, voffB); PG8_STAGE(PG8_SA(1, 0), a3, voffA);
            PG8_WAIT_V(8); PG8_WAIT_L(0); PG8_BAR; PG8_MMA(1, 0, At, B0); PG8_MMA(1, 1, At, B1); PG8_BAR; PG8_SCHED;
            } else {
            PG8_LDB(B0, 0, 0); PG8_SCHED; PG8_LDA(At, 0, 0); PG8_STAGE(PG8_SA(1, 1), a1 + hstepA, voffA);
            PG8_WAIT_L(8); PG8_BAR; PG8_WAIT_L(0); PG8_MMA(0, 0, At, B0); PG8_BAR; PG8_SCHED;
            PG8_LDB(B1, 0, 1); PG8_STAGE(PG8_SB(0, 0), b2, voffB);
            PG8_BAR; PG8_WAIT_L(0); PG8_MMA(0, 1, At, B1); PG8_BAR;
            PG8_LDA(At, 0, 1); PG8_STAGE(PG8_SA(0, 0), a2, voffA);
            PG8_BAR; PG8_WAIT_L(0); PG8_MMA(1, 0, At, B0); PG8_BAR; PG8_SCHED;
            PG8_STAGE(PG8_SB(0, 1), b2 + hstepB, voffB);
            PG8_WAIT_V(6); PG8_BAR; PG8_MMA(1, 1, At, B1); PG8_BAR;
            PG8_LDB(B0, 1, 0); PG8_SCHED; PG8_LDA(At, 1, 0); PG8_STAGE(PG8_SA(0, 1), a2 + hstepA, voffA);
            PG8_WAIT_L(8); PG8_BAR; PG8_WAIT_L(0); PG8_MMA(0, 0, At, B0); PG8_BAR; PG8_SCHED;
            PG8_LDB(B1, 1, 1); PG8_STAGE(PG8_SB(1, 0), b3, voffB);
            PG8_BAR; PG8_WAIT_L(0); PG8_MMA(0, 1, At, B1); PG8_BAR;
            PG8_LDA(At, 1, 1); PG8_STAGE(PG8_SA(1, 0), a3, voffA);
            PG8_BAR; PG8_WAIT_L(0); PG8_MMA(1, 0, At, B0); PG8_BAR; PG8_SCHED;
            PG8_STAGE(PG8_SB(1, 1), b3 + hstepB, voffB);
            PG8_WAIT_V(6); PG8_BAR; PG8_MMA(1, 1, At, B1); PG8_BAR;
            }
        }
        if constexpr (ALIGN_EPI) { if (wr == 0) PG8_BAR; }
        if constexpr (!Epi::AFTER_DRAIN) { E(acc, cur, wr, wc, fr, fq); S.done(cur); }
        if (!has_next) break;
#pragma unroll
        for (int a = 0; a < 2; ++a)
#pragma unroll
            for (int b = 0; b < 2; ++b)
#pragma unroll
                for (int m = 0; m < 4; ++m)
#pragma unroll
                    for (int n = 0; n < 2; ++n) acc[a][b][m][n] = (f32x4){0.f, 0.f, 0.f, 0.f};
        cur = nxt; cA = nA; cB = nB; ++ui;
        if constexpr (ALIGN_EPI) { if (wr == 1) PG8_BAR; }
    }
    PG8_WAIT_V(0);
    if constexpr (!ALIGN_EPI) { if (wr == 0) PG8_BAR; }
    PG8_BAR;
#undef PG8_SA
#undef PG8_SB
#undef PG8_STAGE
#undef PG8_LDA
#undef PG8_LDB
#undef PG8_MMA
#undef PG8_WAIT_V
#undef PG8_WAIT_L
#undef PG8_BAR
#undef PG8_SCHED
}

template <int MODE> struct Epi {
    static constexpr bool PERM = false, AFTER_DRAIN = false;
    const float* rowsrc; float inv_n; float* ss; bf16_t* ob; int ldc; float* of; const float* xin;
    __device__ __forceinline__ void operator()(const f32x4 (&acc)[2][2][4][2], const Unit& u, int wr, int wc, int fr, int fq) const {
#pragma unroll
        for (int ai = 0; ai < 2; ++ai)
#pragma unroll
            for (int m = 0; m < 4; ++m) {
                const int row = u.pm * BM + ai * HALF + wr * 64 + m * 16 + fr;
                float rs = 1.f;
                if (MODE == 1) rs = rowsrc[row];
                if (MODE == 2 || MODE == 5) rs = rsqrtf(rowsrc[row] * inv_n + EPS);
                float ssq = 0.f;
#pragma unroll
                for (int bj = 0; bj < 2; ++bj)
#pragma unroll
                    for (int n = 0; n < 2; ++n) {
                        const int col = u.pn * BM + bj * HALF + wc * 32 + n * 16 + fq * 4;
                        f32x4 v = acc[ai][bj][m][n] * rs;
                        if (MODE == 1) { if (u.pn < 8) { v[0] = gelu_tanh(v[0]); v[1] = gelu_tanh(v[1]); v[2] = gelu_tanh(v[2]); v[3] = gelu_tanh(v[3]); } }
                        if (MODE == 4) { const f32x4 xr = *(const f32x4*)(xin + (size_t)row * DM + col); v = v + xr; }
                        if (MODE == 1 || MODE == 4) ssq += (v[0] * v[0] + v[1] * v[1]) + (v[2] * v[2] + v[3] * v[3]);
                        if (MODE == 1 || MODE == 2 || MODE == 4) { u32x2 w; w.x = pk2(v[0], v[1]); w.y = pk2(v[2], v[3]); *(u32x2*)(ob + (size_t)row * ldc + col) = w; }
                        if (MODE == 4 || MODE == 5) *(f32x4*)(of + (size_t)row * DM + col) = v;
                    }
                if (MODE == 1) {
                    const int seg = (u.pn >= 4 && u.pn < 8) ? 0 : ((u.pn == 8 || u.pn == 9) ? 1 : (u.pn == 10 ? 2 : -1));
                    if (seg >= 0) { ssq += __shfl_xor(ssq, 16); ssq += __shfl_xor(ssq, 32); if (fq == 0) atomicAdd(ss + seg * S + row, ssq); }
                }
                if (MODE == 4) { ssq += __shfl_xor(ssq, 16); ssq += __shfl_xor(ssq, 32); if (fq == 0) atomicAdd(ss + row, ssq); }
            }
    }
};
}

#define XB_TMO      128
#define XB_XCNT(j)  (256  + 64 * (j))
#define XB_XSUB(j)  (1280 + 64 * (j))
#define XB_XGEN(j)  (2304 + 64 * (j))
#define XB_TOP      3328
#define XB_TOPGEN   3392
#define XCD_BAR_WORDS 3456
#define XB_SPIN_CAP (1u << 18)
__device__ __forceinline__ unsigned xb_ld(unsigned* p)              { return __hip_atomic_load(p, __ATOMIC_RELAXED, __HIP_MEMORY_SCOPE_AGENT); }
__device__ __forceinline__ unsigned xb_add(unsigned* p, unsigned v) { return __hip_atomic_fetch_add(p, v, __ATOMIC_RELAXED, __HIP_MEMORY_SCOPE_AGENT); }
__device__ __forceinline__ unsigned xb_xcc_id() { return (unsigned)__builtin_amdgcn_s_getreg((3 << 11) | 20) & 0xFu; }
#define XB_SPIN(cond, bar) do { unsigned _sp = 0; while (cond) { __builtin_amdgcn_s_sleep(1); \
    if ((++_sp & 255u) == 0u) { if (xb_ld(&(bar)[XB_TMO])) break; if (_sp > XB_SPIN_CAP) { atomicAdd(&(bar)[XB_TMO], 1u); break; } } } } while (0)
struct XcdBarrier { unsigned* bar; unsigned x; volatile LAS unsigned* st; };
__device__ __forceinline__ XcdBarrier xcd_barrier_post(unsigned* bar, volatile LAS unsigned* st) {
    XcdBarrier b; b.bar = bar; b.x = xb_xcc_id(); b.st = st;
    if (threadIdx.x == 0) (void)xb_add(&bar[XB_XCNT(b.x)], 1u);
    return b;
}
__device__ __forceinline__ void xcd_barrier_complete(unsigned* bar, unsigned x, unsigned& nloc, unsigned& nx) {
    const unsigned G = gridDim.x * gridDim.y * gridDim.z;
    unsigned sum, cnt, mine, sp = 0u;
    for (;;) {
        sum = 0u; cnt = 0u; mine = 0u;
#pragma unroll
        for (unsigned j = 0; j < 16; ++j) { const unsigned c = xb_ld(&bar[XB_XCNT(j)]); sum += c; cnt += (c > 0u) ? 1u : 0u; mine = (j == x) ? c : mine; }
        if (sum == G) break;
        __builtin_amdgcn_s_sleep(1);
        if ((++sp & 255u) == 0u) { if (xb_ld(&bar[XB_TMO])) break; if (sp > XB_SPIN_CAP) { atomicAdd(&bar[XB_TMO], 1u); break; } }
    }
    nloc = mine > 0u ? mine : 1u; nx = cnt > 0u ? cnt : 1u;
}
__device__ __forceinline__ void xcd_barrier(const XcdBarrier& b) {
    asm volatile("s_waitcnt vmcnt(0)" ::: "memory");
    __syncthreads();
    if (threadIdx.x == 0) {
        unsigned* bar = b.bar;
        __builtin_amdgcn_s_waitcnt(0);
        unsigned nloc = b.st[0], nx = b.st[1];
        if (nloc == 0u) { xcd_barrier_complete(bar, b.x, nloc, nx); b.st[0] = nloc; b.st[1] = nx; }
        const unsigned old = xb_add(&bar[XB_XSUB(b.x)], 1u);
        const unsigned gen = old / nloc;
        if (old + 1u == (gen + 1u) * nloc) {
            __builtin_amdgcn_fence(__ATOMIC_RELEASE, "agent");
            asm volatile("s_waitcnt vmcnt(0)" ::: "memory");
            const unsigned og = xb_add(&bar[XB_TOP], 1u);
            const unsigned tg = og / nx;
            if (og + 1u == (tg + 1u) * nx) xb_add(&bar[XB_TOPGEN], 1u);
            else XB_SPIN(xb_ld(&bar[XB_TOPGEN]) == tg, bar);
            __builtin_amdgcn_fence(__ATOMIC_ACQUIRE, "agent");
            xb_add(&bar[XB_XGEN(b.x)], 1u);
            asm volatile("s_waitcnt vmcnt(0)" ::: "memory");
        } else {
            XB_SPIN(xb_ld(&bar[XB_XGEN(b.x)]) == gen, bar);
            __builtin_amdgcn_fence(__ATOMIC_ACQUIRE, "agent");
            asm volatile("s_waitcnt vmcnt(0)" ::: "memory");
        }
    }
    __syncthreads();
}

struct Params {
    const float* in[18];
    float* out;
    unsigned char* ws;
    int ph_lo, ph_hi;
};

__device__ __forceinline__ void p0_transpose_item(const float* W, const float* g, int K, int N, bf16_t* WT, LAS float* scr, int item, int lane) {
    const int nblk = N / 32, kb = item / nblk, nb = item % nblk, k0 = 64 * kb, n0 = 32 * nb;
    float wv[32];
#pragma unroll
    for (int i = 0; i < 32; ++i) { const int kk = 2 * i + (lane >> 5); wv[i] = W[(size_t)(k0 + kk) * N + n0 + (lane & 31)]; }
#pragma unroll
    for (int i = 0; i < 32; ++i) { const int kk = 2 * i + (lane >> 5); const float gv = g ? g[k0 + kk] : 1.f; scr[kk * 33 + (lane & 31)] = wv[i] * gv; }
    LDS_WAIT(); asm volatile("" ::: "memory");
    const int c = lane & 7;
#pragma unroll
    for (int j = 0; j < 4; ++j) { const int n = (lane >> 3) + 8 * j; const LAS float* s = scr + (8 * c) * 33 + n;
        u32x4 o; o.x = pk2(s[0 * 33], s[1 * 33]); o.y = pk2(s[2 * 33], s[3 * 33]); o.z = pk2(s[4 * 33], s[5 * 33]); o.w = pk2(s[6 * 33], s[7 * 33]);
        *(u32x4*)(WT + (size_t)(n0 + n) * K + k0 + 8 * c) = o; }
    LDS_WAIT(); asm volatile("" ::: "memory");
}
__device__ __forceinline__ float row_to_bf16(const float* src, const float* g, bf16_t* dst, int lane) {
    float ss = 0.f;
#pragma unroll
    for (int i = 0; i < 8; ++i) {
        const int c = (i * 64 + lane) * 4;
        f32x4 v = *(const f32x4*)(src + c);
        ss += (v[0] * v[0] + v[1] * v[1]) + (v[2] * v[2] + v[3] * v[3]);
        if (g) { const f32x4 gv = *(const f32x4*)(g + c); v = v * gv; }
        u32x2 w; w.x = pk2(v[0], v[1]); w.y = pk2(v[2], v[3]);
        *(u32x2*)(dst + c) = w;
    }
    return ss;
}
constexpr float PEER_USC = 80.0f, PEER_VSC = 5.0f;
constexpr int PEER_ROWB = 1536;
typedef float f32x16v __attribute__((ext_vector_type(16)));
typedef float f32x32v __attribute__((ext_vector_type(32)));
typedef unsigned u32x6 __attribute__((ext_vector_type(6)));
__device__ __forceinline__ void fp6_pack_store(const f32x4 (&x)[8], const f32x4 (&sc)[8], unsigned char* dst, int lane) {
    f32x16v a, b;
#pragma unroll
    for (int i = 0; i < 8; ++i) {
        const f32x4 y = x[i] * sc[i];
#pragma unroll
        for (int q = 0; q < 4; ++q) { const float c = fminf(fmaxf(y[q], -7.5f), 7.5f); const int sl = 4 * i + q; if ((sl & 1) == 0) a[sl >> 1] = c; else b[sl >> 1] = c; }
    }
    const u32x6 pk = __builtin_amdgcn_cvt_scalef32_2xpk16_fp6_f32(a, b, 1.0f);
    *(u32x4*)(dst + lane * 16) = (u32x4){pk[0], pk[1], pk[2], pk[3]};
    *(u32x2*)(dst + 1024 + lane * 8) = (u32x2){pk[4], pk[5]};
}
__device__ __forceinline__ void rows2_to_fp6(const float* s0, const float* s1, const f32x4 (&sc)[8], unsigned char* d0, unsigned char* d1, int lane) {
    f32x4 x0[8], x1[8];
#pragma unroll
    for (int i = 0; i < 8; ++i) { x0[i] = *(const f32x4*)(s0 + (i * 64 + lane) * 4); x1[i] = *(const f32x4*)(s1 + (i * 64 + lane) * 4); }
    fp6_pack_store(x0, sc, d0, lane); fp6_pack_store(x1, sc, d1, lane);
}
__device__ __forceinline__ bf16x8 cvt8(const float* p) {
    const f32x4 a = *(const f32x4*)p, b = *(const f32x4*)(p + 4);
    u32x4 w; w.x = pk2(a[0], a[1]); w.y = pk2(a[2], a[3]); w.z = pk2(b[0], b[1]); w.w = pk2(b[2], b[3]);
    return __builtin_bit_cast(bf16x8, w);
}

__device__ __forceinline__ void phase0(const Params& p, LAS unsigned char* lds, int gw, int NGW, int wave, int lane) {
    unsigned char* ws = p.ws;
    LAS float* scr = (LAS float*)(lds + wave * 16384);
    const float* x = p.in[0];
    {
        constexpr int I_IN = (DM / 64) * (NIN / 32), I_UQ = (512 / 64) * (1536 / 32), I_UKV = (256 / 64) * (2048 / 32), I_OUT = (DM / 64) * (DM / 32);
        constexpr int NIT = I_IN + I_UQ + I_UKV + I_OUT;
        for (int it = gw; it < NIT; it += NGW) {
            int r = it;
            if (r < I_IN) { p0_transpose_item(p.in[2], p.in[1], DM, NIN, (bf16_t*)(ws + WS_WIN), scr, r, lane); continue; } r -= I_IN;
            if (r < I_UQ) { p0_transpose_item(p.in[7], p.in[6], 512, 1536, (bf16_t*)(ws + WS_WUQ), scr, r, lane); continue; } r -= I_UQ;
            if (r < I_UKV) { p0_transpose_item(p.in[9], p.in[8], 256, 2048, (bf16_t*)(ws + WS_WUKV), scr, r, lane); continue; } r -= I_UKV;
            p0_transpose_item(p.in[12], nullptr, DM, DM, (bf16_t*)(ws + WS_WOUT), scr, r, lane);
        }
    }
    for (int r = gw; r < NINP - NIN; r += NGW) {
        bf16_t* d = (bf16_t*)(ws + WS_WIN) + (size_t)(NIN + r) * DM;
#pragma unroll
        for (int i = 0; i < 4; ++i) *(u32x4*)(d + (i * 64 + lane) * 8) = (u32x4){0u, 0u, 0u, 0u};
    }
    {
        const float* wq = p.in[14]; const float* sk = p.in[15]; const float* g2 = p.in[13];
        bf16_t* WsT = (bf16_t*)(ws + WS_WS);
        const int r32 = lane & 31, hh = lane >> 5;
        for (int it = gw; it < 16 * 4 * 64; it += NGW) {
            const int hp = it >> 8, kb = (it >> 6) & 3, nb = it & 63;
            f32x16 acc = {};
            const float* ap = sk + ((size_t)(hp * 128 + kb * 32 + r32)) * 128 + hh * 8;
            const float* bp = wq + ((size_t)(nb * 32 + r32)) * DM + hp * 128 + hh * 8;
#pragma unroll
            for (int s = 0; s < 8; ++s) {
                const bf16x8 a = cvt8(ap + s * 16), b = cvt8(bp + s * 16);
                acc = __builtin_amdgcn_mfma_f32_32x32x16_bf16(a, b, acc, 0, 0, 0);
            }
            const int kcol = nb * 32 + r32; const float gk = g2[kcol];
#pragma unroll
            for (int r = 0; r < 16; ++r) WsT[(size_t)(hp * 128 + kb * 32 + crow(r, hh)) * DM + kcol] = (bf16_t)f2bf(acc[r] * gk);
        }
    }
    {
        bf16_t* xb = (bf16_t*)(ws + WS_XB); float* rstd1 = (float*)(ws + WS_RSTD1);
        for (int t = gw; t + NGW < S; t += 2 * NGW) {
            const int t1 = t + NGW;
            f32x4 a[8], b[8];
#pragma unroll
            for (int i = 0; i < 8; ++i) { a[i] = *(const f32x4*)(x + (size_t)t * DM + (i * 64 + lane) * 4); b[i] = *(const f32x4*)(x + (size_t)t1 * DM + (i * 64 + lane) * 4); }
            float sa = 0.f, sb = 0.f;
#pragma unroll
            for (int i = 0; i < 8; ++i) {
                sa += (a[i][0] * a[i][0] + a[i][1] * a[i][1]) + (a[i][2] * a[i][2] + a[i][3] * a[i][3]);
                sb += (b[i][0] * b[i][0] + b[i][1] * b[i][1]) + (b[i][2] * b[i][2] + b[i][3] * b[i][3]);
                u32x2 wa, wb; wa.x = pk2(a[i][0], a[i][1]); wa.y = pk2(a[i][2], a[i][3]); wb.x = pk2(b[i][0], b[i][1]); wb.y = pk2(b[i][2], b[i][3]);
                *(u32x2*)(xb + (size_t)t * DM + (i * 64 + lane) * 4) = wa; *(u32x2*)(xb + (size_t)t1 * DM + (i * 64 + lane) * 4) = wb;
            }
            sa = wave_sum(sa); sb = wave_sum(sb);
            if (lane == 0) { rstd1[t] = rsqrtf(sa * (1.0f / DM) + EPS); rstd1[t1] = rsqrtf(sb * (1.0f / DM) + EPS); }
        }
    }
    {
        unsigned char* UT = ws + WS_UT; unsigned char* VT = ws + WS_VT;
        f32x4 sc[8];
#pragma unroll
        for (int i = 0; i < 8; ++i) sc[i] = *(const f32x4*)(p.in[13] + (i * 64 + lane) * 4) * PEER_USC;
        for (int e = gw; e + NGW < 16384; e += 2 * NGW)
            rows2_to_fp6(p.in[16] + (size_t)e * DM, p.in[16] + (size_t)(e + NGW) * DM, sc, UT + (size_t)e * PEER_ROWB, UT + (size_t)(e + NGW) * PEER_ROWB, lane);
#pragma unroll
        for (int i = 0; i < 8; ++i) sc[i] = (f32x4){PEER_VSC, PEER_VSC, PEER_VSC, PEER_VSC};
        for (int e = gw; e + NGW < 16384; e += 2 * NGW)
            rows2_to_fp6(p.in[17] + (size_t)e * DM, p.in[17] + (size_t)(e + NGW) * DM, sc, VT + (size_t)e * PEER_ROWB, VT + (size_t)(e + NGW) * PEER_ROWB, lane);
    }
    {
        float* ct = (float*)(ws + WS_COS); float* st = (float*)(ws + WS_SIN);
        for (int it = gw; it < S * 32 / 64; it += NGW) {
            const int idx = it * 64 + lane, t = idx >> 5, j = idx & 31;
            const float inv_freq = powf(10000.0f, -(float)j / 32.0f);
            const float ang = (float)t * inv_freq;
            float sv, cv; sincosf(ang, &sv, &cv); ct[idx] = cv; st[idx] = sv;
        }
    }
}

__device__ __forceinline__ void phase3(const Params& p, int gw, int NGW, int lane) {
    unsigned char* ws = p.ws;
    const bf16_t* qraw = (const bf16_t*)(ws + WS_QRAW); const bf16_t* kvraw = (const bf16_t*)(ws + WS_KVRAW); const bf16_t* proj = (const bf16_t*)(ws + WS_PROJ);
    bf16_t* Qh = (bf16_t*)(ws + WS_QH); bf16_t* Kh = (bf16_t*)(ws + WS_KH); bf16_t* Vh = (bf16_t*)(ws + WS_VH);
    const float* ct = (const float*)(ws + WS_COS); const float* st = (const float*)(ws + WS_SIN);
    const bool act = lane < 48, isrope = lane >= 32 && lane < 48, lowhalf = lane < 40;
    const int e0 = act ? 4 * lane : 0;
    const f32x4 gq = *(const f32x4*)(p.in[10] + e0), gk = *(const f32x4*)(p.in[11] + e0);
    const int j0 = isrope ? ((4 * lane - 128) & 31) : 0;
    constexpr float QS = 0.07216878364870322f * 1.4426950408889634f;
    for (int t = gw; t < S; t += NGW) {
        f32x4 cs = {1.f, 1.f, 1.f, 1.f}, sn = {0.f, 0.f, 0.f, 0.f};
        if (isrope) { cs = *(const f32x4*)(ct + t * 32 + j0); sn = *(const f32x4*)(st + t * 32 + j0); }
        u32x2 krw = {0u, 0u};
        if (isrope) krw = *(const u32x2*)(proj + (size_t)t * NINP + 2816 + (4 * lane - 128));
        const f32x4 krope = {bflo(krw.x), bfhi(krw.x), bflo(krw.y), bfhi(krw.y)};
#pragma unroll
        for (int h = 0; h < 8; ++h) {
            u32x2 qw = {0u, 0u};
            if (act) qw = *(const u32x2*)(qraw + (size_t)t * 1536 + h * 192 + e0);
            f32x4 q = {bflo(qw.x), bfhi(qw.x), bflo(qw.y), bfhi(qw.y)};
            float ss = wave_sum_u((q[0] * q[0] + q[1] * q[1]) + (q[2] * q[2] + q[3] * q[3]));
            float rs = rsqrtf(ss * (1.0f / 192.0f) + EPS);
            q = q * gq * rs;
            {
                f32x4 pr;
#pragma unroll
                for (int c = 0; c < 4; ++c) pr[c] = __shfl_xor(q[c], 8);
                const f32x4 r1 = q * cs - pr * sn, r2 = pr * sn + q * cs;
                if (isrope) q = lowhalf ? r1 : r2;
            }
            q = q * QS;
            if (act) { u32x2 w; w.x = pk2(q[0], q[1]); w.y = pk2(q[2], q[3]); *(u32x2*)(Qh + ((size_t)h * S + t) * 192 + e0) = w; }
            u32x2 kw = {0u, 0u}, vw = {0u, 0u};
            if (lane < 32) { kw = *(const u32x2*)(kvraw + (size_t)t * 2048 + h * 256 + e0); vw = *(const u32x2*)(kvraw + (size_t)t * 2048 + h * 256 + 128 + e0); }
            f32x4 k = {bflo(kw.x), bfhi(kw.x), bflo(kw.y), bfhi(kw.y)};
            if (isrope) k = krope;
            ss = wave_sum_u((k[0] * k[0] + k[1] * k[1]) + (k[2] * k[2] + k[3] * k[3]));
            rs = rsqrtf(ss * (1.0f / 192.0f) + EPS);
            k = k * gk * rs;
            {
                f32x4 pr;
#pragma unroll
                for (int c = 0; c < 4; ++c) pr[c] = __shfl_xor(k[c], 8);
                const f32x4 r1 = k * cs - pr * sn, r2 = pr * sn + k * cs;
                if (isrope) k = lowhalf ? r1 : r2;
            }
            if (act) { u32x2 w; w.x = pk2(k[0], k[1]); w.y = pk2(k[2], k[3]); *(u32x2*)(Kh + ((size_t)h * S + t) * 192 + e0) = w; }
            if (lane < 32) *(u32x2*)(Vh + ((size_t)h * S + t) * 128 + e0) = vw;
        }
    }
}

constexpr int KP = 400, VP = 320;
template <int OFF> __device__ __forceinline__ s16x4 tr_read(unsigned addr) {
    s16x4 r; asm volatile("ds_read_b64_tr_b16 %0, %1 offset:%2" : "=&v"(r) : "v"(addr), "i"(OFF) : "memory"); return r;
}
__device__ __forceinline__ unsigned cvtpk(float lo, float hi) { unsigned r; asm volatile("v_cvt_pk_bf16_f32 %0, %1, %2" : "=v"(r) : "v"(lo), "v"(hi)); return r; }
#define PK8(L, H) ((bf16x8){L[0], L[1], L[2], L[3], H[0], H[1], H[2], H[3]})
constexpr float ATT_THR = 8.0f;

constexpr int ATT_KB = 64 * KP, ATT_VB = 64 * VP;
constexpr int ATT_VOFF = 2 * ATT_KB;
__device__ __forceinline__ float xhalf_max(float v) {
    auto rr = __builtin_amdgcn_permlane32_swap(__builtin_bit_cast(unsigned, v), __builtin_bit_cast(unsigned, v), false, false);
    return fmaxf(__builtin_bit_cast(float, rr[0]), __builtin_bit_cast(float, rr[1]));
}
__device__ __forceinline__ float xhalf_sum(float v) {
    auto rr = __builtin_amdgcn_permlane32_swap(__builtin_bit_cast(unsigned, v), __builtin_bit_cast(unsigned, v), false, false);
    return __builtin_bit_cast(float, rr[0]) + __builtin_bit_cast(float, rr[1]);
}
template <int OFF> __device__ __forceinline__ bf16x8 lds_read128(unsigned addr) {
    bf16x8 r; asm volatile("ds_read_b128 %0, %1 offset:%2" : "=&v"(r) : "v"(addr), "i"(OFF) : "memory"); return r;
}
#define LGKM_WAIT(n) do { asm volatile("s_waitcnt lgkmcnt(" #n ")" ::: "memory"); SBAR(); } while (0)
__device__ __forceinline__ f32x16 att_qk(unsigned kaddr, const bf16x8 (&qr)[12]) {
    f32x16 p = {};
    bf16x8 a0 = lds_read128<0>(kaddr), a1 = lds_read128<32>(kaddr), a2 = lds_read128<64>(kaddr), a3 = lds_read128<96>(kaddr);
    LGKM_WAIT(3); p = __builtin_amdgcn_mfma_f32_32x32x16_bf16(a0, qr[0], p, 0, 0, 0); a0 = lds_read128<128>(kaddr);
    LGKM_WAIT(3); p = __builtin_amdgcn_mfma_f32_32x32x16_bf16(a1, qr[1], p, 0, 0, 0); a1 = lds_read128<160>(kaddr);
    LGKM_WAIT(3); p = __builtin_amdgcn_mfma_f32_32x32x16_bf16(a2, qr[2], p, 0, 0, 0); a2 = lds_read128<192>(kaddr);
    LGKM_WAIT(3); p = __builtin_amdgcn_mfma_f32_32x32x16_bf16(a3, qr[3], p, 0, 0, 0); a3 = lds_read128<224>(kaddr);
    LGKM_WAIT(3); p = __builtin_amdgcn_mfma_f32_32x32x16_bf16(a0, qr[4], p, 0, 0, 0); a0 = lds_read128<256>(kaddr);
    LGKM_WAIT(3); p = __builtin_amdgcn_mfma_f32_32x32x16_bf16(a1, qr[5], p, 0, 0, 0); a1 = lds_read128<288>(kaddr);
    LGKM_WAIT(3); p = __builtin_amdgcn_mfma_f32_32x32x16_bf16(a2, qr[6], p, 0, 0, 0); a2 = lds_read128<320>(kaddr);
    LGKM_WAIT(3); p = __builtin_amdgcn_mfma_f32_32x32x16_bf16(a3, qr[7], p, 0, 0, 0); a3 = lds_read128<352>(kaddr);
    LGKM_WAIT(3); p = __builtin_amdgcn_mfma_f32_32x32x16_bf16(a0, qr[8], p, 0, 0, 0);
    LGKM_WAIT(2); p = __builtin_amdgcn_mfma_f32_32x32x16_bf16(a1, qr[9], p, 0, 0, 0);
    LGKM_WAIT(1); p = __builtin_amdgcn_mfma_f32_32x32x16_bf16(a2, qr[10], p, 0, 0, 0);
    LGKM_WAIT(0); p = __builtin_amdgcn_mfma_f32_32x32x16_bf16(a3, qr[11], p, 0, 0, 0);
    return p;
}
__device__ __forceinline__ void att_finish(f32x16& s, float m, float& lsum, bf16x8& pb0, bf16x8& pb1) {
    float ps = 0.f;
#pragma unroll
    for (int r = 0; r < 16; ++r) { s[r] = __builtin_amdgcn_exp2f(s[r] - m); ps += s[r]; }
    lsum += xhalf_sum(ps);
    u32x4 w0 = {cvtpk(s[0], s[1]), cvtpk(s[2], s[3]), cvtpk(s[4], s[5]), cvtpk(s[6], s[7])};
    u32x4 w1 = {cvtpk(s[8], s[9]), cvtpk(s[10], s[11]), cvtpk(s[12], s[13]), cvtpk(s[14], s[15])};
    pb0 = __builtin_bit_cast(bf16x8, w0); pb1 = __builtin_bit_cast(bf16x8, w1);
}
__device__ __forceinline__ void att_pv(unsigned vaddr, bf16x8 pb0, bf16x8 pb1, f32x16 (&o)[4]) {
#define VOFF(d0, s, hi) (((16 * (s) + 8 * (hi)) * VP) + 64 * (d0))
    const s16x4 a00l = tr_read<VOFF(0, 0, 0)>(vaddr), a00h = tr_read<VOFF(0, 0, 1)>(vaddr), a01l = tr_read<VOFF(0, 1, 0)>(vaddr), a01h = tr_read<VOFF(0, 1, 1)>(vaddr);
    const s16x4 a10l = tr_read<VOFF(1, 0, 0)>(vaddr), a10h = tr_read<VOFF(1, 0, 1)>(vaddr), a11l = tr_read<VOFF(1, 1, 0)>(vaddr), a11h = tr_read<VOFF(1, 1, 1)>(vaddr);
    LGKM_WAIT(4);
    o[0] = __builtin_amdgcn_mfma_f32_32x32x16_bf16(PK8(a00l, a00h), pb0, o[0], 0, 0, 0); o[0] = __builtin_amdgcn_mfma_f32_32x32x16_bf16(PK8(a01l, a01h), pb1, o[0], 0, 0, 0);
    const s16x4 a20l = tr_read<VOFF(2, 0, 0)>(vaddr), a20h = tr_read<VOFF(2, 0, 1)>(vaddr), a21l = tr_read<VOFF(2, 1, 0)>(vaddr), a21h = tr_read<VOFF(2, 1, 1)>(vaddr);
    LGKM_WAIT(4);
    o[1] = __builtin_amdgcn_mfma_f32_32x32x16_bf16(PK8(a10l, a10h), pb0, o[1], 0, 0, 0); o[1] = __builtin_amdgcn_mfma_f32_32x32x16_bf16(PK8(a11l, a11h), pb1, o[1], 0, 0, 0);
    const s16x4 a30l = tr_read<VOFF(3, 0, 0)>(vaddr), a30h = tr_read<VOFF(3, 0, 1)>(vaddr), a31l = tr_read<VOFF(3, 1, 0)>(vaddr), a31h = tr_read<VOFF(3, 1, 1)>(vaddr);
    LGKM_WAIT(4);
    o[2] = __builtin_amdgcn_mfma_f32_32x32x16_bf16(PK8(a20l, a20h), pb0, o[2], 0, 0, 0); o[2] = __builtin_amdgcn_mfma_f32_32x32x16_bf16(PK8(a21l, a21h), pb1, o[2], 0, 0, 0);
    LGKM_WAIT(0);
    o[3] = __builtin_amdgcn_mfma_f32_32x32x16_bf16(PK8(a30l, a30h), pb0, o[3], 0, 0, 0); o[3] = __builtin_amdgcn_mfma_f32_32x32x16_bf16(PK8(a31l, a31h), pb1, o[3], 0, 0, 0);
#undef VOFF
}
__device__ __forceinline__ void att_partial(const f32x16& s, float& m, float& lsum, f32x16 (&o)[4]) {
    float pmax = s[0];
#pragma unroll
    for (int r = 1; r < 16; ++r) pmax = fmaxf(pmax, s[r]);
    pmax = xhalf_max(pmax);
    if (!__all(pmax - m <= ATT_THR)) {
        const float mn = fmaxf(m, pmax); const float alpha = __builtin_amdgcn_exp2f(m - mn); m = mn; lsum *= alpha;
#pragma unroll
        for (int d = 0; d < 4; ++d)
#pragma unroll
            for (int r = 0; r < 16; ++r) o[d][r] *= alpha;
    }
}

__device__ __forceinline__ void attn_unit(const Params& p, LAS unsigned char* lds, int head, int qb, int tid, int wave, int lane) {
    unsigned char* ws = p.ws;
    const bf16_t* Qh = (const bf16_t*)(ws + WS_QH); const bf16_t* Kh = (const bf16_t*)(ws + WS_KH); const bf16_t* Vh = (const bf16_t*)(ws + WS_VH);
    bf16_t* mix = (bf16_t*)(ws + WS_MIX);
    const int rg = wave & 3, kh = wave >> 2, r32 = lane & 31, hh = lane >> 5;
    const int q0row = qb * 128 + rg * 32;
    bf16x8 qr[12];
    {
        const bf16_t* qp = Qh + ((size_t)head * S + q0row + r32) * 192 + hh * 8;
#pragma unroll
        for (int ks = 0; ks < 12; ++ks) qr[ks] = *(const bf16x8*)(qp + ks * 16);
    }
    const int ntiles = 2 * qb + 2, mylast = 2 * qb + (rg >> 1);
    float m = -1e30f, lsum = 0.f; f32x16 o[4] = {};
    const int srow = tid >> 3, sch = tid & 7;
    const int kg0 = srow * 192 + sch * 8, kl0 = srow * KP + sch * 16, vg0 = srow * 128 + sch * 8, vl0 = ATT_VOFF + srow * VP + sch * 16;
    const bf16_t* kbase = Kh + (size_t)head * S * 192; const bf16_t* vbase = Vh + (size_t)head * S * 128;
    u32x4 sk0, sk1, sk2, sv0, sv1;
#define ATT_LOAD(t) do { const bf16_t* kt = kbase + (size_t)(t) * 64 * 192 + kg0; const bf16_t* vt = vbase + (size_t)(t) * 64 * 128 + vg0; \
        sk0 = *(const u32x4*)(kt); sk1 = *(const u32x4*)(kt + 64); sk2 = *(const u32x4*)(kt + 128); sv0 = *(const u32x4*)(vt); sv1 = *(const u32x4*)(vt + 64); } while (0)
#define ATT_WRITE(kb_, vb_) do { LAS unsigned char* bk = lds + (kb_) * ATT_KB + kl0; LAS unsigned char* bv = lds + (vb_) * ATT_VB + vl0; *(LAS u32x4*)(bk) = sk0; *(LAS u32x4*)(bk + 128) = sk1; *(LAS u32x4*)(bk + 256) = sk2; \
        *(LAS u32x4*)(bv) = sv0; *(LAS u32x4*)(bv + 128) = sv1; } while (0)
    const unsigned ldsbase = (unsigned)(size_t)lds;
    const unsigned kaddr0 = ldsbase + (unsigned)((32 * kh + r32) * KP + hh * 16);
    const unsigned vrel = (unsigned)(ATT_VOFF + (32 * kh + 4 * hh + ((lane & 15) >> 2)) * VP + (16 * ((lane >> 4) & 1) + 4 * (lane & 3)) * 2);
    ATT_LOAD(0); ATT_WRITE(0, 0); __syncthreads();
    bf16x8 pb0, pb1;
    const bool more0 = (1 < ntiles);
    if (more0) ATT_LOAD(1);
    f32x16 sprev = att_qk(kaddr0, qr);
    att_partial(sprev, m, lsum, o);
    if (more0) ATT_WRITE(1, 1);
    __syncthreads();
    int vprev = 0, vcur = 1;
#pragma unroll 1
    for (int t = 1; t <= ntiles; ++t) {
        const bool more = (t + 1 < ntiles);
        if (more) ATT_LOAD(t + 1);
        f32x16 sc;
        if (t <= mylast) sc = att_qk(kaddr0 + (t & 1) * ATT_KB, qr);
        else {
#pragma unroll
            for (int r = 0; r < 16; ++r) sc[r] = -1e30f;
        }
        att_finish(sprev, m, lsum, pb0, pb1);
        att_pv(ldsbase + vprev * ATT_VB + vrel, pb0, pb1, o);
        att_partial(sc, m, lsum, o);
        sprev = sc;
        const int vnext = (vcur == 2) ? 0 : vcur + 1;
        if (more) ATT_WRITE((t + 1) & 1, vnext);
        vprev = vcur; vcur = vnext;
        __syncthreads();
    }
#undef ATT_LOAD
#undef ATT_WRITE
    LAS float* scr = (LAS float*)lds + (size_t)rg * 66 * 64 + lane;
    if (kh == 1) {
        scr[0] = m; scr[64] = lsum;
#pragma unroll
        for (int d = 0; d < 4; ++d)
#pragma unroll
            for (int r = 0; r < 16; ++r) scr[(2 + d * 16 + r) * 64] = o[d][r];
    }
    __syncthreads();
    if (kh == 0) {
        const float m2 = scr[0], l2 = scr[64];
        const float mn = fmaxf(m, m2), a1 = __builtin_amdgcn_exp2f(m - mn), a2 = __builtin_amdgcn_exp2f(m2 - mn);
        const float inv = 1.0f / (lsum * a1 + l2 * a2);
        bf16_t* op = mix + (size_t)(q0row + r32) * DM + 1024 + head * 128 + 4 * hh;
#pragma unroll
        for (int d = 0; d < 4; ++d)
#pragma unroll
            for (int g4 = 0; g4 < 4; ++g4) {
                float v[4];
#pragma unroll
                for (int i = 0; i < 4; ++i) { const int r = 4 * g4 + i; v[i] = (o[d][r] * a1 + scr[(2 + d * 16 + r) * 64] * a2) * inv; }
                u32x2 w; w.x = pk2(v[0], v[1]); w.y = pk2(v[2], v[3]);
                *(u32x2*)(op + 32 * d + 8 * g4) = w;
            }
    }
    __syncthreads();
}

__device__ __forceinline__ void gmlp_unit(const Params& p, LAS unsigned char* lds, int nb, int h, int tid, int wave, int lane) {
    unsigned char* ws = p.ws;
    const bf16_t* proj = (const bf16_t*)(ws + WS_PROJ); bf16_t* mix = (bf16_t*)(ws + WS_MIX);
    const float* ssv = (const float*)(ws + WS_ROWSS);
    const float* vg = p.in[3]; const float* wsp = p.in[4]; const float* bs = p.in[5];
#pragma unroll
    for (int i = 0; i < 4; ++i) {
        const int pc = tid + 512 * i, r = pc >> 4, c = pc & 15, t = nb * 128 + r;
        const u32x4 w = *(const u32x4*)(proj + (size_t)t * NINP + 1024 + h * 128 + c * 8);
        const float rs = rsqrtf(ssv[t] * (1.0f / 1024.0f) + EPS);
        const f32x4 g0 = *(const f32x4*)(vg + h * 128 + c * 8), g1 = *(const f32x4*)(vg + h * 128 + c * 8 + 4);
        u32x4 ov;
        ov.x = pk2(bflo(w.x) * rs * g0[0], bfhi(w.x) * rs * g0[1]); ov.y = pk2(bflo(w.y) * rs * g0[2], bfhi(w.y) * rs * g0[3]);
        ov.z = pk2(bflo(w.z) * rs * g1[0], bfhi(w.z) * rs * g1[1]); ov.w = pk2(bflo(w.w) * rs * g1[2], bfhi(w.w) * rs * g1[3]);
        *(LAS u32x4*)(lds + r * VP + c * 16) = ov;
    }
    __syncthreads();
    const int ib = wave & 3, ch = wave >> 2, r32 = lane & 31, hh = lane >> 5;
    const int irow = 32 * ib + r32;
    f32x16 acc0 = {}, acc1 = {};
    const unsigned vaddr = (unsigned)(size_t)lds + (unsigned)((8 * hh + ((lane & 15) >> 2)) * VP + (64 * ch + 16 * ((lane >> 4) & 1) + 4 * (lane & 3)) * 2);
    const float* wrow = wsp + ((size_t)h * 128 + irow) * 128 + hh * 8;
#define GSTEP(s) do { if ((s) < 2 * (ib + 1)) { \
        const f32x4 wa = *(const f32x4*)(wrow + (s) * 16), wb = *(const f32x4*)(wrow + (s) * 16 + 4); const int j0 = (s) * 16 + hh * 8; \
        u32x4 aw; aw.x = pk2(j0 + 0 <= irow ? wa[0] : 0.f, j0 + 1 <= irow ? wa[1] : 0.f); aw.y = pk2(j0 + 2 <= irow ? wa[2] : 0.f, j0 + 3 <= irow ? wa[3] : 0.f); \
        aw.z = pk2(j0 + 4 <= irow ? wb[0] : 0.f, j0 + 5 <= irow ? wb[1] : 0.f); aw.w = pk2(j0 + 6 <= irow ? wb[2] : 0.f, j0 + 7 <= irow ? wb[3] : 0.f); \
        const bf16x8 af = __builtin_bit_cast(bf16x8, aw); \
        const s16x4 b0l = tr_read<(16 * (s)) * VP>(vaddr), b0h = tr_read<(16 * (s) + 4) * VP>(vaddr), b1l = tr_read<(16 * (s)) * VP + 64>(vaddr), b1h = tr_read<(16 * (s) + 4) * VP + 64>(vaddr); \
        LDS_WAIT(); SBAR(); \
        acc0 = __builtin_amdgcn_mfma_f32_32x32x16_bf16(af, PK8(b0l, b0h), acc0, 0, 0, 0); acc1 = __builtin_amdgcn_mfma_f32_32x32x16_bf16(af, PK8(b1l, b1h), acc1, 0, 0, 0); } } while (0)
    GSTEP(0); GSTEP(1); GSTEP(2); GSTEP(3); GSTEP(4); GSTEP(5); GSTEP(6); GSTEP(7);
#undef GSTEP
#pragma unroll
    for (int r = 0; r < 16; ++r) {
        const int i = 32 * ib + crow(r, hh), t = nb * 128 + i; const float b = bs[h * 128 + i];
        const int c0 = h * 128 + 64 * ch + r32;
        const float u0 = bf2f(proj[(size_t)t * NINP + c0]), u1 = bf2f(proj[(size_t)t * NINP + c0 + 32]);
        mix[(size_t)t * DM + c0] = (bf16_t)f2bf(u0 * (acc0[r] + b)); mix[(size_t)t * DM + c0 + 32] = (bf16_t)f2bf(u1 * (acc1[r] + b));
    }
    __syncthreads();
}

__device__ __forceinline__ void phase7(const Params& p, LAS unsigned char* lds, int gw, int NGW, int wave, int lane) {
    unsigned char* ws = p.ws;
    const float* sc = (const float*)(ws + WS_SC); int* ex = (int*)(ws + WS_EXP); float* gt = (float*)(ws + WS_GATE);
    const float NEG = -3.0e38f;
    LAS float* sl = (LAS float*)(lds + wave * 1024);
    const int j8 = lane & 7, g8 = lane >> 3, row = lane >> 4, i16 = lane & 15;
    int ci[4], cj[4]; bool cval[4];
    {
        constexpr int starts[16] = {0, 16, 24, 29, 33, 36, 38, 40, 42, 43, 44, 45, 46, 47, 48, 49};
#pragma unroll
        for (int m = 0; m < 4; ++m) {
            const int c = i16 + 16 * m; int a = 0, st = 0;
#pragma unroll
            for (int i = 1; i < 16; ++i) if (c >= starts[i]) { a = i; st = starts[i]; }
            cval[m] = c < 50; ci[m] = cval[m] ? a : 0; cj[m] = cval[m] ? (c - st) : 0;
        }
    }
    constexpr int NT = S * 2;
    f32x4 nx0, nx1, nx2, nx3;
    if (gw < NT) { const float* b = sc + (size_t)(gw >> 1) * DM + (gw & 1) * 1024 + lane * 16; nx0 = *(const f32x4*)b; nx1 = *(const f32x4*)(b + 4); nx2 = *(const f32x4*)(b + 8); nx3 = *(const f32x4*)(b + 12); }
    for (int it = gw; it < NT; it += NGW) {
        const int t = it >> 1, hh = it & 1;
        float v[16];
#pragma unroll
        for (int q = 0; q < 4; ++q) { v[q] = nx0[q]; v[4 + q] = nx1[q]; v[8 + q] = nx2[q]; v[12 + q] = nx3[q]; }
        if (it + NGW < NT) { const int it2 = it + NGW; const float* b = sc + (size_t)(it2 >> 1) * DM + (it2 & 1) * 1024 + lane * 16;
            nx0 = *(const f32x4*)b; nx1 = *(const f32x4*)(b + 4); nx2 = *(const f32x4*)(b + 8); nx3 = *(const f32x4*)(b + 12); }
#pragma unroll
        for (int m = 0; m < 16; ++m) v[m] = __builtin_bit_cast(float, (__builtin_bit_cast(unsigned, v[m]) & ~127u) | (unsigned)(16 * j8 + m));
        float ra = 0.f, rb = 0.f;
#pragma unroll
        for (int k = 0; k < 16; ++k) {
            float mx = fmaxf(fmaxf(fmaxf(v[0], v[1]), fmaxf(v[2], v[3])), fmaxf(fmaxf(v[4], v[5]), fmaxf(v[6], v[7])));
            mx = fmaxf(mx, fmaxf(fmaxf(fmaxf(v[8], v[9]), fmaxf(v[10], v[11])), fmaxf(fmaxf(v[12], v[13]), fmaxf(v[14], v[15]))));
            mx = fmaxf(mx, dpp_f<0xB1, 0xf>(mx, mx));
            mx = fmaxf(mx, dpp_f<0x4E, 0xf>(mx, mx));
            mx = fmaxf(mx, dpp_f<0x141, 0xf>(mx, mx));
#pragma unroll
            for (int m = 0; m < 16; ++m) v[m] = (v[m] == mx) ? NEG : v[m];
            if (k < 8) ra = (j8 == k) ? mx : ra; else rb = (j8 == k - 8) ? mx : rb;
        }
        sl[g8 * 16 + j8] = ra; sl[g8 * 16 + 8 + j8] = rb;
        LDS_WAIT(); asm volatile("" ::: "memory");
        float cv[4], og[4]; int id[4];
#pragma unroll
        for (int m = 0; m < 4; ++m) {
            const float s1 = sl[(2 * row) * 16 + ci[m]], s2 = sl[(2 * row + 1) * 16 + cj[m]];
            og[m] = cval[m] ? (s1 + s2) : NEG; cv[m] = og[m];
            id[m] = (int)((__builtin_bit_cast(unsigned, s1) & 127u) * 128u + (__builtin_bit_cast(unsigned, s2) & 127u));
        }
        LDS_WAIT(); asm volatile("" ::: "memory");
        float M0 = 0.f;
#pragma unroll
        for (int k = 0; k < 16; ++k) {
            float mx = fmaxf(fmaxf(cv[0], cv[1]), fmaxf(cv[2], cv[3]));
            mx = fmaxf(mx, dpp_f<0xB1, 0xf>(mx, mx));
            mx = fmaxf(mx, dpp_f<0x4E, 0xf>(mx, mx));
            mx = fmaxf(mx, dpp_f<0x141, 0xf>(mx, mx));
            mx = fmaxf(mx, dpp_f<0x140, 0xf>(mx, mx));
            if (k == 0) M0 = mx;
#pragma unroll
            for (int m = 0; m < 4; ++m) cv[m] = (cv[m] == mx) ? NEG : cv[m];
        }
        bool sel[4]; float e[4]; float es = 0.f;
#pragma unroll
        for (int m = 0; m < 4; ++m) { sel[m] = (cv[m] != og[m]); e[m] = sel[m] ? __expf(og[m] - M0) : 0.f; es += e[m]; }
        es += dpp_f<0xB1, 0xf>(0.f, es); es += dpp_f<0x4E, 0xf>(0.f, es); es += dpp_f<0x141, 0xf>(0.f, es); es += dpp_f<0x140, 0xf>(0.f, es);
        const float inv = 1.0f / es;
        int basepos = 0;
        const int head = 4 * hh + row;
#pragma unroll
        for (int m = 0; m < 4; ++m) {
            const unsigned long long bl = __ballot(sel[m]);
            const unsigned rbits = (unsigned)(bl >> (16 * row)) & 0xffffu;
            const int pos = basepos + __popc(rbits & ((1u << i16) - 1u));
            if (sel[m] && pos < 16) { ex[(size_t)t * 128 + head * 16 + pos] = id[m]; gt[(size_t)t * 128 + head * 16 + pos] = e[m] * inv; }
            basepos += __popc(rbits);
        }
    }
}

typedef __bf16 bf16x32v __attribute__((ext_vector_type(32)));
typedef __bf16 bf16x2v __attribute__((ext_vector_type(2)));
typedef float f32x2 __attribute__((ext_vector_type(2)));
#ifndef P8_THROTTLE
#define P8_THROTTLE 0
#endif
constexpr unsigned P8_SLACK = 12;
__device__ __forceinline__ void phase8(const Params& p, LAS unsigned char* lds, float* dst, unsigned xcc, unsigned nwx, int gw, int NGW, int wave, int lane) {
    unsigned char* ws = p.ws;
    const bf16_t* x1b = (const bf16_t*)(ws + WS_X1B); const unsigned char* UT = ws + WS_UT; const unsigned char* VT = ws + WS_VT;
    const int* ex = (const int*)(ws + WS_EXP); const float* gt = (const float*)(ws + WS_GATE); const float* ss2 = (const float*)(ws + WS_ROWSS) + 3 * S;
    const float* out = p.out;
    LAS unsigned char* xl = lds + wave * 16384;
    LAS unsigned* list = (LAS unsigned*)(lds + 131072 + wave * 2048);
    LAS unsigned* hist = (LAS unsigned*)(lds + 147456 + wave * 256);
    for (int tb = gw; tb < S / 4; tb += NGW) {
        const int t0 = tb * 4;
        int id[8]; float gv[8];
#pragma unroll
        for (int r = 0; r < 8; ++r) { const size_t o = (size_t)(t0 + (r >> 1)) * 128 + (r & 1) * 64 + lane; id[r] = ex[o]; gv[r] = gt[o]; }
        const float rs0 = rsqrtf(ss2[t0 + 0] * (1.0f / DM) + EPS) * (1.0f / PEER_USC), rs1 = rsqrtf(ss2[t0 + 1] * (1.0f / DM) + EPS) * (1.0f / PEER_USC);
        const float rs2 = rsqrtf(ss2[t0 + 2] * (1.0f / DM) + EPS) * (1.0f / PEER_USC), rs3 = rsqrtf(ss2[t0 + 3] * (1.0f / DM) + EPS) * (1.0f / PEER_USC);
        hist[lane] = 0u;
        LDS_WAIT(); asm volatile("" ::: "memory");
        unsigned pos[8];
#pragma unroll
        for (int r = 0; r < 8; ++r) pos[r] = __hip_atomic_fetch_add(hist + (id[r] >> 8), 1u, __ATOMIC_RELAXED, __HIP_MEMORY_SCOPE_WORKGROUP);
        LDS_WAIT(); asm volatile("" ::: "memory");
        const unsigned cnt = hist[lane];
        unsigned inc = cnt;
#pragma unroll
        for (int o = 1; o < 64; o <<= 1) { const unsigned n = __shfl_up(inc, o); if (lane >= o) inc += n; }
        LDS_WAIT(); asm volatile("" ::: "memory");
        hist[lane] = inc - cnt;
        LDS_WAIT(); asm volatile("" ::: "memory");
#pragma unroll
        for (int r = 0; r < 8; ++r) { const unsigned d = hist[id[r] >> 8] + pos[r]; list[d] = (unsigned)id[r] | ((unsigned)(r >> 1) << 14) | (f2bf(gv[r]) << 16); }
#pragma unroll
        for (int j = 0; j < 4; ++j)
#pragma unroll
            for (int g = 0; g < 4; ++g) {
                const u32x2 w0 = *(const u32x2*)(x1b + (size_t)(t0 + j) * DM + ((2 * g) * 64 + lane) * 4), w1 = *(const u32x2*)(x1b + (size_t)(t0 + j) * DM + ((2 * g + 1) * 64 + lane) * 4);
                *(LAS u32x4*)(xl + j * 4096 + g * 1024 + lane * 16) = (u32x4){w0.x, w0.y, w1.x, w1.y};
            }
        asm volatile("s_waitcnt vmcnt(0) lgkmcnt(0)" ::: "memory");
        {
            const __amdgpu_buffer_rsrc_t urs = __builtin_amdgcn_make_buffer_rsrc((void*)UT, 0, 16384 * PEER_ROWB, 0x00020000);
            const int vo4 = lane * 16, vo2 = lane * 8 + 1024;
            const bool lb0 = (lane & 1) != 0, lb1 = (lane & 2) != 0, lb2 = (lane & 4) != 0;
#define P8_ULOAD(k, i) do { const unsigned en = (unsigned)__builtin_amdgcn_readfirstlane((int)list[(i)]); uen[k] = en; const int ro = (int)((en & 0x3fffu) * (unsigned)PEER_ROWB); \
            u4[k] = __builtin_amdgcn_raw_buffer_load_b128(urs, vo4, ro, 0); u2[k] = __builtin_amdgcn_raw_buffer_load_b64(urs, vo2, ro, 0); } while (0)
#define P8_UPROC(k) do { const u32x6 pk = {u4[k][0], u4[k][1], u4[k][2], u4[k][3], u2[k][0], u2[k][1]}; \
            const bf16x32v r_ = __builtin_amdgcn_cvt_scalef32_pk32_bf16_fp6(pk, 1.0f); const LAS unsigned char* xp = xl + ((uen[k] >> 14) & 3u) * 4096 + lane * 16; \
            float d0 = 0.f, d1 = 0.f, d2 = 0.f, d3 = 0.f; \
            _Pragma("unroll") for (int g = 0; g < 4; ++g) { const LAS unsigned* xw = (const LAS unsigned*)(xp + g * 1024); const unsigned x0 = xw[0], x1 = xw[1], x2 = xw[2], x3 = xw[3]; \
                { const bf16x2v uu = {r_[8 * g + 0], r_[8 * g + 1]}; d0 = __builtin_amdgcn_fdot2_f32_bf16(uu, __builtin_bit_cast(bf16x2v, x0), d0, false); } \
                { const bf16x2v uu = {r_[8 * g + 2], r_[8 * g + 3]}; d1 = __builtin_amdgcn_fdot2_f32_bf16(uu, __builtin_bit_cast(bf16x2v, x1), d1, false); } \
                { const bf16x2v uu = {r_[8 * g + 4], r_[8 * g + 5]}; d2 = __builtin_amdgcn_fdot2_f32_bf16(uu, __builtin_bit_cast(bf16x2v, x2), d2, false); } \
                { const bf16x2v uu = {r_[8 * g + 6], r_[8 * g + 7]}; d3 = __builtin_amdgcn_fdot2_f32_bf16(uu, __builtin_bit_cast(bf16x2v, x3), d3, false); } } \
            dd[k] = (d0 + d1) + (d2 + d3); } while (0)
#if (PROBE_DUP >> 10) & 1
#define P8_UREPS 2
#else
#define P8_UREPS 1
#endif
#pragma unroll 1
            for (int urep = 0; urep < P8_UREPS; ++urep) {
                u32x4 u4[8]; u32x2 u2[8]; unsigned uen[8];
#pragma unroll
                for (int k = 0; k < 8; ++k) P8_ULOAD(k, k);
#pragma unroll 1
                for (int i = 0; i < 512; i += 8) {
                    const unsigned ev = list[i + (lane & 7)]; const unsigned jl = (ev >> 14) & 3u;
                    const float gl = __builtin_bit_cast(float, ev & 0xffff0000u), rl = jl == 0u ? rs0 : (jl == 1u ? rs1 : (jl == 2u ? rs2 : rs3));
                    float dd[8];
#pragma unroll
                    for (int k = 0; k < 8; ++k) { P8_UPROC(k); const int nx = i + 8 + k; P8_ULOAD(k, nx < 512 ? nx : 511); }
                    float w4[4], w2[2];
#pragma unroll
                    for (int q = 0; q < 4; ++q) { const float kp = lb2 ? dd[q + 4] : dd[q], sd = lb2 ? dd[q] : dd[q + 4]; w4[q] = kp + __shfl_xor(sd, 4); }
#pragma unroll
                    for (int q = 0; q < 2; ++q) { const float kp = lb1 ? w4[q + 2] : w4[q], sd = lb1 ? w4[q] : w4[q + 2]; w2[q] = kp + __shfl_xor(sd, 2); }
                    float dres; { const float kp = lb0 ? w2[1] : w2[0], sd = lb0 ? w2[0] : w2[1]; dres = kp + __shfl_xor(sd, 1); }
                    dres += __shfl_xor(dres, 8); dres += __shfl_xor(dres, 16); dres += __shfl_xor(dres, 32);
                    const float c_ = gl * gelu_tanh(rl * dres) * (1.0f / PEER_VSC);
                    if (lane < 8 && urep == P8_UREPS - 1) list[i + lane] = (ev & 0xffffu) | (f2bf(c_) << 16);
                }
            }
#undef P8_ULOAD
#undef P8_UPROC
        }
        asm volatile("s_waitcnt vmcnt(0)" ::: "memory");
        LDS_WAIT(); asm volatile("" ::: "memory");
        f32x4 acc[32];
#if (PROBE_DUP >> 12) & 1
#define P8_VREPS 2
#else
#define P8_VREPS 1
#endif
#pragma unroll 1
        for (int vrep = 0; vrep < P8_VREPS; ++vrep) {
#pragma unroll
        for (int i = 0; i < 32; ++i) acc[i] = (f32x4){0.f, 0.f, 0.f, 0.f};
        {
            typedef unsigned u32x16 __attribute__((ext_vector_type(16)));
            u32x4 v4[4]; u32x2 v2[4]; unsigned ven[4];
            const unsigned tok = (unsigned)lane & 3u;
            const __amdgpu_buffer_rsrc_t vrs = __builtin_amdgcn_make_buffer_rsrc((void*)VT, 0, 16384 * PEER_ROWB, 0x00020000);
            const int vo4 = lane * 16, vo2 = lane * 8 + 1024;
#define P8_VLOAD(k, i) do { const unsigned en = (unsigned)__builtin_amdgcn_readfirstlane((int)list[(i)]); ven[k] = en; const int ro = (int)((en & 0x3fffu) * (unsigned)PEER_ROWB); \
            v4[k] = __builtin_amdgcn_raw_buffer_load_b128(vrs, vo4, ro, 0); v2[k] = __builtin_amdgcn_raw_buffer_load_b64(vrs, vo2, ro, 0); } while (0)
#define P8_VPROC2(ka, kb) do { const u32x6 pka = {v4[ka][0], v4[ka][1], v4[ka][2], v4[ka][3], v2[ka][0], v2[ka][1]}, pkb = {v4[kb][0], v4[kb][1], v4[kb][2], v4[kb][3], v2[kb][0], v2[kb][1]}; \
            const u32x16 da = __builtin_bit_cast(u32x16, __builtin_amdgcn_cvt_scalef32_pk32_bf16_fp6(pka, 1.0f)), db = __builtin_bit_cast(u32x16, __builtin_amdgcn_cvt_scalef32_pk32_bf16_fp6(pkb, 1.0f)); \
            const unsigned ea = ven[ka], eb = ven[kb]; \
            const unsigned alo = ((((ea >> 14) & 3u) == tok) ? (ea >> 16) : 0u) | ((((eb >> 14) & 3u) == tok) ? (eb & 0xffff0000u) : 0u); \
            const s16x4 av = __builtin_bit_cast(s16x4, (unsigned long long)alo); \
            _Pragma("unroll") for (int m = 0; m < 16; ++m) { \
                const unsigned be = __builtin_amdgcn_perm(db[m], da[m], 0x05040100u), bo = __builtin_amdgcn_perm(db[m], da[m], 0x07060302u); \
                acc[2 * m] = __builtin_amdgcn_mfma_f32_4x4x4bf16_1k(av, __builtin_bit_cast(s16x4, (unsigned long long)be), acc[2 * m], 0, 0, 0); \
                acc[2 * m + 1] = __builtin_amdgcn_mfma_f32_4x4x4bf16_1k(av, __builtin_bit_cast(s16x4, (unsigned long long)bo), acc[2 * m + 1], 0, 0, 0); } } while (0)
#pragma unroll
            for (int k = 0; k < 4; ++k) P8_VLOAD(k, k);
#pragma unroll 1
            for (int i = 0; i < 512; i += 4) {
#pragma unroll
                for (int k = 0; k < 4; k += 2) { P8_VPROC2(k, k + 1); const int nx = i + 4 + k < 512 ? i + 4 + k : 510; P8_VLOAD(k, nx); P8_VLOAD(k + 1, nx + 1); }
            }
#undef P8_VLOAD
#undef P8_VPROC2
        }
        }
        int tq = t0, lq = lane; asm volatile("" : "+s"(tq)); asm volatile("" : "+v"(lq));
#pragma unroll
        for (int j = 0; j < 4; ++j)
#pragma unroll
            for (int i = 0; i < 8; ++i) {
                const size_t o = (size_t)(tq + j) * DM + (i * 64 + lq) * 4;
                f32x4 a = *(const f32x4*)(out + o);
#pragma unroll
                for (int q = 0; q < 4; ++q) a[q] += acc[4 * i + q][j];
                *(f32x4*)(dst + o) = a;
                if (i & 1) asm volatile("" ::: "memory");
            }
        LDS_WAIT(); asm volatile("" ::: "memory");
    }
}

__global__ void __launch_bounds__(NTHREADS, 2) mega(Params p) {
    extern __shared__ __attribute__((aligned(16))) unsigned char lds_raw[];
    LAS unsigned char* lds = (LAS unsigned char*)lds_raw;
    const int tid = threadIdx.x, lane = tid & 63, wave = __builtin_amdgcn_readfirstlane(tid >> 6);
    const int G = gridDim.x, bx = blockIdx.x;
    const int gw = bx * 8 + wave, NGW = G * 8;
    unsigned char* ws = p.ws;
    const int lo = p.ph_lo, hi = p.ph_hi;
    volatile LAS unsigned* misc = (volatile LAS unsigned*)(lds + LDS_MISC);
    if (tid < 4) misc[tid] = 0u;
    __syncthreads();
    const XcdBarrier xbar = xcd_barrier_post((unsigned*)(ws + WS_CTL), misc);
#ifndef PH_MASK
#define PH_MASK 0x1ff
#endif
#define IN(k) (((PH_MASK >> (k)) & 1) && lo <= (k) && (k) < hi)
#define SEAM(k) do { if (IN(k) && IN((k) + 1)) xcd_barrier(xbar); } while (0)

#if (PROBE_DUP >> 0) & 1
    if (IN(0)) { phase0(p, lds, gw, NGW, wave, lane); xcd_barrier(xbar); }
#endif
    if (IN(0)) phase0(p, lds, gw, NGW, wave, lane);
    SEAM(0);
    if (IN(1)) {
        pg8::Gemm g{(const bf16_t*)(ws + WS_XB), (const bf16_t*)(ws + WS_WIN), S, NINP, DM, DM, DM};
        pg8::StaticOrder So; So.init(S, NINP, G, bx);
        pg8::Epi<1> E{(const float*)(ws + WS_RSTD1), 0.f, (float*)(ws + WS_ROWSS), (bf16_t*)(ws + WS_PROJ), NINP, nullptr, nullptr};
#if (PROBE_DUP >> 1) & 1
        { pg8::Epi<1> E2 = E; E2.ss = (float*)(ws + 512 * 1024); pg8::gemm_phase<pg8::Epi<1>, pg8::StaticOrder, true, true>(lds, g, So, E2); xcd_barrier(xbar); }
#endif
        pg8::gemm_phase<pg8::Epi<1>, pg8::StaticOrder, true, true>(lds, g, So, E);
    }
    SEAM(1);
    if (IN(2)) {
        {
            pg8::Gemm g{(const bf16_t*)(ws + WS_PROJ) + 2048, (const bf16_t*)(ws + WS_WUQ), S, 1536, 512, NINP, 512};
            pg8::StaticOrder So; So.init(S, 1536, G, bx);
            pg8::Epi<2> E{(const float*)(ws + WS_ROWSS) + 1 * S, 1.0f / 512.0f, nullptr, (bf16_t*)(ws + WS_QRAW), 1536, nullptr, nullptr};
            pg8::gemm_phase<pg8::Epi<2>, pg8::StaticOrder, true, true>(lds, g, So, E);
        }
        __syncthreads();
        {
            pg8::Gemm g{(const bf16_t*)(ws + WS_PROJ) + 2560, (const bf16_t*)(ws + WS_WUKV), S, 2048, 256, NINP, 256};
            pg8::StaticOrder So; So.init(S, 2048, G, bx);
            pg8::Epi<2> E{(const float*)(ws + WS_ROWSS) + 2 * S, 1.0f / 256.0f, nullptr, (bf16_t*)(ws + WS_KVRAW), 2048, nullptr, nullptr};
            pg8::gemm_phase<pg8::Epi<2>, pg8::StaticOrder, true, true>(lds, g, So, E);
        }
    }
    SEAM(2);
#if (PROBE_DUP >> 3) & 1
    if (IN(3)) { phase3(p, gw, NGW, lane); xcd_barrier(xbar); }
#endif
    if (IN(3)) phase3(p, gw, NGW, lane);
    SEAM(3);
#define P4_BODY_ATT for (int pr = bx; pr < 256; pr += G) { const int head = pr & 7, x = pr >> 3; attn_unit(p, lds, head, 63 - x, tid, wave, lane); attn_unit(p, lds, head, x, tid, wave, lane); }
#define P4_BODY_GMLP for (int u = bx; u < 512; u += G) gmlp_unit(p, lds, u >> 3, u & 7, tid, wave, lane);
#if (PROBE_DUP >> 4) & 1
    if (IN(4)) { P4_BODY_ATT; xcd_barrier(xbar); }
#endif
#if (PROBE_DUP >> 9) & 1
    if (IN(4)) { P4_BODY_GMLP; xcd_barrier(xbar); }
#endif
    if (IN(4)) { P4_BODY_ATT; P4_BODY_GMLP; }
    SEAM(4);
    if (IN(5)) {
        pg8::Gemm g{(const bf16_t*)(ws + WS_MIX), (const bf16_t*)(ws + WS_WOUT), S, DM, DM, DM, DM};
        pg8::StaticOrder So; So.init(S, DM, G, bx);
        pg8::Epi<4> E{nullptr, 0.f, (float*)(ws + WS_ROWSS) + 3 * S, (bf16_t*)(ws + WS_X1B), DM, p.out, p.in[0]};
#if (PROBE_DUP >> 5) & 1
        { pg8::Epi<4> E2 = E; E2.ss = (float*)(ws + 512 * 1024); pg8::gemm_phase<pg8::Epi<4>, pg8::StaticOrder, true, true>(lds, g, So, E2); xcd_barrier(xbar); }
#endif
        pg8::gemm_phase<pg8::Epi<4>, pg8::StaticOrder, true, true>(lds, g, So, E);
    }
    SEAM(5);
    if (IN(6)) {
        pg8::Gemm g{(const bf16_t*)(ws + WS_X1B), (const bf16_t*)(ws + WS_WS), S, DM, DM, DM, DM};
        pg8::StaticOrder So; So.init(S, DM, G, bx);
        pg8::Epi<5> E{(const float*)(ws + WS_ROWSS) + 3 * S, 1.0f / DM, nullptr, nullptr, DM, (float*)(ws + WS_SC), nullptr};
#if (PROBE_DUP >> 6) & 1
        { pg8::gemm_phase<pg8::Epi<5>, pg8::StaticOrder, true, true>(lds, g, So, E); xcd_barrier(xbar); }
#endif
        pg8::gemm_phase<pg8::Epi<5>, pg8::StaticOrder, true, true>(lds, g, So, E);
    }
    SEAM(6);
#if (PROBE_DUP >> 7) & 1
    if (IN(7)) { phase7(p, lds, gw, NGW, wave, lane); xcd_barrier(xbar); }
#endif
    if (IN(7)) phase7(p, lds, gw, NGW, wave, lane);
    SEAM(7);
#if (PROBE_DUP >> 8) & 1
    if (IN(8)) { phase8(p, lds, (float*)(ws + WS_SC), xbar.x, 8u * misc[0], gw, NGW, wave, lane); xcd_barrier(xbar); }
#endif
    if (IN(8)) phase8(p, lds, p.out, xbar.x, 8u * misc[0], gw, NGW, wave, lane);
#undef IN
#undef SEAM
}

extern "C" void kernel_launch(void* const* d_in, const int* in_sizes, int n_in, void* d_out, int out_size, void* d_ws, size_t ws_size, hipStream_t stream) {
    static int grid = 0;
    if (grid == 0) {
        if (n_in != 18 || out_size != S * DM || ws_size < WS_END) { fprintf(stderr, "kernel_launch: unexpected shapes (n_in %d out %d ws %zu)\n", n_in, out_size, ws_size); grid = -1; return; }
        int dev = 0, cus = 0, per_cu = 0;
        hipGetDevice(&dev);
        hipDeviceGetAttribute(&cus, hipDeviceAttributeMultiprocessorCount, dev);
        if (hipFuncSetAttribute((const void*)mega, hipFuncAttributeMaxDynamicSharedMemorySize, LDS_BYTES) != hipSuccess) { fprintf(stderr, "kernel_launch: hipFuncSetAttribute failed\n"); grid = -1; return; }
        if (hipOccupancyMaxActiveBlocksPerMultiprocessor(&per_cu, (const void*)mega, NTHREADS, LDS_BYTES) != hipSuccess || per_cu < 1) { fprintf(stderr, "kernel_launch: occupancy query failed (%d)\n", per_cu); grid = -1; return; }
        grid = cus;
        fprintf(stderr, "kernel_launch: cus %d per_cu %d grid %d\n", cus, per_cu, grid);
    }
    if (grid < 0) return;
    hipMemsetAsync((char*)d_ws + WS_CTL, 0, 1 * MiB, stream);
    Params prm{};
    for (int i = 0; i < 18; ++i) prm.in[i] = (const float*)d_in[i];
    prm.out = (float*)d_out; prm.ws = (unsigned char*)d_ws;
#if MK_ONE_LAUNCH
    prm.ph_lo = 0; prm.ph_hi = NPH;
    { void* args[] = {&prm}; hipError_t e = hipLaunchCooperativeKernel((const void*)mega, dim3(grid), dim3(NTHREADS), args, LDS_BYTES, stream);
      if (e != hipSuccess) fprintf(stderr, "cooperative launch failed: %s\n", hipGetErrorString(e)); }
#else
    for (int ph = 0; ph < NPH; ++ph) {
        prm.ph_lo = ph; prm.ph_hi = ph + 1;
        void* args[] = {&prm};
        hipError_t e = hipLaunchCooperativeKernel((const void*)mega, dim3(grid), dim3(NTHREADS), args, LDS_BYTES, stream);
        if (e != hipSuccess) { fprintf(stderr, "cooperative launch %d failed: %s\n", ph, hipGetErrorString(e)); break; }
    }
#endif
}
```

```cpp
#include <hip/hip_runtime.h>
#include <cstdio>
#include <cstdint>

#define LAS __attribute__((address_space(3)))
typedef unsigned short bf16_t;
typedef short bf16x8 __attribute__((ext_vector_type(8)));
typedef short s16x4 __attribute__((ext_vector_type(4)));
typedef float f32x4 __attribute__((ext_vector_type(4)));
typedef float f32x16 __attribute__((ext_vector_type(16)));
typedef unsigned u32x4 __attribute__((ext_vector_type(4)));
typedef unsigned u32x2 __attribute__((ext_vector_type(2)));

#ifndef PROBE_DUP
#define PROBE_DUP 0
#endif
#ifndef MK_ONE_LAUNCH
#define MK_ONE_LAUNCH 1
#endif

constexpr int S = 8192, DM = 2048, NIN = 2880, NINP = 3072;
constexpr int NPH = 9;
constexpr float EPS = 1e-6f;
constexpr int LDS_BYTES = 163840;
constexpr int NTHREADS = 512;
constexpr int LDS_MISC = 161792;

constexpr size_t MiB = 1u << 20;
constexpr size_t WS_CTL = 0;
constexpr size_t WS_ROWSS = 128 * 1024;
constexpr size_t WS_COS = 1 * MiB, WS_SIN = 2 * MiB;
constexpr size_t WS_RSTD1 = 3 * MiB;
constexpr size_t WS_EXP = 4 * MiB;
constexpr size_t WS_GATE = 8 * MiB;
constexpr size_t WS_WIN = 12 * MiB;
constexpr size_t WS_WUQ = 24 * MiB;
constexpr size_t WS_WUKV = 26 * MiB;
constexpr size_t WS_WOUT = 28 * MiB;
constexpr size_t WS_WS = 36 * MiB;
constexpr size_t WS_XB = 44 * MiB;
constexpr size_t WS_PROJ = 76 * MiB;
constexpr size_t WS_QRAW = 124 * MiB;
constexpr size_t WS_KVRAW = 148 * MiB;
constexpr size_t WS_QH = 180 * MiB;
constexpr size_t WS_KH = 204 * MiB;
constexpr size_t WS_VH = 228 * MiB;
constexpr size_t WS_MIX = 244 * MiB;
constexpr size_t WS_X1B = 276 * MiB;
constexpr size_t WS_SC = 308 * MiB;
constexpr size_t WS_UT = 372 * MiB;
constexpr size_t WS_VT = 436 * MiB;
constexpr size_t WS_END = 500 * MiB;

__device__ __forceinline__ unsigned f2bf(float f) { unsigned u = __builtin_bit_cast(unsigned, f); return (u + 0x7fffu + ((u >> 16) & 1u)) >> 16; }
__device__ __forceinline__ unsigned pk2(float lo, float hi) { return f2bf(lo) | (f2bf(hi) << 16); }
__device__ __forceinline__ float bf2f(unsigned short b) { return __builtin_bit_cast(float, (unsigned)b << 16); }
__device__ __forceinline__ float bflo(unsigned w) { return __builtin_bit_cast(float, w << 16); }
__device__ __forceinline__ float bfhi(unsigned w) { return __builtin_bit_cast(float, w & 0xffff0000u); }
__device__ __forceinline__ float wave_sum(float v) {
#pragma unroll
    for (int o = 32; o > 0; o >>= 1) v += __shfl_xor(v, o);
    return v;
}
__device__ __forceinline__ float wave_max(float v) {
#pragma unroll
    for (int o = 32; o > 0; o >>= 1) v = fmaxf(v, __shfl_xor(v, o));
    return v;
}
template <int CTRL, int ROW_MASK> __device__ __forceinline__ float dpp_f(float old, float v) {
    return __builtin_bit_cast(float, __builtin_amdgcn_update_dpp(__builtin_bit_cast(int, old), __builtin_bit_cast(int, v), CTRL, ROW_MASK, 0xf, false));
}
__device__ __forceinline__ float wave_max_u(float v) {
    v = fmaxf(v, dpp_f<0xB1, 0xf>(v, v));
    v = fmaxf(v, dpp_f<0x4E, 0xf>(v, v));
    v = fmaxf(v, dpp_f<0x141, 0xf>(v, v));
    v = fmaxf(v, dpp_f<0x140, 0xf>(v, v));
    v = fmaxf(v, dpp_f<0x142, 0xa>(v, v));
    v = fmaxf(v, dpp_f<0x143, 0xc>(v, v));
    return __builtin_bit_cast(float, __builtin_amdgcn_readlane(__builtin_bit_cast(int, v), 63));
}
__device__ __forceinline__ float wave_sum_u(float v) {
    v += dpp_f<0xB1, 0xf>(0.f, v);
    v += dpp_f<0x4E, 0xf>(0.f, v);
    v += dpp_f<0x141, 0xf>(0.f, v);
    v += dpp_f<0x140, 0xf>(0.f, v);
    v += dpp_f<0x142, 0xa>(0.f, v);
    v += dpp_f<0x143, 0xc>(0.f, v);
    return __builtin_bit_cast(float, __builtin_amdgcn_readlane(__builtin_bit_cast(int, v), 63));
}
__device__ __forceinline__ float gelu_tanh(float x) {
    const float y = 0.7978845608028654f * (x + 0.044715f * x * x * x);
    return x / (1.0f + __expf(-2.0f * y));
}
__device__ __forceinline__ int crow(int r, int hi) { return (r & 3) + 8 * (r >> 2) + 4 * hi; }
#define LDS_WAIT() asm volatile("s_waitcnt lgkmcnt(0)" ::: "memory")
#define SBAR() __builtin_amdgcn_sched_barrier(0)

namespace pg8 {
#define PG8_LAS __attribute__((address_space(3)))
constexpr int BM = 256, BK = 64, HALF = 128, HTB = HALF * BK * 2  , STAGE_BYTES = 8 * HTB, NXCD = 8, WGM = 8;

__host__ __device__ __forceinline__ int lds_byte(int r, int c) { const int st = (r >> 4) * 2 + (c >> 5), rr = r & 15, cc = c & 31, ob = rr * 64 + cc * 2; return st * 1024 + (ob ^ (((ob >> 9) & 1) << 5)); }
__host__ __device__ __forceinline__ void stage_rc(int b, int& R, int& C) { const int st = b / 1024, sb = b % 1024, swz = sb ^ (((sb >> 9) & 1) << 5); R = (st >> 1) * 16 + swz / 64; C = (st & 1) * 32 + (swz % 64) / 2; }
__host__ __device__ __forceinline__ int perm32(int rho) { const int n = rho >> 4, i = rho & 15; return 8 * (i >> 2) + 4 * n + (i & 3); }

struct Unit { int pm, pn; };
struct Gemm { const bf16_t* A; const bf16_t* Bt; int M, N, K, lda, ldb; };

struct StaticOrder {
    int nM, nN, nwg, G, c;
    __host__ __device__ void init(int M, int N, int G_, int c_) { nM = M / BM; nN = N / BM; nwg = nM * nN; G = G_; c = c_; }
    __host__ __device__ bool next(int i, Unit& u) const {
        const long L = (long)i * G + c; if (L >= nwg) return false;
        int wgid = (int)L; { const int q = nwg / NXCD, r = nwg % NXCD, xcd = wgid % NXCD, off = wgid / NXCD; wgid = (xcd < r ? xcd * (q + 1) : r * (q + 1) + (xcd - r) * q) + off; }
        const int nig = WGM * nN, gid = wgid / nig, fm = gid * WGM, gsz = (nM - fm) < WGM ? (nM - fm) : WGM;
        u.pm = fm + ((wgid % nig) % gsz); u.pn = (wgid % nig) / gsz; return true;
    }
    __device__ __forceinline__ void a_ready(const Unit&) const {}
    __device__ __forceinline__ void done(const Unit&) const {}
};

template <class Epi, class Sched, bool ALIGN_EPI = false, bool SP2 = false>
__device__ __forceinline__ void gemm_phase(PG8_LAS unsigned char* lds, const Gemm g, const Sched& S, const Epi& E) {
    const int tid = threadIdx.x, wid = __builtin_amdgcn_readfirstlane(tid >> 6), lane = tid & 63, wr = wid >> 2, wc = wid & 3, fr = lane & 15, fq = lane >> 4;
    const int K = g.K, nt = K / BK;
    unsigned voffA[2], voffB[2];
#pragma unroll
    for (int i = 0; i < 2; ++i) { int R, C; stage_rc(tid * 16 + i * 8192, R, C); const int Rb = Epi::PERM ? ((R & ~31) + perm32(R & 31)) : R;
        voffA[i] = (unsigned)(R * g.lda + C) * 2u; voffB[i] = (unsigned)(Rb * g.ldb + C) * 2u; }
    const size_t kstep = (size_t)(BK * 2);
    const size_t hstepA = (size_t)HALF * g.lda * 2, hstepB = (size_t)HALF * g.ldb * 2;
    const size_t tstepA = 2 * hstepA, tstepB = 2 * hstepB;
    const unsigned ldsw = (unsigned)wid * 1024u;
    const int aoff = lds_byte(wr * 64 + fr, fq * 8), boff = lds_byte(wc * 32 + fr, fq * 8);
#define PG8_SA(b, h) (((b) * 2 + (h)) * HTB)
#define PG8_SB(b, h) ((4 + (b) * 2 + (h)) * HTB)
#define PG8_STAGE(bufoff, gbase, voff) do { _Pragma("unroll") for (int _i = 0; _i < 2; ++_i) \
        __builtin_amdgcn_global_load_lds((const unsigned*)((const char*)(gbase) + (voff)[_i]), (PG8_LAS unsigned*)(lds + (bufoff) + ldsw + _i * 8192), 16, 0, 0); } while (0)
#define PG8_LDA(dst, b, h) do { _Pragma("unroll") for (int m = 0; m < 4; ++m) _Pragma("unroll") for (int k = 0; k < 2; ++k) dst[m][k] = *(const PG8_LAS bf16x8*)(lds + PG8_SA(b, h) + aoff + m * 2048 + k * 1024); } while (0)
#define PG8_LDB(dst, b, h) do { _Pragma("unroll") for (int n = 0; n < 2; ++n) _Pragma("unroll") for (int k = 0; k < 2; ++k) dst[n][k] = *(const PG8_LAS bf16x8*)(lds + PG8_SB(b, h) + boff + n * 2048 + k * 1024); } while (0)
#define PG8_MMA(ai, bj, At, Bt) do { __builtin_amdgcn_s_setprio(1); _Pragma("unroll") for (int m = 0; m < 4; ++m) _Pragma("unroll") for (int n = 0; n < 2; ++n) _Pragma("unroll") for (int k = 0; k < 2; ++k) \
        acc[ai][bj][m][n] = __builtin_amdgcn_mfma_f32_16x16x32_bf16(Bt[n][k], At[m][k], acc[ai][bj][m][n], 0, 0, 0); __builtin_amdgcn_s_setprio(0); } while (0)
#define PG8_WAIT_V(n) asm volatile("s_waitcnt vmcnt(" #n ")" ::: "memory")
#define PG8_WAIT_L(n) asm volatile("s_waitcnt lgkmcnt(" #n ")" ::: "memory")
#define PG8_BAR __builtin_amdgcn_s_barrier()
#define PG8_SCHED __builtin_amdgcn_sched_barrier(0)
    Unit cur, nxt; int ui = 0;
    if (!S.next(0, cur)) return;
    f32x4 acc[2][2][4][2];
#pragma unroll
    for (int a = 0; a < 2; ++a)
#pragma unroll
        for (int b = 0; b < 2; ++b)
#pragma unroll
            for (int m = 0; m < 4; ++m)
#pragma unroll
                for (int n = 0; n < 2; ++n) acc[a][b][m][n] = (f32x4){0.f, 0.f, 0.f, 0.f};
    bf16x8 At[4][2], B0[2][2], B1[2][2];
    const char* cA = (const char*)g.A + (size_t)cur.pm * tstepA; const char* cB = (const char*)g.Bt + (size_t)cur.pn * tstepB;
    S.a_ready(cur);
    if constexpr (SP2) {
        PG8_STAGE(PG8_SB(0, 0), cB, voffB); PG8_STAGE(PG8_SB(0, 1), cB + hstepB, voffB); PG8_STAGE(PG8_SA(0, 0), cA, voffA); PG8_STAGE(PG8_SA(0, 1), cA + hstepA, voffA);
        if (wr == 1) PG8_BAR;
        PG8_WAIT_V(2); PG8_BAR;
        PG8_STAGE(PG8_SB(1, 0), cB + kstep, voffB); PG8_STAGE(PG8_SA(1, 0), cA + kstep, voffA); PG8_STAGE(PG8_SB(1, 1), cB + hstepB + kstep, voffB);
        PG8_WAIT_V(6); PG8_BAR;
    } else {
        PG8_STAGE(PG8_SB(0, 0), cB, voffB); PG8_STAGE(PG8_SA(0, 0), cA, voffA); PG8_STAGE(PG8_SB(0, 1), cB + hstepB, voffB); PG8_STAGE(PG8_SA(0, 1), cA + hstepA, voffA);
        if (wr == 1) PG8_BAR;
        PG8_WAIT_V(4); PG8_BAR;
        PG8_STAGE(PG8_SB(1, 0), cB + kstep, voffB); PG8_STAGE(PG8_SA(1, 0), cA + kstep, voffA); PG8_STAGE(PG8_SB(1, 1), cB + hstepB + kstep, voffB);
        PG8_WAIT_V(6); PG8_BAR;
    }
    for (;;) {
        const bool has_next = S.next(ui + 1, nxt);
        const char* nA = has_next ? (const char*)g.A + (size_t)nxt.pm * tstepA : cA; const char* nB = has_next ? (const char*)g.Bt + (size_t)nxt.pn * tstepB : cB;
        for (int t = 0; t < nt; t += 2) {
            const bool last = (t == nt - 2);
            const char* a1 = cA + (size_t)(t + 1) * kstep;
            const char* a2 = last ? nA : cA + (size_t)(t + 2) * kstep; const char* b2 = last ? nB : cB + (size_t)(t + 2) * kstep;
            const char* a3 = a2 + kstep; const char* b3 = b2 + kstep;
            if (last && has_next) S.a_ready(nxt);
            if constexpr (SP2) {
            PG8_LDB(B0, 0, 0); PG8_LDB(B1, 0, 1); PG8_SCHED; PG8_LDA(At, 0, 0); PG8_STAGE(PG8_SA(1, 1), a1 + hstepA, voffA);
            PG8_WAIT_V(8); PG8_WAIT_L(0); PG8_BAR; PG8_MMA(0, 0, At, B0); PG8_MMA(0, 1, At, B1); PG8_BAR; PG8_SCHED;
            PG8_LDA(At, 0, 1); PG8_STAGE(PG8_SB(0, 0), b2, voffB); PG8_STAGE(PG8_SB(0, 1), b2 + hstepB, voffB); PG8_STAGE(PG8_SA(0, 0), a2, voffA);
            PG8_WAIT_V(8); PG8_WAIT_L(0); PG8_BAR; PG8_MMA(1, 0, At, B0); PG8_MMA(1, 1, At, B1); PG8_BAR; PG8_SCHED;
            PG8_LDB(B0, 1, 0); PG8_LDB(B1, 1, 1); PG8_SCHED; PG8_LDA(At, 1, 0); PG8_STAGE(PG8_SA(0, 1), a2 + hstepA, voffA);
            PG8_WAIT_V(8); PG8_WAIT_L(0); PG8_BAR; PG8_MMA(0, 0, At, B0); PG8_MMA(0, 1, At, B1); PG8_BAR; PG8_SCHED;
            PG8_LDA(At, 1, 1); PG8_STAGE(PG8_SB(1, 0), b3, voffB); PG8_STAGE(PG8_SB(1, 1), b3 + hstepB, voffB); PG8_STAGE(PG8_SA(1, 0), a3, voffA);
            PG8_WAIT_V(8); PG8_WAIT_L(0); PG8_BAR; PG8_MMA(1, 0, At, B0); PG8_MMA(1, 1, At, B1); PG8_BAR; PG8_SCHED;
            } else {
            PG8_LDB(B0, 0, 0); PG8_SCHED; PG8_LDA(At, 0, 0); PG8_STAGE(PG8_SA(1, 1), a1 + hstepA, voffA);
            PG8_WAIT_L(8); PG8_BAR; PG8_WAIT_L(0); PG8_MMA(0, 0, At, B0); PG8_BAR; PG8_SCHED;
            PG8_LDB(B1, 0, 1); PG8_STAGE(PG8_SB(0, 0), b2, voffB);
            PG8_BAR; PG8_WAIT_L(0); PG8_MMA(0, 1, At, B1); PG8_BAR;
            PG8_LDA(At, 0, 1); PG8_STAGE(PG8_SA(0, 0), a2, voffA);
            PG8_BAR; PG8_WAIT_L(0); PG8_MMA(1, 0, At, B0); PG8_BAR; PG8_SCHED;
            PG8_STAGE(PG8_SB(0, 1), b2 + hstepB, voffB);
            PG8_WAIT_V(6); PG8_BAR; PG8_MMA(1, 1, At, B1); PG8_BAR;
            PG8_LDB(B0, 1, 0); PG8_SCHED; PG8_LDA(At, 1, 0); PG8_STAGE(PG8_SA(0, 1), a2 + hstepA, voffA);
            PG8_WAIT_L(8); PG8_BAR; PG8_WAIT_L(0); PG8_MMA(0, 0, At, B0); PG8_BAR; PG8_SCHED;
            PG8_LDB(B1, 1, 1); PG8_STAGE(PG8_SB(1, 0), b3, voffB);
            PG8_BAR; PG8_WAIT_L(0); PG8_MMA(0, 1, At, B1); PG8_BAR;
            PG8_LDA(At, 1, 1); PG8_STAGE(PG8_SA(1, 0), a3, voffA);
            PG8_BAR; PG8_WAIT_L(0); PG8_MMA(1, 0, At, B0); PG8_BAR; PG8_SCHED;
            PG8_STAGE(PG8_SB(1, 1), b3 + hstepB, voffB);
            PG8_WAIT_V(6); PG8_BAR; PG8_MMA(1, 1, At, B1); PG8_BAR;
            }
        }
        if constexpr (ALIGN_EPI) { if (wr == 0) PG8_BAR; }
        if constexpr (!Epi::AFTER_DRAIN) { E(acc, cur, wr, wc, fr, fq); S.done(cur); }
        if (!has_next) break;
#pragma unroll
        for (int a = 0; a < 2; ++a)
#pragma unroll
            for (int b = 0; b < 2; ++b)
#pragma unroll
                for (int m = 0; m < 4; ++m)
#pragma unroll
                    for (int n = 0; n < 2; ++n) acc[a][b][m][n] = (f32x4){0.f, 0.f, 0.f, 0.f};
        cur = nxt; cA = nA; cB = nB; ++ui;
        if constexpr (ALIGN_EPI) { if (wr == 1) PG8_BAR; }
    }
    PG8_WAIT_V(0);
    if constexpr (!ALIGN_EPI) { if (wr == 0) PG8_BAR; }
    PG8_BAR;
#undef PG8_SA
#undef PG8_SB
#undef PG8_STAGE
#undef PG8_LDA
#undef PG8_LDB
#undef PG8_MMA
#undef PG8_WAIT_V
#undef PG8_WAIT_L
#undef PG8_BAR
#undef PG8_SCHED
}

template <int MODE> struct Epi {
    static constexpr bool PERM = false, AFTER_DRAIN = false;
    const float* rowsrc; float inv_n; float* ss; bf16_t* ob; int ldc; float* of; const float* xin;
    __device__ __forceinline__ void operator()(const f32x4 (&acc)[2][2][4][2], const Unit& u, int wr, int wc, int fr, int fq) const {
#pragma unroll
        for (int ai = 0; ai < 2; ++ai)
#pragma unroll
            for (int m = 0; m < 4; ++m) {
                const int row = u.pm * BM + ai * HALF + wr * 64 + m * 16 + fr;
                float rs = 1.f;
                if (MODE == 1) rs = rowsrc[row];
                if (MODE == 2 || MODE == 5) rs = rsqrtf(rowsrc[row] * inv_n + EPS);
                float ssq = 0.f;
#pragma unroll
                for (int bj = 0; bj < 2; ++bj)
#pragma unroll
                    for (int n = 0; n < 2; ++n) {
                        const int col = u.pn * BM + bj * HALF + wc * 32 + n * 16 + fq * 4;
                        f32x4 v = acc[ai][bj][m][n] * rs;
                        if (MODE == 1) { if (u.pn < 8) { v[0] = gelu_tanh(v[0]); v[1] = gelu_tanh(v[1]); v[2] = gelu_tanh(v[2]); v[3] = gelu_tanh(v[3]); } }
                        if (MODE == 4) { const f32x4 xr = *(const f32x4*)(xin + (size_t)row * DM + col); v = v + xr; }
                        if (MODE == 1 || MODE == 4) ssq += (v[0] * v[0] + v[1] * v[1]) + (v[2] * v[2] + v[3] * v[3]);
                        if (MODE == 1 || MODE == 2 || MODE == 4) { u32x2 w; w.x = pk2(v[0], v[1]); w.y = pk2(v[2], v[3]); *(u32x2*)(ob + (size_t)row * ldc + col) = w; }
                        if (MODE == 4 || MODE == 5) *(f32x4*)(of + (size_t)row * DM + col) = v;
                    }
                if (MODE == 1) {
                    const int seg = (u.pn >= 4 && u.pn < 8) ? 0 : ((u.pn == 8 || u.pn == 9) ? 1 : (u.pn == 10 ? 2 : -1));
                    if (seg >= 0) { ssq += __shfl_xor(ssq, 16); ssq += __shfl_xor(ssq, 32); if (fq == 0) atomicAdd(ss + seg * S + row, ssq); }
                }
                if (MODE == 4) { ssq += __shfl_xor(ssq, 16); ssq += __shfl_xor(ssq, 32); if (fq == 0) atomicAdd(ss + row, ssq); }
            }
    }
};
}

#define XB_TMO      128
#define XB_XCNT(j)  (256  + 64 * (j))
#define XB_XSUB(j)  (1280 + 64 * (j))
#define XB_XGEN(j)  (2304 + 64 * (j))
#define XB_TOP      3328
#define XB_TOPGEN   3392
#define XCD_BAR_WORDS 3456
#define XB_SPIN_CAP (1u << 18)
__device__ __forceinline__ unsigned xb_ld(unsigned* p)              { return __hip_atomic_load(p, __ATOMIC_RELAXED, __HIP_MEMORY_SCOPE_AGENT); }
__device__ __forceinline__ unsigned xb_add(unsigned* p, unsigned v) { return __hip_atomic_fetch_add(p, v, __ATOMIC_RELAXED, __HIP_MEMORY_SCOPE_AGENT); }
__device__ __forceinline__ unsigned xb_xcc_id() { return (unsigned)__builtin_amdgcn_s_getreg((3 << 11) | 20) & 0xFu; }
#define XB_SPIN(cond, bar) do { unsigned _sp = 0; while (cond) { __builtin_amdgcn_s_sleep(1); \
    if ((++_sp & 255u) == 0u) { if (xb_ld(&(bar)[XB_TMO])) break; if (_sp > XB_SPIN_CAP) { atomicAdd(&(bar)[XB_TMO], 1u); break; } } } } while (0)
struct XcdBarrier { unsigned* bar; unsigned x; volatile LAS unsigned* st; };
__device__ __forceinline__ XcdBarrier xcd_barrier_post(unsigned* bar, volatile LAS unsigned* st) {
    XcdBarrier b; b.bar = bar; b.x = xb_xcc_id(); b.st = st;
    if (threadIdx.x == 0) (void)xb_add(&bar[XB_XCNT(b.x)], 1u);
    return b;
}
__device__ __forceinline__ void xcd_barrier_complete(unsigned* bar, unsigned x, unsigned& nloc, unsigned& nx) {
    const unsigned G = gridDim.x * gridDim.y * gridDim.z;
    unsigned sum, cnt, mine, sp = 0u;
    for (;;) {
        sum = 0u; cnt = 0u; mine = 0u;
#pragma unroll
        for (unsigned j = 0; j < 16; ++j) { const unsigned c = xb_ld(&bar[XB_XCNT(j)]); sum += c; cnt += (c > 0u) ? 1u : 0u; mine = (j == x) ? c : mine; }
        if (sum == G) break;
        __builtin_amdgcn_s_sleep(1);
        if ((++sp & 255u) == 0u) { if (xb_ld(&bar[XB_TMO])) break; if (sp > XB_SPIN_CAP) { atomicAdd(&bar[XB_TMO], 1u); break; } }
    }
    nloc = mine > 0u ? mine : 1u; nx = cnt > 0u ? cnt : 1u;
}
__device__ __forceinline__ void xcd_barrier(const XcdBarrier& b) {
    asm volatile("s_waitcnt vmcnt(0)" ::: "memory");
    __syncthreads();
    if (threadIdx.x == 0) {
        unsigned* bar = b.bar;
        __builtin_amdgcn_s_waitcnt(0);
        unsigned nloc = b.st[0], nx = b.st[1];
        if (nloc == 0u) { xcd_barrier_complete(bar, b.x, nloc, nx); b.st[0] = nloc; b.st[1] = nx; }
        const unsigned old = xb_add(&bar[XB_XSUB(b.x)], 1u);
        const unsigned gen = old / nloc;
        if (old + 1u == (gen + 1u) * nloc) {
            __builtin_amdgcn_fence(__ATOMIC_RELEASE, "agent");
            asm volatile("s_waitcnt vmcnt(0)" ::: "memory");
            const unsigned og = xb_add(&bar[XB_TOP], 1u);
            const unsigned tg = og / nx;
            if (og + 1u == (tg + 1u) * nx) xb_add(&bar[XB_TOPGEN], 1u);
            else XB_SPIN(xb_ld(&bar[XB_TOPGEN]) == tg, bar);
            __builtin_amdgcn_fence(__ATOMIC_ACQUIRE, "agent");
            xb_add(&bar[XB_XGEN(b.x)], 1u);
            asm volatile("s_waitcnt vmcnt(0)" ::: "memory");
        } else {
            XB_SPIN(xb_ld(&bar[XB_XGEN(b.x)]) == gen, bar);
            __builtin_amdgcn_fence(__ATOMIC_ACQUIRE, "agent");
            asm volatile("s_waitcnt vmcnt(0)" ::: "memory");
        }
    }
    __syncthreads();
}

struct Params {
    const float* in[18];
    float* out;
    unsigned char* ws;
    int ph_lo, ph_hi;
};

__device__ __forceinline__ void p0_transpose_item(const float* W, const float* g, int K, int N, bf16_t* WT, LAS float* scr, int item, int lane) {
    const int nblk = N / 32, kb = item / nblk, nb = item % nblk, k0 = 64 * kb, n0 = 32 * nb;
    float wv[32];
#pragma unroll
    for (int i = 0; i < 32; ++i) { const int kk = 2 * i + (lane >> 5); wv[i] = W[(size_t)(k0 + kk) * N + n0 + (lane & 31)]; }
#pragma unroll
    for (int i = 0; i < 32; ++i) { const int kk = 2 * i + (lane >> 5); const float gv = g ? g[k0 + kk] : 1.f; scr[kk * 33 + (lane & 31)] = wv[i] * gv; }
    LDS_WAIT(); asm volatile("" ::: "memory");
    const int c = lane & 7;
#pragma unroll
    for (int j = 0; j < 4; ++j) { const int n = (lane >> 3) + 8 * j; const LAS float* s = scr + (8 * c) * 33 + n;
        u32x4 o; o.x = pk2(s[0 * 33], s[1 * 33]); o.y = pk2(s[2 * 33], s[3 * 33]); o.z = pk2(s[4 * 33], s[5 * 33]); o.w = pk2(s[6 * 33], s[7 * 33]);
        *(u32x4*)(WT + (size_t)(n0 + n) * K + k0 + 8 * c) = o; }
    LDS_WAIT(); asm volatile("" ::: "memory");
}
__device__ __forceinline__ float row_to_bf16(const float* src, const float* g, bf16_t* dst, int lane) {
    float ss = 0.f;
#pragma unroll
    for (int i = 0; i < 8; ++i) {
        const int c = (i * 64 + lane) * 4;
        f32x4 v = *(const f32x4*)(src + c);
        ss += (v[0] * v[0] + v[1] * v[1]) + (v[2] * v[2] + v[3] * v[3]);
        if (g) { const f32x4 gv = *(const f32x4*)(g + c); v = v * gv; }
        u32x2 w; w.x = pk2(v[0], v[1]); w.y = pk2(v[2], v[3]);
        *(u32x2*)(dst + c) = w;
    }
    return ss;
}
constexpr float PEER_USC = 80.0f, PEER_VSC = 5.0f;
constexpr int PEER_ROWB = 1536;
typedef float f32x16v __attribute__((ext_vector_type(16)));
typedef float f32x32v __attribute__((ext_vector_type(32)));
typedef unsigned u32x6 __attribute__((ext_vector_type(6)));
__device__ __forceinline__ void fp6_pack_store(const f32x4 (&x)[8], const f32x4 (&sc)[8], unsigned char* dst, int lane) {
    f32x16v a, b;
#pragma unroll
    for (int i = 0; i < 8; ++i) {
        const f32x4 y = x[i] * sc[i];
#pragma unroll
        for (int q = 0; q < 4; ++q) { const float c = fminf(fmaxf(y[q], -7.5f), 7.5f); const int sl = 4 * i + q; if ((sl & 1) == 0) a[sl >> 1] = c; else b[sl >> 1] = c; }
    }
    const u32x6 pk = __builtin_amdgcn_cvt_scalef32_2xpk16_fp6_f32(a, b, 1.0f);
    *(u32x4*)(dst + lane * 16) = (u32x4){pk[0], pk[1], pk[2], pk[3]};
    *(u32x2*)(dst + 1024 + lane * 8) = (u32x2){pk[4], pk[5]};
}
__device__ __forceinline__ void rows2_to_fp6(const float* s0, const float* s1, const f32x4 (&sc)[8], unsigned char* d0, unsigned char* d1, int lane) {
    f32x4 x0[8], x1[8];
#pragma unroll
    for (int i = 0; i < 8; ++i) { x0[i] = *(const f32x4*)(s0 + (i * 64 + lane) * 4); x1[i] = *(const f32x4*)(s1 + (i * 64 + lane) * 4); }
    fp6_pack_store(x0, sc, d0, lane); fp6_pack_store(x1, sc, d1, lane);
}
__device__ __forceinline__ bf16x8 cvt8(const float* p) {
    const f32x4 a = *(const f32x4*)p, b = *(const f32x4*)(p + 4);
    u32x4 w; w.x = pk2(a[0], a[1]); w.y = pk2(a[2], a[3]); w.z = pk2(b[0], b[1]); w.w = pk2(b[2], b[3]);
    return __builtin_bit_cast(bf16x8, w);
}

__device__ __forceinline__ void prep_late(const Params& p, LAS unsigned char* lds, int gw, int NGW, int wave, int lane) {
    unsigned char* ws = p.ws;
    LAS float* scr = (LAS float*)(lds + wave * 16384);
    {
        constexpr int I_UQ = (512 / 64) * (1536 / 32), I_UKV = (256 / 64) * (2048 / 32), I_OUT = (DM / 64) * (DM / 32);
        constexpr int NIT = I_UQ + I_UKV + I_OUT;
        for (int it = gw; it < NIT; it += NGW) {
            int r = it;
            if (r < I_UQ) { p0_transpose_item(p.in[7], p.in[6], 512, 1536, (bf16_t*)(ws + WS_WUQ), scr, r, lane); continue; } r -= I_UQ;
            if (r < I_UKV) { p0_transpose_item(p.in[9], p.in[8], 256, 2048, (bf16_t*)(ws + WS_WUKV), scr, r, lane); continue; } r -= I_UKV;
            p0_transpose_item(p.in[12], nullptr, DM, DM, (bf16_t*)(ws + WS_WOUT), scr, r, lane);
        }
    }
    {
        const float* wq = p.in[14]; const float* sk = p.in[15]; const float* g2 = p.in[13];
        bf16_t* WsT = (bf16_t*)(ws + WS_WS);
        const int r32 = lane & 31, hh = lane >> 5;
        for (int it = gw; it < 16 * 4 * 64; it += NGW) {
            const int hp = it >> 8, kb = (it >> 6) & 3, nb = it & 63;
            f32x16 acc = {};
            const float* ap = sk + ((size_t)(hp * 128 + kb * 32 + r32)) * 128 + hh * 8;
            const float* bp = wq + ((size_t)(nb * 32 + r32)) * DM + hp * 128 + hh * 8;
#pragma unroll
            for (int s = 0; s < 8; ++s) {
                const bf16x8 a = cvt8(ap + s * 16), b = cvt8(bp + s * 16);
                acc = __builtin_amdgcn_mfma_f32_32x32x16_bf16(a, b, acc, 0, 0, 0);
            }
            const int kcol = nb * 32 + r32; const float gk = g2[kcol];
#pragma unroll
            for (int r = 0; r < 16; ++r) WsT[(size_t)(hp * 128 + kb * 32 + crow(r, hh)) * DM + kcol] = (bf16_t)f2bf(acc[r] * gk);
        }
    }
    {
        float* ct = (float*)(ws + WS_COS); float* st = (float*)(ws + WS_SIN);
        for (int it = gw; it < S * 32 / 64; it += NGW) {
            const int idx = it * 64 + lane, t = idx >> 5, j = idx & 31;
            const float inv_freq = powf(10000.0f, -(float)j / 32.0f);
            const float ang = (float)t * inv_freq;
            float sv, cv; sincosf(ang, &sv, &cv); ct[idx] = cv; st[idx] = sv;
        }
    }
}
__device__ __forceinline__ void phase0(const Params& p, LAS unsigned char* lds, bool late_ok, int gw, int NGW, int wave, int lane) {
    unsigned char* ws = p.ws;
    LAS float* scr = (LAS float*)(lds + wave * 16384);
    const float* x = p.in[0];
    {
        constexpr int I_IN = (DM / 64) * (NIN / 32);
        for (int it = gw; it < I_IN; it += NGW) p0_transpose_item(p.in[2], p.in[1], DM, NIN, (bf16_t*)(ws + WS_WIN), scr, it, lane);
    }
    if (!late_ok) prep_late(p, lds, gw, NGW, wave, lane);
    for (int r = gw; r < NINP - NIN; r += NGW) {
        bf16_t* d = (bf16_t*)(ws + WS_WIN) + (size_t)(NIN + r) * DM;
#pragma unroll
        for (int i = 0; i < 4; ++i) *(u32x4*)(d + (i * 64 + lane) * 8) = (u32x4){0u, 0u, 0u, 0u};
    }
    {
        bf16_t* xb = (bf16_t*)(ws + WS_XB); float* rstd1 = (float*)(ws + WS_RSTD1);
        for (int t = gw; t + NGW < S; t += 2 * NGW) {
            const int t1 = t + NGW;
            f32x4 a[8], b[8];
#pragma unroll
            for (int i = 0; i < 8; ++i) { a[i] = *(const f32x4*)(x + (size_t)t * DM + (i * 64 + lane) * 4); b[i] = *(const f32x4*)(x + (size_t)t1 * DM + (i * 64 + lane) * 4); }
            float sa = 0.f, sb = 0.f;
#pragma unroll
            for (int i = 0; i < 8; ++i) {
                sa += (a[i][0] * a[i][0] + a[i][1] * a[i][1]) + (a[i][2] * a[i][2] + a[i][3] * a[i][3]);
                sb += (b[i][0] * b[i][0] + b[i][1] * b[i][1]) + (b[i][2] * b[i][2] + b[i][3] * b[i][3]);
                u32x2 wa, wb; wa.x = pk2(a[i][0], a[i][1]); wa.y = pk2(a[i][2], a[i][3]); wb.x = pk2(b[i][0], b[i][1]); wb.y = pk2(b[i][2], b[i][3]);
                *(u32x2*)(xb + (size_t)t * DM + (i * 64 + lane) * 4) = wa; *(u32x2*)(xb + (size_t)t1 * DM + (i * 64 + lane) * 4) = wb;
            }
            sa = wave_sum(sa); sb = wave_sum(sb);
            if (lane == 0) { rstd1[t] = rsqrtf(sa * (1.0f / DM) + EPS); rstd1[t1] = rsqrtf(sb * (1.0f / DM) + EPS); }
        }
    }
    {
        unsigned char* UT = ws + WS_UT; unsigned char* VT = ws + WS_VT;
        f32x4 sc[8];
#pragma unroll
        for (int i = 0; i < 8; ++i) sc[i] = *(const f32x4*)(p.in[13] + (i * 64 + lane) * 4) * PEER_USC;
        for (int e = gw; e + NGW < 16384; e += 2 * NGW)
            rows2_to_fp6(p.in[16] + (size_t)e * DM, p.in[16] + (size_t)(e + NGW) * DM, sc, UT + (size_t)e * PEER_ROWB, UT + (size_t)(e + NGW) * PEER_ROWB, lane);
#pragma unroll
        for (int i = 0; i < 8; ++i) sc[i] = (f32x4){PEER_VSC, PEER_VSC, PEER_VSC, PEER_VSC};
        for (int e = gw; e + NGW < 16384; e += 2 * NGW)
            rows2_to_fp6(p.in[17] + (size_t)e * DM, p.in[17] + (size_t)(e + NGW) * DM, sc, VT + (size_t)e * PEER_ROWB, VT + (size_t)(e + NGW) * PEER_ROWB, lane);
    }
}

__device__ __forceinline__ void phase3(const Params& p, int gw, int NGW, int lane) {
    unsigned char* ws = p.ws;
    const bf16_t* qraw = (const bf16_t*)(ws + WS_QRAW); const bf16_t* kvraw = (const bf16_t*)(ws + WS_KVRAW); const bf16_t* proj = (const bf16_t*)(ws + WS_PROJ);
    bf16_t* Qh = (bf16_t*)(ws + WS_QH); bf16_t* Kh = (bf16_t*)(ws + WS_KH); bf16_t* Vh = (bf16_t*)(ws + WS_VH);
    const float* ct = (const float*)(ws + WS_COS); const float* st = (const float*)(ws + WS_SIN);
    const bool act = lane < 48, isrope = lane >= 32 && lane < 48, lowhalf = lane < 40;
    const int e0 = act ? 4 * lane : 0;
    const f32x4 gq = *(const f32x4*)(p.in[10] + e0), gk = *(const f32x4*)(p.in[11] + e0);
    const int j0 = isrope ? ((4 * lane - 128) & 31) : 0;
    constexpr float QS = 0.07216878364870322f * 1.4426950408889634f;
    for (int t = gw; t < S; t += NGW) {
        f32x4 cs = {1.f, 1.f, 1.f, 1.f}, sn = {0.f, 0.f, 0.f, 0.f};
        if (isrope) { cs = *(const f32x4*)(ct + t * 32 + j0); sn = *(const f32x4*)(st + t * 32 + j0); }
        u32x2 krw = {0u, 0u};
        if (isrope) krw = *(const u32x2*)(proj + (size_t)t * NINP + 2816 + (4 * lane - 128));
        const f32x4 krope = {bflo(krw.x), bfhi(krw.x), bflo(krw.y), bfhi(krw.y)};
#pragma unroll
        for (int h = 0; h < 8; ++h) {
            u32x2 qw = {0u, 0u};
            if (act) qw = *(const u32x2*)(qraw + (size_t)t * 1536 + h * 192 + e0);
            f32x4 q = {bflo(qw.x), bfhi(qw.x), bflo(qw.y), bfhi(qw.y)};
            float ss = wave_sum_u((q[0] * q[0] + q[1] * q[1]) + (q[2] * q[2] + q[3] * q[3]));
            float rs = rsqrtf(ss * (1.0f / 192.0f) + EPS);
            q = q * gq * rs;
            {
                f32x4 pr;
#pragma unroll
                for (int c = 0; c < 4; ++c) pr[c] = __shfl_xor(q[c], 8);
                const f32x4 r1 = q * cs - pr * sn, r2 = pr * sn + q * cs;
                if (isrope) q = lowhalf ? r1 : r2;
            }
            q = q * QS;
            if (act) { u32x2 w; w.x = pk2(q[0], q[1]); w.y = pk2(q[2], q[3]); *(u32x2*)(Qh + ((size_t)h * S + t) * 192 + e0) = w; }
            u32x2 kw = {0u, 0u}, vw = {0u, 0u};
            if (lane < 32) { kw = *(const u32x2*)(kvraw + (size_t)t * 2048 + h * 256 + e0); vw = *(const u32x2*)(kvraw + (size_t)t * 2048 + h * 256 + 128 + e0); }
            f32x4 k = {bflo(kw.x), bfhi(kw.x), bflo(kw.y), bfhi(kw.y)};
            if (isrope) k = krope;
            ss = wave_sum_u((k[0] * k[0] + k[1] * k[1]) + (k[2] * k[2] + k[3] * k[3]));
            rs = rsqrtf(ss * (1.0f / 192.0f) + EPS);
            k = k * gk * rs;
            {
                f32x4 pr;
#pragma unroll
                for (int c = 0; c < 4; ++c) pr[c] = __shfl_xor(k[c], 8);
                const f32x4 r1 = k * cs - pr * sn, r2 = pr * sn + k * cs;
                if (isrope) k = lowhalf ? r1 : r2;
            }
            if (act) { u32x2 w; w.x = pk2(k[0], k[1]); w.y = pk2(k[2], k[3]); *(u32x2*)(Kh + ((size_t)h * S + t) * 192 + e0) = w; }
            if (lane < 32) *(u32x2*)(Vh + ((size_t)h * S + t) * 128 + e0) = vw;
        }
    }
}

constexpr int KP = 400, VP = 320;
template <int OFF> __device__ __forceinline__ s16x4 tr_read(unsigned addr) {
    s16x4 r; asm volatile("ds_read_b64_tr_b16 %0, %1 offset:%2" : "=&v"(r) : "v"(addr), "i"(OFF) : "memory"); return r;
}
__device__ __forceinline__ unsigned cvtpk(float lo, float hi) { unsigned r; asm volatile("v_cvt_pk_bf16_f32 %0, %1, %2" : "=v"(r) : "v"(lo), "v"(hi)); return r; }
#define PK8(L, H) ((bf16x8){L[0], L[1], L[2], L[3], H[0], H[1], H[2], H[3]})
constexpr float ATT_THR = 8.0f;

constexpr int ATT_KB = 64 * KP, ATT_VB = 64 * VP;
constexpr int ATT_VOFF = 2 * ATT_KB;
__device__ __forceinline__ float xhalf_max(float v) {
    auto rr = __builtin_amdgcn_permlane32_swap(__builtin_bit_cast(unsigned, v), __builtin_bit_cast(unsigned, v), false, false);
    return fmaxf(__builtin_bit_cast(float, rr[0]), __builtin_bit_cast(float, rr[1]));
}
__device__ __forceinline__ float xhalf_sum(float v) {
    auto rr = __builtin_amdgcn_permlane32_swap(__builtin_bit_cast(unsigned, v), __builtin_bit_cast(unsigned, v), false, false);
    return __builtin_bit_cast(float, rr[0]) + __builtin_bit_cast(float, rr[1]);
}
template <int OFF> __device__ __forceinline__ bf16x8 lds_read128(unsigned addr) {
    bf16x8 r; asm volatile("ds_read_b128 %0, %1 offset:%2" : "=&v"(r) : "v"(addr), "i"(OFF) : "memory"); return r;
}
#define LGKM_WAIT(n) do { asm volatile("s_waitcnt lgkmcnt(" #n ")" ::: "memory"); SBAR(); } while (0)
__device__ __forceinline__ f32x16 att_qk(unsigned kaddr, const bf16x8 (&qr)[12]) {
    f32x16 p = {};
    bf16x8 a0 = lds_read128<0>(kaddr), a1 = lds_read128<32>(kaddr), a2 = lds_read128<64>(kaddr), a3 = lds_read128<96>(kaddr);
    LGKM_WAIT(3); p = __builtin_amdgcn_mfma_f32_32x32x16_bf16(a0, qr[0], p, 0, 0, 0); a0 = lds_read128<128>(kaddr);
    LGKM_WAIT(3); p = __builtin_amdgcn_mfma_f32_32x32x16_bf16(a1, qr[1], p, 0, 0, 0); a1 = lds_read128<160>(kaddr);
    LGKM_WAIT(3); p = __builtin_amdgcn_mfma_f32_32x32x16_bf16(a2, qr[2], p, 0, 0, 0); a2 = lds_read128<192>(kaddr);
    LGKM_WAIT(3); p = __builtin_amdgcn_mfma_f32_32x32x16_bf16(a3, qr[3], p, 0, 0, 0); a3 = lds_read128<224>(kaddr);
    LGKM_WAIT(3); p = __builtin_amdgcn_mfma_f32_32x32x16_bf16(a0, qr[4], p, 0, 0, 0); a0 = lds_read128<256>(kaddr);
    LGKM_WAIT(3); p = __builtin_amdgcn_mfma_f32_32x32x16_bf16(a1, qr[5], p, 0, 0, 0); a1 = lds_read128<288>(kaddr);
    LGKM_WAIT(3); p = __builtin_amdgcn_mfma_f32_32x32x16_bf16(a2, qr[6], p, 0, 0, 0); a2 = lds_read128<320>(kaddr);
    LGKM_WAIT(3); p = __builtin_amdgcn_mfma_f32_32x32x16_bf16(a3, qr[7], p, 0, 0, 0); a3 = lds_read128<352>(kaddr);
    LGKM_WAIT(3); p = __builtin_amdgcn_mfma_f32_32x32x16_bf16(a0, qr[8], p, 0, 0, 0);
    LGKM_WAIT(2); p = __builtin_amdgcn_mfma_f32_32x32x16_bf16(a1, qr[9], p, 0, 0, 0);
    LGKM_WAIT(1); p = __builtin_amdgcn_mfma_f32_32x32x16_bf16(a2, qr[10], p, 0, 0, 0);
    LGKM_WAIT(0); p = __builtin_amdgcn_mfma_f32_32x32x16_bf16(a3, qr[11], p, 0, 0, 0);
    return p;
}
__device__ __forceinline__ void att_finish(f32x16& s, float m, float& lsum, bf16x8& pb0, bf16x8& pb1) {
    float ps = 0.f;
#pragma unroll
    for (int r = 0; r < 16; ++r) { s[r] = __builtin_amdgcn_exp2f(s[r] - m); ps += s[r]; }
    lsum += xhalf_sum(ps);
    u32x4 w0 = {cvtpk(s[0], s[1]), cvtpk(s[2], s[3]), cvtpk(s[4], s[5]), cvtpk(s[6], s[7])};
    u32x4 w1 = {cvtpk(s[8], s[9]), cvtpk(s[10], s[11]), cvtpk(s[12], s[13]), cvtpk(s[14], s[15])};
    pb0 = __builtin_bit_cast(bf16x8, w0); pb1 = __builtin_bit_cast(bf16x8, w1);
}
__device__ __forceinline__ void att_pv(unsigned vaddr, bf16x8 pb0, bf16x8 pb1, f32x16 (&o)[4]) {
#define VOFF(d0, s, hi) (((16 * (s) + 8 * (hi)) * VP) + 64 * (d0))
    const s16x4 a00l = tr_read<VOFF(0, 0, 0)>(vaddr), a00h = tr_read<VOFF(0, 0, 1)>(vaddr), a01l = tr_read<VOFF(0, 1, 0)>(vaddr), a01h = tr_read<VOFF(0, 1, 1)>(vaddr);
    const s16x4 a10l = tr_read<VOFF(1, 0, 0)>(vaddr), a10h = tr_read<VOFF(1, 0, 1)>(vaddr), a11l = tr_read<VOFF(1, 1, 0)>(vaddr), a11h = tr_read<VOFF(1, 1, 1)>(vaddr);
    LGKM_WAIT(4);
    o[0] = __builtin_amdgcn_mfma_f32_32x32x16_bf16(PK8(a00l, a00h), pb0, o[0], 0, 0, 0); o[0] = __builtin_amdgcn_mfma_f32_32x32x16_bf16(PK8(a01l, a01h), pb1, o[0], 0, 0, 0);
    const s16x4 a20l = tr_read<VOFF(2, 0, 0)>(vaddr), a20h = tr_read<VOFF(2, 0, 1)>(vaddr), a21l = tr_read<VOFF(2, 1, 0)>(vaddr), a21h = tr_read<VOFF(2, 1, 1)>(vaddr);
    LGKM_WAIT(4);
    o[1] = __builtin_amdgcn_mfma_f32_32x32x16_bf16(PK8(a10l, a10h), pb0, o[1], 0, 0, 0); o[1] = __builtin_amdgcn_mfma_f32_32x32x16_bf16(PK8(a11l, a11h), pb1, o[1], 0, 0, 0);
    const s16x4 a30l = tr_read<VOFF(3, 0, 0)>(vaddr), a30h = tr_read<VOFF(3, 0, 1)>(vaddr), a31l = tr_read<VOFF(3, 1, 0)>(vaddr), a31h = tr_read<VOFF(3, 1, 1)>(vaddr);
    LGKM_WAIT(4);
    o[2] = __builtin_amdgcn_mfma_f32_32x32x16_bf16(PK8(a20l, a20h), pb0, o[2], 0, 0, 0); o[2] = __builtin_amdgcn_mfma_f32_32x32x16_bf16(PK8(a21l, a21h), pb1, o[2], 0, 0, 0);
    LGKM_WAIT(0);
    o[3] = __builtin_amdgcn_mfma_f32_32x32x16_bf16(PK8(a30l, a30h), pb0, o[3], 0, 0, 0); o[3] = __builtin_amdgcn_mfma_f32_32x32x16_bf16(PK8(a31l, a31h), pb1, o[3], 0, 0, 0);
#undef VOFF
}
__device__ __forceinline__ void att_partial(const f32x16& s, float& m, float& lsum, f32x16 (&o)[4]) {
    float pmax = s[0];
#pragma unroll
    for (int r = 1; r < 16; ++r) pmax = fmaxf(pmax, s[r]);
    pmax = xhalf_max(pmax);
    if (!__all(pmax - m <= ATT_THR)) {
        const float mn = fmaxf(m, pmax); const float alpha = __builtin_amdgcn_exp2f(m - mn); m = mn; lsum *= alpha;
#pragma unroll
        for (int d = 0; d < 4; ++d)
#pragma unroll
            for (int r = 0; r < 16; ++r) o[d][r] *= alpha;
    }
}

__device__ __forceinline__ void attn_unit(const Params& p, LAS unsigned char* lds, int head, int qb, int tid, int wave, int lane) {
    unsigned char* ws = p.ws;
    const bf16_t* Qh = (const bf16_t*)(ws + WS_QH); const bf16_t* Kh = (const bf16_t*)(ws + WS_KH); const bf16_t* Vh = (const bf16_t*)(ws + WS_VH);
    bf16_t* mix = (bf16_t*)(ws + WS_MIX);
    const int rg = wave & 3, kh = wave >> 2, r32 = lane & 31, hh = lane >> 5;
    const int q0row = qb * 128 + rg * 32;
    bf16x8 qr[12];
    {
        const bf16_t* qp = Qh + ((size_t)head * S + q0row + r32) * 192 + hh * 8;
#pragma unroll
        for (int ks = 0; ks < 12; ++ks) qr[ks] = *(const bf16x8*)(qp + ks * 16);
    }
    const int ntiles = 2 * qb + 2, mylast = 2 * qb + (rg >> 1);
    float m = -1e30f, lsum = 0.f; f32x16 o[4] = {};
    const int srow = tid >> 3, sch = tid & 7;
    const int kg0 = srow * 192 + sch * 8, kl0 = srow * KP + sch * 16, vg0 = srow * 128 + sch * 8, vl0 = ATT_VOFF + srow * VP + sch * 16;
    const bf16_t* kbase = Kh + (size_t)head * S * 192; const bf16_t* vbase = Vh + (size_t)head * S * 128;
    u32x4 sk0, sk1, sk2, sv0, sv1;
#define ATT_LOAD(t) do { const bf16_t* kt = kbase + (size_t)(t) * 64 * 192 + kg0; const bf16_t* vt = vbase + (size_t)(t) * 64 * 128 + vg0; \
        sk0 = *(const u32x4*)(kt); sk1 = *(const u32x4*)(kt + 64); sk2 = *(const u32x4*)(kt + 128); sv0 = *(const u32x4*)(vt); sv1 = *(const u32x4*)(vt + 64); } while (0)
#define ATT_WRITE(kb_, vb_) do { LAS unsigned char* bk = lds + (kb_) * ATT_KB + kl0; LAS unsigned char* bv = lds + (vb_) * ATT_VB + vl0; *(LAS u32x4*)(bk) = sk0; *(LAS u32x4*)(bk + 128) = sk1; *(LAS u32x4*)(bk + 256) = sk2; \
        *(LAS u32x4*)(bv) = sv0; *(LAS u32x4*)(bv + 128) = sv1; } while (0)
    const unsigned ldsbase = (unsigned)(size_t)lds;
    const unsigned kaddr0 = ldsbase + (unsigned)((32 * kh + r32) * KP + hh * 16);
    const unsigned vrel = (unsigned)(ATT_VOFF + (32 * kh + 4 * hh + ((lane & 15) >> 2)) * VP + (16 * ((lane >> 4) & 1) + 4 * (lane & 3)) * 2);
    ATT_LOAD(0); ATT_WRITE(0, 0); __syncthreads();
    bf16x8 pb0, pb1;
    const bool more0 = (1 < ntiles);
    if (more0) ATT_LOAD(1);
    f32x16 sprev = att_qk(kaddr0, qr);
    att_partial(sprev, m, lsum, o);
    if (more0) ATT_WRITE(1, 1);
    __syncthreads();
    int vprev = 0, vcur = 1;
#pragma unroll 1
    for (int t = 1; t <= ntiles; ++t) {
        const bool more = (t + 1 < ntiles);
        if (more) ATT_LOAD(t + 1);
        f32x16 sc;
        if (t <= mylast) sc = att_qk(kaddr0 + (t & 1) * ATT_KB, qr);
        else {
#pragma unroll
            for (int r = 0; r < 16; ++r) sc[r] = -1e30f;
        }
        att_finish(sprev, m, lsum, pb0, pb1);
        att_pv(ldsbase + vprev * ATT_VB + vrel, pb0, pb1, o);
        att_partial(sc, m, lsum, o);
        sprev = sc;
        const int vnext = (vcur == 2) ? 0 : vcur + 1;
        if (more) ATT_WRITE((t + 1) & 1, vnext);
        vprev = vcur; vcur = vnext;
        __syncthreads();
    }
#undef ATT_LOAD
#undef ATT_WRITE
    LAS float* scr = (LAS float*)lds + (size_t)rg * 66 * 64 + lane;
    if (kh == 1) {
        scr[0] = m; scr[64] = lsum;
#pragma unroll
        for (int d = 0; d < 4; ++d)
#pragma unroll
            for (int r = 0; r < 16; ++r) scr[(2 + d * 16 + r) * 64] = o[d][r];
    }
    __syncthreads();
    if (kh == 0) {
        const float m2 = scr[0], l2 = scr[64];
        const float mn = fmaxf(m, m2), a1 = __builtin_amdgcn_exp2f(m - mn), a2 = __builtin_amdgcn_exp2f(m2 - mn);
        const float inv = 1.0f / (lsum * a1 + l2 * a2);
        bf16_t* op = mix + (size_t)(q0row + r32) * DM + 1024 + head * 128 + 4 * hh;
#pragma unroll
        for (int d = 0; d < 4; ++d)
#pragma unroll
            for (int g4 = 0; g4 < 4; ++g4) {
                float v[4];
#pragma unroll
                for (int i = 0; i < 4; ++i) { const int r = 4 * g4 + i; v[i] = (o[d][r] * a1 + scr[(2 + d * 16 + r) * 64] * a2) * inv; }
                u32x2 w; w.x = pk2(v[0], v[1]); w.y = pk2(v[2], v[3]);
                *(u32x2*)(op + 32 * d + 8 * g4) = w;
            }
    }
    __syncthreads();
}

__device__ __forceinline__ void gmlp_unit(const Params& p, LAS unsigned char* lds, int nb, int h, int tid, int wave, int lane) {
    unsigned char* ws = p.ws;
    const bf16_t* proj = (const bf16_t*)(ws + WS_PROJ); bf16_t* mix = (bf16_t*)(ws + WS_MIX);
    const float* ssv = (const float*)(ws + WS_ROWSS);
    const float* vg = p.in[3]; const float* wsp = p.in[4]; const float* bs = p.in[5];
#pragma unroll
    for (int i = 0; i < 4; ++i) {
        const int pc = tid + 512 * i, r = pc >> 4, c = pc & 15, t = nb * 128 + r;
        const u32x4 w = *(const u32x4*)(proj + (size_t)t * NINP + 1024 + h * 128 + c * 8);
        const float rs = rsqrtf(ssv[t] * (1.0f / 1024.0f) + EPS);
        const f32x4 g0 = *(const f32x4*)(vg + h * 128 + c * 8), g1 = *(const f32x4*)(vg + h * 128 + c * 8 + 4);
        u32x4 ov;
        ov.x = pk2(bflo(w.x) * rs * g0[0], bfhi(w.x) * rs * g0[1]); ov.y = pk2(bflo(w.y) * rs * g0[2], bfhi(w.y) * rs * g0[3]);
        ov.z = pk2(bflo(w.z) * rs * g1[0], bfhi(w.z) * rs * g1[1]); ov.w = pk2(bflo(w.w) * rs * g1[2], bfhi(w.w) * rs * g1[3]);
        *(LAS u32x4*)(lds + r * VP + c * 16) = ov;
    }
    __syncthreads();
    const int ib = wave & 3, ch = wave >> 2, r32 = lane & 31, hh = lane >> 5;
    const int irow = 32 * ib + r32;
    f32x16 acc0 = {}, acc1 = {};
    const unsigned vaddr = (unsigned)(size_t)lds + (unsigned)((8 * hh + ((lane & 15) >> 2)) * VP + (64 * ch + 16 * ((lane >> 4) & 1) + 4 * (lane & 3)) * 2);
    const float* wrow = wsp + ((size_t)h * 128 + irow) * 128 + hh * 8;
#define GSTEP(s) do { if ((s) < 2 * (ib + 1)) { \
        const f32x4 wa = *(const f32x4*)(wrow + (s) * 16), wb = *(const f32x4*)(wrow + (s) * 16 + 4); const int j0 = (s) * 16 + hh * 8; \
        u32x4 aw; aw.x = pk2(j0 + 0 <= irow ? wa[0] : 0.f, j0 + 1 <= irow ? wa[1] : 0.f); aw.y = pk2(j0 + 2 <= irow ? wa[2] : 0.f, j0 + 3 <= irow ? wa[3] : 0.f); \
        aw.z = pk2(j0 + 4 <= irow ? wb[0] : 0.f, j0 + 5 <= irow ? wb[1] : 0.f); aw.w = pk2(j0 + 6 <= irow ? wb[2] : 0.f, j0 + 7 <= irow ? wb[3] : 0.f); \
        const bf16x8 af = __builtin_bit_cast(bf16x8, aw); \
        const s16x4 b0l = tr_read<(16 * (s)) * VP>(vaddr), b0h = tr_read<(16 * (s) + 4) * VP>(vaddr), b1l = tr_read<(16 * (s)) * VP + 64>(vaddr), b1h = tr_read<(16 * (s) + 4) * VP + 64>(vaddr); \
        LDS_WAIT(); SBAR(); \
        acc0 = __builtin_amdgcn_mfma_f32_32x32x16_bf16(af, PK8(b0l, b0h), acc0, 0, 0, 0); acc1 = __builtin_amdgcn_mfma_f32_32x32x16_bf16(af, PK8(b1l, b1h), acc1, 0, 0, 0); } } while (0)
    GSTEP(0); GSTEP(1); GSTEP(2); GSTEP(3); GSTEP(4); GSTEP(5); GSTEP(6); GSTEP(7);
#undef GSTEP
#pragma unroll
    for (int r = 0; r < 16; ++r) {
        const int i = 32 * ib + crow(r, hh), t = nb * 128 + i; const float b = bs[h * 128 + i];
        const int c0 = h * 128 + 64 * ch + r32;
        const float u0 = bf2f(proj[(size_t)t * NINP + c0]), u1 = bf2f(proj[(size_t)t * NINP + c0 + 32]);
        mix[(size_t)t * DM + c0] = (bf16_t)f2bf(u0 * (acc0[r] + b)); mix[(size_t)t * DM + c0 + 32] = (bf16_t)f2bf(u1 * (acc1[r] + b));
    }
    __syncthreads();
}

__device__ __forceinline__ void phase7(const Params& p, LAS unsigned char* lds, int gw, int NGW, int wave, int lane) {
    unsigned char* ws = p.ws;
    const float* sc = (const float*)(ws + WS_SC); int* ex = (int*)(ws + WS_EXP); float* gt = (float*)(ws + WS_GATE);
    const float NEG = -3.0e38f;
    LAS float* sl = (LAS float*)(lds + wave * 1024);
    const int j8 = lane & 7, g8 = lane >> 3, row = lane >> 4, i16 = lane & 15;
    int ci[4], cj[4]; bool cval[4];
    {
        constexpr int starts[16] = {0, 16, 24, 29, 33, 36, 38, 40, 42, 43, 44, 45, 46, 47, 48, 49};
#pragma unroll
        for (int m = 0; m < 4; ++m) {
            const int c = i16 + 16 * m; int a = 0, st = 0;
#pragma unroll
            for (int i = 1; i < 16; ++i) if (c >= starts[i]) { a = i; st = starts[i]; }
            cval[m] = c < 50; ci[m] = cval[m] ? a : 0; cj[m] = cval[m] ? (c - st) : 0;
        }
    }
    constexpr int NT = S * 2;
    f32x4 nx0, nx1, nx2, nx3;
    if (gw < NT) { const float* b = sc + (size_t)(gw >> 1) * DM + (gw & 1) * 1024 + lane * 16; nx0 = *(const f32x4*)b; nx1 = *(const f32x4*)(b + 4); nx2 = *(const f32x4*)(b + 8); nx3 = *(const f32x4*)(b + 12); }
    for (int it = gw; it < NT; it += NGW) {
        const int t = it >> 1, hh = it & 1;
        float v[16];
#pragma unroll
        for (int q = 0; q < 4; ++q) { v[q] = nx0[q]; v[4 + q] = nx1[q]; v[8 + q] = nx2[q]; v[12 + q] = nx3[q]; }
        if (it + NGW < NT) { const int it2 = it + NGW; const float* b = sc + (size_t)(it2 >> 1) * DM + (it2 & 1) * 1024 + lane * 16;
            nx0 = *(const f32x4*)b; nx1 = *(const f32x4*)(b + 4); nx2 = *(const f32x4*)(b + 8); nx3 = *(const f32x4*)(b + 12); }
#pragma unroll
        for (int m = 0; m < 16; ++m) v[m] = __builtin_bit_cast(float, (__builtin_bit_cast(unsigned, v[m]) & ~127u) | (unsigned)(16 * j8 + m));
        float ra = 0.f, rb = 0.f;
#pragma unroll
        for (int k = 0; k < 16; ++k) {
            float mx = fmaxf(fmaxf(fmaxf(v[0], v[1]), fmaxf(v[2], v[3])), fmaxf(fmaxf(v[4], v[5]), fmaxf(v[6], v[7])));
            mx = fmaxf(mx, fmaxf(fmaxf(fmaxf(v[8], v[9]), fmaxf(v[10], v[11])), fmaxf(fmaxf(v[12], v[13]), fmaxf(v[14], v[15]))));
            mx = fmaxf(mx, dpp_f<0xB1, 0xf>(mx, mx));
            mx = fmaxf(mx, dpp_f<0x4E, 0xf>(mx, mx));
            mx = fmaxf(mx, dpp_f<0x141, 0xf>(mx, mx));
#pragma unroll
            for (int m = 0; m < 16; ++m) v[m] = (v[m] == mx) ? NEG : v[m];
            if (k < 8) ra = (j8 == k) ? mx : ra; else rb = (j8 == k - 8) ? mx : rb;
        }
        sl[g8 * 16 + j8] = ra; sl[g8 * 16 + 8 + j8] = rb;
        LDS_WAIT(); asm volatile("" ::: "memory");
        float cv[4], og[4]; int id[4];
#pragma unroll
        for (int m = 0; m < 4; ++m) {
            const float s1 = sl[(2 * row) * 16 + ci[m]], s2 = sl[(2 * row + 1) * 16 + cj[m]];
            og[m] = cval[m] ? (s1 + s2) : NEG; cv[m] = og[m];
            id[m] = (int)((__builtin_bit_cast(unsigned, s1) & 127u) * 128u + (__builtin_bit_cast(unsigned, s2) & 127u));
        }
        LDS_WAIT(); asm volatile("" ::: "memory");
        float M0 = 0.f;
#pragma unroll
        for (int k = 0; k < 16; ++k) {
            float mx = fmaxf(fmaxf(cv[0], cv[1]), fmaxf(cv[2], cv[3]));
            mx = fmaxf(mx, dpp_f<0xB1, 0xf>(mx, mx));
            mx = fmaxf(mx, dpp_f<0x4E, 0xf>(mx, mx));
            mx = fmaxf(mx, dpp_f<0x141, 0xf>(mx, mx));
            mx = fmaxf(mx, dpp_f<0x140, 0xf>(mx, mx));
            if (k == 0) M0 = mx;
#pragma unroll
            for (int m = 0; m < 4; ++m) cv[m] = (cv[m] == mx) ? NEG : cv[m];
        }
        bool sel[4]; float e[4]; float es = 0.f;
#pragma unroll
        for (int m = 0; m < 4; ++m) { sel[m] = (cv[m] != og[m]); e[m] = sel[m] ? __expf(og[m] - M0) : 0.f; es += e[m]; }
        es += dpp_f<0xB1, 0xf>(0.f, es); es += dpp_f<0x4E, 0xf>(0.f, es); es += dpp_f<0x141, 0xf>(0.f, es); es += dpp_f<0x140, 0xf>(0.f, es);
        const float inv = 1.0f / es;
        int basepos = 0;
        const int head = 4 * hh + row;
#pragma unroll
        for (int m = 0; m < 4; ++m) {
            const unsigned long long bl = __ballot(sel[m]);
            const unsigned rbits = (unsigned)(bl >> (16 * row)) & 0xffffu;
            const int pos = basepos + __popc(rbits & ((1u << i16) - 1u));
            if (sel[m] && pos < 16) { ex[(size_t)t * 128 + head * 16 + pos] = id[m]; gt[(size_t)t * 128 + head * 16 + pos] = e[m] * inv; }
            basepos += __popc(rbits);
        }
    }
}

typedef __bf16 bf16x32v __attribute__((ext_vector_type(32)));
typedef __bf16 bf16x2v __attribute__((ext_vector_type(2)));
typedef float f32x2 __attribute__((ext_vector_type(2)));
#ifndef P8_THROTTLE
#define P8_THROTTLE 0
#endif
constexpr unsigned P8_SLACK = 12;
__device__ __forceinline__ void phase8(const Params& p, LAS unsigned char* lds, float* dst, unsigned xcc, unsigned nwx, int gw, int NGW, int wave, int lane) {
    unsigned char* ws = p.ws;
    const bf16_t* x1b = (const bf16_t*)(ws + WS_X1B); const unsigned char* UT = ws + WS_UT; const unsigned char* VT = ws + WS_VT;
    const int* ex = (const int*)(ws + WS_EXP); const float* gt = (const float*)(ws + WS_GATE); const float* ss2 = (const float*)(ws + WS_ROWSS) + 3 * S;
    const float* out = p.out;
    LAS unsigned char* xl = lds + wave * 16384;
    LAS unsigned* list = (LAS unsigned*)(lds + 131072 + wave * 2048);
    LAS unsigned* hist = (LAS unsigned*)(lds + 147456 + wave * 256);
    for (int tb = gw; tb < S / 4; tb += NGW) {
        const int t0 = tb * 4;
        int id[8]; float gv[8];
#pragma unroll
        for (int r = 0; r < 8; ++r) { const size_t o = (size_t)(t0 + (r >> 1)) * 128 + (r & 1) * 64 + lane; id[r] = ex[o]; gv[r] = gt[o]; }
        const float rs0 = rsqrtf(ss2[t0 + 0] * (1.0f / DM) + EPS) * (1.0f / PEER_USC), rs1 = rsqrtf(ss2[t0 + 1] * (1.0f / DM) + EPS) * (1.0f / PEER_USC);
        const float rs2 = rsqrtf(ss2[t0 + 2] * (1.0f / DM) + EPS) * (1.0f / PEER_USC), rs3 = rsqrtf(ss2[t0 + 3] * (1.0f / DM) + EPS) * (1.0f / PEER_USC);
        hist[lane] = 0u;
        LDS_WAIT(); asm volatile("" ::: "memory");
        unsigned pos[8];
#pragma unroll
        for (int r = 0; r < 8; ++r) pos[r] = __hip_atomic_fetch_add(hist + (id[r] >> 8), 1u, __ATOMIC_RELAXED, __HIP_MEMORY_SCOPE_WORKGROUP);
        LDS_WAIT(); asm volatile("" ::: "memory");
        const unsigned cnt = hist[lane];
        unsigned inc = cnt;
#pragma unroll
        for (int o = 1; o < 64; o <<= 1) { const unsigned n = __shfl_up(inc, o); if (lane >= o) inc += n; }
        LDS_WAIT(); asm volatile("" ::: "memory");
        hist[lane] = inc - cnt;
        LDS_WAIT(); asm volatile("" ::: "memory");
#pragma unroll
        for (int r = 0; r < 8; ++r) { const unsigned d = hist[id[r] >> 8] + pos[r]; list[d] = (unsigned)id[r] | ((unsigned)(r >> 1) << 14) | (f2bf(gv[r]) << 16); }
#pragma unroll
        for (int j = 0; j < 4; ++j)
#pragma unroll
            for (int g = 0; g < 4; ++g) {
                const u32x2 w0 = *(const u32x2*)(x1b + (size_t)(t0 + j) * DM + ((2 * g) * 64 + lane) * 4), w1 = *(const u32x2*)(x1b + (size_t)(t0 + j) * DM + ((2 * g + 1) * 64 + lane) * 4);
                *(LAS u32x4*)(xl + j * 4096 + g * 1024 + lane * 16) = (u32x4){w0.x, w0.y, w1.x, w1.y};
            }
        asm volatile("s_waitcnt vmcnt(0) lgkmcnt(0)" ::: "memory");
        {
            const __amdgpu_buffer_rsrc_t urs = __builtin_amdgcn_make_buffer_rsrc((void*)UT, 0, 16384 * PEER_ROWB, 0x00020000);
            const int vo4 = lane * 16, vo2 = lane * 8 + 1024;
            const bool lb0 = (lane & 1) != 0, lb1 = (lane & 2) != 0, lb2 = (lane & 4) != 0;
#define P8_ULOAD(k, i) do { const unsigned en = (unsigned)__builtin_amdgcn_readfirstlane((int)list[(i)]); uen[k] = en; const int ro = (int)((en & 0x3fffu) * (unsigned)PEER_ROWB); \
            u4[k] = __builtin_amdgcn_raw_buffer_load_b128(urs, vo4, ro, 0); u2[k] = __builtin_amdgcn_raw_buffer_load_b64(urs, vo2, ro, 0); } while (0)
#define P8_UPROC(k) do { const u32x6 pk = {u4[k][0], u4[k][1], u4[k][2], u4[k][3], u2[k][0], u2[k][1]}; \
            const bf16x32v r_ = __builtin_amdgcn_cvt_scalef32_pk32_bf16_fp6(pk, 1.0f); const LAS unsigned char* xp = xl + ((uen[k] >> 14) & 3u) * 4096 + lane * 16; \
            float d0 = 0.f, d1 = 0.f, d2 = 0.f, d3 = 0.f; \
            _Pragma("unroll") for (int g = 0; g < 4; ++g) { const LAS unsigned* xw = (const LAS unsigned*)(xp + g * 1024); const unsigned x0 = xw[0], x1 = xw[1], x2 = xw[2], x3 = xw[3]; \
                { const bf16x2v uu = {r_[8 * g + 0], r_[8 * g + 1]}; d0 = __builtin_amdgcn_fdot2_f32_bf16(uu, __builtin_bit_cast(bf16x2v, x0), d0, false); } \
                { const bf16x2v uu = {r_[8 * g + 2], r_[8 * g + 3]}; d1 = __builtin_amdgcn_fdot2_f32_bf16(uu, __builtin_bit_cast(bf16x2v, x1), d1, false); } \
                { const bf16x2v uu = {r_[8 * g + 4], r_[8 * g + 5]}; d2 = __builtin_amdgcn_fdot2_f32_bf16(uu, __builtin_bit_cast(bf16x2v, x2), d2, false); } \
                { const bf16x2v uu = {r_[8 * g + 6], r_[8 * g + 7]}; d3 = __builtin_amdgcn_fdot2_f32_bf16(uu, __builtin_bit_cast(bf16x2v, x3), d3, false); } } \
            dd[k] = (d0 + d1) + (d2 + d3); } while (0)
#if (PROBE_DUP >> 10) & 1
#define P8_UREPS 2
#else
#define P8_UREPS 1
#endif
#pragma unroll 1
            for (int urep = 0; urep < P8_UREPS; ++urep) {
                u32x4 u4[8]; u32x2 u2[8]; unsigned uen[8];
#pragma unroll
                for (int k = 0; k < 8; ++k) P8_ULOAD(k, k);
#pragma unroll 1
                for (int i = 0; i < 512; i += 8) {
                    const unsigned ev = list[i + (lane & 7)]; const unsigned jl = (ev >> 14) & 3u;
                    const float gl = __builtin_bit_cast(float, ev & 0xffff0000u), rl = jl == 0u ? rs0 : (jl == 1u ? rs1 : (jl == 2u ? rs2 : rs3));
                    float dd[8];
#pragma unroll
                    for (int k = 0; k < 8; ++k) { P8_UPROC(k); const int nx = i + 8 + k; P8_ULOAD(k, nx < 512 ? nx : 511); }
                    float w4[4], w2[2];
#pragma unroll
                    for (int q = 0; q < 4; ++q) { const float kp = lb2 ? dd[q + 4] : dd[q], sd = lb2 ? dd[q] : dd[q + 4]; w4[q] = kp + __shfl_xor(sd, 4); }
#pragma unroll
                    for (int q = 0; q < 2; ++q) { const float kp = lb1 ? w4[q + 2] : w4[q], sd = lb1 ? w4[q] : w4[q + 2]; w2[q] = kp + __shfl_xor(sd, 2); }
                    float dres; { const float kp = lb0 ? w2[1] : w2[0], sd = lb0 ? w2[0] : w2[1]; dres = kp + __shfl_xor(sd, 1); }
                    dres += __shfl_xor(dres, 8); dres += __shfl_xor(dres, 16); dres += __shfl_xor(dres, 32);
                    const float c_ = gl * gelu_tanh(rl * dres) * (1.0f / PEER_VSC);
                    if (lane < 8 && urep == P8_UREPS - 1) list[i + lane] = (ev & 0xffffu) | (f2bf(c_) << 16);
                }
            }
#undef P8_ULOAD
#undef P8_UPROC
        }
        asm volatile("s_waitcnt vmcnt(0)" ::: "memory");
        LDS_WAIT(); asm volatile("" ::: "memory");
        f32x4 acc[32];
#if (PROBE_DUP >> 12) & 1
#define P8_VREPS 2
#else
#define P8_VREPS 1
#endif
#pragma unroll 1
        for (int vrep = 0; vrep < P8_VREPS; ++vrep) {
#pragma unroll
        for (int i = 0; i < 32; ++i) acc[i] = (f32x4){0.f, 0.f, 0.f, 0.f};
        {
            typedef unsigned u32x16 __attribute__((ext_vector_type(16)));
            u32x4 v4[4]; u32x2 v2[4]; unsigned ven[4];
            const unsigned tok = (unsigned)lane & 3u;
            const __amdgpu_buffer_rsrc_t vrs = __builtin_amdgcn_make_buffer_rsrc((void*)VT, 0, 16384 * PEER_ROWB, 0x00020000);
            const int vo4 = lane * 16, vo2 = lane * 8 + 1024;
#define P8_VLOAD(k, i) do { const unsigned en = (unsigned)__builtin_amdgcn_readfirstlane((int)list[(i)]); ven[k] = en; const int ro = (int)((en & 0x3fffu) * (unsigned)PEER_ROWB); \
            v4[k] = __builtin_amdgcn_raw_buffer_load_b128(vrs, vo4, ro, 0); v2[k] = __builtin_amdgcn_raw_buffer_load_b64(vrs, vo2, ro, 0); } while (0)
#define P8_VPROC2(ka, kb) do { const u32x6 pka = {v4[ka][0], v4[ka][1], v4[ka][2], v4[ka][3], v2[ka][0], v2[ka][1]}, pkb = {v4[kb][0], v4[kb][1], v4[kb][2], v4[kb][3], v2[kb][0], v2[kb][1]}; \
            const u32x16 da = __builtin_bit_cast(u32x16, __builtin_amdgcn_cvt_scalef32_pk32_bf16_fp6(pka, 1.0f)), db = __builtin_bit_cast(u32x16, __builtin_amdgcn_cvt_scalef32_pk32_bf16_fp6(pkb, 1.0f)); \
            const unsigned ea = ven[ka], eb = ven[kb]; \
            const unsigned alo = ((((ea >> 14) & 3u) == tok) ? (ea >> 16) : 0u) | ((((eb >> 14) & 3u) == tok) ? (eb & 0xffff0000u) : 0u); \
            const s16x4 av = __builtin_bit_cast(s16x4, (unsigned long long)alo); \
            _Pragma("unroll") for (int m = 0; m < 16; ++m) { \
                const unsigned be = __builtin_amdgcn_perm(db[m], da[m], 0x05040100u), bo = __builtin_amdgcn_perm(db[m], da[m], 0x07060302u); \
                acc[2 * m] = __builtin_amdgcn_mfma_f32_4x4x4bf16_1k(av, __builtin_bit_cast(s16x4, (unsigned long long)be), acc[2 * m], 0, 0, 0); \
                acc[2 * m + 1] = __builtin_amdgcn_mfma_f32_4x4x4bf16_1k(av, __builtin_bit_cast(s16x4, (unsigned long long)bo), acc[2 * m + 1], 0, 0, 0); } } while (0)
#pragma unroll
            for (int k = 0; k < 4; ++k) P8_VLOAD(k, k);
#pragma unroll 1
            for (int i = 0; i < 512; i += 4) {
#pragma unroll
                for (int k = 0; k < 4; k += 2) { P8_VPROC2(k, k + 1); const int nx = i + 4 + k < 512 ? i + 4 + k : 510; P8_VLOAD(k, nx); P8_VLOAD(k + 1, nx + 1); }
            }
#undef P8_VLOAD
#undef P8_VPROC2
        }
        }
        int tq = t0, lq = lane; asm volatile("" : "+s"(tq)); asm volatile("" : "+v"(lq));
#pragma unroll
        for (int j = 0; j < 4; ++j)
#pragma unroll
            for (int i = 0; i < 8; ++i) {
                const size_t o = (size_t)(tq + j) * DM + (i * 64 + lq) * 4;
                f32x4 a = *(const f32x4*)(out + o);
#pragma unroll
                for (int q = 0; q < 4; ++q) a[q] += acc[4 * i + q][j];
                *(f32x4*)(dst + o) = a;
                if (i & 1) asm volatile("" ::: "memory");
            }
        LDS_WAIT(); asm volatile("" ::: "memory");
    }
}

__global__ void __launch_bounds__(NTHREADS, 2) mega(Params p) {
    extern __shared__ __attribute__((aligned(16))) unsigned char lds_raw[];
    LAS unsigned char* lds = (LAS unsigned char*)lds_raw;
    const int tid = threadIdx.x, lane = tid & 63, wave = __builtin_amdgcn_readfirstlane(tid >> 6);
    const int G = gridDim.x, bx = blockIdx.x;
    const int gw = bx * 8 + wave, NGW = G * 8;
    unsigned char* ws = p.ws;
    const int lo = p.ph_lo, hi = p.ph_hi;
    volatile LAS unsigned* misc = (volatile LAS unsigned*)(lds + LDS_MISC);
    if (tid < 4) misc[tid] = 0u;
    __syncthreads();
    const XcdBarrier xbar = xcd_barrier_post((unsigned*)(ws + WS_CTL), misc);
#ifndef PH_MASK
#define PH_MASK 0x1ff
#endif
#define IN(k) (((PH_MASK >> (k)) & 1) && lo <= (k) && (k) < hi)
#define SEAM(k) do { if (IN(k) && IN((k) + 1)) xcd_barrier(xbar); } while (0)

#if (PROBE_DUP >> 0) & 1
    if (IN(0)) { phase0(p, lds, G == 256, gw, NGW, wave, lane); xcd_barrier(xbar); }
#endif
    if (IN(0)) phase0(p, lds, G == 256, gw, NGW, wave, lane);
    SEAM(0);
    if (IN(1)) {
        pg8::Gemm g{(const bf16_t*)(ws + WS_XB), (const bf16_t*)(ws + WS_WIN), S, NINP, DM, DM, DM};
        pg8::StaticOrder So; So.init(S, NINP, G, bx);
        pg8::Epi<1> E{(const float*)(ws + WS_RSTD1), 0.f, (float*)(ws + WS_ROWSS), (bf16_t*)(ws + WS_PROJ), NINP, nullptr, nullptr};
#if (PROBE_DUP >> 1) & 1
        { pg8::Epi<1> E2 = E; E2.ss = (float*)(ws + 512 * 1024); pg8::gemm_phase<pg8::Epi<1>, pg8::StaticOrder, true, true>(lds, g, So, E2); xcd_barrier(xbar); }
#endif
        pg8::gemm_phase<pg8::Epi<1>, pg8::StaticOrder, true, true>(lds, g, So, E);
        if (G == 256 && bx >= 128) { __syncthreads(); prep_late(p, lds, (bx - 128) * 8 + wave, 1024, wave, lane); }
    }
    SEAM(1);
    if (IN(2)) {
        {
            pg8::Gemm g{(const bf16_t*)(ws + WS_PROJ) + 2048, (const bf16_t*)(ws + WS_WUQ), S, 1536, 512, NINP, 512};
            pg8::StaticOrder So; So.init(S, 1536, G, bx);
            pg8::Epi<2> E{(const float*)(ws + WS_ROWSS) + 1 * S, 1.0f / 512.0f, nullptr, (bf16_t*)(ws + WS_QRAW), 1536, nullptr, nullptr};
            pg8::gemm_phase<pg8::Epi<2>, pg8::StaticOrder, true, true>(lds, g, So, E);
        }
        __syncthreads();
        {
            pg8::Gemm g{(const bf16_t*)(ws + WS_PROJ) + 2560, (const bf16_t*)(ws + WS_WUKV), S, 2048, 256, NINP, 256};
            pg8::StaticOrder So; So.init(S, 2048, G, bx);
            pg8::Epi<2> E{(const float*)(ws + WS_ROWSS) + 2 * S, 1.0f / 256.0f, nullptr, (bf16_t*)(ws + WS_KVRAW), 2048, nullptr, nullptr};
            pg8::gemm_phase<pg8::Epi<2>, pg8::StaticOrder, true, true>(lds, g, So, E);
        }
    }
    SEAM(2);
#if (PROBE_DUP >> 3) & 1
    if (IN(3)) { phase3(p, gw, NGW, lane); xcd_barrier(xbar); }
#endif
    if (IN(3)) phase3(p, gw, NGW, lane);
    SEAM(3);
#define P4_BODY_ATT for (int pr = bx; pr < 256; pr += G) { const int head = pr & 7, x = pr >> 3; attn_unit(p, lds, head, 63 - x, tid, wave, lane); attn_unit(p, lds, head, x, tid, wave, lane); }
#define P4_BODY_GMLP for (int u = bx; u < 512; u += G) gmlp_unit(p, lds, u >> 3, u & 7, tid, wave, lane);
#if (PROBE_DUP >> 4) & 1
    if (IN(4)) { P4_BODY_ATT; xcd_barrier(xbar); }
#endif
#if (PROBE_DUP >> 9) & 1
    if (IN(4)) { P4_BODY_GMLP; xcd_barrier(xbar); }
#endif
    if (IN(4)) { P4_BODY_ATT; P4_BODY_GMLP; }
    SEAM(4);
    if (IN(5)) {
        pg8::Gemm g{(const bf16_t*)(ws + WS_MIX), (const bf16_t*)(ws + WS_WOUT), S, DM, DM, DM, DM};
        pg8::StaticOrder So; So.init(S, DM, G, bx);
        pg8::Epi<4> E{nullptr, 0.f, (float*)(ws + WS_ROWSS) + 3 * S, (bf16_t*)(ws + WS_X1B), DM, p.out, p.in[0]};
#if (PROBE_DUP >> 5) & 1
        { pg8::Epi<4> E2 = E; E2.ss = (float*)(ws + 512 * 1024); pg8::gemm_phase<pg8::Epi<4>, pg8::StaticOrder, true, true>(lds, g, So, E2); xcd_barrier(xbar); }
#endif
        pg8::gemm_phase<pg8::Epi<4>, pg8::StaticOrder, true, true>(lds, g, So, E);
    }
    SEAM(5);
    if (IN(6)) {
        pg8::Gemm g{(const bf16_t*)(ws + WS_X1B), (const bf16_t*)(ws + WS_WS), S, DM, DM, DM, DM};
        pg8::StaticOrder So; So.init(S, DM, G, bx);
        pg8::Epi<5> E{(const float*)(ws + WS_ROWSS) + 3 * S, 1.0f / DM, nullptr, nullptr, DM, (float*)(ws + WS_SC), nullptr};
#if (PROBE_DUP >> 6) & 1
        { pg8::gemm_phase<pg8::Epi<5>, pg8::StaticOrder, true, true>(lds, g, So, E); xcd_barrier(xbar); }
#endif
        pg8::gemm_phase<pg8::Epi<5>, pg8::StaticOrder, true, true>(lds, g, So, E);
    }
    SEAM(6);
#if (PROBE_DUP >> 7) & 1
    if (IN(7)) { phase7(p, lds, gw, NGW, wave, lane); xcd_barrier(xbar); }
#endif
    if (IN(7)) phase7(p, lds, gw, NGW, wave, lane);
    SEAM(7);
#if (PROBE_DUP >> 8) & 1
    if (IN(8)) { phase8(p, lds, (float*)(ws + WS_SC), xbar.x, 8u * misc[0], gw, NGW, wave, lane); xcd_barrier(xbar); }
#endif
    if (IN(8)) phase8(p, lds, p.out, xbar.x, 8u * misc[0], gw, NGW, wave, lane);
#undef IN
#undef SEAM
}

extern "C" void kernel_launch(void* const* d_in, const int* in_sizes, int n_in, void* d_out, int out_size, void* d_ws, size_t ws_size, hipStream_t stream) {
    static int grid = 0;
    if (grid == 0) {
        if (n_in != 18 || out_size != S * DM || ws_size < WS_END) { fprintf(stderr, "kernel_launch: unexpected shapes (n_in %d out %d ws %zu)\n", n_in, out_size, ws_size); grid = -1; return; }
        int dev = 0, cus = 0, per_cu = 0;
        hipGetDevice(&dev);
        hipDeviceGetAttribute(&cus, hipDeviceAttributeMultiprocessorCount, dev);
        if (hipFuncSetAttribute((const void*)mega, hipFuncAttributeMaxDynamicSharedMemorySize, LDS_BYTES) != hipSuccess) { fprintf(stderr, "kernel_launch: hipFuncSetAttribute failed\n"); grid = -1; return; }
        if (hipOccupancyMaxActiveBlocksPerMultiprocessor(&per_cu, (const void*)mega, NTHREADS, LDS_BYTES) != hipSuccess || per_cu < 1) { fprintf(stderr, "kernel_launch: occupancy query failed (%d)\n", per_cu); grid = -1; return; }
        grid = cus;
        fprintf(stderr, "kernel_launch: cus %d per_cu %d grid %d\n", cus, per_cu, grid);
    }
    if (grid < 0) return;
    hipMemsetAsync((char*)d_ws + WS_CTL, 0, 1 * MiB, stream);
    Params prm{};
    for (int i = 0; i < 18; ++i) prm.in[i] = (const float*)d_in[i];
    prm.out = (float*)d_out; prm.ws = (unsigned char*)d_ws;
#if MK_ONE_LAUNCH
    prm.ph_lo = 0; prm.ph_hi = NPH;
    { void* args[] = {&prm}; hipError_t e = hipLaunchCooperativeKernel((const void*)mega, dim3(grid), dim3(NTHREADS), args, LDS_BYTES, stream);
      if (e != hipSuccess) fprintf(stderr, "cooperative launch failed: %s\n", hipGetErrorString(e)); }
#else
    for (int ph = 0; ph < NPH; ++ph) {
        prm.ph_lo = ph; prm.ph_hi = ph + 1;
        void* args[] = {&prm};
        hipError_t e = hipLaunchCooperativeKernel((const void*)mega, dim3(grid), dim3(NTHREADS), args, LDS_BYTES, stream);
        if (e != hipSuccess) { fprintf(stderr, "cooperative launch %d failed: %s\n", ph, hipGetErrorString(e)); break; }
    }
#endif
}
```

```cpp
#include <hip/hip_runtime.h>
#include <cstdio>
#include <cstdint>

#define LAS __attribute__((address_space(3)))
typedef unsigned short bf16_t;
typedef short bf16x8 __attribute__((ext_vector_type(8)));
typedef short s16x4 __attribute__((ext_vector_type(4)));
typedef float f32x4 __attribute__((ext_vector_type(4)));
typedef float f32x16 __attribute__((ext_vector_type(16)));
typedef unsigned u32x4 __attribute__((ext_vector_type(4)));
typedef unsigned u32x2 __attribute__((ext_vector_type(2)));

#ifndef PROBE_DUP
#define PROBE_DUP 0
#endif
#ifndef MK_ONE_LAUNCH
#define MK_ONE_LAUNCH 1
#endif

constexpr int S = 8192, DM = 2048, NIN = 2880, NINP = 3072;
constexpr int NPH = 9;
constexpr float EPS = 1e-6f;
constexpr int LDS_BYTES = 163840;
constexpr int NTHREADS = 512;
constexpr int LDS_MISC = 161792;

constexpr size_t MiB = 1u << 20;
constexpr size_t WS_CTL = 0;
constexpr size_t WS_ROWSS = 128 * 1024;
constexpr size_t WS_COS = 1 * MiB, WS_SIN = 2 * MiB;
constexpr size_t WS_RSTD1 = 3 * MiB;
constexpr size_t WS_EXP = 4 * MiB;
constexpr size_t WS_GATE = 8 * MiB;
constexpr size_t WS_WIN = 12 * MiB;
constexpr size_t WS_WUQ = 24 * MiB;
constexpr size_t WS_WUKV = 26 * MiB;
constexpr size_t WS_WOUT = 28 * MiB;
constexpr size_t WS_WS = 36 * MiB;
constexpr size_t WS_XB = 44 * MiB;
constexpr size_t WS_PROJ = 76 * MiB;
constexpr size_t WS_QRAW = 124 * MiB;
constexpr size_t WS_KVRAW = 148 * MiB;
constexpr size_t WS_QH = 180 * MiB;
constexpr size_t WS_KH = 204 * MiB;
constexpr size_t WS_VH = 228 * MiB;
constexpr size_t WS_MIX = 244 * MiB;
constexpr size_t WS_X1B = 276 * MiB;
constexpr size_t WS_SC = 308 * MiB;
constexpr size_t WS_UT = 372 * MiB;
constexpr size_t WS_VT = 436 * MiB;
constexpr size_t WS_END = 500 * MiB;

__device__ __forceinline__ unsigned f2bf(float f) { unsigned u = __builtin_bit_cast(unsigned, f); return (u + 0x7fffu + ((u >> 16) & 1u)) >> 16; }
__device__ __forceinline__ unsigned pk2(float lo, float hi) { return f2bf(lo) | (f2bf(hi) << 16); }
__device__ __forceinline__ float bf2f(unsigned short b) { return __builtin_bit_cast(float, (unsigned)b << 16); }
__device__ __forceinline__ float bflo(unsigned w) { return __builtin_bit_cast(float, w << 16); }
__device__ __forceinline__ float bfhi(unsigned w) { return __builtin_bit_cast(float, w & 0xffff0000u); }
__device__ __forceinline__ float wave_sum(float v) {
#pragma unroll
    for (int o = 32; o > 0; o >>= 1) v += __shfl_xor(v, o);
    return v;
}
__device__ __forceinline__ float wave_max(float v) {
#pragma unroll
    for (int o = 32; o > 0; o >>= 1) v = fmaxf(v, __shfl_xor(v, o));
    return v;
}
template <int CTRL, int ROW_MASK> __device__ __forceinline__ float dpp_f(float old, float v) {
    return __builtin_bit_cast(float, __builtin_amdgcn_update_dpp(__builtin_bit_cast(int, old), __builtin_bit_cast(int, v), CTRL, ROW_MASK, 0xf, false));
}
__device__ __forceinline__ float wave_max_u(float v) {
    v = fmaxf(v, dpp_f<0xB1, 0xf>(v, v));
    v = fmaxf(v, dpp_f<0x4E, 0xf>(v, v));
    v = fmaxf(v, dpp_f<0x141, 0xf>(v, v));
    v = fmaxf(v, dpp_f<0x140, 0xf>(v, v));
    v = fmaxf(v, dpp_f<0x142, 0xa>(v, v));
    v = fmaxf(v, dpp_f<0x143, 0xc>(v, v));
    return __builtin_bit_cast(float, __builtin_amdgcn_readlane(__builtin_bit_cast(int, v), 63));
}
__device__ __forceinline__ float wave_sum_u(float v) {
    v += dpp_f<0xB1, 0xf>(0.f, v);
    v += dpp_f<0x4E, 0xf>(0.f, v);
    v += dpp_f<0x141, 0xf>(0.f, v);
    v += dpp_f<0x140, 0xf>(0.f, v);
    v += dpp_f<0x142, 0xa>(0.f, v);
    v += dpp_f<0x143, 0xc>(0.f, v);
    return __builtin_bit_cast(float, __builtin_amdgcn_readlane(__builtin_bit_cast(int, v), 63));
}
__device__ __forceinline__ float gelu_tanh(float x) {
    const float y = 0.7978845608028654f * (x + 0.044715f * x * x * x);
    return x / (1.0f + __expf(-2.0f * y));
}
__device__ __forceinline__ int crow(int r, int hi) { return (r & 3) + 8 * (r >> 2) + 4 * hi; }
#define LDS_WAIT() asm volatile("s_waitcnt lgkmcnt(0)" ::: "memory")
#define SBAR() __builtin_amdgcn_sched_barrier(0)

namespace pg8 {
#define PG8_LAS __attribute__((address_space(3)))
constexpr int BM = 256, BK = 64, HALF = 128, HTB = HALF * BK * 2  , STAGE_BYTES = 8 * HTB, NXCD = 8, WGM = 8;

__host__ __device__ __forceinline__ int lds_byte(int r, int c) { const int st = (r >> 4) * 2 + (c >> 5), rr = r & 15, cc = c & 31, ob = rr * 64 + cc * 2; return st * 1024 + (ob ^ (((ob >> 9) & 1) << 5)); }
__host__ __device__ __forceinline__ void stage_rc(int b, int& R, int& C) { const int st = b / 1024, sb = b % 1024, swz = sb ^ (((sb >> 9) & 1) << 5); R = (st >> 1) * 16 + swz / 64; C = (st & 1) * 32 + (swz % 64) / 2; }
__host__ __device__ __forceinline__ int perm32(int rho) { const int n = rho >> 4, i = rho & 15; return 8 * (i >> 2) + 4 * n + (i & 3); }

struct Unit { int pm, pn; };
struct Gemm { const bf16_t* A; const bf16_t* Bt; int M, N, K, lda, ldb; };

struct StaticOrder {
    int nM, nN, nwg, G, c;
    __host__ __device__ void init(int M, int N, int G_, int c_) { nM = M / BM; nN = N / BM; nwg = nM * nN; G = G_; c = c_; }
    __host__ __device__ bool next(int i, Unit& u) const {
        const long L = (long)i * G + c; if (L >= nwg) return false;
        int wgid = (int)L; { const int q = nwg / NXCD, r = nwg % NXCD, xcd = wgid % NXCD, off = wgid / NXCD; wgid = (xcd < r ? xcd * (q + 1) : r * (q + 1) + (xcd - r) * q) + off; }
        const int nig = WGM * nN, gid = wgid / nig, fm = gid * WGM, gsz = (nM - fm) < WGM ? (nM - fm) : WGM;
        u.pm = fm + ((wgid % nig) % gsz); u.pn = (wgid % nig) / gsz; return true;
    }
    __device__ __forceinline__ void a_ready(const Unit&) const {}
    __device__ __forceinline__ void done(const Unit&) const {}
};

template <class Epi, class Sched, bool ALIGN_EPI = false, bool SP2 = false>
__device__ __forceinline__ void gemm_phase(PG8_LAS unsigned char* lds, const Gemm g, const Sched& S, const Epi& E) {
    const int tid = threadIdx.x, wid = __builtin_amdgcn_readfirstlane(tid >> 6), lane = tid & 63, wr = wid >> 2, wc = wid & 3, fr = lane & 15, fq = lane >> 4;
    const int K = g.K, nt = K / BK;
    unsigned voffA[2], voffB[2];
#pragma unroll
    for (int i = 0; i < 2; ++i) { int R, C; stage_rc(tid * 16 + i * 8192, R, C); const int Rb = Epi::PERM ? ((R & ~31) + perm32(R & 31)) : R;
        voffA[i] = (unsigned)(R * g.lda + C) * 2u; voffB[i] = (unsigned)(Rb * g.ldb + C) * 2u; }
    const size_t kstep = (size_t)(BK * 2);
    const size_t hstepA = (size_t)HALF * g.lda * 2, hstepB = (size_t)HALF * g.ldb * 2;
    const size_t tstepA = 2 * hstepA, tstepB = 2 * hstepB;
    const unsigned ldsw = (unsigned)wid * 1024u;
    const int aoff = lds_byte(wr * 64 + fr, fq * 8), boff = lds_byte(wc * 32 + fr, fq * 8);
#define PG8_SA(b, h) (((b) * 2 + (h)) * HTB)
#define PG8_SB(b, h) ((4 + (b) * 2 + (h)) * HTB)
#define PG8_STAGE(bufoff, gbase, voff) do { _Pragma("unroll") for (int _i = 0; _i < 2; ++_i) \
        __builtin_amdgcn_global_load_lds((const unsigned*)((const char*)(gbase) + (voff)[_i]), (PG8_LAS unsigned*)(lds + (bufoff) + ldsw + _i * 8192), 16, 0, 0); } while (0)
#define PG8_LDA(dst, b, h) do { _Pragma("unroll") for (int m = 0; m < 4; ++m) _Pragma("unroll") for (int k = 0; k < 2; ++k) dst[m][k] = *(const PG8_LAS bf16x8*)(lds + PG8_SA(b, h) + aoff + m * 2048 + k * 1024); } while (0)
#define PG8_LDB(dst, b, h) do { _Pragma("unroll") for (int n = 0; n < 2; ++n) _Pragma("unroll") for (int k = 0; k < 2; ++k) dst[n][k] = *(const PG8_LAS bf16x8*)(lds + PG8_SB(b, h) + boff + n * 2048 + k * 1024); } while (0)
#define PG8_MMA(ai, bj, At, Bt) do { __builtin_amdgcn_s_setprio(1); _Pragma("unroll") for (int m = 0; m < 4; ++m) _Pragma("unroll") for (int n = 0; n < 2; ++n) _Pragma("unroll") for (int k = 0; k < 2; ++k) \
        acc[ai][bj][m][n] = __builtin_amdgcn_mfma_f32_16x16x32_bf16(Bt[n][k], At[m][k], acc[ai][bj][m][n], 0, 0, 0); __builtin_amdgcn_s_setprio(0); } while (0)
#define PG8_WAIT_V(n) asm volatile("s_waitcnt vmcnt(" #n ")" ::: "memory")
#define PG8_WAIT_L(n) asm volatile("s_waitcnt lgkmcnt(" #n ")" ::: "memory")
#define PG8_BAR __builtin_amdgcn_s_barrier()
#define PG8_SCHED __builtin_amdgcn_sched_barrier(0)
    Unit cur, nxt; int ui = 0;
    if (!S.next(0, cur)) return;
    f32x4 acc[2][2][4][2];
#pragma unroll
    for (int a = 0; a < 2; ++a)
#pragma unroll
        for (int b = 0; b < 2; ++b)
#pragma unroll
            for (int m = 0; m < 4; ++m)
#pragma unroll
                for (int n = 0; n < 2; ++n) acc[a][b][m][n] = (f32x4){0.f, 0.f, 0.f, 0.f};
    bf16x8 At[4][2], B0[2][2], B1[2][2];
    const char* cA = (const char*)g.A + (size_t)cur.pm * tstepA; const char* cB = (const char*)g.Bt + (size_t)cur.pn * tstepB;
    S.a_ready(cur);
    if constexpr (SP2) {
        PG8_STAGE(PG8_SB(0, 0), cB, voffB); PG8_STAGE(PG8_SB(0, 1), cB + hstepB, voffB); PG8_STAGE(PG8_SA(0, 0), cA, voffA); PG8_STAGE(PG8_SA(0, 1), cA + hstepA, voffA);
        if (wr == 1) PG8_BAR;
        PG8_WAIT_V(2); PG8_BAR;
        PG8_STAGE(PG8_SB(1, 0), cB + kstep, voffB); PG8_STAGE(PG8_SA(1, 0), cA + kstep, voffA); PG8_STAGE(PG8_SB(1, 1), cB + hstepB + kstep, voffB);
        PG8_WAIT_V(6); PG8_BAR;
    } else {
        PG8_STAGE(PG8_SB(0, 0), cB, voffB); PG8_STAGE(PG8_SA(0, 0), cA, voffA); PG8_STAGE(PG8_SB(0, 1), cB + hstepB, voffB); PG8_STAGE(PG8_SA(0, 1), cA + hstepA, voffA);
        if (wr == 1) PG8_BAR;
        PG8_WAIT_V(4); PG8_BAR;
        PG8_STAGE(PG8_SB(1, 0), cB + kstep, voffB); PG8_STAGE(PG8_SA(1, 0), cA + kstep, voffA); PG8_STAGE(PG8_SB(1, 1), cB + hstepB + kstep, voffB);
        PG8_WAIT_V(6); PG8_BAR;
    }
    for (;;) {
        const bool has_next = S.next(ui + 1, nxt);
        const char* nA = has_next ? (const char*)g.A + (size_t)nxt.pm * tstepA : cA; const char* nB = has_next ? (const char*)g.Bt + (size_t)nxt.pn * tstepB : cB;
        for (int t = 0; t < nt; t += 2) {
            const bool last = (t == nt - 2);
            const char* a1 = cA + (size_t)(t + 1) * kstep;
            const char* a2 = last ? nA : cA + (size_t)(t + 2) * kstep; const char* b2 = last ? nB : cB + (size_t)(t + 2) * kstep;
            const char* a3 = a2 + kstep; const char* b3 = b2 + kstep;
            if (last && has_next) S.a_ready(nxt);
            if constexpr (SP2) {
            PG8_LDB(B0, 0, 0); PG8_LDB(B1, 0, 1); PG8_SCHED; PG8_LDA(At, 0, 0); PG8_STAGE(PG8_SA(1, 1), a1 + hstepA, voffA);
            PG8_WAIT_V(8); PG8_WAIT_L(0); PG8_BAR; PG8_MMA(0, 0, At, B0); PG8_MMA(0, 1, At, B1); PG8_BAR; PG8_SCHED;
            PG8_LDA(At, 0, 1); PG8_STAGE(PG8_SB(0, 0), b2, voffB); PG8_STAGE(PG8_SB(0, 1), b2 + hstepB, voffB); PG8_STAGE(PG8_SA(0, 0), a2, voffA);
            PG8_WAIT_V(8); PG8_WAIT_L(0); PG8_BAR; PG8_MMA(1, 0, At, B0); PG8_MMA(1, 1, At, B1); PG8_BAR; PG8_SCHED;
            PG8_LDB(B0, 1, 0); PG8_LDB(B1, 1, 1); PG8_SCHED; PG8_LDA(At, 1, 0); PG8_STAGE(PG8_SA(0, 1), a2 + hstepA, voffA);
            PG8_WAIT_V(8); PG8_WAIT_L(0); PG8_BAR; PG8_MMA(0, 0, At, B0); PG8_MMA(0, 1, At, B1); PG8_BAR; PG8_SCHED;
            PG8_LDA(At, 1, 1); PG8_STAGE(PG8_SB(1, 0), b3, voffB); PG8_STAGE(PG8_SB(1, 1), b3 + hstepB, voffB); PG8_STAGE(PG8_SA(1, 0), a3, voffA);
            PG8_WAIT_V(8); PG8_WAIT_L(0); PG8_BAR; PG8_MMA(1, 0, At, B0); PG8_MMA(1, 1, At, B1); PG8_BAR; PG8_SCHED;
            } else {
            PG8_LDB(B0, 0, 0); PG8_SCHED; PG8_LDA(At, 0, 0); PG8_STAGE(PG8_SA(1, 1), a1 + hstepA, voffA);
            PG8_WAIT_L(8); PG8_BAR; PG8_WAIT_L(0); PG8_MMA(0, 0, At, B0); PG8_BAR; PG8_SCHED;
            PG8_LDB(B1, 0, 1); PG8_STAGE(PG8_SB(0, 0), b2, voffB);
            PG8_BAR; PG8_WAIT_L(0); PG8_MMA(0, 1, At, B1); PG8_BAR;
            PG8_LDA(At, 0, 1); PG8_STAGE(PG8_SA(0, 0), a2, voffA);
            PG8_BAR; PG8_WAIT_L(0); PG8_MMA(1, 0, At, B0); PG8_BAR; PG8_SCHED;
            PG8_STAGE(PG8_SB(0, 1), b2 + hstepB, voffB);
            PG8_WAIT_V(6); PG8_BAR; PG8_MMA(1, 1, At, B1); PG8_BAR;
            PG8_LDB(B0, 1, 0); PG8_SCHED; PG8_LDA(At, 1, 0); PG8_STAGE(PG8_SA(0, 1), a2 + hstepA, voffA);
            PG8_WAIT_L(8); PG8_BAR; PG8_WAIT_L(0); PG8_MMA(0, 0, At, B0); PG8_BAR; PG8_SCHED;
            PG8_LDB(B1, 1, 1); PG8_STAGE(PG8_SB(1, 0), b3, voffB);
            PG8_BAR; PG8_WAIT_L(0); PG8_MMA(0, 1, At, B1); PG8_BAR;
            PG8_LDA(At, 1, 1); PG8_STAGE(PG8_SA(1, 0), a3, voffA);
            PG8_BAR; PG8_WAIT_L(0); PG8_MMA(1, 0, At, B0); PG8_BAR; PG8_SCHED;
            PG8_STAGE(PG8_SB(1, 1), b3 + hstepB, voffB);
            PG8_WAIT_V(6); PG8_BAR; PG8_MMA(1, 1, At, B1); PG8_BAR;
            }
        }
        if constexpr (ALIGN_EPI) { if (wr == 0) PG8_BAR; }
        if constexpr (!Epi::AFTER_DRAIN) { E(acc, cur, wr, wc, fr, fq); S.done(cur); }
        if (!has_next) break;
#pragma unroll
        for (int a = 0; a < 2; ++a)
#pragma unroll
            for (int b = 0; b < 2; ++b)
#pragma unroll
                for (int m = 0; m < 4; ++m)
#pragma unroll
                    for (int n = 0; n < 2; ++n) acc[a][b][m][n] = (f32x4){0.f, 0.f, 0.f, 0.f};
        cur = nxt; cA = nA; cB = nB; ++ui;
        if constexpr (ALIGN_EPI) { if (wr == 1) PG8_BAR; }
    }
    PG8_WAIT_V(0);
    if constexpr (!ALIGN_EPI) { if (wr == 0) PG8_BAR; }
    PG8_BAR;
#undef PG8_SA
#undef PG8_SB
#undef PG8_STAGE
#undef PG8_LDA
#undef PG8_LDB
#undef PG8_MMA
#undef PG8_WAIT_V
#undef PG8_WAIT_L
#undef PG8_BAR
#undef PG8_SCHED
}

template <int MODE> struct Epi {
    static constexpr bool PERM = false, AFTER_DRAIN = false;
    const float* rowsrc; float inv_n; float* ss; bf16_t* ob; int ldc; float* of; const float* xin;
    __device__ __forceinline__ void operator()(const f32x4 (&acc)[2][2][4][2], const Unit& u, int wr, int wc, int fr, int fq) const {
#pragma unroll
        for (int ai = 0; ai < 2; ++ai)
#pragma unroll
            for (int m = 0; m < 4; ++m) {
                const int row = u.pm * BM + ai * HALF + wr * 64 + m * 16 + fr;
                float rs = 1.f;
                if (MODE == 1) rs = rowsrc[row];
                if (MODE == 2 || MODE == 5) rs = rsqrtf(rowsrc[row] * inv_n + EPS);
                float ssq = 0.f;
#pragma unroll
                for (int bj = 0; bj < 2; ++bj)
#pragma unroll
                    for (int n = 0; n < 2; ++n) {
                        const int col = u.pn * BM + bj * HALF + wc * 32 + n * 16 + fq * 4;
                        f32x4 v = acc[ai][bj][m][n] * rs;
                        if (MODE == 1) { if (u.pn < 8) { v[0] = gelu_tanh(v[0]); v[1] = gelu_tanh(v[1]); v[2] = gelu_tanh(v[2]); v[3] = gelu_tanh(v[3]); } }
                        if (MODE == 4) { const f32x4 xr = *(const f32x4*)(xin + (size_t)row * DM + col); v = v + xr; }
                        if (MODE == 1 || MODE == 4) ssq += (v[0] * v[0] + v[1] * v[1]) + (v[2] * v[2] + v[3] * v[3]);
                        if (MODE == 1 || MODE == 2 || MODE == 4) { u32x2 w; w.x = pk2(v[0], v[1]); w.y = pk2(v[2], v[3]); *(u32x2*)(ob + (size_t)row * ldc + col) = w; }
                        if (MODE == 4 || MODE == 5) *(f32x4*)(of + (size_t)row * DM + col) = v;
                    }
                if (MODE == 1) {
                    const int seg = (u.pn >= 4 && u.pn < 8) ? 0 : ((u.pn == 8 || u.pn == 9) ? 1 : (u.pn == 10 ? 2 : -1));
                    if (seg >= 0) { ssq += __shfl_xor(ssq, 16); ssq += __shfl_xor(ssq, 32); if (fq == 0) atomicAdd(ss + seg * S + row, ssq); }
                }
                if (MODE == 4) { ssq += __shfl_xor(ssq, 16); ssq += __shfl_xor(ssq, 32); if (fq == 0) atomicAdd(ss + row, ssq); }
            }
    }
};
}

#define XB_TMO      128
#define XB_XCNT(j)  (256  + 64 * (j))
#define XB_XSUB(j)  (1280 + 64 * (j))
#define XB_XGEN(j)  (2304 + 64 * (j))
#define XB_TOP      3328
#define XB_TOPGEN   3392
#define XCD_BAR_WORDS 3456
#define XB_SPIN_CAP (1u << 18)
__device__ __forceinline__ unsigned xb_ld(unsigned* p)              { return __hip_atomic_load(p, __ATOMIC_RELAXED, __HIP_MEMORY_SCOPE_AGENT); }
__device__ __forceinline__ unsigned xb_add(unsigned* p, unsigned v) { return __hip_atomic_fetch_add(p, v, __ATOMIC_RELAXED, __HIP_MEMORY_SCOPE_AGENT); }
__device__ __forceinline__ unsigned xb_xcc_id() { return (unsigned)__builtin_amdgcn_s_getreg((3 << 11) | 20) & 0xFu; }
#define XB_SPIN(cond, bar) do { unsigned _sp = 0; while (cond) { __builtin_amdgcn_s_sleep(1); \
    if ((++_sp & 255u) == 0u) { if (xb_ld(&(bar)[XB_TMO])) break; if (_sp > XB_SPIN_CAP) { atomicAdd(&(bar)[XB_TMO], 1u); break; } } } } while (0)
struct XcdBarrier { unsigned* bar; unsigned x; volatile LAS unsigned* st; };
__device__ __forceinline__ XcdBarrier xcd_barrier_post(unsigned* bar, volatile LAS unsigned* st) {
    XcdBarrier b; b.bar = bar; b.x = xb_xcc_id(); b.st = st;
    if (threadIdx.x == 0) (void)xb_add(&bar[XB_XCNT(b.x)], 1u);
    return b;
}
__device__ __forceinline__ void xcd_barrier_complete(unsigned* bar, unsigned x, unsigned& nloc, unsigned& nx) {
    const unsigned G = gridDim.x * gridDim.y * gridDim.z;
    unsigned sum, cnt, mine, sp = 0u;
    for (;;) {
        sum = 0u; cnt = 0u; mine = 0u;
#pragma unroll
        for (unsigned j = 0; j < 16; ++j) { const unsigned c = xb_ld(&bar[XB_XCNT(j)]); sum += c; cnt += (c > 0u) ? 1u : 0u; mine = (j == x) ? c : mine; }
        if (sum == G) break;
        __builtin_amdgcn_s_sleep(1);
        if ((++sp & 255u) == 0u) { if (xb_ld(&bar[XB_TMO])) break; if (sp > XB_SPIN_CAP) { atomicAdd(&bar[XB_TMO], 1u); break; } }
    }
    nloc = mine > 0u ? mine : 1u; nx = cnt > 0u ? cnt : 1u;
}
__device__ __forceinline__ void xcd_barrier(const XcdBarrier& b) {
    asm volatile("s_waitcnt vmcnt(0)" ::: "memory");
    __syncthreads();
    if (threadIdx.x == 0) {
        unsigned* bar = b.bar;
        __builtin_amdgcn_s_waitcnt(0);
        unsigned nloc = b.st[0], nx = b.st[1];
        if (nloc == 0u) { xcd_barrier_complete(bar, b.x, nloc, nx); b.st[0] = nloc; b.st[1] = nx; }
        const unsigned old = xb_add(&bar[XB_XSUB(b.x)], 1u);
        const unsigned gen = old / nloc;
        if (old + 1u == (gen + 1u) * nloc) {
            __builtin_amdgcn_fence(__ATOMIC_RELEASE, "agent");
            asm volatile("s_waitcnt vmcnt(0)" ::: "memory");
            const unsigned og = xb_add(&bar[XB_TOP], 1u);
            const unsigned tg = og / nx;
            if (og + 1u == (tg + 1u) * nx) xb_add(&bar[XB_TOPGEN], 1u);
            else XB_SPIN(xb_ld(&bar[XB_TOPGEN]) == tg, bar);
            __builtin_amdgcn_fence(__ATOMIC_ACQUIRE, "agent");
            xb_add(&bar[XB_XGEN(b.x)], 1u);
            asm volatile("s_waitcnt vmcnt(0)" ::: "memory");
        } else {
            XB_SPIN(xb_ld(&bar[XB_XGEN(b.x)]) == gen, bar);
            __builtin_amdgcn_fence(__ATOMIC_ACQUIRE, "agent");
            asm volatile("s_waitcnt vmcnt(0)" ::: "memory");
        }
    }
    __syncthreads();
}

struct Params {
    const float* in[18];
    float* out;
    unsigned char* ws;
    int ph_lo, ph_hi;
};

__device__ __forceinline__ void p0_transpose_item(const float* W, const float* g, int K, int N, bf16_t* WT, LAS float* scr, int item, int lane) {
    const int nblk = N / 32, kb = item / nblk, nb = item % nblk, k0 = 64 * kb, n0 = 32 * nb;
    float wv[32];
#pragma unroll
    for (int i = 0; i < 32; ++i) { const int kk = 2 * i + (lane >> 5); wv[i] = W[(size_t)(k0 + kk) * N + n0 + (lane & 31)]; }
#pragma unroll
    for (int i = 0; i < 32; ++i) { const int kk = 2 * i + (lane >> 5); const float gv = g ? g[k0 + kk] : 1.f; scr[kk * 33 + (lane & 31)] = wv[i] * gv; }
    LDS_WAIT(); asm volatile("" ::: "memory");
    const int c = lane & 7;
#pragma unroll
    for (int j = 0; j < 4; ++j) { const int n = (lane >> 3) + 8 * j; const LAS float* s = scr + (8 * c) * 33 + n;
        u32x4 o; o.x = pk2(s[0 * 33], s[1 * 33]); o.y = pk2(s[2 * 33], s[3 * 33]); o.z = pk2(s[4 * 33], s[5 * 33]); o.w = pk2(s[6 * 33], s[7 * 33]);
        *(u32x4*)(WT + (size_t)(n0 + n) * K + k0 + 8 * c) = o; }
    LDS_WAIT(); asm volatile("" ::: "memory");
}
__device__ __forceinline__ float row_to_bf16(const float* src, const float* g, bf16_t* dst, int lane) {
    float ss = 0.f;
#pragma unroll
    for (int i = 0; i < 8; ++i) {
        const int c = (i * 64 + lane) * 4;
        f32x4 v = *(const f32x4*)(src + c);
        ss += (v[0] * v[0] + v[1] * v[1]) + (v[2] * v[2] + v[3] * v[3]);
        if (g) { const f32x4 gv = *(const f32x4*)(g + c); v = v * gv; }
        u32x2 w; w.x = pk2(v[0], v[1]); w.y = pk2(v[2], v[3]);
        *(u32x2*)(dst + c) = w;
    }
    return ss;
}
constexpr float PEER_USC = 80.0f, PEER_VSC = 5.0f;
constexpr int PEER_ROWB = 1536;
typedef float f32x16v __attribute__((ext_vector_type(16)));
typedef float f32x32v __attribute__((ext_vector_type(32)));
typedef unsigned u32x6 __attribute__((ext_vector_type(6)));
__device__ __forceinline__ void fp6_pack_store(const f32x4 (&x)[8], const f32x4 (&sc)[8], unsigned char* dst, int lane) {
    f32x16v a, b;
#pragma unroll
    for (int i = 0; i < 8; ++i) {
        const f32x4 y = x[i] * sc[i];
#pragma unroll
        for (int q = 0; q < 4; ++q) { const float c = fminf(fmaxf(y[q], -7.5f), 7.5f); const int sl = 4 * i + q; if ((sl & 1) == 0) a[sl >> 1] = c; else b[sl >> 1] = c; }
    }
    const u32x6 pk = __builtin_amdgcn_cvt_scalef32_2xpk16_fp6_f32(a, b, 1.0f);
    *(u32x4*)(dst + lane * 16) = (u32x4){pk[0], pk[1], pk[2], pk[3]};
    *(u32x2*)(dst + 1024 + lane * 8) = (u32x2){pk[4], pk[5]};
}
__device__ __forceinline__ void rows2_to_fp6(const float* s0, const float* s1, const f32x4 (&sc)[8], unsigned char* d0, unsigned char* d1, int lane) {
    f32x4 x0[8], x1[8];
#pragma unroll
    for (int i = 0; i < 8; ++i) { x0[i] = *(const f32x4*)(s0 + (i * 64 + lane) * 4); x1[i] = *(const f32x4*)(s1 + (i * 64 + lane) * 4); }
    fp6_pack_store(x0, sc, d0, lane); fp6_pack_store(x1, sc, d1, lane);
}
__device__ __forceinline__ bf16x8 cvt8(const float* p) {
    const f32x4 a = *(const f32x4*)p, b = *(const f32x4*)(p + 4);
    u32x4 w; w.x = pk2(a[0], a[1]); w.y = pk2(a[2], a[3]); w.z = pk2(b[0], b[1]); w.w = pk2(b[2], b[3]);
    return __builtin_bit_cast(bf16x8, w);
}

__device__ __forceinline__ void prep_late(const Params& p, LAS unsigned char* lds, int gw, int NGW, int wave, int lane) {
    unsigned char* ws = p.ws;
    LAS float* scr = (LAS float*)(lds + wave * 16384);
    {
        constexpr int I_UQ = (512 / 64) * (1536 / 32), I_UKV = (256 / 64) * (2048 / 32), I_OUT = (DM / 64) * (DM / 32);
        constexpr int NIT = I_UQ + I_UKV + I_OUT;
        for (int it = gw; it < NIT; it += NGW) {
            int r = it;
            if (r < I_UQ) { p0_transpose_item(p.in[7], p.in[6], 512, 1536, (bf16_t*)(ws + WS_WUQ), scr, r, lane); continue; } r -= I_UQ;
            if (r < I_UKV) { p0_transpose_item(p.in[9], p.in[8], 256, 2048, (bf16_t*)(ws + WS_WUKV), scr, r, lane); continue; } r -= I_UKV;
            p0_transpose_item(p.in[12], nullptr, DM, DM, (bf16_t*)(ws + WS_WOUT), scr, r, lane);
        }
    }
    {
        const float* wq = p.in[14]; const float* sk = p.in[15]; const float* g2 = p.in[13];
        bf16_t* WsT = (bf16_t*)(ws + WS_WS);
        const int r32 = lane & 31, hh = lane >> 5;
        for (int it = gw; it < 16 * 4 * 64; it += NGW) {
            const int hp = it >> 8, kb = (it >> 6) & 3, nb = it & 63;
            f32x16 acc = {};
            const float* ap = sk + ((size_t)(hp * 128 + kb * 32 + r32)) * 128 + hh * 8;
            const float* bp = wq + ((size_t)(nb * 32 + r32)) * DM + hp * 128 + hh * 8;
#pragma unroll
            for (int s = 0; s < 8; ++s) {
                const bf16x8 a = cvt8(ap + s * 16), b = cvt8(bp + s * 16);
                acc = __builtin_amdgcn_mfma_f32_32x32x16_bf16(a, b, acc, 0, 0, 0);
            }
            const int kcol = nb * 32 + r32; const float gk = g2[kcol];
#pragma unroll
            for (int r = 0; r < 16; ++r) WsT[(size_t)(hp * 128 + kb * 32 + crow(r, hh)) * DM + kcol] = (bf16_t)f2bf(acc[r] * gk);
        }
    }
    {
        float* ct = (float*)(ws + WS_COS); float* st = (float*)(ws + WS_SIN);
        for (int it = gw; it < S * 32 / 64; it += NGW) {
            const int idx = it * 64 + lane, t = idx >> 5, j = idx & 31;
            const float inv_freq = powf(10000.0f, -(float)j / 32.0f);
            const float ang = (float)t * inv_freq;
            float sv, cv; sincosf(ang, &sv, &cv); ct[idx] = cv; st[idx] = sv;
        }
    }
}
__device__ __forceinline__ void phase0(const Params& p, LAS unsigned char* lds, bool late_ok, int gw, int NGW, int wave, int lane) {
    unsigned char* ws = p.ws;
    LAS float* scr = (LAS float*)(lds + wave * 16384);
    const float* x = p.in[0];
    {
        constexpr int I_IN = (DM / 64) * (NIN / 32);
        for (int it = gw; it < I_IN; it += NGW) p0_transpose_item(p.in[2], p.in[1], DM, NIN, (bf16_t*)(ws + WS_WIN), scr, it, lane);
    }
    if (!late_ok) prep_late(p, lds, gw, NGW, wave, lane);
    for (int r = gw; r < NINP - NIN; r += NGW) {
        bf16_t* d = (bf16_t*)(ws + WS_WIN) + (size_t)(NIN + r) * DM;
#pragma unroll
        for (int i = 0; i < 4; ++i) *(u32x4*)(d + (i * 64 + lane) * 8) = (u32x4){0u, 0u, 0u, 0u};
    }
    {
        bf16_t* xb = (bf16_t*)(ws + WS_XB); float* rstd1 = (float*)(ws + WS_RSTD1);
        for (int t = gw; t + NGW < S; t += 2 * NGW) {
            const int t1 = t + NGW;
            f32x4 a[8], b[8];
#pragma unroll
            for (int i = 0; i < 8; ++i) { a[i] = *(const f32x4*)(x + (size_t)t * DM + (i * 64 + lane) * 4); b[i] = *(const f32x4*)(x + (size_t)t1 * DM + (i * 64 + lane) * 4); }
            float sa = 0.f, sb = 0.f;
#pragma unroll
            for (int i = 0; i < 8; ++i) {
                sa += (a[i][0] * a[i][0] + a[i][1] * a[i][1]) + (a[i][2] * a[i][2] + a[i][3] * a[i][3]);
                sb += (b[i][0] * b[i][0] + b[i][1] * b[i][1]) + (b[i][2] * b[i][2] + b[i][3] * b[i][3]);
                u32x2 wa, wb; wa.x = pk2(a[i][0], a[i][1]); wa.y = pk2(a[i][2], a[i][3]); wb.x = pk2(b[i][0], b[i][1]); wb.y = pk2(b[i][2], b[i][3]);
                *(u32x2*)(xb + (size_t)t * DM + (i * 64 + lane) * 4) = wa; *(u32x2*)(xb + (size_t)t1 * DM + (i * 64 + lane) * 4) = wb;
            }
            sa = wave_sum(sa); sb = wave_sum(sb);
            if (lane == 0) { rstd1[t] = rsqrtf(sa * (1.0f / DM) + EPS); rstd1[t1] = rsqrtf(sb * (1.0f / DM) + EPS); }
        }
    }
    {
        unsigned char* UT = ws + WS_UT; unsigned char* VT = ws + WS_VT;
        f32x4 sc[8];
#pragma unroll
        for (int i = 0; i < 8; ++i) sc[i] = *(const f32x4*)(p.in[13] + (i * 64 + lane) * 4) * PEER_USC;
        for (int e = gw; e + NGW < 16384; e += 2 * NGW)
            rows2_to_fp6(p.in[16] + (size_t)e * DM, p.in[16] + (size_t)(e + NGW) * DM, sc, UT + (size_t)e * PEER_ROWB, UT + (size_t)(e + NGW) * PEER_ROWB, lane);
#pragma unroll
        for (int i = 0; i < 8; ++i) sc[i] = (f32x4){PEER_VSC, PEER_VSC, PEER_VSC, PEER_VSC};
        for (int e = gw; e + NGW < 16384; e += 2 * NGW)
            rows2_to_fp6(p.in[17] + (size_t)e * DM, p.in[17] + (size_t)(e + NGW) * DM, sc, VT + (size_t)e * PEER_ROWB, VT + (size_t)(e + NGW) * PEER_ROWB, lane);
    }
}

__device__ __forceinline__ void phase3(const Params& p, int gw, int NGW, int lane) {
    unsigned char* ws = p.ws;
    const bf16_t* qraw = (const bf16_t*)(ws + WS_QRAW); const bf16_t* kvraw = (const bf16_t*)(ws + WS_KVRAW); const bf16_t* proj = (const bf16_t*)(ws + WS_PROJ);
    bf16_t* Qh = (bf16_t*)(ws + WS_QH); bf16_t* Kh = (bf16_t*)(ws + WS_KH);
    const float* ct = (const float*)(ws + WS_COS); const float* st = (const float*)(ws + WS_SIN);
    const bool act = lane < 48, isrope = lane >= 32 && lane < 48, lowhalf = lane < 40;
    const int e0 = act ? 4 * lane : 0;
    const f32x4 gq = *(const f32x4*)(p.in[10] + e0), gk = *(const f32x4*)(p.in[11] + e0);
    const int j0 = isrope ? ((4 * lane - 128) & 31) : 0;
    constexpr float QS = 0.07216878364870322f * 1.4426950408889634f;
    for (int t = gw; t < S; t += NGW) {
        f32x4 cs = {1.f, 1.f, 1.f, 1.f}, sn = {0.f, 0.f, 0.f, 0.f};
        if (isrope) { cs = *(const f32x4*)(ct + t * 32 + j0); sn = *(const f32x4*)(st + t * 32 + j0); }
        u32x2 krw = {0u, 0u};
        if (isrope) krw = *(const u32x2*)(proj + (size_t)t * NINP + 2816 + (4 * lane - 128));
        const f32x4 krope = {bflo(krw.x), bfhi(krw.x), bflo(krw.y), bfhi(krw.y)};
#pragma unroll
        for (int h = 0; h < 8; ++h) {
            u32x2 qw = {0u, 0u};
            if (act) qw = *(const u32x2*)(qraw + (size_t)t * 1536 + h * 192 + e0);
            f32x4 q = {bflo(qw.x), bfhi(qw.x), bflo(qw.y), bfhi(qw.y)};
            float ss = wave_sum_u((q[0] * q[0] + q[1] * q[1]) + (q[2] * q[2] + q[3] * q[3]));
            float rs = rsqrtf(ss * (1.0f / 192.0f) + EPS);
            q = q * gq * rs;
            {
                f32x4 pr;
#pragma unroll
                for (int c = 0; c < 4; ++c) pr[c] = __shfl_xor(q[c], 8);
                const f32x4 r1 = q * cs - pr * sn, r2 = pr * sn + q * cs;
                if (isrope) q = lowhalf ? r1 : r2;
            }
            q = q * QS;
            if (act) { u32x2 w; w.x = pk2(q[0], q[1]); w.y = pk2(q[2], q[3]); *(u32x2*)(Qh + ((size_t)h * S + t) * 192 + e0) = w; }
            u32x2 kw = {0u, 0u};
            if (lane < 32) kw = *(const u32x2*)(kvraw + (size_t)t * 2048 + h * 256 + e0);
            f32x4 k = {bflo(kw.x), bfhi(kw.x), bflo(kw.y), bfhi(kw.y)};
            if (isrope) k = krope;
            ss = wave_sum_u((k[0] * k[0] + k[1] * k[1]) + (k[2] * k[2] + k[3] * k[3]));
            rs = rsqrtf(ss * (1.0f / 192.0f) + EPS);
            k = k * gk * rs;
            {
                f32x4 pr;
#pragma unroll
                for (int c = 0; c < 4; ++c) pr[c] = __shfl_xor(k[c], 8);
                const f32x4 r1 = k * cs - pr * sn, r2 = pr * sn + k * cs;
                if (isrope) k = lowhalf ? r1 : r2;
            }
            if (act) { u32x2 w; w.x = pk2(k[0], k[1]); w.y = pk2(k[2], k[3]); *(u32x2*)(Kh + ((size_t)h * S + t) * 192 + e0) = w; }
        }
    }
}

constexpr int KP = 400, VP = 320;
template <int OFF> __device__ __forceinline__ s16x4 tr_read(unsigned addr) {
    s16x4 r; asm volatile("ds_read_b64_tr_b16 %0, %1 offset:%2" : "=&v"(r) : "v"(addr), "i"(OFF) : "memory"); return r;
}
__device__ __forceinline__ unsigned cvtpk(float lo, float hi) { unsigned r; asm volatile("v_cvt_pk_bf16_f32 %0, %1, %2" : "=v"(r) : "v"(lo), "v"(hi)); return r; }
#define PK8(L, H) ((bf16x8){L[0], L[1], L[2], L[3], H[0], H[1], H[2], H[3]})
constexpr float ATT_THR = 8.0f;

constexpr int ATT_KB = 64 * KP, ATT_VB = 64 * VP;
constexpr int ATT_VOFF = 2 * ATT_KB;
__device__ __forceinline__ float xhalf_max(float v) {
    auto rr = __builtin_amdgcn_permlane32_swap(__builtin_bit_cast(unsigned, v), __builtin_bit_cast(unsigned, v), false, false);
    return fmaxf(__builtin_bit_cast(float, rr[0]), __builtin_bit_cast(float, rr[1]));
}
__device__ __forceinline__ float xhalf_sum(float v) {
    auto rr = __builtin_amdgcn_permlane32_swap(__builtin_bit_cast(unsigned, v), __builtin_bit_cast(unsigned, v), false, false);
    return __builtin_bit_cast(float, rr[0]) + __builtin_bit_cast(float, rr[1]);
}
template <int OFF> __device__ __forceinline__ bf16x8 lds_read128(unsigned addr) {
    bf16x8 r; asm volatile("ds_read_b128 %0, %1 offset:%2" : "=&v"(r) : "v"(addr), "i"(OFF) : "memory"); return r;
}
#define LGKM_WAIT(n) do { asm volatile("s_waitcnt lgkmcnt(" #n ")" ::: "memory"); SBAR(); } while (0)
__device__ __forceinline__ f32x16 att_qk(unsigned kaddr, const bf16x8 (&qr)[12]) {
    f32x16 p = {};
    bf16x8 a0 = lds_read128<0>(kaddr), a1 = lds_read128<32>(kaddr), a2 = lds_read128<64>(kaddr), a3 = lds_read128<96>(kaddr);
    LGKM_WAIT(3); p = __builtin_amdgcn_mfma_f32_32x32x16_bf16(a0, qr[0], p, 0, 0, 0); a0 = lds_read128<128>(kaddr);
    LGKM_WAIT(3); p = __builtin_amdgcn_mfma_f32_32x32x16_bf16(a1, qr[1], p, 0, 0, 0); a1 = lds_read128<160>(kaddr);
    LGKM_WAIT(3); p = __builtin_amdgcn_mfma_f32_32x32x16_bf16(a2, qr[2], p, 0, 0, 0); a2 = lds_read128<192>(kaddr);
    LGKM_WAIT(3); p = __builtin_amdgcn_mfma_f32_32x32x16_bf16(a3, qr[3], p, 0, 0, 0); a3 = lds_read128<224>(kaddr);
    LGKM_WAIT(3); p = __builtin_amdgcn_mfma_f32_32x32x16_bf16(a0, qr[4], p, 0, 0, 0); a0 = lds_read128<256>(kaddr);
    LGKM_WAIT(3); p = __builtin_amdgcn_mfma_f32_32x32x16_bf16(a1, qr[5], p, 0, 0, 0); a1 = lds_read128<288>(kaddr);
    LGKM_WAIT(3); p = __builtin_amdgcn_mfma_f32_32x32x16_bf16(a2, qr[6], p, 0, 0, 0); a2 = lds_read128<320>(kaddr);
    LGKM_WAIT(3); p = __builtin_amdgcn_mfma_f32_32x32x16_bf16(a3, qr[7], p, 0, 0, 0); a3 = lds_read128<352>(kaddr);
    LGKM_WAIT(3); p = __builtin_amdgcn_mfma_f32_32x32x16_bf16(a0, qr[8], p, 0, 0, 0);
    LGKM_WAIT(2); p = __builtin_amdgcn_mfma_f32_32x32x16_bf16(a1, qr[9], p, 0, 0, 0);
    LGKM_WAIT(1); p = __builtin_amdgcn_mfma_f32_32x32x16_bf16(a2, qr[10], p, 0, 0, 0);
    LGKM_WAIT(0); p = __builtin_amdgcn_mfma_f32_32x32x16_bf16(a3, qr[11], p, 0, 0, 0);
    return p;
}
__device__ __forceinline__ void att_finish(f32x16& s, float m, float& lsum, bf16x8& pb0, bf16x8& pb1) {
    float ps = 0.f;
#pragma unroll
    for (int r = 0; r < 16; ++r) { s[r] = __builtin_amdgcn_exp2f(s[r] - m); ps += s[r]; }
    lsum += xhalf_sum(ps);
    u32x4 w0 = {cvtpk(s[0], s[1]), cvtpk(s[2], s[3]), cvtpk(s[4], s[5]), cvtpk(s[6], s[7])};
    u32x4 w1 = {cvtpk(s[8], s[9]), cvtpk(s[10], s[11]), cvtpk(s[12], s[13]), cvtpk(s[14], s[15])};
    pb0 = __builtin_bit_cast(bf16x8, w0); pb1 = __builtin_bit_cast(bf16x8, w1);
}
__device__ __forceinline__ void att_pv(unsigned vaddr, bf16x8 pb0, bf16x8 pb1, f32x16 (&o)[4]) {
#define VOFF(d0, s, hi) (((16 * (s) + 8 * (hi)) * VP) + 64 * (d0))
    const s16x4 a00l = tr_read<VOFF(0, 0, 0)>(vaddr), a00h = tr_read<VOFF(0, 0, 1)>(vaddr), a01l = tr_read<VOFF(0, 1, 0)>(vaddr), a01h = tr_read<VOFF(0, 1, 1)>(vaddr);
    const s16x4 a10l = tr_read<VOFF(1, 0, 0)>(vaddr), a10h = tr_read<VOFF(1, 0, 1)>(vaddr), a11l = tr_read<VOFF(1, 1, 0)>(vaddr), a11h = tr_read<VOFF(1, 1, 1)>(vaddr);
    LGKM_WAIT(4);
    o[0] = __builtin_amdgcn_mfma_f32_32x32x16_bf16(PK8(a00l, a00h), pb0, o[0], 0, 0, 0); o[0] = __builtin_amdgcn_mfma_f32_32x32x16_bf16(PK8(a01l, a01h), pb1, o[0], 0, 0, 0);
    const s16x4 a20l = tr_read<VOFF(2, 0, 0)>(vaddr), a20h = tr_read<VOFF(2, 0, 1)>(vaddr), a21l = tr_read<VOFF(2, 1, 0)>(vaddr), a21h = tr_read<VOFF(2, 1, 1)>(vaddr);
    LGKM_WAIT(4);
    o[1] = __builtin_amdgcn_mfma_f32_32x32x16_bf16(PK8(a10l, a10h), pb0, o[1], 0, 0, 0); o[1] = __builtin_amdgcn_mfma_f32_32x32x16_bf16(PK8(a11l, a11h), pb1, o[1], 0, 0, 0);
    const s16x4 a30l = tr_read<VOFF(3, 0, 0)>(vaddr), a30h = tr_read<VOFF(3, 0, 1)>(vaddr), a31l = tr_read<VOFF(3, 1, 0)>(vaddr), a31h = tr_read<VOFF(3, 1, 1)>(vaddr);
    LGKM_WAIT(4);
    o[2] = __builtin_amdgcn_mfma_f32_32x32x16_bf16(PK8(a20l, a20h), pb0, o[2], 0, 0, 0); o[2] = __builtin_amdgcn_mfma_f32_32x32x16_bf16(PK8(a21l, a21h), pb1, o[2], 0, 0, 0);
    LGKM_WAIT(0);
    o[3] = __builtin_amdgcn_mfma_f32_32x32x16_bf16(PK8(a30l, a30h), pb0, o[3], 0, 0, 0); o[3] = __builtin_amdgcn_mfma_f32_32x32x16_bf16(PK8(a31l, a31h), pb1, o[3], 0, 0, 0);
#undef VOFF
}
__device__ __forceinline__ void att_partial(const f32x16& s, float& m, float& lsum, f32x16 (&o)[4]) {
    float pmax = s[0];
#pragma unroll
    for (int r = 1; r < 16; ++r) pmax = fmaxf(pmax, s[r]);
    pmax = xhalf_max(pmax);
    if (!__all(pmax - m <= ATT_THR)) {
        const float mn = fmaxf(m, pmax); const float alpha = __builtin_amdgcn_exp2f(m - mn); m = mn; lsum *= alpha;
#pragma unroll
        for (int d = 0; d < 4; ++d)
#pragma unroll
            for (int r = 0; r < 16; ++r) o[d][r] *= alpha;
    }
}

__device__ __forceinline__ void attn_unit(const Params& p, LAS unsigned char* lds, int head, int qb, int tid, int wave, int lane) {
    unsigned char* ws = p.ws;
    const bf16_t* Qh = (const bf16_t*)(ws + WS_QH); const bf16_t* Kh = (const bf16_t*)(ws + WS_KH);
    bf16_t* mix = (bf16_t*)(ws + WS_MIX);
    const int rg = wave & 3, kh = wave >> 2, r32 = lane & 31, hh = lane >> 5;
    const int q0row = qb * 128 + rg * 32;
    bf16x8 qr[12];
    {
        const bf16_t* qp = Qh + ((size_t)head * S + q0row + r32) * 192 + hh * 8;
#pragma unroll
        for (int ks = 0; ks < 12; ++ks) qr[ks] = *(const bf16x8*)(qp + ks * 16);
    }
    const int ntiles = 2 * qb + 2, mylast = 2 * qb + (rg >> 1);
    float m = -1e30f, lsum = 0.f; f32x16 o[4] = {};
    const int srow = tid >> 3, sch = tid & 7;
    const int kg0 = srow * 192 + sch * 8, kl0 = srow * KP + sch * 16, vg0 = srow * 2048 + sch * 8, vl0 = ATT_VOFF + srow * VP + sch * 16;
    const bf16_t* kbase = Kh + (size_t)head * S * 192; const bf16_t* vbase = (const bf16_t*)(ws + WS_KVRAW) + head * 256 + 128;
    u32x4 sk0, sk1, sk2, sv0, sv1;
#define ATT_LOAD(t) do { const bf16_t* kt = kbase + (size_t)(t) * 64 * 192 + kg0; const bf16_t* vt = vbase + (size_t)(t) * 64 * 2048 + vg0; \
        sk0 = *(const u32x4*)(kt); sk1 = *(const u32x4*)(kt + 64); sk2 = *(const u32x4*)(kt + 128); sv0 = *(const u32x4*)(vt); sv1 = *(const u32x4*)(vt + 64); } while (0)
#define ATT_WRITE(kb_, vb_) do { LAS unsigned char* bk = lds + (kb_) * ATT_KB + kl0; LAS unsigned char* bv = lds + (vb_) * ATT_VB + vl0; *(LAS u32x4*)(bk) = sk0; *(LAS u32x4*)(bk + 128) = sk1; *(LAS u32x4*)(bk + 256) = sk2; \
        *(LAS u32x4*)(bv) = sv0; *(LAS u32x4*)(bv + 128) = sv1; } while (0)
    const unsigned ldsbase = (unsigned)(size_t)lds;
    const unsigned kaddr0 = ldsbase + (unsigned)((32 * kh + r32) * KP + hh * 16);
    const unsigned vrel = (unsigned)(ATT_VOFF + (32 * kh + 4 * hh + ((lane & 15) >> 2)) * VP + (16 * ((lane >> 4) & 1) + 4 * (lane & 3)) * 2);
    ATT_LOAD(0); ATT_WRITE(0, 0); __syncthreads();
    bf16x8 pb0, pb1;
    const bool more0 = (1 < ntiles);
    if (more0) ATT_LOAD(1);
    f32x16 sprev = att_qk(kaddr0, qr);
    att_partial(sprev, m, lsum, o);
    if (more0) ATT_WRITE(1, 1);
    __syncthreads();
    int vprev = 0, vcur = 1;
#pragma unroll 1
    for (int t = 1; t <= ntiles; ++t) {
        const bool more = (t + 1 < ntiles);
        if (more) ATT_LOAD(t + 1);
        f32x16 sc;
        if (t <= mylast) sc = att_qk(kaddr0 + (t & 1) * ATT_KB, qr);
        else {
#pragma unroll
            for (int r = 0; r < 16; ++r) sc[r] = -1e30f;
        }
        att_finish(sprev, m, lsum, pb0, pb1);
        att_pv(ldsbase + vprev * ATT_VB + vrel, pb0, pb1, o);
        att_partial(sc, m, lsum, o);
        sprev = sc;
        const int vnext = (vcur == 2) ? 0 : vcur + 1;
        if (more) ATT_WRITE((t + 1) & 1, vnext);
        vprev = vcur; vcur = vnext;
        __syncthreads();
    }
#undef ATT_LOAD
#undef ATT_WRITE
    LAS float* scr = (LAS float*)lds + (size_t)rg * 66 * 64 + lane;
    if (kh == 1) {
        scr[0] = m; scr[64] = lsum;
#pragma unroll
        for (int d = 0; d < 4; ++d)
#pragma unroll
            for (int r = 0; r < 16; ++r) scr[(2 + d * 16 + r) * 64] = o[d][r];
    }
    __syncthreads();
    if (kh == 0) {
        const float m2 = scr[0], l2 = scr[64];
        const float mn = fmaxf(m, m2), a1 = __builtin_amdgcn_exp2f(m - mn), a2 = __builtin_amdgcn_exp2f(m2 - mn);
        const float inv = 1.0f / (lsum * a1 + l2 * a2);
        bf16_t* op = mix + (size_t)(q0row + r32) * DM + 1024 + head * 128 + 4 * hh;
#pragma unroll
        for (int d = 0; d < 4; ++d)
#pragma unroll
            for (int g4 = 0; g4 < 4; ++g4) {
                float v[4];
#pragma unroll
                for (int i = 0; i < 4; ++i) { const int r = 4 * g4 + i; v[i] = (o[d][r] * a1 + scr[(2 + d * 16 + r) * 64] * a2) * inv; }
                u32x2 w; w.x = pk2(v[0], v[1]); w.y = pk2(v[2], v[3]);
                *(u32x2*)(op + 32 * d + 8 * g4) = w;
            }
    }
    __syncthreads();
}

__device__ __forceinline__ void gmlp_unit(const Params& p, LAS unsigned char* lds, int nb, int h, int tid, int wave, int lane) {
    unsigned char* ws = p.ws;
    const bf16_t* proj = (const bf16_t*)(ws + WS_PROJ); bf16_t* mix = (bf16_t*)(ws + WS_MIX);
    const float* ssv = (const float*)(ws + WS_ROWSS);
    const float* vg = p.in[3]; const float* wsp = p.in[4]; const float* bs = p.in[5];
#pragma unroll
    for (int i = 0; i < 4; ++i) {
        const int pc = tid + 512 * i, r = pc >> 4, c = pc & 15, t = nb * 128 + r;
        const u32x4 w = *(const u32x4*)(proj + (size_t)t * NINP + 1024 + h * 128 + c * 8);
        const float rs = rsqrtf(ssv[t] * (1.0f / 1024.0f) + EPS);
        const f32x4 g0 = *(const f32x4*)(vg + h * 128 + c * 8), g1 = *(const f32x4*)(vg + h * 128 + c * 8 + 4);
        u32x4 ov;
        ov.x = pk2(bflo(w.x) * rs * g0[0], bfhi(w.x) * rs * g0[1]); ov.y = pk2(bflo(w.y) * rs * g0[2], bfhi(w.y) * rs * g0[3]);
        ov.z = pk2(bflo(w.z) * rs * g1[0], bfhi(w.z) * rs * g1[1]); ov.w = pk2(bflo(w.w) * rs * g1[2], bfhi(w.w) * rs * g1[3]);
        *(LAS u32x4*)(lds + r * VP + c * 16) = ov;
    }
    __syncthreads();
    const int ib = wave & 3, ch = wave >> 2, r32 = lane & 31, hh = lane >> 5;
    const int irow = 32 * ib + r32;
    f32x16 acc0 = {}, acc1 = {};
    const unsigned vaddr = (unsigned)(size_t)lds + (unsigned)((8 * hh + ((lane & 15) >> 2)) * VP + (64 * ch + 16 * ((lane >> 4) & 1) + 4 * (lane & 3)) * 2);
    const float* wrow = wsp + ((size_t)h * 128 + irow) * 128 + hh * 8;
#define GSTEP(s) do { if ((s) < 2 * (ib + 1)) { \
        const f32x4 wa = *(const f32x4*)(wrow + (s) * 16), wb = *(const f32x4*)(wrow + (s) * 16 + 4); const int j0 = (s) * 16 + hh * 8; \
        u32x4 aw; aw.x = pk2(j0 + 0 <= irow ? wa[0] : 0.f, j0 + 1 <= irow ? wa[1] : 0.f); aw.y = pk2(j0 + 2 <= irow ? wa[2] : 0.f, j0 + 3 <= irow ? wa[3] : 0.f); \
        aw.z = pk2(j0 + 4 <= irow ? wb[0] : 0.f, j0 + 5 <= irow ? wb[1] : 0.f); aw.w = pk2(j0 + 6 <= irow ? wb[2] : 0.f, j0 + 7 <= irow ? wb[3] : 0.f); \
        const bf16x8 af = __builtin_bit_cast(bf16x8, aw); \
        const s16x4 b0l = tr_read<(16 * (s)) * VP>(vaddr), b0h = tr_read<(16 * (s) + 4) * VP>(vaddr), b1l = tr_read<(16 * (s)) * VP + 64>(vaddr), b1h = tr_read<(16 * (s) + 4) * VP + 64>(vaddr); \
        LDS_WAIT(); SBAR(); \
        acc0 = __builtin_amdgcn_mfma_f32_32x32x16_bf16(af, PK8(b0l, b0h), acc0, 0, 0, 0); acc1 = __builtin_amdgcn_mfma_f32_32x32x16_bf16(af, PK8(b1l, b1h), acc1, 0, 0, 0); } } while (0)
    GSTEP(0); GSTEP(1); GSTEP(2); GSTEP(3); GSTEP(4); GSTEP(5); GSTEP(6); GSTEP(7);
#undef GSTEP
#pragma unroll
    for (int r = 0; r < 16; ++r) {
        const int i = 32 * ib + crow(r, hh), t = nb * 128 + i; const float b = bs[h * 128 + i];
        const int c0 = h * 128 + 64 * ch + r32;
        const float u0 = bf2f(proj[(size_t)t * NINP + c0]), u1 = bf2f(proj[(size_t)t * NINP + c0 + 32]);
        mix[(size_t)t * DM + c0] = (bf16_t)f2bf(u0 * (acc0[r] + b)); mix[(size_t)t * DM + c0 + 32] = (bf16_t)f2bf(u1 * (acc1[r] + b));
    }
    __syncthreads();
}

__device__ __forceinline__ void phase7(const Params& p, LAS unsigned char* lds, int gw, int NGW, int wave, int lane) {
    unsigned char* ws = p.ws;
    const float* sc = (const float*)(ws + WS_SC); int* ex = (int*)(ws + WS_EXP); float* gt = (float*)(ws + WS_GATE);
    const float NEG = -3.0e38f;
    LAS float* sl = (LAS float*)(lds + wave * 1024);
    const int j8 = lane & 7, g8 = lane >> 3, row = lane >> 4, i16 = lane & 15;
    int ci[4], cj[4]; bool cval[4];
    {
        constexpr int starts[16] = {0, 16, 24, 29, 33, 36, 38, 40, 42, 43, 44, 45, 46, 47, 48, 49};
#pragma unroll
        for (int m = 0; m < 4; ++m) {
            const int c = i16 + 16 * m; int a = 0, st = 0;
#pragma unroll
            for (int i = 1; i < 16; ++i) if (c >= starts[i]) { a = i; st = starts[i]; }
            cval[m] = c < 50; ci[m] = cval[m] ? a : 0; cj[m] = cval[m] ? (c - st) : 0;
        }
    }
    constexpr int NT = S * 2;
    f32x4 nx0, nx1, nx2, nx3;
    if (gw < NT) { const float* b = sc + (size_t)(gw >> 1) * DM + (gw & 1) * 1024 + lane * 16; nx0 = *(const f32x4*)b; nx1 = *(const f32x4*)(b + 4); nx2 = *(const f32x4*)(b + 8); nx3 = *(const f32x4*)(b + 12); }
    for (int it = gw; it < NT; it += NGW) {
        const int t = it >> 1, hh = it & 1;
        float v[16];
#pragma unroll
        for (int q = 0; q < 4; ++q) { v[q] = nx0[q]; v[4 + q] = nx1[q]; v[8 + q] = nx2[q]; v[12 + q] = nx3[q]; }
        if (it + NGW < NT) { const int it2 = it + NGW; const float* b = sc + (size_t)(it2 >> 1) * DM + (it2 & 1) * 1024 + lane * 16;
            nx0 = *(const f32x4*)b; nx1 = *(const f32x4*)(b + 4); nx2 = *(const f32x4*)(b + 8); nx3 = *(const f32x4*)(b + 12); }
#pragma unroll
        for (int m = 0; m < 16; ++m) v[m] = __builtin_bit_cast(float, (__builtin_bit_cast(unsigned, v[m]) & ~127u) | (unsigned)(16 * j8 + m));
        float ra = 0.f, rb = 0.f;
#pragma unroll
        for (int k = 0; k < 16; ++k) {
            float mx = fmaxf(fmaxf(fmaxf(v[0], v[1]), fmaxf(v[2], v[3])), fmaxf(fmaxf(v[4], v[5]), fmaxf(v[6], v[7])));
            mx = fmaxf(mx, fmaxf(fmaxf(fmaxf(v[8], v[9]), fmaxf(v[10], v[11])), fmaxf(fmaxf(v[12], v[13]), fmaxf(v[14], v[15]))));
            mx = fmaxf(mx, dpp_f<0xB1, 0xf>(mx, mx));
            mx = fmaxf(mx, dpp_f<0x4E, 0xf>(mx, mx));
            mx = fmaxf(mx, dpp_f<0x141, 0xf>(mx, mx));
#pragma unroll
            for (int m = 0; m < 16; ++m) v[m] = (v[m] == mx) ? NEG : v[m];
            if (k < 8) ra = (j8 == k) ? mx : ra; else rb = (j8 == k - 8) ? mx : rb;
        }
        sl[g8 * 16 + j8] = ra; sl[g8 * 16 + 8 + j8] = rb;
        LDS_WAIT(); asm volatile("" ::: "memory");
        float cv[4], og[4]; int id[4];
#pragma unroll
        for (int m = 0; m < 4; ++m) {
            const float s1 = sl[(2 * row) * 16 + ci[m]], s2 = sl[(2 * row + 1) * 16 + cj[m]];
            og[m] = cval[m] ? (s1 + s2) : NEG; cv[m] = og[m];
            id[m] = (int)((__builtin_bit_cast(unsigned, s1) & 127u) * 128u + (__builtin_bit_cast(unsigned, s2) & 127u));
        }
        LDS_WAIT(); asm volatile("" ::: "memory");
        float M0 = 0.f;
#pragma unroll
        for (int k = 0; k < 16; ++k) {
            float mx = fmaxf(fmaxf(cv[0], cv[1]), fmaxf(cv[2], cv[3]));
            mx = fmaxf(mx, dpp_f<0xB1, 0xf>(mx, mx));
            mx = fmaxf(mx, dpp_f<0x4E, 0xf>(mx, mx));
            mx = fmaxf(mx, dpp_f<0x141, 0xf>(mx, mx));
            mx = fmaxf(mx, dpp_f<0x140, 0xf>(mx, mx));
            if (k == 0) M0 = mx;
#pragma unroll
            for (int m = 0; m < 4; ++m) cv[m] = (cv[m] == mx) ? NEG : cv[m];
        }
        bool sel[4]; float e[4]; float es = 0.f;
#pragma unroll
        for (int m = 0; m < 4; ++m) { sel[m] = (cv[m] != og[m]); e[m] = sel[m] ? __expf(og[m] - M0) : 0.f; es += e[m]; }
        es += dpp_f<0xB1, 0xf>(0.f, es); es += dpp_f<0x4E, 0xf>(0.f, es); es += dpp_f<0x141, 0xf>(0.f, es); es += dpp_f<0x140, 0xf>(0.f, es);
        const float inv = 1.0f / es;
        int basepos = 0;
        const int head = 4 * hh + row;
#pragma unroll
        for (int m = 0; m < 4; ++m) {
            const unsigned long long bl = __ballot(sel[m]);
            const unsigned rbits = (unsigned)(bl >> (16 * row)) & 0xffffu;
            const int pos = basepos + __popc(rbits & ((1u << i16) - 1u));
            if (sel[m] && pos < 16) { ex[(size_t)t * 128 + head * 16 + pos] = id[m]; gt[(size_t)t * 128 + head * 16 + pos] = e[m] * inv; }
            basepos += __popc(rbits);
        }
    }
}

typedef __bf16 bf16x32v __attribute__((ext_vector_type(32)));
typedef __bf16 bf16x2v __attribute__((ext_vector_type(2)));
typedef float f32x2 __attribute__((ext_vector_type(2)));
#ifndef P8_THROTTLE
#define P8_THROTTLE 0
#endif
constexpr unsigned P8_SLACK = 12;
__device__ __forceinline__ void phase8(const Params& p, LAS unsigned char* lds, float* dst, unsigned xcc, unsigned nwx, int gw, int NGW, int wave, int lane) {
    unsigned char* ws = p.ws;
    const bf16_t* x1b = (const bf16_t*)(ws + WS_X1B); const unsigned char* UT = ws + WS_UT; const unsigned char* VT = ws + WS_VT;
    const int* ex = (const int*)(ws + WS_EXP); const float* gt = (const float*)(ws + WS_GATE); const float* ss2 = (const float*)(ws + WS_ROWSS) + 3 * S;
    const float* out = p.out;
    LAS unsigned char* xl = lds + wave * 16384;
    LAS unsigned* list = (LAS unsigned*)(lds + 131072 + wave * 2048);
    LAS unsigned* hist = (LAS unsigned*)(lds + 147456 + wave * 256);
    for (int tb = gw; tb < S / 4; tb += NGW) {
        const int t0 = tb * 4;
        int id[8]; float gv[8];
#pragma unroll
        for (int r = 0; r < 8; ++r) { const size_t o = (size_t)(t0 + (r >> 1)) * 128 + (r & 1) * 64 + lane; id[r] = ex[o]; gv[r] = gt[o]; }
        const float rs0 = rsqrtf(ss2[t0 + 0] * (1.0f / DM) + EPS) * (1.0f / PEER_USC), rs1 = rsqrtf(ss2[t0 + 1] * (1.0f / DM) + EPS) * (1.0f / PEER_USC);
        const float rs2 = rsqrtf(ss2[t0 + 2] * (1.0f / DM) + EPS) * (1.0f / PEER_USC), rs3 = rsqrtf(ss2[t0 + 3] * (1.0f / DM) + EPS) * (1.0f / PEER_USC);
        hist[lane] = 0u;
        LDS_WAIT(); asm volatile("" ::: "memory");
        unsigned pos[8];
#pragma unroll
        for (int r = 0; r < 8; ++r) pos[r] = __hip_atomic_fetch_add(hist + (id[r] >> 8), 1u, __ATOMIC_RELAXED, __HIP_MEMORY_SCOPE_WORKGROUP);
        LDS_WAIT(); asm volatile("" ::: "memory");
        const unsigned cnt = hist[lane];
        unsigned inc = cnt;
#pragma unroll
        for (int o = 1; o < 64; o <<= 1) { const unsigned n = __shfl_up(inc, o); if (lane >= o) inc += n; }
        LDS_WAIT(); asm volatile("" ::: "memory");
        hist[lane] = inc - cnt;
        LDS_WAIT(); asm volatile("" ::: "memory");
#pragma unroll
        for (int r = 0; r < 8; ++r) { const unsigned d = hist[id[r] >> 8] + pos[r]; list[d] = (unsigned)id[r] | ((unsigned)(r >> 1) << 14) | (f2bf(gv[r]) << 16); }
#pragma unroll
        for (int j = 0; j < 4; ++j)
#pragma unroll
            for (int g = 0; g < 4; ++g) {
                const u32x2 w0 = *(const u32x2*)(x1b + (size_t)(t0 + j) * DM + ((2 * g) * 64 + lane) * 4), w1 = *(const u32x2*)(x1b + (size_t)(t0 + j) * DM + ((2 * g + 1) * 64 + lane) * 4);
                *(LAS u32x4*)(xl + j * 4096 + g * 1024 + lane * 16) = (u32x4){w0.x, w0.y, w1.x, w1.y};
            }
        asm volatile("s_waitcnt vmcnt(0) lgkmcnt(0)" ::: "memory");
        {
            const __amdgpu_buffer_rsrc_t urs = __builtin_amdgcn_make_buffer_rsrc((void*)UT, 0, 16384 * PEER_ROWB, 0x00020000);
            const int vo4 = lane * 16, vo2 = lane * 8 + 1024;
            const bool lb0 = (lane & 1) != 0, lb1 = (lane & 2) != 0, lb2 = (lane & 4) != 0;
#define P8_ULOAD(k, i) do { const unsigned en = (unsigned)__builtin_amdgcn_readfirstlane((int)list[(i)]); uen[k] = en; const int ro = (int)((en & 0x3fffu) * (unsigned)PEER_ROWB); \
            u4[k] = __builtin_amdgcn_raw_buffer_load_b128(urs, vo4, ro, 0); u2[k] = __builtin_amdgcn_raw_buffer_load_b64(urs, vo2, ro, 0); } while (0)
#define P8_UPROC2(k, dk) do { const u32x6 pk = {u4[k][0], u4[k][1], u4[k][2], u4[k][3], u2[k][0], u2[k][1]}; \
            const bf16x32v r_ = __builtin_amdgcn_cvt_scalef32_pk32_bf16_fp6(pk, 1.0f); const LAS unsigned char* xp = xl + ((uen[k] >> 14) & 3u) * 4096 + lane * 16; \
            float d0 = 0.f, d1 = 0.f, d2 = 0.f, d3 = 0.f; \
            _Pragma("unroll") for (int g = 0; g < 4; ++g) { const LAS unsigned* xw = (const LAS unsigned*)(xp + g * 1024); const unsigned x0 = xw[0], x1 = xw[1], x2 = xw[2], x3 = xw[3]; \
                { const bf16x2v uu = {r_[8 * g + 0], r_[8 * g + 1]}; d0 = __builtin_amdgcn_fdot2_f32_bf16(uu, __builtin_bit_cast(bf16x2v, x0), d0, false); } \
                { const bf16x2v uu = {r_[8 * g + 2], r_[8 * g + 3]}; d1 = __builtin_amdgcn_fdot2_f32_bf16(uu, __builtin_bit_cast(bf16x2v, x1), d1, false); } \
                { const bf16x2v uu = {r_[8 * g + 4], r_[8 * g + 5]}; d2 = __builtin_amdgcn_fdot2_f32_bf16(uu, __builtin_bit_cast(bf16x2v, x2), d2, false); } \
                { const bf16x2v uu = {r_[8 * g + 6], r_[8 * g + 7]}; d3 = __builtin_amdgcn_fdot2_f32_bf16(uu, __builtin_bit_cast(bf16x2v, x3), d3, false); } } \
            dd[dk] = (d0 + d1) + (d2 + d3); } while (0)
#if (PROBE_DUP >> 10) & 1
#define P8_UREPS 2
#else
#define P8_UREPS 1
#endif
#pragma unroll 1
            for (int urep = 0; urep < P8_UREPS; ++urep) {
                u32x4 u4[16]; u32x2 u2[16]; unsigned uen[16];
#pragma unroll
                for (int k = 0; k < 16; ++k) P8_ULOAD(k, k);
#pragma unroll 1
                for (int i0 = 0; i0 < 512; i0 += 16) {
#pragma unroll
                    for (int hb = 0; hb < 2; ++hb) {
                        const int i = i0 + 8 * hb;
                        const unsigned ev = list[i + (lane & 7)]; const unsigned jl = (ev >> 14) & 3u;
                        const float gl = __builtin_bit_cast(float, ev & 0xffff0000u), rl = jl == 0u ? rs0 : (jl == 1u ? rs1 : (jl == 2u ? rs2 : rs3));
                        float dd[8];
#pragma unroll
                        for (int k = 0; k < 8; ++k) { P8_UPROC2(8 * hb + k, k); const int nx = i + 16 + k; P8_ULOAD(8 * hb + k, nx < 512 ? nx : 511); }
                        float w4[4], w2[2];
#pragma unroll
                        for (int q = 0; q < 4; ++q) { const float kp = lb2 ? dd[q + 4] : dd[q], sd = lb2 ? dd[q] : dd[q + 4]; w4[q] = kp + __shfl_xor(sd, 4); }
#pragma unroll
                        for (int q = 0; q < 2; ++q) { const float kp = lb1 ? w4[q + 2] : w4[q], sd = lb1 ? w4[q] : w4[q + 2]; w2[q] = kp + __shfl_xor(sd, 2); }
                        float dres; { const float kp = lb0 ? w2[1] : w2[0], sd = lb0 ? w2[0] : w2[1]; dres = kp + __shfl_xor(sd, 1); }
                        dres += __shfl_xor(dres, 8); dres += __shfl_xor(dres, 16); dres += __shfl_xor(dres, 32);
                        const float c_ = gl * gelu_tanh(rl * dres) * (1.0f / PEER_VSC);
                        if (lane < 8 && urep == P8_UREPS - 1) list[i + lane] = (ev & 0xffffu) | (f2bf(c_) << 16);
                    }
                }
            }
#undef P8_ULOAD
#undef P8_UPROC2
        }
        asm volatile("s_waitcnt vmcnt(0)" ::: "memory");
        LDS_WAIT(); asm volatile("" ::: "memory");
        f32x4 acc[32];
#if (PROBE_DUP >> 12) & 1
#define P8_VREPS 2
#else
#define P8_VREPS 1
#endif
#pragma unroll 1
        for (int vrep = 0; vrep < P8_VREPS; ++vrep) {
#pragma unroll
        for (int i = 0; i < 32; ++i) acc[i] = (f32x4){0.f, 0.f, 0.f, 0.f};
        {
            typedef unsigned u32x16 __attribute__((ext_vector_type(16)));
            u32x4 v4[4]; u32x2 v2[4]; unsigned ven[4];
            const unsigned tok = (unsigned)lane & 3u;
            const __amdgpu_buffer_rsrc_t vrs = __builtin_amdgcn_make_buffer_rsrc((void*)VT, 0, 16384 * PEER_ROWB, 0x00020000);
            const int vo4 = lane * 16, vo2 = lane * 8 + 1024;
#define P8_VLOAD(k, i) do { const unsigned en = (unsigned)__builtin_amdgcn_readfirstlane((int)list[(i)]); ven[k] = en; const int ro = (int)((en & 0x3fffu) * (unsigned)PEER_ROWB); \
            v4[k] = __builtin_amdgcn_raw_buffer_load_b128(vrs, vo4, ro, 0); v2[k] = __builtin_amdgcn_raw_buffer_load_b64(vrs, vo2, ro, 0); } while (0)
#define P8_VPROC2(ka, kb) do { const u32x6 pka = {v4[ka][0], v4[ka][1], v4[ka][2], v4[ka][3], v2[ka][0], v2[ka][1]}, pkb = {v4[kb][0], v4[kb][1], v4[kb][2], v4[kb][3], v2[kb][0], v2[kb][1]}; \
            const u32x16 da = __builtin_bit_cast(u32x16, __builtin_amdgcn_cvt_scalef32_pk32_bf16_fp6(pka, 1.0f)), db = __builtin_bit_cast(u32x16, __builtin_amdgcn_cvt_scalef32_pk32_bf16_fp6(pkb, 1.0f)); \
            const unsigned ea = ven[ka], eb = ven[kb]; \
            const unsigned alo = ((((ea >> 14) & 3u) == tok) ? (ea >> 16) : 0u) | ((((eb >> 14) & 3u) == tok) ? (eb & 0xffff0000u) : 0u); \
            const s16x4 av = __builtin_bit_cast(s16x4, (unsigned long long)alo); \
            _Pragma("unroll") for (int m = 0; m < 16; ++m) { \
                const unsigned be = __builtin_amdgcn_perm(db[m], da[m], 0x05040100u), bo = __builtin_amdgcn_perm(db[m], da[m], 0x07060302u); \
                acc[2 * m] = __builtin_amdgcn_mfma_f32_4x4x4bf16_1k(av, __builtin_bit_cast(s16x4, (unsigned long long)be), acc[2 * m], 0, 0, 0); \
                acc[2 * m + 1] = __builtin_amdgcn_mfma_f32_4x4x4bf16_1k(av, __builtin_bit_cast(s16x4, (unsigned long long)bo), acc[2 * m + 1], 0, 0, 0); } } while (0)
#pragma unroll
            for (int k = 0; k < 4; ++k) P8_VLOAD(k, k);
#pragma unroll 1
            for (int i = 0; i < 512; i += 4) {
#pragma unroll
                for (int k = 0; k < 4; k += 2) { P8_VPROC2(k, k + 1); const int nx = i + 4 + k < 512 ? i + 4 + k : 510; P8_VLOAD(k, nx); P8_VLOAD(k + 1, nx + 1); }
            }
#undef P8_VLOAD
#undef P8_VPROC2
        }
        }
        int tq = t0, lq = lane; asm volatile("" : "+s"(tq)); asm volatile("" : "+v"(lq));
#pragma unroll
        for (int j = 0; j < 4; ++j)
#pragma unroll
            for (int i = 0; i < 8; ++i) {
                const size_t o = (size_t)(tq + j) * DM + (i * 64 + lq) * 4;
                f32x4 a = *(const f32x4*)(out + o);
#pragma unroll
                for (int q = 0; q < 4; ++q) a[q] += acc[4 * i + q][j];
                *(f32x4*)(dst + o) = a;
                if (i & 1) asm volatile("" ::: "memory");
            }
        LDS_WAIT(); asm volatile("" ::: "memory");
    }
}

__global__ void __launch_bounds__(NTHREADS, 2) mega(Params p) {
    extern __shared__ __attribute__((aligned(16))) unsigned char lds_raw[];
    LAS unsigned char* lds = (LAS unsigned char*)lds_raw;
    const int tid = threadIdx.x, lane = tid & 63, wave = __builtin_amdgcn_readfirstlane(tid >> 6);
    const int G = gridDim.x, bx = blockIdx.x;
    const int gw = bx * 8 + wave, NGW = G * 8;
    unsigned char* ws = p.ws;
    const int lo = p.ph_lo, hi = p.ph_hi;
    volatile LAS unsigned* misc = (volatile LAS unsigned*)(lds + LDS_MISC);
    if (tid < 4) misc[tid] = 0u;
    __syncthreads();
    const XcdBarrier xbar = xcd_barrier_post((unsigned*)(ws + WS_CTL), misc);
#ifndef PH_MASK
#define PH_MASK 0x1ff
#endif
#define IN(k) (((PH_MASK >> (k)) & 1) && lo <= (k) && (k) < hi)
#define SEAM(k) do { if (IN(k) && IN((k) + 1)) xcd_barrier(xbar); } while (0)

#if (PROBE_DUP >> 0) & 1
    if (IN(0)) { phase0(p, lds, G == 256, gw, NGW, wave, lane); xcd_barrier(xbar); }
#endif
    if (IN(0)) phase0(p, lds, G == 256, gw, NGW, wave, lane);
    SEAM(0);
    if (IN(1)) {
        pg8::Gemm g{(const bf16_t*)(ws + WS_XB), (const bf16_t*)(ws + WS_WIN), S, NINP, DM, DM, DM};
        pg8::StaticOrder So; So.init(S, NINP, G, bx);
        pg8::Epi<1> E{(const float*)(ws + WS_RSTD1), 0.f, (float*)(ws + WS_ROWSS), (bf16_t*)(ws + WS_PROJ), NINP, nullptr, nullptr};
#if (PROBE_DUP >> 1) & 1
        { pg8::Epi<1> E2 = E; E2.ss = (float*)(ws + 512 * 1024); pg8::gemm_phase<pg8::Epi<1>, pg8::StaticOrder, true, true>(lds, g, So, E2); xcd_barrier(xbar); }
#endif
        pg8::gemm_phase<pg8::Epi<1>, pg8::StaticOrder, true, true>(lds, g, So, E);
        if (G == 256 && bx >= 128) { __syncthreads(); prep_late(p, lds, (bx - 128) * 8 + wave, 1024, wave, lane); }
    }
    SEAM(1);
    if (IN(2)) {
        {
            pg8::Gemm g{(const bf16_t*)(ws + WS_PROJ) + 2048, (const bf16_t*)(ws + WS_WUQ), S, 1536, 512, NINP, 512};
            pg8::StaticOrder So; So.init(S, 1536, G, bx);
            pg8::Epi<2> E{(const float*)(ws + WS_ROWSS) + 1 * S, 1.0f / 512.0f, nullptr, (bf16_t*)(ws + WS_QRAW), 1536, nullptr, nullptr};
            pg8::gemm_phase<pg8::Epi<2>, pg8::StaticOrder, true, true>(lds, g, So, E);
        }
        __syncthreads();
        {
            pg8::Gemm g{(const bf16_t*)(ws + WS_PROJ) + 2560, (const bf16_t*)(ws + WS_WUKV), S, 2048, 256, NINP, 256};
            pg8::StaticOrder So; So.init(S, 2048, G, bx);
            pg8::Epi<2> E{(const float*)(ws + WS_ROWSS) + 2 * S, 1.0f / 256.0f, nullptr, (bf16_t*)(ws + WS_KVRAW), 2048, nullptr, nullptr};
            pg8::gemm_phase<pg8::Epi<2>, pg8::StaticOrder, true, true>(lds, g, So, E);
        }
    }
    SEAM(2);
#if (PROBE_DUP >> 3) & 1
    if (IN(3)) { phase3(p, gw, NGW, lane); xcd_barrier(xbar); }
#endif
    if (IN(3)) phase3(p, gw, NGW, lane);
    SEAM(3);
#define P4_BODY_ATT for (int pr = bx; pr < 256; pr += G) { const int head = pr & 7, x = pr >> 3; attn_unit(p, lds, head, 63 - x, tid, wave, lane); attn_unit(p, lds, head, x, tid, wave, lane); }
#define P4_BODY_GMLP for (int u = bx; u < 512; u += G) gmlp_unit(p, lds, u >> 3, u & 7, tid, wave, lane);
#if (PROBE_DUP >> 4) & 1
    if (IN(4)) { P4_BODY_ATT; xcd_barrier(xbar); }
#endif
#if (PROBE_DUP >> 9) & 1
    if (IN(4)) { P4_BODY_GMLP; xcd_barrier(xbar); }
#endif
    if (IN(4)) { P4_BODY_ATT; P4_BODY_GMLP; }
    SEAM(4);
    if (IN(5)) {
        pg8::Gemm g{(const bf16_t*)(ws + WS_MIX), (const bf16_t*)(ws + WS_WOUT), S, DM, DM, DM, DM};
        pg8::StaticOrder So; So.init(S, DM, G, bx);
        pg8::Epi<4> E{nullptr, 0.f, (float*)(ws + WS_ROWSS) + 3 * S, (bf16_t*)(ws + WS_X1B), DM, p.out, p.in[0]};
#if (PROBE_DUP >> 5) & 1
        { pg8::Epi<4> E2 = E; E2.ss = (float*)(ws + 512 * 1024); pg8::gemm_phase<pg8::Epi<4>, pg8::StaticOrder, true, true>(lds, g, So, E2); xcd_barrier(xbar); }
#endif
        pg8::gemm_phase<pg8::Epi<4>, pg8::StaticOrder, true, true>(lds, g, So, E);
    }
    SEAM(5);
    if (IN(6)) {
        pg8::Gemm g{(const bf16_t*)(ws + WS_X1B), (const bf16_t*)(ws + WS_WS), S, DM, DM, DM, DM};
        pg8::StaticOrder So; So.init(S, DM, G, bx);
        pg8::Epi<5> E{(const float*)(ws + WS_ROWSS) + 3 * S, 1.0f / DM, nullptr, nullptr, DM, (float*)(ws + WS_SC), nullptr};
#if (PROBE_DUP >> 6) & 1
        { pg8::gemm_phase<pg8::Epi<5>, pg8::StaticOrder, true, true>(lds, g, So, E); xcd_barrier(xbar); }
#endif
        pg8::gemm_phase<pg8::Epi<5>, pg8::StaticOrder, true, true>(lds, g, So, E);
    }
    SEAM(6);
#if (PROBE_DUP >> 7) & 1
    if (IN(7)) { phase7(p, lds, gw, NGW, wave, lane); xcd_barrier(xbar); }
#endif
    if (IN(7)) phase7(p, lds, gw, NGW, wave, lane);
    SEAM(7);
#if (PROBE_DUP >> 8) & 1
    if (IN(8)) { phase8(p, lds, (float*)(ws + WS_SC), xbar.x, 8u * misc[0], gw, NGW, wave, lane); xcd_barrier(xbar); }
#endif
    if (IN(8)) phase8(p, lds, p.out, xbar.x, 8u * misc[0], gw, NGW, wave, lane);
#undef IN
#undef SEAM
}

extern "C" void kernel_launch(void* const* d_in, const int* in_sizes, int n_in, void* d_out, int out_size, void* d_ws, size_t ws_size, hipStream_t stream) {
    static int grid = 0;
    if (grid == 0) {
        if (n_in != 18 || out_size != S * DM || ws_size < WS_END) { fprintf(stderr, "kernel_launch: unexpected shapes (n_in %d out %d ws %zu)\n", n_in, out_size, ws_size); grid = -1; return; }
        int dev = 0, cus = 0, per_cu = 0;
        hipGetDevice(&dev);
        hipDeviceGetAttribute(&cus, hipDeviceAttributeMultiprocessorCount, dev);
        if (hipFuncSetAttribute((const void*)mega, hipFuncAttributeMaxDynamicSharedMemorySize, LDS_BYTES) != hipSuccess) { fprintf(stderr, "kernel_launch: hipFuncSetAttribute failed\n"); grid = -1; return; }
        if (hipOccupancyMaxActiveBlocksPerMultiprocessor(&per_cu, (const void*)mega, NTHREADS, LDS_BYTES) != hipSuccess || per_cu < 1) { fprintf(stderr, "kernel_launch: occupancy query failed (%d)\n", per_cu); grid = -1; return; }
        grid = cus;
        fprintf(stderr, "kernel_launch: cus %d per_cu %d grid %d\n", cus, per_cu, grid);
    }
    if (grid < 0) return;
    hipMemsetAsync((char*)d_ws + WS_CTL, 0, 1 * MiB, stream);
    Params prm{};
    for (int i = 0; i < 18; ++i) prm.in[i] = (const float*)d_in[i];
    prm.out = (float*)d_out; prm.ws = (unsigned char*)d_ws;
#if MK_ONE_LAUNCH
    prm.ph_lo = 0; prm.ph_hi = NPH;
    { void* args[] = {&prm}; hipError_t e = hipLaunchCooperativeKernel((const void*)mega, dim3(grid), dim3(NTHREADS), args, LDS_BYTES, stream);
      if (e != hipSuccess) fprintf(stderr, "cooperative launch failed: %s\n", hipGetErrorString(e)); }
#else
    for (int ph = 0; ph < NPH; ++ph) {
        prm.ph_lo = ph; prm.ph_hi = ph + 1;
        void* args[] = {&prm};
        hipError_t e = hipLaunchCooperativeKernel((const void*)mega, dim3(grid), dim3(NTHREADS), args, LDS_BYTES, stream);
        if (e != hipSuccess) { fprintf(stderr, "cooperative launch %d failed: %s\n", ph, hipGetErrorString(e)); break; }
    }
#endif
}
```

```cpp
#include <hip/hip_runtime.h>
#include <cstdio>
#include <cstdint>

#define LAS __attribute__((address_space(3)))
typedef unsigned short bf16_t;
typedef short bf16x8 __attribute__((ext_vector_type(8)));
typedef short s16x4 __attribute__((ext_vector_type(4)));
typedef float f32x4 __attribute__((ext_vector_type(4)));
typedef float f32x16 __attribute__((ext_vector_type(16)));
typedef unsigned u32x4 __attribute__((ext_vector_type(4)));
typedef unsigned u32x2 __attribute__((ext_vector_type(2)));

#ifndef PROBE_DUP
#define PROBE_DUP 0
#endif
#ifndef MK_ONE_LAUNCH
#define MK_ONE_LAUNCH 1
#endif

constexpr int S = 8192, DM = 2048, NIN = 2880, NINP = 3072;
constexpr int NPH = 9;
constexpr float EPS = 1e-6f;
constexpr int LDS_BYTES = 163840;
constexpr int NTHREADS = 512;
constexpr int LDS_MISC = 161792;

constexpr size_t MiB = 1u << 20;
constexpr size_t WS_CTL = 0;
constexpr size_t WS_ROWSS = 128 * 1024;
constexpr size_t WS_COS = 1 * MiB, WS_SIN = 2 * MiB;
constexpr size_t WS_RSTD1 = 3 * MiB;
constexpr size_t WS_EXP = 4 * MiB;
constexpr size_t WS_GATE = 8 * MiB;
constexpr size_t WS_WIN = 12 * MiB;
constexpr size_t WS_WUQ = 24 * MiB;
constexpr size_t WS_WUKV = 26 * MiB;
constexpr size_t WS_WOUT = 28 * MiB;
constexpr size_t WS_WS = 36 * MiB;
constexpr size_t WS_XB = 44 * MiB;
constexpr size_t WS_PROJ = 76 * MiB;
constexpr size_t WS_QRAW = 124 * MiB;
constexpr size_t WS_KVRAW = 148 * MiB;
constexpr size_t WS_QH = 180 * MiB;
constexpr size_t WS_KH = 204 * MiB;
constexpr size_t WS_VH = 228 * MiB;
constexpr size_t WS_MIX = 244 * MiB;
constexpr size_t WS_X1B = 276 * MiB;
constexpr size_t WS_SC = 308 * MiB;
constexpr size_t WS_UT = 372 * MiB;
constexpr size_t WS_VT = 436 * MiB;
constexpr size_t WS_END = 500 * MiB;

__device__ __forceinline__ unsigned f2bf(float f) { unsigned u = __builtin_bit_cast(unsigned, f); return (u + 0x7fffu + ((u >> 16) & 1u)) >> 16; }
__device__ __forceinline__ unsigned pk2(float lo, float hi) { return f2bf(lo) | (f2bf(hi) << 16); }
__device__ __forceinline__ float bf2f(unsigned short b) { return __builtin_bit_cast(float, (unsigned)b << 16); }
__device__ __forceinline__ float bflo(unsigned w) { return __builtin_bit_cast(float, w << 16); }
__device__ __forceinline__ float bfhi(unsigned w) { return __builtin_bit_cast(float, w & 0xffff0000u); }
__device__ __forceinline__ float wave_sum(float v) {
#pragma unroll
    for (int o = 32; o > 0; o >>= 1) v += __shfl_xor(v, o);
    return v;
}
__device__ __forceinline__ float wave_max(float v) {
#pragma unroll
    for (int o = 32; o > 0; o >>= 1) v = fmaxf(v, __shfl_xor(v, o));
    return v;
}
template <int CTRL, int ROW_MASK> __device__ __forceinline__ float dpp_f(float old, float v) {
    return __builtin_bit_cast(float, __builtin_amdgcn_update_dpp(__builtin_bit_cast(int, old), __builtin_bit_cast(int, v), CTRL, ROW_MASK, 0xf, false));
}
__device__ __forceinline__ float wave_max_u(float v) {
    v = fmaxf(v, dpp_f<0xB1, 0xf>(v, v));
    v = fmaxf(v, dpp_f<0x4E, 0xf>(v, v));
    v = fmaxf(v, dpp_f<0x141, 0xf>(v, v));
    v = fmaxf(v, dpp_f<0x140, 0xf>(v, v));
    v = fmaxf(v, dpp_f<0x142, 0xa>(v, v));
    v = fmaxf(v, dpp_f<0x143, 0xc>(v, v));
    return __builtin_bit_cast(float, __builtin_amdgcn_readlane(__builtin_bit_cast(int, v), 63));
}
__device__ __forceinline__ float wave_sum_u(float v) {
    v += dpp_f<0xB1, 0xf>(0.f, v);
    v += dpp_f<0x4E, 0xf>(0.f, v);
    v += dpp_f<0x141, 0xf>(0.f, v);
    v += dpp_f<0x140, 0xf>(0.f, v);
    v += dpp_f<0x142, 0xa>(0.f, v);
    v += dpp_f<0x143, 0xc>(0.f, v);
    return __builtin_bit_cast(float, __builtin_amdgcn_readlane(__builtin_bit_cast(int, v), 63));
}
__device__ __forceinline__ float gelu_tanh(float x) {
    const float y = 0.7978845608028654f * (x + 0.044715f * x * x * x);
    return x / (1.0f + __expf(-2.0f * y));
}
__device__ __forceinline__ int crow(int r, int hi) { return (r & 3) + 8 * (r >> 2) + 4 * hi; }
#define LDS_WAIT() asm volatile("s_waitcnt lgkmcnt(0)" ::: "memory")
#define SBAR() __builtin_amdgcn_sched_barrier(0)

namespace pg8 {
#define PG8_LAS __attribute__((address_space(3)))
constexpr int BM = 256, BK = 64, HALF = 128, HTB = HALF * BK * 2  , STAGE_BYTES = 8 * HTB, NXCD = 8, WGM = 8;

__host__ __device__ __forceinline__ int lds_byte(int r, int c) { const int st = (r >> 4) * 2 + (c >> 5), rr = r & 15, cc = c & 31, ob = rr * 64 + cc * 2; return st * 1024 + (ob ^ (((ob >> 9) & 1) << 5)); }
__host__ __device__ __forceinline__ void stage_rc(int b, int& R, int& C) { const int st = b / 1024, sb = b % 1024, swz = sb ^ (((sb >> 9) & 1) << 5); R = (st >> 1) * 16 + swz / 64; C = (st & 1) * 32 + (swz % 64) / 2; }
__host__ __device__ __forceinline__ int perm32(int rho) { const int n = rho >> 4, i = rho & 15; return 8 * (i >> 2) + 4 * n + (i & 3); }

struct Unit { int pm, pn; };
struct Gemm { const bf16_t* A; const bf16_t* Bt; int M, N, K, lda, ldb; };

struct StaticOrder {
    int nM, nN, nwg, G, c;
    __host__ __device__ void init(int M, int N, int G_, int c_) { nM = M / BM; nN = N / BM; nwg = nM * nN; G = G_; c = c_; }
    __host__ __device__ bool next(int i, Unit& u) const {
        const long L = (long)i * G + c; if (L >= nwg) return false;
        int wgid = (int)L; { const int q = nwg / NXCD, r = nwg % NXCD, xcd = wgid % NXCD, off = wgid / NXCD; wgid = (xcd < r ? xcd * (q + 1) : r * (q + 1) + (xcd - r) * q) + off; }
        const int nig = WGM * nN, gid = wgid / nig, fm = gid * WGM, gsz = (nM - fm) < WGM ? (nM - fm) : WGM;
        u.pm = fm + ((wgid % nig) % gsz); u.pn = (wgid % nig) / gsz; return true;
    }
    __device__ __forceinline__ void a_ready(const Unit&) const {}
    __device__ __forceinline__ void done(const Unit&) const {}
};

template <class Epi, class Sched, bool ALIGN_EPI = false, bool SP2 = false>
__device__ __forceinline__ void gemm_phase(PG8_LAS unsigned char* lds, const Gemm g, const Sched& S, const Epi& E) {
    const int tid = threadIdx.x, wid = __builtin_amdgcn_readfirstlane(tid >> 6), lane = tid & 63, wr = wid >> 2, wc = wid & 3, fr = lane & 15, fq = lane >> 4;
    const int K = g.K, nt = K / BK;
    unsigned voffA[2], voffB[2];
#pragma unroll
    for (int i = 0; i < 2; ++i) { int R, C; stage_rc(tid * 16 + i * 8192, R, C); const int Rb = Epi::PERM ? ((R & ~31) + perm32(R & 31)) : R;
        voffA[i] = (unsigned)(R * g.lda + C) * 2u; voffB[i] = (unsigned)(Rb * g.ldb + C) * 2u; }
    const size_t kstep = (size_t)(BK * 2);
    const size_t hstepA = (size_t)HALF * g.lda * 2, hstepB = (size_t)HALF * g.ldb * 2;
    const size_t tstepA = 2 * hstepA, tstepB = 2 * hstepB;
    const unsigned ldsw = (unsigned)wid * 1024u;
    const int aoff = lds_byte(wr * 64 + fr, fq * 8), boff = lds_byte(wc * 32 + fr, fq * 8);
#define PG8_SA(b, h) (((b) * 2 + (h)) * HTB)
#define PG8_SB(b, h) ((4 + (b) * 2 + (h)) * HTB)
#define PG8_STAGE(bufoff, gbase, voff) do { _Pragma("unroll") for (int _i = 0; _i < 2; ++_i) \
        __builtin_amdgcn_global_load_lds((const unsigned*)((const char*)(gbase) + (voff)[_i]), (PG8_LAS unsigned*)(lds + (bufoff) + ldsw + _i * 8192), 16, 0, 0); } while (0)
#define PG8_LDA(dst, b, h) do { _Pragma("unroll") for (int m = 0; m < 4; ++m) _Pragma("unroll") for (int k = 0; k < 2; ++k) dst[m][k] = *(const PG8_LAS bf16x8*)(lds + PG8_SA(b, h) + aoff + m * 2048 + k * 1024); } while (0)
#define PG8_LDB(dst, b, h) do { _Pragma("unroll") for (int n = 0; n < 2; ++n) _Pragma("unroll") for (int k = 0; k < 2; ++k) dst[n][k] = *(const PG8_LAS bf16x8*)(lds + PG8_SB(b, h) + boff + n * 2048 + k * 1024); } while (0)
#define PG8_MMA(ai, bj, At, Bt) do { __builtin_amdgcn_s_setprio(1); _Pragma("unroll") for (int m = 0; m < 4; ++m) _Pragma("unroll") for (int n = 0; n < 2; ++n) _Pragma("unroll") for (int k = 0; k < 2; ++k) \
        acc[ai][bj][m][n] = __builtin_amdgcn_mfma_f32_16x16x32_bf16(Bt[n][k], At[m][k], acc[ai][bj][m][n], 0, 0, 0); __builtin_amdgcn_s_setprio(0); } while (0)
#define PG8_WAIT_V(n) asm volatile("s_waitcnt vmcnt(" #n ")" ::: "memory")
#define PG8_WAIT_L(n) asm volatile("s_waitcnt lgkmcnt(" #n ")" ::: "memory")
#define PG8_BAR __builtin_amdgcn_s_barrier()
#define PG8_SCHED __builtin_amdgcn_sched_barrier(0)
    Unit cur, nxt; int ui = 0;
    if (!S.next(0, cur)) return;
    f32x4 acc[2][2][4][2];
#pragma unroll
    for (int a = 0; a < 2; ++a)
#pragma unroll
        for (int b = 0; b < 2; ++b)
#pragma unroll
            for (int m = 0; m < 4; ++m)
#pragma unroll
                for (int n = 0; n < 2; ++n) acc[a][b][m][n] = (f32x4){0.f, 0.f, 0.f, 0.f};
    bf16x8 At[4][2], B0[2][2], B1[2][2];
    const char* cA = (const char*)g.A + (size_t)cur.pm * tstepA; const char* cB = (const char*)g.Bt + (size_t)cur.pn * tstepB;
    S.a_ready(cur);
    if constexpr (SP2) {
        PG8_STAGE(PG8_SB(0, 0), cB, voffB); PG8_STAGE(PG8_SB(0, 1), cB + hstepB, voffB); PG8_STAGE(PG8_SA(0, 0), cA, voffA); PG8_STAGE(PG8_SA(0, 1), cA + hstepA, voffA);
        if (wr == 1) PG8_BAR;
        PG8_WAIT_V(2); PG8_BAR;
        PG8_STAGE(PG8_SB(1, 0), cB + kstep, voffB); PG8_STAGE(PG8_SA(1, 0), cA + kstep, voffA); PG8_STAGE(PG8_SB(1, 1), cB + hstepB + kstep, voffB);
        PG8_WAIT_V(6); PG8_BAR;
    } else {
        PG8_STAGE(PG8_SB(0, 0), cB, voffB); PG8_STAGE(PG8_SA(0, 0), cA, voffA); PG8_STAGE(PG8_SB(0, 1), cB + hstepB, voffB); PG8_STAGE(PG8_SA(0, 1), cA + hstepA, voffA);
        if (wr == 1) PG8_BAR;
        PG8_WAIT_V(4); PG8_BAR;
        PG8_STAGE(PG8_SB(1, 0), cB + kstep, voffB); PG8_STAGE(PG8_SA(1, 0), cA + kstep, voffA); PG8_STAGE(PG8_SB(1, 1), cB + hstepB + kstep, voffB);
        PG8_WAIT_V(6); PG8_BAR;
    }
    for (;;) {
        const bool has_next = S.next(ui + 1, nxt);
        const char* nA = has_next ? (const char*)g.A + (size_t)nxt.pm * tstepA : cA; const char* nB = has_next ? (const char*)g.Bt + (size_t)nxt.pn * tstepB : cB;
        for (int t = 0; t < nt; t += 2) {
            const bool last = (t == nt - 2);
            const char* a1 = cA + (size_t)(t + 1) * kstep;
            const char* a2 = last ? nA : cA + (size_t)(t + 2) * kstep; const char* b2 = last ? nB : cB + (size_t)(t + 2) * kstep;
            const char* a3 = a2 + kstep; const char* b3 = b2 + kstep;
            if (last && has_next) S.a_ready(nxt);
            if constexpr (SP2) {
            PG8_LDB(B0, 0, 0); PG8_LDB(B1, 0, 1); PG8_SCHED; PG8_LDA(At, 0, 0); PG8_STAGE(PG8_SA(1, 1), a1 + hstepA, voffA);
            PG8_WAIT_V(8); PG8_WAIT_L(0); PG8_BAR; PG8_MMA(0, 0, At, B0); PG8_MMA(0, 1, At, B1); PG8_BAR; PG8_SCHED;
            PG8_LDA(At, 0, 1); PG8_STAGE(PG8_SB(0, 0), b2, voffB); PG8_STAGE(PG8_SB(0, 1), b2 + hstepB, voffB); PG8_STAGE(PG8_SA(0, 0), a2, voffA);
            PG8_WAIT_V(8); PG8_WAIT_L(0); PG8_BAR; PG8_MMA(1, 0, At, B0); PG8_MMA(1, 1, At, B1); PG8_BAR; PG8_SCHED;
            PG8_LDB(B0, 1, 0); PG8_LDB(B1, 1, 1); PG8_SCHED; PG8_LDA(At, 1, 0); PG8_STAGE(PG8_SA(0, 1), a2 + hstepA, voffA);
            PG8_WAIT_V(8); PG8_WAIT_L(0); PG8_BAR; PG8_MMA(0, 0, At, B0); PG8_MMA(0, 1, At, B1); PG8_BAR; PG8_SCHED;
            PG8_LDA(At, 1, 1); PG8_STAGE(PG8_SB(1, 0), b3, voffB); PG8_STAGE(PG8_SB(1, 1), b3 + hstepB, voffB); PG8_STAGE(PG8_SA(1, 0), a3, voffA);
            PG8_WAIT_V(8); PG8_WAIT_L(0); PG8_BAR; PG8_MMA(1, 0, At, B0); PG8_MMA(1, 1, At, B1); PG8_BAR; PG8_SCHED;
            } else {
            PG8_LDB(B0, 0, 0); PG8_SCHED; PG8_LDA(At, 0, 0); PG8_STAGE(PG8_SA(1, 1), a1 + hstepA, voffA);
            PG8_WAIT_L(8); PG8_BAR; PG8_WAIT_L(0); PG8_MMA(0, 0, At, B0); PG8_BAR; PG8_SCHED;
            PG8_LDB(B1, 0, 1); PG8_STAGE(PG8_SB(0, 0), b2, voffB);
            PG8_BAR; PG8_WAIT_L(0); PG8_MMA(0, 1, At, B1); PG8_BAR;
            PG8_LDA(At, 0, 1); PG8_STAGE(PG8_SA(0, 0), a2, voffA);
            PG8_BAR; PG8_WAIT_L(0); PG8_MMA(1, 0, At, B0); PG8_BAR; PG8_SCHED;
            PG8_STAGE(PG8_SB(0, 1), b2 + hstepB, voffB);
            PG8_WAIT_V(6); PG8_BAR; PG8_MMA(1, 1, At, B1); PG8_BAR;
            PG8_LDB(B0, 1, 0); PG8_SCHED; PG8_LDA(At, 1, 0); PG8_STAGE(PG8_SA(0, 1), a2 + hstepA, voffA);
            PG8_WAIT_L(8); PG8_BAR; PG8_WAIT_L(0); PG8_MMA(0, 0, At, B0); PG8_BAR; PG8_SCHED;
            PG8_LDB(B1, 1, 1); PG8_STAGE(PG8_SB(1, 0), b3, voffB);
            PG8_BAR; PG8_WAIT_L(0); PG8_MMA(0, 1, At, B1); PG8_BAR;
            PG8_LDA(At, 1, 1); PG8_STAGE(PG8_SA(1, 0), a3, voffA);
            PG8_BAR; PG8_WAIT_L(0); PG8_MMA(1, 0, At, B0); PG8_BAR; PG8_SCHED;
            PG8_STAGE(PG8_SB(1, 1), b3 + hstepB, voffB);
            PG8_WAIT_V(6); PG8_BAR; PG8_MMA(1, 1, At, B1); PG8_BAR;
            }
        }
        if constexpr (ALIGN_EPI) { if (wr == 0) PG8_BAR; }
        if constexpr (!Epi::AFTER_DRAIN) { E(acc, cur, wr, wc, fr, fq); S.done(cur); }
        if (!has_next) break;
#pragma unroll
        for (int a = 0; a < 2; ++a)
#pragma unroll
            for (int b = 0; b < 2; ++b)
#pragma unroll
                for (int m = 0; m < 4; ++m)
#pragma unroll
                    for (int n = 0; n < 2; ++n) acc[a][b][m][n] = (f32x4){0.f, 0.f, 0.f, 0.f};
        cur = nxt; cA = nA; cB = nB; ++ui;
        if constexpr (ALIGN_EPI) { if (wr == 1) PG8_BAR; }
    }
    PG8_WAIT_V(0);
    if constexpr (!ALIGN_EPI) { if (wr == 0) PG8_BAR; }
    PG8_BAR;
#undef PG8_SA
#undef PG8_SB
#undef PG8_STAGE
#undef PG8_LDA
#undef PG8_LDB
#undef PG8_MMA
#undef PG8_WAIT_V
#undef PG8_WAIT_L
#undef PG8_BAR
#undef PG8_SCHED
}

template <int MODE> struct Epi {
    static constexpr bool PERM = false, AFTER_DRAIN = false;
    const float* rowsrc; float inv_n; float* ss; bf16_t* ob; int ldc; float* of; const float* xin;
    __device__ __forceinline__ void operator()(const f32x4 (&acc)[2][2][4][2], const Unit& u, int wr, int wc, int fr, int fq) const {
#pragma unroll
        for (int ai = 0; ai < 2; ++ai)
#pragma unroll
            for (int m = 0; m < 4; ++m) {
                const int row = u.pm * BM + ai * HALF + wr * 64 + m * 16 + fr;
                float rs = 1.f;
                if (MODE == 1) rs = rowsrc[row];
                if (MODE == 2 || MODE == 5) rs = rsqrtf(rowsrc[row] * inv_n + EPS);
                float ssq = 0.f;
#pragma unroll
                for (int bj = 0; bj < 2; ++bj)
#pragma unroll
                    for (int n = 0; n < 2; ++n) {
                        const int col = u.pn * BM + bj * HALF + wc * 32 + n * 16 + fq * 4;
                        f32x4 v = acc[ai][bj][m][n] * rs;
                        if (MODE == 1) { if (u.pn < 8) { v[0] = gelu_tanh(v[0]); v[1] = gelu_tanh(v[1]); v[2] = gelu_tanh(v[2]); v[3] = gelu_tanh(v[3]); } }
                        if (MODE == 4) { const f32x4 xr = *(const f32x4*)(xin + (size_t)row * DM + col); v = v + xr; }
                        if (MODE == 1 || MODE == 4) ssq += (v[0] * v[0] + v[1] * v[1]) + (v[2] * v[2] + v[3] * v[3]);
                        if (MODE == 1 || MODE == 2 || MODE == 4) { u32x2 w; w.x = pk2(v[0], v[1]); w.y = pk2(v[2], v[3]); *(u32x2*)(ob + (size_t)row * ldc + col) = w; }
                        if (MODE == 4 || MODE == 5) *(f32x4*)(of + (size_t)row * DM + col) = v;
                    }
                if (MODE == 1) {
                    const int seg = (u.pn >= 4 && u.pn < 8) ? 0 : ((u.pn == 8 || u.pn == 9) ? 1 : (u.pn == 10 ? 2 : -1));
                    if (seg >= 0) { ssq += __shfl_xor(ssq, 16); ssq += __shfl_xor(ssq, 32); if (fq == 0) atomicAdd(ss + seg * S + row, ssq); }
                }
                if (MODE == 4) { ssq += __shfl_xor(ssq, 16); ssq += __shfl_xor(ssq, 32); if (fq == 0) atomicAdd(ss + row, ssq); }
            }
    }
};
}

#define XB_TMO      128
#define XB_XCNT(j)  (256  + 64 * (j))
#define XB_XSUB(j)  (1280 + 64 * (j))
#define XB_XGEN(j)  (2304 + 64 * (j))
#define XB_TOP      3328
#define XB_TOPGEN   3392
#define XCD_BAR_WORDS 3456
#define XB_SPIN_CAP (1u << 18)
__device__ __forceinline__ unsigned xb_ld(unsigned* p)              { return __hip_atomic_load(p, __ATOMIC_RELAXED, __HIP_MEMORY_SCOPE_AGENT); }
__device__ __forceinline__ unsigned xb_add(unsigned* p, unsigned v) { return __hip_atomic_fetch_add(p, v, __ATOMIC_RELAXED, __HIP_MEMORY_SCOPE_AGENT); }
__device__ __forceinline__ unsigned xb_xcc_id() { return (unsigned)__builtin_amdgcn_s_getreg((3 << 11) | 20) & 0xFu; }
#define XB_SPIN(cond, bar) do { unsigned _sp = 0; while (cond) { __builtin_amdgcn_s_sleep(1); \
    if ((++_sp & 255u) == 0u) { if (xb_ld(&(bar)[XB_TMO])) break; if (_sp > XB_SPIN_CAP) { atomicAdd(&(bar)[XB_TMO], 1u); break; } } } } while (0)
struct XcdBarrier { unsigned* bar; unsigned x; volatile LAS unsigned* st; };
__device__ __forceinline__ XcdBarrier xcd_barrier_post(unsigned* bar, volatile LAS unsigned* st) {
    XcdBarrier b; b.bar = bar; b.x = xb_xcc_id(); b.st = st;
    if (threadIdx.x == 0) (void)xb_add(&bar[XB_XCNT(b.x)], 1u);
    return b;
}
__device__ __forceinline__ void xcd_barrier_complete(unsigned* bar, unsigned x, unsigned& nloc, unsigned& nx) {
    const unsigned G = gridDim.x * gridDim.y * gridDim.z;
    unsigned sum, cnt, mine, sp = 0u;
    for (;;) {
        sum = 0u; cnt = 0u; mine = 0u;
#pragma unroll
        for (unsigned j = 0; j < 16; ++j) { const unsigned c = xb_ld(&bar[XB_XCNT(j)]); sum += c; cnt += (c > 0u) ? 1u : 0u; mine = (j == x) ? c : mine; }
        if (sum == G) break;
        __builtin_amdgcn_s_sleep(1);
        if ((++sp & 255u) == 0u) { if (xb_ld(&bar[XB_TMO])) break; if (sp > XB_SPIN_CAP) { atomicAdd(&bar[XB_TMO], 1u); break; } }
    }
    nloc = mine > 0u ? mine : 1u; nx = cnt > 0u ? cnt : 1u;
}
__device__ __forceinline__ void xcd_barrier(const XcdBarrier& b) {
    asm volatile("s_waitcnt vmcnt(0)" ::: "memory");
    __syncthreads();
    if (threadIdx.x == 0) {
        unsigned* bar = b.bar;
        __builtin_amdgcn_s_waitcnt(0);
        unsigned nloc = b.st[0], nx = b.st[1];
        if (nloc == 0u) { xcd_barrier_complete(bar, b.x, nloc, nx); b.st[0] = nloc; b.st[1] = nx; }
        const unsigned old = xb_add(&bar[XB_XSUB(b.x)], 1u);
        const unsigned gen = old / nloc;
        if (old + 1u == (gen + 1u) * nloc) {
            __builtin_amdgcn_fence(__ATOMIC_RELEASE, "agent");
            asm volatile("s_waitcnt vmcnt(0)" ::: "memory");
            const unsigned og = xb_add(&bar[XB_TOP], 1u);
            const unsigned tg = og / nx;
            if (og + 1u == (tg + 1u) * nx) xb_add(&bar[XB_TOPGEN], 1u);
            else XB_SPIN(xb_ld(&bar[XB_TOPGEN]) == tg, bar);
            __builtin_amdgcn_fence(__ATOMIC_ACQUIRE, "agent");
            xb_add(&bar[XB_XGEN(b.x)], 1u);
            asm volatile("s_waitcnt vmcnt(0)" ::: "memory");
        } else {
            XB_SPIN(xb_ld(&bar[XB_XGEN(b.x)]) == gen, bar);
            __builtin_amdgcn_fence(__ATOMIC_ACQUIRE, "agent");
            asm volatile("s_waitcnt vmcnt(0)" ::: "memory");
        }
    }
    __syncthreads();
}

struct Params {
    const float* in[18];
    float* out;
    unsigned char* ws;
    int ph_lo, ph_hi;
};

__device__ __forceinline__ void p0_transpose_item(const float* W, const float* g, int K, int N, bf16_t* WT, LAS float* scr, int item, int lane) {
    const int nblk = N / 32, kb = item / nblk, nb = item % nblk, k0 = 64 * kb, n0 = 32 * nb;
    float wv[32];
#pragma unroll
    for (int i = 0; i < 32; ++i) { const int kk = 2 * i + (lane >> 5); wv[i] = W[(size_t)(k0 + kk) * N + n0 + (lane & 31)]; }
#pragma unroll
    for (int i = 0; i < 32; ++i) { const int kk = 2 * i + (lane >> 5); const float gv = g ? g[k0 + kk] : 1.f; scr[kk * 33 + (lane & 31)] = wv[i] * gv; }
    LDS_WAIT(); asm volatile("" ::: "memory");
    const int c = lane & 7;
#pragma unroll
    for (int j = 0; j < 4; ++j) { const int n = (lane >> 3) + 8 * j; const LAS float* s = scr + (8 * c) * 33 + n;
        u32x4 o; o.x = pk2(s[0 * 33], s[1 * 33]); o.y = pk2(s[2 * 33], s[3 * 33]); o.z = pk2(s[4 * 33], s[5 * 33]); o.w = pk2(s[6 * 33], s[7 * 33]);
        *(u32x4*)(WT + (size_t)(n0 + n) * K + k0 + 8 * c) = o; }
    LDS_WAIT(); asm volatile("" ::: "memory");
}
__device__ __forceinline__ float row_to_bf16(const float* src, const float* g, bf16_t* dst, int lane) {
    float ss = 0.f;
#pragma unroll
    for (int i = 0; i < 8; ++i) {
        const int c = (i * 64 + lane) * 4;
        f32x4 v = *(const f32x4*)(src + c);
        ss += (v[0] * v[0] + v[1] * v[1]) + (v[2] * v[2] + v[3] * v[3]);
        if (g) { const f32x4 gv = *(const f32x4*)(g + c); v = v * gv; }
        u32x2 w; w.x = pk2(v[0], v[1]); w.y = pk2(v[2], v[3]);
        *(u32x2*)(dst + c) = w;
    }
    return ss;
}
constexpr float PEER_USC = 80.0f, PEER_VSC = 5.0f;
constexpr int PEER_ROWB = 1536;
typedef float f32x16v __attribute__((ext_vector_type(16)));
typedef float f32x32v __attribute__((ext_vector_type(32)));
typedef unsigned u32x6 __attribute__((ext_vector_type(6)));
typedef unsigned u32x2a4 __attribute__((ext_vector_type(2), aligned(4)));
template <bool CONTIG>
__device__ __forceinline__ void fp6_pack_store(const f32x4 (&x)[8], const f32x4 (&sc)[8], unsigned char* dst, int lane) {
    f32x16v a, b;
#pragma unroll
    for (int i = 0; i < 8; ++i) {
        const f32x4 y = x[i] * sc[i];
#pragma unroll
        for (int q = 0; q < 4; ++q) { const float c = fminf(fmaxf(y[q], -7.5f), 7.5f); const int sl = 4 * i + q; if ((sl & 1) == 0) a[sl >> 1] = c; else b[sl >> 1] = c; }
    }
    const u32x6 pk = __builtin_amdgcn_cvt_scalef32_2xpk16_fp6_f32(a, b, 1.0f);
    if (CONTIG) {
        *(u32x2*)(dst + lane * 24) = (u32x2){pk[0], pk[1]}; *(u32x2*)(dst + lane * 24 + 8) = (u32x2){pk[2], pk[3]}; *(u32x2*)(dst + lane * 24 + 16) = (u32x2){pk[4], pk[5]};
    } else {
        *(u32x4*)(dst + lane * 16) = (u32x4){pk[0], pk[1], pk[2], pk[3]};
        *(u32x2*)(dst + 1024 + lane * 8) = (u32x2){pk[4], pk[5]};
    }
}
template <bool CONTIG>
__device__ __forceinline__ void rows2_to_fp6(const float* s0, const float* s1, const f32x4 (&sc)[8], unsigned char* d0, unsigned char* d1, int lane) {
    f32x4 x0[8], x1[8];
#pragma unroll
    for (int i = 0; i < 8; ++i) { x0[i] = *(const f32x4*)(s0 + (i * 64 + lane) * 4); x1[i] = *(const f32x4*)(s1 + (i * 64 + lane) * 4); }
    fp6_pack_store<CONTIG>(x0, sc, d0, lane); fp6_pack_store<CONTIG>(x1, sc, d1, lane);
}
__device__ __forceinline__ bf16x8 cvt8(const float* p) {
    const f32x4 a = *(const f32x4*)p, b = *(const f32x4*)(p + 4);
    u32x4 w; w.x = pk2(a[0], a[1]); w.y = pk2(a[2], a[3]); w.z = pk2(b[0], b[1]); w.w = pk2(b[2], b[3]);
    return __builtin_bit_cast(bf16x8, w);
}

__device__ __forceinline__ void prep_late(const Params& p, LAS unsigned char* lds, int gw, int NGW, int wave, int lane) {
    unsigned char* ws = p.ws;
    LAS float* scr = (LAS float*)(lds + wave * 16384);
    {
        constexpr int I_UQ = (512 / 64) * (1536 / 32), I_UKV = (256 / 64) * (2048 / 32), I_OUT = (DM / 64) * (DM / 32);
        constexpr int NIT = I_UQ + I_UKV + I_OUT;
        for (int it = gw; it < NIT; it += NGW) {
            int r = it;
            if (r < I_UQ) { p0_transpose_item(p.in[7], p.in[6], 512, 1536, (bf16_t*)(ws + WS_WUQ), scr, r, lane); continue; } r -= I_UQ;
            if (r < I_UKV) { p0_transpose_item(p.in[9], p.in[8], 256, 2048, (bf16_t*)(ws + WS_WUKV), scr, r, lane); continue; } r -= I_UKV;
            p0_transpose_item(p.in[12], nullptr, DM, DM, (bf16_t*)(ws + WS_WOUT), scr, r, lane);
        }
    }
    {
        const float* wq = p.in[14]; const float* sk = p.in[15]; const float* g2 = p.in[13];
        bf16_t* WsT = (bf16_t*)(ws + WS_WS);
        const int r32 = lane & 31, hh = lane >> 5;
        for (int it = gw; it < 16 * 4 * 64; it += NGW) {
            const int hp = it >> 8, kb = (it >> 6) & 3, nb = it & 63;
            f32x16 acc = {};
            const float* ap = sk + ((size_t)(hp * 128 + kb * 32 + r32)) * 128 + hh * 8;
            const float* bp = wq + ((size_t)(nb * 32 + r32)) * DM + hp * 128 + hh * 8;
#pragma unroll
            for (int s = 0; s < 8; ++s) {
                const bf16x8 a = cvt8(ap + s * 16), b = cvt8(bp + s * 16);
                acc = __builtin_amdgcn_mfma_f32_32x32x16_bf16(a, b, acc, 0, 0, 0);
            }
            const int kcol = nb * 32 + r32; const float gk = g2[kcol];
#pragma unroll
            for (int r = 0; r < 16; ++r) WsT[(size_t)(hp * 128 + kb * 32 + crow(r, hh)) * DM + kcol] = (bf16_t)f2bf(acc[r] * gk);
        }
    }
    {
        float* ct = (float*)(ws + WS_COS); float* st = (float*)(ws + WS_SIN);
        for (int it = gw; it < S * 32 / 64; it += NGW) {
            const int idx = it * 64 + lane, t = idx >> 5, j = idx & 31;
            const float inv_freq = powf(10000.0f, -(float)j / 32.0f);
            const float ang = (float)t * inv_freq;
            float sv, cv; sincosf(ang, &sv, &cv); ct[idx] = cv; st[idx] = sv;
        }
    }
}
__device__ __forceinline__ void phase0(const Params& p, LAS unsigned char* lds, bool late_ok, int gw, int NGW, int wave, int lane) {
    unsigned char* ws = p.ws;
    LAS float* scr = (LAS float*)(lds + wave * 16384);
    const float* x = p.in[0];
    {
        constexpr int I_IN = (DM / 64) * (NIN / 32);
        for (int it = gw; it < I_IN; it += NGW) p0_transpose_item(p.in[2], p.in[1], DM, NIN, (bf16_t*)(ws + WS_WIN), scr, it, lane);
    }
    if (!late_ok) prep_late(p, lds, gw, NGW, wave, lane);
    for (int r = gw; r < NINP - NIN; r += NGW) {
        bf16_t* d = (bf16_t*)(ws + WS_WIN) + (size_t)(NIN + r) * DM;
#pragma unroll
        for (int i = 0; i < 4; ++i) *(u32x4*)(d + (i * 64 + lane) * 8) = (u32x4){0u, 0u, 0u, 0u};
    }
    {
        bf16_t* xb = (bf16_t*)(ws + WS_XB); float* rstd1 = (float*)(ws + WS_RSTD1);
        for (int t = gw; t + NGW < S; t += 2 * NGW) {
            const int t1 = t + NGW;
            f32x4 a[8], b[8];
#pragma unroll
            for (int i = 0; i < 8; ++i) { a[i] = *(const f32x4*)(x + (size_t)t * DM + (i * 64 + lane) * 4); b[i] = *(const f32x4*)(x + (size_t)t1 * DM + (i * 64 + lane) * 4); }
            float sa = 0.f, sb = 0.f;
#pragma unroll
            for (int i = 0; i < 8; ++i) {
                sa += (a[i][0] * a[i][0] + a[i][1] * a[i][1]) + (a[i][2] * a[i][2] + a[i][3] * a[i][3]);
                sb += (b[i][0] * b[i][0] + b[i][1] * b[i][1]) + (b[i][2] * b[i][2] + b[i][3] * b[i][3]);
                u32x2 wa, wb; wa.x = pk2(a[i][0], a[i][1]); wa.y = pk2(a[i][2], a[i][3]); wb.x = pk2(b[i][0], b[i][1]); wb.y = pk2(b[i][2], b[i][3]);
                *(u32x2*)(xb + (size_t)t * DM + (i * 64 + lane) * 4) = wa; *(u32x2*)(xb + (size_t)t1 * DM + (i * 64 + lane) * 4) = wb;
            }
            sa = wave_sum(sa); sb = wave_sum(sb);
            if (lane == 0) { rstd1[t] = rsqrtf(sa * (1.0f / DM) + EPS); rstd1[t1] = rsqrtf(sb * (1.0f / DM) + EPS); }
        }
    }
    {
        unsigned char* UT = ws + WS_UT; unsigned char* VT = ws + WS_VT;
        f32x4 sc[8];
#pragma unroll
        for (int i = 0; i < 8; ++i) sc[i] = *(const f32x4*)(p.in[13] + (i * 64 + lane) * 4) * PEER_USC;
        for (int e = gw; e + NGW < 16384; e += 2 * NGW)
            rows2_to_fp6<false>(p.in[16] + (size_t)e * DM, p.in[16] + (size_t)(e + NGW) * DM, sc, UT + (size_t)e * PEER_ROWB, UT + (size_t)(e + NGW) * PEER_ROWB, lane);
#pragma unroll
        for (int i = 0; i < 8; ++i) sc[i] = (f32x4){PEER_VSC, PEER_VSC, PEER_VSC, PEER_VSC};
        for (int e = gw; e + NGW < 16384; e += 2 * NGW)
            rows2_to_fp6<false>(p.in[17] + (size_t)e * DM, p.in[17] + (size_t)(e + NGW) * DM, sc, VT + (size_t)e * PEER_ROWB, VT + (size_t)(e + NGW) * PEER_ROWB, lane);
    }
}

__device__ __forceinline__ void phase3(const Params& p, int gw, int NGW, int lane) {
    unsigned char* ws = p.ws;
    const bf16_t* qraw = (const bf16_t*)(ws + WS_QRAW); const bf16_t* kvraw = (const bf16_t*)(ws + WS_KVRAW); const bf16_t* proj = (const bf16_t*)(ws + WS_PROJ);
    bf16_t* Qh = (bf16_t*)(ws + WS_QH); bf16_t* Kh = (bf16_t*)(ws + WS_KH);
    const float* ct = (const float*)(ws + WS_COS); const float* st = (const float*)(ws + WS_SIN);
    const bool act = lane < 48, isrope = lane >= 32 && lane < 48, lowhalf = lane < 40;
    const int e0 = act ? 4 * lane : 0;
    const f32x4 gq = *(const f32x4*)(p.in[10] + e0), gk = *(const f32x4*)(p.in[11] + e0);
    const int j0 = isrope ? ((4 * lane - 128) & 31) : 0;
    constexpr float QS = 0.07216878364870322f * 1.4426950408889634f;
    for (int t = gw; t < S; t += NGW) {
        f32x4 cs = {1.f, 1.f, 1.f, 1.f}, sn = {0.f, 0.f, 0.f, 0.f};
        if (isrope) { cs = *(const f32x4*)(ct + t * 32 + j0); sn = *(const f32x4*)(st + t * 32 + j0); }
        u32x2 krw = {0u, 0u};
        if (isrope) krw = *(const u32x2*)(proj + (size_t)t * NINP + 2816 + (4 * lane - 128));
        const f32x4 krope = {bflo(krw.x), bfhi(krw.x), bflo(krw.y), bfhi(krw.y)};
#pragma unroll
        for (int h = 0; h < 8; ++h) {
            u32x2 qw = {0u, 0u};
            if (act) qw = *(const u32x2*)(qraw + (size_t)t * 1536 + h * 192 + e0);
            f32x4 q = {bflo(qw.x), bfhi(qw.x), bflo(qw.y), bfhi(qw.y)};
            float ss = wave_sum_u((q[0] * q[0] + q[1] * q[1]) + (q[2] * q[2] + q[3] * q[3]));
            float rs = rsqrtf(ss * (1.0f / 192.0f) + EPS);
            q = q * gq * rs;
            {
                f32x4 pr;
#pragma unroll
                for (int c = 0; c < 4; ++c) pr[c] = __shfl_xor(q[c], 8);
                const f32x4 r1 = q * cs - pr * sn, r2 = pr * sn + q * cs;
                if (isrope) q = lowhalf ? r1 : r2;
            }
            q = q * QS;
            if (act) { u32x2 w; w.x = pk2(q[0], q[1]); w.y = pk2(q[2], q[3]); *(u32x2*)(Qh + ((size_t)h * S + t) * 192 + e0) = w; }
            u32x2 kw = {0u, 0u};
            if (lane < 32) kw = *(const u32x2*)(kvraw + (size_t)t * 2048 + h * 256 + e0);
            f32x4 k = {bflo(kw.x), bfhi(kw.x), bflo(kw.y), bfhi(kw.y)};
            if (isrope) k = krope;
            ss = wave_sum_u((k[0] * k[0] + k[1] * k[1]) + (k[2] * k[2] + k[3] * k[3]));
            rs = rsqrtf(ss * (1.0f / 192.0f) + EPS);
            k = k * gk * rs;
            {
                f32x4 pr;
#pragma unroll
                for (int c = 0; c < 4; ++c) pr[c] = __shfl_xor(k[c], 8);
                const f32x4 r1 = k * cs - pr * sn, r2 = pr * sn + k * cs;
                if (isrope) k = lowhalf ? r1 : r2;
            }
            if (act) { u32x2 w; w.x = pk2(k[0], k[1]); w.y = pk2(k[2], k[3]); *(u32x2*)(Kh + ((size_t)h * S + t) * 192 + e0) = w; }
        }
    }
}

constexpr int KP = 400, VP = 320;
template <int OFF> __device__ __forceinline__ s16x4 tr_read(unsigned addr) {
    s16x4 r; asm volatile("ds_read_b64_tr_b16 %0, %1 offset:%2" : "=&v"(r) : "v"(addr), "i"(OFF) : "memory"); return r;
}
__device__ __forceinline__ unsigned cvtpk(float lo, float hi) { unsigned r; asm volatile("v_cvt_pk_bf16_f32 %0, %1, %2" : "=v"(r) : "v"(lo), "v"(hi)); return r; }
#define PK8(L, H) ((bf16x8){L[0], L[1], L[2], L[3], H[0], H[1], H[2], H[3]})
constexpr float ATT_THR = 8.0f;

constexpr int ATT_KB = 64 * KP, ATT_VB = 64 * VP;
constexpr int ATT_VOFF = 2 * ATT_KB;
__device__ __forceinline__ float xhalf_max(float v) {
    auto rr = __builtin_amdgcn_permlane32_swap(__builtin_bit_cast(unsigned, v), __builtin_bit_cast(unsigned, v), false, false);
    return fmaxf(__builtin_bit_cast(float, rr[0]), __builtin_bit_cast(float, rr[1]));
}
__device__ __forceinline__ float xhalf_sum(float v) {
    auto rr = __builtin_amdgcn_permlane32_swap(__builtin_bit_cast(unsigned, v), __builtin_bit_cast(unsigned, v), false, false);
    return __builtin_bit_cast(float, rr[0]) + __builtin_bit_cast(float, rr[1]);
}
template <int OFF> __device__ __forceinline__ bf16x8 lds_read128(unsigned addr) {
    bf16x8 r; asm volatile("ds_read_b128 %0, %1 offset:%2" : "=&v"(r) : "v"(addr), "i"(OFF) : "memory"); return r;
}
#define LGKM_WAIT(n) do { asm volatile("s_waitcnt lgkmcnt(" #n ")" ::: "memory"); SBAR(); } while (0)
__device__ __forceinline__ f32x16 att_qk(unsigned kaddr, const bf16x8 (&qr)[12]) {
    f32x16 p = {};
    bf16x8 a0 = lds_read128<0>(kaddr), a1 = lds_read128<32>(kaddr), a2 = lds_read128<64>(kaddr), a3 = lds_read128<96>(kaddr);
    LGKM_WAIT(3); p = __builtin_amdgcn_mfma_f32_32x32x16_bf16(a0, qr[0], p, 0, 0, 0); a0 = lds_read128<128>(kaddr);
    LGKM_WAIT(3); p = __builtin_amdgcn_mfma_f32_32x32x16_bf16(a1, qr[1], p, 0, 0, 0); a1 = lds_read128<160>(kaddr);
    LGKM_WAIT(3); p = __builtin_amdgcn_mfma_f32_32x32x16_bf16(a2, qr[2], p, 0, 0, 0); a2 = lds_read128<192>(kaddr);
    LGKM_WAIT(3); p = __builtin_amdgcn_mfma_f32_32x32x16_bf16(a3, qr[3], p, 0, 0, 0); a3 = lds_read128<224>(kaddr);
    LGKM_WAIT(3); p = __builtin_amdgcn_mfma_f32_32x32x16_bf16(a0, qr[4], p, 0, 0, 0); a0 = lds_read128<256>(kaddr);
    LGKM_WAIT(3); p = __builtin_amdgcn_mfma_f32_32x32x16_bf16(a1, qr[5], p, 0, 0, 0); a1 = lds_read128<288>(kaddr);
    LGKM_WAIT(3); p = __builtin_amdgcn_mfma_f32_32x32x16_bf16(a2, qr[6], p, 0, 0, 0); a2 = lds_read128<320>(kaddr);
    LGKM_WAIT(3); p = __builtin_amdgcn_mfma_f32_32x32x16_bf16(a3, qr[7], p, 0, 0, 0); a3 = lds_read128<352>(kaddr);
    LGKM_WAIT(3); p = __builtin_amdgcn_mfma_f32_32x32x16_bf16(a0, qr[8], p, 0, 0, 0);
    LGKM_WAIT(2); p = __builtin_amdgcn_mfma_f32_32x32x16_bf16(a1, qr[9], p, 0, 0, 0);
    LGKM_WAIT(1); p = __builtin_amdgcn_mfma_f32_32x32x16_bf16(a2, qr[10], p, 0, 0, 0);
    LGKM_WAIT(0); p = __builtin_amdgcn_mfma_f32_32x32x16_bf16(a3, qr[11], p, 0, 0, 0);
    return p;
}
__device__ __forceinline__ void att_finish(f32x16& s, float m, float& lsum, bf16x8& pb0, bf16x8& pb1) {
    float ps = 0.f;
#pragma unroll
    for (int r = 0; r < 16; ++r) { s[r] = __builtin_amdgcn_exp2f(s[r] - m); ps += s[r]; }
    lsum += xhalf_sum(ps);
    u32x4 w0 = {cvtpk(s[0], s[1]), cvtpk(s[2], s[3]), cvtpk(s[4], s[5]), cvtpk(s[6], s[7])};
    u32x4 w1 = {cvtpk(s[8], s[9]), cvtpk(s[10], s[11]), cvtpk(s[12], s[13]), cvtpk(s[14], s[15])};
    pb0 = __builtin_bit_cast(bf16x8, w0); pb1 = __builtin_bit_cast(bf16x8, w1);
}
__device__ __forceinline__ void att_pv(unsigned vaddr, bf16x8 pb0, bf16x8 pb1, f32x16 (&o)[4]) {
#define VOFF(d0, s, hi) (((16 * (s) + 8 * (hi)) * VP) + 64 * (d0))
    const s16x4 a00l = tr_read<VOFF(0, 0, 0)>(vaddr), a00h = tr_read<VOFF(0, 0, 1)>(vaddr), a01l = tr_read<VOFF(0, 1, 0)>(vaddr), a01h = tr_read<VOFF(0, 1, 1)>(vaddr);
    const s16x4 a10l = tr_read<VOFF(1, 0, 0)>(vaddr), a10h = tr_read<VOFF(1, 0, 1)>(vaddr), a11l = tr_read<VOFF(1, 1, 0)>(vaddr), a11h = tr_read<VOFF(1, 1, 1)>(vaddr);
    LGKM_WAIT(4);
    o[0] = __builtin_amdgcn_mfma_f32_32x32x16_bf16(PK8(a00l, a00h), pb0, o[0], 0, 0, 0); o[0] = __builtin_amdgcn_mfma_f32_32x32x16_bf16(PK8(a01l, a01h), pb1, o[0], 0, 0, 0);
    const s16x4 a20l = tr_read<VOFF(2, 0, 0)>(vaddr), a20h = tr_read<VOFF(2, 0, 1)>(vaddr), a21l = tr_read<VOFF(2, 1, 0)>(vaddr), a21h = tr_read<VOFF(2, 1, 1)>(vaddr);
    LGKM_WAIT(4);
    o[1] = __builtin_amdgcn_mfma_f32_32x32x16_bf16(PK8(a10l, a10h), pb0, o[1], 0, 0, 0); o[1] = __builtin_amdgcn_mfma_f32_32x32x16_bf16(PK8(a11l, a11h), pb1, o[1], 0, 0, 0);
    const s16x4 a30l = tr_read<VOFF(3, 0, 0)>(vaddr), a30h = tr_read<VOFF(3, 0, 1)>(vaddr), a31l = tr_read<VOFF(3, 1, 0)>(vaddr), a31h = tr_read<VOFF(3, 1, 1)>(vaddr);
    LGKM_WAIT(4);
    o[2] = __builtin_amdgcn_mfma_f32_32x32x16_bf16(PK8(a20l, a20h), pb0, o[2], 0, 0, 0); o[2] = __builtin_amdgcn_mfma_f32_32x32x16_bf16(PK8(a21l, a21h), pb1, o[2], 0, 0, 0);
    LGKM_WAIT(0);
    o[3] = __builtin_amdgcn_mfma_f32_32x32x16_bf16(PK8(a30l, a30h), pb0, o[3], 0, 0, 0); o[3] = __builtin_amdgcn_mfma_f32_32x32x16_bf16(PK8(a31l, a31h), pb1, o[3], 0, 0, 0);
#undef VOFF
}
__device__ __forceinline__ void att_partial(const f32x16& s, float& m, float& lsum, f32x16 (&o)[4]) {
    float pmax = s[0];
#pragma unroll
    for (int r = 1; r < 16; ++r) pmax = fmaxf(pmax, s[r]);
    pmax = xhalf_max(pmax);
    if (!__all(pmax - m <= ATT_THR)) {
        const float mn = fmaxf(m, pmax); const float alpha = __builtin_amdgcn_exp2f(m - mn); m = mn; lsum *= alpha;
#pragma unroll
        for (int d = 0; d < 4; ++d)
#pragma unroll
            for (int r = 0; r < 16; ++r) o[d][r] *= alpha;
    }
}

__device__ __forceinline__ void attn_unit(const Params& p, LAS unsigned char* lds, int head, int qb, int tid, int wave, int lane) {
    unsigned char* ws = p.ws;
    const bf16_t* Qh = (const bf16_t*)(ws + WS_QH); const bf16_t* Kh = (const bf16_t*)(ws + WS_KH);
    bf16_t* mix = (bf16_t*)(ws + WS_MIX);
    const int rg = wave & 3, kh = wave >> 2, r32 = lane & 31, hh = lane >> 5;
    const int q0row = qb * 128 + rg * 32;
    bf16x8 qr[12];
    {
        const bf16_t* qp = Qh + ((size_t)head * S + q0row + r32) * 192 + hh * 8;
#pragma unroll
        for (int ks = 0; ks < 12; ++ks) qr[ks] = *(const bf16x8*)(qp + ks * 16);
    }
    const int ntiles = 2 * qb + 2, mylast = 2 * qb + (rg >> 1);
    float m = -1e30f, lsum = 0.f; f32x16 o[4] = {};
    const int srow = tid >> 3, sch = tid & 7;
    const int kg0 = srow * 192 + sch * 8, kl0 = srow * KP + sch * 16, vg0 = srow * 2048 + sch * 8, vl0 = ATT_VOFF + srow * VP + sch * 16;
    const bf16_t* kbase = Kh + (size_t)head * S * 192; const bf16_t* vbase = (const bf16_t*)(ws + WS_KVRAW) + head * 256 + 128;
    u32x4 sk0, sk1, sk2, sv0, sv1;
#define ATT_LOAD(t) do { const bf16_t* kt = kbase + (size_t)(t) * 64 * 192 + kg0; const bf16_t* vt = vbase + (size_t)(t) * 64 * 2048 + vg0; \
        sk0 = *(const u32x4*)(kt); sk1 = *(const u32x4*)(kt + 64); sk2 = *(const u32x4*)(kt + 128); sv0 = *(const u32x4*)(vt); sv1 = *(const u32x4*)(vt + 64); } while (0)
#define ATT_WRITE(kb_, vb_) do { LAS unsigned char* bk = lds + (kb_) * ATT_KB + kl0; LAS unsigned char* bv = lds + (vb_) * ATT_VB + vl0; *(LAS u32x4*)(bk) = sk0; *(LAS u32x4*)(bk + 128) = sk1; *(LAS u32x4*)(bk + 256) = sk2; \
        *(LAS u32x4*)(bv) = sv0; *(LAS u32x4*)(bv + 128) = sv1; } while (0)
    const unsigned ldsbase = (unsigned)(size_t)lds;
    const unsigned kaddr0 = ldsbase + (unsigned)((32 * kh + r32) * KP + hh * 16);
    const unsigned vrel = (unsigned)(ATT_VOFF + (32 * kh + 4 * hh + ((lane & 15) >> 2)) * VP + (16 * ((lane >> 4) & 1) + 4 * (lane & 3)) * 2);
    ATT_LOAD(0); ATT_WRITE(0, 0); __syncthreads();
    bf16x8 pb0, pb1;
    const bool more0 = (1 < ntiles);
    if (more0) ATT_LOAD(1);
    f32x16 sprev = att_qk(kaddr0, qr);
    att_partial(sprev, m, lsum, o);
    if (more0) ATT_WRITE(1, 1);
    __syncthreads();
    int vprev = 0, vcur = 1;
#pragma unroll 1
    for (int t = 1; t <= ntiles; ++t) {
        const bool more = (t + 1 < ntiles);
        if (more) ATT_LOAD(t + 1);
        f32x16 sc;
        if (t <= mylast) sc = att_qk(kaddr0 + (t & 1) * ATT_KB, qr);
        else {
#pragma unroll
            for (int r = 0; r < 16; ++r) sc[r] = -1e30f;
        }
        att_finish(sprev, m, lsum, pb0, pb1);
        att_pv(ldsbase + vprev * ATT_VB + vrel, pb0, pb1, o);
        att_partial(sc, m, lsum, o);
        sprev = sc;
        const int vnext = (vcur == 2) ? 0 : vcur + 1;
        if (more) ATT_WRITE((t + 1) & 1, vnext);
        vprev = vcur; vcur = vnext;
        __syncthreads();
    }
#undef ATT_LOAD
#undef ATT_WRITE
    LAS float* scr = (LAS float*)lds + (size_t)rg * 66 * 64 + lane;
    if (kh == 1) {
        scr[0] = m; scr[64] = lsum;
#pragma unroll
        for (int d = 0; d < 4; ++d)
#pragma unroll
            for (int r = 0; r < 16; ++r) scr[(2 + d * 16 + r) * 64] = o[d][r];
    }
    __syncthreads();
    if (kh == 0) {
        const float m2 = scr[0], l2 = scr[64];
        const float mn = fmaxf(m, m2), a1 = __builtin_amdgcn_exp2f(m - mn), a2 = __builtin_amdgcn_exp2f(m2 - mn);
        const float inv = 1.0f / (lsum * a1 + l2 * a2);
        bf16_t* op = mix + (size_t)(q0row + r32) * DM + 1024 + head * 128 + 4 * hh;
#pragma unroll
        for (int d = 0; d < 4; ++d)
#pragma unroll
            for (int g4 = 0; g4 < 4; ++g4) {
                float v[4];
#pragma unroll
                for (int i = 0; i < 4; ++i) { const int r = 4 * g4 + i; v[i] = (o[d][r] * a1 + scr[(2 + d * 16 + r) * 64] * a2) * inv; }
                u32x2 w; w.x = pk2(v[0], v[1]); w.y = pk2(v[2], v[3]);
                *(u32x2*)(op + 32 * d + 8 * g4) = w;
            }
    }
    __syncthreads();
}

__device__ __forceinline__ void gmlp_unit(const Params& p, LAS unsigned char* lds, int nb, int h, int tid, int wave, int lane) {
    unsigned char* ws = p.ws;
    const bf16_t* proj = (const bf16_t*)(ws + WS_PROJ); bf16_t* mix = (bf16_t*)(ws + WS_MIX);
    const float* ssv = (const float*)(ws + WS_ROWSS);
    const float* vg = p.in[3]; const float* wsp = p.in[4]; const float* bs = p.in[5];
#pragma unroll
    for (int i = 0; i < 4; ++i) {
        const int pc = tid + 512 * i, r = pc >> 4, c = pc & 15, t = nb * 128 + r;
        const u32x4 w = *(const u32x4*)(proj + (size_t)t * NINP + 1024 + h * 128 + c * 8);
        const float rs = rsqrtf(ssv[t] * (1.0f / 1024.0f) + EPS);
        const f32x4 g0 = *(const f32x4*)(vg + h * 128 + c * 8), g1 = *(const f32x4*)(vg + h * 128 + c * 8 + 4);
        u32x4 ov;
        ov.x = pk2(bflo(w.x) * rs * g0[0], bfhi(w.x) * rs * g0[1]); ov.y = pk2(bflo(w.y) * rs * g0[2], bfhi(w.y) * rs * g0[3]);
        ov.z = pk2(bflo(w.z) * rs * g1[0], bfhi(w.z) * rs * g1[1]); ov.w = pk2(bflo(w.w) * rs * g1[2], bfhi(w.w) * rs * g1[3]);
        *(LAS u32x4*)(lds + r * VP + c * 16) = ov;
    }
    __syncthreads();
    const int ib = wave & 3, ch = wave >> 2, r32 = lane & 31, hh = lane >> 5;
    const int irow = 32 * ib + r32;
    f32x16 acc0 = {}, acc1 = {};
    const unsigned vaddr = (unsigned)(size_t)lds + (unsigned)((8 * hh + ((lane & 15) >> 2)) * VP + (64 * ch + 16 * ((lane >> 4) & 1) + 4 * (lane & 3)) * 2);
    const float* wrow = wsp + ((size_t)h * 128 + irow) * 128 + hh * 8;
#define GSTEP(s) do { if ((s) < 2 * (ib + 1)) { \
        const f32x4 wa = *(const f32x4*)(wrow + (s) * 16), wb = *(const f32x4*)(wrow + (s) * 16 + 4); const int j0 = (s) * 16 + hh * 8; \
        u32x4 aw; aw.x = pk2(j0 + 0 <= irow ? wa[0] : 0.f, j0 + 1 <= irow ? wa[1] : 0.f); aw.y = pk2(j0 + 2 <= irow ? wa[2] : 0.f, j0 + 3 <= irow ? wa[3] : 0.f); \
        aw.z = pk2(j0 + 4 <= irow ? wb[0] : 0.f, j0 + 5 <= irow ? wb[1] : 0.f); aw.w = pk2(j0 + 6 <= irow ? wb[2] : 0.f, j0 + 7 <= irow ? wb[3] : 0.f); \
        const bf16x8 af = __builtin_bit_cast(bf16x8, aw); \
        const s16x4 b0l = tr_read<(16 * (s)) * VP>(vaddr), b0h = tr_read<(16 * (s) + 4) * VP>(vaddr), b1l = tr_read<(16 * (s)) * VP + 64>(vaddr), b1h = tr_read<(16 * (s) + 4) * VP + 64>(vaddr); \
        LDS_WAIT(); SBAR(); \
        acc0 = __builtin_amdgcn_mfma_f32_32x32x16_bf16(af, PK8(b0l, b0h), acc0, 0, 0, 0); acc1 = __builtin_amdgcn_mfma_f32_32x32x16_bf16(af, PK8(b1l, b1h), acc1, 0, 0, 0); } } while (0)
    GSTEP(0); GSTEP(1); GSTEP(2); GSTEP(3); GSTEP(4); GSTEP(5); GSTEP(6); GSTEP(7);
#undef GSTEP
#pragma unroll
    for (int r = 0; r < 16; ++r) {
        const int i = 32 * ib + crow(r, hh), t = nb * 128 + i; const float b = bs[h * 128 + i];
        const int c0 = h * 128 + 64 * ch + r32;
        const float u0 = bf2f(proj[(size_t)t * NINP + c0]), u1 = bf2f(proj[(size_t)t * NINP + c0 + 32]);
        mix[(size_t)t * DM + c0] = (bf16_t)f2bf(u0 * (acc0[r] + b)); mix[(size_t)t * DM + c0 + 32] = (bf16_t)f2bf(u1 * (acc1[r] + b));
    }
    __syncthreads();
}

__device__ __forceinline__ void phase7(const Params& p, LAS unsigned char* lds, int gw, int NGW, int wave, int lane) {
    unsigned char* ws = p.ws;
    const float* sc = (const float*)(ws + WS_SC); int* ex = (int*)(ws + WS_EXP); float* gt = (float*)(ws + WS_GATE);
    const float NEG = -3.0e38f;
    LAS float* sl = (LAS float*)(lds + wave * 1024);
    const int j8 = lane & 7, g8 = lane >> 3, row = lane >> 4, i16 = lane & 15;
    int ci[4], cj[4]; bool cval[4];
    {
        constexpr int starts[16] = {0, 16, 24, 29, 33, 36, 38, 40, 42, 43, 44, 45, 46, 47, 48, 49};
#pragma unroll
        for (int m = 0; m < 4; ++m) {
            const int c = i16 + 16 * m; int a = 0, st = 0;
#pragma unroll
            for (int i = 1; i < 16; ++i) if (c >= starts[i]) { a = i; st = starts[i]; }
            cval[m] = c < 50; ci[m] = cval[m] ? a : 0; cj[m] = cval[m] ? (c - st) : 0;
        }
    }
    constexpr int NT = S * 2;
    f32x4 nx0, nx1, nx2, nx3;
    if (gw < NT) { const float* b = sc + (size_t)(gw >> 1) * DM + (gw & 1) * 1024 + lane * 16; nx0 = *(const f32x4*)b; nx1 = *(const f32x4*)(b + 4); nx2 = *(const f32x4*)(b + 8); nx3 = *(const f32x4*)(b + 12); }
    for (int it = gw; it < NT; it += NGW) {
        const int t = it >> 1, hh = it & 1;
        float v[16];
#pragma unroll
        for (int q = 0; q < 4; ++q) { v[q] = nx0[q]; v[4 + q] = nx1[q]; v[8 + q] = nx2[q]; v[12 + q] = nx3[q]; }
        if (it + NGW < NT) { const int it2 = it + NGW; const float* b = sc + (size_t)(it2 >> 1) * DM + (it2 & 1) * 1024 + lane * 16;
            nx0 = *(const f32x4*)b; nx1 = *(const f32x4*)(b + 4); nx2 = *(const f32x4*)(b + 8); nx3 = *(const f32x4*)(b + 12); }
#pragma unroll
        for (int m = 0; m < 16; ++m) v[m] = __builtin_bit_cast(float, (__builtin_bit_cast(unsigned, v[m]) & ~127u) | (unsigned)(16 * j8 + m));
        float ra = 0.f, rb = 0.f;
#pragma unroll
        for (int k = 0; k < 16; ++k) {
            float mx = fmaxf(fmaxf(fmaxf(v[0], v[1]), fmaxf(v[2], v[3])), fmaxf(fmaxf(v[4], v[5]), fmaxf(v[6], v[7])));
            mx = fmaxf(mx, fmaxf(fmaxf(fmaxf(v[8], v[9]), fmaxf(v[10], v[11])), fmaxf(fmaxf(v[12], v[13]), fmaxf(v[14], v[15]))));
            mx = fmaxf(mx, dpp_f<0xB1, 0xf>(mx, mx));
            mx = fmaxf(mx, dpp_f<0x4E, 0xf>(mx, mx));
            mx = fmaxf(mx, dpp_f<0x141, 0xf>(mx, mx));
#pragma unroll
            for (int m = 0; m < 16; ++m) v[m] = (v[m] == mx) ? NEG : v[m];
            if (k < 8) ra = (j8 == k) ? mx : ra; else rb = (j8 == k - 8) ? mx : rb;
        }
        sl[g8 * 16 + j8] = ra; sl[g8 * 16 + 8 + j8] = rb;
        LDS_WAIT(); asm volatile("" ::: "memory");
        float cv[4], og[4]; int id[4];
#pragma unroll
        for (int m = 0; m < 4; ++m) {
            const float s1 = sl[(2 * row) * 16 + ci[m]], s2 = sl[(2 * row + 1) * 16 + cj[m]];
            og[m] = cval[m] ? (s1 + s2) : NEG; cv[m] = og[m];
            id[m] = (int)((__builtin_bit_cast(unsigned, s1) & 127u) * 128u + (__builtin_bit_cast(unsigned, s2) & 127u));
        }
        LDS_WAIT(); asm volatile("" ::: "memory");
        float M0 = 0.f;
#pragma unroll
        for (int k = 0; k < 16; ++k) {
            float mx = fmaxf(fmaxf(cv[0], cv[1]), fmaxf(cv[2], cv[3]));
            mx = fmaxf(mx, dpp_f<0xB1, 0xf>(mx, mx));
            mx = fmaxf(mx, dpp_f<0x4E, 0xf>(mx, mx));
            mx = fmaxf(mx, dpp_f<0x141, 0xf>(mx, mx));
            mx = fmaxf(mx, dpp_f<0x140, 0xf>(mx, mx));
            if (k == 0) M0 = mx;
#pragma unroll
            for (int m = 0; m < 4; ++m) cv[m] = (cv[m] == mx) ? NEG : cv[m];
        }
        bool sel[4]; float e[4]; float es = 0.f;
#pragma unroll
        for (int m = 0; m < 4; ++m) { sel[m] = (cv[m] != og[m]); e[m] = sel[m] ? __expf(og[m] - M0) : 0.f; es += e[m]; }
        es += dpp_f<0xB1, 0xf>(0.f, es); es += dpp_f<0x4E, 0xf>(0.f, es); es += dpp_f<0x141, 0xf>(0.f, es); es += dpp_f<0x140, 0xf>(0.f, es);
        const float inv = 1.0f / es;
        int basepos = 0;
        const int head = 4 * hh + row;
#pragma unroll
        for (int m = 0; m < 4; ++m) {
            const unsigned long long bl = __ballot(sel[m]);
            const unsigned rbits = (unsigned)(bl >> (16 * row)) & 0xffffu;
            const int pos = basepos + __popc(rbits & ((1u << i16) - 1u));
            if (sel[m] && pos < 16) { ex[(size_t)t * 128 + head * 16 + pos] = id[m]; gt[(size_t)t * 128 + head * 16 + pos] = e[m] * inv; }
            basepos += __popc(rbits);
        }
    }
}

typedef __bf16 bf16x32v __attribute__((ext_vector_type(32)));
typedef __bf16 bf16x2v __attribute__((ext_vector_type(2)));
typedef float f32x2 __attribute__((ext_vector_type(2)));
#ifndef P8_THROTTLE
#define P8_THROTTLE 0
#endif
constexpr unsigned P8_SLACK = 12;
__device__ __forceinline__ void phase8(const Params& p, LAS unsigned char* lds, float* dst, unsigned xcc, unsigned nwx, int gw, int NGW, int wave, int lane) {
    unsigned char* ws = p.ws;
    const bf16_t* x1b = (const bf16_t*)(ws + WS_X1B); const unsigned char* UT = ws + WS_UT; const unsigned char* VT = ws + WS_VT;
    const int* ex = (const int*)(ws + WS_EXP); const float* gt = (const float*)(ws + WS_GATE); const float* ss2 = (const float*)(ws + WS_ROWSS) + 3 * S;
    const float* out = p.out;
    LAS unsigned* list = (LAS unsigned*)(lds + 131072 + wave * 2048);
    LAS unsigned* hist = (LAS unsigned*)(lds + 147456 + wave * 256);
    for (int tb = gw; tb < S / 4; tb += NGW) {
        const int t0 = tb * 4;
        int id[8]; float gv[8];
#pragma unroll
        for (int r = 0; r < 8; ++r) { const size_t o = (size_t)(t0 + (r >> 1)) * 128 + (r & 1) * 64 + lane; id[r] = ex[o]; gv[r] = gt[o]; }
        const float rs0 = rsqrtf(ss2[t0 + 0] * (1.0f / DM) + EPS) * (1.0f / PEER_USC), rs1 = rsqrtf(ss2[t0 + 1] * (1.0f / DM) + EPS) * (1.0f / PEER_USC);
        const float rs2 = rsqrtf(ss2[t0 + 2] * (1.0f / DM) + EPS) * (1.0f / PEER_USC), rs3 = rsqrtf(ss2[t0 + 3] * (1.0f / DM) + EPS) * (1.0f / PEER_USC);
        hist[lane] = 0u;
        LDS_WAIT(); asm volatile("" ::: "memory");
        unsigned pos[8];
#pragma unroll
        for (int r = 0; r < 8; ++r) pos[r] = __hip_atomic_fetch_add(hist + (id[r] >> 8), 1u, __ATOMIC_RELAXED, __HIP_MEMORY_SCOPE_WORKGROUP);
        LDS_WAIT(); asm volatile("" ::: "memory");
        const unsigned cnt = hist[lane];
        unsigned inc = cnt;
#pragma unroll
        for (int o = 1; o < 64; o <<= 1) { const unsigned n = __shfl_up(inc, o); if (lane >= o) inc += n; }
        LDS_WAIT(); asm volatile("" ::: "memory");
        hist[lane] = inc - cnt;
        LDS_WAIT(); asm volatile("" ::: "memory");
#pragma unroll
        for (int r = 0; r < 8; ++r) { const unsigned d = hist[id[r] >> 8] + pos[r]; list[d] = (unsigned)id[r] | ((unsigned)(r >> 1) << 14) | (f2bf(gv[r]) << 16); }
        LDS_WAIT(); asm volatile("" ::: "memory");
        {
            typedef unsigned u32x16 __attribute__((ext_vector_type(16)));
            const __amdgpu_buffer_rsrc_t urs = __builtin_amdgcn_make_buffer_rsrc((void*)UT, 0, 16384 * PEER_ROWB, 0x00020000);
            const int vo4 = lane * 16, vo2 = lane * 8 + 1024;
            const int li = lane & 3;
            const bool lb2 = (lane & 4) != 0, lb3 = (lane & 8) != 0;
            LAS unsigned char* stw = lds + wave * 16384;
            const LAS unsigned char* strd = stw + li * 1600 + (lane >> 2) * 16;
            const LAS unsigned char* strd2 = stw + li * 1600 + 1024 + (lane >> 2) * 8;
            s16x4 xr[32];
#pragma unroll
            for (int c = 0; c < 4; ++c)
#pragma unroll
                for (int q = 0; q < 8; ++q) xr[c * 8 + q] = __builtin_bit_cast(s16x4, *(const u32x2*)(x1b + (size_t)(t0 + li) * DM + (q * 64 + c * 16 + (lane >> 2)) * 4));
#define P8_ULOAD(k, i) do { const unsigned en = (unsigned)__builtin_amdgcn_readfirstlane((int)list[(i)]); const int ro = (int)((en & 0x3fffu) * (unsigned)PEER_ROWB); \
            u4[k] = __builtin_amdgcn_raw_buffer_load_b128(urs, vo4, ro, 0); u2[k] = __builtin_amdgcn_raw_buffer_load_b64(urs, vo2, ro, 0); } while (0)
#define P8_USTAGE(kb) do { _Pragma("unroll") for (int r = 0; r < 4; ++r) { *(LAS u32x4*)(stw + r * 1600 + lane * 16) = u4[(kb) + r]; *(LAS u32x2*)(stw + r * 1600 + 1024 + lane * 8) = u2[(kb) + r]; } } while (0)
#define P8_UPROCB(RES) do { f32x4 a0 = {0.f, 0.f, 0.f, 0.f}, a1 = {0.f, 0.f, 0.f, 0.f}; \
            _Pragma("unroll") for (int c = 0; c < 4; ++c) { const u32x4 q4 = *(const LAS u32x4*)(strd + c * 256); const u32x2 q2 = *(const LAS u32x2*)(strd2 + c * 128); \
                const u32x6 pk = {q4[0], q4[1], q4[2], q4[3], q2[0], q2[1]}; \
                const u32x16 r_ = __builtin_bit_cast(u32x16, __builtin_amdgcn_cvt_scalef32_pk32_bf16_fp6(pk, 1.0f)); \
                _Pragma("unroll") for (int q = 0; q < 8; q += 2) { \
                    a0 = __builtin_amdgcn_mfma_f32_4x4x4bf16_1k(__builtin_bit_cast(s16x4, (u32x2){r_[2 * q], r_[2 * q + 1]}), xr[c * 8 + q], a0, 0, 0, 0); \
                    a1 = __builtin_amdgcn_mfma_f32_4x4x4bf16_1k(__builtin_bit_cast(s16x4, (u32x2){r_[2 * q + 2], r_[2 * q + 3]}), xr[c * 8 + q + 1], a1, 0, 0, 0); } } \
            const f32x4 a_ = a0 + a1; \
            const float k0 = lb2 ? a_[2] : a_[0], s0 = lb2 ? a_[0] : a_[2], k1 = lb2 ? a_[3] : a_[1], s1 = lb2 ? a_[1] : a_[3]; \
            const float w0 = k0 + __shfl_xor(s0, 4), w1 = k1 + __shfl_xor(s1, 4); \
            float r1 = (lb3 ? w1 : w0) + __shfl_xor(lb3 ? w0 : w1, 8); \
            r1 += __shfl_xor(r1, 16); r1 += __shfl_xor(r1, 32); RES = r1; } while (0)
#if (PROBE_DUP >> 10) & 1
#define P8_UREPS 2
#else
#define P8_UREPS 1
#endif
#pragma unroll 1
            for (int urep = 0; urep < P8_UREPS; ++urep) {
                u32x4 u4[16]; u32x2 u2[16];
#pragma unroll
                for (int k = 0; k < 16; ++k) P8_ULOAD(k, k);
#pragma unroll 1
                for (int i0 = 0; i0 < 512; i0 += 16) {
#pragma unroll
                    for (int hb = 0; hb < 2; ++hb) {
                        const int i = i0 + 8 * hb;
                        const unsigned ev = list[i + (lane & 7)]; const unsigned jl = (ev >> 14) & 3u;
                        const float gl = __builtin_bit_cast(float, ev & 0xffff0000u), rl = jl == 0u ? rs0 : (jl == 1u ? rs1 : (jl == 2u ? rs2 : rs3));
                        const int srcl = ((lane & 2) << 1) + ((lane & 1) << 3) + (int)jl;
                        float ra, rb;
                        P8_USTAGE(8 * hb);
#pragma unroll
                        for (int k = 0; k < 4; ++k) { const int nx = i + 16 + k; P8_ULOAD(8 * hb + k, nx < 512 ? nx : 511); }
                        P8_UPROCB(ra);
                        P8_USTAGE(8 * hb + 4);
#pragma unroll
                        for (int k = 4; k < 8; ++k) { const int nx = i + 16 + k; P8_ULOAD(8 * hb + k, nx < 512 ? nx : 511); }
                        P8_UPROCB(rb);
                        const float da = __shfl(ra, srcl), db = __shfl(rb, srcl);
                        const float dres = (lane & 4) ? db : da;
                        const float c_ = gl * gelu_tanh(rl * dres) * (1.0f / PEER_VSC);
                        if (lane < 8 && urep == P8_UREPS - 1) list[i + lane] = (ev & 0xffffu) | (f2bf(c_) << 16);
                    }
                }
            }
#undef P8_ULOAD
#undef P8_USTAGE
#undef P8_UPROCB
        }
        asm volatile("s_waitcnt vmcnt(0)" ::: "memory");
        LDS_WAIT(); asm volatile("" ::: "memory");
        f32x4 acc[32];
#if (PROBE_DUP >> 12) & 1
#define P8_VREPS 2
#else
#define P8_VREPS 1
#endif
#pragma unroll 1
        for (int vrep = 0; vrep < P8_VREPS; ++vrep) {
#pragma unroll
        for (int i = 0; i < 32; ++i) acc[i] = (f32x4){0.f, 0.f, 0.f, 0.f};
        {
            typedef unsigned u32x16 __attribute__((ext_vector_type(16)));
            u32x4 v4[4]; u32x2 v2[4]; unsigned ven[4];
            const unsigned tok = (unsigned)lane & 3u;
            const __amdgpu_buffer_rsrc_t vrs = __builtin_amdgcn_make_buffer_rsrc((void*)VT, 0, 16384 * PEER_ROWB, 0x00020000);
            const int vo4 = lane * 16, vo2 = lane * 8 + 1024;
#define P8_VLOAD(k, i) do { const unsigned en = (unsigned)__builtin_amdgcn_readfirstlane((int)list[(i)]); ven[k] = en; const int ro = (int)((en & 0x3fffu) * (unsigned)PEER_ROWB); \
            v4[k] = __builtin_amdgcn_raw_buffer_load_b128(vrs, vo4, ro, 0); v2[k] = __builtin_amdgcn_raw_buffer_load_b64(vrs, vo2, ro, 0); } while (0)
#define P8_VPROC2(ka, kb) do { const u32x6 pka = {v4[ka][0], v4[ka][1], v4[ka][2], v4[ka][3], v2[ka][0], v2[ka][1]}, pkb = {v4[kb][0], v4[kb][1], v4[kb][2], v4[kb][3], v2[kb][0], v2[kb][1]}; \
            const u32x16 da = __builtin_bit_cast(u32x16, __builtin_amdgcn_cvt_scalef32_pk32_bf16_fp6(pka, 1.0f)), db = __builtin_bit_cast(u32x16, __builtin_amdgcn_cvt_scalef32_pk32_bf16_fp6(pkb, 1.0f)); \
            const unsigned ea = ven[ka], eb = ven[kb]; \
            const unsigned alo = ((((ea >> 14) & 3u) == tok) ? (ea >> 16) : 0u) | ((((eb >> 14) & 3u) == tok) ? (eb & 0xffff0000u) : 0u); \
            const s16x4 av = __builtin_bit_cast(s16x4, (unsigned long long)alo); \
            _Pragma("unroll") for (int m = 0; m < 16; ++m) { \
                const unsigned be = __builtin_amdgcn_perm(db[m], da[m], 0x05040100u), bo = __builtin_amdgcn_perm(db[m], da[m], 0x07060302u); \
                acc[2 * m] = __builtin_amdgcn_mfma_f32_4x4x4bf16_1k(av, __builtin_bit_cast(s16x4, (unsigned long long)be), acc[2 * m], 0, 0, 0); \
                acc[2 * m + 1] = __builtin_amdgcn_mfma_f32_4x4x4bf16_1k(av, __builtin_bit_cast(s16x4, (unsigned long long)bo), acc[2 * m + 1], 0, 0, 0); } } while (0)
#pragma unroll
            for (int k = 0; k < 4; ++k) P8_VLOAD(k, k);
#pragma unroll 1
            for (int i = 0; i < 512; i += 4) {
#pragma unroll
                for (int k = 0; k < 4; k += 2) { P8_VPROC2(k, k + 1); const int nx = i + 4 + k < 512 ? i + 4 + k : 510; P8_VLOAD(k, nx); P8_VLOAD(k + 1, nx + 1); }
            }
#undef P8_VLOAD
#undef P8_VPROC2
        }
        }
        int tq = t0, lq = lane; asm volatile("" : "+s"(tq)); asm volatile("" : "+v"(lq));
#pragma unroll
        for (int j = 0; j < 4; ++j)
#pragma unroll
            for (int i = 0; i < 8; ++i) {
                const size_t o = (size_t)(tq + j) * DM + (i * 64 + lq) * 4;
                f32x4 a = *(const f32x4*)(out + o);
#pragma unroll
                for (int q = 0; q < 4; ++q) a[q] += acc[4 * i + q][j];
                *(f32x4*)(dst + o) = a;
                if (i & 1) asm volatile("" ::: "memory");
            }
        LDS_WAIT(); asm volatile("" ::: "memory");
    }
}

__global__ void __launch_bounds__(NTHREADS, 2) mega(Params p) {
    extern __shared__ __attribute__((aligned(16))) unsigned char lds_raw[];
    LAS unsigned char* lds = (LAS unsigned char*)lds_raw;
    const int tid = threadIdx.x, lane = tid & 63, wave = __builtin_amdgcn_readfirstlane(tid >> 6);
    const int G = gridDim.x, bx = blockIdx.x;
    const int gw = bx * 8 + wave, NGW = G * 8;
    unsigned char* ws = p.ws;
    const int lo = p.ph_lo, hi = p.ph_hi;
    volatile LAS unsigned* misc = (volatile LAS unsigned*)(lds + LDS_MISC);
    if (tid < 4) misc[tid] = 0u;
    __syncthreads();
    const XcdBarrier xbar = xcd_barrier_post((unsigned*)(ws + WS_CTL), misc);
#ifndef PH_MASK
#define PH_MASK 0x1ff
#endif
#define IN(k) (((PH_MASK >> (k)) & 1) && lo <= (k) && (k) < hi)
#define SEAM(k) do { if (IN(k) && IN((k) + 1)) xcd_barrier(xbar); } while (0)

#if (PROBE_DUP >> 0) & 1
    if (IN(0)) { phase0(p, lds, G == 256, gw, NGW, wave, lane); xcd_barrier(xbar); }
#endif
    if (IN(0)) phase0(p, lds, G == 256, gw, NGW, wave, lane);
    SEAM(0);
    if (IN(1)) {
        pg8::Gemm g{(const bf16_t*)(ws + WS_XB), (const bf16_t*)(ws + WS_WIN), S, NINP, DM, DM, DM};
        pg8::StaticOrder So; So.init(S, NINP, G, bx);
        pg8::Epi<1> E{(const float*)(ws + WS_RSTD1), 0.f, (float*)(ws + WS_ROWSS), (bf16_t*)(ws + WS_PROJ), NINP, nullptr, nullptr};
#if (PROBE_DUP >> 1) & 1
        { pg8::Epi<1> E2 = E; E2.ss = (float*)(ws + 512 * 1024); pg8::gemm_phase<pg8::Epi<1>, pg8::StaticOrder, true, true>(lds, g, So, E2); xcd_barrier(xbar); }
#endif
        pg8::gemm_phase<pg8::Epi<1>, pg8::StaticOrder, true, true>(lds, g, So, E);
        if (G == 256 && bx >= 128) { __syncthreads(); prep_late(p, lds, (bx - 128) * 8 + wave, 1024, wave, lane); }
    }
    SEAM(1);
    if (IN(2)) {
        {
            pg8::Gemm g{(const bf16_t*)(ws + WS_PROJ) + 2048, (const bf16_t*)(ws + WS_WUQ), S, 1536, 512, NINP, 512};
            pg8::StaticOrder So; So.init(S, 1536, G, bx);
            pg8::Epi<2> E{(const float*)(ws + WS_ROWSS) + 1 * S, 1.0f / 512.0f, nullptr, (bf16_t*)(ws + WS_QRAW), 1536, nullptr, nullptr};
            pg8::gemm_phase<pg8::Epi<2>, pg8::StaticOrder, true, true>(lds, g, So, E);
        }
        __syncthreads();
        {
            pg8::Gemm g{(const bf16_t*)(ws + WS_PROJ) + 2560, (const bf16_t*)(ws + WS_WUKV), S, 2048, 256, NINP, 256};
            pg8::StaticOrder So; So.init(S, 2048, G, bx);
            pg8::Epi<2> E{(const float*)(ws + WS_ROWSS) + 2 * S, 1.0f / 256.0f, nullptr, (bf16_t*)(ws + WS_KVRAW), 2048, nullptr, nullptr};
            pg8::gemm_phase<pg8::Epi<2>, pg8::StaticOrder, true, true>(lds, g, So, E);
        }
    }
    SEAM(2);
#if (PROBE_DUP >> 3) & 1
    if (IN(3)) { phase3(p, gw, NGW, lane); xcd_barrier(xbar); }
#endif
    if (IN(3)) phase3(p, gw, NGW, lane);
    SEAM(3);
#define P4_BODY_ATT for (int pr = bx; pr < 256; pr += G) { const int head = pr & 7, x = pr >> 3; attn_unit(p, lds, head, 63 - x, tid, wave, lane); attn_unit(p, lds, head, x, tid, wave, lane); }
#define P4_BODY_GMLP for (int u = bx; u < 512; u += G) gmlp_unit(p, lds, u >> 3, u & 7, tid, wave, lane);
#if (PROBE_DUP >> 4) & 1
    if (IN(4)) { P4_BODY_ATT; xcd_barrier(xbar); }
#endif
#if (PROBE_DUP >> 9) & 1
    if (IN(4)) { P4_BODY_GMLP; xcd_barrier(xbar); }
#endif
    if (IN(4)) { P4_BODY_ATT; P4_BODY_GMLP; }
    SEAM(4);
    if (IN(5)) {
        pg8::Gemm g{(const bf16_t*)(ws + WS_MIX), (const bf16_t*)(ws + WS_WOUT), S, DM, DM, DM, DM};
        pg8::StaticOrder So; So.init(S, DM, G, bx);
        pg8::Epi<4> E{nullptr, 0.f, (float*)(ws + WS_ROWSS) + 3 * S, (bf16_t*)(ws + WS_X1B), DM, p.out, p.in[0]};
#if (PROBE_DUP >> 5) & 1
        { pg8::Epi<4> E2 = E; E2.ss = (float*)(ws + 512 * 1024); pg8::gemm_phase<pg8::Epi<4>, pg8::StaticOrder, true, true>(lds, g, So, E2); xcd_barrier(xbar); }
#endif
        pg8::gemm_phase<pg8::Epi<4>, pg8::StaticOrder, true, true>(lds, g, So, E);
    }
    SEAM(5);
    if (IN(6)) {
        pg8::Gemm g{(const bf16_t*)(ws + WS_X1B), (const bf16_t*)(ws + WS_WS), S, DM, DM, DM, DM};
        pg8::StaticOrder So; So.init(S, DM, G, bx);
        pg8::Epi<5> E{(const float*)(ws + WS_ROWSS) + 3 * S, 1.0f / DM, nullptr, nullptr, DM, (float*)(ws + WS_SC), nullptr};
#if (PROBE_DUP >> 6) & 1
        { pg8::gemm_phase<pg8::Epi<5>, pg8::StaticOrder, true, true>(lds, g, So, E); xcd_barrier(xbar); }
#endif
        pg8::gemm_phase<pg8::Epi<5>, pg8::StaticOrder, true, true>(lds, g, So, E);
    }
    SEAM(6);
#if (PROBE_DUP >> 7) & 1
    if (IN(7)) { phase7(p, lds, gw, NGW, wave, lane); xcd_barrier(xbar); }
#endif
    if (IN(7)) phase7(p, lds, gw, NGW, wave, lane);
    SEAM(7);
#if (PROBE_DUP >> 8) & 1
    if (IN(8)) { phase8(p, lds, (float*)(ws + WS_SC), xbar.x, 8u * misc[0], gw, NGW, wave, lane); xcd_barrier(xbar); }
#endif
    if (IN(8)) phase8(p, lds, p.out, xbar.x, 8u * misc[0], gw, NGW, wave, lane);
#undef IN
#undef SEAM
}

extern "C" void kernel_launch(void* const* d_in, const int* in_sizes, int n_in, void* d_out, int out_size, void* d_ws, size_t ws_size, hipStream_t stream) {
    static int grid = 0;
    if (grid == 0) {
        if (n_in != 18 || out_size != S * DM || ws_size < WS_END) { fprintf(stderr, "kernel_launch: unexpected shapes (n_in %d out %d ws %zu)\n", n_in, out_size, ws_size); grid = -1; return; }
        int dev = 0, cus = 0, per_cu = 0;
        hipGetDevice(&dev);
        hipDeviceGetAttribute(&cus, hipDeviceAttributeMultiprocessorCount, dev);
        if (hipFuncSetAttribute((const void*)mega, hipFuncAttributeMaxDynamicSharedMemorySize, LDS_BYTES) != hipSuccess) { fprintf(stderr, "kernel_launch: hipFuncSetAttribute failed\n"); grid = -1; return; }
        if (hipOccupancyMaxActiveBlocksPerMultiprocessor(&per_cu, (const void*)mega, NTHREADS, LDS_BYTES) != hipSuccess || per_cu < 1) { fprintf(stderr, "kernel_launch: occupancy query failed (%d)\n", per_cu); grid = -1; return; }
        grid = cus;
        fprintf(stderr, "kernel_launch: cus %d per_cu %d grid %d\n", cus, per_cu, grid);
    }
    if (grid < 0) return;
    hipMemsetAsync((char*)d_ws + WS_CTL, 0, 1 * MiB, stream);
    Params prm{};
    for (int i = 0; i < 18; ++i) prm.in[i] = (const float*)d_in[i];
    prm.out = (float*)d_out; prm.ws = (unsigned char*)d_ws;
#if MK_ONE_LAUNCH
    prm.ph_lo = 0; prm.ph_hi = NPH;
    { void* args[] = {&prm}; hipError_t e = hipLaunchCooperativeKernel((const void*)mega, dim3(grid), dim3(NTHREADS), args, LDS_BYTES, stream);
      if (e != hipSuccess) fprintf(stderr, "cooperative launch failed: %s\n", hipGetErrorString(e)); }
#else
    for (int ph = 0; ph < NPH; ++ph) {
        prm.ph_lo = ph; prm.ph_hi = ph + 1;
        void* args[] = {&prm};
        hipError_t e = hipLaunchCooperativeKernel((const void*)mega, dim3(grid), dim3(NTHREADS), args, LDS_BYTES, stream);
        if (e != hipSuccess) { fprintf(stderr, "cooperative launch %d failed: %s\n", ph, hipGetErrorString(e)); break; }
    }
#endif
}
```

```cpp
#include <hip/hip_runtime.h>
#include <cstdio>
#include <cstdint>

#define LAS __attribute__((address_space(3)))
typedef unsigned short bf16_t;
typedef short bf16x8 __attribute__((ext_vector_type(8)));
typedef short s16x4 __attribute__((ext_vector_type(4)));
typedef float f32x4 __attribute__((ext_vector_type(4)));
typedef float f32x16 __attribute__((ext_vector_type(16)));
typedef unsigned u32x4 __attribute__((ext_vector_type(4)));
typedef unsigned u32x2 __attribute__((ext_vector_type(2)));

#ifndef PROBE_DUP
#define PROBE_DUP 0
#endif
#ifndef MK_ONE_LAUNCH
#define MK_ONE_LAUNCH 1
#endif

constexpr int S = 8192, DM = 2048, NIN = 2880, NINP = 3072;
constexpr int NPH = 9;
constexpr float EPS = 1e-6f;
constexpr int LDS_BYTES = 163840;
constexpr int NTHREADS = 512;
constexpr int LDS_MISC = 161792;

constexpr size_t MiB = 1u << 20;
constexpr size_t WS_CTL = 0;
constexpr size_t WS_ROWSS = 128 * 1024;
constexpr size_t WS_COS = 1 * MiB, WS_SIN = 2 * MiB;
constexpr size_t WS_RSTD1 = 3 * MiB;
constexpr size_t WS_EXP = 4 * MiB;
constexpr size_t WS_GATE = 8 * MiB;
constexpr size_t WS_WIN = 12 * MiB;
constexpr size_t WS_WUQ = 24 * MiB;
constexpr size_t WS_WUKV = 26 * MiB;
constexpr size_t WS_WOUT = 28 * MiB;
constexpr size_t WS_WS = 36 * MiB;
constexpr size_t WS_XB = 44 * MiB;
constexpr size_t WS_PROJ = 76 * MiB;
constexpr size_t WS_QRAW = 124 * MiB;
constexpr size_t WS_KVRAW = 148 * MiB;
constexpr size_t WS_QH = 180 * MiB;
constexpr size_t WS_KH = 204 * MiB;
constexpr size_t WS_VH = 228 * MiB;
constexpr size_t WS_MIX = 244 * MiB;
constexpr size_t WS_X1B = 276 * MiB;
constexpr size_t WS_SC = 308 * MiB;
constexpr size_t WS_UT = 372 * MiB;
constexpr size_t WS_VT = 436 * MiB;
constexpr size_t WS_END = 500 * MiB;

__device__ __forceinline__ unsigned f2bf(float f) { unsigned u = __builtin_bit_cast(unsigned, f); return (u + 0x7fffu + ((u >> 16) & 1u)) >> 16; }
__device__ __forceinline__ unsigned pk2(float lo, float hi) { return f2bf(lo) | (f2bf(hi) << 16); }
__device__ __forceinline__ float bf2f(unsigned short b) { return __builtin_bit_cast(float, (unsigned)b << 16); }
__device__ __forceinline__ float bflo(unsigned w) { return __builtin_bit_cast(float, w << 16); }
__device__ __forceinline__ float bfhi(unsigned w) { return __builtin_bit_cast(float, w & 0xffff0000u); }
__device__ __forceinline__ float wave_sum(float v) {
#pragma unroll
    for (int o = 32; o > 0; o >>= 1) v += __shfl_xor(v, o);
    return v;
}
__device__ __forceinline__ float wave_max(float v) {
#pragma unroll
    for (int o = 32; o > 0; o >>= 1) v = fmaxf(v, __shfl_xor(v, o));
    return v;
}
template <int CTRL, int ROW_MASK> __device__ __forceinline__ float dpp_f(float old, float v) {
    return __builtin_bit_cast(float, __builtin_amdgcn_update_dpp(__builtin_bit_cast(int, old), __builtin_bit_cast(int, v), CTRL, ROW_MASK, 0xf, false));
}
__device__ __forceinline__ float wave_max_u(float v) {
    v = fmaxf(v, dpp_f<0xB1, 0xf>(v, v));
    v = fmaxf(v, dpp_f<0x4E, 0xf>(v, v));
    v = fmaxf(v, dpp_f<0x141, 0xf>(v, v));
    v = fmaxf(v, dpp_f<0x140, 0xf>(v, v));
    v = fmaxf(v, dpp_f<0x142, 0xa>(v, v));
    v = fmaxf(v, dpp_f<0x143, 0xc>(v, v));
    return __builtin_bit_cast(float, __builtin_amdgcn_readlane(__builtin_bit_cast(int, v), 63));
}
__device__ __forceinline__ float wave_sum_u(float v) {
    v += dpp_f<0xB1, 0xf>(0.f, v);
    v += dpp_f<0x4E, 0xf>(0.f, v);
    v += dpp_f<0x141, 0xf>(0.f, v);
    v += dpp_f<0x140, 0xf>(0.f, v);
    v += dpp_f<0x142, 0xa>(0.f, v);
    v += dpp_f<0x143, 0xc>(0.f, v);
    return __builtin_bit_cast(float, __builtin_amdgcn_readlane(__builtin_bit_cast(int, v), 63));
}
__device__ __forceinline__ float gelu_tanh(float x) {
    const float y = 0.7978845608028654f * (x + 0.044715f * x * x * x);
    return x / (1.0f + __expf(-2.0f * y));
}
__device__ __forceinline__ int crow(int r, int hi) { return (r & 3) + 8 * (r >> 2) + 4 * hi; }
#define LDS_WAIT() asm volatile("s_waitcnt lgkmcnt(0)" ::: "memory")
#define SBAR() __builtin_amdgcn_sched_barrier(0)

namespace pg8 {
#define PG8_LAS __attribute__((address_space(3)))
constexpr int BM = 256, BK = 64, HALF = 128, HTB = HALF * BK * 2  , STAGE_BYTES = 8 * HTB, NXCD = 8, WGM = 8;

__host__ __device__ __forceinline__ int lds_byte(int r, int c) { const int st = (r >> 4) * 2 + (c >> 5), rr = r & 15, cc = c & 31, ob = rr * 64 + cc * 2; return st * 1024 + (ob ^ (((ob >> 9) & 1) << 5)); }
__host__ __device__ __forceinline__ void stage_rc(int b, int& R, int& C) { const int st = b / 1024, sb = b % 1024, swz = sb ^ (((sb >> 9) & 1) << 5); R = (st >> 1) * 16 + swz / 64; C = (st & 1) * 32 + (swz % 64) / 2; }
__host__ __device__ __forceinline__ int perm32(int rho) { const int n = rho >> 4, i = rho & 15; return 8 * (i >> 2) + 4 * n + (i & 3); }

struct Unit { int pm, pn; };
struct Gemm { const bf16_t* A; const bf16_t* Bt; int M, N, K, lda, ldb; };

struct StaticOrder {
    int nM, nN, nwg, G, c;
    __host__ __device__ void init(int M, int N, int G_, int c_) { nM = M / BM; nN = N / BM; nwg = nM * nN; G = G_; c = c_; }
    __host__ __device__ bool next(int i, Unit& u) const {
        const long L = (long)i * G + c; if (L >= nwg) return false;
        int wgid = (int)L; { const int q = nwg / NXCD, r = nwg % NXCD, xcd = wgid % NXCD, off = wgid / NXCD; wgid = (xcd < r ? xcd * (q + 1) : r * (q + 1) + (xcd - r) * q) + off; }
        const int nig = WGM * nN, gid = wgid / nig, fm = gid * WGM, gsz = (nM - fm) < WGM ? (nM - fm) : WGM;
        u.pm = fm + ((wgid % nig) % gsz); u.pn = (wgid % nig) / gsz; return true;
    }
    __device__ __forceinline__ void a_ready(const Unit&) const {}
    __device__ __forceinline__ void done(const Unit&) const {}
};

template <class Epi, class Sched, bool ALIGN_EPI = false, bool SP2 = false>
__device__ __forceinline__ void gemm_phase(PG8_LAS unsigned char* lds, const Gemm g, const Sched& S, const Epi& E) {
    const int tid = threadIdx.x, wid = __builtin_amdgcn_readfirstlane(tid >> 6), lane = tid & 63, wr = wid >> 2, wc = wid & 3, fr = lane & 15, fq = lane >> 4;
    const int K = g.K, nt = K / BK;
    unsigned voffA[2], voffB[2];
#pragma unroll
    for (int i = 0; i < 2; ++i) { int R, C; stage_rc(tid * 16 + i * 8192, R, C); const int Rb = Epi::PERM ? ((R & ~31) + perm32(R & 31)) : R;
        voffA[i] = (unsigned)(R * g.lda + C) * 2u; voffB[i] = (unsigned)(Rb * g.ldb + C) * 2u; }
    const size_t kstep = (size_t)(BK * 2);
    const size_t hstepA = (size_t)HALF * g.lda * 2, hstepB = (size_t)HALF * g.ldb * 2;
    const size_t tstepA = 2 * hstepA, tstepB = 2 * hstepB;
    const unsigned ldsw = (unsigned)wid * 1024u;
    const int aoff = lds_byte(wr * 64 + fr, fq * 8), boff = lds_byte(wc * 32 + fr, fq * 8);
#define PG8_SA(b, h) (((b) * 2 + (h)) * HTB)
#define PG8_SB(b, h) ((4 + (b) * 2 + (h)) * HTB)
#define PG8_STAGE(bufoff, gbase, voff) do { _Pragma("unroll") for (int _i = 0; _i < 2; ++_i) \
        __builtin_amdgcn_global_load_lds((const unsigned*)((const char*)(gbase) + (voff)[_i]), (PG8_LAS unsigned*)(lds + (bufoff) + ldsw + _i * 8192), 16, 0, 0); } while (0)
#define PG8_LDA(dst, b, h) do { _Pragma("unroll") for (int m = 0; m < 4; ++m) _Pragma("unroll") for (int k = 0; k < 2; ++k) dst[m][k] = *(const PG8_LAS bf16x8*)(lds + PG8_SA(b, h) + aoff + m * 2048 + k * 1024); } while (0)
#define PG8_LDB(dst, b, h) do { _Pragma("unroll") for (int n = 0; n < 2; ++n) _Pragma("unroll") for (int k = 0; k < 2; ++k) dst[n][k] = *(const PG8_LAS bf16x8*)(lds + PG8_SB(b, h) + boff + n * 2048 + k * 1024); } while (0)
#define PG8_MMA(ai, bj, At, Bt) do { __builtin_amdgcn_s_setprio(1); _Pragma("unroll") for (int m = 0; m < 4; ++m) _Pragma("unroll") for (int n = 0; n < 2; ++n) _Pragma("unroll") for (int k = 0; k < 2; ++k) \
        acc[ai][bj][m][n] = __builtin_amdgcn_mfma_f32_16x16x32_bf16(Bt[n][k], At[m][k], acc[ai][bj][m][n], 0, 0, 0); __builtin_amdgcn_s_setprio(0); } while (0)
#define PG8_WAIT_V(n) asm volatile("s_waitcnt vmcnt(" #n ")" ::: "memory")
#define PG8_WAIT_L(n) asm volatile("s_waitcnt lgkmcnt(" #n ")" ::: "memory")
#define PG8_BAR __builtin_amdgcn_s_barrier()
#define PG8_SCHED __builtin_amdgcn_sched_barrier(0)
    Unit cur, nxt; int ui = 0;
    if (!S.next(0, cur)) return;
    f32x4 acc[2][2][4][2];
#pragma unroll
    for (int a = 0; a < 2; ++a)
#pragma unroll
        for (int b = 0; b < 2; ++b)
#pragma unroll
            for (int m = 0; m < 4; ++m)
#pragma unroll
                for (int n = 0; n < 2; ++n) acc[a][b][m][n] = (f32x4){0.f, 0.f, 0.f, 0.f};
    bf16x8 At[4][2], B0[2][2], B1[2][2];
    const char* cA = (const char*)g.A + (size_t)cur.pm * tstepA; const char* cB = (const char*)g.Bt + (size_t)cur.pn * tstepB;
    S.a_ready(cur);
    if constexpr (SP2) {
        PG8_STAGE(PG8_SB(0, 0), cB, voffB); PG8_STAGE(PG8_SB(0, 1), cB + hstepB, voffB); PG8_STAGE(PG8_SA(0, 0), cA, voffA); PG8_STAGE(PG8_SA(0, 1), cA + hstepA, voffA);
        if (wr == 1) PG8_BAR;
        PG8_WAIT_V(2); PG8_BAR;
        PG8_STAGE(PG8_SB(1, 0), cB + kstep, voffB); PG8_STAGE(PG8_SA(1, 0), cA + kstep, voffA); PG8_STAGE(PG8_SB(1, 1), cB + hstepB + kstep, voffB);
        PG8_WAIT_V(6); PG8_BAR;
    } else {
        PG8_STAGE(PG8_SB(0, 0), cB, voffB); PG8_STAGE(PG8_SA(0, 0), cA, voffA); PG8_STAGE(PG8_SB(0, 1), cB + hstepB, voffB); PG8_STAGE(PG8_SA(0, 1), cA + hstepA, voffA);
        if (wr == 1) PG8_BAR;
        PG8_WAIT_V(4); PG8_BAR;
        PG8_STAGE(PG8_SB(1, 0), cB + kstep, voffB); PG8_STAGE(PG8_SA(1, 0), cA + kstep, voffA); PG8_STAGE(PG8_SB(1, 1), cB + hstepB + kstep, voffB);
        PG8_WAIT_V(6); PG8_BAR;
    }
    for (;;) {
        const bool has_next = S.next(ui + 1, nxt);
        const char* nA = has_next ? (const char*)g.A + (size_t)nxt.pm * tstepA : cA; const char* nB = has_next ? (const char*)g.Bt + (size_t)nxt.pn * tstepB : cB;
        for (int t = 0; t < nt; t += 2) {
            const bool last = (t == nt - 2);
            const char* a1 = cA + (size_t)(t + 1) * kstep;
            const char* a2 = last ? nA : cA + (size_t)(t + 2) * kstep; const char* b2 = last ? nB : cB + (size_t)(t + 2) * kstep;
            const char* a3 = a2 + kstep; const char* b3 = b2 + kstep;
            if (last && has_next) S.a_ready(nxt);
            if constexpr (SP2) {
            PG8_LDB(B0, 0, 0); PG8_LDB(B1, 0, 1); PG8_SCHED; PG8_LDA(At, 0, 0); PG8_STAGE(PG8_SA(1, 1), a1 + hstepA, voffA);
            PG8_WAIT_V(8); PG8_WAIT_L(0); PG8_BAR; PG8_MMA(0, 0, At, B0); PG8_MMA(0, 1, At, B1); PG8_BAR; PG8_SCHED;
            PG8_LDA(At, 0, 1); PG8_STAGE(PG8_SB(0, 0), b2, voffB); PG8_STAGE(PG8_SB(0, 1), b2 + hstepB, voffB); PG8_STAGE(PG8_SA(0, 0), a2, voffA);
            PG8_WAIT_V(8); PG8_WAIT_L(0); PG8_BAR; PG8_MMA(1, 0, At, B0); PG8_MMA(1, 1, At, B1); PG8_BAR; PG8_SCHED;
            PG8_LDB(B0, 1, 0); PG8_LDB(B1, 1, 1); PG8_SCHED; PG8_LDA(At, 1, 0); PG8_STAGE(PG8_SA(0, 1), a2 + hstepA, voffA);
            PG8_WAIT_V(8); PG8_WAIT_L(0); PG8_BAR; PG8_MMA(0, 0, At, B0); PG8_MMA(0, 1, At, B1); PG8_BAR; PG8_SCHED;
            PG8_LDA(At, 1, 1); PG8_STAGE(PG8_SB(1, 0), b3, voffB); PG8_STAGE(PG8_SB(1, 1), b3 + hstepB, voffB); PG8_STAGE(PG8_SA(1, 0), a3, voffA);
            PG8_WAIT_V(8); PG8_WAIT_L(0); PG8_BAR; PG8_MMA(1, 0, At, B0); PG8_MMA(1, 1, At, B1); PG8_BAR; PG8_SCHED;
            } else {
            PG8_LDB(B0, 0, 0); PG8_SCHED; PG8_LDA(At, 0, 0); PG8_STAGE(PG8_SA(1, 1), a1 + hstepA, voffA);
            PG8_WAIT_L(8); PG8_BAR; PG8_WAIT_L(0); PG8_MMA(0, 0, At, B0); PG8_BAR; PG8_SCHED;
            PG8_LDB(B1, 0, 1); PG8_STAGE(PG8_SB(0, 0), b2, voffB);
            PG8_BAR; PG8_WAIT_L(0); PG8_MMA(0, 1, At, B1); PG8_BAR;
            PG8_LDA(At, 0, 1); PG8_STAGE(PG8_SA(0, 0), a2, voffA);
            PG8_BAR; PG8_WAIT_L(0); PG8_MMA(1, 0, At, B0); PG8_BAR; PG8_SCHED;
            PG8_STAGE(PG8_SB(0, 1), b2 + hstepB, voffB);
            PG8_WAIT_V(6); PG8_BAR; PG8_MMA(1, 1, At, B1); PG8_BAR;
            PG8_LDB(B0, 1, 0); PG8_SCHED; PG8_LDA(At, 1, 0); PG8_STAGE(PG8_SA(0, 1), a2 + hstepA, voffA);
            PG8_WAIT_L(8); PG8_BAR; PG8_WAIT_L(0); PG8_MMA(0, 0, At, B0); PG8_BAR; PG8_SCHED;
            PG8_LDB(B1, 1, 1); PG8_STAGE(PG8_SB(1, 0), b3, voffB);
            PG8_BAR; PG8_WAIT_L(0); PG8_MMA(0, 1, At, B1); PG8_BAR;
            PG8_LDA(At, 1, 1); PG8_STAGE(PG8_SA(1, 0), a3, voffA);
            PG8_BAR; PG8_WAIT_L(0); PG8_MMA(1, 0, At, B0); PG8_BAR; PG8_SCHED;
            PG8_STAGE(PG8_SB(1, 1), b3 + hstepB, voffB);
            PG8_WAIT_V(6); PG8_BAR; PG8_MMA(1, 1, At, B1); PG8_BAR;
            }
        }
        if constexpr (ALIGN_EPI) { if (wr == 0) PG8_BAR; }
        if constexpr (!Epi::AFTER_DRAIN) { E(acc, cur, wr, wc, fr, fq); S.done(cur); }
        if (!has_next) break;
#pragma unroll
        for (int a = 0; a < 2; ++a)
#pragma unroll
            for (int b = 0; b < 2; ++b)
#pragma unroll
                for (int m = 0; m < 4; ++m)
#pragma unroll
                    for (int n = 0; n < 2; ++n) acc[a][b][m][n] = (f32x4){0.f, 0.f, 0.f, 0.f};
        cur = nxt; cA = nA; cB = nB; ++ui;
        if constexpr (ALIGN_EPI) { if (wr == 1) PG8_BAR; }
    }
    PG8_WAIT_V(0);
    if constexpr (!ALIGN_EPI) { if (wr == 0) PG8_BAR; }
    PG8_BAR;
#undef PG8_SA
#undef PG8_SB
#undef PG8_STAGE
#undef PG8_LDA
#undef PG8_LDB
#undef PG8_MMA
#undef PG8_WAIT_V
#undef PG8_WAIT_L
#undef PG8_BAR
#undef PG8_SCHED
}

template <int MODE> struct Epi {
    static constexpr bool PERM = false, AFTER_DRAIN = false;
    const float* rowsrc; float inv_n; float* ss; bf16_t* ob; int ldc; float* of; const float* xin;
    __device__ __forceinline__ void operator()(const f32x4 (&acc)[2][2][4][2], const Unit& u, int wr, int wc, int fr, int fq) const {
#pragma unroll
        for (int ai = 0; ai < 2; ++ai)
#pragma unroll
            for (int m = 0; m < 4; ++m) {
                const int row = u.pm * BM + ai * HALF + wr * 64 + m * 16 + fr;
                float rs = 1.f;
                if (MODE == 1) rs = rowsrc[row];
                if (MODE == 2 || MODE == 5) rs = rsqrtf(rowsrc[row] * inv_n + EPS);
                float ssq = 0.f;
#pragma unroll
                for (int bj = 0; bj < 2; ++bj)
#pragma unroll
                    for (int n = 0; n < 2; ++n) {
                        const int col = u.pn * BM + bj * HALF + wc * 32 + n * 16 + fq * 4;
                        f32x4 v = acc[ai][bj][m][n] * rs;
                        if (MODE == 1) { if (u.pn < 8) { v[0] = gelu_tanh(v[0]); v[1] = gelu_tanh(v[1]); v[2] = gelu_tanh(v[2]); v[3] = gelu_tanh(v[3]); } }
                        if (MODE == 4) { const f32x4 xr = *(const f32x4*)(xin + (size_t)row * DM + col); v = v + xr; }
                        if (MODE == 1 || MODE == 4) ssq += (v[0] * v[0] + v[1] * v[1]) + (v[2] * v[2] + v[3] * v[3]);
                        if (MODE == 1 || MODE == 2 || MODE == 4) { u32x2 w; w.x = pk2(v[0], v[1]); w.y = pk2(v[2], v[3]); *(u32x2*)(ob + (size_t)row * ldc + col) = w; }
                        if (MODE == 4 || MODE == 5) *(f32x4*)(of + (size_t)row * DM + col) = v;
                    }
                if (MODE == 1) {
                    const int seg = (u.pn >= 4 && u.pn < 8) ? 0 : ((u.pn == 8 || u.pn == 9) ? 1 : (u.pn == 10 ? 2 : -1));
                    if (seg >= 0) { ssq += __shfl_xor(ssq, 16); ssq += __shfl_xor(ssq, 32); if (fq == 0) atomicAdd(ss + seg * S + row, ssq); }
                }
                if (MODE == 4) { ssq += __shfl_xor(ssq, 16); ssq += __shfl_xor(ssq, 32); if (fq == 0) atomicAdd(ss + row, ssq); }
            }
    }
};
}

#define XB_TMO      128
#define XB_XCNT(j)  (256  + 64 * (j))
#define XB_XSUB(j)  (1280 + 64 * (j))
#define XB_XGEN(j)  (2304 + 64 * (j))
#define XB_TOP      3328
#define XB_TOPGEN   3392
#define XCD_BAR_WORDS 3456
#define XB_SPIN_CAP (1u << 18)
__device__ __forceinline__ unsigned xb_ld(unsigned* p)              { return __hip_atomic_load(p, __ATOMIC_RELAXED, __HIP_MEMORY_SCOPE_AGENT); }
__device__ __forceinline__ unsigned xb_add(unsigned* p, unsigned v) { return __hip_atomic_fetch_add(p, v, __ATOMIC_RELAXED, __HIP_MEMORY_SCOPE_AGENT); }
__device__ __forceinline__ unsigned xb_xcc_id() { return (unsigned)__builtin_amdgcn_s_getreg((3 << 11) | 20) & 0xFu; }
#define XB_SPIN(cond, bar) do { unsigned _sp = 0; while (cond) { __builtin_amdgcn_s_sleep(1); \
    if ((++_sp & 255u) == 0u) { if (xb_ld(&(bar)[XB_TMO])) break; if (_sp > XB_SPIN_CAP) { atomicAdd(&(bar)[XB_TMO], 1u); break; } } } } while (0)
struct XcdBarrier { unsigned* bar; unsigned x; volatile LAS unsigned* st; };
__device__ __forceinline__ XcdBarrier xcd_barrier_post(unsigned* bar, volatile LAS unsigned* st) {
    XcdBarrier b; b.bar = bar; b.x = xb_xcc_id(); b.st = st;
    if (threadIdx.x == 0) (void)xb_add(&bar[XB_XCNT(b.x)], 1u);
    return b;
}
__device__ __forceinline__ void xcd_barrier_complete(unsigned* bar, unsigned x, unsigned& nloc, unsigned& nx) {
    const unsigned G = gridDim.x * gridDim.y * gridDim.z;
    unsigned sum, cnt, mine, sp = 0u;
    for (;;) {
        sum = 0u; cnt = 0u; mine = 0u;
#pragma unroll
        for (unsigned j = 0; j < 16; ++j) { const unsigned c = xb_ld(&bar[XB_XCNT(j)]); sum += c; cnt += (c > 0u) ? 1u : 0u; mine = (j == x) ? c : mine; }
        if (sum == G) break;
        __builtin_amdgcn_s_sleep(1);
        if ((++sp & 255u) == 0u) { if (xb_ld(&bar[XB_TMO])) break; if (sp > XB_SPIN_CAP) { atomicAdd(&bar[XB_TMO], 1u); break; } }
    }
    nloc = mine > 0u ? mine : 1u; nx = cnt > 0u ? cnt : 1u;
}
__device__ __forceinline__ void xcd_barrier(const XcdBarrier& b) {
    asm volatile("s_waitcnt vmcnt(0)" ::: "memory");
    __syncthreads();
    if (threadIdx.x == 0) {
        unsigned* bar = b.bar;
        __builtin_amdgcn_s_waitcnt(0);
        unsigned nloc = b.st[0], nx = b.st[1];
        if (nloc == 0u) { xcd_barrier_complete(bar, b.x, nloc, nx); b.st[0] = nloc; b.st[1] = nx; }
        const unsigned old = xb_add(&bar[XB_XSUB(b.x)], 1u);
        const unsigned gen = old / nloc;
        if (old + 1u == (gen + 1u) * nloc) {
            __builtin_amdgcn_fence(__ATOMIC_RELEASE, "agent");
            asm volatile("s_waitcnt vmcnt(0)" ::: "memory");
            const unsigned og = xb_add(&bar[XB_TOP], 1u);
            const unsigned tg = og / nx;
            if (og + 1u == (tg + 1u) * nx) xb_add(&bar[XB_TOPGEN], 1u);
            else XB_SPIN(xb_ld(&bar[XB_TOPGEN]) == tg, bar);
            __builtin_amdgcn_fence(__ATOMIC_ACQUIRE, "agent");
            xb_add(&bar[XB_XGEN(b.x)], 1u);
            asm volatile("s_waitcnt vmcnt(0)" ::: "memory");
        } else {
            XB_SPIN(xb_ld(&bar[XB_XGEN(b.x)]) == gen, bar);
            __builtin_amdgcn_fence(__ATOMIC_ACQUIRE, "agent");
            asm volatile("s_waitcnt vmcnt(0)" ::: "memory");
        }
    }
    __syncthreads();
}

struct Params {
    const float* in[18];
    float* out;
    unsigned char* ws;
    int ph_lo, ph_hi;
};

__device__ __forceinline__ void p0_transpose_item(const float* W, const float* g, int K, int N, bf16_t* WT, LAS float* scr, int item, int lane) {
    const int nblk = N / 32, kb = item / nblk, nb = item % nblk, k0 = 64 * kb, n0 = 32 * nb;
    float wv[32];
#pragma unroll
    for (int i = 0; i < 32; ++i) { const int kk = 2 * i + (lane >> 5); wv[i] = W[(size_t)(k0 + kk) * N + n0 + (lane & 31)]; }
#pragma unroll
    for (int i = 0; i < 32; ++i) { const int kk = 2 * i + (lane >> 5); const float gv = g ? g[k0 + kk] : 1.f; scr[kk * 33 + (lane & 31)] = wv[i] * gv; }
    LDS_WAIT(); asm volatile("" ::: "memory");
    const int c = lane & 7;
#pragma unroll
    for (int j = 0; j < 4; ++j) { const int n = (lane >> 3) + 8 * j; const LAS float* s = scr + (8 * c) * 33 + n;
        u32x4 o; o.x = pk2(s[0 * 33], s[1 * 33]); o.y = pk2(s[2 * 33], s[3 * 33]); o.z = pk2(s[4 * 33], s[5 * 33]); o.w = pk2(s[6 * 33], s[7 * 33]);
        *(u32x4*)(WT + (size_t)(n0 + n) * K + k0 + 8 * c) = o; }
    LDS_WAIT(); asm volatile("" ::: "memory");
}
__device__ __forceinline__ float row_to_bf16(const float* src, const float* g, bf16_t* dst, int lane) {
    float ss = 0.f;
#pragma unroll
    for (int i = 0; i < 8; ++i) {
        const int c = (i * 64 + lane) * 4;
        f32x4 v = *(const f32x4*)(src + c);
        ss += (v[0] * v[0] + v[1] * v[1]) + (v[2] * v[2] + v[3] * v[3]);
        if (g) { const f32x4 gv = *(const f32x4*)(g + c); v = v * gv; }
        u32x2 w; w.x = pk2(v[0], v[1]); w.y = pk2(v[2], v[3]);
        *(u32x2*)(dst + c) = w;
    }
    return ss;
}
constexpr float PEER_USC = 80.0f, PEER_VSC = 5.0f;
constexpr int PEER_ROWB = 1536;
typedef float f32x16v __attribute__((ext_vector_type(16)));
typedef float f32x32v __attribute__((ext_vector_type(32)));
typedef unsigned u32x6 __attribute__((ext_vector_type(6)));
typedef unsigned u32x2a4 __attribute__((ext_vector_type(2), aligned(4)));
template <bool CONTIG>
__device__ __forceinline__ void fp6_pack_store(const f32x4 (&x)[8], const f32x4 (&sc)[8], unsigned char* dst, int lane) {
    f32x16v a, b;
#pragma unroll
    for (int i = 0; i < 8; ++i) {
        const f32x4 y = x[i] * sc[i];
#pragma unroll
        for (int q = 0; q < 4; ++q) { const float c = fminf(fmaxf(y[q], -7.5f), 7.5f); const int sl = 4 * i + q; if ((sl & 1) == 0) a[sl >> 1] = c; else b[sl >> 1] = c; }
    }
    const u32x6 pk = __builtin_amdgcn_cvt_scalef32_2xpk16_fp6_f32(a, b, 1.0f);
    if (CONTIG) {
        *(u32x2*)(dst + lane * 24) = (u32x2){pk[0], pk[1]}; *(u32x2*)(dst + lane * 24 + 8) = (u32x2){pk[2], pk[3]}; *(u32x2*)(dst + lane * 24 + 16) = (u32x2){pk[4], pk[5]};
    } else {
        *(u32x4*)(dst + lane * 16) = (u32x4){pk[0], pk[1], pk[2], pk[3]};
        *(u32x2*)(dst + 1024 + lane * 8) = (u32x2){pk[4], pk[5]};
    }
}
template <bool CONTIG>
__device__ __forceinline__ void rows2_to_fp6(const float* s0, const float* s1, const f32x4 (&sc)[8], unsigned char* d0, unsigned char* d1, int lane) {
    f32x4 x0[8], x1[8];
#pragma unroll
    for (int i = 0; i < 8; ++i) { x0[i] = *(const f32x4*)(s0 + (i * 64 + lane) * 4); x1[i] = *(const f32x4*)(s1 + (i * 64 + lane) * 4); }
    fp6_pack_store<CONTIG>(x0, sc, d0, lane); fp6_pack_store<CONTIG>(x1, sc, d1, lane);
}
__device__ __forceinline__ bf16x8 cvt8(const float* p) {
    const f32x4 a = *(const f32x4*)p, b = *(const f32x4*)(p + 4);
    u32x4 w; w.x = pk2(a[0], a[1]); w.y = pk2(a[2], a[3]); w.z = pk2(b[0], b[1]); w.w = pk2(b[2], b[3]);
    return __builtin_bit_cast(bf16x8, w);
}

__device__ __forceinline__ void prep_late(const Params& p, LAS unsigned char* lds, int gw, int NGW, int wave, int lane) {
    unsigned char* ws = p.ws;
    LAS float* scr = (LAS float*)(lds + wave * 16384);
    {
        constexpr int I_UQ = (512 / 64) * (1536 / 32), I_UKV = (256 / 64) * (2048 / 32), I_OUT = (DM / 64) * (DM / 32);
        constexpr int NIT = I_UQ + I_UKV + I_OUT;
        for (int it = gw; it < NIT; it += NGW) {
            int r = it;
            if (r < I_UQ) { p0_transpose_item(p.in[7], p.in[6], 512, 1536, (bf16_t*)(ws + WS_WUQ), scr, r, lane); continue; } r -= I_UQ;
            if (r < I_UKV) { p0_transpose_item(p.in[9], p.in[8], 256, 2048, (bf16_t*)(ws + WS_WUKV), scr, r, lane); continue; } r -= I_UKV;
            p0_transpose_item(p.in[12], nullptr, DM, DM, (bf16_t*)(ws + WS_WOUT), scr, r, lane);
        }
    }
    {
        const float* wq = p.in[14]; const float* sk = p.in[15]; const float* g2 = p.in[13];
        bf16_t* WsT = (bf16_t*)(ws + WS_WS);
        const int r32 = lane & 31, hh = lane >> 5;
        for (int it = gw; it < 16 * 4 * 64; it += NGW) {
            const int hp = it >> 8, kb = (it >> 6) & 3, nb = it & 63;
            f32x16 acc = {};
            const float* ap = sk + ((size_t)(hp * 128 + kb * 32 + r32)) * 128 + hh * 8;
            const float* bp = wq + ((size_t)(nb * 32 + r32)) * DM + hp * 128 + hh * 8;
#pragma unroll
            for (int s = 0; s < 8; ++s) {
                const bf16x8 a = cvt8(ap + s * 16), b = cvt8(bp + s * 16);
                acc = __builtin_amdgcn_mfma_f32_32x32x16_bf16(a, b, acc, 0, 0, 0);
            }
            const int kcol = nb * 32 + r32; const float gk = g2[kcol];
#pragma unroll
            for (int r = 0; r < 16; ++r) WsT[(size_t)(hp * 128 + kb * 32 + crow(r, hh)) * DM + kcol] = (bf16_t)f2bf(acc[r] * gk);
        }
    }
    {
        float* ct = (float*)(ws + WS_COS); float* st = (float*)(ws + WS_SIN);
        for (int it = gw; it < S * 32 / 64; it += NGW) {
            const int idx = it * 64 + lane, t = idx >> 5, j = idx & 31;
            const float inv_freq = powf(10000.0f, -(float)j / 32.0f);
            const float ang = (float)t * inv_freq;
            float sv, cv; sincosf(ang, &sv, &cv); ct[idx] = cv; st[idx] = sv;
        }
    }
}
__device__ __forceinline__ void phase0(const Params& p, LAS unsigned char* lds, bool late_ok, int gw, int NGW, int wave, int lane) {
    unsigned char* ws = p.ws;
    LAS float* scr = (LAS float*)(lds + wave * 16384);
    const float* x = p.in[0];
    {
        constexpr int I_IN = (DM / 64) * (NIN / 32);
        for (int it = gw; it < I_IN; it += NGW) p0_transpose_item(p.in[2], p.in[1], DM, NIN, (bf16_t*)(ws + WS_WIN), scr, it, lane);
    }
    if (!late_ok) prep_late(p, lds, gw, NGW, wave, lane);
    for (int r = gw; r < NINP - NIN; r += NGW) {
        bf16_t* d = (bf16_t*)(ws + WS_WIN) + (size_t)(NIN + r) * DM;
#pragma unroll
        for (int i = 0; i < 4; ++i) *(u32x4*)(d + (i * 64 + lane) * 8) = (u32x4){0u, 0u, 0u, 0u};
    }
    {
        bf16_t* xb = (bf16_t*)(ws + WS_XB); float* rstd1 = (float*)(ws + WS_RSTD1);
        for (int t = gw; t + NGW < S; t += 2 * NGW) {
            const int t1 = t + NGW;
            f32x4 a[8], b[8];
#pragma unroll
            for (int i = 0; i < 8; ++i) { a[i] = *(const f32x4*)(x + (size_t)t * DM + (i * 64 + lane) * 4); b[i] = *(const f32x4*)(x + (size_t)t1 * DM + (i * 64 + lane) * 4); }
            float sa = 0.f, sb = 0.f;
#pragma unroll
            for (int i = 0; i < 8; ++i) {
                sa += (a[i][0] * a[i][0] + a[i][1] * a[i][1]) + (a[i][2] * a[i][2] + a[i][3] * a[i][3]);
                sb += (b[i][0] * b[i][0] + b[i][1] * b[i][1]) + (b[i][2] * b[i][2] + b[i][3] * b[i][3]);
                u32x2 wa, wb; wa.x = pk2(a[i][0], a[i][1]); wa.y = pk2(a[i][2], a[i][3]); wb.x = pk2(b[i][0], b[i][1]); wb.y = pk2(b[i][2], b[i][3]);
                *(u32x2*)(xb + (size_t)t * DM + (i * 64 + lane) * 4) = wa; *(u32x2*)(xb + (size_t)t1 * DM + (i * 64 + lane) * 4) = wb;
            }
            sa = wave_sum(sa); sb = wave_sum(sb);
            if (lane == 0) { rstd1[t] = rsqrtf(sa * (1.0f / DM) + EPS); rstd1[t1] = rsqrtf(sb * (1.0f / DM) + EPS); }
        }
    }
    {
        unsigned char* UT = ws + WS_UT; unsigned char* VT = ws + WS_VT;
        f32x4 sc[8];
#pragma unroll
        for (int i = 0; i < 8; ++i) sc[i] = *(const f32x4*)(p.in[13] + (i * 64 + lane) * 4) * PEER_USC;
        for (int e = gw; e + NGW < 16384; e += 2 * NGW)
            rows2_to_fp6<false>(p.in[16] + (size_t)e * DM, p.in[16] + (size_t)(e + NGW) * DM, sc, UT + (size_t)e * PEER_ROWB, UT + (size_t)(e + NGW) * PEER_ROWB, lane);
#pragma unroll
        for (int i = 0; i < 8; ++i) sc[i] = (f32x4){PEER_VSC, PEER_VSC, PEER_VSC, PEER_VSC};
        for (int e = gw; e + NGW < 16384; e += 2 * NGW)
            rows2_to_fp6<false>(p.in[17] + (size_t)e * DM, p.in[17] + (size_t)(e + NGW) * DM, sc, VT + (size_t)e * PEER_ROWB, VT + (size_t)(e + NGW) * PEER_ROWB, lane);
    }
}

__device__ __forceinline__ void phase3(const Params& p, int gw, int NGW, int lane) {
    unsigned char* ws = p.ws;
    const bf16_t* qraw = (const bf16_t*)(ws + WS_QRAW); const bf16_t* kvraw = (const bf16_t*)(ws + WS_KVRAW); const bf16_t* proj = (const bf16_t*)(ws + WS_PROJ);
    bf16_t* Qh = (bf16_t*)(ws + WS_QH); bf16_t* Kh = (bf16_t*)(ws + WS_KH);
    const float* ct = (const float*)(ws + WS_COS); const float* st = (const float*)(ws + WS_SIN);
    const bool act = lane < 48, isrope = lane >= 32 && lane < 48, lowhalf = lane < 40;
    const int e0 = act ? 4 * lane : 0;
    const f32x4 gq = *(const f32x4*)(p.in[10] + e0), gk = *(const f32x4*)(p.in[11] + e0);
    const int j0 = isrope ? ((4 * lane - 128) & 31) : 0;
    constexpr float QS = 0.07216878364870322f * 1.4426950408889634f;
    for (int t = gw; t < S; t += NGW) {
        f32x4 cs = {1.f, 1.f, 1.f, 1.f}, sn = {0.f, 0.f, 0.f, 0.f};
        if (isrope) { cs = *(const f32x4*)(ct + t * 32 + j0); sn = *(const f32x4*)(st + t * 32 + j0); }
        u32x2 krw = {0u, 0u};
        if (isrope) krw = *(const u32x2*)(proj + (size_t)t * NINP + 2816 + (4 * lane - 128));
        const f32x4 krope = {bflo(krw.x), bfhi(krw.x), bflo(krw.y), bfhi(krw.y)};
#pragma unroll
        for (int h = 0; h < 8; ++h) {
            u32x2 qw = {0u, 0u};
            if (act) qw = *(const u32x2*)(qraw + (size_t)t * 1536 + h * 192 + e0);
            f32x4 q = {bflo(qw.x), bfhi(qw.x), bflo(qw.y), bfhi(qw.y)};
            float ss = wave_sum_u((q[0] * q[0] + q[1] * q[1]) + (q[2] * q[2] + q[3] * q[3]));
            float rs = rsqrtf(ss * (1.0f / 192.0f) + EPS);
            q = q * gq * rs;
            {
                f32x4 pr;
#pragma unroll
                for (int c = 0; c < 4; ++c) pr[c] = __shfl_xor(q[c], 8);
                const f32x4 r1 = q * cs - pr * sn, r2 = pr * sn + q * cs;
                if (isrope) q = lowhalf ? r1 : r2;
            }
            q = q * QS;
            if (act) { u32x2 w; w.x = pk2(q[0], q[1]); w.y = pk2(q[2], q[3]); *(u32x2*)(Qh + ((size_t)h * S + t) * 192 + e0) = w; }
            u32x2 kw = {0u, 0u};
            if (lane < 32) kw = *(const u32x2*)(kvraw + (size_t)t * 2048 + h * 256 + e0);
            f32x4 k = {bflo(kw.x), bfhi(kw.x), bflo(kw.y), bfhi(kw.y)};
            if (isrope) k = krope;
            ss = wave_sum_u((k[0] * k[0] + k[1] * k[1]) + (k[2] * k[2] + k[3] * k[3]));
            rs = rsqrtf(ss * (1.0f / 192.0f) + EPS);
            k = k * gk * rs;
            {
                f32x4 pr;
#pragma unroll
                for (int c = 0; c < 4; ++c) pr[c] = __shfl_xor(k[c], 8);
                const f32x4 r1 = k * cs - pr * sn, r2 = pr * sn + k * cs;
                if (isrope) k = lowhalf ? r1 : r2;
            }
            if (act) { u32x2 w; w.x = pk2(k[0], k[1]); w.y = pk2(k[2], k[3]); *(u32x2*)(Kh + ((size_t)h * S + t) * 192 + e0) = w; }
        }
    }
}

constexpr int KP = 400, VP = 320;
template <int OFF> __device__ __forceinline__ s16x4 tr_read(unsigned addr) {
    s16x4 r; asm volatile("ds_read_b64_tr_b16 %0, %1 offset:%2" : "=&v"(r) : "v"(addr), "i"(OFF) : "memory"); return r;
}
__device__ __forceinline__ unsigned cvtpk(float lo, float hi) { unsigned r; asm volatile("v_cvt_pk_bf16_f32 %0, %1, %2" : "=v"(r) : "v"(lo), "v"(hi)); return r; }
#define PK8(L, H) ((bf16x8){L[0], L[1], L[2], L[3], H[0], H[1], H[2], H[3]})
constexpr float ATT_THR = 8.0f;

constexpr int ATT_KB = 64 * KP, ATT_VB = 64 * VP;
constexpr int ATT_VOFF = 2 * ATT_KB;
__device__ __forceinline__ float xhalf_max(float v) {
    auto rr = __builtin_amdgcn_permlane32_swap(__builtin_bit_cast(unsigned, v), __builtin_bit_cast(unsigned, v), false, false);
    return fmaxf(__builtin_bit_cast(float, rr[0]), __builtin_bit_cast(float, rr[1]));
}
__device__ __forceinline__ float xhalf_sum(float v) {
    auto rr = __builtin_amdgcn_permlane32_swap(__builtin_bit_cast(unsigned, v), __builtin_bit_cast(unsigned, v), false, false);
    return __builtin_bit_cast(float, rr[0]) + __builtin_bit_cast(float, rr[1]);
}
template <int OFF> __device__ __forceinline__ bf16x8 lds_read128(unsigned addr) {
    bf16x8 r; asm volatile("ds_read_b128 %0, %1 offset:%2" : "=&v"(r) : "v"(addr), "i"(OFF) : "memory"); return r;
}
#define LGKM_WAIT(n) do { asm volatile("s_waitcnt lgkmcnt(" #n ")" ::: "memory"); SBAR(); } while (0)
__device__ __forceinline__ f32x16 att_qk(unsigned kaddr, const bf16x8 (&qr)[12]) {
    f32x16 p = {};
    bf16x8 a0 = lds_read128<0>(kaddr), a1 = lds_read128<32>(kaddr), a2 = lds_read128<64>(kaddr), a3 = lds_read128<96>(kaddr);
    LGKM_WAIT(3); p = __builtin_amdgcn_mfma_f32_32x32x16_bf16(a0, qr[0], p, 0, 0, 0); a0 = lds_read128<128>(kaddr);
    LGKM_WAIT(3); p = __builtin_amdgcn_mfma_f32_32x32x16_bf16(a1, qr[1], p, 0, 0, 0); a1 = lds_read128<160>(kaddr);
    LGKM_WAIT(3); p = __builtin_amdgcn_mfma_f32_32x32x16_bf16(a2, qr[2], p, 0, 0, 0); a2 = lds_read128<192>(kaddr);
    LGKM_WAIT(3); p = __builtin_amdgcn_mfma_f32_32x32x16_bf16(a3, qr[3], p, 0, 0, 0); a3 = lds_read128<224>(kaddr);
    LGKM_WAIT(3); p = __builtin_amdgcn_mfma_f32_32x32x16_bf16(a0, qr[4], p, 0, 0, 0); a0 = lds_read128<256>(kaddr);
    LGKM_WAIT(3); p = __builtin_amdgcn_mfma_f32_32x32x16_bf16(a1, qr[5], p, 0, 0, 0); a1 = lds_read128<288>(kaddr);
    LGKM_WAIT(3); p = __builtin_amdgcn_mfma_f32_32x32x16_bf16(a2, qr[6], p, 0, 0, 0); a2 = lds_read128<320>(kaddr);
    LGKM_WAIT(3); p = __builtin_amdgcn_mfma_f32_32x32x16_bf16(a3, qr[7], p, 0, 0, 0); a3 = lds_read128<352>(kaddr);
    LGKM_WAIT(3); p = __builtin_amdgcn_mfma_f32_32x32x16_bf16(a0, qr[8], p, 0, 0, 0);
    LGKM_WAIT(2); p = __builtin_amdgcn_mfma_f32_32x32x16_bf16(a1, qr[9], p, 0, 0, 0);
    LGKM_WAIT(1); p = __builtin_amdgcn_mfma_f32_32x32x16_bf16(a2, qr[10], p, 0, 0, 0);
    LGKM_WAIT(0); p = __builtin_amdgcn_mfma_f32_32x32x16_bf16(a3, qr[11], p, 0, 0, 0);
    return p;
}
__device__ __forceinline__ void att_finish(f32x16& s, float m, float& lsum, bf16x8& pb0, bf16x8& pb1) {
    float ps = 0.f;
#pragma unroll
    for (int r = 0; r < 16; ++r) { s[r] = __builtin_amdgcn_exp2f(s[r] - m); ps += s[r]; }
    lsum += xhalf_sum(ps);
    u32x4 w0 = {cvtpk(s[0], s[1]), cvtpk(s[2], s[3]), cvtpk(s[4], s[5]), cvtpk(s[6], s[7])};
    u32x4 w1 = {cvtpk(s[8], s[9]), cvtpk(s[10], s[11]), cvtpk(s[12], s[13]), cvtpk(s[14], s[15])};
    pb0 = __builtin_bit_cast(bf16x8, w0); pb1 = __builtin_bit_cast(bf16x8, w1);
}
__device__ __forceinline__ void att_pv(unsigned vaddr, bf16x8 pb0, bf16x8 pb1, f32x16 (&o)[4]) {
#define VOFF(d0, s, hi) (((16 * (s) + 8 * (hi)) * VP) + 64 * (d0))
    const s16x4 a00l = tr_read<VOFF(0, 0, 0)>(vaddr), a00h = tr_read<VOFF(0, 0, 1)>(vaddr), a01l = tr_read<VOFF(0, 1, 0)>(vaddr), a01h = tr_read<VOFF(0, 1, 1)>(vaddr);
    const s16x4 a10l = tr_read<VOFF(1, 0, 0)>(vaddr), a10h = tr_read<VOFF(1, 0, 1)>(vaddr), a11l = tr_read<VOFF(1, 1, 0)>(vaddr), a11h = tr_read<VOFF(1, 1, 1)>(vaddr);
    LGKM_WAIT(4);
    o[0] = __builtin_amdgcn_mfma_f32_32x32x16_bf16(PK8(a00l, a00h), pb0, o[0], 0, 0, 0); o[0] = __builtin_amdgcn_mfma_f32_32x32x16_bf16(PK8(a01l, a01h), pb1, o[0], 0, 0, 0);
    const s16x4 a20l = tr_read<VOFF(2, 0, 0)>(vaddr), a20h = tr_read<VOFF(2, 0, 1)>(vaddr), a21l = tr_read<VOFF(2, 1, 0)>(vaddr), a21h = tr_read<VOFF(2, 1, 1)>(vaddr);
    LGKM_WAIT(4);
    o[1] = __builtin_amdgcn_mfma_f32_32x32x16_bf16(PK8(a10l, a10h), pb0, o[1], 0, 0, 0); o[1] = __builtin_amdgcn_mfma_f32_32x32x16_bf16(PK8(a11l, a11h), pb1, o[1], 0, 0, 0);
    const s16x4 a30l = tr_read<VOFF(3, 0, 0)>(vaddr), a30h = tr_read<VOFF(3, 0, 1)>(vaddr), a31l = tr_read<VOFF(3, 1, 0)>(vaddr), a31h = tr_read<VOFF(3, 1, 1)>(vaddr);
    LGKM_WAIT(4);
    o[2] = __builtin_amdgcn_mfma_f32_32x32x16_bf16(PK8(a20l, a20h), pb0, o[2], 0, 0, 0); o[2] = __builtin_amdgcn_mfma_f32_32x32x16_bf16(PK8(a21l, a21h), pb1, o[2], 0, 0, 0);
    LGKM_WAIT(0);
    o[3] = __builtin_amdgcn_mfma_f32_32x32x16_bf16(PK8(a30l, a30h), pb0, o[3], 0, 0, 0); o[3] = __builtin_amdgcn_mfma_f32_32x32x16_bf16(PK8(a31l, a31h), pb1, o[3], 0, 0, 0);
#undef VOFF
}
__device__ __forceinline__ void att_partial(const f32x16& s, float& m, float& lsum, f32x16 (&o)[4]) {
    float pmax = s[0];
#pragma unroll
    for (int r = 1; r < 16; ++r) pmax = fmaxf(pmax, s[r]);
    pmax = xhalf_max(pmax);
    if (!__all(pmax - m <= ATT_THR)) {
        const float mn = fmaxf(m, pmax); const float alpha = __builtin_amdgcn_exp2f(m - mn); m = mn; lsum *= alpha;
#pragma unroll
        for (int d = 0; d < 4; ++d)
#pragma unroll
            for (int r = 0; r < 16; ++r) o[d][r] *= alpha;
    }
}

__device__ __forceinline__ void attn_unit(const Params& p, LAS unsigned char* lds, int head, int qb, int tid, int wave, int lane) {
    unsigned char* ws = p.ws;
    const bf16_t* Qh = (const bf16_t*)(ws + WS_QH); const bf16_t* Kh = (const bf16_t*)(ws + WS_KH);
    bf16_t* mix = (bf16_t*)(ws + WS_MIX);
    const int rg = wave & 3, kh = wave >> 2, r32 = lane & 31, hh = lane >> 5;
    const int q0row = qb * 128 + rg * 32;
    bf16x8 qr[12];
    {
        const bf16_t* qp = Qh + ((size_t)head * S + q0row + r32) * 192 + hh * 8;
#pragma unroll
        for (int ks = 0; ks < 12; ++ks) qr[ks] = *(const bf16x8*)(qp + ks * 16);
    }
    const int ntiles = 2 * qb + 2, mylast = 2 * qb + (rg >> 1);
    float m = -1e30f, lsum = 0.f; f32x16 o[4] = {};
    const int srow = tid >> 3, sch = tid & 7;
    const int kg0 = srow * 192 + sch * 8, kl0 = srow * KP + sch * 16, vg0 = srow * 2048 + sch * 8, vl0 = ATT_VOFF + srow * VP + sch * 16;
    const bf16_t* kbase = Kh + (size_t)head * S * 192; const bf16_t* vbase = (const bf16_t*)(ws + WS_KVRAW) + head * 256 + 128;
    u32x4 sk0, sk1, sk2, sv0, sv1;
#define ATT_LOAD(t) do { const bf16_t* kt = kbase + (size_t)(t) * 64 * 192 + kg0; const bf16_t* vt = vbase + (size_t)(t) * 64 * 2048 + vg0; \
        sk0 = *(const u32x4*)(kt); sk1 = *(const u32x4*)(kt + 64); sk2 = *(const u32x4*)(kt + 128); sv0 = *(const u32x4*)(vt); sv1 = *(const u32x4*)(vt + 64); } while (0)
#define ATT_WRITE(kb_, vb_) do { LAS unsigned char* bk = lds + (kb_) * ATT_KB + kl0; LAS unsigned char* bv = lds + (vb_) * ATT_VB + vl0; *(LAS u32x4*)(bk) = sk0; *(LAS u32x4*)(bk + 128) = sk1; *(LAS u32x4*)(bk + 256) = sk2; \
        *(LAS u32x4*)(bv) = sv0; *(LAS u32x4*)(bv + 128) = sv1; } while (0)
    const unsigned ldsbase = (unsigned)(size_t)lds;
    const unsigned kaddr0 = ldsbase + (unsigned)((32 * kh + r32) * KP + hh * 16);
    const unsigned vrel = (unsigned)(ATT_VOFF + (32 * kh + 4 * hh + ((lane & 15) >> 2)) * VP + (16 * ((lane >> 4) & 1) + 4 * (lane & 3)) * 2);
    ATT_LOAD(0); ATT_WRITE(0, 0); __syncthreads();
    bf16x8 pb0, pb1;
    const bool more0 = (1 < ntiles);
    if (more0) ATT_LOAD(1);
    f32x16 sprev = att_qk(kaddr0, qr);
    att_partial(sprev, m, lsum, o);
    if (more0) ATT_WRITE(1, 1);
    __syncthreads();
    int vprev = 0, vcur = 1;
#pragma unroll 1
    for (int t = 1; t <= ntiles; ++t) {
        const bool more = (t + 1 < ntiles);
        if (more) ATT_LOAD(t + 1);
        f32x16 sc;
        if (t <= mylast) sc = att_qk(kaddr0 + (t & 1) * ATT_KB, qr);
        else {
#pragma unroll
            for (int r = 0; r < 16; ++r) sc[r] = -1e30f;
        }
        att_finish(sprev, m, lsum, pb0, pb1);
        att_pv(ldsbase + vprev * ATT_VB + vrel, pb0, pb1, o);
        att_partial(sc, m, lsum, o);
        sprev = sc;
        const int vnext = (vcur == 2) ? 0 : vcur + 1;
        if (more) ATT_WRITE((t + 1) & 1, vnext);
        vprev = vcur; vcur = vnext;
        __syncthreads();
    }
#undef ATT_LOAD
#undef ATT_WRITE
    LAS float* scr = (LAS float*)lds + (size_t)rg * 66 * 64 + lane;
    if (kh == 1) {
        scr[0] = m; scr[64] = lsum;
#pragma unroll
        for (int d = 0; d < 4; ++d)
#pragma unroll
            for (int r = 0; r < 16; ++r) scr[(2 + d * 16 + r) * 64] = o[d][r];
    }
    __syncthreads();
    if (kh == 0) {
        const float m2 = scr[0], l2 = scr[64];
        const float mn = fmaxf(m, m2), a1 = __builtin_amdgcn_exp2f(m - mn), a2 = __builtin_amdgcn_exp2f(m2 - mn);
        const float inv = 1.0f / (lsum * a1 + l2 * a2);
        bf16_t* op = mix + (size_t)(q0row + r32) * DM + 1024 + head * 128 + 4 * hh;
#pragma unroll
        for (int d = 0; d < 4; ++d)
#pragma unroll
            for (int g4 = 0; g4 < 4; ++g4) {
                float v[4];
#pragma unroll
                for (int i = 0; i < 4; ++i) { const int r = 4 * g4 + i; v[i] = (o[d][r] * a1 + scr[(2 + d * 16 + r) * 64] * a2) * inv; }
                u32x2 w; w.x = pk2(v[0], v[1]); w.y = pk2(v[2], v[3]);
                *(u32x2*)(op + 32 * d + 8 * g4) = w;
            }
    }
    __syncthreads();
}

__device__ __forceinline__ void gmlp_unit(const Params& p, LAS unsigned char* lds, int nb, int h, int tid, int wave, int lane) {
    unsigned char* ws = p.ws;
    const bf16_t* proj = (const bf16_t*)(ws + WS_PROJ); bf16_t* mix = (bf16_t*)(ws + WS_MIX);
    const float* ssv = (const float*)(ws + WS_ROWSS);
    const float* vg = p.in[3]; const float* wsp = p.in[4]; const float* bs = p.in[5];
#pragma unroll
    for (int i = 0; i < 4; ++i) {
        const int pc = tid + 512 * i, r = pc >> 4, c = pc & 15, t = nb * 128 + r;
        const u32x4 w = *(const u32x4*)(proj + (size_t)t * NINP + 1024 + h * 128 + c * 8);
        const float rs = rsqrtf(ssv[t] * (1.0f / 1024.0f) + EPS);
        const f32x4 g0 = *(const f32x4*)(vg + h * 128 + c * 8), g1 = *(const f32x4*)(vg + h * 128 + c * 8 + 4);
        u32x4 ov;
        ov.x = pk2(bflo(w.x) * rs * g0[0], bfhi(w.x) * rs * g0[1]); ov.y = pk2(bflo(w.y) * rs * g0[2], bfhi(w.y) * rs * g0[3]);
        ov.z = pk2(bflo(w.z) * rs * g1[0], bfhi(w.z) * rs * g1[1]); ov.w = pk2(bflo(w.w) * rs * g1[2], bfhi(w.w) * rs * g1[3]);
        *(LAS u32x4*)(lds + r * VP + c * 16) = ov;
    }
    __syncthreads();
    const int ib = wave & 3, ch = wave >> 2, r32 = lane & 31, hh = lane >> 5;
    const int irow = 32 * ib + r32;
    f32x16 acc0 = {}, acc1 = {};
    const unsigned vaddr = (unsigned)(size_t)lds + (unsigned)((8 * hh + ((lane & 15) >> 2)) * VP + (64 * ch + 16 * ((lane >> 4) & 1) + 4 * (lane & 3)) * 2);
    const float* wrow = wsp + ((size_t)h * 128 + irow) * 128 + hh * 8;
#define GSTEP(s) do { if ((s) < 2 * (ib + 1)) { \
        const f32x4 wa = *(const f32x4*)(wrow + (s) * 16), wb = *(const f32x4*)(wrow + (s) * 16 + 4); const int j0 = (s) * 16 + hh * 8; \
        u32x4 aw; aw.x = pk2(j0 + 0 <= irow ? wa[0] : 0.f, j0 + 1 <= irow ? wa[1] : 0.f); aw.y = pk2(j0 + 2 <= irow ? wa[2] : 0.f, j0 + 3 <= irow ? wa[3] : 0.f); \
        aw.z = pk2(j0 + 4 <= irow ? wb[0] : 0.f, j0 + 5 <= irow ? wb[1] : 0.f); aw.w = pk2(j0 + 6 <= irow ? wb[2] : 0.f, j0 + 7 <= irow ? wb[3] : 0.f); \
        const bf16x8 af = __builtin_bit_cast(bf16x8, aw); \
        const s16x4 b0l = tr_read<(16 * (s)) * VP>(vaddr), b0h = tr_read<(16 * (s) + 4) * VP>(vaddr), b1l = tr_read<(16 * (s)) * VP + 64>(vaddr), b1h = tr_read<(16 * (s) + 4) * VP + 64>(vaddr); \
        LDS_WAIT(); SBAR(); \
        acc0 = __builtin_amdgcn_mfma_f32_32x32x16_bf16(af, PK8(b0l, b0h), acc0, 0, 0, 0); acc1 = __builtin_amdgcn_mfma_f32_32x32x16_bf16(af, PK8(b1l, b1h), acc1, 0, 0, 0); } } while (0)
    GSTEP(0); GSTEP(1); GSTEP(2); GSTEP(3); GSTEP(4); GSTEP(5); GSTEP(6); GSTEP(7);
#undef GSTEP
#pragma unroll
    for (int r = 0; r < 16; ++r) {
        const int i = 32 * ib + crow(r, hh), t = nb * 128 + i; const float b = bs[h * 128 + i];
        const int c0 = h * 128 + 64 * ch + r32;
        const float u0 = bf2f(proj[(size_t)t * NINP + c0]), u1 = bf2f(proj[(size_t)t * NINP + c0 + 32]);
        mix[(size_t)t * DM + c0] = (bf16_t)f2bf(u0 * (acc0[r] + b)); mix[(size_t)t * DM + c0 + 32] = (bf16_t)f2bf(u1 * (acc1[r] + b));
    }
    __syncthreads();
}

__device__ __forceinline__ void phase7(const Params& p, LAS unsigned char* lds, int gw, int NGW, int wave, int lane) {
    unsigned char* ws = p.ws;
    const float* sc = (const float*)(ws + WS_SC); int* ex = (int*)(ws + WS_EXP); float* gt = (float*)(ws + WS_GATE);
    const float NEG = -3.0e38f;
    LAS float* sl = (LAS float*)(lds + wave * 1024);
    const int j8 = lane & 7, g8 = lane >> 3, row = lane >> 4, i16 = lane & 15;
    int ci[4], cj[4]; bool cval[4];
    {
        constexpr int starts[16] = {0, 16, 24, 29, 33, 36, 38, 40, 42, 43, 44, 45, 46, 47, 48, 49};
#pragma unroll
        for (int m = 0; m < 4; ++m) {
            const int c = i16 + 16 * m; int a = 0, st = 0;
#pragma unroll
            for (int i = 1; i < 16; ++i) if (c >= starts[i]) { a = i; st = starts[i]; }
            cval[m] = c < 50; ci[m] = cval[m] ? a : 0; cj[m] = cval[m] ? (c - st) : 0;
        }
    }
    constexpr int NT = S * 2;
    f32x4 nx0, nx1, nx2, nx3;
    if (gw < NT) { const float* b = sc + (size_t)(gw >> 1) * DM + (gw & 1) * 1024 + lane * 16; nx0 = *(const f32x4*)b; nx1 = *(const f32x4*)(b + 4); nx2 = *(const f32x4*)(b + 8); nx3 = *(const f32x4*)(b + 12); }
    for (int it = gw; it < NT; it += NGW) {
        const int t = it >> 1, hh = it & 1;
        float v[16];
#pragma unroll
        for (int q = 0; q < 4; ++q) { v[q] = nx0[q]; v[4 + q] = nx1[q]; v[8 + q] = nx2[q]; v[12 + q] = nx3[q]; }
        if (it + NGW < NT) { const int it2 = it + NGW; const float* b = sc + (size_t)(it2 >> 1) * DM + (it2 & 1) * 1024 + lane * 16;
            nx0 = *(const f32x4*)b; nx1 = *(const f32x4*)(b + 4); nx2 = *(const f32x4*)(b + 8); nx3 = *(const f32x4*)(b + 12); }
#pragma unroll
        for (int m = 0; m < 16; ++m) v[m] = __builtin_bit_cast(float, (__builtin_bit_cast(unsigned, v[m]) & ~127u) | (unsigned)(16 * j8 + m));
        float ra = 0.f, rb = 0.f;
#pragma unroll
        for (int k = 0; k < 16; ++k) {
            float mx = fmaxf(fmaxf(fmaxf(v[0], v[1]), fmaxf(v[2], v[3])), fmaxf(fmaxf(v[4], v[5]), fmaxf(v[6], v[7])));
            mx = fmaxf(mx, fmaxf(fmaxf(fmaxf(v[8], v[9]), fmaxf(v[10], v[11])), fmaxf(fmaxf(v[12], v[13]), fmaxf(v[14], v[15]))));
            mx = fmaxf(mx, dpp_f<0xB1, 0xf>(mx, mx));
            mx = fmaxf(mx, dpp_f<0x4E, 0xf>(mx, mx));
            mx = fmaxf(mx, dpp_f<0x141, 0xf>(mx, mx));
#pragma unroll
            for (int m = 0; m < 16; ++m) v[m] = (v[m] == mx) ? NEG : v[m];
            if (k < 8) ra = (j8 == k) ? mx : ra; else rb = (j8 == k - 8) ? mx : rb;
        }
        sl[g8 * 16 + j8] = ra; sl[g8 * 16 + 8 + j8] = rb;
        LDS_WAIT(); asm volatile("" ::: "memory");
        float cv[4], og[4]; int id[4];
#pragma unroll
        for (int m = 0; m < 4; ++m) {
            const float s1 = sl[(2 * row) * 16 + ci[m]], s2 = sl[(2 * row + 1) * 16 + cj[m]];
            og[m] = cval[m] ? (s1 + s2) : NEG; cv[m] = og[m];
            id[m] = (int)((__builtin_bit_cast(unsigned, s1) & 127u) * 128u + (__builtin_bit_cast(unsigned, s2) & 127u));
        }
        LDS_WAIT(); asm volatile("" ::: "memory");
        float M0 = 0.f;
#pragma unroll
        for (int k = 0; k < 16; ++k) {
            float mx = fmaxf(fmaxf(cv[0], cv[1]), fmaxf(cv[2], cv[3]));
            mx = fmaxf(mx, dpp_f<0xB1, 0xf>(mx, mx));
            mx = fmaxf(mx, dpp_f<0x4E, 0xf>(mx, mx));
            mx = fmaxf(mx, dpp_f<0x141, 0xf>(mx, mx));
            mx = fmaxf(mx, dpp_f<0x140, 0xf>(mx, mx));
            if (k == 0) M0 = mx;
#pragma unroll
            for (int m = 0; m < 4; ++m) cv[m] = (cv[m] == mx) ? NEG : cv[m];
        }
        bool sel[4]; float e[4]; float es = 0.f;
#pragma unroll
        for (int m = 0; m < 4; ++m) { sel[m] = (cv[m] != og[m]); e[m] = sel[m] ? __expf(og[m] - M0) : 0.f; es += e[m]; }
        es += dpp_f<0xB1, 0xf>(0.f, es); es += dpp_f<0x4E, 0xf>(0.f, es); es += dpp_f<0x141, 0xf>(0.f, es); es += dpp_f<0x140, 0xf>(0.f, es);
        const float inv = 1.0f / es;
        int basepos = 0;
        const int head = 4 * hh + row;
#pragma unroll
        for (int m = 0; m < 4; ++m) {
            const unsigned long long bl = __ballot(sel[m]);
            const unsigned rbits = (unsigned)(bl >> (16 * row)) & 0xffffu;
            const int pos = basepos + __popc(rbits & ((1u << i16) - 1u));
            if (sel[m] && pos < 16) { ex[(size_t)t * 128 + head * 16 + pos] = id[m]; gt[(size_t)t * 128 + head * 16 + pos] = e[m] * inv; }
            basepos += __popc(rbits);
        }
    }
}

typedef __bf16 bf16x32v __attribute__((ext_vector_type(32)));
typedef __bf16 bf16x2v __attribute__((ext_vector_type(2)));
typedef float f32x2 __attribute__((ext_vector_type(2)));
#ifndef P8_THROTTLE
#define P8_THROTTLE 0
#endif
constexpr unsigned P8_SLACK = 12;
__device__ __forceinline__ void phase8(const Params& p, LAS unsigned char* lds, float* dst, unsigned xcc, unsigned nwx, int gw, int NGW, int wave, int lane) {
    unsigned char* ws = p.ws;
    const bf16_t* x1b = (const bf16_t*)(ws + WS_X1B); const unsigned char* UT = ws + WS_UT; const unsigned char* VT = ws + WS_VT;
    const int* ex = (const int*)(ws + WS_EXP); const float* gt = (const float*)(ws + WS_GATE); const float* ss2 = (const float*)(ws + WS_ROWSS) + 3 * S;
    const float* out = p.out;
    LAS unsigned* list = (LAS unsigned*)(lds + 131072 + wave * 2048);
    LAS unsigned* hist = (LAS unsigned*)(lds + 147456 + wave * 1024);
    for (int tb = gw; tb < S / 4; tb += NGW) {
        const int t0 = tb * 4;
        int id[8]; float gv[8];
#pragma unroll
        for (int r = 0; r < 8; ++r) { const size_t o = (size_t)(t0 + (r >> 1)) * 128 + (r & 1) * 64 + lane; id[r] = ex[o]; gv[r] = gt[o]; }
        const float rs0 = rsqrtf(ss2[t0 + 0] * (1.0f / DM) + EPS) * (1.0f / PEER_USC), rs1 = rsqrtf(ss2[t0 + 1] * (1.0f / DM) + EPS) * (1.0f / PEER_USC);
        const float rs2 = rsqrtf(ss2[t0 + 2] * (1.0f / DM) + EPS) * (1.0f / PEER_USC), rs3 = rsqrtf(ss2[t0 + 3] * (1.0f / DM) + EPS) * (1.0f / PEER_USC);
#pragma unroll
        for (int j = 0; j < 4; ++j) hist[j * 64 + lane] = 0u;
        LDS_WAIT(); asm volatile("" ::: "memory");
        unsigned pos[8];
#pragma unroll
        for (int r = 0; r < 8; ++r) pos[r] = __hip_atomic_fetch_add(hist + (r >> 1) * 64 + (id[r] >> 8), 1u, __ATOMIC_RELAXED, __HIP_MEMORY_SCOPE_WORKGROUP);
        LDS_WAIT(); asm volatile("" ::: "memory");
        unsigned cnt[4], inc[4];
#pragma unroll
        for (int j = 0; j < 4; ++j) { cnt[j] = hist[j * 64 + lane]; inc[j] = cnt[j]; }
#pragma unroll
        for (int o = 1; o < 64; o <<= 1)
#pragma unroll
            for (int j = 0; j < 4; ++j) { const unsigned n = __shfl_up(inc[j], o); if (lane >= o) inc[j] += n; }
        LDS_WAIT(); asm volatile("" ::: "memory");
#pragma unroll
        for (int j = 0; j < 4; ++j) hist[j * 64 + lane] = inc[j] - cnt[j];
        LDS_WAIT(); asm volatile("" ::: "memory");
#pragma unroll
        for (int r = 0; r < 8; ++r) { const unsigned d = hist[(r >> 1) * 64 + (id[r] >> 8)] + pos[r]; list[4u * d + (unsigned)(r >> 1)] = (unsigned)id[r] | ((unsigned)(r >> 1) << 14) | (f2bf(gv[r]) << 16); }
        LDS_WAIT(); asm volatile("" ::: "memory");
        {
            typedef unsigned u32x16 __attribute__((ext_vector_type(16)));
            const __amdgpu_buffer_rsrc_t urs = __builtin_amdgcn_make_buffer_rsrc((void*)UT, 0, 16384 * PEER_ROWB, 0x00020000);
            const int vo4 = lane * 16, vo2 = lane * 8 + 1024;
            const bool lb0 = (lane & 1) != 0, lb1 = (lane & 2) != 0, lb2 = (lane & 4) != 0;
            s16x4 xr[4][8];
#pragma unroll
            for (int j = 0; j < 4; ++j)
#pragma unroll
                for (int q = 0; q < 8; ++q) xr[j][q] = __builtin_bit_cast(s16x4, *(const u32x2*)(x1b + (size_t)(t0 + j) * DM + (q * 64 + lane) * 4));
#define P8_ULOAD(k, i) do { const unsigned en = (unsigned)__builtin_amdgcn_readfirstlane((int)list[(i)]); const int ro = (int)((en & 0x3fffu) * (unsigned)PEER_ROWB); \
            u4[k] = __builtin_amdgcn_raw_buffer_load_b128(urs, vo4, ro, 0); u2[k] = __builtin_amdgcn_raw_buffer_load_b64(urs, vo2, ro, 0); } while (0)
#define P8_UPROC2(k, dk) do { const u32x6 pk = {u4[k][0], u4[k][1], u4[k][2], u4[k][3], u2[k][0], u2[k][1]}; \
            const u32x16 r_ = __builtin_bit_cast(u32x16, __builtin_amdgcn_cvt_scalef32_pk32_bf16_fp6(pk, 1.0f)); \
            f32x4 a0 = {0.f, 0.f, 0.f, 0.f}, a1 = {0.f, 0.f, 0.f, 0.f}; \
            _Pragma("unroll") for (int q = 0; q < 8; q += 2) { \
                a0 = __builtin_amdgcn_mfma_f32_4x4x4bf16_1k(__builtin_bit_cast(s16x4, (u32x2){r_[2 * q], r_[2 * q + 1]}), xr[(k) & 3][q], a0, 0, 0, 0); \
                a1 = __builtin_amdgcn_mfma_f32_4x4x4bf16_1k(__builtin_bit_cast(s16x4, (u32x2){r_[2 * q + 2], r_[2 * q + 3]}), xr[(k) & 3][q + 1], a1, 0, 0, 0); } \
            const f32x4 a_ = a0 + a1; \
            const float e0 = lb0 ? a_[1] : a_[0], e1 = lb0 ? a_[3] : a_[2]; dd[dk] = lb1 ? e1 : e0; } while (0)
#ifndef P8_URING
#define P8_URING 8
#endif
#if (PROBE_DUP >> 10) & 1
#define P8_UREPS 2
#else
#define P8_UREPS 1
#endif
#pragma unroll 1
            for (int urep = 0; urep < P8_UREPS; ++urep) {
                u32x4 u4[P8_URING]; u32x2 u2[P8_URING];
#pragma unroll
                for (int k = 0; k < P8_URING; ++k) P8_ULOAD(k, k);
#pragma unroll 1
                for (int i0 = 0; i0 < 512; i0 += P8_URING) {
#pragma unroll
                    for (int hb = 0; hb < P8_URING / 8; ++hb) {
                        const int i = i0 + 8 * hb;
                        const unsigned ev = list[i + (lane & 7)]; const unsigned jl = (unsigned)lane & 3u;
                        const float gl = __builtin_bit_cast(float, ev & 0xffff0000u), rl = jl == 0u ? rs0 : (jl == 1u ? rs1 : (jl == 2u ? rs2 : rs3));
                        float dd[8];
#pragma unroll
                        for (int k = 0; k < 8; ++k) { P8_UPROC2(8 * hb + k, k); const int nx = i + P8_URING + k; P8_ULOAD(8 * hb + k, nx < 512 ? nx : 508 + (k & 3)); }
                        float w4[4], w2[2];
#pragma unroll
                        for (int q = 0; q < 4; ++q) { const float kp = lb2 ? dd[q + 4] : dd[q], sd = lb2 ? dd[q] : dd[q + 4]; w4[q] = kp + __shfl_xor(sd, 4); }
#pragma unroll
                        for (int q = 0; q < 2; ++q) { const float kp = lb1 ? w4[q + 2] : w4[q], sd = lb1 ? w4[q] : w4[q + 2]; w2[q] = kp + __shfl_xor(sd, 2); }
                        float dres; { const float kp = lb0 ? w2[1] : w2[0], sd = lb0 ? w2[0] : w2[1]; dres = kp + __shfl_xor(sd, 1); }
                        dres += __shfl_xor(dres, 8); dres += __shfl_xor(dres, 16); dres += __shfl_xor(dres, 32);
                        const float c_ = gl * gelu_tanh(rl * dres) * (1.0f / PEER_VSC);
                        if (lane < 8 && urep == P8_UREPS - 1) list[i + lane] = (ev & 0xffffu) | (f2bf(c_) << 16);
                    }
                }
            }
#undef P8_ULOAD
#undef P8_UPROC2
        }
        asm volatile("s_waitcnt vmcnt(0)" ::: "memory");
        LDS_WAIT(); asm volatile("" ::: "memory");
        f32x4 acc[4][8];
#if (PROBE_DUP >> 12) & 1
#define P8_VREPS 2
#else
#define P8_VREPS 1
#endif
#ifndef P8_VRING
#define P8_VRING 8
#endif
#pragma unroll 1
        for (int vrep = 0; vrep < P8_VREPS; ++vrep) {
#pragma unroll
        for (int j = 0; j < 4; ++j)
#pragma unroll
            for (int q = 0; q < 8; ++q) acc[j][q] = (f32x4){0.f, 0.f, 0.f, 0.f};
        {
            typedef unsigned u32x16 __attribute__((ext_vector_type(16)));
            u32x4 v4[P8_VRING]; u32x2 v2[P8_VRING]; unsigned ven[P8_VRING];
            const unsigned li = (unsigned)lane & 3u;
            const unsigned m0 = li == 0u ? 0x0000ffffu : (li == 1u ? 0xffff0000u : 0u), m1 = li == 2u ? 0x0000ffffu : (li == 3u ? 0xffff0000u : 0u);
            const __amdgpu_buffer_rsrc_t vrs = __builtin_amdgcn_make_buffer_rsrc((void*)VT, 0, 16384 * PEER_ROWB, 0x00020000);
            const int vo4 = lane * 16, vo2 = lane * 8 + 1024;
#define P8_VLOAD(k, i) do { const unsigned en = (unsigned)__builtin_amdgcn_readfirstlane((int)list[(i)]); ven[k] = en; const int ro = (int)((en & 0x3fffu) * (unsigned)PEER_ROWB); \
            v4[k] = __builtin_amdgcn_raw_buffer_load_b128(vrs, vo4, ro, 0); v2[k] = __builtin_amdgcn_raw_buffer_load_b64(vrs, vo2, ro, 0); } while (0)
#define P8_VPROC(k) do { const u32x6 pk = {v4[k][0], v4[k][1], v4[k][2], v4[k][3], v2[k][0], v2[k][1]}; \
            const u32x16 r_ = __builtin_bit_cast(u32x16, __builtin_amdgcn_cvt_scalef32_pk32_bf16_fp6(pk, 1.0f)); \
            const unsigned e_ = ven[k], cf = (e_ >> 16) | (e_ & 0xffff0000u); \
            const s16x4 av = __builtin_bit_cast(s16x4, (u32x2){cf & m0, cf & m1}); \
            _Pragma("unroll") for (int q = 0; q < 8; ++q) \
                acc[(k) & 3][q] = __builtin_amdgcn_mfma_f32_4x4x4bf16_1k(av, __builtin_bit_cast(s16x4, (u32x2){r_[2 * q], r_[2 * q + 1]}), acc[(k) & 3][q], 0, 0, 0); } while (0)
#pragma unroll
            for (int k = 0; k < P8_VRING; ++k) P8_VLOAD(k, k);
#pragma unroll 1
            for (int i = 0; i < 512 - 512 % P8_VRING; i += P8_VRING) {
#pragma unroll
                for (int k = 0; k < P8_VRING; ++k) { P8_VPROC(k); const int nx = i + P8_VRING + k; P8_VLOAD(k, nx < 512 ? nx : 508 + (k & 3)); }
            }
#pragma unroll
            for (int k = 0; k < 512 % P8_VRING; ++k) P8_VPROC(k);
#undef P8_VLOAD
#undef P8_VPROC
        }
        }
        int tq = t0, lq = lane; asm volatile("" : "+s"(tq)); asm volatile("" : "+v"(lq));
#pragma unroll
        for (int j = 0; j < 4; ++j)
#pragma unroll
            for (int i = 0; i < 8; ++i) {
                const size_t o = (size_t)(tq + j) * DM + (i * 64 + lq) * 4;
                f32x4 a = *(const f32x4*)(out + o);
                a += acc[j][i];
                *(f32x4*)(dst + o) = a;
                if (i & 1) asm volatile("" ::: "memory");
            }
        LDS_WAIT(); asm volatile("" ::: "memory");
    }
}

__global__ void __launch_bounds__(NTHREADS, 2) mega(Params p) {
    extern __shared__ __attribute__((aligned(16))) unsigned char lds_raw[];
    LAS unsigned char* lds = (LAS unsigned char*)lds_raw;
    const int tid = threadIdx.x, lane = tid & 63, wave = __builtin_amdgcn_readfirstlane(tid >> 6);
    const int G = gridDim.x, bx = blockIdx.x;
    const int gw = bx * 8 + wave, NGW = G * 8;
    unsigned char* ws = p.ws;
    const int lo = p.ph_lo, hi = p.ph_hi;
    volatile LAS unsigned* misc = (volatile LAS unsigned*)(lds + LDS_MISC);
    if (tid < 4) misc[tid] = 0u;
    __syncthreads();
    const XcdBarrier xbar = xcd_barrier_post((unsigned*)(ws + WS_CTL), misc);
#ifndef PH_MASK
#define PH_MASK 0x1ff
#endif
#define IN(k) (((PH_MASK >> (k)) & 1) && lo <= (k) && (k) < hi)
#define SEAM(k) do { if (IN(k) && IN((k) + 1)) xcd_barrier(xbar); } while (0)

#if (PROBE_DUP >> 0) & 1
    if (IN(0)) { phase0(p, lds, G == 256, gw, NGW, wave, lane); xcd_barrier(xbar); }
#endif
    if (IN(0)) phase0(p, lds, G == 256, gw, NGW, wave, lane);
    SEAM(0);
    if (IN(1)) {
        pg8::Gemm g{(const bf16_t*)(ws + WS_XB), (const bf16_t*)(ws + WS_WIN), S, NINP, DM, DM, DM};
        pg8::StaticOrder So; So.init(S, NINP, G, bx);
        pg8::Epi<1> E{(const float*)(ws + WS_RSTD1), 0.f, (float*)(ws + WS_ROWSS), (bf16_t*)(ws + WS_PROJ), NINP, nullptr, nullptr};
#if (PROBE_DUP >> 1) & 1
        { pg8::Epi<1> E2 = E; E2.ss = (float*)(ws + 512 * 1024); pg8::gemm_phase<pg8::Epi<1>, pg8::StaticOrder, true, true>(lds, g, So, E2); xcd_barrier(xbar); }
#endif
        pg8::gemm_phase<pg8::Epi<1>, pg8::StaticOrder, true, true>(lds, g, So, E);
        if (G == 256 && bx >= 128) { __syncthreads(); prep_late(p, lds, (bx - 128) * 8 + wave, 1024, wave, lane); }
    }
    SEAM(1);
    if (IN(2)) {
        {
            pg8::Gemm g{(const bf16_t*)(ws + WS_PROJ) + 2048, (const bf16_t*)(ws + WS_WUQ), S, 1536, 512, NINP, 512};
            pg8::StaticOrder So; So.init(S, 1536, G, bx);
            pg8::Epi<2> E{(const float*)(ws + WS_ROWSS) + 1 * S, 1.0f / 512.0f, nullptr, (bf16_t*)(ws + WS_QRAW), 1536, nullptr, nullptr};
            pg8::gemm_phase<pg8::Epi<2>, pg8::StaticOrder, true, true>(lds, g, So, E);
        }
        __syncthreads();
        {
            pg8::Gemm g{(const bf16_t*)(ws + WS_PROJ) + 2560, (const bf16_t*)(ws + WS_WUKV), S, 2048, 256, NINP, 256};
            pg8::StaticOrder So; So.init(S, 2048, G, bx);
            pg8::Epi<2> E{(const float*)(ws + WS_ROWSS) + 2 * S, 1.0f / 256.0f, nullptr, (bf16_t*)(ws + WS_KVRAW), 2048, nullptr, nullptr};
            pg8::gemm_phase<pg8::Epi<2>, pg8::StaticOrder, true, true>(lds, g, So, E);
        }
    }
    SEAM(2);
#if (PROBE_DUP >> 3) & 1
    if (IN(3)) { phase3(p, gw, NGW, lane); xcd_barrier(xbar); }
#endif
    if (IN(3)) phase3(p, gw, NGW, lane);
    SEAM(3);
#define P4_BODY_ATT for (int pr = bx; pr < 256; pr += G) { const int head = pr & 7, x = pr >> 3; attn_unit(p, lds, head, 63 - x, tid, wave, lane); attn_unit(p, lds, head, x, tid, wave, lane); }
#define P4_BODY_GMLP for (int u = bx; u < 512; u += G) gmlp_unit(p, lds, u >> 3, u & 7, tid, wave, lane);
#if (PROBE_DUP >> 4) & 1
    if (IN(4)) { P4_BODY_ATT; xcd_barrier(xbar); }
#endif
#if (PROBE_DUP >> 9) & 1
    if (IN(4)) { P4_BODY_GMLP; xcd_barrier(xbar); }
#endif
    if (IN(4)) { P4_BODY_ATT; P4_BODY_GMLP; }
    SEAM(4);
    if (IN(5)) {
        pg8::Gemm g{(const bf16_t*)(ws + WS_MIX), (const bf16_t*)(ws + WS_WOUT), S, DM, DM, DM, DM};
        pg8::StaticOrder So; So.init(S, DM, G, bx);
        pg8::Epi<4> E{nullptr, 0.f, (float*)(ws + WS_ROWSS) + 3 * S, (bf16_t*)(ws + WS_X1B), DM, p.out, p.in[0]};
#if (PROBE_DUP >> 5) & 1
        { pg8::Epi<4> E2 = E; E2.ss = (float*)(ws + 512 * 1024); pg8::gemm_phase<pg8::Epi<4>, pg8::StaticOrder, true, true>(lds, g, So, E2); xcd_barrier(xbar); }
#endif
        pg8::gemm_phase<pg8::Epi<4>, pg8::StaticOrder, true, true>(lds, g, So, E);
    }
    SEAM(5);
    if (IN(6)) {
        pg8::Gemm g{(const bf16_t*)(ws + WS_X1B), (const bf16_t*)(ws + WS_WS), S, DM, DM, DM, DM};
        pg8::StaticOrder So; So.init(S, DM, G, bx);
        pg8::Epi<5> E{(const float*)(ws + WS_ROWSS) + 3 * S, 1.0f / DM, nullptr, nullptr, DM, (float*)(ws + WS_SC), nullptr};
#if (PROBE_DUP >> 6) & 1
        { pg8::gemm_phase<pg8::Epi<5>, pg8::StaticOrder, true, true>(lds, g, So, E); xcd_barrier(xbar); }
#endif
        pg8::gemm_phase<pg8::Epi<5>, pg8::StaticOrder, true, true>(lds, g, So, E);
    }
    SEAM(6);
#if (PROBE_DUP >> 7) & 1
    if (IN(7)) { phase7(p, lds, gw, NGW, wave, lane); xcd_barrier(xbar); }
#endif
    if (IN(7)) phase7(p, lds, gw, NGW, wave, lane);
    SEAM(7);
#if (PROBE_DUP >> 8) & 1
    if (IN(8)) { phase8(p, lds, (float*)(ws + WS_SC), xbar.x, 8u * misc[0], gw, NGW, wave, lane); xcd_barrier(xbar); }
#endif
    if (IN(8)) phase8(p, lds, p.out, xbar.x, 8u * misc[0], gw, NGW, wave, lane);
#undef IN
#undef SEAM
}

extern "C" void kernel_launch(void* const* d_in, const int* in_sizes, int n_in, void* d_out, int out_size, void* d_ws, size_t ws_size, hipStream_t stream) {
    static int grid = 0;
    if (grid == 0) {
        if (n_in != 18 || out_size != S * DM || ws_size < WS_END) { fprintf(stderr, "kernel_launch: unexpected shapes (n_in %d out %d ws %zu)\n", n_in, out_size, ws_size); grid = -1; return; }
        int dev = 0, cus = 0, per_cu = 0;
        hipGetDevice(&dev);
        hipDeviceGetAttribute(&cus, hipDeviceAttributeMultiprocessorCount, dev);
        if (hipFuncSetAttribute((const void*)mega, hipFuncAttributeMaxDynamicSharedMemorySize, LDS_BYTES) != hipSuccess) { fprintf(stderr, "kernel_launch: hipFuncSetAttribute failed\n"); grid = -1; return; }
        if (hipOccupancyMaxActiveBlocksPerMultiprocessor(&per_cu, (const void*)mega, NTHREADS, LDS_BYTES) != hipSuccess || per_cu < 1) { fprintf(stderr, "kernel_launch: occupancy query failed (%d)\n", per_cu); grid = -1; return; }
        grid = cus;
        fprintf(stderr, "kernel_launch: cus %d per_cu %d grid %d\n", cus, per_cu, grid);
    }
    if (grid < 0) return;
    hipMemsetAsync((char*)d_ws + WS_CTL, 0, 1 * MiB, stream);
    Params prm{};
    for (int i = 0; i < 18; ++i) prm.in[i] = (const float*)d_in[i];
    prm.out = (float*)d_out; prm.ws = (unsigned char*)d_ws;
#if MK_ONE_LAUNCH
    prm.ph_lo = 0; prm.ph_hi = NPH;
    { void* args[] = {&prm}; hipError_t e = hipLaunchCooperativeKernel((const void*)mega, dim3(grid), dim3(NTHREADS), args, LDS_BYTES, stream);
      if (e != hipSuccess) fprintf(stderr, "cooperative launch failed: %s\n", hipGetErrorString(e)); }
#else
    for (int ph = 0; ph < NPH; ++ph) {
        prm.ph_lo = ph; prm.ph_hi = ph + 1;
        void* args[] = {&prm};
        hipError_t e = hipLaunchCooperativeKernel((const void*)mega, dim3(grid), dim3(NTHREADS), args, LDS_BYTES, stream);
        if (e != hipSuccess) { fprintf(stderr, "cooperative launch %d failed: %s\n", ph, hipGetErrorString(e)); break; }
    }
#endif
}
```

```cpp
#include <hip/hip_runtime.h>
#include <cstdio>
#include <cstdint>

#define LAS __attribute__((address_space(3)))
typedef unsigned short bf16_t;
typedef short bf16x8 __attribute__((ext_vector_type(8)));
typedef short s16x4 __attribute__((ext_vector_type(4)));
typedef float f32x4 __attribute__((ext_vector_type(4)));
typedef float f32x16 __attribute__((ext_vector_type(16)));
typedef unsigned u32x4 __attribute__((ext_vector_type(4)));
typedef unsigned u32x2 __attribute__((ext_vector_type(2)));

#ifndef PROBE_DUP
#define PROBE_DUP 0
#endif
#ifndef MK_ONE_LAUNCH
#define MK_ONE_LAUNCH 1
#endif

constexpr int S = 8192, DM = 2048, NIN = 2880, NINP = 3072;
constexpr int NPH = 9;
constexpr float EPS = 1e-6f;
constexpr int LDS_BYTES = 163840;
constexpr int NTHREADS = 512;
constexpr int LDS_MISC = 161792;

constexpr size_t MiB = 1u << 20;
constexpr size_t WS_CTL = 0;
constexpr size_t WS_ROWSS = 128 * 1024;
constexpr size_t WS_COS = 1 * MiB, WS_SIN = 2 * MiB;
constexpr size_t WS_RSTD1 = 3 * MiB;
constexpr size_t WS_EXP = 4 * MiB;
constexpr size_t WS_GATE = 8 * MiB;
constexpr size_t WS_WIN = 12 * MiB;
constexpr size_t WS_WUQ = 24 * MiB;
constexpr size_t WS_WUKV = 26 * MiB;
constexpr size_t WS_WOUT = 28 * MiB;
constexpr size_t WS_WS = 36 * MiB;
constexpr size_t WS_XB = 44 * MiB;
constexpr size_t WS_PROJ = 76 * MiB;
constexpr size_t WS_QRAW = 124 * MiB;
constexpr size_t WS_KVRAW = 148 * MiB;
constexpr size_t WS_QH = 180 * MiB;
constexpr size_t WS_KH = 204 * MiB;
constexpr size_t WS_VH = 228 * MiB;
constexpr size_t WS_MIX = 244 * MiB;
constexpr size_t WS_X1B = 276 * MiB;
constexpr size_t WS_SC = 308 * MiB;
constexpr size_t WS_UT = 372 * MiB;
constexpr size_t WS_VT = 436 * MiB;
constexpr size_t WS_END = 500 * MiB;

__device__ __forceinline__ unsigned f2bf(float f) { unsigned u = __builtin_bit_cast(unsigned, f); return (u + 0x7fffu + ((u >> 16) & 1u)) >> 16; }
__device__ __forceinline__ unsigned pk2(float lo, float hi) { return f2bf(lo) | (f2bf(hi) << 16); }
__device__ __forceinline__ float bf2f(unsigned short b) { return __builtin_bit_cast(float, (unsigned)b << 16); }
__device__ __forceinline__ float bflo(unsigned w) { return __builtin_bit_cast(float, w << 16); }
__device__ __forceinline__ float bfhi(unsigned w) { return __builtin_bit_cast(float, w & 0xffff0000u); }
__device__ __forceinline__ float wave_sum(float v) {
#pragma unroll
    for (int o = 32; o > 0; o >>= 1) v += __shfl_xor(v, o);
    return v;
}
__device__ __forceinline__ float wave_max(float v) {
#pragma unroll
    for (int o = 32; o > 0; o >>= 1) v = fmaxf(v, __shfl_xor(v, o));
    return v;
}
template <int CTRL, int ROW_MASK> __device__ __forceinline__ float dpp_f(float old, float v) {
    return __builtin_bit_cast(float, __builtin_amdgcn_update_dpp(__builtin_bit_cast(int, old), __builtin_bit_cast(int, v), CTRL, ROW_MASK, 0xf, false));
}
__device__ __forceinline__ float wave_max_u(float v) {
    v = fmaxf(v, dpp_f<0xB1, 0xf>(v, v));
    v = fmaxf(v, dpp_f<0x4E, 0xf>(v, v));
    v = fmaxf(v, dpp_f<0x141, 0xf>(v, v));
    v = fmaxf(v, dpp_f<0x140, 0xf>(v, v));
    v = fmaxf(v, dpp_f<0x142, 0xa>(v, v));
    v = fmaxf(v, dpp_f<0x143, 0xc>(v, v));
    return __builtin_bit_cast(float, __builtin_amdgcn_readlane(__builtin_bit_cast(int, v), 63));
}
__device__ __forceinline__ float wave_sum_u(float v) {
    v += dpp_f<0xB1, 0xf>(0.f, v);
    v += dpp_f<0x4E, 0xf>(0.f, v);
    v += dpp_f<0x141, 0xf>(0.f, v);
    v += dpp_f<0x140, 0xf>(0.f, v);
    v += dpp_f<0x142, 0xa>(0.f, v);
    v += dpp_f<0x143, 0xc>(0.f, v);
    return __builtin_bit_cast(float, __builtin_amdgcn_readlane(__builtin_bit_cast(int, v), 63));
}
__device__ __forceinline__ float gelu_tanh(float x) {
    const float y = 0.7978845608028654f * (x + 0.044715f * x * x * x);
    return x / (1.0f + __expf(-2.0f * y));
}
__device__ __forceinline__ int crow(int r, int hi) { return (r & 3) + 8 * (r >> 2) + 4 * hi; }
#define LDS_WAIT() asm volatile("s_waitcnt lgkmcnt(0)" ::: "memory")
#define SBAR() __builtin_amdgcn_sched_barrier(0)

namespace pg8 {
#define PG8_LAS __attribute__((address_space(3)))
constexpr int BM = 256, BK = 64, HALF = 128, HTB = HALF * BK * 2  , STAGE_BYTES = 8 * HTB, NXCD = 8, WGM = 8;

__host__ __device__ __forceinline__ int lds_byte(int r, int c) { const int st = (r >> 4) * 2 + (c >> 5), rr = r & 15, cc = c & 31, ob = rr * 64 + cc * 2; return st * 1024 + (ob ^ (((ob >> 9) & 1) << 5)); }
__host__ __device__ __forceinline__ void stage_rc(int b, int& R, int& C) { const int st = b / 1024, sb = b % 1024, swz = sb ^ (((sb >> 9) & 1) << 5); R = (st >> 1) * 16 + swz / 64; C = (st & 1) * 32 + (swz % 64) / 2; }
__host__ __device__ __forceinline__ int perm32(int rho) { const int n = rho >> 4, i = rho & 15; return 8 * (i >> 2) + 4 * n + (i & 3); }

struct Unit { int pm, pn; };
struct Gemm { const bf16_t* A; const bf16_t* Bt; int M, N, K, lda, ldb; };

struct StaticOrder {
    int nM, nN, nwg, G, c;
    __host__ __device__ void init(int M, int N, int G_, int c_) { nM = M / BM; nN = N / BM; nwg = nM * nN; G = G_; c = c_; }
    __host__ __device__ bool next(int i, Unit& u) const {
        const long L = (long)i * G + c; if (L >= nwg) return false;
        int wgid = (int)L; { const int q = nwg / NXCD, r = nwg % NXCD, xcd = wgid % NXCD, off = wgid / NXCD; wgid = (xcd < r ? xcd * (q + 1) : r * (q + 1) + (xcd - r) * q) + off; }
        const int nig = WGM * nN, gid = wgid / nig, fm = gid * WGM, gsz = (nM - fm) < WGM ? (nM - fm) : WGM;
        u.pm = fm + ((wgid % nig) % gsz); u.pn = (wgid % nig) / gsz; return true;
    }
    __device__ __forceinline__ void a_ready(const Unit&) const {}
    __device__ __forceinline__ void done(const Unit&) const {}
};

template <class Epi, class Sched, bool ALIGN_EPI = false, bool SP2 = false>
__device__ __forceinline__ void gemm_phase(PG8_LAS unsigned char* lds, const Gemm g, const Sched& S, const Epi& E) {
    const int tid = threadIdx.x, wid = __builtin_amdgcn_readfirstlane(tid >> 6), lane = tid & 63, wr = wid >> 2, wc = wid & 3, fr = lane & 15, fq = lane >> 4;
    const int K = g.K, nt = K / BK;
    unsigned voffA[2], voffB[2];
#pragma unroll
    for (int i = 0; i < 2; ++i) { int R, C; stage_rc(tid * 16 + i * 8192, R, C); const int Rb = Epi::PERM ? ((R & ~31) + perm32(R & 31)) : R;
        voffA[i] = (unsigned)(R * g.lda + C) * 2u; voffB[i] = (unsigned)(Rb * g.ldb + C) * 2u; }
    const size_t kstep = (size_t)(BK * 2);
    const size_t hstepA = (size_t)HALF * g.lda * 2, hstepB = (size_t)HALF * g.ldb * 2;
    const size_t tstepA = 2 * hstepA, tstepB = 2 * hstepB;
    const unsigned ldsw = (unsigned)wid * 1024u;
    const int aoff = lds_byte(wr * 64 + fr, fq * 8), boff = lds_byte(wc * 32 + fr, fq * 8);
#define PG8_SA(b, h) (((b) * 2 + (h)) * HTB)
#define PG8_SB(b, h) ((4 + (b) * 2 + (h)) * HTB)
#define PG8_STAGE(bufoff, gbase, voff) do { _Pragma("unroll") for (int _i = 0; _i < 2; ++_i) \
        __builtin_amdgcn_global_load_lds((const unsigned*)((const char*)(gbase) + (voff)[_i]), (PG8_LAS unsigned*)(lds + (bufoff) + ldsw + _i * 8192), 16, 0, 0); } while (0)
#define PG8_LDA(dst, b, h) do { _Pragma("unroll") for (int m = 0; m < 4; ++m) _Pragma("unroll") for (int k = 0; k < 2; ++k) dst[m][k] = *(const PG8_LAS bf16x8*)(lds + PG8_SA(b, h) + aoff + m * 2048 + k * 1024); } while (0)
#define PG8_LDB(dst, b, h) do { _Pragma("unroll") for (int n = 0; n < 2; ++n) _Pragma("unroll") for (int k = 0; k < 2; ++k) dst[n][k] = *(const PG8_LAS bf16x8*)(lds + PG8_SB(b, h) + boff + n * 2048 + k * 1024); } while (0)
#define PG8_MMA(ai, bj, At, Bt) do { __builtin_amdgcn_s_setprio(1); _Pragma("unroll") for (int m = 0; m < 4; ++m) _Pragma("unroll") for (int n = 0; n < 2; ++n) _Pragma("unroll") for (int k = 0; k < 2; ++k) \
        acc[ai][bj][m][n] = __builtin_amdgcn_mfma_f32_16x16x32_bf16(Bt[n][k], At[m][k], acc[ai][bj][m][n], 0, 0, 0); __builtin_amdgcn_s_setprio(0); } while (0)
#define PG8_WAIT_V(n) asm volatile("s_waitcnt vmcnt(" #n ")" ::: "memory")
#define PG8_WAIT_L(n) asm volatile("s_waitcnt lgkmcnt(" #n ")" ::: "memory")
#define PG8_BAR __builtin_amdgcn_s_barrier()
#define PG8_SCHED __builtin_amdgcn_sched_barrier(0)
    Unit cur, nxt; int ui = 0;
    if (!S.next(0, cur)) return;
    f32x4 acc[2][2][4][2];
#pragma unroll
    for (int a = 0; a < 2; ++a)
#pragma unroll
        for (int b = 0; b < 2; ++b)
#pragma unroll
            for (int m = 0; m < 4; ++m)
#pragma unroll
                for (int n = 0; n < 2; ++n) acc[a][b][m][n] = (f32x4){0.f, 0.f, 0.f, 0.f};
    bf16x8 At[4][2], B0[2][2], B1[2][2];
    const char* cA = (const char*)g.A + (size_t)cur.pm * tstepA; const char* cB = (const char*)g.Bt + (size_t)cur.pn * tstepB;
    S.a_ready(cur);
    if constexpr (SP2) {
        PG8_STAGE(PG8_SB(0, 0), cB, voffB); PG8_STAGE(PG8_SB(0, 1), cB + hstepB, voffB); PG8_STAGE(PG8_SA(0, 0), cA, voffA); PG8_STAGE(PG8_SA(0, 1), cA + hstepA, voffA);
        if (wr == 1) PG8_BAR;
        PG8_WAIT_V(2); PG8_BAR;
        PG8_STAGE(PG8_SB(1, 0), cB + kstep, voffB); PG8_STAGE(PG8_SA(1, 0), cA + kstep, voffA); PG8_STAGE(PG8_SB(1, 1), cB + hstepB + kstep, voffB);
        PG8_WAIT_V(6); PG8_BAR;
    } else {
        PG8_STAGE(PG8_SB(0, 0), cB, voffB); PG8_STAGE(PG8_SA(0, 0), cA, voffA); PG8_STAGE(PG8_SB(0, 1), cB + hstepB, voffB); PG8_STAGE(PG8_SA(0, 1), cA + hstepA, voffA);
        if (wr == 1) PG8_BAR;
        PG8_WAIT_V(4); PG8_BAR;
        PG8_STAGE(PG8_SB(1, 0), cB + kstep, voffB); PG8_STAGE(PG8_SA(1, 0), cA + kstep, voffA); PG8_STAGE(PG8_SB(1, 1), cB + hstepB + kstep, voffB);
        PG8_WAIT_V(6); PG8_BAR;
    }
    for (;;) {
        const bool has_next = S.next(ui + 1, nxt);
        const char* nA = has_next ? (const char*)g.A + (size_t)nxt.pm * tstepA : cA; const char* nB = has_next ? (const char*)g.Bt + (size_t)nxt.pn * tstepB : cB;
        for (int t = 0; t < nt; t += 2) {
            const bool last = (t == nt - 2);
            const char* a1 = cA + (size_t)(t + 1) * kstep;
            const char* a2 = last ? nA : cA + (size_t)(t + 2) * kstep; const char* b2 = last ? nB : cB + (size_t)(t + 2) * kstep;
            const char* a3 = a2 + kstep; const char* b3 = b2 + kstep;
            if (last && has_next) S.a_ready(nxt);
            if constexpr (SP2) {
            PG8_LDB(B0, 0, 0); PG8_LDB(B1, 0, 1); PG8_SCHED; PG8_LDA(At, 0, 0); PG8_STAGE(PG8_SA(1, 1), a1 + hstepA, voffA);
            PG8_WAIT_V(8); PG8_WAIT_L(0); PG8_BAR; PG8_MMA(0, 0, At, B0); PG8_MMA(0, 1, At, B1); PG8_BAR; PG8_SCHED;
            PG8_LDA(At, 0, 1); PG8_STAGE(PG8_SB(0, 0), b2, voffB); PG8_STAGE(PG8_SB(0, 1), b2 + hstepB, voffB); PG8_STAGE(PG8_SA(0, 0), a2, voffA);
            PG8_WAIT_V(8); PG8_WAIT_L(0); PG8_BAR; PG8_MMA(1, 0, At, B0); PG8_MMA(1, 1, At, B1); PG8_BAR; PG8_SCHED;
            PG8_LDB(B0, 1, 0); PG8_LDB(B1, 1, 1); PG8_SCHED; PG8_LDA(At, 1, 0); PG8_STAGE(PG8_SA(0, 1), a2 + hstepA, voffA);
            PG8_WAIT_V(8); PG8_WAIT_L(0); PG8_BAR; PG8_MMA(0, 0, At, B0); PG8_MMA(0, 1, At, B1); PG8_BAR; PG8_SCHED;
            PG8_LDA(At, 1, 1); PG8_STAGE(PG8_SB(1, 0), b3, voffB); PG8_STAGE(PG8_SB(1, 1), b3 + hstepB, voffB); PG8_STAGE(PG8_SA(1, 0), a3, voffA);
            PG8_WAIT_V(8); PG8_WAIT_L(0); PG8_BAR; PG8_MMA(1, 0, At, B0); PG8_MMA(1, 1, At, B1); PG8_BAR; PG8_SCHED;
            } else {
            PG8_LDB(B0, 0, 0); PG8_SCHED; PG8_LDA(At, 0, 0); PG8_STAGE(PG8_SA(1, 1), a1 + hstepA, voffA);
            PG8_WAIT_L(8); PG8_BAR; PG8_WAIT_L(0); PG8_MMA(0, 0, At, B0); PG8_BAR; PG8_SCHED;
            PG8_LDB(B1, 0, 1); PG8_STAGE(PG8_SB(0, 0), b2, voffB);
            PG8_BAR; PG8_WAIT_L(0); PG8_MMA(0, 1, At, B1); PG8_BAR;
            PG8_LDA(At, 0, 1); PG8_STAGE(PG8_SA(0, 0), a2, voffA);
            PG8_BAR; PG8_WAIT_L(0); PG8_MMA(1, 0, At, B0); PG8_BAR; PG8_SCHED;
            PG8_STAGE(PG8_SB(0, 1), b2 + hstepB, voffB);
            PG8_WAIT_V(6); PG8_BAR; PG8_MMA(1, 1, At, B1); PG8_BAR;
            PG8_LDB(B0, 1, 0); PG8_SCHED; PG8_LDA(At, 1, 0); PG8_STAGE(PG8_SA(0, 1), a2 + hstepA, voffA);
            PG8_WAIT_L(8); PG8_BAR; PG8_WAIT_L(0); PG8_MMA(0, 0, At, B0); PG8_BAR; PG8_SCHED;
            PG8_LDB(B1, 1, 1); PG8_STAGE(PG8_SB(1, 0), b3, voffB);
            PG8_BAR; PG8_WAIT_L(0); PG8_MMA(0, 1, At, B1); PG8_BAR;
            PG8_LDA(At, 1, 1); PG8_STAGE(PG8_SA(1, 0), a3, voffA);
            PG8_BAR; PG8_WAIT_L(0); PG8_MMA(1, 0, At, B0); PG8_BAR; PG8_SCHED;
            PG8_STAGE(PG8_SB(1, 1), b3 + hstepB, voffB);
            PG8_WAIT_V(6); PG8_BAR; PG8_MMA(1, 1, At, B1); PG8_BAR;
            }
        }
        if constexpr (ALIGN_EPI) { if (wr == 0) PG8_BAR; }
        if constexpr (!Epi::AFTER_DRAIN) { E(acc, cur, wr, wc, fr, fq); S.done(cur); }
        if (!has_next) break;
#pragma unroll
        for (int a = 0; a < 2; ++a)
#pragma unroll
            for (int b = 0; b < 2; ++b)
#pragma unroll
                for (int m = 0; m < 4; ++m)
#pragma unroll
                    for (int n = 0; n < 2; ++n) acc[a][b][m][n] = (f32x4){0.f, 0.f, 0.f, 0.f};
        cur = nxt; cA = nA; cB = nB; ++ui;
        if constexpr (ALIGN_EPI) { if (wr == 1) PG8_BAR; }
    }
    PG8_WAIT_V(0);
    if constexpr (!ALIGN_EPI) { if (wr == 0) PG8_BAR; }
    PG8_BAR;
#undef PG8_SA
#undef PG8_SB
#undef PG8_STAGE
#undef PG8_LDA
#undef PG8_LDB
#undef PG8_MMA
#undef PG8_WAIT_V
#undef PG8_WAIT_L
#undef PG8_BAR
#undef PG8_SCHED
}

template <int MODE> struct Epi {
    static constexpr bool PERM = false, AFTER_DRAIN = false;
    const float* rowsrc; float inv_n; float* ss; bf16_t* ob; int ldc; float* of; const float* xin;
    __device__ __forceinline__ void operator()(const f32x4 (&acc)[2][2][4][2], const Unit& u, int wr, int wc, int fr, int fq) const {
#pragma unroll
        for (int ai = 0; ai < 2; ++ai)
#pragma unroll
            for (int m = 0; m < 4; ++m) {
                const int row = u.pm * BM + ai * HALF + wr * 64 + m * 16 + fr;
                float rs = 1.f;
                if (MODE == 1) rs = rowsrc[row];
                if (MODE == 2 || MODE == 5) rs = rsqrtf(rowsrc[row] * inv_n + EPS);
                float ssq = 0.f;
#pragma unroll
                for (int bj = 0; bj < 2; ++bj)
#pragma unroll
                    for (int n = 0; n < 2; ++n) {
                        const int col = u.pn * BM + bj * HALF + wc * 32 + n * 16 + fq * 4;
                        f32x4 v = acc[ai][bj][m][n] * rs;
                        if (MODE == 1) { if (u.pn < 8) { v[0] = gelu_tanh(v[0]); v[1] = gelu_tanh(v[1]); v[2] = gelu_tanh(v[2]); v[3] = gelu_tanh(v[3]); } }
                        if (MODE == 4) { const f32x4 xr = *(const f32x4*)(xin + (size_t)row * DM + col); v = v + xr; }
                        if (MODE == 1 || MODE == 4) ssq += (v[0] * v[0] + v[1] * v[1]) + (v[2] * v[2] + v[3] * v[3]);
                        if (MODE == 1 || MODE == 2 || MODE == 4) { u32x2 w; w.x = pk2(v[0], v[1]); w.y = pk2(v[2], v[3]); *(u32x2*)(ob + (size_t)row * ldc + col) = w; }
                        if (MODE == 4 || MODE == 5) *(f32x4*)(of + (size_t)row * DM + col) = v;
                    }
                if (MODE == 1) {
                    const int seg = (u.pn >= 4 && u.pn < 8) ? 0 : ((u.pn == 8 || u.pn == 9) ? 1 : (u.pn == 10 ? 2 : -1));
                    if (seg >= 0) { ssq += __shfl_xor(ssq, 16); ssq += __shfl_xor(ssq, 32); if (fq == 0) atomicAdd(ss + seg * S + row, ssq); }
                }
                if (MODE == 4) { ssq += __shfl_xor(ssq, 16); ssq += __shfl_xor(ssq, 32); if (fq == 0) atomicAdd(ss + row, ssq); }
            }
    }
};
}

#define XB_TMO      128
#define XB_XCNT(j)  (256  + 64 * (j))
#define XB_XSUB(j)  (1280 + 64 * (j))
#define XB_XGEN(j)  (2304 + 64 * (j))
#define XB_TOP      3328
#define XB_TOPGEN   3392
#define XCD_BAR_WORDS 3456
#define XB_SPIN_CAP (1u << 18)
__device__ __forceinline__ unsigned xb_ld(unsigned* p)              { return __hip_atomic_load(p, __ATOMIC_RELAXED, __HIP_MEMORY_SCOPE_AGENT); }
__device__ __forceinline__ unsigned xb_add(unsigned* p, unsigned v) { return __hip_atomic_fetch_add(p, v, __ATOMIC_RELAXED, __HIP_MEMORY_SCOPE_AGENT); }
__device__ __forceinline__ unsigned xb_xcc_id() { return (unsigned)__builtin_amdgcn_s_getreg((3 << 11) | 20) & 0xFu; }
#define XB_SPIN(cond, bar) do { unsigned _sp = 0; while (cond) { __builtin_amdgcn_s_sleep(1); \
    if ((++_sp & 255u) == 0u) { if (xb_ld(&(bar)[XB_TMO])) break; if (_sp > XB_SPIN_CAP) { atomicAdd(&(bar)[XB_TMO], 1u); break; } } } } while (0)
struct XcdBarrier { unsigned* bar; unsigned x; volatile LAS unsigned* st; };
__device__ __forceinline__ XcdBarrier xcd_barrier_post(unsigned* bar, volatile LAS unsigned* st) {
    XcdBarrier b; b.bar = bar; b.x = xb_xcc_id(); b.st = st;
    if (threadIdx.x == 0) (void)xb_add(&bar[XB_XCNT(b.x)], 1u);
    return b;
}
__device__ __forceinline__ void xcd_barrier_complete(unsigned* bar, unsigned x, unsigned& nloc, unsigned& nx) {
    const unsigned G = gridDim.x * gridDim.y * gridDim.z;
    unsigned sum, cnt, mine, sp = 0u;
    for (;;) {
        sum = 0u; cnt = 0u; mine = 0u;
#pragma unroll
        for (unsigned j = 0; j < 16; ++j) { const unsigned c = xb_ld(&bar[XB_XCNT(j)]); sum += c; cnt += (c > 0u) ? 1u : 0u; mine = (j == x) ? c : mine; }
        if (sum == G) break;
        __builtin_amdgcn_s_sleep(1);
        if ((++sp & 255u) == 0u) { if (xb_ld(&bar[XB_TMO])) break; if (sp > XB_SPIN_CAP) { atomicAdd(&bar[XB_TMO], 1u); break; } }
    }
    nloc = mine > 0u ? mine : 1u; nx = cnt > 0u ? cnt : 1u;
}
__device__ __forceinline__ void xcd_barrier(const XcdBarrier& b) {
    asm volatile("s_waitcnt vmcnt(0)" ::: "memory");
    __syncthreads();
    if (threadIdx.x == 0) {
        unsigned* bar = b.bar;
        __builtin_amdgcn_s_waitcnt(0);
        unsigned nloc = b.st[0], nx = b.st[1];
        if (nloc == 0u) { xcd_barrier_complete(bar, b.x, nloc, nx); b.st[0] = nloc; b.st[1] = nx; }
        const unsigned old = xb_add(&bar[XB_XSUB(b.x)], 1u);
        const unsigned gen = old / nloc;
        if (old + 1u == (gen + 1u) * nloc) {
            __builtin_amdgcn_fence(__ATOMIC_RELEASE, "agent");
            asm volatile("s_waitcnt vmcnt(0)" ::: "memory");
            const unsigned og = xb_add(&bar[XB_TOP], 1u);
            const unsigned tg = og / nx;
            if (og + 1u == (tg + 1u) * nx) xb_add(&bar[XB_TOPGEN], 1u);
            else XB_SPIN(xb_ld(&bar[XB_TOPGEN]) == tg, bar);
            __builtin_amdgcn_fence(__ATOMIC_ACQUIRE, "agent");
            xb_add(&bar[XB_XGEN(b.x)], 1u);
            asm volatile("s_waitcnt vmcnt(0)" ::: "memory");
        } else {
            XB_SPIN(xb_ld(&bar[XB_XGEN(b.x)]) == gen, bar);
            __builtin_amdgcn_fence(__ATOMIC_ACQUIRE, "agent");
            asm volatile("s_waitcnt vmcnt(0)" ::: "memory");
        }
    }
    __syncthreads();
}

struct Params {
    const float* in[18];
    float* out;
    unsigned char* ws;
    int ph_lo, ph_hi;
};

__device__ __forceinline__ void p0_transpose_item(const float* W, const float* g, int K, int N, bf16_t* WT, LAS float* scr, int item, int lane) {
    const int nblk = N / 32, kb = item / nblk, nb = item % nblk, k0 = 64 * kb, n0 = 32 * nb;
    float wv[32];
#pragma unroll
    for (int i = 0; i < 32; ++i) { const int kk = 2 * i + (lane >> 5); wv[i] = W[(size_t)(k0 + kk) * N + n0 + (lane & 31)]; }
#pragma unroll
    for (int i = 0; i < 32; ++i) { const int kk = 2 * i + (lane >> 5); const float gv = g ? g[k0 + kk] : 1.f; scr[kk * 33 + (lane & 31)] = wv[i] * gv; }
    LDS_WAIT(); asm volatile("" ::: "memory");
    const int c = lane & 7;
#pragma unroll
    for (int j = 0; j < 4; ++j) { const int n = (lane >> 3) + 8 * j; const LAS float* s = scr + (8 * c) * 33 + n;
        u32x4 o; o.x = pk2(s[0 * 33], s[1 * 33]); o.y = pk2(s[2 * 33], s[3 * 33]); o.z = pk2(s[4 * 33], s[5 * 33]); o.w = pk2(s[6 * 33], s[7 * 33]);
        *(u32x4*)(WT + (size_t)(n0 + n) * K + k0 + 8 * c) = o; }
    LDS_WAIT(); asm volatile("" ::: "memory");
}
__device__ __forceinline__ float row_to_bf16(const float* src, const float* g, bf16_t* dst, int lane) {
    float ss = 0.f;
#pragma unroll
    for (int i = 0; i < 8; ++i) {
        const int c = (i * 64 + lane) * 4;
        f32x4 v = *(const f32x4*)(src + c);
        ss += (v[0] * v[0] + v[1] * v[1]) + (v[2] * v[2] + v[3] * v[3]);
        if (g) { const f32x4 gv = *(const f32x4*)(g + c); v = v * gv; }
        u32x2 w; w.x = pk2(v[0], v[1]); w.y = pk2(v[2], v[3]);
        *(u32x2*)(dst + c) = w;
    }
    return ss;
}
constexpr float PEER_USC = 80.0f, PEER_VSC = 5.0f;
constexpr int PEER_ROWB = 1536;
typedef float f32x16v __attribute__((ext_vector_type(16)));
typedef float f32x32v __attribute__((ext_vector_type(32)));
typedef unsigned u32x6 __attribute__((ext_vector_type(6)));
typedef unsigned u32x2a4 __attribute__((ext_vector_type(2), aligned(4)));
template <bool CONTIG>
__device__ __forceinline__ void fp6_pack_store(const f32x4 (&x)[8], const f32x4 (&sc)[8], unsigned char* dst, int lane) {
    f32x16v a, b;
#pragma unroll
    for (int i = 0; i < 8; ++i) {
        const f32x4 y = x[i] * sc[i];
#pragma unroll
        for (int q = 0; q < 4; ++q) { const float c = fminf(fmaxf(y[q], -7.5f), 7.5f); const int sl = 4 * i + q; if ((sl & 1) == 0) a[sl >> 1] = c; else b[sl >> 1] = c; }
    }
    const u32x6 pk = __builtin_amdgcn_cvt_scalef32_2xpk16_fp6_f32(a, b, 1.0f);
    asm volatile("s_nop 15" : "+v"(a), "+v"(b));
    if (CONTIG) {
        *(u32x2*)(dst + lane * 24) = (u32x2){pk[0], pk[1]}; *(u32x2*)(dst + lane * 24 + 8) = (u32x2){pk[2], pk[3]}; *(u32x2*)(dst + lane * 24 + 16) = (u32x2){pk[4], pk[5]};
    } else {
        *(u32x4*)(dst + lane * 16) = (u32x4){pk[0], pk[1], pk[2], pk[3]};
        *(u32x2*)(dst + 1024 + lane * 8) = (u32x2){pk[4], pk[5]};
    }
}
template <bool CONTIG>
__device__ __forceinline__ void rows2_to_fp6(const float* s0, const float* s1, const f32x4 (&sc)[8], unsigned char* d0, unsigned char* d1, int lane) {
    f32x4 x0[8], x1[8];
#pragma unroll
    for (int i = 0; i < 8; ++i) { x0[i] = *(const f32x4*)(s0 + (i * 64 + lane) * 4); x1[i] = *(const f32x4*)(s1 + (i * 64 + lane) * 4); }
    fp6_pack_store<CONTIG>(x0, sc, d0, lane); fp6_pack_store<CONTIG>(x1, sc, d1, lane);
}
__device__ __forceinline__ bf16x8 cvt8(const float* p) {
    const f32x4 a = *(const f32x4*)p, b = *(const f32x4*)(p + 4);
    u32x4 w; w.x = pk2(a[0], a[1]); w.y = pk2(a[2], a[3]); w.z = pk2(b[0], b[1]); w.w = pk2(b[2], b[3]);
    return __builtin_bit_cast(bf16x8, w);
}

__device__ __forceinline__ void prep_late(const Params& p, LAS unsigned char* lds, int gw, int NGW, int wave, int lane) {
    unsigned char* ws = p.ws;
    LAS float* scr = (LAS float*)(lds + wave * 16384);
    {
        constexpr int I_UQ = (512 / 64) * (1536 / 32), I_UKV = (256 / 64) * (2048 / 32), I_OUT = (DM / 64) * (DM / 32);
        constexpr int NIT = I_UQ + I_UKV + I_OUT;
        for (int it = gw; it < NIT; it += NGW) {
            int r = it;
            if (r < I_UQ) { p0_transpose_item(p.in[7], p.in[6], 512, 1536, (bf16_t*)(ws + WS_WUQ), scr, r, lane); continue; } r -= I_UQ;
            if (r < I_UKV) { p0_transpose_item(p.in[9], p.in[8], 256, 2048, (bf16_t*)(ws + WS_WUKV), scr, r, lane); continue; } r -= I_UKV;
            p0_transpose_item(p.in[12], nullptr, DM, DM, (bf16_t*)(ws + WS_WOUT), scr, r, lane);
        }
    }
    {
        const float* wq = p.in[14]; const float* sk = p.in[15]; const float* g2 = p.in[13];
        bf16_t* WsT = (bf16_t*)(ws + WS_WS);
        const int r32 = lane & 31, hh = lane >> 5;
        for (int it = gw; it < 16 * 4 * 64; it += NGW) {
            const int hp = it >> 8, kb = (it >> 6) & 3, nb = it & 63;
            f32x16 acc = {};
            const float* ap = sk + ((size_t)(hp * 128 + kb * 32 + r32)) * 128 + hh * 8;
            const float* bp = wq + ((size_t)(nb * 32 + r32)) * DM + hp * 128 + hh * 8;
#pragma unroll
            for (int s = 0; s < 8; ++s) {
                const bf16x8 a = cvt8(ap + s * 16), b = cvt8(bp + s * 16);
                acc = __builtin_amdgcn_mfma_f32_32x32x16_bf16(a, b, acc, 0, 0, 0);
            }
            const int kcol = nb * 32 + r32; const float gk = g2[kcol];
#pragma unroll
            for (int r = 0; r < 16; ++r) WsT[(size_t)(hp * 128 + kb * 32 + crow(r, hh)) * DM + kcol] = (bf16_t)f2bf(acc[r] * gk);
        }
    }
    {
        float* ct = (float*)(ws + WS_COS); float* st = (float*)(ws + WS_SIN);
        for (int it = gw; it < S * 32 / 64; it += NGW) {
            const int idx = it * 64 + lane, t = idx >> 5, j = idx & 31;
            const float inv_freq = powf(10000.0f, -(float)j / 32.0f);
            const float ang = (float)t * inv_freq;
            float sv, cv; sincosf(ang, &sv, &cv); ct[idx] = cv; st[idx] = sv;
        }
    }
}
__device__ __forceinline__ void phase0(const Params& p, LAS unsigned char* lds, bool late_ok, int gw, int NGW, int wave, int lane) {
    unsigned char* ws = p.ws;
    LAS float* scr = (LAS float*)(lds + wave * 16384);
    const float* x = p.in[0];
    {
        constexpr int I_IN = (DM / 64) * (NIN / 32);
        for (int it = gw; it < I_IN; it += NGW) p0_transpose_item(p.in[2], p.in[1], DM, NIN, (bf16_t*)(ws + WS_WIN), scr, it, lane);
    }
    if (!late_ok) prep_late(p, lds, gw, NGW, wave, lane);
    for (int r = gw; r < NINP - NIN; r += NGW) {
        bf16_t* d = (bf16_t*)(ws + WS_WIN) + (size_t)(NIN + r) * DM;
#pragma unroll
        for (int i = 0; i < 4; ++i) *(u32x4*)(d + (i * 64 + lane) * 8) = (u32x4){0u, 0u, 0u, 0u};
    }
    {
        bf16_t* xb = (bf16_t*)(ws + WS_XB); float* rstd1 = (float*)(ws + WS_RSTD1);
        for (int t = gw; t + NGW < S; t += 2 * NGW) {
            const int t1 = t + NGW;
            f32x4 a[8], b[8];
#pragma unroll
            for (int i = 0; i < 8; ++i) { a[i] = *(const f32x4*)(x + (size_t)t * DM + (i * 64 + lane) * 4); b[i] = *(const f32x4*)(x + (size_t)t1 * DM + (i * 64 + lane) * 4); }
            float sa = 0.f, sb = 0.f;
#pragma unroll
            for (int i = 0; i < 8; ++i) {
                sa += (a[i][0] * a[i][0] + a[i][1] * a[i][1]) + (a[i][2] * a[i][2] + a[i][3] * a[i][3]);
                sb += (b[i][0] * b[i][0] + b[i][1] * b[i][1]) + (b[i][2] * b[i][2] + b[i][3] * b[i][3]);
                u32x2 wa, wb; wa.x = pk2(a[i][0], a[i][1]); wa.y = pk2(a[i][2], a[i][3]); wb.x = pk2(b[i][0], b[i][1]); wb.y = pk2(b[i][2], b[i][3]);
                *(u32x2*)(xb + (size_t)t * DM + (i * 64 + lane) * 4) = wa; *(u32x2*)(xb + (size_t)t1 * DM + (i * 64 + lane) * 4) = wb;
            }
            sa = wave_sum(sa); sb = wave_sum(sb);
            if (lane == 0) { rstd1[t] = rsqrtf(sa * (1.0f / DM) + EPS); rstd1[t1] = rsqrtf(sb * (1.0f / DM) + EPS); }
        }
    }
    {
        unsigned char* UT = ws + WS_UT; unsigned char* VT = ws + WS_VT;
        f32x4 sc[8];
#pragma unroll
        for (int i = 0; i < 8; ++i) sc[i] = *(const f32x4*)(p.in[13] + (i * 64 + lane) * 4) * PEER_USC;
        for (int e = gw; e + NGW < 16384; e += 2 * NGW)
            rows2_to_fp6<false>(p.in[16] + (size_t)e * DM, p.in[16] + (size_t)(e + NGW) * DM, sc, UT + (size_t)e * PEER_ROWB, UT + (size_t)(e + NGW) * PEER_ROWB, lane);
#pragma unroll
        for (int i = 0; i < 8; ++i) sc[i] = (f32x4){PEER_VSC, PEER_VSC, PEER_VSC, PEER_VSC};
        for (int e = gw; e + NGW < 16384; e += 2 * NGW)
            rows2_to_fp6<false>(p.in[17] + (size_t)e * DM, p.in[17] + (size_t)(e + NGW) * DM, sc, VT + (size_t)e * PEER_ROWB, VT + (size_t)(e + NGW) * PEER_ROWB, lane);
    }
}

__device__ __forceinline__ void phase3(const Params& p, int gw, int NGW, int lane) {
    unsigned char* ws = p.ws;
    const bf16_t* qraw = (const bf16_t*)(ws + WS_QRAW); const bf16_t* kvraw = (const bf16_t*)(ws + WS_KVRAW); const bf16_t* proj = (const bf16_t*)(ws + WS_PROJ);
    bf16_t* Qh = (bf16_t*)(ws + WS_QH); bf16_t* Kh = (bf16_t*)(ws + WS_KH);
    const float* ct = (const float*)(ws + WS_COS); const float* st = (const float*)(ws + WS_SIN);
    const bool act = lane < 48, isrope = lane >= 32 && lane < 48, lowhalf = lane < 40;
    const int e0 = act ? 4 * lane : 0;
    const f32x4 gq = *(const f32x4*)(p.in[10] + e0), gk = *(const f32x4*)(p.in[11] + e0);
    const int j0 = isrope ? ((4 * lane - 128) & 31) : 0;
    constexpr float QS = 0.07216878364870322f * 1.4426950408889634f;
    for (int t = gw; t < S; t += NGW) {
        f32x4 cs = {1.f, 1.f, 1.f, 1.f}, sn = {0.f, 0.f, 0.f, 0.f};
        if (isrope) { cs = *(const f32x4*)(ct + t * 32 + j0); sn = *(const f32x4*)(st + t * 32 + j0); }
        u32x2 krw = {0u, 0u};
        if (isrope) krw = *(const u32x2*)(proj + (size_t)t * NINP + 2816 + (4 * lane - 128));
        const f32x4 krope = {bflo(krw.x), bfhi(krw.x), bflo(krw.y), bfhi(krw.y)};
#pragma unroll
        for (int h = 0; h < 8; ++h) {
            u32x2 qw = {0u, 0u};
            if (act) qw = *(const u32x2*)(qraw + (size_t)t * 1536 + h * 192 + e0);
            f32x4 q = {bflo(qw.x), bfhi(qw.x), bflo(qw.y), bfhi(qw.y)};
            float ss = wave_sum_u((q[0] * q[0] + q[1] * q[1]) + (q[2] * q[2] + q[3] * q[3]));
            float rs = rsqrtf(ss * (1.0f / 192.0f) + EPS);
            q = q * gq * rs;
            {
                f32x4 pr;
#pragma unroll
                for (int c = 0; c < 4; ++c) pr[c] = __shfl_xor(q[c], 8);
                const f32x4 r1 = q * cs - pr * sn, r2 = pr * sn + q * cs;
                if (isrope) q = lowhalf ? r1 : r2;
            }
            q = q * QS;
            if (act) { u32x2 w; w.x = pk2(q[0], q[1]); w.y = pk2(q[2], q[3]); *(u32x2*)(Qh + ((size_t)h * S + t) * 192 + e0) = w; }
            u32x2 kw = {0u, 0u};
            if (lane < 32) kw = *(const u32x2*)(kvraw + (size_t)t * 2048 + h * 256 + e0);
            f32x4 k = {bflo(kw.x), bfhi(kw.x), bflo(kw.y), bfhi(kw.y)};
            if (isrope) k = krope;
            ss = wave_sum_u((k[0] * k[0] + k[1] * k[1]) + (k[2] * k[2] + k[3] * k[3]));
            rs = rsqrtf(ss * (1.0f / 192.0f) + EPS);
            k = k * gk * rs;
            {
                f32x4 pr;
#pragma unroll
                for (int c = 0; c < 4; ++c) pr[c] = __shfl_xor(k[c], 8);
                const f32x4 r1 = k * cs - pr * sn, r2 = pr * sn + k * cs;
                if (isrope) k = lowhalf ? r1 : r2;
            }
            if (act) { u32x2 w; w.x = pk2(k[0], k[1]); w.y = pk2(k[2], k[3]); *(u32x2*)(Kh + ((size_t)h * S + t) * 192 + e0) = w; }
        }
    }
}

constexpr int KP = 400, VP = 320;
template <int OFF> __device__ __forceinline__ s16x4 tr_read(unsigned addr) {
    s16x4 r; asm volatile("ds_read_b64_tr_b16 %0, %1 offset:%2" : "=&v"(r) : "v"(addr), "i"(OFF) : "memory"); return r;
}
__device__ __forceinline__ unsigned cvtpk(float lo, float hi) { unsigned r; asm volatile("v_cvt_pk_bf16_f32 %0, %1, %2" : "=v"(r) : "v"(lo), "v"(hi)); return r; }
#define PK8(L, H) ((bf16x8){L[0], L[1], L[2], L[3], H[0], H[1], H[2], H[3]})
constexpr float ATT_THR = 8.0f;

constexpr int ATT_KB = 64 * KP, ATT_VB = 64 * VP;
constexpr int ATT_VOFF = 2 * ATT_KB;
__device__ __forceinline__ float xhalf_max(float v) {
    auto rr = __builtin_amdgcn_permlane32_swap(__builtin_bit_cast(unsigned, v), __builtin_bit_cast(unsigned, v), false, false);
    return fmaxf(__builtin_bit_cast(float, rr[0]), __builtin_bit_cast(float, rr[1]));
}
__device__ __forceinline__ float xhalf_sum(float v) {
    auto rr = __builtin_amdgcn_permlane32_swap(__builtin_bit_cast(unsigned, v), __builtin_bit_cast(unsigned, v), false, false);
    return __builtin_bit_cast(float, rr[0]) + __builtin_bit_cast(float, rr[1]);
}
template <int OFF> __device__ __forceinline__ bf16x8 lds_read128(unsigned addr) {
    bf16x8 r; asm volatile("ds_read_b128 %0, %1 offset:%2" : "=&v"(r) : "v"(addr), "i"(OFF) : "memory"); return r;
}
#define LGKM_WAIT(n) do { asm volatile("s_waitcnt lgkmcnt(" #n ")" ::: "memory"); SBAR(); } while (0)
__device__ __forceinline__ f32x16 att_qk(unsigned kaddr, const bf16x8 (&qr)[12]) {
    f32x16 p = {};
    bf16x8 a0 = lds_read128<0>(kaddr), a1 = lds_read128<32>(kaddr), a2 = lds_read128<64>(kaddr), a3 = lds_read128<96>(kaddr);
    LGKM_WAIT(3); p = __builtin_amdgcn_mfma_f32_32x32x16_bf16(a0, qr[0], p, 0, 0, 0); a0 = lds_read128<128>(kaddr);
    LGKM_WAIT(3); p = __builtin_amdgcn_mfma_f32_32x32x16_bf16(a1, qr[1], p, 0, 0, 0); a1 = lds_read128<160>(kaddr);
    LGKM_WAIT(3); p = __builtin_amdgcn_mfma_f32_32x32x16_bf16(a2, qr[2], p, 0, 0, 0); a2 = lds_read128<192>(kaddr);
    LGKM_WAIT(3); p = __builtin_amdgcn_mfma_f32_32x32x16_bf16(a3, qr[3], p, 0, 0, 0); a3 = lds_read128<224>(kaddr);
    LGKM_WAIT(3); p = __builtin_amdgcn_mfma_f32_32x32x16_bf16(a0, qr[4], p, 0, 0, 0); a0 = lds_read128<256>(kaddr);
    LGKM_WAIT(3); p = __builtin_amdgcn_mfma_f32_32x32x16_bf16(a1, qr[5], p, 0, 0, 0); a1 = lds_read128<288>(kaddr);
    LGKM_WAIT(3); p = __builtin_amdgcn_mfma_f32_32x32x16_bf16(a2, qr[6], p, 0, 0, 0); a2 = lds_read128<320>(kaddr);
    LGKM_WAIT(3); p = __builtin_amdgcn_mfma_f32_32x32x16_bf16(a3, qr[7], p, 0, 0, 0); a3 = lds_read128<352>(kaddr);
    LGKM_WAIT(3); p = __builtin_amdgcn_mfma_f32_32x32x16_bf16(a0, qr[8], p, 0, 0, 0);
    LGKM_WAIT(2); p = __builtin_amdgcn_mfma_f32_32x32x16_bf16(a1, qr[9], p, 0, 0, 0);
    LGKM_WAIT(1); p = __builtin_amdgcn_mfma_f32_32x32x16_bf16(a2, qr[10], p, 0, 0, 0);
    LGKM_WAIT(0); p = __builtin_amdgcn_mfma_f32_32x32x16_bf16(a3, qr[11], p, 0, 0, 0);
    return p;
}
__device__ __forceinline__ void att_finish(f32x16& s, float m, float& lsum, bf16x8& pb0, bf16x8& pb1) {
    float ps = 0.f;
#pragma unroll
    for (int r = 0; r < 16; ++r) { s[r] = __builtin_amdgcn_exp2f(s[r] - m); ps += s[r]; }
    lsum += xhalf_sum(ps);
    u32x4 w0 = {cvtpk(s[0], s[1]), cvtpk(s[2], s[3]), cvtpk(s[4], s[5]), cvtpk(s[6], s[7])};
    u32x4 w1 = {cvtpk(s[8], s[9]), cvtpk(s[10], s[11]), cvtpk(s[12], s[13]), cvtpk(s[14], s[15])};
    pb0 = __builtin_bit_cast(bf16x8, w0); pb1 = __builtin_bit_cast(bf16x8, w1);
}
__device__ __forceinline__ void att_pv(unsigned vaddr, bf16x8 pb0, bf16x8 pb1, f32x16 (&o)[4]) {
#define VOFF(d0, s, hi) (((16 * (s) + 8 * (hi)) * VP) + 64 * (d0))
    const s16x4 a00l = tr_read<VOFF(0, 0, 0)>(vaddr), a00h = tr_read<VOFF(0, 0, 1)>(vaddr), a01l = tr_read<VOFF(0, 1, 0)>(vaddr), a01h = tr_read<VOFF(0, 1, 1)>(vaddr);
    const s16x4 a10l = tr_read<VOFF(1, 0, 0)>(vaddr), a10h = tr_read<VOFF(1, 0, 1)>(vaddr), a11l = tr_read<VOFF(1, 1, 0)>(vaddr), a11h = tr_read<VOFF(1, 1, 1)>(vaddr);
    LGKM_WAIT(4);
    o[0] = __builtin_amdgcn_mfma_f32_32x32x16_bf16(PK8(a00l, a00h), pb0, o[0], 0, 0, 0); o[0] = __builtin_amdgcn_mfma_f32_32x32x16_bf16(PK8(a01l, a01h), pb1, o[0], 0, 0, 0);
    const s16x4 a20l = tr_read<VOFF(2, 0, 0)>(vaddr), a20h = tr_read<VOFF(2, 0, 1)>(vaddr), a21l = tr_read<VOFF(2, 1, 0)>(vaddr), a21h = tr_read<VOFF(2, 1, 1)>(vaddr);
    LGKM_WAIT(4);
    o[1] = __builtin_amdgcn_mfma_f32_32x32x16_bf16(PK8(a10l, a10h), pb0, o[1], 0, 0, 0); o[1] = __builtin_amdgcn_mfma_f32_32x32x16_bf16(PK8(a11l, a11h), pb1, o[1], 0, 0, 0);
    const s16x4 a30l = tr_read<VOFF(3, 0, 0)>(vaddr), a30h = tr_read<VOFF(3, 0, 1)>(vaddr), a31l = tr_read<VOFF(3, 1, 0)>(vaddr), a31h = tr_read<VOFF(3, 1, 1)>(vaddr);
    LGKM_WAIT(4);
    o[2] = __builtin_amdgcn_mfma_f32_32x32x16_bf16(PK8(a20l, a20h), pb0, o[2], 0, 0, 0); o[2] = __builtin_amdgcn_mfma_f32_32x32x16_bf16(PK8(a21l, a21h), pb1, o[2], 0, 0, 0);
    LGKM_WAIT(0);
    o[3] = __builtin_amdgcn_mfma_f32_32x32x16_bf16(PK8(a30l, a30h), pb0, o[3], 0, 0, 0); o[3] = __builtin_amdgcn_mfma_f32_32x32x16_bf16(PK8(a31l, a31h), pb1, o[3], 0, 0, 0);
#undef VOFF
}
__device__ __forceinline__ void att_partial(const f32x16& s, float& m, float& lsum, f32x16 (&o)[4]) {
    float pmax = s[0];
#pragma unroll
    for (int r = 1; r < 16; ++r) pmax = fmaxf(pmax, s[r]);
    pmax = xhalf_max(pmax);
    if (!__all(pmax - m <= ATT_THR)) {
        const float mn = fmaxf(m, pmax); const float alpha = __builtin_amdgcn_exp2f(m - mn); m = mn; lsum *= alpha;
#pragma unroll
        for (int d = 0; d < 4; ++d)
#pragma unroll
            for (int r = 0; r < 16; ++r) o[d][r] *= alpha;
    }
}

__device__ __forceinline__ void attn_unit(const Params& p, LAS unsigned char* lds, int head, int qb, int tid, int wave, int lane) {
    unsigned char* ws = p.ws;
    const bf16_t* Qh = (const bf16_t*)(ws + WS_QH); const bf16_t* Kh = (const bf16_t*)(ws + WS_KH);
    bf16_t* mix = (bf16_t*)(ws + WS_MIX);
    const int rg = wave & 3, kh = wave >> 2, r32 = lane & 31, hh = lane >> 5;
    const int q0row = qb * 128 + rg * 32;
    bf16x8 qr[12];
    {
        const bf16_t* qp = Qh + ((size_t)head * S + q0row + r32) * 192 + hh * 8;
#pragma unroll
        for (int ks = 0; ks < 12; ++ks) qr[ks] = *(const bf16x8*)(qp + ks * 16);
    }
    const int ntiles = 2 * qb + 2, mylast = 2 * qb + (rg >> 1);
    float m = -1e30f, lsum = 0.f; f32x16 o[4] = {};
    const int srow = tid >> 3, sch = tid & 7;
    const int kg0 = srow * 192 + sch * 8, kl0 = srow * KP + sch * 16, vg0 = srow * 2048 + sch * 8, vl0 = ATT_VOFF + srow * VP + sch * 16;
    const bf16_t* kbase = Kh + (size_t)head * S * 192; const bf16_t* vbase = (const bf16_t*)(ws + WS_KVRAW) + head * 256 + 128;
    u32x4 sk0, sk1, sk2, sv0, sv1;
#define ATT_LOAD(t) do { const bf16_t* kt = kbase + (size_t)(t) * 64 * 192 + kg0; const bf16_t* vt = vbase + (size_t)(t) * 64 * 2048 + vg0; \
        sk0 = *(const u32x4*)(kt); sk1 = *(const u32x4*)(kt + 64); sk2 = *(const u32x4*)(kt + 128); sv0 = *(const u32x4*)(vt); sv1 = *(const u32x4*)(vt + 64); } while (0)
#define ATT_WRITE(kb_, vb_) do { LAS unsigned char* bk = lds + (kb_) * ATT_KB + kl0; LAS unsigned char* bv = lds + (vb_) * ATT_VB + vl0; *(LAS u32x4*)(bk) = sk0; *(LAS u32x4*)(bk + 128) = sk1; *(LAS u32x4*)(bk + 256) = sk2; \
        *(LAS u32x4*)(bv) = sv0; *(LAS u32x4*)(bv + 128) = sv1; } while (0)
    const unsigned ldsbase = (unsigned)(size_t)lds;
    const unsigned kaddr0 = ldsbase + (unsigned)((32 * kh + r32) * KP + hh * 16);
    const unsigned vrel = (unsigned)(ATT_VOFF + (32 * kh + 4 * hh + ((lane & 15) >> 2)) * VP + (16 * ((lane >> 4) & 1) + 4 * (lane & 3)) * 2);
    ATT_LOAD(0); ATT_WRITE(0, 0); __syncthreads();
    bf16x8 pb0, pb1;
    const bool more0 = (1 < ntiles);
    if (more0) ATT_LOAD(1);
    f32x16 sprev = att_qk(kaddr0, qr);
    att_partial(sprev, m, lsum, o);
    if (more0) ATT_WRITE(1, 1);
    __syncthreads();
    int vprev = 0, vcur = 1;
#pragma unroll 1
    for (int t = 1; t <= ntiles; ++t) {
        const bool more = (t + 1 < ntiles);
        if (more) ATT_LOAD(t + 1);
        f32x16 sc;
        if (t <= mylast) sc = att_qk(kaddr0 + (t & 1) * ATT_KB, qr);
        else {
#pragma unroll
            for (int r = 0; r < 16; ++r) sc[r] = -1e30f;
        }
        att_finish(sprev, m, lsum, pb0, pb1);
        att_pv(ldsbase + vprev * ATT_VB + vrel, pb0, pb1, o);
        att_partial(sc, m, lsum, o);
        sprev = sc;
        const int vnext = (vcur == 2) ? 0 : vcur + 1;
        if (more) ATT_WRITE((t + 1) & 1, vnext);
        vprev = vcur; vcur = vnext;
        __syncthreads();
    }
#undef ATT_LOAD
#undef ATT_WRITE
    LAS float* scr = (LAS float*)lds + (size_t)rg * 66 * 64 + lane;
    if (kh == 1) {
        scr[0] = m; scr[64] = lsum;
#pragma unroll
        for (int d = 0; d < 4; ++d)
#pragma unroll
            for (int r = 0; r < 16; ++r) scr[(2 + d * 16 + r) * 64] = o[d][r];
    }
    __syncthreads();
    if (kh == 0) {
        const float m2 = scr[0], l2 = scr[64];
        const float mn = fmaxf(m, m2), a1 = __builtin_amdgcn_exp2f(m - mn), a2 = __builtin_amdgcn_exp2f(m2 - mn);
        const float inv = 1.0f / (lsum * a1 + l2 * a2);
        bf16_t* op = mix + (size_t)(q0row + r32) * DM + 1024 + head * 128 + 4 * hh;
#pragma unroll
        for (int d = 0; d < 4; ++d)
#pragma unroll
            for (int g4 = 0; g4 < 4; ++g4) {
                float v[4];
#pragma unroll
                for (int i = 0; i < 4; ++i) { const int r = 4 * g4 + i; v[i] = (o[d][r] * a1 + scr[(2 + d * 16 + r) * 64] * a2) * inv; }
                u32x2 w; w.x = pk2(v[0], v[1]); w.y = pk2(v[2], v[3]);
                *(u32x2*)(op + 32 * d + 8 * g4) = w;
            }
    }
    __syncthreads();
}

__device__ __forceinline__ void gmlp_unit(const Params& p, LAS unsigned char* lds, int nb, int h, int tid, int wave, int lane) {
    unsigned char* ws = p.ws;
    const bf16_t* proj = (const bf16_t*)(ws + WS_PROJ); bf16_t* mix = (bf16_t*)(ws + WS_MIX);
    const float* ssv = (const float*)(ws + WS_ROWSS);
    const float* vg = p.in[3]; const float* wsp = p.in[4]; const float* bs = p.in[5];
#pragma unroll
    for (int i = 0; i < 4; ++i) {
        const int pc = tid + 512 * i, r = pc >> 4, c = pc & 15, t = nb * 128 + r;
        const u32x4 w = *(const u32x4*)(proj + (size_t)t * NINP + 1024 + h * 128 + c * 8);
        const float rs = rsqrtf(ssv[t] * (1.0f / 1024.0f) + EPS);
        const f32x4 g0 = *(const f32x4*)(vg + h * 128 + c * 8), g1 = *(const f32x4*)(vg + h * 128 + c * 8 + 4);
        u32x4 ov;
        ov.x = pk2(bflo(w.x) * rs * g0[0], bfhi(w.x) * rs * g0[1]); ov.y = pk2(bflo(w.y) * rs * g0[2], bfhi(w.y) * rs * g0[3]);
        ov.z = pk2(bflo(w.z) * rs * g1[0], bfhi(w.z) * rs * g1[1]); ov.w = pk2(bflo(w.w) * rs * g1[2], bfhi(w.w) * rs * g1[3]);
        *(LAS u32x4*)(lds + r * VP + c * 16) = ov;
    }
    __syncthreads();
    const int ib = wave & 3, ch = wave >> 2, r32 = lane & 31, hh = lane >> 5;
    const int irow = 32 * ib + r32;
    f32x16 acc0 = {}, acc1 = {};
    const unsigned vaddr = (unsigned)(size_t)lds + (unsigned)((8 * hh + ((lane & 15) >> 2)) * VP + (64 * ch + 16 * ((lane >> 4) & 1) + 4 * (lane & 3)) * 2);
    const float* wrow = wsp + ((size_t)h * 128 + irow) * 128 + hh * 8;
#define GSTEP(s) do { if ((s) < 2 * (ib + 1)) { \
        const f32x4 wa = *(const f32x4*)(wrow + (s) * 16), wb = *(const f32x4*)(wrow + (s) * 16 + 4); const int j0 = (s) * 16 + hh * 8; \
        u32x4 aw; aw.x = pk2(j0 + 0 <= irow ? wa[0] : 0.f, j0 + 1 <= irow ? wa[1] : 0.f); aw.y = pk2(j0 + 2 <= irow ? wa[2] : 0.f, j0 + 3 <= irow ? wa[3] : 0.f); \
        aw.z = pk2(j0 + 4 <= irow ? wb[0] : 0.f, j0 + 5 <= irow ? wb[1] : 0.f); aw.w = pk2(j0 + 6 <= irow ? wb[2] : 0.f, j0 + 7 <= irow ? wb[3] : 0.f); \
        const bf16x8 af = __builtin_bit_cast(bf16x8, aw); \
        const s16x4 b0l = tr_read<(16 * (s)) * VP>(vaddr), b0h = tr_read<(16 * (s) + 4) * VP>(vaddr), b1l = tr_read<(16 * (s)) * VP + 64>(vaddr), b1h = tr_read<(16 * (s) + 4) * VP + 64>(vaddr); \
        LDS_WAIT(); SBAR(); \
        acc0 = __builtin_amdgcn_mfma_f32_32x32x16_bf16(af, PK8(b0l, b0h), acc0, 0, 0, 0); acc1 = __builtin_amdgcn_mfma_f32_32x32x16_bf16(af, PK8(b1l, b1h), acc1, 0, 0, 0); } } while (0)
    GSTEP(0); GSTEP(1); GSTEP(2); GSTEP(3); GSTEP(4); GSTEP(5); GSTEP(6); GSTEP(7);
#undef GSTEP
#pragma unroll
    for (int r = 0; r < 16; ++r) {
        const int i = 32 * ib + crow(r, hh), t = nb * 128 + i; const float b = bs[h * 128 + i];
        const int c0 = h * 128 + 64 * ch + r32;
        const float u0 = bf2f(proj[(size_t)t * NINP + c0]), u1 = bf2f(proj[(size_t)t * NINP + c0 + 32]);
        mix[(size_t)t * DM + c0] = (bf16_t)f2bf(u0 * (acc0[r] + b)); mix[(size_t)t * DM + c0 + 32] = (bf16_t)f2bf(u1 * (acc1[r] + b));
    }
    __syncthreads();
}

__device__ __forceinline__ void phase7(const Params& p, LAS unsigned char* lds, int gw, int NGW, int wave, int lane) {
    unsigned char* ws = p.ws;
    const float* sc = (const float*)(ws + WS_SC); int* ex = (int*)(ws + WS_EXP); float* gt = (float*)(ws + WS_GATE);
    const float NEG = -3.0e38f;
    LAS float* sl = (LAS float*)(lds + wave * 1024);
    const int j8 = lane & 7, g8 = lane >> 3, row = lane >> 4, i16 = lane & 15;
    int ci[4], cj[4]; bool cval[4];
    {
        constexpr int starts[16] = {0, 16, 24, 29, 33, 36, 38, 40, 42, 43, 44, 45, 46, 47, 48, 49};
#pragma unroll
        for (int m = 0; m < 4; ++m) {
            const int c = i16 + 16 * m; int a = 0, st = 0;
#pragma unroll
            for (int i = 1; i < 16; ++i) if (c >= starts[i]) { a = i; st = starts[i]; }
            cval[m] = c < 50; ci[m] = cval[m] ? a : 0; cj[m] = cval[m] ? (c - st) : 0;
        }
    }
    constexpr int NT = S * 2;
    f32x4 nx0, nx1, nx2, nx3;
    if (gw < NT) { const float* b = sc + (size_t)(gw >> 1) * DM + (gw & 1) * 1024 + lane * 16; nx0 = *(const f32x4*)b; nx1 = *(const f32x4*)(b + 4); nx2 = *(const f32x4*)(b + 8); nx3 = *(const f32x4*)(b + 12); }
    for (int it = gw; it < NT; it += NGW) {
        const int t = it >> 1, hh = it & 1;
        float v[16];
#pragma unroll
        for (int q = 0; q < 4; ++q) { v[q] = nx0[q]; v[4 + q] = nx1[q]; v[8 + q] = nx2[q]; v[12 + q] = nx3[q]; }
        if (it + NGW < NT) { const int it2 = it + NGW; const float* b = sc + (size_t)(it2 >> 1) * DM + (it2 & 1) * 1024 + lane * 16;
            nx0 = *(const f32x4*)b; nx1 = *(const f32x4*)(b + 4); nx2 = *(const f32x4*)(b + 8); nx3 = *(const f32x4*)(b + 12); }
#pragma unroll
        for (int m = 0; m < 16; ++m) v[m] = __builtin_bit_cast(float, (__builtin_bit_cast(unsigned, v[m]) & ~127u) | (unsigned)(16 * j8 + m));
        float ra = 0.f, rb = 0.f;
#pragma unroll
        for (int k = 0; k < 16; ++k) {
            float mx = fmaxf(fmaxf(fmaxf(v[0], v[1]), fmaxf(v[2], v[3])), fmaxf(fmaxf(v[4], v[5]), fmaxf(v[6], v[7])));
            mx = fmaxf(mx, fmaxf(fmaxf(fmaxf(v[8], v[9]), fmaxf(v[10], v[11])), fmaxf(fmaxf(v[12], v[13]), fmaxf(v[14], v[15]))));
            mx = fmaxf(mx, dpp_f<0xB1, 0xf>(mx, mx));
            mx = fmaxf(mx, dpp_f<0x4E, 0xf>(mx, mx));
            mx = fmaxf(mx, dpp_f<0x141, 0xf>(mx, mx));
#pragma unroll
            for (int m = 0; m < 16; ++m) v[m] = (v[m] == mx) ? NEG : v[m];
            if (k < 8) ra = (j8 == k) ? mx : ra; else rb = (j8 == k - 8) ? mx : rb;
        }
        sl[g8 * 16 + j8] = ra; sl[g8 * 16 + 8 + j8] = rb;
        LDS_WAIT(); asm volatile("" ::: "memory");
        float cv[4], og[4]; int id[4];
#pragma unroll
        for (int m = 0; m < 4; ++m) {
            const float s1 = sl[(2 * row) * 16 + ci[m]], s2 = sl[(2 * row + 1) * 16 + cj[m]];
            og[m] = cval[m] ? (s1 + s2) : NEG; cv[m] = og[m];
            id[m] = (int)((__builtin_bit_cast(unsigned, s1) & 127u) * 128u + (__builtin_bit_cast(unsigned, s2) & 127u));
        }
        LDS_WAIT(); asm volatile("" ::: "memory");
        float M0 = 0.f;
#pragma unroll
        for (int k = 0; k < 16; ++k) {
            float mx = fmaxf(fmaxf(cv[0], cv[1]), fmaxf(cv[2], cv[3]));
            mx = fmaxf(mx, dpp_f<0xB1, 0xf>(mx, mx));
            mx = fmaxf(mx, dpp_f<0x4E, 0xf>(mx, mx));
            mx = fmaxf(mx, dpp_f<0x141, 0xf>(mx, mx));
            mx = fmaxf(mx, dpp_f<0x140, 0xf>(mx, mx));
            if (k == 0) M0 = mx;
#pragma unroll
            for (int m = 0; m < 4; ++m) cv[m] = (cv[m] == mx) ? NEG : cv[m];
        }
        bool sel[4]; float e[4]; float es = 0.f;
#pragma unroll
        for (int m = 0; m < 4; ++m) { sel[m] = (cv[m] != og[m]); e[m] = sel[m] ? __expf(og[m] - M0) : 0.f; es += e[m]; }
        es += dpp_f<0xB1, 0xf>(0.f, es); es += dpp_f<0x4E, 0xf>(0.f, es); es += dpp_f<0x141, 0xf>(0.f, es); es += dpp_f<0x140, 0xf>(0.f, es);
        const float inv = 1.0f / es;
        int basepos = 0;
        const int head = 4 * hh + row;
#pragma unroll
        for (int m = 0; m < 4; ++m) {
            const unsigned long long bl = __ballot(sel[m]);
            const unsigned rbits = (unsigned)(bl >> (16 * row)) & 0xffffu;
            const int pos = basepos + __popc(rbits & ((1u << i16) - 1u));
            if (sel[m] && pos < 16) { ex[(size_t)t * 128 + head * 16 + pos] = id[m]; gt[(size_t)t * 128 + head * 16 + pos] = e[m] * inv; }
            basepos += __popc(rbits);
        }
    }
}

typedef __bf16 bf16x32v __attribute__((ext_vector_type(32)));
typedef __bf16 bf16x2v __attribute__((ext_vector_type(2)));
typedef float f32x2 __attribute__((ext_vector_type(2)));
#ifndef P8_THROTTLE
#define P8_THROTTLE 0
#endif
constexpr unsigned P8_SLACK = 12;
__device__ __forceinline__ void phase8(const Params& p, LAS unsigned char* lds, float* dst, unsigned xcc, unsigned nwx, int gw, int NGW, int wave, int lane) {
    unsigned char* ws = p.ws;
    const bf16_t* x1b = (const bf16_t*)(ws + WS_X1B); const unsigned char* UT = ws + WS_UT; const unsigned char* VT = ws + WS_VT;
    const int* ex = (const int*)(ws + WS_EXP); const float* gt = (const float*)(ws + WS_GATE); const float* ss2 = (const float*)(ws + WS_ROWSS) + 3 * S;
    const float* out = p.out;
    LAS unsigned* list = (LAS unsigned*)(lds + 131072 + wave * 2048);
    LAS unsigned* hist = (LAS unsigned*)(lds + 147456 + wave * 1024);
    for (int tb = gw; tb < S / 4; tb += NGW) {
        const int t0 = tb * 4;
        int id[8]; float gv[8];
#pragma unroll
        for (int r = 0; r < 8; ++r) { const size_t o = (size_t)(t0 + (r >> 1)) * 128 + (r & 1) * 64 + lane; id[r] = ex[o]; gv[r] = gt[o]; }
        const float rs0 = rsqrtf(ss2[t0 + 0] * (1.0f / DM) + EPS) * (1.0f / PEER_USC), rs1 = rsqrtf(ss2[t0 + 1] * (1.0f / DM) + EPS) * (1.0f / PEER_USC);
        const float rs2 = rsqrtf(ss2[t0 + 2] * (1.0f / DM) + EPS) * (1.0f / PEER_USC), rs3 = rsqrtf(ss2[t0 + 3] * (1.0f / DM) + EPS) * (1.0f / PEER_USC);
#pragma unroll
        for (int j = 0; j < 4; ++j) hist[j * 64 + lane] = 0u;
        LDS_WAIT(); asm volatile("" ::: "memory");
        unsigned pos[8];
#pragma unroll
        for (int r = 0; r < 8; ++r) pos[r] = __hip_atomic_fetch_add(hist + (r >> 1) * 64 + (id[r] >> 8), 1u, __ATOMIC_RELAXED, __HIP_MEMORY_SCOPE_WORKGROUP);
        LDS_WAIT(); asm volatile("" ::: "memory");
        unsigned cnt[4], inc[4];
#pragma unroll
        for (int j = 0; j < 4; ++j) { cnt[j] = hist[j * 64 + lane]; inc[j] = cnt[j]; }
#pragma unroll
        for (int o = 1; o < 64; o <<= 1)
#pragma unroll
            for (int j = 0; j < 4; ++j) { const unsigned n = __shfl_up(inc[j], o); if (lane >= o) inc[j] += n; }
        LDS_WAIT(); asm volatile("" ::: "memory");
#pragma unroll
        for (int j = 0; j < 4; ++j) hist[j * 64 + lane] = inc[j] - cnt[j];
        LDS_WAIT(); asm volatile("" ::: "memory");
#pragma unroll
        for (int r = 0; r < 8; ++r) { const unsigned d = hist[(r >> 1) * 64 + (id[r] >> 8)] + pos[r]; list[4u * d + (unsigned)(r >> 1)] = (unsigned)id[r] | ((unsigned)(r >> 1) << 14) | (f2bf(gv[r]) << 16); }
        LDS_WAIT(); asm volatile("" ::: "memory");
        {
            typedef unsigned u32x16 __attribute__((ext_vector_type(16)));
            const __amdgpu_buffer_rsrc_t urs = __builtin_amdgcn_make_buffer_rsrc((void*)UT, 0, 16384 * PEER_ROWB, 0x00020000);
            const int vo4 = lane * 16, vo2 = lane * 8 + 1024;
            const bool lb0 = (lane & 1) != 0, lb1 = (lane & 2) != 0, lb2 = (lane & 4) != 0;
            s16x4 xr[4][8];
#pragma unroll
            for (int j = 0; j < 4; ++j)
#pragma unroll
                for (int q = 0; q < 8; ++q) xr[j][q] = __builtin_bit_cast(s16x4, *(const u32x2*)(x1b + (size_t)(t0 + j) * DM + (q * 64 + lane) * 4));
#define P8_ULOAD(k, i) do { const unsigned en = (unsigned)__builtin_amdgcn_readfirstlane((int)list[(i)]); const int ro = (int)((en & 0x3fffu) * (unsigned)PEER_ROWB); \
            u4[k] = __builtin_amdgcn_raw_buffer_load_b128(urs, vo4, ro, 0); u2[k] = __builtin_amdgcn_raw_buffer_load_b64(urs, vo2, ro, 0); } while (0)
#define P8_UPROC2(k, dk) do { const u32x6 pk = {u4[k][0], u4[k][1], u4[k][2], u4[k][3], u2[k][0], u2[k][1]}; \
            const u32x16 r_ = __builtin_bit_cast(u32x16, __builtin_amdgcn_cvt_scalef32_pk32_bf16_fp6(pk, 1.0f)); \
            f32x4 a0 = {0.f, 0.f, 0.f, 0.f}, a1 = {0.f, 0.f, 0.f, 0.f}; \
            _Pragma("unroll") for (int q = 0; q < 8; q += 2) { \
                a0 = __builtin_amdgcn_mfma_f32_4x4x4bf16_1k(__builtin_bit_cast(s16x4, (u32x2){r_[2 * q], r_[2 * q + 1]}), xr[(k) & 3][q], a0, 0, 0, 0); \
                a1 = __builtin_amdgcn_mfma_f32_4x4x4bf16_1k(__builtin_bit_cast(s16x4, (u32x2){r_[2 * q + 2], r_[2 * q + 3]}), xr[(k) & 3][q + 1], a1, 0, 0, 0); } \
            const f32x4 a_ = a0 + a1; \
            const float e0 = lb0 ? a_[1] : a_[0], e1 = lb0 ? a_[3] : a_[2]; dd[dk] = lb1 ? e1 : e0; } while (0)
#ifndef P8_URING
#define P8_URING 8
#endif
#if (PROBE_DUP >> 10) & 1
#define P8_UREPS 2
#else
#define P8_UREPS 1
#endif
#pragma unroll 1
            for (int urep = 0; urep < P8_UREPS; ++urep) {
                u32x4 u4[P8_URING]; u32x2 u2[P8_URING];
#pragma unroll
                for (int k = 0; k < P8_URING; ++k) P8_ULOAD(k, k);
#pragma unroll 1
                for (int i0 = 0; i0 < 512; i0 += P8_URING) {
#pragma unroll
                    for (int hb = 0; hb < P8_URING / 8; ++hb) {
                        const int i = i0 + 8 * hb;
                        const unsigned ev = list[i + (lane & 7)]; const unsigned jl = (unsigned)lane & 3u;
                        const float gl = __builtin_bit_cast(float, ev & 0xffff0000u), rl = jl == 0u ? rs0 : (jl == 1u ? rs1 : (jl == 2u ? rs2 : rs3));
                        float dd[8];
#pragma unroll
                        for (int k = 0; k < 8; ++k) { P8_UPROC2(8 * hb + k, k); const int nx = i + P8_URING + k; P8_ULOAD(8 * hb + k, nx < 512 ? nx : 508 + (k & 3)); }
                        float w4[4], w2[2];
#pragma unroll
                        for (int q = 0; q < 4; ++q) { const float kp = lb2 ? dd[q + 4] : dd[q], sd = lb2 ? dd[q] : dd[q + 4]; w4[q] = kp + __shfl_xor(sd, 4); }
#pragma unroll
                        for (int q = 0; q < 2; ++q) { const float kp = lb1 ? w4[q + 2] : w4[q], sd = lb1 ? w4[q] : w4[q + 2]; w2[q] = kp + __shfl_xor(sd, 2); }
                        float dres; { const float kp = lb0 ? w2[1] : w2[0], sd = lb0 ? w2[0] : w2[1]; dres = kp + __shfl_xor(sd, 1); }
                        dres += __shfl_xor(dres, 8); dres += __shfl_xor(dres, 16); dres += __shfl_xor(dres, 32);
                        const float c_ = gl * gelu_tanh(rl * dres) * (1.0f / PEER_VSC);
                        if (lane < 8 && urep == P8_UREPS - 1) list[i + lane] = (ev & 0xffffu) | (f2bf(c_) << 16);
                    }
                }
            }
#undef P8_ULOAD
#undef P8_UPROC2
        }
        asm volatile("s_waitcnt vmcnt(0)" ::: "memory");
        LDS_WAIT(); asm volatile("" ::: "memory");
        f32x4 acc[4][8];
#if (PROBE_DUP >> 12) & 1
#define P8_VREPS 2
#else
#define P8_VREPS 1
#endif
#ifndef P8_VRING
#define P8_VRING 8
#endif
#pragma unroll 1
        for (int vrep = 0; vrep < P8_VREPS; ++vrep) {
#pragma unroll
        for (int j = 0; j < 4; ++j)
#pragma unroll
            for (int q = 0; q < 8; ++q) acc[j][q] = (f32x4){0.f, 0.f, 0.f, 0.f};
        {
            typedef unsigned u32x16 __attribute__((ext_vector_type(16)));
            u32x4 v4[P8_VRING]; u32x2 v2[P8_VRING]; unsigned ven[P8_VRING];
            const unsigned li = (unsigned)lane & 3u;
            const unsigned m0 = li == 0u ? 0x0000ffffu : (li == 1u ? 0xffff0000u : 0u), m1 = li == 2u ? 0x0000ffffu : (li == 3u ? 0xffff0000u : 0u);
            const __amdgpu_buffer_rsrc_t vrs = __builtin_amdgcn_make_buffer_rsrc((void*)VT, 0, 16384 * PEER_ROWB, 0x00020000);
            const int vo4 = lane * 16, vo2 = lane * 8 + 1024;
#define P8_VLOAD(k, i) do { const unsigned en = (unsigned)__builtin_amdgcn_readfirstlane((int)list[(i)]); ven[k] = en; const int ro = (int)((en & 0x3fffu) * (unsigned)PEER_ROWB); \
            v4[k] = __builtin_amdgcn_raw_buffer_load_b128(vrs, vo4, ro, 0); v2[k] = __builtin_amdgcn_raw_buffer_load_b64(vrs, vo2, ro, 0); } while (0)
#define P8_VPROC(k) do { const u32x6 pk = {v4[k][0], v4[k][1], v4[k][2], v4[k][3], v2[k][0], v2[k][1]}; \
            const u32x16 r_ = __builtin_bit_cast(u32x16, __builtin_amdgcn_cvt_scalef32_pk32_bf16_fp6(pk, 1.0f)); \
            const unsigned e_ = ven[k], cf = (e_ >> 16) | (e_ & 0xffff0000u); \
            const s16x4 av = __builtin_bit_cast(s16x4, (u32x2){cf & m0, cf & m1}); \
            _Pragma("unroll") for (int q = 0; q < 8; ++q) \
                acc[(k) & 3][q] = __builtin_amdgcn_mfma_f32_4x4x4bf16_1k(av, __builtin_bit_cast(s16x4, (u32x2){r_[2 * q], r_[2 * q + 1]}), acc[(k) & 3][q], 0, 0, 0); } while (0)
#pragma unroll
            for (int k = 0; k < P8_VRING; ++k) P8_VLOAD(k, k);
#pragma unroll 1
            for (int i = 0; i < 512 - 512 % P8_VRING; i += P8_VRING) {
#pragma unroll
                for (int k = 0; k < P8_VRING; ++k) { P8_VPROC(k); const int nx = i + P8_VRING + k; P8_VLOAD(k, nx < 512 ? nx : 508 + (k & 3)); }
            }
#pragma unroll
            for (int k = 0; k < 512 % P8_VRING; ++k) P8_VPROC(k);
#undef P8_VLOAD
#undef P8_VPROC
        }
        }
        int tq = t0, lq = lane; asm volatile("" : "+s"(tq)); asm volatile("" : "+v"(lq));
#pragma unroll
        for (int j = 0; j < 4; ++j)
#pragma unroll
            for (int i = 0; i < 8; ++i) {
                const size_t o = (size_t)(tq + j) * DM + (i * 64 + lq) * 4;
                f32x4 a = *(const f32x4*)(out + o);
                a += acc[j][i];
                *(f32x4*)(dst + o) = a;
                if (i & 1) asm volatile("" ::: "memory");
            }
        LDS_WAIT(); asm volatile("" ::: "memory");
    }
}

__global__ void __launch_bounds__(NTHREADS, 2) mega(Params p) {
    extern __shared__ __attribute__((aligned(16))) unsigned char lds_raw[];
    LAS unsigned char* lds = (LAS unsigned char*)lds_raw;
    const int tid = threadIdx.x, lane = tid & 63, wave = __builtin_amdgcn_readfirstlane(tid >> 6);
    const int G = gridDim.x, bx = blockIdx.x;
    const int gw = bx * 8 + wave, NGW = G * 8;
    unsigned char* ws = p.ws;
    const int lo = p.ph_lo, hi = p.ph_hi;
    volatile LAS unsigned* misc = (volatile LAS unsigned*)(lds + LDS_MISC);
    if (tid < 4) misc[tid] = 0u;
    __syncthreads();
    const XcdBarrier xbar = xcd_barrier_post((unsigned*)(ws + WS_CTL), misc);
#ifndef PH_MASK
#define PH_MASK 0x1ff
#endif
#define IN(k) (((PH_MASK >> (k)) & 1) && lo <= (k) && (k) < hi)
#define SEAM(k) do { if (IN(k) && IN((k) + 1)) xcd_barrier(xbar); } while (0)

#if (PROBE_DUP >> 0) & 1
    if (IN(0)) { phase0(p, lds, G == 256, gw, NGW, wave, lane); xcd_barrier(xbar); }
#endif
    if (IN(0)) phase0(p, lds, G == 256, gw, NGW, wave, lane);
    SEAM(0);
    if (IN(1)) {
        pg8::Gemm g{(const bf16_t*)(ws + WS_XB), (const bf16_t*)(ws + WS_WIN), S, NINP, DM, DM, DM};
        pg8::StaticOrder So; So.init(S, NINP, G, bx);
        pg8::Epi<1> E{(const float*)(ws + WS_RSTD1), 0.f, (float*)(ws + WS_ROWSS), (bf16_t*)(ws + WS_PROJ), NINP, nullptr, nullptr};
#if (PROBE_DUP >> 1) & 1
        { pg8::Epi<1> E2 = E; E2.ss = (float*)(ws + 512 * 1024); pg8::gemm_phase<pg8::Epi<1>, pg8::StaticOrder, true, true>(lds, g, So, E2); xcd_barrier(xbar); }
#endif
        pg8::gemm_phase<pg8::Epi<1>, pg8::StaticOrder, true, true>(lds, g, So, E);
        if (G == 256 && bx >= 128) { __syncthreads(); prep_late(p, lds, (bx - 128) * 8 + wave, 1024, wave, lane); }
    }
    SEAM(1);
    if (IN(2)) {
        {
            pg8::Gemm g{(const bf16_t*)(ws + WS_PROJ) + 2048, (const bf16_t*)(ws + WS_WUQ), S, 1536, 512, NINP, 512};
            pg8::StaticOrder So; So.init(S, 1536, G, bx);
            pg8::Epi<2> E{(const float*)(ws + WS_ROWSS) + 1 * S, 1.0f / 512.0f, nullptr, (bf16_t*)(ws + WS_QRAW), 1536, nullptr, nullptr};
            pg8::gemm_phase<pg8::Epi<2>, pg8::StaticOrder, true, true>(lds, g, So, E);
        }
        __syncthreads();
        {
            pg8::Gemm g{(const bf16_t*)(ws + WS_PROJ) + 2560, (const bf16_t*)(ws + WS_WUKV), S, 2048, 256, NINP, 256};
            pg8::StaticOrder So; So.init(S, 2048, G, bx);
            pg8::Epi<2> E{(const float*)(ws + WS_ROWSS) + 2 * S, 1.0f / 256.0f, nullptr, (bf16_t*)(ws + WS_KVRAW), 2048, nullptr, nullptr};
            pg8::gemm_phase<pg8::Epi<2>, pg8::StaticOrder, true, true>(lds, g, So, E);
        }
    }
    SEAM(2);
#if (PROBE_DUP >> 3) & 1
    if (IN(3)) { phase3(p, gw, NGW, lane); xcd_barrier(xbar); }
#endif
    if (IN(3)) phase3(p, gw, NGW, lane);
    SEAM(3);
#define P4_BODY_ATT for (int pr = bx; pr < 256; pr += G) { const int head = pr & 7, x = pr >> 3; attn_unit(p, lds, head, 63 - x, tid, wave, lane); attn_unit(p, lds, head, x, tid, wave, lane); }
#define P4_BODY_GMLP for (int u = bx; u < 512; u += G) gmlp_unit(p, lds, u >> 3, u & 7, tid, wave, lane);
#if (PROBE_DUP >> 4) & 1
    if (IN(4)) { P4_BODY_ATT; xcd_barrier(xbar); }
#endif
#if (PROBE_DUP >> 9) & 1
    if (IN(4)) { P4_BODY_GMLP; xcd_barrier(xbar); }
#endif
    if (IN(4)) { P4_BODY_ATT; P4_BODY_GMLP; }
    SEAM(4);
    if (IN(5)) {
        pg8::Gemm g{(const bf16_t*)(ws + WS_MIX), (const bf16_t*)(ws + WS_WOUT), S, DM, DM, DM, DM};
        pg8::StaticOrder So; So.init(S, DM, G, bx);
        pg8::Epi<4> E{nullptr, 0.f, (float*)(ws + WS_ROWSS) + 3 * S, (bf16_t*)(ws + WS_X1B), DM, p.out, p.in[0]};
#if (PROBE_DUP >> 5) & 1
        { pg8::Epi<4> E2 = E; E2.ss = (float*)(ws + 512 * 1024); pg8::gemm_phase<pg8::Epi<4>, pg8::StaticOrder, true, true>(lds, g, So, E2); xcd_barrier(xbar); }
#endif
        pg8::gemm_phase<pg8::Epi<4>, pg8::StaticOrder, true, true>(lds, g, So, E);
    }
    SEAM(5);
    if (IN(6)) {
        pg8::Gemm g{(const bf16_t*)(ws + WS_X1B), (const bf16_t*)(ws + WS_WS), S, DM, DM, DM, DM};
        pg8::StaticOrder So; So.init(S, DM, G, bx);
        pg8::Epi<5> E{(const float*)(ws + WS_ROWSS) + 3 * S, 1.0f / DM, nullptr, nullptr, DM, (float*)(ws + WS_SC), nullptr};
#if (PROBE_DUP >> 6) & 1
        { pg8::gemm_phase<pg8::Epi<5>, pg8::StaticOrder, true, true>(lds, g, So, E); xcd_barrier(xbar); }
#endif
        pg8::gemm_phase<pg8::Epi<5>, pg8::StaticOrder, true, true>(lds, g, So, E);
    }
    SEAM(6);
#if (PROBE_DUP >> 7) & 1
    if (IN(7)) { phase7(p, lds, gw, NGW, wave, lane); xcd_barrier(xbar); }
#endif
    if (IN(7)) phase7(p, lds, gw, NGW, wave, lane);
    SEAM(7);
#if (PROBE_DUP >> 8) & 1
    if (IN(8)) { phase8(p, lds, (float*)(ws + WS_SC), xbar.x, 8u * misc[0], gw, NGW, wave, lane); xcd_barrier(xbar); }
#endif
    if (IN(8)) phase8(p, lds, p.out, xbar.x, 8u * misc[0], gw, NGW, wave, lane);
#undef IN
#undef SEAM
}

extern "C" void kernel_launch(void* const* d_in, const int* in_sizes, int n_in, void* d_out, int out_size, void* d_ws, size_t ws_size, hipStream_t stream) {
    static int grid = 0;
    if (grid == 0) {
        if (n_in != 18 || out_size != S * DM || ws_size < WS_END) { fprintf(stderr, "kernel_launch: unexpected shapes (n_in %d out %d ws %zu)\n", n_in, out_size, ws_size); grid = -1; return; }
        int dev = 0, cus = 0, per_cu = 0;
        hipGetDevice(&dev);
        hipDeviceGetAttribute(&cus, hipDeviceAttributeMultiprocessorCount, dev);
        if (hipFuncSetAttribute((const void*)mega, hipFuncAttributeMaxDynamicSharedMemorySize, LDS_BYTES) != hipSuccess) { fprintf(stderr, "kernel_launch: hipFuncSetAttribute failed\n"); grid = -1; return; }
        if (hipOccupancyMaxActiveBlocksPerMultiprocessor(&per_cu, (const void*)mega, NTHREADS, LDS_BYTES) != hipSuccess || per_cu < 1) { fprintf(stderr, "kernel_launch: occupancy query failed (%d)\n", per_cu); grid = -1; return; }
        grid = cus;
        fprintf(stderr, "kernel_launch: cus %d per_cu %d grid %d\n", cus, per_cu, grid);
    }
    if (grid < 0) return;
    hipMemsetAsync((char*)d_ws + WS_CTL, 0, 1 * MiB, stream);
    Params prm{};
    for (int i = 0; i < 18; ++i) prm.in[i] = (const float*)d_in[i];
    prm.out = (float*)d_out; prm.ws = (unsigned char*)d_ws;
#if MK_ONE_LAUNCH
    prm.ph_lo = 0; prm.ph_hi = NPH;
    { void* args[] = {&prm}; hipError_t e = hipLaunchCooperativeKernel((const void*)mega, dim3(grid), dim3(NTHREADS), args, LDS_BYTES, stream);
      if (e != hipSuccess) fprintf(stderr, "cooperative launch failed: %s\n", hipGetErrorString(e)); }
#else
    for (int ph = 0; ph < NPH; ++ph) {
        prm.ph_lo = ph; prm.ph_hi = ph + 1;
        void* args[] = {&prm};
        hipError_t e = hipLaunchCooperativeKernel((const void*)mega, dim3(grid), dim3(NTHREADS), args, LDS_BYTES, stream);
        if (e != hipSuccess) { fprintf(stderr, "cooperative launch %d failed: %s\n", ph, hipGetErrorString(e)); break; }
    }
#endif
}
```

```cpp
#include <hip/hip_runtime.h>
#include <cstdio>
#include <cstdint>

#define LAS __attribute__((address_space(3)))
typedef unsigned short bf16_t;
typedef short bf16x8 __attribute__((ext_vector_type(8)));
typedef short s16x4 __attribute__((ext_vector_type(4)));
typedef float f32x4 __attribute__((ext_vector_type(4)));
typedef float f32x16 __attribute__((ext_vector_type(16)));
typedef unsigned u32x4 __attribute__((ext_vector_type(4)));
typedef unsigned u32x2 __attribute__((ext_vector_type(2)));

#ifndef PROBE_DUP
#define PROBE_DUP 0
#endif
#ifndef MK_ONE_LAUNCH
#define MK_ONE_LAUNCH 1
#endif

constexpr int S = 8192, DM = 2048, NIN = 2880, NINP = 3072;
constexpr int NPH = 9;
constexpr float EPS = 1e-6f;
constexpr int LDS_BYTES = 163840;
constexpr int NTHREADS = 512;
constexpr int LDS_MISC = 161792;

constexpr size_t MiB = 1u << 20;
constexpr size_t WS_CTL = 0;
constexpr size_t WS_ROWSS = 128 * 1024;
constexpr size_t WS_COS = 1 * MiB, WS_SIN = 2 * MiB;
constexpr size_t WS_RSTD1 = 3 * MiB;
constexpr size_t WS_EXP = 4 * MiB;
constexpr size_t WS_GATE = 8 * MiB;
constexpr size_t WS_WIN = 12 * MiB;
constexpr size_t WS_WUQ = 24 * MiB;
constexpr size_t WS_WUKV = 26 * MiB;
constexpr size_t WS_WOUT = 28 * MiB;
constexpr size_t WS_WS = 36 * MiB;
constexpr size_t WS_XB = 44 * MiB;
constexpr size_t WS_PROJ = 76 * MiB;
constexpr size_t WS_QRAW = 124 * MiB;
constexpr size_t WS_KVRAW = 148 * MiB;
constexpr size_t WS_QH = 180 * MiB;
constexpr size_t WS_KH = 204 * MiB;
constexpr size_t WS_VH = 228 * MiB;
constexpr size_t WS_MIX = 244 * MiB;
constexpr size_t WS_X1B = 276 * MiB;
constexpr size_t WS_SC = 308 * MiB;
constexpr size_t WS_UT = 372 * MiB;
constexpr size_t WS_VT = 436 * MiB;
constexpr size_t WS_END = 500 * MiB;

__device__ __forceinline__ unsigned f2bf(float f) { unsigned u = __builtin_bit_cast(unsigned, f); return (u + 0x7fffu + ((u >> 16) & 1u)) >> 16; }
__device__ __forceinline__ unsigned pk2(float lo, float hi) { return f2bf(lo) | (f2bf(hi) << 16); }
__device__ __forceinline__ float bf2f(unsigned short b) { return __builtin_bit_cast(float, (unsigned)b << 16); }
__device__ __forceinline__ float bflo(unsigned w) { return __builtin_bit_cast(float, w << 16); }
__device__ __forceinline__ float bfhi(unsigned w) { return __builtin_bit_cast(float, w & 0xffff0000u); }
__device__ __forceinline__ float wave_sum(float v) {
#pragma unroll
    for (int o = 32; o > 0; o >>= 1) v += __shfl_xor(v, o);
    return v;
}
__device__ __forceinline__ float wave_max(float v) {
#pragma unroll
    for (int o = 32; o > 0; o >>= 1) v = fmaxf(v, __shfl_xor(v, o));
    return v;
}
template <int CTRL, int ROW_MASK> __device__ __forceinline__ float dpp_f(float old, float v) {
    return __builtin_bit_cast(float, __builtin_amdgcn_update_dpp(__builtin_bit_cast(int, old), __builtin_bit_cast(int, v), CTRL, ROW_MASK, 0xf, false));
}
__device__ __forceinline__ float wave_max_u(float v) {
    v = fmaxf(v, dpp_f<0xB1, 0xf>(v, v));
    v = fmaxf(v, dpp_f<0x4E, 0xf>(v, v));
    v = fmaxf(v, dpp_f<0x141, 0xf>(v, v));
    v = fmaxf(v, dpp_f<0x140, 0xf>(v, v));
    v = fmaxf(v, dpp_f<0x142, 0xa>(v, v));
    v = fmaxf(v, dpp_f<0x143, 0xc>(v, v));
    return __builtin_bit_cast(float, __builtin_amdgcn_readlane(__builtin_bit_cast(int, v), 63));
}
__device__ __forceinline__ float wave_sum_u(float v) {
    v += dpp_f<0xB1, 0xf>(0.f, v);
    v += dpp_f<0x4E, 0xf>(0.f, v);
    v += dpp_f<0x141, 0xf>(0.f, v);
    v += dpp_f<0x140, 0xf>(0.f, v);
    v += dpp_f<0x142, 0xa>(0.f, v);
    v += dpp_f<0x143, 0xc>(0.f, v);
    return __builtin_bit_cast(float, __builtin_amdgcn_readlane(__builtin_bit_cast(int, v), 63));
}
__device__ __forceinline__ float gelu_tanh(float x) {
    const float y = 0.7978845608028654f * (x + 0.044715f * x * x * x);
    return x / (1.0f + __expf(-2.0f * y));
}
__device__ __forceinline__ int crow(int r, int hi) { return (r & 3) + 8 * (r >> 2) + 4 * hi; }
#define LDS_WAIT() asm volatile("s_waitcnt lgkmcnt(0)" ::: "memory")
#define SBAR() __builtin_amdgcn_sched_barrier(0)

namespace pg8 {
#define PG8_LAS __attribute__((address_space(3)))
constexpr int BM = 256, BK = 64, HALF = 128, HTB = HALF * BK * 2  , STAGE_BYTES = 8 * HTB, NXCD = 8, WGM = 8;

__host__ __device__ __forceinline__ int lds_byte(int r, int c) { const int st = (r >> 4) * 2 + (c >> 5), rr = r & 15, cc = c & 31, ob = rr * 64 + cc * 2; return st * 1024 + (ob ^ (((ob >> 9) & 1) << 5)); }
__host__ __device__ __forceinline__ void stage_rc(int b, int& R, int& C) { const int st = b / 1024, sb = b % 1024, swz = sb ^ (((sb >> 9) & 1) << 5); R = (st >> 1) * 16 + swz / 64; C = (st & 1) * 32 + (swz % 64) / 2; }
__host__ __device__ __forceinline__ int perm32(int rho) { const int n = rho >> 4, i = rho & 15; return 8 * (i >> 2) + 4 * n + (i & 3); }

struct Unit { int pm, pn; };
struct Gemm { const bf16_t* A; const bf16_t* Bt; int M, N, K, lda, ldb; };

struct StaticOrder {
    int nM, nN, nwg, G, c;
    __host__ __device__ void init(int M, int N, int G_, int c_) { nM = M / BM; nN = N / BM; nwg = nM * nN; G = G_; c = c_; }
    __host__ __device__ bool next(int i, Unit& u) const {
        const long L = (long)i * G + c; if (L >= nwg) return false;
        int wgid = (int)L; { const int q = nwg / NXCD, r = nwg % NXCD, xcd = wgid % NXCD, off = wgid / NXCD; wgid = (xcd < r ? xcd * (q + 1) : r * (q + 1) + (xcd - r) * q) + off; }
        const int nig = WGM * nN, gid = wgid / nig, fm = gid * WGM, gsz = (nM - fm) < WGM ? (nM - fm) : WGM;
        u.pm = fm + ((wgid % nig) % gsz); u.pn = (wgid % nig) / gsz; return true;
    }
    __device__ __forceinline__ void a_ready(const Unit&) const {}
    __device__ __forceinline__ void done(const Unit&) const {}
};

template <class Epi, class Sched, bool ALIGN_EPI = false, bool SP2 = false>
__device__ __forceinline__ void gemm_phase(PG8_LAS unsigned char* lds, const Gemm g, const Sched& S, const Epi& E) {
    const int tid = threadIdx.x, wid = __builtin_amdgcn_readfirstlane(tid >> 6), lane = tid & 63, wr = wid >> 2, wc = wid & 3, fr = lane & 15, fq = lane >> 4;
    const int K = g.K, nt = K / BK;
    unsigned voffA[2], voffB[2];
#pragma unroll
    for (int i = 0; i < 2; ++i) { int R, C; stage_rc(tid * 16 + i * 8192, R, C); const int Rb = Epi::PERM ? ((R & ~31) + perm32(R & 31)) : R;
        voffA[i] = (unsigned)(R * g.lda + C) * 2u; voffB[i] = (unsigned)(Rb * g.ldb + C) * 2u; }
    const size_t kstep = (size_t)(BK * 2);
    const size_t hstepA = (size_t)HALF * g.lda * 2, hstepB = (size_t)HALF * g.ldb * 2;
    const size_t tstepA = 2 * hstepA, tstepB = 2 * hstepB;
    const unsigned ldsw = (unsigned)wid * 1024u;
    const int aoff = lds_byte(wr * 64 + fr, fq * 8), boff = lds_byte(wc * 32 + fr, fq * 8);
#define PG8_SA(b, h) (((b) * 2 + (h)) * HTB)
#define PG8_SB(b, h) ((4 + (b) * 2 + (h)) * HTB)
#define PG8_STAGE(bufoff, gbase, voff) do { _Pragma("unroll") for (int _i = 0; _i < 2; ++_i) \
        __builtin_amdgcn_global_load_lds((const unsigned*)((const char*)(gbase) + (voff)[_i]), (PG8_LAS unsigned*)(lds + (bufoff) + ldsw + _i * 8192), 16, 0, 0); } while (0)
#define PG8_LDA(dst, b, h) do { _Pragma("unroll") for (int m = 0; m < 4; ++m) _Pragma("unroll") for (int k = 0; k < 2; ++k) dst[m][k] = *(const PG8_LAS bf16x8*)(lds + PG8_SA(b, h) + aoff + m * 2048 + k * 1024); } while (0)
#define PG8_LDB(dst, b, h) do { _Pragma("unroll") for (int n = 0; n < 2; ++n) _Pragma("unroll") for (int k = 0; k < 2; ++k) dst[n][k] = *(const PG8_LAS bf16x8*)(lds + PG8_SB(b, h) + boff + n * 2048 + k * 1024); } while (0)
#define PG8_MMA(ai, bj, At, Bt) do { __builtin_amdgcn_s_setprio(1); _Pragma("unroll") for (int m = 0; m < 4; ++m) _Pragma("unroll") for (int n = 0; n < 2; ++n) _Pragma("unroll") for (int k = 0; k < 2; ++k) \
        acc[ai][bj][m][n] = __builtin_amdgcn_mfma_f32_16x16x32_bf16(Bt[n][k], At[m][k], acc[ai][bj][m][n], 0, 0, 0); __builtin_amdgcn_s_setprio(0); } while (0)
#define PG8_WAIT_V(n) asm volatile("s_waitcnt vmcnt(" #n ")" ::: "memory")
#define PG8_WAIT_L(n) asm volatile("s_waitcnt lgkmcnt(" #n ")" ::: "memory")
#define PG8_BAR __builtin_amdgcn_s_barrier()
#define PG8_SCHED __builtin_amdgcn_sched_barrier(0)
    Unit cur, nxt; int ui = 0;
    if (!S.next(0, cur)) return;
    f32x4 acc[2][2][4][2];
#pragma unroll
    for (int a = 0; a < 2; ++a)
#pragma unroll
        for (int b = 0; b < 2; ++b)
#pragma unroll
            for (int m = 0; m < 4; ++m)
#pragma unroll
                for (int n = 0; n < 2; ++n) acc[a][b][m][n] = (f32x4){0.f, 0.f, 0.f, 0.f};
    bf16x8 At[4][2], B0[2][2], B1[2][2];
    const char* cA = (const char*)g.A + (size_t)cur.pm * tstepA; const char* cB = (const char*)g.Bt + (size_t)cur.pn * tstepB;
    S.a_ready(cur);
    if constexpr (SP2) {
        PG8_STAGE(PG8_SB(0, 0), cB, voffB); PG8_STAGE(PG8_SB(0, 1), cB + hstepB, voffB); PG8_STAGE(PG8_SA(0, 0), cA, voffA); PG8_STAGE(PG8_SA(0, 1), cA + hstepA, voffA);
        if (wr == 1) PG8_BAR;
        PG8_WAIT_V(2); PG8_BAR;
        PG8_STAGE(PG8_SB(1, 0), cB + kstep, voffB); PG8_STAGE(PG8_SA(1, 0), cA + kstep, voffA); PG8_STAGE(PG8_SB(1, 1), cB + hstepB + kstep, voffB);
        PG8_WAIT_V(6); PG8_BAR;
    } else {
        PG8_STAGE(PG8_SB(0, 0), cB, voffB); PG8_STAGE(PG8_SA(0, 0), cA, voffA); PG8_STAGE(PG8_SB(0, 1), cB + hstepB, voffB); PG8_STAGE(PG8_SA(0, 1), cA + hstepA, voffA);
        if (wr == 1) PG8_BAR;
        PG8_WAIT_V(4); PG8_BAR;
        PG8_STAGE(PG8_SB(1, 0), cB + kstep, voffB); PG8_STAGE(PG8_SA(1, 0), cA + kstep, voffA); PG8_STAGE(PG8_SB(1, 1), cB + hstepB + kstep, voffB);
        PG8_WAIT_V(6); PG8_BAR;
    }
    for (;;) {
        const bool has_next = S.next(ui + 1, nxt);
        const char* nA = has_next ? (const char*)g.A + (size_t)nxt.pm * tstepA : cA; const char* nB = has_next ? (const char*)g.Bt + (size_t)nxt.pn * tstepB : cB;
        for (int t = 0; t < nt; t += 2) {
            const bool last = (t == nt - 2);
            const char* a1 = cA + (size_t)(t + 1) * kstep;
            const char* a2 = last ? nA : cA + (size_t)(t + 2) * kstep; const char* b2 = last ? nB : cB + (size_t)(t + 2) * kstep;
            const char* a3 = a2 + kstep; const char* b3 = b2 + kstep;
            if (last && has_next) S.a_ready(nxt);
            if constexpr (SP2) {
            PG8_LDB(B0, 0, 0); PG8_LDB(B1, 0, 1); PG8_SCHED; PG8_LDA(At, 0, 0); PG8_STAGE(PG8_SA(1, 1), a1 + hstepA, voffA);
            PG8_WAIT_V(8); PG8_WAIT_L(0); PG8_BAR; PG8_MMA(0, 0, At, B0); PG8_MMA(0, 1, At, B1); PG8_BAR; PG8_SCHED;
            PG8_LDA(At, 0, 1); PG8_STAGE(PG8_SB(0, 0), b2, voffB); PG8_STAGE(PG8_SB(0, 1), b2 + hstepB, voffB); PG8_STAGE(PG8_SA(0, 0), a2, voffA);
            PG8_WAIT_V(8); PG8_WAIT_L(0); PG8_BAR; PG8_MMA(1, 0, At, B0); PG8_MMA(1, 1, At, B1); PG8_BAR; PG8_SCHED;
            PG8_LDB(B0, 1, 0); PG8_LDB(B1, 1, 1); PG8_SCHED; PG8_LDA(At, 1, 0); PG8_STAGE(PG8_SA(0, 1), a2 + hstepA, voffA);
            PG8_WAIT_V(8); PG8_WAIT_L(0); PG8_BAR; PG8_MMA(0, 0, At, B0); PG8_MMA(0, 1, At, B1); PG8_BAR; PG8_SCHED;
            PG8_LDA(At, 1, 1); PG8_STAGE(PG8_SB(1, 0), b3, voffB); PG8_STAGE(PG8_SB(1, 1), b3 + hstepB, voffB); PG8_STAGE(PG8_SA(1, 0), a3, voffA);
            PG8_WAIT_V(8); PG8_WAIT_L(0); PG8_BAR; PG8_MMA(1, 0, At, B0); PG8_MMA(1, 1, At, B1); PG8_BAR; PG8_SCHED;
            } else {
            PG8_LDB(B0, 0, 0); PG8_SCHED; PG8_LDA(At, 0, 0); PG8_STAGE(PG8_SA(1, 1), a1 + hstepA, voffA);
            PG8_WAIT_L(8); PG8_BAR; PG8_WAIT_L(0); PG8_MMA(0, 0, At, B0); PG8_BAR; PG8_SCHED;
            PG8_LDB(B1, 0, 1); PG8_STAGE(PG8_SB(0, 0), b2, voffB);
            PG8_BAR; PG8_WAIT_L(0); PG8_MMA(0, 1, At, B1); PG8_BAR;
            PG8_LDA(At, 0, 1); PG8_STAGE(PG8_SA(0, 0), a2, voffA);
            PG8_BAR; PG8_WAIT_L(0); PG8_MMA(1, 0, At, B0); PG8_BAR; PG8_SCHED;
            PG8_STAGE(PG8_SB(0, 1), b2 + hstepB, voffB);
            PG8_WAIT_V(6); PG8_BAR; PG8_MMA(1, 1, At, B1); PG8_BAR;
            PG8_LDB(B0, 1, 0); PG8_SCHED; PG8_LDA(At, 1, 0); PG8_STAGE(PG8_SA(0, 1), a2 + hstepA, voffA);
            PG8_WAIT_L(8); PG8_BAR; PG8_WAIT_L(0); PG8_MMA(0, 0, At, B0); PG8_BAR; PG8_SCHED;
            PG8_LDB(B1, 1, 1); PG8_STAGE(PG8_SB(1, 0), b3, voffB);
            PG8_BAR; PG8_WAIT_L(0); PG8_MMA(0, 1, At, B1); PG8_BAR;
            PG8_LDA(At, 1, 1); PG8_STAGE(PG8_SA(1, 0), a3, voffA);
            PG8_BAR; PG8_WAIT_L(0); PG8_MMA(1, 0, At, B0); PG8_BAR; PG8_SCHED;
            PG8_STAGE(PG8_SB(1, 1), b3 + hstepB, voffB);
            PG8_WAIT_V(6); PG8_BAR; PG8_MMA(1, 1, At, B1); PG8_BAR;
            }
        }
        if constexpr (ALIGN_EPI) { if (wr == 0) PG8_BAR; }
        if constexpr (!Epi::AFTER_DRAIN) { E(acc, cur, wr, wc, fr, fq); S.done(cur); }
        if (!has_next) break;
#pragma unroll
        for (int a = 0; a < 2; ++a)
#pragma unroll
            for (int b = 0; b < 2; ++b)
#pragma unroll
                for (int m = 0; m < 4; ++m)
#pragma unroll
                    for (int n = 0; n < 2; ++n) acc[a][b][m][n] = (f32x4){0.f, 0.f, 0.f, 0.f};
        cur = nxt; cA = nA; cB = nB; ++ui;
        if constexpr (ALIGN_EPI) { if (wr == 1) PG8_BAR; }
    }
    PG8_WAIT_V(0);
    if constexpr (!ALIGN_EPI) { if (wr == 0) PG8_BAR; }
    PG8_BAR;
#undef PG8_SA
#undef PG8_SB
#undef PG8_STAGE
#undef PG8_LDA
#undef PG8_LDB
#undef PG8_MMA
#undef PG8_WAIT_V
#undef PG8_WAIT_L
#undef PG8_BAR
#undef PG8_SCHED
}

template <int MODE> struct Epi {
    static constexpr bool PERM = false, AFTER_DRAIN = false;
    const float* rowsrc; float inv_n; float* ss; bf16_t* ob; int ldc; float* of; const float* xin;
    __device__ __forceinline__ void operator()(const f32x4 (&acc)[2][2][4][2], const Unit& u, int wr, int wc, int fr, int fq) const {
#pragma unroll
        for (int ai = 0; ai < 2; ++ai)
#pragma unroll
            for (int m = 0; m < 4; ++m) {
                const int row = u.pm * BM + ai * HALF + wr * 64 + m * 16 + fr;
                float rs = 1.f;
                if (MODE == 1) rs = rowsrc[row];
                if (MODE == 2 || MODE == 5) rs = rsqrtf(rowsrc[row] * inv_n + EPS);
                float ssq = 0.f;
#pragma unroll
                for (int bj = 0; bj < 2; ++bj)
#pragma unroll
                    for (int n = 0; n < 2; ++n) {
                        const int col = u.pn * BM + bj * HALF + wc * 32 + n * 16 + fq * 4;
                        f32x4 v = acc[ai][bj][m][n] * rs;
                        if (MODE == 1) { if (u.pn < 8) { v[0] = gelu_tanh(v[0]); v[1] = gelu_tanh(v[1]); v[2] = gelu_tanh(v[2]); v[3] = gelu_tanh(v[3]); } }
                        if (MODE == 4) { const f32x4 xr = *(const f32x4*)(xin + (size_t)row * DM + col); v = v + xr; }
                        if (MODE == 1 || MODE == 4) ssq += (v[0] * v[0] + v[1] * v[1]) + (v[2] * v[2] + v[3] * v[3]);
                        if (MODE == 1 || MODE == 2 || MODE == 4) { u32x2 w; w.x = pk2(v[0], v[1]); w.y = pk2(v[2], v[3]); *(u32x2*)(ob + (size_t)row * ldc + col) = w; }
                        if (MODE == 4 || MODE == 5) *(f32x4*)(of + (size_t)row * DM + col) = v;
                    }
                if (MODE == 1) {
                    const int seg = (u.pn >= 4 && u.pn < 8) ? 0 : ((u.pn == 8 || u.pn == 9) ? 1 : (u.pn == 10 ? 2 : -1));
                    if (seg >= 0) { ssq += __shfl_xor(ssq, 16); ssq += __shfl_xor(ssq, 32); if (fq == 0) atomicAdd(ss + seg * S + row, ssq); }
                }
                if (MODE == 4) { ssq += __shfl_xor(ssq, 16); ssq += __shfl_xor(ssq, 32); if (fq == 0) atomicAdd(ss + row, ssq); }
            }
    }
};
}

#define XB_TMO      128
#define XB_XCNT(j)  (256  + 64 * (j))
#define XB_XSUB(j)  (1280 + 64 * (j))
#define XB_XGEN(j)  (2304 + 64 * (j))
#define XB_TOP      3328
#define XB_TOPGEN   3392
#define XCD_BAR_WORDS 3456
#define XB_SPIN_CAP (1u << 18)
__device__ __forceinline__ unsigned xb_ld(unsigned* p)              { return __hip_atomic_load(p, __ATOMIC_RELAXED, __HIP_MEMORY_SCOPE_AGENT); }
__device__ __forceinline__ unsigned xb_add(unsigned* p, unsigned v) { return __hip_atomic_fetch_add(p, v, __ATOMIC_RELAXED, __HIP_MEMORY_SCOPE_AGENT); }
__device__ __forceinline__ unsigned xb_xcc_id() { return (unsigned)__builtin_amdgcn_s_getreg((3 << 11) | 20) & 0xFu; }
#define XB_SPIN(cond, bar) do { unsigned _sp = 0; while (cond) { __builtin_amdgcn_s_sleep(1); \
    if ((++_sp & 255u) == 0u) { if (xb_ld(&(bar)[XB_TMO])) break; if (_sp > XB_SPIN_CAP) { atomicAdd(&(bar)[XB_TMO], 1u); break; } } } } while (0)
struct XcdBarrier { unsigned* bar; unsigned x; volatile LAS unsigned* st; };
__device__ __forceinline__ XcdBarrier xcd_barrier_post(unsigned* bar, volatile LAS unsigned* st) {
    XcdBarrier b; b.bar = bar; b.x = xb_xcc_id(); b.st = st;
    if (threadIdx.x == 0) (void)xb_add(&bar[XB_XCNT(b.x)], 1u);
    return b;
}
__device__ __forceinline__ void xcd_barrier_complete(unsigned* bar, unsigned x, unsigned& nloc, unsigned& nx) {
    const unsigned G = gridDim.x * gridDim.y * gridDim.z;
    unsigned sum, cnt, mine, sp = 0u;
    for (;;) {
        sum = 0u; cnt = 0u; mine = 0u;
#pragma unroll
        for (unsigned j = 0; j < 16; ++j) { const unsigned c = xb_ld(&bar[XB_XCNT(j)]); sum += c; cnt += (c > 0u) ? 1u : 0u; mine = (j == x) ? c : mine; }
        if (sum == G) break;
        __builtin_amdgcn_s_sleep(1);
        if ((++sp & 255u) == 0u) { if (xb_ld(&bar[XB_TMO])) break; if (sp > XB_SPIN_CAP) { atomicAdd(&bar[XB_TMO], 1u); break; } }
    }
    nloc = mine > 0u ? mine : 1u; nx = cnt > 0u ? cnt : 1u;
}
#define XB_LSUB(j)  (3456 + 64 * (j))
#define XB_LGEN(j)  (4480 + 64 * (j))
__device__ __forceinline__ void xcd_local_barrier(const XcdBarrier& b) {
    asm volatile("s_waitcnt vmcnt(0)" ::: "memory");
    __syncthreads();
    if (threadIdx.x == 0) {
        unsigned* bar = b.bar;
        const unsigned nloc = b.st[0];
        const unsigned old = xb_add(&bar[XB_LSUB(b.x)], 1u);
        const unsigned gen = old / nloc;
        if (old + 1u == (gen + 1u) * nloc) xb_add(&bar[XB_LGEN(b.x)], 1u);
        else XB_SPIN(xb_ld(&bar[XB_LGEN(b.x)]) == gen, bar);
    }
    __syncthreads();
}
__device__ __forceinline__ void xcd_barrier(const XcdBarrier& b) {
    asm volatile("s_waitcnt vmcnt(0)" ::: "memory");
    __syncthreads();
    if (threadIdx.x == 0) {
        unsigned* bar = b.bar;
        __builtin_amdgcn_s_waitcnt(0);
        unsigned nloc = b.st[0], nx = b.st[1];
        if (nloc == 0u) { xcd_barrier_complete(bar, b.x, nloc, nx); b.st[0] = nloc; b.st[1] = nx; }
        const unsigned old = xb_add(&bar[XB_XSUB(b.x)], 1u);
        const unsigned gen = old / nloc;
        if (old + 1u == (gen + 1u) * nloc) {
            __builtin_amdgcn_fence(__ATOMIC_RELEASE, "agent");
            asm volatile("s_waitcnt vmcnt(0)" ::: "memory");
            const unsigned og = xb_add(&bar[XB_TOP], 1u);
            const unsigned tg = og / nx;
            if (og + 1u == (tg + 1u) * nx) xb_add(&bar[XB_TOPGEN], 1u);
            else XB_SPIN(xb_ld(&bar[XB_TOPGEN]) == tg, bar);
            __builtin_amdgcn_fence(__ATOMIC_ACQUIRE, "agent");
            xb_add(&bar[XB_XGEN(b.x)], 1u);
            asm volatile("s_waitcnt vmcnt(0)" ::: "memory");
        } else {
            XB_SPIN(xb_ld(&bar[XB_XGEN(b.x)]) == gen, bar);
            __builtin_amdgcn_fence(__ATOMIC_ACQUIRE, "agent");
            asm volatile("s_waitcnt vmcnt(0)" ::: "memory");
        }
    }
    __syncthreads();
}

struct Params {
    const float* in[18];
    float* out;
    unsigned char* ws;
    int ph_lo, ph_hi;
};

__device__ __forceinline__ void p0_transpose_item(const float* W, const float* g, int K, int N, bf16_t* WT, LAS float* scr, int item, int lane) {
    const int nblk = N / 32, kb = item / nblk, nb = item % nblk, k0 = 64 * kb, n0 = 32 * nb;
    float wv[32];
#pragma unroll
    for (int i = 0; i < 32; ++i) { const int kk = 2 * i + (lane >> 5); wv[i] = W[(size_t)(k0 + kk) * N + n0 + (lane & 31)]; }
#pragma unroll
    for (int i = 0; i < 32; ++i) { const int kk = 2 * i + (lane >> 5); const float gv = g ? g[k0 + kk] : 1.f; scr[kk * 33 + (lane & 31)] = wv[i] * gv; }
    LDS_WAIT(); asm volatile("" ::: "memory");
    const int c = lane & 7;
#pragma unroll
    for (int j = 0; j < 4; ++j) { const int n = (lane >> 3) + 8 * j; const LAS float* s = scr + (8 * c) * 33 + n;
        u32x4 o; o.x = pk2(s[0 * 33], s[1 * 33]); o.y = pk2(s[2 * 33], s[3 * 33]); o.z = pk2(s[4 * 33], s[5 * 33]); o.w = pk2(s[6 * 33], s[7 * 33]);
        *(u32x4*)(WT + (size_t)(n0 + n) * K + k0 + 8 * c) = o; }
    LDS_WAIT(); asm volatile("" ::: "memory");
}
__device__ __forceinline__ float row_to_bf16(const float* src, const float* g, bf16_t* dst, int lane) {
    float ss = 0.f;
#pragma unroll
    for (int i = 0; i < 8; ++i) {
        const int c = (i * 64 + lane) * 4;
        f32x4 v = *(const f32x4*)(src + c);
        ss += (v[0] * v[0] + v[1] * v[1]) + (v[2] * v[2] + v[3] * v[3]);
        if (g) { const f32x4 gv = *(const f32x4*)(g + c); v = v * gv; }
        u32x2 w; w.x = pk2(v[0], v[1]); w.y = pk2(v[2], v[3]);
        *(u32x2*)(dst + c) = w;
    }
    return ss;
}
constexpr float PEER_USC = 80.0f, PEER_VSC = 5.0f;
constexpr int PEER_ROWB = 1536;
typedef float f32x16v __attribute__((ext_vector_type(16)));
typedef float f32x32v __attribute__((ext_vector_type(32)));
typedef unsigned u32x6 __attribute__((ext_vector_type(6)));
typedef unsigned u32x2a4 __attribute__((ext_vector_type(2), aligned(4)));
template <bool CONTIG>
__device__ __forceinline__ void fp6_pack_store(const f32x4 (&x)[8], const f32x4 (&sc)[8], unsigned char* dst, int lane) {
    f32x16v a, b;
#pragma unroll
    for (int i = 0; i < 8; ++i) {
        const f32x4 y = x[i] * sc[i];
#pragma unroll
        for (int q = 0; q < 4; ++q) { const float c = fminf(fmaxf(y[q], -7.5f), 7.5f); const int sl = 4 * i + q; if ((sl & 1) == 0) a[sl >> 1] = c; else b[sl >> 1] = c; }
    }
    const u32x6 pk = __builtin_amdgcn_cvt_scalef32_2xpk16_fp6_f32(a, b, 1.0f);
    asm volatile("s_nop 15" : "+v"(a), "+v"(b));
    if (CONTIG) {
        *(u32x2*)(dst + lane * 24) = (u32x2){pk[0], pk[1]}; *(u32x2*)(dst + lane * 24 + 8) = (u32x2){pk[2], pk[3]}; *(u32x2*)(dst + lane * 24 + 16) = (u32x2){pk[4], pk[5]};
    } else {
        *(u32x4*)(dst + lane * 16) = (u32x4){pk[0], pk[1], pk[2], pk[3]};
        *(u32x2*)(dst + 1024 + lane * 8) = (u32x2){pk[4], pk[5]};
    }
}
template <bool CONTIG>
__device__ __forceinline__ void rows2_to_fp6(const float* s0, const float* s1, const f32x4 (&sc)[8], unsigned char* d0, unsigned char* d1, int lane) {
    f32x4 x0[8], x1[8];
#pragma unroll
    for (int i = 0; i < 8; ++i) { x0[i] = *(const f32x4*)(s0 + (i * 64 + lane) * 4); x1[i] = *(const f32x4*)(s1 + (i * 64 + lane) * 4); }
    fp6_pack_store<CONTIG>(x0, sc, d0, lane); fp6_pack_store<CONTIG>(x1, sc, d1, lane);
}
__device__ __forceinline__ bf16x8 cvt8(const float* p) {
    const f32x4 a = *(const f32x4*)p, b = *(const f32x4*)(p + 4);
    u32x4 w; w.x = pk2(a[0], a[1]); w.y = pk2(a[2], a[3]); w.z = pk2(b[0], b[1]); w.w = pk2(b[2], b[3]);
    return __builtin_bit_cast(bf16x8, w);
}

__device__ __forceinline__ void prep_late(const Params& p, LAS unsigned char* lds, int gw, int NGW, int wave, int lane) {
    unsigned char* ws = p.ws;
    LAS float* scr = (LAS float*)(lds + wave * 16384);
    {
        constexpr int I_UQ = (512 / 64) * (1536 / 32), I_UKV = (256 / 64) * (2048 / 32), I_OUT = (DM / 64) * (DM / 32);
        constexpr int NIT = I_UQ + I_UKV + I_OUT;
        for (int it = gw; it < NIT; it += NGW) {
            int r = it;
            if (r < I_UQ) { p0_transpose_item(p.in[7], p.in[6], 512, 1536, (bf16_t*)(ws + WS_WUQ), scr, r, lane); continue; } r -= I_UQ;
            if (r < I_UKV) { p0_transpose_item(p.in[9], p.in[8], 256, 2048, (bf16_t*)(ws + WS_WUKV), scr, r, lane); continue; } r -= I_UKV;
            p0_transpose_item(p.in[12], nullptr, DM, DM, (bf16_t*)(ws + WS_WOUT), scr, r, lane);
        }
    }
    {
        const float* wq = p.in[14]; const float* sk = p.in[15]; const float* g2 = p.in[13];
        bf16_t* WsT = (bf16_t*)(ws + WS_WS);
        const int r32 = lane & 31, hh = lane >> 5;
        for (int it = gw; it < 16 * 4 * 64; it += NGW) {
            const int hp = it >> 8, kb = (it >> 6) & 3, nb = it & 63;
            f32x16 acc = {};
            const float* ap = sk + ((size_t)(hp * 128 + kb * 32 + r32)) * 128 + hh * 8;
            const float* bp = wq + ((size_t)(nb * 32 + r32)) * DM + hp * 128 + hh * 8;
#pragma unroll
            for (int s = 0; s < 8; ++s) {
                const bf16x8 a = cvt8(ap + s * 16), b = cvt8(bp + s * 16);
                acc = __builtin_amdgcn_mfma_f32_32x32x16_bf16(a, b, acc, 0, 0, 0);
            }
            const int kcol = nb * 32 + r32; const float gk = g2[kcol];
#pragma unroll
            for (int r = 0; r < 16; ++r) WsT[(size_t)(hp * 128 + kb * 32 + crow(r, hh)) * DM + kcol] = (bf16_t)f2bf(acc[r] * gk);
        }
    }
    {
        float* ct = (float*)(ws + WS_COS); float* st = (float*)(ws + WS_SIN);
        for (int it = gw; it < S * 32 / 64; it += NGW) {
            const int idx = it * 64 + lane, t = idx >> 5, j = idx & 31;
            const float inv_freq = powf(10000.0f, -(float)j / 32.0f);
            const float ang = (float)t * inv_freq;
            float sv, cv; sincosf(ang, &sv, &cv); ct[idx] = cv; st[idx] = sv;
        }
    }
}
__device__ __forceinline__ void phase0(const Params& p, LAS unsigned char* lds, bool late_ok, int gw, int NGW, int wave, int lane) {
    unsigned char* ws = p.ws;
    LAS float* scr = (LAS float*)(lds + wave * 16384);
    const float* x = p.in[0];
    {
        constexpr int I_IN = (DM / 64) * (NIN / 32);
        for (int it = gw; it < I_IN; it += NGW) p0_transpose_item(p.in[2], p.in[1], DM, NIN, (bf16_t*)(ws + WS_WIN), scr, it, lane);
    }
    if (!late_ok) prep_late(p, lds, gw, NGW, wave, lane);
    for (int r = gw; r < NINP - NIN; r += NGW) {
        bf16_t* d = (bf16_t*)(ws + WS_WIN) + (size_t)(NIN + r) * DM;
#pragma unroll
        for (int i = 0; i < 4; ++i) *(u32x4*)(d + (i * 64 + lane) * 8) = (u32x4){0u, 0u, 0u, 0u};
    }
    {
        bf16_t* xb = (bf16_t*)(ws + WS_XB); float* rstd1 = (float*)(ws + WS_RSTD1);
        for (int t = gw; t + NGW < S; t += 2 * NGW) {
            const int t1 = t + NGW;
            f32x4 a[8], b[8];
#pragma unroll
            for (int i = 0; i < 8; ++i) { a[i] = *(const f32x4*)(x + (size_t)t * DM + (i * 64 + lane) * 4); b[i] = *(const f32x4*)(x + (size_t)t1 * DM + (i * 64 + lane) * 4); }
            float sa = 0.f, sb = 0.f;
#pragma unroll
            for (int i = 0; i < 8; ++i) {
                sa += (a[i][0] * a[i][0] + a[i][1] * a[i][1]) + (a[i][2] * a[i][2] + a[i][3] * a[i][3]);
                sb += (b[i][0] * b[i][0] + b[i][1] * b[i][1]) + (b[i][2] * b[i][2] + b[i][3] * b[i][3]);
                u32x2 wa, wb; wa.x = pk2(a[i][0], a[i][1]); wa.y = pk2(a[i][2], a[i][3]); wb.x = pk2(b[i][0], b[i][1]); wb.y = pk2(b[i][2], b[i][3]);
                *(u32x2*)(xb + (size_t)t * DM + (i * 64 + lane) * 4) = wa; *(u32x2*)(xb + (size_t)t1 * DM + (i * 64 + lane) * 4) = wb;
            }
            sa = wave_sum(sa); sb = wave_sum(sb);
            if (lane == 0) { rstd1[t] = rsqrtf(sa * (1.0f / DM) + EPS); rstd1[t1] = rsqrtf(sb * (1.0f / DM) + EPS); }
        }
    }
    {
        unsigned char* UT = ws + WS_UT; unsigned char* VT = ws + WS_VT;
        f32x4 sc[8];
#pragma unroll
        for (int i = 0; i < 8; ++i) sc[i] = *(const f32x4*)(p.in[13] + (i * 64 + lane) * 4) * PEER_USC;
        for (int e = gw; e + NGW < 16384; e += 2 * NGW)
            rows2_to_fp6<false>(p.in[16] + (size_t)e * DM, p.in[16] + (size_t)(e + NGW) * DM, sc, UT + (size_t)e * PEER_ROWB, UT + (size_t)(e + NGW) * PEER_ROWB, lane);
#pragma unroll
        for (int i = 0; i < 8; ++i) sc[i] = (f32x4){PEER_VSC, PEER_VSC, PEER_VSC, PEER_VSC};
        for (int e = gw; e + NGW < 16384; e += 2 * NGW)
            rows2_to_fp6<false>(p.in[17] + (size_t)e * DM, p.in[17] + (size_t)(e + NGW) * DM, sc, VT + (size_t)e * PEER_ROWB, VT + (size_t)(e + NGW) * PEER_ROWB, lane);
    }
}

__device__ __forceinline__ void phase3(const Params& p, int gw, int NGW, int lane) {
    unsigned char* ws = p.ws;
    const bf16_t* qraw = (const bf16_t*)(ws + WS_QRAW); const bf16_t* kvraw = (const bf16_t*)(ws + WS_KVRAW); const bf16_t* proj = (const bf16_t*)(ws + WS_PROJ);
    bf16_t* Qh = (bf16_t*)(ws + WS_QH); bf16_t* Kh = (bf16_t*)(ws + WS_KH);
    const float* ct = (const float*)(ws + WS_COS); const float* st = (const float*)(ws + WS_SIN);
    const bool act = lane < 48, isrope = lane >= 32 && lane < 48, lowhalf = lane < 40;
    const int e0 = act ? 4 * lane : 0;
    const f32x4 gq = *(const f32x4*)(p.in[10] + e0), gk = *(const f32x4*)(p.in[11] + e0);
    const int j0 = isrope ? ((4 * lane - 128) & 31) : 0;
    constexpr float QS = 0.07216878364870322f * 1.4426950408889634f;
    for (int t = gw; t < S; t += NGW) {
        f32x4 cs = {1.f, 1.f, 1.f, 1.f}, sn = {0.f, 0.f, 0.f, 0.f};
        if (isrope) { cs = *(const f32x4*)(ct + t * 32 + j0); sn = *(const f32x4*)(st + t * 32 + j0); }
        u32x2 krw = {0u, 0u};
        if (isrope) krw = *(const u32x2*)(proj + (size_t)t * NINP + 2816 + (4 * lane - 128));
        const f32x4 krope = {bflo(krw.x), bfhi(krw.x), bflo(krw.y), bfhi(krw.y)};
#pragma unroll
        for (int h = 0; h < 8; ++h) {
            u32x2 qw = {0u, 0u};
            if (act) qw = *(const u32x2*)(qraw + (size_t)t * 1536 + h * 192 + e0);
            f32x4 q = {bflo(qw.x), bfhi(qw.x), bflo(qw.y), bfhi(qw.y)};
            float ss = wave_sum_u((q[0] * q[0] + q[1] * q[1]) + (q[2] * q[2] + q[3] * q[3]));
            float rs = rsqrtf(ss * (1.0f / 192.0f) + EPS);
            q = q * gq * rs;
            {
                f32x4 pr;
#pragma unroll
                for (int c = 0; c < 4; ++c) pr[c] = __shfl_xor(q[c], 8);
                const f32x4 r1 = q * cs - pr * sn, r2 = pr * sn + q * cs;
                if (isrope) q = lowhalf ? r1 : r2;
            }
            q = q * QS;
            if (act) { u32x2 w; w.x = pk2(q[0], q[1]); w.y = pk2(q[2], q[3]); *(u32x2*)(Qh + ((size_t)h * S + t) * 192 + e0) = w; }
            u32x2 kw = {0u, 0u};
            if (lane < 32) kw = *(const u32x2*)(kvraw + (size_t)t * 2048 + h * 256 + e0);
            f32x4 k = {bflo(kw.x), bfhi(kw.x), bflo(kw.y), bfhi(kw.y)};
            if (isrope) k = krope;
            ss = wave_sum_u((k[0] * k[0] + k[1] * k[1]) + (k[2] * k[2] + k[3] * k[3]));
            rs = rsqrtf(ss * (1.0f / 192.0f) + EPS);
            k = k * gk * rs;
            {
                f32x4 pr;
#pragma unroll
                for (int c = 0; c < 4; ++c) pr[c] = __shfl_xor(k[c], 8);
                const f32x4 r1 = k * cs - pr * sn, r2 = pr * sn + k * cs;
                if (isrope) k = lowhalf ? r1 : r2;
            }
            if (act) { u32x2 w; w.x = pk2(k[0], k[1]); w.y = pk2(k[2], k[3]); *(u32x2*)(Kh + ((size_t)h * S + t) * 192 + e0) = w; }
        }
    }
}

constexpr int KP = 400, VP = 320;
template <int OFF> __device__ __forceinline__ s16x4 tr_read(unsigned addr) {
    s16x4 r; asm volatile("ds_read_b64_tr_b16 %0, %1 offset:%2" : "=&v"(r) : "v"(addr), "i"(OFF) : "memory"); return r;
}
__device__ __forceinline__ unsigned cvtpk(float lo, float hi) { unsigned r; asm volatile("v_cvt_pk_bf16_f32 %0, %1, %2" : "=v"(r) : "v"(lo), "v"(hi)); return r; }
#define PK8(L, H) ((bf16x8){L[0], L[1], L[2], L[3], H[0], H[1], H[2], H[3]})
constexpr float ATT_THR = 8.0f;

constexpr int ATT_KB = 64 * KP, ATT_VB = 64 * VP;
constexpr int ATT_VOFF = 2 * ATT_KB;
__device__ __forceinline__ float xhalf_max(float v) {
    auto rr = __builtin_amdgcn_permlane32_swap(__builtin_bit_cast(unsigned, v), __builtin_bit_cast(unsigned, v), false, false);
    return fmaxf(__builtin_bit_cast(float, rr[0]), __builtin_bit_cast(float, rr[1]));
}
__device__ __forceinline__ float xhalf_sum(float v) {
    auto rr = __builtin_amdgcn_permlane32_swap(__builtin_bit_cast(unsigned, v), __builtin_bit_cast(unsigned, v), false, false);
    return __builtin_bit_cast(float, rr[0]) + __builtin_bit_cast(float, rr[1]);
}
template <int OFF> __device__ __forceinline__ bf16x8 lds_read128(unsigned addr) {
    bf16x8 r; asm volatile("ds_read_b128 %0, %1 offset:%2" : "=&v"(r) : "v"(addr), "i"(OFF) : "memory"); return r;
}
#define LGKM_WAIT(n) do { asm volatile("s_waitcnt lgkmcnt(" #n ")" ::: "memory"); SBAR(); } while (0)
__device__ __forceinline__ f32x16 att_qk(unsigned kaddr, const bf16x8 (&qr)[12]) {
    f32x16 p = {};
    bf16x8 a0 = lds_read128<0>(kaddr), a1 = lds_read128<32>(kaddr), a2 = lds_read128<64>(kaddr), a3 = lds_read128<96>(kaddr);
    LGKM_WAIT(3); p = __builtin_amdgcn_mfma_f32_32x32x16_bf16(a0, qr[0], p, 0, 0, 0); a0 = lds_read128<128>(kaddr);
    LGKM_WAIT(3); p = __builtin_amdgcn_mfma_f32_32x32x16_bf16(a1, qr[1], p, 0, 0, 0); a1 = lds_read128<160>(kaddr);
    LGKM_WAIT(3); p = __builtin_amdgcn_mfma_f32_32x32x16_bf16(a2, qr[2], p, 0, 0, 0); a2 = lds_read128<192>(kaddr);
    LGKM_WAIT(3); p = __builtin_amdgcn_mfma_f32_32x32x16_bf16(a3, qr[3], p, 0, 0, 0); a3 = lds_read128<224>(kaddr);
    LGKM_WAIT(3); p = __builtin_amdgcn_mfma_f32_32x32x16_bf16(a0, qr[4], p, 0, 0, 0); a0 = lds_read128<256>(kaddr);
    LGKM_WAIT(3); p = __builtin_amdgcn_mfma_f32_32x32x16_bf16(a1, qr[5], p, 0, 0, 0); a1 = lds_read128<288>(kaddr);
    LGKM_WAIT(3); p = __builtin_amdgcn_mfma_f32_32x32x16_bf16(a2, qr[6], p, 0, 0, 0); a2 = lds_read128<320>(kaddr);
    LGKM_WAIT(3); p = __builtin_amdgcn_mfma_f32_32x32x16_bf16(a3, qr[7], p, 0, 0, 0); a3 = lds_read128<352>(kaddr);
    LGKM_WAIT(3); p = __builtin_amdgcn_mfma_f32_32x32x16_bf16(a0, qr[8], p, 0, 0, 0);
    LGKM_WAIT(2); p = __builtin_amdgcn_mfma_f32_32x32x16_bf16(a1, qr[9], p, 0, 0, 0);
    LGKM_WAIT(1); p = __builtin_amdgcn_mfma_f32_32x32x16_bf16(a2, qr[10], p, 0, 0, 0);
    LGKM_WAIT(0); p = __builtin_amdgcn_mfma_f32_32x32x16_bf16(a3, qr[11], p, 0, 0, 0);
    return p;
}
__device__ __forceinline__ void att_finish(f32x16& s, float m, float& lsum, bf16x8& pb0, bf16x8& pb1) {
    float ps = 0.f;
#pragma unroll
    for (int r = 0; r < 16; ++r) { s[r] = __builtin_amdgcn_exp2f(s[r] - m); ps += s[r]; }
    lsum += xhalf_sum(ps);
    u32x4 w0 = {cvtpk(s[0], s[1]), cvtpk(s[2], s[3]), cvtpk(s[4], s[5]), cvtpk(s[6], s[7])};
    u32x4 w1 = {cvtpk(s[8], s[9]), cvtpk(s[10], s[11]), cvtpk(s[12], s[13]), cvtpk(s[14], s[15])};
    pb0 = __builtin_bit_cast(bf16x8, w0); pb1 = __builtin_bit_cast(bf16x8, w1);
}
__device__ __forceinline__ void att_pv(unsigned vaddr, bf16x8 pb0, bf16x8 pb1, f32x16 (&o)[4]) {
#define VOFF(d0, s, hi) (((16 * (s) + 8 * (hi)) * VP) + 64 * (d0))
    const s16x4 a00l = tr_read<VOFF(0, 0, 0)>(vaddr), a00h = tr_read<VOFF(0, 0, 1)>(vaddr), a01l = tr_read<VOFF(0, 1, 0)>(vaddr), a01h = tr_read<VOFF(0, 1, 1)>(vaddr);
    const s16x4 a10l = tr_read<VOFF(1, 0, 0)>(vaddr), a10h = tr_read<VOFF(1, 0, 1)>(vaddr), a11l = tr_read<VOFF(1, 1, 0)>(vaddr), a11h = tr_read<VOFF(1, 1, 1)>(vaddr);
    LGKM_WAIT(4);
    o[0] = __builtin_amdgcn_mfma_f32_32x32x16_bf16(PK8(a00l, a00h), pb0, o[0], 0, 0, 0); o[0] = __builtin_amdgcn_mfma_f32_32x32x16_bf16(PK8(a01l, a01h), pb1, o[0], 0, 0, 0);
    const s16x4 a20l = tr_read<VOFF(2, 0, 0)>(vaddr), a20h = tr_read<VOFF(2, 0, 1)>(vaddr), a21l = tr_read<VOFF(2, 1, 0)>(vaddr), a21h = tr_read<VOFF(2, 1, 1)>(vaddr);
    LGKM_WAIT(4);
    o[1] = __builtin_amdgcn_mfma_f32_32x32x16_bf16(PK8(a10l, a10h), pb0, o[1], 0, 0, 0); o[1] = __builtin_amdgcn_mfma_f32_32x32x16_bf16(PK8(a11l, a11h), pb1, o[1], 0, 0, 0);
    const s16x4 a30l = tr_read<VOFF(3, 0, 0)>(vaddr), a30h = tr_read<VOFF(3, 0, 1)>(vaddr), a31l = tr_read<VOFF(3, 1, 0)>(vaddr), a31h = tr_read<VOFF(3, 1, 1)>(vaddr);
    LGKM_WAIT(4);
    o[2] = __builtin_amdgcn_mfma_f32_32x32x16_bf16(PK8(a20l, a20h), pb0, o[2], 0, 0, 0); o[2] = __builtin_amdgcn_mfma_f32_32x32x16_bf16(PK8(a21l, a21h), pb1, o[2], 0, 0, 0);
    LGKM_WAIT(0);
    o[3] = __builtin_amdgcn_mfma_f32_32x32x16_bf16(PK8(a30l, a30h), pb0, o[3], 0, 0, 0); o[3] = __builtin_amdgcn_mfma_f32_32x32x16_bf16(PK8(a31l, a31h), pb1, o[3], 0, 0, 0);
#undef VOFF
}
__device__ __forceinline__ void att_partial(const f32x16& s, float& m, float& lsum, f32x16 (&o)[4]) {
    float pmax = s[0];
#pragma unroll
    for (int r = 1; r < 16; ++r) pmax = fmaxf(pmax, s[r]);
    pmax = xhalf_max(pmax);
    if (!__all(pmax - m <= ATT_THR)) {
        const float mn = fmaxf(m, pmax); const float alpha = __builtin_amdgcn_exp2f(m - mn); m = mn; lsum *= alpha;
#pragma unroll
        for (int d = 0; d < 4; ++d)
#pragma unroll
            for (int r = 0; r < 16; ++r) o[d][r] *= alpha;
    }
}

__device__ __forceinline__ void attn_unit(const Params& p, LAS unsigned char* lds, int head, int qb, int tid, int wave, int lane) {
    unsigned char* ws = p.ws;
    const bf16_t* Qh = (const bf16_t*)(ws + WS_QH); const bf16_t* Kh = (const bf16_t*)(ws + WS_KH);
    bf16_t* mix = (bf16_t*)(ws + WS_MIX);
    const int rg = wave & 3, kh = wave >> 2, r32 = lane & 31, hh = lane >> 5;
    const int q0row = qb * 128 + rg * 32;
    bf16x8 qr[12];
    {
        const bf16_t* qp = Qh + ((size_t)head * S + q0row + r32) * 192 + hh * 8;
#pragma unroll
        for (int ks = 0; ks < 12; ++ks) qr[ks] = *(const bf16x8*)(qp + ks * 16);
    }
    const int ntiles = 2 * qb + 2, mylast = 2 * qb + (rg >> 1);
    float m = -1e30f, lsum = 0.f; f32x16 o[4] = {};
    const int srow = tid >> 3, sch = tid & 7;
    const int kg0 = srow * 192 + sch * 8, kl0 = srow * KP + sch * 16, vg0 = srow * 2048 + sch * 8, vl0 = ATT_VOFF + srow * VP + sch * 16;
    const bf16_t* kbase = Kh + (size_t)head * S * 192; const bf16_t* vbase = (const bf16_t*)(ws + WS_KVRAW) + head * 256 + 128;
    u32x4 sk0, sk1, sk2, sv0, sv1;
#define ATT_LOAD(t) do { const bf16_t* kt = kbase + (size_t)(t) * 64 * 192 + kg0; const bf16_t* vt = vbase + (size_t)(t) * 64 * 2048 + vg0; \
        sk0 = *(const u32x4*)(kt); sk1 = *(const u32x4*)(kt + 64); sk2 = *(const u32x4*)(kt + 128); sv0 = *(const u32x4*)(vt); sv1 = *(const u32x4*)(vt + 64); } while (0)
#define ATT_WRITE(kb_, vb_) do { LAS unsigned char* bk = lds + (kb_) * ATT_KB + kl0; LAS unsigned char* bv = lds + (vb_) * ATT_VB + vl0; *(LAS u32x4*)(bk) = sk0; *(LAS u32x4*)(bk + 128) = sk1; *(LAS u32x4*)(bk + 256) = sk2; \
        *(LAS u32x4*)(bv) = sv0; *(LAS u32x4*)(bv + 128) = sv1; } while (0)
    const unsigned ldsbase = (unsigned)(size_t)lds;
    const unsigned kaddr0 = ldsbase + (unsigned)((32 * kh + r32) * KP + hh * 16);
    const unsigned vrel = (unsigned)(ATT_VOFF + (32 * kh + 4 * hh + ((lane & 15) >> 2)) * VP + (16 * ((lane >> 4) & 1) + 4 * (lane & 3)) * 2);
    ATT_LOAD(0); ATT_WRITE(0, 0); __syncthreads();
    bf16x8 pb0, pb1;
    const bool more0 = (1 < ntiles);
    if (more0) ATT_LOAD(1);
    f32x16 sprev = att_qk(kaddr0, qr);
    att_partial(sprev, m, lsum, o);
    if (more0) ATT_WRITE(1, 1);
    __syncthreads();
    int vprev = 0, vcur = 1;
#pragma unroll 1
    for (int t = 1; t <= ntiles; ++t) {
        const bool more = (t + 1 < ntiles);
        if (more) ATT_LOAD(t + 1);
        f32x16 sc;
        if (t <= mylast) sc = att_qk(kaddr0 + (t & 1) * ATT_KB, qr);
        else {
#pragma unroll
            for (int r = 0; r < 16; ++r) sc[r] = -1e30f;
        }
        att_finish(sprev, m, lsum, pb0, pb1);
        att_pv(ldsbase + vprev * ATT_VB + vrel, pb0, pb1, o);
        att_partial(sc, m, lsum, o);
        sprev = sc;
        const int vnext = (vcur == 2) ? 0 : vcur + 1;
        if (more) ATT_WRITE((t + 1) & 1, vnext);
        vprev = vcur; vcur = vnext;
        __syncthreads();
    }
#undef ATT_LOAD
#undef ATT_WRITE
    LAS float* scr = (LAS float*)lds + (size_t)rg * 66 * 64 + lane;
    if (kh == 1) {
        scr[0] = m; scr[64] = lsum;
#pragma unroll
        for (int d = 0; d < 4; ++d)
#pragma unroll
            for (int r = 0; r < 16; ++r) scr[(2 + d * 16 + r) * 64] = o[d][r];
    }
    __syncthreads();
    if (kh == 0) {
        const float m2 = scr[0], l2 = scr[64];
        const float mn = fmaxf(m, m2), a1 = __builtin_amdgcn_exp2f(m - mn), a2 = __builtin_amdgcn_exp2f(m2 - mn);
        const float inv = 1.0f / (lsum * a1 + l2 * a2);
        bf16_t* op = mix + (size_t)(q0row + r32) * DM + 1024 + head * 128 + 4 * hh;
#pragma unroll
        for (int d = 0; d < 4; ++d)
#pragma unroll
            for (int g4 = 0; g4 < 4; ++g4) {
                float v[4];
#pragma unroll
                for (int i = 0; i < 4; ++i) { const int r = 4 * g4 + i; v[i] = (o[d][r] * a1 + scr[(2 + d * 16 + r) * 64] * a2) * inv; }
                u32x2 w; w.x = pk2(v[0], v[1]); w.y = pk2(v[2], v[3]);
                *(u32x2*)(op + 32 * d + 8 * g4) = w;
            }
    }
    __syncthreads();
}

__device__ __forceinline__ void gmlp_unit(const Params& p, LAS unsigned char* lds, int nb, int h, int tid, int wave, int lane) {
    unsigned char* ws = p.ws;
    const bf16_t* proj = (const bf16_t*)(ws + WS_PROJ); bf16_t* mix = (bf16_t*)(ws + WS_MIX);
    const float* ssv = (const float*)(ws + WS_ROWSS);
    const float* vg = p.in[3]; const float* wsp = p.in[4]; const float* bs = p.in[5];
#pragma unroll
    for (int i = 0; i < 4; ++i) {
        const int pc = tid + 512 * i, r = pc >> 4, c = pc & 15, t = nb * 128 + r;
        const u32x4 w = *(const u32x4*)(proj + (size_t)t * NINP + 1024 + h * 128 + c * 8);
        const float rs = rsqrtf(ssv[t] * (1.0f / 1024.0f) + EPS);
        const f32x4 g0 = *(const f32x4*)(vg + h * 128 + c * 8), g1 = *(const f32x4*)(vg + h * 128 + c * 8 + 4);
        u32x4 ov;
        ov.x = pk2(bflo(w.x) * rs * g0[0], bfhi(w.x) * rs * g0[1]); ov.y = pk2(bflo(w.y) * rs * g0[2], bfhi(w.y) * rs * g0[3]);
        ov.z = pk2(bflo(w.z) * rs * g1[0], bfhi(w.z) * rs * g1[1]); ov.w = pk2(bflo(w.w) * rs * g1[2], bfhi(w.w) * rs * g1[3]);
        *(LAS u32x4*)(lds + r * VP + c * 16) = ov;
    }
    __syncthreads();
    const int ib = wave & 3, ch = wave >> 2, r32 = lane & 31, hh = lane >> 5;
    const int irow = 32 * ib + r32;
    f32x16 acc0 = {}, acc1 = {};
    const unsigned vaddr = (unsigned)(size_t)lds + (unsigned)((8 * hh + ((lane & 15) >> 2)) * VP + (64 * ch + 16 * ((lane >> 4) & 1) + 4 * (lane & 3)) * 2);
    const float* wrow = wsp + ((size_t)h * 128 + irow) * 128 + hh * 8;
#define GSTEP(s) do { if ((s) < 2 * (ib + 1)) { \
        const f32x4 wa = *(const f32x4*)(wrow + (s) * 16), wb = *(const f32x4*)(wrow + (s) * 16 + 4); const int j0 = (s) * 16 + hh * 8; \
        u32x4 aw; aw.x = pk2(j0 + 0 <= irow ? wa[0] : 0.f, j0 + 1 <= irow ? wa[1] : 0.f); aw.y = pk2(j0 + 2 <= irow ? wa[2] : 0.f, j0 + 3 <= irow ? wa[3] : 0.f); \
        aw.z = pk2(j0 + 4 <= irow ? wb[0] : 0.f, j0 + 5 <= irow ? wb[1] : 0.f); aw.w = pk2(j0 + 6 <= irow ? wb[2] : 0.f, j0 + 7 <= irow ? wb[3] : 0.f); \
        const bf16x8 af = __builtin_bit_cast(bf16x8, aw); \
        const s16x4 b0l = tr_read<(16 * (s)) * VP>(vaddr), b0h = tr_read<(16 * (s) + 4) * VP>(vaddr), b1l = tr_read<(16 * (s)) * VP + 64>(vaddr), b1h = tr_read<(16 * (s) + 4) * VP + 64>(vaddr); \
        LDS_WAIT(); SBAR(); \
        acc0 = __builtin_amdgcn_mfma_f32_32x32x16_bf16(af, PK8(b0l, b0h), acc0, 0, 0, 0); acc1 = __builtin_amdgcn_mfma_f32_32x32x16_bf16(af, PK8(b1l, b1h), acc1, 0, 0, 0); } } while (0)
    GSTEP(0); GSTEP(1); GSTEP(2); GSTEP(3); GSTEP(4); GSTEP(5); GSTEP(6); GSTEP(7);
#undef GSTEP
#pragma unroll
    for (int r = 0; r < 16; ++r) {
        const int i = 32 * ib + crow(r, hh), t = nb * 128 + i; const float b = bs[h * 128 + i];
        const int c0 = h * 128 + 64 * ch + r32;
        const float u0 = bf2f(proj[(size_t)t * NINP + c0]), u1 = bf2f(proj[(size_t)t * NINP + c0 + 32]);
        mix[(size_t)t * DM + c0] = (bf16_t)f2bf(u0 * (acc0[r] + b)); mix[(size_t)t * DM + c0 + 32] = (bf16_t)f2bf(u1 * (acc1[r] + b));
    }
    __syncthreads();
}

__device__ __forceinline__ void phase7(const Params& p, LAS unsigned char* lds, int gw, int NGW, int wave, int lane) {
    unsigned char* ws = p.ws;
    const float* sc = (const float*)(ws + WS_SC); int* ex = (int*)(ws + WS_EXP); float* gt = (float*)(ws + WS_GATE);
    const float NEG = -3.0e38f;
    LAS float* sl = (LAS float*)(lds + wave * 1024);
    const int j8 = lane & 7, g8 = lane >> 3, row = lane >> 4, i16 = lane & 15;
    int ci[4], cj[4]; bool cval[4];
    {
        constexpr int starts[16] = {0, 16, 24, 29, 33, 36, 38, 40, 42, 43, 44, 45, 46, 47, 48, 49};
#pragma unroll
        for (int m = 0; m < 4; ++m) {
            const int c = i16 + 16 * m; int a = 0, st = 0;
#pragma unroll
            for (int i = 1; i < 16; ++i) if (c >= starts[i]) { a = i; st = starts[i]; }
            cval[m] = c < 50; ci[m] = cval[m] ? a : 0; cj[m] = cval[m] ? (c - st) : 0;
        }
    }
    f32x4 nx0, nx1, nx2, nx3;
    if (gw < S / 4) { const float* b = sc + (size_t)(gw * 4) * DM + lane * 16; nx0 = *(const f32x4*)b; nx1 = *(const f32x4*)(b + 4); nx2 = *(const f32x4*)(b + 8); nx3 = *(const f32x4*)(b + 12); }
    for (int tb = gw; tb < S / 4; tb += NGW)
#pragma unroll 1
    for (int n8 = 0; n8 < 8; ++n8) {
        const int it = tb * 8 + n8;
        const int t = it >> 1, hh = it & 1;
        float v[16];
#pragma unroll
        for (int q = 0; q < 4; ++q) { v[q] = nx0[q]; v[4 + q] = nx1[q]; v[8 + q] = nx2[q]; v[12 + q] = nx3[q]; }
        { const int it2 = n8 < 7 ? it + 1 : (tb + NGW) * 8;
          if (it2 < S * 2) { const float* b = sc + (size_t)(it2 >> 1) * DM + (it2 & 1) * 1024 + lane * 16;
            nx0 = *(const f32x4*)b; nx1 = *(const f32x4*)(b + 4); nx2 = *(const f32x4*)(b + 8); nx3 = *(const f32x4*)(b + 12); } }
#pragma unroll
        for (int m = 0; m < 16; ++m) v[m] = __builtin_bit_cast(float, (__builtin_bit_cast(unsigned, v[m]) & ~127u) | (unsigned)(16 * j8 + m));
#define P7_CE(A, B) do { const float hi_ = fmaxf(v[A], v[B]), lo_ = fminf(v[A], v[B]); v[A] = hi_; v[B] = lo_; } while (0)
        P7_CE(0, 13); P7_CE(1, 12); P7_CE(2, 15); P7_CE(3, 14); P7_CE(4, 8); P7_CE(5, 6); P7_CE(7, 11); P7_CE(9, 10);
        P7_CE(0, 5); P7_CE(1, 7); P7_CE(2, 9); P7_CE(3, 4); P7_CE(6, 13); P7_CE(8, 14); P7_CE(10, 15); P7_CE(11, 12);
        P7_CE(0, 1); P7_CE(2, 3); P7_CE(4, 5); P7_CE(6, 8); P7_CE(7, 9); P7_CE(10, 11); P7_CE(12, 13); P7_CE(14, 15);
        P7_CE(0, 2); P7_CE(1, 3); P7_CE(4, 10); P7_CE(5, 11); P7_CE(6, 7); P7_CE(8, 9); P7_CE(12, 14); P7_CE(13, 15);
        P7_CE(1, 2); P7_CE(3, 12); P7_CE(4, 6); P7_CE(5, 7); P7_CE(8, 10); P7_CE(9, 11); P7_CE(13, 14);
        P7_CE(1, 4); P7_CE(2, 6); P7_CE(5, 8); P7_CE(7, 10); P7_CE(9, 13); P7_CE(11, 14);
        P7_CE(2, 4); P7_CE(3, 6); P7_CE(9, 12); P7_CE(11, 13);
        P7_CE(3, 5); P7_CE(6, 8); P7_CE(7, 9); P7_CE(10, 12);
        P7_CE(3, 4); P7_CE(5, 6); P7_CE(7, 8); P7_CE(9, 10); P7_CE(11, 12);
        P7_CE(6, 7); P7_CE(8, 9);
#define P7_MERGE(CTRL) do { float t_[16]; \
            _Pragma("unroll") for (int i = 0; i < 16; ++i) t_[i] = fmaxf(v[i], dpp_f<CTRL, 0xf>(v[15 - i], v[15 - i])); \
            _Pragma("unroll") for (int i = 0; i < 16; ++i) v[i] = t_[i]; \
            _Pragma("unroll") for (int j = 8; j >= 1; j >>= 1) _Pragma("unroll") for (int i = 0; i < 16; ++i) if ((i & j) == 0) P7_CE(i, i + j); } while (0)
        P7_MERGE(0xB1); P7_MERGE(0x4E); P7_MERGE(0x141);
#undef P7_MERGE
#undef P7_CE
        if (j8 == 0) {
#pragma unroll
            for (int q = 0; q < 4; ++q) *(LAS f32x4*)(sl + g8 * 16 + 4 * q) = (f32x4){v[4 * q], v[4 * q + 1], v[4 * q + 2], v[4 * q + 3]};
        }
        LDS_WAIT(); asm volatile("" ::: "memory");
        float cv[4], og[4]; int id[4];
#pragma unroll
        for (int m = 0; m < 4; ++m) {
            const float s1 = sl[(2 * row) * 16 + ci[m]], s2 = sl[(2 * row + 1) * 16 + cj[m]];
            og[m] = cval[m] ? (s1 + s2) : NEG; cv[m] = og[m];
            id[m] = (int)((__builtin_bit_cast(unsigned, s1) & 127u) * 128u + (__builtin_bit_cast(unsigned, s2) & 127u));
        }
        LDS_WAIT(); asm volatile("" ::: "memory");
        float M0 = 0.f;
#pragma unroll
        for (int k = 0; k < 16; ++k) {
            float mx = fmaxf(fmaxf(cv[0], cv[1]), fmaxf(cv[2], cv[3]));
            mx = fmaxf(mx, dpp_f<0xB1, 0xf>(mx, mx));
            mx = fmaxf(mx, dpp_f<0x4E, 0xf>(mx, mx));
            mx = fmaxf(mx, dpp_f<0x141, 0xf>(mx, mx));
            mx = fmaxf(mx, dpp_f<0x140, 0xf>(mx, mx));
            if (k == 0) M0 = mx;
#pragma unroll
            for (int m = 0; m < 4; ++m) cv[m] = (cv[m] == mx) ? NEG : cv[m];
        }
        bool sel[4]; float e[4]; float es = 0.f;
#pragma unroll
        for (int m = 0; m < 4; ++m) { sel[m] = (cv[m] != og[m]); e[m] = sel[m] ? __expf(og[m] - M0) : 0.f; es += e[m]; }
        es += dpp_f<0xB1, 0xf>(0.f, es); es += dpp_f<0x4E, 0xf>(0.f, es); es += dpp_f<0x141, 0xf>(0.f, es); es += dpp_f<0x140, 0xf>(0.f, es);
        const float inv = 1.0f / es;
        int basepos = 0;
        const int head = 4 * hh + row;
#pragma unroll
        for (int m = 0; m < 4; ++m) {
            const unsigned long long bl = __ballot(sel[m]);
            const unsigned rbits = (unsigned)(bl >> (16 * row)) & 0xffffu;
            const int pos = basepos + __popc(rbits & ((1u << i16) - 1u));
            if (sel[m] && pos < 16) { ex[(size_t)t * 128 + head * 16 + pos] = id[m]; gt[(size_t)t * 128 + head * 16 + pos] = e[m] * inv; }
            basepos += __popc(rbits);
        }
    }
}

typedef __bf16 bf16x32v __attribute__((ext_vector_type(32)));
typedef __bf16 bf16x2v __attribute__((ext_vector_type(2)));
typedef float f32x2 __attribute__((ext_vector_type(2)));
#ifndef P8_THROTTLE
#define P8_THROTTLE 0
#endif
constexpr unsigned P8_SLACK = 12;
#ifndef P8_MIDSYNC
#define P8_MIDSYNC 2
#endif
__device__ __forceinline__ void phase8(const Params& p, LAS unsigned char* lds, float* dst, const XcdBarrier& xb, int gw, int NGW, int wave, int lane) {
    unsigned char* ws = p.ws;
    const bf16_t* x1b = (const bf16_t*)(ws + WS_X1B); const unsigned char* UT = ws + WS_UT; const unsigned char* VT = ws + WS_VT;
    const int* ex = (const int*)(ws + WS_EXP); const float* gt = (const float*)(ws + WS_GATE); const float* ss2 = (const float*)(ws + WS_ROWSS) + 3 * S;
    const float* out = p.out;
    LAS unsigned* list = (LAS unsigned*)(lds + 131072 + wave * 2048);
    LAS unsigned* hist = (LAS unsigned*)(lds + 147456 + wave * 1024);
    for (int tb = gw; tb < S / 4; tb += NGW) {
        const int t0 = tb * 4;
        int id[8]; float gv[8];
#pragma unroll
        for (int r = 0; r < 8; ++r) { const size_t o = (size_t)(t0 + (r >> 1)) * 128 + (r & 1) * 64 + lane; id[r] = ex[o]; gv[r] = gt[o]; }
        const float rs0 = rsqrtf(ss2[t0 + 0] * (1.0f / DM) + EPS) * (1.0f / PEER_USC), rs1 = rsqrtf(ss2[t0 + 1] * (1.0f / DM) + EPS) * (1.0f / PEER_USC);
        const float rs2 = rsqrtf(ss2[t0 + 2] * (1.0f / DM) + EPS) * (1.0f / PEER_USC), rs3 = rsqrtf(ss2[t0 + 3] * (1.0f / DM) + EPS) * (1.0f / PEER_USC);
#pragma unroll
        for (int j = 0; j < 4; ++j) hist[j * 64 + lane] = 0u;
        LDS_WAIT(); asm volatile("" ::: "memory");
        unsigned pos[8];
#pragma unroll
        for (int r = 0; r < 8; ++r) pos[r] = __hip_atomic_fetch_add(hist + (r >> 1) * 64 + (id[r] >> 8), 1u, __ATOMIC_RELAXED, __HIP_MEMORY_SCOPE_WORKGROUP);
        LDS_WAIT(); asm volatile("" ::: "memory");
        unsigned cnt[4], inc[4];
#pragma unroll
        for (int j = 0; j < 4; ++j) { cnt[j] = hist[j * 64 + lane]; inc[j] = cnt[j]; }
#pragma unroll
        for (int o = 1; o < 64; o <<= 1)
#pragma unroll
            for (int j = 0; j < 4; ++j) { const unsigned n = __shfl_up(inc[j], o); if (lane >= o) inc[j] += n; }
        LDS_WAIT(); asm volatile("" ::: "memory");
#pragma unroll
        for (int j = 0; j < 4; ++j) hist[j * 64 + lane] = inc[j] - cnt[j];
        LDS_WAIT(); asm volatile("" ::: "memory");
#pragma unroll
        for (int r = 0; r < 8; ++r) { const unsigned d = hist[(r >> 1) * 64 + (id[r] >> 8)] + pos[r]; list[4u * d + (unsigned)(r >> 1)] = (unsigned)id[r] | ((unsigned)(r >> 1) << 14) | (f2bf(gv[r]) << 16); }
        LDS_WAIT(); asm volatile("" ::: "memory");
        {
            typedef unsigned u32x16 __attribute__((ext_vector_type(16)));
            const __amdgpu_buffer_rsrc_t urs = __builtin_amdgcn_make_buffer_rsrc((void*)UT, 0, 16384 * PEER_ROWB, 0x00020000);
            const int vo4 = lane * 16, vo2 = lane * 8 + 1024;
            const bool lb0 = (lane & 1) != 0, lb1 = (lane & 2) != 0, lb2 = (lane & 4) != 0;
            s16x4 xr[4][8];
#pragma unroll
            for (int j = 0; j < 4; ++j)
#pragma unroll
                for (int q = 0; q < 8; ++q) xr[j][q] = __builtin_bit_cast(s16x4, *(const u32x2*)(x1b + (size_t)(t0 + j) * DM + (q * 64 + lane) * 4));
#define P8_ULOAD(k, i) do { const unsigned en = (unsigned)__builtin_amdgcn_readfirstlane((int)list[(i)]); const int ro = (int)((en & 0x3fffu) * (unsigned)PEER_ROWB); \
            u4[k] = __builtin_amdgcn_raw_buffer_load_b128(urs, vo4, ro, 0); u2[k] = __builtin_amdgcn_raw_buffer_load_b64(urs, vo2, ro, 0); } while (0)
#define P8_UPROC2(k, dk) do { const u32x6 pk = {u4[k][0], u4[k][1], u4[k][2], u4[k][3], u2[k][0], u2[k][1]}; \
            const u32x16 r_ = __builtin_bit_cast(u32x16, __builtin_amdgcn_cvt_scalef32_pk32_bf16_fp6(pk, 1.0f)); \
            f32x4 a0 = {0.f, 0.f, 0.f, 0.f}, a1 = {0.f, 0.f, 0.f, 0.f}; \
            _Pragma("unroll") for (int q = 0; q < 8; q += 2) { \
                a0 = __builtin_amdgcn_mfma_f32_4x4x4bf16_1k(__builtin_bit_cast(s16x4, (u32x2){r_[2 * q], r_[2 * q + 1]}), xr[(k) & 3][q], a0, 0, 0, 0); \
                a1 = __builtin_amdgcn_mfma_f32_4x4x4bf16_1k(__builtin_bit_cast(s16x4, (u32x2){r_[2 * q + 2], r_[2 * q + 3]}), xr[(k) & 3][q + 1], a1, 0, 0, 0); } \
            const f32x4 a_ = a0 + a1; \
            const float e0 = lb0 ? a_[1] : a_[0], e1 = lb0 ? a_[3] : a_[2]; dd[dk] = lb1 ? e1 : e0; } while (0)
#ifndef P8_URING
#define P8_URING 8
#endif
#if (PROBE_DUP >> 10) & 1
#define P8_UREPS 2
#else
#define P8_UREPS 1
#endif
#pragma unroll 1
            for (int urep = 0; urep < P8_UREPS; ++urep) {
                u32x4 u4[P8_URING]; u32x2 u2[P8_URING];
#pragma unroll
                for (int k = 0; k < P8_URING; ++k) P8_ULOAD(k, k);
#pragma unroll 1
                for (int i0 = 0; i0 < 512; i0 += P8_URING) {
#pragma unroll
                    for (int hb = 0; hb < P8_URING / 8; ++hb) {
                        const int i = i0 + 8 * hb;
                        const unsigned ev = list[i + (lane & 7)]; const unsigned jl = (unsigned)lane & 3u;
                        const float gl = __builtin_bit_cast(float, ev & 0xffff0000u), rl = jl == 0u ? rs0 : (jl == 1u ? rs1 : (jl == 2u ? rs2 : rs3));
                        float dd[8];
#pragma unroll
                        for (int k = 0; k < 8; ++k) { P8_UPROC2(8 * hb + k, k); const int nx = i + P8_URING + k; P8_ULOAD(8 * hb + k, nx < 512 ? nx : 508 + (k & 3)); }
                        float w4[4], w2[2];
#pragma unroll
                        for (int q = 0; q < 4; ++q) { const float kp = lb2 ? dd[q + 4] : dd[q], sd = lb2 ? dd[q] : dd[q + 4]; w4[q] = kp + __shfl_xor(sd, 4); }
#pragma unroll
                        for (int q = 0; q < 2; ++q) { const float kp = lb1 ? w4[q + 2] : w4[q], sd = lb1 ? w4[q] : w4[q + 2]; w2[q] = kp + __shfl_xor(sd, 2); }
                        float dres; { const float kp = lb0 ? w2[1] : w2[0], sd = lb0 ? w2[0] : w2[1]; dres = kp + __shfl_xor(sd, 1); }
                        dres += __shfl_xor(dres, 8); dres += __shfl_xor(dres, 16); dres += __shfl_xor(dres, 32);
                        const float c_ = gl * gelu_tanh(rl * dres) * (1.0f / PEER_VSC);
                        if (lane < 8 && urep == P8_UREPS - 1) list[i + lane] = (ev & 0xffffu) | (f2bf(c_) << 16);
                    }
                }
            }
#undef P8_ULOAD
#undef P8_UPROC2
        }
        asm volatile("s_waitcnt vmcnt(0)" ::: "memory");
        LDS_WAIT(); asm volatile("" ::: "memory");
#if P8_MIDSYNC == 1
        __syncthreads();
#elif P8_MIDSYNC == 2
        if (NGW == S / 4) xcd_local_barrier(xb);
#endif
        f32x4 acc[4][8];
#if (PROBE_DUP >> 12) & 1
#define P8_VREPS 2
#else
#define P8_VREPS 1
#endif
#ifndef P8_VRING
#define P8_VRING 8
#endif
#pragma unroll 1
        for (int vrep = 0; vrep < P8_VREPS; ++vrep) {
#pragma unroll
        for (int j = 0; j < 4; ++j)
#pragma unroll
            for (int q = 0; q < 8; ++q) acc[j][q] = (f32x4){0.f, 0.f, 0.f, 0.f};
        {
            typedef unsigned u32x16 __attribute__((ext_vector_type(16)));
            u32x4 v4[P8_VRING]; u32x2 v2[P8_VRING]; unsigned ven[P8_VRING];
            const unsigned li = (unsigned)lane & 3u;
            const unsigned m0 = li == 0u ? 0x0000ffffu : (li == 1u ? 0xffff0000u : 0u), m1 = li == 2u ? 0x0000ffffu : (li == 3u ? 0xffff0000u : 0u);
            const __amdgpu_buffer_rsrc_t vrs = __builtin_amdgcn_make_buffer_rsrc((void*)VT, 0, 16384 * PEER_ROWB, 0x00020000);
            const int vo4 = lane * 16, vo2 = lane * 8 + 1024;
#define P8_VLOAD(k, i) do { const unsigned en = (unsigned)__builtin_amdgcn_readfirstlane((int)list[(i)]); ven[k] = en; const int ro = (int)((en & 0x3fffu) * (unsigned)PEER_ROWB); \
            v4[k] = __builtin_amdgcn_raw_buffer_load_b128(vrs, vo4, ro, 0); v2[k] = __builtin_amdgcn_raw_buffer_load_b64(vrs, vo2, ro, 0); } while (0)
#define P8_VPROC(k) do { const u32x6 pk = {v4[k][0], v4[k][1], v4[k][2], v4[k][3], v2[k][0], v2[k][1]}; \
            const u32x16 r_ = __builtin_bit_cast(u32x16, __builtin_amdgcn_cvt_scalef32_pk32_bf16_fp6(pk, 1.0f)); \
            const unsigned e_ = ven[k], cf = (e_ >> 16) | (e_ & 0xffff0000u); \
            const s16x4 av = __builtin_bit_cast(s16x4, (u32x2){cf & m0, cf & m1}); \
            _Pragma("unroll") for (int q = 0; q < 8; ++q) \
                acc[(k) & 3][q] = __builtin_amdgcn_mfma_f32_4x4x4bf16_1k(av, __builtin_bit_cast(s16x4, (u32x2){r_[2 * q], r_[2 * q + 1]}), acc[(k) & 3][q], 0, 0, 0); } while (0)
#pragma unroll
            for (int k = 0; k < P8_VRING; ++k) P8_VLOAD(k, k);
#pragma unroll 1
            for (int i = 0; i < 512 - 512 % P8_VRING; i += P8_VRING) {
#pragma unroll
                for (int k = 0; k < P8_VRING; ++k) { P8_VPROC(k); const int nx = i + P8_VRING + k; P8_VLOAD(k, nx < 512 ? nx : 508 + (k & 3)); }
            }
#pragma unroll
            for (int k = 0; k < 512 % P8_VRING; ++k) P8_VPROC(k);
#undef P8_VLOAD
#undef P8_VPROC
        }
        }
        int tq = t0, lq = lane; asm volatile("" : "+s"(tq)); asm volatile("" : "+v"(lq));
#pragma unroll
        for (int j = 0; j < 4; ++j)
#pragma unroll
            for (int i = 0; i < 8; ++i) {
                const size_t o = (size_t)(tq + j) * DM + (i * 64 + lq) * 4;
                f32x4 a = *(const f32x4*)(out + o);
                a += acc[j][i];
                *(f32x4*)(dst + o) = a;
                if (i & 1) asm volatile("" ::: "memory");
            }
        LDS_WAIT(); asm volatile("" ::: "memory");
    }
}

__global__ void __launch_bounds__(NTHREADS, 2) mega(Params p) {
    extern __shared__ __attribute__((aligned(16))) unsigned char lds_raw[];
    LAS unsigned char* lds = (LAS unsigned char*)lds_raw;
    const int tid = threadIdx.x, lane = tid & 63, wave = __builtin_amdgcn_readfirstlane(tid >> 6);
    const int G = gridDim.x, bx = blockIdx.x;
    const int gw = bx * 8 + wave, NGW = G * 8;
    unsigned char* ws = p.ws;
    const int lo = p.ph_lo, hi = p.ph_hi;
    volatile LAS unsigned* misc = (volatile LAS unsigned*)(lds + LDS_MISC);
    if (tid < 4) misc[tid] = 0u;
    __syncthreads();
    const XcdBarrier xbar = xcd_barrier_post((unsigned*)(ws + WS_CTL), misc);
#ifndef PH_MASK
#define PH_MASK 0x1ff
#endif
#define IN(k) (((PH_MASK >> (k)) & 1) && lo <= (k) && (k) < hi)
#define SEAM(k) do { if (IN(k) && IN((k) + 1)) xcd_barrier(xbar); } while (0)

#if (PROBE_DUP >> 0) & 1
    if (IN(0)) { phase0(p, lds, G == 256, gw, NGW, wave, lane); xcd_barrier(xbar); }
#endif
    if (IN(0)) phase0(p, lds, G == 256, gw, NGW, wave, lane);
    SEAM(0);
    if (IN(1)) {
        pg8::Gemm g{(const bf16_t*)(ws + WS_XB), (const bf16_t*)(ws + WS_WIN), S, NINP, DM, DM, DM};
        pg8::StaticOrder So; So.init(S, NINP, G, bx);
        pg8::Epi<1> E{(const float*)(ws + WS_RSTD1), 0.f, (float*)(ws + WS_ROWSS), (bf16_t*)(ws + WS_PROJ), NINP, nullptr, nullptr};
#if (PROBE_DUP >> 1) & 1
        { pg8::Epi<1> E2 = E; E2.ss = (float*)(ws + 512 * 1024); pg8::gemm_phase<pg8::Epi<1>, pg8::StaticOrder, true, true>(lds, g, So, E2); xcd_barrier(xbar); }
#endif
        pg8::gemm_phase<pg8::Epi<1>, pg8::StaticOrder, true, true>(lds, g, So, E);
        if (G == 256 && bx >= 128) { __syncthreads(); prep_late(p, lds, (bx - 128) * 8 + wave, 1024, wave, lane); }
    }
    SEAM(1);
    if (IN(2)) {
        {
            pg8::Gemm g{(const bf16_t*)(ws + WS_PROJ) + 2048, (const bf16_t*)(ws + WS_WUQ), S, 1536, 512, NINP, 512};
            pg8::StaticOrder So; So.init(S, 1536, G, bx);
            pg8::Epi<2> E{(const float*)(ws + WS_ROWSS) + 1 * S, 1.0f / 512.0f, nullptr, (bf16_t*)(ws + WS_QRAW), 1536, nullptr, nullptr};
            pg8::gemm_phase<pg8::Epi<2>, pg8::StaticOrder, true, true>(lds, g, So, E);
        }
        __syncthreads();
        {
            pg8::Gemm g{(const bf16_t*)(ws + WS_PROJ) + 2560, (const bf16_t*)(ws + WS_WUKV), S, 2048, 256, NINP, 256};
            pg8::StaticOrder So; So.init(S, 2048, G, bx);
            pg8::Epi<2> E{(const float*)(ws + WS_ROWSS) + 2 * S, 1.0f / 256.0f, nullptr, (bf16_t*)(ws + WS_KVRAW), 2048, nullptr, nullptr};
            pg8::gemm_phase<pg8::Epi<2>, pg8::StaticOrder, true, true>(lds, g, So, E);
        }
    }
    SEAM(2);
#if (PROBE_DUP >> 3) & 1
    if (IN(3)) { phase3(p, gw, NGW, lane); xcd_barrier(xbar); }
#endif
    if (IN(3)) phase3(p, gw, NGW, lane);
    SEAM(3);
#define P4_BODY_ATT for (int pr = bx; pr < 256; pr += G) { const int head = pr & 7, x = pr >> 3; attn_unit(p, lds, head, 63 - x, tid, wave, lane); attn_unit(p, lds, head, x, tid, wave, lane); }
#define P4_BODY_GMLP for (int u = bx; u < 512; u += G) gmlp_unit(p, lds, u >> 3, u & 7, tid, wave, lane);
#if (PROBE_DUP >> 4) & 1
    if (IN(4)) { P4_BODY_ATT; xcd_barrier(xbar); }
#endif
#if (PROBE_DUP >> 9) & 1
    if (IN(4)) { P4_BODY_GMLP; xcd_barrier(xbar); }
#endif
    if (IN(4)) { P4_BODY_ATT; P4_BODY_GMLP; }
    SEAM(4);
    if (IN(5)) {
        pg8::Gemm g{(const bf16_t*)(ws + WS_MIX), (const bf16_t*)(ws + WS_WOUT), S, DM, DM, DM, DM};
        pg8::StaticOrder So; So.init(S, DM, G, bx);
        pg8::Epi<4> E{nullptr, 0.f, (float*)(ws + WS_ROWSS) + 3 * S, (bf16_t*)(ws + WS_X1B), DM, p.out, p.in[0]};
#if (PROBE_DUP >> 5) & 1
        { pg8::Epi<4> E2 = E; E2.ss = (float*)(ws + 512 * 1024); pg8::gemm_phase<pg8::Epi<4>, pg8::StaticOrder, true, true>(lds, g, So, E2); xcd_barrier(xbar); }
#endif
        pg8::gemm_phase<pg8::Epi<4>, pg8::StaticOrder, true, true>(lds, g, So, E);
    }
    SEAM(5);
    if (IN(6)) {
        pg8::Gemm g{(const bf16_t*)(ws + WS_X1B), (const bf16_t*)(ws + WS_WS), S, DM, DM, DM, DM};
        pg8::StaticOrder So; So.init(S, DM, G, bx);
        pg8::Epi<5> E{(const float*)(ws + WS_ROWSS) + 3 * S, 1.0f / DM, nullptr, nullptr, DM, (float*)(ws + WS_SC), nullptr};
#if (PROBE_DUP >> 6) & 1
        { pg8::gemm_phase<pg8::Epi<5>, pg8::StaticOrder, true, true>(lds, g, So, E); xcd_barrier(xbar); }
#endif
        pg8::gemm_phase<pg8::Epi<5>, pg8::StaticOrder, true, true>(lds, g, So, E);
    }
    SEAM(6);
#if (PROBE_DUP >> 7) & 1
    if (IN(7)) { phase7(p, lds, gw, NGW, wave, lane); xcd_barrier(xbar); }
#endif
    if (IN(7)) phase7(p, lds, gw, NGW, wave, lane);
    if (IN(7) && IN(8)) { if (NGW == S / 4) xcd_local_barrier(xbar); else xcd_barrier(xbar); }
#if (PROBE_DUP >> 8) & 1
    if (IN(8)) { phase8(p, lds, (float*)(ws + WS_SC), xbar, gw, NGW, wave, lane); xcd_barrier(xbar); }
#endif
    if (IN(8)) phase8(p, lds, p.out, xbar, gw, NGW, wave, lane);
#undef IN
#undef SEAM
}

extern "C" void kernel_launch(void* const* d_in, const int* in_sizes, int n_in, void* d_out, int out_size, void* d_ws, size_t ws_size, hipStream_t stream) {
    static int grid = 0;
    if (grid == 0) {
        if (n_in != 18 || out_size != S * DM || ws_size < WS_END) { fprintf(stderr, "kernel_launch: unexpected shapes (n_in %d out %d ws %zu)\n", n_in, out_size, ws_size); grid = -1; return; }
        int dev = 0, cus = 0, per_cu = 0;
        hipGetDevice(&dev);
        hipDeviceGetAttribute(&cus, hipDeviceAttributeMultiprocessorCount, dev);
        if (hipFuncSetAttribute((const void*)mega, hipFuncAttributeMaxDynamicSharedMemorySize, LDS_BYTES) != hipSuccess) { fprintf(stderr, "kernel_launch: hipFuncSetAttribute failed\n"); grid = -1; return; }
        if (hipOccupancyMaxActiveBlocksPerMultiprocessor(&per_cu, (const void*)mega, NTHREADS, LDS_BYTES) != hipSuccess || per_cu < 1) { fprintf(stderr, "kernel_launch: occupancy query failed (%d)\n", per_cu); grid = -1; return; }
        grid = cus;
        fprintf(stderr, "kernel_launch: cus %d per_cu %d grid %d\n", cus, per_cu, grid);
    }
    if (grid < 0) return;
    hipMemsetAsync((char*)d_ws + WS_CTL, 0, 1 * MiB, stream);
    Params prm{};
    for (int i = 0; i < 18; ++i) prm.in[i] = (const float*)d_in[i];
    prm.out = (float*)d_out; prm.ws = (unsigned char*)d_ws;
#if MK_ONE_LAUNCH
    prm.ph_lo = 0; prm.ph_hi = NPH;
    { void* args[] = {&prm}; hipError_t e = hipLaunchCooperativeKernel((const void*)mega, dim3(grid), dim3(NTHREADS), args, LDS_BYTES, stream);
      if (e != hipSuccess) fprintf(stderr, "cooperative launch failed: %s\n", hipGetErrorString(e)); }
#else
    for (int ph = 0; ph < NPH; ++ph) {
        prm.ph_lo = ph; prm.ph_hi = ph + 1;
        void* args[] = {&prm};
        hipError_t e = hipLaunchCooperativeKernel((const void*)mega, dim3(grid), dim3(NTHREADS), args, LDS_BYTES, stream);
        if (e != hipSuccess) { fprintf(stderr, "cooperative launch %d failed: %s\n", ph, hipGetErrorString(e)); break; }
    }
#endif
}
```

```cpp
#include <hip/hip_runtime.h>
#include <cstdio>
#include <cstdint>

#define LAS __attribute__((address_space(3)))
typedef unsigned short bf16_t;
typedef short bf16x8 __attribute__((ext_vector_type(8)));
typedef short s16x4 __attribute__((ext_vector_type(4)));
typedef float f32x4 __attribute__((ext_vector_type(4)));
typedef float f32x16 __attribute__((ext_vector_type(16)));
typedef unsigned u32x4 __attribute__((ext_vector_type(4)));
typedef unsigned u32x2 __attribute__((ext_vector_type(2)));

#ifndef PROBE_DUP
#define PROBE_DUP 0
#endif
#ifndef MK_ONE_LAUNCH
#define MK_ONE_LAUNCH 1
#endif

constexpr int S = 8192, DM = 2048, NIN = 2880, NINP = 3072;
constexpr int NPH = 9;
constexpr float EPS = 1e-6f;
constexpr int LDS_BYTES = 163840;
constexpr int NTHREADS = 512;
constexpr int LDS_MISC = 161792;

constexpr size_t MiB = 1u << 20;
constexpr size_t WS_CTL = 0;
constexpr size_t WS_ROWSS = 128 * 1024;
constexpr size_t WS_COS = 1 * MiB, WS_SIN = 2 * MiB;
constexpr size_t WS_RSTD1 = 3 * MiB;
constexpr size_t WS_EXP = 4 * MiB;
constexpr size_t WS_GATE = 8 * MiB;
constexpr size_t WS_WIN = 12 * MiB;
constexpr size_t WS_WUQ = 24 * MiB;
constexpr size_t WS_WUKV = 26 * MiB;
constexpr size_t WS_WOUT = 28 * MiB;
constexpr size_t WS_WS = 36 * MiB;
constexpr size_t WS_XB = 44 * MiB;
constexpr size_t WS_PROJ = 76 * MiB;
constexpr size_t WS_QRAW = 124 * MiB;
constexpr size_t WS_KVRAW = 148 * MiB;
constexpr size_t WS_QH = 180 * MiB;
constexpr size_t WS_KH = 204 * MiB;
constexpr size_t WS_VH = 228 * MiB;
constexpr size_t WS_MIX = 244 * MiB;
constexpr size_t WS_X1B = 276 * MiB;
constexpr size_t WS_SC = 308 * MiB;
constexpr size_t WS_UT = 372 * MiB;
constexpr size_t WS_VT = 436 * MiB;
constexpr size_t WS_END = 500 * MiB;

__device__ __forceinline__ unsigned f2bf(float f) { unsigned u = __builtin_bit_cast(unsigned, f); return (u + 0x7fffu + ((u >> 16) & 1u)) >> 16; }
__device__ __forceinline__ unsigned pk2(float lo, float hi) { return f2bf(lo) | (f2bf(hi) << 16); }
__device__ __forceinline__ float bf2f(unsigned short b) { return __builtin_bit_cast(float, (unsigned)b << 16); }
__device__ __forceinline__ float bflo(unsigned w) { return __builtin_bit_cast(float, w << 16); }
__device__ __forceinline__ float bfhi(unsigned w) { return __builtin_bit_cast(float, w & 0xffff0000u); }
__device__ __forceinline__ float wave_sum(float v) {
#pragma unroll
    for (int o = 32; o > 0; o >>= 1) v += __shfl_xor(v, o);
    return v;
}
__device__ __forceinline__ float wave_max(float v) {
#pragma unroll
    for (int o = 32; o > 0; o >>= 1) v = fmaxf(v, __shfl_xor(v, o));
    return v;
}
template <int CTRL, int ROW_MASK> __device__ __forceinline__ float dpp_f(float old, float v) {
    return __builtin_bit_cast(float, __builtin_amdgcn_update_dpp(__builtin_bit_cast(int, old), __builtin_bit_cast(int, v), CTRL, ROW_MASK, 0xf, false));
}
__device__ __forceinline__ float wave_max_u(float v) {
    v = fmaxf(v, dpp_f<0xB1, 0xf>(v, v));
    v = fmaxf(v, dpp_f<0x4E, 0xf>(v, v));
    v = fmaxf(v, dpp_f<0x141, 0xf>(v, v));
    v = fmaxf(v, dpp_f<0x140, 0xf>(v, v));
    v = fmaxf(v, dpp_f<0x142, 0xa>(v, v));
    v = fmaxf(v, dpp_f<0x143, 0xc>(v, v));
    return __builtin_bit_cast(float, __builtin_amdgcn_readlane(__builtin_bit_cast(int, v), 63));
}
__device__ __forceinline__ float wave_sum_u(float v) {
    v += dpp_f<0xB1, 0xf>(0.f, v);
    v += dpp_f<0x4E, 0xf>(0.f, v);
    v += dpp_f<0x141, 0xf>(0.f, v);
    v += dpp_f<0x140, 0xf>(0.f, v);
    v += dpp_f<0x142, 0xa>(0.f, v);
    v += dpp_f<0x143, 0xc>(0.f, v);
    return __builtin_bit_cast(float, __builtin_amdgcn_readlane(__builtin_bit_cast(int, v), 63));
}
__device__ __forceinline__ float gelu_tanh(float x) {
    const float y = 0.7978845608028654f * (x + 0.044715f * x * x * x);
    return x / (1.0f + __expf(-2.0f * y));
}
__device__ __forceinline__ int crow(int r, int hi) { return (r & 3) + 8 * (r >> 2) + 4 * hi; }
#define LDS_WAIT() asm volatile("s_waitcnt lgkmcnt(0)" ::: "memory")
#define SBAR() __builtin_amdgcn_sched_barrier(0)

namespace pg8 {
#define PG8_LAS __attribute__((address_space(3)))
constexpr int BM = 256, BK = 64, HALF = 128, HTB = HALF * BK * 2  , STAGE_BYTES = 8 * HTB, NXCD = 8, WGM = 8;

__host__ __device__ __forceinline__ int lds_byte(int r, int c) { const int st = (r >> 4) * 2 + (c >> 5), rr = r & 15, cc = c & 31, ob = rr * 64 + cc * 2; return st * 1024 + (ob ^ (((ob >> 9) & 1) << 5)); }
__host__ __device__ __forceinline__ void stage_rc(int b, int& R, int& C) { const int st = b / 1024, sb = b % 1024, swz = sb ^ (((sb >> 9) & 1) << 5); R = (st >> 1) * 16 + swz / 64; C = (st & 1) * 32 + (swz % 64) / 2; }
__host__ __device__ __forceinline__ int perm32(int rho) { const int n = rho >> 4, i = rho & 15; return 8 * (i >> 2) + 4 * n + (i & 3); }

struct Unit { int pm, pn; };
struct Gemm { const bf16_t* A; const bf16_t* Bt; int M, N, K, lda, ldb; };

struct StaticOrder {
    int nM, nN, nwg, G, c, fpm = -1, fpn = 0;
    __host__ __device__ void init(int M, int N, int G_, int c_) { nM = M / BM; nN = N / BM; nwg = nM * nN; G = G_; c = c_; fpm = -1; }
    __host__ __device__ void fixed(int pm, int pn) { fpm = pm; fpn = pn; }
    __host__ __device__ bool next(int i, Unit& u) const {
        if (fpm >= 0) { if (i > 0) return false; u.pm = fpm; u.pn = fpn; return true; }
        const long L = (long)i * G + c; if (L >= nwg) return false;
        int wgid = (int)L; { const int q = nwg / NXCD, r = nwg % NXCD, xcd = wgid % NXCD, off = wgid / NXCD; wgid = (xcd < r ? xcd * (q + 1) : r * (q + 1) + (xcd - r) * q) + off; }
        const int nig = WGM * nN, gid = wgid / nig, fm = gid * WGM, gsz = (nM - fm) < WGM ? (nM - fm) : WGM;
        u.pm = fm + ((wgid % nig) % gsz); u.pn = (wgid % nig) / gsz; return true;
    }
    __device__ __forceinline__ void a_ready(const Unit&) const {}
    __device__ __forceinline__ void done(const Unit&) const {}
};

template <class Epi, class Sched, bool ALIGN_EPI = false, bool SP2 = false>
__device__ __forceinline__ void gemm_phase(PG8_LAS unsigned char* lds, const Gemm g, const Sched& S, const Epi& E) {
    const int tid = threadIdx.x, wid = __builtin_amdgcn_readfirstlane(tid >> 6), lane = tid & 63, wr = wid >> 2, wc = wid & 3, fr = lane & 15, fq = lane >> 4;
    const int K = g.K, nt = K / BK;
    unsigned voffA[2], voffB[2];
#pragma unroll
    for (int i = 0; i < 2; ++i) { int R, C; stage_rc(tid * 16 + i * 8192, R, C); const int Rb = Epi::PERM ? ((R & ~31) + perm32(R & 31)) : R;
        voffA[i] = (unsigned)(R * g.lda + C) * 2u; voffB[i] = (unsigned)(Rb * g.ldb + C) * 2u; }
    const size_t kstep = (size_t)(BK * 2);
    const size_t hstepA = (size_t)HALF * g.lda * 2, hstepB = (size_t)HALF * g.ldb * 2;
    const size_t tstepA = 2 * hstepA, tstepB = 2 * hstepB;
    const unsigned ldsw = (unsigned)wid * 1024u;
    const int aoff = lds_byte(wr * 64 + fr, fq * 8), boff = lds_byte(wc * 32 + fr, fq * 8);
#define PG8_SA(b, h) (((b) * 2 + (h)) * HTB)
#define PG8_SB(b, h) ((4 + (b) * 2 + (h)) * HTB)
#define PG8_STAGE(bufoff, gbase, voff) do { _Pragma("unroll") for (int _i = 0; _i < 2; ++_i) \
        __builtin_amdgcn_global_load_lds((const unsigned*)((const char*)(gbase) + (voff)[_i]), (PG8_LAS unsigned*)(lds + (bufoff) + ldsw + _i * 8192), 16, 0, 0); } while (0)
#define PG8_LDA(dst, b, h) do { _Pragma("unroll") for (int m = 0; m < 4; ++m) _Pragma("unroll") for (int k = 0; k < 2; ++k) dst[m][k] = *(const PG8_LAS bf16x8*)(lds + PG8_SA(b, h) + aoff + m * 2048 + k * 1024); } while (0)
#define PG8_LDB(dst, b, h) do { _Pragma("unroll") for (int n = 0; n < 2; ++n) _Pragma("unroll") for (int k = 0; k < 2; ++k) dst[n][k] = *(const PG8_LAS bf16x8*)(lds + PG8_SB(b, h) + boff + n * 2048 + k * 1024); } while (0)
#define PG8_MMA(ai, bj, At, Bt) do { __builtin_amdgcn_s_setprio(1); _Pragma("unroll") for (int m = 0; m < 4; ++m) _Pragma("unroll") for (int n = 0; n < 2; ++n) _Pragma("unroll") for (int k = 0; k < 2; ++k) \
        acc[ai][bj][m][n] = __builtin_amdgcn_mfma_f32_16x16x32_bf16(Bt[n][k], At[m][k], acc[ai][bj][m][n], 0, 0, 0); __builtin_amdgcn_s_setprio(0); } while (0)
#define PG8_WAIT_V(n) asm volatile("s_waitcnt vmcnt(" #n ")" ::: "memory")
#define PG8_WAIT_L(n) asm volatile("s_waitcnt lgkmcnt(" #n ")" ::: "memory")
#define PG8_BAR __builtin_amdgcn_s_barrier()
#define PG8_SCHED __builtin_amdgcn_sched_barrier(0)
    Unit cur, nxt; int ui = 0;
    if (!S.next(0, cur)) return;
    f32x4 acc[2][2][4][2];
#pragma unroll
    for (int a = 0; a < 2; ++a)
#pragma unroll
        for (int b = 0; b < 2; ++b)
#pragma unroll
            for (int m = 0; m < 4; ++m)
#pragma unroll
                for (int n = 0; n < 2; ++n) acc[a][b][m][n] = (f32x4){0.f, 0.f, 0.f, 0.f};
    bf16x8 At[4][2], B0[2][2], B1[2][2];
    const char* cA = (const char*)g.A + (size_t)cur.pm * tstepA; const char* cB = (const char*)g.Bt + (size_t)cur.pn * tstepB;
    S.a_ready(cur);
    if constexpr (SP2) {
        PG8_STAGE(PG8_SB(0, 0), cB, voffB); PG8_STAGE(PG8_SB(0, 1), cB + hstepB, voffB); PG8_STAGE(PG8_SA(0, 0), cA, voffA); PG8_STAGE(PG8_SA(0, 1), cA + hstepA, voffA);
        if (wr == 1) PG8_BAR;
        PG8_WAIT_V(2); PG8_BAR;
        PG8_STAGE(PG8_SB(1, 0), cB + kstep, voffB); PG8_STAGE(PG8_SA(1, 0), cA + kstep, voffA); PG8_STAGE(PG8_SB(1, 1), cB + hstepB + kstep, voffB);
        PG8_WAIT_V(6); PG8_BAR;
    } else {
        PG8_STAGE(PG8_SB(0, 0), cB, voffB); PG8_STAGE(PG8_SA(0, 0), cA, voffA); PG8_STAGE(PG8_SB(0, 1), cB + hstepB, voffB); PG8_STAGE(PG8_SA(0, 1), cA + hstepA, voffA);
        if (wr == 1) PG8_BAR;
        PG8_WAIT_V(4); PG8_BAR;
        PG8_STAGE(PG8_SB(1, 0), cB + kstep, voffB); PG8_STAGE(PG8_SA(1, 0), cA + kstep, voffA); PG8_STAGE(PG8_SB(1, 1), cB + hstepB + kstep, voffB);
        PG8_WAIT_V(6); PG8_BAR;
    }
    for (;;) {
        const bool has_next = S.next(ui + 1, nxt);
        const char* nA = has_next ? (const char*)g.A + (size_t)nxt.pm * tstepA : cA; const char* nB = has_next ? (const char*)g.Bt + (size_t)nxt.pn * tstepB : cB;
        for (int t = 0; t < nt; t += 2) {
            const bool last = (t == nt - 2);
            const char* a1 = cA + (size_t)(t + 1) * kstep;
            const char* a2 = last ? nA : cA + (size_t)(t + 2) * kstep; const char* b2 = last ? nB : cB + (size_t)(t + 2) * kstep;
            const char* a3 = a2 + kstep; const char* b3 = b2 + kstep;
            if (last && has_next) S.a_ready(nxt);
            if constexpr (SP2) {
            PG8_LDB(B0, 0, 0); PG8_LDB(B1, 0, 1); PG8_SCHED; PG8_LDA(At, 0, 0); PG8_STAGE(PG8_SA(1, 1), a1 + hstepA, voffA);
            PG8_WAIT_V(8); PG8_WAIT_L(0); PG8_BAR; PG8_MMA(0, 0, At, B0); PG8_MMA(0, 1, At, B1); PG8_BAR; PG8_SCHED;
            PG8_LDA(At, 0, 1); PG8_STAGE(PG8_SB(0, 0), b2, voffB); PG8_STAGE(PG8_SB(0, 1), b2 + hstepB, voffB); PG8_STAGE(PG8_SA(0, 0), a2, voffA);
            PG8_WAIT_V(8); PG8_WAIT_L(0); PG8_BAR; PG8_MMA(1, 0, At, B0); PG8_MMA(1, 1, At, B1); PG8_BAR; PG8_SCHED;
            PG8_LDB(B0, 1, 0); PG8_LDB(B1, 1, 1); PG8_SCHED; PG8_LDA(At, 1, 0); PG8_STAGE(PG8_SA(0, 1), a2 + hstepA, voffA);
            PG8_WAIT_V(8); PG8_WAIT_L(0); PG8_BAR; PG8_MMA(0, 0, At, B0); PG8_MMA(0, 1, At, B1); PG8_BAR; PG8_SCHED;
            PG8_LDA(At, 1, 1); PG8_STAGE(PG8_SB(1, 0), b3, voffB); PG8_STAGE(PG8_SB(1, 1), b3 + hstepB, voffB); PG8_STAGE(PG8_SA(1, 0), a3, voffA);
            PG8_WAIT_V(8); PG8_WAIT_L(0); PG8_BAR; PG8_MMA(1, 0, At, B0); PG8_MMA(1, 1, At, B1); PG8_BAR; PG8_SCHED;
            } else {
            PG8_LDB(B0, 0, 0); PG8_SCHED; PG8_LDA(At, 0, 0); PG8_STAGE(PG8_SA(1, 1), a1 + hstepA, voffA);
            PG8_WAIT_L(8); PG8_BAR; PG8_WAIT_L(0); PG8_MMA(0, 0, At, B0); PG8_BAR; PG8_SCHED;
            PG8_LDB(B1, 0, 1); PG8_STAGE(PG8_SB(0, 0), b2, voffB);
            PG8_BAR; PG8_WAIT_L(0); PG8_MMA(0, 1, At, B1); PG8_BAR;
            PG8_LDA(At, 0, 1); PG8_STAGE(PG8_SA(0, 0), a2, voffA);
            PG8_BAR; PG8_WAIT_L(0); PG8_MMA(1, 0, At, B0); PG8_BAR; PG8_SCHED;
            PG8_STAGE(PG8_SB(0, 1), b2 + hstepB, voffB);
            PG8_WAIT_V(6); PG8_BAR; PG8_MMA(1, 1, At, B1); PG8_BAR;
            PG8_LDB(B0, 1, 0); PG8_SCHED; PG8_LDA(At, 1, 0); PG8_STAGE(PG8_SA(0, 1), a2 + hstepA, voffA);
            PG8_WAIT_L(8); PG8_BAR; PG8_WAIT_L(0); PG8_MMA(0, 0, At, B0); PG8_BAR; PG8_SCHED;
            PG8_LDB(B1, 1, 1); PG8_STAGE(PG8_SB(1, 0), b3, voffB);
            PG8_BAR; PG8_WAIT_L(0); PG8_MMA(0, 1, At, B1); PG8_BAR;
            PG8_LDA(At, 1, 1); PG8_STAGE(PG8_SA(1, 0), a3, voffA);
            PG8_BAR; PG8_WAIT_L(0); PG8_MMA(1, 0, At, B0); PG8_BAR; PG8_SCHED;
            PG8_STAGE(PG8_SB(1, 1), b3 + hstepB, voffB);
            PG8_WAIT_V(6); PG8_BAR; PG8_MMA(1, 1, At, B1); PG8_BAR;
            }
        }
        if constexpr (ALIGN_EPI) { if (wr == 0) PG8_BAR; }
        if constexpr (!Epi::AFTER_DRAIN) { E(acc, cur, wr, wc, fr, fq); S.done(cur); }
        if (!has_next) break;
#pragma unroll
        for (int a = 0; a < 2; ++a)
#pragma unroll
            for (int b = 0; b < 2; ++b)
#pragma unroll
                for (int m = 0; m < 4; ++m)
#pragma unroll
                    for (int n = 0; n < 2; ++n) acc[a][b][m][n] = (f32x4){0.f, 0.f, 0.f, 0.f};
        cur = nxt; cA = nA; cB = nB; ++ui;
        if constexpr (ALIGN_EPI) { if (wr == 1) PG8_BAR; }
    }
    PG8_WAIT_V(0);
    if constexpr (!ALIGN_EPI) { if (wr == 0) PG8_BAR; }
    PG8_BAR;
#undef PG8_SA
#undef PG8_SB
#undef PG8_STAGE
#undef PG8_LDA
#undef PG8_LDB
#undef PG8_MMA
#undef PG8_WAIT_V
#undef PG8_WAIT_L
#undef PG8_BAR
#undef PG8_SCHED
}

template <int MODE> struct Epi {
    static constexpr bool PERM = false, AFTER_DRAIN = false;
    const float* rowsrc; float inv_n; float* ss; bf16_t* ob; int ldc; float* of; const float* xin;
    __device__ __forceinline__ void operator()(const f32x4 (&acc)[2][2][4][2], const Unit& u, int wr, int wc, int fr, int fq) const {
#pragma unroll
        for (int ai = 0; ai < 2; ++ai)
#pragma unroll
            for (int m = 0; m < 4; ++m) {
                const int row = u.pm * BM + ai * HALF + wr * 64 + m * 16 + fr;
                float rs = 1.f;
                if (MODE == 1) rs = rowsrc[row];
                if (MODE == 2 || MODE == 5) rs = rsqrtf(rowsrc[row] * inv_n + EPS);
                float ssq = 0.f;
#pragma unroll
                for (int bj = 0; bj < 2; ++bj)
#pragma unroll
                    for (int n = 0; n < 2; ++n) {
                        const int col = u.pn * BM + bj * HALF + wc * 32 + n * 16 + fq * 4;
                        f32x4 v = acc[ai][bj][m][n] * rs;
                        if (MODE == 1) { if (u.pn < 8) { v[0] = gelu_tanh(v[0]); v[1] = gelu_tanh(v[1]); v[2] = gelu_tanh(v[2]); v[3] = gelu_tanh(v[3]); } }
                        if (MODE == 4) { const f32x4 xr = *(const f32x4*)(xin + (size_t)row * DM + col); v = v + xr; }
                        if (MODE == 1 || MODE == 4) ssq += (v[0] * v[0] + v[1] * v[1]) + (v[2] * v[2] + v[3] * v[3]);
                        if (MODE == 1 || MODE == 2 || MODE == 4) { u32x2 w; w.x = pk2(v[0], v[1]); w.y = pk2(v[2], v[3]); *(u32x2*)(ob + (size_t)row * ldc + col) = w; }
                        if (MODE == 4 || MODE == 5) *(f32x4*)(of + (size_t)row * DM + col) = v;
                    }
                if (MODE == 1) {
                    const int seg = (u.pn >= 4 && u.pn < 8) ? 0 : ((u.pn == 8 || u.pn == 9) ? 1 : (u.pn == 10 ? 2 : -1));
                    if (seg >= 0) { ssq += __shfl_xor(ssq, 16); ssq += __shfl_xor(ssq, 32); if (fq == 0) atomicAdd(ss + seg * S + row, ssq); }
                }
                if (MODE == 4) { ssq += __shfl_xor(ssq, 16); ssq += __shfl_xor(ssq, 32); if (fq == 0) atomicAdd(ss + row, ssq); }
            }
    }
};
}

#define XB_TMO      128
#define XB_XCNT(j)  (256  + 64 * (j))
#define XB_XSUB(j)  (1280 + 64 * (j))
#define XB_XGEN(j)  (2304 + 64 * (j))
#define XB_TOP      3328
#define XB_TOPGEN   3392
#define XCD_BAR_WORDS 3456
#define XB_SPIN_CAP (1u << 18)
__device__ __forceinline__ unsigned xb_ld(unsigned* p)              { return __hip_atomic_load(p, __ATOMIC_RELAXED, __HIP_MEMORY_SCOPE_AGENT); }
__device__ __forceinline__ unsigned xb_add(unsigned* p, unsigned v) { return __hip_atomic_fetch_add(p, v, __ATOMIC_RELAXED, __HIP_MEMORY_SCOPE_AGENT); }
__device__ __forceinline__ unsigned xb_xcc_id() { return (unsigned)__builtin_amdgcn_s_getreg((3 << 11) | 20) & 0xFu; }
#define XB_SPIN(cond, bar) do { unsigned _sp = 0; while (cond) { __builtin_amdgcn_s_sleep(1); \
    if ((++_sp & 255u) == 0u) { if (xb_ld(&(bar)[XB_TMO])) break; if (_sp > XB_SPIN_CAP) { atomicAdd(&(bar)[XB_TMO], 1u); break; } } } } while (0)
struct XcdBarrier { unsigned* bar; unsigned x; volatile LAS unsigned* st; };
__device__ __forceinline__ XcdBarrier xcd_barrier_post(unsigned* bar, volatile LAS unsigned* st) {
    XcdBarrier b; b.bar = bar; b.x = xb_xcc_id(); b.st = st;
    if (threadIdx.x == 0) st[3] = xb_add(&bar[XB_XCNT(b.x)], 1u);
    return b;
}
__device__ __forceinline__ void xcd_barrier_complete(unsigned* bar, unsigned x, unsigned& nloc, unsigned& nx, unsigned& eq32) {
    const unsigned G = gridDim.x * gridDim.y * gridDim.z;
    unsigned sum, cnt, mine, sp = 0u;
    for (;;) {
        sum = 0u; cnt = 0u; mine = 0u; eq32 = 1u;
#pragma unroll
        for (unsigned j = 0; j < 16; ++j) { const unsigned c = xb_ld(&bar[XB_XCNT(j)]); sum += c; cnt += (c > 0u) ? 1u : 0u; mine = (j == x) ? c : mine; if (c != (j < 8u ? 32u : 0u)) eq32 = 0u; }
        if (sum == G) break;
        __builtin_amdgcn_s_sleep(1);
        if ((++sp & 255u) == 0u) { if (xb_ld(&bar[XB_TMO])) break; if (sp > XB_SPIN_CAP) { atomicAdd(&bar[XB_TMO], 1u); break; } }
    }
    nloc = mine > 0u ? mine : 1u; nx = cnt > 0u ? cnt : 1u;
}
#define XB_LSUB(j)  (3456 + 64 * (j))
#define XB_LGEN(j)  (4480 + 64 * (j))
__device__ __forceinline__ void xcd_local_barrier(const XcdBarrier& b) {
    asm volatile("s_waitcnt vmcnt(0)" ::: "memory");
    __syncthreads();
    if (threadIdx.x == 0) {
        unsigned* bar = b.bar;
        const unsigned nloc = b.st[0];
        const unsigned old = xb_add(&bar[XB_LSUB(b.x)], 1u);
        const unsigned gen = old / nloc;
        if (old + 1u == (gen + 1u) * nloc) xb_add(&bar[XB_LGEN(b.x)], 1u);
        else XB_SPIN(xb_ld(&bar[XB_LGEN(b.x)]) == gen, bar);
    }
    __syncthreads();
}
__device__ __forceinline__ void xcd_local_barrier_acq(const XcdBarrier& b) {
    asm volatile("s_waitcnt vmcnt(0)" ::: "memory");
    __syncthreads();
    if (threadIdx.x == 0) {
        unsigned* bar = b.bar;
        __builtin_amdgcn_s_waitcnt(0);
        const unsigned nloc = b.st[0];
        const unsigned old = xb_add(&bar[XB_LSUB(b.x)], 1u);
        const unsigned gen = old / nloc;
        if (old + 1u == (gen + 1u) * nloc) xb_add(&bar[XB_LGEN(b.x)], 1u);
        else XB_SPIN(xb_ld(&bar[XB_LGEN(b.x)]) == gen, bar);
        __builtin_amdgcn_fence(__ATOMIC_ACQUIRE, "agent");
        asm volatile("s_waitcnt vmcnt(0)" ::: "memory");
    }
    __syncthreads();
}
__device__ __forceinline__ void xcd_barrier(const XcdBarrier& b) {
    asm volatile("s_waitcnt vmcnt(0)" ::: "memory");
    __syncthreads();
    if (threadIdx.x == 0) {
        unsigned* bar = b.bar;
        __builtin_amdgcn_s_waitcnt(0);
        unsigned nloc = b.st[0], nx = b.st[1];
        if (nloc == 0u) { unsigned eq32; xcd_barrier_complete(bar, b.x, nloc, nx, eq32); b.st[0] = nloc; b.st[1] = nx; b.st[2] = eq32; }
        const unsigned old = xb_add(&bar[XB_XSUB(b.x)], 1u);
        const unsigned gen = old / nloc;
        if (old + 1u == (gen + 1u) * nloc) {
            __builtin_amdgcn_fence(__ATOMIC_RELEASE, "agent");
            asm volatile("s_waitcnt vmcnt(0)" ::: "memory");
            const unsigned og = xb_add(&bar[XB_TOP], 1u);
            const unsigned tg = og / nx;
            if (og + 1u == (tg + 1u) * nx) xb_add(&bar[XB_TOPGEN], 1u);
            else XB_SPIN(xb_ld(&bar[XB_TOPGEN]) == tg, bar);
            __builtin_amdgcn_fence(__ATOMIC_ACQUIRE, "agent");
            xb_add(&bar[XB_XGEN(b.x)], 1u);
            asm volatile("s_waitcnt vmcnt(0)" ::: "memory");
        } else {
            XB_SPIN(xb_ld(&bar[XB_XGEN(b.x)]) == gen, bar);
            __builtin_amdgcn_fence(__ATOMIC_ACQUIRE, "agent");
            asm volatile("s_waitcnt vmcnt(0)" ::: "memory");
        }
    }
    __syncthreads();
}

struct Params {
    const float* in[18];
    float* out;
    unsigned char* ws;
    int ph_lo, ph_hi;
};

__device__ __forceinline__ void p0_transpose_item(const float* W, const float* g, int K, int N, bf16_t* WT, LAS float* scr, int item, int lane) {
    const int nblk = N / 32, kb = item / nblk, nb = item % nblk, k0 = 64 * kb, n0 = 32 * nb;
    float wv[32];
#pragma unroll
    for (int i = 0; i < 32; ++i) { const int kk = 2 * i + (lane >> 5); wv[i] = W[(size_t)(k0 + kk) * N + n0 + (lane & 31)]; }
#pragma unroll
    for (int i = 0; i < 32; ++i) { const int kk = 2 * i + (lane >> 5); const float gv = g ? g[k0 + kk] : 1.f; scr[kk * 33 + (lane & 31)] = wv[i] * gv; }
    LDS_WAIT(); asm volatile("" ::: "memory");
    const int c = lane & 7;
#pragma unroll
    for (int j = 0; j < 4; ++j) { const int n = (lane >> 3) + 8 * j; const LAS float* s = scr + (8 * c) * 33 + n;
        u32x4 o; o.x = pk2(s[0 * 33], s[1 * 33]); o.y = pk2(s[2 * 33], s[3 * 33]); o.z = pk2(s[4 * 33], s[5 * 33]); o.w = pk2(s[6 * 33], s[7 * 33]);
        *(u32x4*)(WT + (size_t)(n0 + n) * K + k0 + 8 * c) = o; }
    LDS_WAIT(); asm volatile("" ::: "memory");
}
__device__ __forceinline__ float row_to_bf16(const float* src, const float* g, bf16_t* dst, int lane) {
    float ss = 0.f;
#pragma unroll
    for (int i = 0; i < 8; ++i) {
        const int c = (i * 64 + lane) * 4;
        f32x4 v = *(const f32x4*)(src + c);
        ss += (v[0] * v[0] + v[1] * v[1]) + (v[2] * v[2] + v[3] * v[3]);
        if (g) { const f32x4 gv = *(const f32x4*)(g + c); v = v * gv; }
        u32x2 w; w.x = pk2(v[0], v[1]); w.y = pk2(v[2], v[3]);
        *(u32x2*)(dst + c) = w;
    }
    return ss;
}
constexpr float PEER_USC = 80.0f, PEER_VSC = 5.0f;
constexpr int PEER_ROWB = 1536;
typedef float f32x16v __attribute__((ext_vector_type(16)));
typedef float f32x32v __attribute__((ext_vector_type(32)));
typedef unsigned u32x6 __attribute__((ext_vector_type(6)));
typedef unsigned u32x2a4 __attribute__((ext_vector_type(2), aligned(4)));
template <bool CONTIG>
__device__ __forceinline__ void fp6_pack_store(const f32x4 (&x)[8], const f32x4 (&sc)[8], unsigned char* dst, int lane) {
    f32x16v a, b;
#pragma unroll
    for (int i = 0; i < 8; ++i) {
        const f32x4 y = x[i] * sc[i];
#pragma unroll
        for (int q = 0; q < 4; ++q) { const float c = fminf(fmaxf(y[q], -7.5f), 7.5f); const int sl = 4 * i + q; if ((sl & 1) == 0) a[sl >> 1] = c; else b[sl >> 1] = c; }
    }
    const u32x6 pk = __builtin_amdgcn_cvt_scalef32_2xpk16_fp6_f32(a, b, 1.0f);
    asm volatile("s_nop 15" : "+v"(a), "+v"(b));
    if (CONTIG) {
        *(u32x2*)(dst + lane * 24) = (u32x2){pk[0], pk[1]}; *(u32x2*)(dst + lane * 24 + 8) = (u32x2){pk[2], pk[3]}; *(u32x2*)(dst + lane * 24 + 16) = (u32x2){pk[4], pk[5]};
    } else {
        *(u32x4*)(dst + lane * 16) = (u32x4){pk[0], pk[1], pk[2], pk[3]};
        *(u32x2*)(dst + 1024 + lane * 8) = (u32x2){pk[4], pk[5]};
    }
}
template <bool CONTIG>
__device__ __forceinline__ void rows2_to_fp6(const float* s0, const float* s1, const f32x4 (&sc)[8], unsigned char* d0, unsigned char* d1, int lane) {
    f32x4 x0[8], x1[8];
#pragma unroll
    for (int i = 0; i < 8; ++i) { x0[i] = *(const f32x4*)(s0 + (i * 64 + lane) * 4); x1[i] = *(const f32x4*)(s1 + (i * 64 + lane) * 4); }
    fp6_pack_store<CONTIG>(x0, sc, d0, lane); fp6_pack_store<CONTIG>(x1, sc, d1, lane);
}
__device__ __forceinline__ bf16x8 cvt8(const float* p) {
    const f32x4 a = *(const f32x4*)p, b = *(const f32x4*)(p + 4);
    u32x4 w; w.x = pk2(a[0], a[1]); w.y = pk2(a[2], a[3]); w.z = pk2(b[0], b[1]); w.w = pk2(b[2], b[3]);
    return __builtin_bit_cast(bf16x8, w);
}

__device__ __forceinline__ void prep_late(const Params& p, LAS unsigned char* lds, int gw, int NGW, int wave, int lane) {
    unsigned char* ws = p.ws;
    LAS float* scr = (LAS float*)(lds + wave * 16384);
    {
        constexpr int I_UQ = (512 / 64) * (1536 / 32), I_UKV = (256 / 64) * (2048 / 32), I_OUT = (DM / 64) * (DM / 32);
        constexpr int NIT = I_UQ + I_UKV + I_OUT;
        for (int it = gw; it < NIT; it += NGW) {
            int r = it;
            if (r < I_UQ) { p0_transpose_item(p.in[7], p.in[6], 512, 1536, (bf16_t*)(ws + WS_WUQ), scr, r, lane); continue; } r -= I_UQ;
            if (r < I_UKV) { p0_transpose_item(p.in[9], p.in[8], 256, 2048, (bf16_t*)(ws + WS_WUKV), scr, r, lane); continue; } r -= I_UKV;
            p0_transpose_item(p.in[12], nullptr, DM, DM, (bf16_t*)(ws + WS_WOUT), scr, r, lane);
        }
    }
    {
        const float* wq = p.in[14]; const float* sk = p.in[15]; const float* g2 = p.in[13];
        bf16_t* WsT = (bf16_t*)(ws + WS_WS);
        const int r32 = lane & 31, hh = lane >> 5;
        for (int it = gw; it < 16 * 4 * 64; it += NGW) {
            const int hp = it >> 8, kb = (it >> 6) & 3, nb = it & 63;
            f32x16 acc = {};
            const float* ap = sk + ((size_t)(hp * 128 + kb * 32 + r32)) * 128 + hh * 8;
            const float* bp = wq + ((size_t)(nb * 32 + r32)) * DM + hp * 128 + hh * 8;
#pragma unroll
            for (int s = 0; s < 8; ++s) {
                const bf16x8 a = cvt8(ap + s * 16), b = cvt8(bp + s * 16);
                acc = __builtin_amdgcn_mfma_f32_32x32x16_bf16(a, b, acc, 0, 0, 0);
            }
            const int kcol = nb * 32 + r32; const float gk = g2[kcol];
#pragma unroll
            for (int r = 0; r < 16; ++r) WsT[(size_t)(hp * 128 + kb * 32 + crow(r, hh)) * DM + kcol] = (bf16_t)f2bf(acc[r] * gk);
        }
    }
    {
        float* ct = (float*)(ws + WS_COS); float* st = (float*)(ws + WS_SIN);
        for (int it = gw; it < S * 32 / 64; it += NGW) {
            const int idx = it * 64 + lane, t = idx >> 5, j = idx & 31;
            const float inv_freq = powf(10000.0f, -(float)j / 32.0f);
            const float ang = (float)t * inv_freq;
            float sv, cv; sincosf(ang, &sv, &cv); ct[idx] = cv; st[idx] = sv;
        }
    }
}
__device__ __forceinline__ void phase0(const Params& p, LAS unsigned char* lds, bool late_ok, int gw, int NGW, int wave, int lane) {
    unsigned char* ws = p.ws;
    LAS float* scr = (LAS float*)(lds + wave * 16384);
    const float* x = p.in[0];
    {
        constexpr int I_IN = (DM / 64) * (NIN / 32);
        for (int it = gw; it < I_IN; it += NGW) p0_transpose_item(p.in[2], p.in[1], DM, NIN, (bf16_t*)(ws + WS_WIN), scr, it, lane);
    }
    if (!late_ok) prep_late(p, lds, gw, NGW, wave, lane);
    for (int r = gw; r < NINP - NIN; r += NGW) {
        bf16_t* d = (bf16_t*)(ws + WS_WIN) + (size_t)(NIN + r) * DM;
#pragma unroll
        for (int i = 0; i < 4; ++i) *(u32x4*)(d + (i * 64 + lane) * 8) = (u32x4){0u, 0u, 0u, 0u};
    }
    {
        bf16_t* xb = (bf16_t*)(ws + WS_XB); float* rstd1 = (float*)(ws + WS_RSTD1);
        for (int t = gw; t + NGW < S; t += 2 * NGW) {
            const int t1 = t + NGW;
            f32x4 a[8], b[8];
#pragma unroll
            for (int i = 0; i < 8; ++i) { a[i] = *(const f32x4*)(x + (size_t)t * DM + (i * 64 + lane) * 4); b[i] = *(const f32x4*)(x + (size_t)t1 * DM + (i * 64 + lane) * 4); }
            float sa = 0.f, sb = 0.f;
#pragma unroll
            for (int i = 0; i < 8; ++i) {
                sa += (a[i][0] * a[i][0] + a[i][1] * a[i][1]) + (a[i][2] * a[i][2] + a[i][3] * a[i][3]);
                sb += (b[i][0] * b[i][0] + b[i][1] * b[i][1]) + (b[i][2] * b[i][2] + b[i][3] * b[i][3]);
                u32x2 wa, wb; wa.x = pk2(a[i][0], a[i][1]); wa.y = pk2(a[i][2], a[i][3]); wb.x = pk2(b[i][0], b[i][1]); wb.y = pk2(b[i][2], b[i][3]);
                *(u32x2*)(xb + (size_t)t * DM + (i * 64 + lane) * 4) = wa; *(u32x2*)(xb + (size_t)t1 * DM + (i * 64 + lane) * 4) = wb;
            }
            sa = wave_sum(sa); sb = wave_sum(sb);
            if (lane == 0) { rstd1[t] = rsqrtf(sa * (1.0f / DM) + EPS); rstd1[t1] = rsqrtf(sb * (1.0f / DM) + EPS); }
        }
    }
    {
        unsigned char* UT = ws + WS_UT; unsigned char* VT = ws + WS_VT;
        f32x4 sc[8];
#pragma unroll
        for (int i = 0; i < 8; ++i) sc[i] = *(const f32x4*)(p.in[13] + (i * 64 + lane) * 4) * PEER_USC;
        for (int e = gw; e + NGW < 16384; e += 2 * NGW)
            rows2_to_fp6<false>(p.in[16] + (size_t)e * DM, p.in[16] + (size_t)(e + NGW) * DM, sc, UT + (size_t)e * PEER_ROWB, UT + (size_t)(e + NGW) * PEER_ROWB, lane);
#pragma unroll
        for (int i = 0; i < 8; ++i) sc[i] = (f32x4){PEER_VSC, PEER_VSC, PEER_VSC, PEER_VSC};
        for (int e = gw; e + NGW < 16384; e += 2 * NGW)
            rows2_to_fp6<false>(p.in[17] + (size_t)e * DM, p.in[17] + (size_t)(e + NGW) * DM, sc, VT + (size_t)e * PEER_ROWB, VT + (size_t)(e + NGW) * PEER_ROWB, lane);
    }
}

__device__ __forceinline__ void phase3(const Params& p, int gw, int NGW, int lane) {
    unsigned char* ws = p.ws;
    const bf16_t* qraw = (const bf16_t*)(ws + WS_QRAW); const bf16_t* kvraw = (const bf16_t*)(ws + WS_KVRAW); const bf16_t* proj = (const bf16_t*)(ws + WS_PROJ);
    bf16_t* Qh = (bf16_t*)(ws + WS_QH); bf16_t* Kh = (bf16_t*)(ws + WS_KH);
    const float* ct = (const float*)(ws + WS_COS); const float* st = (const float*)(ws + WS_SIN);
    const bool act = lane < 48, isrope = lane >= 32 && lane < 48, lowhalf = lane < 40;
    const int e0 = act ? 4 * lane : 0;
    const f32x4 gq = *(const f32x4*)(p.in[10] + e0), gk = *(const f32x4*)(p.in[11] + e0);
    const int j0 = isrope ? ((4 * lane - 128) & 31) : 0;
    constexpr float QS = 0.07216878364870322f * 1.4426950408889634f;
    for (int t = gw; t < S; t += NGW) {
        f32x4 cs = {1.f, 1.f, 1.f, 1.f}, sn = {0.f, 0.f, 0.f, 0.f};
        if (isrope) { cs = *(const f32x4*)(ct + t * 32 + j0); sn = *(const f32x4*)(st + t * 32 + j0); }
        u32x2 krw = {0u, 0u};
        if (isrope) krw = *(const u32x2*)(proj + (size_t)t * NINP + 2816 + (4 * lane - 128));
        const f32x4 krope = {bflo(krw.x), bfhi(krw.x), bflo(krw.y), bfhi(krw.y)};
#pragma unroll
        for (int h = 0; h < 8; ++h) {
            u32x2 qw = {0u, 0u};
            if (act) qw = *(const u32x2*)(qraw + (size_t)t * 1536 + h * 192 + e0);
            f32x4 q = {bflo(qw.x), bfhi(qw.x), bflo(qw.y), bfhi(qw.y)};
            float ss = wave_sum_u((q[0] * q[0] + q[1] * q[1]) + (q[2] * q[2] + q[3] * q[3]));
            float rs = rsqrtf(ss * (1.0f / 192.0f) + EPS);
            q = q * gq * rs;
            {
                f32x4 pr;
#pragma unroll
                for (int c = 0; c < 4; ++c) pr[c] = __shfl_xor(q[c], 8);
                const f32x4 r1 = q * cs - pr * sn, r2 = pr * sn + q * cs;
                if (isrope) q = lowhalf ? r1 : r2;
            }
            q = q * QS;
            if (act) { u32x2 w; w.x = pk2(q[0], q[1]); w.y = pk2(q[2], q[3]); *(u32x2*)(Qh + ((size_t)h * S + t) * 192 + e0) = w; }
            u32x2 kw = {0u, 0u};
            if (lane < 32) kw = *(const u32x2*)(kvraw + (size_t)t * 2048 + h * 256 + e0);
            f32x4 k = {bflo(kw.x), bfhi(kw.x), bflo(kw.y), bfhi(kw.y)};
            if (isrope) k = krope;
            ss = wave_sum_u((k[0] * k[0] + k[1] * k[1]) + (k[2] * k[2] + k[3] * k[3]));
            rs = rsqrtf(ss * (1.0f / 192.0f) + EPS);
            k = k * gk * rs;
            {
                f32x4 pr;
#pragma unroll
                for (int c = 0; c < 4; ++c) pr[c] = __shfl_xor(k[c], 8);
                const f32x4 r1 = k * cs - pr * sn, r2 = pr * sn + k * cs;
                if (isrope) k = lowhalf ? r1 : r2;
            }
            if (act) { u32x2 w; w.x = pk2(k[0], k[1]); w.y = pk2(k[2], k[3]); *(u32x2*)(Kh + ((size_t)h * S + t) * 192 + e0) = w; }
        }
    }
}

constexpr int KP = 400, VP = 320;
template <int OFF> __device__ __forceinline__ s16x4 tr_read(unsigned addr) {
    s16x4 r; asm volatile("ds_read_b64_tr_b16 %0, %1 offset:%2" : "=&v"(r) : "v"(addr), "i"(OFF) : "memory"); return r;
}
__device__ __forceinline__ unsigned cvtpk(float lo, float hi) { unsigned r; asm volatile("v_cvt_pk_bf16_f32 %0, %1, %2" : "=v"(r) : "v"(lo), "v"(hi)); return r; }
#define PK8(L, H) ((bf16x8){L[0], L[1], L[2], L[3], H[0], H[1], H[2], H[3]})
constexpr float ATT_THR = 8.0f;

constexpr int ATT_KB = 64 * KP, ATT_VB = 64 * VP;
constexpr int ATT_VOFF = 2 * ATT_KB;
__device__ __forceinline__ float xhalf_max(float v) {
    auto rr = __builtin_amdgcn_permlane32_swap(__builtin_bit_cast(unsigned, v), __builtin_bit_cast(unsigned, v), false, false);
    return fmaxf(__builtin_bit_cast(float, rr[0]), __builtin_bit_cast(float, rr[1]));
}
__device__ __forceinline__ float xhalf_sum(float v) {
    auto rr = __builtin_amdgcn_permlane32_swap(__builtin_bit_cast(unsigned, v), __builtin_bit_cast(unsigned, v), false, false);
    return __builtin_bit_cast(float, rr[0]) + __builtin_bit_cast(float, rr[1]);
}
template <int OFF> __device__ __forceinline__ bf16x8 lds_read128(unsigned addr) {
    bf16x8 r; asm volatile("ds_read_b128 %0, %1 offset:%2" : "=&v"(r) : "v"(addr), "i"(OFF) : "memory"); return r;
}
#define LGKM_WAIT(n) do { asm volatile("s_waitcnt lgkmcnt(" #n ")" ::: "memory"); SBAR(); } while (0)
__device__ __forceinline__ f32x16 att_qk(unsigned kaddr, const bf16x8 (&qr)[12]) {
    f32x16 p = {};
    bf16x8 a0 = lds_read128<0>(kaddr), a1 = lds_read128<32>(kaddr), a2 = lds_read128<64>(kaddr), a3 = lds_read128<96>(kaddr);
    LGKM_WAIT(3); p = __builtin_amdgcn_mfma_f32_32x32x16_bf16(a0, qr[0], p, 0, 0, 0); a0 = lds_read128<128>(kaddr);
    LGKM_WAIT(3); p = __builtin_amdgcn_mfma_f32_32x32x16_bf16(a1, qr[1], p, 0, 0, 0); a1 = lds_read128<160>(kaddr);
    LGKM_WAIT(3); p = __builtin_amdgcn_mfma_f32_32x32x16_bf16(a2, qr[2], p, 0, 0, 0); a2 = lds_read128<192>(kaddr);
    LGKM_WAIT(3); p = __builtin_amdgcn_mfma_f32_32x32x16_bf16(a3, qr[3], p, 0, 0, 0); a3 = lds_read128<224>(kaddr);
    LGKM_WAIT(3); p = __builtin_amdgcn_mfma_f32_32x32x16_bf16(a0, qr[4], p, 0, 0, 0); a0 = lds_read128<256>(kaddr);
    LGKM_WAIT(3); p = __builtin_amdgcn_mfma_f32_32x32x16_bf16(a1, qr[5], p, 0, 0, 0); a1 = lds_read128<288>(kaddr);
    LGKM_WAIT(3); p = __builtin_amdgcn_mfma_f32_32x32x16_bf16(a2, qr[6], p, 0, 0, 0); a2 = lds_read128<320>(kaddr);
    LGKM_WAIT(3); p = __builtin_amdgcn_mfma_f32_32x32x16_bf16(a3, qr[7], p, 0, 0, 0); a3 = lds_read128<352>(kaddr);
    LGKM_WAIT(3); p = __builtin_amdgcn_mfma_f32_32x32x16_bf16(a0, qr[8], p, 0, 0, 0);
    LGKM_WAIT(2); p = __builtin_amdgcn_mfma_f32_32x32x16_bf16(a1, qr[9], p, 0, 0, 0);
    LGKM_WAIT(1); p = __builtin_amdgcn_mfma_f32_32x32x16_bf16(a2, qr[10], p, 0, 0, 0);
    LGKM_WAIT(0); p = __builtin_amdgcn_mfma_f32_32x32x16_bf16(a3, qr[11], p, 0, 0, 0);
    return p;
}
__device__ __forceinline__ void att_finish(f32x16& s, float m, float& lsum, bf16x8& pb0, bf16x8& pb1) {
    float ps = 0.f;
#pragma unroll
    for (int r = 0; r < 16; ++r) { s[r] = __builtin_amdgcn_exp2f(s[r] - m); ps += s[r]; }
    lsum += xhalf_sum(ps);
    u32x4 w0 = {cvtpk(s[0], s[1]), cvtpk(s[2], s[3]), cvtpk(s[4], s[5]), cvtpk(s[6], s[7])};
    u32x4 w1 = {cvtpk(s[8], s[9]), cvtpk(s[10], s[11]), cvtpk(s[12], s[13]), cvtpk(s[14], s[15])};
    pb0 = __builtin_bit_cast(bf16x8, w0); pb1 = __builtin_bit_cast(bf16x8, w1);
}
__device__ __forceinline__ void att_pv(unsigned vaddr, bf16x8 pb0, bf16x8 pb1, f32x16 (&o)[4]) {
#define VOFF(d0, s, hi) (((16 * (s) + 8 * (hi)) * VP) + 64 * (d0))
    const s16x4 a00l = tr_read<VOFF(0, 0, 0)>(vaddr), a00h = tr_read<VOFF(0, 0, 1)>(vaddr), a01l = tr_read<VOFF(0, 1, 0)>(vaddr), a01h = tr_read<VOFF(0, 1, 1)>(vaddr);
    const s16x4 a10l = tr_read<VOFF(1, 0, 0)>(vaddr), a10h = tr_read<VOFF(1, 0, 1)>(vaddr), a11l = tr_read<VOFF(1, 1, 0)>(vaddr), a11h = tr_read<VOFF(1, 1, 1)>(vaddr);
    LGKM_WAIT(4);
    o[0] = __builtin_amdgcn_mfma_f32_32x32x16_bf16(PK8(a00l, a00h), pb0, o[0], 0, 0, 0); o[0] = __builtin_amdgcn_mfma_f32_32x32x16_bf16(PK8(a01l, a01h), pb1, o[0], 0, 0, 0);
    const s16x4 a20l = tr_read<VOFF(2, 0, 0)>(vaddr), a20h = tr_read<VOFF(2, 0, 1)>(vaddr), a21l = tr_read<VOFF(2, 1, 0)>(vaddr), a21h = tr_read<VOFF(2, 1, 1)>(vaddr);
    LGKM_WAIT(4);
    o[1] = __builtin_amdgcn_mfma_f32_32x32x16_bf16(PK8(a10l, a10h), pb0, o[1], 0, 0, 0); o[1] = __builtin_amdgcn_mfma_f32_32x32x16_bf16(PK8(a11l, a11h), pb1, o[1], 0, 0, 0);
    const s16x4 a30l = tr_read<VOFF(3, 0, 0)>(vaddr), a30h = tr_read<VOFF(3, 0, 1)>(vaddr), a31l = tr_read<VOFF(3, 1, 0)>(vaddr), a31h = tr_read<VOFF(3, 1, 1)>(vaddr);
    LGKM_WAIT(4);
    o[2] = __builtin_amdgcn_mfma_f32_32x32x16_bf16(PK8(a20l, a20h), pb0, o[2], 0, 0, 0); o[2] = __builtin_amdgcn_mfma_f32_32x32x16_bf16(PK8(a21l, a21h), pb1, o[2], 0, 0, 0);
    LGKM_WAIT(0);
    o[3] = __builtin_amdgcn_mfma_f32_32x32x16_bf16(PK8(a30l, a30h), pb0, o[3], 0, 0, 0); o[3] = __builtin_amdgcn_mfma_f32_32x32x16_bf16(PK8(a31l, a31h), pb1, o[3], 0, 0, 0);
#undef VOFF
}
__device__ __forceinline__ void att_partial(const f32x16& s, float& m, float& lsum, f32x16 (&o)[4]) {
    float pmax = s[0];
#pragma unroll
    for (int r = 1; r < 16; ++r) pmax = fmaxf(pmax, s[r]);
    pmax = xhalf_max(pmax);
    if (!__all(pmax - m <= ATT_THR)) {
        const float mn = fmaxf(m, pmax); const float alpha = __builtin_amdgcn_exp2f(m - mn); m = mn; lsum *= alpha;
#pragma unroll
        for (int d = 0; d < 4; ++d)
#pragma unroll
            for (int r = 0; r < 16; ++r) o[d][r] *= alpha;
    }
}

__device__ __forceinline__ void attn_unit(const Params& p, LAS unsigned char* lds, int head, int qb, int tid, int wave, int lane) {
    unsigned char* ws = p.ws;
    const bf16_t* Qh = (const bf16_t*)(ws + WS_QH); const bf16_t* Kh = (const bf16_t*)(ws + WS_KH);
    bf16_t* mix = (bf16_t*)(ws + WS_MIX);
    const int rg = wave & 3, kh = wave >> 2, r32 = lane & 31, hh = lane >> 5;
    const int q0row = qb * 128 + rg * 32;
    bf16x8 qr[12];
    {
        const bf16_t* qp = Qh + ((size_t)head * S + q0row + r32) * 192 + hh * 8;
#pragma unroll
        for (int ks = 0; ks < 12; ++ks) qr[ks] = *(const bf16x8*)(qp + ks * 16);
    }
    const int ntiles = 2 * qb + 2, mylast = 2 * qb + (rg >> 1);
    float m = -1e30f, lsum = 0.f; f32x16 o[4] = {};
    const int srow = tid >> 3, sch = tid & 7;
    const int kg0 = srow * 192 + sch * 8, kl0 = srow * KP + sch * 16, vg0 = srow * 2048 + sch * 8, vl0 = ATT_VOFF + srow * VP + sch * 16;
    const bf16_t* kbase = Kh + (size_t)head * S * 192; const bf16_t* vbase = (const bf16_t*)(ws + WS_KVRAW) + head * 256 + 128;
    u32x4 sk0, sk1, sk2, sv0, sv1;
#define ATT_LOAD(t) do { const bf16_t* kt = kbase + (size_t)(t) * 64 * 192 + kg0; const bf16_t* vt = vbase + (size_t)(t) * 64 * 2048 + vg0; \
        sk0 = *(const u32x4*)(kt); sk1 = *(const u32x4*)(kt + 64); sk2 = *(const u32x4*)(kt + 128); sv0 = *(const u32x4*)(vt); sv1 = *(const u32x4*)(vt + 64); } while (0)
#define ATT_WRITE(kb_, vb_) do { LAS unsigned char* bk = lds + (kb_) * ATT_KB + kl0; LAS unsigned char* bv = lds + (vb_) * ATT_VB + vl0; *(LAS u32x4*)(bk) = sk0; *(LAS u32x4*)(bk + 128) = sk1; *(LAS u32x4*)(bk + 256) = sk2; \
        *(LAS u32x4*)(bv) = sv0; *(LAS u32x4*)(bv + 128) = sv1; } while (0)
    const unsigned ldsbase = (unsigned)(size_t)lds;
    const unsigned kaddr0 = ldsbase + (unsigned)((32 * kh + r32) * KP + hh * 16);
    const unsigned vrel = (unsigned)(ATT_VOFF + (32 * kh + 4 * hh + ((lane & 15) >> 2)) * VP + (16 * ((lane >> 4) & 1) + 4 * (lane & 3)) * 2);
    ATT_LOAD(0); ATT_WRITE(0, 0); __syncthreads();
    bf16x8 pb0, pb1;
    const bool more0 = (1 < ntiles);
    if (more0) ATT_LOAD(1);
    f32x16 sprev = att_qk(kaddr0, qr);
    att_partial(sprev, m, lsum, o);
    if (more0) ATT_WRITE(1, 1);
    __syncthreads();
    int vprev = 0, vcur = 1;
#pragma unroll 1
    for (int t = 1; t <= ntiles; ++t) {
        const bool more = (t + 1 < ntiles);
        if (more) ATT_LOAD(t + 1);
        f32x16 sc;
        if (t <= mylast) sc = att_qk(kaddr0 + (t & 1) * ATT_KB, qr);
        else {
#pragma unroll
            for (int r = 0; r < 16; ++r) sc[r] = -1e30f;
        }
        att_finish(sprev, m, lsum, pb0, pb1);
        att_pv(ldsbase + vprev * ATT_VB + vrel, pb0, pb1, o);
        att_partial(sc, m, lsum, o);
        sprev = sc;
        const int vnext = (vcur == 2) ? 0 : vcur + 1;
        if (more) ATT_WRITE((t + 1) & 1, vnext);
        vprev = vcur; vcur = vnext;
        __syncthreads();
    }
#undef ATT_LOAD
#undef ATT_WRITE
    LAS float* scr = (LAS float*)lds + (size_t)rg * 66 * 64 + lane;
    if (kh == 1) {
        scr[0] = m; scr[64] = lsum;
#pragma unroll
        for (int d = 0; d < 4; ++d)
#pragma unroll
            for (int r = 0; r < 16; ++r) scr[(2 + d * 16 + r) * 64] = o[d][r];
    }
    __syncthreads();
    if (kh == 0) {
        const float m2 = scr[0], l2 = scr[64];
        const float mn = fmaxf(m, m2), a1 = __builtin_amdgcn_exp2f(m - mn), a2 = __builtin_amdgcn_exp2f(m2 - mn);
        const float inv = 1.0f / (lsum * a1 + l2 * a2);
        bf16_t* op = mix + (size_t)(q0row + r32) * DM + 1024 + head * 128 + 4 * hh;
#pragma unroll
        for (int d = 0; d < 4; ++d)
#pragma unroll
            for (int g4 = 0; g4 < 4; ++g4) {
                float v[4];
#pragma unroll
                for (int i = 0; i < 4; ++i) { const int r = 4 * g4 + i; v[i] = (o[d][r] * a1 + scr[(2 + d * 16 + r) * 64] * a2) * inv; }
                u32x2 w; w.x = pk2(v[0], v[1]); w.y = pk2(v[2], v[3]);
                *(u32x2*)(op + 32 * d + 8 * g4) = w;
            }
    }
    __syncthreads();
}

__device__ __forceinline__ void gmlp_unit(const Params& p, LAS unsigned char* lds, int nb, int h, int tid, int wave, int lane) {
    unsigned char* ws = p.ws;
    const bf16_t* proj = (const bf16_t*)(ws + WS_PROJ); bf16_t* mix = (bf16_t*)(ws + WS_MIX);
    const float* ssv = (const float*)(ws + WS_ROWSS);
    const float* vg = p.in[3]; const float* wsp = p.in[4]; const float* bs = p.in[5];
#pragma unroll
    for (int i = 0; i < 4; ++i) {
        const int pc = tid + 512 * i, r = pc >> 4, c = pc & 15, t = nb * 128 + r;
        const u32x4 w = *(const u32x4*)(proj + (size_t)t * NINP + 1024 + h * 128 + c * 8);
        const float rs = rsqrtf(ssv[t] * (1.0f / 1024.0f) + EPS);
        const f32x4 g0 = *(const f32x4*)(vg + h * 128 + c * 8), g1 = *(const f32x4*)(vg + h * 128 + c * 8 + 4);
        u32x4 ov;
        ov.x = pk2(bflo(w.x) * rs * g0[0], bfhi(w.x) * rs * g0[1]); ov.y = pk2(bflo(w.y) * rs * g0[2], bfhi(w.y) * rs * g0[3]);
        ov.z = pk2(bflo(w.z) * rs * g1[0], bfhi(w.z) * rs * g1[1]); ov.w = pk2(bflo(w.w) * rs * g1[2], bfhi(w.w) * rs * g1[3]);
        *(LAS u32x4*)(lds + r * VP + c * 16) = ov;
    }
    __syncthreads();
    const int ib = wave & 3, ch = wave >> 2, r32 = lane & 31, hh = lane >> 5;
    const int irow = 32 * ib + r32;
    f32x16 acc0 = {}, acc1 = {};
    const unsigned vaddr = (unsigned)(size_t)lds + (unsigned)((8 * hh + ((lane & 15) >> 2)) * VP + (64 * ch + 16 * ((lane >> 4) & 1) + 4 * (lane & 3)) * 2);
    const float* wrow = wsp + ((size_t)h * 128 + irow) * 128 + hh * 8;
#define GSTEP(s) do { if ((s) < 2 * (ib + 1)) { \
        const f32x4 wa = *(const f32x4*)(wrow + (s) * 16), wb = *(const f32x4*)(wrow + (s) * 16 + 4); const int j0 = (s) * 16 + hh * 8; \
        u32x4 aw; aw.x = pk2(j0 + 0 <= irow ? wa[0] : 0.f, j0 + 1 <= irow ? wa[1] : 0.f); aw.y = pk2(j0 + 2 <= irow ? wa[2] : 0.f, j0 + 3 <= irow ? wa[3] : 0.f); \
        aw.z = pk2(j0 + 4 <= irow ? wb[0] : 0.f, j0 + 5 <= irow ? wb[1] : 0.f); aw.w = pk2(j0 + 6 <= irow ? wb[2] : 0.f, j0 + 7 <= irow ? wb[3] : 0.f); \
        const bf16x8 af = __builtin_bit_cast(bf16x8, aw); \
        const s16x4 b0l = tr_read<(16 * (s)) * VP>(vaddr), b0h = tr_read<(16 * (s) + 4) * VP>(vaddr), b1l = tr_read<(16 * (s)) * VP + 64>(vaddr), b1h = tr_read<(16 * (s) + 4) * VP + 64>(vaddr); \
        LDS_WAIT(); SBAR(); \
        acc0 = __builtin_amdgcn_mfma_f32_32x32x16_bf16(af, PK8(b0l, b0h), acc0, 0, 0, 0); acc1 = __builtin_amdgcn_mfma_f32_32x32x16_bf16(af, PK8(b1l, b1h), acc1, 0, 0, 0); } } while (0)
    GSTEP(0); GSTEP(1); GSTEP(2); GSTEP(3); GSTEP(4); GSTEP(5); GSTEP(6); GSTEP(7);
#undef GSTEP
#pragma unroll
    for (int r = 0; r < 16; ++r) {
        const int i = 32 * ib + crow(r, hh), t = nb * 128 + i; const float b = bs[h * 128 + i];
        const int c0 = h * 128 + 64 * ch + r32;
        const float u0 = bf2f(proj[(size_t)t * NINP + c0]), u1 = bf2f(proj[(size_t)t * NINP + c0 + 32]);
        mix[(size_t)t * DM + c0] = (bf16_t)f2bf(u0 * (acc0[r] + b)); mix[(size_t)t * DM + c0 + 32] = (bf16_t)f2bf(u1 * (acc1[r] + b));
    }
    __syncthreads();
}

__device__ __forceinline__ void phase7(const Params& p, LAS unsigned char* lds, int gw, int NGW, int wave, int lane) {
    unsigned char* ws = p.ws;
    const float* sc = (const float*)(ws + WS_SC); int* ex = (int*)(ws + WS_EXP); float* gt = (float*)(ws + WS_GATE);
    const float NEG = -3.0e38f;
    LAS float* sl = (LAS float*)(lds + wave * 1024);
    const int j8 = lane & 7, g8 = lane >> 3, row = lane >> 4, i16 = lane & 15;
    int ci[4], cj[4]; bool cval[4];
    {
        constexpr int starts[16] = {0, 16, 24, 29, 33, 36, 38, 40, 42, 43, 44, 45, 46, 47, 48, 49};
#pragma unroll
        for (int m = 0; m < 4; ++m) {
            const int c = i16 + 16 * m; int a = 0, st = 0;
#pragma unroll
            for (int i = 1; i < 16; ++i) if (c >= starts[i]) { a = i; st = starts[i]; }
            cval[m] = c < 50; ci[m] = cval[m] ? a : 0; cj[m] = cval[m] ? (c - st) : 0;
        }
    }
    f32x4 nx0, nx1, nx2, nx3;
    if (gw < S / 4) { const float* b = sc + (size_t)(gw * 4) * DM + lane * 16; nx0 = *(const f32x4*)b; nx1 = *(const f32x4*)(b + 4); nx2 = *(const f32x4*)(b + 8); nx3 = *(const f32x4*)(b + 12); }
    for (int tb = gw; tb < S / 4; tb += NGW)
#pragma unroll 1
    for (int n8 = 0; n8 < 8; ++n8) {
        const int it = tb * 8 + n8;
        const int t = it >> 1, hh = it & 1;
        float v[16];
#pragma unroll
        for (int q = 0; q < 4; ++q) { v[q] = nx0[q]; v[4 + q] = nx1[q]; v[8 + q] = nx2[q]; v[12 + q] = nx3[q]; }
        { const int it2 = n8 < 7 ? it + 1 : (tb + NGW) * 8;
          if (it2 < S * 2) { const float* b = sc + (size_t)(it2 >> 1) * DM + (it2 & 1) * 1024 + lane * 16;
            nx0 = *(const f32x4*)b; nx1 = *(const f32x4*)(b + 4); nx2 = *(const f32x4*)(b + 8); nx3 = *(const f32x4*)(b + 12); } }
#pragma unroll
        for (int m = 0; m < 16; ++m) v[m] = __builtin_bit_cast(float, (__builtin_bit_cast(unsigned, v[m]) & ~127u) | (unsigned)(16 * j8 + m));
#define P7_CE(A, B) do { const float hi_ = fmaxf(v[A], v[B]), lo_ = fminf(v[A], v[B]); v[A] = hi_; v[B] = lo_; } while (0)
        P7_CE(0, 13); P7_CE(1, 12); P7_CE(2, 15); P7_CE(3, 14); P7_CE(4, 8); P7_CE(5, 6); P7_CE(7, 11); P7_CE(9, 10);
        P7_CE(0, 5); P7_CE(1, 7); P7_CE(2, 9); P7_CE(3, 4); P7_CE(6, 13); P7_CE(8, 14); P7_CE(10, 15); P7_CE(11, 12);
        P7_CE(0, 1); P7_CE(2, 3); P7_CE(4, 5); P7_CE(6, 8); P7_CE(7, 9); P7_CE(10, 11); P7_CE(12, 13); P7_CE(14, 15);
        P7_CE(0, 2); P7_CE(1, 3); P7_CE(4, 10); P7_CE(5, 11); P7_CE(6, 7); P7_CE(8, 9); P7_CE(12, 14); P7_CE(13, 15);
        P7_CE(1, 2); P7_CE(3, 12); P7_CE(4, 6); P7_CE(5, 7); P7_CE(8, 10); P7_CE(9, 11); P7_CE(13, 14);
        P7_CE(1, 4); P7_CE(2, 6); P7_CE(5, 8); P7_CE(7, 10); P7_CE(9, 13); P7_CE(11, 14);
        P7_CE(2, 4); P7_CE(3, 6); P7_CE(9, 12); P7_CE(11, 13);
        P7_CE(3, 5); P7_CE(6, 8); P7_CE(7, 9); P7_CE(10, 12);
        P7_CE(3, 4); P7_CE(5, 6); P7_CE(7, 8); P7_CE(9, 10); P7_CE(11, 12);
        P7_CE(6, 7); P7_CE(8, 9);
#define P7_MERGE(CTRL) do { float t_[16]; \
            _Pragma("unroll") for (int i = 0; i < 16; ++i) t_[i] = fmaxf(v[i], dpp_f<CTRL, 0xf>(v[15 - i], v[15 - i])); \
            _Pragma("unroll") for (int i = 0; i < 16; ++i) v[i] = t_[i]; \
            _Pragma("unroll") for (int j = 8; j >= 1; j >>= 1) _Pragma("unroll") for (int i = 0; i < 16; ++i) if ((i & j) == 0) P7_CE(i, i + j); } while (0)
        P7_MERGE(0xB1); P7_MERGE(0x4E); P7_MERGE(0x141);
#undef P7_MERGE
#undef P7_CE
        if (j8 == 0) {
#pragma unroll
            for (int q = 0; q < 4; ++q) *(LAS f32x4*)(sl + g8 * 16 + 4 * q) = (f32x4){v[4 * q], v[4 * q + 1], v[4 * q + 2], v[4 * q + 3]};
        }
        LDS_WAIT(); asm volatile("" ::: "memory");
        float cv[4], og[4]; int id[4];
#pragma unroll
        for (int m = 0; m < 4; ++m) {
            const float s1 = sl[(2 * row) * 16 + ci[m]], s2 = sl[(2 * row + 1) * 16 + cj[m]];
            og[m] = cval[m] ? (s1 + s2) : NEG; cv[m] = og[m];
            id[m] = (int)((__builtin_bit_cast(unsigned, s1) & 127u) * 128u + (__builtin_bit_cast(unsigned, s2) & 127u));
        }
        LDS_WAIT(); asm volatile("" ::: "memory");
        float M0 = 0.f;
#pragma unroll
        for (int k = 0; k < 16; ++k) {
            float mx = fmaxf(fmaxf(cv[0], cv[1]), fmaxf(cv[2], cv[3]));
            mx = fmaxf(mx, dpp_f<0xB1, 0xf>(mx, mx));
            mx = fmaxf(mx, dpp_f<0x4E, 0xf>(mx, mx));
            mx = fmaxf(mx, dpp_f<0x141, 0xf>(mx, mx));
            mx = fmaxf(mx, dpp_f<0x140, 0xf>(mx, mx));
            if (k == 0) M0 = mx;
#pragma unroll
            for (int m = 0; m < 4; ++m) cv[m] = (cv[m] == mx) ? NEG : cv[m];
        }
        bool sel[4]; float e[4]; float es = 0.f;
#pragma unroll
        for (int m = 0; m < 4; ++m) { sel[m] = (cv[m] != og[m]); e[m] = sel[m] ? __expf(og[m] - M0) : 0.f; es += e[m]; }
        es += dpp_f<0xB1, 0xf>(0.f, es); es += dpp_f<0x4E, 0xf>(0.f, es); es += dpp_f<0x141, 0xf>(0.f, es); es += dpp_f<0x140, 0xf>(0.f, es);
        const float inv = 1.0f / es;
        int basepos = 0;
        const int head = 4 * hh + row;
#pragma unroll
        for (int m = 0; m < 4; ++m) {
            const unsigned long long bl = __ballot(sel[m]);
            const unsigned rbits = (unsigned)(bl >> (16 * row)) & 0xffffu;
            const int pos = basepos + __popc(rbits & ((1u << i16) - 1u));
            if (sel[m] && pos < 16) { ex[(size_t)t * 128 + head * 16 + pos] = id[m]; gt[(size_t)t * 128 + head * 16 + pos] = e[m] * inv; }
            basepos += __popc(rbits);
        }
    }
}

typedef __bf16 bf16x32v __attribute__((ext_vector_type(32)));
typedef __bf16 bf16x2v __attribute__((ext_vector_type(2)));
typedef float f32x2 __attribute__((ext_vector_type(2)));
#ifndef P8_THROTTLE
#define P8_THROTTLE 0
#endif
constexpr unsigned P8_SLACK = 12;
#ifndef P8_SWEEPSYNC
#define P8_SWEEPSYNC 1
#endif
#ifndef P8_MIDSYNC
#define P8_MIDSYNC 2
#endif
__device__ __forceinline__ void phase8(const Params& p, LAS unsigned char* lds, float* dst, const XcdBarrier& xb, int gw, int NGW, int wave, int lane) {
    unsigned char* ws = p.ws;
    const bf16_t* x1b = (const bf16_t*)(ws + WS_X1B); const unsigned char* UT = ws + WS_UT; const unsigned char* VT = ws + WS_VT;
    const int* ex = (const int*)(ws + WS_EXP); const float* gt = (const float*)(ws + WS_GATE); const float* ss2 = (const float*)(ws + WS_ROWSS) + 3 * S;
    const float* out = p.out;
    LAS unsigned* list = (LAS unsigned*)(lds + 131072 + wave * 2048);
    LAS unsigned* hist = (LAS unsigned*)(lds + 147456 + wave * 1024);
    for (int tb = gw; tb < S / 4; tb += NGW) {
        const int t0 = tb * 4;
        int id[8]; float gv[8];
#pragma unroll
        for (int r = 0; r < 8; ++r) { const size_t o = (size_t)(t0 + (r >> 1)) * 128 + (r & 1) * 64 + lane; id[r] = ex[o]; gv[r] = gt[o]; }
        const float rs0 = rsqrtf(ss2[t0 + 0] * (1.0f / DM) + EPS) * (1.0f / PEER_USC), rs1 = rsqrtf(ss2[t0 + 1] * (1.0f / DM) + EPS) * (1.0f / PEER_USC);
        const float rs2 = rsqrtf(ss2[t0 + 2] * (1.0f / DM) + EPS) * (1.0f / PEER_USC), rs3 = rsqrtf(ss2[t0 + 3] * (1.0f / DM) + EPS) * (1.0f / PEER_USC);
#pragma unroll
        for (int j = 0; j < 4; ++j) hist[j * 64 + lane] = 0u;
        LDS_WAIT(); asm volatile("" ::: "memory");
        unsigned pos[8];
#pragma unroll
        for (int r = 0; r < 8; ++r) pos[r] = __hip_atomic_fetch_add(hist + (r >> 1) * 64 + (id[r] >> 8), 1u, __ATOMIC_RELAXED, __HIP_MEMORY_SCOPE_WORKGROUP);
        LDS_WAIT(); asm volatile("" ::: "memory");
        unsigned cnt[4], inc[4];
#pragma unroll
        for (int j = 0; j < 4; ++j) { cnt[j] = hist[j * 64 + lane]; inc[j] = cnt[j]; }
#pragma unroll
        for (int o = 1; o < 64; o <<= 1)
#pragma unroll
            for (int j = 0; j < 4; ++j) { const unsigned n = __shfl_up(inc[j], o); if (lane >= o) inc[j] += n; }
        LDS_WAIT(); asm volatile("" ::: "memory");
#pragma unroll
        for (int j = 0; j < 4; ++j) hist[j * 64 + lane] = inc[j] - cnt[j];
        LDS_WAIT(); asm volatile("" ::: "memory");
#pragma unroll
        for (int r = 0; r < 8; ++r) { const unsigned d = hist[(r >> 1) * 64 + (id[r] >> 8)] + pos[r]; list[4u * d + (unsigned)(r >> 1)] = (unsigned)id[r] | ((unsigned)(r >> 1) << 14) | (f2bf(gv[r]) << 16); }
        LDS_WAIT(); asm volatile("" ::: "memory");
        {
            typedef unsigned u32x16 __attribute__((ext_vector_type(16)));
            const __amdgpu_buffer_rsrc_t urs = __builtin_amdgcn_make_buffer_rsrc((void*)UT, 0, 16384 * PEER_ROWB, 0x00020000);
            const int vo4 = lane * 16, vo2 = lane * 8 + 1024;
            const bool lb0 = (lane & 1) != 0, lb1 = (lane & 2) != 0, lb2 = (lane & 4) != 0;
            s16x4 xr[4][8];
#pragma unroll
            for (int j = 0; j < 4; ++j)
#pragma unroll
                for (int q = 0; q < 8; ++q) xr[j][q] = __builtin_bit_cast(s16x4, *(const u32x2*)(x1b + (size_t)(t0 + j) * DM + (q * 64 + lane) * 4));
#define P8_ULOAD(k, i) do { const unsigned en = (unsigned)__builtin_amdgcn_readfirstlane((int)list[(i)]); const int ro = (int)((en & 0x3fffu) * (unsigned)PEER_ROWB); \
            u4[k] = __builtin_amdgcn_raw_buffer_load_b128(urs, vo4, ro, 0); u2[k] = __builtin_amdgcn_raw_buffer_load_b64(urs, vo2, ro, 0); } while (0)
#define P8_UPROC2(k, dk) do { const u32x6 pk = {u4[k][0], u4[k][1], u4[k][2], u4[k][3], u2[k][0], u2[k][1]}; \
            const u32x16 r_ = __builtin_bit_cast(u32x16, __builtin_amdgcn_cvt_scalef32_pk32_bf16_fp6(pk, 1.0f)); \
            f32x4 a0 = {0.f, 0.f, 0.f, 0.f}, a1 = {0.f, 0.f, 0.f, 0.f}; \
            _Pragma("unroll") for (int q = 0; q < 8; q += 2) { \
                a0 = __builtin_amdgcn_mfma_f32_4x4x4bf16_1k(__builtin_bit_cast(s16x4, (u32x2){r_[2 * q], r_[2 * q + 1]}), xr[(k) & 3][q], a0, 0, 0, 0); \
                a1 = __builtin_amdgcn_mfma_f32_4x4x4bf16_1k(__builtin_bit_cast(s16x4, (u32x2){r_[2 * q + 2], r_[2 * q + 3]}), xr[(k) & 3][q + 1], a1, 0, 0, 0); } \
            const f32x4 a_ = a0 + a1; \
            const float e0 = lb0 ? a_[1] : a_[0], e1 = lb0 ? a_[3] : a_[2]; dd[dk] = lb1 ? e1 : e0; } while (0)
#ifndef P8_URING
#define P8_URING 8
#endif
#if (PROBE_DUP >> 10) & 1
#define P8_UREPS 2
#else
#define P8_UREPS 1
#endif
#pragma unroll 1
            for (int urep = 0; urep < P8_UREPS; ++urep) {
                u32x4 u4[P8_URING]; u32x2 u2[P8_URING];
#pragma unroll
                for (int k = 0; k < P8_URING; ++k) P8_ULOAD(k, k);
#pragma unroll 1
                for (int i0 = 0; i0 < 512; i0 += P8_URING) {
                    if (P8_SWEEPSYNC && i0 == 256 && NGW == S / 4) xcd_local_barrier(xb);
#pragma unroll
                    for (int hb = 0; hb < P8_URING / 8; ++hb) {
                        const int i = i0 + 8 * hb;
                        const unsigned ev = list[i + (lane & 7)]; const unsigned jl = (unsigned)lane & 3u;
                        const float gl = __builtin_bit_cast(float, ev & 0xffff0000u), rl = jl == 0u ? rs0 : (jl == 1u ? rs1 : (jl == 2u ? rs2 : rs3));
                        float dd[8];
#pragma unroll
                        for (int k = 0; k < 8; ++k) { P8_UPROC2(8 * hb + k, k); const int nx = i + P8_URING + k; P8_ULOAD(8 * hb + k, nx < 512 ? nx : 508 + (k & 3)); }
                        float w4[4], w2[2];
#pragma unroll
                        for (int q = 0; q < 4; ++q) { const float kp = lb2 ? dd[q + 4] : dd[q], sd = lb2 ? dd[q] : dd[q + 4]; w4[q] = kp + __shfl_xor(sd, 4); }
#pragma unroll
                        for (int q = 0; q < 2; ++q) { const float kp = lb1 ? w4[q + 2] : w4[q], sd = lb1 ? w4[q] : w4[q + 2]; w2[q] = kp + __shfl_xor(sd, 2); }
                        float dres; { const float kp = lb0 ? w2[1] : w2[0], sd = lb0 ? w2[0] : w2[1]; dres = kp + __shfl_xor(sd, 1); }
                        dres += __shfl_xor(dres, 8); dres += __shfl_xor(dres, 16); dres += __shfl_xor(dres, 32);
                        const float c_ = gl * gelu_tanh(rl * dres) * (1.0f / PEER_VSC);
                        if (lane < 8 && urep == P8_UREPS - 1) list[i + lane] = (ev & 0xffffu) | (f2bf(c_) << 16);
                    }
                }
            }
#undef P8_ULOAD
#undef P8_UPROC2
        }
        asm volatile("s_waitcnt vmcnt(0)" ::: "memory");
        LDS_WAIT(); asm volatile("" ::: "memory");
#if P8_MIDSYNC == 1
        __syncthreads();
#elif P8_MIDSYNC == 2
        if (NGW == S / 4) xcd_local_barrier(xb);
#endif
        f32x4 acc[4][8];
#if (PROBE_DUP >> 12) & 1
#define P8_VREPS 2
#else
#define P8_VREPS 1
#endif
#ifndef P8_VRING
#define P8_VRING 8
#endif
#pragma unroll 1
        for (int vrep = 0; vrep < P8_VREPS; ++vrep) {
#pragma unroll
        for (int j = 0; j < 4; ++j)
#pragma unroll
            for (int q = 0; q < 8; ++q) acc[j][q] = (f32x4){0.f, 0.f, 0.f, 0.f};
        {
            typedef unsigned u32x16 __attribute__((ext_vector_type(16)));
            u32x4 v4[P8_VRING]; u32x2 v2[P8_VRING]; unsigned ven[P8_VRING];
            const unsigned li = (unsigned)lane & 3u;
            const unsigned m0 = li == 0u ? 0x0000ffffu : (li == 1u ? 0xffff0000u : 0u), m1 = li == 2u ? 0x0000ffffu : (li == 3u ? 0xffff0000u : 0u);
            const __amdgpu_buffer_rsrc_t vrs = __builtin_amdgcn_make_buffer_rsrc((void*)VT, 0, 16384 * PEER_ROWB, 0x00020000);
            const int vo4 = lane * 16, vo2 = lane * 8 + 1024;
#define P8_VLOAD(k, i) do { const unsigned en = (unsigned)__builtin_amdgcn_readfirstlane((int)list[(i)]); ven[k] = en; const int ro = (int)((en & 0x3fffu) * (unsigned)PEER_ROWB); \
            v4[k] = __builtin_amdgcn_raw_buffer_load_b128(vrs, vo4, ro, 0); v2[k] = __builtin_amdgcn_raw_buffer_load_b64(vrs, vo2, ro, 0); } while (0)
#define P8_VPROC(k) do { const u32x6 pk = {v4[k][0], v4[k][1], v4[k][2], v4[k][3], v2[k][0], v2[k][1]}; \
            const u32x16 r_ = __builtin_bit_cast(u32x16, __builtin_amdgcn_cvt_scalef32_pk32_bf16_fp6(pk, 1.0f)); \
            const unsigned e_ = ven[k], cf = (e_ >> 16) | (e_ & 0xffff0000u); \
            const s16x4 av = __builtin_bit_cast(s16x4, (u32x2){cf & m0, cf & m1}); \
            _Pragma("unroll") for (int q = 0; q < 8; ++q) \
                acc[(k) & 3][q] = __builtin_amdgcn_mfma_f32_4x4x4bf16_1k(av, __builtin_bit_cast(s16x4, (u32x2){r_[2 * q], r_[2 * q + 1]}), acc[(k) & 3][q], 0, 0, 0); } while (0)
#pragma unroll
            for (int k = 0; k < P8_VRING; ++k) P8_VLOAD(k, k);
#pragma unroll 1
            for (int i = 0; i < 512 - 512 % P8_VRING; i += P8_VRING) {
                if (P8_SWEEPSYNC && i == 256 && NGW == S / 4) xcd_local_barrier(xb);
#pragma unroll
                for (int k = 0; k < P8_VRING; ++k) { P8_VPROC(k); const int nx = i + P8_VRING + k; P8_VLOAD(k, nx < 512 ? nx : 508 + (k & 3)); }
            }
#pragma unroll
            for (int k = 0; k < 512 % P8_VRING; ++k) P8_VPROC(k);
#undef P8_VLOAD
#undef P8_VPROC
        }
        }
        int tq = t0, lq = lane; asm volatile("" : "+s"(tq)); asm volatile("" : "+v"(lq));
#pragma unroll
        for (int j = 0; j < 4; ++j)
#pragma unroll
            for (int i = 0; i < 8; ++i) {
                const size_t o = (size_t)(tq + j) * DM + (i * 64 + lq) * 4;
                f32x4 a = *(const f32x4*)(out + o);
                a += acc[j][i];
                *(f32x4*)(dst + o) = a;
                if (i & 1) asm volatile("" ::: "memory");
            }
        LDS_WAIT(); asm volatile("" ::: "memory");
    }
}

__global__ void __launch_bounds__(NTHREADS, 2) mega(Params p) {
    extern __shared__ __attribute__((aligned(16))) unsigned char lds_raw[];
    LAS unsigned char* lds = (LAS unsigned char*)lds_raw;
    const int tid = threadIdx.x, lane = tid & 63, wave = __builtin_amdgcn_readfirstlane(tid >> 6);
    const int G = gridDim.x, bx = blockIdx.x;
    const int gw = bx * 8 + wave, NGW = G * 8;
    unsigned char* ws = p.ws;
    const int lo = p.ph_lo, hi = p.ph_hi;
    volatile LAS unsigned* misc = (volatile LAS unsigned*)(lds + LDS_MISC);
    if (tid < 4) misc[tid] = 0u;
    __syncthreads();
    const XcdBarrier xbar = xcd_barrier_post((unsigned*)(ws + WS_CTL), misc);
#ifndef PH_MASK
#define PH_MASK 0x1ff
#endif
#define IN(k) (((PH_MASK >> (k)) & 1) && lo <= (k) && (k) < hi)
#define SEAM(k) do { if (IN(k) && IN((k) + 1)) xcd_barrier(xbar); } while (0)

#if (PROBE_DUP >> 0) & 1
    if (IN(0)) { phase0(p, lds, G == 256, gw, NGW, wave, lane); xcd_barrier(xbar); }
#endif
    if (IN(0)) phase0(p, lds, G == 256, gw, NGW, wave, lane);
    SEAM(0);
    const bool part = (G == 256) && (misc[2] != 0u);
    const int vx = __builtin_amdgcn_readfirstlane(part ? (int)xbar.x : (bx & 7)), vr = __builtin_amdgcn_readfirstlane(part ? (int)misc[3] : (bx >> 3));
    const int vpanel = (vr >> 3) == 0 ? vx : ((vr >> 3) == 1 ? 31 - vx : ((vr >> 3) == 2 ? vx + 8 : 23 - vx));
    const int gwv = (G == 256) ? vpanel * 64 + (vr & 7) * 8 + wave : gw;
#define SEAM_X(k) do { if (IN(k) && IN((k) + 1)) { if (part) xcd_local_barrier_acq(xbar); else xcd_barrier(xbar); } } while (0)
    if (IN(1)) {
        pg8::Gemm g{(const bf16_t*)(ws + WS_XB), (const bf16_t*)(ws + WS_WIN), S, NINP, DM, DM, DM};
        pg8::StaticOrder So; So.init(S, NINP, G, bx);
        pg8::Epi<1> E{(const float*)(ws + WS_RSTD1), 0.f, (float*)(ws + WS_ROWSS), (bf16_t*)(ws + WS_PROJ), NINP, nullptr, nullptr};
#if (PROBE_DUP >> 1) & 1
        { pg8::Epi<1> E2 = E; E2.ss = (float*)(ws + 512 * 1024); pg8::gemm_phase<pg8::Epi<1>, pg8::StaticOrder, true, true>(lds, g, So, E2); xcd_barrier(xbar); }
#endif
        pg8::gemm_phase<pg8::Epi<1>, pg8::StaticOrder, true, true>(lds, g, So, E);
        if (G == 256 && bx >= 128) { __syncthreads(); prep_late(p, lds, (bx - 128) * 8 + wave, 1024, wave, lane); }
    }
    SEAM(1);
    if (IN(2)) {
        {
            pg8::Gemm g{(const bf16_t*)(ws + WS_PROJ) + 2048, (const bf16_t*)(ws + WS_WUQ), S, 1536, 512, NINP, 512};
            pg8::StaticOrder So; So.init(S, 1536, G, bx);
            pg8::Epi<2> E{(const float*)(ws + WS_ROWSS) + 1 * S, 1.0f / 512.0f, nullptr, (bf16_t*)(ws + WS_QRAW), 1536, nullptr, nullptr};
            pg8::gemm_phase<pg8::Epi<2>, pg8::StaticOrder, true, true>(lds, g, So, E);
        }
        __syncthreads();
        {
            pg8::Gemm g{(const bf16_t*)(ws + WS_PROJ) + 2560, (const bf16_t*)(ws + WS_WUKV), S, 2048, 256, NINP, 256};
            pg8::StaticOrder So; So.init(S, 2048, G, bx);
            pg8::Epi<2> E{(const float*)(ws + WS_ROWSS) + 2 * S, 1.0f / 256.0f, nullptr, (bf16_t*)(ws + WS_KVRAW), 2048, nullptr, nullptr};
            pg8::gemm_phase<pg8::Epi<2>, pg8::StaticOrder, true, true>(lds, g, So, E);
        }
    }
    SEAM(2);
#if (PROBE_DUP >> 3) & 1
    if (IN(3)) { phase3(p, gw, NGW, lane); xcd_barrier(xbar); }
#endif
    if (IN(3)) phase3(p, gw, NGW, lane);
    SEAM(3);
    const int vP = (vr >> 4) ? vx + 8 : vx, vqa = ((vr >> 3) & 1) ? 62 - 2 * vP : 63 - 2 * vP, vqb = ((vr >> 3) & 1) ? 2 * vP + 1 : 2 * vP;
#define P4_BODY_ATT do { if (G == 256) { attn_unit(p, lds, vr & 7, vqa, tid, wave, lane); attn_unit(p, lds, vr & 7, vqb, tid, wave, lane); } \
        else for (int pr = bx; pr < 256; pr += G) { const int head = pr & 7, x = pr >> 3; attn_unit(p, lds, head, 63 - x, tid, wave, lane); attn_unit(p, lds, head, x, tid, wave, lane); } } while (0)
#define P4_BODY_GMLP do { if (G == 256) { gmlp_unit(p, lds, vqa, vr & 7, tid, wave, lane); gmlp_unit(p, lds, vqb, vr & 7, tid, wave, lane); } \
        else for (int u = bx; u < 512; u += G) gmlp_unit(p, lds, u >> 3, u & 7, tid, wave, lane); } while (0)
#if (PROBE_DUP >> 4) & 1
    if (IN(4)) { P4_BODY_ATT; xcd_barrier(xbar); }
#endif
#if (PROBE_DUP >> 9) & 1
    if (IN(4)) { P4_BODY_GMLP; xcd_barrier(xbar); }
#endif
    if (IN(4)) { P4_BODY_ATT; P4_BODY_GMLP; }
    SEAM_X(4);
    if (IN(5)) {
        pg8::Gemm g{(const bf16_t*)(ws + WS_MIX), (const bf16_t*)(ws + WS_WOUT), S, DM, DM, DM, DM};
        pg8::StaticOrder So; So.init(S, DM, G, bx); if (G == 256) So.fixed(vpanel, vr & 7);
        pg8::Epi<4> E{nullptr, 0.f, (float*)(ws + WS_ROWSS) + 3 * S, (bf16_t*)(ws + WS_X1B), DM, p.out, p.in[0]};
#if (PROBE_DUP >> 5) & 1
        { pg8::Epi<4> E2 = E; E2.ss = (float*)(ws + 512 * 1024); pg8::gemm_phase<pg8::Epi<4>, pg8::StaticOrder, true, true>(lds, g, So, E2); xcd_barrier(xbar); }
#endif
        pg8::gemm_phase<pg8::Epi<4>, pg8::StaticOrder, true, true>(lds, g, So, E);
    }
    SEAM_X(5);
    if (IN(6)) {
        pg8::Gemm g{(const bf16_t*)(ws + WS_X1B), (const bf16_t*)(ws + WS_WS), S, DM, DM, DM, DM};
        pg8::StaticOrder So; So.init(S, DM, G, bx); if (G == 256) So.fixed(vpanel, vr & 7);
        pg8::Epi<5> E{(const float*)(ws + WS_ROWSS) + 3 * S, 1.0f / DM, nullptr, nullptr, DM, (float*)(ws + WS_SC), nullptr};
#if (PROBE_DUP >> 6) & 1
        { pg8::gemm_phase<pg8::Epi<5>, pg8::StaticOrder, true, true>(lds, g, So, E); xcd_barrier(xbar); }
#endif
        pg8::gemm_phase<pg8::Epi<5>, pg8::StaticOrder, true, true>(lds, g, So, E);
    }
    SEAM_X(6);
#if (PROBE_DUP >> 7) & 1
    if (IN(7)) { phase7(p, lds, gwv, NGW, wave, lane); xcd_barrier(xbar); }
#endif
    if (IN(7)) phase7(p, lds, gwv, NGW, wave, lane);
    if (IN(7) && IN(8)) { if (NGW == S / 4) xcd_local_barrier(xbar); else xcd_barrier(xbar); }
#if (PROBE_DUP >> 8) & 1
    if (IN(8)) { phase8(p, lds, (float*)(ws + WS_SC), xbar, gwv, NGW, wave, lane); xcd_barrier(xbar); }
#endif
    if (IN(8)) phase8(p, lds, p.out, xbar, gwv, NGW, wave, lane);
#undef IN
#undef SEAM
#undef SEAM_X
}

extern "C" void kernel_launch(void* const* d_in, const int* in_sizes, int n_in, void* d_out, int out_size, void* d_ws, size_t ws_size, hipStream_t stream) {
    static int grid = 0;
    if (grid == 0) {
        if (n_in != 18 || out_size != S * DM || ws_size < WS_END) { fprintf(stderr, "kernel_launch: unexpected shapes (n_in %d out %d ws %zu)\n", n_in, out_size, ws_size); grid = -1; return; }
        int dev = 0, cus = 0, per_cu = 0;
        hipGetDevice(&dev);
        hipDeviceGetAttribute(&cus, hipDeviceAttributeMultiprocessorCount, dev);
        if (hipFuncSetAttribute((const void*)mega, hipFuncAttributeMaxDynamicSharedMemorySize, LDS_BYTES) != hipSuccess) { fprintf(stderr, "kernel_launch: hipFuncSetAttribute failed\n"); grid = -1; return; }
        if (hipOccupancyMaxActiveBlocksPerMultiprocessor(&per_cu, (const void*)mega, NTHREADS, LDS_BYTES) != hipSuccess || per_cu < 1) { fprintf(stderr, "kernel_launch: occupancy query failed (%d)\n", per_cu); grid = -1; return; }
        grid = cus;
        fprintf(stderr, "kernel_launch: cus %d per_cu %d grid %d\n", cus, per_cu, grid);
    }
    if (grid < 0) return;
    hipMemsetAsync((char*)d_ws + WS_CTL, 0, 1 * MiB, stream);
    Params prm{};
    for (int i = 0; i < 18; ++i) prm.in[i] = (const float*)d_in[i];
    prm.out = (float*)d_out; prm.ws = (unsigned char*)d_ws;
#if MK_ONE_LAUNCH
    prm.ph_lo = 0; prm.ph_hi = NPH;
    { void* args[] = {&prm}; hipError_t e = hipLaunchCooperativeKernel((const void*)mega, dim3(grid), dim3(NTHREADS), args, LDS_BYTES, stream);
      if (e != hipSuccess) fprintf(stderr, "cooperative launch failed: %s\n", hipGetErrorString(e)); }
#else
    for (int ph = 0; ph < NPH; ++ph) {
        prm.ph_lo = ph; prm.ph_hi = ph + 1;
        void* args[] = {&prm};
        hipError_t e = hipLaunchCooperativeKernel((const void*)mega, dim3(grid), dim3(NTHREADS), args, LDS_BYTES, stream);
        if (e != hipSuccess) { fprintf(stderr, "cooperative launch %d failed: %s\n", ph, hipGetErrorString(e)); break; }
    }
#endif
}
```

```cpp
#include <hip/hip_runtime.h>
#include <cstdio>
#include <cstdint>

#define LAS __attribute__((address_space(3)))
typedef unsigned short bf16_t;
typedef short bf16x8 __attribute__((ext_vector_type(8)));
typedef short s16x4 __attribute__((ext_vector_type(4)));
typedef float f32x4 __attribute__((ext_vector_type(4)));
typedef float f32x16 __attribute__((ext_vector_type(16)));
typedef unsigned u32x4 __attribute__((ext_vector_type(4)));
typedef unsigned u32x2 __attribute__((ext_vector_type(2)));

#ifndef PROBE_DUP
#define PROBE_DUP 0
#endif
#ifndef MK_ONE_LAUNCH
#define MK_ONE_LAUNCH 1
#endif

constexpr int S = 8192, DM = 2048, NIN = 2880, NINP = 3072;
constexpr int NPH = 9;
constexpr float EPS = 1e-6f;
constexpr int LDS_BYTES = 163840;
constexpr int NTHREADS = 512;
constexpr int LDS_MISC = 161792;

constexpr size_t MiB = 1u << 20;
constexpr size_t WS_CTL = 0;
constexpr size_t WS_ROWSS = 128 * 1024;
constexpr size_t WS_COS = 1 * MiB, WS_SIN = 2 * MiB;
constexpr size_t WS_RSTD1 = 3 * MiB;
constexpr size_t WS_EXP = 4 * MiB;
constexpr size_t WS_GATE = 8 * MiB;
constexpr size_t WS_WIN = 12 * MiB;
constexpr size_t WS_WUQ = 24 * MiB;
constexpr size_t WS_WUKV = 26 * MiB;
constexpr size_t WS_WOUT = 28 * MiB;
constexpr size_t WS_WS = 36 * MiB;
constexpr size_t WS_XB = 44 * MiB;
constexpr size_t WS_PROJ = 76 * MiB;
constexpr size_t WS_QRAW = 124 * MiB;
constexpr size_t WS_KVRAW = 148 * MiB;
constexpr size_t WS_QH = 180 * MiB;
constexpr size_t WS_KH = 204 * MiB;
constexpr size_t WS_VH = 228 * MiB;
constexpr size_t WS_MIX = 244 * MiB;
constexpr size_t WS_X1B = 276 * MiB;
constexpr size_t WS_SC = 308 * MiB;
constexpr size_t WS_UT = 372 * MiB;
constexpr size_t WS_VT = 436 * MiB;
constexpr size_t WS_END = 500 * MiB;

__device__ __forceinline__ unsigned f2bf(float f) { unsigned u = __builtin_bit_cast(unsigned, f); return (u + 0x7fffu + ((u >> 16) & 1u)) >> 16; }
__device__ __forceinline__ unsigned pk2(float lo, float hi) { return f2bf(lo) | (f2bf(hi) << 16); }
__device__ __forceinline__ float bf2f(unsigned short b) { return __builtin_bit_cast(float, (unsigned)b << 16); }
__device__ __forceinline__ float bflo(unsigned w) { return __builtin_bit_cast(float, w << 16); }
__device__ __forceinline__ float bfhi(unsigned w) { return __builtin_bit_cast(float, w & 0xffff0000u); }
__device__ __forceinline__ float wave_sum(float v) {
#pragma unroll
    for (int o = 32; o > 0; o >>= 1) v += __shfl_xor(v, o);
    return v;
}
__device__ __forceinline__ float wave_max(float v) {
#pragma unroll
    for (int o = 32; o > 0; o >>= 1) v = fmaxf(v, __shfl_xor(v, o));
    return v;
}
template <int CTRL, int ROW_MASK> __device__ __forceinline__ float dpp_f(float old, float v) {
    return __builtin_bit_cast(float, __builtin_amdgcn_update_dpp(__builtin_bit_cast(int, old), __builtin_bit_cast(int, v), CTRL, ROW_MASK, 0xf, false));
}
__device__ __forceinline__ float wave_max_u(float v) {
    v = fmaxf(v, dpp_f<0xB1, 0xf>(v, v));
    v = fmaxf(v, dpp_f<0x4E, 0xf>(v, v));
    v = fmaxf(v, dpp_f<0x141, 0xf>(v, v));
    v = fmaxf(v, dpp_f<0x140, 0xf>(v, v));
    v = fmaxf(v, dpp_f<0x142, 0xa>(v, v));
    v = fmaxf(v, dpp_f<0x143, 0xc>(v, v));
    return __builtin_bit_cast(float, __builtin_amdgcn_readlane(__builtin_bit_cast(int, v), 63));
}
__device__ __forceinline__ float wave_sum_u(float v) {
    v += dpp_f<0xB1, 0xf>(0.f, v);
    v += dpp_f<0x4E, 0xf>(0.f, v);
    v += dpp_f<0x141, 0xf>(0.f, v);
    v += dpp_f<0x140, 0xf>(0.f, v);
    v += dpp_f<0x142, 0xa>(0.f, v);
    v += dpp_f<0x143, 0xc>(0.f, v);
    return __builtin_bit_cast(float, __builtin_amdgcn_readlane(__builtin_bit_cast(int, v), 63));
}
__device__ __forceinline__ float gelu_tanh(float x) {
    const float y = 0.7978845608028654f * (x + 0.044715f * x * x * x);
    return x / (1.0f + __expf(-2.0f * y));
}
__device__ __forceinline__ int crow(int r, int hi) { return (r & 3) + 8 * (r >> 2) + 4 * hi; }
#define LDS_WAIT() asm volatile("s_waitcnt lgkmcnt(0)" ::: "memory")
#define SBAR() __builtin_amdgcn_sched_barrier(0)

namespace pg8 {
#define PG8_LAS __attribute__((address_space(3)))
constexpr int BM = 256, BK = 64, HALF = 128, HTB = HALF * BK * 2  , STAGE_BYTES = 8 * HTB, NXCD = 8, WGM = 8;

__host__ __device__ __forceinline__ int lds_byte(int r, int c) { const int st = (r >> 4) * 2 + (c >> 5), rr = r & 15, cc = c & 31, ob = rr * 64 + cc * 2; return st * 1024 + (ob ^ (((ob >> 9) & 1) << 5)); }
__host__ __device__ __forceinline__ void stage_rc(int b, int& R, int& C) { const int st = b / 1024, sb = b % 1024, swz = sb ^ (((sb >> 9) & 1) << 5); R = (st >> 1) * 16 + swz / 64; C = (st & 1) * 32 + (swz % 64) / 2; }
__host__ __device__ __forceinline__ int perm32(int rho) { const int n = rho >> 4, i = rho & 15; return 8 * (i >> 2) + 4 * n + (i & 3); }

struct Unit { int pm, pn; };
struct Gemm { const bf16_t* A; const bf16_t* Bt; int M, N, K, lda, ldb; };

struct StaticOrder {
    int nM, nN, nwg, G, c, fpm = -1, fpn = 0;
    __host__ __device__ void init(int M, int N, int G_, int c_) { nM = M / BM; nN = N / BM; nwg = nM * nN; G = G_; c = c_; fpm = -1; }
    __host__ __device__ void fixed(int pm, int pn) { fpm = pm; fpn = pn; }
    __host__ __device__ bool next(int i, Unit& u) const {
        if (fpm >= 0) { if (i > 0) return false; u.pm = fpm; u.pn = fpn; return true; }
        const long L = (long)i * G + c; if (L >= nwg) return false;
        int wgid = (int)L; { const int q = nwg / NXCD, r = nwg % NXCD, xcd = wgid % NXCD, off = wgid / NXCD; wgid = (xcd < r ? xcd * (q + 1) : r * (q + 1) + (xcd - r) * q) + off; }
        const int nig = WGM * nN, gid = wgid / nig, fm = gid * WGM, gsz = (nM - fm) < WGM ? (nM - fm) : WGM;
        u.pm = fm + ((wgid % nig) % gsz); u.pn = (wgid % nig) / gsz; return true;
    }
    __device__ __forceinline__ void a_ready(const Unit&) const {}
    __device__ __forceinline__ void done(const Unit&) const {}
};

template <class Epi, class Sched, bool ALIGN_EPI = false, bool SP2 = false>
__device__ __forceinline__ void gemm_phase(PG8_LAS unsigned char* lds, const Gemm g, const Sched& S, const Epi& E) {
    const int tid = threadIdx.x, wid = __builtin_amdgcn_readfirstlane(tid >> 6), lane = tid & 63, wr = wid >> 2, wc = wid & 3, fr = lane & 15, fq = lane >> 4;
    const int K = g.K, nt = K / BK;
    unsigned voffA[2], voffB[2];
#pragma unroll
    for (int i = 0; i < 2; ++i) { int R, C; stage_rc(tid * 16 + i * 8192, R, C); const int Rb = Epi::PERM ? ((R & ~31) + perm32(R & 31)) : R;
        voffA[i] = (unsigned)(R * g.lda + C) * 2u; voffB[i] = (unsigned)(Rb * g.ldb + C) * 2u; }
    const size_t kstep = (size_t)(BK * 2);
    const size_t hstepA = (size_t)HALF * g.lda * 2, hstepB = (size_t)HALF * g.ldb * 2;
    const size_t tstepA = 2 * hstepA, tstepB = 2 * hstepB;
    const unsigned ldsw = (unsigned)wid * 1024u;
    const int aoff = lds_byte(wr * 64 + fr, fq * 8), boff = lds_byte(wc * 32 + fr, fq * 8);
#define PG8_SA(b, h) (((b) * 2 + (h)) * HTB)
#define PG8_SB(b, h) ((4 + (b) * 2 + (h)) * HTB)
#define PG8_STAGE(bufoff, gbase, voff) do { _Pragma("unroll") for (int _i = 0; _i < 2; ++_i) \
        __builtin_amdgcn_global_load_lds((const unsigned*)((const char*)(gbase) + (voff)[_i]), (PG8_LAS unsigned*)(lds + (bufoff) + ldsw + _i * 8192), 16, 0, 0); } while (0)
#define PG8_LDA(dst, b, h) do { _Pragma("unroll") for (int m = 0; m < 4; ++m) _Pragma("unroll") for (int k = 0; k < 2; ++k) dst[m][k] = *(const PG8_LAS bf16x8*)(lds + PG8_SA(b, h) + aoff + m * 2048 + k * 1024); } while (0)
#define PG8_LDB(dst, b, h) do { _Pragma("unroll") for (int n = 0; n < 2; ++n) _Pragma("unroll") for (int k = 0; k < 2; ++k) dst[n][k] = *(const PG8_LAS bf16x8*)(lds + PG8_SB(b, h) + boff + n * 2048 + k * 1024); } while (0)
#define PG8_MMA(ai, bj, At, Bt) do { __builtin_amdgcn_s_setprio(1); _Pragma("unroll") for (int m = 0; m < 4; ++m) _Pragma("unroll") for (int n = 0; n < 2; ++n) _Pragma("unroll") for (int k = 0; k < 2; ++k) \
        acc[ai][bj][m][n] = __builtin_amdgcn_mfma_f32_16x16x32_bf16(Bt[n][k], At[m][k], acc[ai][bj][m][n], 0, 0, 0); __builtin_amdgcn_s_setprio(0); } while (0)
#define PG8_WAIT_V(n) asm volatile("s_waitcnt vmcnt(" #n ")" ::: "memory")
#define PG8_WAIT_L(n) asm volatile("s_waitcnt lgkmcnt(" #n ")" ::: "memory")
#define PG8_BAR __builtin_amdgcn_s_barrier()
#define PG8_SCHED __builtin_amdgcn_sched_barrier(0)
    Unit cur, nxt; int ui = 0;
    if (!S.next(0, cur)) return;
    f32x4 acc[2][2][4][2];
#pragma unroll
    for (int a = 0; a < 2; ++a)
#pragma unroll
        for (int b = 0; b < 2; ++b)
#pragma unroll
            for (int m = 0; m < 4; ++m)
#pragma unroll
                for (int n = 0; n < 2; ++n) acc[a][b][m][n] = (f32x4){0.f, 0.f, 0.f, 0.f};
    bf16x8 At[4][2], B0[2][2], B1[2][2];
    const char* cA = (const char*)g.A + (size_t)cur.pm * tstepA; const char* cB = (const char*)g.Bt + (size_t)cur.pn * tstepB;
    S.a_ready(cur);
    if constexpr (SP2) {
        PG8_STAGE(PG8_SB(0, 0), cB, voffB); PG8_STAGE(PG8_SB(0, 1), cB + hstepB, voffB); PG8_STAGE(PG8_SA(0, 0), cA, voffA); PG8_STAGE(PG8_SA(0, 1), cA + hstepA, voffA);
        if (wr == 1) PG8_BAR;
        PG8_WAIT_V(2); PG8_BAR;
        PG8_STAGE(PG8_SB(1, 0), cB + kstep, voffB); PG8_STAGE(PG8_SA(1, 0), cA + kstep, voffA); PG8_STAGE(PG8_SB(1, 1), cB + hstepB + kstep, voffB);
        PG8_WAIT_V(6); PG8_BAR;
    } else {
        PG8_STAGE(PG8_SB(0, 0), cB, voffB); PG8_STAGE(PG8_SA(0, 0), cA, voffA); PG8_STAGE(PG8_SB(0, 1), cB + hstepB, voffB); PG8_STAGE(PG8_SA(0, 1), cA + hstepA, voffA);
        if (wr == 1) PG8_BAR;
        PG8_WAIT_V(4); PG8_BAR;
        PG8_STAGE(PG8_SB(1, 0), cB + kstep, voffB); PG8_STAGE(PG8_SA(1, 0), cA + kstep, voffA); PG8_STAGE(PG8_SB(1, 1), cB + hstepB + kstep, voffB);
        PG8_WAIT_V(6); PG8_BAR;
    }
    for (;;) {
        const bool has_next = S.next(ui + 1, nxt);
        const char* nA = has_next ? (const char*)g.A + (size_t)nxt.pm * tstepA : cA; const char* nB = has_next ? (const char*)g.Bt + (size_t)nxt.pn * tstepB : cB;
        for (int t = 0; t < nt; t += 2) {
            const bool last = (t == nt - 2);
            const char* a1 = cA + (size_t)(t + 1) * kstep;
            const char* a2 = last ? nA : cA + (size_t)(t + 2) * kstep; const char* b2 = last ? nB : cB + (size_t)(t + 2) * kstep;
            const char* a3 = a2 + kstep; const char* b3 = b2 + kstep;
            if (last && has_next) S.a_ready(nxt);
            if constexpr (SP2) {
            PG8_LDB(B0, 0, 0); PG8_LDB(B1, 0, 1); PG8_SCHED; PG8_LDA(At, 0, 0); PG8_STAGE(PG8_SA(1, 1), a1 + hstepA, voffA);
            PG8_WAIT_V(8); PG8_WAIT_L(0); PG8_BAR; PG8_MMA(0, 0, At, B0); PG8_MMA(0, 1, At, B1); PG8_BAR; PG8_SCHED;
            PG8_LDA(At, 0, 1); PG8_STAGE(PG8_SB(0, 0), b2, voffB); PG8_STAGE(PG8_SB(0, 1), b2 + hstepB, voffB); PG8_STAGE(PG8_SA(0, 0), a2, voffA);
            PG8_WAIT_V(8); PG8_WAIT_L(0); PG8_BAR; PG8_MMA(1, 0, At, B0); PG8_MMA(1, 1, At, B1); PG8_BAR; PG8_SCHED;
            PG8_LDB(B0, 1, 0); PG8_LDB(B1, 1, 1); PG8_SCHED; PG8_LDA(At, 1, 0); PG8_STAGE(PG8_SA(0, 1), a2 + hstepA, voffA);
            PG8_WAIT_V(8); PG8_WAIT_L(0); PG8_BAR; PG8_MMA(0, 0, At, B0); PG8_MMA(0, 1, At, B1); PG8_BAR; PG8_SCHED;
            PG8_LDA(At, 1, 1); PG8_STAGE(PG8_SB(1, 0), b3, voffB); PG8_STAGE(PG8_SB(1, 1), b3 + hstepB, voffB); PG8_STAGE(PG8_SA(1, 0), a3, voffA);
            PG8_WAIT_V(8); PG8_WAIT_L(0); PG8_BAR; PG8_MMA(1, 0, At, B0); PG8_MMA(1, 1, At, B1); PG8_BAR; PG8_SCHED;
            } else {
            PG8_LDB(B0, 0, 0); PG8_SCHED; PG8_LDA(At, 0, 0); PG8_STAGE(PG8_SA(1, 1), a1 + hstepA, voffA);
            PG8_WAIT_L(8); PG8_BAR; PG8_WAIT_L(0); PG8_MMA(0, 0, At, B0); PG8_BAR; PG8_SCHED;
            PG8_LDB(B1, 0, 1); PG8_STAGE(PG8_SB(0, 0), b2, voffB);
            PG8_BAR; PG8_WAIT_L(0); PG8_MMA(0, 1, At, B1); PG8_BAR;
            PG8_LDA(At, 0, 1); PG8_STAGE(PG8_SA(0, 0), a2, voffA);
            PG8_BAR; PG8_WAIT_L(0); PG8_MMA(1, 0, At, B0); PG8_BAR; PG8_SCHED;
            PG8_STAGE(PG8_SB(0, 1), b2 + hstepB, voffB);
            PG8_WAIT_V(6); PG8_BAR; PG8_MMA(1, 1, At, B1); PG8_BAR;
            PG8_LDB(B0, 1, 0); PG8_SCHED; PG8_LDA(At, 1, 0); PG8_STAGE(PG8_SA(0, 1), a2 + hstepA, voffA);
            PG8_WAIT_L(8); PG8_BAR; PG8_WAIT_L(0); PG8_MMA(0, 0, At, B0); PG8_BAR; PG8_SCHED;
            PG8_LDB(B1, 1, 1); PG8_STAGE(PG8_SB(1, 0), b3, voffB);
            PG8_BAR; PG8_WAIT_L(0); PG8_MMA(0, 1, At, B1); PG8_BAR;
            PG8_LDA(At, 1, 1); PG8_STAGE(PG8_SA(1, 0), a3, voffA);
            PG8_BAR; PG8_WAIT_L(0); PG8_MMA(1, 0, At, B0); PG8_BAR; PG8_SCHED;
            PG8_STAGE(PG8_SB(1, 1), b3 + hstepB, voffB);
            PG8_WAIT_V(6); PG8_BAR; PG8_MMA(1, 1, At, B1); PG8_BAR;
            }
        }
        if constexpr (ALIGN_EPI) { if (wr == 0) PG8_BAR; }
        if constexpr (!Epi::AFTER_DRAIN) { E(acc, cur, wr, wc, fr, fq); S.done(cur); }
        if (!has_next) break;
#pragma unroll
        for (int a = 0; a < 2; ++a)
#pragma unroll
            for (int b = 0; b < 2; ++b)
#pragma unroll
                for (int m = 0; m < 4; ++m)
#pragma unroll
                    for (int n = 0; n < 2; ++n) acc[a][b][m][n] = (f32x4){0.f, 0.f, 0.f, 0.f};
        cur = nxt; cA = nA; cB = nB; ++ui;
        if constexpr (ALIGN_EPI) { if (wr == 1) PG8_BAR; }
    }
    PG8_WAIT_V(0);
    if constexpr (!ALIGN_EPI) { if (wr == 0) PG8_BAR; }
    PG8_BAR;
#undef PG8_SA
#undef PG8_SB
#undef PG8_STAGE
#undef PG8_LDA
#undef PG8_LDB
#undef PG8_MMA
#undef PG8_WAIT_V
#undef PG8_WAIT_L
#undef PG8_BAR
#undef PG8_SCHED
}

template <int MODE> struct Epi {
    static constexpr bool PERM = false, AFTER_DRAIN = false;
    const float* rowsrc; float inv_n; float* ss; bf16_t* ob; int ldc; float* of; const float* xin;
    __device__ __forceinline__ void operator()(const f32x4 (&acc)[2][2][4][2], const Unit& u, int wr, int wc, int fr, int fq) const {
#pragma unroll
        for (int ai = 0; ai < 2; ++ai)
#pragma unroll
            for (int m = 0; m < 4; ++m) {
                const int row = u.pm * BM + ai * HALF + wr * 64 + m * 16 + fr;
                float rs = 1.f;
                if (MODE == 1) rs = rowsrc[row];
                if (MODE == 2 || MODE == 5) rs = rsqrtf(rowsrc[row] * inv_n + EPS);
                float ssq = 0.f;
#pragma unroll
                for (int bj = 0; bj < 2; ++bj)
#pragma unroll
                    for (int n = 0; n < 2; ++n) {
                        const int col = u.pn * BM + bj * HALF + wc * 32 + n * 16 + fq * 4;
                        f32x4 v = acc[ai][bj][m][n] * rs;
                        if (MODE == 1) { if (u.pn < 8) { v[0] = gelu_tanh(v[0]); v[1] = gelu_tanh(v[1]); v[2] = gelu_tanh(v[2]); v[3] = gelu_tanh(v[3]); } }
                        if (MODE == 4) { const f32x4 xr = *(const f32x4*)(xin + (size_t)row * DM + col); v = v + xr; }
                        if (MODE == 1 || MODE == 4) ssq += (v[0] * v[0] + v[1] * v[1]) + (v[2] * v[2] + v[3] * v[3]);
                        if (MODE == 1 || MODE == 2 || MODE == 4) { u32x2 w; w.x = pk2(v[0], v[1]); w.y = pk2(v[2], v[3]); *(u32x2*)(ob + (size_t)row * ldc + col) = w; }
                        if (MODE == 5) *(f32x4*)(of + (size_t)row * DM + col) = v;
                    }
                if (MODE == 1) {
                    const int seg = (u.pn >= 4 && u.pn < 8) ? 0 : ((u.pn == 8 || u.pn == 9) ? 1 : (u.pn == 10 ? 2 : -1));
                    if (seg >= 0) { ssq += __shfl_xor(ssq, 16); ssq += __shfl_xor(ssq, 32); if (fq == 0) atomicAdd(ss + seg * S + row, ssq); }
                }
                if (MODE == 4) { ssq += __shfl_xor(ssq, 16); ssq += __shfl_xor(ssq, 32); if (fq == 0) atomicAdd(ss + row, ssq); }
            }
    }
};
}

#define XB_TMO      128
#define XB_XCNT(j)  (256  + 64 * (j))
#define XB_XSUB(j)  (1280 + 64 * (j))
#define XB_XGEN(j)  (2304 + 64 * (j))
#define XB_TOP      3328
#define XB_TOPGEN   3392
#define XCD_BAR_WORDS 3456
#define XB_SPIN_CAP (1u << 18)
__device__ __forceinline__ unsigned xb_ld(unsigned* p)              { return __hip_atomic_load(p, __ATOMIC_RELAXED, __HIP_MEMORY_SCOPE_AGENT); }
__device__ __forceinline__ unsigned xb_add(unsigned* p, unsigned v) { return __hip_atomic_fetch_add(p, v, __ATOMIC_RELAXED, __HIP_MEMORY_SCOPE_AGENT); }
__device__ __forceinline__ unsigned xb_xcc_id() { return (unsigned)__builtin_amdgcn_s_getreg((3 << 11) | 20) & 0xFu; }
#define XB_SPIN(cond, bar) do { unsigned _sp = 0; while (cond) { __builtin_amdgcn_s_sleep(1); \
    if ((++_sp & 255u) == 0u) { if (xb_ld(&(bar)[XB_TMO])) break; if (_sp > XB_SPIN_CAP) { atomicAdd(&(bar)[XB_TMO], 1u); break; } } } } while (0)
struct XcdBarrier { unsigned* bar; unsigned x; volatile LAS unsigned* st; };
__device__ __forceinline__ XcdBarrier xcd_barrier_post(unsigned* bar, volatile LAS unsigned* st) {
    XcdBarrier b; b.bar = bar; b.x = xb_xcc_id(); b.st = st;
    if (threadIdx.x == 0) st[3] = xb_add(&bar[XB_XCNT(b.x)], 1u);
    return b;
}
__device__ __forceinline__ void xcd_barrier_complete(unsigned* bar, unsigned x, unsigned& nloc, unsigned& nx, unsigned& eq32) {
    const unsigned G = gridDim.x * gridDim.y * gridDim.z;
    unsigned sum, cnt, mine, sp = 0u;
    for (;;) {
        sum = 0u; cnt = 0u; mine = 0u; eq32 = 1u;
#pragma unroll
        for (unsigned j = 0; j < 16; ++j) { const unsigned c = xb_ld(&bar[XB_XCNT(j)]); sum += c; cnt += (c > 0u) ? 1u : 0u; mine = (j == x) ? c : mine; if (c != (j < 8u ? 32u : 0u)) eq32 = 0u; }
        if (sum == G) break;
        __builtin_amdgcn_s_sleep(1);
        if ((++sp & 255u) == 0u) { if (xb_ld(&bar[XB_TMO])) break; if (sp > XB_SPIN_CAP) { atomicAdd(&bar[XB_TMO], 1u); break; } }
    }
    nloc = mine > 0u ? mine : 1u; nx = cnt > 0u ? cnt : 1u;
}
#define XB_LSUB(j)  (3456 + 64 * (j))
#define XB_LGEN(j)  (4480 + 64 * (j))
__device__ __forceinline__ void xcd_local_barrier(const XcdBarrier& b) {
    asm volatile("s_waitcnt vmcnt(0)" ::: "memory");
    __syncthreads();
    if (threadIdx.x == 0) {
        unsigned* bar = b.bar;
        const unsigned nloc = b.st[0];
        const unsigned old = xb_add(&bar[XB_LSUB(b.x)], 1u);
        const unsigned gen = old / nloc;
        if (old + 1u == (gen + 1u) * nloc) xb_add(&bar[XB_LGEN(b.x)], 1u);
        else XB_SPIN(xb_ld(&bar[XB_LGEN(b.x)]) == gen, bar);
    }
    __syncthreads();
}
__device__ __forceinline__ void xcd_local_barrier_acq(const XcdBarrier& b) {
    asm volatile("s_waitcnt vmcnt(0)" ::: "memory");
    __syncthreads();
    if (threadIdx.x == 0) {
        unsigned* bar = b.bar;
        __builtin_amdgcn_s_waitcnt(0);
        const unsigned nloc = b.st[0];
        const unsigned old = xb_add(&bar[XB_LSUB(b.x)], 1u);
        const unsigned gen = old / nloc;
        if (old + 1u == (gen + 1u) * nloc) xb_add(&bar[XB_LGEN(b.x)], 1u);
        else XB_SPIN(xb_ld(&bar[XB_LGEN(b.x)]) == gen, bar);
        __builtin_amdgcn_fence(__ATOMIC_ACQUIRE, "agent");
        asm volatile("s_waitcnt vmcnt(0)" ::: "memory");
    }
    __syncthreads();
}
__device__ __forceinline__ void xcd_barrier(const XcdBarrier& b) {
    asm volatile("s_waitcnt vmcnt(0)" ::: "memory");
    __syncthreads();
    if (threadIdx.x == 0) {
        unsigned* bar = b.bar;
        __builtin_amdgcn_s_waitcnt(0);
        unsigned nloc = b.st[0], nx = b.st[1];
        if (nloc == 0u) { unsigned eq32; xcd_barrier_complete(bar, b.x, nloc, nx, eq32); b.st[0] = nloc; b.st[1] = nx; b.st[2] = eq32; }
        const unsigned old = xb_add(&bar[XB_XSUB(b.x)], 1u);
        const unsigned gen = old / nloc;
        if (old + 1u == (gen + 1u) * nloc) {
            __builtin_amdgcn_fence(__ATOMIC_RELEASE, "agent");
            asm volatile("s_waitcnt vmcnt(0)" ::: "memory");
            const unsigned og = xb_add(&bar[XB_TOP], 1u);
            const unsigned tg = og / nx;
            if (og + 1u == (tg + 1u) * nx) xb_add(&bar[XB_TOPGEN], 1u);
            else XB_SPIN(xb_ld(&bar[XB_TOPGEN]) == tg, bar);
            __builtin_amdgcn_fence(__ATOMIC_ACQUIRE, "agent");
            xb_add(&bar[XB_XGEN(b.x)], 1u);
            asm volatile("s_waitcnt vmcnt(0)" ::: "memory");
        } else {
            XB_SPIN(xb_ld(&bar[XB_XGEN(b.x)]) == gen, bar);
            __builtin_amdgcn_fence(__ATOMIC_ACQUIRE, "agent");
            asm volatile("s_waitcnt vmcnt(0)" ::: "memory");
        }
    }
    __syncthreads();
}

struct Params {
    const float* in[18];
    float* out;
    unsigned char* ws;
    int ph_lo, ph_hi;
};

__device__ __forceinline__ void p0_transpose_item(const float* W, const float* g, int K, int N, bf16_t* WT, LAS float* scr, int item, int lane) {
    const int nblk = N / 32, kb = item / nblk, nb = item % nblk, k0 = 64 * kb, n0 = 32 * nb;
    float wv[32];
#pragma unroll
    for (int i = 0; i < 32; ++i) { const int kk = 2 * i + (lane >> 5); wv[i] = W[(size_t)(k0 + kk) * N + n0 + (lane & 31)]; }
#pragma unroll
    for (int i = 0; i < 32; ++i) { const int kk = 2 * i + (lane >> 5); const float gv = g ? g[k0 + kk] : 1.f; scr[kk * 33 + (lane & 31)] = wv[i] * gv; }
    LDS_WAIT(); asm volatile("" ::: "memory");
    const int c = lane & 7;
#pragma unroll
    for (int j = 0; j < 4; ++j) { const int n = (lane >> 3) + 8 * j; const LAS float* s = scr + (8 * c) * 33 + n;
        u32x4 o; o.x = pk2(s[0 * 33], s[1 * 33]); o.y = pk2(s[2 * 33], s[3 * 33]); o.z = pk2(s[4 * 33], s[5 * 33]); o.w = pk2(s[6 * 33], s[7 * 33]);
        *(u32x4*)(WT + (size_t)(n0 + n) * K + k0 + 8 * c) = o; }
    LDS_WAIT(); asm volatile("" ::: "memory");
}
__device__ __forceinline__ float row_to_bf16(const float* src, const float* g, bf16_t* dst, int lane) {
    float ss = 0.f;
#pragma unroll
    for (int i = 0; i < 8; ++i) {
        const int c = (i * 64 + lane) * 4;
        f32x4 v = *(const f32x4*)(src + c);
        ss += (v[0] * v[0] + v[1] * v[1]) + (v[2] * v[2] + v[3] * v[3]);
        if (g) { const f32x4 gv = *(const f32x4*)(g + c); v = v * gv; }
        u32x2 w; w.x = pk2(v[0], v[1]); w.y = pk2(v[2], v[3]);
        *(u32x2*)(dst + c) = w;
    }
    return ss;
}
constexpr float PEER_USC = 80.0f, PEER_VSC = 5.0f;
constexpr int PEER_ROWB = 1536;
typedef float f32x16v __attribute__((ext_vector_type(16)));
typedef float f32x32v __attribute__((ext_vector_type(32)));
typedef unsigned u32x6 __attribute__((ext_vector_type(6)));
typedef unsigned u32x2a4 __attribute__((ext_vector_type(2), aligned(4)));
template <bool CONTIG>
__device__ __forceinline__ void fp6_pack_store(const f32x4 (&x)[8], const f32x4 (&sc)[8], unsigned char* dst, int lane) {
    f32x16v a, b;
#pragma unroll
    for (int i = 0; i < 8; ++i) {
        const f32x4 y = x[i] * sc[i];
#pragma unroll
        for (int q = 0; q < 4; ++q) { const float c = fminf(fmaxf(y[q], -7.5f), 7.5f); const int sl = 4 * i + q; if ((sl & 1) == 0) a[sl >> 1] = c; else b[sl >> 1] = c; }
    }
    const u32x6 pk = __builtin_amdgcn_cvt_scalef32_2xpk16_fp6_f32(a, b, 1.0f);
    asm volatile("s_nop 15" : "+v"(a), "+v"(b));
    if (CONTIG) {
        *(u32x2*)(dst + lane * 24) = (u32x2){pk[0], pk[1]}; *(u32x2*)(dst + lane * 24 + 8) = (u32x2){pk[2], pk[3]}; *(u32x2*)(dst + lane * 24 + 16) = (u32x2){pk[4], pk[5]};
    } else {
        *(u32x4*)(dst + lane * 16) = (u32x4){pk[0], pk[1], pk[2], pk[3]};
        *(u32x2*)(dst + 1024 + lane * 8) = (u32x2){pk[4], pk[5]};
    }
}
template <bool CONTIG>
__device__ __forceinline__ void rows2_to_fp6(const float* s0, const float* s1, const f32x4 (&sc)[8], unsigned char* d0, unsigned char* d1, int lane) {
    f32x4 x0[8], x1[8];
#pragma unroll
    for (int i = 0; i < 8; ++i) { x0[i] = *(const f32x4*)(s0 + (i * 64 + lane) * 4); x1[i] = *(const f32x4*)(s1 + (i * 64 + lane) * 4); }
    fp6_pack_store<CONTIG>(x0, sc, d0, lane); fp6_pack_store<CONTIG>(x1, sc, d1, lane);
}
__device__ __forceinline__ bf16x8 cvt8(const float* p) {
    const f32x4 a = *(const f32x4*)p, b = *(const f32x4*)(p + 4);
    u32x4 w; w.x = pk2(a[0], a[1]); w.y = pk2(a[2], a[3]); w.z = pk2(b[0], b[1]); w.w = pk2(b[2], b[3]);
    return __builtin_bit_cast(bf16x8, w);
}

__device__ __forceinline__ void prep_late(const Params& p, LAS unsigned char* lds, int gw, int NGW, int wave, int lane) {
    unsigned char* ws = p.ws;
    LAS float* scr = (LAS float*)(lds + wave * 16384);
    {
        constexpr int I_UQ = (512 / 64) * (1536 / 32), I_UKV = (256 / 64) * (2048 / 32), I_OUT = (DM / 64) * (DM / 32);
        constexpr int NIT = I_UQ + I_UKV + I_OUT;
        for (int it = gw; it < NIT; it += NGW) {
            int r = it;
            if (r < I_UQ) { p0_transpose_item(p.in[7], p.in[6], 512, 1536, (bf16_t*)(ws + WS_WUQ), scr, r, lane); continue; } r -= I_UQ;
            if (r < I_UKV) { p0_transpose_item(p.in[9], p.in[8], 256, 2048, (bf16_t*)(ws + WS_WUKV), scr, r, lane); continue; } r -= I_UKV;
            p0_transpose_item(p.in[12], nullptr, DM, DM, (bf16_t*)(ws + WS_WOUT), scr, r, lane);
        }
    }
    {
        const float* wq = p.in[14]; const float* sk = p.in[15]; const float* g2 = p.in[13];
        bf16_t* WsT = (bf16_t*)(ws + WS_WS);
        const int r32 = lane & 31, hh = lane >> 5;
        for (int it = gw; it < 16 * 4 * 64; it += NGW) {
            const int hp = it >> 8, kb = (it >> 6) & 3, nb = it & 63;
            f32x16 acc = {};
            const float* ap = sk + ((size_t)(hp * 128 + kb * 32 + r32)) * 128 + hh * 8;
            const float* bp = wq + ((size_t)(nb * 32 + r32)) * DM + hp * 128 + hh * 8;
#pragma unroll
            for (int s = 0; s < 8; ++s) {
                const bf16x8 a = cvt8(ap + s * 16), b = cvt8(bp + s * 16);
                acc = __builtin_amdgcn_mfma_f32_32x32x16_bf16(a, b, acc, 0, 0, 0);
            }
            const int kcol = nb * 32 + r32; const float gk = g2[kcol];
#pragma unroll
            for (int r = 0; r < 16; ++r) WsT[(size_t)(hp * 128 + kb * 32 + crow(r, hh)) * DM + kcol] = (bf16_t)f2bf(acc[r] * gk);
        }
    }
    {
        float* ct = (float*)(ws + WS_COS); float* st = (float*)(ws + WS_SIN);
        for (int it = gw; it < S * 32 / 64; it += NGW) {
            const int idx = it * 64 + lane, t = idx >> 5, j = idx & 31;
            const float inv_freq = powf(10000.0f, -(float)j / 32.0f);
            const float ang = (float)t * inv_freq;
            float sv, cv; sincosf(ang, &sv, &cv); ct[idx] = cv; st[idx] = sv;
        }
    }
}
__device__ __forceinline__ void phase0(const Params& p, LAS unsigned char* lds, bool late_ok, int gw, int NGW, int wave, int lane) {
    unsigned char* ws = p.ws;
    LAS float* scr = (LAS float*)(lds + wave * 16384);
    const float* x = p.in[0];
    {
        constexpr int I_IN = (DM / 64) * (NIN / 32);
        for (int it = gw; it < I_IN; it += NGW) p0_transpose_item(p.in[2], p.in[1], DM, NIN, (bf16_t*)(ws + WS_WIN), scr, it, lane);
    }
    if (!late_ok) prep_late(p, lds, gw, NGW, wave, lane);
    for (int r = gw; r < NINP - NIN; r += NGW) {
        bf16_t* d = (bf16_t*)(ws + WS_WIN) + (size_t)(NIN + r) * DM;
#pragma unroll
        for (int i = 0; i < 4; ++i) *(u32x4*)(d + (i * 64 + lane) * 8) = (u32x4){0u, 0u, 0u, 0u};
    }
    {
        bf16_t* xb = (bf16_t*)(ws + WS_XB); float* rstd1 = (float*)(ws + WS_RSTD1);
        for (int t = gw; t + NGW < S; t += 2 * NGW) {
            const int t1 = t + NGW;
            f32x4 a[8], b[8];
#pragma unroll
            for (int i = 0; i < 8; ++i) { a[i] = *(const f32x4*)(x + (size_t)t * DM + (i * 64 + lane) * 4); b[i] = *(const f32x4*)(x + (size_t)t1 * DM + (i * 64 + lane) * 4); }
            float sa = 0.f, sb = 0.f;
#pragma unroll
            for (int i = 0; i < 8; ++i) {
                sa += (a[i][0] * a[i][0] + a[i][1] * a[i][1]) + (a[i][2] * a[i][2] + a[i][3] * a[i][3]);
                sb += (b[i][0] * b[i][0] + b[i][1] * b[i][1]) + (b[i][2] * b[i][2] + b[i][3] * b[i][3]);
                u32x2 wa, wb; wa.x = pk2(a[i][0], a[i][1]); wa.y = pk2(a[i][2], a[i][3]); wb.x = pk2(b[i][0], b[i][1]); wb.y = pk2(b[i][2], b[i][3]);
                *(u32x2*)(xb + (size_t)t * DM + (i * 64 + lane) * 4) = wa; *(u32x2*)(xb + (size_t)t1 * DM + (i * 64 + lane) * 4) = wb;
            }
            sa = wave_sum(sa); sb = wave_sum(sb);
            if (lane == 0) { rstd1[t] = rsqrtf(sa * (1.0f / DM) + EPS); rstd1[t1] = rsqrtf(sb * (1.0f / DM) + EPS); }
        }
    }
    {
        unsigned char* UT = ws + WS_UT; unsigned char* VT = ws + WS_VT;
        f32x4 sc[8];
#pragma unroll
        for (int i = 0; i < 8; ++i) sc[i] = *(const f32x4*)(p.in[13] + (i * 64 + lane) * 4) * PEER_USC;
        for (int e = gw; e + NGW < 16384; e += 2 * NGW)
            rows2_to_fp6<false>(p.in[16] + (size_t)e * DM, p.in[16] + (size_t)(e + NGW) * DM, sc, UT + (size_t)e * PEER_ROWB, UT + (size_t)(e + NGW) * PEER_ROWB, lane);
#pragma unroll
        for (int i = 0; i < 8; ++i) sc[i] = (f32x4){PEER_VSC, PEER_VSC, PEER_VSC, PEER_VSC};
        for (int e = gw; e + NGW < 16384; e += 2 * NGW)
            rows2_to_fp6<false>(p.in[17] + (size_t)e * DM, p.in[17] + (size_t)(e + NGW) * DM, sc, VT + (size_t)e * PEER_ROWB, VT + (size_t)(e + NGW) * PEER_ROWB, lane);
    }
}

__device__ __forceinline__ void phase3(const Params& p, int gw, int NGW, int lane) {
    unsigned char* ws = p.ws;
    const bf16_t* qraw = (const bf16_t*)(ws + WS_QRAW); const bf16_t* kvraw = (const bf16_t*)(ws + WS_KVRAW); const bf16_t* proj = (const bf16_t*)(ws + WS_PROJ);
    bf16_t* Qh = (bf16_t*)(ws + WS_QH); bf16_t* Kh = (bf16_t*)(ws + WS_KH);
    const float* ct = (const float*)(ws + WS_COS); const float* st = (const float*)(ws + WS_SIN);
    const bool act = lane < 48, isrope = lane >= 32 && lane < 48, lowhalf = lane < 40;
    const int e0 = act ? 4 * lane : 0;
    const f32x4 gq = *(const f32x4*)(p.in[10] + e0), gk = *(const f32x4*)(p.in[11] + e0);
    const int j0 = isrope ? ((4 * lane - 128) & 31) : 0;
    constexpr float QS = 0.07216878364870322f * 1.4426950408889634f;
    for (int t = gw; t < S; t += NGW) {
        f32x4 cs = {1.f, 1.f, 1.f, 1.f}, sn = {0.f, 0.f, 0.f, 0.f};
        if (isrope) { cs = *(const f32x4*)(ct + t * 32 + j0); sn = *(const f32x4*)(st + t * 32 + j0); }
        u32x2 krw = {0u, 0u};
        if (isrope) krw = *(const u32x2*)(proj + (size_t)t * NINP + 2816 + (4 * lane - 128));
        const f32x4 krope = {bflo(krw.x), bfhi(krw.x), bflo(krw.y), bfhi(krw.y)};
#pragma unroll
        for (int h = 0; h < 8; ++h) {
            u32x2 qw = {0u, 0u};
            if (act) qw = *(const u32x2*)(qraw + (size_t)t * 1536 + h * 192 + e0);
            f32x4 q = {bflo(qw.x), bfhi(qw.x), bflo(qw.y), bfhi(qw.y)};
            float ss = wave_sum_u((q[0] * q[0] + q[1] * q[1]) + (q[2] * q[2] + q[3] * q[3]));
            float rs = rsqrtf(ss * (1.0f / 192.0f) + EPS);
            q = q * gq * rs;
            {
                f32x4 pr;
#pragma unroll
                for (int c = 0; c < 4; ++c) pr[c] = __shfl_xor(q[c], 8);
                const f32x4 r1 = q * cs - pr * sn, r2 = pr * sn + q * cs;
                if (isrope) q = lowhalf ? r1 : r2;
            }
            q = q * QS;
            if (act) { u32x2 w; w.x = pk2(q[0], q[1]); w.y = pk2(q[2], q[3]); *(u32x2*)(Qh + ((size_t)h * S + t) * 192 + e0) = w; }
            u32x2 kw = {0u, 0u};
            if (lane < 32) kw = *(const u32x2*)(kvraw + (size_t)t * 2048 + h * 256 + e0);
            f32x4 k = {bflo(kw.x), bfhi(kw.x), bflo(kw.y), bfhi(kw.y)};
            if (isrope) k = krope;
            ss = wave_sum_u((k[0] * k[0] + k[1] * k[1]) + (k[2] * k[2] + k[3] * k[3]));
            rs = rsqrtf(ss * (1.0f / 192.0f) + EPS);
            k = k * gk * rs;
            {
                f32x4 pr;
#pragma unroll
                for (int c = 0; c < 4; ++c) pr[c] = __shfl_xor(k[c], 8);
                const f32x4 r1 = k * cs - pr * sn, r2 = pr * sn + k * cs;
                if (isrope) k = lowhalf ? r1 : r2;
            }
            if (act) { u32x2 w; w.x = pk2(k[0], k[1]); w.y = pk2(k[2], k[3]); *(u32x2*)(Kh + ((size_t)h * S + t) * 192 + e0) = w; }
        }
    }
}

constexpr int KP = 400, VP = 320;
template <int OFF> __device__ __forceinline__ s16x4 tr_read(unsigned addr) {
    s16x4 r; asm volatile("ds_read_b64_tr_b16 %0, %1 offset:%2" : "=&v"(r) : "v"(addr), "i"(OFF) : "memory"); return r;
}
__device__ __forceinline__ unsigned cvtpk(float lo, float hi) { unsigned r; asm volatile("v_cvt_pk_bf16_f32 %0, %1, %2" : "=v"(r) : "v"(lo), "v"(hi)); return r; }
#define PK8(L, H) ((bf16x8){L[0], L[1], L[2], L[3], H[0], H[1], H[2], H[3]})
constexpr float ATT_THR = 8.0f;

constexpr int ATT_KB = 64 * KP, ATT_VB = 64 * VP;
constexpr int ATT_VOFF = 2 * ATT_KB;
__device__ __forceinline__ float xhalf_max(float v) {
    auto rr = __builtin_amdgcn_permlane32_swap(__builtin_bit_cast(unsigned, v), __builtin_bit_cast(unsigned, v), false, false);
    return fmaxf(__builtin_bit_cast(float, rr[0]), __builtin_bit_cast(float, rr[1]));
}
__device__ __forceinline__ float xhalf_sum(float v) {
    auto rr = __builtin_amdgcn_permlane32_swap(__builtin_bit_cast(unsigned, v), __builtin_bit_cast(unsigned, v), false, false);
    return __builtin_bit_cast(float, rr[0]) + __builtin_bit_cast(float, rr[1]);
}
template <int OFF> __device__ __forceinline__ bf16x8 lds_read128(unsigned addr) {
    bf16x8 r; asm volatile("ds_read_b128 %0, %1 offset:%2" : "=&v"(r) : "v"(addr), "i"(OFF) : "memory"); return r;
}
#define LGKM_WAIT(n) do { asm volatile("s_waitcnt lgkmcnt(" #n ")" ::: "memory"); SBAR(); } while (0)
__device__ __forceinline__ f32x16 att_qk(unsigned kaddr, const bf16x8 (&qr)[12]) {
    f32x16 p = {};
    bf16x8 a0 = lds_read128<0>(kaddr), a1 = lds_read128<32>(kaddr), a2 = lds_read128<64>(kaddr), a3 = lds_read128<96>(kaddr);
    LGKM_WAIT(3); p = __builtin_amdgcn_mfma_f32_32x32x16_bf16(a0, qr[0], p, 0, 0, 0); a0 = lds_read128<128>(kaddr);
    LGKM_WAIT(3); p = __builtin_amdgcn_mfma_f32_32x32x16_bf16(a1, qr[1], p, 0, 0, 0); a1 = lds_read128<160>(kaddr);
    LGKM_WAIT(3); p = __builtin_amdgcn_mfma_f32_32x32x16_bf16(a2, qr[2], p, 0, 0, 0); a2 = lds_read128<192>(kaddr);
    LGKM_WAIT(3); p = __builtin_amdgcn_mfma_f32_32x32x16_bf16(a3, qr[3], p, 0, 0, 0); a3 = lds_read128<224>(kaddr);
    LGKM_WAIT(3); p = __builtin_amdgcn_mfma_f32_32x32x16_bf16(a0, qr[4], p, 0, 0, 0); a0 = lds_read128<256>(kaddr);
    LGKM_WAIT(3); p = __builtin_amdgcn_mfma_f32_32x32x16_bf16(a1, qr[5], p, 0, 0, 0); a1 = lds_read128<288>(kaddr);
    LGKM_WAIT(3); p = __builtin_amdgcn_mfma_f32_32x32x16_bf16(a2, qr[6], p, 0, 0, 0); a2 = lds_read128<320>(kaddr);
    LGKM_WAIT(3); p = __builtin_amdgcn_mfma_f32_32x32x16_bf16(a3, qr[7], p, 0, 0, 0); a3 = lds_read128<352>(kaddr);
    LGKM_WAIT(3); p = __builtin_amdgcn_mfma_f32_32x32x16_bf16(a0, qr[8], p, 0, 0, 0);
    LGKM_WAIT(2); p = __builtin_amdgcn_mfma_f32_32x32x16_bf16(a1, qr[9], p, 0, 0, 0);
    LGKM_WAIT(1); p = __builtin_amdgcn_mfma_f32_32x32x16_bf16(a2, qr[10], p, 0, 0, 0);
    LGKM_WAIT(0); p = __builtin_amdgcn_mfma_f32_32x32x16_bf16(a3, qr[11], p, 0, 0, 0);
    return p;
}
__device__ __forceinline__ void att_finish(f32x16& s, float m, float& lsum, bf16x8& pb0, bf16x8& pb1) {
    float ps = 0.f;
#pragma unroll
    for (int r = 0; r < 16; ++r) { s[r] = __builtin_amdgcn_exp2f(s[r] - m); ps += s[r]; }
    lsum += xhalf_sum(ps);
    u32x4 w0 = {cvtpk(s[0], s[1]), cvtpk(s[2], s[3]), cvtpk(s[4], s[5]), cvtpk(s[6], s[7])};
    u32x4 w1 = {cvtpk(s[8], s[9]), cvtpk(s[10], s[11]), cvtpk(s[12], s[13]), cvtpk(s[14], s[15])};
    pb0 = __builtin_bit_cast(bf16x8, w0); pb1 = __builtin_bit_cast(bf16x8, w1);
}
__device__ __forceinline__ void att_pv(unsigned vaddr, bf16x8 pb0, bf16x8 pb1, f32x16 (&o)[4]) {
#define VOFF(d0, s, hi) (((16 * (s) + 8 * (hi)) * VP) + 64 * (d0))
    const s16x4 a00l = tr_read<VOFF(0, 0, 0)>(vaddr), a00h = tr_read<VOFF(0, 0, 1)>(vaddr), a01l = tr_read<VOFF(0, 1, 0)>(vaddr), a01h = tr_read<VOFF(0, 1, 1)>(vaddr);
    const s16x4 a10l = tr_read<VOFF(1, 0, 0)>(vaddr), a10h = tr_read<VOFF(1, 0, 1)>(vaddr), a11l = tr_read<VOFF(1, 1, 0)>(vaddr), a11h = tr_read<VOFF(1, 1, 1)>(vaddr);
    LGKM_WAIT(4);
    o[0] = __builtin_amdgcn_mfma_f32_32x32x16_bf16(PK8(a00l, a00h), pb0, o[0], 0, 0, 0); o[0] = __builtin_amdgcn_mfma_f32_32x32x16_bf16(PK8(a01l, a01h), pb1, o[0], 0, 0, 0);
    const s16x4 a20l = tr_read<VOFF(2, 0, 0)>(vaddr), a20h = tr_read<VOFF(2, 0, 1)>(vaddr), a21l = tr_read<VOFF(2, 1, 0)>(vaddr), a21h = tr_read<VOFF(2, 1, 1)>(vaddr);
    LGKM_WAIT(4);
    o[1] = __builtin_amdgcn_mfma_f32_32x32x16_bf16(PK8(a10l, a10h), pb0, o[1], 0, 0, 0); o[1] = __builtin_amdgcn_mfma_f32_32x32x16_bf16(PK8(a11l, a11h), pb1, o[1], 0, 0, 0);
    const s16x4 a30l = tr_read<VOFF(3, 0, 0)>(vaddr), a30h = tr_read<VOFF(3, 0, 1)>(vaddr), a31l = tr_read<VOFF(3, 1, 0)>(vaddr), a31h = tr_read<VOFF(3, 1, 1)>(vaddr);
    LGKM_WAIT(4);
    o[2] = __builtin_amdgcn_mfma_f32_32x32x16_bf16(PK8(a20l, a20h), pb0, o[2], 0, 0, 0); o[2] = __builtin_amdgcn_mfma_f32_32x32x16_bf16(PK8(a21l, a21h), pb1, o[2], 0, 0, 0);
    LGKM_WAIT(0);
    o[3] = __builtin_amdgcn_mfma_f32_32x32x16_bf16(PK8(a30l, a30h), pb0, o[3], 0, 0, 0); o[3] = __builtin_amdgcn_mfma_f32_32x32x16_bf16(PK8(a31l, a31h), pb1, o[3], 0, 0, 0);
#undef VOFF
}
__device__ __forceinline__ void att_partial(const f32x16& s, float& m, float& lsum, f32x16 (&o)[4]) {
    float pmax = s[0];
#pragma unroll
    for (int r = 1; r < 16; ++r) pmax = fmaxf(pmax, s[r]);
    pmax = xhalf_max(pmax);
    if (!__all(pmax - m <= ATT_THR)) {
        const float mn = fmaxf(m, pmax); const float alpha = __builtin_amdgcn_exp2f(m - mn); m = mn; lsum *= alpha;
#pragma unroll
        for (int d = 0; d < 4; ++d)
#pragma unroll
            for (int r = 0; r < 16; ++r) o[d][r] *= alpha;
    }
}

__device__ __forceinline__ void attn_unit(const Params& p, LAS unsigned char* lds, int head, int qb, int tid, int wave, int lane) {
    unsigned char* ws = p.ws;
    const bf16_t* Qh = (const bf16_t*)(ws + WS_QH); const bf16_t* Kh = (const bf16_t*)(ws + WS_KH);
    bf16_t* mix = (bf16_t*)(ws + WS_MIX);
    const int rg = wave & 3, kh = wave >> 2, r32 = lane & 31, hh = lane >> 5;
    const int q0row = qb * 128 + rg * 32;
    bf16x8 qr[12];
    {
        const bf16_t* qp = Qh + ((size_t)head * S + q0row + r32) * 192 + hh * 8;
#pragma unroll
        for (int ks = 0; ks < 12; ++ks) qr[ks] = *(const bf16x8*)(qp + ks * 16);
    }
    const int ntiles = 2 * qb + 2, mylast = 2 * qb + (rg >> 1);
    float m = -1e30f, lsum = 0.f; f32x16 o[4] = {};
    const int srow = tid >> 3, sch = tid & 7;
    const int kg0 = srow * 192 + sch * 8, kl0 = srow * KP + sch * 16, vg0 = srow * 2048 + sch * 8, vl0 = ATT_VOFF + srow * VP + sch * 16;
    const bf16_t* kbase = Kh + (size_t)head * S * 192; const bf16_t* vbase = (const bf16_t*)(ws + WS_KVRAW) + head * 256 + 128;
    u32x4 sk0, sk1, sk2, sv0, sv1;
#define ATT_LOAD(t) do { const bf16_t* kt = kbase + (size_t)(t) * 64 * 192 + kg0; const bf16_t* vt = vbase + (size_t)(t) * 64 * 2048 + vg0; \
        sk0 = *(const u32x4*)(kt); sk1 = *(const u32x4*)(kt + 64); sk2 = *(const u32x4*)(kt + 128); sv0 = *(const u32x4*)(vt); sv1 = *(const u32x4*)(vt + 64); } while (0)
#define ATT_WRITE(kb_, vb_) do { LAS unsigned char* bk = lds + (kb_) * ATT_KB + kl0; LAS unsigned char* bv = lds + (vb_) * ATT_VB + vl0; *(LAS u32x4*)(bk) = sk0; *(LAS u32x4*)(bk + 128) = sk1; *(LAS u32x4*)(bk + 256) = sk2; \
        *(LAS u32x4*)(bv) = sv0; *(LAS u32x4*)(bv + 128) = sv1; } while (0)
    const unsigned ldsbase = (unsigned)(size_t)lds;
    const unsigned kaddr0 = ldsbase + (unsigned)((32 * kh + r32) * KP + hh * 16);
    const unsigned vrel = (unsigned)(ATT_VOFF + (32 * kh + 4 * hh + ((lane & 15) >> 2)) * VP + (16 * ((lane >> 4) & 1) + 4 * (lane & 3)) * 2);
    ATT_LOAD(0); ATT_WRITE(0, 0); __syncthreads();
    bf16x8 pb0, pb1;
    const bool more0 = (1 < ntiles);
    if (more0) ATT_LOAD(1);
    f32x16 sprev = att_qk(kaddr0, qr);
    att_partial(sprev, m, lsum, o);
    if (more0) ATT_WRITE(1, 1);
    __syncthreads();
    int vprev = 0, vcur = 1;
#pragma unroll 1
    for (int t = 1; t <= ntiles; ++t) {
        const bool more = (t + 1 < ntiles);
        if (more) ATT_LOAD(t + 1);
        f32x16 sc;
        if (t <= mylast) sc = att_qk(kaddr0 + (t & 1) * ATT_KB, qr);
        else {
#pragma unroll
            for (int r = 0; r < 16; ++r) sc[r] = -1e30f;
        }
        att_finish(sprev, m, lsum, pb0, pb1);
        att_pv(ldsbase + vprev * ATT_VB + vrel, pb0, pb1, o);
        att_partial(sc, m, lsum, o);
        sprev = sc;
        const int vnext = (vcur == 2) ? 0 : vcur + 1;
        if (more) ATT_WRITE((t + 1) & 1, vnext);
        vprev = vcur; vcur = vnext;
        __syncthreads();
    }
#undef ATT_LOAD
#undef ATT_WRITE
    LAS float* scr = (LAS float*)lds + (size_t)rg * 66 * 64 + lane;
    if (kh == 1) {
        scr[0] = m; scr[64] = lsum;
#pragma unroll
        for (int d = 0; d < 4; ++d)
#pragma unroll
            for (int r = 0; r < 16; ++r) scr[(2 + d * 16 + r) * 64] = o[d][r];
    }
    __syncthreads();
    if (kh == 0) {
        const float m2 = scr[0], l2 = scr[64];
        const float mn = fmaxf(m, m2), a1 = __builtin_amdgcn_exp2f(m - mn), a2 = __builtin_amdgcn_exp2f(m2 - mn);
        const float inv = 1.0f / (lsum * a1 + l2 * a2);
        bf16_t* op = mix + (size_t)(q0row + r32) * DM + 1024 + head * 128 + 4 * hh;
#pragma unroll
        for (int d = 0; d < 4; ++d)
#pragma unroll
            for (int g4 = 0; g4 < 4; ++g4) {
                float v[4];
#pragma unroll
                for (int i = 0; i < 4; ++i) { const int r = 4 * g4 + i; v[i] = (o[d][r] * a1 + scr[(2 + d * 16 + r) * 64] * a2) * inv; }
                u32x2 w; w.x = pk2(v[0], v[1]); w.y = pk2(v[2], v[3]);
                *(u32x2*)(op + 32 * d + 8 * g4) = w;
            }
    }
    __syncthreads();
}

__device__ __forceinline__ void gmlp_unit(const Params& p, LAS unsigned char* lds, int nb, int h, int tid, int wave, int lane) {
    unsigned char* ws = p.ws;
    const bf16_t* proj = (const bf16_t*)(ws + WS_PROJ); bf16_t* mix = (bf16_t*)(ws + WS_MIX);
    const float* ssv = (const float*)(ws + WS_ROWSS);
    const float* vg = p.in[3]; const float* wsp = p.in[4]; const float* bs = p.in[5];
#pragma unroll
    for (int i = 0; i < 4; ++i) {
        const int pc = tid + 512 * i, r = pc >> 4, c = pc & 15, t = nb * 128 + r;
        const u32x4 w = *(const u32x4*)(proj + (size_t)t * NINP + 1024 + h * 128 + c * 8);
        const float rs = rsqrtf(ssv[t] * (1.0f / 1024.0f) + EPS);
        const f32x4 g0 = *(const f32x4*)(vg + h * 128 + c * 8), g1 = *(const f32x4*)(vg + h * 128 + c * 8 + 4);
        u32x4 ov;
        ov.x = pk2(bflo(w.x) * rs * g0[0], bfhi(w.x) * rs * g0[1]); ov.y = pk2(bflo(w.y) * rs * g0[2], bfhi(w.y) * rs * g0[3]);
        ov.z = pk2(bflo(w.z) * rs * g1[0], bfhi(w.z) * rs * g1[1]); ov.w = pk2(bflo(w.w) * rs * g1[2], bfhi(w.w) * rs * g1[3]);
        *(LAS u32x4*)(lds + r * VP + c * 16) = ov;
    }
    __syncthreads();
    const int ib = wave & 3, ch = wave >> 2, r32 = lane & 31, hh = lane >> 5;
    const int irow = 32 * ib + r32;
    f32x16 acc0 = {}, acc1 = {};
    const unsigned vaddr = (unsigned)(size_t)lds + (unsigned)((8 * hh + ((lane & 15) >> 2)) * VP + (64 * ch + 16 * ((lane >> 4) & 1) + 4 * (lane & 3)) * 2);
    const float* wrow = wsp + ((size_t)h * 128 + irow) * 128 + hh * 8;
#define GSTEP(s) do { if ((s) < 2 * (ib + 1)) { \
        const f32x4 wa = *(const f32x4*)(wrow + (s) * 16), wb = *(const f32x4*)(wrow + (s) * 16 + 4); const int j0 = (s) * 16 + hh * 8; \
        u32x4 aw; aw.x = pk2(j0 + 0 <= irow ? wa[0] : 0.f, j0 + 1 <= irow ? wa[1] : 0.f); aw.y = pk2(j0 + 2 <= irow ? wa[2] : 0.f, j0 + 3 <= irow ? wa[3] : 0.f); \
        aw.z = pk2(j0 + 4 <= irow ? wb[0] : 0.f, j0 + 5 <= irow ? wb[1] : 0.f); aw.w = pk2(j0 + 6 <= irow ? wb[2] : 0.f, j0 + 7 <= irow ? wb[3] : 0.f); \
        const bf16x8 af = __builtin_bit_cast(bf16x8, aw); \
        const s16x4 b0l = tr_read<(16 * (s)) * VP>(vaddr), b0h = tr_read<(16 * (s) + 4) * VP>(vaddr), b1l = tr_read<(16 * (s)) * VP + 64>(vaddr), b1h = tr_read<(16 * (s) + 4) * VP + 64>(vaddr); \
        LDS_WAIT(); SBAR(); \
        acc0 = __builtin_amdgcn_mfma_f32_32x32x16_bf16(af, PK8(b0l, b0h), acc0, 0, 0, 0); acc1 = __builtin_amdgcn_mfma_f32_32x32x16_bf16(af, PK8(b1l, b1h), acc1, 0, 0, 0); } } while (0)
    GSTEP(0); GSTEP(1); GSTEP(2); GSTEP(3); GSTEP(4); GSTEP(5); GSTEP(6); GSTEP(7);
#undef GSTEP
#pragma unroll
    for (int r = 0; r < 16; ++r) {
        const int i = 32 * ib + crow(r, hh), t = nb * 128 + i; const float b = bs[h * 128 + i];
        const int c0 = h * 128 + 64 * ch + r32;
        const float u0 = bf2f(proj[(size_t)t * NINP + c0]), u1 = bf2f(proj[(size_t)t * NINP + c0 + 32]);
        mix[(size_t)t * DM + c0] = (bf16_t)f2bf(u0 * (acc0[r] + b)); mix[(size_t)t * DM + c0 + 32] = (bf16_t)f2bf(u1 * (acc1[r] + b));
    }
    __syncthreads();
}

__device__ __forceinline__ void phase7(const Params& p, LAS unsigned char* lds, int gw, int NGW, int wave, int lane) {
    unsigned char* ws = p.ws;
    const float* sc = (const float*)(ws + WS_SC); int* ex = (int*)(ws + WS_EXP); float* gt = (float*)(ws + WS_GATE);
    const float NEG = -3.0e38f;
    LAS float* sl = (LAS float*)(lds + wave * 1024);
    const int j8 = lane & 7, g8 = lane >> 3, row = lane >> 4, i16 = lane & 15;
    int ci[4], cj[4]; bool cval[4];
    {
        constexpr int starts[16] = {0, 16, 24, 29, 33, 36, 38, 40, 42, 43, 44, 45, 46, 47, 48, 49};
#pragma unroll
        for (int m = 0; m < 4; ++m) {
            const int c = i16 + 16 * m; int a = 0, st = 0;
#pragma unroll
            for (int i = 1; i < 16; ++i) if (c >= starts[i]) { a = i; st = starts[i]; }
            cval[m] = c < 50; ci[m] = cval[m] ? a : 0; cj[m] = cval[m] ? (c - st) : 0;
        }
    }
    f32x4 nx0, nx1, nx2, nx3;
    if (gw < S / 4) { const float* b = sc + (size_t)(gw * 4) * DM + lane * 16; nx0 = *(const f32x4*)b; nx1 = *(const f32x4*)(b + 4); nx2 = *(const f32x4*)(b + 8); nx3 = *(const f32x4*)(b + 12); }
    for (int tb = gw; tb < S / 4; tb += NGW)
#pragma unroll 1
    for (int n8 = 0; n8 < 8; ++n8) {
        const int it = tb * 8 + n8;
        const int t = it >> 1, hh = it & 1;
        float v[16];
#pragma unroll
        for (int q = 0; q < 4; ++q) { v[q] = nx0[q]; v[4 + q] = nx1[q]; v[8 + q] = nx2[q]; v[12 + q] = nx3[q]; }
        { const int it2 = n8 < 7 ? it + 1 : (tb + NGW) * 8;
          if (it2 < S * 2) { const float* b = sc + (size_t)(it2 >> 1) * DM + (it2 & 1) * 1024 + lane * 16;
            nx0 = *(const f32x4*)b; nx1 = *(const f32x4*)(b + 4); nx2 = *(const f32x4*)(b + 8); nx3 = *(const f32x4*)(b + 12); } }
#pragma unroll
        for (int m = 0; m < 16; ++m) v[m] = __builtin_bit_cast(float, (__builtin_bit_cast(unsigned, v[m]) & ~127u) | (unsigned)(16 * j8 + m));
#define P7_CE(A, B) do { const float hi_ = fmaxf(v[A], v[B]), lo_ = fminf(v[A], v[B]); v[A] = hi_; v[B] = lo_; } while (0)
        P7_CE(0, 13); P7_CE(1, 12); P7_CE(2, 15); P7_CE(3, 14); P7_CE(4, 8); P7_CE(5, 6); P7_CE(7, 11); P7_CE(9, 10);
        P7_CE(0, 5); P7_CE(1, 7); P7_CE(2, 9); P7_CE(3, 4); P7_CE(6, 13); P7_CE(8, 14); P7_CE(10, 15); P7_CE(11, 12);
        P7_CE(0, 1); P7_CE(2, 3); P7_CE(4, 5); P7_CE(6, 8); P7_CE(7, 9); P7_CE(10, 11); P7_CE(12, 13); P7_CE(14, 15);
        P7_CE(0, 2); P7_CE(1, 3); P7_CE(4, 10); P7_CE(5, 11); P7_CE(6, 7); P7_CE(8, 9); P7_CE(12, 14); P7_CE(13, 15);
        P7_CE(1, 2); P7_CE(3, 12); P7_CE(4, 6); P7_CE(5, 7); P7_CE(8, 10); P7_CE(9, 11); P7_CE(13, 14);
        P7_CE(1, 4); P7_CE(2, 6); P7_CE(5, 8); P7_CE(7, 10); P7_CE(9, 13); P7_CE(11, 14);
        P7_CE(2, 4); P7_CE(3, 6); P7_CE(9, 12); P7_CE(11, 13);
        P7_CE(3, 5); P7_CE(6, 8); P7_CE(7, 9); P7_CE(10, 12);
        P7_CE(3, 4); P7_CE(5, 6); P7_CE(7, 8); P7_CE(9, 10); P7_CE(11, 12);
        P7_CE(6, 7); P7_CE(8, 9);
#define P7_MERGE(CTRL) do { float t_[16]; \
            _Pragma("unroll") for (int i = 0; i < 16; ++i) t_[i] = fmaxf(v[i], dpp_f<CTRL, 0xf>(v[15 - i], v[15 - i])); \
            _Pragma("unroll") for (int i = 0; i < 16; ++i) v[i] = t_[i]; \
            _Pragma("unroll") for (int j = 8; j >= 1; j >>= 1) _Pragma("unroll") for (int i = 0; i < 16; ++i) if ((i & j) == 0) P7_CE(i, i + j); } while (0)
        P7_MERGE(0xB1); P7_MERGE(0x4E); P7_MERGE(0x141);
#undef P7_MERGE
#undef P7_CE
        if (j8 == 0) {
#pragma unroll
            for (int q = 0; q < 4; ++q) *(LAS f32x4*)(sl + g8 * 16 + 4 * q) = (f32x4){v[4 * q], v[4 * q + 1], v[4 * q + 2], v[4 * q + 3]};
        }
        LDS_WAIT(); asm volatile("" ::: "memory");
        float cv[4], og[4]; int id[4];
#pragma unroll
        for (int m = 0; m < 4; ++m) {
            const float s1 = sl[(2 * row) * 16 + ci[m]], s2 = sl[(2 * row + 1) * 16 + cj[m]];
            og[m] = cval[m] ? (s1 + s2) : NEG; cv[m] = og[m];
            id[m] = (int)((__builtin_bit_cast(unsigned, s1) & 127u) * 128u + (__builtin_bit_cast(unsigned, s2) & 127u));
        }
        LDS_WAIT(); asm volatile("" ::: "memory");
        float M0 = 0.f;
#pragma unroll
        for (int k = 0; k < 16; ++k) {
            float mx = fmaxf(fmaxf(cv[0], cv[1]), fmaxf(cv[2], cv[3]));
            mx = fmaxf(mx, dpp_f<0xB1, 0xf>(mx, mx));
            mx = fmaxf(mx, dpp_f<0x4E, 0xf>(mx, mx));
            mx = fmaxf(mx, dpp_f<0x141, 0xf>(mx, mx));
            mx = fmaxf(mx, dpp_f<0x140, 0xf>(mx, mx));
            if (k == 0) M0 = mx;
#pragma unroll
            for (int m = 0; m < 4; ++m) cv[m] = (cv[m] == mx) ? NEG : cv[m];
        }
        bool sel[4]; float e[4]; float es = 0.f;
#pragma unroll
        for (int m = 0; m < 4; ++m) { sel[m] = (cv[m] != og[m]); e[m] = sel[m] ? __expf(og[m] - M0) : 0.f; es += e[m]; }
        es += dpp_f<0xB1, 0xf>(0.f, es); es += dpp_f<0x4E, 0xf>(0.f, es); es += dpp_f<0x141, 0xf>(0.f, es); es += dpp_f<0x140, 0xf>(0.f, es);
        const float inv = 1.0f / es;
        int basepos = 0;
        const int head = 4 * hh + row;
#pragma unroll
        for (int m = 0; m < 4; ++m) {
            const unsigned long long bl = __ballot(sel[m]);
            const unsigned rbits = (unsigned)(bl >> (16 * row)) & 0xffffu;
            const int pos = basepos + __popc(rbits & ((1u << i16) - 1u));
            if (sel[m] && pos < 16) { ex[(size_t)t * 128 + head * 16 + pos] = id[m]; gt[(size_t)t * 128 + head * 16 + pos] = e[m] * inv; }
            basepos += __popc(rbits);
        }
    }
}

typedef __bf16 bf16x32v __attribute__((ext_vector_type(32)));
typedef __bf16 bf16x2v __attribute__((ext_vector_type(2)));
typedef float f32x2 __attribute__((ext_vector_type(2)));
#ifndef P8_THROTTLE
#define P8_THROTTLE 0
#endif
constexpr unsigned P8_SLACK = 12;
#ifndef P8_SWEEPSYNC
#define P8_SWEEPSYNC 1
#endif
#ifndef P8_MIDSYNC
#define P8_MIDSYNC 2
#endif
__device__ __forceinline__ void phase8(const Params& p, LAS unsigned char* lds, float* dst, const XcdBarrier& xb, int gw, int NGW, int wave, int lane) {
    unsigned char* ws = p.ws;
    const bf16_t* x1b = (const bf16_t*)(ws + WS_X1B); const unsigned char* UT = ws + WS_UT; const unsigned char* VT = ws + WS_VT;
    const int* ex = (const int*)(ws + WS_EXP); const float* gt = (const float*)(ws + WS_GATE); const float* ss2 = (const float*)(ws + WS_ROWSS) + 3 * S;
    const float* out = p.out;
    LAS unsigned* list = (LAS unsigned*)(lds + 131072 + wave * 2048);
    LAS unsigned* hist = (LAS unsigned*)(lds + 147456 + wave * 1024);
    for (int tb = gw; tb < S / 4; tb += NGW) {
        const int t0 = tb * 4;
        int id[8]; float gv[8];
#pragma unroll
        for (int r = 0; r < 8; ++r) { const size_t o = (size_t)(t0 + (r >> 1)) * 128 + (r & 1) * 64 + lane; id[r] = ex[o]; gv[r] = gt[o]; }
        const float rs0 = rsqrtf(ss2[t0 + 0] * (1.0f / DM) + EPS) * (1.0f / PEER_USC), rs1 = rsqrtf(ss2[t0 + 1] * (1.0f / DM) + EPS) * (1.0f / PEER_USC);
        const float rs2 = rsqrtf(ss2[t0 + 2] * (1.0f / DM) + EPS) * (1.0f / PEER_USC), rs3 = rsqrtf(ss2[t0 + 3] * (1.0f / DM) + EPS) * (1.0f / PEER_USC);
#pragma unroll
        for (int j = 0; j < 4; ++j) hist[j * 64 + lane] = 0u;
        LDS_WAIT(); asm volatile("" ::: "memory");
        unsigned pos[8];
#pragma unroll
        for (int r = 0; r < 8; ++r) pos[r] = __hip_atomic_fetch_add(hist + (r >> 1) * 64 + (id[r] >> 8), 1u, __ATOMIC_RELAXED, __HIP_MEMORY_SCOPE_WORKGROUP);
        LDS_WAIT(); asm volatile("" ::: "memory");
        unsigned cnt[4], inc[4];
#pragma unroll
        for (int j = 0; j < 4; ++j) { cnt[j] = hist[j * 64 + lane]; inc[j] = cnt[j]; }
#pragma unroll
        for (int o = 1; o < 64; o <<= 1)
#pragma unroll
            for (int j = 0; j < 4; ++j) { const unsigned n = __shfl_up(inc[j], o); if (lane >= o) inc[j] += n; }
        LDS_WAIT(); asm volatile("" ::: "memory");
#pragma unroll
        for (int j = 0; j < 4; ++j) hist[j * 64 + lane] = inc[j] - cnt[j];
        LDS_WAIT(); asm volatile("" ::: "memory");
#pragma unroll
        for (int r = 0; r < 8; ++r) { const unsigned d = hist[(r >> 1) * 64 + (id[r] >> 8)] + pos[r]; list[4u * d + (unsigned)(r >> 1)] = (unsigned)id[r] | ((unsigned)(r >> 1) << 14) | (f2bf(gv[r]) << 16); }
        LDS_WAIT(); asm volatile("" ::: "memory");
        {
            typedef unsigned u32x16 __attribute__((ext_vector_type(16)));
            const __amdgpu_buffer_rsrc_t urs = __builtin_amdgcn_make_buffer_rsrc((void*)UT, 0, 16384 * PEER_ROWB, 0x00020000);
            const int vo4 = lane * 16, vo2 = lane * 8 + 1024;
            const bool lb0 = (lane & 1) != 0, lb1 = (lane & 2) != 0, lb2 = (lane & 4) != 0;
            s16x4 xr[4][8];
#pragma unroll
            for (int j = 0; j < 4; ++j)
#pragma unroll
                for (int q = 0; q < 8; ++q) xr[j][q] = __builtin_bit_cast(s16x4, *(const u32x2*)(x1b + (size_t)(t0 + j) * DM + (q * 64 + lane) * 4));
#define P8_ULOAD(k, i) do { const unsigned en = (unsigned)__builtin_amdgcn_readfirstlane((int)list[(i)]); const int ro = (int)((en & 0x3fffu) * (unsigned)PEER_ROWB); \
            u4[k] = __builtin_amdgcn_raw_buffer_load_b128(urs, vo4, ro, 0); u2[k] = __builtin_amdgcn_raw_buffer_load_b64(urs, vo2, ro, 0); } while (0)
#define P8_UPROC2(k, dk) do { const u32x6 pk = {u4[k][0], u4[k][1], u4[k][2], u4[k][3], u2[k][0], u2[k][1]}; \
            const u32x16 r_ = __builtin_bit_cast(u32x16, __builtin_amdgcn_cvt_scalef32_pk32_bf16_fp6(pk, 1.0f)); \
            f32x4 a0 = {0.f, 0.f, 0.f, 0.f}, a1 = {0.f, 0.f, 0.f, 0.f}; \
            _Pragma("unroll") for (int q = 0; q < 8; q += 2) { \
                a0 = __builtin_amdgcn_mfma_f32_4x4x4bf16_1k(__builtin_bit_cast(s16x4, (u32x2){r_[2 * q], r_[2 * q + 1]}), xr[(k) & 3][q], a0, 0, 0, 0); \
                a1 = __builtin_amdgcn_mfma_f32_4x4x4bf16_1k(__builtin_bit_cast(s16x4, (u32x2){r_[2 * q + 2], r_[2 * q + 3]}), xr[(k) & 3][q + 1], a1, 0, 0, 0); } \
            const f32x4 a_ = a0 + a1; \
            const float e0 = lb0 ? a_[1] : a_[0], e1 = lb0 ? a_[3] : a_[2]; dd[dk] = lb1 ? e1 : e0; } while (0)
#ifndef P8_URING
#define P8_URING 8
#endif
#if (PROBE_DUP >> 10) & 1
#define P8_UREPS 2
#else
#define P8_UREPS 1
#endif
#pragma unroll 1
            for (int urep = 0; urep < P8_UREPS; ++urep) {
                u32x4 u4[P8_URING]; u32x2 u2[P8_URING];
#pragma unroll
                for (int k = 0; k < P8_URING; ++k) P8_ULOAD(k, k);
#pragma unroll 1
                for (int i0 = 0; i0 < 512; i0 += P8_URING) {
                    if (P8_SWEEPSYNC && i0 == 256 && NGW == S / 4) xcd_local_barrier(xb);
#pragma unroll
                    for (int hb = 0; hb < P8_URING / 8; ++hb) {
                        const int i = i0 + 8 * hb;
                        const unsigned ev = list[i + (lane & 7)]; const unsigned jl = (unsigned)lane & 3u;
                        const float gl = __builtin_bit_cast(float, ev & 0xffff0000u), rl = jl == 0u ? rs0 : (jl == 1u ? rs1 : (jl == 2u ? rs2 : rs3));
                        float dd[8];
#pragma unroll
                        for (int k = 0; k < 8; ++k) { P8_UPROC2(8 * hb + k, k); const int nx = i + P8_URING + k; P8_ULOAD(8 * hb + k, nx < 512 ? nx : 508 + (k & 3)); }
                        float w4[4], w2[2];
#pragma unroll
                        for (int q = 0; q < 4; ++q) { const float kp = lb2 ? dd[q + 4] : dd[q], sd = lb2 ? dd[q] : dd[q + 4]; w4[q] = kp + __shfl_xor(sd, 4); }
#pragma unroll
                        for (int q = 0; q < 2; ++q) { const float kp = lb1 ? w4[q + 2] : w4[q], sd = lb1 ? w4[q] : w4[q + 2]; w2[q] = kp + __shfl_xor(sd, 2); }
                        float dres; { const float kp = lb0 ? w2[1] : w2[0], sd = lb0 ? w2[0] : w2[1]; dres = kp + __shfl_xor(sd, 1); }
                        dres += __shfl_xor(dres, 8); dres += __shfl_xor(dres, 16); dres += __shfl_xor(dres, 32);
                        const float c_ = gl * gelu_tanh(rl * dres) * (1.0f / PEER_VSC);
                        if (lane < 8 && urep == P8_UREPS - 1) list[i + lane] = (ev & 0xffffu) | (f2bf(c_) << 16);
                    }
                }
            }
#undef P8_ULOAD
#undef P8_UPROC2
        }
        asm volatile("s_waitcnt vmcnt(0)" ::: "memory");
        LDS_WAIT(); asm volatile("" ::: "memory");
#if P8_MIDSYNC == 1
        __syncthreads();
#elif P8_MIDSYNC == 2
        if (NGW == S / 4) xcd_local_barrier(xb);
#endif
        f32x4 acc[4][8];
#if (PROBE_DUP >> 12) & 1
#define P8_VREPS 2
#else
#define P8_VREPS 1
#endif
#ifndef P8_VRING
#define P8_VRING 8
#endif
#pragma unroll 1
        for (int vrep = 0; vrep < P8_VREPS; ++vrep) {
#pragma unroll
        for (int j = 0; j < 4; ++j)
#pragma unroll
            for (int q = 0; q < 8; ++q) acc[j][q] = (f32x4){0.f, 0.f, 0.f, 0.f};
        {
            typedef unsigned u32x16 __attribute__((ext_vector_type(16)));
            u32x4 v4[P8_VRING]; u32x2 v2[P8_VRING]; unsigned ven[P8_VRING];
            const unsigned li = (unsigned)lane & 3u;
            const unsigned m0 = li == 0u ? 0x0000ffffu : (li == 1u ? 0xffff0000u : 0u), m1 = li == 2u ? 0x0000ffffu : (li == 3u ? 0xffff0000u : 0u);
            const __amdgpu_buffer_rsrc_t vrs = __builtin_amdgcn_make_buffer_rsrc((void*)VT, 0, 16384 * PEER_ROWB, 0x00020000);
            const int vo4 = lane * 16, vo2 = lane * 8 + 1024;
#define P8_VLOAD(k, i) do { const unsigned en = (unsigned)__builtin_amdgcn_readfirstlane((int)list[(i)]); ven[k] = en; const int ro = (int)((en & 0x3fffu) * (unsigned)PEER_ROWB); \
            v4[k] = __builtin_amdgcn_raw_buffer_load_b128(vrs, vo4, ro, 0); v2[k] = __builtin_amdgcn_raw_buffer_load_b64(vrs, vo2, ro, 0); } while (0)
#define P8_VPROC(k) do { const u32x6 pk = {v4[k][0], v4[k][1], v4[k][2], v4[k][3], v2[k][0], v2[k][1]}; \
            const u32x16 r_ = __builtin_bit_cast(u32x16, __builtin_amdgcn_cvt_scalef32_pk32_bf16_fp6(pk, 1.0f)); \
            const unsigned e_ = ven[k], cf = (e_ >> 16) | (e_ & 0xffff0000u); \
            const s16x4 av = __builtin_bit_cast(s16x4, (u32x2){cf & m0, cf & m1}); \
            _Pragma("unroll") for (int q = 0; q < 8; ++q) \
                acc[(k) & 3][q] = __builtin_amdgcn_mfma_f32_4x4x4bf16_1k(av, __builtin_bit_cast(s16x4, (u32x2){r_[2 * q], r_[2 * q + 1]}), acc[(k) & 3][q], 0, 0, 0); } while (0)
#pragma unroll
            for (int k = 0; k < P8_VRING; ++k) P8_VLOAD(k, k);
#pragma unroll 1
            for (int i = 0; i < 512 - 512 % P8_VRING; i += P8_VRING) {
                if (P8_SWEEPSYNC && i == 256 && NGW == S / 4) xcd_local_barrier(xb);
#pragma unroll
                for (int k = 0; k < P8_VRING; ++k) { P8_VPROC(k); const int nx = i + P8_VRING + k; P8_VLOAD(k, nx < 512 ? nx : 508 + (k & 3)); }
            }
#pragma unroll
            for (int k = 0; k < 512 % P8_VRING; ++k) P8_VPROC(k);
#undef P8_VLOAD
#undef P8_VPROC
        }
        }
        int tq = t0, lq = lane; asm volatile("" : "+s"(tq)); asm volatile("" : "+v"(lq));
#pragma unroll
        for (int j = 0; j < 4; ++j)
#pragma unroll
            for (int i = 0; i < 8; ++i) {
                const size_t o = (size_t)(tq + j) * DM + (i * 64 + lq) * 4;
                const u32x2 xw = *(const u32x2*)(x1b + o);
                f32x4 a = {bflo(xw.x), bfhi(xw.x), bflo(xw.y), bfhi(xw.y)};
                a += acc[j][i];
                *(f32x4*)(dst + o) = a;
                if (i & 1) asm volatile("" ::: "memory");
            }
        LDS_WAIT(); asm volatile("" ::: "memory");
    }
}

__global__ void __launch_bounds__(NTHREADS, 2) mega(Params p) {
    extern __shared__ __attribute__((aligned(16))) unsigned char lds_raw[];
    LAS unsigned char* lds = (LAS unsigned char*)lds_raw;
    const int tid = threadIdx.x, lane = tid & 63, wave = __builtin_amdgcn_readfirstlane(tid >> 6);
    const int G = gridDim.x, bx = blockIdx.x;
    const int gw = bx * 8 + wave, NGW = G * 8;
    unsigned char* ws = p.ws;
    const int lo = p.ph_lo, hi = p.ph_hi;
    volatile LAS unsigned* misc = (volatile LAS unsigned*)(lds + LDS_MISC);
    if (tid < 4) misc[tid] = 0u;
    __syncthreads();
    const XcdBarrier xbar = xcd_barrier_post((unsigned*)(ws + WS_CTL), misc);
#ifndef PH_MASK
#define PH_MASK 0x1ff
#endif
#define IN(k) (((PH_MASK >> (k)) & 1) && lo <= (k) && (k) < hi)
#define SEAM(k) do { if (IN(k) && IN((k) + 1)) xcd_barrier(xbar); } while (0)

#if (PROBE_DUP >> 0) & 1
    if (IN(0)) { phase0(p, lds, G == 256, gw, NGW, wave, lane); xcd_barrier(xbar); }
#endif
    if (IN(0)) phase0(p, lds, G == 256, gw, NGW, wave, lane);
    SEAM(0);
    const bool part = (G == 256) && (misc[2] != 0u);
    const int vx = __builtin_amdgcn_readfirstlane(part ? (int)xbar.x : (bx & 7)), vr = __builtin_amdgcn_readfirstlane(part ? (int)misc[3] : (bx >> 3));
    const int vpanel = (vr >> 3) == 0 ? vx : ((vr >> 3) == 1 ? 31 - vx : ((vr >> 3) == 2 ? vx + 8 : 23 - vx));
    const int gwv = (G == 256) ? vpanel * 64 + (vr & 7) * 8 + wave : gw;
#define SEAM_X(k) do { if (IN(k) && IN((k) + 1)) { if (part) xcd_local_barrier_acq(xbar); else xcd_barrier(xbar); } } while (0)
    if (IN(1)) {
        pg8::Gemm g{(const bf16_t*)(ws + WS_XB), (const bf16_t*)(ws + WS_WIN), S, NINP, DM, DM, DM};
        pg8::StaticOrder So; So.init(S, NINP, G, bx);
        pg8::Epi<1> E{(const float*)(ws + WS_RSTD1), 0.f, (float*)(ws + WS_ROWSS), (bf16_t*)(ws + WS_PROJ), NINP, nullptr, nullptr};
#if (PROBE_DUP >> 1) & 1
        { pg8::Epi<1> E2 = E; E2.ss = (float*)(ws + 512 * 1024); pg8::gemm_phase<pg8::Epi<1>, pg8::StaticOrder, true, true>(lds, g, So, E2); xcd_barrier(xbar); }
#endif
        pg8::gemm_phase<pg8::Epi<1>, pg8::StaticOrder, true, true>(lds, g, So, E);
        if (G == 256 && bx >= 128) { __syncthreads(); prep_late(p, lds, (bx - 128) * 8 + wave, 1024, wave, lane); }
    }
    SEAM(1);
    if (IN(2)) {
        {
            pg8::Gemm g{(const bf16_t*)(ws + WS_PROJ) + 2048, (const bf16_t*)(ws + WS_WUQ), S, 1536, 512, NINP, 512};
            pg8::StaticOrder So; So.init(S, 1536, G, bx);
            pg8::Epi<2> E{(const float*)(ws + WS_ROWSS) + 1 * S, 1.0f / 512.0f, nullptr, (bf16_t*)(ws + WS_QRAW), 1536, nullptr, nullptr};
            pg8::gemm_phase<pg8::Epi<2>, pg8::StaticOrder, true, true>(lds, g, So, E);
        }
        __syncthreads();
        {
            pg8::Gemm g{(const bf16_t*)(ws + WS_PROJ) + 2560, (const bf16_t*)(ws + WS_WUKV), S, 2048, 256, NINP, 256};
            pg8::StaticOrder So; So.init(S, 2048, G, bx);
            pg8::Epi<2> E{(const float*)(ws + WS_ROWSS) + 2 * S, 1.0f / 256.0f, nullptr, (bf16_t*)(ws + WS_KVRAW), 2048, nullptr, nullptr};
            pg8::gemm_phase<pg8::Epi<2>, pg8::StaticOrder, true, true>(lds, g, So, E);
        }
    }
    SEAM(2);
#if (PROBE_DUP >> 3) & 1
    if (IN(3)) { phase3(p, gw, NGW, lane); xcd_barrier(xbar); }
#endif
    if (IN(3)) phase3(p, gw, NGW, lane);
    SEAM(3);
    const int vP = (vr >> 4) ? vx + 8 : vx, vqa = ((vr >> 3) & 1) ? 62 - 2 * vP : 63 - 2 * vP, vqb = ((vr >> 3) & 1) ? 2 * vP + 1 : 2 * vP;
#define P4_BODY_ATT do { if (G == 256) { attn_unit(p, lds, vr & 7, vqa, tid, wave, lane); attn_unit(p, lds, vr & 7, vqb, tid, wave, lane); } \
        else for (int pr = bx; pr < 256; pr += G) { const int head = pr & 7, x = pr >> 3; attn_unit(p, lds, head, 63 - x, tid, wave, lane); attn_unit(p, lds, head, x, tid, wave, lane); } } while (0)
#define P4_BODY_GMLP do { if (G == 256) { gmlp_unit(p, lds, vqa, vr & 7, tid, wave, lane); gmlp_unit(p, lds, vqb, vr & 7, tid, wave, lane); } \
        else for (int u = bx; u < 512; u += G) gmlp_unit(p, lds, u >> 3, u & 7, tid, wave, lane); } while (0)
#if (PROBE_DUP >> 4) & 1
    if (IN(4)) { P4_BODY_ATT; xcd_barrier(xbar); }
#endif
#if (PROBE_DUP >> 9) & 1
    if (IN(4)) { P4_BODY_GMLP; xcd_barrier(xbar); }
#endif
    if (IN(4)) { P4_BODY_ATT; P4_BODY_GMLP; }
    SEAM_X(4);
    if (IN(5)) {
        pg8::Gemm g{(const bf16_t*)(ws + WS_MIX), (const bf16_t*)(ws + WS_WOUT), S, DM, DM, DM, DM};
        pg8::StaticOrder So; So.init(S, DM, G, bx); if (G == 256) So.fixed(vpanel, vr & 7);
        pg8::Epi<4> E{nullptr, 0.f, (float*)(ws + WS_ROWSS) + 3 * S, (bf16_t*)(ws + WS_X1B), DM, p.out, p.in[0]};
#if (PROBE_DUP >> 5) & 1
        { pg8::Epi<4> E2 = E; E2.ss = (float*)(ws + 512 * 1024); pg8::gemm_phase<pg8::Epi<4>, pg8::StaticOrder, true, true>(lds, g, So, E2); xcd_barrier(xbar); }
#endif
        pg8::gemm_phase<pg8::Epi<4>, pg8::StaticOrder, true, true>(lds, g, So, E);
    }
    SEAM_X(5);
    if (IN(6)) {
        pg8::Gemm g{(const bf16_t*)(ws + WS_X1B), (const bf16_t*)(ws + WS_WS), S, DM, DM, DM, DM};
        pg8::StaticOrder So; So.init(S, DM, G, bx); if (G == 256) So.fixed(vpanel, vr & 7);
        pg8::Epi<5> E{(const float*)(ws + WS_ROWSS) + 3 * S, 1.0f / DM, nullptr, nullptr, DM, (float*)(ws + WS_SC), nullptr};
#if (PROBE_DUP >> 6) & 1
        { pg8::gemm_phase<pg8::Epi<5>, pg8::StaticOrder, true, true>(lds, g, So, E); xcd_barrier(xbar); }
#endif
        pg8::gemm_phase<pg8::Epi<5>, pg8::StaticOrder, true, true>(lds, g, So, E);
    }
    SEAM_X(6);
#if (PROBE_DUP >> 7) & 1
    if (IN(7)) { phase7(p, lds, gwv, NGW, wave, lane); xcd_barrier(xbar); }
#endif
    if (IN(7)) phase7(p, lds, gwv, NGW, wave, lane);
    if (IN(7) && IN(8)) { if (NGW == S / 4) xcd_local_barrier(xbar); else xcd_barrier(xbar); }
#if (PROBE_DUP >> 8) & 1
    if (IN(8)) { phase8(p, lds, (float*)(ws + WS_SC), xbar, gwv, NGW, wave, lane); xcd_barrier(xbar); }
#endif
    if (IN(8)) phase8(p, lds, p.out, xbar, gwv, NGW, wave, lane);
#undef IN
#undef SEAM
#undef SEAM_X
}

extern "C" void kernel_launch(void* const* d_in, const int* in_sizes, int n_in, void* d_out, int out_size, void* d_ws, size_t ws_size, hipStream_t stream) {
    static int grid = 0;
    if (grid == 0) {
        if (n_in != 18 || out_size != S * DM || ws_size < WS_END) { fprintf(stderr, "kernel_launch: unexpected shapes (n_in %d out %d ws %zu)\n", n_in, out_size, ws_size); grid = -1; return; }
        int dev = 0, cus = 0, per_cu = 0;
        hipGetDevice(&dev);
        hipDeviceGetAttribute(&cus, hipDeviceAttributeMultiprocessorCount, dev);
        if (hipFuncSetAttribute((const void*)mega, hipFuncAttributeMaxDynamicSharedMemorySize, LDS_BYTES) != hipSuccess) { fprintf(stderr, "kernel_launch: hipFuncSetAttribute failed\n"); grid = -1; return; }
        if (hipOccupancyMaxActiveBlocksPerMultiprocessor(&per_cu, (const void*)mega, NTHREADS, LDS_BYTES) != hipSuccess || per_cu < 1) { fprintf(stderr, "kernel_launch: occupancy query failed (%d)\n", per_cu); grid = -1; return; }
        grid = cus;
        fprintf(stderr, "kernel_launch: cus %d per_cu %d grid %d\n", cus, per_cu, grid);
    }
    if (grid < 0) return;
    hipMemsetAsync((char*)d_ws + WS_CTL, 0, 1 * MiB, stream);
    Params prm{};
    for (int i = 0; i < 18; ++i) prm.in[i] = (const float*)d_in[i];
    prm.out = (float*)d_out; prm.ws = (unsigned char*)d_ws;
#if MK_ONE_LAUNCH
    prm.ph_lo = 0; prm.ph_hi = NPH;
    { void* args[] = {&prm}; hipError_t e = hipLaunchCooperativeKernel((const void*)mega, dim3(grid), dim3(NTHREADS), args, LDS_BYTES, stream);
      if (e != hipSuccess) fprintf(stderr, "cooperative launch failed: %s\n", hipGetErrorString(e)); }
#else
    for (int ph = 0; ph < NPH; ++ph) {
        prm.ph_lo = ph; prm.ph_hi = ph + 1;
        void* args[] = {&prm};
        hipError_t e = hipLaunchCooperativeKernel((const void*)mega, dim3(grid), dim3(NTHREADS), args, LDS_BYTES, stream);
        if (e != hipSuccess) { fprintf(stderr, "cooperative launch %d failed: %s\n", ph, hipGetErrorString(e)); break; }
    }
#endif
}
```

```cpp
#include <hip/hip_runtime.h>
#include <cstdio>
#include <cstdint>

#define LAS __attribute__((address_space(3)))
typedef unsigned short bf16_t;
typedef short bf16x8 __attribute__((ext_vector_type(8)));
typedef short s16x4 __attribute__((ext_vector_type(4)));
typedef float f32x4 __attribute__((ext_vector_type(4)));
typedef float f32x16 __attribute__((ext_vector_type(16)));
typedef unsigned u32x4 __attribute__((ext_vector_type(4)));
typedef unsigned u32x2 __attribute__((ext_vector_type(2)));

#ifndef PROBE_DUP
#define PROBE_DUP 0
#endif
#ifndef MK_ONE_LAUNCH
#define MK_ONE_LAUNCH 1
#endif

constexpr int S = 8192, DM = 2048, NIN = 2880, NINP = 3072;
constexpr int NPH = 9;
constexpr float EPS = 1e-6f;
constexpr int LDS_BYTES = 163840;
constexpr int NTHREADS = 512;
constexpr int LDS_MISC = 161792;

constexpr size_t MiB = 1u << 20;
constexpr size_t WS_CTL = 0;
constexpr size_t WS_ROWSS = 128 * 1024;
constexpr size_t WS_COS = 1 * MiB, WS_SIN = 2 * MiB;
constexpr size_t WS_RSTD1 = 3 * MiB;
constexpr size_t WS_EXP = 4 * MiB;
constexpr size_t WS_GATE = 8 * MiB;
constexpr size_t WS_WIN = 12 * MiB;
constexpr size_t WS_WUQ = 24 * MiB;
constexpr size_t WS_WUKV = 26 * MiB;
constexpr size_t WS_WOUT = 28 * MiB;
constexpr size_t WS_WS = 36 * MiB;
constexpr size_t WS_XB = 44 * MiB;
constexpr size_t WS_PROJ = 76 * MiB;
constexpr size_t WS_QRAW = 124 * MiB;
constexpr size_t WS_KVRAW = 148 * MiB;
constexpr size_t WS_QH = 180 * MiB;
constexpr size_t WS_KH = 204 * MiB;
constexpr size_t WS_VH = 228 * MiB;
constexpr size_t WS_MIX = 244 * MiB;
constexpr size_t WS_X1B = 276 * MiB;
constexpr size_t WS_SC = 308 * MiB;
constexpr size_t WS_UT = 372 * MiB;
constexpr size_t WS_VT = 436 * MiB;
constexpr size_t WS_END = 500 * MiB;

__device__ __forceinline__ unsigned f2bf(float f) { unsigned u = __builtin_bit_cast(unsigned, f); return (u + 0x7fffu + ((u >> 16) & 1u)) >> 16; }
__device__ __forceinline__ unsigned pk2(float lo, float hi) { return f2bf(lo) | (f2bf(hi) << 16); }
__device__ __forceinline__ float bf2f(unsigned short b) { return __builtin_bit_cast(float, (unsigned)b << 16); }
__device__ __forceinline__ float bflo(unsigned w) { return __builtin_bit_cast(float, w << 16); }
__device__ __forceinline__ float bfhi(unsigned w) { return __builtin_bit_cast(float, w & 0xffff0000u); }
__device__ __forceinline__ float wave_sum(float v) {
#pragma unroll
    for (int o = 32; o > 0; o >>= 1) v += __shfl_xor(v, o);
    return v;
}
__device__ __forceinline__ float wave_max(float v) {
#pragma unroll
    for (int o = 32; o > 0; o >>= 1) v = fmaxf(v, __shfl_xor(v, o));
    return v;
}
template <int CTRL, int ROW_MASK> __device__ __forceinline__ float dpp_f(float old, float v) {
    return __builtin_bit_cast(float, __builtin_amdgcn_update_dpp(__builtin_bit_cast(int, old), __builtin_bit_cast(int, v), CTRL, ROW_MASK, 0xf, false));
}
__device__ __forceinline__ float wave_max_u(float v) {
    v = fmaxf(v, dpp_f<0xB1, 0xf>(v, v));
    v = fmaxf(v, dpp_f<0x4E, 0xf>(v, v));
    v = fmaxf(v, dpp_f<0x141, 0xf>(v, v));
    v = fmaxf(v, dpp_f<0x140, 0xf>(v, v));
    v = fmaxf(v, dpp_f<0x142, 0xa>(v, v));
    v = fmaxf(v, dpp_f<0x143, 0xc>(v, v));
    return __builtin_bit_cast(float, __builtin_amdgcn_readlane(__builtin_bit_cast(int, v), 63));
}
__device__ __forceinline__ float wave_sum_u(float v) {
    v += dpp_f<0xB1, 0xf>(0.f, v);
    v += dpp_f<0x4E, 0xf>(0.f, v);
    v += dpp_f<0x141, 0xf>(0.f, v);
    v += dpp_f<0x140, 0xf>(0.f, v);
    v += dpp_f<0x142, 0xa>(0.f, v);
    v += dpp_f<0x143, 0xc>(0.f, v);
    return __builtin_bit_cast(float, __builtin_amdgcn_readlane(__builtin_bit_cast(int, v), 63));
}
__device__ __forceinline__ float gelu_tanh(float x) {
    const float y = 0.7978845608028654f * (x + 0.044715f * x * x * x);
    return x / (1.0f + __expf(-2.0f * y));
}
__device__ __forceinline__ int crow(int r, int hi) { return (r & 3) + 8 * (r >> 2) + 4 * hi; }
#define LDS_WAIT() asm volatile("s_waitcnt lgkmcnt(0)" ::: "memory")
#define SBAR() __builtin_amdgcn_sched_barrier(0)

namespace pg8 {
#define PG8_LAS __attribute__((address_space(3)))
constexpr int BM = 256, BK = 64, HALF = 128, HTB = HALF * BK * 2  , STAGE_BYTES = 8 * HTB, NXCD = 8, WGM = 8;

__host__ __device__ __forceinline__ int lds_byte(int r, int c) { const int st = (r >> 4) * 2 + (c >> 5), rr = r & 15, cc = c & 31, ob = rr * 64 + cc * 2; return st * 1024 + (ob ^ (((ob >> 9) & 1) << 5)); }
__host__ __device__ __forceinline__ void stage_rc(int b, int& R, int& C) { const int st = b / 1024, sb = b % 1024, swz = sb ^ (((sb >> 9) & 1) << 5); R = (st >> 1) * 16 + swz / 64; C = (st & 1) * 32 + (swz % 64) / 2; }
__host__ __device__ __forceinline__ int perm32(int rho) { const int n = rho >> 4, i = rho & 15; return 8 * (i >> 2) + 4 * n + (i & 3); }

struct Unit { int pm, pn; };
struct Gemm { const bf16_t* A; const bf16_t* Bt; int M, N, K, lda, ldb; };

struct StaticOrder {
    int nM, nN, nwg, G, c, fpm = -1, fpn = 0;
    __host__ __device__ void init(int M, int N, int G_, int c_) { nM = M / BM; nN = N / BM; nwg = nM * nN; G = G_; c = c_; fpm = -1; }
    __host__ __device__ void fixed(int pm, int pn) { fpm = pm; fpn = pn; }
    __host__ __device__ bool next(int i, Unit& u) const {
        if (fpm >= 0) { if (i > 0) return false; u.pm = fpm; u.pn = fpn; return true; }
        const long L = (long)i * G + c; if (L >= nwg) return false;
        int wgid = (int)L; { const int q = nwg / NXCD, r = nwg % NXCD, xcd = wgid % NXCD, off = wgid / NXCD; wgid = (xcd < r ? xcd * (q + 1) : r * (q + 1) + (xcd - r) * q) + off; }
        const int nig = WGM * nN, gid = wgid / nig, fm = gid * WGM, gsz = (nM - fm) < WGM ? (nM - fm) : WGM;
        u.pm = fm + ((wgid % nig) % gsz); u.pn = (wgid % nig) / gsz; return true;
    }
    __device__ __forceinline__ void a_ready(const Unit&) const {}
    __device__ __forceinline__ void done(const Unit&) const {}
};

template <class Epi, class Sched, bool ALIGN_EPI = false, bool SP2 = false>
__device__ __forceinline__ void gemm_phase(PG8_LAS unsigned char* lds, const Gemm g, const Sched& S, const Epi& E) {
    const int tid = threadIdx.x, wid = __builtin_amdgcn_readfirstlane(tid >> 6), lane = tid & 63, wr = wid >> 2, wc = wid & 3, fr = lane & 15, fq = lane >> 4;
    const int K = g.K, nt = K / BK;
    unsigned voffA[2], voffB[2];
#pragma unroll
    for (int i = 0; i < 2; ++i) { int R, C; stage_rc(tid * 16 + i * 8192, R, C); const int Rb = Epi::PERM ? ((R & ~31) + perm32(R & 31)) : R;
        voffA[i] = (unsigned)(R * g.lda + C) * 2u; voffB[i] = (unsigned)(Rb * g.ldb + C) * 2u; }
    const size_t kstep = (size_t)(BK * 2);
    const size_t hstepA = (size_t)HALF * g.lda * 2, hstepB = (size_t)HALF * g.ldb * 2;
    const size_t tstepA = 2 * hstepA, tstepB = 2 * hstepB;
    const unsigned ldsw = (unsigned)wid * 1024u;
    const int aoff = lds_byte(wr * 64 + fr, fq * 8), boff = lds_byte(wc * 32 + fr, fq * 8);
#define PG8_SA(b, h) (((b) * 2 + (h)) * HTB)
#define PG8_SB(b, h) ((4 + (b) * 2 + (h)) * HTB)
#define PG8_STAGE(bufoff, gbase, voff) do { _Pragma("unroll") for (int _i = 0; _i < 2; ++_i) \
        __builtin_amdgcn_global_load_lds((const unsigned*)((const char*)(gbase) + (voff)[_i]), (PG8_LAS unsigned*)(lds + (bufoff) + ldsw + _i * 8192), 16, 0, 0); } while (0)
#define PG8_LDA(dst, b, h) do { _Pragma("unroll") for (int m = 0; m < 4; ++m) _Pragma("unroll") for (int k = 0; k < 2; ++k) dst[m][k] = *(const PG8_LAS bf16x8*)(lds + PG8_SA(b, h) + aoff + m * 2048 + k * 1024); } while (0)
#define PG8_LDB(dst, b, h) do { _Pragma("unroll") for (int n = 0; n < 2; ++n) _Pragma("unroll") for (int k = 0; k < 2; ++k) dst[n][k] = *(const PG8_LAS bf16x8*)(lds + PG8_SB(b, h) + boff + n * 2048 + k * 1024); } while (0)
#define PG8_MMA(ai, bj, At, Bt) do { __builtin_amdgcn_s_setprio(1); _Pragma("unroll") for (int m = 0; m < 4; ++m) _Pragma("unroll") for (int n = 0; n < 2; ++n) _Pragma("unroll") for (int k = 0; k < 2; ++k) \
        acc[ai][bj][m][n] = __builtin_amdgcn_mfma_f32_16x16x32_bf16(Bt[n][k], At[m][k], acc[ai][bj][m][n], 0, 0, 0); __builtin_amdgcn_s_setprio(0); } while (0)
#define PG8_WAIT_V(n) asm volatile("s_waitcnt vmcnt(" #n ")" ::: "memory")
#define PG8_WAIT_L(n) asm volatile("s_waitcnt lgkmcnt(" #n ")" ::: "memory")
#define PG8_BAR __builtin_amdgcn_s_barrier()
#define PG8_SCHED __builtin_amdgcn_sched_barrier(0)
    Unit cur, nxt; int ui = 0;
    if (!S.next(0, cur)) return;
    f32x4 acc[2][2][4][2];
#pragma unroll
    for (int a = 0; a < 2; ++a)
#pragma unroll
        for (int b = 0; b < 2; ++b)
#pragma unroll
            for (int m = 0; m < 4; ++m)
#pragma unroll
                for (int n = 0; n < 2; ++n) acc[a][b][m][n] = (f32x4){0.f, 0.f, 0.f, 0.f};
    bf16x8 At[4][2], B0[2][2], B1[2][2];
    const char* cA = (const char*)g.A + (size_t)cur.pm * tstepA; const char* cB = (const char*)g.Bt + (size_t)cur.pn * tstepB;
    S.a_ready(cur);
    if constexpr (SP2) {
        PG8_STAGE(PG8_SB(0, 0), cB, voffB); PG8_STAGE(PG8_SB(0, 1), cB + hstepB, voffB); PG8_STAGE(PG8_SA(0, 0), cA, voffA); PG8_STAGE(PG8_SA(0, 1), cA + hstepA, voffA);
        if (wr == 1) PG8_BAR;
        PG8_WAIT_V(2); PG8_BAR;
        PG8_STAGE(PG8_SB(1, 0), cB + kstep, voffB); PG8_STAGE(PG8_SA(1, 0), cA + kstep, voffA); PG8_STAGE(PG8_SB(1, 1), cB + hstepB + kstep, voffB);
        PG8_WAIT_V(6); PG8_BAR;
    } else {
        PG8_STAGE(PG8_SB(0, 0), cB, voffB); PG8_STAGE(PG8_SA(0, 0), cA, voffA); PG8_STAGE(PG8_SB(0, 1), cB + hstepB, voffB); PG8_STAGE(PG8_SA(0, 1), cA + hstepA, voffA);
        if (wr == 1) PG8_BAR;
        PG8_WAIT_V(4); PG8_BAR;
        PG8_STAGE(PG8_SB(1, 0), cB + kstep, voffB); PG8_STAGE(PG8_SA(1, 0), cA + kstep, voffA); PG8_STAGE(PG8_SB(1, 1), cB + hstepB + kstep, voffB);
        PG8_WAIT_V(6); PG8_BAR;
    }
    for (;;) {
        const bool has_next = S.next(ui + 1, nxt);
        const char* nA = has_next ? (const char*)g.A + (size_t)nxt.pm * tstepA : cA; const char* nB = has_next ? (const char*)g.Bt + (size_t)nxt.pn * tstepB : cB;
        for (int t = 0; t < nt; t += 2) {
            const bool last = (t == nt - 2);
            const char* a1 = cA + (size_t)(t + 1) * kstep;
            const char* a2 = last ? nA : cA + (size_t)(t + 2) * kstep; const char* b2 = last ? nB : cB + (size_t)(t + 2) * kstep;
            const char* a3 = a2 + kstep; const char* b3 = b2 + kstep;
            if (last && has_next) S.a_ready(nxt);
            if constexpr (SP2) {
            PG8_LDB(B0, 0, 0); PG8_LDB(B1, 0, 1); PG8_SCHED; PG8_LDA(At, 0, 0); PG8_STAGE(PG8_SA(1, 1), a1 + hstepA, voffA);
            PG8_WAIT_V(8); PG8_WAIT_L(0); PG8_BAR; PG8_MMA(0, 0, At, B0); PG8_MMA(0, 1, At, B1); PG8_BAR; PG8_SCHED;
            PG8_LDA(At, 0, 1); PG8_STAGE(PG8_SB(0, 0), b2, voffB); PG8_STAGE(PG8_SB(0, 1), b2 + hstepB, voffB); PG8_STAGE(PG8_SA(0, 0), a2, voffA);
            PG8_WAIT_V(8); PG8_WAIT_L(0); PG8_BAR; PG8_MMA(1, 0, At, B0); PG8_MMA(1, 1, At, B1); PG8_BAR; PG8_SCHED;
            PG8_LDB(B0, 1, 0); PG8_LDB(B1, 1, 1); PG8_SCHED; PG8_LDA(At, 1, 0); PG8_STAGE(PG8_SA(0, 1), a2 + hstepA, voffA);
            PG8_WAIT_V(8); PG8_WAIT_L(0); PG8_BAR; PG8_MMA(0, 0, At, B0); PG8_MMA(0, 1, At, B1); PG8_BAR; PG8_SCHED;
            PG8_LDA(At, 1, 1); PG8_STAGE(PG8_SB(1, 0), b3, voffB); PG8_STAGE(PG8_SB(1, 1), b3 + hstepB, voffB); PG8_STAGE(PG8_SA(1, 0), a3, voffA);
            PG8_WAIT_V(8); PG8_WAIT_L(0); PG8_BAR; PG8_MMA(1, 0, At, B0); PG8_MMA(1, 1, At, B1); PG8_BAR; PG8_SCHED;
            } else {
            PG8_LDB(B0, 0, 0); PG8_SCHED; PG8_LDA(At, 0, 0); PG8_STAGE(PG8_SA(1, 1), a1 + hstepA, voffA);
            PG8_WAIT_L(8); PG8_BAR; PG8_WAIT_L(0); PG8_MMA(0, 0, At, B0); PG8_BAR; PG8_SCHED;
            PG8_LDB(B1, 0, 1); PG8_STAGE(PG8_SB(0, 0), b2, voffB);
            PG8_BAR; PG8_WAIT_L(0); PG8_MMA(0, 1, At, B1); PG8_BAR;
            PG8_LDA(At, 0, 1); PG8_STAGE(PG8_SA(0, 0), a2, voffA);
            PG8_BAR; PG8_WAIT_L(0); PG8_MMA(1, 0, At, B0); PG8_BAR; PG8_SCHED;
            PG8_STAGE(PG8_SB(0, 1), b2 + hstepB, voffB);
            PG8_WAIT_V(6); PG8_BAR; PG8_MMA(1, 1, At, B1); PG8_BAR;
            PG8_LDB(B0, 1, 0); PG8_SCHED; PG8_LDA(At, 1, 0); PG8_STAGE(PG8_SA(0, 1), a2 + hstepA, voffA);
            PG8_WAIT_L(8); PG8_BAR; PG8_WAIT_L(0); PG8_MMA(0, 0, At, B0); PG8_BAR; PG8_SCHED;
            PG8_LDB(B1, 1, 1); PG8_STAGE(PG8_SB(1, 0), b3, voffB);
            PG8_BAR; PG8_WAIT_L(0); PG8_MMA(0, 1, At, B1); PG8_BAR;
            PG8_LDA(At, 1, 1); PG8_STAGE(PG8_SA(1, 0), a3, voffA);
            PG8_BAR; PG8_WAIT_L(0); PG8_MMA(1, 0, At, B0); PG8_BAR; PG8_SCHED;
            PG8_STAGE(PG8_SB(1, 1), b3 + hstepB, voffB);
            PG8_WAIT_V(6); PG8_BAR; PG8_MMA(1, 1, At, B1); PG8_BAR;
            }
        }
        if constexpr (ALIGN_EPI) { if (wr == 0) PG8_BAR; }
        if constexpr (!Epi::AFTER_DRAIN) { E(acc, cur, wr, wc, fr, fq); S.done(cur); }
        if (!has_next) break;
#pragma unroll
        for (int a = 0; a < 2; ++a)
#pragma unroll
            for (int b = 0; b < 2; ++b)
#pragma unroll
                for (int m = 0; m < 4; ++m)
#pragma unroll
                    for (int n = 0; n < 2; ++n) acc[a][b][m][n] = (f32x4){0.f, 0.f, 0.f, 0.f};
        cur = nxt; cA = nA; cB = nB; ++ui;
        if constexpr (ALIGN_EPI) { if (wr == 1) PG8_BAR; }
    }
    PG8_WAIT_V(0);
    if constexpr (!ALIGN_EPI) { if (wr == 0) PG8_BAR; }
    PG8_BAR;
#undef PG8_SA
#undef PG8_SB
#undef PG8_STAGE
#undef PG8_LDA
#undef PG8_LDB
#undef PG8_MMA
#undef PG8_WAIT_V
#undef PG8_WAIT_L
#undef PG8_BAR
#undef PG8_SCHED
}

template <int MODE> struct Epi {
    static constexpr bool PERM = false, AFTER_DRAIN = false;
    const float* rowsrc; float inv_n; float* ss; bf16_t* ob; int ldc; float* of; const float* xin;
    __device__ __forceinline__ void operator()(const f32x4 (&acc)[2][2][4][2], const Unit& u, int wr, int wc, int fr, int fq) const {
#pragma unroll
        for (int ai = 0; ai < 2; ++ai)
#pragma unroll
            for (int m = 0; m < 4; ++m) {
                const int row = u.pm * BM + ai * HALF + wr * 64 + m * 16 + fr;
                float rs = 1.f;
                if (MODE == 1) rs = rowsrc[row];
                if (MODE == 2 || MODE == 5) rs = rsqrtf(rowsrc[row] * inv_n + EPS);
                float ssq = 0.f;
#pragma unroll
                for (int bj = 0; bj < 2; ++bj)
#pragma unroll
                    for (int n = 0; n < 2; ++n) {
                        const int col = u.pn * BM + bj * HALF + wc * 32 + n * 16 + fq * 4;
                        f32x4 v = acc[ai][bj][m][n] * rs;
                        if (MODE == 1) { if (u.pn < 8) { v[0] = gelu_tanh(v[0]); v[1] = gelu_tanh(v[1]); v[2] = gelu_tanh(v[2]); v[3] = gelu_tanh(v[3]); } }
                        if (MODE == 4) { const f32x4 xr = *(const f32x4*)(xin + (size_t)row * DM + col); v = v + xr; }
                        if (MODE == 1 || MODE == 4) ssq += (v[0] * v[0] + v[1] * v[1]) + (v[2] * v[2] + v[3] * v[3]);
                        if (MODE == 1 || MODE == 2 || MODE == 4) { u32x2 w; w.x = pk2(v[0], v[1]); w.y = pk2(v[2], v[3]); *(u32x2*)(ob + (size_t)row * ldc + col) = w; }
                        if (MODE == 5) *(f32x4*)(of + (size_t)row * DM + col) = v;
                    }
                if (MODE == 1) {
                    const int seg = (u.pn >= 4 && u.pn < 8) ? 0 : ((u.pn == 8 || u.pn == 9) ? 1 : (u.pn == 10 ? 2 : -1));
                    if (seg >= 0) { ssq += __shfl_xor(ssq, 16); ssq += __shfl_xor(ssq, 32); if (fq == 0) atomicAdd(ss + seg * S + row, ssq); }
                }
                if (MODE == 4) { ssq += __shfl_xor(ssq, 16); ssq += __shfl_xor(ssq, 32); if (fq == 0) atomicAdd(ss + row, ssq); }
            }
    }
};
}

#define XB_TMO      128
#define XB_XCNT(j)  (256  + 64 * (j))
#define XB_XSUB(j)  (1280 + 64 * (j))
#define XB_XGEN(j)  (2304 + 64 * (j))
#define XB_TOP      3328
#define XB_TOPGEN   3392
#define XCD_BAR_WORDS 3456
#define XB_SPIN_CAP (1u << 18)
__device__ __forceinline__ unsigned xb_ld(unsigned* p)              { return __hip_atomic_load(p, __ATOMIC_RELAXED, __HIP_MEMORY_SCOPE_AGENT); }
__device__ __forceinline__ unsigned xb_add(unsigned* p, unsigned v) { return __hip_atomic_fetch_add(p, v, __ATOMIC_RELAXED, __HIP_MEMORY_SCOPE_AGENT); }
__device__ __forceinline__ unsigned xb_xcc_id() { return (unsigned)__builtin_amdgcn_s_getreg((3 << 11) | 20) & 0xFu; }
#define XB_SPIN(cond, bar) do { unsigned _sp = 0; while (cond) { __builtin_amdgcn_s_sleep(1); \
    if ((++_sp & 255u) == 0u) { if (xb_ld(&(bar)[XB_TMO])) break; if (_sp > XB_SPIN_CAP) { atomicAdd(&(bar)[XB_TMO], 1u); break; } } } } while (0)
struct XcdBarrier { unsigned* bar; unsigned x; volatile LAS unsigned* st; };
__device__ __forceinline__ XcdBarrier xcd_barrier_post(unsigned* bar, volatile LAS unsigned* st) {
    XcdBarrier b; b.bar = bar; b.x = xb_xcc_id(); b.st = st;
    if (threadIdx.x == 0) st[3] = xb_add(&bar[XB_XCNT(b.x)], 1u);
    return b;
}
__device__ __forceinline__ void xcd_barrier_complete(unsigned* bar, unsigned x, unsigned& nloc, unsigned& nx, unsigned& eq32) {
    const unsigned G = gridDim.x * gridDim.y * gridDim.z;
    unsigned sum, cnt, mine, sp = 0u;
    for (;;) {
        sum = 0u; cnt = 0u; mine = 0u; eq32 = 1u;
#pragma unroll
        for (unsigned j = 0; j < 16; ++j) { const unsigned c = xb_ld(&bar[XB_XCNT(j)]); sum += c; cnt += (c > 0u) ? 1u : 0u; mine = (j == x) ? c : mine; if (c != (j < 8u ? 32u : 0u)) eq32 = 0u; }
        if (sum == G) break;
        __builtin_amdgcn_s_sleep(1);
        if ((++sp & 255u) == 0u) { if (xb_ld(&bar[XB_TMO])) break; if (sp > XB_SPIN_CAP) { atomicAdd(&bar[XB_TMO], 1u); break; } }
    }
    nloc = mine > 0u ? mine : 1u; nx = cnt > 0u ? cnt : 1u;
}
#define XB_LSUB(j)  (3456 + 64 * (j))
#define XB_LGEN(j)  (4480 + 64 * (j))
__device__ __forceinline__ void xcd_local_barrier(const XcdBarrier& b) {
    asm volatile("s_waitcnt vmcnt(0)" ::: "memory");
    __syncthreads();
    if (threadIdx.x == 0) {
        unsigned* bar = b.bar;
        const unsigned nloc = b.st[0];
        const unsigned old = xb_add(&bar[XB_LSUB(b.x)], 1u);
        const unsigned gen = old / nloc;
        if (old + 1u == (gen + 1u) * nloc) xb_add(&bar[XB_LGEN(b.x)], 1u);
        else XB_SPIN(xb_ld(&bar[XB_LGEN(b.x)]) == gen, bar);
    }
    __syncthreads();
}
__device__ __forceinline__ void xcd_local_barrier_acq(const XcdBarrier& b) {
    asm volatile("s_waitcnt vmcnt(0)" ::: "memory");
    __syncthreads();
    if (threadIdx.x == 0) {
        unsigned* bar = b.bar;
        __builtin_amdgcn_s_waitcnt(0);
        const unsigned nloc = b.st[0];
        const unsigned old = xb_add(&bar[XB_LSUB(b.x)], 1u);
        const unsigned gen = old / nloc;
        if (old + 1u == (gen + 1u) * nloc) xb_add(&bar[XB_LGEN(b.x)], 1u);
        else XB_SPIN(xb_ld(&bar[XB_LGEN(b.x)]) == gen, bar);
        __builtin_amdgcn_fence(__ATOMIC_ACQUIRE, "agent");
        asm volatile("s_waitcnt vmcnt(0)" ::: "memory");
    }
    __syncthreads();
}
__device__ __forceinline__ void xcd_barrier(const XcdBarrier& b) {
    asm volatile("s_waitcnt vmcnt(0)" ::: "memory");
    __syncthreads();
    if (threadIdx.x == 0) {
        unsigned* bar = b.bar;
        __builtin_amdgcn_s_waitcnt(0);
        unsigned nloc = b.st[0], nx = b.st[1];
        if (nloc == 0u) { unsigned eq32; xcd_barrier_complete(bar, b.x, nloc, nx, eq32); b.st[0] = nloc; b.st[1] = nx; b.st[2] = eq32; }
        const unsigned old = xb_add(&bar[XB_XSUB(b.x)], 1u);
        const unsigned gen = old / nloc;
        if (old + 1u == (gen + 1u) * nloc) {
            __builtin_amdgcn_fence(__ATOMIC_RELEASE, "agent");
            asm volatile("s_waitcnt vmcnt(0)" ::: "memory");
            const unsigned og = xb_add(&bar[XB_TOP], 1u);
            const unsigned tg = og / nx;
            if (og + 1u == (tg + 1u) * nx) xb_add(&bar[XB_TOPGEN], 1u);
            else XB_SPIN(xb_ld(&bar[XB_TOPGEN]) == tg, bar);
            __builtin_amdgcn_fence(__ATOMIC_ACQUIRE, "agent");
            xb_add(&bar[XB_XGEN(b.x)], 1u);
            asm volatile("s_waitcnt vmcnt(0)" ::: "memory");
        } else {
            XB_SPIN(xb_ld(&bar[XB_XGEN(b.x)]) == gen, bar);
            __builtin_amdgcn_fence(__ATOMIC_ACQUIRE, "agent");
            asm volatile("s_waitcnt vmcnt(0)" ::: "memory");
        }
    }
    __syncthreads();
}

struct Params {
    const float* in[18];
    float* out;
    unsigned char* ws;
    int ph_lo, ph_hi;
};

__device__ __forceinline__ void p0_transpose_item(const float* W, const float* g, int K, int N, bf16_t* WT, LAS float* scr, int item, int lane) {
    const int nblk = N / 32, kb = item / nblk, nb = item % nblk, k0 = 64 * kb, n0 = 32 * nb;
    float wv[32];
#pragma unroll
    for (int i = 0; i < 32; ++i) { const int kk = 2 * i + (lane >> 5); wv[i] = W[(size_t)(k0 + kk) * N + n0 + (lane & 31)]; }
#pragma unroll
    for (int i = 0; i < 32; ++i) { const int kk = 2 * i + (lane >> 5); const float gv = g ? g[k0 + kk] : 1.f; scr[kk * 33 + (lane & 31)] = wv[i] * gv; }
    LDS_WAIT(); asm volatile("" ::: "memory");
    const int c = lane & 7;
#pragma unroll
    for (int j = 0; j < 4; ++j) { const int n = (lane >> 3) + 8 * j; const LAS float* s = scr + (8 * c) * 33 + n;
        u32x4 o; o.x = pk2(s[0 * 33], s[1 * 33]); o.y = pk2(s[2 * 33], s[3 * 33]); o.z = pk2(s[4 * 33], s[5 * 33]); o.w = pk2(s[6 * 33], s[7 * 33]);
        *(u32x4*)(WT + (size_t)(n0 + n) * K + k0 + 8 * c) = o; }
    LDS_WAIT(); asm volatile("" ::: "memory");
}
__device__ __forceinline__ float row_to_bf16(const float* src, const float* g, bf16_t* dst, int lane) {
    float ss = 0.f;
#pragma unroll
    for (int i = 0; i < 8; ++i) {
        const int c = (i * 64 + lane) * 4;
        f32x4 v = *(const f32x4*)(src + c);
        ss += (v[0] * v[0] + v[1] * v[1]) + (v[2] * v[2] + v[3] * v[3]);
        if (g) { const f32x4 gv = *(const f32x4*)(g + c); v = v * gv; }
        u32x2 w; w.x = pk2(v[0], v[1]); w.y = pk2(v[2], v[3]);
        *(u32x2*)(dst + c) = w;
    }
    return ss;
}
constexpr float PEER_USC = 80.0f, PEER_VSC = 5.0f;
constexpr int PEER_ROWB = 1536;
typedef float f32x16v __attribute__((ext_vector_type(16)));
typedef float f32x32v __attribute__((ext_vector_type(32)));
typedef unsigned u32x6 __attribute__((ext_vector_type(6)));
typedef unsigned u32x2a4 __attribute__((ext_vector_type(2), aligned(4)));
template <bool CONTIG>
__device__ __forceinline__ void fp6_pack_store(const f32x4 (&x)[8], const f32x4 (&sc)[8], unsigned char* dst, int lane) {
    f32x16v a, b;
#pragma unroll
    for (int i = 0; i < 8; ++i) {
        const f32x4 y = x[i] * sc[i];
#pragma unroll
        for (int q = 0; q < 4; ++q) { const float c = fminf(fmaxf(y[q], -7.5f), 7.5f); const int sl = 4 * i + q; if ((sl & 1) == 0) a[sl >> 1] = c; else b[sl >> 1] = c; }
    }
    const u32x6 pk = __builtin_amdgcn_cvt_scalef32_2xpk16_fp6_f32(a, b, 1.0f);
    asm volatile("s_nop 15" : "+v"(a), "+v"(b));
    if (CONTIG) {
        *(u32x2*)(dst + lane * 24) = (u32x2){pk[0], pk[1]}; *(u32x2*)(dst + lane * 24 + 8) = (u32x2){pk[2], pk[3]}; *(u32x2*)(dst + lane * 24 + 16) = (u32x2){pk[4], pk[5]};
    } else {
        *(u32x4*)(dst + lane * 16) = (u32x4){pk[0], pk[1], pk[2], pk[3]};
        *(u32x2*)(dst + 1024 + lane * 8) = (u32x2){pk[4], pk[5]};
    }
}
template <bool CONTIG>
__device__ __forceinline__ void rows2_to_fp6(const float* s0, const float* s1, const f32x4 (&sc)[8], unsigned char* d0, unsigned char* d1, int lane) {
    f32x4 x0[8], x1[8];
#pragma unroll
    for (int i = 0; i < 8; ++i) { x0[i] = *(const f32x4*)(s0 + (i * 64 + lane) * 4); x1[i] = *(const f32x4*)(s1 + (i * 64 + lane) * 4); }
    fp6_pack_store<CONTIG>(x0, sc, d0, lane); fp6_pack_store<CONTIG>(x1, sc, d1, lane);
}
__device__ __forceinline__ bf16x8 cvt8(const float* p) {
    const f32x4 a = *(const f32x4*)p, b = *(const f32x4*)(p + 4);
    u32x4 w; w.x = pk2(a[0], a[1]); w.y = pk2(a[2], a[3]); w.z = pk2(b[0], b[1]); w.w = pk2(b[2], b[3]);
    return __builtin_bit_cast(bf16x8, w);
}

__device__ __forceinline__ void prep_late(const Params& p, LAS unsigned char* lds, int gw, int NGW, int wave, int lane) {
    unsigned char* ws = p.ws;
    LAS float* scr = (LAS float*)(lds + wave * 16384);
    {
        constexpr int I_UQ = (512 / 64) * (1536 / 32), I_UKV = (256 / 64) * (2048 / 32), I_OUT = (DM / 64) * (DM / 32);
        constexpr int NIT = I_UQ + I_UKV + I_OUT;
        for (int it = gw; it < NIT; it += NGW) {
            int r = it;
            if (r < I_UQ) { p0_transpose_item(p.in[7], p.in[6], 512, 1536, (bf16_t*)(ws + WS_WUQ), scr, r, lane); continue; } r -= I_UQ;
            if (r < I_UKV) { p0_transpose_item(p.in[9], p.in[8], 256, 2048, (bf16_t*)(ws + WS_WUKV), scr, r, lane); continue; } r -= I_UKV;
            p0_transpose_item(p.in[12], nullptr, DM, DM, (bf16_t*)(ws + WS_WOUT), scr, r, lane);
        }
    }
    {
        const float* wq = p.in[14]; const float* sk = p.in[15]; const float* g2 = p.in[13];
        bf16_t* WsT = (bf16_t*)(ws + WS_WS);
        const int r32 = lane & 31, hh = lane >> 5;
        for (int it = gw; it < 16 * 4 * 64; it += NGW) {
            const int hp = it >> 8, kb = (it >> 6) & 3, nb = it & 63;
            f32x16 acc = {};
            const float* ap = sk + ((size_t)(hp * 128 + kb * 32 + r32)) * 128 + hh * 8;
            const float* bp = wq + ((size_t)(nb * 32 + r32)) * DM + hp * 128 + hh * 8;
#pragma unroll
            for (int s = 0; s < 8; ++s) {
                const bf16x8 a = cvt8(ap + s * 16), b = cvt8(bp + s * 16);
                acc = __builtin_amdgcn_mfma_f32_32x32x16_bf16(a, b, acc, 0, 0, 0);
            }
            const int kcol = nb * 32 + r32; const float gk = g2[kcol];
#pragma unroll
            for (int r = 0; r < 16; ++r) WsT[(size_t)(hp * 128 + kb * 32 + crow(r, hh)) * DM + kcol] = (bf16_t)f2bf(acc[r] * gk);
        }
    }
    {
        float* ct = (float*)(ws + WS_COS); float* st = (float*)(ws + WS_SIN);
        for (int it = gw; it < S * 32 / 64; it += NGW) {
            const int idx = it * 64 + lane, t = idx >> 5, j = idx & 31;
            const float inv_freq = powf(10000.0f, -(float)j / 32.0f);
            const float ang = (float)t * inv_freq;
            float sv, cv; sincosf(ang, &sv, &cv); ct[idx] = cv; st[idx] = sv;
        }
    }
}
__device__ __forceinline__ void phase0(const Params& p, LAS unsigned char* lds, bool late_ok, int gw, int NGW, int wave, int lane) {
    unsigned char* ws = p.ws;
    LAS float* scr = (LAS float*)(lds + wave * 16384);
    const float* x = p.in[0];
    {
        constexpr int I_IN = (DM / 64) * (NIN / 32);
        for (int it = gw; it < I_IN; it += NGW) p0_transpose_item(p.in[2], p.in[1], DM, NIN, (bf16_t*)(ws + WS_WIN), scr, it, lane);
    }
    if (!late_ok) prep_late(p, lds, gw, NGW, wave, lane);
    for (int r = gw; r < NINP - NIN; r += NGW) {
        bf16_t* d = (bf16_t*)(ws + WS_WIN) + (size_t)(NIN + r) * DM;
#pragma unroll
        for (int i = 0; i < 4; ++i) *(u32x4*)(d + (i * 64 + lane) * 8) = (u32x4){0u, 0u, 0u, 0u};
    }
    {
        bf16_t* xb = (bf16_t*)(ws + WS_XB); float* rstd1 = (float*)(ws + WS_RSTD1);
        for (int t = gw; t + NGW < S; t += 2 * NGW) {
            const int t1 = t + NGW;
            f32x4 a[8], b[8];
#pragma unroll
            for (int i = 0; i < 8; ++i) { a[i] = *(const f32x4*)(x + (size_t)t * DM + (i * 64 + lane) * 4); b[i] = *(const f32x4*)(x + (size_t)t1 * DM + (i * 64 + lane) * 4); }
            float sa = 0.f, sb = 0.f;
#pragma unroll
            for (int i = 0; i < 8; ++i) {
                sa += (a[i][0] * a[i][0] + a[i][1] * a[i][1]) + (a[i][2] * a[i][2] + a[i][3] * a[i][3]);
                sb += (b[i][0] * b[i][0] + b[i][1] * b[i][1]) + (b[i][2] * b[i][2] + b[i][3] * b[i][3]);
                u32x2 wa, wb; wa.x = pk2(a[i][0], a[i][1]); wa.y = pk2(a[i][2], a[i][3]); wb.x = pk2(b[i][0], b[i][1]); wb.y = pk2(b[i][2], b[i][3]);
                *(u32x2*)(xb + (size_t)t * DM + (i * 64 + lane) * 4) = wa; *(u32x2*)(xb + (size_t)t1 * DM + (i * 64 + lane) * 4) = wb;
            }
            sa = wave_sum(sa); sb = wave_sum(sb);
            if (lane == 0) { rstd1[t] = rsqrtf(sa * (1.0f / DM) + EPS); rstd1[t1] = rsqrtf(sb * (1.0f / DM) + EPS); }
        }
    }
    {
        unsigned char* UT = ws + WS_UT; unsigned char* VT = ws + WS_VT;
        f32x4 sc[8];
#pragma unroll
        for (int i = 0; i < 8; ++i) sc[i] = *(const f32x4*)(p.in[13] + (i * 64 + lane) * 4) * PEER_USC;
        for (int e = gw; e + NGW < 16384; e += 2 * NGW)
            rows2_to_fp6<false>(p.in[16] + (size_t)e * DM, p.in[16] + (size_t)(e + NGW) * DM, sc, UT + (size_t)e * PEER_ROWB, UT + (size_t)(e + NGW) * PEER_ROWB, lane);
#pragma unroll
        for (int i = 0; i < 8; ++i) sc[i] = (f32x4){PEER_VSC, PEER_VSC, PEER_VSC, PEER_VSC};
        for (int e = gw; e + NGW < 16384; e += 2 * NGW)
            rows2_to_fp6<false>(p.in[17] + (size_t)e * DM, p.in[17] + (size_t)(e + NGW) * DM, sc, VT + (size_t)e * PEER_ROWB, VT + (size_t)(e + NGW) * PEER_ROWB, lane);
    }
}

__device__ __forceinline__ float half_sum(float v) {
    v += dpp_f<0xB1, 0xf>(0.f, v); v += dpp_f<0x4E, 0xf>(0.f, v); v += dpp_f<0x141, 0xf>(0.f, v); v += dpp_f<0x140, 0xf>(0.f, v);
    return v + __shfl_xor(v, 16);
}
__device__ __forceinline__ void phase3(const Params& p, int tfirst, int tstep, int tcnt, int lane) {
    unsigned char* ws = p.ws;
    const bf16_t* qraw = (const bf16_t*)(ws + WS_QRAW); const bf16_t* kvraw = (const bf16_t*)(ws + WS_KVRAW); const bf16_t* proj = (const bf16_t*)(ws + WS_PROJ);
    bf16_t* Qh = (bf16_t*)(ws + WS_QH); bf16_t* Kh = (bf16_t*)(ws + WS_KH);
    const float* ct = (const float*)(ws + WS_COS); const float* st = (const float*)(ws + WS_SIN);
    const int sub = lane & 31, hsel = lane >> 5;
    const bool act = sub < 24, isrope = sub >= 16 && sub < 24, lowhalf = sub < 20;
    const int e0 = act ? 8 * sub : 0;
    f32x4 gq[2], gk[2];
#pragma unroll
    for (int c = 0; c < 2; ++c) { gq[c] = *(const f32x4*)(p.in[10] + e0 + 4 * c); gk[c] = *(const f32x4*)(p.in[11] + e0 + 4 * c); }
    const int j0 = isrope ? ((8 * sub - 128) & 31) : 0;
    constexpr float QS = 0.07216878364870322f * 1.4426950408889634f;
    for (int ti = 0; ti < tcnt; ++ti) {
        const int t = tfirst + ti * tstep;
        f32x4 cs[2] = {{1.f, 1.f, 1.f, 1.f}, {1.f, 1.f, 1.f, 1.f}}, sn[2] = {{0.f, 0.f, 0.f, 0.f}, {0.f, 0.f, 0.f, 0.f}};
        u32x4 krw = {0u, 0u, 0u, 0u};
        if (isrope) {
#pragma unroll
            for (int c = 0; c < 2; ++c) { cs[c] = *(const f32x4*)(ct + t * 32 + j0 + 4 * c); sn[c] = *(const f32x4*)(st + t * 32 + j0 + 4 * c); }
            krw = *(const u32x4*)(proj + (size_t)t * NINP + 2816 + (8 * sub - 128));
        }
#pragma unroll
        for (int hp = 0; hp < 4; ++hp) {
            const int h = 2 * hp + hsel;
            u32x4 qw = {0u, 0u, 0u, 0u}, kw = {0u, 0u, 0u, 0u};
            if (act) qw = *(const u32x4*)(qraw + (size_t)t * 1536 + h * 192 + e0);
            if (sub < 16) kw = *(const u32x4*)(kvraw + (size_t)t * 2048 + h * 256 + e0);
            if (isrope) kw = krw;
#pragma unroll
            for (int which = 0; which < 2; ++which) {
                const u32x4 w = which ? kw : qw;
                f32x4 x[2] = {{bflo(w[0]), bfhi(w[0]), bflo(w[1]), bfhi(w[1])}, {bflo(w[2]), bfhi(w[2]), bflo(w[3]), bfhi(w[3])}};
                float ss = 0.f;
#pragma unroll
                for (int c = 0; c < 2; ++c) ss += (x[c][0] * x[c][0] + x[c][1] * x[c][1]) + (x[c][2] * x[c][2] + x[c][3] * x[c][3]);
                ss = half_sum(ss);
                const float rs = rsqrtf(ss * (1.0f / 192.0f) + EPS);
#pragma unroll
                for (int c = 0; c < 2; ++c) {
                    x[c] = x[c] * (which ? gk[c] : gq[c]) * rs;
                    f32x4 pr;
#pragma unroll
                    for (int q = 0; q < 4; ++q) pr[q] = __shfl_xor(x[c][q], 4);
                    const f32x4 r1 = x[c] * cs[c] - pr * sn[c], r2 = pr * sn[c] + x[c] * cs[c];
                    if (isrope) x[c] = lowhalf ? r1 : r2;
                    if (!which) x[c] = x[c] * QS;
                }
                if (act) {
                    u32x4 o; o.x = pk2(x[0][0], x[0][1]); o.y = pk2(x[0][2], x[0][3]); o.z = pk2(x[1][0], x[1][1]); o.w = pk2(x[1][2], x[1][3]);
                    *(u32x4*)((which ? Kh : Qh) + ((size_t)h * S + t) * 192 + e0) = o;
                }
            }
        }
    }
}

constexpr int KP = 400, VP = 320;
template <int OFF> __device__ __forceinline__ s16x4 tr_read(unsigned addr) {
    s16x4 r; asm volatile("ds_read_b64_tr_b16 %0, %1 offset:%2" : "=&v"(r) : "v"(addr), "i"(OFF) : "memory"); return r;
}
__device__ __forceinline__ unsigned cvtpk(float lo, float hi) { unsigned r; asm volatile("v_cvt_pk_bf16_f32 %0, %1, %2" : "=v"(r) : "v"(lo), "v"(hi)); return r; }
#define PK8(L, H) ((bf16x8){L[0], L[1], L[2], L[3], H[0], H[1], H[2], H[3]})
constexpr float ATT_THR = 8.0f;

constexpr int ATT_KB = 64 * KP, ATT_VB = 64 * VP;
constexpr int ATT_VOFF = 2 * ATT_KB;
__device__ __forceinline__ float xhalf_max(float v) {
    auto rr = __builtin_amdgcn_permlane32_swap(__builtin_bit_cast(unsigned, v), __builtin_bit_cast(unsigned, v), false, false);
    return fmaxf(__builtin_bit_cast(float, rr[0]), __builtin_bit_cast(float, rr[1]));
}
__device__ __forceinline__ float xhalf_sum(float v) {
    auto rr = __builtin_amdgcn_permlane32_swap(__builtin_bit_cast(unsigned, v), __builtin_bit_cast(unsigned, v), false, false);
    return __builtin_bit_cast(float, rr[0]) + __builtin_bit_cast(float, rr[1]);
}
template <int OFF> __device__ __forceinline__ bf16x8 lds_read128(unsigned addr) {
    bf16x8 r; asm volatile("ds_read_b128 %0, %1 offset:%2" : "=&v"(r) : "v"(addr), "i"(OFF) : "memory"); return r;
}
#define LGKM_WAIT(n) do { asm volatile("s_waitcnt lgkmcnt(" #n ")" ::: "memory"); SBAR(); } while (0)
__device__ __forceinline__ f32x16 att_qk(unsigned kaddr, const bf16x8 (&qr)[12]) {
    f32x16 p = {};
    bf16x8 a0 = lds_read128<0>(kaddr), a1 = lds_read128<32>(kaddr), a2 = lds_read128<64>(kaddr), a3 = lds_read128<96>(kaddr);
    LGKM_WAIT(3); p = __builtin_amdgcn_mfma_f32_32x32x16_bf16(a0, qr[0], p, 0, 0, 0); a0 = lds_read128<128>(kaddr);
    LGKM_WAIT(3); p = __builtin_amdgcn_mfma_f32_32x32x16_bf16(a1, qr[1], p, 0, 0, 0); a1 = lds_read128<160>(kaddr);
    LGKM_WAIT(3); p = __builtin_amdgcn_mfma_f32_32x32x16_bf16(a2, qr[2], p, 0, 0, 0); a2 = lds_read128<192>(kaddr);
    LGKM_WAIT(3); p = __builtin_amdgcn_mfma_f32_32x32x16_bf16(a3, qr[3], p, 0, 0, 0); a3 = lds_read128<224>(kaddr);
    LGKM_WAIT(3); p = __builtin_amdgcn_mfma_f32_32x32x16_bf16(a0, qr[4], p, 0, 0, 0); a0 = lds_read128<256>(kaddr);
    LGKM_WAIT(3); p = __builtin_amdgcn_mfma_f32_32x32x16_bf16(a1, qr[5], p, 0, 0, 0); a1 = lds_read128<288>(kaddr);
    LGKM_WAIT(3); p = __builtin_amdgcn_mfma_f32_32x32x16_bf16(a2, qr[6], p, 0, 0, 0); a2 = lds_read128<320>(kaddr);
    LGKM_WAIT(3); p = __builtin_amdgcn_mfma_f32_32x32x16_bf16(a3, qr[7], p, 0, 0, 0); a3 = lds_read128<352>(kaddr);
    LGKM_WAIT(3); p = __builtin_amdgcn_mfma_f32_32x32x16_bf16(a0, qr[8], p, 0, 0, 0);
    LGKM_WAIT(2); p = __builtin_amdgcn_mfma_f32_32x32x16_bf16(a1, qr[9], p, 0, 0, 0);
    LGKM_WAIT(1); p = __builtin_amdgcn_mfma_f32_32x32x16_bf16(a2, qr[10], p, 0, 0, 0);
    LGKM_WAIT(0); p = __builtin_amdgcn_mfma_f32_32x32x16_bf16(a3, qr[11], p, 0, 0, 0);
    return p;
}
__device__ __forceinline__ void att_finish(f32x16& s, float m, float& lsum, bf16x8& pb0, bf16x8& pb1) {
    float ps = 0.f;
#pragma unroll
    for (int r = 0; r < 16; ++r) { s[r] = __builtin_amdgcn_exp2f(s[r] - m); ps += s[r]; }
    lsum += xhalf_sum(ps);
    u32x4 w0 = {cvtpk(s[0], s[1]), cvtpk(s[2], s[3]), cvtpk(s[4], s[5]), cvtpk(s[6], s[7])};
    u32x4 w1 = {cvtpk(s[8], s[9]), cvtpk(s[10], s[11]), cvtpk(s[12], s[13]), cvtpk(s[14], s[15])};
    pb0 = __builtin_bit_cast(bf16x8, w0); pb1 = __builtin_bit_cast(bf16x8, w1);
}
__device__ __forceinline__ void att_pv(unsigned vaddr, bf16x8 pb0, bf16x8 pb1, f32x16 (&o)[4]) {
#define VOFF(d0, s, hi) (((16 * (s) + 8 * (hi)) * VP) + 64 * (d0))
    const s16x4 a00l = tr_read<VOFF(0, 0, 0)>(vaddr), a00h = tr_read<VOFF(0, 0, 1)>(vaddr), a01l = tr_read<VOFF(0, 1, 0)>(vaddr), a01h = tr_read<VOFF(0, 1, 1)>(vaddr);
    const s16x4 a10l = tr_read<VOFF(1, 0, 0)>(vaddr), a10h = tr_read<VOFF(1, 0, 1)>(vaddr), a11l = tr_read<VOFF(1, 1, 0)>(vaddr), a11h = tr_read<VOFF(1, 1, 1)>(vaddr);
    LGKM_WAIT(4);
    o[0] = __builtin_amdgcn_mfma_f32_32x32x16_bf16(PK8(a00l, a00h), pb0, o[0], 0, 0, 0); o[0] = __builtin_amdgcn_mfma_f32_32x32x16_bf16(PK8(a01l, a01h), pb1, o[0], 0, 0, 0);
    const s16x4 a20l = tr_read<VOFF(2, 0, 0)>(vaddr), a20h = tr_read<VOFF(2, 0, 1)>(vaddr), a21l = tr_read<VOFF(2, 1, 0)>(vaddr), a21h = tr_read<VOFF(2, 1, 1)>(vaddr);
    LGKM_WAIT(4);
    o[1] = __builtin_amdgcn_mfma_f32_32x32x16_bf16(PK8(a10l, a10h), pb0, o[1], 0, 0, 0); o[1] = __builtin_amdgcn_mfma_f32_32x32x16_bf16(PK8(a11l, a11h), pb1, o[1], 0, 0, 0);
    const s16x4 a30l = tr_read<VOFF(3, 0, 0)>(vaddr), a30h = tr_read<VOFF(3, 0, 1)>(vaddr), a31l = tr_read<VOFF(3, 1, 0)>(vaddr), a31h = tr_read<VOFF(3, 1, 1)>(vaddr);
    LGKM_WAIT(4);
    o[2] = __builtin_amdgcn_mfma_f32_32x32x16_bf16(PK8(a20l, a20h), pb0, o[2], 0, 0, 0); o[2] = __builtin_amdgcn_mfma_f32_32x32x16_bf16(PK8(a21l, a21h), pb1, o[2], 0, 0, 0);
    LGKM_WAIT(0);
    o[3] = __builtin_amdgcn_mfma_f32_32x32x16_bf16(PK8(a30l, a30h), pb0, o[3], 0, 0, 0); o[3] = __builtin_amdgcn_mfma_f32_32x32x16_bf16(PK8(a31l, a31h), pb1, o[3], 0, 0, 0);
#undef VOFF
}
__device__ __forceinline__ void att_partial(const f32x16& s, float& m, float& lsum, f32x16 (&o)[4]) {
    float pmax = s[0];
#pragma unroll
    for (int r = 1; r < 16; ++r) pmax = fmaxf(pmax, s[r]);
    pmax = xhalf_max(pmax);
    if (!__all(pmax - m <= ATT_THR)) {
        const float mn = fmaxf(m, pmax); const float alpha = __builtin_amdgcn_exp2f(m - mn); m = mn; lsum *= alpha;
#pragma unroll
        for (int d = 0; d < 4; ++d)
#pragma unroll
            for (int r = 0; r < 16; ++r) o[d][r] *= alpha;
    }
}

__device__ __forceinline__ void attn_unit(const Params& p, LAS unsigned char* lds, int head, int qb, int tid, int wave, int lane) {
    unsigned char* ws = p.ws;
    const bf16_t* Qh = (const bf16_t*)(ws + WS_QH); const bf16_t* Kh = (const bf16_t*)(ws + WS_KH);
    bf16_t* mix = (bf16_t*)(ws + WS_MIX);
    const int rg = wave & 3, kh = wave >> 2, r32 = lane & 31, hh = lane >> 5;
    const int q0row = qb * 128 + rg * 32;
    bf16x8 qr[12];
    {
        const bf16_t* qp = Qh + ((size_t)head * S + q0row + r32) * 192 + hh * 8;
#pragma unroll
        for (int ks = 0; ks < 12; ++ks) qr[ks] = *(const bf16x8*)(qp + ks * 16);
    }
    const int ntiles = 2 * qb + 2, mylast = 2 * qb + (rg >> 1);
    float m = -1e30f, lsum = 0.f; f32x16 o[4] = {};
    const int srow = tid >> 3, sch = tid & 7;
    const int kg0 = srow * 192 + sch * 8, kl0 = srow * KP + sch * 16, vg0 = srow * 2048 + sch * 8, vl0 = ATT_VOFF + srow * VP + sch * 16;
    const bf16_t* kbase = Kh + (size_t)head * S * 192; const bf16_t* vbase = (const bf16_t*)(ws + WS_KVRAW) + head * 256 + 128;
    u32x4 sk0, sk1, sk2, sv0, sv1;
#define ATT_LOAD(t) do { const bf16_t* kt = kbase + (size_t)(t) * 64 * 192 + kg0; const bf16_t* vt = vbase + (size_t)(t) * 64 * 2048 + vg0; \
        sk0 = *(const u32x4*)(kt); sk1 = *(const u32x4*)(kt + 64); sk2 = *(const u32x4*)(kt + 128); sv0 = *(const u32x4*)(vt); sv1 = *(const u32x4*)(vt + 64); } while (0)
#define ATT_WRITE(kb_, vb_) do { LAS unsigned char* bk = lds + (kb_) * ATT_KB + kl0; LAS unsigned char* bv = lds + (vb_) * ATT_VB + vl0; *(LAS u32x4*)(bk) = sk0; *(LAS u32x4*)(bk + 128) = sk1; *(LAS u32x4*)(bk + 256) = sk2; \
        *(LAS u32x4*)(bv) = sv0; *(LAS u32x4*)(bv + 128) = sv1; } while (0)
    const unsigned ldsbase = (unsigned)(size_t)lds;
    const unsigned kaddr0 = ldsbase + (unsigned)((32 * kh + r32) * KP + hh * 16);
    const unsigned vrel = (unsigned)(ATT_VOFF + (32 * kh + 4 * hh + ((lane & 15) >> 2)) * VP + (16 * ((lane >> 4) & 1) + 4 * (lane & 3)) * 2);
    ATT_LOAD(0); ATT_WRITE(0, 0); __syncthreads();
    bf16x8 pb0, pb1;
    const bool more0 = (1 < ntiles);
    if (more0) ATT_LOAD(1);
    f32x16 sprev = att_qk(kaddr0, qr);
    att_partial(sprev, m, lsum, o);
    if (more0) ATT_WRITE(1, 1);
    __syncthreads();
    int vprev = 0, vcur = 1;
#pragma unroll 1
    for (int t = 1; t <= ntiles; ++t) {
        const bool more = (t + 1 < ntiles);
        if (more) ATT_LOAD(t + 1);
        f32x16 sc;
        if (t <= mylast) sc = att_qk(kaddr0 + (t & 1) * ATT_KB, qr);
        else {
#pragma unroll
            for (int r = 0; r < 16; ++r) sc[r] = -1e30f;
        }
        att_finish(sprev, m, lsum, pb0, pb1);
        att_pv(ldsbase + vprev * ATT_VB + vrel, pb0, pb1, o);
        att_partial(sc, m, lsum, o);
        sprev = sc;
        const int vnext = (vcur == 2) ? 0 : vcur + 1;
        if (more) ATT_WRITE((t + 1) & 1, vnext);
        vprev = vcur; vcur = vnext;
        __syncthreads();
    }
#undef ATT_LOAD
#undef ATT_WRITE
    LAS float* scr = (LAS float*)lds + (size_t)rg * 66 * 64 + lane;
    if (kh == 1) {
        scr[0] = m; scr[64] = lsum;
#pragma unroll
        for (int d = 0; d < 4; ++d)
#pragma unroll
            for (int r = 0; r < 16; ++r) scr[(2 + d * 16 + r) * 64] = o[d][r];
    }
    __syncthreads();
    if (kh == 0) {
        const float m2 = scr[0], l2 = scr[64];
        const float mn = fmaxf(m, m2), a1 = __builtin_amdgcn_exp2f(m - mn), a2 = __builtin_amdgcn_exp2f(m2 - mn);
        const float inv = 1.0f / (lsum * a1 + l2 * a2);
        bf16_t* op = mix + (size_t)(q0row + r32) * DM + 1024 + head * 128 + 4 * hh;
#pragma unroll
        for (int d = 0; d < 4; ++d)
#pragma unroll
            for (int g4 = 0; g4 < 4; ++g4) {
                float v[4];
#pragma unroll
                for (int i = 0; i < 4; ++i) { const int r = 4 * g4 + i; v[i] = (o[d][r] * a1 + scr[(2 + d * 16 + r) * 64] * a2) * inv; }
                u32x2 w; w.x = pk2(v[0], v[1]); w.y = pk2(v[2], v[3]);
                *(u32x2*)(op + 32 * d + 8 * g4) = w;
            }
    }
    __syncthreads();
}

__device__ __forceinline__ void gmlp_unit(const Params& p, LAS unsigned char* lds, int nb, int h, int tid, int wave, int lane) {
    unsigned char* ws = p.ws;
    const bf16_t* proj = (const bf16_t*)(ws + WS_PROJ); bf16_t* mix = (bf16_t*)(ws + WS_MIX);
    const float* ssv = (const float*)(ws + WS_ROWSS);
    const float* vg = p.in[3]; const float* wsp = p.in[4]; const float* bs = p.in[5];
#pragma unroll
    for (int i = 0; i < 4; ++i) {
        const int pc = tid + 512 * i, r = pc >> 4, c = pc & 15, t = nb * 128 + r;
        const u32x4 w = *(const u32x4*)(proj + (size_t)t * NINP + 1024 + h * 128 + c * 8);
        const float rs = rsqrtf(ssv[t] * (1.0f / 1024.0f) + EPS);
        const f32x4 g0 = *(const f32x4*)(vg + h * 128 + c * 8), g1 = *(const f32x4*)(vg + h * 128 + c * 8 + 4);
        u32x4 ov;
        ov.x = pk2(bflo(w.x) * rs * g0[0], bfhi(w.x) * rs * g0[1]); ov.y = pk2(bflo(w.y) * rs * g0[2], bfhi(w.y) * rs * g0[3]);
        ov.z = pk2(bflo(w.z) * rs * g1[0], bfhi(w.z) * rs * g1[1]); ov.w = pk2(bflo(w.w) * rs * g1[2], bfhi(w.w) * rs * g1[3]);
        *(LAS u32x4*)(lds + r * VP + c * 16) = ov;
    }
    __syncthreads();
    const int ib = wave & 3, ch = wave >> 2, r32 = lane & 31, hh = lane >> 5;
    const int irow = 32 * ib + r32;
    f32x16 acc0 = {}, acc1 = {};
    const unsigned vaddr = (unsigned)(size_t)lds + (unsigned)((8 * hh + ((lane & 15) >> 2)) * VP + (64 * ch + 16 * ((lane >> 4) & 1) + 4 * (lane & 3)) * 2);
    const float* wrow = wsp + ((size_t)h * 128 + irow) * 128 + hh * 8;
#define GSTEP(s) do { if ((s) < 2 * (ib + 1)) { \
        const f32x4 wa = *(const f32x4*)(wrow + (s) * 16), wb = *(const f32x4*)(wrow + (s) * 16 + 4); const int j0 = (s) * 16 + hh * 8; \
        u32x4 aw; aw.x = pk2(j0 + 0 <= irow ? wa[0] : 0.f, j0 + 1 <= irow ? wa[1] : 0.f); aw.y = pk2(j0 + 2 <= irow ? wa[2] : 0.f, j0 + 3 <= irow ? wa[3] : 0.f); \
        aw.z = pk2(j0 + 4 <= irow ? wb[0] : 0.f, j0 + 5 <= irow ? wb[1] : 0.f); aw.w = pk2(j0 + 6 <= irow ? wb[2] : 0.f, j0 + 7 <= irow ? wb[3] : 0.f); \
        const bf16x8 af = __builtin_bit_cast(bf16x8, aw); \
        const s16x4 b0l = tr_read<(16 * (s)) * VP>(vaddr), b0h = tr_read<(16 * (s) + 4) * VP>(vaddr), b1l = tr_read<(16 * (s)) * VP + 64>(vaddr), b1h = tr_read<(16 * (s) + 4) * VP + 64>(vaddr); \
        LDS_WAIT(); SBAR(); \
        acc0 = __builtin_amdgcn_mfma_f32_32x32x16_bf16(af, PK8(b0l, b0h), acc0, 0, 0, 0); acc1 = __builtin_amdgcn_mfma_f32_32x32x16_bf16(af, PK8(b1l, b1h), acc1, 0, 0, 0); } } while (0)
    GSTEP(0); GSTEP(1); GSTEP(2); GSTEP(3); GSTEP(4); GSTEP(5); GSTEP(6); GSTEP(7);
#undef GSTEP
#pragma unroll
    for (int r = 0; r < 16; ++r) {
        const int i = 32 * ib + crow(r, hh), t = nb * 128 + i; const float b = bs[h * 128 + i];
        const int c0 = h * 128 + 64 * ch + r32;
        const float u0 = bf2f(proj[(size_t)t * NINP + c0]), u1 = bf2f(proj[(size_t)t * NINP + c0 + 32]);
        mix[(size_t)t * DM + c0] = (bf16_t)f2bf(u0 * (acc0[r] + b)); mix[(size_t)t * DM + c0 + 32] = (bf16_t)f2bf(u1 * (acc1[r] + b));
    }
    __syncthreads();
}

__device__ __forceinline__ void phase7(const Params& p, LAS unsigned char* lds, int gw, int NGW, int wave, int lane) {
    unsigned char* ws = p.ws;
    const float* sc = (const float*)(ws + WS_SC); int* ex = (int*)(ws + WS_EXP); float* gt = (float*)(ws + WS_GATE);
    const float NEG = -3.0e38f;
    LAS float* sl = (LAS float*)(lds + wave * 1024);
    const int j8 = lane & 7, g8 = lane >> 3, row = lane >> 4, i16 = lane & 15;
    int ci[4], cj[4]; bool cval[4];
    {
        constexpr int starts[16] = {0, 16, 24, 29, 33, 36, 38, 40, 42, 43, 44, 45, 46, 47, 48, 49};
#pragma unroll
        for (int m = 0; m < 4; ++m) {
            const int c = i16 + 16 * m; int a = 0, st = 0;
#pragma unroll
            for (int i = 1; i < 16; ++i) if (c >= starts[i]) { a = i; st = starts[i]; }
            cval[m] = c < 50; ci[m] = cval[m] ? a : 0; cj[m] = cval[m] ? (c - st) : 0;
        }
    }
    f32x4 nx0, nx1, nx2, nx3;
    if (gw < S / 4) { const float* b = sc + (size_t)(gw * 4) * DM + lane * 16; nx0 = *(const f32x4*)b; nx1 = *(const f32x4*)(b + 4); nx2 = *(const f32x4*)(b + 8); nx3 = *(const f32x4*)(b + 12); }
    for (int tb = gw; tb < S / 4; tb += NGW)
#pragma unroll 1
    for (int n8 = 0; n8 < 8; ++n8) {
        const int it = tb * 8 + n8;
        const int t = it >> 1, hh = it & 1;
        float v[16];
#pragma unroll
        for (int q = 0; q < 4; ++q) { v[q] = nx0[q]; v[4 + q] = nx1[q]; v[8 + q] = nx2[q]; v[12 + q] = nx3[q]; }
        { const int it2 = n8 < 7 ? it + 1 : (tb + NGW) * 8;
          if (it2 < S * 2) { const float* b = sc + (size_t)(it2 >> 1) * DM + (it2 & 1) * 1024 + lane * 16;
            nx0 = *(const f32x4*)b; nx1 = *(const f32x4*)(b + 4); nx2 = *(const f32x4*)(b + 8); nx3 = *(const f32x4*)(b + 12); } }
#pragma unroll
        for (int m = 0; m < 16; ++m) v[m] = __builtin_bit_cast(float, (__builtin_bit_cast(unsigned, v[m]) & ~127u) | (unsigned)(16 * j8 + m));
#define P7_CE(A, B) do { const float hi_ = fmaxf(v[A], v[B]), lo_ = fminf(v[A], v[B]); v[A] = hi_; v[B] = lo_; } while (0)
        P7_CE(0, 13); P7_CE(1, 12); P7_CE(2, 15); P7_CE(3, 14); P7_CE(4, 8); P7_CE(5, 6); P7_CE(7, 11); P7_CE(9, 10);
        P7_CE(0, 5); P7_CE(1, 7); P7_CE(2, 9); P7_CE(3, 4); P7_CE(6, 13); P7_CE(8, 14); P7_CE(10, 15); P7_CE(11, 12);
        P7_CE(0, 1); P7_CE(2, 3); P7_CE(4, 5); P7_CE(6, 8); P7_CE(7, 9); P7_CE(10, 11); P7_CE(12, 13); P7_CE(14, 15);
        P7_CE(0, 2); P7_CE(1, 3); P7_CE(4, 10); P7_CE(5, 11); P7_CE(6, 7); P7_CE(8, 9); P7_CE(12, 14); P7_CE(13, 15);
        P7_CE(1, 2); P7_CE(3, 12); P7_CE(4, 6); P7_CE(5, 7); P7_CE(8, 10); P7_CE(9, 11); P7_CE(13, 14);
        P7_CE(1, 4); P7_CE(2, 6); P7_CE(5, 8); P7_CE(7, 10); P7_CE(9, 13); P7_CE(11, 14);
        P7_CE(2, 4); P7_CE(3, 6); P7_CE(9, 12); P7_CE(11, 13);
        P7_CE(3, 5); P7_CE(6, 8); P7_CE(7, 9); P7_CE(10, 12);
        P7_CE(3, 4); P7_CE(5, 6); P7_CE(7, 8); P7_CE(9, 10); P7_CE(11, 12);
        P7_CE(6, 7); P7_CE(8, 9);
#define P7_MERGE(CTRL) do { float t_[16]; \
            _Pragma("unroll") for (int i = 0; i < 16; ++i) t_[i] = fmaxf(v[i], dpp_f<CTRL, 0xf>(v[15 - i], v[15 - i])); \
            _Pragma("unroll") for (int i = 0; i < 16; ++i) v[i] = t_[i]; \
            _Pragma("unroll") for (int j = 8; j >= 1; j >>= 1) _Pragma("unroll") for (int i = 0; i < 16; ++i) if ((i & j) == 0) P7_CE(i, i + j); } while (0)
        P7_MERGE(0xB1); P7_MERGE(0x4E); P7_MERGE(0x141);
#undef P7_MERGE
#undef P7_CE
        if (j8 == 0) {
#pragma unroll
            for (int q = 0; q < 4; ++q) *(LAS f32x4*)(sl + g8 * 16 + 4 * q) = (f32x4){v[4 * q], v[4 * q + 1], v[4 * q + 2], v[4 * q + 3]};
        }
        LDS_WAIT(); asm volatile("" ::: "memory");
        float cv[4], og[4]; int id[4];
#pragma unroll
        for (int m = 0; m < 4; ++m) {
            const float s1 = sl[(2 * row) * 16 + ci[m]], s2 = sl[(2 * row + 1) * 16 + cj[m]];
            og[m] = cval[m] ? (s1 + s2) : NEG; cv[m] = og[m];
            id[m] = (int)((__builtin_bit_cast(unsigned, s1) & 127u) * 128u + (__builtin_bit_cast(unsigned, s2) & 127u));
        }
        LDS_WAIT(); asm volatile("" ::: "memory");
        float M0 = 0.f;
#pragma unroll
        for (int k = 0; k < 16; ++k) {
            float mx = fmaxf(fmaxf(cv[0], cv[1]), fmaxf(cv[2], cv[3]));
            mx = fmaxf(mx, dpp_f<0xB1, 0xf>(mx, mx));
            mx = fmaxf(mx, dpp_f<0x4E, 0xf>(mx, mx));
            mx = fmaxf(mx, dpp_f<0x141, 0xf>(mx, mx));
            mx = fmaxf(mx, dpp_f<0x140, 0xf>(mx, mx));
            if (k == 0) M0 = mx;
#pragma unroll
            for (int m = 0; m < 4; ++m) cv[m] = (cv[m] == mx) ? NEG : cv[m];
        }
        bool sel[4]; float e[4]; float es = 0.f;
#pragma unroll
        for (int m = 0; m < 4; ++m) { sel[m] = (cv[m] != og[m]); e[m] = sel[m] ? __expf(og[m] - M0) : 0.f; es += e[m]; }
        es += dpp_f<0xB1, 0xf>(0.f, es); es += dpp_f<0x4E, 0xf>(0.f, es); es += dpp_f<0x141, 0xf>(0.f, es); es += dpp_f<0x140, 0xf>(0.f, es);
        const float inv = 1.0f / es;
        int basepos = 0;
        const int head = 4 * hh + row;
#pragma unroll
        for (int m = 0; m < 4; ++m) {
            const unsigned long long bl = __ballot(sel[m]);
            const unsigned rbits = (unsigned)(bl >> (16 * row)) & 0xffffu;
            const int pos = basepos + __popc(rbits & ((1u << i16) - 1u));
            if (sel[m] && pos < 16) { ex[(size_t)t * 128 + head * 16 + pos] = id[m]; gt[(size_t)t * 128 + head * 16 + pos] = e[m] * inv; }
            basepos += __popc(rbits);
        }
    }
}

typedef __bf16 bf16x32v __attribute__((ext_vector_type(32)));
typedef __bf16 bf16x2v __attribute__((ext_vector_type(2)));
typedef float f32x2 __attribute__((ext_vector_type(2)));
#ifndef P8_THROTTLE
#define P8_THROTTLE 0
#endif
constexpr unsigned P8_SLACK = 12;
#ifndef P8_SWEEPSYNC
#define P8_SWEEPSYNC 1
#endif
#ifndef P8_MIDSYNC
#define P8_MIDSYNC 2
#endif
__device__ __forceinline__ void phase8(const Params& p, LAS unsigned char* lds, float* dst, const XcdBarrier& xb, int gw, int NGW, int wave, int lane) {
    unsigned char* ws = p.ws;
    const bf16_t* x1b = (const bf16_t*)(ws + WS_X1B); const unsigned char* UT = ws + WS_UT; const unsigned char* VT = ws + WS_VT;
    const int* ex = (const int*)(ws + WS_EXP); const float* gt = (const float*)(ws + WS_GATE); const float* ss2 = (const float*)(ws + WS_ROWSS) + 3 * S;
    const float* out = p.out;
    LAS unsigned* list = (LAS unsigned*)(lds + 131072 + wave * 2048);
    LAS unsigned* hist = (LAS unsigned*)(lds + 147456 + wave * 1024);
    for (int tb = gw; tb < S / 4; tb += NGW) {
        const int t0 = tb * 4;
        int id[8]; float gv[8];
#pragma unroll
        for (int r = 0; r < 8; ++r) { const size_t o = (size_t)(t0 + (r >> 1)) * 128 + (r & 1) * 64 + lane; id[r] = ex[o]; gv[r] = gt[o]; }
        const float rs0 = rsqrtf(ss2[t0 + 0] * (1.0f / DM) + EPS) * (1.0f / PEER_USC), rs1 = rsqrtf(ss2[t0 + 1] * (1.0f / DM) + EPS) * (1.0f / PEER_USC);
        const float rs2 = rsqrtf(ss2[t0 + 2] * (1.0f / DM) + EPS) * (1.0f / PEER_USC), rs3 = rsqrtf(ss2[t0 + 3] * (1.0f / DM) + EPS) * (1.0f / PEER_USC);
#pragma unroll
        for (int j = 0; j < 4; ++j) hist[j * 64 + lane] = 0u;
        LDS_WAIT(); asm volatile("" ::: "memory");
        unsigned pos[8];
#pragma unroll
        for (int r = 0; r < 8; ++r) pos[r] = __hip_atomic_fetch_add(hist + (r >> 1) * 64 + (id[r] >> 8), 1u, __ATOMIC_RELAXED, __HIP_MEMORY_SCOPE_WORKGROUP);
        LDS_WAIT(); asm volatile("" ::: "memory");
        unsigned cnt[4], inc[4];
#pragma unroll
        for (int j = 0; j < 4; ++j) { cnt[j] = hist[j * 64 + lane]; inc[j] = cnt[j]; }
#pragma unroll
        for (int o = 1; o < 64; o <<= 1)
#pragma unroll
            for (int j = 0; j < 4; ++j) { const unsigned n = __shfl_up(inc[j], o); if (lane >= o) inc[j] += n; }
        LDS_WAIT(); asm volatile("" ::: "memory");
#pragma unroll
        for (int j = 0; j < 4; ++j) hist[j * 64 + lane] = inc[j] - cnt[j];
        LDS_WAIT(); asm volatile("" ::: "memory");
#pragma unroll
        for (int r = 0; r < 8; ++r) { const unsigned d = hist[(r >> 1) * 64 + (id[r] >> 8)] + pos[r]; list[4u * d + (unsigned)(r >> 1)] = (unsigned)id[r] | ((unsigned)(r >> 1) << 14) | (f2bf(gv[r]) << 16); }
        LDS_WAIT(); asm volatile("" ::: "memory");
        {
            typedef unsigned u32x16 __attribute__((ext_vector_type(16)));
            const __amdgpu_buffer_rsrc_t urs = __builtin_amdgcn_make_buffer_rsrc((void*)UT, 0, 16384 * PEER_ROWB, 0x00020000);
            const int vo4 = lane * 16, vo2 = lane * 8 + 1024;
            const bool lb0 = (lane & 1) != 0, lb1 = (lane & 2) != 0, lb2 = (lane & 4) != 0;
            s16x4 xr[4][8];
#pragma unroll
            for (int j = 0; j < 4; ++j)
#pragma unroll
                for (int q = 0; q < 8; ++q) xr[j][q] = __builtin_bit_cast(s16x4, *(const u32x2*)(x1b + (size_t)(t0 + j) * DM + (q * 64 + lane) * 4));
#define P8_ULOAD(k, i) do { const unsigned en = (unsigned)__builtin_amdgcn_readfirstlane((int)list[(i)]); const int ro = (int)((en & 0x3fffu) * (unsigned)PEER_ROWB); \
            u4[k] = __builtin_amdgcn_raw_buffer_load_b128(urs, vo4, ro, 0); u2[k] = __builtin_amdgcn_raw_buffer_load_b64(urs, vo2, ro, 0); } while (0)
#define P8_UPROC2(k, dk) do { const u32x6 pk = {u4[k][0], u4[k][1], u4[k][2], u4[k][3], u2[k][0], u2[k][1]}; \
            const u32x16 r_ = __builtin_bit_cast(u32x16, __builtin_amdgcn_cvt_scalef32_pk32_bf16_fp6(pk, 1.0f)); \
            f32x4 a0 = {0.f, 0.f, 0.f, 0.f}, a1 = {0.f, 0.f, 0.f, 0.f}; \
            _Pragma("unroll") for (int q = 0; q < 8; q += 2) { \
                a0 = __builtin_amdgcn_mfma_f32_4x4x4bf16_1k(__builtin_bit_cast(s16x4, (u32x2){r_[2 * q], r_[2 * q + 1]}), xr[(k) & 3][q], a0, 0, 0, 0); \
                a1 = __builtin_amdgcn_mfma_f32_4x4x4bf16_1k(__builtin_bit_cast(s16x4, (u32x2){r_[2 * q + 2], r_[2 * q + 3]}), xr[(k) & 3][q + 1], a1, 0, 0, 0); } \
            const f32x4 a_ = a0 + a1; \
            const float e0 = lb0 ? a_[1] : a_[0], e1 = lb0 ? a_[3] : a_[2]; dd[dk] = lb1 ? e1 : e0; } while (0)
#ifndef P8_URING
#define P8_URING 8
#endif
#if (PROBE_DUP >> 10) & 1
#define P8_UREPS 2
#else
#define P8_UREPS 1
#endif
#pragma unroll 1
            for (int urep = 0; urep < P8_UREPS; ++urep) {
                u32x4 u4[P8_URING]; u32x2 u2[P8_URING];
#pragma unroll
                for (int k = 0; k < P8_URING; ++k) P8_ULOAD(k, k);
#pragma unroll 1
                for (int i0 = 0; i0 < 512; i0 += P8_URING) {
                    if (P8_SWEEPSYNC && i0 == 256 && NGW == S / 4) xcd_local_barrier(xb);
#pragma unroll
                    for (int hb = 0; hb < P8_URING / 8; ++hb) {
                        const int i = i0 + 8 * hb;
                        const unsigned ev = list[i + (lane & 7)]; const unsigned jl = (unsigned)lane & 3u;
                        const float gl = __builtin_bit_cast(float, ev & 0xffff0000u), rl = jl == 0u ? rs0 : (jl == 1u ? rs1 : (jl == 2u ? rs2 : rs3));
                        float dd[8];
#pragma unroll
                        for (int k = 0; k < 8; ++k) { P8_UPROC2(8 * hb + k, k); const int nx = i + P8_URING + k; P8_ULOAD(8 * hb + k, nx < 512 ? nx : 508 + (k & 3)); }
                        float w4[4], w2[2];
#pragma unroll
                        for (int q = 0; q < 4; ++q) { const float kp = lb2 ? dd[q + 4] : dd[q], sd = lb2 ? dd[q] : dd[q + 4]; w4[q] = kp + __shfl_xor(sd, 4); }
#pragma unroll
                        for (int q = 0; q < 2; ++q) { const float kp = lb1 ? w4[q + 2] : w4[q], sd = lb1 ? w4[q] : w4[q + 2]; w2[q] = kp + __shfl_xor(sd, 2); }
                        float dres; { const float kp = lb0 ? w2[1] : w2[0], sd = lb0 ? w2[0] : w2[1]; dres = kp + __shfl_xor(sd, 1); }
                        dres += __shfl_xor(dres, 8); dres += __shfl_xor(dres, 16); dres += __shfl_xor(dres, 32);
                        const float c_ = gl * gelu_tanh(rl * dres) * (1.0f / PEER_VSC);
                        if (lane < 8 && urep == P8_UREPS - 1) list[i + lane] = (ev & 0xffffu) | (f2bf(c_) << 16);
                    }
                }
            }
#undef P8_ULOAD
#undef P8_UPROC2
        }
        asm volatile("s_waitcnt vmcnt(0)" ::: "memory");
        LDS_WAIT(); asm volatile("" ::: "memory");
#if P8_MIDSYNC == 1
        __syncthreads();
#elif P8_MIDSYNC == 2
        if (NGW == S / 4) xcd_local_barrier(xb);
#endif
        f32x4 acc[4][8];
#if (PROBE_DUP >> 12) & 1
#define P8_VREPS 2
#else
#define P8_VREPS 1
#endif
#ifndef P8_VRING
#define P8_VRING 8
#endif
#pragma unroll 1
        for (int vrep = 0; vrep < P8_VREPS; ++vrep) {
#pragma unroll
        for (int j = 0; j < 4; ++j)
#pragma unroll
            for (int q = 0; q < 8; ++q) acc[j][q] = (f32x4){0.f, 0.f, 0.f, 0.f};
        {
            typedef unsigned u32x16 __attribute__((ext_vector_type(16)));
            u32x4 v4[P8_VRING]; u32x2 v2[P8_VRING]; unsigned ven[P8_VRING];
            const unsigned li = (unsigned)lane & 3u;
            const unsigned m0 = li == 0u ? 0x0000ffffu : (li == 1u ? 0xffff0000u : 0u), m1 = li == 2u ? 0x0000ffffu : (li == 3u ? 0xffff0000u : 0u);
            const __amdgpu_buffer_rsrc_t vrs = __builtin_amdgcn_make_buffer_rsrc((void*)VT, 0, 16384 * PEER_ROWB, 0x00020000);
            const int vo4 = lane * 16, vo2 = lane * 8 + 1024;
#define P8_VLOAD(k, i) do { const unsigned en = (unsigned)__builtin_amdgcn_readfirstlane((int)list[(i)]); ven[k] = en; const int ro = (int)((en & 0x3fffu) * (unsigned)PEER_ROWB); \
            v4[k] = __builtin_amdgcn_raw_buffer_load_b128(vrs, vo4, ro, 0); v2[k] = __builtin_amdgcn_raw_buffer_load_b64(vrs, vo2, ro, 0); } while (0)
#define P8_VPROC(k) do { const u32x6 pk = {v4[k][0], v4[k][1], v4[k][2], v4[k][3], v2[k][0], v2[k][1]}; \
            const u32x16 r_ = __builtin_bit_cast(u32x16, __builtin_amdgcn_cvt_scalef32_pk32_bf16_fp6(pk, 1.0f)); \
            const unsigned e_ = ven[k], cf = (e_ >> 16) | (e_ & 0xffff0000u); \
            const s16x4 av = __builtin_bit_cast(s16x4, (u32x2){cf & m0, cf & m1}); \
            _Pragma("unroll") for (int q = 0; q < 8; ++q) \
                acc[(k) & 3][q] = __builtin_amdgcn_mfma_f32_4x4x4bf16_1k(av, __builtin_bit_cast(s16x4, (u32x2){r_[2 * q], r_[2 * q + 1]}), acc[(k) & 3][q], 0, 0, 0); } while (0)
#pragma unroll
            for (int k = 0; k < P8_VRING; ++k) P8_VLOAD(k, k);
#pragma unroll 1
            for (int i = 0; i < 512 - 512 % P8_VRING; i += P8_VRING) {
                if (P8_SWEEPSYNC && i == 256 && NGW == S / 4) xcd_local_barrier(xb);
#pragma unroll
                for (int k = 0; k < P8_VRING; ++k) { P8_VPROC(k); const int nx = i + P8_VRING + k; P8_VLOAD(k, nx < 512 ? nx : 508 + (k & 3)); }
            }
#pragma unroll
            for (int k = 0; k < 512 % P8_VRING; ++k) P8_VPROC(k);
#undef P8_VLOAD
#undef P8_VPROC
        }
        }
        int tq = t0, lq = lane; asm volatile("" : "+s"(tq)); asm volatile("" : "+v"(lq));
#pragma unroll
        for (int j = 0; j < 4; ++j)
#pragma unroll
            for (int i = 0; i < 8; ++i) {
                const size_t o = (size_t)(tq + j) * DM + (i * 64 + lq) * 4;
                const u32x2 xw = *(const u32x2*)(x1b + o);
                f32x4 a = {bflo(xw.x), bfhi(xw.x), bflo(xw.y), bfhi(xw.y)};
                a += acc[j][i];
                *(f32x4*)(dst + o) = a;
                if (i & 1) asm volatile("" ::: "memory");
            }
        LDS_WAIT(); asm volatile("" ::: "memory");
    }
}

__global__ void __launch_bounds__(NTHREADS, 2) mega(Params p) {
    extern __shared__ __attribute__((aligned(16))) unsigned char lds_raw[];
    LAS unsigned char* lds = (LAS unsigned char*)lds_raw;
    const int tid = threadIdx.x, lane = tid & 63, wave = __builtin_amdgcn_readfirstlane(tid >> 6);
    const int G = gridDim.x, bx = blockIdx.x;
    const int gw = bx * 8 + wave, NGW = G * 8;
    unsigned char* ws = p.ws;
    const int lo = p.ph_lo, hi = p.ph_hi;
    volatile LAS unsigned* misc = (volatile LAS unsigned*)(lds + LDS_MISC);
    if (tid < 4) misc[tid] = 0u;
    __syncthreads();
    const XcdBarrier xbar = xcd_barrier_post((unsigned*)(ws + WS_CTL), misc);
#ifndef PH_MASK
#define PH_MASK 0x1ff
#endif
#define IN(k) (((PH_MASK >> (k)) & 1) && lo <= (k) && (k) < hi)
#define SEAM(k) do { if (IN(k) && IN((k) + 1)) xcd_barrier(xbar); } while (0)

#if (PROBE_DUP >> 0) & 1
    if (IN(0)) { phase0(p, lds, G == 256, gw, NGW, wave, lane); xcd_barrier(xbar); }
#endif
    if (IN(0)) phase0(p, lds, G == 256, gw, NGW, wave, lane);
    SEAM(0);
    const bool part = (G == 256) && (misc[2] != 0u);
    const int vx = __builtin_amdgcn_readfirstlane(part ? (int)xbar.x : (bx & 7)), vr = __builtin_amdgcn_readfirstlane(part ? (int)misc[3] : (bx >> 3));
    const int vpanel = (vr >> 3) == 0 ? vx : ((vr >> 3) == 1 ? 31 - vx : ((vr >> 3) == 2 ? vx + 8 : 23 - vx));
    const int gwv = (G == 256) ? vpanel * 64 + (vr & 7) * 8 + wave : gw;
#define SEAM_X(k) do { if (IN(k) && IN((k) + 1)) { if (part) xcd_local_barrier_acq(xbar); else xcd_barrier(xbar); } } while (0)
    if (IN(1)) {
        pg8::Gemm g{(const bf16_t*)(ws + WS_XB), (const bf16_t*)(ws + WS_WIN), S, NINP, DM, DM, DM};
        pg8::StaticOrder So; So.init(S, NINP, G, bx);
        pg8::Epi<1> E{(const float*)(ws + WS_RSTD1), 0.f, (float*)(ws + WS_ROWSS), (bf16_t*)(ws + WS_PROJ), NINP, nullptr, nullptr};
#if (PROBE_DUP >> 1) & 1
        { pg8::Epi<1> E2 = E; E2.ss = (float*)(ws + 512 * 1024); pg8::gemm_phase<pg8::Epi<1>, pg8::StaticOrder, true, true>(lds, g, So, E2); xcd_barrier(xbar); }
#endif
        pg8::gemm_phase<pg8::Epi<1>, pg8::StaticOrder, true, true>(lds, g, So, E);
        if (G == 256 && bx >= 128) { __syncthreads(); prep_late(p, lds, (bx - 128) * 8 + wave, 1024, wave, lane); }
    }
    SEAM(1);
    if (IN(2)) {
        {
            pg8::Gemm g{(const bf16_t*)(ws + WS_PROJ) + 2048, (const bf16_t*)(ws + WS_WUQ), S, 1536, 512, NINP, 512};
            pg8::StaticOrder So; So.init(S, 1536, G, bx);
            pg8::Epi<2> E{(const float*)(ws + WS_ROWSS) + 1 * S, 1.0f / 512.0f, nullptr, (bf16_t*)(ws + WS_QRAW), 1536, nullptr, nullptr};
            pg8::gemm_phase<pg8::Epi<2>, pg8::StaticOrder, true, true>(lds, g, So, E);
        }
        __syncthreads();
        {
            pg8::Gemm g{(const bf16_t*)(ws + WS_PROJ) + 2560, (const bf16_t*)(ws + WS_WUKV), S, 2048, 256, NINP, 256};
            pg8::StaticOrder So; So.init(S, 2048, G, bx);
            pg8::Epi<2> E{(const float*)(ws + WS_ROWSS) + 2 * S, 1.0f / 256.0f, nullptr, (bf16_t*)(ws + WS_KVRAW), 2048, nullptr, nullptr};
            pg8::gemm_phase<pg8::Epi<2>, pg8::StaticOrder, true, true>(lds, g, So, E);
        }
    }
    SEAM(2);
#if (PROBE_DUP >> 3) & 1
    if (IN(3)) { phase3(p, gw, NGW, (S - gw + NGW - 1) / NGW, lane); xcd_barrier(xbar); }
#endif
    if (IN(3)) phase3(p, gw, NGW, (S - gw + NGW - 1) / NGW, lane);
    SEAM(3);
    const int vP = (vr >> 4) ? vx + 8 : vx, vqa = ((vr >> 3) & 1) ? 62 - 2 * vP : 63 - 2 * vP, vqb = ((vr >> 3) & 1) ? 2 * vP + 1 : 2 * vP;
#define P4_BODY_ATT do { if (G == 256) { attn_unit(p, lds, vr & 7, vqa, tid, wave, lane); attn_unit(p, lds, vr & 7, vqb, tid, wave, lane); } \
        else for (int pr = bx; pr < 256; pr += G) { const int head = pr & 7, x = pr >> 3; attn_unit(p, lds, head, 63 - x, tid, wave, lane); attn_unit(p, lds, head, x, tid, wave, lane); } } while (0)
#define P4_BODY_GMLP do { if (G == 256) { gmlp_unit(p, lds, vqa, vr & 7, tid, wave, lane); gmlp_unit(p, lds, vqb, vr & 7, tid, wave, lane); } \
        else for (int u = bx; u < 512; u += G) gmlp_unit(p, lds, u >> 3, u & 7, tid, wave, lane); } while (0)
#if (PROBE_DUP >> 4) & 1
    if (IN(4)) { P4_BODY_ATT; xcd_barrier(xbar); }
#endif
#if (PROBE_DUP >> 9) & 1
    if (IN(4)) { P4_BODY_GMLP; xcd_barrier(xbar); }
#endif
    if (IN(4)) { P4_BODY_ATT; P4_BODY_GMLP; }
    SEAM_X(4);
    if (IN(5)) {
        pg8::Gemm g{(const bf16_t*)(ws + WS_MIX), (const bf16_t*)(ws + WS_WOUT), S, DM, DM, DM, DM};
        pg8::StaticOrder So; So.init(S, DM, G, bx); if (G == 256) So.fixed(vpanel, vr & 7);
        pg8::Epi<4> E{nullptr, 0.f, (float*)(ws + WS_ROWSS) + 3 * S, (bf16_t*)(ws + WS_X1B), DM, p.out, p.in[0]};
#if (PROBE_DUP >> 5) & 1
        { pg8::Epi<4> E2 = E; E2.ss = (float*)(ws + 512 * 1024); pg8::gemm_phase<pg8::Epi<4>, pg8::StaticOrder, true, true>(lds, g, So, E2); xcd_barrier(xbar); }
#endif
        pg8::gemm_phase<pg8::Epi<4>, pg8::StaticOrder, true, true>(lds, g, So, E);
    }
    SEAM_X(5);
    if (IN(6)) {
        pg8::Gemm g{(const bf16_t*)(ws + WS_X1B), (const bf16_t*)(ws + WS_WS), S, DM, DM, DM, DM};
        pg8::StaticOrder So; So.init(S, DM, G, bx); if (G == 256) So.fixed(vpanel, vr & 7);
        pg8::Epi<5> E{(const float*)(ws + WS_ROWSS) + 3 * S, 1.0f / DM, nullptr, nullptr, DM, (float*)(ws + WS_SC), nullptr};
#if (PROBE_DUP >> 6) & 1
        { pg8::gemm_phase<pg8::Epi<5>, pg8::StaticOrder, true, true>(lds, g, So, E); xcd_barrier(xbar); }
#endif
        pg8::gemm_phase<pg8::Epi<5>, pg8::StaticOrder, true, true>(lds, g, So, E);
    }
    SEAM_X(6);
#if (PROBE_DUP >> 7) & 1
    if (IN(7)) { phase7(p, lds, gwv, NGW, wave, lane); xcd_barrier(xbar); }
#endif
    if (IN(7)) phase7(p, lds, gwv, NGW, wave, lane);
    if (IN(7) && IN(8)) { if (NGW == S / 4) xcd_local_barrier(xbar); else xcd_barrier(xbar); }
#if (PROBE_DUP >> 8) & 1
    if (IN(8)) { phase8(p, lds, (float*)(ws + WS_SC), xbar, gwv, NGW, wave, lane); xcd_barrier(xbar); }
#endif
    if (IN(8)) phase8(p, lds, p.out, xbar, gwv, NGW, wave, lane);
#undef IN
#undef SEAM
#undef SEAM_X
}

extern "C" void kernel_launch(void* const* d_in, const int* in_sizes, int n_in, void* d_out, int out_size, void* d_ws, size_t ws_size, hipStream_t stream) {
    static int grid = 0;
    if (grid == 0) {
        if (n_in != 18 || out_size != S * DM || ws_size < WS_END) { fprintf(stderr, "kernel_launch: unexpected shapes (n_in %d out %d ws %zu)\n", n_in, out_size, ws_size); grid = -1; return; }
        int dev = 0, cus = 0, per_cu = 0;
        hipGetDevice(&dev);
        hipDeviceGetAttribute(&cus, hipDeviceAttributeMultiprocessorCount, dev);
        if (hipFuncSetAttribute((const void*)mega, hipFuncAttributeMaxDynamicSharedMemorySize, LDS_BYTES) != hipSuccess) { fprintf(stderr, "kernel_launch: hipFuncSetAttribute failed\n"); grid = -1; return; }
        if (hipOccupancyMaxActiveBlocksPerMultiprocessor(&per_cu, (const void*)mega, NTHREADS, LDS_BYTES) != hipSuccess || per_cu < 1) { fprintf(stderr, "kernel_launch: occupancy query failed (%d)\n", per_cu); grid = -1; return; }
        grid = cus;
        fprintf(stderr, "kernel_launch: cus %d per_cu %d grid %d\n", cus, per_cu, grid);
    }
    if (grid < 0) return;
    hipMemsetAsync((char*)d_ws + WS_CTL, 0, 1 * MiB, stream);
    Params prm{};
    for (int i = 0; i < 18; ++i) prm.in[i] = (const float*)d_in[i];
    prm.out = (float*)d_out; prm.ws = (unsigned char*)d_ws;
#if MK_ONE_LAUNCH
    prm.ph_lo = 0; prm.ph_hi = NPH;
    { void* args[] = {&prm}; hipError_t e = hipLaunchCooperativeKernel((const void*)mega, dim3(grid), dim3(NTHREADS), args, LDS_BYTES, stream);
      if (e != hipSuccess) fprintf(stderr, "cooperative launch failed: %s\n", hipGetErrorString(e)); }
#else
    for (int ph = 0; ph < NPH; ++ph) {
        prm.ph_lo = ph; prm.ph_hi = ph + 1;
        void* args[] = {&prm};
        hipError_t e = hipLaunchCooperativeKernel((const void*)mega, dim3(grid), dim3(NTHREADS), args, LDS_BYTES, stream);
        if (e != hipSuccess) { fprintf(stderr, "cooperative launch %d failed: %s\n", ph, hipGetErrorString(e)); break; }
    }
#endif
}
```

```cpp
#include <hip/hip_runtime.h>
#include <cstdio>
#include <cstdint>

#define LAS __attribute__((address_space(3)))
typedef unsigned short bf16_t;
typedef short bf16x8 __attribute__((ext_vector_type(8)));
typedef short s16x4 __attribute__((ext_vector_type(4)));
typedef float f32x4 __attribute__((ext_vector_type(4)));
typedef float f32x16 __attribute__((ext_vector_type(16)));
typedef unsigned u32x4 __attribute__((ext_vector_type(4)));
typedef unsigned u32x2 __attribute__((ext_vector_type(2)));

#ifndef PROBE_DUP
#define PROBE_DUP 0
#endif
#ifndef MK_ONE_LAUNCH
#define MK_ONE_LAUNCH 1
#endif

constexpr int S = 8192, DM = 2048, NIN = 2880, NINP = 3072;
constexpr int NPH = 9;
constexpr float EPS = 1e-6f;
constexpr int LDS_BYTES = 163840;
constexpr int NTHREADS = 512;
constexpr int LDS_MISC = 161792;

constexpr size_t MiB = 1u << 20;
constexpr size_t WS_CTL = 0;
constexpr size_t WS_ROWSS = 128 * 1024;
constexpr size_t WS_COS = 1 * MiB, WS_SIN = 2 * MiB;
constexpr size_t WS_RSTD1 = 3 * MiB;
constexpr size_t WS_EXP = 4 * MiB;
constexpr size_t WS_GATE = 8 * MiB;
constexpr size_t WS_WIN = 12 * MiB;
constexpr size_t WS_WUQ = 24 * MiB;
constexpr size_t WS_WUKV = 26 * MiB;
constexpr size_t WS_WOUT = 28 * MiB;
constexpr size_t WS_WS = 36 * MiB;
constexpr size_t WS_XB = 44 * MiB;
constexpr size_t WS_PROJ = 76 * MiB;
constexpr size_t WS_QRAW = 124 * MiB;
constexpr size_t WS_KVRAW = 148 * MiB;
constexpr size_t WS_QH = 180 * MiB;
constexpr size_t WS_KH = 204 * MiB;
constexpr size_t WS_VH = 228 * MiB;
constexpr size_t WS_MIX = 244 * MiB;
constexpr size_t WS_X1B = 276 * MiB;
constexpr size_t WS_SC = 308 * MiB;
constexpr size_t WS_UT = 372 * MiB;
constexpr size_t WS_VT = 436 * MiB;
constexpr size_t WS_END = 500 * MiB;

__device__ __forceinline__ unsigned f2bf(float f) { unsigned u = __builtin_bit_cast(unsigned, f); return (u + 0x7fffu + ((u >> 16) & 1u)) >> 16; }
__device__ __forceinline__ unsigned pk2(float lo, float hi) { return f2bf(lo) | (f2bf(hi) << 16); }
__device__ __forceinline__ float bf2f(unsigned short b) { return __builtin_bit_cast(float, (unsigned)b << 16); }
__device__ __forceinline__ float bflo(unsigned w) { return __builtin_bit_cast(float, w << 16); }
__device__ __forceinline__ float bfhi(unsigned w) { return __builtin_bit_cast(float, w & 0xffff0000u); }
__device__ __forceinline__ float wave_sum(float v) {
#pragma unroll
    for (int o = 32; o > 0; o >>= 1) v += __shfl_xor(v, o);
    return v;
}
__device__ __forceinline__ float wave_max(float v) {
#pragma unroll
    for (int o = 32; o > 0; o >>= 1) v = fmaxf(v, __shfl_xor(v, o));
    return v;
}
template <int CTRL, int ROW_MASK> __device__ __forceinline__ float dpp_f(float old, float v) {
    return __builtin_bit_cast(float, __builtin_amdgcn_update_dpp(__builtin_bit_cast(int, old), __builtin_bit_cast(int, v), CTRL, ROW_MASK, 0xf, false));
}
__device__ __forceinline__ float wave_max_u(float v) {
    v = fmaxf(v, dpp_f<0xB1, 0xf>(v, v));
    v = fmaxf(v, dpp_f<0x4E, 0xf>(v, v));
    v = fmaxf(v, dpp_f<0x141, 0xf>(v, v));
    v = fmaxf(v, dpp_f<0x140, 0xf>(v, v));
    v = fmaxf(v, dpp_f<0x142, 0xa>(v, v));
    v = fmaxf(v, dpp_f<0x143, 0xc>(v, v));
    return __builtin_bit_cast(float, __builtin_amdgcn_readlane(__builtin_bit_cast(int, v), 63));
}
__device__ __forceinline__ float wave_sum_u(float v) {
    v += dpp_f<0xB1, 0xf>(0.f, v);
    v += dpp_f<0x4E, 0xf>(0.f, v);
    v += dpp_f<0x141, 0xf>(0.f, v);
    v += dpp_f<0x140, 0xf>(0.f, v);
    v += dpp_f<0x142, 0xa>(0.f, v);
    v += dpp_f<0x143, 0xc>(0.f, v);
    return __builtin_bit_cast(float, __builtin_amdgcn_readlane(__builtin_bit_cast(int, v), 63));
}
__device__ __forceinline__ float gelu_tanh(float x) {
    const float y = 0.7978845608028654f * (x + 0.044715f * x * x * x);
    return x / (1.0f + __expf(-2.0f * y));
}
__device__ __forceinline__ int crow(int r, int hi) { return (r & 3) + 8 * (r >> 2) + 4 * hi; }
#define LDS_WAIT() asm volatile("s_waitcnt lgkmcnt(0)" ::: "memory")
#define SBAR() __builtin_amdgcn_sched_barrier(0)

namespace pg8 {
#define PG8_LAS __attribute__((address_space(3)))
constexpr int BM = 256, BK = 64, HALF = 128, HTB = HALF * BK * 2  , STAGE_BYTES = 8 * HTB, NXCD = 8, WGM = 8;

__host__ __device__ __forceinline__ int lds_byte(int r, int c) { const int st = (r >> 4) * 2 + (c >> 5), rr = r & 15, cc = c & 31, ob = rr * 64 + cc * 2; return st * 1024 + (ob ^ (((ob >> 9) & 1) << 5)); }
__host__ __device__ __forceinline__ void stage_rc(int b, int& R, int& C) { const int st = b / 1024, sb = b % 1024, swz = sb ^ (((sb >> 9) & 1) << 5); R = (st >> 1) * 16 + swz / 64; C = (st & 1) * 32 + (swz % 64) / 2; }
__host__ __device__ __forceinline__ int perm32(int rho) { const int n = rho >> 4, i = rho & 15; return 8 * (i >> 2) + 4 * n + (i & 3); }

struct Unit { int pm, pn; };
struct Gemm { const bf16_t* A; const bf16_t* Bt; int M, N, K, lda, ldb; };

struct StaticOrder {
    int nM, nN, nwg, G, c, fpm = -1, fpn = 0;
    __host__ __device__ void init(int M, int N, int G_, int c_) { nM = M / BM; nN = N / BM; nwg = nM * nN; G = G_; c = c_; fpm = -1; }
    __host__ __device__ void fixed(int pm, int pn) { fpm = pm; fpn = pn; }
    __host__ __device__ bool next(int i, Unit& u) const {
        if (fpm >= 0) { if (i > 0) return false; u.pm = fpm; u.pn = fpn; return true; }
        const long L = (long)i * G + c; if (L >= nwg) return false;
        int wgid = (int)L; { const int q = nwg / NXCD, r = nwg % NXCD, xcd = wgid % NXCD, off = wgid / NXCD; wgid = (xcd < r ? xcd * (q + 1) : r * (q + 1) + (xcd - r) * q) + off; }
        const int nig = WGM * nN, gid = wgid / nig, fm = gid * WGM, gsz = (nM - fm) < WGM ? (nM - fm) : WGM;
        u.pm = fm + ((wgid % nig) % gsz); u.pn = (wgid % nig) / gsz; return true;
    }
    __device__ __forceinline__ void a_ready(const Unit&) const {}
    __device__ __forceinline__ void done(const Unit&) const {}
};

template <class Epi, class Sched, bool ALIGN_EPI = false, bool SP2 = false>
__device__ __forceinline__ void gemm_phase(PG8_LAS unsigned char* lds, const Gemm g, const Sched& S, const Epi& E) {
    const int tid = threadIdx.x, wid = __builtin_amdgcn_readfirstlane(tid >> 6), lane = tid & 63, wr = wid >> 2, wc = wid & 3, fr = lane & 15, fq = lane >> 4;
    const int K = g.K, nt = K / BK;
    unsigned voffA[2], voffB[2];
#pragma unroll
    for (int i = 0; i < 2; ++i) { int R, C; stage_rc(tid * 16 + i * 8192, R, C); const int Rb = Epi::PERM ? ((R & ~31) + perm32(R & 31)) : R;
        voffA[i] = (unsigned)(R * g.lda + C) * 2u; voffB[i] = (unsigned)(Rb * g.ldb + C) * 2u; }
    const size_t kstep = (size_t)(BK * 2);
    const size_t hstepA = (size_t)HALF * g.lda * 2, hstepB = (size_t)HALF * g.ldb * 2;
    const size_t tstepA = 2 * hstepA, tstepB = 2 * hstepB;
    const unsigned ldsw = (unsigned)wid * 1024u;
    const int aoff = lds_byte(wr * 64 + fr, fq * 8), boff = lds_byte(wc * 32 + fr, fq * 8);
#define PG8_SA(b, h) (((b) * 2 + (h)) * HTB)
#define PG8_SB(b, h) ((4 + (b) * 2 + (h)) * HTB)
#define PG8_STAGE(bufoff, gbase, voff) do { _Pragma("unroll") for (int _i = 0; _i < 2; ++_i) \
        __builtin_amdgcn_global_load_lds((const unsigned*)((const char*)(gbase) + (voff)[_i]), (PG8_LAS unsigned*)(lds + (bufoff) + ldsw + _i * 8192), 16, 0, 0); } while (0)
#define PG8_LDA(dst, b, h) do { _Pragma("unroll") for (int m = 0; m < 4; ++m) _Pragma("unroll") for (int k = 0; k < 2; ++k) dst[m][k] = *(const PG8_LAS bf16x8*)(lds + PG8_SA(b, h) + aoff + m * 2048 + k * 1024); } while (0)
#define PG8_LDB(dst, b, h) do { _Pragma("unroll") for (int n = 0; n < 2; ++n) _Pragma("unroll") for (int k = 0; k < 2; ++k) dst[n][k] = *(const PG8_LAS bf16x8*)(lds + PG8_SB(b, h) + boff + n * 2048 + k * 1024); } while (0)
#define PG8_MMA(ai, bj, At, Bt) do { __builtin_amdgcn_s_setprio(1); _Pragma("unroll") for (int m = 0; m < 4; ++m) _Pragma("unroll") for (int n = 0; n < 2; ++n) _Pragma("unroll") for (int k = 0; k < 2; ++k) \
        acc[ai][bj][m][n] = __builtin_amdgcn_mfma_f32_16x16x32_bf16(Bt[n][k], At[m][k], acc[ai][bj][m][n], 0, 0, 0); __builtin_amdgcn_s_setprio(0); } while (0)
#define PG8_WAIT_V(n) asm volatile("s_waitcnt vmcnt(" #n ")" ::: "memory")
#define PG8_WAIT_L(n) asm volatile("s_waitcnt lgkmcnt(" #n ")" ::: "memory")
#define PG8_BAR __builtin_amdgcn_s_barrier()
#define PG8_SCHED __builtin_amdgcn_sched_barrier(0)
    Unit cur, nxt; int ui = 0;
    if (!S.next(0, cur)) return;
    f32x4 acc[2][2][4][2];
#pragma unroll
    for (int a = 0; a < 2; ++a)
#pragma unroll
        for (int b = 0; b < 2; ++b)
#pragma unroll
            for (int m = 0; m < 4; ++m)
#pragma unroll
                for (int n = 0; n < 2; ++n) acc[a][b][m][n] = (f32x4){0.f, 0.f, 0.f, 0.f};
    bf16x8 At[4][2], B0[2][2], B1[2][2];
    const char* cA = (const char*)g.A + (size_t)cur.pm * tstepA; const char* cB = (const char*)g.Bt + (size_t)cur.pn * tstepB;
    S.a_ready(cur);
    if constexpr (SP2) {
        PG8_STAGE(PG8_SB(0, 0), cB, voffB); PG8_STAGE(PG8_SB(0, 1), cB + hstepB, voffB); PG8_STAGE(PG8_SA(0, 0), cA, voffA); PG8_STAGE(PG8_SA(0, 1), cA + hstepA, voffA);
        if (wr == 1) PG8_BAR;
        PG8_WAIT_V(2); PG8_BAR;
        PG8_STAGE(PG8_SB(1, 0), cB + kstep, voffB); PG8_STAGE(PG8_SA(1, 0), cA + kstep, voffA); PG8_STAGE(PG8_SB(1, 1), cB + hstepB + kstep, voffB);
        PG8_WAIT_V(6); PG8_BAR;
    } else {
        PG8_STAGE(PG8_SB(0, 0), cB, voffB); PG8_STAGE(PG8_SA(0, 0), cA, voffA); PG8_STAGE(PG8_SB(0, 1), cB + hstepB, voffB); PG8_STAGE(PG8_SA(0, 1), cA + hstepA, voffA);
        if (wr == 1) PG8_BAR;
        PG8_WAIT_V(4); PG8_BAR;
        PG8_STAGE(PG8_SB(1, 0), cB + kstep, voffB); PG8_STAGE(PG8_SA(1, 0), cA + kstep, voffA); PG8_STAGE(PG8_SB(1, 1), cB + hstepB + kstep, voffB);
        PG8_WAIT_V(6); PG8_BAR;
    }
    for (;;) {
        const bool has_next = S.next(ui + 1, nxt);
        const char* nA = has_next ? (const char*)g.A + (size_t)nxt.pm * tstepA : cA; const char* nB = has_next ? (const char*)g.Bt + (size_t)nxt.pn * tstepB : cB;
        for (int t = 0; t < nt; t += 2) {
            const bool last = (t == nt - 2);
            const char* a1 = cA + (size_t)(t + 1) * kstep;
            const char* a2 = last ? nA : cA + (size_t)(t + 2) * kstep; const char* b2 = last ? nB : cB + (size_t)(t + 2) * kstep;
            const char* a3 = a2 + kstep; const char* b3 = b2 + kstep;
            if (last && has_next) S.a_ready(nxt);
            if constexpr (SP2) {
            PG8_LDB(B0, 0, 0); PG8_LDB(B1, 0, 1); PG8_SCHED; PG8_LDA(At, 0, 0); PG8_STAGE(PG8_SA(1, 1), a1 + hstepA, voffA);
            PG8_WAIT_V(8); PG8_WAIT_L(0); PG8_BAR; PG8_MMA(0, 0, At, B0); PG8_MMA(0, 1, At, B1); PG8_BAR; PG8_SCHED;
            PG8_LDA(At, 0, 1); PG8_STAGE(PG8_SB(0, 0), b2, voffB); PG8_STAGE(PG8_SB(0, 1), b2 + hstepB, voffB); PG8_STAGE(PG8_SA(0, 0), a2, voffA);
            PG8_WAIT_V(8); PG8_WAIT_L(0); PG8_BAR; PG8_MMA(1, 0, At, B0); PG8_MMA(1, 1, At, B1); PG8_BAR; PG8_SCHED;
            PG8_LDB(B0, 1, 0); PG8_LDB(B1, 1, 1); PG8_SCHED; PG8_LDA(At, 1, 0); PG8_STAGE(PG8_SA(0, 1), a2 + hstepA, voffA);
            PG8_WAIT_V(8); PG8_WAIT_L(0); PG8_BAR; PG8_MMA(0, 0, At, B0); PG8_MMA(0, 1, At, B1); PG8_BAR; PG8_SCHED;
            PG8_LDA(At, 1, 1); PG8_STAGE(PG8_SB(1, 0), b3, voffB); PG8_STAGE(PG8_SB(1, 1), b3 + hstepB, voffB); PG8_STAGE(PG8_SA(1, 0), a3, voffA);
            PG8_WAIT_V(8); PG8_WAIT_L(0); PG8_BAR; PG8_MMA(1, 0, At, B0); PG8_MMA(1, 1, At, B1); PG8_BAR; PG8_SCHED;
            } else {
            PG8_LDB(B0, 0, 0); PG8_SCHED; PG8_LDA(At, 0, 0); PG8_STAGE(PG8_SA(1, 1), a1 + hstepA, voffA);
            PG8_WAIT_L(8); PG8_BAR; PG8_WAIT_L(0); PG8_MMA(0, 0, At, B0); PG8_BAR; PG8_SCHED;
            PG8_LDB(B1, 0, 1); PG8_STAGE(PG8_SB(0, 0), b2, voffB);
            PG8_BAR; PG8_WAIT_L(0); PG8_MMA(0, 1, At, B1); PG8_BAR;
            PG8_LDA(At, 0, 1); PG8_STAGE(PG8_SA(0, 0), a2, voffA);
            PG8_BAR; PG8_WAIT_L(0); PG8_MMA(1, 0, At, B0); PG8_BAR; PG8_SCHED;
            PG8_STAGE(PG8_SB(0, 1), b2 + hstepB, voffB);
            PG8_WAIT_V(6); PG8_BAR; PG8_MMA(1, 1, At, B1); PG8_BAR;
            PG8_LDB(B0, 1, 0); PG8_SCHED; PG8_LDA(At, 1, 0); PG8_STAGE(PG8_SA(0, 1), a2 + hstepA, voffA);
            PG8_WAIT_L(8); PG8_BAR; PG8_WAIT_L(0); PG8_MMA(0, 0, At, B0); PG8_BAR; PG8_SCHED;
            PG8_LDB(B1, 1, 1); PG8_STAGE(PG8_SB(1, 0), b3, voffB);
            PG8_BAR; PG8_WAIT_L(0); PG8_MMA(0, 1, At, B1); PG8_BAR;
            PG8_LDA(At, 1, 1); PG8_STAGE(PG8_SA(1, 0), a3, voffA);
            PG8_BAR; PG8_WAIT_L(0); PG8_MMA(1, 0, At, B0); PG8_BAR; PG8_SCHED;
            PG8_STAGE(PG8_SB(1, 1), b3 + hstepB, voffB);
            PG8_WAIT_V(6); PG8_BAR; PG8_MMA(1, 1, At, B1); PG8_BAR;
            }
        }
        if constexpr (ALIGN_EPI) { if (wr == 0) PG8_BAR; }
        if constexpr (!Epi::AFTER_DRAIN) { E(acc, cur, wr, wc, fr, fq); S.done(cur); }
        if (!has_next) break;
#pragma unroll
        for (int a = 0; a < 2; ++a)
#pragma unroll
            for (int b = 0; b < 2; ++b)
#pragma unroll
                for (int m = 0; m < 4; ++m)
#pragma unroll
                    for (int n = 0; n < 2; ++n) acc[a][b][m][n] = (f32x4){0.f, 0.f, 0.f, 0.f};
        cur = nxt; cA = nA; cB = nB; ++ui;
        if constexpr (ALIGN_EPI) { if (wr == 1) PG8_BAR; }
    }
    PG8_WAIT_V(0);
    if constexpr (!ALIGN_EPI) { if (wr == 0) PG8_BAR; }
    PG8_BAR;
#undef PG8_SA
#undef PG8_SB
#undef PG8_STAGE
#undef PG8_LDA
#undef PG8_LDB
#undef PG8_MMA
#undef PG8_WAIT_V
#undef PG8_WAIT_L
#undef PG8_BAR
#undef PG8_SCHED
}

template <int MODE> struct Epi {
    static constexpr bool PERM = false, AFTER_DRAIN = false;
    const float* rowsrc; float inv_n; float* ss; bf16_t* ob; int ldc; float* of; const float* xin;
    __device__ __forceinline__ void operator()(const f32x4 (&acc)[2][2][4][2], const Unit& u, int wr, int wc, int fr, int fq) const {
#pragma unroll
        for (int ai = 0; ai < 2; ++ai)
#pragma unroll
            for (int m = 0; m < 4; ++m) {
                const int row = u.pm * BM + ai * HALF + wr * 64 + m * 16 + fr;
                float rs = 1.f;
                if (MODE == 1) rs = rowsrc[row];
                if (MODE == 2 || MODE == 5) rs = rsqrtf(rowsrc[row] * inv_n + EPS);
                float ssq = 0.f;
#pragma unroll
                for (int bj = 0; bj < 2; ++bj)
#pragma unroll
                    for (int n = 0; n < 2; ++n) {
                        const int col = u.pn * BM + bj * HALF + wc * 32 + n * 16 + fq * 4;
                        f32x4 v = acc[ai][bj][m][n] * rs;
                        if (MODE == 1) { if (u.pn < 8) { v[0] = gelu_tanh(v[0]); v[1] = gelu_tanh(v[1]); v[2] = gelu_tanh(v[2]); v[3] = gelu_tanh(v[3]); } }
                        if (MODE == 4) { const f32x4 xr = __builtin_nontemporal_load((const f32x4*)(xin + (size_t)row * DM + col)); v = v + xr; }
                        if (MODE == 1 || MODE == 4) ssq += (v[0] * v[0] + v[1] * v[1]) + (v[2] * v[2] + v[3] * v[3]);
                        if (MODE == 1 || MODE == 2 || MODE == 4) { u32x2 w; w.x = pk2(v[0], v[1]); w.y = pk2(v[2], v[3]); *(u32x2*)(ob + (size_t)row * ldc + col) = w; }
                        if (MODE == 5) *(f32x4*)(of + (size_t)row * DM + col) = v;
                    }
                if (MODE == 1) {
                    const int seg = (u.pn >= 4 && u.pn < 8) ? 0 : ((u.pn == 8 || u.pn == 9) ? 1 : (u.pn == 10 ? 2 : -1));
                    if (seg >= 0) { ssq += __shfl_xor(ssq, 16); ssq += __shfl_xor(ssq, 32); if (fq == 0) atomicAdd(ss + seg * S + row, ssq); }
                }
                if (MODE == 4) { ssq += __shfl_xor(ssq, 16); ssq += __shfl_xor(ssq, 32); if (fq == 0) atomicAdd(ss + row, ssq); }
            }
    }
};
}

#define XB_TMO      128
#define XB_XCNT(j)  (256  + 64 * (j))
#define XB_XSUB(j)  (1280 + 64 * (j))
#define XB_XGEN(j)  (2304 + 64 * (j))
#define XB_TOP      3328
#define XB_TOPGEN   3392
#define XCD_BAR_WORDS 3456
#define XB_SPIN_CAP (1u << 18)
__device__ __forceinline__ unsigned xb_ld(unsigned* p)              { return __hip_atomic_load(p, __ATOMIC_RELAXED, __HIP_MEMORY_SCOPE_AGENT); }
__device__ __forceinline__ unsigned xb_add(unsigned* p, unsigned v) { return __hip_atomic_fetch_add(p, v, __ATOMIC_RELAXED, __HIP_MEMORY_SCOPE_AGENT); }
__device__ __forceinline__ unsigned xb_xcc_id() { return (unsigned)__builtin_amdgcn_s_getreg((3 << 11) | 20) & 0xFu; }
#define XB_SPIN(cond, bar) do { unsigned _sp = 0; while (cond) { __builtin_amdgcn_s_sleep(1); \
    if ((++_sp & 255u) == 0u) { if (xb_ld(&(bar)[XB_TMO])) break; if (_sp > XB_SPIN_CAP) { atomicAdd(&(bar)[XB_TMO], 1u); break; } } } } while (0)
struct XcdBarrier { unsigned* bar; unsigned x; volatile LAS unsigned* st; };
__device__ __forceinline__ XcdBarrier xcd_barrier_post(unsigned* bar, volatile LAS unsigned* st) {
    XcdBarrier b; b.bar = bar; b.x = xb_xcc_id(); b.st = st;
    if (threadIdx.x == 0) st[3] = xb_add(&bar[XB_XCNT(b.x)], 1u);
    return b;
}
__device__ __forceinline__ void xcd_barrier_complete(unsigned* bar, unsigned x, unsigned& nloc, unsigned& nx, unsigned& eq32) {
    const unsigned G = gridDim.x * gridDim.y * gridDim.z;
    unsigned sum, cnt, mine, sp = 0u;
    for (;;) {
        sum = 0u; cnt = 0u; mine = 0u; eq32 = 1u;
#pragma unroll
        for (unsigned j = 0; j < 16; ++j) { const unsigned c = xb_ld(&bar[XB_XCNT(j)]); sum += c; cnt += (c > 0u) ? 1u : 0u; mine = (j == x) ? c : mine; if (c != (j < 8u ? 32u : 0u)) eq32 = 0u; }
        if (sum == G) break;
        __builtin_amdgcn_s_sleep(1);
        if ((++sp & 255u) == 0u) { if (xb_ld(&bar[XB_TMO])) break; if (sp > XB_SPIN_CAP) { atomicAdd(&bar[XB_TMO], 1u); break; } }
    }
    nloc = mine > 0u ? mine : 1u; nx = cnt > 0u ? cnt : 1u;
}
#define XB_LSUB(j)  (3456 + 64 * (j))
#define XB_LGEN(j)  (4480 + 64 * (j))
__device__ __forceinline__ void xcd_local_barrier(const XcdBarrier& b) {
    asm volatile("s_waitcnt vmcnt(0)" ::: "memory");
    __syncthreads();
    if (threadIdx.x == 0) {
        unsigned* bar = b.bar;
        const unsigned nloc = b.st[0];
        const unsigned old = xb_add(&bar[XB_LSUB(b.x)], 1u);
        const unsigned gen = old / nloc;
        if (old + 1u == (gen + 1u) * nloc) xb_add(&bar[XB_LGEN(b.x)], 1u);
        else XB_SPIN(xb_ld(&bar[XB_LGEN(b.x)]) == gen, bar);
    }
    __syncthreads();
}
__device__ __forceinline__ void xcd_local_barrier_acq(const XcdBarrier& b) {
    asm volatile("s_waitcnt vmcnt(0)" ::: "memory");
    __syncthreads();
    if (threadIdx.x == 0) {
        unsigned* bar = b.bar;
        __builtin_amdgcn_s_waitcnt(0);
        const unsigned nloc = b.st[0];
        const unsigned old = xb_add(&bar[XB_LSUB(b.x)], 1u);
        const unsigned gen = old / nloc;
        if (old + 1u == (gen + 1u) * nloc) xb_add(&bar[XB_LGEN(b.x)], 1u);
        else XB_SPIN(xb_ld(&bar[XB_LGEN(b.x)]) == gen, bar);
        __builtin_amdgcn_fence(__ATOMIC_ACQUIRE, "agent");
        asm volatile("s_waitcnt vmcnt(0)" ::: "memory");
    }
    __syncthreads();
}
__device__ __forceinline__ void xcd_barrier(const XcdBarrier& b) {
    asm volatile("s_waitcnt vmcnt(0)" ::: "memory");
    __syncthreads();
    if (threadIdx.x == 0) {
        unsigned* bar = b.bar;
        __builtin_amdgcn_s_waitcnt(0);
        unsigned nloc = b.st[0], nx = b.st[1];
        if (nloc == 0u) { unsigned eq32; xcd_barrier_complete(bar, b.x, nloc, nx, eq32); b.st[0] = nloc; b.st[1] = nx; b.st[2] = eq32; }
        const unsigned old = xb_add(&bar[XB_XSUB(b.x)], 1u);
        const unsigned gen = old / nloc;
        if (old + 1u == (gen + 1u) * nloc) {
            __builtin_amdgcn_fence(__ATOMIC_RELEASE, "agent");
            asm volatile("s_waitcnt vmcnt(0)" ::: "memory");
            const unsigned og = xb_add(&bar[XB_TOP], 1u);
            const unsigned tg = og / nx;
            if (og + 1u == (tg + 1u) * nx) xb_add(&bar[XB_TOPGEN], 1u);
            else XB_SPIN(xb_ld(&bar[XB_TOPGEN]) == tg, bar);
            __builtin_amdgcn_fence(__ATOMIC_ACQUIRE, "agent");
            xb_add(&bar[XB_XGEN(b.x)], 1u);
            asm volatile("s_waitcnt vmcnt(0)" ::: "memory");
        } else {
            XB_SPIN(xb_ld(&bar[XB_XGEN(b.x)]) == gen, bar);
            __builtin_amdgcn_fence(__ATOMIC_ACQUIRE, "agent");
            asm volatile("s_waitcnt vmcnt(0)" ::: "memory");
        }
    }
    __syncthreads();
}

struct Params {
    const float* in[18];
    float* out;
    unsigned char* ws;
    int ph_lo, ph_hi;
};

__device__ __forceinline__ void p0_transpose_item(const float* W, const float* g, int K, int N, bf16_t* WT, LAS float* scr, int item, int lane) {
    const int nblk = N / 32, kb = item / nblk, nb = item % nblk, k0 = 64 * kb, n0 = 32 * nb;
    float wv[32];
#pragma unroll
    for (int i = 0; i < 32; ++i) { const int kk = 2 * i + (lane >> 5); wv[i] = __builtin_nontemporal_load(W + (size_t)(k0 + kk) * N + n0 + (lane & 31)); }
#pragma unroll
    for (int i = 0; i < 32; ++i) { const int kk = 2 * i + (lane >> 5); const float gv = g ? g[k0 + kk] : 1.f; scr[kk * 33 + (lane & 31)] = wv[i] * gv; }
    LDS_WAIT(); asm volatile("" ::: "memory");
    const int c = lane & 7;
#pragma unroll
    for (int j = 0; j < 4; ++j) { const int n = (lane >> 3) + 8 * j; const LAS float* s = scr + (8 * c) * 33 + n;
        u32x4 o; o.x = pk2(s[0 * 33], s[1 * 33]); o.y = pk2(s[2 * 33], s[3 * 33]); o.z = pk2(s[4 * 33], s[5 * 33]); o.w = pk2(s[6 * 33], s[7 * 33]);
        *(u32x4*)(WT + (size_t)(n0 + n) * K + k0 + 8 * c) = o; }
    LDS_WAIT(); asm volatile("" ::: "memory");
}
__device__ __forceinline__ float row_to_bf16(const float* src, const float* g, bf16_t* dst, int lane) {
    float ss = 0.f;
#pragma unroll
    for (int i = 0; i < 8; ++i) {
        const int c = (i * 64 + lane) * 4;
        f32x4 v = *(const f32x4*)(src + c);
        ss += (v[0] * v[0] + v[1] * v[1]) + (v[2] * v[2] + v[3] * v[3]);
        if (g) { const f32x4 gv = *(const f32x4*)(g + c); v = v * gv; }
        u32x2 w; w.x = pk2(v[0], v[1]); w.y = pk2(v[2], v[3]);
        *(u32x2*)(dst + c) = w;
    }
    return ss;
}
constexpr float PEER_USC = 80.0f, PEER_VSC = 5.0f;
constexpr int PEER_ROWB = 1536;
typedef float f32x16v __attribute__((ext_vector_type(16)));
typedef float f32x32v __attribute__((ext_vector_type(32)));
typedef unsigned u32x6 __attribute__((ext_vector_type(6)));
typedef unsigned u32x2a4 __attribute__((ext_vector_type(2), aligned(4)));
template <bool CONTIG>
__device__ __forceinline__ void fp6_pack_store(const f32x4 (&x)[8], const f32x4 (&sc)[8], unsigned char* dst, int lane) {
    f32x16v a, b;
#pragma unroll
    for (int i = 0; i < 8; ++i) {
        const f32x4 y = x[i] * sc[i];
#pragma unroll
        for (int q = 0; q < 4; ++q) { const float c = fminf(fmaxf(y[q], -7.5f), 7.5f); const int sl = 4 * i + q; if ((sl & 1) == 0) a[sl >> 1] = c; else b[sl >> 1] = c; }
    }
    const u32x6 pk = __builtin_amdgcn_cvt_scalef32_2xpk16_fp6_f32(a, b, 1.0f);
    asm volatile("s_nop 15" : "+v"(a), "+v"(b));
    if (CONTIG) {
        *(u32x2*)(dst + lane * 24) = (u32x2){pk[0], pk[1]}; *(u32x2*)(dst + lane * 24 + 8) = (u32x2){pk[2], pk[3]}; *(u32x2*)(dst + lane * 24 + 16) = (u32x2){pk[4], pk[5]};
    } else {
        *(u32x4*)(dst + lane * 16) = (u32x4){pk[0], pk[1], pk[2], pk[3]};
        *(u32x2*)(dst + 1024 + lane * 8) = (u32x2){pk[4], pk[5]};
    }
}
template <bool CONTIG>
__device__ __forceinline__ void rows2_to_fp6(const float* s0, const float* s1, const f32x4 (&sc)[8], unsigned char* d0, unsigned char* d1, int lane) {
    f32x4 x0[8], x1[8];
#pragma unroll
    for (int i = 0; i < 8; ++i) { x0[i] = __builtin_nontemporal_load((const f32x4*)(s0 + (i * 64 + lane) * 4)); x1[i] = __builtin_nontemporal_load((const f32x4*)(s1 + (i * 64 + lane) * 4)); }
    fp6_pack_store<CONTIG>(x0, sc, d0, lane); fp6_pack_store<CONTIG>(x1, sc, d1, lane);
}
__device__ __forceinline__ bf16x8 cvt8(const float* p) {
    const f32x4 a = *(const f32x4*)p, b = *(const f32x4*)(p + 4);
    u32x4 w; w.x = pk2(a[0], a[1]); w.y = pk2(a[2], a[3]); w.z = pk2(b[0], b[1]); w.w = pk2(b[2], b[3]);
    return __builtin_bit_cast(bf16x8, w);
}

__device__ __forceinline__ void prep_late(const Params& p, LAS unsigned char* lds, int gw, int NGW, int wave, int lane) {
    unsigned char* ws = p.ws;
    LAS float* scr = (LAS float*)(lds + wave * 16384);
    {
        constexpr int I_UQ = (512 / 64) * (1536 / 32), I_UKV = (256 / 64) * (2048 / 32), I_OUT = (DM / 64) * (DM / 32);
        constexpr int NIT = I_UQ + I_UKV + I_OUT;
        for (int it = gw; it < NIT; it += NGW) {
            int r = it;
            if (r < I_UQ) { p0_transpose_item(p.in[7], p.in[6], 512, 1536, (bf16_t*)(ws + WS_WUQ), scr, r, lane); continue; } r -= I_UQ;
            if (r < I_UKV) { p0_transpose_item(p.in[9], p.in[8], 256, 2048, (bf16_t*)(ws + WS_WUKV), scr, r, lane); continue; } r -= I_UKV;
            p0_transpose_item(p.in[12], nullptr, DM, DM, (bf16_t*)(ws + WS_WOUT), scr, r, lane);
        }
    }
    {
        const float* wq = p.in[14]; const float* sk = p.in[15]; const float* g2 = p.in[13];
        bf16_t* WsT = (bf16_t*)(ws + WS_WS);
        const int r32 = lane & 31, hh = lane >> 5;
        for (int it = gw; it < 16 * 4 * 64; it += NGW) {
            const int hp = it >> 8, kb = (it >> 6) & 3, nb = it & 63;
            f32x16 acc = {};
            const float* ap = sk + ((size_t)(hp * 128 + kb * 32 + r32)) * 128 + hh * 8;
            const float* bp = wq + ((size_t)(nb * 32 + r32)) * DM + hp * 128 + hh * 8;
#pragma unroll
            for (int s = 0; s < 8; ++s) {
                const bf16x8 a = cvt8(ap + s * 16), b = cvt8(bp + s * 16);
                acc = __builtin_amdgcn_mfma_f32_32x32x16_bf16(a, b, acc, 0, 0, 0);
            }
            const int kcol = nb * 32 + r32; const float gk = g2[kcol];
#pragma unroll
            for (int r = 0; r < 16; ++r) WsT[(size_t)(hp * 128 + kb * 32 + crow(r, hh)) * DM + kcol] = (bf16_t)f2bf(acc[r] * gk);
        }
    }
    {
        float* ct = (float*)(ws + WS_COS); float* st = (float*)(ws + WS_SIN);
        for (int it = gw; it < S * 32 / 64; it += NGW) {
            const int idx = it * 64 + lane, t = idx >> 5, j = idx & 31;
            const float inv_freq = powf(10000.0f, -(float)j / 32.0f);
            const float ang = (float)t * inv_freq;
            float sv, cv; sincosf(ang, &sv, &cv); ct[idx] = cv; st[idx] = sv;
        }
    }
}
__device__ __forceinline__ void phase0(const Params& p, LAS unsigned char* lds, bool late_ok, int gw, int NGW, int wave, int lane) {
    unsigned char* ws = p.ws;
    LAS float* scr = (LAS float*)(lds + wave * 16384);
    const float* x = p.in[0];
    {
        constexpr int I_IN = (DM / 64) * (NIN / 32);
        for (int it = gw; it < I_IN; it += NGW) p0_transpose_item(p.in[2], p.in[1], DM, NIN, (bf16_t*)(ws + WS_WIN), scr, it, lane);
    }
    if (!late_ok) prep_late(p, lds, gw, NGW, wave, lane);
    for (int r = gw; r < NINP - NIN; r += NGW) {
        bf16_t* d = (bf16_t*)(ws + WS_WIN) + (size_t)(NIN + r) * DM;
#pragma unroll
        for (int i = 0; i < 4; ++i) *(u32x4*)(d + (i * 64 + lane) * 8) = (u32x4){0u, 0u, 0u, 0u};
    }
    {
        bf16_t* xb = (bf16_t*)(ws + WS_XB); float* rstd1 = (float*)(ws + WS_RSTD1);
        for (int t = gw; t + NGW < S; t += 2 * NGW) {
            const int t1 = t + NGW;
            f32x4 a[8], b[8];
#pragma unroll
            for (int i = 0; i < 8; ++i) { a[i] = __builtin_nontemporal_load((const f32x4*)(x + (size_t)t * DM + (i * 64 + lane) * 4)); b[i] = __builtin_nontemporal_load((const f32x4*)(x + (size_t)t1 * DM + (i * 64 + lane) * 4)); }
            float sa = 0.f, sb = 0.f;
#pragma unroll
            for (int i = 0; i < 8; ++i) {
                sa += (a[i][0] * a[i][0] + a[i][1] * a[i][1]) + (a[i][2] * a[i][2] + a[i][3] * a[i][3]);
                sb += (b[i][0] * b[i][0] + b[i][1] * b[i][1]) + (b[i][2] * b[i][2] + b[i][3] * b[i][3]);
                u32x2 wa, wb; wa.x = pk2(a[i][0], a[i][1]); wa.y = pk2(a[i][2], a[i][3]); wb.x = pk2(b[i][0], b[i][1]); wb.y = pk2(b[i][2], b[i][3]);
                *(u32x2*)(xb + (size_t)t * DM + (i * 64 + lane) * 4) = wa; *(u32x2*)(xb + (size_t)t1 * DM + (i * 64 + lane) * 4) = wb;
            }
            sa = wave_sum(sa); sb = wave_sum(sb);
            if (lane == 0) { rstd1[t] = rsqrtf(sa * (1.0f / DM) + EPS); rstd1[t1] = rsqrtf(sb * (1.0f / DM) + EPS); }
        }
    }
    {
        unsigned char* UT = ws + WS_UT; unsigned char* VT = ws + WS_VT;
        f32x4 sc[8];
#pragma unroll
        for (int i = 0; i < 8; ++i) sc[i] = *(const f32x4*)(p.in[13] + (i * 64 + lane) * 4) * PEER_USC;
        for (int e = gw; e + NGW < 16384; e += 2 * NGW)
            rows2_to_fp6<false>(p.in[16] + (size_t)e * DM, p.in[16] + (size_t)(e + NGW) * DM, sc, UT + (size_t)e * PEER_ROWB, UT + (size_t)(e + NGW) * PEER_ROWB, lane);
#pragma unroll
        for (int i = 0; i < 8; ++i) sc[i] = (f32x4){PEER_VSC, PEER_VSC, PEER_VSC, PEER_VSC};
        for (int e = gw; e + NGW < 16384; e += 2 * NGW)
            rows2_to_fp6<false>(p.in[17] + (size_t)e * DM, p.in[17] + (size_t)(e + NGW) * DM, sc, VT + (size_t)e * PEER_ROWB, VT + (size_t)(e + NGW) * PEER_ROWB, lane);
    }
}

__device__ __forceinline__ float half_sum(float v) {
    v += dpp_f<0xB1, 0xf>(0.f, v); v += dpp_f<0x4E, 0xf>(0.f, v); v += dpp_f<0x141, 0xf>(0.f, v); v += dpp_f<0x140, 0xf>(0.f, v);
    return v + __shfl_xor(v, 16);
}
__device__ __forceinline__ void phase3(const Params& p, int tfirst, int tstep, int tcnt, int lane) {
    unsigned char* ws = p.ws;
    const bf16_t* qraw = (const bf16_t*)(ws + WS_QRAW); const bf16_t* kvraw = (const bf16_t*)(ws + WS_KVRAW); const bf16_t* proj = (const bf16_t*)(ws + WS_PROJ);
    bf16_t* Qh = (bf16_t*)(ws + WS_QH); bf16_t* Kh = (bf16_t*)(ws + WS_KH);
    const float* ct = (const float*)(ws + WS_COS); const float* st = (const float*)(ws + WS_SIN);
    const int sub = lane & 31, hsel = lane >> 5;
    const bool act = sub < 24, isrope = sub >= 16 && sub < 24, lowhalf = sub < 20;
    const int e0 = act ? 8 * sub : 0;
    f32x4 gq[2], gk[2];
#pragma unroll
    for (int c = 0; c < 2; ++c) { gq[c] = *(const f32x4*)(p.in[10] + e0 + 4 * c); gk[c] = *(const f32x4*)(p.in[11] + e0 + 4 * c); }
    const int j0 = isrope ? ((8 * sub - 128) & 31) : 0;
    constexpr float QS = 0.07216878364870322f * 1.4426950408889634f;
    for (int ti = 0; ti < tcnt; ++ti) {
        const int t = tfirst + ti * tstep;
        f32x4 cs[2] = {{1.f, 1.f, 1.f, 1.f}, {1.f, 1.f, 1.f, 1.f}}, sn[2] = {{0.f, 0.f, 0.f, 0.f}, {0.f, 0.f, 0.f, 0.f}};
        u32x4 krw = {0u, 0u, 0u, 0u};
        if (isrope) {
#pragma unroll
            for (int c = 0; c < 2; ++c) { cs[c] = *(const f32x4*)(ct + t * 32 + j0 + 4 * c); sn[c] = *(const f32x4*)(st + t * 32 + j0 + 4 * c); }
            krw = *(const u32x4*)(proj + (size_t)t * NINP + 2816 + (8 * sub - 128));
        }
#pragma unroll
        for (int hp = 0; hp < 4; ++hp) {
            const int h = 2 * hp + hsel;
            u32x4 qw = {0u, 0u, 0u, 0u}, kw = {0u, 0u, 0u, 0u};
            if (act) qw = *(const u32x4*)(qraw + (size_t)t * 1536 + h * 192 + e0);
            if (sub < 16) kw = *(const u32x4*)(kvraw + (size_t)t * 2048 + h * 256 + e0);
            if (isrope) kw = krw;
#pragma unroll
            for (int which = 0; which < 2; ++which) {
                const u32x4 w = which ? kw : qw;
                f32x4 x[2] = {{bflo(w[0]), bfhi(w[0]), bflo(w[1]), bfhi(w[1])}, {bflo(w[2]), bfhi(w[2]), bflo(w[3]), bfhi(w[3])}};
                float ss = 0.f;
#pragma unroll
                for (int c = 0; c < 2; ++c) ss += (x[c][0] * x[c][0] + x[c][1] * x[c][1]) + (x[c][2] * x[c][2] + x[c][3] * x[c][3]);
                ss = half_sum(ss);
                const float rs = rsqrtf(ss * (1.0f / 192.0f) + EPS);
#pragma unroll
                for (int c = 0; c < 2; ++c) {
                    x[c] = x[c] * (which ? gk[c] : gq[c]) * rs;
                    f32x4 pr;
#pragma unroll
                    for (int q = 0; q < 4; ++q) pr[q] = __shfl_xor(x[c][q], 4);
                    const f32x4 r1 = x[c] * cs[c] - pr * sn[c], r2 = pr * sn[c] + x[c] * cs[c];
                    if (isrope) x[c] = lowhalf ? r1 : r2;
                    if (!which) x[c] = x[c] * QS;
                }
                if (act) {
                    u32x4 o; o.x = pk2(x[0][0], x[0][1]); o.y = pk2(x[0][2], x[0][3]); o.z = pk2(x[1][0], x[1][1]); o.w = pk2(x[1][2], x[1][3]);
                    *(u32x4*)((which ? Kh : Qh) + ((size_t)h * S + t) * 192 + e0) = o;
                }
            }
        }
    }
}

constexpr int KP = 400, VP = 320;
template <int OFF> __device__ __forceinline__ s16x4 tr_read(unsigned addr) {
    s16x4 r; asm volatile("ds_read_b64_tr_b16 %0, %1 offset:%2" : "=&v"(r) : "v"(addr), "i"(OFF) : "memory"); return r;
}
__device__ __forceinline__ unsigned cvtpk(float lo, float hi) { unsigned r; asm volatile("v_cvt_pk_bf16_f32 %0, %1, %2" : "=v"(r) : "v"(lo), "v"(hi)); return r; }
#define PK8(L, H) ((bf16x8){L[0], L[1], L[2], L[3], H[0], H[1], H[2], H[3]})
constexpr float ATT_THR = 8.0f;

constexpr int ATT_KB = 64 * KP, ATT_VB = 64 * VP;
constexpr int ATT_VOFF = 2 * ATT_KB;
__device__ __forceinline__ float xhalf_max(float v) {
    auto rr = __builtin_amdgcn_permlane32_swap(__builtin_bit_cast(unsigned, v), __builtin_bit_cast(unsigned, v), false, false);
    return fmaxf(__builtin_bit_cast(float, rr[0]), __builtin_bit_cast(float, rr[1]));
}
__device__ __forceinline__ float xhalf_sum(float v) {
    auto rr = __builtin_amdgcn_permlane32_swap(__builtin_bit_cast(unsigned, v), __builtin_bit_cast(unsigned, v), false, false);
    return __builtin_bit_cast(float, rr[0]) + __builtin_bit_cast(float, rr[1]);
}
template <int OFF> __device__ __forceinline__ bf16x8 lds_read128(unsigned addr) {
    bf16x8 r; asm volatile("ds_read_b128 %0, %1 offset:%2" : "=&v"(r) : "v"(addr), "i"(OFF) : "memory"); return r;
}
#define LGKM_WAIT(n) do { asm volatile("s_waitcnt lgkmcnt(" #n ")" ::: "memory"); SBAR(); } while (0)
__device__ __forceinline__ f32x16 att_qk(unsigned kaddr, const bf16x8 (&qr)[12]) {
    f32x16 p = {};
    bf16x8 a0 = lds_read128<0>(kaddr), a1 = lds_read128<32>(kaddr), a2 = lds_read128<64>(kaddr), a3 = lds_read128<96>(kaddr);
    LGKM_WAIT(3); p = __builtin_amdgcn_mfma_f32_32x32x16_bf16(a0, qr[0], p, 0, 0, 0); a0 = lds_read128<128>(kaddr);
    LGKM_WAIT(3); p = __builtin_amdgcn_mfma_f32_32x32x16_bf16(a1, qr[1], p, 0, 0, 0); a1 = lds_read128<160>(kaddr);
    LGKM_WAIT(3); p = __builtin_amdgcn_mfma_f32_32x32x16_bf16(a2, qr[2], p, 0, 0, 0); a2 = lds_read128<192>(kaddr);
    LGKM_WAIT(3); p = __builtin_amdgcn_mfma_f32_32x32x16_bf16(a3, qr[3], p, 0, 0, 0); a3 = lds_read128<224>(kaddr);
    LGKM_WAIT(3); p = __builtin_amdgcn_mfma_f32_32x32x16_bf16(a0, qr[4], p, 0, 0, 0); a0 = lds_read128<256>(kaddr);
    LGKM_WAIT(3); p = __builtin_amdgcn_mfma_f32_32x32x16_bf16(a1, qr[5], p, 0, 0, 0); a1 = lds_read128<288>(kaddr);
    LGKM_WAIT(3); p = __builtin_amdgcn_mfma_f32_32x32x16_bf16(a2, qr[6], p, 0, 0, 0); a2 = lds_read128<320>(kaddr);
    LGKM_WAIT(3); p = __builtin_amdgcn_mfma_f32_32x32x16_bf16(a3, qr[7], p, 0, 0, 0); a3 = lds_read128<352>(kaddr);
    LGKM_WAIT(3); p = __builtin_amdgcn_mfma_f32_32x32x16_bf16(a0, qr[8], p, 0, 0, 0);
    LGKM_WAIT(2); p = __builtin_amdgcn_mfma_f32_32x32x16_bf16(a1, qr[9], p, 0, 0, 0);
    LGKM_WAIT(1); p = __builtin_amdgcn_mfma_f32_32x32x16_bf16(a2, qr[10], p, 0, 0, 0);
    LGKM_WAIT(0); p = __builtin_amdgcn_mfma_f32_32x32x16_bf16(a3, qr[11], p, 0, 0, 0);
    return p;
}
__device__ __forceinline__ void att_finish(f32x16& s, float m, float& lsum, bf16x8& pb0, bf16x8& pb1) {
    float ps = 0.f;
#pragma unroll
    for (int r = 0; r < 16; ++r) { s[r] = __builtin_amdgcn_exp2f(s[r] - m); ps += s[r]; }
    lsum += xhalf_sum(ps);
    u32x4 w0 = {cvtpk(s[0], s[1]), cvtpk(s[2], s[3]), cvtpk(s[4], s[5]), cvtpk(s[6], s[7])};
    u32x4 w1 = {cvtpk(s[8], s[9]), cvtpk(s[10], s[11]), cvtpk(s[12], s[13]), cvtpk(s[14], s[15])};
    pb0 = __builtin_bit_cast(bf16x8, w0); pb1 = __builtin_bit_cast(bf16x8, w1);
}
__device__ __forceinline__ void att_pv(unsigned vaddr, bf16x8 pb0, bf16x8 pb1, f32x16 (&o)[4]) {
#define VOFF(d0, s, hi) (((16 * (s) + 8 * (hi)) * VP) + 64 * (d0))
    const s16x4 a00l = tr_read<VOFF(0, 0, 0)>(vaddr), a00h = tr_read<VOFF(0, 0, 1)>(vaddr), a01l = tr_read<VOFF(0, 1, 0)>(vaddr), a01h = tr_read<VOFF(0, 1, 1)>(vaddr);
    const s16x4 a10l = tr_read<VOFF(1, 0, 0)>(vaddr), a10h = tr_read<VOFF(1, 0, 1)>(vaddr), a11l = tr_read<VOFF(1, 1, 0)>(vaddr), a11h = tr_read<VOFF(1, 1, 1)>(vaddr);
    LGKM_WAIT(4);
    o[0] = __builtin_amdgcn_mfma_f32_32x32x16_bf16(PK8(a00l, a00h), pb0, o[0], 0, 0, 0); o[0] = __builtin_amdgcn_mfma_f32_32x32x16_bf16(PK8(a01l, a01h), pb1, o[0], 0, 0, 0);
    const s16x4 a20l = tr_read<VOFF(2, 0, 0)>(vaddr), a20h = tr_read<VOFF(2, 0, 1)>(vaddr), a21l = tr_read<VOFF(2, 1, 0)>(vaddr), a21h = tr_read<VOFF(2, 1, 1)>(vaddr);
    LGKM_WAIT(4);
    o[1] = __builtin_amdgcn_mfma_f32_32x32x16_bf16(PK8(a10l, a10h), pb0, o[1], 0, 0, 0); o[1] = __builtin_amdgcn_mfma_f32_32x32x16_bf16(PK8(a11l, a11h), pb1, o[1], 0, 0, 0);
    const s16x4 a30l = tr_read<VOFF(3, 0, 0)>(vaddr), a30h = tr_read<VOFF(3, 0, 1)>(vaddr), a31l = tr_read<VOFF(3, 1, 0)>(vaddr), a31h = tr_read<VOFF(3, 1, 1)>(vaddr);
    LGKM_WAIT(4);
    o[2] = __builtin_amdgcn_mfma_f32_32x32x16_bf16(PK8(a20l, a20h), pb0, o[2], 0, 0, 0); o[2] = __builtin_amdgcn_mfma_f32_32x32x16_bf16(PK8(a21l, a21h), pb1, o[2], 0, 0, 0);
    LGKM_WAIT(0);
    o[3] = __builtin_amdgcn_mfma_f32_32x32x16_bf16(PK8(a30l, a30h), pb0, o[3], 0, 0, 0); o[3] = __builtin_amdgcn_mfma_f32_32x32x16_bf16(PK8(a31l, a31h), pb1, o[3], 0, 0, 0);
#undef VOFF
}
__device__ __forceinline__ void att_partial(const f32x16& s, float& m, float& lsum, f32x16 (&o)[4]) {
    float pmax = s[0];
#pragma unroll
    for (int r = 1; r < 16; ++r) pmax = fmaxf(pmax, s[r]);
    pmax = xhalf_max(pmax);
    if (!__all(pmax - m <= ATT_THR)) {
        const float mn = fmaxf(m, pmax); const float alpha = __builtin_amdgcn_exp2f(m - mn); m = mn; lsum *= alpha;
#pragma unroll
        for (int d = 0; d < 4; ++d)
#pragma unroll
            for (int r = 0; r < 16; ++r) o[d][r] *= alpha;
    }
}

__device__ __forceinline__ void attn_unit(const Params& p, LAS unsigned char* lds, int head, int qb, int tid, int wave, int lane) {
    unsigned char* ws = p.ws;
    const bf16_t* Qh = (const bf16_t*)(ws + WS_QH); const bf16_t* Kh = (const bf16_t*)(ws + WS_KH);
    bf16_t* mix = (bf16_t*)(ws + WS_MIX);
    const int rg = wave & 3, kh = wave >> 2, r32 = lane & 31, hh = lane >> 5;
    const int q0row = qb * 128 + rg * 32;
    bf16x8 qr[12];
    {
        const bf16_t* qp = Qh + ((size_t)head * S + q0row + r32) * 192 + hh * 8;
#pragma unroll
        for (int ks = 0; ks < 12; ++ks) qr[ks] = *(const bf16x8*)(qp + ks * 16);
    }
    const int ntiles = 2 * qb + 2, mylast = 2 * qb + (rg >> 1);
    float m = -1e30f, lsum = 0.f; f32x16 o[4] = {};
    const int srow = tid >> 3, sch = tid & 7;
    const int kg0 = srow * 192 + sch * 8, kl0 = srow * KP + sch * 16, vg0 = srow * 2048 + sch * 8, vl0 = ATT_VOFF + srow * VP + sch * 16;
    const bf16_t* kbase = Kh + (size_t)head * S * 192; const bf16_t* vbase = (const bf16_t*)(ws + WS_KVRAW) + head * 256 + 128;
    u32x4 sk0, sk1, sk2, sv0, sv1;
#define ATT_LOAD(t) do { const bf16_t* kt = kbase + (size_t)(t) * 64 * 192 + kg0; const bf16_t* vt = vbase + (size_t)(t) * 64 * 2048 + vg0; \
        sk0 = *(const u32x4*)(kt); sk1 = *(const u32x4*)(kt + 64); sk2 = *(const u32x4*)(kt + 128); sv0 = *(const u32x4*)(vt); sv1 = *(const u32x4*)(vt + 64); } while (0)
#define ATT_WRITE(kb_, vb_) do { LAS unsigned char* bk = lds + (kb_) * ATT_KB + kl0; LAS unsigned char* bv = lds + (vb_) * ATT_VB + vl0; *(LAS u32x4*)(bk) = sk0; *(LAS u32x4*)(bk + 128) = sk1; *(LAS u32x4*)(bk + 256) = sk2; \
        *(LAS u32x4*)(bv) = sv0; *(LAS u32x4*)(bv + 128) = sv1; } while (0)
    const unsigned ldsbase = (unsigned)(size_t)lds;
    const unsigned kaddr0 = ldsbase + (unsigned)((32 * kh + r32) * KP + hh * 16);
    const unsigned vrel = (unsigned)(ATT_VOFF + (32 * kh + 4 * hh + ((lane & 15) >> 2)) * VP + (16 * ((lane >> 4) & 1) + 4 * (lane & 3)) * 2);
    ATT_LOAD(0); ATT_WRITE(0, 0); __syncthreads();
    bf16x8 pb0, pb1;
    const bool more0 = (1 < ntiles);
    if (more0) ATT_LOAD(1);
    f32x16 sprev = att_qk(kaddr0, qr);
    att_partial(sprev, m, lsum, o);
    if (more0) ATT_WRITE(1, 1);
    __syncthreads();
    int vprev = 0, vcur = 1;
#pragma unroll 1
    for (int t = 1; t <= ntiles; ++t) {
        const bool more = (t + 1 < ntiles);
        if (more) ATT_LOAD(t + 1);
        f32x16 sc;
        if (t <= mylast) sc = att_qk(kaddr0 + (t & 1) * ATT_KB, qr);
        else {
#pragma unroll
            for (int r = 0; r < 16; ++r) sc[r] = -1e30f;
        }
        att_finish(sprev, m, lsum, pb0, pb1);
        att_pv(ldsbase + vprev * ATT_VB + vrel, pb0, pb1, o);
        att_partial(sc, m, lsum, o);
        sprev = sc;
        const int vnext = (vcur == 2) ? 0 : vcur + 1;
        if (more) ATT_WRITE((t + 1) & 1, vnext);
        vprev = vcur; vcur = vnext;
        __syncthreads();
    }
#undef ATT_LOAD
#undef ATT_WRITE
    LAS float* scr = (LAS float*)lds + (size_t)rg * 66 * 64 + lane;
    if (kh == 1) {
        scr[0] = m; scr[64] = lsum;
#pragma unroll
        for (int d = 0; d < 4; ++d)
#pragma unroll
            for (int r = 0; r < 16; ++r) scr[(2 + d * 16 + r) * 64] = o[d][r];
    }
    __syncthreads();
    if (kh == 0) {
        const float m2 = scr[0], l2 = scr[64];
        const float mn = fmaxf(m, m2), a1 = __builtin_amdgcn_exp2f(m - mn), a2 = __builtin_amdgcn_exp2f(m2 - mn);
        const float inv = 1.0f / (lsum * a1 + l2 * a2);
        bf16_t* op = mix + (size_t)(q0row + r32) * DM + 1024 + head * 128 + 4 * hh;
#pragma unroll
        for (int d = 0; d < 4; ++d)
#pragma unroll
            for (int g4 = 0; g4 < 4; ++g4) {
                float v[4];
#pragma unroll
                for (int i = 0; i < 4; ++i) { const int r = 4 * g4 + i; v[i] = (o[d][r] * a1 + scr[(2 + d * 16 + r) * 64] * a2) * inv; }
                u32x2 w; w.x = pk2(v[0], v[1]); w.y = pk2(v[2], v[3]);
                *(u32x2*)(op + 32 * d + 8 * g4) = w;
            }
    }
    __syncthreads();
}

__device__ __forceinline__ void gmlp_unit(const Params& p, LAS unsigned char* lds, int nb, int h, int tid, int wave, int lane) {
    unsigned char* ws = p.ws;
    const bf16_t* proj = (const bf16_t*)(ws + WS_PROJ); bf16_t* mix = (bf16_t*)(ws + WS_MIX);
    const float* ssv = (const float*)(ws + WS_ROWSS);
    const float* vg = p.in[3]; const float* wsp = p.in[4]; const float* bs = p.in[5];
#pragma unroll
    for (int i = 0; i < 4; ++i) {
        const int pc = tid + 512 * i, r = pc >> 4, c = pc & 15, t = nb * 128 + r;
        const u32x4 w = *(const u32x4*)(proj + (size_t)t * NINP + 1024 + h * 128 + c * 8);
        const float rs = rsqrtf(ssv[t] * (1.0f / 1024.0f) + EPS);
        const f32x4 g0 = *(const f32x4*)(vg + h * 128 + c * 8), g1 = *(const f32x4*)(vg + h * 128 + c * 8 + 4);
        u32x4 ov;
        ov.x = pk2(bflo(w.x) * rs * g0[0], bfhi(w.x) * rs * g0[1]); ov.y = pk2(bflo(w.y) * rs * g0[2], bfhi(w.y) * rs * g0[3]);
        ov.z = pk2(bflo(w.z) * rs * g1[0], bfhi(w.z) * rs * g1[1]); ov.w = pk2(bflo(w.w) * rs * g1[2], bfhi(w.w) * rs * g1[3]);
        *(LAS u32x4*)(lds + r * VP + c * 16) = ov;
    }
    __syncthreads();
    const int ib = wave & 3, ch = wave >> 2, r32 = lane & 31, hh = lane >> 5;
    const int irow = 32 * ib + r32;
    f32x16 acc0 = {}, acc1 = {};
    const unsigned vaddr = (unsigned)(size_t)lds + (unsigned)((8 * hh + ((lane & 15) >> 2)) * VP + (64 * ch + 16 * ((lane >> 4) & 1) + 4 * (lane & 3)) * 2);
    const float* wrow = wsp + ((size_t)h * 128 + irow) * 128 + hh * 8;
#define GSTEP(s) do { if ((s) < 2 * (ib + 1)) { \
        const f32x4 wa = *(const f32x4*)(wrow + (s) * 16), wb = *(const f32x4*)(wrow + (s) * 16 + 4); const int j0 = (s) * 16 + hh * 8; \
        u32x4 aw; aw.x = pk2(j0 + 0 <= irow ? wa[0] : 0.f, j0 + 1 <= irow ? wa[1] : 0.f); aw.y = pk2(j0 + 2 <= irow ? wa[2] : 0.f, j0 + 3 <= irow ? wa[3] : 0.f); \
        aw.z = pk2(j0 + 4 <= irow ? wb[0] : 0.f, j0 + 5 <= irow ? wb[1] : 0.f); aw.w = pk2(j0 + 6 <= irow ? wb[2] : 0.f, j0 + 7 <= irow ? wb[3] : 0.f); \
        const bf16x8 af = __builtin_bit_cast(bf16x8, aw); \
        const s16x4 b0l = tr_read<(16 * (s)) * VP>(vaddr), b0h = tr_read<(16 * (s) + 4) * VP>(vaddr), b1l = tr_read<(16 * (s)) * VP + 64>(vaddr), b1h = tr_read<(16 * (s) + 4) * VP + 64>(vaddr); \
        LDS_WAIT(); SBAR(); \
        acc0 = __builtin_amdgcn_mfma_f32_32x32x16_bf16(af, PK8(b0l, b0h), acc0, 0, 0, 0); acc1 = __builtin_amdgcn_mfma_f32_32x32x16_bf16(af, PK8(b1l, b1h), acc1, 0, 0, 0); } } while (0)
    GSTEP(0); GSTEP(1); GSTEP(2); GSTEP(3); GSTEP(4); GSTEP(5); GSTEP(6); GSTEP(7);
#undef GSTEP
#pragma unroll
    for (int r = 0; r < 16; ++r) {
        const int i = 32 * ib + crow(r, hh), t = nb * 128 + i; const float b = bs[h * 128 + i];
        const int c0 = h * 128 + 64 * ch + r32;
        const float u0 = bf2f(proj[(size_t)t * NINP + c0]), u1 = bf2f(proj[(size_t)t * NINP + c0 + 32]);
        mix[(size_t)t * DM + c0] = (bf16_t)f2bf(u0 * (acc0[r] + b)); mix[(size_t)t * DM + c0 + 32] = (bf16_t)f2bf(u1 * (acc1[r] + b));
    }
    __syncthreads();
}

__device__ __forceinline__ void phase7(const Params& p, LAS unsigned char* lds, int gw, int NGW, int wave, int lane) {
    unsigned char* ws = p.ws;
    const float* sc = (const float*)(ws + WS_SC); int* ex = (int*)(ws + WS_EXP); float* gt = (float*)(ws + WS_GATE);
    const float NEG = -3.0e38f;
    LAS float* sl = (LAS float*)(lds + wave * 1024);
    const int j8 = lane & 7, g8 = lane >> 3, row = lane >> 4, i16 = lane & 15;
    int ci[4], cj[4]; bool cval[4];
    {
        constexpr int starts[16] = {0, 16, 24, 29, 33, 36, 38, 40, 42, 43, 44, 45, 46, 47, 48, 49};
#pragma unroll
        for (int m = 0; m < 4; ++m) {
            const int c = i16 + 16 * m; int a = 0, st = 0;
#pragma unroll
            for (int i = 1; i < 16; ++i) if (c >= starts[i]) { a = i; st = starts[i]; }
            cval[m] = c < 50; ci[m] = cval[m] ? a : 0; cj[m] = cval[m] ? (c - st) : 0;
        }
    }
    f32x4 nx0, nx1, nx2, nx3;
    if (gw < S / 4) { const float* b = sc + (size_t)(gw * 4) * DM + lane * 16; nx0 = *(const f32x4*)b; nx1 = *(const f32x4*)(b + 4); nx2 = *(const f32x4*)(b + 8); nx3 = *(const f32x4*)(b + 12); }
    for (int tb = gw; tb < S / 4; tb += NGW)
#pragma unroll 1
    for (int n8 = 0; n8 < 8; ++n8) {
        const int it = tb * 8 + n8;
        const int t = it >> 1, hh = it & 1;
        float v[16];
#pragma unroll
        for (int q = 0; q < 4; ++q) { v[q] = nx0[q]; v[4 + q] = nx1[q]; v[8 + q] = nx2[q]; v[12 + q] = nx3[q]; }
        { const int it2 = n8 < 7 ? it + 1 : (tb + NGW) * 8;
          if (it2 < S * 2) { const float* b = sc + (size_t)(it2 >> 1) * DM + (it2 & 1) * 1024 + lane * 16;
            nx0 = *(const f32x4*)b; nx1 = *(const f32x4*)(b + 4); nx2 = *(const f32x4*)(b + 8); nx3 = *(const f32x4*)(b + 12); } }
#pragma unroll
        for (int m = 0; m < 16; ++m) v[m] = __builtin_bit_cast(float, (__builtin_bit_cast(unsigned, v[m]) & ~127u) | (unsigned)(16 * j8 + m));
#define P7_CE(A, B) do { const float hi_ = fmaxf(v[A], v[B]), lo_ = fminf(v[A], v[B]); v[A] = hi_; v[B] = lo_; } while (0)
        P7_CE(0, 13); P7_CE(1, 12); P7_CE(2, 15); P7_CE(3, 14); P7_CE(4, 8); P7_CE(5, 6); P7_CE(7, 11); P7_CE(9, 10);
        P7_CE(0, 5); P7_CE(1, 7); P7_CE(2, 9); P7_CE(3, 4); P7_CE(6, 13); P7_CE(8, 14); P7_CE(10, 15); P7_CE(11, 12);
        P7_CE(0, 1); P7_CE(2, 3); P7_CE(4, 5); P7_CE(6, 8); P7_CE(7, 9); P7_CE(10, 11); P7_CE(12, 13); P7_CE(14, 15);
        P7_CE(0, 2); P7_CE(1, 3); P7_CE(4, 10); P7_CE(5, 11); P7_CE(6, 7); P7_CE(8, 9); P7_CE(12, 14); P7_CE(13, 15);
        P7_CE(1, 2); P7_CE(3, 12); P7_CE(4, 6); P7_CE(5, 7); P7_CE(8, 10); P7_CE(9, 11); P7_CE(13, 14);
        P7_CE(1, 4); P7_CE(2, 6); P7_CE(5, 8); P7_CE(7, 10); P7_CE(9, 13); P7_CE(11, 14);
        P7_CE(2, 4); P7_CE(3, 6); P7_CE(9, 12); P7_CE(11, 13);
        P7_CE(3, 5); P7_CE(6, 8); P7_CE(7, 9); P7_CE(10, 12);
        P7_CE(3, 4); P7_CE(5, 6); P7_CE(7, 8); P7_CE(9, 10); P7_CE(11, 12);
        P7_CE(6, 7); P7_CE(8, 9);
#define P7_MERGE(CTRL) do { float t_[16]; \
            _Pragma("unroll") for (int i = 0; i < 16; ++i) t_[i] = fmaxf(v[i], dpp_f<CTRL, 0xf>(v[15 - i], v[15 - i])); \
            _Pragma("unroll") for (int i = 0; i < 16; ++i) v[i] = t_[i]; \
            _Pragma("unroll") for (int j = 8; j >= 1; j >>= 1) _Pragma("unroll") for (int i = 0; i < 16; ++i) if ((i & j) == 0) P7_CE(i, i + j); } while (0)
        P7_MERGE(0xB1); P7_MERGE(0x4E); P7_MERGE(0x141);
#undef P7_MERGE
#undef P7_CE
        if (j8 == 0) {
#pragma unroll
            for (int q = 0; q < 4; ++q) *(LAS f32x4*)(sl + g8 * 16 + 4 * q) = (f32x4){v[4 * q], v[4 * q + 1], v[4 * q + 2], v[4 * q + 3]};
        }
        LDS_WAIT(); asm volatile("" ::: "memory");
        float cv[4], og[4]; int id[4];
#pragma unroll
        for (int m = 0; m < 4; ++m) {
            const float s1 = sl[(2 * row) * 16 + ci[m]], s2 = sl[(2 * row + 1) * 16 + cj[m]];
            og[m] = cval[m] ? (s1 + s2) : NEG; cv[m] = og[m];
            id[m] = (int)((__builtin_bit_cast(unsigned, s1) & 127u) * 128u + (__builtin_bit_cast(unsigned, s2) & 127u));
        }
        LDS_WAIT(); asm volatile("" ::: "memory");
        float M0 = 0.f;
#pragma unroll
        for (int k = 0; k < 16; ++k) {
            float mx = fmaxf(fmaxf(cv[0], cv[1]), fmaxf(cv[2], cv[3]));
            mx = fmaxf(mx, dpp_f<0xB1, 0xf>(mx, mx));
            mx = fmaxf(mx, dpp_f<0x4E, 0xf>(mx, mx));
            mx = fmaxf(mx, dpp_f<0x141, 0xf>(mx, mx));
            mx = fmaxf(mx, dpp_f<0x140, 0xf>(mx, mx));
            if (k == 0) M0 = mx;
#pragma unroll
            for (int m = 0; m < 4; ++m) cv[m] = (cv[m] == mx) ? NEG : cv[m];
        }
        bool sel[4]; float e[4]; float es = 0.f;
#pragma unroll
        for (int m = 0; m < 4; ++m) { sel[m] = (cv[m] != og[m]); e[m] = sel[m] ? __expf(og[m] - M0) : 0.f; es += e[m]; }
        es += dpp_f<0xB1, 0xf>(0.f, es); es += dpp_f<0x4E, 0xf>(0.f, es); es += dpp_f<0x141, 0xf>(0.f, es); es += dpp_f<0x140, 0xf>(0.f, es);
        const float inv = 1.0f / es;
        int basepos = 0;
        const int head = 4 * hh + row;
#pragma unroll
        for (int m = 0; m < 4; ++m) {
            const unsigned long long bl = __ballot(sel[m]);
            const unsigned rbits = (unsigned)(bl >> (16 * row)) & 0xffffu;
            const int pos = basepos + __popc(rbits & ((1u << i16) - 1u));
            if (sel[m] && pos < 16) { ex[(size_t)t * 128 + head * 16 + pos] = id[m]; gt[(size_t)t * 128 + head * 16 + pos] = e[m] * inv; }
            basepos += __popc(rbits);
        }
    }
}

typedef __bf16 bf16x32v __attribute__((ext_vector_type(32)));
typedef __bf16 bf16x2v __attribute__((ext_vector_type(2)));
typedef float f32x2 __attribute__((ext_vector_type(2)));
#ifndef P8_THROTTLE
#define P8_THROTTLE 0
#endif
constexpr unsigned P8_SLACK = 12;
#ifndef P8_SWEEPSYNC
#define P8_SWEEPSYNC 1
#endif
#ifndef P8_MIDSYNC
#define P8_MIDSYNC 2
#endif
__device__ __forceinline__ void phase8(const Params& p, LAS unsigned char* lds, float* dst, const XcdBarrier& xb, int gw, int NGW, int wave, int lane) {
    unsigned char* ws = p.ws;
    const bf16_t* x1b = (const bf16_t*)(ws + WS_X1B); const unsigned char* UT = ws + WS_UT; const unsigned char* VT = ws + WS_VT;
    const int* ex = (const int*)(ws + WS_EXP); const float* gt = (const float*)(ws + WS_GATE); const float* ss2 = (const float*)(ws + WS_ROWSS) + 3 * S;
    const float* out = p.out;
    LAS unsigned* list = (LAS unsigned*)(lds + 131072 + wave * 2048);
    LAS unsigned* hist = (LAS unsigned*)(lds + 147456 + wave * 1024);
    for (int tb = gw; tb < S / 4; tb += NGW) {
        const int t0 = tb * 4;
        int id[8]; float gv[8];
#pragma unroll
        for (int r = 0; r < 8; ++r) { const size_t o = (size_t)(t0 + (r >> 1)) * 128 + (r & 1) * 64 + lane; id[r] = ex[o]; gv[r] = gt[o]; }
        const float rs0 = rsqrtf(ss2[t0 + 0] * (1.0f / DM) + EPS) * (1.0f / PEER_USC), rs1 = rsqrtf(ss2[t0 + 1] * (1.0f / DM) + EPS) * (1.0f / PEER_USC);
        const float rs2 = rsqrtf(ss2[t0 + 2] * (1.0f / DM) + EPS) * (1.0f / PEER_USC), rs3 = rsqrtf(ss2[t0 + 3] * (1.0f / DM) + EPS) * (1.0f / PEER_USC);
#pragma unroll
        for (int j = 0; j < 4; ++j) hist[j * 64 + lane] = 0u;
        LDS_WAIT(); asm volatile("" ::: "memory");
        unsigned pos[8];
#pragma unroll
        for (int r = 0; r < 8; ++r) pos[r] = __hip_atomic_fetch_add(hist + (r >> 1) * 64 + (id[r] >> 8), 1u, __ATOMIC_RELAXED, __HIP_MEMORY_SCOPE_WORKGROUP);
        LDS_WAIT(); asm volatile("" ::: "memory");
        unsigned cnt[4], inc[4];
#pragma unroll
        for (int j = 0; j < 4; ++j) { cnt[j] = hist[j * 64 + lane]; inc[j] = cnt[j]; }
#pragma unroll
        for (int o = 1; o < 64; o <<= 1)
#pragma unroll
            for (int j = 0; j < 4; ++j) { const unsigned n = __shfl_up(inc[j], o); if (lane >= o) inc[j] += n; }
        LDS_WAIT(); asm volatile("" ::: "memory");
#pragma unroll
        for (int j = 0; j < 4; ++j) hist[j * 64 + lane] = inc[j] - cnt[j];
        LDS_WAIT(); asm volatile("" ::: "memory");
#pragma unroll
        for (int r = 0; r < 8; ++r) { const unsigned d = hist[(r >> 1) * 64 + (id[r] >> 8)] + pos[r]; list[4u * d + (unsigned)(r >> 1)] = (unsigned)id[r] | ((unsigned)(r >> 1) << 14) | (f2bf(gv[r]) << 16); }
        LDS_WAIT(); asm volatile("" ::: "memory");
        {
            typedef unsigned u32x16 __attribute__((ext_vector_type(16)));
            const __amdgpu_buffer_rsrc_t urs = __builtin_amdgcn_make_buffer_rsrc((void*)UT, 0, 16384 * PEER_ROWB, 0x00020000);
            const int vo4 = lane * 16, vo2 = lane * 8 + 1024;
            const bool lb0 = (lane & 1) != 0, lb1 = (lane & 2) != 0, lb2 = (lane & 4) != 0;
            s16x4 xr[4][8];
#pragma unroll
            for (int j = 0; j < 4; ++j)
#pragma unroll
                for (int q = 0; q < 8; ++q) xr[j][q] = __builtin_bit_cast(s16x4, *(const u32x2*)(x1b + (size_t)(t0 + j) * DM + (q * 64 + lane) * 4));
#define P8_ULOAD(k, i) do { const unsigned en = (unsigned)__builtin_amdgcn_readfirstlane((int)list[(i)]); const int ro = (int)((en & 0x3fffu) * (unsigned)PEER_ROWB); \
            u4[k] = __builtin_amdgcn_raw_buffer_load_b128(urs, vo4, ro, 0); u2[k] = __builtin_amdgcn_raw_buffer_load_b64(urs, vo2, ro, 0); } while (0)
#define P8_UPROC2(k, dk) do { const u32x6 pk = {u4[k][0], u4[k][1], u4[k][2], u4[k][3], u2[k][0], u2[k][1]}; \
            const u32x16 r_ = __builtin_bit_cast(u32x16, __builtin_amdgcn_cvt_scalef32_pk32_bf16_fp6(pk, 1.0f)); \
            f32x4 a0 = {0.f, 0.f, 0.f, 0.f}, a1 = {0.f, 0.f, 0.f, 0.f}; \
            _Pragma("unroll") for (int q = 0; q < 8; q += 2) { \
                a0 = __builtin_amdgcn_mfma_f32_4x4x4bf16_1k(__builtin_bit_cast(s16x4, (u32x2){r_[2 * q], r_[2 * q + 1]}), xr[(k) & 3][q], a0, 0, 0, 0); \
                a1 = __builtin_amdgcn_mfma_f32_4x4x4bf16_1k(__builtin_bit_cast(s16x4, (u32x2){r_[2 * q + 2], r_[2 * q + 3]}), xr[(k) & 3][q + 1], a1, 0, 0, 0); } \
            const f32x4 a_ = a0 + a1; \
            const float e0 = lb0 ? a_[1] : a_[0], e1 = lb0 ? a_[3] : a_[2]; dd[dk] = lb1 ? e1 : e0; } while (0)
#ifndef P8_URING
#define P8_URING 8
#endif
#if (PROBE_DUP >> 10) & 1
#define P8_UREPS 2
#else
#define P8_UREPS 1
#endif
#pragma unroll 1
            for (int urep = 0; urep < P8_UREPS; ++urep) {
                u32x4 u4[P8_URING]; u32x2 u2[P8_URING];
#pragma unroll
                for (int k = 0; k < P8_URING; ++k) P8_ULOAD(k, k);
#pragma unroll 1
                for (int i0 = 0; i0 < 512; i0 += P8_URING) {
                    if (P8_SWEEPSYNC && i0 == 256 && NGW == S / 4) xcd_local_barrier(xb);
#pragma unroll
                    for (int hb = 0; hb < P8_URING / 8; ++hb) {
                        const int i = i0 + 8 * hb;
                        const unsigned ev = list[i + (lane & 7)]; const unsigned jl = (unsigned)lane & 3u;
                        const float gl = __builtin_bit_cast(float, ev & 0xffff0000u), rl = jl == 0u ? rs0 : (jl == 1u ? rs1 : (jl == 2u ? rs2 : rs3));
                        float dd[8];
#pragma unroll
                        for (int k = 0; k < 8; ++k) { P8_UPROC2(8 * hb + k, k); const int nx = i + P8_URING + k; P8_ULOAD(8 * hb + k, nx < 512 ? nx : 508 + (k & 3)); }
                        float w4[4], w2[2];
#pragma unroll
                        for (int q = 0; q < 4; ++q) { const float kp = lb2 ? dd[q + 4] : dd[q], sd = lb2 ? dd[q] : dd[q + 4]; w4[q] = kp + __shfl_xor(sd, 4); }
#pragma unroll
                        for (int q = 0; q < 2; ++q) { const float kp = lb1 ? w4[q + 2] : w4[q], sd = lb1 ? w4[q] : w4[q + 2]; w2[q] = kp + __shfl_xor(sd, 2); }
                        float dres; { const float kp = lb0 ? w2[1] : w2[0], sd = lb0 ? w2[0] : w2[1]; dres = kp + __shfl_xor(sd, 1); }
                        dres += __shfl_xor(dres, 8); dres += __shfl_xor(dres, 16); dres += __shfl_xor(dres, 32);
                        const float c_ = gl * gelu_tanh(rl * dres) * (1.0f / PEER_VSC);
                        if (lane < 8 && urep == P8_UREPS - 1) list[i + lane] = (ev & 0xffffu) | (f2bf(c_) << 16);
                    }
                }
            }
#undef P8_ULOAD
#undef P8_UPROC2
        }
        asm volatile("s_waitcnt vmcnt(0)" ::: "memory");
        LDS_WAIT(); asm volatile("" ::: "memory");
#if P8_MIDSYNC == 1
        __syncthreads();
#elif P8_MIDSYNC == 2
        if (NGW == S / 4) xcd_local_barrier(xb);
#endif
        f32x4 acc[4][8];
#if (PROBE_DUP >> 12) & 1
#define P8_VREPS 2
#else
#define P8_VREPS 1
#endif
#ifndef P8_VRING
#define P8_VRING 8
#endif
#pragma unroll 1
        for (int vrep = 0; vrep < P8_VREPS; ++vrep) {
#pragma unroll
        for (int j = 0; j < 4; ++j)
#pragma unroll
            for (int q = 0; q < 8; ++q) acc[j][q] = (f32x4){0.f, 0.f, 0.f, 0.f};
        {
            typedef unsigned u32x16 __attribute__((ext_vector_type(16)));
            u32x4 v4[P8_VRING]; u32x2 v2[P8_VRING]; unsigned ven[P8_VRING];
            const unsigned li = (unsigned)lane & 3u;
            const unsigned m0 = li == 0u ? 0x0000ffffu : (li == 1u ? 0xffff0000u : 0u), m1 = li == 2u ? 0x0000ffffu : (li == 3u ? 0xffff0000u : 0u);
            const __amdgpu_buffer_rsrc_t vrs = __builtin_amdgcn_make_buffer_rsrc((void*)VT, 0, 16384 * PEER_ROWB, 0x00020000);
            const int vo4 = lane * 16, vo2 = lane * 8 + 1024;
#define P8_VLOAD(k, i) do { const unsigned en = (unsigned)__builtin_amdgcn_readfirstlane((int)list[(i)]); ven[k] = en; const int ro = (int)((en & 0x3fffu) * (unsigned)PEER_ROWB); \
            v4[k] = __builtin_amdgcn_raw_buffer_load_b128(vrs, vo4, ro, 0); v2[k] = __builtin_amdgcn_raw_buffer_load_b64(vrs, vo2, ro, 0); } while (0)
#define P8_VPROC(k) do { const u32x6 pk = {v4[k][0], v4[k][1], v4[k][2], v4[k][3], v2[k][0], v2[k][1]}; \
            const u32x16 r_ = __builtin_bit_cast(u32x16, __builtin_amdgcn_cvt_scalef32_pk32_bf16_fp6(pk, 1.0f)); \
            const unsigned e_ = ven[k], cf = (e_ >> 16) | (e_ & 0xffff0000u); \
            const s16x4 av = __builtin_bit_cast(s16x4, (u32x2){cf & m0, cf & m1}); \
            _Pragma("unroll") for (int q = 0; q < 8; ++q) \
                acc[(k) & 3][q] = __builtin_amdgcn_mfma_f32_4x4x4bf16_1k(av, __builtin_bit_cast(s16x4, (u32x2){r_[2 * q], r_[2 * q + 1]}), acc[(k) & 3][q], 0, 0, 0); } while (0)
#pragma unroll
            for (int k = 0; k < P8_VRING; ++k) P8_VLOAD(k, k);
#pragma unroll 1
            for (int i = 0; i < 512 - 512 % P8_VRING; i += P8_VRING) {
                if (P8_SWEEPSYNC && i == 256 && NGW == S / 4) xcd_local_barrier(xb);
#pragma unroll
                for (int k = 0; k < P8_VRING; ++k) { P8_VPROC(k); const int nx = i + P8_VRING + k; P8_VLOAD(k, nx < 512 ? nx : 508 + (k & 3)); }
            }
#pragma unroll
            for (int k = 0; k < 512 % P8_VRING; ++k) P8_VPROC(k);
#undef P8_VLOAD
#undef P8_VPROC
        }
        }
        int tq = t0, lq = lane; asm volatile("" : "+s"(tq)); asm volatile("" : "+v"(lq));
#pragma unroll
        for (int j = 0; j < 4; ++j)
#pragma unroll
            for (int i = 0; i < 8; ++i) {
                const size_t o = (size_t)(tq + j) * DM + (i * 64 + lq) * 4;
                const u32x2 xw = *(const u32x2*)(x1b + o);
                f32x4 a = {bflo(xw.x), bfhi(xw.x), bflo(xw.y), bfhi(xw.y)};
                a += acc[j][i];
                __builtin_nontemporal_store(a, (f32x4*)(dst + o));
                if (i & 1) asm volatile("" ::: "memory");
            }
        LDS_WAIT(); asm volatile("" ::: "memory");
    }
}

__global__ void __launch_bounds__(NTHREADS, 2) mega(Params p) {
    extern __shared__ __attribute__((aligned(16))) unsigned char lds_raw[];
    LAS unsigned char* lds = (LAS unsigned char*)lds_raw;
    const int tid = threadIdx.x, lane = tid & 63, wave = __builtin_amdgcn_readfirstlane(tid >> 6);
    const int G = gridDim.x, bx = blockIdx.x;
    const int gw = bx * 8 + wave, NGW = G * 8;
    unsigned char* ws = p.ws;
    const int lo = p.ph_lo, hi = p.ph_hi;
    volatile LAS unsigned* misc = (volatile LAS unsigned*)(lds + LDS_MISC);
    if (tid < 4) misc[tid] = 0u;
    __syncthreads();
    const XcdBarrier xbar = xcd_barrier_post((unsigned*)(ws + WS_CTL), misc);
#ifndef PH_MASK
#define PH_MASK 0x1ff
#endif
#define IN(k) (((PH_MASK >> (k)) & 1) && lo <= (k) && (k) < hi)
#define SEAM(k) do { if (IN(k) && IN((k) + 1)) xcd_barrier(xbar); } while (0)

#if (PROBE_DUP >> 0) & 1
    if (IN(0)) { phase0(p, lds, G == 256, gw, NGW, wave, lane); xcd_barrier(xbar); }
#endif
    if (IN(0)) phase0(p, lds, G == 256, gw, NGW, wave, lane);
    SEAM(0);
    const bool part = (G == 256) && (misc[2] != 0u);
    const int vx = __builtin_amdgcn_readfirstlane(part ? (int)xbar.x : (bx & 7)), vr = __builtin_amdgcn_readfirstlane(part ? (int)misc[3] : (bx >> 3));
    const int vpanel = (vr >> 3) == 0 ? vx : ((vr >> 3) == 1 ? 31 - vx : ((vr >> 3) == 2 ? vx + 8 : 23 - vx));
    const int gwv = (G == 256) ? vpanel * 64 + (vr & 7) * 8 + wave : gw;
#define SEAM_X(k) do { if (IN(k) && IN((k) + 1)) { if (part) xcd_local_barrier_acq(xbar); else xcd_barrier(xbar); } } while (0)
    if (IN(1)) {
        pg8::Gemm g{(const bf16_t*)(ws + WS_XB), (const bf16_t*)(ws + WS_WIN), S, NINP, DM, DM, DM};
        pg8::StaticOrder So; So.init(S, NINP, G, bx);
        pg8::Epi<1> E{(const float*)(ws + WS_RSTD1), 0.f, (float*)(ws + WS_ROWSS), (bf16_t*)(ws + WS_PROJ), NINP, nullptr, nullptr};
#if (PROBE_DUP >> 1) & 1
        { pg8::Epi<1> E2 = E; E2.ss = (float*)(ws + 512 * 1024); pg8::gemm_phase<pg8::Epi<1>, pg8::StaticOrder, true, true>(lds, g, So, E2); xcd_barrier(xbar); }
#endif
        pg8::gemm_phase<pg8::Epi<1>, pg8::StaticOrder, true, true>(lds, g, So, E);
        if (G == 256 && bx >= 128) { __syncthreads(); prep_late(p, lds, (bx - 128) * 8 + wave, 1024, wave, lane); }
    }
    SEAM(1);
    if (IN(2)) {
        {
            pg8::Gemm g{(const bf16_t*)(ws + WS_PROJ) + 2048, (const bf16_t*)(ws + WS_WUQ), S, 1536, 512, NINP, 512};
            pg8::StaticOrder So; So.init(S, 1536, G, bx);
            pg8::Epi<2> E{(const float*)(ws + WS_ROWSS) + 1 * S, 1.0f / 512.0f, nullptr, (bf16_t*)(ws + WS_QRAW), 1536, nullptr, nullptr};
            pg8::gemm_phase<pg8::Epi<2>, pg8::StaticOrder, true, true>(lds, g, So, E);
        }
        __syncthreads();
        {
            pg8::Gemm g{(const bf16_t*)(ws + WS_PROJ) + 2560, (const bf16_t*)(ws + WS_WUKV), S, 2048, 256, NINP, 256};
            pg8::StaticOrder So; So.init(S, 2048, G, bx);
            pg8::Epi<2> E{(const float*)(ws + WS_ROWSS) + 2 * S, 1.0f / 256.0f, nullptr, (bf16_t*)(ws + WS_KVRAW), 2048, nullptr, nullptr};
            pg8::gemm_phase<pg8::Epi<2>, pg8::StaticOrder, true, true>(lds, g, So, E);
        }
    }
    SEAM(2);
#if (PROBE_DUP >> 3) & 1
    if (IN(3)) { phase3(p, gw, NGW, (S - gw + NGW - 1) / NGW, lane); xcd_barrier(xbar); }
#endif
    if (IN(3)) phase3(p, gw, NGW, (S - gw + NGW - 1) / NGW, lane);
    SEAM(3);
    const int vP = (vr >> 4) ? vx + 8 : vx, vqa = ((vr >> 3) & 1) ? 62 - 2 * vP : 63 - 2 * vP, vqb = ((vr >> 3) & 1) ? 2 * vP + 1 : 2 * vP;
#define P4_BODY_ATT do { if (G == 256) { attn_unit(p, lds, vr & 7, vqa, tid, wave, lane); attn_unit(p, lds, vr & 7, vqb, tid, wave, lane); } \
        else for (int pr = bx; pr < 256; pr += G) { const int head = pr & 7, x = pr >> 3; attn_unit(p, lds, head, 63 - x, tid, wave, lane); attn_unit(p, lds, head, x, tid, wave, lane); } } while (0)
#define P4_BODY_GMLP do { if (G == 256) { gmlp_unit(p, lds, vqa, vr & 7, tid, wave, lane); gmlp_unit(p, lds, vqb, vr & 7, tid, wave, lane); } \
        else for (int u = bx; u < 512; u += G) gmlp_unit(p, lds, u >> 3, u & 7, tid, wave, lane); } while (0)
#if (PROBE_DUP >> 4) & 1
    if (IN(4)) { P4_BODY_ATT; xcd_barrier(xbar); }
#endif
#if (PROBE_DUP >> 9) & 1
    if (IN(4)) { P4_BODY_GMLP; xcd_barrier(xbar); }
#endif
    if (IN(4)) { P4_BODY_ATT; P4_BODY_GMLP; }
    SEAM_X(4);
    if (IN(5)) {
        pg8::Gemm g{(const bf16_t*)(ws + WS_MIX), (const bf16_t*)(ws + WS_WOUT), S, DM, DM, DM, DM};
        pg8::StaticOrder So; So.init(S, DM, G, bx); if (G == 256) So.fixed(vpanel, vr & 7);
        pg8::Epi<4> E{nullptr, 0.f, (float*)(ws + WS_ROWSS) + 3 * S, (bf16_t*)(ws + WS_X1B), DM, p.out, p.in[0]};
#if (PROBE_DUP >> 5) & 1
        { pg8::Epi<4> E2 = E; E2.ss = (float*)(ws + 512 * 1024); pg8::gemm_phase<pg8::Epi<4>, pg8::StaticOrder, true, true>(lds, g, So, E2); xcd_barrier(xbar); }
#endif
        pg8::gemm_phase<pg8::Epi<4>, pg8::StaticOrder, true, true>(lds, g, So, E);
    }
    SEAM_X(5);
    if (IN(6)) {
        pg8::Gemm g{(const bf16_t*)(ws + WS_X1B), (const bf16_t*)(ws + WS_WS), S, DM, DM, DM, DM};
        pg8::StaticOrder So; So.init(S, DM, G, bx); if (G == 256) So.fixed(vpanel, vr & 7);
        pg8::Epi<5> E{(const float*)(ws + WS_ROWSS) + 3 * S, 1.0f / DM, nullptr, nullptr, DM, (float*)(ws + WS_SC), nullptr};
#if (PROBE_DUP >> 6) & 1
        { pg8::gemm_phase<pg8::Epi<5>, pg8::StaticOrder, true, true>(lds, g, So, E); xcd_barrier(xbar); }
#endif
        pg8::gemm_phase<pg8::Epi<5>, pg8::StaticOrder, true, true>(lds, g, So, E);
    }
    SEAM_X(6);
#if (PROBE_DUP >> 7) & 1
    if (IN(7)) { phase7(p, lds, gwv, NGW, wave, lane); xcd_barrier(xbar); }
#endif
    if (IN(7)) phase7(p, lds, gwv, NGW, wave, lane);
    if (IN(7) && IN(8)) { if (NGW == S / 4) xcd_local_barrier(xbar); else xcd_barrier(xbar); }
#if (PROBE_DUP >> 8) & 1
    if (IN(8)) { phase8(p, lds, (float*)(ws + WS_SC), xbar, gwv, NGW, wave, lane); xcd_barrier(xbar); }
#endif
    if (IN(8)) phase8(p, lds, p.out, xbar, gwv, NGW, wave, lane);
#undef IN
#undef SEAM
#undef SEAM_X
}

extern "C" void kernel_launch(void* const* d_in, const int* in_sizes, int n_in, void* d_out, int out_size, void* d_ws, size_t ws_size, hipStream_t stream) {
    static int grid = 0;
    if (grid == 0) {
        if (n_in != 18 || out_size != S * DM || ws_size < WS_END) { fprintf(stderr, "kernel_launch: unexpected shapes (n_in %d out %d ws %zu)\n", n_in, out_size, ws_size); grid = -1; return; }
        int dev = 0, cus = 0, per_cu = 0;
        hipGetDevice(&dev);
        hipDeviceGetAttribute(&cus, hipDeviceAttributeMultiprocessorCount, dev);
        if (hipFuncSetAttribute((const void*)mega, hipFuncAttributeMaxDynamicSharedMemorySize, LDS_BYTES) != hipSuccess) { fprintf(stderr, "kernel_launch: hipFuncSetAttribute failed\n"); grid = -1; return; }
        if (hipOccupancyMaxActiveBlocksPerMultiprocessor(&per_cu, (const void*)mega, NTHREADS, LDS_BYTES) != hipSuccess || per_cu < 1) { fprintf(stderr, "kernel_launch: occupancy query failed (%d)\n", per_cu); grid = -1; return; }
        grid = cus;
        fprintf(stderr, "kernel_launch: cus %d per_cu %d grid %d\n", cus, per_cu, grid);
    }
    if (grid < 0) return;
    hipMemsetAsync((char*)d_ws + WS_CTL, 0, 1 * MiB, stream);
    Params prm{};
    for (int i = 0; i < 18; ++i) prm.in[i] = (const float*)d_in[i];
    prm.out = (float*)d_out; prm.ws = (unsigned char*)d_ws;
#if MK_ONE_LAUNCH
    prm.ph_lo = 0; prm.ph_hi = NPH;
    { void* args[] = {&prm}; hipError_t e = hipLaunchCooperativeKernel((const void*)mega, dim3(grid), dim3(NTHREADS), args, LDS_BYTES, stream);
      if (e != hipSuccess) fprintf(stderr, "cooperative launch failed: %s\n", hipGetErrorString(e)); }
#else
    for (int ph = 0; ph < NPH; ++ph) {
        prm.ph_lo = ph; prm.ph_hi = ph + 1;
        void* args[] = {&prm};
        hipError_t e = hipLaunchCooperativeKernel((const void*)mega, dim3(grid), dim3(NTHREADS), args, LDS_BYTES, stream);
        if (e != hipSuccess) { fprintf(stderr, "cooperative launch %d failed: %s\n", ph, hipGetErrorString(e)); break; }
    }
#endif
}
```

```cpp
#include <hip/hip_runtime.h>
#include <cstdio>
#include <cstdint>

#define LAS __attribute__((address_space(3)))
typedef unsigned short bf16_t;
typedef short bf16x8 __attribute__((ext_vector_type(8)));
typedef short s16x4 __attribute__((ext_vector_type(4)));
typedef float f32x4 __attribute__((ext_vector_type(4)));
typedef float f32x16 __attribute__((ext_vector_type(16)));
typedef unsigned u32x4 __attribute__((ext_vector_type(4)));
typedef unsigned u32x2 __attribute__((ext_vector_type(2)));

#ifndef PROBE_DUP
#define PROBE_DUP 0
#endif
#ifndef MK_ONE_LAUNCH
#define MK_ONE_LAUNCH 1
#endif

constexpr int S = 8192, DM = 2048, NIN = 2880, NINP = 3072;
constexpr int NPH = 9;
constexpr float EPS = 1e-6f;
constexpr int LDS_BYTES = 163840;
constexpr int NTHREADS = 512;
constexpr int LDS_MISC = 161792;

constexpr size_t MiB = 1u << 20;
constexpr size_t WS_CTL = 0;
constexpr size_t WS_ROWSS = 128 * 1024;
constexpr size_t WS_COS = 1 * MiB, WS_SIN = 2 * MiB;
constexpr size_t WS_RSTD1 = 3 * MiB;
constexpr size_t WS_EXP = 4 * MiB;
constexpr size_t WS_GATE = 8 * MiB;
constexpr size_t WS_WIN = 12 * MiB;
constexpr size_t WS_WUQ = 24 * MiB;
constexpr size_t WS_WUKV = 26 * MiB;
constexpr size_t WS_WOUT = 28 * MiB;
constexpr size_t WS_WS = 36 * MiB;
constexpr size_t WS_XB = 44 * MiB;
constexpr size_t WS_PROJ = 76 * MiB;
constexpr size_t WS_QRAW = 124 * MiB;
constexpr size_t WS_KVRAW = 148 * MiB;
constexpr size_t WS_QH = 180 * MiB;
constexpr size_t WS_KH = 204 * MiB;
constexpr size_t WS_VH = 228 * MiB;
constexpr size_t WS_MIX = 244 * MiB;
constexpr size_t WS_X1B = 276 * MiB;
constexpr size_t WS_SC = 308 * MiB;
constexpr size_t WS_UT = 372 * MiB;
constexpr size_t WS_VT = 436 * MiB;
constexpr size_t WS_END = 500 * MiB;

__device__ __forceinline__ unsigned f2bf(float f) { unsigned u = __builtin_bit_cast(unsigned, f); return (u + 0x7fffu + ((u >> 16) & 1u)) >> 16; }
__device__ __forceinline__ unsigned pk2(float lo, float hi) { return f2bf(lo) | (f2bf(hi) << 16); }
__device__ __forceinline__ float bf2f(unsigned short b) { return __builtin_bit_cast(float, (unsigned)b << 16); }
__device__ __forceinline__ float bflo(unsigned w) { return __builtin_bit_cast(float, w << 16); }
__device__ __forceinline__ float bfhi(unsigned w) { return __builtin_bit_cast(float, w & 0xffff0000u); }
__device__ __forceinline__ float wave_sum(float v) {
#pragma unroll
    for (int o = 32; o > 0; o >>= 1) v += __shfl_xor(v, o);
    return v;
}
__device__ __forceinline__ float wave_max(float v) {
#pragma unroll
    for (int o = 32; o > 0; o >>= 1) v = fmaxf(v, __shfl_xor(v, o));
    return v;
}
template <int CTRL, int ROW_MASK> __device__ __forceinline__ float dpp_f(float old, float v) {
    return __builtin_bit_cast(float, __builtin_amdgcn_update_dpp(__builtin_bit_cast(int, old), __builtin_bit_cast(int, v), CTRL, ROW_MASK, 0xf, false));
}
__device__ __forceinline__ float wave_max_u(float v) {
    v = fmaxf(v, dpp_f<0xB1, 0xf>(v, v));
    v = fmaxf(v, dpp_f<0x4E, 0xf>(v, v));
    v = fmaxf(v, dpp_f<0x141, 0xf>(v, v));
    v = fmaxf(v, dpp_f<0x140, 0xf>(v, v));
    v = fmaxf(v, dpp_f<0x142, 0xa>(v, v));
    v = fmaxf(v, dpp_f<0x143, 0xc>(v, v));
    return __builtin_bit_cast(float, __builtin_amdgcn_readlane(__builtin_bit_cast(int, v), 63));
}
__device__ __forceinline__ float wave_sum_u(float v) {
    v += dpp_f<0xB1, 0xf>(0.f, v);
    v += dpp_f<0x4E, 0xf>(0.f, v);
    v += dpp_f<0x141, 0xf>(0.f, v);
    v += dpp_f<0x140, 0xf>(0.f, v);
    v += dpp_f<0x142, 0xa>(0.f, v);
    v += dpp_f<0x143, 0xc>(0.f, v);
    return __builtin_bit_cast(float, __builtin_amdgcn_readlane(__builtin_bit_cast(int, v), 63));
}
__device__ __forceinline__ float gelu_tanh(float x) {
    const float y = 0.7978845608028654f * (x + 0.044715f * x * x * x);
    return x / (1.0f + __expf(-2.0f * y));
}
__device__ __forceinline__ int crow(int r, int hi) { return (r & 3) + 8 * (r >> 2) + 4 * hi; }
#define LDS_WAIT() asm volatile("s_waitcnt lgkmcnt(0)" ::: "memory")
#define SBAR() __builtin_amdgcn_sched_barrier(0)

namespace pg8 {
#define PG8_LAS __attribute__((address_space(3)))
constexpr int BM = 256, BK = 64, HALF = 128, HTB = HALF * BK * 2  , STAGE_BYTES = 8 * HTB, NXCD = 8, WGM = 8;

__host__ __device__ __forceinline__ int lds_byte(int r, int c) { const int st = (r >> 4) * 2 + (c >> 5), rr = r & 15, cc = c & 31, ob = rr * 64 + cc * 2; return st * 1024 + (ob ^ (((ob >> 9) & 1) << 5)); }
__host__ __device__ __forceinline__ void stage_rc(int b, int& R, int& C) { const int st = b / 1024, sb = b % 1024, swz = sb ^ (((sb >> 9) & 1) << 5); R = (st >> 1) * 16 + swz / 64; C = (st & 1) * 32 + (swz % 64) / 2; }
__host__ __device__ __forceinline__ int perm32(int rho) { const int n = rho >> 4, i = rho & 15; return 8 * (i >> 2) + 4 * n + (i & 3); }

struct Unit { int pm, pn; };
struct Gemm { const bf16_t* A; const bf16_t* Bt; int M, N, K, lda, ldb; };

struct StaticOrder {
    int nM, nN, nwg, G, c, fpm = -1, fpn = 0;
    __host__ __device__ void init(int M, int N, int G_, int c_) { nM = M / BM; nN = N / BM; nwg = nM * nN; G = G_; c = c_; fpm = -1; }
    __host__ __device__ void fixed(int pm, int pn) { fpm = pm; fpn = pn; }
    __host__ __device__ bool next(int i, Unit& u) const {
        if (fpm >= 0) { if (i > 0) return false; u.pm = fpm; u.pn = fpn; return true; }
        const long L = (long)i * G + c; if (L >= nwg) return false;
        int wgid = (int)L; { const int q = nwg / NXCD, r = nwg % NXCD, xcd = wgid % NXCD, off = wgid / NXCD; wgid = (xcd < r ? xcd * (q + 1) : r * (q + 1) + (xcd - r) * q) + off; }
        const int nig = WGM * nN, gid = wgid / nig, fm = gid * WGM, gsz = (nM - fm) < WGM ? (nM - fm) : WGM;
        u.pm = fm + ((wgid % nig) % gsz); u.pn = (wgid % nig) / gsz; return true;
    }
    __device__ __forceinline__ void a_ready(const Unit&) const {}
    __device__ __forceinline__ void done(const Unit&) const {}
};

template <class Epi, class Sched, bool ALIGN_EPI = false, bool SP2 = false>
__device__ __forceinline__ void gemm_phase(PG8_LAS unsigned char* lds, const Gemm g, const Sched& S, const Epi& E) {
    const int tid = threadIdx.x, wid = __builtin_amdgcn_readfirstlane(tid >> 6), lane = tid & 63, wr = wid >> 2, wc = wid & 3, fr = lane & 15, fq = lane >> 4;
    const int K = g.K, nt = K / BK;
    unsigned voffA[2], voffB[2];
#pragma unroll
    for (int i = 0; i < 2; ++i) { int R, C; stage_rc(tid * 16 + i * 8192, R, C); const int Rb = Epi::PERM ? ((R & ~31) + perm32(R & 31)) : R;
        voffA[i] = (unsigned)(R * g.lda + C) * 2u; voffB[i] = (unsigned)(Rb * g.ldb + C) * 2u; }
    const size_t kstep = (size_t)(BK * 2);
    const size_t hstepA = (size_t)HALF * g.lda * 2, hstepB = (size_t)HALF * g.ldb * 2;
    const size_t tstepA = 2 * hstepA, tstepB = 2 * hstepB;
    const unsigned ldsw = (unsigned)wid * 1024u;
    const int aoff = lds_byte(wr * 64 + fr, fq * 8), boff = lds_byte(wc * 32 + fr, fq * 8);
#define PG8_SA(b, h) (((b) * 2 + (h)) * HTB)
#define PG8_SB(b, h) ((4 + (b) * 2 + (h)) * HTB)
#define PG8_STAGE(bufoff, gbase, voff) do { _Pragma("unroll") for (int _i = 0; _i < 2; ++_i) \
        __builtin_amdgcn_global_load_lds((const unsigned*)((const char*)(gbase) + (voff)[_i]), (PG8_LAS unsigned*)(lds + (bufoff) + ldsw + _i * 8192), 16, 0, 0); } while (0)
#define PG8_LDA(dst, b, h) do { _Pragma("unroll") for (int m = 0; m < 4; ++m) _Pragma("unroll") for (int k = 0; k < 2; ++k) dst[m][k] = *(const PG8_LAS bf16x8*)(lds + PG8_SA(b, h) + aoff + m * 2048 + k * 1024); } while (0)
#define PG8_LDB(dst, b, h) do { _Pragma("unroll") for (int n = 0; n < 2; ++n) _Pragma("unroll") for (int k = 0; k < 2; ++k) dst[n][k] = *(const PG8_LAS bf16x8*)(lds + PG8_SB(b, h) + boff + n * 2048 + k * 1024); } while (0)
#define PG8_MMA(ai, bj, At, Bt) do { __builtin_amdgcn_s_setprio(1); _Pragma("unroll") for (int m = 0; m < 4; ++m) _Pragma("unroll") for (int n = 0; n < 2; ++n) _Pragma("unroll") for (int k = 0; k < 2; ++k) \
        acc[ai][bj][m][n] = __builtin_amdgcn_mfma_f32_16x16x32_bf16(Bt[n][k], At[m][k], acc[ai][bj][m][n], 0, 0, 0); __builtin_amdgcn_s_setprio(0); } while (0)
#define PG8_WAIT_V(n) asm volatile("s_waitcnt vmcnt(" #n ")" ::: "memory")
#define PG8_WAIT_L(n) asm volatile("s_waitcnt lgkmcnt(" #n ")" ::: "memory")
#define PG8_BAR __builtin_amdgcn_s_barrier()
#define PG8_SCHED __builtin_amdgcn_sched_barrier(0)
    Unit cur, nxt; int ui = 0;
    if (!S.next(0, cur)) return;
    f32x4 acc[2][2][4][2];
#pragma unroll
    for (int a = 0; a < 2; ++a)
#pragma unroll
        for (int b = 0; b < 2; ++b)
#pragma unroll
            for (int m = 0; m < 4; ++m)
#pragma unroll
                for (int n = 0; n < 2; ++n) acc[a][b][m][n] = (f32x4){0.f, 0.f, 0.f, 0.f};
    bf16x8 At[4][2], B0[2][2], B1[2][2];
    const char* cA = (const char*)g.A + (size_t)cur.pm * tstepA; const char* cB = (const char*)g.Bt + (size_t)cur.pn * tstepB;
    S.a_ready(cur);
    if constexpr (SP2) {
        PG8_STAGE(PG8_SB(0, 0), cB, voffB); PG8_STAGE(PG8_SB(0, 1), cB + hstepB, voffB); PG8_STAGE(PG8_SA(0, 0), cA, voffA); PG8_STAGE(PG8_SA(0, 1), cA + hstepA, voffA);
        if (wr == 1) PG8_BAR;
        PG8_WAIT_V(2); PG8_BAR;
        PG8_STAGE(PG8_SB(1, 0), cB + kstep, voffB); PG8_STAGE(PG8_SA(1, 0), cA + kstep, voffA); PG8_STAGE(PG8_SB(1, 1), cB + hstepB + kstep, voffB);
        PG8_WAIT_V(6); PG8_BAR;
    } else {
        PG8_STAGE(PG8_SB(0, 0), cB, voffB); PG8_STAGE(PG8_SA(0, 0), cA, voffA); PG8_STAGE(PG8_SB(0, 1), cB + hstepB, voffB); PG8_STAGE(PG8_SA(0, 1), cA + hstepA, voffA);
        if (wr == 1) PG8_BAR;
        PG8_WAIT_V(4); PG8_BAR;
        PG8_STAGE(PG8_SB(1, 0), cB + kstep, voffB); PG8_STAGE(PG8_SA(1, 0), cA + kstep, voffA); PG8_STAGE(PG8_SB(1, 1), cB + hstepB + kstep, voffB);
        PG8_WAIT_V(6); PG8_BAR;
    }
    for (;;) {
        const bool has_next = S.next(ui + 1, nxt);
        const char* nA = has_next ? (const char*)g.A + (size_t)nxt.pm * tstepA : cA; const char* nB = has_next ? (const char*)g.Bt + (size_t)nxt.pn * tstepB : cB;
        for (int t = 0; t < nt; t += 2) {
            const bool last = (t == nt - 2);
            const char* a1 = cA + (size_t)(t + 1) * kstep;
            const char* a2 = last ? nA : cA + (size_t)(t + 2) * kstep; const char* b2 = last ? nB : cB + (size_t)(t + 2) * kstep;
            const char* a3 = a2 + kstep; const char* b3 = b2 + kstep;
            if (last && has_next) S.a_ready(nxt);
            if constexpr (SP2) {
            PG8_LDB(B0, 0, 0); PG8_LDB(B1, 0, 1); PG8_SCHED; PG8_LDA(At, 0, 0); PG8_STAGE(PG8_SA(1, 1), a1 + hstepA, voffA);
            PG8_WAIT_V(8); PG8_WAIT_L(0); PG8_BAR; PG8_MMA(0, 0, At, B0); PG8_MMA(0, 1, At, B1); PG8_BAR; PG8_SCHED;
            PG8_LDA(At, 0, 1); PG8_STAGE(PG8_SB(0, 0), b2, voffB); PG8_STAGE(PG8_SB(0, 1), b2 + hstepB, voffB); PG8_STAGE(PG8_SA(0, 0), a2, voffA);
            PG8_WAIT_V(8); PG8_WAIT_L(0); PG8_BAR; PG8_MMA(1, 0, At, B0); PG8_MMA(1, 1, At, B1); PG8_BAR; PG8_SCHED;
            PG8_LDB(B0, 1, 0); PG8_LDB(B1, 1, 1); PG8_SCHED; PG8_LDA(At, 1, 0); PG8_STAGE(PG8_SA(0, 1), a2 + hstepA, voffA);
            PG8_WAIT_V(8); PG8_WAIT_L(0); PG8_BAR; PG8_MMA(0, 0, At, B0); PG8_MMA(0, 1, At, B1); PG8_BAR; PG8_SCHED;
            PG8_LDA(At, 1, 1); PG8_STAGE(PG8_SB(1, 0), b3, voffB); PG8_STAGE(PG8_SB(1, 1), b3 + hstepB, voffB); PG8_STAGE(PG8_SA(1, 0), a3, voffA);
            PG8_WAIT_V(8); PG8_WAIT_L(0); PG8_BAR; PG8_MMA(1, 0, At, B0); PG8_MMA(1, 1, At, B1); PG8_BAR; PG8_SCHED;
            } else {
            PG8_LDB(B0, 0, 0); PG8_SCHED; PG8_LDA(At, 0, 0); PG8_STAGE(PG8_SA(1, 1), a1 + hstepA, voffA);
            PG8_WAIT_L(8); PG8_BAR; PG8_WAIT_L(0); PG8_MMA(0, 0, At, B0); PG8_BAR; PG8_SCHED;
            PG8_LDB(B1, 0, 1); PG8_STAGE(PG8_SB(0, 0), b2, voffB);
            PG8_BAR; PG8_WAIT_L(0); PG8_MMA(0, 1, At, B1); PG8_BAR;
            PG8_LDA(At, 0, 1); PG8_STAGE(PG8_SA(0, 0), a2, voffA);
            PG8_BAR; PG8_WAIT_L(0); PG8_MMA(1, 0, At, B0); PG8_BAR; PG8_SCHED;
            PG8_STAGE(PG8_SB(0, 1), b2 + hstepB, voffB);
            PG8_WAIT_V(6); PG8_BAR; PG8_MMA(1, 1, At, B1); PG8_BAR;
            PG8_LDB(B0, 1, 0); PG8_SCHED; PG8_LDA(At, 1, 0); PG8_STAGE(PG8_SA(0, 1), a2 + hstepA, voffA);
            PG8_WAIT_L(8); PG8_BAR; PG8_WAIT_L(0); PG8_MMA(0, 0, At, B0); PG8_BAR; PG8_SCHED;
            PG8_LDB(B1, 1, 1); PG8_STAGE(PG8_SB(1, 0), b3, voffB);
            PG8_BAR; PG8_WAIT_L(0); PG8_MMA(0, 1, At, B1); PG8_BAR;
            PG8_LDA(At, 1, 1); PG8_STAGE(PG8_SA(1, 0), a3, voffA);
            PG8_BAR; PG8_WAIT_L(0); PG8_MMA(1, 0, At, B0); PG8_BAR; PG8_SCHED;
            PG8_STAGE(PG8_SB(1, 1), b3 + hstepB, voffB);
            PG8_WAIT_V(6); PG8_BAR; PG8_MMA(1, 1, At, B1); PG8_BAR;
            }
        }
        if constexpr (ALIGN_EPI) { if (wr == 0) PG8_BAR; }
        if constexpr (!Epi::AFTER_DRAIN) { E(acc, cur, wr, wc, fr, fq); S.done(cur); }
        if (!has_next) break;
#pragma unroll
        for (int a = 0; a < 2; ++a)
#pragma unroll
            for (int b = 0; b < 2; ++b)
#pragma unroll
                for (int m = 0; m < 4; ++m)
#pragma unroll
                    for (int n = 0; n < 2; ++n) acc[a][b][m][n] = (f32x4){0.f, 0.f, 0.f, 0.f};
        cur = nxt; cA = nA; cB = nB; ++ui;
        if constexpr (ALIGN_EPI) { if (wr == 1) PG8_BAR; }
    }
    PG8_WAIT_V(0);
    if constexpr (!ALIGN_EPI) { if (wr == 0) PG8_BAR; }
    PG8_BAR;
#undef PG8_SA
#undef PG8_SB
#undef PG8_STAGE
#undef PG8_LDA
#undef PG8_LDB
#undef PG8_MMA
#undef PG8_WAIT_V
#undef PG8_WAIT_L
#undef PG8_BAR
#undef PG8_SCHED
}

template <int MODE> struct Epi {
    static constexpr bool PERM = false, AFTER_DRAIN = false;
    const float* rowsrc; float inv_n; float* ss; bf16_t* ob; int ldc; float* of; const float* xin;
    __device__ __forceinline__ void operator()(const f32x4 (&acc)[2][2][4][2], const Unit& u, int wr, int wc, int fr, int fq) const {
#pragma unroll
        for (int ai = 0; ai < 2; ++ai)
#pragma unroll
            for (int m = 0; m < 4; ++m) {
                const int row = u.pm * BM + ai * HALF + wr * 64 + m * 16 + fr;
                float rs = 1.f;
                if (MODE == 1) rs = rowsrc[row];
                if (MODE == 2 || MODE == 5) rs = rsqrtf(rowsrc[row] * inv_n + EPS);
                float ssq = 0.f;
#pragma unroll
                for (int bj = 0; bj < 2; ++bj)
#pragma unroll
                    for (int n = 0; n < 2; ++n) {
                        const int col = u.pn * BM + bj * HALF + wc * 32 + n * 16 + fq * 4;
                        f32x4 v = acc[ai][bj][m][n] * rs;
                        if (MODE == 1) { if (u.pn < 8) { v[0] = gelu_tanh(v[0]); v[1] = gelu_tanh(v[1]); v[2] = gelu_tanh(v[2]); v[3] = gelu_tanh(v[3]); } }
                        if (MODE == 4) { const f32x4 xr = __builtin_nontemporal_load((const f32x4*)(xin + (size_t)row * DM + col)); v = v + xr; }
                        if (MODE == 1 || MODE == 4) ssq += (v[0] * v[0] + v[1] * v[1]) + (v[2] * v[2] + v[3] * v[3]);
                        if (MODE == 1 || MODE == 2 || MODE == 4) { u32x2 w; w.x = pk2(v[0], v[1]); w.y = pk2(v[2], v[3]); *(u32x2*)(ob + (size_t)row * ldc + col) = w; }
                        if (MODE == 5) *(f32x4*)(of + (size_t)row * DM + col) = v;
                    }
                if (MODE == 1) {
                    const int seg = (u.pn >= 4 && u.pn < 8) ? 0 : ((u.pn == 8 || u.pn == 9) ? 1 : (u.pn == 10 ? 2 : -1));
                    if (seg >= 0) { ssq += __shfl_xor(ssq, 16); ssq += __shfl_xor(ssq, 32); if (fq == 0) atomicAdd(ss + seg * S + row, ssq); }
                }
                if (MODE == 4) { ssq += __shfl_xor(ssq, 16); ssq += __shfl_xor(ssq, 32); if (fq == 0) atomicAdd(ss + row, ssq); }
            }
    }
};
}

#define XB_TMO      128
#define XB_XCNT(j)  (256  + 64 * (j))
#define XB_XSUB(j)  (1280 + 64 * (j))
#define XB_XGEN(j)  (2304 + 64 * (j))
#define XB_TOP      3328
#define XB_TOPGEN   3392
#define XCD_BAR_WORDS 3456
#define XB_SPIN_CAP (1u << 18)
__device__ __forceinline__ unsigned xb_ld(unsigned* p)              { return __hip_atomic_load(p, __ATOMIC_RELAXED, __HIP_MEMORY_SCOPE_AGENT); }
__device__ __forceinline__ unsigned xb_add(unsigned* p, unsigned v) { return __hip_atomic_fetch_add(p, v, __ATOMIC_RELAXED, __HIP_MEMORY_SCOPE_AGENT); }
__device__ __forceinline__ unsigned xb_xcc_id() { return (unsigned)__builtin_amdgcn_s_getreg((3 << 11) | 20) & 0xFu; }
#define XB_SPIN(cond, bar) do { unsigned _sp = 0; while (cond) { __builtin_amdgcn_s_sleep(1); \
    if ((++_sp & 255u) == 0u) { if (xb_ld(&(bar)[XB_TMO])) break; if (_sp > XB_SPIN_CAP) { atomicAdd(&(bar)[XB_TMO], 1u); break; } } } } while (0)
struct XcdBarrier { unsigned* bar; unsigned x; volatile LAS unsigned* st; };
__device__ __forceinline__ XcdBarrier xcd_barrier_post(unsigned* bar, volatile LAS unsigned* st) {
    XcdBarrier b; b.bar = bar; b.x = xb_xcc_id(); b.st = st;
    if (threadIdx.x == 0) st[3] = xb_add(&bar[XB_XCNT(b.x)], 1u);
    return b;
}
__device__ __forceinline__ void xcd_barrier_complete(unsigned* bar, unsigned x, unsigned& nloc, unsigned& nx, unsigned& eq32) {
    const unsigned G = gridDim.x * gridDim.y * gridDim.z;
    unsigned sum, cnt, mine, sp = 0u;
    for (;;) {
        sum = 0u; cnt = 0u; mine = 0u; eq32 = 1u;
#pragma unroll
        for (unsigned j = 0; j < 16; ++j) { const unsigned c = xb_ld(&bar[XB_XCNT(j)]); sum += c; cnt += (c > 0u) ? 1u : 0u; mine = (j == x) ? c : mine; if (c != (j < 8u ? 32u : 0u)) eq32 = 0u; }
        if (sum == G) break;
        __builtin_amdgcn_s_sleep(1);
        if ((++sp & 255u) == 0u) { if (xb_ld(&bar[XB_TMO])) break; if (sp > XB_SPIN_CAP) { atomicAdd(&bar[XB_TMO], 1u); break; } }
    }
    nloc = mine > 0u ? mine : 1u; nx = cnt > 0u ? cnt : 1u;
}
#define XB_LSUB(j)  (3456 + 64 * (j))
#define XB_LGEN(j)  (4480 + 64 * (j))
__device__ __forceinline__ void xcd_local_barrier(const XcdBarrier& b) {
    asm volatile("s_waitcnt vmcnt(0)" ::: "memory");
    __syncthreads();
    if (threadIdx.x == 0) {
        unsigned* bar = b.bar;
        const unsigned nloc = b.st[0];
        const unsigned old = xb_add(&bar[XB_LSUB(b.x)], 1u);
        const unsigned gen = old / nloc;
        if (old + 1u == (gen + 1u) * nloc) xb_add(&bar[XB_LGEN(b.x)], 1u);
        else XB_SPIN(xb_ld(&bar[XB_LGEN(b.x)]) == gen, bar);
    }
    __syncthreads();
}
__device__ __forceinline__ void xcd_local_barrier_acq(const XcdBarrier& b) {
    asm volatile("s_waitcnt vmcnt(0)" ::: "memory");
    __syncthreads();
    if (threadIdx.x == 0) {
        unsigned* bar = b.bar;
        __builtin_amdgcn_s_waitcnt(0);
        const unsigned nloc = b.st[0];
        const unsigned old = xb_add(&bar[XB_LSUB(b.x)], 1u);
        const unsigned gen = old / nloc;
        if (old + 1u == (gen + 1u) * nloc) xb_add(&bar[XB_LGEN(b.x)], 1u);
        else XB_SPIN(xb_ld(&bar[XB_LGEN(b.x)]) == gen, bar);
        __builtin_amdgcn_fence(__ATOMIC_ACQUIRE, "agent");
        asm volatile("s_waitcnt vmcnt(0)" ::: "memory");
    }
    __syncthreads();
}
__device__ __forceinline__ void xcd_barrier(const XcdBarrier& b) {
    asm volatile("s_waitcnt vmcnt(0)" ::: "memory");
    __syncthreads();
    if (threadIdx.x == 0) {
        unsigned* bar = b.bar;
        __builtin_amdgcn_s_waitcnt(0);
        unsigned nloc = b.st[0], nx = b.st[1];
        if (nloc == 0u) { unsigned eq32; xcd_barrier_complete(bar, b.x, nloc, nx, eq32); b.st[0] = nloc; b.st[1] = nx; b.st[2] = eq32; }
        const unsigned old = xb_add(&bar[XB_XSUB(b.x)], 1u);
        const unsigned gen = old / nloc;
        if (old + 1u == (gen + 1u) * nloc) {
            __builtin_amdgcn_fence(__ATOMIC_RELEASE, "agent");
            asm volatile("s_waitcnt vmcnt(0)" ::: "memory");
            const unsigned og = xb_add(&bar[XB_TOP], 1u);
            const unsigned tg = og / nx;
            if (og + 1u == (tg + 1u) * nx) xb_add(&bar[XB_TOPGEN], 1u);
            else XB_SPIN(xb_ld(&bar[XB_TOPGEN]) == tg, bar);
            __builtin_amdgcn_fence(__ATOMIC_ACQUIRE, "agent");
            xb_add(&bar[XB_XGEN(b.x)], 1u);
            asm volatile("s_waitcnt vmcnt(0)" ::: "memory");
        } else {
            XB_SPIN(xb_ld(&bar[XB_XGEN(b.x)]) == gen, bar);
            __builtin_amdgcn_fence(__ATOMIC_ACQUIRE, "agent");
            asm volatile("s_waitcnt vmcnt(0)" ::: "memory");
        }
    }
    __syncthreads();
}

struct Params {
    const float* in[18];
    float* out;
    unsigned char* ws;
    int ph_lo, ph_hi;
};

__device__ __forceinline__ void p0_transpose_item(const float* W, const float* g, int K, int N, bf16_t* WT, LAS float* scr, int item, int lane) {
    const int nblk = N / 32, kb = item / nblk, nb = item % nblk, k0 = 64 * kb, n0 = 32 * nb;
    float wv[32];
#pragma unroll
    for (int i = 0; i < 32; ++i) { const int kk = 2 * i + (lane >> 5); wv[i] = __builtin_nontemporal_load(W + (size_t)(k0 + kk) * N + n0 + (lane & 31)); }
#pragma unroll
    for (int i = 0; i < 32; ++i) { const int kk = 2 * i + (lane >> 5); const float gv = g ? g[k0 + kk] : 1.f; scr[kk * 33 + (lane & 31)] = wv[i] * gv; }
    LDS_WAIT(); asm volatile("" ::: "memory");
    const int c = lane & 7;
#pragma unroll
    for (int j = 0; j < 4; ++j) { const int n = (lane >> 3) + 8 * j; const LAS float* s = scr + (8 * c) * 33 + n;
        u32x4 o; o.x = pk2(s[0 * 33], s[1 * 33]); o.y = pk2(s[2 * 33], s[3 * 33]); o.z = pk2(s[4 * 33], s[5 * 33]); o.w = pk2(s[6 * 33], s[7 * 33]);
        *(u32x4*)(WT + (size_t)(n0 + n) * K + k0 + 8 * c) = o; }
    LDS_WAIT(); asm volatile("" ::: "memory");
}
__device__ __forceinline__ float row_to_bf16(const float* src, const float* g, bf16_t* dst, int lane) {
    float ss = 0.f;
#pragma unroll
    for (int i = 0; i < 8; ++i) {
        const int c = (i * 64 + lane) * 4;
        f32x4 v = *(const f32x4*)(src + c);
        ss += (v[0] * v[0] + v[1] * v[1]) + (v[2] * v[2] + v[3] * v[3]);
        if (g) { const f32x4 gv = *(const f32x4*)(g + c); v = v * gv; }
        u32x2 w; w.x = pk2(v[0], v[1]); w.y = pk2(v[2], v[3]);
        *(u32x2*)(dst + c) = w;
    }
    return ss;
}
constexpr float PEER_USC = 80.0f, PEER_VSC = 5.0f;
constexpr int PEER_ROWB = 1536;
typedef float f32x16v __attribute__((ext_vector_type(16)));
typedef float f32x32v __attribute__((ext_vector_type(32)));
typedef unsigned u32x6 __attribute__((ext_vector_type(6)));
typedef unsigned u32x2a4 __attribute__((ext_vector_type(2), aligned(4)));
template <bool CONTIG>
__device__ __forceinline__ void fp6_pack_store(const f32x4 (&x)[8], const f32x4 (&sc)[8], unsigned char* dst, int lane) {
    f32x16v a, b;
#pragma unroll
    for (int i = 0; i < 8; ++i) {
        const f32x4 y = x[i] * sc[i];
#pragma unroll
        for (int q = 0; q < 4; ++q) { const float c = fminf(fmaxf(y[q], -7.5f), 7.5f); const int sl = 4 * i + q; if ((sl & 1) == 0) a[sl >> 1] = c; else b[sl >> 1] = c; }
    }
    const u32x6 pk = __builtin_amdgcn_cvt_scalef32_2xpk16_fp6_f32(a, b, 1.0f);
    asm volatile("s_nop 15" : "+v"(a), "+v"(b));
    if (CONTIG) {
        *(u32x2*)(dst + lane * 24) = (u32x2){pk[0], pk[1]}; *(u32x2*)(dst + lane * 24 + 8) = (u32x2){pk[2], pk[3]}; *(u32x2*)(dst + lane * 24 + 16) = (u32x2){pk[4], pk[5]};
    } else {
        __builtin_nontemporal_store((u32x4){pk[0], pk[1], pk[2], pk[3]}, (u32x4*)(dst + lane * 16));
        __builtin_nontemporal_store((u32x2){pk[4], pk[5]}, (u32x2*)(dst + 1024 + lane * 8));
    }
}
template <bool CONTIG>
__device__ __forceinline__ void rows2_to_fp6(const float* s0, const float* s1, const f32x4 (&sc)[8], unsigned char* d0, unsigned char* d1, int lane) {
    f32x4 x0[8], x1[8];
#pragma unroll
    for (int i = 0; i < 8; ++i) { x0[i] = __builtin_nontemporal_load((const f32x4*)(s0 + (i * 64 + lane) * 4)); x1[i] = __builtin_nontemporal_load((const f32x4*)(s1 + (i * 64 + lane) * 4)); }
    fp6_pack_store<CONTIG>(x0, sc, d0, lane); fp6_pack_store<CONTIG>(x1, sc, d1, lane);
}
__device__ __forceinline__ bf16x8 cvt8(const float* p) {
    const f32x4 a = *(const f32x4*)p, b = *(const f32x4*)(p + 4);
    u32x4 w; w.x = pk2(a[0], a[1]); w.y = pk2(a[2], a[3]); w.z = pk2(b[0], b[1]); w.w = pk2(b[2], b[3]);
    return __builtin_bit_cast(bf16x8, w);
}

__device__ __forceinline__ void prep_late(const Params& p, LAS unsigned char* lds, int gw, int NGW, int wave, int lane) {
    unsigned char* ws = p.ws;
    LAS float* scr = (LAS float*)(lds + wave * 16384);
    {
        constexpr int I_UQ = (512 / 64) * (1536 / 32), I_UKV = (256 / 64) * (2048 / 32), I_OUT = (DM / 64) * (DM / 32);
        constexpr int NIT = I_UQ + I_UKV + I_OUT;
        for (int it = gw; it < NIT; it += NGW) {
            int r = it;
            if (r < I_UQ) { p0_transpose_item(p.in[7], p.in[6], 512, 1536, (bf16_t*)(ws + WS_WUQ), scr, r, lane); continue; } r -= I_UQ;
            if (r < I_UKV) { p0_transpose_item(p.in[9], p.in[8], 256, 2048, (bf16_t*)(ws + WS_WUKV), scr, r, lane); continue; } r -= I_UKV;
            p0_transpose_item(p.in[12], nullptr, DM, DM, (bf16_t*)(ws + WS_WOUT), scr, r, lane);
        }
    }
    {
        const float* wq = p.in[14]; const float* sk = p.in[15]; const float* g2 = p.in[13];
        bf16_t* WsT = (bf16_t*)(ws + WS_WS);
        const int r32 = lane & 31, hh = lane >> 5;
        for (int it = gw; it < 16 * 4 * 64; it += NGW) {
            const int hp = it >> 8, kb = (it >> 6) & 3, nb = it & 63;
            f32x16 acc = {};
            const float* ap = sk + ((size_t)(hp * 128 + kb * 32 + r32)) * 128 + hh * 8;
            const float* bp = wq + ((size_t)(nb * 32 + r32)) * DM + hp * 128 + hh * 8;
#pragma unroll
            for (int s = 0; s < 8; ++s) {
                const bf16x8 a = cvt8(ap + s * 16), b = cvt8(bp + s * 16);
                acc = __builtin_amdgcn_mfma_f32_32x32x16_bf16(a, b, acc, 0, 0, 0);
            }
            const int kcol = nb * 32 + r32; const float gk = g2[kcol];
#pragma unroll
            for (int r = 0; r < 16; ++r) WsT[(size_t)(hp * 128 + kb * 32 + crow(r, hh)) * DM + kcol] = (bf16_t)f2bf(acc[r] * gk);
        }
    }
    {
        float* ct = (float*)(ws + WS_COS); float* st = (float*)(ws + WS_SIN);
        for (int it = gw; it < S * 32 / 64; it += NGW) {
            const int idx = it * 64 + lane, t = idx >> 5, j = idx & 31;
            const float inv_freq = powf(10000.0f, -(float)j / 32.0f);
            const float ang = (float)t * inv_freq;
            float sv, cv; sincosf(ang, &sv, &cv); ct[idx] = cv; st[idx] = sv;
        }
    }
}
__device__ __forceinline__ void phase0(const Params& p, LAS unsigned char* lds, bool late_ok, int gw, int NGW, int wave, int lane) {
    unsigned char* ws = p.ws;
    LAS float* scr = (LAS float*)(lds + wave * 16384);
    const float* x = p.in[0];
    {
        constexpr int I_IN = (DM / 64) * (NIN / 32);
        for (int it = gw; it < I_IN; it += NGW) p0_transpose_item(p.in[2], p.in[1], DM, NIN, (bf16_t*)(ws + WS_WIN), scr, it, lane);
    }
    if (!late_ok) prep_late(p, lds, gw, NGW, wave, lane);
    for (int r = gw; r < NINP - NIN; r += NGW) {
        bf16_t* d = (bf16_t*)(ws + WS_WIN) + (size_t)(NIN + r) * DM;
#pragma unroll
        for (int i = 0; i < 4; ++i) *(u32x4*)(d + (i * 64 + lane) * 8) = (u32x4){0u, 0u, 0u, 0u};
    }
    {
        bf16_t* xb = (bf16_t*)(ws + WS_XB); float* rstd1 = (float*)(ws + WS_RSTD1);
        for (int t = gw; t + NGW < S; t += 2 * NGW) {
            const int t1 = t + NGW;
            f32x4 a[8], b[8];
#pragma unroll
            for (int i = 0; i < 8; ++i) { a[i] = __builtin_nontemporal_load((const f32x4*)(x + (size_t)t * DM + (i * 64 + lane) * 4)); b[i] = __builtin_nontemporal_load((const f32x4*)(x + (size_t)t1 * DM + (i * 64 + lane) * 4)); }
            float sa = 0.f, sb = 0.f;
#pragma unroll
            for (int i = 0; i < 8; ++i) {
                sa += (a[i][0] * a[i][0] + a[i][1] * a[i][1]) + (a[i][2] * a[i][2] + a[i][3] * a[i][3]);
                sb += (b[i][0] * b[i][0] + b[i][1] * b[i][1]) + (b[i][2] * b[i][2] + b[i][3] * b[i][3]);
                u32x2 wa, wb; wa.x = pk2(a[i][0], a[i][1]); wa.y = pk2(a[i][2], a[i][3]); wb.x = pk2(b[i][0], b[i][1]); wb.y = pk2(b[i][2], b[i][3]);
                *(u32x2*)(xb + (size_t)t * DM + (i * 64 + lane) * 4) = wa; *(u32x2*)(xb + (size_t)t1 * DM + (i * 64 + lane) * 4) = wb;
            }
            sa = wave_sum(sa); sb = wave_sum(sb);
            if (lane == 0) { rstd1[t] = rsqrtf(sa * (1.0f / DM) + EPS); rstd1[t1] = rsqrtf(sb * (1.0f / DM) + EPS); }
        }
    }
    {
        unsigned char* UT = ws + WS_UT; unsigned char* VT = ws + WS_VT;
        f32x4 sc[8];
#pragma unroll
        for (int i = 0; i < 8; ++i) sc[i] = *(const f32x4*)(p.in[13] + (i * 64 + lane) * 4) * PEER_USC;
        for (int e = gw; e + NGW < 16384; e += 2 * NGW)
            rows2_to_fp6<false>(p.in[16] + (size_t)e * DM, p.in[16] + (size_t)(e + NGW) * DM, sc, UT + (size_t)e * PEER_ROWB, UT + (size_t)(e + NGW) * PEER_ROWB, lane);
#pragma unroll
        for (int i = 0; i < 8; ++i) sc[i] = (f32x4){PEER_VSC, PEER_VSC, PEER_VSC, PEER_VSC};
        for (int e = gw; e + NGW < 16384; e += 2 * NGW)
            rows2_to_fp6<false>(p.in[17] + (size_t)e * DM, p.in[17] + (size_t)(e + NGW) * DM, sc, VT + (size_t)e * PEER_ROWB, VT + (size_t)(e + NGW) * PEER_ROWB, lane);
    }
}

__device__ __forceinline__ float half_sum(float v) {
    v += dpp_f<0xB1, 0xf>(0.f, v); v += dpp_f<0x4E, 0xf>(0.f, v); v += dpp_f<0x141, 0xf>(0.f, v); v += dpp_f<0x140, 0xf>(0.f, v);
    return v + __shfl_xor(v, 16);
}
__device__ __forceinline__ void phase3(const Params& p, int tfirst, int tstep, int tcnt, int lane) {
    unsigned char* ws = p.ws;
    const bf16_t* qraw = (const bf16_t*)(ws + WS_QRAW); const bf16_t* kvraw = (const bf16_t*)(ws + WS_KVRAW); const bf16_t* proj = (const bf16_t*)(ws + WS_PROJ);
    bf16_t* Qh = (bf16_t*)(ws + WS_QH); bf16_t* Kh = (bf16_t*)(ws + WS_KH);
    const float* ct = (const float*)(ws + WS_COS); const float* st = (const float*)(ws + WS_SIN);
    const int sub = lane & 31, hsel = lane >> 5;
    const bool act = sub < 24, isrope = sub >= 16 && sub < 24, lowhalf = sub < 20;
    const int e0 = act ? 8 * sub : 0;
    f32x4 gq[2], gk[2];
#pragma unroll
    for (int c = 0; c < 2; ++c) { gq[c] = *(const f32x4*)(p.in[10] + e0 + 4 * c); gk[c] = *(const f32x4*)(p.in[11] + e0 + 4 * c); }
    const int j0 = isrope ? ((8 * sub - 128) & 31) : 0;
    constexpr float QS = 0.07216878364870322f * 1.4426950408889634f;
    for (int ti = 0; ti < tcnt; ++ti) {
        const int t = tfirst + ti * tstep;
        f32x4 cs[2] = {{1.f, 1.f, 1.f, 1.f}, {1.f, 1.f, 1.f, 1.f}}, sn[2] = {{0.f, 0.f, 0.f, 0.f}, {0.f, 0.f, 0.f, 0.f}};
        u32x4 krw = {0u, 0u, 0u, 0u};
        if (isrope) {
#pragma unroll
            for (int c = 0; c < 2; ++c) { cs[c] = *(const f32x4*)(ct + t * 32 + j0 + 4 * c); sn[c] = *(const f32x4*)(st + t * 32 + j0 + 4 * c); }
            krw = *(const u32x4*)(proj + (size_t)t * NINP + 2816 + (8 * sub - 128));
        }
#pragma unroll
        for (int hp = 0; hp < 4; ++hp) {
            const int h = 2 * hp + hsel;
            u32x4 qw = {0u, 0u, 0u, 0u}, kw = {0u, 0u, 0u, 0u};
            if (act) qw = *(const u32x4*)(qraw + (size_t)t * 1536 + h * 192 + e0);
            if (sub < 16) kw = *(const u32x4*)(kvraw + (size_t)t * 2048 + h * 256 + e0);
            if (isrope) kw = krw;
#pragma unroll
            for (int which = 0; which < 2; ++which) {
                const u32x4 w = which ? kw : qw;
                f32x4 x[2] = {{bflo(w[0]), bfhi(w[0]), bflo(w[1]), bfhi(w[1])}, {bflo(w[2]), bfhi(w[2]), bflo(w[3]), bfhi(w[3])}};
                float ss = 0.f;
#pragma unroll
                for (int c = 0; c < 2; ++c) ss += (x[c][0] * x[c][0] + x[c][1] * x[c][1]) + (x[c][2] * x[c][2] + x[c][3] * x[c][3]);
                ss = half_sum(ss);
                const float rs = rsqrtf(ss * (1.0f / 192.0f) + EPS);
#pragma unroll
                for (int c = 0; c < 2; ++c) {
                    x[c] = x[c] * (which ? gk[c] : gq[c]) * rs;
                    f32x4 pr;
#pragma unroll
                    for (int q = 0; q < 4; ++q) pr[q] = __shfl_xor(x[c][q], 4);
                    const f32x4 r1 = x[c] * cs[c] - pr * sn[c], r2 = pr * sn[c] + x[c] * cs[c];
                    if (isrope) x[c] = lowhalf ? r1 : r2;
                    if (!which) x[c] = x[c] * QS;
                }
                if (act) {
                    u32x4 o; o.x = pk2(x[0][0], x[0][1]); o.y = pk2(x[0][2], x[0][3]); o.z = pk2(x[1][0], x[1][1]); o.w = pk2(x[1][2], x[1][3]);
                    *(u32x4*)((which ? Kh : Qh) + ((size_t)h * S + t) * 192 + e0) = o;
                }
            }
        }
    }
}

constexpr int KP = 400, VP = 320;
template <int OFF> __device__ __forceinline__ s16x4 tr_read(unsigned addr) {
    s16x4 r; asm volatile("ds_read_b64_tr_b16 %0, %1 offset:%2" : "=&v"(r) : "v"(addr), "i"(OFF) : "memory"); return r;
}
__device__ __forceinline__ unsigned cvtpk(float lo, float hi) { unsigned r; asm volatile("v_cvt_pk_bf16_f32 %0, %1, %2" : "=v"(r) : "v"(lo), "v"(hi)); return r; }
#define PK8(L, H) ((bf16x8){L[0], L[1], L[2], L[3], H[0], H[1], H[2], H[3]})
constexpr float ATT_THR = 8.0f;

constexpr int ATT_KB = 64 * KP, ATT_VB = 64 * VP;
constexpr int ATT_VOFF = 2 * ATT_KB;
__device__ __forceinline__ float xhalf_max(float v) {
    auto rr = __builtin_amdgcn_permlane32_swap(__builtin_bit_cast(unsigned, v), __builtin_bit_cast(unsigned, v), false, false);
    return fmaxf(__builtin_bit_cast(float, rr[0]), __builtin_bit_cast(float, rr[1]));
}
__device__ __forceinline__ float xhalf_sum(float v) {
    auto rr = __builtin_amdgcn_permlane32_swap(__builtin_bit_cast(unsigned, v), __builtin_bit_cast(unsigned, v), false, false);
    return __builtin_bit_cast(float, rr[0]) + __builtin_bit_cast(float, rr[1]);
}
template <int OFF> __device__ __forceinline__ bf16x8 lds_read128(unsigned addr) {
    bf16x8 r; asm volatile("ds_read_b128 %0, %1 offset:%2" : "=&v"(r) : "v"(addr), "i"(OFF) : "memory"); return r;
}
#define LGKM_WAIT(n) do { asm volatile("s_waitcnt lgkmcnt(" #n ")" ::: "memory"); SBAR(); } while (0)
__device__ __forceinline__ f32x16 att_qk(unsigned kaddr, const bf16x8 (&qr)[12]) {
    f32x16 p = {};
    bf16x8 a0 = lds_read128<0>(kaddr), a1 = lds_read128<32>(kaddr), a2 = lds_read128<64>(kaddr), a3 = lds_read128<96>(kaddr);
    LGKM_WAIT(3); p = __builtin_amdgcn_mfma_f32_32x32x16_bf16(a0, qr[0], p, 0, 0, 0); a0 = lds_read128<128>(kaddr);
    LGKM_WAIT(3); p = __builtin_amdgcn_mfma_f32_32x32x16_bf16(a1, qr[1], p, 0, 0, 0); a1 = lds_read128<160>(kaddr);
    LGKM_WAIT(3); p = __builtin_amdgcn_mfma_f32_32x32x16_bf16(a2, qr[2], p, 0, 0, 0); a2 = lds_read128<192>(kaddr);
    LGKM_WAIT(3); p = __builtin_amdgcn_mfma_f32_32x32x16_bf16(a3, qr[3], p, 0, 0, 0); a3 = lds_read128<224>(kaddr);
    LGKM_WAIT(3); p = __builtin_amdgcn_mfma_f32_32x32x16_bf16(a0, qr[4], p, 0, 0, 0); a0 = lds_read128<256>(kaddr);
    LGKM_WAIT(3); p = __builtin_amdgcn_mfma_f32_32x32x16_bf16(a1, qr[5], p, 0, 0, 0); a1 = lds_read128<288>(kaddr);
    LGKM_WAIT(3); p = __builtin_amdgcn_mfma_f32_32x32x16_bf16(a2, qr[6], p, 0, 0, 0); a2 = lds_read128<320>(kaddr);
    LGKM_WAIT(3); p = __builtin_amdgcn_mfma_f32_32x32x16_bf16(a3, qr[7], p, 0, 0, 0); a3 = lds_read128<352>(kaddr);
    LGKM_WAIT(3); p = __builtin_amdgcn_mfma_f32_32x32x16_bf16(a0, qr[8], p, 0, 0, 0);
    LGKM_WAIT(2); p = __builtin_amdgcn_mfma_f32_32x32x16_bf16(a1, qr[9], p, 0, 0, 0);
    LGKM_WAIT(1); p = __builtin_amdgcn_mfma_f32_32x32x16_bf16(a2, qr[10], p, 0, 0, 0);
    LGKM_WAIT(0); p = __builtin_amdgcn_mfma_f32_32x32x16_bf16(a3, qr[11], p, 0, 0, 0);
    return p;
}
__device__ __forceinline__ void att_finish(f32x16& s, float m, float& lsum, bf16x8& pb0, bf16x8& pb1) {
    float ps = 0.f;
#pragma unroll
    for (int r = 0; r < 16; ++r) { s[r] = __builtin_amdgcn_exp2f(s[r] - m); ps += s[r]; }
    lsum += xhalf_sum(ps);
    u32x4 w0 = {cvtpk(s[0], s[1]), cvtpk(s[2], s[3]), cvtpk(s[4], s[5]), cvtpk(s[6], s[7])};
    u32x4 w1 = {cvtpk(s[8], s[9]), cvtpk(s[10], s[11]), cvtpk(s[12], s[13]), cvtpk(s[14], s[15])};
    pb0 = __builtin_bit_cast(bf16x8, w0); pb1 = __builtin_bit_cast(bf16x8, w1);
}
__device__ __forceinline__ void att_pv(unsigned vaddr, bf16x8 pb0, bf16x8 pb1, f32x16 (&o)[4]) {
#define VOFF(d0, s, hi) (((16 * (s) + 8 * (hi)) * VP) + 64 * (d0))
    const s16x4 a00l = tr_read<VOFF(0, 0, 0)>(vaddr), a00h = tr_read<VOFF(0, 0, 1)>(vaddr), a01l = tr_read<VOFF(0, 1, 0)>(vaddr), a01h = tr_read<VOFF(0, 1, 1)>(vaddr);
    const s16x4 a10l = tr_read<VOFF(1, 0, 0)>(vaddr), a10h = tr_read<VOFF(1, 0, 1)>(vaddr), a11l = tr_read<VOFF(1, 1, 0)>(vaddr), a11h = tr_read<VOFF(1, 1, 1)>(vaddr);
    LGKM_WAIT(4);
    o[0] = __builtin_amdgcn_mfma_f32_32x32x16_bf16(PK8(a00l, a00h), pb0, o[0], 0, 0, 0); o[0] = __builtin_amdgcn_mfma_f32_32x32x16_bf16(PK8(a01l, a01h), pb1, o[0], 0, 0, 0);
    const s16x4 a20l = tr_read<VOFF(2, 0, 0)>(vaddr), a20h = tr_read<VOFF(2, 0, 1)>(vaddr), a21l = tr_read<VOFF(2, 1, 0)>(vaddr), a21h = tr_read<VOFF(2, 1, 1)>(vaddr);
    LGKM_WAIT(4);
    o[1] = __builtin_amdgcn_mfma_f32_32x32x16_bf16(PK8(a10l, a10h), pb0, o[1], 0, 0, 0); o[1] = __builtin_amdgcn_mfma_f32_32x32x16_bf16(PK8(a11l, a11h), pb1, o[1], 0, 0, 0);
    const s16x4 a30l = tr_read<VOFF(3, 0, 0)>(vaddr), a30h = tr_read<VOFF(3, 0, 1)>(vaddr), a31l = tr_read<VOFF(3, 1, 0)>(vaddr), a31h = tr_read<VOFF(3, 1, 1)>(vaddr);
    LGKM_WAIT(4);
    o[2] = __builtin_amdgcn_mfma_f32_32x32x16_bf16(PK8(a20l, a20h), pb0, o[2], 0, 0, 0); o[2] = __builtin_amdgcn_mfma_f32_32x32x16_bf16(PK8(a21l, a21h), pb1, o[2], 0, 0, 0);
    LGKM_WAIT(0);
    o[3] = __builtin_amdgcn_mfma_f32_32x32x16_bf16(PK8(a30l, a30h), pb0, o[3], 0, 0, 0); o[3] = __builtin_amdgcn_mfma_f32_32x32x16_bf16(PK8(a31l, a31h), pb1, o[3], 0, 0, 0);
#undef VOFF
}
__device__ __forceinline__ void att_partial(const f32x16& s, float& m, float& lsum, f32x16 (&o)[4]) {
    float pmax = s[0];
#pragma unroll
    for (int r = 1; r < 16; ++r) pmax = fmaxf(pmax, s[r]);
    pmax = xhalf_max(pmax);
    if (!__all(pmax - m <= ATT_THR)) {
        const float mn = fmaxf(m, pmax); const float alpha = __builtin_amdgcn_exp2f(m - mn); m = mn; lsum *= alpha;
#pragma unroll
        for (int d = 0; d < 4; ++d)
#pragma unroll
            for (int r = 0; r < 16; ++r) o[d][r] *= alpha;
    }
}

__device__ __forceinline__ void attn_unit(const Params& p, LAS unsigned char* lds, int head, int qb, int tid, int wave, int lane) {
    unsigned char* ws = p.ws;
    const bf16_t* Qh = (const bf16_t*)(ws + WS_QH); const bf16_t* Kh = (const bf16_t*)(ws + WS_KH);
    bf16_t* mix = (bf16_t*)(ws + WS_MIX);
    const int rg = wave & 3, kh = wave >> 2, r32 = lane & 31, hh = lane >> 5;
    const int q0row = qb * 128 + rg * 32;
    bf16x8 qr[12];
    {
        const bf16_t* qp = Qh + ((size_t)head * S + q0row + r32) * 192 + hh * 8;
#pragma unroll
        for (int ks = 0; ks < 12; ++ks) qr[ks] = *(const bf16x8*)(qp + ks * 16);
    }
    const int ntiles = 2 * qb + 2, mylast = 2 * qb + (rg >> 1);
    float m = -1e30f, lsum = 0.f; f32x16 o[4] = {};
    const int srow = tid >> 3, sch = tid & 7;
    const int kg0 = srow * 192 + sch * 8, kl0 = srow * KP + sch * 16, vg0 = srow * 2048 + sch * 8, vl0 = ATT_VOFF + srow * VP + sch * 16;
    const bf16_t* kbase = Kh + (size_t)head * S * 192; const bf16_t* vbase = (const bf16_t*)(ws + WS_KVRAW) + head * 256 + 128;
    u32x4 sk0, sk1, sk2, sv0, sv1;
#define ATT_LOAD(t) do { const bf16_t* kt = kbase + (size_t)(t) * 64 * 192 + kg0; const bf16_t* vt = vbase + (size_t)(t) * 64 * 2048 + vg0; \
        sk0 = *(const u32x4*)(kt); sk1 = *(const u32x4*)(kt + 64); sk2 = *(const u32x4*)(kt + 128); sv0 = *(const u32x4*)(vt); sv1 = *(const u32x4*)(vt + 64); } while (0)
#define ATT_WRITE(kb_, vb_) do { LAS unsigned char* bk = lds + (kb_) * ATT_KB + kl0; LAS unsigned char* bv = lds + (vb_) * ATT_VB + vl0; *(LAS u32x4*)(bk) = sk0; *(LAS u32x4*)(bk + 128) = sk1; *(LAS u32x4*)(bk + 256) = sk2; \
        *(LAS u32x4*)(bv) = sv0; *(LAS u32x4*)(bv + 128) = sv1; } while (0)
    const unsigned ldsbase = (unsigned)(size_t)lds;
    const unsigned kaddr0 = ldsbase + (unsigned)((32 * kh + r32) * KP + hh * 16);
    const unsigned vrel = (unsigned)(ATT_VOFF + (32 * kh + 4 * hh + ((lane & 15) >> 2)) * VP + (16 * ((lane >> 4) & 1) + 4 * (lane & 3)) * 2);
    ATT_LOAD(0); ATT_WRITE(0, 0); __syncthreads();
    bf16x8 pb0, pb1;
    const bool more0 = (1 < ntiles);
    if (more0) ATT_LOAD(1);
    f32x16 sprev = att_qk(kaddr0, qr);
    att_partial(sprev, m, lsum, o);
    if (more0) ATT_WRITE(1, 1);
    __syncthreads();
    int vprev = 0, vcur = 1;
#pragma unroll 1
    for (int t = 1; t <= ntiles; ++t) {
        const bool more = (t + 1 < ntiles);
        if (more) ATT_LOAD(t + 1);
        f32x16 sc;
        if (t <= mylast) sc = att_qk(kaddr0 + (t & 1) * ATT_KB, qr);
        else {
#pragma unroll
            for (int r = 0; r < 16; ++r) sc[r] = -1e30f;
        }
        att_finish(sprev, m, lsum, pb0, pb1);
        att_pv(ldsbase + vprev * ATT_VB + vrel, pb0, pb1, o);
        att_partial(sc, m, lsum, o);
        sprev = sc;
        const int vnext = (vcur == 2) ? 0 : vcur + 1;
        if (more) ATT_WRITE((t + 1) & 1, vnext);
        vprev = vcur; vcur = vnext;
        __syncthreads();
    }
#undef ATT_LOAD
#undef ATT_WRITE
    LAS float* scr = (LAS float*)lds + (size_t)rg * 66 * 64 + lane;
    if (kh == 1) {
        scr[0] = m; scr[64] = lsum;
#pragma unroll
        for (int d = 0; d < 4; ++d)
#pragma unroll
            for (int r = 0; r < 16; ++r) scr[(2 + d * 16 + r) * 64] = o[d][r];
    }
    __syncthreads();
    if (kh == 0) {
        const float m2 = scr[0], l2 = scr[64];
        const float mn = fmaxf(m, m2), a1 = __builtin_amdgcn_exp2f(m - mn), a2 = __builtin_amdgcn_exp2f(m2 - mn);
        const float inv = 1.0f / (lsum * a1 + l2 * a2);
        bf16_t* op = mix + (size_t)(q0row + r32) * DM + 1024 + head * 128 + 4 * hh;
#pragma unroll
        for (int d = 0; d < 4; ++d)
#pragma unroll
            for (int g4 = 0; g4 < 4; ++g4) {
                float v[4];
#pragma unroll
                for (int i = 0; i < 4; ++i) { const int r = 4 * g4 + i; v[i] = (o[d][r] * a1 + scr[(2 + d * 16 + r) * 64] * a2) * inv; }
                u32x2 w; w.x = pk2(v[0], v[1]); w.y = pk2(v[2], v[3]);
                *(u32x2*)(op + 32 * d + 8 * g4) = w;
            }
    }
    __syncthreads();
}

__device__ __forceinline__ void gmlp_unit(const Params& p, LAS unsigned char* lds, int nb, int h, int tid, int wave, int lane) {
    unsigned char* ws = p.ws;
    const bf16_t* proj = (const bf16_t*)(ws + WS_PROJ); bf16_t* mix = (bf16_t*)(ws + WS_MIX);
    const float* ssv = (const float*)(ws + WS_ROWSS);
    const float* vg = p.in[3]; const float* wsp = p.in[4]; const float* bs = p.in[5];
#pragma unroll
    for (int i = 0; i < 4; ++i) {
        const int pc = tid + 512 * i, r = pc >> 4, c = pc & 15, t = nb * 128 + r;
        const u32x4 w = *(const u32x4*)(proj + (size_t)t * NINP + 1024 + h * 128 + c * 8);
        const float rs = rsqrtf(ssv[t] * (1.0f / 1024.0f) + EPS);
        const f32x4 g0 = *(const f32x4*)(vg + h * 128 + c * 8), g1 = *(const f32x4*)(vg + h * 128 + c * 8 + 4);
        u32x4 ov;
        ov.x = pk2(bflo(w.x) * rs * g0[0], bfhi(w.x) * rs * g0[1]); ov.y = pk2(bflo(w.y) * rs * g0[2], bfhi(w.y) * rs * g0[3]);
        ov.z = pk2(bflo(w.z) * rs * g1[0], bfhi(w.z) * rs * g1[1]); ov.w = pk2(bflo(w.w) * rs * g1[2], bfhi(w.w) * rs * g1[3]);
        *(LAS u32x4*)(lds + r * VP + c * 16) = ov;
    }
    __syncthreads();
    const int ib = wave & 3, ch = wave >> 2, r32 = lane & 31, hh = lane >> 5;
    const int irow = 32 * ib + r32;
    f32x16 acc0 = {}, acc1 = {};
    const unsigned vaddr = (unsigned)(size_t)lds + (unsigned)((8 * hh + ((lane & 15) >> 2)) * VP + (64 * ch + 16 * ((lane >> 4) & 1) + 4 * (lane & 3)) * 2);
    const float* wrow = wsp + ((size_t)h * 128 + irow) * 128 + hh * 8;
#define GSTEP(s) do { if ((s) < 2 * (ib + 1)) { \
        const f32x4 wa = *(const f32x4*)(wrow + (s) * 16), wb = *(const f32x4*)(wrow + (s) * 16 + 4); const int j0 = (s) * 16 + hh * 8; \
        u32x4 aw; aw.x = pk2(j0 + 0 <= irow ? wa[0] : 0.f, j0 + 1 <= irow ? wa[1] : 0.f); aw.y = pk2(j0 + 2 <= irow ? wa[2] : 0.f, j0 + 3 <= irow ? wa[3] : 0.f); \
        aw.z = pk2(j0 + 4 <= irow ? wb[0] : 0.f, j0 + 5 <= irow ? wb[1] : 0.f); aw.w = pk2(j0 + 6 <= irow ? wb[2] : 0.f, j0 + 7 <= irow ? wb[3] : 0.f); \
        const bf16x8 af = __builtin_bit_cast(bf16x8, aw); \
        const s16x4 b0l = tr_read<(16 * (s)) * VP>(vaddr), b0h = tr_read<(16 * (s) + 4) * VP>(vaddr), b1l = tr_read<(16 * (s)) * VP + 64>(vaddr), b1h = tr_read<(16 * (s) + 4) * VP + 64>(vaddr); \
        LDS_WAIT(); SBAR(); \
        acc0 = __builtin_amdgcn_mfma_f32_32x32x16_bf16(af, PK8(b0l, b0h), acc0, 0, 0, 0); acc1 = __builtin_amdgcn_mfma_f32_32x32x16_bf16(af, PK8(b1l, b1h), acc1, 0, 0, 0); } } while (0)
    GSTEP(0); GSTEP(1); GSTEP(2); GSTEP(3); GSTEP(4); GSTEP(5); GSTEP(6); GSTEP(7);
#undef GSTEP
#pragma unroll
    for (int r = 0; r < 16; ++r) {
        const int i = 32 * ib + crow(r, hh), t = nb * 128 + i; const float b = bs[h * 128 + i];
        const int c0 = h * 128 + 64 * ch + r32;
        const float u0 = bf2f(proj[(size_t)t * NINP + c0]), u1 = bf2f(proj[(size_t)t * NINP + c0 + 32]);
        mix[(size_t)t * DM + c0] = (bf16_t)f2bf(u0 * (acc0[r] + b)); mix[(size_t)t * DM + c0 + 32] = (bf16_t)f2bf(u1 * (acc1[r] + b));
    }
    __syncthreads();
}

__device__ __forceinline__ void phase7(const Params& p, LAS unsigned char* lds, int gw, int NGW, int wave, int lane) {
    unsigned char* ws = p.ws;
    const float* sc = (const float*)(ws + WS_SC); int* ex = (int*)(ws + WS_EXP); float* gt = (float*)(ws + WS_GATE);
    const float NEG = -3.0e38f;
    LAS float* sl = (LAS float*)(lds + wave * 1024);
    const int j8 = lane & 7, g8 = lane >> 3, row = lane >> 4, i16 = lane & 15;
    int ci[4], cj[4]; bool cval[4];
    {
        constexpr int starts[16] = {0, 16, 24, 29, 33, 36, 38, 40, 42, 43, 44, 45, 46, 47, 48, 49};
#pragma unroll
        for (int m = 0; m < 4; ++m) {
            const int c = i16 + 16 * m; int a = 0, st = 0;
#pragma unroll
            for (int i = 1; i < 16; ++i) if (c >= starts[i]) { a = i; st = starts[i]; }
            cval[m] = c < 50; ci[m] = cval[m] ? a : 0; cj[m] = cval[m] ? (c - st) : 0;
        }
    }
    f32x4 nx0, nx1, nx2, nx3;
    if (gw < S / 4) { const float* b = sc + (size_t)(gw * 4) * DM + lane * 16; nx0 = *(const f32x4*)b; nx1 = *(const f32x4*)(b + 4); nx2 = *(const f32x4*)(b + 8); nx3 = *(const f32x4*)(b + 12); }
    for (int tb = gw; tb < S / 4; tb += NGW)
#pragma unroll 1
    for (int n8 = 0; n8 < 8; ++n8) {
        const int it = tb * 8 + n8;
        const int t = it >> 1, hh = it & 1;
        float v[16];
#pragma unroll
        for (int q = 0; q < 4; ++q) { v[q] = nx0[q]; v[4 + q] = nx1[q]; v[8 + q] = nx2[q]; v[12 + q] = nx3[q]; }
        { const int it2 = n8 < 7 ? it + 1 : (tb + NGW) * 8;
          if (it2 < S * 2) { const float* b = sc + (size_t)(it2 >> 1) * DM + (it2 & 1) * 1024 + lane * 16;
            nx0 = *(const f32x4*)b; nx1 = *(const f32x4*)(b + 4); nx2 = *(const f32x4*)(b + 8); nx3 = *(const f32x4*)(b + 12); } }
#pragma unroll
        for (int m = 0; m < 16; ++m) v[m] = __builtin_bit_cast(float, (__builtin_bit_cast(unsigned, v[m]) & ~127u) | (unsigned)(16 * j8 + m));
#define P7_CE(A, B) do { const float hi_ = fmaxf(v[A], v[B]), lo_ = fminf(v[A], v[B]); v[A] = hi_; v[B] = lo_; } while (0)
        P7_CE(0, 13); P7_CE(1, 12); P7_CE(2, 15); P7_CE(3, 14); P7_CE(4, 8); P7_CE(5, 6); P7_CE(7, 11); P7_CE(9, 10);
        P7_CE(0, 5); P7_CE(1, 7); P7_CE(2, 9); P7_CE(3, 4); P7_CE(6, 13); P7_CE(8, 14); P7_CE(10, 15); P7_CE(11, 12);
        P7_CE(0, 1); P7_CE(2, 3); P7_CE(4, 5); P7_CE(6, 8); P7_CE(7, 9); P7_CE(10, 11); P7_CE(12, 13); P7_CE(14, 15);
        P7_CE(0, 2); P7_CE(1, 3); P7_CE(4, 10); P7_CE(5, 11); P7_CE(6, 7); P7_CE(8, 9); P7_CE(12, 14); P7_CE(13, 15);
        P7_CE(1, 2); P7_CE(3, 12); P7_CE(4, 6); P7_CE(5, 7); P7_CE(8, 10); P7_CE(9, 11); P7_CE(13, 14);
        P7_CE(1, 4); P7_CE(2, 6); P7_CE(5, 8); P7_CE(7, 10); P7_CE(9, 13); P7_CE(11, 14);
        P7_CE(2, 4); P7_CE(3, 6); P7_CE(9, 12); P7_CE(11, 13);
        P7_CE(3, 5); P7_CE(6, 8); P7_CE(7, 9); P7_CE(10, 12);
        P7_CE(3, 4); P7_CE(5, 6); P7_CE(7, 8); P7_CE(9, 10); P7_CE(11, 12);
        P7_CE(6, 7); P7_CE(8, 9);
#define P7_MERGE(CTRL) do { float t_[16]; \
            _Pragma("unroll") for (int i = 0; i < 16; ++i) t_[i] = fmaxf(v[i], dpp_f<CTRL, 0xf>(v[15 - i], v[15 - i])); \
            _Pragma("unroll") for (int i = 0; i < 16; ++i) v[i] = t_[i]; \
            _Pragma("unroll") for (int j = 8; j >= 1; j >>= 1) _Pragma("unroll") for (int i = 0; i < 16; ++i) if ((i & j) == 0) P7_CE(i, i + j); } while (0)
        P7_MERGE(0xB1); P7_MERGE(0x4E); P7_MERGE(0x141);
#undef P7_MERGE
#undef P7_CE
        if (j8 == 0) {
#pragma unroll
            for (int q = 0; q < 4; ++q) *(LAS f32x4*)(sl + g8 * 16 + 4 * q) = (f32x4){v[4 * q], v[4 * q + 1], v[4 * q + 2], v[4 * q + 3]};
        }
        LDS_WAIT(); asm volatile("" ::: "memory");
        float cv[4], og[4]; int id[4];
#pragma unroll
        for (int m = 0; m < 4; ++m) {
            const float s1 = sl[(2 * row) * 16 + ci[m]], s2 = sl[(2 * row + 1) * 16 + cj[m]];
            og[m] = cval[m] ? (s1 + s2) : NEG; cv[m] = og[m];
            id[m] = (int)((__builtin_bit_cast(unsigned, s1) & 127u) * 128u + (__builtin_bit_cast(unsigned, s2) & 127u));
        }
        LDS_WAIT(); asm volatile("" ::: "memory");
        float M0 = 0.f;
#pragma unroll
        for (int k = 0; k < 16; ++k) {
            float mx = fmaxf(fmaxf(cv[0], cv[1]), fmaxf(cv[2], cv[3]));
            mx = fmaxf(mx, dpp_f<0xB1, 0xf>(mx, mx));
            mx = fmaxf(mx, dpp_f<0x4E, 0xf>(mx, mx));
            mx = fmaxf(mx, dpp_f<0x141, 0xf>(mx, mx));
            mx = fmaxf(mx, dpp_f<0x140, 0xf>(mx, mx));
            if (k == 0) M0 = mx;
#pragma unroll
            for (int m = 0; m < 4; ++m) cv[m] = (cv[m] == mx) ? NEG : cv[m];
        }
        bool sel[4]; float e[4]; float es = 0.f;
#pragma unroll
        for (int m = 0; m < 4; ++m) { sel[m] = (cv[m] != og[m]); e[m] = sel[m] ? __expf(og[m] - M0) : 0.f; es += e[m]; }
        es += dpp_f<0xB1, 0xf>(0.f, es); es += dpp_f<0x4E, 0xf>(0.f, es); es += dpp_f<0x141, 0xf>(0.f, es); es += dpp_f<0x140, 0xf>(0.f, es);
        const float inv = 1.0f / es;
        int basepos = 0;
        const int head = 4 * hh + row;
#pragma unroll
        for (int m = 0; m < 4; ++m) {
            const unsigned long long bl = __ballot(sel[m]);
            const unsigned rbits = (unsigned)(bl >> (16 * row)) & 0xffffu;
            const int pos = basepos + __popc(rbits & ((1u << i16) - 1u));
            if (sel[m] && pos < 16) { ex[(size_t)t * 128 + head * 16 + pos] = id[m]; gt[(size_t)t * 128 + head * 16 + pos] = e[m] * inv; }
            basepos += __popc(rbits);
        }
    }
}

typedef __bf16 bf16x32v __attribute__((ext_vector_type(32)));
typedef __bf16 bf16x2v __attribute__((ext_vector_type(2)));
typedef float f32x2 __attribute__((ext_vector_type(2)));
#ifndef P8_THROTTLE
#define P8_THROTTLE 0
#endif
constexpr unsigned P8_SLACK = 12;
#ifndef P8_SWEEPSYNC
#define P8_SWEEPSYNC 1
#endif
#ifndef P8_MIDSYNC
#define P8_MIDSYNC 2
#endif
__device__ __forceinline__ void phase8(const Params& p, LAS unsigned char* lds, float* dst, const XcdBarrier& xb, int gw, int NGW, int wave, int lane) {
    unsigned char* ws = p.ws;
    const bf16_t* x1b = (const bf16_t*)(ws + WS_X1B); const unsigned char* UT = ws + WS_UT; const unsigned char* VT = ws + WS_VT;
    const int* ex = (const int*)(ws + WS_EXP); const float* gt = (const float*)(ws + WS_GATE); const float* ss2 = (const float*)(ws + WS_ROWSS) + 3 * S;
    const float* out = p.out;
    LAS unsigned* list = (LAS unsigned*)(lds + 131072 + wave * 2048);
    LAS unsigned* hist = (LAS unsigned*)(lds + 147456 + wave * 1024);
    for (int tb = gw; tb < S / 4; tb += NGW) {
        const int t0 = tb * 4;
        int id[8]; float gv[8];
#pragma unroll
        for (int r = 0; r < 8; ++r) { const size_t o = (size_t)(t0 + (r >> 1)) * 128 + (r & 1) * 64 + lane; id[r] = ex[o]; gv[r] = gt[o]; }
        const float rs0 = rsqrtf(ss2[t0 + 0] * (1.0f / DM) + EPS) * (1.0f / PEER_USC), rs1 = rsqrtf(ss2[t0 + 1] * (1.0f / DM) + EPS) * (1.0f / PEER_USC);
        const float rs2 = rsqrtf(ss2[t0 + 2] * (1.0f / DM) + EPS) * (1.0f / PEER_USC), rs3 = rsqrtf(ss2[t0 + 3] * (1.0f / DM) + EPS) * (1.0f / PEER_USC);
#pragma unroll
        for (int j = 0; j < 4; ++j) hist[j * 64 + lane] = 0u;
        LDS_WAIT(); asm volatile("" ::: "memory");
        unsigned pos[8];
#pragma unroll
        for (int r = 0; r < 8; ++r) pos[r] = __hip_atomic_fetch_add(hist + (r >> 1) * 64 + (id[r] >> 8), 1u, __ATOMIC_RELAXED, __HIP_MEMORY_SCOPE_WORKGROUP);
        LDS_WAIT(); asm volatile("" ::: "memory");
        unsigned cnt[4], inc[4];
#pragma unroll
        for (int j = 0; j < 4; ++j) { cnt[j] = hist[j * 64 + lane]; inc[j] = cnt[j]; }
#pragma unroll
        for (int o = 1; o < 64; o <<= 1)
#pragma unroll
            for (int j = 0; j < 4; ++j) { const unsigned n = __shfl_up(inc[j], o); if (lane >= o) inc[j] += n; }
        LDS_WAIT(); asm volatile("" ::: "memory");
#pragma unroll
        for (int j = 0; j < 4; ++j) hist[j * 64 + lane] = inc[j] - cnt[j];
        LDS_WAIT(); asm volatile("" ::: "memory");
#pragma unroll
        for (int r = 0; r < 8; ++r) { const unsigned d = hist[(r >> 1) * 64 + (id[r] >> 8)] + pos[r]; list[4u * d + (unsigned)(r >> 1)] = (unsigned)id[r] | ((unsigned)(r >> 1) << 14) | (f2bf(gv[r]) << 16); }
        LDS_WAIT(); asm volatile("" ::: "memory");
        {
            typedef unsigned u32x16 __attribute__((ext_vector_type(16)));
            const __amdgpu_buffer_rsrc_t urs = __builtin_amdgcn_make_buffer_rsrc((void*)UT, 0, 16384 * PEER_ROWB, 0x00020000);
            const int vo4 = lane * 16, vo2 = lane * 8 + 1024;
            const bool lb0 = (lane & 1) != 0, lb1 = (lane & 2) != 0, lb2 = (lane & 4) != 0;
            s16x4 xr[4][8];
#pragma unroll
            for (int j = 0; j < 4; ++j)
#pragma unroll
                for (int q = 0; q < 8; ++q) xr[j][q] = __builtin_bit_cast(s16x4, *(const u32x2*)(x1b + (size_t)(t0 + j) * DM + (q * 64 + lane) * 4));
#define P8_ULOAD(k, i) do { const unsigned en = (unsigned)__builtin_amdgcn_readfirstlane((int)list[(i)]); const int ro = (int)((en & 0x3fffu) * (unsigned)PEER_ROWB); \
            u4[k] = __builtin_amdgcn_raw_buffer_load_b128(urs, vo4, ro, 0); u2[k] = __builtin_amdgcn_raw_buffer_load_b64(urs, vo2, ro, 0); } while (0)
#define P8_UPROC2(k, dk) do { const u32x6 pk = {u4[k][0], u4[k][1], u4[k][2], u4[k][3], u2[k][0], u2[k][1]}; \
            const u32x16 r_ = __builtin_bit_cast(u32x16, __builtin_amdgcn_cvt_scalef32_pk32_bf16_fp6(pk, 1.0f)); \
            f32x4 a0 = {0.f, 0.f, 0.f, 0.f}, a1 = {0.f, 0.f, 0.f, 0.f}; \
            _Pragma("unroll") for (int q = 0; q < 8; q += 2) { \
                a0 = __builtin_amdgcn_mfma_f32_4x4x4bf16_1k(__builtin_bit_cast(s16x4, (u32x2){r_[2 * q], r_[2 * q + 1]}), xr[(k) & 3][q], a0, 0, 0, 0); \
                a1 = __builtin_amdgcn_mfma_f32_4x4x4bf16_1k(__builtin_bit_cast(s16x4, (u32x2){r_[2 * q + 2], r_[2 * q + 3]}), xr[(k) & 3][q + 1], a1, 0, 0, 0); } \
            const f32x4 a_ = a0 + a1; \
            const float e0 = lb0 ? a_[1] : a_[0], e1 = lb0 ? a_[3] : a_[2]; dd[dk] = lb1 ? e1 : e0; } while (0)
#ifndef P8_URING
#define P8_URING 8
#endif
#if (PROBE_DUP >> 10) & 1
#define P8_UREPS 2
#else
#define P8_UREPS 1
#endif
#pragma unroll 1
            for (int urep = 0; urep < P8_UREPS; ++urep) {
                u32x4 u4[P8_URING]; u32x2 u2[P8_URING];
#pragma unroll
                for (int k = 0; k < P8_URING; ++k) P8_ULOAD(k, k);
#pragma unroll 1
                for (int i0 = 0; i0 < 512; i0 += P8_URING) {
                    if (P8_SWEEPSYNC && i0 == 256 && NGW == S / 4) xcd_local_barrier(xb);
#pragma unroll
                    for (int hb = 0; hb < P8_URING / 8; ++hb) {
                        const int i = i0 + 8 * hb;
                        const unsigned ev = list[i + (lane & 7)]; const unsigned jl = (unsigned)lane & 3u;
                        const float gl = __builtin_bit_cast(float, ev & 0xffff0000u), rl = jl == 0u ? rs0 : (jl == 1u ? rs1 : (jl == 2u ? rs2 : rs3));
                        float dd[8];
#pragma unroll
                        for (int k = 0; k < 8; ++k) { P8_UPROC2(8 * hb + k, k); const int nx = i + P8_URING + k; P8_ULOAD(8 * hb + k, nx < 512 ? nx : 508 + (k & 3)); }
                        float w4[4], w2[2];
#pragma unroll
                        for (int q = 0; q < 4; ++q) { const float kp = lb2 ? dd[q + 4] : dd[q], sd = lb2 ? dd[q] : dd[q + 4]; w4[q] = kp + __shfl_xor(sd, 4); }
#pragma unroll
                        for (int q = 0; q < 2; ++q) { const float kp = lb1 ? w4[q + 2] : w4[q], sd = lb1 ? w4[q] : w4[q + 2]; w2[q] = kp + __shfl_xor(sd, 2); }
                        float dres; { const float kp = lb0 ? w2[1] : w2[0], sd = lb0 ? w2[0] : w2[1]; dres = kp + __shfl_xor(sd, 1); }
                        dres += __shfl_xor(dres, 8); dres += __shfl_xor(dres, 16); dres += __shfl_xor(dres, 32);
                        const float c_ = gl * gelu_tanh(rl * dres) * (1.0f / PEER_VSC);
                        if (lane < 8 && urep == P8_UREPS - 1) list[i + lane] = (ev & 0xffffu) | (f2bf(c_) << 16);
                    }
                }
            }
#undef P8_ULOAD
#undef P8_UPROC2
        }
        asm volatile("s_waitcnt vmcnt(0)" ::: "memory");
        LDS_WAIT(); asm volatile("" ::: "memory");
#if P8_MIDSYNC == 1
        __syncthreads();
#elif P8_MIDSYNC == 2
        if (NGW == S / 4) xcd_local_barrier(xb);
#endif
        f32x4 acc[4][8];
#if (PROBE_DUP >> 12) & 1
#define P8_VREPS 2
#else
#define P8_VREPS 1
#endif
#ifndef P8_VRING
#define P8_VRING 8
#endif
#pragma unroll 1
        for (int vrep = 0; vrep < P8_VREPS; ++vrep) {
#pragma unroll
        for (int j = 0; j < 4; ++j)
#pragma unroll
            for (int q = 0; q < 8; ++q) acc[j][q] = (f32x4){0.f, 0.f, 0.f, 0.f};
        {
            typedef unsigned u32x16 __attribute__((ext_vector_type(16)));
            u32x4 v4[P8_VRING]; u32x2 v2[P8_VRING]; unsigned ven[P8_VRING];
            const unsigned li = (unsigned)lane & 3u;
            const unsigned m0 = li == 0u ? 0x0000ffffu : (li == 1u ? 0xffff0000u : 0u), m1 = li == 2u ? 0x0000ffffu : (li == 3u ? 0xffff0000u : 0u);
            const __amdgpu_buffer_rsrc_t vrs = __builtin_amdgcn_make_buffer_rsrc((void*)VT, 0, 16384 * PEER_ROWB, 0x00020000);
            const int vo4 = lane * 16, vo2 = lane * 8 + 1024;
#define P8_VLOAD(k, i) do { const unsigned en = (unsigned)__builtin_amdgcn_readfirstlane((int)list[(i)]); ven[k] = en; const int ro = (int)((en & 0x3fffu) * (unsigned)PEER_ROWB); \
            v4[k] = __builtin_amdgcn_raw_buffer_load_b128(vrs, vo4, ro, 0); v2[k] = __builtin_amdgcn_raw_buffer_load_b64(vrs, vo2, ro, 0); } while (0)
#define P8_VPROC(k) do { const u32x6 pk = {v4[k][0], v4[k][1], v4[k][2], v4[k][3], v2[k][0], v2[k][1]}; \
            const u32x16 r_ = __builtin_bit_cast(u32x16, __builtin_amdgcn_cvt_scalef32_pk32_bf16_fp6(pk, 1.0f)); \
            const unsigned e_ = ven[k], cf = (e_ >> 16) | (e_ & 0xffff0000u); \
            const s16x4 av = __builtin_bit_cast(s16x4, (u32x2){cf & m0, cf & m1}); \
            _Pragma("unroll") for (int q = 0; q < 8; ++q) \
                acc[(k) & 3][q] = __builtin_amdgcn_mfma_f32_4x4x4bf16_1k(av, __builtin_bit_cast(s16x4, (u32x2){r_[2 * q], r_[2 * q + 1]}), acc[(k) & 3][q], 0, 0, 0); } while (0)
#pragma unroll
            for (int k = 0; k < P8_VRING; ++k) P8_VLOAD(k, k);
#pragma unroll 1
            for (int i = 0; i < 512 - 512 % P8_VRING; i += P8_VRING) {
                if (P8_SWEEPSYNC && i == 256 && NGW == S / 4) xcd_local_barrier(xb);
#pragma unroll
                for (int k = 0; k < P8_VRING; ++k) { P8_VPROC(k); const int nx = i + P8_VRING + k; P8_VLOAD(k, nx < 512 ? nx : 508 + (k & 3)); }
            }
#pragma unroll
            for (int k = 0; k < 512 % P8_VRING; ++k) P8_VPROC(k);
#undef P8_VLOAD
#undef P8_VPROC
        }
        }
        int tq = t0, lq = lane; asm volatile("" : "+s"(tq)); asm volatile("" : "+v"(lq));
#pragma unroll
        for (int j = 0; j < 4; ++j)
#pragma unroll
            for (int i = 0; i < 8; ++i) {
                const size_t o = (size_t)(tq + j) * DM + (i * 64 + lq) * 4;
                const u32x2 xw = *(const u32x2*)(x1b + o);
                f32x4 a = {bflo(xw.x), bfhi(xw.x), bflo(xw.y), bfhi(xw.y)};
                a += acc[j][i];
                __builtin_nontemporal_store(a, (f32x4*)(dst + o));
                if (i & 1) asm volatile("" ::: "memory");
            }
        LDS_WAIT(); asm volatile("" ::: "memory");
    }
}

__global__ void __launch_bounds__(NTHREADS, 2) mega(Params p) {
    extern __shared__ __attribute__((aligned(16))) unsigned char lds_raw[];
    LAS unsigned char* lds = (LAS unsigned char*)lds_raw;
    const int tid = threadIdx.x, lane = tid & 63, wave = __builtin_amdgcn_readfirstlane(tid >> 6);
    const int G = gridDim.x, bx = blockIdx.x;
    const int gw = bx * 8 + wave, NGW = G * 8;
    unsigned char* ws = p.ws;
    const int lo = p.ph_lo, hi = p.ph_hi;
    volatile LAS unsigned* misc = (volatile LAS unsigned*)(lds + LDS_MISC);
    if (tid < 4) misc[tid] = 0u;
    __syncthreads();
    const XcdBarrier xbar = xcd_barrier_post((unsigned*)(ws + WS_CTL), misc);
#ifndef PH_MASK
#define PH_MASK 0x1ff
#endif
#define IN(k) (((PH_MASK >> (k)) & 1) && lo <= (k) && (k) < hi)
#define SEAM(k) do { if (IN(k) && IN((k) + 1)) xcd_barrier(xbar); } while (0)

#if (PROBE_DUP >> 0) & 1
    if (IN(0)) { phase0(p, lds, G == 256, gw, NGW, wave, lane); xcd_barrier(xbar); }
#endif
    if (IN(0)) phase0(p, lds, G == 256, gw, NGW, wave, lane);
    SEAM(0);
    const bool part = (G == 256) && (misc[2] != 0u);
    const int vx = __builtin_amdgcn_readfirstlane(part ? (int)xbar.x : (bx & 7)), vr = __builtin_amdgcn_readfirstlane(part ? (int)misc[3] : (bx >> 3));
    const int vpanel = (vr >> 3) == 0 ? vx : ((vr >> 3) == 1 ? 31 - vx : ((vr >> 3) == 2 ? vx + 8 : 23 - vx));
    const int gwv = (G == 256) ? vpanel * 64 + (vr & 7) * 8 + wave : gw;
#define SEAM_X(k) do { if (IN(k) && IN((k) + 1)) { if (part) xcd_local_barrier_acq(xbar); else xcd_barrier(xbar); } } while (0)
    if (IN(1)) {
        pg8::Gemm g{(const bf16_t*)(ws + WS_XB), (const bf16_t*)(ws + WS_WIN), S, NINP, DM, DM, DM};
        pg8::StaticOrder So; So.init(S, NINP, G, bx);
        pg8::Epi<1> E{(const float*)(ws + WS_RSTD1), 0.f, (float*)(ws + WS_ROWSS), (bf16_t*)(ws + WS_PROJ), NINP, nullptr, nullptr};
#if (PROBE_DUP >> 1) & 1
        { pg8::Epi<1> E2 = E; E2.ss = (float*)(ws + 512 * 1024); pg8::gemm_phase<pg8::Epi<1>, pg8::StaticOrder, true, true>(lds, g, So, E2); xcd_barrier(xbar); }
#endif
        pg8::gemm_phase<pg8::Epi<1>, pg8::StaticOrder, true, true>(lds, g, So, E);
        if (G == 256 && bx >= 128) { __syncthreads(); prep_late(p, lds, (bx - 128) * 8 + wave, 1024, wave, lane); }
    }
    SEAM(1);
    if (IN(2)) {
        {
            pg8::Gemm g{(const bf16_t*)(ws + WS_PROJ) + 2048, (const bf16_t*)(ws + WS_WUQ), S, 1536, 512, NINP, 512};
            pg8::StaticOrder So; So.init(S, 1536, G, bx);
            pg8::Epi<2> E{(const float*)(ws + WS_ROWSS) + 1 * S, 1.0f / 512.0f, nullptr, (bf16_t*)(ws + WS_QRAW), 1536, nullptr, nullptr};
            pg8::gemm_phase<pg8::Epi<2>, pg8::StaticOrder, true, true>(lds, g, So, E);
        }
        __syncthreads();
        {
            pg8::Gemm g{(const bf16_t*)(ws + WS_PROJ) + 2560, (const bf16_t*)(ws + WS_WUKV), S, 2048, 256, NINP, 256};
            pg8::StaticOrder So; So.init(S, 2048, G, bx);
            pg8::Epi<2> E{(const float*)(ws + WS_ROWSS) + 2 * S, 1.0f / 256.0f, nullptr, (bf16_t*)(ws + WS_KVRAW), 2048, nullptr, nullptr};
            pg8::gemm_phase<pg8::Epi<2>, pg8::StaticOrder, true, true>(lds, g, So, E);
        }
    }
    SEAM(2);
#if (PROBE_DUP >> 3) & 1
    if (IN(3)) { phase3(p, gw, NGW, (S - gw + NGW - 1) / NGW, lane); xcd_barrier(xbar); }
#endif
    if (IN(3)) phase3(p, gw, NGW, (S - gw + NGW - 1) / NGW, lane);
    SEAM(3);
    const int vP = (vr >> 4) ? vx + 8 : vx, vqa = ((vr >> 3) & 1) ? 62 - 2 * vP : 63 - 2 * vP, vqb = ((vr >> 3) & 1) ? 2 * vP + 1 : 2 * vP;
#define P4_BODY_ATT do { if (G == 256) { attn_unit(p, lds, vr & 7, vqa, tid, wave, lane); attn_unit(p, lds, vr & 7, vqb, tid, wave, lane); } \
        else for (int pr = bx; pr < 256; pr += G) { const int head = pr & 7, x = pr >> 3; attn_unit(p, lds, head, 63 - x, tid, wave, lane); attn_unit(p, lds, head, x, tid, wave, lane); } } while (0)
#define P4_BODY_GMLP do { if (G == 256) { gmlp_unit(p, lds, vqa, vr & 7, tid, wave, lane); gmlp_unit(p, lds, vqb, vr & 7, tid, wave, lane); } \
        else for (int u = bx; u < 512; u += G) gmlp_unit(p, lds, u >> 3, u & 7, tid, wave, lane); } while (0)
#if (PROBE_DUP >> 4) & 1
    if (IN(4)) { P4_BODY_ATT; xcd_barrier(xbar); }
#endif
#if (PROBE_DUP >> 9) & 1
    if (IN(4)) { P4_BODY_GMLP; xcd_barrier(xbar); }
#endif
    if (IN(4)) { P4_BODY_ATT; P4_BODY_GMLP; }
    SEAM_X(4);
    if (IN(5)) {
        pg8::Gemm g{(const bf16_t*)(ws + WS_MIX), (const bf16_t*)(ws + WS_WOUT), S, DM, DM, DM, DM};
        pg8::StaticOrder So; So.init(S, DM, G, bx); if (G == 256) So.fixed(vpanel, vr & 7);
        pg8::Epi<4> E{nullptr, 0.f, (float*)(ws + WS_ROWSS) + 3 * S, (bf16_t*)(ws + WS_X1B), DM, p.out, p.in[0]};
#if (PROBE_DUP >> 5) & 1
        { pg8::Epi<4> E2 = E; E2.ss = (float*)(ws + 512 * 1024); pg8::gemm_phase<pg8::Epi<4>, pg8::StaticOrder, true, true>(lds, g, So, E2); xcd_barrier(xbar); }
#endif
        pg8::gemm_phase<pg8::Epi<4>, pg8::StaticOrder, true, true>(lds, g, So, E);
    }
    SEAM_X(5);
    if (IN(6)) {
        pg8::Gemm g{(const bf16_t*)(ws + WS_X1B), (const bf16_t*)(ws + WS_WS), S, DM, DM, DM, DM};
        pg8::StaticOrder So; So.init(S, DM, G, bx); if (G == 256) So.fixed(vpanel, vr & 7);
        pg8::Epi<5> E{(const float*)(ws + WS_ROWSS) + 3 * S, 1.0f / DM, nullptr, nullptr, DM, (float*)(ws + WS_SC), nullptr};
#if (PROBE_DUP >> 6) & 1
        { pg8::gemm_phase<pg8::Epi<5>, pg8::StaticOrder, true, true>(lds, g, So, E); xcd_barrier(xbar); }
#endif
        pg8::gemm_phase<pg8::Epi<5>, pg8::StaticOrder, true, true>(lds, g, So, E);
    }
    SEAM_X(6);
#if (PROBE_DUP >> 7) & 1
    if (IN(7)) { phase7(p, lds, gwv, NGW, wave, lane); xcd_barrier(xbar); }
#endif
    if (IN(7)) phase7(p, lds, gwv, NGW, wave, lane);
    if (IN(7) && IN(8)) { if (NGW == S / 4) xcd_local_barrier(xbar); else xcd_barrier(xbar); }
#if (PROBE_DUP >> 8) & 1
    if (IN(8)) { phase8(p, lds, (float*)(ws + WS_SC), xbar, gwv, NGW, wave, lane); xcd_barrier(xbar); }
#endif
    if (IN(8)) phase8(p, lds, p.out, xbar, gwv, NGW, wave, lane);
#undef IN
#undef SEAM
#undef SEAM_X
}

extern "C" void kernel_launch(void* const* d_in, const int* in_sizes, int n_in, void* d_out, int out_size, void* d_ws, size_t ws_size, hipStream_t stream) {
    static int grid = 0;
    if (grid == 0) {
        if (n_in != 18 || out_size != S * DM || ws_size < WS_END) { fprintf(stderr, "kernel_launch: unexpected shapes (n_in %d out %d ws %zu)\n", n_in, out_size, ws_size); grid = -1; return; }
        int dev = 0, cus = 0, per_cu = 0;
        hipGetDevice(&dev);
        hipDeviceGetAttribute(&cus, hipDeviceAttributeMultiprocessorCount, dev);
        if (hipFuncSetAttribute((const void*)mega, hipFuncAttributeMaxDynamicSharedMemorySize, LDS_BYTES) != hipSuccess) { fprintf(stderr, "kernel_launch: hipFuncSetAttribute failed\n"); grid = -1; return; }
        if (hipOccupancyMaxActiveBlocksPerMultiprocessor(&per_cu, (const void*)mega, NTHREADS, LDS_BYTES) != hipSuccess || per_cu < 1) { fprintf(stderr, "kernel_launch: occupancy query failed (%d)\n", per_cu); grid = -1; return; }
        grid = cus;
        fprintf(stderr, "kernel_launch: cus %d per_cu %d grid %d\n", cus, per_cu, grid);
    }
    if (grid < 0) return;
    hipMemsetAsync((char*)d_ws + WS_CTL, 0, 1 * MiB, stream);
    Params prm{};
    for (int i = 0; i < 18; ++i) prm.in[i] = (const float*)d_in[i];
    prm.out = (float*)d_out; prm.ws = (unsigned char*)d_ws;
#if MK_ONE_LAUNCH
    prm.ph_lo = 0; prm.ph_hi = NPH;
    { void* args[] = {&prm}; hipError_t e = hipLaunchCooperativeKernel((const void*)mega, dim3(grid), dim3(NTHREADS), args, LDS_BYTES, stream);
      if (e != hipSuccess) fprintf(stderr, "cooperative launch failed: %s\n", hipGetErrorString(e)); }
#else
    for (int ph = 0; ph < NPH; ++ph) {
        prm.ph_lo = ph; prm.ph_hi = ph + 1;
        void* args[] = {&prm};
        hipError_t e = hipLaunchCooperativeKernel((const void*)mega, dim3(grid), dim3(NTHREADS), args, LDS_BYTES, stream);
        if (e != hipSuccess) { fprintf(stderr, "cooperative launch %d failed: %s\n", ph, hipGetErrorString(e)); break; }
    }
#endif
}
```

```cpp
#include <hip/hip_runtime.h>
#include <cstdio>
#include <cstdint>

#define LAS __attribute__((address_space(3)))
typedef unsigned short bf16_t;
typedef short bf16x8 __attribute__((ext_vector_type(8)));
typedef short s16x4 __attribute__((ext_vector_type(4)));
typedef float f32x4 __attribute__((ext_vector_type(4)));
typedef float f32x16 __attribute__((ext_vector_type(16)));
typedef unsigned u32x4 __attribute__((ext_vector_type(4)));
typedef unsigned u32x2 __attribute__((ext_vector_type(2)));

#ifndef PROBE_DUP
#define PROBE_DUP 0
#endif
#ifndef MK_ONE_LAUNCH
#define MK_ONE_LAUNCH 1
#endif

constexpr int S = 8192, DM = 2048, NIN = 2880, NINP = 3072;
constexpr int NPH = 9;
constexpr float EPS = 1e-6f;
constexpr int LDS_BYTES = 163840;
constexpr int NTHREADS = 512;
constexpr int LDS_MISC = 161792;

constexpr size_t MiB = 1u << 20;
constexpr size_t WS_CTL = 0;
constexpr size_t WS_ROWSS = 128 * 1024;
constexpr size_t WS_COS = 1 * MiB, WS_SIN = 2 * MiB;
constexpr size_t WS_RSTD1 = 3 * MiB;
constexpr size_t WS_EXP = 4 * MiB;
constexpr size_t WS_GATE = 8 * MiB;
constexpr size_t WS_WIN = 12 * MiB;
constexpr size_t WS_WUQ = 24 * MiB;
constexpr size_t WS_WUKV = 26 * MiB;
constexpr size_t WS_WOUT = 28 * MiB;
constexpr size_t WS_WS = 36 * MiB;
constexpr size_t WS_XB = 44 * MiB;
constexpr size_t WS_PROJ = 76 * MiB;
constexpr size_t WS_QRAW = 124 * MiB;
constexpr size_t WS_KVRAW = 148 * MiB;
constexpr size_t WS_QH = 180 * MiB;
constexpr size_t WS_KH = 204 * MiB;
constexpr size_t WS_VH = 228 * MiB;
constexpr size_t WS_MIX = 244 * MiB;
constexpr size_t WS_X1B = 276 * MiB;
constexpr size_t WS_SC = 308 * MiB;
constexpr size_t WS_UT = 372 * MiB;
constexpr size_t WS_VT = 436 * MiB;
constexpr size_t WS_END = 500 * MiB;

__device__ __forceinline__ unsigned f2bf(float f) { unsigned u = __builtin_bit_cast(unsigned, f); return (u + 0x7fffu + ((u >> 16) & 1u)) >> 16; }
__device__ __forceinline__ unsigned pk2(float lo, float hi) { return f2bf(lo) | (f2bf(hi) << 16); }
__device__ __forceinline__ float bf2f(unsigned short b) { return __builtin_bit_cast(float, (unsigned)b << 16); }
__device__ __forceinline__ float bflo(unsigned w) { return __builtin_bit_cast(float, w << 16); }
__device__ __forceinline__ float bfhi(unsigned w) { return __builtin_bit_cast(float, w & 0xffff0000u); }
__device__ __forceinline__ float wave_sum(float v) {
#pragma unroll
    for (int o = 32; o > 0; o >>= 1) v += __shfl_xor(v, o);
    return v;
}
__device__ __forceinline__ float wave_max(float v) {
#pragma unroll
    for (int o = 32; o > 0; o >>= 1) v = fmaxf(v, __shfl_xor(v, o));
    return v;
}
template <int CTRL, int ROW_MASK> __device__ __forceinline__ float dpp_f(float old, float v) {
    return __builtin_bit_cast(float, __builtin_amdgcn_update_dpp(__builtin_bit_cast(int, old), __builtin_bit_cast(int, v), CTRL, ROW_MASK, 0xf, false));
}
__device__ __forceinline__ float wave_max_u(float v) {
    v = fmaxf(v, dpp_f<0xB1, 0xf>(v, v));
    v = fmaxf(v, dpp_f<0x4E, 0xf>(v, v));
    v = fmaxf(v, dpp_f<0x141, 0xf>(v, v));
    v = fmaxf(v, dpp_f<0x140, 0xf>(v, v));
    v = fmaxf(v, dpp_f<0x142, 0xa>(v, v));
    v = fmaxf(v, dpp_f<0x143, 0xc>(v, v));
    return __builtin_bit_cast(float, __builtin_amdgcn_readlane(__builtin_bit_cast(int, v), 63));
}
__device__ __forceinline__ float wave_sum_u(float v) {
    v += dpp_f<0xB1, 0xf>(0.f, v);
    v += dpp_f<0x4E, 0xf>(0.f, v);
    v += dpp_f<0x141, 0xf>(0.f, v);
    v += dpp_f<0x140, 0xf>(0.f, v);
    v += dpp_f<0x142, 0xa>(0.f, v);
    v += dpp_f<0x143, 0xc>(0.f, v);
    return __builtin_bit_cast(float, __builtin_amdgcn_readlane(__builtin_bit_cast(int, v), 63));
}
__device__ __forceinline__ float gelu_tanh(float x) {
    const float y = 0.7978845608028654f * (x + 0.044715f * x * x * x);
    return x / (1.0f + __expf(-2.0f * y));
}
__device__ __forceinline__ int crow(int r, int hi) { return (r & 3) + 8 * (r >> 2) + 4 * hi; }
#define LDS_WAIT() asm volatile("s_waitcnt lgkmcnt(0)" ::: "memory")
#define SBAR() __builtin_amdgcn_sched_barrier(0)

namespace pg8 {
#define PG8_LAS __attribute__((address_space(3)))
constexpr int BM = 256, BK = 64, HALF = 128, HTB = HALF * BK * 2  , STAGE_BYTES = 8 * HTB, NXCD = 8, WGM = 8;

__host__ __device__ __forceinline__ int lds_byte(int r, int c) { const int st = (r >> 4) * 2 + (c >> 5), rr = r & 15, cc = c & 31, ob = rr * 64 + cc * 2; return st * 1024 + (ob ^ (((ob >> 9) & 1) << 5)); }
__host__ __device__ __forceinline__ void stage_rc(int b, int& R, int& C) { const int st = b / 1024, sb = b % 1024, swz = sb ^ (((sb >> 9) & 1) << 5); R = (st >> 1) * 16 + swz / 64; C = (st & 1) * 32 + (swz % 64) / 2; }
__host__ __device__ __forceinline__ int perm32(int rho) { const int n = rho >> 4, i = rho & 15; return 8 * (i >> 2) + 4 * n + (i & 3); }

struct Unit { int pm, pn; };
struct Gemm { const bf16_t* A; const bf16_t* Bt; int M, N, K, lda, ldb; };

struct StaticOrder {
    int nM, nN, nwg, G, c, fpm = -1, fpn = 0;
    __host__ __device__ void init(int M, int N, int G_, int c_) { nM = M / BM; nN = N / BM; nwg = nM * nN; G = G_; c = c_; fpm = -1; }
    __host__ __device__ void fixed(int pm, int pn) { fpm = pm; fpn = pn; }
    __host__ __device__ bool next(int i, Unit& u) const {
        if (fpm >= 0) { if (i > 0) return false; u.pm = fpm; u.pn = fpn; return true; }
        const long L = (long)i * G + c; if (L >= nwg) return false;
        int wgid = (int)L; { const int q = nwg / NXCD, r = nwg % NXCD, xcd = wgid % NXCD, off = wgid / NXCD; wgid = (xcd < r ? xcd * (q + 1) : r * (q + 1) + (xcd - r) * q) + off; }
        const int nig = WGM * nN, gid = wgid / nig, fm = gid * WGM, gsz = (nM - fm) < WGM ? (nM - fm) : WGM;
        u.pm = fm + ((wgid % nig) % gsz); u.pn = (wgid % nig) / gsz; return true;
    }
    __device__ __forceinline__ void a_ready(const Unit&) const {}
    __device__ __forceinline__ void done(const Unit&) const {}
};

template <class Epi, class Sched, bool ALIGN_EPI = false, bool SP2 = false>
__device__ __forceinline__ void gemm_phase(PG8_LAS unsigned char* lds, const Gemm g, const Sched& S, const Epi& E) {
    const int tid = threadIdx.x, wid = __builtin_amdgcn_readfirstlane(tid >> 6), lane = tid & 63, wr = wid >> 2, wc = wid & 3, fr = lane & 15, fq = lane >> 4;
    const int K = g.K, nt = K / BK;
    unsigned voffA[2], voffB[2];
#pragma unroll
    for (int i = 0; i < 2; ++i) { int R, C; stage_rc(tid * 16 + i * 8192, R, C); const int Rb = Epi::PERM ? ((R & ~31) + perm32(R & 31)) : R;
        voffA[i] = (unsigned)(R * g.lda + C) * 2u; voffB[i] = (unsigned)(Rb * g.ldb + C) * 2u; }
    const size_t kstep = (size_t)(BK * 2);
    const size_t hstepA = (size_t)HALF * g.lda * 2, hstepB = (size_t)HALF * g.ldb * 2;
    const size_t tstepA = 2 * hstepA, tstepB = 2 * hstepB;
    const unsigned ldsw = (unsigned)wid * 1024u;
    const int aoff = lds_byte(wr * 64 + fr, fq * 8), boff = lds_byte(wc * 32 + fr, fq * 8);
#define PG8_SA(b, h) (((b) * 2 + (h)) * HTB)
#define PG8_SB(b, h) ((4 + (b) * 2 + (h)) * HTB)
#define PG8_STAGE(bufoff, gbase, voff) do { _Pragma("unroll") for (int _i = 0; _i < 2; ++_i) \
        __builtin_amdgcn_global_load_lds((const unsigned*)((const char*)(gbase) + (voff)[_i]), (PG8_LAS unsigned*)(lds + (bufoff) + ldsw + _i * 8192), 16, 0, 0); } while (0)
#define PG8_LDA(dst, b, h) do { _Pragma("unroll") for (int m = 0; m < 4; ++m) _Pragma("unroll") for (int k = 0; k < 2; ++k) dst[m][k] = *(const PG8_LAS bf16x8*)(lds + PG8_SA(b, h) + aoff + m * 2048 + k * 1024); } while (0)
#define PG8_LDB(dst, b, h) do { _Pragma("unroll") for (int n = 0; n < 2; ++n) _Pragma("unroll") for (int k = 0; k < 2; ++k) dst[n][k] = *(const PG8_LAS bf16x8*)(lds + PG8_SB(b, h) + boff + n * 2048 + k * 1024); } while (0)
#define PG8_MMA(ai, bj, At, Bt) do { __builtin_amdgcn_s_setprio(1); _Pragma("unroll") for (int m = 0; m < 4; ++m) _Pragma("unroll") for (int n = 0; n < 2; ++n) _Pragma("unroll") for (int k = 0; k < 2; ++k) \
        acc[ai][bj][m][n] = __builtin_amdgcn_mfma_f32_16x16x32_bf16(Bt[n][k], At[m][k], acc[ai][bj][m][n], 0, 0, 0); __builtin_amdgcn_s_setprio(0); } while (0)
#define PG8_WAIT_V(n) asm volatile("s_waitcnt vmcnt(" #n ")" ::: "memory")
#define PG8_WAIT_L(n) asm volatile("s_waitcnt lgkmcnt(" #n ")" ::: "memory")
#define PG8_BAR __builtin_amdgcn_s_barrier()
#define PG8_SCHED __builtin_amdgcn_sched_barrier(0)
    Unit cur, nxt; int ui = 0;
    if (!S.next(0, cur)) return;
    f32x4 acc[2][2][4][2];
#pragma unroll
    for (int a = 0; a < 2; ++a)
#pragma unroll
        for (int b = 0; b < 2; ++b)
#pragma unroll
            for (int m = 0; m < 4; ++m)
#pragma unroll
                for (int n = 0; n < 2; ++n) acc[a][b][m][n] = (f32x4){0.f, 0.f, 0.f, 0.f};
    bf16x8 At[4][2], B0[2][2], B1[2][2];
    const char* cA = (const char*)g.A + (size_t)cur.pm * tstepA; const char* cB = (const char*)g.Bt + (size_t)cur.pn * tstepB;
    S.a_ready(cur);
    if constexpr (SP2) {
        PG8_STAGE(PG8_SB(0, 0), cB, voffB); PG8_STAGE(PG8_SB(0, 1), cB + hstepB, voffB); PG8_STAGE(PG8_SA(0, 0), cA, voffA); PG8_STAGE(PG8_SA(0, 1), cA + hstepA, voffA);
        if (wr == 1) PG8_BAR;
        PG8_WAIT_V(2); PG8_BAR;
        PG8_STAGE(PG8_SB(1, 0), cB + kstep, voffB); PG8_STAGE(PG8_SA(1, 0), cA + kstep, voffA); PG8_STAGE(PG8_SB(1, 1), cB + hstepB + kstep, voffB);
        PG8_WAIT_V(6); PG8_BAR;
    } else {
        PG8_STAGE(PG8_SB(0, 0), cB, voffB); PG8_STAGE(PG8_SA(0, 0), cA, voffA); PG8_STAGE(PG8_SB(0, 1), cB + hstepB, voffB); PG8_STAGE(PG8_SA(0, 1), cA + hstepA, voffA);
        if (wr == 1) PG8_BAR;
        PG8_WAIT_V(4); PG8_BAR;
        PG8_STAGE(PG8_SB(1, 0), cB + kstep, voffB); PG8_STAGE(PG8_SA(1, 0), cA + kstep, voffA); PG8_STAGE(PG8_SB(1, 1), cB + hstepB + kstep, voffB);
        PG8_WAIT_V(6); PG8_BAR;
    }
    for (;;) {
        const bool has_next = S.next(ui + 1, nxt);
        const char* nA = has_next ? (const char*)g.A + (size_t)nxt.pm * tstepA : cA; const char* nB = has_next ? (const char*)g.Bt + (size_t)nxt.pn * tstepB : cB;
        for (int t = 0; t < nt; t += 2) {
            const bool last = (t == nt - 2);
            const char* a1 = cA + (size_t)(t + 1) * kstep;
            const char* a2 = last ? nA : cA + (size_t)(t + 2) * kstep; const char* b2 = last ? nB : cB + (size_t)(t + 2) * kstep;
            const char* a3 = a2 + kstep; const char* b3 = b2 + kstep;
            if (last && has_next) S.a_ready(nxt);
            if constexpr (SP2) {
            PG8_LDB(B0, 0, 0); PG8_LDB(B1, 0, 1); PG8_SCHED; PG8_LDA(At, 0, 0); PG8_STAGE(PG8_SA(1, 1), a1 + hstepA, voffA);
            PG8_WAIT_V(8); PG8_WAIT_L(0); PG8_BAR; PG8_MMA(0, 0, At, B0); PG8_MMA(0, 1, At, B1); PG8_BAR; PG8_SCHED;
            PG8_LDA(At, 0, 1); PG8_STAGE(PG8_SB(0, 0), b2, voffB); PG8_STAGE(PG8_SB(0, 1), b2 + hstepB, voffB); PG8_STAGE(PG8_SA(0, 0), a2, voffA);
            PG8_WAIT_V(8); PG8_WAIT_L(0); PG8_BAR; PG8_MMA(1, 0, At, B0); PG8_MMA(1, 1, At, B1); PG8_BAR; PG8_SCHED;
            PG8_LDB(B0, 1, 0); PG8_LDB(B1, 1, 1); PG8_SCHED; PG8_LDA(At, 1, 0); PG8_STAGE(PG8_SA(0, 1), a2 + hstepA, voffA);
            PG8_WAIT_V(8); PG8_WAIT_L(0); PG8_BAR; PG8_MMA(0, 0, At, B0); PG8_MMA(0, 1, At, B1); PG8_BAR; PG8_SCHED;
            PG8_LDA(At, 1, 1); PG8_STAGE(PG8_SB(1, 0), b3, voffB); PG8_STAGE(PG8_SB(1, 1), b3 + hstepB, voffB); PG8_STAGE(PG8_SA(1, 0), a3, voffA);
            PG8_WAIT_V(8); PG8_WAIT_L(0); PG8_BAR; PG8_MMA(1, 0, At, B0); PG8_MMA(1, 1, At, B1); PG8_BAR; PG8_SCHED;
            } else {
            PG8_LDB(B0, 0, 0); PG8_SCHED; PG8_LDA(At, 0, 0); PG8_STAGE(PG8_SA(1, 1), a1 + hstepA, voffA);
            PG8_WAIT_L(8); PG8_BAR; PG8_WAIT_L(0); PG8_MMA(0, 0, At, B0); PG8_BAR; PG8_SCHED;
            PG8_LDB(B1, 0, 1); PG8_STAGE(PG8_SB(0, 0), b2, voffB);
            PG8_BAR; PG8_WAIT_L(0); PG8_MMA(0, 1, At, B1); PG8_BAR;
            PG8_LDA(At, 0, 1); PG8_STAGE(PG8_SA(0, 0), a2, voffA);
            PG8_BAR; PG8_WAIT_L(0); PG8_MMA(1, 0, At, B0); PG8_BAR; PG8_SCHED;
            PG8_STAGE(PG8_SB(0, 1), b2 + hstepB, voffB);
            PG8_WAIT_V(6); PG8_BAR; PG8_MMA(1, 1, At, B1); PG8_BAR;
            PG8_LDB(B0, 1, 0); PG8_SCHED; PG8_LDA(At, 1, 0); PG8_STAGE(PG8_SA(0, 1), a2 + hstepA, voffA);
            PG8_WAIT_L(8); PG8_BAR; PG8_WAIT_L(0); PG8_MMA(0, 0, At, B0); PG8_BAR; PG8_SCHED;
            PG8_LDB(B1, 1, 1); PG8_STAGE(PG8_SB(1, 0), b3, voffB);
            PG8_BAR; PG8_WAIT_L(0); PG8_MMA(0, 1, At, B1); PG8_BAR;
            PG8_LDA(At, 1, 1); PG8_STAGE(PG8_SA(1, 0), a3, voffA);
            PG8_BAR; PG8_WAIT_L(0); PG8_MMA(1, 0, At, B0); PG8_BAR; PG8_SCHED;
            PG8_STAGE(PG8_SB(1, 1), b3 + hstepB, voffB);
            PG8_WAIT_V(6); PG8_BAR; PG8_MMA(1, 1, At, B1); PG8_BAR;
            }
        }
        if constexpr (ALIGN_EPI) { if (wr == 0) PG8_BAR; }
        if constexpr (!Epi::AFTER_DRAIN) { E(acc, cur, wr, wc, fr, fq); S.done(cur); }
        if (!has_next) break;
#pragma unroll
        for (int a = 0; a < 2; ++a)
#pragma unroll
            for (int b = 0; b < 2; ++b)
#pragma unroll
                for (int m = 0; m < 4; ++m)
#pragma unroll
                    for (int n = 0; n < 2; ++n) acc[a][b][m][n] = (f32x4){0.f, 0.f, 0.f, 0.f};
        cur = nxt; cA = nA; cB = nB; ++ui;
        if constexpr (ALIGN_EPI) { if (wr == 1) PG8_BAR; }
    }
    PG8_WAIT_V(0);
    if constexpr (!ALIGN_EPI) { if (wr == 0) PG8_BAR; }
    PG8_BAR;
#undef PG8_SA
#undef PG8_SB
#undef PG8_STAGE
#undef PG8_LDA
#undef PG8_LDB
#undef PG8_MMA
#undef PG8_WAIT_V
#undef PG8_WAIT_L
#undef PG8_BAR
#undef PG8_SCHED
}

template <int MODE> struct Epi {
    static constexpr bool PERM = false, AFTER_DRAIN = false;
    const float* rowsrc; float inv_n; float* ss; bf16_t* ob; int ldc; float* of; const float* xin;
    __device__ __forceinline__ void operator()(const f32x4 (&acc)[2][2][4][2], const Unit& u, int wr, int wc, int fr, int fq) const {
#pragma unroll
        for (int ai = 0; ai < 2; ++ai)
#pragma unroll
            for (int m = 0; m < 4; ++m) {
                const int row = u.pm * BM + ai * HALF + wr * 64 + m * 16 + fr;
                float rs = 1.f;
                if (MODE == 1) rs = rowsrc[row];
                if (MODE == 2 || MODE == 5) rs = rsqrtf(rowsrc[row] * inv_n + EPS);
                float ssq = 0.f;
#pragma unroll
                for (int bj = 0; bj < 2; ++bj)
#pragma unroll
                    for (int n = 0; n < 2; ++n) {
                        const int col = u.pn * BM + bj * HALF + wc * 32 + n * 16 + fq * 4;
                        f32x4 v = acc[ai][bj][m][n] * rs;
                        if (MODE == 1) { if (u.pn < 8) { v[0] = gelu_tanh(v[0]); v[1] = gelu_tanh(v[1]); v[2] = gelu_tanh(v[2]); v[3] = gelu_tanh(v[3]); } }
                        if (MODE == 4) { const f32x4 xr = __builtin_nontemporal_load((const f32x4*)(xin + (size_t)row * DM + col)); v = v + xr; }
                        if (MODE == 1 || MODE == 4) ssq += (v[0] * v[0] + v[1] * v[1]) + (v[2] * v[2] + v[3] * v[3]);
                        if (MODE == 1 || MODE == 2 || MODE == 4) { u32x2 w; w.x = pk2(v[0], v[1]); w.y = pk2(v[2], v[3]); *(u32x2*)(ob + (size_t)row * ldc + col) = w; }
                        if (MODE == 5) *(f32x4*)(of + (size_t)row * DM + col) = v;
                    }
                if (MODE == 1) {
                    const int seg = (u.pn >= 4 && u.pn < 8) ? 0 : ((u.pn == 8 || u.pn == 9) ? 1 : (u.pn == 10 ? 2 : -1));
                    if (seg >= 0) { ssq += __shfl_xor(ssq, 16); ssq += __shfl_xor(ssq, 32); if (fq == 0) atomicAdd(ss + seg * S + row, ssq); }
                }
                if (MODE == 4) { ssq += __shfl_xor(ssq, 16); ssq += __shfl_xor(ssq, 32); if (fq == 0) atomicAdd(ss + row, ssq); }
            }
    }
};
}

#define XB_TMO      128
#define XB_XCNT(j)  (256  + 64 * (j))
#define XB_XSUB(j)  (1280 + 64 * (j))
#define XB_XGEN(j)  (2304 + 64 * (j))
#define XB_TOP      3328
#define XB_TOPGEN   3392
#define XCD_BAR_WORDS 3456
#define XB_SPIN_CAP (1u << 18)
__device__ __forceinline__ unsigned xb_ld(unsigned* p)              { return __hip_atomic_load(p, __ATOMIC_RELAXED, __HIP_MEMORY_SCOPE_AGENT); }
__device__ __forceinline__ unsigned xb_add(unsigned* p, unsigned v) { return __hip_atomic_fetch_add(p, v, __ATOMIC_RELAXED, __HIP_MEMORY_SCOPE_AGENT); }
__device__ __forceinline__ unsigned xb_xcc_id() { return (unsigned)__builtin_amdgcn_s_getreg((3 << 11) | 20) & 0xFu; }
#define XB_SPIN(cond, bar) do { unsigned _sp = 0; while (cond) { __builtin_amdgcn_s_sleep(1); \
    if ((++_sp & 255u) == 0u) { if (xb_ld(&(bar)[XB_TMO])) break; if (_sp > XB_SPIN_CAP) { atomicAdd(&(bar)[XB_TMO], 1u); break; } } } } while (0)
struct XcdBarrier { unsigned* bar; unsigned x; volatile LAS unsigned* st; };
__device__ __forceinline__ XcdBarrier xcd_barrier_post(unsigned* bar, volatile LAS unsigned* st) {
    XcdBarrier b; b.bar = bar; b.x = xb_xcc_id(); b.st = st;
    if (threadIdx.x == 0) st[3] = xb_add(&bar[XB_XCNT(b.x)], 1u);
    return b;
}
__device__ __forceinline__ void xcd_barrier_complete(unsigned* bar, unsigned x, unsigned& nloc, unsigned& nx, unsigned& eq32) {
    const unsigned G = gridDim.x * gridDim.y * gridDim.z;
    unsigned sum, cnt, mine, sp = 0u;
    for (;;) {
        sum = 0u; cnt = 0u; mine = 0u; eq32 = 1u;
#pragma unroll
        for (unsigned j = 0; j < 16; ++j) { const unsigned c = xb_ld(&bar[XB_XCNT(j)]); sum += c; cnt += (c > 0u) ? 1u : 0u; mine = (j == x) ? c : mine; if (c != (j < 8u ? 32u : 0u)) eq32 = 0u; }
        if (sum == G) break;
        __builtin_amdgcn_s_sleep(1);
        if ((++sp & 255u) == 0u) { if (xb_ld(&bar[XB_TMO])) break; if (sp > XB_SPIN_CAP) { atomicAdd(&bar[XB_TMO], 1u); break; } }
    }
    nloc = mine > 0u ? mine : 1u; nx = cnt > 0u ? cnt : 1u;
}
#define XB_LSUB(j)  (3456 + 64 * (j))
#define XB_LGEN(j)  (4480 + 64 * (j))
__device__ __forceinline__ void xcd_local_barrier(const XcdBarrier& b) {
    asm volatile("s_waitcnt vmcnt(0)" ::: "memory");
    __syncthreads();
    if (threadIdx.x == 0) {
        unsigned* bar = b.bar;
        const unsigned nloc = b.st[0];
        const unsigned old = xb_add(&bar[XB_LSUB(b.x)], 1u);
        const unsigned gen = old / nloc;
        if (old + 1u == (gen + 1u) * nloc) xb_add(&bar[XB_LGEN(b.x)], 1u);
        else XB_SPIN(xb_ld(&bar[XB_LGEN(b.x)]) == gen, bar);
    }
    __syncthreads();
}
__device__ __forceinline__ void xcd_local_barrier_acq(const XcdBarrier& b) {
    asm volatile("s_waitcnt vmcnt(0)" ::: "memory");
    __syncthreads();
    if (threadIdx.x == 0) {
        unsigned* bar = b.bar;
        __builtin_amdgcn_s_waitcnt(0);
        const unsigned nloc = b.st[0];
        const unsigned old = xb_add(&bar[XB_LSUB(b.x)], 1u);
        const unsigned gen = old / nloc;
        if (old + 1u == (gen + 1u) * nloc) xb_add(&bar[XB_LGEN(b.x)], 1u);
        else XB_SPIN(xb_ld(&bar[XB_LGEN(b.x)]) == gen, bar);
        __builtin_amdgcn_fence(__ATOMIC_ACQUIRE, "agent");
        asm volatile("s_waitcnt vmcnt(0)" ::: "memory");
    }
    __syncthreads();
}
__device__ __forceinline__ void xcd_barrier(const XcdBarrier& b) {
    asm volatile("s_waitcnt vmcnt(0)" ::: "memory");
    __syncthreads();
    if (threadIdx.x == 0) {
        unsigned* bar = b.bar;
        __builtin_amdgcn_s_waitcnt(0);
        unsigned nloc = b.st[0], nx = b.st[1];
        if (nloc == 0u) { unsigned eq32; xcd_barrier_complete(bar, b.x, nloc, nx, eq32); b.st[0] = nloc; b.st[1] = nx; b.st[2] = eq32; }
        const unsigned old = xb_add(&bar[XB_XSUB(b.x)], 1u);
        const unsigned gen = old / nloc;
        if (old + 1u == (gen + 1u) * nloc) {
            __builtin_amdgcn_fence(__ATOMIC_RELEASE, "agent");
            asm volatile("s_waitcnt vmcnt(0)" ::: "memory");
            const unsigned og = xb_add(&bar[XB_TOP], 1u);
            const unsigned tg = og / nx;
            if (og + 1u == (tg + 1u) * nx) xb_add(&bar[XB_TOPGEN], 1u);
            else XB_SPIN(xb_ld(&bar[XB_TOPGEN]) == tg, bar);
            __builtin_amdgcn_fence(__ATOMIC_ACQUIRE, "agent");
            xb_add(&bar[XB_XGEN(b.x)], 1u);
            asm volatile("s_waitcnt vmcnt(0)" ::: "memory");
        } else {
            XB_SPIN(xb_ld(&bar[XB_XGEN(b.x)]) == gen, bar);
            __builtin_amdgcn_fence(__ATOMIC_ACQUIRE, "agent");
            asm volatile("s_waitcnt vmcnt(0)" ::: "memory");
        }
    }
    __syncthreads();
}

struct Params {
    const float* in[18];
    float* out;
    unsigned char* ws;
    int ph_lo, ph_hi;
};

__device__ __forceinline__ void p0_transpose_item(const float* W, const float* g, int K, int N, bf16_t* WT, LAS float* scr, int item, int lane) {
    const int nblk = N / 32, kb = item / nblk, nb = item % nblk, k0 = 64 * kb, n0 = 32 * nb;
    float wv[32];
#pragma unroll
    for (int i = 0; i < 32; ++i) { const int kk = 2 * i + (lane >> 5); wv[i] = __builtin_nontemporal_load(W + (size_t)(k0 + kk) * N + n0 + (lane & 31)); }
#pragma unroll
    for (int i = 0; i < 32; ++i) { const int kk = 2 * i + (lane >> 5); const float gv = g ? g[k0 + kk] : 1.f; scr[kk * 33 + (lane & 31)] = wv[i] * gv; }
    LDS_WAIT(); asm volatile("" ::: "memory");
    const int c = lane & 7;
#pragma unroll
    for (int j = 0; j < 4; ++j) { const int n = (lane >> 3) + 8 * j; const LAS float* s = scr + (8 * c) * 33 + n;
        u32x4 o; o.x = pk2(s[0 * 33], s[1 * 33]); o.y = pk2(s[2 * 33], s[3 * 33]); o.z = pk2(s[4 * 33], s[5 * 33]); o.w = pk2(s[6 * 33], s[7 * 33]);
        *(u32x4*)(WT + (size_t)(n0 + n) * K + k0 + 8 * c) = o; }
    LDS_WAIT(); asm volatile("" ::: "memory");
}
__device__ __forceinline__ float row_to_bf16(const float* src, const float* g, bf16_t* dst, int lane) {
    float ss = 0.f;
#pragma unroll
    for (int i = 0; i < 8; ++i) {
        const int c = (i * 64 + lane) * 4;
        f32x4 v = *(const f32x4*)(src + c);
        ss += (v[0] * v[0] + v[1] * v[1]) + (v[2] * v[2] + v[3] * v[3]);
        if (g) { const f32x4 gv = *(const f32x4*)(g + c); v = v * gv; }
        u32x2 w; w.x = pk2(v[0], v[1]); w.y = pk2(v[2], v[3]);
        *(u32x2*)(dst + c) = w;
    }
    return ss;
}
constexpr float PEER_USC = 80.0f, PEER_VSC = 5.0f;
constexpr int PEER_ROWB = 1536;
typedef float f32x16v __attribute__((ext_vector_type(16)));
typedef float f32x32v __attribute__((ext_vector_type(32)));
typedef unsigned u32x6 __attribute__((ext_vector_type(6)));
typedef unsigned u32x2a4 __attribute__((ext_vector_type(2), aligned(4)));
template <bool CONTIG>
__device__ __forceinline__ void fp6_pack_store(const f32x4 (&x)[8], const f32x4 (&sc)[8], unsigned char* dst, int lane) {
    f32x16v a, b;
#pragma unroll
    for (int i = 0; i < 8; ++i) {
        const f32x4 y = x[i] * sc[i];
#pragma unroll
        for (int q = 0; q < 4; ++q) { const float c = fminf(fmaxf(y[q], -7.5f), 7.5f); const int sl = 4 * i + q; if ((sl & 1) == 0) a[sl >> 1] = c; else b[sl >> 1] = c; }
    }
    const u32x6 pk = __builtin_amdgcn_cvt_scalef32_2xpk16_fp6_f32(a, b, 1.0f);
    asm volatile("s_nop 15" : "+v"(a), "+v"(b));
    if (CONTIG) {
        *(u32x2*)(dst + lane * 24) = (u32x2){pk[0], pk[1]}; *(u32x2*)(dst + lane * 24 + 8) = (u32x2){pk[2], pk[3]}; *(u32x2*)(dst + lane * 24 + 16) = (u32x2){pk[4], pk[5]};
    } else {
        __builtin_nontemporal_store((u32x4){pk[0], pk[1], pk[2], pk[3]}, (u32x4*)(dst + lane * 16));
        __builtin_nontemporal_store((u32x2){pk[4], pk[5]}, (u32x2*)(dst + 1024 + lane * 8));
    }
}
__device__ __forceinline__ void fp6_pack_store_s(const f32x4 (&x)[8], float scale, unsigned char* dst, int lane) {
    f32x16v a, b;
#pragma unroll
    for (int i = 0; i < 8; ++i) {
        const f32x4 y = x[i] * scale;
#pragma unroll
        for (int q = 0; q < 4; ++q) { const float c = fminf(fmaxf(y[q], -7.5f), 7.5f); const int sl = 4 * i + q; if ((sl & 1) == 0) a[sl >> 1] = c; else b[sl >> 1] = c; }
    }
    const u32x6 pk = __builtin_amdgcn_cvt_scalef32_2xpk16_fp6_f32(a, b, 1.0f);
    asm volatile("s_nop 15" : "+v"(a), "+v"(b));
    __builtin_nontemporal_store((u32x4){pk[0], pk[1], pk[2], pk[3]}, (u32x4*)(dst + lane * 16));
    __builtin_nontemporal_store((u32x2){pk[4], pk[5]}, (u32x2*)(dst + 1024 + lane * 8));
}
template <bool CONTIG>
__device__ __forceinline__ void rows2_to_fp6(const float* s0, const float* s1, const f32x4 (&sc)[8], unsigned char* d0, unsigned char* d1, int lane) {
    f32x4 x0[8], x1[8];
#pragma unroll
    for (int i = 0; i < 8; ++i) { x0[i] = __builtin_nontemporal_load((const f32x4*)(s0 + (i * 64 + lane) * 4)); x1[i] = __builtin_nontemporal_load((const f32x4*)(s1 + (i * 64 + lane) * 4)); }
    fp6_pack_store<CONTIG>(x0, sc, d0, lane); fp6_pack_store<CONTIG>(x1, sc, d1, lane);
}
__device__ __forceinline__ bf16x8 cvt8(const float* p) {
    const f32x4 a = *(const f32x4*)p, b = *(const f32x4*)(p + 4);
    u32x4 w; w.x = pk2(a[0], a[1]); w.y = pk2(a[2], a[3]); w.z = pk2(b[0], b[1]); w.w = pk2(b[2], b[3]);
    return __builtin_bit_cast(bf16x8, w);
}

__device__ __forceinline__ void prep_late(const Params& p, LAS unsigned char* lds, int gw, int NGW, int wave, int lane) {
    unsigned char* ws = p.ws;
    LAS float* scr = (LAS float*)(lds + wave * 16384);
    {
        constexpr int I_UQ = (512 / 64) * (1536 / 32), I_UKV = (256 / 64) * (2048 / 32), I_OUT = (DM / 64) * (DM / 32);
        constexpr int NIT = I_UQ + I_UKV + I_OUT;
        for (int it = gw; it < NIT; it += NGW) {
            int r = it;
            if (r < I_UQ) { p0_transpose_item(p.in[7], p.in[6], 512, 1536, (bf16_t*)(ws + WS_WUQ), scr, r, lane); continue; } r -= I_UQ;
            if (r < I_UKV) { p0_transpose_item(p.in[9], p.in[8], 256, 2048, (bf16_t*)(ws + WS_WUKV), scr, r, lane); continue; } r -= I_UKV;
            p0_transpose_item(p.in[12], nullptr, DM, DM, (bf16_t*)(ws + WS_WOUT), scr, r, lane);
        }
    }
    {
        const float* wq = p.in[14]; const float* sk = p.in[15]; const float* g2 = p.in[13];
        bf16_t* WsT = (bf16_t*)(ws + WS_WS);
        const int r32 = lane & 31, hh = lane >> 5;
        for (int it = gw; it < 16 * 4 * 64; it += NGW) {
            const int hp = it >> 8, kb = (it >> 6) & 3, nb = it & 63;
            f32x16 acc = {};
            const float* ap = sk + ((size_t)(hp * 128 + kb * 32 + r32)) * 128 + hh * 8;
            const float* bp = wq + ((size_t)(nb * 32 + r32)) * DM + hp * 128 + hh * 8;
#pragma unroll
            for (int s = 0; s < 8; ++s) {
                const bf16x8 a = cvt8(ap + s * 16), b = cvt8(bp + s * 16);
                acc = __builtin_amdgcn_mfma_f32_32x32x16_bf16(a, b, acc, 0, 0, 0);
            }
            const int kcol = nb * 32 + r32; const float gk = g2[kcol];
#pragma unroll
            for (int r = 0; r < 16; ++r) WsT[(size_t)(hp * 128 + kb * 32 + crow(r, hh)) * DM + kcol] = (bf16_t)f2bf(acc[r] * gk);
        }
    }
    {
        float* ct = (float*)(ws + WS_COS); float* st = (float*)(ws + WS_SIN);
        for (int it = gw; it < S * 32 / 64; it += NGW) {
            const int idx = it * 64 + lane, t = idx >> 5, j = idx & 31;
            const float inv_freq = powf(10000.0f, -(float)j / 32.0f);
            const float ang = (float)t * inv_freq;
            float sv, cv; sincosf(ang, &sv, &cv); ct[idx] = cv; st[idx] = sv;
        }
    }
}
__device__ __forceinline__ void phase0(const Params& p, LAS unsigned char* lds, bool late_ok, int gw, int NGW, int wave, int lane) {
    unsigned char* ws = p.ws;
    LAS float* scr = (LAS float*)(lds + wave * 16384);
    const float* x = p.in[0];
    {
        constexpr int I_IN = (DM / 64) * (NIN / 32);
        for (int it = gw; it < I_IN; it += NGW) p0_transpose_item(p.in[2], p.in[1], DM, NIN, (bf16_t*)(ws + WS_WIN), scr, it, lane);
    }
    if (!late_ok) prep_late(p, lds, gw, NGW, wave, lane);
    for (int r = gw; r < NINP - NIN; r += NGW) {
        bf16_t* d = (bf16_t*)(ws + WS_WIN) + (size_t)(NIN + r) * DM;
#pragma unroll
        for (int i = 0; i < 4; ++i) *(u32x4*)(d + (i * 64 + lane) * 8) = (u32x4){0u, 0u, 0u, 0u};
    }
    {
        bf16_t* xb = (bf16_t*)(ws + WS_XB); float* rstd1 = (float*)(ws + WS_RSTD1);
        for (int t = gw; t + NGW < S; t += 2 * NGW) {
            const int t1 = t + NGW;
            f32x4 a[8], b[8];
#pragma unroll
            for (int i = 0; i < 8; ++i) { a[i] = __builtin_nontemporal_load((const f32x4*)(x + (size_t)t * DM + (i * 64 + lane) * 4)); b[i] = __builtin_nontemporal_load((const f32x4*)(x + (size_t)t1 * DM + (i * 64 + lane) * 4)); }
            float sa = 0.f, sb = 0.f;
#pragma unroll
            for (int i = 0; i < 8; ++i) {
                sa += (a[i][0] * a[i][0] + a[i][1] * a[i][1]) + (a[i][2] * a[i][2] + a[i][3] * a[i][3]);
                sb += (b[i][0] * b[i][0] + b[i][1] * b[i][1]) + (b[i][2] * b[i][2] + b[i][3] * b[i][3]);
                u32x2 wa, wb; wa.x = pk2(a[i][0], a[i][1]); wa.y = pk2(a[i][2], a[i][3]); wb.x = pk2(b[i][0], b[i][1]); wb.y = pk2(b[i][2], b[i][3]);
                *(u32x2*)(xb + (size_t)t * DM + (i * 64 + lane) * 4) = wa; *(u32x2*)(xb + (size_t)t1 * DM + (i * 64 + lane) * 4) = wb;
            }
            sa = wave_sum(sa); sb = wave_sum(sb);
            if (lane == 0) { rstd1[t] = rsqrtf(sa * (1.0f / DM) + EPS); rstd1[t1] = rsqrtf(sb * (1.0f / DM) + EPS); }
        }
    }
    if (!late_ok) {
        f32x4 sc[8];
#pragma unroll
        for (int i = 0; i < 8; ++i) sc[i] = *(const f32x4*)(p.in[13] + (i * 64 + lane) * 4) * PEER_USC;
        for (int e = gw; e < 16384; e += NGW) { f32x4 xv[8];
#pragma unroll
            for (int i = 0; i < 8; ++i) xv[i] = __builtin_nontemporal_load((const f32x4*)(p.in[16] + (size_t)e * DM + (i * 64 + lane) * 4));
            fp6_pack_store<false>(xv, sc, ws + WS_UT + (size_t)e * PEER_ROWB, lane); }
        for (int e = gw; e < 16384; e += NGW) { f32x4 xv[8];
#pragma unroll
            for (int i = 0; i < 8; ++i) xv[i] = __builtin_nontemporal_load((const f32x4*)(p.in[17] + (size_t)e * DM + (i * 64 + lane) * 4));
            fp6_pack_store_s(xv, PEER_VSC, ws + WS_VT + (size_t)e * PEER_ROWB, lane); }
    }
}

__device__ __forceinline__ float half_sum(float v) {
    v += dpp_f<0xB1, 0xf>(0.f, v); v += dpp_f<0x4E, 0xf>(0.f, v); v += dpp_f<0x141, 0xf>(0.f, v); v += dpp_f<0x140, 0xf>(0.f, v);
    return v + __shfl_xor(v, 16);
}
__device__ __forceinline__ void phase3(const Params& p, int tfirst, int tstep, int tcnt, int lane) {
    unsigned char* ws = p.ws;
    const bf16_t* qraw = (const bf16_t*)(ws + WS_QRAW); const bf16_t* kvraw = (const bf16_t*)(ws + WS_KVRAW); const bf16_t* proj = (const bf16_t*)(ws + WS_PROJ);
    bf16_t* Qh = (bf16_t*)(ws + WS_QH); bf16_t* Kh = (bf16_t*)(ws + WS_KH);
    const float* ct = (const float*)(ws + WS_COS); const float* st = (const float*)(ws + WS_SIN);
    const int sub = lane & 31, hsel = lane >> 5;
    const bool act = sub < 24, isrope = sub >= 16 && sub < 24, lowhalf = sub < 20;
    const int e0 = act ? 8 * sub : 0;
    f32x4 gq[2], gk[2];
#pragma unroll
    for (int c = 0; c < 2; ++c) { gq[c] = *(const f32x4*)(p.in[10] + e0 + 4 * c); gk[c] = *(const f32x4*)(p.in[11] + e0 + 4 * c); }
    const int j0 = isrope ? ((8 * sub - 128) & 31) : 0;
    constexpr float QS = 0.07216878364870322f * 1.4426950408889634f;
    for (int ti = 0; ti < tcnt; ++ti) {
        const int t = tfirst + ti * tstep;
        f32x4 cs[2] = {{1.f, 1.f, 1.f, 1.f}, {1.f, 1.f, 1.f, 1.f}}, sn[2] = {{0.f, 0.f, 0.f, 0.f}, {0.f, 0.f, 0.f, 0.f}};
        u32x4 krw = {0u, 0u, 0u, 0u};
        if (isrope) {
#pragma unroll
            for (int c = 0; c < 2; ++c) { cs[c] = *(const f32x4*)(ct + t * 32 + j0 + 4 * c); sn[c] = *(const f32x4*)(st + t * 32 + j0 + 4 * c); }
            krw = *(const u32x4*)(proj + (size_t)t * NINP + 2816 + (8 * sub - 128));
        }
#pragma unroll
        for (int hp = 0; hp < 4; ++hp) {
            const int h = 2 * hp + hsel;
            u32x4 qw = {0u, 0u, 0u, 0u}, kw = {0u, 0u, 0u, 0u};
            if (act) qw = *(const u32x4*)(qraw + (size_t)t * 1536 + h * 192 + e0);
            if (sub < 16) kw = *(const u32x4*)(kvraw + (size_t)t * 2048 + h * 256 + e0);
            if (isrope) kw = krw;
#pragma unroll
            for (int which = 0; which < 2; ++which) {
                const u32x4 w = which ? kw : qw;
                f32x4 x[2] = {{bflo(w[0]), bfhi(w[0]), bflo(w[1]), bfhi(w[1])}, {bflo(w[2]), bfhi(w[2]), bflo(w[3]), bfhi(w[3])}};
                float ss = 0.f;
#pragma unroll
                for (int c = 0; c < 2; ++c) ss += (x[c][0] * x[c][0] + x[c][1] * x[c][1]) + (x[c][2] * x[c][2] + x[c][3] * x[c][3]);
                ss = half_sum(ss);
                const float rs = rsqrtf(ss * (1.0f / 192.0f) + EPS);
#pragma unroll
                for (int c = 0; c < 2; ++c) {
                    x[c] = x[c] * (which ? gk[c] : gq[c]) * rs;
                    f32x4 pr;
#pragma unroll
                    for (int q = 0; q < 4; ++q) pr[q] = __shfl_xor(x[c][q], 4);
                    const f32x4 r1 = x[c] * cs[c] - pr * sn[c], r2 = pr * sn[c] + x[c] * cs[c];
                    if (isrope) x[c] = lowhalf ? r1 : r2;
                    if (!which) x[c] = x[c] * QS;
                }
                if (act) {
                    u32x4 o; o.x = pk2(x[0][0], x[0][1]); o.y = pk2(x[0][2], x[0][3]); o.z = pk2(x[1][0], x[1][1]); o.w = pk2(x[1][2], x[1][3]);
                    *(u32x4*)((which ? Kh : Qh) + ((size_t)h * S + t) * 192 + e0) = o;
                }
            }
        }
    }
}

constexpr int KP = 400, VP = 320;
template <int OFF> __device__ __forceinline__ s16x4 tr_read(unsigned addr) {
    s16x4 r; asm volatile("ds_read_b64_tr_b16 %0, %1 offset:%2" : "=&v"(r) : "v"(addr), "i"(OFF) : "memory"); return r;
}
__device__ __forceinline__ unsigned cvtpk(float lo, float hi) { unsigned r; asm volatile("v_cvt_pk_bf16_f32 %0, %1, %2" : "=v"(r) : "v"(lo), "v"(hi)); return r; }
#define PK8(L, H) ((bf16x8){L[0], L[1], L[2], L[3], H[0], H[1], H[2], H[3]})
constexpr float ATT_THR = 8.0f;

constexpr int ATT_KB = 64 * KP, ATT_VB = 64 * VP;
constexpr int ATT_VOFF = 2 * ATT_KB;
__device__ __forceinline__ float xhalf_max(float v) {
    auto rr = __builtin_amdgcn_permlane32_swap(__builtin_bit_cast(unsigned, v), __builtin_bit_cast(unsigned, v), false, false);
    return fmaxf(__builtin_bit_cast(float, rr[0]), __builtin_bit_cast(float, rr[1]));
}
__device__ __forceinline__ float xhalf_sum(float v) {
    auto rr = __builtin_amdgcn_permlane32_swap(__builtin_bit_cast(unsigned, v), __builtin_bit_cast(unsigned, v), false, false);
    return __builtin_bit_cast(float, rr[0]) + __builtin_bit_cast(float, rr[1]);
}
template <int OFF> __device__ __forceinline__ bf16x8 lds_read128(unsigned addr) {
    bf16x8 r; asm volatile("ds_read_b128 %0, %1 offset:%2" : "=&v"(r) : "v"(addr), "i"(OFF) : "memory"); return r;
}
#define LGKM_WAIT(n) do { asm volatile("s_waitcnt lgkmcnt(" #n ")" ::: "memory"); SBAR(); } while (0)
__device__ __forceinline__ f32x16 att_qk(unsigned kaddr, const bf16x8 (&qr)[12]) {
    f32x16 p = {};
    bf16x8 a0 = lds_read128<0>(kaddr), a1 = lds_read128<32>(kaddr), a2 = lds_read128<64>(kaddr), a3 = lds_read128<96>(kaddr);
    LGKM_WAIT(3); p = __builtin_amdgcn_mfma_f32_32x32x16_bf16(a0, qr[0], p, 0, 0, 0); a0 = lds_read128<128>(kaddr);
    LGKM_WAIT(3); p = __builtin_amdgcn_mfma_f32_32x32x16_bf16(a1, qr[1], p, 0, 0, 0); a1 = lds_read128<160>(kaddr);
    LGKM_WAIT(3); p = __builtin_amdgcn_mfma_f32_32x32x16_bf16(a2, qr[2], p, 0, 0, 0); a2 = lds_read128<192>(kaddr);
    LGKM_WAIT(3); p = __builtin_amdgcn_mfma_f32_32x32x16_bf16(a3, qr[3], p, 0, 0, 0); a3 = lds_read128<224>(kaddr);
    LGKM_WAIT(3); p = __builtin_amdgcn_mfma_f32_32x32x16_bf16(a0, qr[4], p, 0, 0, 0); a0 = lds_read128<256>(kaddr);
    LGKM_WAIT(3); p = __builtin_amdgcn_mfma_f32_32x32x16_bf16(a1, qr[5], p, 0, 0, 0); a1 = lds_read128<288>(kaddr);
    LGKM_WAIT(3); p = __builtin_amdgcn_mfma_f32_32x32x16_bf16(a2, qr[6], p, 0, 0, 0); a2 = lds_read128<320>(kaddr);
    LGKM_WAIT(3); p = __builtin_amdgcn_mfma_f32_32x32x16_bf16(a3, qr[7], p, 0, 0, 0); a3 = lds_read128<352>(kaddr);
    LGKM_WAIT(3); p = __builtin_amdgcn_mfma_f32_32x32x16_bf16(a0, qr[8], p, 0, 0, 0);
    LGKM_WAIT(2); p = __builtin_amdgcn_mfma_f32_32x32x16_bf16(a1, qr[9], p, 0, 0, 0);
    LGKM_WAIT(1); p = __builtin_amdgcn_mfma_f32_32x32x16_bf16(a2, qr[10], p, 0, 0, 0);
    LGKM_WAIT(0); p = __builtin_amdgcn_mfma_f32_32x32x16_bf16(a3, qr[11], p, 0, 0, 0);
    return p;
}
__device__ __forceinline__ void att_finish(f32x16& s, float m, float& lsum, bf16x8& pb0, bf16x8& pb1) {
    float ps = 0.f;
#pragma unroll
    for (int r = 0; r < 16; ++r) { s[r] = __builtin_amdgcn_exp2f(s[r] - m); ps += s[r]; }
    lsum += xhalf_sum(ps);
    u32x4 w0 = {cvtpk(s[0], s[1]), cvtpk(s[2], s[3]), cvtpk(s[4], s[5]), cvtpk(s[6], s[7])};
    u32x4 w1 = {cvtpk(s[8], s[9]), cvtpk(s[10], s[11]), cvtpk(s[12], s[13]), cvtpk(s[14], s[15])};
    pb0 = __builtin_bit_cast(bf16x8, w0); pb1 = __builtin_bit_cast(bf16x8, w1);
}
__device__ __forceinline__ void att_pv(unsigned vaddr, bf16x8 pb0, bf16x8 pb1, f32x16 (&o)[4]) {
#define VOFF(d0, s, hi) (((16 * (s) + 8 * (hi)) * VP) + 64 * (d0))
    const s16x4 a00l = tr_read<VOFF(0, 0, 0)>(vaddr), a00h = tr_read<VOFF(0, 0, 1)>(vaddr), a01l = tr_read<VOFF(0, 1, 0)>(vaddr), a01h = tr_read<VOFF(0, 1, 1)>(vaddr);
    const s16x4 a10l = tr_read<VOFF(1, 0, 0)>(vaddr), a10h = tr_read<VOFF(1, 0, 1)>(vaddr), a11l = tr_read<VOFF(1, 1, 0)>(vaddr), a11h = tr_read<VOFF(1, 1, 1)>(vaddr);
    LGKM_WAIT(4);
    o[0] = __builtin_amdgcn_mfma_f32_32x32x16_bf16(PK8(a00l, a00h), pb0, o[0], 0, 0, 0); o[0] = __builtin_amdgcn_mfma_f32_32x32x16_bf16(PK8(a01l, a01h), pb1, o[0], 0, 0, 0);
    const s16x4 a20l = tr_read<VOFF(2, 0, 0)>(vaddr), a20h = tr_read<VOFF(2, 0, 1)>(vaddr), a21l = tr_read<VOFF(2, 1, 0)>(vaddr), a21h = tr_read<VOFF(2, 1, 1)>(vaddr);
    LGKM_WAIT(4);
    o[1] = __builtin_amdgcn_mfma_f32_32x32x16_bf16(PK8(a10l, a10h), pb0, o[1], 0, 0, 0); o[1] = __builtin_amdgcn_mfma_f32_32x32x16_bf16(PK8(a11l, a11h), pb1, o[1], 0, 0, 0);
    const s16x4 a30l = tr_read<VOFF(3, 0, 0)>(vaddr), a30h = tr_read<VOFF(3, 0, 1)>(vaddr), a31l = tr_read<VOFF(3, 1, 0)>(vaddr), a31h = tr_read<VOFF(3, 1, 1)>(vaddr);
    LGKM_WAIT(4);
    o[2] = __builtin_amdgcn_mfma_f32_32x32x16_bf16(PK8(a20l, a20h), pb0, o[2], 0, 0, 0); o[2] = __builtin_amdgcn_mfma_f32_32x32x16_bf16(PK8(a21l, a21h), pb1, o[2], 0, 0, 0);
    LGKM_WAIT(0);
    o[3] = __builtin_amdgcn_mfma_f32_32x32x16_bf16(PK8(a30l, a30h), pb0, o[3], 0, 0, 0); o[3] = __builtin_amdgcn_mfma_f32_32x32x16_bf16(PK8(a31l, a31h), pb1, o[3], 0, 0, 0);
#undef VOFF
}
__device__ __forceinline__ void att_partial(const f32x16& s, float& m, float& lsum, f32x16 (&o)[4]) {
    float pmax = s[0];
#pragma unroll
    for (int r = 1; r < 16; ++r) pmax = fmaxf(pmax, s[r]);
    pmax = xhalf_max(pmax);
    if (!__all(pmax - m <= ATT_THR)) {
        const float mn = fmaxf(m, pmax); const float alpha = __builtin_amdgcn_exp2f(m - mn); m = mn; lsum *= alpha;
#pragma unroll
        for (int d = 0; d < 4; ++d)
#pragma unroll
            for (int r = 0; r < 16; ++r) o[d][r] *= alpha;
    }
}

__device__ __forceinline__ void attn_unit(const Params& p, LAS unsigned char* lds, int head, int qb, int tid, int wave, int lane) {
    unsigned char* ws = p.ws;
    const bf16_t* Qh = (const bf16_t*)(ws + WS_QH); const bf16_t* Kh = (const bf16_t*)(ws + WS_KH);
    bf16_t* mix = (bf16_t*)(ws + WS_MIX);
    const int rg = wave & 3, kh = wave >> 2, r32 = lane & 31, hh = lane >> 5;
    const int q0row = qb * 128 + rg * 32;
    bf16x8 qr[12];
    {
        const bf16_t* qp = Qh + ((size_t)head * S + q0row + r32) * 192 + hh * 8;
#pragma unroll
        for (int ks = 0; ks < 12; ++ks) qr[ks] = *(const bf16x8*)(qp + ks * 16);
    }
    const int ntiles = 2 * qb + 2, mylast = 2 * qb + (rg >> 1);
    float m = -1e30f, lsum = 0.f; f32x16 o[4] = {};
    const int srow = tid >> 3, sch = tid & 7;
    const int kg0 = srow * 192 + sch * 8, kl0 = srow * KP + sch * 16, vg0 = srow * 2048 + sch * 8, vl0 = ATT_VOFF + srow * VP + sch * 16;
    const bf16_t* kbase = Kh + (size_t)head * S * 192; const bf16_t* vbase = (const bf16_t*)(ws + WS_KVRAW) + head * 256 + 128;
    u32x4 sk0, sk1, sk2, sv0, sv1;
#define ATT_LOAD(t) do { const bf16_t* kt = kbase + (size_t)(t) * 64 * 192 + kg0; const bf16_t* vt = vbase + (size_t)(t) * 64 * 2048 + vg0; \
        sk0 = *(const u32x4*)(kt); sk1 = *(const u32x4*)(kt + 64); sk2 = *(const u32x4*)(kt + 128); sv0 = *(const u32x4*)(vt); sv1 = *(const u32x4*)(vt + 64); } while (0)
#define ATT_WRITE(kb_, vb_) do { LAS unsigned char* bk = lds + (kb_) * ATT_KB + kl0; LAS unsigned char* bv = lds + (vb_) * ATT_VB + vl0; *(LAS u32x4*)(bk) = sk0; *(LAS u32x4*)(bk + 128) = sk1; *(LAS u32x4*)(bk + 256) = sk2; \
        *(LAS u32x4*)(bv) = sv0; *(LAS u32x4*)(bv + 128) = sv1; } while (0)
    const unsigned ldsbase = (unsigned)(size_t)lds;
    const unsigned kaddr0 = ldsbase + (unsigned)((32 * kh + r32) * KP + hh * 16);
    const unsigned vrel = (unsigned)(ATT_VOFF + (32 * kh + 4 * hh + ((lane & 15) >> 2)) * VP + (16 * ((lane >> 4) & 1) + 4 * (lane & 3)) * 2);
    ATT_LOAD(0); ATT_WRITE(0, 0); __syncthreads();
    bf16x8 pb0, pb1;
    const bool more0 = (1 < ntiles);
    if (more0) ATT_LOAD(1);
    f32x16 sprev = att_qk(kaddr0, qr);
    att_partial(sprev, m, lsum, o);
    if (more0) ATT_WRITE(1, 1);
    __syncthreads();
    int vprev = 0, vcur = 1;
#pragma unroll 1
    for (int t = 1; t <= ntiles; ++t) {
        const bool more = (t + 1 < ntiles);
        if (more) ATT_LOAD(t + 1);
        f32x16 sc;
        if (t <= mylast) sc = att_qk(kaddr0 + (t & 1) * ATT_KB, qr);
        else {
#pragma unroll
            for (int r = 0; r < 16; ++r) sc[r] = -1e30f;
        }
        att_finish(sprev, m, lsum, pb0, pb1);
        att_pv(ldsbase + vprev * ATT_VB + vrel, pb0, pb1, o);
        att_partial(sc, m, lsum, o);
        sprev = sc;
        const int vnext = (vcur == 2) ? 0 : vcur + 1;
        if (more) ATT_WRITE((t + 1) & 1, vnext);
        vprev = vcur; vcur = vnext;
        __syncthreads();
    }
#undef ATT_LOAD
#undef ATT_WRITE
    LAS float* scr = (LAS float*)lds + (size_t)rg * 66 * 64 + lane;
    if (kh == 1) {
        scr[0] = m; scr[64] = lsum;
#pragma unroll
        for (int d = 0; d < 4; ++d)
#pragma unroll
            for (int r = 0; r < 16; ++r) scr[(2 + d * 16 + r) * 64] = o[d][r];
    }
    __syncthreads();
    if (kh == 0) {
        const float m2 = scr[0], l2 = scr[64];
        const float mn = fmaxf(m, m2), a1 = __builtin_amdgcn_exp2f(m - mn), a2 = __builtin_amdgcn_exp2f(m2 - mn);
        const float inv = 1.0f / (lsum * a1 + l2 * a2);
        bf16_t* op = mix + (size_t)(q0row + r32) * DM + 1024 + head * 128 + 4 * hh;
#pragma unroll
        for (int d = 0; d < 4; ++d)
#pragma unroll
            for (int g4 = 0; g4 < 4; ++g4) {
                float v[4];
#pragma unroll
                for (int i = 0; i < 4; ++i) { const int r = 4 * g4 + i; v[i] = (o[d][r] * a1 + scr[(2 + d * 16 + r) * 64] * a2) * inv; }
                u32x2 w; w.x = pk2(v[0], v[1]); w.y = pk2(v[2], v[3]);
                *(u32x2*)(op + 32 * d + 8 * g4) = w;
            }
    }
    __syncthreads();
}

__device__ __forceinline__ void gmlp_unit(const Params& p, LAS unsigned char* lds, int nb, int h, int tid, int wave, int lane) {
    unsigned char* ws = p.ws;
    const bf16_t* proj = (const bf16_t*)(ws + WS_PROJ); bf16_t* mix = (bf16_t*)(ws + WS_MIX);
    const float* ssv = (const float*)(ws + WS_ROWSS);
    const float* vg = p.in[3]; const float* wsp = p.in[4]; const float* bs = p.in[5];
#pragma unroll
    for (int i = 0; i < 4; ++i) {
        const int pc = tid + 512 * i, r = pc >> 4, c = pc & 15, t = nb * 128 + r;
        const u32x4 w = *(const u32x4*)(proj + (size_t)t * NINP + 1024 + h * 128 + c * 8);
        const float rs = rsqrtf(ssv[t] * (1.0f / 1024.0f) + EPS);
        const f32x4 g0 = *(const f32x4*)(vg + h * 128 + c * 8), g1 = *(const f32x4*)(vg + h * 128 + c * 8 + 4);
        u32x4 ov;
        ov.x = pk2(bflo(w.x) * rs * g0[0], bfhi(w.x) * rs * g0[1]); ov.y = pk2(bflo(w.y) * rs * g0[2], bfhi(w.y) * rs * g0[3]);
        ov.z = pk2(bflo(w.z) * rs * g1[0], bfhi(w.z) * rs * g1[1]); ov.w = pk2(bflo(w.w) * rs * g1[2], bfhi(w.w) * rs * g1[3]);
        *(LAS u32x4*)(lds + r * VP + c * 16) = ov;
    }
    __syncthreads();
    const int ib = wave & 3, ch = wave >> 2, r32 = lane & 31, hh = lane >> 5;
    const int irow = 32 * ib + r32;
    f32x16 acc0 = {}, acc1 = {};
    const unsigned vaddr = (unsigned)(size_t)lds + (unsigned)((8 * hh + ((lane & 15) >> 2)) * VP + (64 * ch + 16 * ((lane >> 4) & 1) + 4 * (lane & 3)) * 2);
    const float* wrow = wsp + ((size_t)h * 128 + irow) * 128 + hh * 8;
#define GSTEP(s) do { if ((s) < 2 * (ib + 1)) { \
        const f32x4 wa = *(const f32x4*)(wrow + (s) * 16), wb = *(const f32x4*)(wrow + (s) * 16 + 4); const int j0 = (s) * 16 + hh * 8; \
        u32x4 aw; aw.x = pk2(j0 + 0 <= irow ? wa[0] : 0.f, j0 + 1 <= irow ? wa[1] : 0.f); aw.y = pk2(j0 + 2 <= irow ? wa[2] : 0.f, j0 + 3 <= irow ? wa[3] : 0.f); \
        aw.z = pk2(j0 + 4 <= irow ? wb[0] : 0.f, j0 + 5 <= irow ? wb[1] : 0.f); aw.w = pk2(j0 + 6 <= irow ? wb[2] : 0.f, j0 + 7 <= irow ? wb[3] : 0.f); \
        const bf16x8 af = __builtin_bit_cast(bf16x8, aw); \
        const s16x4 b0l = tr_read<(16 * (s)) * VP>(vaddr), b0h = tr_read<(16 * (s) + 4) * VP>(vaddr), b1l = tr_read<(16 * (s)) * VP + 64>(vaddr), b1h = tr_read<(16 * (s) + 4) * VP + 64>(vaddr); \
        LDS_WAIT(); SBAR(); \
        acc0 = __builtin_amdgcn_mfma_f32_32x32x16_bf16(af, PK8(b0l, b0h), acc0, 0, 0, 0); acc1 = __builtin_amdgcn_mfma_f32_32x32x16_bf16(af, PK8(b1l, b1h), acc1, 0, 0, 0); } } while (0)
    GSTEP(0); GSTEP(1); GSTEP(2); GSTEP(3); GSTEP(4); GSTEP(5); GSTEP(6); GSTEP(7);
#undef GSTEP
#pragma unroll
    for (int r = 0; r < 16; ++r) {
        const int i = 32 * ib + crow(r, hh), t = nb * 128 + i; const float b = bs[h * 128 + i];
        const int c0 = h * 128 + 64 * ch + r32;
        const float u0 = bf2f(proj[(size_t)t * NINP + c0]), u1 = bf2f(proj[(size_t)t * NINP + c0 + 32]);
        mix[(size_t)t * DM + c0] = (bf16_t)f2bf(u0 * (acc0[r] + b)); mix[(size_t)t * DM + c0 + 32] = (bf16_t)f2bf(u1 * (acc1[r] + b));
    }
    __syncthreads();
}

__device__ __forceinline__ void phase7(const Params& p, LAS unsigned char* lds, int gw, int NGW, int wave, int lane, bool conv_u) {
    unsigned char* ws = p.ws;
    const float* sc = (const float*)(ws + WS_SC); int* ex = (int*)(ws + WS_EXP); float* gt = (float*)(ws + WS_GATE);
    const float NEG = -3.0e38f;
    LAS float* sl = (LAS float*)(lds + wave * 1024);
    const int j8 = lane & 7, g8 = lane >> 3, row = lane >> 4, i16 = lane & 15;
    int ci[4], cj[4]; bool cval[4];
    {
        constexpr int starts[16] = {0, 16, 24, 29, 33, 36, 38, 40, 42, 43, 44, 45, 46, 47, 48, 49};
#pragma unroll
        for (int m = 0; m < 4; ++m) {
            const int c = i16 + 16 * m; int a = 0, st = 0;
#pragma unroll
            for (int i = 1; i < 16; ++i) if (c >= starts[i]) { a = i; st = starts[i]; }
            cval[m] = c < 50; ci[m] = cval[m] ? a : 0; cj[m] = cval[m] ? (c - st) : 0;
        }
    }
    f32x4 nx0, nx1, nx2, nx3;
    if (gw < S / 4) { const float* b = sc + (size_t)(gw * 4) * DM + lane * 16; nx0 = *(const f32x4*)b; nx1 = *(const f32x4*)(b + 4); nx2 = *(const f32x4*)(b + 8); nx3 = *(const f32x4*)(b + 12); }
    f32x4 ux0[8], ux1[8];
    for (int tb = gw; tb < S / 4; tb += NGW)
#pragma unroll 1
    for (int n8 = 0; n8 < 8; ++n8) {
        const int it = tb * 8 + n8;
        const int t = it >> 1, hh = it & 1;
        if (conv_u && !(n8 & 1)) {
            const float* s0 = p.in[16] + (size_t)it * DM; const float* s1 = s0 + DM;
#pragma unroll
            for (int i = 0; i < 8; ++i) { ux0[i] = __builtin_nontemporal_load((const f32x4*)(s0 + (i * 64 + lane) * 4)); ux1[i] = __builtin_nontemporal_load((const f32x4*)(s1 + (i * 64 + lane) * 4)); }
            __builtin_amdgcn_sched_barrier(0);
        }
        float v[16];
#pragma unroll
        for (int q = 0; q < 4; ++q) { v[q] = nx0[q]; v[4 + q] = nx1[q]; v[8 + q] = nx2[q]; v[12 + q] = nx3[q]; }
        { const int it2 = n8 < 7 ? it + 1 : (tb + NGW) * 8;
          if (it2 < S * 2) { const float* b = sc + (size_t)(it2 >> 1) * DM + (it2 & 1) * 1024 + lane * 16;
            nx0 = *(const f32x4*)b; nx1 = *(const f32x4*)(b + 4); nx2 = *(const f32x4*)(b + 8); nx3 = *(const f32x4*)(b + 12); } }
#pragma unroll
        for (int m = 0; m < 16; ++m) v[m] = __builtin_bit_cast(float, (__builtin_bit_cast(unsigned, v[m]) & ~127u) | (unsigned)(16 * j8 + m));
#define P7_CE(A, B) do { const float hi_ = fmaxf(v[A], v[B]), lo_ = fminf(v[A], v[B]); v[A] = hi_; v[B] = lo_; } while (0)
        P7_CE(0, 13); P7_CE(1, 12); P7_CE(2, 15); P7_CE(3, 14); P7_CE(4, 8); P7_CE(5, 6); P7_CE(7, 11); P7_CE(9, 10);
        P7_CE(0, 5); P7_CE(1, 7); P7_CE(2, 9); P7_CE(3, 4); P7_CE(6, 13); P7_CE(8, 14); P7_CE(10, 15); P7_CE(11, 12);
        P7_CE(0, 1); P7_CE(2, 3); P7_CE(4, 5); P7_CE(6, 8); P7_CE(7, 9); P7_CE(10, 11); P7_CE(12, 13); P7_CE(14, 15);
        P7_CE(0, 2); P7_CE(1, 3); P7_CE(4, 10); P7_CE(5, 11); P7_CE(6, 7); P7_CE(8, 9); P7_CE(12, 14); P7_CE(13, 15);
        P7_CE(1, 2); P7_CE(3, 12); P7_CE(4, 6); P7_CE(5, 7); P7_CE(8, 10); P7_CE(9, 11); P7_CE(13, 14);
        P7_CE(1, 4); P7_CE(2, 6); P7_CE(5, 8); P7_CE(7, 10); P7_CE(9, 13); P7_CE(11, 14);
        P7_CE(2, 4); P7_CE(3, 6); P7_CE(9, 12); P7_CE(11, 13);
        P7_CE(3, 5); P7_CE(6, 8); P7_CE(7, 9); P7_CE(10, 12);
        P7_CE(3, 4); P7_CE(5, 6); P7_CE(7, 8); P7_CE(9, 10); P7_CE(11, 12);
        P7_CE(6, 7); P7_CE(8, 9);
#define P7_MERGE(CTRL) do { float t_[16]; \
            _Pragma("unroll") for (int i = 0; i < 16; ++i) t_[i] = fmaxf(v[i], dpp_f<CTRL, 0xf>(v[15 - i], v[15 - i])); \
            _Pragma("unroll") for (int i = 0; i < 16; ++i) v[i] = t_[i]; \
            _Pragma("unroll") for (int j = 8; j >= 1; j >>= 1) _Pragma("unroll") for (int i = 0; i < 16; ++i) if ((i & j) == 0) P7_CE(i, i + j); } while (0)
        P7_MERGE(0xB1); P7_MERGE(0x4E); P7_MERGE(0x141);
#undef P7_MERGE
#undef P7_CE
        if (j8 == 0) {
#pragma unroll
            for (int q = 0; q < 4; ++q) *(LAS f32x4*)(sl + g8 * 16 + 4 * q) = (f32x4){v[4 * q], v[4 * q + 1], v[4 * q + 2], v[4 * q + 3]};
        }
        LDS_WAIT(); asm volatile("" ::: "memory");
        float cv[4], og[4]; int id[4];
#pragma unroll
        for (int m = 0; m < 4; ++m) {
            const float s1 = sl[(2 * row) * 16 + ci[m]], s2 = sl[(2 * row + 1) * 16 + cj[m]];
            og[m] = cval[m] ? (s1 + s2) : NEG; cv[m] = og[m];
            id[m] = (int)((__builtin_bit_cast(unsigned, s1) & 127u) * 128u + (__builtin_bit_cast(unsigned, s2) & 127u));
        }
        LDS_WAIT(); asm volatile("" ::: "memory");
        float M0 = 0.f;
#pragma unroll
        for (int k = 0; k < 16; ++k) {
            float mx = fmaxf(fmaxf(cv[0], cv[1]), fmaxf(cv[2], cv[3]));
            mx = fmaxf(mx, dpp_f<0xB1, 0xf>(mx, mx));
            mx = fmaxf(mx, dpp_f<0x4E, 0xf>(mx, mx));
            mx = fmaxf(mx, dpp_f<0x141, 0xf>(mx, mx));
            mx = fmaxf(mx, dpp_f<0x140, 0xf>(mx, mx));
            if (k == 0) M0 = mx;
#pragma unroll
            for (int m = 0; m < 4; ++m) cv[m] = (cv[m] == mx) ? NEG : cv[m];
        }
        bool sel[4]; float e[4]; float es = 0.f;
#pragma unroll
        for (int m = 0; m < 4; ++m) { sel[m] = (cv[m] != og[m]); e[m] = sel[m] ? __expf(og[m] - M0) : 0.f; es += e[m]; }
        es += dpp_f<0xB1, 0xf>(0.f, es); es += dpp_f<0x4E, 0xf>(0.f, es); es += dpp_f<0x141, 0xf>(0.f, es); es += dpp_f<0x140, 0xf>(0.f, es);
        const float inv = 1.0f / es;
        int basepos = 0;
        const int head = 4 * hh + row;
#pragma unroll
        for (int m = 0; m < 4; ++m) {
            const unsigned long long bl = __ballot(sel[m]);
            const unsigned rbits = (unsigned)(bl >> (16 * row)) & 0xffffu;
            const int pos = basepos + __popc(rbits & ((1u << i16) - 1u));
            if (sel[m] && pos < 16) { ex[(size_t)t * 128 + head * 16 + pos] = id[m]; gt[(size_t)t * 128 + head * 16 + pos] = e[m] * inv; }
            basepos += __popc(rbits);
        }
        if (conv_u && (n8 & 1)) {
            f32x4 usc[8];
#pragma unroll
            for (int i = 0; i < 8; ++i) usc[i] = *(const f32x4*)(p.in[13] + (i * 64 + lane) * 4) * PEER_USC;
            unsigned char* d0 = ws + WS_UT + (size_t)(it - 1) * PEER_ROWB;
            fp6_pack_store<false>(ux0, usc, d0, lane); fp6_pack_store<false>(ux1, usc, d0 + PEER_ROWB, lane);
        }
    }
}

typedef __bf16 bf16x32v __attribute__((ext_vector_type(32)));
typedef __bf16 bf16x2v __attribute__((ext_vector_type(2)));
typedef float f32x2 __attribute__((ext_vector_type(2)));
#ifndef P8_THROTTLE
#define P8_THROTTLE 0
#endif
constexpr unsigned P8_SLACK = 12;
#ifndef P8_SWEEPSYNC
#define P8_SWEEPSYNC 1
#endif
#ifndef P8_MIDSYNC
#define P8_MIDSYNC 2
#endif
__device__ __forceinline__ void phase8(const Params& p, LAS unsigned char* lds, float* dst, const XcdBarrier& xb, int gw, int NGW, int wave, int lane) {
    unsigned char* ws = p.ws;
    const bf16_t* x1b = (const bf16_t*)(ws + WS_X1B); const unsigned char* UT = ws + WS_UT; const unsigned char* VT = ws + WS_VT;
    const int* ex = (const int*)(ws + WS_EXP); const float* gt = (const float*)(ws + WS_GATE); const float* ss2 = (const float*)(ws + WS_ROWSS) + 3 * S;
    const float* out = p.out;
    LAS unsigned* list = (LAS unsigned*)(lds + 131072 + wave * 2048);
    LAS unsigned* hist = (LAS unsigned*)(lds + 147456 + wave * 1024);
    for (int tb = gw; tb < S / 4; tb += NGW) {
        const int t0 = tb * 4;
        int id[8]; float gv[8];
#pragma unroll
        for (int r = 0; r < 8; ++r) { const size_t o = (size_t)(t0 + (r >> 1)) * 128 + (r & 1) * 64 + lane; id[r] = ex[o]; gv[r] = gt[o]; }
        const float rs0 = rsqrtf(ss2[t0 + 0] * (1.0f / DM) + EPS) * (1.0f / PEER_USC), rs1 = rsqrtf(ss2[t0 + 1] * (1.0f / DM) + EPS) * (1.0f / PEER_USC);
        const float rs2 = rsqrtf(ss2[t0 + 2] * (1.0f / DM) + EPS) * (1.0f / PEER_USC), rs3 = rsqrtf(ss2[t0 + 3] * (1.0f / DM) + EPS) * (1.0f / PEER_USC);
#pragma unroll
        for (int j = 0; j < 4; ++j) hist[j * 64 + lane] = 0u;
        LDS_WAIT(); asm volatile("" ::: "memory");
        unsigned pos[8];
#pragma unroll
        for (int r = 0; r < 8; ++r) pos[r] = __hip_atomic_fetch_add(hist + (r >> 1) * 64 + (id[r] >> 8), 1u, __ATOMIC_RELAXED, __HIP_MEMORY_SCOPE_WORKGROUP);
        LDS_WAIT(); asm volatile("" ::: "memory");
        unsigned cnt[4], inc[4];
#pragma unroll
        for (int j = 0; j < 4; ++j) { cnt[j] = hist[j * 64 + lane]; inc[j] = cnt[j]; }
#pragma unroll
        for (int o = 1; o < 64; o <<= 1)
#pragma unroll
            for (int j = 0; j < 4; ++j) { const unsigned n = __shfl_up(inc[j], o); if (lane >= o) inc[j] += n; }
        LDS_WAIT(); asm volatile("" ::: "memory");
#pragma unroll
        for (int j = 0; j < 4; ++j) hist[j * 64 + lane] = inc[j] - cnt[j];
        LDS_WAIT(); asm volatile("" ::: "memory");
#pragma unroll
        for (int r = 0; r < 8; ++r) { const unsigned d = hist[(r >> 1) * 64 + (id[r] >> 8)] + pos[r]; list[4u * d + (unsigned)(r >> 1)] = (unsigned)id[r] | ((unsigned)(r >> 1) << 14) | (f2bf(gv[r]) << 16); }
        LDS_WAIT(); asm volatile("" ::: "memory");
        {
            typedef unsigned u32x16 __attribute__((ext_vector_type(16)));
            const __amdgpu_buffer_rsrc_t urs = __builtin_amdgcn_make_buffer_rsrc((void*)UT, 0, 16384 * PEER_ROWB, 0x00020000);
            const int vo4 = lane * 16, vo2 = lane * 8 + 1024;
            const bool lb0 = (lane & 1) != 0, lb1 = (lane & 2) != 0, lb2 = (lane & 4) != 0;
            s16x4 xr[4][8];
#pragma unroll
            for (int j = 0; j < 4; ++j)
#pragma unroll
                for (int q = 0; q < 8; ++q) xr[j][q] = __builtin_bit_cast(s16x4, *(const u32x2*)(x1b + (size_t)(t0 + j) * DM + (q * 64 + lane) * 4));
#define P8_ULOAD(k, i) do { const unsigned en = (unsigned)__builtin_amdgcn_readfirstlane((int)list[(i)]); const int ro = (int)((en & 0x3fffu) * (unsigned)PEER_ROWB); \
            u4[k] = __builtin_amdgcn_raw_buffer_load_b128(urs, vo4, ro, 0); u2[k] = __builtin_amdgcn_raw_buffer_load_b64(urs, vo2, ro, 0); } while (0)
#define P8_UPROC2(k, dk) do { const u32x6 pk = {u4[k][0], u4[k][1], u4[k][2], u4[k][3], u2[k][0], u2[k][1]}; \
            const u32x16 r_ = __builtin_bit_cast(u32x16, __builtin_amdgcn_cvt_scalef32_pk32_bf16_fp6(pk, 1.0f)); \
            f32x4 a0 = {0.f, 0.f, 0.f, 0.f}, a1 = {0.f, 0.f, 0.f, 0.f}; \
            _Pragma("unroll") for (int q = 0; q < 8; q += 2) { \
                a0 = __builtin_amdgcn_mfma_f32_4x4x4bf16_1k(__builtin_bit_cast(s16x4, (u32x2){r_[2 * q], r_[2 * q + 1]}), xr[(k) & 3][q], a0, 0, 0, 0); \
                a1 = __builtin_amdgcn_mfma_f32_4x4x4bf16_1k(__builtin_bit_cast(s16x4, (u32x2){r_[2 * q + 2], r_[2 * q + 3]}), xr[(k) & 3][q + 1], a1, 0, 0, 0); } \
            const f32x4 a_ = a0 + a1; \
            const float e0 = lb0 ? a_[1] : a_[0], e1 = lb0 ? a_[3] : a_[2]; dd[dk] = lb1 ? e1 : e0; } while (0)
#ifndef P8_URING
#define P8_URING 8
#endif
#if (PROBE_DUP >> 10) & 1
#define P8_UREPS 2
#else
#define P8_UREPS 1
#endif
#pragma unroll 1
            for (int urep = 0; urep < P8_UREPS; ++urep) {
                u32x4 u4[P8_URING]; u32x2 u2[P8_URING];
#pragma unroll
                for (int k = 0; k < P8_URING; ++k) P8_ULOAD(k, k);
                f32x4 vx[8];
#pragma unroll 1
                for (int i0 = 0; i0 < 512; i0 += P8_URING) {
                    if (P8_SWEEPSYNC && i0 == 256 && NGW == S / 4) xcd_local_barrier(xb);
                    if (urep == P8_UREPS - 1 && NGW == S / 4) {
                        if ((i0 & 63) == 0) {
                            const float* s0 = p.in[17] + (size_t)(tb * 8 + (i0 >> 6)) * DM;
#pragma unroll
                            for (int i = 0; i < 8; ++i) vx[i] = __builtin_nontemporal_load((const f32x4*)(s0 + (i * 64 + lane) * 4));
                        } else if ((i0 & 63) == 32) fp6_pack_store_s(vx, PEER_VSC, ws + WS_VT + (size_t)(tb * 8 + (i0 >> 6)) * PEER_ROWB, lane);
                    }
#pragma unroll
                    for (int hb = 0; hb < P8_URING / 8; ++hb) {
                        const int i = i0 + 8 * hb;
                        const unsigned ev = list[i + (lane & 7)]; const unsigned jl = (unsigned)lane & 3u;
                        const float gl = __builtin_bit_cast(float, ev & 0xffff0000u), rl = jl == 0u ? rs0 : (jl == 1u ? rs1 : (jl == 2u ? rs2 : rs3));
                        float dd[8];
#pragma unroll
                        for (int k = 0; k < 8; ++k) { P8_UPROC2(8 * hb + k, k); const int nx = i + P8_URING + k; P8_ULOAD(8 * hb + k, nx < 512 ? nx : 508 + (k & 3)); }
                        float w4[4], w2[2];
#pragma unroll
                        for (int q = 0; q < 4; ++q) { const float kp = lb2 ? dd[q + 4] : dd[q], sd = lb2 ? dd[q] : dd[q + 4]; w4[q] = kp + __shfl_xor(sd, 4); }
#pragma unroll
                        for (int q = 0; q < 2; ++q) { const float kp = lb1 ? w4[q + 2] : w4[q], sd = lb1 ? w4[q] : w4[q + 2]; w2[q] = kp + __shfl_xor(sd, 2); }
                        float dres; { const float kp = lb0 ? w2[1] : w2[0], sd = lb0 ? w2[0] : w2[1]; dres = kp + __shfl_xor(sd, 1); }
                        dres += __shfl_xor(dres, 8); dres += __shfl_xor(dres, 16); dres += __shfl_xor(dres, 32);
                        const float c_ = gl * gelu_tanh(rl * dres) * (1.0f / PEER_VSC);
                        if (lane < 8 && urep == P8_UREPS - 1) list[i + lane] = (ev & 0xffffu) | (f2bf(c_) << 16);
                    }
                }
            }
#undef P8_ULOAD
#undef P8_UPROC2
        }
        asm volatile("s_waitcnt vmcnt(0)" ::: "memory");
        LDS_WAIT(); asm volatile("" ::: "memory");
#if P8_MIDSYNC == 1
        __syncthreads();
#elif P8_MIDSYNC == 2
        if (NGW == S / 4) xcd_barrier(xb);
#endif
        f32x4 acc[4][8];
#if (PROBE_DUP >> 12) & 1
#define P8_VREPS 2
#else
#define P8_VREPS 1
#endif
#ifndef P8_VRING
#define P8_VRING 8
#endif
#pragma unroll 1
        for (int vrep = 0; vrep < P8_VREPS; ++vrep) {
#pragma unroll
        for (int j = 0; j < 4; ++j)
#pragma unroll
            for (int q = 0; q < 8; ++q) acc[j][q] = (f32x4){0.f, 0.f, 0.f, 0.f};
        {
            typedef unsigned u32x16 __attribute__((ext_vector_type(16)));
            u32x4 v4[P8_VRING]; u32x2 v2[P8_VRING]; unsigned ven[P8_VRING];
            const unsigned li = (unsigned)lane & 3u;
            const unsigned m0 = li == 0u ? 0x0000ffffu : (li == 1u ? 0xffff0000u : 0u), m1 = li == 2u ? 0x0000ffffu : (li == 3u ? 0xffff0000u : 0u);
            const __amdgpu_buffer_rsrc_t vrs = __builtin_amdgcn_make_buffer_rsrc((void*)VT, 0, 16384 * PEER_ROWB, 0x00020000);
            const int vo4 = lane * 16, vo2 = lane * 8 + 1024;
#define P8_VLOAD(k, i) do { const unsigned en = (unsigned)__builtin_amdgcn_readfirstlane((int)list[(i)]); ven[k] = en; const int ro = (int)((en & 0x3fffu) * (unsigned)PEER_ROWB); \
            v4[k] = __builtin_amdgcn_raw_buffer_load_b128(vrs, vo4, ro, 0); v2[k] = __builtin_amdgcn_raw_buffer_load_b64(vrs, vo2, ro, 0); } while (0)
#define P8_VPROC(k) do { const u32x6 pk = {v4[k][0], v4[k][1], v4[k][2], v4[k][3], v2[k][0], v2[k][1]}; \
            const u32x16 r_ = __builtin_bit_cast(u32x16, __builtin_amdgcn_cvt_scalef32_pk32_bf16_fp6(pk, 1.0f)); \
            const unsigned e_ = ven[k], cf = (e_ >> 16) | (e_ & 0xffff0000u); \
            const s16x4 av = __builtin_bit_cast(s16x4, (u32x2){cf & m0, cf & m1}); \
            _Pragma("unroll") for (int q = 0; q < 8; ++q) \
                acc[(k) & 3][q] = __builtin_amdgcn_mfma_f32_4x4x4bf16_1k(av, __builtin_bit_cast(s16x4, (u32x2){r_[2 * q], r_[2 * q + 1]}), acc[(k) & 3][q], 0, 0, 0); } while (0)
#pragma unroll
            for (int k = 0; k < P8_VRING; ++k) P8_VLOAD(k, k);
#pragma unroll 1
            for (int i = 0; i < 512 - 512 % P8_VRING; i += P8_VRING) {
                if (P8_SWEEPSYNC && i == 256 && NGW == S / 4) xcd_local_barrier(xb);
#pragma unroll
                for (int k = 0; k < P8_VRING; ++k) { P8_VPROC(k); const int nx = i + P8_VRING + k; P8_VLOAD(k, nx < 512 ? nx : 508 + (k & 3)); }
            }
#pragma unroll
            for (int k = 0; k < 512 % P8_VRING; ++k) P8_VPROC(k);
#undef P8_VLOAD
#undef P8_VPROC
        }
        }
        int tq = t0, lq = lane; asm volatile("" : "+s"(tq)); asm volatile("" : "+v"(lq));
#pragma unroll
        for (int j = 0; j < 4; ++j)
#pragma unroll
            for (int i = 0; i < 8; ++i) {
                const size_t o = (size_t)(tq + j) * DM + (i * 64 + lq) * 4;
                const u32x2 xw = *(const u32x2*)(x1b + o);
                f32x4 a = {bflo(xw.x), bfhi(xw.x), bflo(xw.y), bfhi(xw.y)};
                a += acc[j][i];
                __builtin_nontemporal_store(a, (f32x4*)(dst + o));
                if (i & 1) asm volatile("" ::: "memory");
            }
        LDS_WAIT(); asm volatile("" ::: "memory");
    }
}

__global__ void __launch_bounds__(NTHREADS, 2) mega(Params p) {
    extern __shared__ __attribute__((aligned(16))) unsigned char lds_raw[];
    LAS unsigned char* lds = (LAS unsigned char*)lds_raw;
    const int tid = threadIdx.x, lane = tid & 63, wave = __builtin_amdgcn_readfirstlane(tid >> 6);
    const int G = gridDim.x, bx = blockIdx.x;
    const int gw = bx * 8 + wave, NGW = G * 8;
    unsigned char* ws = p.ws;
    const int lo = p.ph_lo, hi = p.ph_hi;
    volatile LAS unsigned* misc = (volatile LAS unsigned*)(lds + LDS_MISC);
    if (tid < 4) misc[tid] = 0u;
    __syncthreads();
    const XcdBarrier xbar = xcd_barrier_post((unsigned*)(ws + WS_CTL), misc);
#ifndef PH_MASK
#define PH_MASK 0x1ff
#endif
#define IN(k) (((PH_MASK >> (k)) & 1) && lo <= (k) && (k) < hi)
#define SEAM(k) do { if (IN(k) && IN((k) + 1)) xcd_barrier(xbar); } while (0)

#if (PROBE_DUP >> 0) & 1
    if (IN(0)) { phase0(p, lds, G == 256, gw, NGW, wave, lane); xcd_barrier(xbar); }
#endif
    if (IN(0)) phase0(p, lds, G == 256, gw, NGW, wave, lane);
    SEAM(0);
    const bool part = (G == 256) && (misc[2] != 0u);
    const int vx = __builtin_amdgcn_readfirstlane(part ? (int)xbar.x : (bx & 7)), vr = __builtin_amdgcn_readfirstlane(part ? (int)misc[3] : (bx >> 3));
    const int vpanel = (vr >> 3) == 0 ? vx : ((vr >> 3) == 1 ? 31 - vx : ((vr >> 3) == 2 ? vx + 8 : 23 - vx));
    const int gwv = (G == 256) ? vpanel * 64 + (vr & 7) * 8 + wave : gw;
#define SEAM_X(k) do { if (IN(k) && IN((k) + 1)) { if (part) xcd_local_barrier_acq(xbar); else xcd_barrier(xbar); } } while (0)
    if (IN(1)) {
        pg8::Gemm g{(const bf16_t*)(ws + WS_XB), (const bf16_t*)(ws + WS_WIN), S, NINP, DM, DM, DM};
        pg8::StaticOrder So; So.init(S, NINP, G, bx);
        pg8::Epi<1> E{(const float*)(ws + WS_RSTD1), 0.f, (float*)(ws + WS_ROWSS), (bf16_t*)(ws + WS_PROJ), NINP, nullptr, nullptr};
#if (PROBE_DUP >> 1) & 1
        { pg8::Epi<1> E2 = E; E2.ss = (float*)(ws + 512 * 1024); pg8::gemm_phase<pg8::Epi<1>, pg8::StaticOrder, true, true>(lds, g, So, E2); xcd_barrier(xbar); }
#endif
        pg8::gemm_phase<pg8::Epi<1>, pg8::StaticOrder, true, true>(lds, g, So, E);
        if (G == 256 && bx >= 128) { __syncthreads(); prep_late(p, lds, (bx - 128) * 8 + wave, 1024, wave, lane); }
    }
    SEAM(1);
    if (IN(2)) {
        {
            pg8::Gemm g{(const bf16_t*)(ws + WS_PROJ) + 2048, (const bf16_t*)(ws + WS_WUQ), S, 1536, 512, NINP, 512};
            pg8::StaticOrder So; So.init(S, 1536, G, bx);
            pg8::Epi<2> E{(const float*)(ws + WS_ROWSS) + 1 * S, 1.0f / 512.0f, nullptr, (bf16_t*)(ws + WS_QRAW), 1536, nullptr, nullptr};
            pg8::gemm_phase<pg8::Epi<2>, pg8::StaticOrder, true, true>(lds, g, So, E);
        }
        __syncthreads();
        {
            pg8::Gemm g{(const bf16_t*)(ws + WS_PROJ) + 2560, (const bf16_t*)(ws + WS_WUKV), S, 2048, 256, NINP, 256};
            pg8::StaticOrder So; So.init(S, 2048, G, bx);
            pg8::Epi<2> E{(const float*)(ws + WS_ROWSS) + 2 * S, 1.0f / 256.0f, nullptr, (bf16_t*)(ws + WS_KVRAW), 2048, nullptr, nullptr};
            pg8::gemm_phase<pg8::Epi<2>, pg8::StaticOrder, true, true>(lds, g, So, E);
        }
    }
    SEAM(2);
#if (PROBE_DUP >> 3) & 1
    if (IN(3)) { phase3(p, gw, NGW, (S - gw + NGW - 1) / NGW, lane); xcd_barrier(xbar); }
#endif
    if (IN(3)) phase3(p, gw, NGW, (S - gw + NGW - 1) / NGW, lane);
    SEAM(3);
    const int vP = (vr >> 4) ? vx + 8 : vx, vqa = ((vr >> 3) & 1) ? 62 - 2 * vP : 63 - 2 * vP, vqb = ((vr >> 3) & 1) ? 2 * vP + 1 : 2 * vP;
#define P4_BODY_ATT do { if (G == 256) { attn_unit(p, lds, vr & 7, vqa, tid, wave, lane); attn_unit(p, lds, vr & 7, vqb, tid, wave, lane); } \
        else for (int pr = bx; pr < 256; pr += G) { const int head = pr & 7, x = pr >> 3; attn_unit(p, lds, head, 63 - x, tid, wave, lane); attn_unit(p, lds, head, x, tid, wave, lane); } } while (0)
#define P4_BODY_GMLP do { if (G == 256) { gmlp_unit(p, lds, vqa, vr & 7, tid, wave, lane); gmlp_unit(p, lds, vqb, vr & 7, tid, wave, lane); } \
        else for (int u = bx; u < 512; u += G) gmlp_unit(p, lds, u >> 3, u & 7, tid, wave, lane); } while (0)
#if (PROBE_DUP >> 4) & 1
    if (IN(4)) { P4_BODY_ATT; xcd_barrier(xbar); }
#endif
#if (PROBE_DUP >> 9) & 1
    if (IN(4)) { P4_BODY_GMLP; xcd_barrier(xbar); }
#endif
    if (IN(4)) { P4_BODY_ATT; P4_BODY_GMLP; }
    SEAM_X(4);
    if (IN(5)) {
        pg8::Gemm g{(const bf16_t*)(ws + WS_MIX), (const bf16_t*)(ws + WS_WOUT), S, DM, DM, DM, DM};
        pg8::StaticOrder So; So.init(S, DM, G, bx); if (G == 256) So.fixed(vpanel, vr & 7);
        pg8::Epi<4> E{nullptr, 0.f, (float*)(ws + WS_ROWSS) + 3 * S, (bf16_t*)(ws + WS_X1B), DM, p.out, p.in[0]};
#if (PROBE_DUP >> 5) & 1
        { pg8::Epi<4> E2 = E; E2.ss = (float*)(ws + 512 * 1024); pg8::gemm_phase<pg8::Epi<4>, pg8::StaticOrder, true, true>(lds, g, So, E2); xcd_barrier(xbar); }
#endif
        pg8::gemm_phase<pg8::Epi<4>, pg8::StaticOrder, true, true>(lds, g, So, E);
    }
    SEAM_X(5);
    if (IN(6)) {
        pg8::Gemm g{(const bf16_t*)(ws + WS_X1B), (const bf16_t*)(ws + WS_WS), S, DM, DM, DM, DM};
        pg8::StaticOrder So; So.init(S, DM, G, bx); if (G == 256) So.fixed(vpanel, vr & 7);
        pg8::Epi<5> E{(const float*)(ws + WS_ROWSS) + 3 * S, 1.0f / DM, nullptr, nullptr, DM, (float*)(ws + WS_SC), nullptr};
#if (PROBE_DUP >> 6) & 1
        { pg8::gemm_phase<pg8::Epi<5>, pg8::StaticOrder, true, true>(lds, g, So, E); xcd_barrier(xbar); }
#endif
        pg8::gemm_phase<pg8::Epi<5>, pg8::StaticOrder, true, true>(lds, g, So, E);
    }
    SEAM_X(6);
#if (PROBE_DUP >> 7) & 1
    if (IN(7)) { phase7(p, lds, gwv, NGW, wave, lane, G == 256); xcd_barrier(xbar); }
#endif
    if (IN(7)) phase7(p, lds, gwv, NGW, wave, lane, G == 256);
    if (IN(7) && IN(8)) xcd_barrier(xbar);
#if (PROBE_DUP >> 8) & 1
    if (IN(8)) { phase8(p, lds, (float*)(ws + WS_SC), xbar, gwv, NGW, wave, lane); xcd_barrier(xbar); }
#endif
    if (IN(8)) phase8(p, lds, p.out, xbar, gwv, NGW, wave, lane);
#undef IN
#undef SEAM
#undef SEAM_X
}

extern "C" void kernel_launch(void* const* d_in, const int* in_sizes, int n_in, void* d_out, int out_size, void* d_ws, size_t ws_size, hipStream_t stream) {
    static int grid = 0;
    if (grid == 0) {
        if (n_in != 18 || out_size != S * DM || ws_size < WS_END) { fprintf(stderr, "kernel_launch: unexpected shapes (n_in %d out %d ws %zu)\n", n_in, out_size, ws_size); grid = -1; return; }
        int dev = 0, cus = 0, per_cu = 0;
        hipGetDevice(&dev);
        hipDeviceGetAttribute(&cus, hipDeviceAttributeMultiprocessorCount, dev);
        if (hipFuncSetAttribute((const void*)mega, hipFuncAttributeMaxDynamicSharedMemorySize, LDS_BYTES) != hipSuccess) { fprintf(stderr, "kernel_launch: hipFuncSetAttribute failed\n"); grid = -1; return; }
        if (hipOccupancyMaxActiveBlocksPerMultiprocessor(&per_cu, (const void*)mega, NTHREADS, LDS_BYTES) != hipSuccess || per_cu < 1) { fprintf(stderr, "kernel_launch: occupancy query failed (%d)\n", per_cu); grid = -1; return; }
        grid = cus;
        fprintf(stderr, "kernel_launch: cus %d per_cu %d grid %d\n", cus, per_cu, grid);
    }
    if (grid < 0) return;
    hipMemsetAsync((char*)d_ws + WS_CTL, 0, 1 * MiB, stream);
    Params prm{};
    for (int i = 0; i < 18; ++i) prm.in[i] = (const float*)d_in[i];
    prm.out = (float*)d_out; prm.ws = (unsigned char*)d_ws;
#if MK_ONE_LAUNCH
    prm.ph_lo = 0; prm.ph_hi = NPH;
    { void* args[] = {&prm}; hipError_t e = hipLaunchCooperativeKernel((const void*)mega, dim3(grid), dim3(NTHREADS), args, LDS_BYTES, stream);
      if (e != hipSuccess) fprintf(stderr, "cooperative launch failed: %s\n", hipGetErrorString(e)); }
#else
    for (int ph = 0; ph < NPH; ++ph) {
        prm.ph_lo = ph; prm.ph_hi = ph + 1;
        void* args[] = {&prm};
        hipError_t e = hipLaunchCooperativeKernel((const void*)mega, dim3(grid), dim3(NTHREADS), args, LDS_BYTES, stream);
        if (e != hipSuccess) { fprintf(stderr, "cooperative launch %d failed: %s\n", ph, hipGetErrorString(e)); break; }
    }
#endif
}
```

```cpp
#include <hip/hip_runtime.h>
#include <cstdio>
#include <cstdint>

#define LAS __attribute__((address_space(3)))
typedef unsigned short bf16_t;
typedef short bf16x8 __attribute__((ext_vector_type(8)));
typedef short s16x4 __attribute__((ext_vector_type(4)));
typedef float f32x4 __attribute__((ext_vector_type(4)));
typedef float f32x16 __attribute__((ext_vector_type(16)));
typedef unsigned u32x4 __attribute__((ext_vector_type(4)));
typedef unsigned u32x2 __attribute__((ext_vector_type(2)));

#ifndef PROBE_DUP
#define PROBE_DUP 0
#endif
#ifndef MK_ONE_LAUNCH
#define MK_ONE_LAUNCH 1
#endif

constexpr int S = 8192, DM = 2048, NIN = 2880, NINP = 3072;
constexpr int NPH = 9;
constexpr float EPS = 1e-6f;
constexpr int LDS_BYTES = 163840;
constexpr int NTHREADS = 512;
constexpr int LDS_MISC = 161792;

constexpr size_t MiB = 1u << 20;
constexpr size_t WS_CTL = 0;
constexpr size_t WS_ROWSS = 128 * 1024;
constexpr size_t WS_COS = 1 * MiB, WS_SIN = 2 * MiB;
constexpr size_t WS_RSTD1 = 3 * MiB;
constexpr size_t WS_EXP = 4 * MiB;
constexpr size_t WS_GATE = 8 * MiB;
constexpr size_t WS_WIN = 12 * MiB;
constexpr size_t WS_WUQ = 24 * MiB;
constexpr size_t WS_WUKV = 26 * MiB;
constexpr size_t WS_WOUT = 28 * MiB;
constexpr size_t WS_WS = 36 * MiB;
constexpr size_t WS_XB = 44 * MiB;
constexpr size_t WS_PROJ = 76 * MiB;
constexpr size_t WS_QRAW = 124 * MiB;
constexpr size_t WS_KVRAW = 148 * MiB;
constexpr size_t WS_QH = 180 * MiB;
constexpr size_t WS_KH = 204 * MiB;
constexpr size_t WS_VH = 228 * MiB;
constexpr size_t WS_MIX = 244 * MiB;
constexpr size_t WS_X1B = 276 * MiB;
constexpr size_t WS_SC = 308 * MiB;
constexpr size_t WS_UT = 372 * MiB;
constexpr size_t WS_VT = 436 * MiB;
constexpr size_t WS_END = 500 * MiB;

__device__ __forceinline__ unsigned f2bf(float f) { unsigned u = __builtin_bit_cast(unsigned, f); return (u + 0x7fffu + ((u >> 16) & 1u)) >> 16; }
__device__ __forceinline__ unsigned pk2(float lo, float hi) { return f2bf(lo) | (f2bf(hi) << 16); }
__device__ __forceinline__ float bf2f(unsigned short b) { return __builtin_bit_cast(float, (unsigned)b << 16); }
__device__ __forceinline__ float bflo(unsigned w) { return __builtin_bit_cast(float, w << 16); }
__device__ __forceinline__ float bfhi(unsigned w) { return __builtin_bit_cast(float, w & 0xffff0000u); }
__device__ __forceinline__ float wave_sum(float v) {
#pragma unroll
    for (int o = 32; o > 0; o >>= 1) v += __shfl_xor(v, o);
    return v;
}
__device__ __forceinline__ float wave_max(float v) {
#pragma unroll
    for (int o = 32; o > 0; o >>= 1) v = fmaxf(v, __shfl_xor(v, o));
    return v;
}
template <int CTRL, int ROW_MASK> __device__ __forceinline__ float dpp_f(float old, float v) {
    return __builtin_bit_cast(float, __builtin_amdgcn_update_dpp(__builtin_bit_cast(int, old), __builtin_bit_cast(int, v), CTRL, ROW_MASK, 0xf, false));
}
__device__ __forceinline__ float wave_max_u(float v) {
    v = fmaxf(v, dpp_f<0xB1, 0xf>(v, v));
    v = fmaxf(v, dpp_f<0x4E, 0xf>(v, v));
    v = fmaxf(v, dpp_f<0x141, 0xf>(v, v));
    v = fmaxf(v, dpp_f<0x140, 0xf>(v, v));
    v = fmaxf(v, dpp_f<0x142, 0xa>(v, v));
    v = fmaxf(v, dpp_f<0x143, 0xc>(v, v));
    return __builtin_bit_cast(float, __builtin_amdgcn_readlane(__builtin_bit_cast(int, v), 63));
}
__device__ __forceinline__ float wave_sum_u(float v) {
    v += dpp_f<0xB1, 0xf>(0.f, v);
    v += dpp_f<0x4E, 0xf>(0.f, v);
    v += dpp_f<0x141, 0xf>(0.f, v);
    v += dpp_f<0x140, 0xf>(0.f, v);
    v += dpp_f<0x142, 0xa>(0.f, v);
    v += dpp_f<0x143, 0xc>(0.f, v);
    return __builtin_bit_cast(float, __builtin_amdgcn_readlane(__builtin_bit_cast(int, v), 63));
}
__device__ __forceinline__ float gelu_tanh(float x) {
    const float y = 0.7978845608028654f * (x + 0.044715f * x * x * x);
    return x / (1.0f + __expf(-2.0f * y));
}
__device__ __forceinline__ int crow(int r, int hi) { return (r & 3) + 8 * (r >> 2) + 4 * hi; }
#define LDS_WAIT() asm volatile("s_waitcnt lgkmcnt(0)" ::: "memory")
#define SBAR() __builtin_amdgcn_sched_barrier(0)

namespace pg8 {
#define PG8_LAS __attribute__((address_space(3)))
constexpr int BM = 256, BK = 64, HALF = 128, HTB = HALF * BK * 2  , STAGE_BYTES = 8 * HTB, NXCD = 8, WGM = 8;

__host__ __device__ __forceinline__ int lds_byte(int r, int c) { const int st = (r >> 4) * 2 + (c >> 5), rr = r & 15, cc = c & 31, ob = rr * 64 + cc * 2; return st * 1024 + (ob ^ (((ob >> 9) & 1) << 5)); }
__host__ __device__ __forceinline__ void stage_rc(int b, int& R, int& C) { const int st = b / 1024, sb = b % 1024, swz = sb ^ (((sb >> 9) & 1) << 5); R = (st >> 1) * 16 + swz / 64; C = (st & 1) * 32 + (swz % 64) / 2; }
__host__ __device__ __forceinline__ int perm32(int rho) { const int n = rho >> 4, i = rho & 15; return 8 * (i >> 2) + 4 * n + (i & 3); }

struct Unit { int pm, pn; };
struct Gemm { const bf16_t* A; const bf16_t* Bt; int M, N, K, lda, ldb; };

struct StaticOrder {
    int nM, nN, nwg, G, c, fpm = -1, fpn = 0;
    __host__ __device__ void init(int M, int N, int G_, int c_) { nM = M / BM; nN = N / BM; nwg = nM * nN; G = G_; c = c_; fpm = -1; }
    __host__ __device__ void fixed(int pm, int pn) { fpm = pm; fpn = pn; }
    __host__ __device__ bool next(int i, Unit& u) const {
        if (fpm >= 0) { if (i > 0) return false; u.pm = fpm; u.pn = fpn; return true; }
        const long L = (long)i * G + c; if (L >= nwg) return false;
        int wgid = (int)L; { const int q = nwg / NXCD, r = nwg % NXCD, xcd = wgid % NXCD, off = wgid / NXCD; wgid = (xcd < r ? xcd * (q + 1) : r * (q + 1) + (xcd - r) * q) + off; }
        const int nig = WGM * nN, gid = wgid / nig, fm = gid * WGM, gsz = (nM - fm) < WGM ? (nM - fm) : WGM;
        u.pm = fm + ((wgid % nig) % gsz); u.pn = (wgid % nig) / gsz; return true;
    }
    __device__ __forceinline__ void a_ready(const Unit&) const {}
    __device__ __forceinline__ void done(const Unit&) const {}
};

template <class Epi, class Sched, bool ALIGN_EPI = false, bool SP2 = false>
__device__ __forceinline__ void gemm_phase(PG8_LAS unsigned char* lds, const Gemm g, const Sched& S, const Epi& E) {
    const int tid = threadIdx.x, wid = __builtin_amdgcn_readfirstlane(tid >> 6), lane = tid & 63, wr = wid >> 2, wc = wid & 3, fr = lane & 15, fq = lane >> 4;
    const int K = g.K, nt = K / BK;
    unsigned voffA[2], voffB[2];
#pragma unroll
    for (int i = 0; i < 2; ++i) { int R, C; stage_rc(tid * 16 + i * 8192, R, C); const int Rb = Epi::PERM ? ((R & ~31) + perm32(R & 31)) : R;
        voffA[i] = (unsigned)(R * g.lda + C) * 2u; voffB[i] = (unsigned)(Rb * g.ldb + C) * 2u; }
    const size_t kstep = (size_t)(BK * 2);
    const size_t hstepA = (size_t)HALF * g.lda * 2, hstepB = (size_t)HALF * g.ldb * 2;
    const size_t tstepA = 2 * hstepA, tstepB = 2 * hstepB;
    const unsigned ldsw = (unsigned)wid * 1024u;
    const int aoff = lds_byte(wr * 64 + fr, fq * 8), boff = lds_byte(wc * 32 + fr, fq * 8);
#define PG8_SA(b, h) (((b) * 2 + (h)) * HTB)
#define PG8_SB(b, h) ((4 + (b) * 2 + (h)) * HTB)
#define PG8_STAGE(bufoff, gbase, voff) do { _Pragma("unroll") for (int _i = 0; _i < 2; ++_i) \
        __builtin_amdgcn_global_load_lds((const unsigned*)((const char*)(gbase) + (voff)[_i]), (PG8_LAS unsigned*)(lds + (bufoff) + ldsw + _i * 8192), 16, 0, 0); } while (0)
#define PG8_LDA(dst, b, h) do { _Pragma("unroll") for (int m = 0; m < 4; ++m) _Pragma("unroll") for (int k = 0; k < 2; ++k) dst[m][k] = *(const PG8_LAS bf16x8*)(lds + PG8_SA(b, h) + aoff + m * 2048 + k * 1024); } while (0)
#define PG8_LDB(dst, b, h) do { _Pragma("unroll") for (int n = 0; n < 2; ++n) _Pragma("unroll") for (int k = 0; k < 2; ++k) dst[n][k] = *(const PG8_LAS bf16x8*)(lds + PG8_SB(b, h) + boff + n * 2048 + k * 1024); } while (0)
#define PG8_MMA(ai, bj, At, Bt) do { __builtin_amdgcn_s_setprio(1); _Pragma("unroll") for (int m = 0; m < 4; ++m) _Pragma("unroll") for (int n = 0; n < 2; ++n) _Pragma("unroll") for (int k = 0; k < 2; ++k) \
        acc[ai][bj][m][n] = __builtin_amdgcn_mfma_f32_16x16x32_bf16(Bt[n][k], At[m][k], acc[ai][bj][m][n], 0, 0, 0); __builtin_amdgcn_s_setprio(0); } while (0)
#define PG8_WAIT_V(n) asm volatile("s_waitcnt vmcnt(" #n ")" ::: "memory")
#define PG8_WAIT_L(n) asm volatile("s_waitcnt lgkmcnt(" #n ")" ::: "memory")
#define PG8_BAR __builtin_amdgcn_s_barrier()
#define PG8_SCHED __builtin_amdgcn_sched_barrier(0)
    Unit cur, nxt; int ui = 0;
    if (!S.next(0, cur)) return;
    f32x4 acc[2][2][4][2];
#pragma unroll
    for (int a = 0; a < 2; ++a)
#pragma unroll
        for (int b = 0; b < 2; ++b)
#pragma unroll
            for (int m = 0; m < 4; ++m)
#pragma unroll
                for (int n = 0; n < 2; ++n) acc[a][b][m][n] = (f32x4){0.f, 0.f, 0.f, 0.f};
    bf16x8 At[4][2], B0[2][2], B1[2][2];
    const char* cA = (const char*)g.A + (size_t)cur.pm * tstepA; const char* cB = (const char*)g.Bt + (size_t)cur.pn * tstepB;
    S.a_ready(cur);
    if constexpr (SP2) {
        PG8_STAGE(PG8_SB(0, 0), cB, voffB); PG8_STAGE(PG8_SB(0, 1), cB + hstepB, voffB); PG8_STAGE(PG8_SA(0, 0), cA, voffA); PG8_STAGE(PG8_SA(0, 1), cA + hstepA, voffA);
        if (wr == 1) PG8_BAR;
        PG8_WAIT_V(2); PG8_BAR;
        PG8_STAGE(PG8_SB(1, 0), cB + kstep, voffB); PG8_STAGE(PG8_SA(1, 0), cA + kstep, voffA); PG8_STAGE(PG8_SB(1, 1), cB + hstepB + kstep, voffB);
        PG8_WAIT_V(6); PG8_BAR;
    } else {
        PG8_STAGE(PG8_SB(0, 0), cB, voffB); PG8_STAGE(PG8_SA(0, 0), cA, voffA); PG8_STAGE(PG8_SB(0, 1), cB + hstepB, voffB); PG8_STAGE(PG8_SA(0, 1), cA + hstepA, voffA);
        if (wr == 1) PG8_BAR;
        PG8_WAIT_V(4); PG8_BAR;
        PG8_STAGE(PG8_SB(1, 0), cB + kstep, voffB); PG8_STAGE(PG8_SA(1, 0), cA + kstep, voffA); PG8_STAGE(PG8_SB(1, 1), cB + hstepB + kstep, voffB);
        PG8_WAIT_V(6); PG8_BAR;
    }
    for (;;) {
        const bool has_next = S.next(ui + 1, nxt);
        const char* nA = has_next ? (const char*)g.A + (size_t)nxt.pm * tstepA : cA; const char* nB = has_next ? (const char*)g.Bt + (size_t)nxt.pn * tstepB : cB;
        for (int t = 0; t < nt; t += 2) {
            const bool last = (t == nt - 2);
            const char* a1 = cA + (size_t)(t + 1) * kstep;
            const char* a2 = last ? nA : cA + (size_t)(t + 2) * kstep; const char* b2 = last ? nB : cB + (size_t)(t + 2) * kstep;
            const char* a3 = a2 + kstep; const char* b3 = b2 + kstep;
            if (last && has_next) S.a_ready(nxt);
            if constexpr (SP2) {
            PG8_LDB(B0, 0, 0); PG8_LDB(B1, 0, 1); PG8_SCHED; PG8_LDA(At, 0, 0); PG8_STAGE(PG8_SA(1, 1), a1 + hstepA, voffA);
            PG8_WAIT_V(8); PG8_WAIT_L(0); PG8_BAR; PG8_MMA(0, 0, At, B0); PG8_MMA(0, 1, At, B1); PG8_BAR; PG8_SCHED;
            PG8_LDA(At, 0, 1); PG8_STAGE(PG8_SB(0, 0), b2, voffB); PG8_STAGE(PG8_SB(0, 1), b2 + hstepB, voffB); PG8_STAGE(PG8_SA(0, 0), a2, voffA);
            PG8_WAIT_V(8); PG8_WAIT_L(0); PG8_BAR; PG8_MMA(1, 0, At, B0); PG8_MMA(1, 1, At, B1); PG8_BAR; PG8_SCHED;
            PG8_LDB(B0, 1, 0); PG8_LDB(B1, 1, 1); PG8_SCHED; PG8_LDA(At, 1, 0); PG8_STAGE(PG8_SA(0, 1), a2 + hstepA, voffA);
            PG8_WAIT_V(8); PG8_WAIT_L(0); PG8_BAR; PG8_MMA(0, 0, At, B0); PG8_MMA(0, 1, At, B1); PG8_BAR; PG8_SCHED;
            PG8_LDA(At, 1, 1); PG8_STAGE(PG8_SB(1, 0), b3, voffB); PG8_STAGE(PG8_SB(1, 1), b3 + hstepB, voffB); PG8_STAGE(PG8_SA(1, 0), a3, voffA);
            PG8_WAIT_V(8); PG8_WAIT_L(0); PG8_BAR; PG8_MMA(1, 0, At, B0); PG8_MMA(1, 1, At, B1); PG8_BAR; PG8_SCHED;
            } else {
            PG8_LDB(B0, 0, 0); PG8_SCHED; PG8_LDA(At, 0, 0); PG8_STAGE(PG8_SA(1, 1), a1 + hstepA, voffA);
            PG8_WAIT_L(8); PG8_BAR; PG8_WAIT_L(0); PG8_MMA(0, 0, At, B0); PG8_BAR; PG8_SCHED;
            PG8_LDB(B1, 0, 1); PG8_STAGE(PG8_SB(0, 0), b2, voffB);
            PG8_BAR; PG8_WAIT_L(0); PG8_MMA(0, 1, At, B1); PG8_BAR;
            PG8_LDA(At, 0, 1); PG8_STAGE(PG8_SA(0, 0), a2, voffA);
            PG8_BAR; PG8_WAIT_L(0); PG8_MMA(1, 0, At, B0); PG8_BAR; PG8_SCHED;
            PG8_STAGE(PG8_SB(0, 1), b2 + hstepB, voffB);
            PG8_WAIT_V(6); PG8_BAR; PG8_MMA(1, 1, At, B1); PG8_BAR;
            PG8_LDB(B0, 1, 0); PG8_SCHED; PG8_LDA(At, 1, 0); PG8_STAGE(PG8_SA(0, 1), a2 + hstepA, voffA);
            PG8_WAIT_L(8); PG8_BAR; PG8_WAIT_L(0); PG8_MMA(0, 0, At, B0); PG8_BAR; PG8_SCHED;
            PG8_LDB(B1, 1, 1); PG8_STAGE(PG8_SB(1, 0), b3, voffB);
            PG8_BAR; PG8_WAIT_L(0); PG8_MMA(0, 1, At, B1); PG8_BAR;
            PG8_LDA(At, 1, 1); PG8_STAGE(PG8_SA(1, 0), a3, voffA);
            PG8_BAR; PG8_WAIT_L(0); PG8_MMA(1, 0, At, B0); PG8_BAR; PG8_SCHED;
            PG8_STAGE(PG8_SB(1, 1), b3 + hstepB, voffB);
            PG8_WAIT_V(6); PG8_BAR; PG8_MMA(1, 1, At, B1); PG8_BAR;
            }
        }
        if constexpr (ALIGN_EPI) { if (wr == 0) PG8_BAR; }
        if constexpr (!Epi::AFTER_DRAIN) { E(acc, cur, wr, wc, fr, fq); S.done(cur); }
        if (!has_next) break;
#pragma unroll
        for (int a = 0; a < 2; ++a)
#pragma unroll
            for (int b = 0; b < 2; ++b)
#pragma unroll
                for (int m = 0; m < 4; ++m)
#pragma unroll
                    for (int n = 0; n < 2; ++n) acc[a][b][m][n] = (f32x4){0.f, 0.f, 0.f, 0.f};
        cur = nxt; cA = nA; cB = nB; ++ui;
        if constexpr (ALIGN_EPI) { if (wr == 1) PG8_BAR; }
    }
    PG8_WAIT_V(0);
    if constexpr (!ALIGN_EPI) { if (wr == 0) PG8_BAR; }
    PG8_BAR;
#undef PG8_SA
#undef PG8_SB
#undef PG8_STAGE
#undef PG8_LDA
#undef PG8_LDB
#undef PG8_MMA
#undef PG8_WAIT_V
#undef PG8_WAIT_L
#undef PG8_BAR
#undef PG8_SCHED
}

template <int MODE> struct Epi {
    static constexpr bool PERM = false, AFTER_DRAIN = false;
    const float* rowsrc; float inv_n; float* ss; bf16_t* ob; int ldc; float* of; const float* xin;
    __device__ __forceinline__ void operator()(const f32x4 (&acc)[2][2][4][2], const Unit& u, int wr, int wc, int fr, int fq) const {
#pragma unroll
        for (int ai = 0; ai < 2; ++ai)
#pragma unroll
            for (int m = 0; m < 4; ++m) {
                const int row = u.pm * BM + ai * HALF + wr * 64 + m * 16 + fr;
                float rs = 1.f;
                if (MODE == 1) rs = rowsrc[row];
                if (MODE == 2 || MODE == 5) rs = rsqrtf(rowsrc[row] * inv_n + EPS);
                float ssq = 0.f;
#pragma unroll
                for (int bj = 0; bj < 2; ++bj)
#pragma unroll
                    for (int n = 0; n < 2; ++n) {
                        const int col = u.pn * BM + bj * HALF + wc * 32 + n * 16 + fq * 4;
                        f32x4 v = acc[ai][bj][m][n] * rs;
                        if (MODE == 1) { if (u.pn < 8) { v[0] = gelu_tanh(v[0]); v[1] = gelu_tanh(v[1]); v[2] = gelu_tanh(v[2]); v[3] = gelu_tanh(v[3]); } }
                        if (MODE == 4) { const u32x2 xw = *(const u32x2*)((const bf16_t*)xin + (size_t)row * DM + col); v = v + (f32x4){bflo(xw.x), bfhi(xw.x), bflo(xw.y), bfhi(xw.y)}; }
                        if (MODE == 1 || MODE == 4) ssq += (v[0] * v[0] + v[1] * v[1]) + (v[2] * v[2] + v[3] * v[3]);
                        if (MODE == 1 || MODE == 2 || MODE == 4) { u32x2 w; w.x = pk2(v[0], v[1]); w.y = pk2(v[2], v[3]); *(u32x2*)(ob + (size_t)row * ldc + col) = w; }
                        if (MODE == 5) *(f32x4*)(of + (size_t)row * DM + col) = v;
                    }
                if (MODE == 1) {
                    const int seg = (u.pn >= 4 && u.pn < 8) ? 0 : ((u.pn == 8 || u.pn == 9) ? 1 : (u.pn == 10 ? 2 : -1));
                    if (seg >= 0) { ssq += __shfl_xor(ssq, 16); ssq += __shfl_xor(ssq, 32); if (fq == 0) atomicAdd(ss + seg * S + row, ssq); }
                }
                if (MODE == 4) { ssq += __shfl_xor(ssq, 16); ssq += __shfl_xor(ssq, 32); if (fq == 0) atomicAdd(ss + row, ssq); }
            }
    }
};
}

#define XB_TMO      128
#define XB_XCNT(j)  (256  + 64 * (j))
#define XB_XSUB(j)  (1280 + 64 * (j))
#define XB_XGEN(j)  (2304 + 64 * (j))
#define XB_TOP      3328
#define XB_TOPGEN   3392
#define XCD_BAR_WORDS 3456
#define XB_SPIN_CAP (1u << 18)
__device__ __forceinline__ unsigned xb_ld(unsigned* p)              { return __hip_atomic_load(p, __ATOMIC_RELAXED, __HIP_MEMORY_SCOPE_AGENT); }
__device__ __forceinline__ unsigned xb_add(unsigned* p, unsigned v) { return __hip_atomic_fetch_add(p, v, __ATOMIC_RELAXED, __HIP_MEMORY_SCOPE_AGENT); }
__device__ __forceinline__ unsigned xb_xcc_id() { return (unsigned)__builtin_amdgcn_s_getreg((3 << 11) | 20) & 0xFu; }
#define XB_SPIN(cond, bar) do { unsigned _sp = 0; while (cond) { __builtin_amdgcn_s_sleep(1); \
    if ((++_sp & 255u) == 0u) { if (xb_ld(&(bar)[XB_TMO])) break; if (_sp > XB_SPIN_CAP) { atomicAdd(&(bar)[XB_TMO], 1u); break; } } } } while (0)
struct XcdBarrier { unsigned* bar; unsigned x; volatile LAS unsigned* st; };
__device__ __forceinline__ XcdBarrier xcd_barrier_post(unsigned* bar, volatile LAS unsigned* st) {
    XcdBarrier b; b.bar = bar; b.x = xb_xcc_id(); b.st = st;
    if (threadIdx.x == 0) st[3] = xb_add(&bar[XB_XCNT(b.x)], 1u);
    return b;
}
__device__ __forceinline__ void xcd_barrier_complete(unsigned* bar, unsigned x, unsigned& nloc, unsigned& nx, unsigned& eq32) {
    const unsigned G = gridDim.x * gridDim.y * gridDim.z;
    unsigned sum, cnt, mine, sp = 0u;
    for (;;) {
        sum = 0u; cnt = 0u; mine = 0u; eq32 = 1u;
#pragma unroll
        for (unsigned j = 0; j < 16; ++j) { const unsigned c = xb_ld(&bar[XB_XCNT(j)]); sum += c; cnt += (c > 0u) ? 1u : 0u; mine = (j == x) ? c : mine; if (c != (j < 8u ? 32u : 0u)) eq32 = 0u; }
        if (sum == G) break;
        __builtin_amdgcn_s_sleep(1);
        if ((++sp & 255u) == 0u) { if (xb_ld(&bar[XB_TMO])) break; if (sp > XB_SPIN_CAP) { atomicAdd(&bar[XB_TMO], 1u); break; } }
    }
    nloc = mine > 0u ? mine : 1u; nx = cnt > 0u ? cnt : 1u;
}
#define XB_LSUB(j)  (3456 + 64 * (j))
#define XB_LGEN(j)  (4480 + 64 * (j))
__device__ __forceinline__ void xcd_local_barrier(const XcdBarrier& b) {
    asm volatile("s_waitcnt vmcnt(0)" ::: "memory");
    __syncthreads();
    if (threadIdx.x == 0) {
        unsigned* bar = b.bar;
        const unsigned nloc = b.st[0];
        const unsigned old = xb_add(&bar[XB_LSUB(b.x)], 1u);
        const unsigned gen = old / nloc;
        if (old + 1u == (gen + 1u) * nloc) xb_add(&bar[XB_LGEN(b.x)], 1u);
        else XB_SPIN(xb_ld(&bar[XB_LGEN(b.x)]) == gen, bar);
    }
    __syncthreads();
}
__device__ __forceinline__ void xcd_local_barrier_acq(const XcdBarrier& b) {
    asm volatile("s_waitcnt vmcnt(0)" ::: "memory");
    __syncthreads();
    if (threadIdx.x == 0) {
        unsigned* bar = b.bar;
        __builtin_amdgcn_s_waitcnt(0);
        const unsigned nloc = b.st[0];
        const unsigned old = xb_add(&bar[XB_LSUB(b.x)], 1u);
        const unsigned gen = old / nloc;
        if (old + 1u == (gen + 1u) * nloc) xb_add(&bar[XB_LGEN(b.x)], 1u);
        else XB_SPIN(xb_ld(&bar[XB_LGEN(b.x)]) == gen, bar);
        __builtin_amdgcn_fence(__ATOMIC_ACQUIRE, "agent");
        asm volatile("s_waitcnt vmcnt(0)" ::: "memory");
    }
    __syncthreads();
}
__device__ __forceinline__ void xcd_barrier(const XcdBarrier& b) {
    asm volatile("s_waitcnt vmcnt(0)" ::: "memory");
    __syncthreads();
    if (threadIdx.x == 0) {
        unsigned* bar = b.bar;
        __builtin_amdgcn_s_waitcnt(0);
        unsigned nloc = b.st[0], nx = b.st[1];
        if (nloc == 0u) { unsigned eq32; xcd_barrier_complete(bar, b.x, nloc, nx, eq32); b.st[0] = nloc; b.st[1] = nx; b.st[2] = eq32; }
        const unsigned old = xb_add(&bar[XB_XSUB(b.x)], 1u);
        const unsigned gen = old / nloc;
        if (old + 1u == (gen + 1u) * nloc) {
            __builtin_amdgcn_fence(__ATOMIC_RELEASE, "agent");
            asm volatile("s_waitcnt vmcnt(0)" ::: "memory");
            const unsigned og = xb_add(&bar[XB_TOP], 1u);
            const unsigned tg = og / nx;
            if (og + 1u == (tg + 1u) * nx) xb_add(&bar[XB_TOPGEN], 1u);
            else XB_SPIN(xb_ld(&bar[XB_TOPGEN]) == tg, bar);
            __builtin_amdgcn_fence(__ATOMIC_ACQUIRE, "agent");
            xb_add(&bar[XB_XGEN(b.x)], 1u);
            asm volatile("s_waitcnt vmcnt(0)" ::: "memory");
        } else {
            XB_SPIN(xb_ld(&bar[XB_XGEN(b.x)]) == gen, bar);
            __builtin_amdgcn_fence(__ATOMIC_ACQUIRE, "agent");
            asm volatile("s_waitcnt vmcnt(0)" ::: "memory");
        }
    }
    __syncthreads();
}

struct Params {
    const float* in[18];
    float* out;
    unsigned char* ws;
    int ph_lo, ph_hi;
};

__device__ __forceinline__ void p0_transpose_item(const float* W, const float* g, int K, int N, bf16_t* WT, LAS float* scr, int item, int lane) {
    const int nblk = N / 32, kb = item / nblk, nb = item % nblk, k0 = 64 * kb, n0 = 32 * nb;
    float wv[32];
#pragma unroll
    for (int i = 0; i < 32; ++i) { const int kk = 2 * i + (lane >> 5); wv[i] = __builtin_nontemporal_load(W + (size_t)(k0 + kk) * N + n0 + (lane & 31)); }
#pragma unroll
    for (int i = 0; i < 32; ++i) { const int kk = 2 * i + (lane >> 5); const float gv = g ? g[k0 + kk] : 1.f; scr[kk * 33 + (lane & 31)] = wv[i] * gv; }
    LDS_WAIT(); asm volatile("" ::: "memory");
    const int c = lane & 7;
#pragma unroll
    for (int j = 0; j < 4; ++j) { const int n = (lane >> 3) + 8 * j; const LAS float* s = scr + (8 * c) * 33 + n;
        u32x4 o; o.x = pk2(s[0 * 33], s[1 * 33]); o.y = pk2(s[2 * 33], s[3 * 33]); o.z = pk2(s[4 * 33], s[5 * 33]); o.w = pk2(s[6 * 33], s[7 * 33]);
        *(u32x4*)(WT + (size_t)(n0 + n) * K + k0 + 8 * c) = o; }
    LDS_WAIT(); asm volatile("" ::: "memory");
}
__device__ __forceinline__ float row_to_bf16(const float* src, const float* g, bf16_t* dst, int lane) {
    float ss = 0.f;
#pragma unroll
    for (int i = 0; i < 8; ++i) {
        const int c = (i * 64 + lane) * 4;
        f32x4 v = *(const f32x4*)(src + c);
        ss += (v[0] * v[0] + v[1] * v[1]) + (v[2] * v[2] + v[3] * v[3]);
        if (g) { const f32x4 gv = *(const f32x4*)(g + c); v = v * gv; }
        u32x2 w; w.x = pk2(v[0], v[1]); w.y = pk2(v[2], v[3]);
        *(u32x2*)(dst + c) = w;
    }
    return ss;
}
constexpr float PEER_USC = 80.0f, PEER_VSC = 5.0f;
constexpr int PEER_ROWB = 1536;
typedef float f32x16v __attribute__((ext_vector_type(16)));
typedef float f32x32v __attribute__((ext_vector_type(32)));
typedef unsigned u32x6 __attribute__((ext_vector_type(6)));
typedef unsigned u32x2a4 __attribute__((ext_vector_type(2), aligned(4)));
template <bool CONTIG>
__device__ __forceinline__ void fp6_pack_store(const f32x4 (&x)[8], const f32x4 (&sc)[8], unsigned char* dst, int lane) {
    f32x16v a, b;
#pragma unroll
    for (int i = 0; i < 8; ++i) {
        const f32x4 y = x[i] * sc[i];
#pragma unroll
        for (int q = 0; q < 4; ++q) { const float c = fminf(fmaxf(y[q], -7.5f), 7.5f); const int sl = 4 * i + q; if ((sl & 1) == 0) a[sl >> 1] = c; else b[sl >> 1] = c; }
    }
    const u32x6 pk = __builtin_amdgcn_cvt_scalef32_2xpk16_fp6_f32(a, b, 1.0f);
    asm volatile("s_nop 15" : "+v"(a), "+v"(b));
    if (CONTIG) {
        *(u32x2*)(dst + lane * 24) = (u32x2){pk[0], pk[1]}; *(u32x2*)(dst + lane * 24 + 8) = (u32x2){pk[2], pk[3]}; *(u32x2*)(dst + lane * 24 + 16) = (u32x2){pk[4], pk[5]};
    } else {
        __builtin_nontemporal_store((u32x4){pk[0], pk[1], pk[2], pk[3]}, (u32x4*)(dst + lane * 16));
        __builtin_nontemporal_store((u32x2){pk[4], pk[5]}, (u32x2*)(dst + 1024 + lane * 8));
    }
}
__device__ __forceinline__ void fp6_pack_store_s(const f32x4 (&x)[8], float scale, unsigned char* dst, int lane) {
    f32x16v a, b;
#pragma unroll
    for (int i = 0; i < 8; ++i) {
        const f32x4 y = x[i] * scale;
#pragma unroll
        for (int q = 0; q < 4; ++q) { const float c = fminf(fmaxf(y[q], -7.5f), 7.5f); const int sl = 4 * i + q; if ((sl & 1) == 0) a[sl >> 1] = c; else b[sl >> 1] = c; }
    }
    const u32x6 pk = __builtin_amdgcn_cvt_scalef32_2xpk16_fp6_f32(a, b, 1.0f);
    asm volatile("s_nop 15" : "+v"(a), "+v"(b));
    __builtin_nontemporal_store((u32x4){pk[0], pk[1], pk[2], pk[3]}, (u32x4*)(dst + lane * 16));
    __builtin_nontemporal_store((u32x2){pk[4], pk[5]}, (u32x2*)(dst + 1024 + lane * 8));
}
template <bool CONTIG>
__device__ __forceinline__ void rows2_to_fp6(const float* s0, const float* s1, const f32x4 (&sc)[8], unsigned char* d0, unsigned char* d1, int lane) {
    f32x4 x0[8], x1[8];
#pragma unroll
    for (int i = 0; i < 8; ++i) { x0[i] = __builtin_nontemporal_load((const f32x4*)(s0 + (i * 64 + lane) * 4)); x1[i] = __builtin_nontemporal_load((const f32x4*)(s1 + (i * 64 + lane) * 4)); }
    fp6_pack_store<CONTIG>(x0, sc, d0, lane); fp6_pack_store<CONTIG>(x1, sc, d1, lane);
}
__device__ __forceinline__ bf16x8 cvt8(const float* p) {
    const f32x4 a = *(const f32x4*)p, b = *(const f32x4*)(p + 4);
    u32x4 w; w.x = pk2(a[0], a[1]); w.y = pk2(a[2], a[3]); w.z = pk2(b[0], b[1]); w.w = pk2(b[2], b[3]);
    return __builtin_bit_cast(bf16x8, w);
}

__device__ __forceinline__ void prep_late(const Params& p, LAS unsigned char* lds, int gw, int NGW, int wave, int lane) {
    unsigned char* ws = p.ws;
    LAS float* scr = (LAS float*)(lds + wave * 16384);
    {
        constexpr int I_UQ = (512 / 64) * (1536 / 32), I_UKV = (256 / 64) * (2048 / 32), I_OUT = (DM / 64) * (DM / 32);
        constexpr int NIT = I_UQ + I_UKV + I_OUT;
        for (int it = gw; it < NIT; it += NGW) {
            int r = it;
            if (r < I_UQ) { p0_transpose_item(p.in[7], p.in[6], 512, 1536, (bf16_t*)(ws + WS_WUQ), scr, r, lane); continue; } r -= I_UQ;
            if (r < I_UKV) { p0_transpose_item(p.in[9], p.in[8], 256, 2048, (bf16_t*)(ws + WS_WUKV), scr, r, lane); continue; } r -= I_UKV;
            p0_transpose_item(p.in[12], nullptr, DM, DM, (bf16_t*)(ws + WS_WOUT), scr, r, lane);
        }
    }
    {
        const float* wq = p.in[14]; const float* sk = p.in[15]; const float* g2 = p.in[13];
        bf16_t* WsT = (bf16_t*)(ws + WS_WS);
        const int r32 = lane & 31, hh = lane >> 5;
        for (int it = gw; it < 16 * 4 * 64; it += NGW) {
            const int hp = it >> 8, kb = (it >> 6) & 3, nb = it & 63;
            f32x16 acc = {};
            const float* ap = sk + ((size_t)(hp * 128 + kb * 32 + r32)) * 128 + hh * 8;
            const float* bp = wq + ((size_t)(nb * 32 + r32)) * DM + hp * 128 + hh * 8;
#pragma unroll
            for (int s = 0; s < 8; ++s) {
                const bf16x8 a = cvt8(ap + s * 16), b = cvt8(bp + s * 16);
                acc = __builtin_amdgcn_mfma_f32_32x32x16_bf16(a, b, acc, 0, 0, 0);
            }
            const int kcol = nb * 32 + r32; const float gk = g2[kcol];
#pragma unroll
            for (int r = 0; r < 16; ++r) WsT[(size_t)(hp * 128 + kb * 32 + crow(r, hh)) * DM + kcol] = (bf16_t)f2bf(acc[r] * gk);
        }
    }
    {
        float* ct = (float*)(ws + WS_COS); float* st = (float*)(ws + WS_SIN);
        for (int it = gw; it < S * 32 / 64; it += NGW) {
            const int idx = it * 64 + lane, t = idx >> 5, j = idx & 31;
            const float inv_freq = powf(10000.0f, -(float)j / 32.0f);
            const float ang = (float)t * inv_freq;
            float sv, cv; sincosf(ang, &sv, &cv); ct[idx] = cv; st[idx] = sv;
        }
    }
}
__device__ __forceinline__ void phase0(const Params& p, LAS unsigned char* lds, bool late_ok, int gw, int NGW, int wave, int lane) {
    unsigned char* ws = p.ws;
    LAS float* scr = (LAS float*)(lds + wave * 16384);
    const float* x = p.in[0];
    {
        constexpr int I_IN = (DM / 64) * (NIN / 32);
        for (int it = gw; it < I_IN; it += NGW) p0_transpose_item(p.in[2], p.in[1], DM, NIN, (bf16_t*)(ws + WS_WIN), scr, it, lane);
    }
    if (!late_ok) prep_late(p, lds, gw, NGW, wave, lane);
    for (int r = gw; r < NINP - NIN; r += NGW) {
        bf16_t* d = (bf16_t*)(ws + WS_WIN) + (size_t)(NIN + r) * DM;
#pragma unroll
        for (int i = 0; i < 4; ++i) *(u32x4*)(d + (i * 64 + lane) * 8) = (u32x4){0u, 0u, 0u, 0u};
    }
    {
        bf16_t* xb = (bf16_t*)(ws + WS_XB); float* rstd1 = (float*)(ws + WS_RSTD1);
        for (int t = gw; t + NGW < S; t += 2 * NGW) {
            const int t1 = t + NGW;
            f32x4 a[8], b[8];
#pragma unroll
            for (int i = 0; i < 8; ++i) { a[i] = __builtin_nontemporal_load((const f32x4*)(x + (size_t)t * DM + (i * 64 + lane) * 4)); b[i] = __builtin_nontemporal_load((const f32x4*)(x + (size_t)t1 * DM + (i * 64 + lane) * 4)); }
            float sa = 0.f, sb = 0.f;
#pragma unroll
            for (int i = 0; i < 8; ++i) {
                sa += (a[i][0] * a[i][0] + a[i][1] * a[i][1]) + (a[i][2] * a[i][2] + a[i][3] * a[i][3]);
                sb += (b[i][0] * b[i][0] + b[i][1] * b[i][1]) + (b[i][2] * b[i][2] + b[i][3] * b[i][3]);
                u32x2 wa, wb; wa.x = pk2(a[i][0], a[i][1]); wa.y = pk2(a[i][2], a[i][3]); wb.x = pk2(b[i][0], b[i][1]); wb.y = pk2(b[i][2], b[i][3]);
                *(u32x2*)(xb + (size_t)t * DM + (i * 64 + lane) * 4) = wa; *(u32x2*)(xb + (size_t)t1 * DM + (i * 64 + lane) * 4) = wb;
            }
            sa = wave_sum(sa); sb = wave_sum(sb);
            if (lane == 0) { rstd1[t] = rsqrtf(sa * (1.0f / DM) + EPS); rstd1[t1] = rsqrtf(sb * (1.0f / DM) + EPS); }
        }
    }
    if (!late_ok) {
        f32x4 sc[8];
#pragma unroll
        for (int i = 0; i < 8; ++i) sc[i] = *(const f32x4*)(p.in[13] + (i * 64 + lane) * 4) * PEER_USC;
        for (int e = gw; e < 16384; e += NGW) { f32x4 xv[8];
#pragma unroll
            for (int i = 0; i < 8; ++i) xv[i] = __builtin_nontemporal_load((const f32x4*)(p.in[16] + (size_t)e * DM + (i * 64 + lane) * 4));
            fp6_pack_store<false>(xv, sc, ws + WS_UT + (size_t)e * PEER_ROWB, lane); }
        for (int e = gw; e < 16384; e += NGW) { f32x4 xv[8];
#pragma unroll
            for (int i = 0; i < 8; ++i) xv[i] = __builtin_nontemporal_load((const f32x4*)(p.in[17] + (size_t)e * DM + (i * 64 + lane) * 4));
            fp6_pack_store_s(xv, PEER_VSC, ws + WS_VT + (size_t)e * PEER_ROWB, lane); }
    }
}

__device__ __forceinline__ float half_sum(float v) {
    v += dpp_f<0xB1, 0xf>(0.f, v); v += dpp_f<0x4E, 0xf>(0.f, v); v += dpp_f<0x141, 0xf>(0.f, v); v += dpp_f<0x140, 0xf>(0.f, v);
    return v + __shfl_xor(v, 16);
}
__device__ __forceinline__ void phase3(const Params& p, int tfirst, int tstep, int tcnt, int lane) {
    unsigned char* ws = p.ws;
    const bf16_t* qraw = (const bf16_t*)(ws + WS_QRAW); const bf16_t* kvraw = (const bf16_t*)(ws + WS_KVRAW); const bf16_t* proj = (const bf16_t*)(ws + WS_PROJ);
    bf16_t* Qh = (bf16_t*)(ws + WS_QH); bf16_t* Kh = (bf16_t*)(ws + WS_KH);
    const float* ct = (const float*)(ws + WS_COS); const float* st = (const float*)(ws + WS_SIN);
    const int sub = lane & 31, hsel = lane >> 5;
    const bool act = sub < 24, isrope = sub >= 16 && sub < 24, lowhalf = sub < 20;
    const int e0 = act ? 8 * sub : 0;
    f32x4 gq[2], gk[2];
#pragma unroll
    for (int c = 0; c < 2; ++c) { gq[c] = *(const f32x4*)(p.in[10] + e0 + 4 * c); gk[c] = *(const f32x4*)(p.in[11] + e0 + 4 * c); }
    const int j0 = isrope ? ((8 * sub - 128) & 31) : 0;
    constexpr float QS = 0.07216878364870322f * 1.4426950408889634f;
    for (int ti = 0; ti < tcnt; ++ti) {
        const int t = tfirst + ti * tstep;
        f32x4 cs[2] = {{1.f, 1.f, 1.f, 1.f}, {1.f, 1.f, 1.f, 1.f}}, sn[2] = {{0.f, 0.f, 0.f, 0.f}, {0.f, 0.f, 0.f, 0.f}};
        u32x4 krw = {0u, 0u, 0u, 0u};
        if (isrope) {
#pragma unroll
            for (int c = 0; c < 2; ++c) { cs[c] = *(const f32x4*)(ct + t * 32 + j0 + 4 * c); sn[c] = *(const f32x4*)(st + t * 32 + j0 + 4 * c); }
            krw = *(const u32x4*)(proj + (size_t)t * NINP + 2816 + (8 * sub - 128));
        }
#pragma unroll
        for (int hp = 0; hp < 4; ++hp) {
            const int h = 2 * hp + hsel;
            u32x4 qw = {0u, 0u, 0u, 0u}, kw = {0u, 0u, 0u, 0u};
            if (act) qw = *(const u32x4*)(qraw + (size_t)t * 1536 + h * 192 + e0);
            if (sub < 16) kw = *(const u32x4*)(kvraw + (size_t)t * 2048 + h * 256 + e0);
            if (isrope) kw = krw;
#pragma unroll
            for (int which = 0; which < 2; ++which) {
                const u32x4 w = which ? kw : qw;
                f32x4 x[2] = {{bflo(w[0]), bfhi(w[0]), bflo(w[1]), bfhi(w[1])}, {bflo(w[2]), bfhi(w[2]), bflo(w[3]), bfhi(w[3])}};
                float ss = 0.f;
#pragma unroll
                for (int c = 0; c < 2; ++c) ss += (x[c][0] * x[c][0] + x[c][1] * x[c][1]) + (x[c][2] * x[c][2] + x[c][3] * x[c][3]);
                ss = half_sum(ss);
                const float rs = rsqrtf(ss * (1.0f / 192.0f) + EPS);
#pragma unroll
                for (int c = 0; c < 2; ++c) {
                    x[c] = x[c] * (which ? gk[c] : gq[c]) * rs;
                    f32x4 pr;
#pragma unroll
                    for (int q = 0; q < 4; ++q) pr[q] = __shfl_xor(x[c][q], 4);
                    const f32x4 r1 = x[c] * cs[c] - pr * sn[c], r2 = pr * sn[c] + x[c] * cs[c];
                    if (isrope) x[c] = lowhalf ? r1 : r2;
                    if (!which) x[c] = x[c] * QS;
                }
                if (act) {
                    u32x4 o; o.x = pk2(x[0][0], x[0][1]); o.y = pk2(x[0][2], x[0][3]); o.z = pk2(x[1][0], x[1][1]); o.w = pk2(x[1][2], x[1][3]);
                    *(u32x4*)((which ? Kh : Qh) + ((size_t)h * S + t) * 192 + e0) = o;
                }
            }
        }
    }
}

constexpr int KP = 400, VP = 320;
template <int OFF> __device__ __forceinline__ s16x4 tr_read(unsigned addr) {
    s16x4 r; asm volatile("ds_read_b64_tr_b16 %0, %1 offset:%2" : "=&v"(r) : "v"(addr), "i"(OFF) : "memory"); return r;
}
__device__ __forceinline__ unsigned cvtpk(float lo, float hi) { unsigned r; asm volatile("v_cvt_pk_bf16_f32 %0, %1, %2" : "=v"(r) : "v"(lo), "v"(hi)); return r; }
#define PK8(L, H) ((bf16x8){L[0], L[1], L[2], L[3], H[0], H[1], H[2], H[3]})
constexpr float ATT_THR = 8.0f;

constexpr int ATT_KB = 64 * KP, ATT_VB = 64 * VP;
constexpr int ATT_VOFF = 2 * ATT_KB;
__device__ __forceinline__ float xhalf_max(float v) {
    auto rr = __builtin_amdgcn_permlane32_swap(__builtin_bit_cast(unsigned, v), __builtin_bit_cast(unsigned, v), false, false);
    return fmaxf(__builtin_bit_cast(float, rr[0]), __builtin_bit_cast(float, rr[1]));
}
__device__ __forceinline__ float xhalf_sum(float v) {
    auto rr = __builtin_amdgcn_permlane32_swap(__builtin_bit_cast(unsigned, v), __builtin_bit_cast(unsigned, v), false, false);
    return __builtin_bit_cast(float, rr[0]) + __builtin_bit_cast(float, rr[1]);
}
template <int OFF> __device__ __forceinline__ bf16x8 lds_read128(unsigned addr) {
    bf16x8 r; asm volatile("ds_read_b128 %0, %1 offset:%2" : "=&v"(r) : "v"(addr), "i"(OFF) : "memory"); return r;
}
#define LGKM_WAIT(n) do { asm volatile("s_waitcnt lgkmcnt(" #n ")" ::: "memory"); SBAR(); } while (0)
__device__ __forceinline__ f32x16 att_qk(unsigned kaddr, const bf16x8 (&qr)[12]) {
    f32x16 p = {};
    bf16x8 a0 = lds_read128<0>(kaddr), a1 = lds_read128<32>(kaddr), a2 = lds_read128<64>(kaddr), a3 = lds_read128<96>(kaddr);
    LGKM_WAIT(3); p = __builtin_amdgcn_mfma_f32_32x32x16_bf16(a0, qr[0], p, 0, 0, 0); a0 = lds_read128<128>(kaddr);
    LGKM_WAIT(3); p = __builtin_amdgcn_mfma_f32_32x32x16_bf16(a1, qr[1], p, 0, 0, 0); a1 = lds_read128<160>(kaddr);
    LGKM_WAIT(3); p = __builtin_amdgcn_mfma_f32_32x32x16_bf16(a2, qr[2], p, 0, 0, 0); a2 = lds_read128<192>(kaddr);
    LGKM_WAIT(3); p = __builtin_amdgcn_mfma_f32_32x32x16_bf16(a3, qr[3], p, 0, 0, 0); a3 = lds_read128<224>(kaddr);
    LGKM_WAIT(3); p = __builtin_amdgcn_mfma_f32_32x32x16_bf16(a0, qr[4], p, 0, 0, 0); a0 = lds_read128<256>(kaddr);
    LGKM_WAIT(3); p = __builtin_amdgcn_mfma_f32_32x32x16_bf16(a1, qr[5], p, 0, 0, 0); a1 = lds_read128<288>(kaddr);
    LGKM_WAIT(3); p = __builtin_amdgcn_mfma_f32_32x32x16_bf16(a2, qr[6], p, 0, 0, 0); a2 = lds_read128<320>(kaddr);
    LGKM_WAIT(3); p = __builtin_amdgcn_mfma_f32_32x32x16_bf16(a3, qr[7], p, 0, 0, 0); a3 = lds_read128<352>(kaddr);
    LGKM_WAIT(3); p = __builtin_amdgcn_mfma_f32_32x32x16_bf16(a0, qr[8], p, 0, 0, 0);
    LGKM_WAIT(2); p = __builtin_amdgcn_mfma_f32_32x32x16_bf16(a1, qr[9], p, 0, 0, 0);
    LGKM_WAIT(1); p = __builtin_amdgcn_mfma_f32_32x32x16_bf16(a2, qr[10], p, 0, 0, 0);
    LGKM_WAIT(0); p = __builtin_amdgcn_mfma_f32_32x32x16_bf16(a3, qr[11], p, 0, 0, 0);
    return p;
}
__device__ __forceinline__ void att_finish(f32x16& s, float m, float& lsum, bf16x8& pb0, bf16x8& pb1) {
    float ps = 0.f;
#pragma unroll
    for (int r = 0; r < 16; ++r) { s[r] = __builtin_amdgcn_exp2f(s[r] - m); ps += s[r]; }
    lsum += xhalf_sum(ps);
    u32x4 w0 = {cvtpk(s[0], s[1]), cvtpk(s[2], s[3]), cvtpk(s[4], s[5]), cvtpk(s[6], s[7])};
    u32x4 w1 = {cvtpk(s[8], s[9]), cvtpk(s[10], s[11]), cvtpk(s[12], s[13]), cvtpk(s[14], s[15])};
    pb0 = __builtin_bit_cast(bf16x8, w0); pb1 = __builtin_bit_cast(bf16x8, w1);
}
__device__ __forceinline__ void att_pv(unsigned vaddr, bf16x8 pb0, bf16x8 pb1, f32x16 (&o)[4]) {
#define VOFF(d0, s, hi) (((16 * (s) + 8 * (hi)) * VP) + 64 * (d0))
    const s16x4 a00l = tr_read<VOFF(0, 0, 0)>(vaddr), a00h = tr_read<VOFF(0, 0, 1)>(vaddr), a01l = tr_read<VOFF(0, 1, 0)>(vaddr), a01h = tr_read<VOFF(0, 1, 1)>(vaddr);
    const s16x4 a10l = tr_read<VOFF(1, 0, 0)>(vaddr), a10h = tr_read<VOFF(1, 0, 1)>(vaddr), a11l = tr_read<VOFF(1, 1, 0)>(vaddr), a11h = tr_read<VOFF(1, 1, 1)>(vaddr);
    LGKM_WAIT(4);
    o[0] = __builtin_amdgcn_mfma_f32_32x32x16_bf16(PK8(a00l, a00h), pb0, o[0], 0, 0, 0); o[0] = __builtin_amdgcn_mfma_f32_32x32x16_bf16(PK8(a01l, a01h), pb1, o[0], 0, 0, 0);
    const s16x4 a20l = tr_read<VOFF(2, 0, 0)>(vaddr), a20h = tr_read<VOFF(2, 0, 1)>(vaddr), a21l = tr_read<VOFF(2, 1, 0)>(vaddr), a21h = tr_read<VOFF(2, 1, 1)>(vaddr);
    LGKM_WAIT(4);
    o[1] = __builtin_amdgcn_mfma_f32_32x32x16_bf16(PK8(a10l, a10h), pb0, o[1], 0, 0, 0); o[1] = __builtin_amdgcn_mfma_f32_32x32x16_bf16(PK8(a11l, a11h), pb1, o[1], 0, 0, 0);
    const s16x4 a30l = tr_read<VOFF(3, 0, 0)>(vaddr), a30h = tr_read<VOFF(3, 0, 1)>(vaddr), a31l = tr_read<VOFF(3, 1, 0)>(vaddr), a31h = tr_read<VOFF(3, 1, 1)>(vaddr);
    LGKM_WAIT(4);
    o[2] = __builtin_amdgcn_mfma_f32_32x32x16_bf16(PK8(a20l, a20h), pb0, o[2], 0, 0, 0); o[2] = __builtin_amdgcn_mfma_f32_32x32x16_bf16(PK8(a21l, a21h), pb1, o[2], 0, 0, 0);
    LGKM_WAIT(0);
    o[3] = __builtin_amdgcn_mfma_f32_32x32x16_bf16(PK8(a30l, a30h), pb0, o[3], 0, 0, 0); o[3] = __builtin_amdgcn_mfma_f32_32x32x16_bf16(PK8(a31l, a31h), pb1, o[3], 0, 0, 0);
#undef VOFF
}
__device__ __forceinline__ void att_partial(const f32x16& s, float& m, float& lsum, f32x16 (&o)[4]) {
    float pmax = s[0];
#pragma unroll
    for (int r = 1; r < 16; ++r) pmax = fmaxf(pmax, s[r]);
    pmax = xhalf_max(pmax);
    if (!__all(pmax - m <= ATT_THR)) {
        const float mn = fmaxf(m, pmax); const float alpha = __builtin_amdgcn_exp2f(m - mn); m = mn; lsum *= alpha;
#pragma unroll
        for (int d = 0; d < 4; ++d)
#pragma unroll
            for (int r = 0; r < 16; ++r) o[d][r] *= alpha;
    }
}

__device__ __forceinline__ void attn_unit(const Params& p, LAS unsigned char* lds, int head, int qb, int tid, int wave, int lane) {
    unsigned char* ws = p.ws;
    const bf16_t* Qh = (const bf16_t*)(ws + WS_QH); const bf16_t* Kh = (const bf16_t*)(ws + WS_KH);
    bf16_t* mix = (bf16_t*)(ws + WS_MIX);
    const int rg = wave & 3, kh = wave >> 2, r32 = lane & 31, hh = lane >> 5;
    const int q0row = qb * 128 + rg * 32;
    bf16x8 qr[12];
    {
        const bf16_t* qp = Qh + ((size_t)head * S + q0row + r32) * 192 + hh * 8;
#pragma unroll
        for (int ks = 0; ks < 12; ++ks) qr[ks] = *(const bf16x8*)(qp + ks * 16);
    }
    const int ntiles = 2 * qb + 2, mylast = 2 * qb + (rg >> 1);
    float m = -1e30f, lsum = 0.f; f32x16 o[4] = {};
    const int srow = tid >> 3, sch = tid & 7;
    const int kg0 = srow * 192 + sch * 8, kl0 = srow * KP + sch * 16, vg0 = srow * 2048 + sch * 8, vl0 = ATT_VOFF + srow * VP + sch * 16;
    const bf16_t* kbase = Kh + (size_t)head * S * 192; const bf16_t* vbase = (const bf16_t*)(ws + WS_KVRAW) + head * 256 + 128;
    u32x4 sk0, sk1, sk2, sv0, sv1;
#define ATT_LOAD(t) do { const bf16_t* kt = kbase + (size_t)(t) * 64 * 192 + kg0; const bf16_t* vt = vbase + (size_t)(t) * 64 * 2048 + vg0; \
        sk0 = *(const u32x4*)(kt); sk1 = *(const u32x4*)(kt + 64); sk2 = *(const u32x4*)(kt + 128); sv0 = *(const u32x4*)(vt); sv1 = *(const u32x4*)(vt + 64); } while (0)
#define ATT_WRITE(kb_, vb_) do { LAS unsigned char* bk = lds + (kb_) * ATT_KB + kl0; LAS unsigned char* bv = lds + (vb_) * ATT_VB + vl0; *(LAS u32x4*)(bk) = sk0; *(LAS u32x4*)(bk + 128) = sk1; *(LAS u32x4*)(bk + 256) = sk2; \
        *(LAS u32x4*)(bv) = sv0; *(LAS u32x4*)(bv + 128) = sv1; } while (0)
    const unsigned ldsbase = (unsigned)(size_t)lds;
    const unsigned kaddr0 = ldsbase + (unsigned)((32 * kh + r32) * KP + hh * 16);
    const unsigned vrel = (unsigned)(ATT_VOFF + (32 * kh + 4 * hh + ((lane & 15) >> 2)) * VP + (16 * ((lane >> 4) & 1) + 4 * (lane & 3)) * 2);
    ATT_LOAD(0); ATT_WRITE(0, 0); __syncthreads();
    bf16x8 pb0, pb1;
    const bool more0 = (1 < ntiles);
    if (more0) ATT_LOAD(1);
    f32x16 sprev = att_qk(kaddr0, qr);
    att_partial(sprev, m, lsum, o);
    if (more0) ATT_WRITE(1, 1);
    __syncthreads();
    int vprev = 0, vcur = 1;
#pragma unroll 1
    for (int t = 1; t <= ntiles; ++t) {
        const bool more = (t + 1 < ntiles);
        if (more) ATT_LOAD(t + 1);
        f32x16 sc;
        if (t <= mylast) sc = att_qk(kaddr0 + (t & 1) * ATT_KB, qr);
        else {
#pragma unroll
            for (int r = 0; r < 16; ++r) sc[r] = -1e30f;
        }
        att_finish(sprev, m, lsum, pb0, pb1);
        att_pv(ldsbase + vprev * ATT_VB + vrel, pb0, pb1, o);
        att_partial(sc, m, lsum, o);
        sprev = sc;
        const int vnext = (vcur == 2) ? 0 : vcur + 1;
        if (more) ATT_WRITE((t + 1) & 1, vnext);
        vprev = vcur; vcur = vnext;
        __syncthreads();
    }
#undef ATT_LOAD
#undef ATT_WRITE
    LAS float* scr = (LAS float*)lds + (size_t)rg * 66 * 64 + lane;
    if (kh == 1) {
        scr[0] = m; scr[64] = lsum;
#pragma unroll
        for (int d = 0; d < 4; ++d)
#pragma unroll
            for (int r = 0; r < 16; ++r) scr[(2 + d * 16 + r) * 64] = o[d][r];
    }
    __syncthreads();
    if (kh == 0) {
        const float m2 = scr[0], l2 = scr[64];
        const float mn = fmaxf(m, m2), a1 = __builtin_amdgcn_exp2f(m - mn), a2 = __builtin_amdgcn_exp2f(m2 - mn);
        const float inv = 1.0f / (lsum * a1 + l2 * a2);
        bf16_t* op = mix + (size_t)(q0row + r32) * DM + 1024 + head * 128 + 4 * hh;
#pragma unroll
        for (int d = 0; d < 4; ++d)
#pragma unroll
            for (int g4 = 0; g4 < 4; ++g4) {
                float v[4];
#pragma unroll
                for (int i = 0; i < 4; ++i) { const int r = 4 * g4 + i; v[i] = (o[d][r] * a1 + scr[(2 + d * 16 + r) * 64] * a2) * inv; }
                u32x2 w; w.x = pk2(v[0], v[1]); w.y = pk2(v[2], v[3]);
                *(u32x2*)(op + 32 * d + 8 * g4) = w;
            }
    }
    __syncthreads();
}

__device__ __forceinline__ void gmlp_unit(const Params& p, LAS unsigned char* lds, int nb, int h, int tid, int wave, int lane) {
    unsigned char* ws = p.ws;
    const bf16_t* proj = (const bf16_t*)(ws + WS_PROJ); bf16_t* mix = (bf16_t*)(ws + WS_MIX);
    const float* ssv = (const float*)(ws + WS_ROWSS);
    const float* vg = p.in[3]; const float* wsp = p.in[4]; const float* bs = p.in[5];
#pragma unroll
    for (int i = 0; i < 4; ++i) {
        const int pc = tid + 512 * i, r = pc >> 4, c = pc & 15, t = nb * 128 + r;
        const u32x4 w = *(const u32x4*)(proj + (size_t)t * NINP + 1024 + h * 128 + c * 8);
        const float rs = rsqrtf(ssv[t] * (1.0f / 1024.0f) + EPS);
        const f32x4 g0 = *(const f32x4*)(vg + h * 128 + c * 8), g1 = *(const f32x4*)(vg + h * 128 + c * 8 + 4);
        u32x4 ov;
        ov.x = pk2(bflo(w.x) * rs * g0[0], bfhi(w.x) * rs * g0[1]); ov.y = pk2(bflo(w.y) * rs * g0[2], bfhi(w.y) * rs * g0[3]);
        ov.z = pk2(bflo(w.z) * rs * g1[0], bfhi(w.z) * rs * g1[1]); ov.w = pk2(bflo(w.w) * rs * g1[2], bfhi(w.w) * rs * g1[3]);
        *(LAS u32x4*)(lds + r * VP + c * 16) = ov;
    }
    __syncthreads();
    const int ib = wave & 3, ch = wave >> 2, r32 = lane & 31, hh = lane >> 5;
    const int irow = 32 * ib + r32;
    f32x16 acc0 = {}, acc1 = {};
    const unsigned vaddr = (unsigned)(size_t)lds + (unsigned)((8 * hh + ((lane & 15) >> 2)) * VP + (64 * ch + 16 * ((lane >> 4) & 1) + 4 * (lane & 3)) * 2);
    const float* wrow = wsp + ((size_t)h * 128 + irow) * 128 + hh * 8;
#define GSTEP(s) do { if ((s) < 2 * (ib + 1)) { \
        const f32x4 wa = *(const f32x4*)(wrow + (s) * 16), wb = *(const f32x4*)(wrow + (s) * 16 + 4); const int j0 = (s) * 16 + hh * 8; \
        u32x4 aw; aw.x = pk2(j0 + 0 <= irow ? wa[0] : 0.f, j0 + 1 <= irow ? wa[1] : 0.f); aw.y = pk2(j0 + 2 <= irow ? wa[2] : 0.f, j0 + 3 <= irow ? wa[3] : 0.f); \
        aw.z = pk2(j0 + 4 <= irow ? wb[0] : 0.f, j0 + 5 <= irow ? wb[1] : 0.f); aw.w = pk2(j0 + 6 <= irow ? wb[2] : 0.f, j0 + 7 <= irow ? wb[3] : 0.f); \
        const bf16x8 af = __builtin_bit_cast(bf16x8, aw); \
        const s16x4 b0l = tr_read<(16 * (s)) * VP>(vaddr), b0h = tr_read<(16 * (s) + 4) * VP>(vaddr), b1l = tr_read<(16 * (s)) * VP + 64>(vaddr), b1h = tr_read<(16 * (s) + 4) * VP + 64>(vaddr); \
        LDS_WAIT(); SBAR(); \
        acc0 = __builtin_amdgcn_mfma_f32_32x32x16_bf16(af, PK8(b0l, b0h), acc0, 0, 0, 0); acc1 = __builtin_amdgcn_mfma_f32_32x32x16_bf16(af, PK8(b1l, b1h), acc1, 0, 0, 0); } } while (0)
    GSTEP(0); GSTEP(1); GSTEP(2); GSTEP(3); GSTEP(4); GSTEP(5); GSTEP(6); GSTEP(7);
#undef GSTEP
#pragma unroll
    for (int r = 0; r < 16; ++r) {
        const int i = 32 * ib + crow(r, hh), t = nb * 128 + i; const float b = bs[h * 128 + i];
        const int c0 = h * 128 + 64 * ch + r32;
        const float u0 = bf2f(proj[(size_t)t * NINP + c0]), u1 = bf2f(proj[(size_t)t * NINP + c0 + 32]);
        mix[(size_t)t * DM + c0] = (bf16_t)f2bf(u0 * (acc0[r] + b)); mix[(size_t)t * DM + c0 + 32] = (bf16_t)f2bf(u1 * (acc1[r] + b));
    }
    __syncthreads();
}

__device__ __forceinline__ void phase7(const Params& p, LAS unsigned char* lds, int gw, int NGW, int wave, int lane, bool conv_u) {
    unsigned char* ws = p.ws;
    const float* sc = (const float*)(ws + WS_SC); int* ex = (int*)(ws + WS_EXP); float* gt = (float*)(ws + WS_GATE);
    const float NEG = -3.0e38f;
    LAS float* sl = (LAS float*)(lds + wave * 1024);
    const int j8 = lane & 7, g8 = lane >> 3, row = lane >> 4, i16 = lane & 15;
    int ci[4], cj[4]; bool cval[4];
    {
        constexpr int starts[16] = {0, 16, 24, 29, 33, 36, 38, 40, 42, 43, 44, 45, 46, 47, 48, 49};
#pragma unroll
        for (int m = 0; m < 4; ++m) {
            const int c = i16 + 16 * m; int a = 0, st = 0;
#pragma unroll
            for (int i = 1; i < 16; ++i) if (c >= starts[i]) { a = i; st = starts[i]; }
            cval[m] = c < 50; ci[m] = cval[m] ? a : 0; cj[m] = cval[m] ? (c - st) : 0;
        }
    }
    f32x4 nx0, nx1, nx2, nx3;
    if (gw < S / 4) { const float* b = sc + (size_t)(gw * 4) * DM + lane * 16; nx0 = *(const f32x4*)b; nx1 = *(const f32x4*)(b + 4); nx2 = *(const f32x4*)(b + 8); nx3 = *(const f32x4*)(b + 12); }
    f32x4 ux0[8], ux1[8];
    for (int tb = gw; tb < S / 4; tb += NGW)
#pragma unroll 1
    for (int n8 = 0; n8 < 8; ++n8) {
        const int it = tb * 8 + n8;
        const int t = it >> 1, hh = it & 1;
        if (conv_u && !(n8 & 1)) {
            const float* s0 = p.in[16] + (size_t)it * DM; const float* s1 = s0 + DM;
#pragma unroll
            for (int i = 0; i < 8; ++i) { ux0[i] = __builtin_nontemporal_load((const f32x4*)(s0 + (i * 64 + lane) * 4)); ux1[i] = __builtin_nontemporal_load((const f32x4*)(s1 + (i * 64 + lane) * 4)); }
            __builtin_amdgcn_sched_barrier(0);
        }
        float v[16];
#pragma unroll
        for (int q = 0; q < 4; ++q) { v[q] = nx0[q]; v[4 + q] = nx1[q]; v[8 + q] = nx2[q]; v[12 + q] = nx3[q]; }
        { const int it2 = n8 < 7 ? it + 1 : (tb + NGW) * 8;
          if (it2 < S * 2) { const float* b = sc + (size_t)(it2 >> 1) * DM + (it2 & 1) * 1024 + lane * 16;
            nx0 = *(const f32x4*)b; nx1 = *(const f32x4*)(b + 4); nx2 = *(const f32x4*)(b + 8); nx3 = *(const f32x4*)(b + 12); } }
#pragma unroll
        for (int m = 0; m < 16; ++m) v[m] = __builtin_bit_cast(float, (__builtin_bit_cast(unsigned, v[m]) & ~127u) | (unsigned)(16 * j8 + m));
#define P7_CE(A, B) do { const float hi_ = fmaxf(v[A], v[B]), lo_ = fminf(v[A], v[B]); v[A] = hi_; v[B] = lo_; } while (0)
        P7_CE(0, 13); P7_CE(1, 12); P7_CE(2, 15); P7_CE(3, 14); P7_CE(4, 8); P7_CE(5, 6); P7_CE(7, 11); P7_CE(9, 10);
        P7_CE(0, 5); P7_CE(1, 7); P7_CE(2, 9); P7_CE(3, 4); P7_CE(6, 13); P7_CE(8, 14); P7_CE(10, 15); P7_CE(11, 12);
        P7_CE(0, 1); P7_CE(2, 3); P7_CE(4, 5); P7_CE(6, 8); P7_CE(7, 9); P7_CE(10, 11); P7_CE(12, 13); P7_CE(14, 15);
        P7_CE(0, 2); P7_CE(1, 3); P7_CE(4, 10); P7_CE(5, 11); P7_CE(6, 7); P7_CE(8, 9); P7_CE(12, 14); P7_CE(13, 15);
        P7_CE(1, 2); P7_CE(3, 12); P7_CE(4, 6); P7_CE(5, 7); P7_CE(8, 10); P7_CE(9, 11); P7_CE(13, 14);
        P7_CE(1, 4); P7_CE(2, 6); P7_CE(5, 8); P7_CE(7, 10); P7_CE(9, 13); P7_CE(11, 14);
        P7_CE(2, 4); P7_CE(3, 6); P7_CE(9, 12); P7_CE(11, 13);
        P7_CE(3, 5); P7_CE(6, 8); P7_CE(7, 9); P7_CE(10, 12);
        P7_CE(3, 4); P7_CE(5, 6); P7_CE(7, 8); P7_CE(9, 10); P7_CE(11, 12);
        P7_CE(6, 7); P7_CE(8, 9);
#define P7_MERGE(CTRL) do { float t_[16]; \
            _Pragma("unroll") for (int i = 0; i < 16; ++i) t_[i] = fmaxf(v[i], dpp_f<CTRL, 0xf>(v[15 - i], v[15 - i])); \
            _Pragma("unroll") for (int i = 0; i < 16; ++i) v[i] = t_[i]; \
            _Pragma("unroll") for (int j = 8; j >= 1; j >>= 1) _Pragma("unroll") for (int i = 0; i < 16; ++i) if ((i & j) == 0) P7_CE(i, i + j); } while (0)
        P7_MERGE(0xB1); P7_MERGE(0x4E); P7_MERGE(0x141);
#undef P7_MERGE
#undef P7_CE
        if (j8 == 0) {
#pragma unroll
            for (int q = 0; q < 4; ++q) *(LAS f32x4*)(sl + g8 * 16 + 4 * q) = (f32x4){v[4 * q], v[4 * q + 1], v[4 * q + 2], v[4 * q + 3]};
        }
        LDS_WAIT(); asm volatile("" ::: "memory");
        float cv[4], og[4]; int id[4];
#pragma unroll
        for (int m = 0; m < 4; ++m) {
            const float s1 = sl[(2 * row) * 16 + ci[m]], s2 = sl[(2 * row + 1) * 16 + cj[m]];
            og[m] = cval[m] ? (s1 + s2) : NEG; cv[m] = og[m];
            id[m] = (int)((__builtin_bit_cast(unsigned, s1) & 127u) * 128u + (__builtin_bit_cast(unsigned, s2) & 127u));
        }
        LDS_WAIT(); asm volatile("" ::: "memory");
        float M0 = 0.f;
#pragma unroll
        for (int k = 0; k < 16; ++k) {
            float mx = fmaxf(fmaxf(cv[0], cv[1]), fmaxf(cv[2], cv[3]));
            mx = fmaxf(mx, dpp_f<0xB1, 0xf>(mx, mx));
            mx = fmaxf(mx, dpp_f<0x4E, 0xf>(mx, mx));
            mx = fmaxf(mx, dpp_f<0x141, 0xf>(mx, mx));
            mx = fmaxf(mx, dpp_f<0x140, 0xf>(mx, mx));
            if (k == 0) M0 = mx;
#pragma unroll
            for (int m = 0; m < 4; ++m) cv[m] = (cv[m] == mx) ? NEG : cv[m];
        }
        bool sel[4]; float e[4]; float es = 0.f;
#pragma unroll
        for (int m = 0; m < 4; ++m) { sel[m] = (cv[m] != og[m]); e[m] = sel[m] ? __expf(og[m] - M0) : 0.f; es += e[m]; }
        es += dpp_f<0xB1, 0xf>(0.f, es); es += dpp_f<0x4E, 0xf>(0.f, es); es += dpp_f<0x141, 0xf>(0.f, es); es += dpp_f<0x140, 0xf>(0.f, es);
        const float inv = 1.0f / es;
        int basepos = 0;
        const int head = 4 * hh + row;
#pragma unroll
        for (int m = 0; m < 4; ++m) {
            const unsigned long long bl = __ballot(sel[m]);
            const unsigned rbits = (unsigned)(bl >> (16 * row)) & 0xffffu;
            const int pos = basepos + __popc(rbits & ((1u << i16) - 1u));
            if (sel[m] && pos < 16) { ex[(size_t)t * 128 + head * 16 + pos] = id[m]; gt[(size_t)t * 128 + head * 16 + pos] = e[m] * inv; }
            basepos += __popc(rbits);
        }
        if (conv_u && (n8 & 1)) {
            f32x4 usc[8];
#pragma unroll
            for (int i = 0; i < 8; ++i) usc[i] = *(const f32x4*)(p.in[13] + (i * 64 + lane) * 4) * PEER_USC;
            unsigned char* d0 = ws + WS_UT + (size_t)(it - 1) * PEER_ROWB;
            fp6_pack_store<false>(ux0, usc, d0, lane); fp6_pack_store<false>(ux1, usc, d0 + PEER_ROWB, lane);
        }
    }
}

typedef __bf16 bf16x32v __attribute__((ext_vector_type(32)));
typedef __bf16 bf16x2v __attribute__((ext_vector_type(2)));
typedef float f32x2 __attribute__((ext_vector_type(2)));
#ifndef P8_THROTTLE
#define P8_THROTTLE 0
#endif
constexpr unsigned P8_SLACK = 12;
#ifndef P8_SWEEPSYNC
#define P8_SWEEPSYNC 1
#endif
#ifndef P8_MIDSYNC
#define P8_MIDSYNC 2
#endif
__device__ __forceinline__ void phase8(const Params& p, LAS unsigned char* lds, float* dst, const XcdBarrier& xb, int gw, int NGW, int wave, int lane) {
    unsigned char* ws = p.ws;
    const bf16_t* x1b = (const bf16_t*)(ws + WS_X1B); const unsigned char* UT = ws + WS_UT; const unsigned char* VT = ws + WS_VT;
    const int* ex = (const int*)(ws + WS_EXP); const float* gt = (const float*)(ws + WS_GATE); const float* ss2 = (const float*)(ws + WS_ROWSS) + 3 * S;
    const float* out = p.out;
    LAS unsigned* list = (LAS unsigned*)(lds + 131072 + wave * 2048);
    LAS unsigned* hist = (LAS unsigned*)(lds + 147456 + wave * 1024);
    for (int tb = gw; tb < S / 4; tb += NGW) {
        const int t0 = tb * 4;
        int id[8]; float gv[8];
#pragma unroll
        for (int r = 0; r < 8; ++r) { const size_t o = (size_t)(t0 + (r >> 1)) * 128 + (r & 1) * 64 + lane; id[r] = ex[o]; gv[r] = gt[o]; }
        const float rs0 = rsqrtf(ss2[t0 + 0] * (1.0f / DM) + EPS) * (1.0f / PEER_USC), rs1 = rsqrtf(ss2[t0 + 1] * (1.0f / DM) + EPS) * (1.0f / PEER_USC);
        const float rs2 = rsqrtf(ss2[t0 + 2] * (1.0f / DM) + EPS) * (1.0f / PEER_USC), rs3 = rsqrtf(ss2[t0 + 3] * (1.0f / DM) + EPS) * (1.0f / PEER_USC);
#pragma unroll
        for (int j = 0; j < 4; ++j) hist[j * 64 + lane] = 0u;
        LDS_WAIT(); asm volatile("" ::: "memory");
        unsigned pos[8];
#pragma unroll
        for (int r = 0; r < 8; ++r) pos[r] = __hip_atomic_fetch_add(hist + (r >> 1) * 64 + (id[r] >> 8), 1u, __ATOMIC_RELAXED, __HIP_MEMORY_SCOPE_WORKGROUP);
        LDS_WAIT(); asm volatile("" ::: "memory");
        unsigned cnt[4], inc[4];
#pragma unroll
        for (int j = 0; j < 4; ++j) { cnt[j] = hist[j * 64 + lane]; inc[j] = cnt[j]; }
#pragma unroll
        for (int o = 1; o < 64; o <<= 1)
#pragma unroll
            for (int j = 0; j < 4; ++j) { const unsigned n = __shfl_up(inc[j], o); if (lane >= o) inc[j] += n; }
        LDS_WAIT(); asm volatile("" ::: "memory");
#pragma unroll
        for (int j = 0; j < 4; ++j) hist[j * 64 + lane] = inc[j] - cnt[j];
        LDS_WAIT(); asm volatile("" ::: "memory");
#pragma unroll
        for (int r = 0; r < 8; ++r) { const unsigned d = hist[(r >> 1) * 64 + (id[r] >> 8)] + pos[r]; list[4u * d + (unsigned)(r >> 1)] = (unsigned)id[r] | ((unsigned)(r >> 1) << 14) | (f2bf(gv[r]) << 16); }
        LDS_WAIT(); asm volatile("" ::: "memory");
        {
            typedef unsigned u32x16 __attribute__((ext_vector_type(16)));
            const __amdgpu_buffer_rsrc_t urs = __builtin_amdgcn_make_buffer_rsrc((void*)UT, 0, 16384 * PEER_ROWB, 0x00020000);
            const int vo4 = lane * 16, vo2 = lane * 8 + 1024;
            const bool lb0 = (lane & 1) != 0, lb1 = (lane & 2) != 0, lb2 = (lane & 4) != 0;
            s16x4 xr[4][8];
#pragma unroll
            for (int j = 0; j < 4; ++j)
#pragma unroll
                for (int q = 0; q < 8; ++q) xr[j][q] = __builtin_bit_cast(s16x4, *(const u32x2*)(x1b + (size_t)(t0 + j) * DM + (q * 64 + lane) * 4));
#define P8_ULOAD(k, i) do { const unsigned en = (unsigned)__builtin_amdgcn_readfirstlane((int)list[(i)]); const int ro = (int)((en & 0x3fffu) * (unsigned)PEER_ROWB); \
            u4[k] = __builtin_amdgcn_raw_buffer_load_b128(urs, vo4, ro, 0); u2[k] = __builtin_amdgcn_raw_buffer_load_b64(urs, vo2, ro, 0); } while (0)
#define P8_UPROC2(k, dk) do { const u32x6 pk = {u4[k][0], u4[k][1], u4[k][2], u4[k][3], u2[k][0], u2[k][1]}; \
            const u32x16 r_ = __builtin_bit_cast(u32x16, __builtin_amdgcn_cvt_scalef32_pk32_bf16_fp6(pk, 1.0f)); \
            f32x4 a0 = {0.f, 0.f, 0.f, 0.f}, a1 = {0.f, 0.f, 0.f, 0.f}; \
            _Pragma("unroll") for (int q = 0; q < 8; q += 2) { \
                a0 = __builtin_amdgcn_mfma_f32_4x4x4bf16_1k(__builtin_bit_cast(s16x4, (u32x2){r_[2 * q], r_[2 * q + 1]}), xr[(k) & 3][q], a0, 0, 0, 0); \
                a1 = __builtin_amdgcn_mfma_f32_4x4x4bf16_1k(__builtin_bit_cast(s16x4, (u32x2){r_[2 * q + 2], r_[2 * q + 3]}), xr[(k) & 3][q + 1], a1, 0, 0, 0); } \
            const f32x4 a_ = a0 + a1; \
            const float e0 = lb0 ? a_[1] : a_[0], e1 = lb0 ? a_[3] : a_[2]; dd[dk] = lb1 ? e1 : e0; } while (0)
#ifndef P8_URING
#define P8_URING 8
#endif
#if (PROBE_DUP >> 10) & 1
#define P8_UREPS 2
#else
#define P8_UREPS 1
#endif
#pragma unroll 1
            for (int urep = 0; urep < P8_UREPS; ++urep) {
                u32x4 u4[P8_URING]; u32x2 u2[P8_URING];
#pragma unroll
                for (int k = 0; k < P8_URING; ++k) P8_ULOAD(k, k);
                f32x4 vx[8];
#pragma unroll 1
                for (int i0 = 0; i0 < 512; i0 += P8_URING) {
                    if (P8_SWEEPSYNC && i0 == 256 && NGW == S / 4) xcd_local_barrier(xb);
                    if (urep == P8_UREPS - 1 && NGW == S / 4) {
                        if ((i0 & 63) == 0) {
                            const float* s0 = p.in[17] + (size_t)(tb * 8 + (i0 >> 6)) * DM;
#pragma unroll
                            for (int i = 0; i < 8; ++i) vx[i] = __builtin_nontemporal_load((const f32x4*)(s0 + (i * 64 + lane) * 4));
                        } else if ((i0 & 63) == 32) fp6_pack_store_s(vx, PEER_VSC, ws + WS_VT + (size_t)(tb * 8 + (i0 >> 6)) * PEER_ROWB, lane);
                    }
#pragma unroll
                    for (int hb = 0; hb < P8_URING / 8; ++hb) {
                        const int i = i0 + 8 * hb;
                        const unsigned ev = list[i + (lane & 7)]; const unsigned jl = (unsigned)lane & 3u;
                        const float gl = __builtin_bit_cast(float, ev & 0xffff0000u), rl = jl == 0u ? rs0 : (jl == 1u ? rs1 : (jl == 2u ? rs2 : rs3));
                        float dd[8];
#pragma unroll
                        for (int k = 0; k < 8; ++k) { P8_UPROC2(8 * hb + k, k); const int nx = i + P8_URING + k; P8_ULOAD(8 * hb + k, nx < 512 ? nx : 508 + (k & 3)); }
                        float w4[4], w2[2];
#pragma unroll
                        for (int q = 0; q < 4; ++q) { const float kp = lb2 ? dd[q + 4] : dd[q], sd = lb2 ? dd[q] : dd[q + 4]; w4[q] = kp + __shfl_xor(sd, 4); }
#pragma unroll
                        for (int q = 0; q < 2; ++q) { const float kp = lb1 ? w4[q + 2] : w4[q], sd = lb1 ? w4[q] : w4[q + 2]; w2[q] = kp + __shfl_xor(sd, 2); }
                        float dres; { const float kp = lb0 ? w2[1] : w2[0], sd = lb0 ? w2[0] : w2[1]; dres = kp + __shfl_xor(sd, 1); }
                        dres += __shfl_xor(dres, 8); dres += __shfl_xor(dres, 16); dres += __shfl_xor(dres, 32);
                        const float c_ = gl * gelu_tanh(rl * dres) * (1.0f / PEER_VSC);
                        if (lane < 8 && urep == P8_UREPS - 1) list[i + lane] = (ev & 0xffffu) | (f2bf(c_) << 16);
                    }
                }
            }
#undef P8_ULOAD
#undef P8_UPROC2
        }
        asm volatile("s_waitcnt vmcnt(0)" ::: "memory");
        LDS_WAIT(); asm volatile("" ::: "memory");
#if P8_MIDSYNC == 1
        __syncthreads();
#elif P8_MIDSYNC == 2
        if (NGW == S / 4) xcd_barrier(xb);
#endif
        f32x4 acc[4][8];
#if (PROBE_DUP >> 12) & 1
#define P8_VREPS 2
#else
#define P8_VREPS 1
#endif
#ifndef P8_VRING
#define P8_VRING 8
#endif
#pragma unroll 1
        for (int vrep = 0; vrep < P8_VREPS; ++vrep) {
#pragma unroll
        for (int j = 0; j < 4; ++j)
#pragma unroll
            for (int q = 0; q < 8; ++q) acc[j][q] = (f32x4){0.f, 0.f, 0.f, 0.f};
        {
            typedef unsigned u32x16 __attribute__((ext_vector_type(16)));
            u32x4 v4[P8_VRING]; u32x2 v2[P8_VRING]; unsigned ven[P8_VRING];
            const unsigned li = (unsigned)lane & 3u;
            const unsigned m0 = li == 0u ? 0x0000ffffu : (li == 1u ? 0xffff0000u : 0u), m1 = li == 2u ? 0x0000ffffu : (li == 3u ? 0xffff0000u : 0u);
            const __amdgpu_buffer_rsrc_t vrs = __builtin_amdgcn_make_buffer_rsrc((void*)VT, 0, 16384 * PEER_ROWB, 0x00020000);
            const int vo4 = lane * 16, vo2 = lane * 8 + 1024;
#define P8_VLOAD(k, i) do { const unsigned en = (unsigned)__builtin_amdgcn_readfirstlane((int)list[(i)]); ven[k] = en; const int ro = (int)((en & 0x3fffu) * (unsigned)PEER_ROWB); \
            v4[k] = __builtin_amdgcn_raw_buffer_load_b128(vrs, vo4, ro, 0); v2[k] = __builtin_amdgcn_raw_buffer_load_b64(vrs, vo2, ro, 0); } while (0)
#define P8_VPROC(k) do { const u32x6 pk = {v4[k][0], v4[k][1], v4[k][2], v4[k][3], v2[k][0], v2[k][1]}; \
            const u32x16 r_ = __builtin_bit_cast(u32x16, __builtin_amdgcn_cvt_scalef32_pk32_bf16_fp6(pk, 1.0f)); \
            const unsigned e_ = ven[k], cf = (e_ >> 16) | (e_ & 0xffff0000u); \
            const s16x4 av = __builtin_bit_cast(s16x4, (u32x2){cf & m0, cf & m1}); \
            _Pragma("unroll") for (int q = 0; q < 8; ++q) \
                acc[(k) & 3][q] = __builtin_amdgcn_mfma_f32_4x4x4bf16_1k(av, __builtin_bit_cast(s16x4, (u32x2){r_[2 * q], r_[2 * q + 1]}), acc[(k) & 3][q], 0, 0, 0); } while (0)
#pragma unroll
            for (int k = 0; k < P8_VRING; ++k) P8_VLOAD(k, k);
#pragma unroll 1
            for (int i = 0; i < 512 - 512 % P8_VRING; i += P8_VRING) {
                if (P8_SWEEPSYNC && i == 256 && NGW == S / 4) xcd_local_barrier(xb);
#pragma unroll
                for (int k = 0; k < P8_VRING; ++k) { P8_VPROC(k); const int nx = i + P8_VRING + k; P8_VLOAD(k, nx < 512 ? nx : 508 + (k & 3)); }
            }
#pragma unroll
            for (int k = 0; k < 512 % P8_VRING; ++k) P8_VPROC(k);
#undef P8_VLOAD
#undef P8_VPROC
        }
        }
        int tq = t0, lq = lane; asm volatile("" : "+s"(tq)); asm volatile("" : "+v"(lq));
#pragma unroll
        for (int j = 0; j < 4; ++j)
#pragma unroll
            for (int i = 0; i < 8; ++i) {
                const size_t o = (size_t)(tq + j) * DM + (i * 64 + lq) * 4;
                const u32x2 xw = *(const u32x2*)(x1b + o);
                f32x4 a = {bflo(xw.x), bfhi(xw.x), bflo(xw.y), bfhi(xw.y)};
                a += acc[j][i];
                __builtin_nontemporal_store(a, (f32x4*)(dst + o));
                if (i & 1) asm volatile("" ::: "memory");
            }
        LDS_WAIT(); asm volatile("" ::: "memory");
    }
}

__global__ void __launch_bounds__(NTHREADS, 2) mega(Params p) {
    extern __shared__ __attribute__((aligned(16))) unsigned char lds_raw[];
    LAS unsigned char* lds = (LAS unsigned char*)lds_raw;
    const int tid = threadIdx.x, lane = tid & 63, wave = __builtin_amdgcn_readfirstlane(tid >> 6);
    const int G = gridDim.x, bx = blockIdx.x;
    const int gw = bx * 8 + wave, NGW = G * 8;
    unsigned char* ws = p.ws;
    const int lo = p.ph_lo, hi = p.ph_hi;
    volatile LAS unsigned* misc = (volatile LAS unsigned*)(lds + LDS_MISC);
    if (tid < 4) misc[tid] = 0u;
    __syncthreads();
    const XcdBarrier xbar = xcd_barrier_post((unsigned*)(ws + WS_CTL), misc);
#ifndef PH_MASK
#define PH_MASK 0x1ff
#endif
#define IN(k) (((PH_MASK >> (k)) & 1) && lo <= (k) && (k) < hi)
#define SEAM(k) do { if (IN(k) && IN((k) + 1)) xcd_barrier(xbar); } while (0)

#if (PROBE_DUP >> 0) & 1
    if (IN(0)) { phase0(p, lds, G == 256, gw, NGW, wave, lane); xcd_barrier(xbar); }
#endif
    if (IN(0)) phase0(p, lds, G == 256, gw, NGW, wave, lane);
    SEAM(0);
    const bool part = (G == 256) && (misc[2] != 0u);
    const int vx = __builtin_amdgcn_readfirstlane(part ? (int)xbar.x : (bx & 7)), vr = __builtin_amdgcn_readfirstlane(part ? (int)misc[3] : (bx >> 3));
    const int vpanel = (vr >> 3) == 0 ? vx : ((vr >> 3) == 1 ? 31 - vx : ((vr >> 3) == 2 ? vx + 8 : 23 - vx));
    const int gwv = (G == 256) ? vpanel * 64 + (vr & 7) * 8 + wave : gw;
#define SEAM_X(k) do { if (IN(k) && IN((k) + 1)) { if (part) xcd_local_barrier_acq(xbar); else xcd_barrier(xbar); } } while (0)
    if (IN(1)) {
        pg8::Gemm g{(const bf16_t*)(ws + WS_XB), (const bf16_t*)(ws + WS_WIN), S, NINP, DM, DM, DM};
        pg8::StaticOrder So; So.init(S, NINP, G, bx);
        pg8::Epi<1> E{(const float*)(ws + WS_RSTD1), 0.f, (float*)(ws + WS_ROWSS), (bf16_t*)(ws + WS_PROJ), NINP, nullptr, nullptr};
#if (PROBE_DUP >> 1) & 1
        { pg8::Epi<1> E2 = E; E2.ss = (float*)(ws + 512 * 1024); pg8::gemm_phase<pg8::Epi<1>, pg8::StaticOrder, true, true>(lds, g, So, E2); xcd_barrier(xbar); }
#endif
        pg8::gemm_phase<pg8::Epi<1>, pg8::StaticOrder, true, true>(lds, g, So, E);
        if (G == 256 && bx >= 128) { __syncthreads(); prep_late(p, lds, (bx - 128) * 8 + wave, 1024, wave, lane); }
    }
    SEAM(1);
    if (IN(2)) {
        {
            pg8::Gemm g{(const bf16_t*)(ws + WS_PROJ) + 2048, (const bf16_t*)(ws + WS_WUQ), S, 1536, 512, NINP, 512};
            pg8::StaticOrder So; So.init(S, 1536, G, bx);
            pg8::Epi<2> E{(const float*)(ws + WS_ROWSS) + 1 * S, 1.0f / 512.0f, nullptr, (bf16_t*)(ws + WS_QRAW), 1536, nullptr, nullptr};
            pg8::gemm_phase<pg8::Epi<2>, pg8::StaticOrder, true, true>(lds, g, So, E);
        }
        __syncthreads();
        {
            pg8::Gemm g{(const bf16_t*)(ws + WS_PROJ) + 2560, (const bf16_t*)(ws + WS_WUKV), S, 2048, 256, NINP, 256};
            pg8::StaticOrder So; So.init(S, 2048, G, bx);
            pg8::Epi<2> E{(const float*)(ws + WS_ROWSS) + 2 * S, 1.0f / 256.0f, nullptr, (bf16_t*)(ws + WS_KVRAW), 2048, nullptr, nullptr};
            pg8::gemm_phase<pg8::Epi<2>, pg8::StaticOrder, true, true>(lds, g, So, E);
        }
    }
    SEAM(2);
#if (PROBE_DUP >> 3) & 1
    if (IN(3)) { phase3(p, gw, NGW, (S - gw + NGW - 1) / NGW, lane); xcd_barrier(xbar); }
#endif
    if (IN(3)) phase3(p, gw, NGW, (S - gw + NGW - 1) / NGW, lane);
    SEAM(3);
    const int vP = (vr >> 4) ? vx + 8 : vx, vqa = ((vr >> 3) & 1) ? 62 - 2 * vP : 63 - 2 * vP, vqb = ((vr >> 3) & 1) ? 2 * vP + 1 : 2 * vP;
#define P4_BODY_ATT do { if (G == 256) { attn_unit(p, lds, vr & 7, vqa, tid, wave, lane); attn_unit(p, lds, vr & 7, vqb, tid, wave, lane); } \
        else for (int pr = bx; pr < 256; pr += G) { const int head = pr & 7, x = pr >> 3; attn_unit(p, lds, head, 63 - x, tid, wave, lane); attn_unit(p, lds, head, x, tid, wave, lane); } } while (0)
#define P4_BODY_GMLP do { if (G == 256) { gmlp_unit(p, lds, vqa, vr & 7, tid, wave, lane); gmlp_unit(p, lds, vqb, vr & 7, tid, wave, lane); } \
        else for (int u = bx; u < 512; u += G) gmlp_unit(p, lds, u >> 3, u & 7, tid, wave, lane); } while (0)
#if (PROBE_DUP >> 4) & 1
    if (IN(4)) { P4_BODY_ATT; xcd_barrier(xbar); }
#endif
#if (PROBE_DUP >> 9) & 1
    if (IN(4)) { P4_BODY_GMLP; xcd_barrier(xbar); }
#endif
    if (IN(4)) { P4_BODY_ATT; P4_BODY_GMLP; }
    SEAM_X(4);
    if (IN(5)) {
        pg8::Gemm g{(const bf16_t*)(ws + WS_MIX), (const bf16_t*)(ws + WS_WOUT), S, DM, DM, DM, DM};
        pg8::StaticOrder So; So.init(S, DM, G, bx); if (G == 256) So.fixed(vpanel, vr & 7);
        pg8::Epi<4> E{nullptr, 0.f, (float*)(ws + WS_ROWSS) + 3 * S, (bf16_t*)(ws + WS_X1B), DM, p.out, (const float*)(ws + WS_XB)};
#if (PROBE_DUP >> 5) & 1
        { pg8::Epi<4> E2 = E; E2.ss = (float*)(ws + 512 * 1024); pg8::gemm_phase<pg8::Epi<4>, pg8::StaticOrder, true, true>(lds, g, So, E2); xcd_barrier(xbar); }
#endif
        pg8::gemm_phase<pg8::Epi<4>, pg8::StaticOrder, true, true>(lds, g, So, E);
    }
    SEAM_X(5);
    if (IN(6)) {
        pg8::Gemm g{(const bf16_t*)(ws + WS_X1B), (const bf16_t*)(ws + WS_WS), S, DM, DM, DM, DM};
        pg8::StaticOrder So; So.init(S, DM, G, bx); if (G == 256) So.fixed(vpanel, vr & 7);
        pg8::Epi<5> E{(const float*)(ws + WS_ROWSS) + 3 * S, 1.0f / DM, nullptr, nullptr, DM, (float*)(ws + WS_SC), nullptr};
#if (PROBE_DUP >> 6) & 1
        { pg8::gemm_phase<pg8::Epi<5>, pg8::StaticOrder, true, true>(lds, g, So, E); xcd_barrier(xbar); }
#endif
        pg8::gemm_phase<pg8::Epi<5>, pg8::StaticOrder, true, true>(lds, g, So, E);
    }
    SEAM_X(6);
#if (PROBE_DUP >> 7) & 1
    if (IN(7)) { phase7(p, lds, gwv, NGW, wave, lane, G == 256); xcd_barrier(xbar); }
#endif
    if (IN(7)) phase7(p, lds, gwv, NGW, wave, lane, G == 256);
    if (IN(7) && IN(8)) xcd_barrier(xbar);
#if (PROBE_DUP >> 8) & 1
    if (IN(8)) { phase8(p, lds, (float*)(ws + WS_SC), xbar, gwv, NGW, wave, lane); xcd_barrier(xbar); }
#endif
    if (IN(8)) phase8(p, lds, p.out, xbar, gwv, NGW, wave, lane);
#undef IN
#undef SEAM
#undef SEAM_X
}

extern "C" void kernel_launch(void* const* d_in, const int* in_sizes, int n_in, void* d_out, int out_size, void* d_ws, size_t ws_size, hipStream_t stream) {
    static int grid = 0;
    if (grid == 0) {
        if (n_in != 18 || out_size != S * DM || ws_size < WS_END) { fprintf(stderr, "kernel_launch: unexpected shapes (n_in %d out %d ws %zu)\n", n_in, out_size, ws_size); grid = -1; return; }
        int dev = 0, cus = 0, per_cu = 0;
        hipGetDevice(&dev);
        hipDeviceGetAttribute(&cus, hipDeviceAttributeMultiprocessorCount, dev);
        if (hipFuncSetAttribute((const void*)mega, hipFuncAttributeMaxDynamicSharedMemorySize, LDS_BYTES) != hipSuccess) { fprintf(stderr, "kernel_launch: hipFuncSetAttribute failed\n"); grid = -1; return; }
        if (hipOccupancyMaxActiveBlocksPerMultiprocessor(&per_cu, (const void*)mega, NTHREADS, LDS_BYTES) != hipSuccess || per_cu < 1) { fprintf(stderr, "kernel_launch: occupancy query failed (%d)\n", per_cu); grid = -1; return; }
        grid = cus;
        fprintf(stderr, "kernel_launch: cus %d per_cu %d grid %d\n", cus, per_cu, grid);
    }
    if (grid < 0) return;
    hipMemsetAsync((char*)d_ws + WS_CTL, 0, 1 * MiB, stream);
    Params prm{};
    for (int i = 0; i < 18; ++i) prm.in[i] = (const float*)d_in[i];
    prm.out = (float*)d_out; prm.ws = (unsigned char*)d_ws;
#if MK_ONE_LAUNCH
    prm.ph_lo = 0; prm.ph_hi = NPH;
    { void* args[] = {&prm}; hipError_t e = hipLaunchCooperativeKernel((const void*)mega, dim3(grid), dim3(NTHREADS), args, LDS_BYTES, stream);
      if (e != hipSuccess) fprintf(stderr, "cooperative launch failed: %s\n", hipGetErrorString(e)); }
#else
    for (int ph = 0; ph < NPH; ++ph) {
        prm.ph_lo = ph; prm.ph_hi = ph + 1;
        void* args[] = {&prm};
        hipError_t e = hipLaunchCooperativeKernel((const void*)mega, dim3(grid), dim3(NTHREADS), args, LDS_BYTES, stream);
        if (e != hipSuccess) { fprintf(stderr, "cooperative launch %d failed: %s\n", ph, hipGetErrorString(e)); break; }
    }
#endif
}
```

```cpp
#include <hip/hip_runtime.h>
#include <cstdio>
#include <cstdint>

#define LAS __attribute__((address_space(3)))
typedef unsigned short bf16_t;
typedef short bf16x8 __attribute__((ext_vector_type(8)));
typedef short s16x4 __attribute__((ext_vector_type(4)));
typedef float f32x4 __attribute__((ext_vector_type(4)));
typedef float f32x16 __attribute__((ext_vector_type(16)));
typedef unsigned u32x4 __attribute__((ext_vector_type(4)));
typedef unsigned u32x2 __attribute__((ext_vector_type(2)));

#ifndef PROBE_DUP
#define PROBE_DUP 0
#endif
#ifndef MK_ONE_LAUNCH
#define MK_ONE_LAUNCH 1
#endif

constexpr int S = 8192, DM = 2048, NIN = 2880, NINP = 3072;
constexpr int NPH = 9;
constexpr float EPS = 1e-6f;
constexpr int LDS_BYTES = 163840;
constexpr int NTHREADS = 512;
constexpr int LDS_MISC = 161792;

constexpr size_t MiB = 1u << 20;
constexpr size_t WS_CTL = 0;
constexpr size_t WS_ROWSS = 128 * 1024;
constexpr size_t WS_COS = 1 * MiB, WS_SIN = 2 * MiB;
constexpr size_t WS_RSTD1 = 3 * MiB;
constexpr size_t WS_EXP = 4 * MiB;
constexpr size_t WS_GATE = 8 * MiB;
constexpr size_t WS_WIN = 12 * MiB;
constexpr size_t WS_WUQ = 24 * MiB;
constexpr size_t WS_WUKV = 26 * MiB;
constexpr size_t WS_WOUT = 28 * MiB;
constexpr size_t WS_WS = 36 * MiB;
constexpr size_t WS_XB = 44 * MiB;
constexpr size_t WS_PROJ = 76 * MiB;
constexpr size_t WS_QRAW = 124 * MiB;
constexpr size_t WS_KVRAW = 148 * MiB;
constexpr size_t WS_QH = 180 * MiB;
constexpr size_t WS_KH = 204 * MiB;
constexpr size_t WS_VH = 228 * MiB;
constexpr size_t WS_MIX = 244 * MiB;
constexpr size_t WS_X1B = 276 * MiB;
constexpr size_t WS_SC = 308 * MiB;
constexpr size_t WS_UT = 372 * MiB;
constexpr size_t WS_VT = 436 * MiB;
constexpr size_t WS_END = 500 * MiB;

__device__ __forceinline__ unsigned f2bf(float f) { unsigned u = __builtin_bit_cast(unsigned, f); return (u + 0x7fffu + ((u >> 16) & 1u)) >> 16; }
__device__ __forceinline__ unsigned pk2(float lo, float hi) { unsigned r; asm("v_cvt_pk_bf16_f32 %0, %1, %2" : "=v"(r) : "v"(lo), "v"(hi)); return r; }
__device__ __forceinline__ float bf2f(unsigned short b) { return __builtin_bit_cast(float, (unsigned)b << 16); }
__device__ __forceinline__ float bflo(unsigned w) { return __builtin_bit_cast(float, w << 16); }
__device__ __forceinline__ float bfhi(unsigned w) { return __builtin_bit_cast(float, w & 0xffff0000u); }
__device__ __forceinline__ float wave_sum(float v) {
#pragma unroll
    for (int o = 32; o > 0; o >>= 1) v += __shfl_xor(v, o);
    return v;
}
__device__ __forceinline__ float wave_max(float v) {
#pragma unroll
    for (int o = 32; o > 0; o >>= 1) v = fmaxf(v, __shfl_xor(v, o));
    return v;
}
template <int CTRL, int ROW_MASK> __device__ __forceinline__ float dpp_f(float old, float v) {
    return __builtin_bit_cast(float, __builtin_amdgcn_update_dpp(__builtin_bit_cast(int, old), __builtin_bit_cast(int, v), CTRL, ROW_MASK, 0xf, false));
}
__device__ __forceinline__ float wave_max_u(float v) {
    v = fmaxf(v, dpp_f<0xB1, 0xf>(v, v));
    v = fmaxf(v, dpp_f<0x4E, 0xf>(v, v));
    v = fmaxf(v, dpp_f<0x141, 0xf>(v, v));
    v = fmaxf(v, dpp_f<0x140, 0xf>(v, v));
    v = fmaxf(v, dpp_f<0x142, 0xa>(v, v));
    v = fmaxf(v, dpp_f<0x143, 0xc>(v, v));
    return __builtin_bit_cast(float, __builtin_amdgcn_readlane(__builtin_bit_cast(int, v), 63));
}
__device__ __forceinline__ float wave_sum_u(float v) {
    v += dpp_f<0xB1, 0xf>(0.f, v);
    v += dpp_f<0x4E, 0xf>(0.f, v);
    v += dpp_f<0x141, 0xf>(0.f, v);
    v += dpp_f<0x140, 0xf>(0.f, v);
    v += dpp_f<0x142, 0xa>(0.f, v);
    v += dpp_f<0x143, 0xc>(0.f, v);
    return __builtin_bit_cast(float, __builtin_amdgcn_readlane(__builtin_bit_cast(int, v), 63));
}
__device__ __forceinline__ float gelu_tanh(float x) {
    constexpr float C0 = -2.0f * 0.7978845608028654f * 1.4426950408889634f, C1 = C0 * 0.044715f;
    const float e = __builtin_amdgcn_exp2f(x * (C0 + C1 * (x * x)));
    return x * __builtin_amdgcn_rcpf(1.0f + e);
}
__device__ __forceinline__ int crow(int r, int hi) { return (r & 3) + 8 * (r >> 2) + 4 * hi; }
#define LDS_WAIT() asm volatile("s_waitcnt lgkmcnt(0)" ::: "memory")
#define SBAR() __builtin_amdgcn_sched_barrier(0)

namespace pg8 {
#define PG8_LAS __attribute__((address_space(3)))
constexpr int BM = 256, BK = 64, HALF = 128, HTB = HALF * BK * 2  , STAGE_BYTES = 8 * HTB, NXCD = 8, WGM = 8;

__host__ __device__ __forceinline__ int lds_byte(int r, int c) { const int st = (r >> 4) * 2 + (c >> 5), rr = r & 15, cc = c & 31, ob = rr * 64 + cc * 2; return st * 1024 + (ob ^ (((ob >> 9) & 1) << 5)); }
__host__ __device__ __forceinline__ void stage_rc(int b, int& R, int& C) { const int st = b / 1024, sb = b % 1024, swz = sb ^ (((sb >> 9) & 1) << 5); R = (st >> 1) * 16 + swz / 64; C = (st & 1) * 32 + (swz % 64) / 2; }
__host__ __device__ __forceinline__ int perm32(int rho) { const int n = rho >> 4, i = rho & 15; return 8 * (i >> 2) + 4 * n + (i & 3); }

struct Unit { int pm, pn; };
struct Gemm { const bf16_t* A; const bf16_t* Bt; int M, N, K, lda, ldb; };

struct StaticOrder {
    int nM, nN, nwg, G, c, nfix = -1, fpm = 0, fpn = 0, fpm2 = 0, fpn2 = 0;
    __host__ __device__ void init(int M, int N, int G_, int c_) { nM = M / BM; nN = N / BM; nwg = nM * nN; G = G_; c = c_; nfix = -1; }
    __host__ __device__ void fixed(int pm, int pn) { nfix = 1; fpm = pm; fpn = pn; }
    __host__ __device__ void fixed2(int pm, int pn, int pm2, int pn2) { nfix = 2; fpm = pm; fpn = pn; fpm2 = pm2; fpn2 = pn2; }
    __host__ __device__ void none() { nfix = 0; }
    __host__ __device__ bool next(int i, Unit& u) const {
        if (nfix >= 0) { if (i >= nfix) return false; u.pm = i ? fpm2 : fpm; u.pn = i ? fpn2 : fpn; return true; }
        const long L = (long)i * G + c; if (L >= nwg) return false;
        int wgid = (int)L; { const int q = nwg / NXCD, r = nwg % NXCD, xcd = wgid % NXCD, off = wgid / NXCD; wgid = (xcd < r ? xcd * (q + 1) : r * (q + 1) + (xcd - r) * q) + off; }
        const int nig = WGM * nN, gid = wgid / nig, fm = gid * WGM, gsz = (nM - fm) < WGM ? (nM - fm) : WGM;
        u.pm = fm + ((wgid % nig) % gsz); u.pn = (wgid % nig) / gsz; return true;
    }
    __device__ __forceinline__ void a_ready(const Unit&) const {}
    __device__ __forceinline__ void done(const Unit&) const {}
};

template <class Epi, class Sched, bool ALIGN_EPI = false, bool SP2 = false>
__device__ __forceinline__ void gemm_phase(PG8_LAS unsigned char* lds, const Gemm g, const Sched& S, const Epi& E) {
    const int tid = threadIdx.x, wid = __builtin_amdgcn_readfirstlane(tid >> 6), lane = tid & 63, wr = wid >> 2, wc = wid & 3, fr = lane & 15, fq = lane >> 4;
    const int K = g.K, nt = K / BK;
    unsigned voffA[2], voffB[2];
#pragma unroll
    for (int i = 0; i < 2; ++i) { int R, C; stage_rc(tid * 16 + i * 8192, R, C); const int Rb = Epi::PERM ? ((R & ~31) + perm32(R & 31)) : R;
        voffA[i] = (unsigned)(R * g.lda + C) * 2u; voffB[i] = (unsigned)(Rb * g.ldb + C) * 2u; }
    const size_t kstep = (size_t)(BK * 2);
    const size_t hstepA = (size_t)HALF * g.lda * 2, hstepB = (size_t)HALF * g.ldb * 2;
    const size_t tstepA = 2 * hstepA, tstepB = 2 * hstepB;
    const unsigned ldsw = (unsigned)wid * 1024u;
    const int aoff = lds_byte(wr * 64 + fr, fq * 8), boff = lds_byte(wc * 32 + fr, fq * 8);
#define PG8_SA(b, h) (((b) * 2 + (h)) * HTB)
#define PG8_SB(b, h) ((4 + (b) * 2 + (h)) * HTB)
#define PG8_STAGE(bufoff, gbase, voff) do { _Pragma("unroll") for (int _i = 0; _i < 2; ++_i) \
        __builtin_amdgcn_global_load_lds((const unsigned*)((const char*)(gbase) + (voff)[_i]), (PG8_LAS unsigned*)(lds + (bufoff) + ldsw + _i * 8192), 16, 0, 0); } while (0)
#define PG8_LDA(dst, b, h) do { _Pragma("unroll") for (int m = 0; m < 4; ++m) _Pragma("unroll") for (int k = 0; k < 2; ++k) dst[m][k] = *(const PG8_LAS bf16x8*)(lds + PG8_SA(b, h) + aoff + m * 2048 + k * 1024); } while (0)
#define PG8_LDB(dst, b, h) do { _Pragma("unroll") for (int n = 0; n < 2; ++n) _Pragma("unroll") for (int k = 0; k < 2; ++k) dst[n][k] = *(const PG8_LAS bf16x8*)(lds + PG8_SB(b, h) + boff + n * 2048 + k * 1024); } while (0)
#define PG8_MMA(ai, bj, At, Bt) do { __builtin_amdgcn_s_setprio(1); _Pragma("unroll") for (int m = 0; m < 4; ++m) _Pragma("unroll") for (int n = 0; n < 2; ++n) _Pragma("unroll") for (int k = 0; k < 2; ++k) \
        acc[ai][bj][m][n] = __builtin_amdgcn_mfma_f32_16x16x32_bf16(Bt[n][k], At[m][k], acc[ai][bj][m][n], 0, 0, 0); __builtin_amdgcn_s_setprio(0); } while (0)
#define PG8_WAIT_V(n) asm volatile("s_waitcnt vmcnt(" #n ")" ::: "memory")
#define PG8_WAIT_L(n) asm volatile("s_waitcnt lgkmcnt(" #n ")" ::: "memory")
#define PG8_BAR __builtin_amdgcn_s_barrier()
#define PG8_SCHED __builtin_amdgcn_sched_barrier(0)
    Unit cur, nxt; int ui = 0;
    if (!S.next(0, cur)) return;
    f32x4 acc[2][2][4][2];
#pragma unroll
    for (int a = 0; a < 2; ++a)
#pragma unroll
        for (int b = 0; b < 2; ++b)
#pragma unroll
            for (int m = 0; m < 4; ++m)
#pragma unroll
                for (int n = 0; n < 2; ++n) acc[a][b][m][n] = (f32x4){0.f, 0.f, 0.f, 0.f};
    bf16x8 At[4][2], B0[2][2], B1[2][2];
    const char* cA = (const char*)g.A + (size_t)cur.pm * tstepA; const char* cB = (const char*)g.Bt + (size_t)cur.pn * tstepB;
    S.a_ready(cur);
    if constexpr (SP2) {
        PG8_STAGE(PG8_SB(0, 0), cB, voffB); PG8_STAGE(PG8_SB(0, 1), cB + hstepB, voffB); PG8_STAGE(PG8_SA(0, 0), cA, voffA); PG8_STAGE(PG8_SA(0, 1), cA + hstepA, voffA);
        if (wr == 1) PG8_BAR;
        PG8_WAIT_V(2); PG8_BAR;
        PG8_STAGE(PG8_SB(1, 0), cB + kstep, voffB); PG8_STAGE(PG8_SA(1, 0), cA + kstep, voffA); PG8_STAGE(PG8_SB(1, 1), cB + hstepB + kstep, voffB);
        PG8_WAIT_V(6); PG8_BAR;
    } else {
        PG8_STAGE(PG8_SB(0, 0), cB, voffB); PG8_STAGE(PG8_SA(0, 0), cA, voffA); PG8_STAGE(PG8_SB(0, 1), cB + hstepB, voffB); PG8_STAGE(PG8_SA(0, 1), cA + hstepA, voffA);
        if (wr == 1) PG8_BAR;
        PG8_WAIT_V(4); PG8_BAR;
        PG8_STAGE(PG8_SB(1, 0), cB + kstep, voffB); PG8_STAGE(PG8_SA(1, 0), cA + kstep, voffA); PG8_STAGE(PG8_SB(1, 1), cB + hstepB + kstep, voffB);
        PG8_WAIT_V(6); PG8_BAR;
    }
    for (;;) {
        const bool has_next = S.next(ui + 1, nxt);
        const char* nA = has_next ? (const char*)g.A + (size_t)nxt.pm * tstepA : cA; const char* nB = has_next ? (const char*)g.Bt + (size_t)nxt.pn * tstepB : cB;
        for (int t = 0; t < nt; t += 2) {
            const bool last = (t == nt - 2);
            const char* a1 = cA + (size_t)(t + 1) * kstep;
            const char* a2 = last ? nA : cA + (size_t)(t + 2) * kstep; const char* b2 = last ? nB : cB + (size_t)(t + 2) * kstep;
            const char* a3 = a2 + kstep; const char* b3 = b2 + kstep;
            if (last && has_next) S.a_ready(nxt);
            if constexpr (SP2) {
            PG8_LDB(B0, 0, 0); PG8_LDB(B1, 0, 1); PG8_SCHED; PG8_LDA(At, 0, 0); PG8_STAGE(PG8_SA(1, 1), a1 + hstepA, voffA);
            PG8_WAIT_V(8); PG8_WAIT_L(0); PG8_BAR; PG8_MMA(0, 0, At, B0); PG8_MMA(0, 1, At, B1); PG8_BAR; PG8_SCHED;
            PG8_LDA(At, 0, 1); PG8_STAGE(PG8_SB(0, 0), b2, voffB); PG8_STAGE(PG8_SB(0, 1), b2 + hstepB, voffB); PG8_STAGE(PG8_SA(0, 0), a2, voffA);
            PG8_WAIT_V(8); PG8_WAIT_L(0); PG8_BAR; PG8_MMA(1, 0, At, B0); PG8_MMA(1, 1, At, B1); PG8_BAR; PG8_SCHED;
            PG8_LDB(B0, 1, 0); PG8_LDB(B1, 1, 1); PG8_SCHED; PG8_LDA(At, 1, 0); PG8_STAGE(PG8_SA(0, 1), a2 + hstepA, voffA);
            PG8_WAIT_V(8); PG8_WAIT_L(0); PG8_BAR; PG8_MMA(0, 0, At, B0); PG8_MMA(0, 1, At, B1); PG8_BAR; PG8_SCHED;
            PG8_LDA(At, 1, 1); PG8_STAGE(PG8_SB(1, 0), b3, voffB); PG8_STAGE(PG8_SB(1, 1), b3 + hstepB, voffB); PG8_STAGE(PG8_SA(1, 0), a3, voffA);
            PG8_WAIT_V(8); PG8_WAIT_L(0); PG8_BAR; PG8_MMA(1, 0, At, B0); PG8_MMA(1, 1, At, B1); PG8_BAR; PG8_SCHED;
            } else {
            PG8_LDB(B0, 0, 0); PG8_SCHED; PG8_LDA(At, 0, 0); PG8_STAGE(PG8_SA(1, 1), a1 + hstepA, voffA);
            PG8_WAIT_L(8); PG8_BAR; PG8_WAIT_L(0); PG8_MMA(0, 0, At, B0); PG8_BAR; PG8_SCHED;
            PG8_LDB(B1, 0, 1); PG8_STAGE(PG8_SB(0, 0), b2, voffB);
            PG8_BAR; PG8_WAIT_L(0); PG8_MMA(0, 1, At, B1); PG8_BAR;
            PG8_LDA(At, 0, 1); PG8_STAGE(PG8_SA(0, 0), a2, voffA);
            PG8_BAR; PG8_WAIT_L(0); PG8_MMA(1, 0, At, B0); PG8_BAR; PG8_SCHED;
            PG8_STAGE(PG8_SB(0, 1), b2 + hstepB, voffB);
            PG8_WAIT_V(6); PG8_BAR; PG8_MMA(1, 1, At, B1); PG8_BAR;
            PG8_LDB(B0, 1, 0); PG8_SCHED; PG8_LDA(At, 1, 0); PG8_STAGE(PG8_SA(0, 1), a2 + hstepA, voffA);
            PG8_WAIT_L(8); PG8_BAR; PG8_WAIT_L(0); PG8_MMA(0, 0, At, B0); PG8_BAR; PG8_SCHED;
            PG8_LDB(B1, 1, 1); PG8_STAGE(PG8_SB(1, 0), b3, voffB);
            PG8_BAR; PG8_WAIT_L(0); PG8_MMA(0, 1, At, B1); PG8_BAR;
            PG8_LDA(At, 1, 1); PG8_STAGE(PG8_SA(1, 0), a3, voffA);
            PG8_BAR; PG8_WAIT_L(0); PG8_MMA(1, 0, At, B0); PG8_BAR; PG8_SCHED;
            PG8_STAGE(PG8_SB(1, 1), b3 + hstepB, voffB);
            PG8_WAIT_V(6); PG8_BAR; PG8_MMA(1, 1, At, B1); PG8_BAR;
            }
        }
        if constexpr (ALIGN_EPI) { if (wr == 0) PG8_BAR; }
        if constexpr (!Epi::AFTER_DRAIN) { E(acc, cur, wr, wc, fr, fq); S.done(cur); }
        if (!has_next) break;
#pragma unroll
        for (int a = 0; a < 2; ++a)
#pragma unroll
            for (int b = 0; b < 2; ++b)
#pragma unroll
                for (int m = 0; m < 4; ++m)
#pragma unroll
                    for (int n = 0; n < 2; ++n) acc[a][b][m][n] = (f32x4){0.f, 0.f, 0.f, 0.f};
        cur = nxt; cA = nA; cB = nB; ++ui;
        if constexpr (ALIGN_EPI) { if (wr == 1) PG8_BAR; }
    }
    PG8_WAIT_V(0);
    if constexpr (!ALIGN_EPI) { if (wr == 0) PG8_BAR; }
    PG8_BAR;
#undef PG8_SA
#undef PG8_SB
#undef PG8_STAGE
#undef PG8_LDA
#undef PG8_LDB
#undef PG8_MMA
#undef PG8_WAIT_V
#undef PG8_WAIT_L
#undef PG8_BAR
#undef PG8_SCHED
}

template <int MODE> struct Epi {
    static constexpr bool PERM = true, AFTER_DRAIN = false;
    const float* rowsrc; float inv_n; float* ss; bf16_t* ob; int ldc; float* of; const float* xin;
    const float* gk; PG8_LAS float* xl;
    __device__ __forceinline__ void kv_epilogue(const f32x4 (&acc)[2][2][4][2], const Unit& u_, int wr_, int wc_, int fr_, int fq_) const {
        Unit u = u_; int wr = wr_, wc = wc_, fr = fr_, fq = fq_;
        asm volatile("" : "+s"(u.pm), "+s"(u.pn), "+s"(wr), "+s"(wc), "+v"(fr), "+v"(fq));
        unsigned char* wsb = (unsigned char*)ob - WS_KVRAW;
        bf16_t* kh = (bf16_t*)(wsb + WS_KH); const bf16_t* kproj = (const bf16_t*)(wsb + WS_PROJ);
        const float* ct = (const float*)(wsb + WS_COS); const float* st = (const float*)(wsb + WS_SIN);
#pragma unroll
        for (int ai = 0; ai < 2; ++ai)
#pragma unroll
            for (int m = 0; m < 4; ++m) {
                const int row = u.pm * BM + ai * HALF + wr * 64 + m * 16 + fr;
                const float rs = rsqrtf(rowsrc[row] * inv_n + EPS);
                if (wc == m) {
                    const u32x4 r1 = *(const u32x4*)(kproj + (size_t)row * NINP + 2816 + 8 * fq), r2 = *(const u32x4*)(kproj + (size_t)row * NINP + 2848 + 8 * fq);
                    float sr = 0.f;
                    sr += (bflo(r1.x) * bflo(r1.x) + bfhi(r1.x) * bfhi(r1.x)) + (bflo(r1.y) * bflo(r1.y) + bfhi(r1.y) * bfhi(r1.y)) + (bflo(r1.z) * bflo(r1.z) + bfhi(r1.z) * bfhi(r1.z)) + (bflo(r1.w) * bflo(r1.w) + bfhi(r1.w) * bfhi(r1.w));
                    sr += (bflo(r2.x) * bflo(r2.x) + bfhi(r2.x) * bfhi(r2.x)) + (bflo(r2.y) * bflo(r2.y) + bfhi(r2.y) * bfhi(r2.y)) + (bflo(r2.z) * bflo(r2.z) + bfhi(r2.z) * bfhi(r2.z)) + (bflo(r2.w) * bflo(r2.w) + bfhi(r2.w) * bfhi(r2.w));
                    sr += __shfl_xor(sr, 16); sr += __shfl_xor(sr, 32);
                    if (fq == 0) xl[1024 + ((wr * 2 + ai) * 4 + m) * 16 + fr] = sr;
                }
                const f32x4 a0 = acc[ai][0][m][0] * rs, a1 = acc[ai][0][m][1] * rs;
                float sq = 0.f;
#pragma unroll
                for (int j = 0; j < 4; ++j) { const float e0 = bf2f((unsigned short)f2bf(a0[j])), e1 = bf2f((unsigned short)f2bf(a1[j])); sq += e0 * e0 + e1 * e1; }
                sq += __shfl_xor(sq, 16); sq += __shfl_xor(sq, 32);
                if (fq == 0) xl[((((wc * 2 + wr) * 2 + ai) * 4 + m) * 16) + fr] = sq;
                const int colv = u.pn * BM + HALF + wc * 32 + fq * 8;
                const f32x4 v0 = acc[ai][1][m][0] * rs, v1 = acc[ai][1][m][1] * rs;
                u32x4 w; w.x = pk2(v0[0], v0[1]); w.y = pk2(v0[2], v0[3]); w.z = pk2(v1[0], v1[1]); w.w = pk2(v1[2], v1[3]);
                *(u32x4*)(ob + (size_t)row * ldc + colv) = w;
                asm volatile("" ::: "memory");
            }
        __syncthreads();
        const int h = u.pn;
#pragma unroll
        for (int ai = 0; ai < 2; ++ai)
#pragma unroll
            for (int m = 0; m < 4; ++m) {
                const int row = u.pm * BM + ai * HALF + wr * 64 + m * 16 + fr;
                float tot = xl[1024 + ((wr * 2 + ai) * 4 + m) * 16 + fr];
#pragma unroll
                for (int c = 0; c < 4; ++c) tot += xl[((((c * 2 + wr) * 2 + ai) * 4 + m) * 16) + fr];
                const float rk = rsqrtf(tot * (1.0f / 192.0f) + EPS), rs = rsqrtf(rowsrc[row] * inv_n + EPS);
                bf16_t* kd = kh + ((size_t)h * S + row) * 192;
                {
                    const f32x4 g0 = *(const f32x4*)(gk + wc * 32 + fq * 8), g1 = *(const f32x4*)(gk + wc * 32 + fq * 8 + 4);
                    f32x4 a0 = acc[ai][0][m][0] * rs, a1 = acc[ai][0][m][1] * rs;
#pragma unroll
                    for (int j = 0; j < 4; ++j) { a0[j] = bf2f((unsigned short)f2bf(a0[j])) * g0[j] * rk; a1[j] = bf2f((unsigned short)f2bf(a1[j])) * g1[j] * rk; }
                    u32x4 w; w.x = pk2(a0[0], a0[1]); w.y = pk2(a0[2], a0[3]); w.z = pk2(a1[0], a1[1]); w.w = pk2(a1[2], a1[3]);
                    *(u32x4*)(kd + wc * 32 + fq * 8) = w;
                }
                if (wc == m) {
#pragma unroll
                    for (int hf = 0; hf < 2; ++hf) {
                        const u32x2 r1 = *(const u32x2*)(kproj + (size_t)row * NINP + 2816 + 8 * fq + 4 * hf), r2 = *(const u32x2*)(kproj + (size_t)row * NINP + 2848 + 8 * fq + 4 * hf);
                        const f32x4 c0 = *(const f32x4*)(ct + row * 32 + 8 * fq + 4 * hf), s0 = *(const f32x4*)(st + row * 32 + 8 * fq + 4 * hf);
                        const f32x4 ga = *(const f32x4*)(gk + 128 + 8 * fq + 4 * hf), gb = *(const f32x4*)(gk + 160 + 8 * fq + 4 * hf);
                        const f32x4 x1 = (f32x4){bflo(r1.x), bfhi(r1.x), bflo(r1.y), bfhi(r1.y)} * ga * rk, x2 = (f32x4){bflo(r2.x), bfhi(r2.x), bflo(r2.y), bfhi(r2.y)} * gb * rk;
                        const f32x4 o1 = x1 * c0 - x2 * s0, o2 = x1 * s0 + x2 * c0;
                        *(u32x2*)(kd + 128 + 8 * fq + 4 * hf) = (u32x2){pk2(o1[0], o1[1]), pk2(o1[2], o1[3])};
                        *(u32x2*)(kd + 160 + 8 * fq + 4 * hf) = (u32x2){pk2(o2[0], o2[1]), pk2(o2[2], o2[3])};
                        asm volatile("" ::: "memory");
                    }
                }
                asm volatile("" ::: "memory");
            }
    }
    __device__ __forceinline__ void operator()(const f32x4 (&acc)[2][2][4][2], const Unit& u, int wr, int wc, int fr, int fq) const {
        if (MODE == 6) { kv_epilogue(acc, u, wr, wc, fr, fq); return; }
        u32x4 xres[2][4][2];
        if (MODE == 4) {
#pragma unroll
            for (int ai = 0; ai < 2; ++ai)
#pragma unroll
                for (int m = 0; m < 4; ++m)
#pragma unroll
                    for (int bj = 0; bj < 2; ++bj)
                        xres[ai][m][bj] = *(const u32x4*)((const bf16_t*)xin + (size_t)(u.pm * BM + ai * HALF + wr * 64 + m * 16 + fr) * DM + u.pn * BM + bj * HALF + wc * 32 + fq * 8);
        }
#pragma unroll
        for (int ai = 0; ai < 2; ++ai)
#pragma unroll
            for (int m = 0; m < 4; ++m) {
                const int row = u.pm * BM + ai * HALF + wr * 64 + m * 16 + fr;
                float rs = 1.f;
                if (MODE == 1) rs = rowsrc[row];
                if (MODE == 2 || MODE == 5) rs = rsqrtf(rowsrc[row] * inv_n + EPS);
                float ssq = 0.f;
#pragma unroll
                for (int bj = 0; bj < 2; ++bj) {
                    const int col = u.pn * BM + bj * HALF + wc * 32 + fq * 8;
                    f32x4 v0 = acc[ai][bj][m][0] * rs, v1 = acc[ai][bj][m][1] * rs;
                    if (MODE == 1) { if (u.pn < 8) {
#pragma unroll
                        for (int j = 0; j < 4; ++j) { v0[j] = gelu_tanh(v0[j]); v1[j] = gelu_tanh(v1[j]); } } }
                    if (MODE == 4) { const u32x4 xw = xres[ai][m][bj];
                        v0 = v0 + (f32x4){bflo(xw.x), bfhi(xw.x), bflo(xw.y), bfhi(xw.y)}; v1 = v1 + (f32x4){bflo(xw.z), bfhi(xw.z), bflo(xw.w), bfhi(xw.w)}; }
                    if (MODE == 1 || MODE == 4) ssq += ((v0[0] * v0[0] + v0[1] * v0[1]) + (v0[2] * v0[2] + v0[3] * v0[3])) + ((v1[0] * v1[0] + v1[1] * v1[1]) + (v1[2] * v1[2] + v1[3] * v1[3]));
                    if (MODE == 1 || MODE == 2 || MODE == 4) { u32x4 w; w.x = pk2(v0[0], v0[1]); w.y = pk2(v0[2], v0[3]); w.z = pk2(v1[0], v1[1]); w.w = pk2(v1[2], v1[3]); *(u32x4*)(ob + (size_t)row * ldc + col) = w; }
                    if (MODE == 5) { *(f32x4*)(of + (size_t)row * DM + col) = v0; *(f32x4*)(of + (size_t)row * DM + col + 4) = v1; }
                }
                if (MODE == 1) {
                    const int seg = (u.pn >= 4 && u.pn < 8) ? 0 : ((u.pn == 8 || u.pn == 9) ? 1 : (u.pn == 10 ? 2 : -1));
                    if (seg >= 0) { ssq += __shfl_xor(ssq, 16); ssq += __shfl_xor(ssq, 32); if (fq == 0) atomicAdd(ss + seg * S + row, ssq); }
                }
                if (MODE == 4) { ssq += __shfl_xor(ssq, 16); ssq += __shfl_xor(ssq, 32); if (fq == 0) atomicAdd(ss + row, ssq); }
            }
    }
};
}

#define XB_TMO      128
#define XB_XCNT(j)  (256  + 64 * (j))
#define XB_XSUB(j)  (1280 + 64 * (j))
#define XB_XGEN(j)  (2304 + 64 * (j))
#define XB_TOP      3328
#define XB_TOPGEN   3392
#define XCD_BAR_WORDS 3456
#define XB_SPIN_CAP (1u << 18)
__device__ __forceinline__ unsigned xb_ld(unsigned* p)              { return __hip_atomic_load(p, __ATOMIC_RELAXED, __HIP_MEMORY_SCOPE_AGENT); }
__device__ __forceinline__ unsigned xb_add(unsigned* p, unsigned v) { return __hip_atomic_fetch_add(p, v, __ATOMIC_RELAXED, __HIP_MEMORY_SCOPE_AGENT); }
__device__ __forceinline__ unsigned xb_xcc_id() { return (unsigned)__builtin_amdgcn_s_getreg((3 << 11) | 20) & 0xFu; }
#define XB_SPIN(cond, bar) do { unsigned _sp = 0; while (cond) { __builtin_amdgcn_s_sleep(1); \
    if ((++_sp & 255u) == 0u) { if (xb_ld(&(bar)[XB_TMO])) break; if (_sp > XB_SPIN_CAP) { atomicAdd(&(bar)[XB_TMO], 1u); break; } } } } while (0)
struct XcdBarrier { unsigned* bar; unsigned x; volatile LAS unsigned* st; };
__device__ __forceinline__ XcdBarrier xcd_barrier_post(unsigned* bar, volatile LAS unsigned* st) {
    XcdBarrier b; b.bar = bar; b.x = xb_xcc_id(); b.st = st;
    if (threadIdx.x == 0) st[3] = xb_add(&bar[XB_XCNT(b.x)], 1u);
    return b;
}
__device__ __forceinline__ void xcd_barrier_complete(unsigned* bar, unsigned x, unsigned& nloc, unsigned& nx, unsigned& eq32) {
    const unsigned G = gridDim.x * gridDim.y * gridDim.z;
    unsigned sum, cnt, mine, sp = 0u;
    for (;;) {
        sum = 0u; cnt = 0u; mine = 0u; eq32 = 1u;
#pragma unroll
        for (unsigned j = 0; j < 16; ++j) { const unsigned c = xb_ld(&bar[XB_XCNT(j)]); sum += c; cnt += (c > 0u) ? 1u : 0u; mine = (j == x) ? c : mine; if (c != (j < 8u ? 32u : 0u)) eq32 = 0u; }
        if (sum == G) break;
        __builtin_amdgcn_s_sleep(1);
        if ((++sp & 255u) == 0u) { if (xb_ld(&bar[XB_TMO])) break; if (sp > XB_SPIN_CAP) { atomicAdd(&bar[XB_TMO], 1u); break; } }
    }
    nloc = mine > 0u ? mine : 1u; nx = cnt > 0u ? cnt : 1u;
}
#define XB_LSUB(j)  (3456 + 64 * (j))
#define XB_LGEN(j)  (4480 + 64 * (j))
__device__ __forceinline__ void xcd_local_barrier(const XcdBarrier& b) {
    asm volatile("s_waitcnt vmcnt(0)" ::: "memory");
    __syncthreads();
    if (threadIdx.x == 0) {
        unsigned* bar = b.bar;
        const unsigned nloc = b.st[0];
        const unsigned old = xb_add(&bar[XB_LSUB(b.x)], 1u);
        const unsigned gen = old / nloc;
        if (old + 1u == (gen + 1u) * nloc) xb_add(&bar[XB_LGEN(b.x)], 1u);
        else XB_SPIN(xb_ld(&bar[XB_LGEN(b.x)]) == gen, bar);
    }
    __syncthreads();
}
__device__ __forceinline__ void xcd_local_barrier_acq(const XcdBarrier& b) {
    asm volatile("s_waitcnt vmcnt(0)" ::: "memory");
    __syncthreads();
    if (threadIdx.x == 0) {
        unsigned* bar = b.bar;
        __builtin_amdgcn_s_waitcnt(0);
        const unsigned nloc = b.st[0];
        const unsigned old = xb_add(&bar[XB_LSUB(b.x)], 1u);
        const unsigned gen = old / nloc;
        if (old + 1u == (gen + 1u) * nloc) xb_add(&bar[XB_LGEN(b.x)], 1u);
        else XB_SPIN(xb_ld(&bar[XB_LGEN(b.x)]) == gen, bar);
        __builtin_amdgcn_fence(__ATOMIC_ACQUIRE, "agent");
        asm volatile("s_waitcnt vmcnt(0)" ::: "memory");
    }
    __syncthreads();
}
__device__ __forceinline__ void xcd_barrier(const XcdBarrier& b) {
    asm volatile("s_waitcnt vmcnt(0)" ::: "memory");
    __syncthreads();
    if (threadIdx.x == 0) {
        unsigned* bar = b.bar;
        __builtin_amdgcn_s_waitcnt(0);
        unsigned nloc = b.st[0], nx = b.st[1];
        if (nloc == 0u) { unsigned eq32; xcd_barrier_complete(bar, b.x, nloc, nx, eq32); b.st[0] = nloc; b.st[1] = nx; b.st[2] = eq32; }
        const unsigned old = xb_add(&bar[XB_XSUB(b.x)], 1u);
        const unsigned gen = old / nloc;
        if (old + 1u == (gen + 1u) * nloc) {
            __builtin_amdgcn_fence(__ATOMIC_RELEASE, "agent");
            asm volatile("s_waitcnt vmcnt(0)" ::: "memory");
            const unsigned og = xb_add(&bar[XB_TOP], 1u);
            const unsigned tg = og / nx;
            if (og + 1u == (tg + 1u) * nx) xb_add(&bar[XB_TOPGEN], 1u);
            else XB_SPIN(xb_ld(&bar[XB_TOPGEN]) == tg, bar);
            __builtin_amdgcn_fence(__ATOMIC_ACQUIRE, "agent");
            xb_add(&bar[XB_XGEN(b.x)], 1u);
            asm volatile("s_waitcnt vmcnt(0)" ::: "memory");
        } else {
            XB_SPIN(xb_ld(&bar[XB_XGEN(b.x)]) == gen, bar);
            __builtin_amdgcn_fence(__ATOMIC_ACQUIRE, "agent");
            asm volatile("s_waitcnt vmcnt(0)" ::: "memory");
        }
    }
    __syncthreads();
}

struct Params {
    const float* in[18];
    float* out;
    unsigned char* ws;
    int ph_lo, ph_hi;
};

__device__ __forceinline__ void p0_transpose_item(const float* W, const float* g, int K, int N, bf16_t* WT, LAS float* scr, int item, int lane) {
    const int nblk = N / 32, kb = item / nblk, nb = item % nblk, k0 = 64 * kb, n0 = 32 * nb;
    float wv[32];
#pragma unroll
    for (int i = 0; i < 32; ++i) { const int kk = 2 * i + (lane >> 5); wv[i] = __builtin_nontemporal_load(W + (size_t)(k0 + kk) * N + n0 + (lane & 31)); }
#pragma unroll
    for (int i = 0; i < 32; ++i) { const int kk = 2 * i + (lane >> 5); const float gv = g ? g[k0 + kk] : 1.f; scr[kk * 33 + (lane & 31)] = wv[i] * gv; }
    LDS_WAIT(); asm volatile("" ::: "memory");
    const int c = lane & 7;
#pragma unroll
    for (int j = 0; j < 4; ++j) { const int n = (lane >> 3) + 8 * j; const LAS float* s = scr + (8 * c) * 33 + n;
        u32x4 o; o.x = pk2(s[0 * 33], s[1 * 33]); o.y = pk2(s[2 * 33], s[3 * 33]); o.z = pk2(s[4 * 33], s[5 * 33]); o.w = pk2(s[6 * 33], s[7 * 33]);
        *(u32x4*)(WT + (size_t)(n0 + n) * K + k0 + 8 * c) = o; }
    LDS_WAIT(); asm volatile("" ::: "memory");
}
__device__ __forceinline__ float row_to_bf16(const float* src, const float* g, bf16_t* dst, int lane) {
    float ss = 0.f;
#pragma unroll
    for (int i = 0; i < 8; ++i) {
        const int c = (i * 64 + lane) * 4;
        f32x4 v = *(const f32x4*)(src + c);
        ss += (v[0] * v[0] + v[1] * v[1]) + (v[2] * v[2] + v[3] * v[3]);
        if (g) { const f32x4 gv = *(const f32x4*)(g + c); v = v * gv; }
        u32x2 w; w.x = pk2(v[0], v[1]); w.y = pk2(v[2], v[3]);
        *(u32x2*)(dst + c) = w;
    }
    return ss;
}
constexpr float PEER_USC = 80.0f, PEER_VSC = 5.0f;
constexpr int PEER_ROWB = 1536;
typedef float f32x16v __attribute__((ext_vector_type(16)));
typedef float f32x32v __attribute__((ext_vector_type(32)));
typedef unsigned u32x6 __attribute__((ext_vector_type(6)));
typedef unsigned u32x2a4 __attribute__((ext_vector_type(2), aligned(4)));
template <bool CONTIG>
__device__ __forceinline__ void fp6_pack_store(const f32x4 (&x)[8], const f32x4 (&sc)[8], unsigned char* dst, int lane) {
    f32x16v a, b;
#pragma unroll
    for (int i = 0; i < 8; ++i) {
        const f32x4 y = x[i] * sc[i];
#pragma unroll
        for (int q = 0; q < 4; ++q) { const float c = fminf(fmaxf(y[q], -7.5f), 7.5f); const int sl = 4 * i + q; if ((sl & 1) == 0) a[sl >> 1] = c; else b[sl >> 1] = c; }
    }
    const u32x6 pk = __builtin_amdgcn_cvt_scalef32_2xpk16_fp6_f32(a, b, 1.0f);
    asm volatile("s_nop 15" : "+v"(a), "+v"(b));
    if (CONTIG) {
        *(u32x2*)(dst + lane * 24) = (u32x2){pk[0], pk[1]}; *(u32x2*)(dst + lane * 24 + 8) = (u32x2){pk[2], pk[3]}; *(u32x2*)(dst + lane * 24 + 16) = (u32x2){pk[4], pk[5]};
    } else {
        __builtin_nontemporal_store((u32x4){pk[0], pk[1], pk[2], pk[3]}, (u32x4*)(dst + lane * 16));
        __builtin_nontemporal_store((u32x2){pk[4], pk[5]}, (u32x2*)(dst + 1024 + lane * 8));
    }
}
__device__ __forceinline__ void fp6_pack_store_s(const f32x4 (&x)[8], float scale, unsigned char* dst, int lane) {
    f32x16v a, b;
#pragma unroll
    for (int i = 0; i < 8; ++i) {
        const f32x4 y = x[i] * scale;
#pragma unroll
        for (int q = 0; q < 4; ++q) { const float c = fminf(fmaxf(y[q], -7.5f), 7.5f); const int sl = 4 * i + q; if ((sl & 1) == 0) a[sl >> 1] = c; else b[sl >> 1] = c; }
    }
    const u32x6 pk = __builtin_amdgcn_cvt_scalef32_2xpk16_fp6_f32(a, b, 1.0f);
    asm volatile("s_nop 15" : "+v"(a), "+v"(b));
    __builtin_nontemporal_store((u32x4){pk[0], pk[1], pk[2], pk[3]}, (u32x4*)(dst + lane * 16));
    __builtin_nontemporal_store((u32x2){pk[4], pk[5]}, (u32x2*)(dst + 1024 + lane * 8));
}
template <bool CONTIG>
__device__ __forceinline__ void rows2_to_fp6(const float* s0, const float* s1, const f32x4 (&sc)[8], unsigned char* d0, unsigned char* d1, int lane) {
    f32x4 x0[8], x1[8];
#pragma unroll
    for (int i = 0; i < 8; ++i) { x0[i] = __builtin_nontemporal_load((const f32x4*)(s0 + (i * 64 + lane) * 4)); x1[i] = __builtin_nontemporal_load((const f32x4*)(s1 + (i * 64 + lane) * 4)); }
    fp6_pack_store<CONTIG>(x0, sc, d0, lane); fp6_pack_store<CONTIG>(x1, sc, d1, lane);
}
__device__ __forceinline__ bf16x8 cvt8(const float* p) {
    const f32x4 a = *(const f32x4*)p, b = *(const f32x4*)(p + 4);
    u32x4 w; w.x = pk2(a[0], a[1]); w.y = pk2(a[2], a[3]); w.z = pk2(b[0], b[1]); w.w = pk2(b[2], b[3]);
    return __builtin_bit_cast(bf16x8, w);
}

__device__ __forceinline__ void prep_late(const Params& p, LAS unsigned char* lds, int gw, int NGW, int wave, int lane, int which, int out_lo = 0, int out_hi = 1 << 30) {
    unsigned char* ws = p.ws;
    LAS float* scr = (LAS float*)(lds + wave * 16384);
    constexpr int I_UQ = (512 / 64) * (1536 / 32), I_UKV = (256 / 64) * (2048 / 32), I_OUT = (DM / 64) * (DM / 32);
    if (which & 1) {
        for (int it = gw; it < I_UQ + I_UKV; it += NGW) {
            if (it < I_UQ) p0_transpose_item(p.in[7], p.in[6], 512, 1536, (bf16_t*)(ws + WS_WUQ), scr, it, lane);
            else p0_transpose_item(p.in[9], p.in[8], 256, 2048, (bf16_t*)(ws + WS_WUKV), scr, it - I_UQ, lane);
        }
    }
    if (which & 4) {
        float* ct = (float*)(ws + WS_COS); float* st = (float*)(ws + WS_SIN);
        for (int it = gw; it < S * 32 / 64; it += NGW) {
            const int idx = it * 64 + lane, t = idx >> 5, j = idx & 31;
            const float inv_freq = powf(10000.0f, -(float)j / 32.0f);
            const float ang = (float)t * inv_freq;
            float sv, cv; sincosf(ang, &sv, &cv); ct[idx] = cv; st[idx] = sv;
        }
    }
    if (!(which & 2)) return;
    for (int it = out_lo + gw; it < (out_hi < I_OUT ? out_hi : I_OUT); it += NGW) p0_transpose_item(p.in[12], nullptr, DM, DM, (bf16_t*)(ws + WS_WOUT), scr, it, lane);
    if (which & 8) return;
    {
        const float* wq = p.in[14]; const float* sk = p.in[15]; const float* g2 = p.in[13];
        bf16_t* WsT = (bf16_t*)(ws + WS_WS);
        const int r32 = lane & 31, hh = lane >> 5;
        for (int it = gw; it < 16 * 4 * 64; it += NGW) {
            const int hp = it >> 8, kb = (it >> 6) & 3, nb = it & 63;
            f32x16 acc = {};
            const float* ap = sk + ((size_t)(hp * 128 + kb * 32 + r32)) * 128 + hh * 8;
            const float* bp = wq + ((size_t)(nb * 32 + r32)) * DM + hp * 128 + hh * 8;
#pragma unroll
            for (int s = 0; s < 8; ++s) {
                const bf16x8 a = cvt8(ap + s * 16), b = cvt8(bp + s * 16);
                acc = __builtin_amdgcn_mfma_f32_32x32x16_bf16(a, b, acc, 0, 0, 0);
            }
            const int kcol = nb * 32 + r32; const float gk = g2[kcol];
#pragma unroll
            for (int r = 0; r < 16; ++r) WsT[(size_t)(hp * 128 + kb * 32 + crow(r, hh)) * DM + kcol] = (bf16_t)f2bf(acc[r] * gk);
        }
    }
}
__device__ __forceinline__ void rope_rows8(const Params& p, int t0, int lane) {
    float* ct = (float*)(p.ws + WS_COS); float* st = (float*)(p.ws + WS_SIN);
#pragma unroll 1
    for (int it = 0; it < 4; ++it) {
        const int idx = it * 64 + lane, t = t0 + (idx >> 5), j = idx & 31;
        const float inv_freq = powf(10000.0f, -(float)j / 32.0f);
        const float ang = (float)t * inv_freq;
        float sv, cv; sincosf(ang, &sv, &cv); ct[t * 32 + j] = cv; st[t * 32 + j] = sv;
    }
}
__device__ __forceinline__ void phase0(const Params& p, LAS unsigned char* lds, bool late_ok, int gw, int NGW, int wave, int lane) {
    unsigned char* ws = p.ws;
    LAS float* scr = (LAS float*)(lds + wave * 16384);
    const float* x = p.in[0];
    {
        constexpr int I_IN = (DM / 64) * (NIN / 32);
        for (int it = gw; it < I_IN; it += NGW) p0_transpose_item(p.in[2], p.in[1], DM, NIN, (bf16_t*)(ws + WS_WIN), scr, it, lane);
    }
    prep_late(p, lds, gw, NGW, wave, lane, late_ok ? 1 : 7);
    for (int r = gw; r < NINP - NIN; r += NGW) {
        bf16_t* d = (bf16_t*)(ws + WS_WIN) + (size_t)(NIN + r) * DM;
#pragma unroll
        for (int i = 0; i < 4; ++i) *(u32x4*)(d + (i * 64 + lane) * 8) = (u32x4){0u, 0u, 0u, 0u};
    }
    {
        bf16_t* xb = (bf16_t*)(ws + WS_XB); float* rstd1 = (float*)(ws + WS_RSTD1);
        for (int t = gw; t + NGW < S; t += 2 * NGW) {
            const int t1 = t + NGW;
            f32x4 a[8], b[8];
#pragma unroll
            for (int i = 0; i < 8; ++i) { a[i] = __builtin_nontemporal_load((const f32x4*)(x + (size_t)t * DM + (i * 64 + lane) * 4)); b[i] = __builtin_nontemporal_load((const f32x4*)(x + (size_t)t1 * DM + (i * 64 + lane) * 4)); }
            float sa = 0.f, sb = 0.f;
#pragma unroll
            for (int i = 0; i < 8; ++i) {
                sa += (a[i][0] * a[i][0] + a[i][1] * a[i][1]) + (a[i][2] * a[i][2] + a[i][3] * a[i][3]);
                sb += (b[i][0] * b[i][0] + b[i][1] * b[i][1]) + (b[i][2] * b[i][2] + b[i][3] * b[i][3]);
                u32x2 wa, wb; wa.x = pk2(a[i][0], a[i][1]); wa.y = pk2(a[i][2], a[i][3]); wb.x = pk2(b[i][0], b[i][1]); wb.y = pk2(b[i][2], b[i][3]);
                *(u32x2*)(xb + (size_t)t * DM + (i * 64 + lane) * 4) = wa; *(u32x2*)(xb + (size_t)t1 * DM + (i * 64 + lane) * 4) = wb;
            }
            sa = wave_sum(sa); sb = wave_sum(sb);
            if (lane == 0) { rstd1[t] = rsqrtf(sa * (1.0f / DM) + EPS); rstd1[t1] = rsqrtf(sb * (1.0f / DM) + EPS); }
        }
    }
    if (!late_ok) {
        f32x4 sc[8];
#pragma unroll
        for (int i = 0; i < 8; ++i) sc[i] = *(const f32x4*)(p.in[13] + (i * 64 + lane) * 4) * PEER_USC;
        for (int e = gw; e < 16384; e += NGW) { f32x4 xv[8];
#pragma unroll
            for (int i = 0; i < 8; ++i) xv[i] = __builtin_nontemporal_load((const f32x4*)(p.in[16] + (size_t)e * DM + (i * 64 + lane) * 4));
            fp6_pack_store<false>(xv, sc, ws + WS_UT + (size_t)e * PEER_ROWB, lane); }
        for (int e = gw; e < 16384; e += NGW) { f32x4 xv[8];
#pragma unroll
            for (int i = 0; i < 8; ++i) xv[i] = __builtin_nontemporal_load((const f32x4*)(p.in[17] + (size_t)e * DM + (i * 64 + lane) * 4));
            fp6_pack_store_s(xv, PEER_VSC, ws + WS_VT + (size_t)e * PEER_ROWB, lane); }
    }
}

__device__ __forceinline__ float row16_sum(float v) {
    v += dpp_f<0xB1, 0xf>(0.f, v); v += dpp_f<0x4E, 0xf>(0.f, v); v += dpp_f<0x141, 0xf>(0.f, v); v += dpp_f<0x140, 0xf>(0.f, v);
    return v;
}
__device__ __forceinline__ void phase3(const Params& p, int tfirst, int tstep, int tcnt, int lane) {
    unsigned char* ws = p.ws;
    const bf16_t* kvraw = (const bf16_t*)(ws + WS_KVRAW); const bf16_t* proj = (const bf16_t*)(ws + WS_PROJ);
    bf16_t* Kh = (bf16_t*)(ws + WS_KH);
    const float* ct = (const float*)(ws + WS_COS); const float* st = (const float*)(ws + WS_SIN);
    const int s = lane & 15, hl = lane >> 4;
    const bool lowhalf = s < 8;
    const f32x4 gn0 = *(const f32x4*)(p.in[11] + 8 * s), gn1 = *(const f32x4*)(p.in[11] + 8 * s + 4), gr = *(const f32x4*)(p.in[11] + 128 + 4 * s);
    const int j0 = (4 * s) & 31;
    for (int ti = 0; ti < tcnt; ++ti) {
        const int t = tfirst + ti * tstep;
        const u32x2 krw = *(const u32x2*)(proj + (size_t)t * NINP + 2816 + 4 * s);
        const f32x4 cs = *(const f32x4*)(ct + t * 32 + j0), sn = *(const f32x4*)(st + t * 32 + j0);
        u32x4 kn[2];
#pragma unroll
        for (int pp = 0; pp < 2; ++pp) kn[pp] = *(const u32x4*)(kvraw + (size_t)t * 2048 + (4 * pp + hl) * 256 + 8 * s);
        const f32x4 xr = {bflo(krw.x), bfhi(krw.x), bflo(krw.y), bfhi(krw.y)};
        const float ssr = (xr[0] * xr[0] + xr[1] * xr[1]) + (xr[2] * xr[2] + xr[3] * xr[3]);
#pragma unroll
        for (int pp = 0; pp < 2; ++pp) {
            const int h = 4 * pp + hl;
            const u32x4 w = kn[pp];
            f32x4 x0 = {bflo(w.x), bfhi(w.x), bflo(w.y), bfhi(w.y)}, x1 = {bflo(w.z), bfhi(w.z), bflo(w.w), bfhi(w.w)};
            float ss = ssr + ((x0[0] * x0[0] + x0[1] * x0[1]) + (x0[2] * x0[2] + x0[3] * x0[3])) + ((x1[0] * x1[0] + x1[1] * x1[1]) + (x1[2] * x1[2] + x1[3] * x1[3]));
            ss = row16_sum(ss);
            const float rs = rsqrtf(ss * (1.0f / 192.0f) + EPS);
            x0 = x0 * gn0 * rs; x1 = x1 * gn1 * rs;
            const f32x4 y = xr * gr * rs;
            f32x4 pr;
#pragma unroll
            for (int q = 0; q < 4; ++q) pr[q] = __shfl_xor(y[q], 8);
            const f32x4 ro = lowhalf ? (y * cs - pr * sn) : (pr * sn + y * cs);
            bf16_t* kd = Kh + ((size_t)h * S + t) * 192;
            u32x4 o; o.x = pk2(x0[0], x0[1]); o.y = pk2(x0[2], x0[3]); o.z = pk2(x1[0], x1[1]); o.w = pk2(x1[2], x1[3]);
            *(u32x4*)(kd + 8 * s) = o;
            u32x2 orp; orp.x = pk2(ro[0], ro[1]); orp.y = pk2(ro[2], ro[3]);
            *(u32x2*)(kd + 128 + 4 * s) = orp;
        }
    }
}

constexpr int KP = 400, VP = 320;
template <int OFF> __device__ __forceinline__ s16x4 tr_read(unsigned addr) {
    s16x4 r; asm volatile("ds_read_b64_tr_b16 %0, %1 offset:%2" : "=&v"(r) : "v"(addr), "i"(OFF) : "memory"); return r;
}
__device__ __forceinline__ unsigned cvtpk(float lo, float hi) { unsigned r; asm volatile("v_cvt_pk_bf16_f32 %0, %1, %2" : "=v"(r) : "v"(lo), "v"(hi)); return r; }
#define PK8(L, H) ((bf16x8){L[0], L[1], L[2], L[3], H[0], H[1], H[2], H[3]})
constexpr float ATT_THR = 8.0f;

constexpr int ATT_KB = 64 * KP, ATT_VB = 64 * VP;
constexpr int ATT_VOFF = 2 * ATT_KB;
__device__ __forceinline__ float xhalf_max(float v) {
    unsigned a = __builtin_bit_cast(unsigned, v), b = a;
    asm volatile("s_nop 1\n\tv_permlane32_swap_b32 %0, %1" : "+v"(a), "+v"(b));
    return fmaxf(__builtin_bit_cast(float, a), __builtin_bit_cast(float, b));
}
__device__ __forceinline__ float xhalf_sum(float v) {
    unsigned a = __builtin_bit_cast(unsigned, v), b = a;
    asm volatile("s_nop 1\n\tv_permlane32_swap_b32 %0, %1" : "+v"(a), "+v"(b));
    return __builtin_bit_cast(float, a) + __builtin_bit_cast(float, b);
}
template <int OFF> __device__ __forceinline__ bf16x8 lds_read128(unsigned addr) {
    bf16x8 r; asm volatile("ds_read_b128 %0, %1 offset:%2" : "=&v"(r) : "v"(addr), "i"(OFF) : "memory"); return r;
}
#define LGKM_WAIT(n) do { asm volatile("s_waitcnt lgkmcnt(" #n ")" ::: "memory"); SBAR(); } while (0)
__device__ __forceinline__ f32x16 att_qk(unsigned kaddr, const bf16x8 (&qr)[12]) {
    f32x16 p = {};
    bf16x8 a0 = lds_read128<0>(kaddr), a1 = lds_read128<32>(kaddr), a2 = lds_read128<64>(kaddr), a3 = lds_read128<96>(kaddr);
    LGKM_WAIT(3); p = __builtin_amdgcn_mfma_f32_32x32x16_bf16(a0, qr[0], p, 0, 0, 0); a0 = lds_read128<128>(kaddr);
    LGKM_WAIT(3); p = __builtin_amdgcn_mfma_f32_32x32x16_bf16(a1, qr[1], p, 0, 0, 0); a1 = lds_read128<160>(kaddr);
    LGKM_WAIT(3); p = __builtin_amdgcn_mfma_f32_32x32x16_bf16(a2, qr[2], p, 0, 0, 0); a2 = lds_read128<192>(kaddr);
    LGKM_WAIT(3); p = __builtin_amdgcn_mfma_f32_32x32x16_bf16(a3, qr[3], p, 0, 0, 0); a3 = lds_read128<224>(kaddr);
    LGKM_WAIT(3); p = __builtin_amdgcn_mfma_f32_32x32x16_bf16(a0, qr[4], p, 0, 0, 0); a0 = lds_read128<256>(kaddr);
    LGKM_WAIT(3); p = __builtin_amdgcn_mfma_f32_32x32x16_bf16(a1, qr[5], p, 0, 0, 0); a1 = lds_read128<288>(kaddr);
    LGKM_WAIT(3); p = __builtin_amdgcn_mfma_f32_32x32x16_bf16(a2, qr[6], p, 0, 0, 0); a2 = lds_read128<320>(kaddr);
    LGKM_WAIT(3); p = __builtin_amdgcn_mfma_f32_32x32x16_bf16(a3, qr[7], p, 0, 0, 0); a3 = lds_read128<352>(kaddr);
    LGKM_WAIT(3); p = __builtin_amdgcn_mfma_f32_32x32x16_bf16(a0, qr[8], p, 0, 0, 0);
    LGKM_WAIT(2); p = __builtin_amdgcn_mfma_f32_32x32x16_bf16(a1, qr[9], p, 0, 0, 0);
    LGKM_WAIT(1); p = __builtin_amdgcn_mfma_f32_32x32x16_bf16(a2, qr[10], p, 0, 0, 0);
    LGKM_WAIT(0); p = __builtin_amdgcn_mfma_f32_32x32x16_bf16(a3, qr[11], p, 0, 0, 0);
    return p;
}
__device__ __forceinline__ void att_finish(f32x16& s, float m, float& lsum, bf16x8& pb0, bf16x8& pb1) {
    float ps = 0.f;
#pragma unroll
    for (int r = 0; r < 16; ++r) { s[r] = __builtin_amdgcn_exp2f(s[r] - m); ps += s[r]; }
    lsum += xhalf_sum(ps);
    u32x4 w0 = {cvtpk(s[0], s[1]), cvtpk(s[2], s[3]), cvtpk(s[4], s[5]), cvtpk(s[6], s[7])};
    u32x4 w1 = {cvtpk(s[8], s[9]), cvtpk(s[10], s[11]), cvtpk(s[12], s[13]), cvtpk(s[14], s[15])};
    pb0 = __builtin_bit_cast(bf16x8, w0); pb1 = __builtin_bit_cast(bf16x8, w1);
}
__device__ __forceinline__ void att_pv(unsigned vaddr, bf16x8 pb0, bf16x8 pb1, f32x16 (&o)[4]) {
#define VOFF(d0, s, hi) (((16 * (s) + 8 * (hi)) * VP) + 64 * (d0))
    const s16x4 a00l = tr_read<VOFF(0, 0, 0)>(vaddr), a00h = tr_read<VOFF(0, 0, 1)>(vaddr), a01l = tr_read<VOFF(0, 1, 0)>(vaddr), a01h = tr_read<VOFF(0, 1, 1)>(vaddr);
    const s16x4 a10l = tr_read<VOFF(1, 0, 0)>(vaddr), a10h = tr_read<VOFF(1, 0, 1)>(vaddr), a11l = tr_read<VOFF(1, 1, 0)>(vaddr), a11h = tr_read<VOFF(1, 1, 1)>(vaddr);
    LGKM_WAIT(4);
    o[0] = __builtin_amdgcn_mfma_f32_32x32x16_bf16(PK8(a00l, a00h), pb0, o[0], 0, 0, 0); o[0] = __builtin_amdgcn_mfma_f32_32x32x16_bf16(PK8(a01l, a01h), pb1, o[0], 0, 0, 0);
    const s16x4 a20l = tr_read<VOFF(2, 0, 0)>(vaddr), a20h = tr_read<VOFF(2, 0, 1)>(vaddr), a21l = tr_read<VOFF(2, 1, 0)>(vaddr), a21h = tr_read<VOFF(2, 1, 1)>(vaddr);
    LGKM_WAIT(4);
    o[1] = __builtin_amdgcn_mfma_f32_32x32x16_bf16(PK8(a10l, a10h), pb0, o[1], 0, 0, 0); o[1] = __builtin_amdgcn_mfma_f32_32x32x16_bf16(PK8(a11l, a11h), pb1, o[1], 0, 0, 0);
    const s16x4 a30l = tr_read<VOFF(3, 0, 0)>(vaddr), a30h = tr_read<VOFF(3, 0, 1)>(vaddr), a31l = tr_read<VOFF(3, 1, 0)>(vaddr), a31h = tr_read<VOFF(3, 1, 1)>(vaddr);
    LGKM_WAIT(4);
    o[2] = __builtin_amdgcn_mfma_f32_32x32x16_bf16(PK8(a20l, a20h), pb0, o[2], 0, 0, 0); o[2] = __builtin_amdgcn_mfma_f32_32x32x16_bf16(PK8(a21l, a21h), pb1, o[2], 0, 0, 0);
    LGKM_WAIT(0);
    o[3] = __builtin_amdgcn_mfma_f32_32x32x16_bf16(PK8(a30l, a30h), pb0, o[3], 0, 0, 0); o[3] = __builtin_amdgcn_mfma_f32_32x32x16_bf16(PK8(a31l, a31h), pb1, o[3], 0, 0, 0);
#undef VOFF
}
__device__ __forceinline__ void att_partial(const f32x16& s, float& m, float& lsum, f32x16 (&o)[4]) {
    float pmax = s[0];
#pragma unroll
    for (int r = 1; r < 16; ++r) pmax = fmaxf(pmax, s[r]);
    pmax = xhalf_max(pmax);
    if (!__all(pmax - m <= ATT_THR)) {
        const float mn = fmaxf(m, pmax); const float alpha = __builtin_amdgcn_exp2f(m - mn); m = mn; lsum *= alpha;
#pragma unroll
        for (int d = 0; d < 4; ++d)
#pragma unroll
            for (int r = 0; r < 16; ++r) o[d][r] *= alpha;
    }
}

__device__ __forceinline__ void attn_unit(const Params& p, LAS unsigned char* lds, int head, int qb, int tid, int wave, int lane) {
    unsigned char* ws = p.ws;
    const bf16_t* Qh = (const bf16_t*)(ws + WS_QH); const bf16_t* Kh = (const bf16_t*)(ws + WS_KH);
    bf16_t* mix = (bf16_t*)(ws + WS_MIX);
    const int rg = wave & 3, kh = wave >> 2, r32 = lane & 31, hh = lane >> 5;
    const int q0row = qb * 128 + rg * 32;
    bf16x8 qr[12];
    {
        constexpr float QS = 0.07216878364870322f * 1.4426950408889634f;
        const int t = q0row + r32;
        const bf16_t* qp = (const bf16_t*)(ws + WS_QRAW) + (size_t)t * 1536 + head * 192 + hh * 8;
        u32x4 qw[12];
#pragma unroll
        for (int ks = 0; ks < 12; ++ks) qw[ks] = *(const u32x4*)(qp + ks * 16);
        const float* ctp = (const float*)(ws + WS_COS) + t * 32 + hh * 8; const float* stp = (const float*)(ws + WS_SIN) + t * 32 + hh * 8;
        f32x4 cs[2][2], sn[2][2];
#pragma unroll
        for (int pr = 0; pr < 2; ++pr)
#pragma unroll
            for (int c = 0; c < 2; ++c) { cs[pr][c] = *(const f32x4*)(ctp + 16 * pr + 4 * c); sn[pr][c] = *(const f32x4*)(stp + 16 * pr + 4 * c); }
        float ss = 0.f;
#pragma unroll
        for (int ks = 0; ks < 12; ++ks)
#pragma unroll
            for (int c = 0; c < 4; ++c) { const float a = bflo(qw[ks][c]), b = bfhi(qw[ks][c]); ss += a * a + b * b; }
        ss = xhalf_sum(ss);
        const float rs = rsqrtf(ss * (1.0f / 192.0f) + EPS);
        const float* gqp = p.in[10] + hh * 8;
#define ATT_QX(ks, X0, X1) do { const f32x4 g0_ = *(const f32x4*)(gqp + (ks) * 16), g1_ = *(const f32x4*)(gqp + (ks) * 16 + 4); const u32x4 w_ = qw[ks]; \
            X0 = (f32x4){bflo(w_.x), bfhi(w_.x), bflo(w_.y), bfhi(w_.y)} * g0_ * rs; X1 = (f32x4){bflo(w_.z), bfhi(w_.z), bflo(w_.w), bfhi(w_.w)} * g1_ * rs; } while (0)
#define ATT_QPK(X0, X1) __builtin_bit_cast(bf16x8, (u32x4){pk2(X0[0] * QS, X0[1] * QS), pk2(X0[2] * QS, X0[3] * QS), pk2(X1[0] * QS, X1[1] * QS), pk2(X1[2] * QS, X1[3] * QS)})
#pragma unroll
        for (int ks = 0; ks < 8; ++ks) { f32x4 x0, x1; ATT_QX(ks, x0, x1); qr[ks] = ATT_QPK(x0, x1); }
#pragma unroll
        for (int pr = 0; pr < 2; ++pr) {
            f32x4 a0, a1, b0, b1; ATT_QX(8 + pr, a0, a1); ATT_QX(10 + pr, b0, b1);
            const f32x4 ra0 = a0 * cs[pr][0] - b0 * sn[pr][0], ra1 = a1 * cs[pr][1] - b1 * sn[pr][1];
            const f32x4 rb0 = a0 * sn[pr][0] + b0 * cs[pr][0], rb1 = a1 * sn[pr][1] + b1 * cs[pr][1];
            qr[8 + pr] = ATT_QPK(ra0, ra1); qr[10 + pr] = ATT_QPK(rb0, rb1);
        }
#undef ATT_QX
#undef ATT_QPK
    }
    const int ntiles = 2 * qb + 2, mylast = 2 * qb + (rg >> 1);
    float m = -1e30f, lsum = 0.f; f32x16 o[4] = {};
    const bf16_t* kbase = Kh + (size_t)head * S * 192; const bf16_t* vbase = (const bf16_t*)(ws + WS_KVRAW) + head * 256 + 128;
    unsigned kgo[4], vgo[3];
#pragma unroll
    for (int i = 0; i < 4; ++i) { const int s = 64 * (wave + 8 * i) + lane, r = s / 25, c = s - 25 * r; kgo[i] = (unsigned)(r * 384 + (c < 24 ? c : 23) * 16); }
#pragma unroll
    for (int i = 0; i < 3; ++i) { const int s = 64 * (wave + 8 * i) + lane, r = s / 20, c = s - 20 * r; vgo[i] = (unsigned)(r * 4096 + (c < 16 ? c : 15) * 16); }
#define ATT_DMA(t, kb_, vb_) do { unsigned long long kt_ = (unsigned long long)(kbase + (size_t)(t) * 64 * 192), vt_ = (unsigned long long)(vbase + (size_t)(t) * 64 * 2048); \
        asm volatile("" : "+s"(kt_), "+s"(vt_));        \
        const unsigned char* kt = (const unsigned char*)kt_; const unsigned char* vt = (const unsigned char*)vt_; \
        _Pragma("unroll") for (int i = 0; i < 4; ++i) if (wave + 8 * i < 25) __builtin_amdgcn_global_load_lds((const unsigned*)(kt + kgo[i]), (LAS unsigned*)(lds + (kb_) * ATT_KB + 1024 * (wave + 8 * i)), 16, 0, 0); \
        _Pragma("unroll") for (int i = 0; i < 3; ++i) if (wave + 8 * i < 20) __builtin_amdgcn_global_load_lds((const unsigned*)(vt + vgo[i]), (LAS unsigned*)(lds + ATT_VOFF + (vb_) * ATT_VB + 1024 * (wave + 8 * i)), 16, 0, 0); } while (0)
#define ATT_DMA_WAIT() asm volatile("s_waitcnt vmcnt(0)" ::: "memory")
    const unsigned ldsbase = (unsigned)(size_t)lds;
    const unsigned kaddr0 = ldsbase + (unsigned)((32 * kh + r32) * KP + hh * 16);
    const unsigned vrel = (unsigned)(ATT_VOFF + (32 * kh + 4 * hh + ((lane & 15) >> 2)) * VP + (16 * ((lane >> 4) & 1) + 4 * (lane & 3)) * 2);
    ATT_DMA(0, 0, 0); ATT_DMA_WAIT(); __syncthreads();
    bf16x8 pb0, pb1;
    const bool more0 = (1 < ntiles);
    if (more0) ATT_DMA(1, 1, 1);
    f32x16 sprev = att_qk(kaddr0, qr);
    att_partial(sprev, m, lsum, o);
    ATT_DMA_WAIT();
    __syncthreads();
    int vprev = 0, vcur = 1;
#define ATT_STEP(tt, SP, SC) do { const bool more = ((tt) + 1 < ntiles); const int vnext = (vcur == 2) ? 0 : vcur + 1; \
        if (more) ATT_DMA((tt) + 1, ((tt) + 1) & 1, vnext);         \
        if ((tt) <= mylast) SC = att_qk(kaddr0 + ((tt) & 1) * ATT_KB, qr); \
        else { _Pragma("unroll") for (int r = 0; r < 16; ++r) SC[r] = -1e30f; }        \
        att_finish(SP, m, lsum, pb0, pb1); \
        att_pv(ldsbase + vprev * ATT_VB + vrel, pb0, pb1, o); \
        att_partial(SC, m, lsum, o); \
        vprev = vcur; vcur = vnext; \
        ATT_DMA_WAIT(); \
        __syncthreads(); } while (0)
    f32x16 snext;
#pragma unroll 1
    for (int t = 1; t <= ntiles; t += 2) { ATT_STEP(t, sprev, snext); ATT_STEP(t + 1, snext, sprev); }
#undef ATT_STEP
#undef ATT_DMA
#undef ATT_DMA_WAIT
    LAS float* scr = (LAS float*)lds + (size_t)rg * 66 * 64 + lane;
    if (kh == 1) {
        scr[0] = m; scr[64] = lsum;
#pragma unroll
        for (int d = 0; d < 4; ++d)
#pragma unroll
            for (int r = 0; r < 16; ++r) scr[(2 + d * 16 + r) * 64] = o[d][r];
    }
    __syncthreads();
    if (kh == 0) {
        const float m2 = scr[0], l2 = scr[64];
        const float mn = fmaxf(m, m2), a1 = __builtin_amdgcn_exp2f(m - mn), a2 = __builtin_amdgcn_exp2f(m2 - mn);
        const float inv = 1.0f / (lsum * a1 + l2 * a2);
        LAS unsigned char* ob = lds + 69632 + (rg * 32 + r32) * 272 + 8 * hh;
#pragma unroll
        for (int d = 0; d < 4; ++d)
#pragma unroll
            for (int g4 = 0; g4 < 4; ++g4) {
                float v[4];
#pragma unroll
                for (int i = 0; i < 4; ++i) { const int r = 4 * g4 + i; v[i] = (o[d][r] * a1 + scr[(2 + d * 16 + r) * 64] * a2) * inv; }
                u32x2 w; w.x = pk2(v[0], v[1]); w.y = pk2(v[2], v[3]);
                *(LAS u32x2*)(ob + 64 * d + 16 * g4) = w;
            }
    }
    __syncthreads();
    {
        bf16_t* op = mix + (size_t)(qb * 128) * DM + 1024 + head * 128;
#pragma unroll
        for (int k = 0; k < 4; ++k) {
            const int chunk = tid + 512 * k, row = chunk >> 4, c = chunk & 15;
            *(u32x4*)(op + (size_t)row * DM + c * 8) = *(const LAS u32x4*)(lds + 69632 + row * 272 + c * 16);
        }
    }
    __syncthreads();
}

__device__ __forceinline__ void gmlp_unit(const Params& p, LAS unsigned char* lds, int nb, int h, int tid, int wave, int lane) {
    unsigned char* ws = p.ws;
    const bf16_t* proj = (const bf16_t*)(ws + WS_PROJ); bf16_t* mix = (bf16_t*)(ws + WS_MIX);
    const float* ssv = (const float*)(ws + WS_ROWSS);
    const float* vg = p.in[3]; const float* wsp = p.in[4]; const float* bs = p.in[5];
    const int pcol = (tid & 15) * 8;
    u32x4 vw[4], uw[4]; f32x4 wa[4], wb[4]; float rsv[4];
    const f32x4 g0 = *(const f32x4*)(vg + h * 128 + pcol), g1 = *(const f32x4*)(vg + h * 128 + pcol + 4);
#pragma unroll
    for (int i = 0; i < 4; ++i) {
        const int r = (tid >> 4) + 32 * i, t = nb * 128 + r;
        vw[i] = *(const u32x4*)(proj + (size_t)t * NINP + 1024 + h * 128 + pcol);
        uw[i] = *(const u32x4*)(proj + (size_t)t * NINP + h * 128 + pcol);
        rsv[i] = ssv[t];
        wa[i] = *(const f32x4*)(wsp + ((size_t)h * 128 + r) * 128 + pcol); wb[i] = *(const f32x4*)(wsp + ((size_t)h * 128 + r) * 128 + pcol + 4);
    }
#pragma unroll
    for (int i = 0; i < 4; ++i) {
        const int r = (tid >> 4) + 32 * i;
        const float rs = rsqrtf(rsv[i] * (1.0f / 1024.0f) + EPS);
        const u32x4 w = vw[i];
        u32x4 ov;
        ov.x = pk2(bflo(w.x) * rs * g0[0], bfhi(w.x) * rs * g0[1]); ov.y = pk2(bflo(w.y) * rs * g0[2], bfhi(w.y) * rs * g0[3]);
        ov.z = pk2(bflo(w.z) * rs * g1[0], bfhi(w.z) * rs * g1[1]); ov.w = pk2(bflo(w.w) * rs * g1[2], bfhi(w.w) * rs * g1[3]);
        *(LAS u32x4*)(lds + r * VP + pcol * 2) = ov;
        u32x4 aw; aw.x = pk2(pcol + 0 <= r ? wa[i][0] : 0.f, pcol + 1 <= r ? wa[i][1] : 0.f); aw.y = pk2(pcol + 2 <= r ? wa[i][2] : 0.f, pcol + 3 <= r ? wa[i][3] : 0.f);
        aw.z = pk2(pcol + 4 <= r ? wb[i][0] : 0.f, pcol + 5 <= r ? wb[i][1] : 0.f); aw.w = pk2(pcol + 6 <= r ? wb[i][2] : 0.f, pcol + 7 <= r ? wb[i][3] : 0.f);
        *(LAS u32x4*)(lds + 40960 + r * 272 + pcol * 2) = aw;
    }
    __syncthreads();
    const int ib = wave & 3, ch = wave >> 2, r32 = lane & 31, hh = lane >> 5;
    const int irow = 32 * ib + r32;
    f32x16 acc0 = {}, acc1 = {};
    const unsigned vaddr = (unsigned)(size_t)lds + (unsigned)((8 * hh + ((lane & 15) >> 2)) * VP + (64 * ch + 16 * ((lane >> 4) & 1) + 4 * (lane & 3)) * 2);
    const LAS unsigned char* wrow = lds + 40960 + irow * 272 + hh * 16;
#define GSTEP(s) do { if ((s) < 2 * (ib + 1)) { \
        const bf16x8 af = *(const LAS bf16x8*)(wrow + (s) * 32); \
        const s16x4 b0l = tr_read<(16 * (s)) * VP>(vaddr), b0h = tr_read<(16 * (s) + 4) * VP>(vaddr), b1l = tr_read<(16 * (s)) * VP + 64>(vaddr), b1h = tr_read<(16 * (s) + 4) * VP + 64>(vaddr); \
        LDS_WAIT(); SBAR(); \
        acc0 = __builtin_amdgcn_mfma_f32_32x32x16_bf16(af, PK8(b0l, b0h), acc0, 0, 0, 0); acc1 = __builtin_amdgcn_mfma_f32_32x32x16_bf16(af, PK8(b1l, b1h), acc1, 0, 0, 0); } } while (0)
    GSTEP(0); GSTEP(1); GSTEP(2); GSTEP(3); GSTEP(4); GSTEP(5); GSTEP(6); GSTEP(7);
#undef GSTEP
#pragma unroll
    for (int r = 0; r < 16; ++r) {
        const int i = 32 * ib + crow(r, hh); const float b = bs[h * 128 + i];
        LAS float* orow = (LAS float*)(lds + 81920 + i * 528) + 64 * ch + r32;
        orow[0] = acc0[r] + b; orow[32] = acc1[r] + b;
    }
    __syncthreads();
#pragma unroll
    for (int k = 0; k < 4; ++k) {
        const int i = (tid >> 4) + 32 * k, t = nb * 128 + i;
        const LAS float* orow = (const LAS float*)(lds + 81920 + i * 528) + pcol;
        const f32x4 o0 = *(const LAS f32x4*)orow, o1 = *(const LAS f32x4*)(orow + 4);
        const u32x4 u_ = uw[k];
        u32x4 ow;
        ow.x = pk2(bflo(u_.x) * o0[0], bfhi(u_.x) * o0[1]); ow.y = pk2(bflo(u_.y) * o0[2], bfhi(u_.y) * o0[3]);
        ow.z = pk2(bflo(u_.z) * o1[0], bfhi(u_.z) * o1[1]); ow.w = pk2(bflo(u_.w) * o1[2], bfhi(u_.w) * o1[3]);
        *(u32x4*)(mix + (size_t)t * DM + h * 128 + pcol) = ow;
    }
    __syncthreads();
}

__device__ __forceinline__ void phase7(const Params& p, LAS unsigned char* lds, int gw, int NGW, int wave, int lane, bool conv_u) {
    unsigned char* ws = p.ws;
    const float* sc = (const float*)(ws + WS_SC); int* ex = (int*)(ws + WS_EXP); float* gt = (float*)(ws + WS_GATE);
    const float NEG = -3.0e38f;
    LAS float* sl = (LAS float*)(lds + wave * 1024);
    const int j8 = lane & 7, g8 = lane >> 3, row = lane >> 4, i16 = lane & 15;
    int ci[4], cj[4]; bool cval[4];
    {
        constexpr int starts[16] = {0, 16, 24, 29, 33, 36, 38, 40, 42, 43, 44, 45, 46, 47, 48, 49};
#pragma unroll
        for (int m = 0; m < 4; ++m) {
            const int c = i16 + 16 * m; int a = 0, st = 0;
#pragma unroll
            for (int i = 1; i < 16; ++i) if (c >= starts[i]) { a = i; st = starts[i]; }
            cval[m] = c < 50; ci[m] = cval[m] ? a : 0; cj[m] = cval[m] ? (c - st) : 0;
        }
    }
    f32x4 nx0, nx1, nx2, nx3;
    if (gw < S / 4) { const float* b = sc + (size_t)(gw * 4) * DM + lane * 16; nx0 = *(const f32x4*)b; nx1 = *(const f32x4*)(b + 4); nx2 = *(const f32x4*)(b + 8); nx3 = *(const f32x4*)(b + 12); }
    f32x4 ux0[8], ux1[8];
    for (int tb = gw; tb < S / 4; tb += NGW)
#pragma unroll 1
    for (int n8 = 0; n8 < 8; ++n8) {
        const int it = tb * 8 + n8;
        const int t = it >> 1, hh = it & 1;
        if (conv_u && !(n8 & 1)) {
            const float* s0 = p.in[16] + (size_t)it * DM; const float* s1 = s0 + DM;
#pragma unroll
            for (int i = 0; i < 8; ++i) { ux0[i] = __builtin_nontemporal_load((const f32x4*)(s0 + (i * 64 + lane) * 4)); ux1[i] = __builtin_nontemporal_load((const f32x4*)(s1 + (i * 64 + lane) * 4)); }
            __builtin_amdgcn_sched_barrier(0);
        }
        float v[16];
#pragma unroll
        for (int q = 0; q < 4; ++q) { v[q] = nx0[q]; v[4 + q] = nx1[q]; v[8 + q] = nx2[q]; v[12 + q] = nx3[q]; }
        { const int it2 = n8 < 7 ? it + 1 : (tb + NGW) * 8;
          if (it2 < S * 2) { const float* b = sc + (size_t)(it2 >> 1) * DM + (it2 & 1) * 1024 + lane * 16;
            nx0 = *(const f32x4*)b; nx1 = *(const f32x4*)(b + 4); nx2 = *(const f32x4*)(b + 8); nx3 = *(const f32x4*)(b + 12); } }
#pragma unroll
        for (int m = 0; m < 16; ++m) v[m] = __builtin_bit_cast(float, (__builtin_bit_cast(unsigned, v[m]) & ~127u) | (unsigned)(16 * j8 + m));
#define P7_CE(A, B) do { float hi_, lo_; asm("v_max_f32 %0, %2, %3\n\tv_min_f32 %1, %2, %3" : "=&v"(hi_), "=&v"(lo_) : "v"(v[A]), "v"(v[B])); v[A] = hi_; v[B] = lo_; } while (0)
#define P7_MAXDPP(D, OWN, OTH, CTRLSTR) asm("s_nop 1\n\tv_max_f32_dpp %0, %1, %2 " CTRLSTR " row_mask:0xf bank_mask:0xf" : "=v"(D) : "v"(OTH), "v"(OWN))
        P7_CE(0, 13); P7_CE(1, 12); P7_CE(2, 15); P7_CE(3, 14); P7_CE(4, 8); P7_CE(5, 6); P7_CE(7, 11); P7_CE(9, 10);
        P7_CE(0, 5); P7_CE(1, 7); P7_CE(2, 9); P7_CE(3, 4); P7_CE(6, 13); P7_CE(8, 14); P7_CE(10, 15); P7_CE(11, 12);
        P7_CE(0, 1); P7_CE(2, 3); P7_CE(4, 5); P7_CE(6, 8); P7_CE(7, 9); P7_CE(10, 11); P7_CE(12, 13); P7_CE(14, 15);
        P7_CE(0, 2); P7_CE(1, 3); P7_CE(4, 10); P7_CE(5, 11); P7_CE(6, 7); P7_CE(8, 9); P7_CE(12, 14); P7_CE(13, 15);
        P7_CE(1, 2); P7_CE(3, 12); P7_CE(4, 6); P7_CE(5, 7); P7_CE(8, 10); P7_CE(9, 11); P7_CE(13, 14);
        P7_CE(1, 4); P7_CE(2, 6); P7_CE(5, 8); P7_CE(7, 10); P7_CE(9, 13); P7_CE(11, 14);
        P7_CE(2, 4); P7_CE(3, 6); P7_CE(9, 12); P7_CE(11, 13);
        P7_CE(3, 5); P7_CE(6, 8); P7_CE(7, 9); P7_CE(10, 12);
        P7_CE(3, 4); P7_CE(5, 6); P7_CE(7, 8); P7_CE(9, 10); P7_CE(11, 12);
        P7_CE(6, 7); P7_CE(8, 9);
#define P7_MERGE(CTRLSTR) do { float t_[16]; \
            _Pragma("unroll") for (int i = 0; i < 16; ++i) P7_MAXDPP(t_[i], v[i], v[15 - i], CTRLSTR); \
            _Pragma("unroll") for (int i = 0; i < 16; ++i) v[i] = t_[i]; \
            _Pragma("unroll") for (int j = 8; j >= 1; j >>= 1) _Pragma("unroll") for (int i = 0; i < 16; ++i) if ((i & j) == 0) P7_CE(i, i + j); } while (0)
        P7_MERGE("quad_perm:[1,0,3,2]"); P7_MERGE("quad_perm:[2,3,0,1]"); P7_MERGE("row_half_mirror");
#undef P7_MERGE
#undef P7_CE
        if (j8 == 0) {
#pragma unroll
            for (int q = 0; q < 4; ++q) *(LAS f32x4*)(sl + g8 * 16 + 4 * q) = (f32x4){v[4 * q], v[4 * q + 1], v[4 * q + 2], v[4 * q + 3]};
        }
        LDS_WAIT(); asm volatile("" ::: "memory");
        float cv[4], og[4]; int id[4];
#pragma unroll
        for (int m = 0; m < 4; ++m) {
            const float s1 = sl[(2 * row) * 16 + ci[m]], s2 = sl[(2 * row + 1) * 16 + cj[m]];
            og[m] = cval[m] ? (s1 + s2) : NEG; cv[m] = og[m];
            id[m] = (int)((__builtin_bit_cast(unsigned, s1) & 127u) * 128u + (__builtin_bit_cast(unsigned, s2) & 127u));
        }
        LDS_WAIT(); asm volatile("" ::: "memory");
        float M0 = 0.f;
#pragma unroll
        for (int k = 0; k < 16; ++k) {
            float mx, m1_;
            asm("v_max3_f32 %0, %1, %2, %3" : "=v"(m1_) : "v"(cv[0]), "v"(cv[1]), "v"(cv[2]));
            asm("v_max_f32 %0, %1, %2" : "=v"(mx) : "v"(m1_), "v"(cv[3]));
            P7_MAXDPP(mx, mx, mx, "quad_perm:[1,0,3,2]"); P7_MAXDPP(mx, mx, mx, "quad_perm:[2,3,0,1]");
            P7_MAXDPP(mx, mx, mx, "row_half_mirror"); P7_MAXDPP(mx, mx, mx, "row_mirror");
            if (k == 0) M0 = mx;
#pragma unroll
            for (int m = 0; m < 4; ++m) cv[m] = (cv[m] == mx) ? NEG : cv[m];
        }
        bool sel[4]; float e[4]; float es = 0.f;
#pragma unroll
        for (int m = 0; m < 4; ++m) { sel[m] = (cv[m] != og[m]); e[m] = sel[m] ? __expf(og[m] - M0) : 0.f; es += e[m]; }
        es += dpp_f<0xB1, 0xf>(0.f, es); es += dpp_f<0x4E, 0xf>(0.f, es); es += dpp_f<0x141, 0xf>(0.f, es); es += dpp_f<0x140, 0xf>(0.f, es);
        const float inv = 1.0f / es;
        int basepos = 0;
        const int head = 4 * hh + row;
#pragma unroll
        for (int m = 0; m < 4; ++m) {
            const unsigned long long bl = __ballot(sel[m]);
            const unsigned rbits = (unsigned)(bl >> (16 * row)) & 0xffffu;
            const int pos = basepos + __popc(rbits & ((1u << i16) - 1u));
            if (sel[m] && pos < 16) { ex[(size_t)t * 128 + head * 16 + pos] = id[m]; gt[(size_t)t * 128 + head * 16 + pos] = e[m] * inv; }
            basepos += __popc(rbits);
        }
        if (conv_u && (n8 & 1)) {
            f32x4 usc[8];
#pragma unroll
            for (int i = 0; i < 8; ++i) usc[i] = *(const f32x4*)(p.in[13] + (i * 64 + lane) * 4) * PEER_USC;
            unsigned char* d0 = ws + WS_UT + (size_t)(it - 1) * PEER_ROWB;
            fp6_pack_store<false>(ux0, usc, d0, lane); fp6_pack_store<false>(ux1, usc, d0 + PEER_ROWB, lane);
        }
    }
}

typedef __bf16 bf16x32v __attribute__((ext_vector_type(32)));
typedef __bf16 bf16x2v __attribute__((ext_vector_type(2)));
typedef float f32x2 __attribute__((ext_vector_type(2)));
#ifndef P8_THROTTLE
#define P8_THROTTLE 0
#endif
constexpr unsigned P8_SLACK = 12;
#ifndef P8_SWEEPSYNC
#define P8_SWEEPSYNC 1
#endif
#ifndef P8_MIDSYNC
#define P8_MIDSYNC 2
#endif
__device__ __forceinline__ void phase8(const Params& p, LAS unsigned char* lds, float* dst, const XcdBarrier& xb, int gw, int NGW, int wave, int lane) {
    unsigned char* ws = p.ws;
    const bf16_t* x1b = (const bf16_t*)(ws + WS_X1B); const unsigned char* UT = ws + WS_UT; const unsigned char* VT = ws + WS_VT;
    const int* ex = (const int*)(ws + WS_EXP); const float* gt = (const float*)(ws + WS_GATE); const float* ss2 = (const float*)(ws + WS_ROWSS) + 3 * S;
    const float* out = p.out;
    LAS unsigned* list = (LAS unsigned*)(lds + 131072 + wave * 2048);
    LAS unsigned* hist = (LAS unsigned*)(lds + 147456 + wave * 1024);
    for (int tb = gw; tb < S / 4; tb += NGW) {
        const int t0 = tb * 4;
        int id[8]; float gv[8];
#pragma unroll
        for (int r = 0; r < 8; ++r) { const size_t o = (size_t)(t0 + (r >> 1)) * 128 + (r & 1) * 64 + lane; id[r] = ex[o]; gv[r] = gt[o]; }
        s16x4 xr[4][8];
#pragma unroll
        for (int j = 0; j < 4; ++j)
#pragma unroll
            for (int q = 0; q < 8; ++q) xr[j][q] = __builtin_bit_cast(s16x4, *(const u32x2*)(x1b + (size_t)(t0 + j) * DM + (q * 64 + lane) * 4));
        const float rs0 = rsqrtf(ss2[t0 + 0] * (1.0f / DM) + EPS) * (1.0f / PEER_USC), rs1 = rsqrtf(ss2[t0 + 1] * (1.0f / DM) + EPS) * (1.0f / PEER_USC);
        const float rs2 = rsqrtf(ss2[t0 + 2] * (1.0f / DM) + EPS) * (1.0f / PEER_USC), rs3 = rsqrtf(ss2[t0 + 3] * (1.0f / DM) + EPS) * (1.0f / PEER_USC);
#pragma unroll
        for (int j = 0; j < 4; ++j) hist[j * 64 + lane] = 0u;
        LDS_WAIT(); asm volatile("" ::: "memory");
        unsigned pos[8];
#pragma unroll
        for (int r = 0; r < 8; ++r) pos[r] = __hip_atomic_fetch_add(hist + (r >> 1) * 64 + (id[r] >> 8), 1u, __ATOMIC_RELAXED, __HIP_MEMORY_SCOPE_WORKGROUP);
        LDS_WAIT(); asm volatile("" ::: "memory");
        unsigned cnt[4], inc[4];
#pragma unroll
        for (int j = 0; j < 4; ++j) { cnt[j] = hist[j * 64 + lane]; inc[j] = cnt[j]; }
#pragma unroll
        for (int o = 1; o < 64; o <<= 1)
#pragma unroll
            for (int j = 0; j < 4; ++j) { const unsigned n = __shfl_up(inc[j], o); if (lane >= o) inc[j] += n; }
        LDS_WAIT(); asm volatile("" ::: "memory");
#pragma unroll
        for (int j = 0; j < 4; ++j) hist[j * 64 + lane] = inc[j] - cnt[j];
        LDS_WAIT(); asm volatile("" ::: "memory");
#pragma unroll
        for (int r = 0; r < 8; ++r) { const unsigned d = hist[(r >> 1) * 64 + (id[r] >> 8)] + pos[r]; list[4u * d + (unsigned)(r >> 1)] = (unsigned)id[r] | ((unsigned)(r >> 1) << 14) | (f2bf(gv[r]) << 16); }
        LDS_WAIT(); asm volatile("" ::: "memory");
        {
            typedef unsigned u32x16 __attribute__((ext_vector_type(16)));
            const __amdgpu_buffer_rsrc_t urs = __builtin_amdgcn_make_buffer_rsrc((void*)UT, 0, 16384 * PEER_ROWB, 0x00020000);
            const int vo4 = lane * 16, vo2 = lane * 8 + 1024;
            const bool lb0 = (lane & 1) != 0, lb1 = (lane & 2) != 0, lb2 = (lane & 4) != 0;
#define P8_ULOADE(k, en_) do { const unsigned en = (en_); const int ro = (int)((en & 0x3fffu) * (unsigned)PEER_ROWB); \
            u4[k] = __builtin_amdgcn_raw_buffer_load_b128(urs, vo4, ro, 0); u2[k] = __builtin_amdgcn_raw_buffer_load_b64(urs, vo2, ro, 0); } while (0)
#define P8_ULOAD(k, i) do { const unsigned en = (unsigned)__builtin_amdgcn_readfirstlane((int)list[(i)]); const int ro = (int)((en & 0x3fffu) * (unsigned)PEER_ROWB); \
            u4[k] = __builtin_amdgcn_raw_buffer_load_b128(urs, vo4, ro, 0); u2[k] = __builtin_amdgcn_raw_buffer_load_b64(urs, vo2, ro, 0); } while (0)
#define P8_UPROC2(k, dk) do { const u32x6 pk = {u4[k][0], u4[k][1], u4[k][2], u4[k][3], u2[k][0], u2[k][1]}; \
            const u32x16 r_ = __builtin_bit_cast(u32x16, __builtin_amdgcn_cvt_scalef32_pk32_bf16_fp6(pk, 1.0f)); \
            f32x4 a0 = {0.f, 0.f, 0.f, 0.f}, a1 = {0.f, 0.f, 0.f, 0.f}; \
            _Pragma("unroll") for (int q = 0; q < 8; q += 2) { \
                a0 = __builtin_amdgcn_mfma_f32_4x4x4bf16_1k(__builtin_bit_cast(s16x4, (u32x2){r_[2 * q], r_[2 * q + 1]}), xr[(k) & 3][q], a0, 0, 0, 0); \
                a1 = __builtin_amdgcn_mfma_f32_4x4x4bf16_1k(__builtin_bit_cast(s16x4, (u32x2){r_[2 * q + 2], r_[2 * q + 3]}), xr[(k) & 3][q + 1], a1, 0, 0, 0); } \
            const f32x4 a_ = a0 + a1; \
            const float e0 = lb0 ? a_[1] : a_[0], e1 = lb0 ? a_[3] : a_[2]; dd[dk] = lb1 ? e1 : e0; } while (0)
#ifndef P8_URING
#define P8_URING 8
#endif
#if (PROBE_DUP >> 10) & 1
#define P8_UREPS 2
#else
#define P8_UREPS 1
#endif
#pragma unroll 1
            for (int urep = 0; urep < P8_UREPS; ++urep) {
                u32x4 u4[P8_URING]; u32x2 u2[P8_URING];
#pragma unroll
                for (int k = 0; k < P8_URING; ++k) P8_ULOAD(k, k);
                f32x4 vx[8];
#pragma unroll 1
                for (int i0 = 0; i0 < 512; i0 += P8_URING) {
                    if (P8_SWEEPSYNC && i0 == 256 && NGW == S / 4) xcd_local_barrier(xb);
                    if (urep == P8_UREPS - 1 && NGW == S / 4) {
                        if ((i0 & 63) == 0) {
                            const float* s0 = p.in[17] + (size_t)(tb * 8 + (i0 >> 6)) * DM;
#pragma unroll
                            for (int i = 0; i < 8; ++i) vx[i] = __builtin_nontemporal_load((const f32x4*)(s0 + (i * 64 + lane) * 4));
                        } else if ((i0 & 63) == 32) fp6_pack_store_s(vx, PEER_VSC, ws + WS_VT + (size_t)(tb * 8 + (i0 >> 6)) * PEER_ROWB, lane);
                    }
#pragma unroll
                    for (int hb = 0; hb < P8_URING / 8; ++hb) {
                        const int i = i0 + 8 * hb;
                        const unsigned ev = list[i + (lane & 7)]; const unsigned jl = (unsigned)lane & 3u;
                        const float gl = __builtin_bit_cast(float, ev & 0xffff0000u), rl = jl == 0u ? rs0 : (jl == 1u ? rs1 : (jl == 2u ? rs2 : rs3));
                        float dd[8];
                        const int nxi = i + P8_URING + (lane & 7);
                        const unsigned nxv = list[nxi < 512 ? nxi : 504 + (lane & 7)];
#pragma unroll
                        for (int k = 0; k < 8; ++k) { P8_UPROC2(8 * hb + k, k); P8_ULOADE(8 * hb + k, (unsigned)__builtin_amdgcn_readlane((int)nxv, k)); }
                        float w4[4], w2[2];
#pragma unroll
                        for (int q = 0; q < 4; ++q) { const float kp = lb2 ? dd[q + 4] : dd[q], sd = lb2 ? dd[q] : dd[q + 4]; w4[q] = kp + __shfl_xor(sd, 4); }
#pragma unroll
                        for (int q = 0; q < 2; ++q) { const float kp = lb1 ? w4[q + 2] : w4[q], sd = lb1 ? w4[q] : w4[q + 2]; w2[q] = kp + __shfl_xor(sd, 2); }
                        float dres; { const float kp = lb0 ? w2[1] : w2[0], sd = lb0 ? w2[0] : w2[1]; dres = kp + __shfl_xor(sd, 1); }
                        dres += __shfl_xor(dres, 8); dres += __shfl_xor(dres, 16); dres += __shfl_xor(dres, 32);
                        const float c_ = gl * gelu_tanh(rl * dres) * (1.0f / PEER_VSC);
                        if (lane < 8 && urep == P8_UREPS - 1) list[i + lane] = (ev & 0xffffu) | (f2bf(c_) << 16);
                    }
                }
            }
#undef P8_ULOAD
#undef P8_UPROC2
        }
        asm volatile("s_waitcnt vmcnt(0)" ::: "memory");
        LDS_WAIT(); asm volatile("" ::: "memory");
#if P8_MIDSYNC == 1
        __syncthreads();
#elif P8_MIDSYNC == 2
        if (NGW == S / 4) xcd_barrier(xb);
#endif
        f32x4 acc[4][8];
#if (PROBE_DUP >> 12) & 1
#define P8_VREPS 2
#else
#define P8_VREPS 1
#endif
#ifndef P8_VRING
#define P8_VRING 8
#endif
#pragma unroll 1
        for (int vrep = 0; vrep < P8_VREPS; ++vrep) {
#pragma unroll
        for (int j = 0; j < 4; ++j)
#pragma unroll
            for (int q = 0; q < 8; ++q) acc[j][q] = (f32x4){0.f, 0.f, 0.f, 0.f};
        {
            typedef unsigned u32x16 __attribute__((ext_vector_type(16)));
            u32x4 v4[P8_VRING]; u32x2 v2[P8_VRING]; unsigned ven[P8_VRING];
            const unsigned li = (unsigned)lane & 3u;
            const unsigned m0 = li == 0u ? 0x0000ffffu : (li == 1u ? 0xffff0000u : 0u), m1 = li == 2u ? 0x0000ffffu : (li == 3u ? 0xffff0000u : 0u);
            const __amdgpu_buffer_rsrc_t vrs = __builtin_amdgcn_make_buffer_rsrc((void*)VT, 0, 16384 * PEER_ROWB, 0x00020000);
            const int vo4 = lane * 16, vo2 = lane * 8 + 1024;
#define P8_VLOADE(k, en_) do { const unsigned en = (en_); ven[k] = en; const int ro = (int)((en & 0x3fffu) * (unsigned)PEER_ROWB); \
            v4[k] = __builtin_amdgcn_raw_buffer_load_b128(vrs, vo4, ro, 0); v2[k] = __builtin_amdgcn_raw_buffer_load_b64(vrs, vo2, ro, 0); } while (0)
#define P8_VLOAD(k, i) do { const unsigned en = (unsigned)__builtin_amdgcn_readfirstlane((int)list[(i)]); ven[k] = en; const int ro = (int)((en & 0x3fffu) * (unsigned)PEER_ROWB); \
            v4[k] = __builtin_amdgcn_raw_buffer_load_b128(vrs, vo4, ro, 0); v2[k] = __builtin_amdgcn_raw_buffer_load_b64(vrs, vo2, ro, 0); } while (0)
#define P8_VPROC(k) do { const u32x6 pk = {v4[k][0], v4[k][1], v4[k][2], v4[k][3], v2[k][0], v2[k][1]}; \
            const u32x16 r_ = __builtin_bit_cast(u32x16, __builtin_amdgcn_cvt_scalef32_pk32_bf16_fp6(pk, 1.0f)); \
            const unsigned e_ = ven[k], cf = (e_ >> 16) | (e_ & 0xffff0000u); \
            const s16x4 av = __builtin_bit_cast(s16x4, (u32x2){cf & m0, cf & m1}); \
            _Pragma("unroll") for (int q = 0; q < 8; ++q) \
                acc[(k) & 3][q] = __builtin_amdgcn_mfma_f32_4x4x4bf16_1k(av, __builtin_bit_cast(s16x4, (u32x2){r_[2 * q], r_[2 * q + 1]}), acc[(k) & 3][q], 0, 0, 0); } while (0)
#pragma unroll
            for (int k = 0; k < P8_VRING; ++k) P8_VLOAD(k, k);
#pragma unroll 1
            for (int i = 0; i < 512 - 512 % P8_VRING; i += P8_VRING) {
                if (P8_SWEEPSYNC && i == 256 && NGW == S / 4) xcd_local_barrier(xb);
                const int nxi = i + P8_VRING + (lane & 7);
                const unsigned nxv = list[nxi < 512 ? nxi : 504 + (lane & 7)];
#pragma unroll
                for (int k = 0; k < P8_VRING; ++k) { P8_VPROC(k); P8_VLOADE(k, (unsigned)__builtin_amdgcn_readlane((int)nxv, k)); }
            }
#pragma unroll
            for (int k = 0; k < 512 % P8_VRING; ++k) P8_VPROC(k);
#undef P8_VLOAD
#undef P8_VPROC
        }
        }
        int tq = t0, lq = lane; asm volatile("" : "+s"(tq)); asm volatile("" : "+v"(lq));
#pragma unroll
        for (int j = 0; j < 4; ++j)
#pragma unroll
            for (int i = 0; i < 8; ++i) {
                const size_t o = (size_t)(tq + j) * DM + (i * 64 + lq) * 4;
                const u32x2 xw = *(const u32x2*)(x1b + o);
                f32x4 a = {bflo(xw.x), bfhi(xw.x), bflo(xw.y), bfhi(xw.y)};
                a += acc[j][i];
                __builtin_nontemporal_store(a, (f32x4*)(dst + o));
                if (i & 1) asm volatile("" ::: "memory");
            }
        LDS_WAIT(); asm volatile("" ::: "memory");
    }
}

__global__ void __launch_bounds__(NTHREADS, 2) mega(Params p) {
    extern __shared__ __attribute__((aligned(16))) unsigned char lds_raw[];
    LAS unsigned char* lds = (LAS unsigned char*)lds_raw;
    const int tid = threadIdx.x, lane = tid & 63, wave = __builtin_amdgcn_readfirstlane(tid >> 6);
    const int G = gridDim.x, bx = blockIdx.x;
    const int gw = bx * 8 + wave, NGW = G * 8;
    unsigned char* ws = p.ws;
    const int lo = p.ph_lo, hi = p.ph_hi;
    volatile LAS unsigned* misc = (volatile LAS unsigned*)(lds + LDS_MISC);
    if (tid < 4) misc[tid] = 0u;
    __syncthreads();
    const XcdBarrier xbar = xcd_barrier_post((unsigned*)(ws + WS_CTL), misc);
#ifndef PH_MASK
#define PH_MASK 0x1ff
#endif
#define IN(k) (((PH_MASK >> (k)) & 1) && lo <= (k) && (k) < hi)
#define SEAM(k) do { if (IN(k) && IN((k) + 1)) xcd_barrier(xbar); } while (0)

#if (PROBE_DUP >> 0) & 1
    if (IN(0)) { phase0(p, lds, G == 256, gw, NGW, wave, lane); xcd_barrier(xbar); }
#endif
    if (IN(0)) phase0(p, lds, G == 256, gw, NGW, wave, lane);
    SEAM(0);
    const bool part = (G == 256) && (misc[2] != 0u);
    const int vx = __builtin_amdgcn_readfirstlane(part ? (int)xbar.x : (bx & 7)), vr = __builtin_amdgcn_readfirstlane(part ? (int)misc[3] : (bx >> 3));
    const int vpanel = (vr >> 3) == 0 ? vx : ((vr >> 3) == 1 ? 31 - vx : ((vr >> 3) == 2 ? vx + 8 : 23 - vx));
    const int gwv = (G == 256) ? vpanel * 64 + (vr & 7) * 8 + wave : gw;
#define SEAM_X(k) do { if (IN(k) && IN((k) + 1)) { if (part) xcd_local_barrier_acq(xbar); else xcd_barrier(xbar); } } while (0)
    if (IN(1)) {
        pg8::Gemm g{(const bf16_t*)(ws + WS_XB), (const bf16_t*)(ws + WS_WIN), S, NINP, DM, DM, DM};
        pg8::StaticOrder So; So.init(S, NINP, G, bx);
        if (G == 256) {
            const int p2 = (vr >> 2) == 0 ? vx : ((vr >> 2) == 1 ? 31 - vx : ((vr >> 2) == 2 ? vx + 8 : 23 - vx));
            if (vr < 16) So.fixed2(vpanel, vr & 7, p2, 8 + (vr & 3)); else So.fixed(vpanel, vr & 7);
        }
        pg8::Epi<1> E{(const float*)(ws + WS_RSTD1), 0.f, (float*)(ws + WS_ROWSS), (bf16_t*)(ws + WS_PROJ), NINP, nullptr, nullptr};
#if (PROBE_DUP >> 1) & 1
        { pg8::Epi<1> E2 = E; E2.ss = (float*)(ws + 512 * 1024); pg8::gemm_phase<pg8::Epi<1>, pg8::StaticOrder, true, true>(lds, g, So, E2); xcd_barrier(xbar); }
#endif
        pg8::gemm_phase<pg8::Epi<1>, pg8::StaticOrder, true, true>(lds, g, So, E);
        if (G == 256 && vr >= 16) {
            __syncthreads();
            const int pw = (vr - 16) * 8 + wave, pk = pw >> 5;
            rope_rows8(p, (pk == 0 ? vx : (pk == 1 ? 31 - vx : (pk == 2 ? vx + 8 : 23 - vx))) * 256 + (pw & 31) * 8, lane);
            prep_late(p, lds, (vx * 16 + vr - 16) * 8 + wave, 1024, wave, lane, 2, 0, G == 256 ? 1536 : (1 << 30));
        }
    }
    SEAM_X(1);
    if (IN(2)) {
        {
            pg8::Gemm g{(const bf16_t*)(ws + WS_PROJ) + 2048, (const bf16_t*)(ws + WS_WUQ), S, 1536, 512, NINP, 512};
            pg8::StaticOrder So; So.init(S, 1536, G, bx);
            if (G == 256) { if (vr < 24) { const int k = vr / 6; So.fixed(k == 0 ? vx : (k == 1 ? 31 - vx : (k == 2 ? vx + 8 : 23 - vx)), vr % 6); } else So.none(); }
            pg8::Epi<2> E{(const float*)(ws + WS_ROWSS) + 1 * S, 1.0f / 512.0f, nullptr, (bf16_t*)(ws + WS_QRAW), 1536, nullptr, nullptr};
            pg8::gemm_phase<pg8::Epi<2>, pg8::StaticOrder, true, true>(lds, g, So, E);
            if (G == 256 && vr >= 24) prep_late(p, lds, (vx * 8 + vr - 24) * 8 + wave, 512, wave, lane, 2 | 8, 1536, 2048);
        }
        __syncthreads();
        {
            pg8::Gemm g{(const bf16_t*)(ws + WS_PROJ) + 2560, (const bf16_t*)(ws + WS_WUKV), S, 2048, 256, NINP, 256};
            pg8::StaticOrder So; So.init(S, 2048, G, bx); if (G == 256) So.fixed(vpanel, vr & 7);
            pg8::Epi<6> E{(const float*)(ws + WS_ROWSS) + 2 * S, 1.0f / 256.0f, nullptr, (bf16_t*)(ws + WS_KVRAW), 2048, nullptr, nullptr, p.in[11], (LAS float*)(lds + 131072)};
            pg8::gemm_phase<pg8::Epi<6>, pg8::StaticOrder, true, false>(lds, g, So, E);
        }
    }
    SEAM(2);
#if (PROBE_DUP >> 3) & 1
    if (IN(3)) { phase3(p, gw, NGW, (S - gw + NGW - 1) / NGW, lane); xcd_barrier(xbar); }
#endif
    const int vP = (vr >> 4) ? vx + 8 : vx, vqa = ((vr >> 3) & 1) ? 62 - 2 * vP : 63 - 2 * vP, vqb = ((vr >> 3) & 1) ? 2 * vP + 1 : 2 * vP;
#define P4_BODY_ATT do { if (G == 256) { attn_unit(p, lds, vr & 7, vqa, tid, wave, lane); attn_unit(p, lds, vr & 7, vqb, tid, wave, lane); } \
        else for (int pr = bx; pr < 256; pr += G) { const int head = pr & 7, x = pr >> 3; attn_unit(p, lds, head, 63 - x, tid, wave, lane); attn_unit(p, lds, head, x, tid, wave, lane); } } while (0)
#define P4_BODY_GMLP do { if (G == 256) { gmlp_unit(p, lds, vqa, vr & 7, tid, wave, lane); gmlp_unit(p, lds, vqb, vr & 7, tid, wave, lane); } \
        else for (int u = bx; u < 512; u += G) gmlp_unit(p, lds, u >> 3, u & 7, tid, wave, lane); } while (0)
#if (PROBE_DUP >> 4) & 1
    if (IN(4)) { P4_BODY_ATT; xcd_barrier(xbar); }
#endif
#if (PROBE_DUP >> 9) & 1
    if (IN(4)) { P4_BODY_GMLP; xcd_barrier(xbar); }
#endif
    if (IN(4)) { P4_BODY_ATT; P4_BODY_GMLP; }
    SEAM_X(4);
    if (IN(5)) {
        pg8::Gemm g{(const bf16_t*)(ws + WS_MIX), (const bf16_t*)(ws + WS_WOUT), S, DM, DM, DM, DM};
        pg8::StaticOrder So; So.init(S, DM, G, bx); if (G == 256) So.fixed(vpanel, vr & 7);
        pg8::Epi<4> E{nullptr, 0.f, (float*)(ws + WS_ROWSS) + 3 * S, (bf16_t*)(ws + WS_X1B), DM, p.out, (const float*)(ws + WS_XB)};
#if (PROBE_DUP >> 5) & 1
        { pg8::Epi<4> E2 = E; E2.ss = (float*)(ws + 512 * 1024); pg8::gemm_phase<pg8::Epi<4>, pg8::StaticOrder, true, true>(lds, g, So, E2); xcd_barrier(xbar); }
#endif
        pg8::gemm_phase<pg8::Epi<4>, pg8::StaticOrder, true, true>(lds, g, So, E);
    }
    SEAM_X(5);
    if (IN(6)) {
        pg8::Gemm g{(const bf16_t*)(ws + WS_X1B), (const bf16_t*)(ws + WS_WS), S, DM, DM, DM, DM};
        pg8::StaticOrder So; So.init(S, DM, G, bx); if (G == 256) So.fixed(vpanel, vr & 7);
        pg8::Epi<5> E{(const float*)(ws + WS_ROWSS) + 3 * S, 1.0f / DM, nullptr, nullptr, DM, (float*)(ws + WS_SC), nullptr};
#if (PROBE_DUP >> 6) & 1
        { pg8::gemm_phase<pg8::Epi<5>, pg8::StaticOrder, true, true>(lds, g, So, E); xcd_barrier(xbar); }
#endif
        pg8::gemm_phase<pg8::Epi<5>, pg8::StaticOrder, true, true>(lds, g, So, E);
    }
    SEAM_X(6);
#if (PROBE_DUP >> 7) & 1
    if (IN(7)) { phase7(p, lds, gwv, NGW, wave, lane, G == 256); xcd_barrier(xbar); }
#endif
    if (IN(7)) phase7(p, lds, gwv, NGW, wave, lane, G == 256);
    if (IN(7) && IN(8)) xcd_barrier(xbar);
#if (PROBE_DUP >> 8) & 1
    if (IN(8)) { phase8(p, lds, (float*)(ws + WS_SC), xbar, gwv, NGW, wave, lane); xcd_barrier(xbar); }
#endif
    if (IN(8)) phase8(p, lds, p.out, xbar, gwv, NGW, wave, lane);
#undef IN
#undef SEAM
#undef SEAM_X
}

extern "C" void kernel_launch(void* const* d_in, const int* in_sizes, int n_in, void* d_out, int out_size, void* d_ws, size_t ws_size, hipStream_t stream) {
    static int grid = 0;
    if (grid == 0) {
        if (n_in != 18 || out_size != S * DM || ws_size < WS_END) { fprintf(stderr, "kernel_launch: unexpected shapes (n_in %d out %d ws %zu)\n", n_in, out_size, ws_size); grid = -1; return; }
        int dev = 0, cus = 0, per_cu = 0;
        hipGetDevice(&dev);
        hipDeviceGetAttribute(&cus, hipDeviceAttributeMultiprocessorCount, dev);
        if (hipFuncSetAttribute((const void*)mega, hipFuncAttributeMaxDynamicSharedMemorySize, LDS_BYTES) != hipSuccess) { fprintf(stderr, "kernel_launch: hipFuncSetAttribute failed\n"); grid = -1; return; }
        if (hipOccupancyMaxActiveBlocksPerMultiprocessor(&per_cu, (const void*)mega, NTHREADS, LDS_BYTES) != hipSuccess || per_cu < 1) { fprintf(stderr, "kernel_launch: occupancy query failed (%d)\n", per_cu); grid = -1; return; }
        grid = cus;
        fprintf(stderr, "kernel_launch: cus %d per_cu %d grid %d\n", cus, per_cu, grid);
    }
    if (grid < 0) return;
    hipMemsetAsync((char*)d_ws + WS_CTL, 0, 256 * 1024, stream);
    Params prm{};
    for (int i = 0; i < 18; ++i) prm.in[i] = (const float*)d_in[i];
    prm.out = (float*)d_out; prm.ws = (unsigned char*)d_ws;
#if MK_ONE_LAUNCH
    prm.ph_lo = 0; prm.ph_hi = NPH;
    { void* args[] = {&prm}; hipError_t e = hipLaunchCooperativeKernel((const void*)mega, dim3(grid), dim3(NTHREADS), args, LDS_BYTES, stream);
      if (e != hipSuccess) fprintf(stderr, "cooperative launch failed: %s\n", hipGetErrorString(e)); }
#else
    for (int ph = 0; ph < NPH; ++ph) {
        prm.ph_lo = ph; prm.ph_hi = ph + 1;
        void* args[] = {&prm};
        hipError_t e = hipLaunchCooperativeKernel((const void*)mega, dim3(grid), dim3(NTHREADS), args, LDS_BYTES, stream);
        if (e != hipSuccess) { fprintf(stderr, "cooperative launch %d failed: %s\n", ph, hipGetErrorString(e)); break; }
    }
#endif
}
```
